# Optimizing an MI355X kernel written in HIP

```python
import jax
import jax.numpy as jnp
from jax import lax
import numpy as np

D_MODEL = 1024
BATCH = 4
SEQ = 8192
DEPTH = 2

D_MIX = D_MODEL
GLA_HEADS = 4
GLA_VW = D_MIX // 2
GLA_KW = GLA_VW // 2
GLA_DV = GLA_VW // GLA_HEADS
GLA_DK = GLA_KW // GLA_HEADS
GLA_GATE_RANK = 16
GLA_GATE_NORM = 16.0
GLA_CHUNK = 64
RWKV_VW = D_MIX - GLA_VW
RWKV_HEAD = 64
RWKV_HEADS = RWKV_VW // RWKV_HEAD
DECAY_LORA = 64
AAA_LORA = 64
GATE_LORA = 128
MV_LORA = 32
GN_EPS = 64e-5
D_FF = 128 * ((8 * D_MODEL // 3 + 127) // 128)
CONV_W = 3
NORM_EPS = 1e-6
N_MOD = 6
GLA_COLS = 2 * GLA_KW + 2 * GLA_VW + GLA_GATE_RANK
RWKV_COLS = 3 * RWKV_VW + DECAY_LORA + AAA_LORA + GATE_LORA
IN_COLS = GLA_COLS + RWKV_COLS

kernel_name = 'hybrid_gla_rwkv7_convffn_adaln'


def rms_norm(x, g):
    xf = x.astype(jnp.float32)
    y = xf * lax.rsqrt(jnp.mean(xf * xf, axis=-1, keepdims=True) + NORM_EPS)
    return (y * g.astype(jnp.float32)).astype(x.dtype)


def modulate(x, g, shift, scale):
    return rms_norm(x, g) * (1 + scale[:, None, :]) + shift[:, None, :]


def token_shift(p):
    return jnp.pad(p, ((0, 0), (1, 0), (0, 0)))[:, :-1]


def gla_chunked(q, k, v, gk):
    B, T, H, DK = q.shape
    DV = v.shape[-1]
    NC = T // GLA_CHUNK

    def to_chunks(t):
        return t.reshape(B, NC, GLA_CHUNK, H, t.shape[-1]).transpose(1, 0, 3, 2, 4).astype(jnp.float32)

    qc, kc, vc, gc = (to_chunks(t) for t in (q, k, v, gk))
    G = jnp.cumsum(gc, axis=3)
    causal = jnp.tril(jnp.ones((GLA_CHUNK, GLA_CHUNK), dtype=bool))[:, :, None]

    def step(S, inp):
        qi, ki, vi, Gi = inp
        inter = jnp.einsum('bhid,bhde->bhie', qi * jnp.exp(Gi), S)
        rel = jnp.where(causal, Gi[:, :, :, None, :] - Gi[:, :, None, :, :], -jnp.inf)
        A = jnp.einsum('bhid,bhjd,bhijd->bhij', qi, ki, jnp.exp(rel))
        o = inter + jnp.einsum('bhij,bhje->bhie', A, vi)
        G_last = Gi[:, :, -1, :]
        S = jnp.exp(G_last)[..., None] * S + jnp.einsum(
            'bhjd,bhje->bhde', ki * jnp.exp(G_last[:, :, None, :] - Gi), vi)
        return S, o

    S0 = jnp.zeros((B, H, DK, DV), jnp.float32)
    _, o = lax.scan(step, S0, (qc, kc, vc, G))
    return o.transpose(1, 0, 3, 2, 4).reshape(B, T, H, DV)


def gla_group(p, gk_up, gk_b, norm_g):
    B, T, _ = p.shape
    q = p[..., :GLA_KW].reshape(B, T, GLA_HEADS, GLA_DK) * (GLA_DK ** -0.5)
    k = p[..., GLA_KW:2 * GLA_KW].reshape(B, T, GLA_HEADS, GLA_DK)
    v = p[..., 2 * GLA_KW:2 * GLA_KW + GLA_VW].reshape(B, T, GLA_HEADS, GLA_DV)
    g = p[..., 2 * GLA_KW + GLA_VW:2 * GLA_KW + 2 * GLA_VW]
    z = p[..., 2 * GLA_KW + 2 * GLA_VW:]
    gk = jax.nn.log_sigmoid((z @ gk_up + gk_b).astype(jnp.float32)) / GLA_GATE_NORM
    o = gla_chunked(q, k, v, gk.reshape(B, T, GLA_HEADS, GLA_DK))
    o = rms_norm(o, norm_g).reshape(B, T, GLA_VW)
    return o.astype(p.dtype) * jax.nn.silu(g)


def wkv7_scan(r, w, k, v, a, b):
    B, T, H, N = r.shape
    xs = tuple(t.transpose(1, 0, 2, 3) for t in (r, w, k, v, a, b))

    def step(S, inp):
        rt, wt, kt, vt, at, bt = inp
        sa = jnp.einsum('bhvk,bhk->bhv', S, at)
        S = S * wt[:, :, None, :] + sa[..., None] * bt[:, :, None, :] + vt[..., None] * kt[:, :, None, :]
        return S, jnp.einsum('bhvk,bhk->bhv', S, rt)

    _, y = lax.scan(step, jnp.zeros((B, H, N, N), jnp.float32), xs)
    return y.transpose(1, 0, 2, 3)


def rwkv7_group(p, mu, w_up, w0, a_up, a0, g_up, k_k, k_a, r_k, gn_g, gn_b, v_first, v_up, v0):
    B, T, _ = p.shape
    H, N = RWKV_HEADS, RWKV_HEAD
    p = p + (token_shift(p) - p) * mu
    c0 = 3 * RWKV_VW
    c1 = c0 + DECAY_LORA
    c2 = c1 + AAA_LORA
    c3 = c2 + GATE_LORA
    r = p[..., :RWKV_VW]
    k = p[..., RWKV_VW:2 * RWKV_VW]
    v = p[..., 2 * RWKV_VW:c0]
    w_log = -jax.nn.softplus(-(w0 + jnp.tanh(p[..., c0:c1]) @ w_up)) - 0.5
    decay = jnp.exp(-jnp.exp(w_log.astype(jnp.float32)))
    a = jax.nn.sigmoid(a0 + p[..., c1:c2] @ a_up)
    g = jax.nn.sigmoid(p[..., c2:c3]) @ g_up
    if v_first is None:
        v_first = v
    else:
        v = v + (v_first - v) * jax.nn.sigmoid(v0 + p[..., c3:] @ v_up)
    kk = (k * k_k).reshape(B, T, H, N).astype(jnp.float32)
    kk = kk * lax.rsqrt(jnp.maximum(jnp.sum(kk * kk, axis=-1, keepdims=True), 1e-24))
    k = k * (1 + (a - 1) * k_a)

    def heads(t):
        return t.reshape(B, T, H, N).astype(jnp.float32)

    rh, kh, vh, ah = heads(r), heads(k), heads(v), heads(a)
    y = wkv7_scan(rh, decay.reshape(B, T, H, N), kh, vh, -kk, kk * ah)
    mean = jnp.mean(y, axis=-1, keepdims=True)
    var = jnp.mean(jnp.square(y - mean), axis=-1, keepdims=True)
    y = ((y - mean) * lax.rsqrt(var + GN_EPS)).reshape(B, T, RWKV_VW) * gn_g + gn_b
    bonus = jnp.sum(rh * kh * r_k, axis=-1, keepdims=True) * vh
    y = y + bonus.reshape(B, T, RWKV_VW)
    return (y * g).astype(p.dtype), v_first


def conv_ffn(h, w_up, conv_w, conv_b, w_down):
    T = h.shape[1]
    u = h @ w_up
    up = jnp.pad(u, ((0, 0), (CONV_W - 1, 0), (0, 0)))
    u = sum(conv_w[j] * up[:, j:j + T] for j in range(CONV_W)) + conv_b
    gate, val = jnp.split(u, 2, axis=-1)
    return (jax.nn.silu(gate) * val) @ w_down


def setup_inputs(seed: int = 0) -> dict:
    key = jax.random.key(seed)
    ks = jax.random.split(key, 31)
    L, Lv, D = DEPTH, DEPTH - 1, D_MODEL

    def nrm(k, shape, scale):
        return jax.random.normal(k, shape, jnp.float32) * scale

    def unif(k, shape, lo, hi):
        return jax.random.uniform(k, shape, jnp.float32, lo, hi)

    return {
        'x': nrm(ks[0], (BATCH, SEQ, D), 1.0),
        'c': nrm(ks[1], (BATCH, D), 1.0),
        'ada_w': nrm(ks[2], (L, D, N_MOD * D), 0.5 * D ** -0.5),
        'ada_b': nrm(ks[3], (L, N_MOD * D), 0.05),
        'norm_mix_g': 1.0 + nrm(ks[4], (L, D), 0.02),
        'w_in': nrm(ks[5], (L, D, IN_COLS), D ** -0.5),
        'w_in_vres': nrm(ks[6], (Lv, D, MV_LORA), D ** -0.5),
        'gla_gk_up': nrm(ks[7], (L, GLA_GATE_RANK, GLA_KW), GLA_GATE_RANK ** -0.5),
        'gla_gk_b': nrm(ks[8], (L, GLA_KW), 0.5),
        'gla_norm_g': 1.0 + nrm(ks[9], (L, GLA_DV), 0.02),
        'rwkv_mu': unif(ks[10], (L, RWKV_COLS), 0.0, 1.0),
        'rwkv_mu_vres': unif(ks[11], (Lv, MV_LORA), 0.0, 1.0),
        'w_lora_up': nrm(ks[12], (L, DECAY_LORA, RWKV_VW), 0.1 * DECAY_LORA ** -0.5),
        'w0': unif(ks[13], (L, RWKV_VW), -6.5, -1.5),
        'a_lora_up': nrm(ks[14], (L, AAA_LORA, RWKV_VW), AAA_LORA ** -0.5),
        'a0': nrm(ks[15], (L, RWKV_VW), 0.1),
        'g_lora_up': nrm(ks[16], (L, GATE_LORA, RWKV_VW), GATE_LORA ** -0.5),
        'v_lora_up': nrm(ks[17], (Lv, MV_LORA, RWKV_VW), MV_LORA ** -0.5),
        'v0': 1.0 + nrm(ks[18], (Lv, RWKV_VW), 0.1),
        'k_k': 0.85 + nrm(ks[19], (L, RWKV_VW), 0.02),
        'k_a': 1.0 + nrm(ks[20], (L, RWKV_VW), 0.02),
        'r_k': nrm(ks[21], (L, RWKV_HEADS, RWKV_HEAD), 0.1),
        'gn_g': 1.0 + nrm(ks[22], (L, RWKV_VW), 0.02),
        'gn_b': nrm(ks[23], (L, RWKV_VW), 0.02),
        'w_out': nrm(ks[24], (L, D_MIX, D), D_MIX ** -0.5),
        'norm_ffn_g': 1.0 + nrm(ks[25], (L, D), 0.02),
        'ffn_up': nrm(ks[26], (L, D, 2 * D_FF), D ** -0.5),
        'ffn_conv_w': nrm(ks[27], (L, CONV_W, 2 * D_FF), CONV_W ** -0.5),
        'ffn_conv_b': nrm(ks[28], (L, 2 * D_FF), 0.02),
        'ffn_down': nrm(ks[29], (L, D_FF, D), D_FF ** -0.5),
        'final_g': 1.0 + nrm(ks[30], (D,), 0.02),
    }


def reference(x, c, ada_w, ada_b, norm_mix_g, w_in, w_in_vres, gla_gk_up, gla_gk_b, gla_norm_g,
              rwkv_mu, rwkv_mu_vres, w_lora_up, w0, a_lora_up, a0, g_lora_up, v_lora_up, v0,
              k_k, k_a, r_k, gn_g, gn_b, w_out, norm_ffn_g, ffn_up, ffn_conv_w, ffn_conv_b,
              ffn_down, final_g):
    v_first = None
    for l in range(DEPTH):
        mod = jax.nn.silu(c) @ ada_w[l] + ada_b[l]
        sh_m, sc_m, gt_m, sh_f, sc_f, gt_f = jnp.split(mod, N_MOD, axis=-1)
        h = modulate(x, norm_mix_g[l], sh_m, sc_m)
        if l == 0:
            w_proj, mu, v_up_l, v0_l = w_in[0], rwkv_mu[0], None, None
        else:
            w_proj = jnp.concatenate([w_in[l], w_in_vres[l - 1]], axis=1)
            mu = jnp.concatenate([rwkv_mu[l], rwkv_mu_vres[l - 1]], axis=0)
            v_up_l, v0_l = v_lora_up[l - 1], v0[l - 1]
        proj = h @ w_proj
        o_gla = gla_group(proj[..., :GLA_COLS], gla_gk_up[l], gla_gk_b[l], gla_norm_g[l])
        o_rwkv, v_first = rwkv7_group(proj[..., GLA_COLS:], mu, w_lora_up[l], w0[l], a_lora_up[l], a0[l],
                                      g_lora_up[l], k_k[l], k_a[l], r_k[l], gn_g[l], gn_b[l],
                                      v_first, v_up_l, v0_l)
        mixed = jnp.concatenate([o_gla, o_rwkv], axis=-1) @ w_out[l]
        x = x + gt_m[:, None, :] * mixed
        h = modulate(x, norm_ffn_g[l], sh_f, sc_f)
        x = x + gt_f[:, None, :] * conv_ffn(h, ffn_up[l], ffn_conv_w[l], ffn_conv_b[l], ffn_down[l])
    return rms_norm(x, final_g)
```

```cpp
#include <hip/hip_runtime.h>
#include <cstdio>
#include <cstdint>
namespace pg8 {
#define PG8_LAS __attribute__((address_space(3)))
typedef unsigned short bf16_t;
typedef short bf16x8 __attribute__((ext_vector_type(8)));
typedef float f32x4 __attribute__((ext_vector_type(4)));
typedef unsigned u32x4 __attribute__((ext_vector_type(4)));
constexpr int BM = 256, BK = 64, HALF = 128, HTB = HALF * BK * 2  , STAGE_BYTES = 8 * HTB, NXCD = 8, WGM = 8;

__host__ __device__ __forceinline__ int lds_byte(int r, int c) { const int st = (r >> 4) * 2 + (c >> 5), rr = r & 15, cc = c & 31, ob = rr * 64 + cc * 2; return st * 1024 + (ob ^ (((ob >> 9) & 1) << 5)); }
__host__ __device__ __forceinline__ void stage_rc(int b, int& R, int& C) { const int st = b / 1024, sb = b % 1024, swz = sb ^ (((sb >> 9) & 1) << 5); R = (st >> 1) * 16 + swz / 64; C = (st & 1) * 32 + (swz % 64) / 2; }
__host__ __device__ __forceinline__ int perm32(int rho) { const int n = rho >> 4, i = rho & 15; return 8 * (i >> 2) + 4 * n + (i & 3); }

struct Unit { int pm, pn; };
struct Gemm { const bf16_t* A; const bf16_t* Bt; int M, N, K; };

struct StaticOrder {
    int nM, nN, nwg, G, c;
    __host__ __device__ void init(int M, int N, int G_, int c_) { nM = M / BM; nN = N / BM; nwg = nM * nN; G = G_; c = c_; }
    __host__ __device__ bool next(int i, Unit& u) const {
        const long L = (long)i * G + c; if (L >= nwg) return false;
        int wgid = (int)L; { const int q = nwg / NXCD, r = nwg % NXCD, xcd = wgid % NXCD, off = wgid / NXCD; wgid = (xcd < r ? xcd * (q + 1) : r * (q + 1) + (xcd - r) * q) + off; }
        const int nig = WGM * nN, gid = wgid / nig, fm = gid * WGM, gsz = (nM - fm) < WGM ? (nM - fm) : WGM;
        u.pm = fm + ((wgid % nig) % gsz); u.pn = (wgid % nig) / gsz; return true;
    }
    __device__ __forceinline__ void a_ready(const Unit&) const {}
    __device__ __forceinline__ void done(const Unit&) const {}
};

__device__ __forceinline__ unsigned cvt_pk_bf16(float lo, float hi) { unsigned r; asm volatile("v_cvt_pk_bf16_f32 %0, %1, %2" : "=v"(r) : "v"(lo), "v"(hi)); return r; }
typedef float f32x2 __attribute__((ext_vector_type(2)));
__device__ __forceinline__ f32x2 gelu_pk(f32x2 v) {
    const f32x2 av = __builtin_elementwise_abs(v), d = av * 0.2316418882f + 1.0f;
    f32x2 t; t.x = __builtin_amdgcn_rcpf(d.x); t.y = __builtin_amdgcn_rcpf(d.y);
    f32x2 q = t * 0.5307027145f + (-0.7265760135f); q = q * t + 0.7107068705f; q = q * t + (-0.142248368f); q = q * t + 0.127414796f; q = q * t;
    const f32x2 s = (v * v) * (-0.72134752044f);
    f32x2 e; e.x = __builtin_amdgcn_exp2f(s.x); e.y = __builtin_amdgcn_exp2f(s.y);
    const f32x2 m = v * (q * e), r = v - m;
    f32x2 o; o.x = v.x < 0.f ? m.x : r.x; o.y = v.y < 0.f ? m.y : r.y; return o;
}

template <int ACT  > struct EpiBf16 {
    static constexpr bool PERM = true, AFTER_DRAIN = false; static_assert(ACT == 0 || ACT == 1, "EpiBf16: ACT is 0 (none) or 1 (gelu_pk)");
    bf16_t* O; int ldc; const float* bias; int split_cols; size_t split_stride; float scale0;
    __device__ __forceinline__ void operator()(const f32x4 (&acc)[2][2][4][2], const Unit& u, int wr, int wc, int fr, int fq) const {
        const int row0 = u.pm * BM + wr * 64 + fr; int colt = u.pn * BM; bf16_t* base = O;
        float sc = 1.f; if (split_cols) { const int t = colt / split_cols; base += (size_t)t * split_stride; colt -= t * split_cols; if (t == 0) sc = scale0; }
        const int col0 = colt + wc * 32 + 8 * fq, bcol0 = u.pn * BM + wc * 32 + 8 * fq;
        f32x4 bv[2][2];
#pragma unroll
        for (int bj = 0; bj < 2; ++bj)
#pragma unroll
            for (int n = 0; n < 2; ++n) bv[bj][n] = bias ? *(const f32x4*)(bias + bcol0 + bj * HALF + 4 * n) : (f32x4){0.f, 0.f, 0.f, 0.f};
#pragma unroll
        for (int ai = 0; ai < 2; ++ai)
#pragma unroll
            for (int m = 0; m < 4; ++m) { bf16_t* rowp = base + (size_t)(row0 + ai * HALF + m * 16) * ldc + col0;
#pragma unroll
                for (int bj = 0; bj < 2; ++bj) { f32x4 v0 = acc[ai][bj][m][0] + bv[bj][0], v1 = acc[ai][bj][m][1] + bv[bj][1];
                    if (ACT == 1) { f32x2 a = gelu_pk((f32x2){v0[0], v0[1]}), b = gelu_pk((f32x2){v0[2], v0[3]}), c = gelu_pk((f32x2){v1[0], v1[1]}), d = gelu_pk((f32x2){v1[2], v1[3]});
                        v0 = (f32x4){a.x, a.y, b.x, b.y}; v1 = (f32x4){c.x, c.y, d.x, d.y}; }
                    v0 = v0 * sc; v1 = v1 * sc; u32x4 w; w.x = cvt_pk_bf16(v0[0], v0[1]); w.y = cvt_pk_bf16(v0[2], v0[3]); w.z = cvt_pk_bf16(v1[0], v1[1]); w.w = cvt_pk_bf16(v1[2], v1[3]);
                    *(u32x4*)(rowp + bj * HALF) = w; } }
    }
};
template <class Epi, class Sched, bool ALIGN_EPI = false, bool SP2 = false>
__device__ __forceinline__ void gemm_phase(PG8_LAS unsigned char* lds, const Gemm g, const Sched& S, const Epi& E) {
    const int tid = threadIdx.x, wid = __builtin_amdgcn_readfirstlane(tid >> 6), lane = tid & 63, wr = wid >> 2, wc = wid & 3, fr = lane & 15, fq = lane >> 4;
    const int K = g.K, nt = K / BK;
    unsigned voffA[2], voffB[2];
#pragma unroll
    for (int i = 0; i < 2; ++i) { int R, C; stage_rc(tid * 16 + i * 8192, R, C); const int Rb = Epi::PERM ? ((R & ~31) + perm32(R & 31)) : R;
        voffA[i] = (unsigned)(R * K + C) * 2u; voffB[i] = (unsigned)(Rb * K + C) * 2u; }
    const size_t kstep = (size_t)(BK * 2);
    const size_t hstep = (size_t)HALF * K * 2;
    const size_t tstep = 2 * hstep;
    const unsigned ldsw = (unsigned)wid * 1024u;
    const int aoff = lds_byte(wr * 64 + fr, fq * 8), boff = lds_byte(wc * 32 + fr, fq * 8);
#define PG8_SA(b, h) (((b) * 2 + (h)) * HTB)
#define PG8_SB(b, h) ((4 + (b) * 2 + (h)) * HTB)
#define PG8_STAGE(bufoff, gbase, voff) do { _Pragma("unroll") for (int _i = 0; _i < 2; ++_i) \
        __builtin_amdgcn_global_load_lds((const unsigned*)((const char*)(gbase) + (voff)[_i]), (PG8_LAS unsigned*)(lds + (bufoff) + ldsw + _i * 8192), 16, 0, 0); } while (0)
#define PG8_LDA(dst, b, h) do { _Pragma("unroll") for (int m = 0; m < 4; ++m) _Pragma("unroll") for (int k = 0; k < 2; ++k) dst[m][k] = *(const PG8_LAS bf16x8*)(lds + PG8_SA(b, h) + aoff + m * 2048 + k * 1024); } while (0)
#define PG8_LDB(dst, b, h) do { _Pragma("unroll") for (int n = 0; n < 2; ++n) _Pragma("unroll") for (int k = 0; k < 2; ++k) dst[n][k] = *(const PG8_LAS bf16x8*)(lds + PG8_SB(b, h) + boff + n * 2048 + k * 1024); } while (0)
#define PG8_MMA(ai, bj, At, Bt) do { __builtin_amdgcn_s_setprio(1); _Pragma("unroll") for (int m = 0; m < 4; ++m) _Pragma("unroll") for (int n = 0; n < 2; ++n) _Pragma("unroll") for (int k = 0; k < 2; ++k) \
        acc[ai][bj][m][n] = __builtin_amdgcn_mfma_f32_16x16x32_bf16(Bt[n][k], At[m][k], acc[ai][bj][m][n], 0, 0, 0); __builtin_amdgcn_s_setprio(0); } while (0)
#define PG8_WAIT_V(n) asm volatile("s_waitcnt vmcnt(" #n ")" ::: "memory")
#define PG8_WAIT_L(n) asm volatile("s_waitcnt lgkmcnt(" #n ")" ::: "memory")
#define PG8_BAR __builtin_amdgcn_s_barrier()
#define PG8_SCHED __builtin_amdgcn_sched_barrier(0)
    Unit cur, nxt; int ui = 0;
    if (!S.next(0, cur)) return;
    f32x4 acc[2][2][4][2];
#pragma unroll
    for (int a = 0; a < 2; ++a)
#pragma unroll
        for (int b = 0; b < 2; ++b)
#pragma unroll
            for (int m = 0; m < 4; ++m)
#pragma unroll
                for (int n = 0; n < 2; ++n) acc[a][b][m][n] = (f32x4){0.f, 0.f, 0.f, 0.f};
    bf16x8 At[4][2], B0[2][2], B1[2][2];
    const char* cA = (const char*)g.A + (size_t)cur.pm * tstep; const char* cB = (const char*)g.Bt + (size_t)cur.pn * tstep;
    S.a_ready(cur);
    if constexpr (SP2) {
        PG8_STAGE(PG8_SB(0, 0), cB, voffB); PG8_STAGE(PG8_SB(0, 1), cB + hstep, voffB); PG8_STAGE(PG8_SA(0, 0), cA, voffA); PG8_STAGE(PG8_SA(0, 1), cA + hstep, voffA);
        if (wr == 1) PG8_BAR;
        PG8_WAIT_V(2); PG8_BAR;
        PG8_STAGE(PG8_SB(1, 0), cB + kstep, voffB); PG8_STAGE(PG8_SA(1, 0), cA + kstep, voffA); PG8_STAGE(PG8_SB(1, 1), cB + hstep + kstep, voffB);
        PG8_WAIT_V(6); PG8_BAR;
    } else {
        PG8_STAGE(PG8_SB(0, 0), cB, voffB); PG8_STAGE(PG8_SA(0, 0), cA, voffA); PG8_STAGE(PG8_SB(0, 1), cB + hstep, voffB); PG8_STAGE(PG8_SA(0, 1), cA + hstep, voffA);
        if (wr == 1) PG8_BAR;
        PG8_WAIT_V(4); PG8_BAR;
        PG8_STAGE(PG8_SB(1, 0), cB + kstep, voffB); PG8_STAGE(PG8_SA(1, 0), cA + kstep, voffA); PG8_STAGE(PG8_SB(1, 1), cB + hstep + kstep, voffB);
        PG8_WAIT_V(6); PG8_BAR;
    }
    for (;;) {
        const bool has_next = S.next(ui + 1, nxt);
        const char* nA = has_next ? (const char*)g.A + (size_t)nxt.pm * tstep : cA; const char* nB = has_next ? (const char*)g.Bt + (size_t)nxt.pn * tstep : cB;
        for (int t = 0; t < nt; t += 2) {
            const bool last = (t == nt - 2);
            const char* a1 = cA + (size_t)(t + 1) * kstep;
            const char* a2 = last ? nA : cA + (size_t)(t + 2) * kstep; const char* b2 = last ? nB : cB + (size_t)(t + 2) * kstep;
            const char* a3 = a2 + kstep; const char* b3 = b2 + kstep;
            if (last && has_next) S.a_ready(nxt);
            if constexpr (SP2) {
            PG8_LDB(B0, 0, 0); PG8_LDB(B1, 0, 1); PG8_SCHED; PG8_LDA(At, 0, 0); PG8_STAGE(PG8_SA(1, 1), a1 + hstep, voffA);
            PG8_WAIT_V(8); PG8_WAIT_L(0); PG8_BAR; PG8_MMA(0, 0, At, B0); PG8_MMA(0, 1, At, B1); PG8_BAR; PG8_SCHED;
            PG8_LDA(At, 0, 1); PG8_STAGE(PG8_SB(0, 0), b2, voffB); PG8_STAGE(PG8_SB(0, 1), b2 + hstep, voffB); PG8_STAGE(PG8_SA(0, 0), a2, voffA);
            PG8_WAIT_V(8); PG8_WAIT_L(0); PG8_BAR; PG8_MMA(1, 0, At, B0); PG8_MMA(1, 1, At, B1); PG8_BAR; PG8_SCHED;
            PG8_LDB(B0, 1, 0); PG8_LDB(B1, 1, 1); PG8_SCHED; PG8_LDA(At, 1, 0); PG8_STAGE(PG8_SA(0, 1), a2 + hstep, voffA);
            PG8_WAIT_V(8); PG8_WAIT_L(0); PG8_BAR; PG8_MMA(0, 0, At, B0); PG8_MMA(0, 1, At, B1); PG8_BAR; PG8_SCHED;
            PG8_LDA(At, 1, 1); PG8_STAGE(PG8_SB(1, 0), b3, voffB); PG8_STAGE(PG8_SB(1, 1), b3 + hstep, voffB); PG8_STAGE(PG8_SA(1, 0), a3, voffA);
            PG8_WAIT_V(8); PG8_WAIT_L(0); PG8_BAR; PG8_MMA(1, 0, At, B0); PG8_MMA(1, 1, At, B1); PG8_BAR; PG8_SCHED;
            } else {
            PG8_LDB(B0, 0, 0); PG8_SCHED; PG8_LDA(At, 0, 0); PG8_STAGE(PG8_SA(1, 1), a1 + hstep, voffA);
            PG8_WAIT_L(8); PG8_BAR; PG8_WAIT_L(0); PG8_MMA(0, 0, At, B0); PG8_BAR; PG8_SCHED;
            PG8_LDB(B1, 0, 1); PG8_STAGE(PG8_SB(0, 0), b2, voffB);
            PG8_BAR; PG8_WAIT_L(0); PG8_MMA(0, 1, At, B1); PG8_BAR;
            PG8_LDA(At, 0, 1); PG8_STAGE(PG8_SA(0, 0), a2, voffA);
            PG8_BAR; PG8_WAIT_L(0); PG8_MMA(1, 0, At, B0); PG8_BAR; PG8_SCHED;
            PG8_STAGE(PG8_SB(0, 1), b2 + hstep, voffB);
            PG8_WAIT_V(6); PG8_BAR; PG8_MMA(1, 1, At, B1); PG8_BAR;
            PG8_LDB(B0, 1, 0); PG8_SCHED; PG8_LDA(At, 1, 0); PG8_STAGE(PG8_SA(0, 1), a2 + hstep, voffA);
            PG8_WAIT_L(8); PG8_BAR; PG8_WAIT_L(0); PG8_MMA(0, 0, At, B0); PG8_BAR; PG8_SCHED;
            PG8_LDB(B1, 1, 1); PG8_STAGE(PG8_SB(1, 0), b3, voffB);
            PG8_BAR; PG8_WAIT_L(0); PG8_MMA(0, 1, At, B1); PG8_BAR;
            PG8_LDA(At, 1, 1); PG8_STAGE(PG8_SA(1, 0), a3, voffA);
            PG8_BAR; PG8_WAIT_L(0); PG8_MMA(1, 0, At, B0); PG8_BAR; PG8_SCHED;
            PG8_STAGE(PG8_SB(1, 1), b3 + hstep, voffB);
            PG8_WAIT_V(6); PG8_BAR; PG8_MMA(1, 1, At, B1); PG8_BAR;
            }
        }
        if constexpr (ALIGN_EPI) { if (wr == 0) PG8_BAR; }
        if constexpr (!Epi::AFTER_DRAIN) { E(acc, cur, wr, wc, fr, fq); S.done(cur); }
        if (!has_next) break;
#pragma unroll
        for (int a = 0; a < 2; ++a)
#pragma unroll
            for (int b = 0; b < 2; ++b)
#pragma unroll
                for (int m = 0; m < 4; ++m)
#pragma unroll
                    for (int n = 0; n < 2; ++n) acc[a][b][m][n] = (f32x4){0.f, 0.f, 0.f, 0.f};
        cur = nxt; cA = nA; cB = nB; ++ui;
        if constexpr (ALIGN_EPI) { if (wr == 1) PG8_BAR; }
    }
    PG8_WAIT_V(0);
    if constexpr (!ALIGN_EPI) { if (wr == 0) PG8_BAR; }
    PG8_BAR;
    if constexpr (Epi::AFTER_DRAIN) { E.fused(acc, cur, wr, wc, fr, fq, lds, wid, lane); S.done(cur); }
#undef PG8_SA
#undef PG8_SB
#undef PG8_STAGE
#undef PG8_LDA
#undef PG8_LDB
#undef PG8_MMA
#undef PG8_WAIT_V
#undef PG8_WAIT_L
#undef PG8_BAR
#undef PG8_SCHED
}
}

namespace hy {
typedef unsigned short bf16;
typedef float f32x4 __attribute__((ext_vector_type(4)));
constexpr int B_ = 4, T_ = 8192, D_ = 1024, M_ = B_ * T_, L_ = 2;
constexpr int NIN = 3584, NPG = 1792, NPR = 1792;
constexpr int DFF = 2816, NUP = 5632, IN_COLS = 3344;
constexpr size_t MiB = 1u << 20;
constexpr size_t WS_MOD = 1 * MiB;
constexpr size_t WS_WIN = 2 * MiB, WS_WOUT = 9 * MiB, WS_WUP = 11 * MiB, WS_WDN = 22 * MiB, WS_INVN = 28 * MiB, WS_VL = 29 * MiB;
constexpr size_t WS_XB = 32 * MiB, WS_O = 96 * MiB, WS_VF = 160 * MiB, WS_GK = 192 * MiB, WS_PG = 224 * MiB, WS_PR = 336 * MiB, WS_END = 512 * MiB;
constexpr size_t WS_LW = WS_XB, WS_SAR = 224 * MiB, WS_SAK = 256 * MiB, WS_SAV = 288 * MiB, WS_SAA = 448 * MiB, WS_SAG = 480 * MiB, WS_Y = WS_PR;
constexpr size_t WS_ACT = 224 * MiB, WS_U = 400 * MiB;

__device__ __forceinline__ unsigned f2bf(float f) { unsigned u = __builtin_bit_cast(unsigned, f); return (u + 0x7fffu + ((u >> 16) & 1u)) >> 16; }
__device__ __forceinline__ float bf2f(bf16 h) { return __builtin_bit_cast(float, (unsigned)h << 16); }
__device__ __forceinline__ float sigmoidf_(float x) { return 1.f / (1.f + __expf(-x)); }
__device__ __forceinline__ float siluf_(float x) { return x / (1.f + __expf(-x)); }
__device__ __forceinline__ float softplusf_(float x) { return fmaxf(x, 0.f) + log1pf(__expf(-fabsf(x))); }

template <int CTRL> __device__ __forceinline__ float dpp_f(float v) {
    return __builtin_bit_cast(float, __builtin_amdgcn_update_dpp(0, __builtin_bit_cast(int, v), CTRL, 0xf, 0xf, false));
}
__device__ __forceinline__ float wave_sum(float v) {
    v += dpp_f<0xB1>(v);
    v += dpp_f<0x4E>(v);
    v += dpp_f<0x141>(v);
    v += dpp_f<0x140>(v);
    v += __shfl_xor(v, 16);
    v += __shfl_xor(v, 32);
    return v;
}

__global__ void __launch_bounds__(256) k_mod(const float* __restrict__ c, const float* __restrict__ ada_w, const float* __restrict__ ada_b, float* __restrict__ MOD) {
    __shared__ float sc[4][1024];
    __shared__ float red[4][4][64];
    const int l = blockIdx.y, j0 = blockIdx.x * 64, tid = threadIdx.x, w = tid >> 6, lane = tid & 63;
    for (int i = tid; i < 4096; i += 256) sc[i >> 10][i & 1023] = siluf_(c[i]);
    __syncthreads();
    const float* W = ada_w + (size_t)l * 1024 * 6144 + j0 + lane;
    float a0 = 0.f, a1 = 0.f, a2 = 0.f, a3 = 0.f;
    for (int k = w * 256; k < w * 256 + 256; ++k) { const float wv = W[(size_t)k * 6144]; a0 += sc[0][k] * wv; a1 += sc[1][k] * wv; a2 += sc[2][k] * wv; a3 += sc[3][k] * wv; }
    red[w][0][lane] = a0; red[w][1][lane] = a1; red[w][2][lane] = a2; red[w][3][lane] = a3;
    __syncthreads();
    { const int b = w; const float s = red[0][b][lane] + red[1][b][lane] + red[2][b][lane] + red[3][b][lane] + ada_b[l * 6144 + j0 + lane];
      MOD[((size_t)l * 4 + b) * 6144 + j0 + lane] = s; }
}

__global__ void __launch_bounds__(256) k_wprep(const float* __restrict__ W, int K, int Nsrc, int Ndst, bf16* __restrict__ Wt, int mode, const float* __restrict__ vres) {
    __shared__ float tile[32][33];
    const int n0 = blockIdx.x * 32, k0 = blockIdx.y * 32, tx = threadIdx.x & 31, ty = threadIdx.x >> 5;
    const int n = n0 + tx;
#pragma unroll
    for (int i = 0; i < 4; ++i) { const int k = k0 + ty + 8 * i; float v = 0.f;
        if (mode == 0) v = W[(size_t)k * Nsrc + n];
        else { if (n < 1552) v = W[(size_t)k * Nsrc + n]; else if (n < 1584) v = vres ? vres[(size_t)k * 32 + (n - 1552)] : 0.f; else if (n < 1792) v = 0.f; else v = W[(size_t)k * Nsrc + (n - 240)]; }
        tile[ty + 8 * i][tx] = v; }
    __syncthreads();
#pragma unroll
    for (int i = 0; i < 4; ++i) { const int nn = n0 + ty + 8 * i; Wt[(size_t)nn * K + k0 + tx] = (bf16)f2bf(tile[tx][ty + 8 * i]); }
}

__global__ void __launch_bounds__(512) k_norm(const float* __restrict__ x, const float* __restrict__ g, const float* __restrict__ sh, const float* __restrict__ sc, bf16* __restrict__ XB) {
    const int lane = threadIdx.x & 63, gw = blockIdx.x * 8 + (threadIdx.x >> 6), NGW = gridDim.x * 8;
    for (int m = gw; m < M_; m += NGW) {
        const int b = m / T_;
        const f32x4* xr = (const f32x4*)(x + (size_t)m * D_) + lane;
        f32x4 v[4]; float s = 0.f;
#pragma unroll
        for (int j = 0; j < 4; ++j) { v[j] = xr[64 * j]; s += (v[j].x * v[j].x + v[j].y * v[j].y) + (v[j].z * v[j].z + v[j].w * v[j].w); }
        const float rstd = 1.f / sqrtf(wave_sum(s) * (1.f / D_) + 1e-6f);
        unsigned long long* o8 = (unsigned long long*)(XB + (size_t)m * D_) + lane;
#pragma unroll
        for (int j = 0; j < 4; ++j) { const int col = 4 * lane + 256 * j;
            const f32x4 gv = *(const f32x4*)(g + col), shv = *(const f32x4*)(sh + b * 6144 + col), scv = *(const f32x4*)(sc + b * 6144 + col);
            const f32x4 h = v[j] * rstd * gv * (scv + 1.f) + shv;
            o8[64 * j] = (unsigned long long)(f2bf(h.x) | (f2bf(h.y) << 16)) | ((unsigned long long)(f2bf(h.z) | (f2bf(h.w) << 16)) << 32); }
    }
}
__global__ void __launch_bounds__(512) k_final(float* __restrict__ x, const float* __restrict__ g) {
    const int lane = threadIdx.x & 63, gw = blockIdx.x * 8 + (threadIdx.x >> 6), NGW = gridDim.x * 8;
    for (int m = gw; m < M_; m += NGW) {
        f32x4* xr = (f32x4*)(x + (size_t)m * D_) + lane;
        f32x4 v[4]; float s = 0.f;
#pragma unroll
        for (int j = 0; j < 4; ++j) { v[j] = xr[64 * j]; s += (v[j].x * v[j].x + v[j].y * v[j].y) + (v[j].z * v[j].z + v[j].w * v[j].w); }
        const float rstd = 1.f / sqrtf(wave_sum(s) * (1.f / D_) + 1e-6f);
#pragma unroll
        for (int j = 0; j < 4; ++j) { const f32x4 gv = *(const f32x4*)(g + 4 * lane + 256 * j); xr[64 * j] = v[j] * rstd * gv; }
    }
}

__global__ void __launch_bounds__(256) k_gkprep(const bf16* __restrict__ PG, const float* __restrict__ gk_up, const float* __restrict__ gk_b, float* __restrict__ GK, bf16* __restrict__ VL) {
    const int j = threadIdx.x;
    float wv[16];
#pragma unroll
    for (int i = 0; i < 16; ++i) wv[i] = gk_up[i * 256 + j];
    const float bj = gk_b[j];
    for (int m = blockIdx.x; m < M_; m += gridDim.x) {
        const bf16* row = PG + (size_t)m * NPG;
        float a = bj;
#pragma unroll
        for (int i = 0; i < 16; ++i) a += bf2f(row[1536 + i]) * wv[i];
        GK[(size_t)m * 256 + j] = -softplusf_(-a) * (1.f / 16.f);
        if (j < 32) VL[(size_t)m * 32 + j] = row[1552 + j];
    }
}

__global__ void __launch_bounds__(512) k_gla_scan(const bf16* __restrict__ PG, const float* __restrict__ GK, bf16* __restrict__ O) {
    const int wg = blockIdx.x, bh = wg >> 4, eb = wg & 15, b = bh >> 2, h = bh & 3;
    const int wave = threadIdx.x >> 6, lane = threadIdx.x & 63, e = eb * 8 + wave;
    const bf16* pg = PG + (size_t)b * T_ * NPG;
    const float* gk = GK + (size_t)b * T_ * 256 + h * 64 + lane;
    bf16* o = O + (size_t)b * T_ * D_ + h * 128 + e;
    float S = 0.f;
    for (int t0 = 0; t0 < T_; t0 += 8) {
        float q[8], k[8], v[8], g[8];
#pragma unroll
        for (int i = 0; i < 8; ++i) { const bf16* row = pg + (size_t)(t0 + i) * NPG;
            q[i] = bf2f(row[h * 64 + lane]); k[i] = bf2f(row[256 + h * 64 + lane]); v[i] = bf2f(row[512 + h * 128 + e]); g[i] = gk[(size_t)(t0 + i) * 256]; }
#pragma unroll
        for (int i = 0; i < 8; ++i) { S = S * __expf(g[i]) + k[i] * v[i]; const float r = wave_sum(q[i] * S) * 0.125f; if (lane == 0) o[(size_t)(t0 + i) * D_] = (bf16)f2bf(r); }
    }
}
__global__ void __launch_bounds__(512) k_gla_post(const bf16* __restrict__ PG, const float* __restrict__ norm_g, bf16* __restrict__ O) {
    const int lane = threadIdx.x & 63, gw = blockIdx.x * 8 + (threadIdx.x >> 6), NGW = gridDim.x * 8;
    for (int it = gw; it < M_ * 4; it += NGW) {
        const int m = it >> 2, h = it & 3;
        bf16* o = O + (size_t)m * D_ + h * 128; const bf16* g = PG + (size_t)m * NPG + 1024 + h * 128;
        const float o0 = bf2f(o[lane]), o1 = bf2f(o[64 + lane]);
        const float rstd = 1.f / sqrtf(wave_sum(o0 * o0 + o1 * o1) * (1.f / 128.f) + 1e-6f);
        o[lane] = (bf16)f2bf(o0 * rstd * norm_g[lane] * siluf_(bf2f(g[lane])));
        o[64 + lane] = (bf16)f2bf(o1 * rstd * norm_g[64 + lane] * siluf_(bf2f(g[64 + lane])));
    }
}

struct RwkvW { const float *mu, *mu_vres, *w_up, *w0, *a_up, *a0, *g_up, *v_up, *v0, *k_k; };
__global__ void __launch_bounds__(512) k_rwkv_prep(const bf16* __restrict__ PR, const bf16* __restrict__ VL, RwkvW W, int layer,
                                                   bf16* __restrict__ SAR, bf16* __restrict__ SAK, bf16* __restrict__ SAV, bf16* __restrict__ SAA, bf16* __restrict__ SAG,
                                                   float* __restrict__ LW, float* __restrict__ INVN, bf16* __restrict__ VF) {
    __shared__ __attribute__((aligned(16))) float lin[288][16];
    const int j = threadIdx.x, lane = j & 63, h = j >> 6;
    const int NI = layer ? 288 : 256;
    for (int grp = blockIdx.x; grp < M_ / 16; grp += gridDim.x) {
        const int m0 = grp * 16;
        __syncthreads();
        for (int idx = j; idx < 16 * NI; idx += 512) {
            const int tk = idx / NI, c = idx % NI, m = m0 + tk, t = m % T_;
            float cur, prev, mu;
            if (c < 256) { cur = bf2f(PR[(size_t)m * NPR + 1536 + c]); prev = t ? bf2f(PR[(size_t)(m - 1) * NPR + 1536 + c]) : 0.f; mu = W.mu[1536 + c]; }
            else { cur = bf2f(VL[(size_t)m * 32 + (c - 256)]); prev = t ? bf2f(VL[(size_t)(m - 1) * 32 + (c - 256)]) : 0.f; mu = W.mu_vres[c - 256]; }
            float p = cur + (prev - cur) * mu;
            if (c < 64) p = tanhf(p); else if (c >= 128 && c < 256) p = sigmoidf_(p);
            lin[c][tk] = p;
        }
        __syncthreads();
        float aw[16], aa[16], ag[16], av[16];
#pragma unroll
        for (int tk = 0; tk < 16; ++tk) { aw[tk] = 0.f; aa[tk] = 0.f; ag[tk] = 0.f; av[tk] = 0.f; }
        for (int i = 0; i < 64; ++i) { const float w1 = W.w_up[i * 512 + j], w2 = W.a_up[i * 512 + j];
#pragma unroll
            for (int q = 0; q < 4; ++q) { const f32x4 x1 = *(const f32x4*)&lin[i][4 * q], x2 = *(const f32x4*)&lin[64 + i][4 * q];
                aw[4 * q] += x1.x * w1; aw[4 * q + 1] += x1.y * w1; aw[4 * q + 2] += x1.z * w1; aw[4 * q + 3] += x1.w * w1;
                aa[4 * q] += x2.x * w2; aa[4 * q + 1] += x2.y * w2; aa[4 * q + 2] += x2.z * w2; aa[4 * q + 3] += x2.w * w2; } }
        for (int i = 0; i < 128; ++i) { const float w3 = W.g_up[i * 512 + j];
#pragma unroll
            for (int q = 0; q < 4; ++q) { const f32x4 x3 = *(const f32x4*)&lin[128 + i][4 * q];
                ag[4 * q] += x3.x * w3; ag[4 * q + 1] += x3.y * w3; ag[4 * q + 2] += x3.z * w3; ag[4 * q + 3] += x3.w * w3; } }
        if (layer) for (int i = 0; i < 32; ++i) { const float w4 = W.v_up[i * 512 + j];
#pragma unroll
            for (int q = 0; q < 4; ++q) { const f32x4 x4 = *(const f32x4*)&lin[256 + i][4 * q];
                av[4 * q] += x4.x * w4; av[4 * q + 1] += x4.y * w4; av[4 * q + 2] += x4.z * w4; av[4 * q + 3] += x4.w * w4; } }
        const float mur = W.mu[j], muk = W.mu[512 + j], muv = W.mu[1024 + j], w0 = W.w0[j], a0 = W.a0[j], kkc = W.k_k[j];
        const float v0 = layer ? W.v0[j] : 0.f;
#pragma unroll
        for (int tk = 0; tk < 16; ++tk) {
            const int m = m0 + tk, t = m % T_;
            const bf16* cr = PR + (size_t)m * NPR; const bf16* pr = cr - NPR;
            const float rc = bf2f(cr[j]), kc = bf2f(cr[512 + j]), vc = bf2f(cr[1024 + j]);
            const float rp = t ? bf2f(pr[j]) : 0.f, kp = t ? bf2f(pr[512 + j]) : 0.f, vp = t ? bf2f(pr[1024 + j]) : 0.f;
            const float r = rc + (rp - rc) * mur, k = kc + (kp - kc) * muk; float v = vc + (vp - vc) * muv;
            const float wlog = -softplusf_(-(w0 + aw[tk])) - 0.5f;
            const float lw = -__expf(wlog);
            const float as = sigmoidf_(a0 + aa[tk]);
            const size_t o = (size_t)m * 512 + j;
            if (layer) { const float vf = bf2f(VF[o]); v = v + (vf - v) * sigmoidf_(v0 + av[tk]); } else VF[o] = (bf16)f2bf(v);
            const float kk = k * kkc; const float ss = wave_sum(kk * kk);
            if (lane == 0) INVN[(size_t)m * 8 + h] = 1.f / sqrtf(fmaxf(ss, 1e-24f));
            SAR[o] = (bf16)f2bf(r); SAK[o] = (bf16)f2bf(k); SAV[o] = (bf16)f2bf(v); SAA[o] = (bf16)f2bf(as); SAG[o] = (bf16)f2bf(ag[tk]); LW[o] = lw;
        }
    }
}

__global__ void __launch_bounds__(512) k_rwkv_scan(const bf16* __restrict__ SAR, const bf16* __restrict__ SAK, const bf16* __restrict__ SAV, const bf16* __restrict__ SAA,
                                                   const float* __restrict__ LW, const float* __restrict__ INVN, const float* __restrict__ k_k, const float* __restrict__ k_a, float* __restrict__ Y) {
    const int wg = blockIdx.x, bh = wg >> 3, rb = wg & 7, b = bh >> 3, h = bh & 7;
    const int wave = threadIdx.x >> 6, lane = threadIdx.x & 63, row = rb * 8 + wave;
    const size_t base = (size_t)b * T_ * 512 + h * 64;
    const float kkc = k_k[h * 64 + lane], kac = k_a[h * 64 + lane];
    float S = 0.f;
    for (int t0 = 0; t0 < T_; t0 += 8) {
        float r[8], k[8], a[8], w[8], v[8], n[8];
#pragma unroll
        for (int i = 0; i < 8; ++i) { const size_t o = base + (size_t)(t0 + i) * 512;
            r[i] = bf2f(SAR[o + lane]); k[i] = bf2f(SAK[o + lane]); a[i] = bf2f(SAA[o + lane]); w[i] = LW[o + lane]; v[i] = bf2f(SAV[o + row]); n[i] = INVN[((size_t)b * T_ + t0 + i) * 8 + h]; }
#pragma unroll
        for (int i = 0; i < 8; ++i) {
            const float kk = k[i] * kkc * n[i], bb = kk * a[i], km = k[i] * (1.f + (a[i] - 1.f) * kac), dec = __expf(w[i]);
            const float sa = -wave_sum(S * kk);
            S = S * dec + sa * bb + v[i] * km;
            const float y = wave_sum(S * r[i]);
            if (lane == 0) Y[base + (size_t)(t0 + i) * 512 + row] = y;
        }
    }
}
__global__ void __launch_bounds__(512) k_rwkv_post(const float* __restrict__ Y, const bf16* __restrict__ SAR, const bf16* __restrict__ SAK, const bf16* __restrict__ SAV, const bf16* __restrict__ SAA,
                                                   const bf16* __restrict__ SAG, const float* __restrict__ k_a, const float* __restrict__ r_k, const float* __restrict__ gn_g, const float* __restrict__ gn_b, bf16* __restrict__ O) {
    const int lane = threadIdx.x & 63, gw = blockIdx.x * 8 + (threadIdx.x >> 6), NGW = gridDim.x * 8;
    for (int it = gw; it < M_ * 8; it += NGW) {
        const int m = it >> 3, h = it & 7, c = h * 64 + lane; const size_t o = (size_t)m * 512 + c;
        const float y = Y[o];
        const float mean = wave_sum(y) * (1.f / 64.f), d = y - mean, var = wave_sum(d * d) * (1.f / 64.f);
        const float yn = d * (1.f / sqrtf(var + 64e-5f)) * gn_g[c] + gn_b[c];
        const float r = bf2f(SAR[o]), k = bf2f(SAK[o]), v = bf2f(SAV[o]), a = bf2f(SAA[o]), g = bf2f(SAG[o]);
        const float km = k * (1.f + (a - 1.f) * k_a[c]);
        const float rk = wave_sum(r * km * r_k[c]);
        O[(size_t)m * D_ + 512 + c] = (bf16)f2bf((yn + rk * v) * g);
    }
}

__global__ void __launch_bounds__(256) k_conv(const bf16* __restrict__ U, const float* __restrict__ cw, const float* __restrict__ cb, bf16* __restrict__ ACT) {
    for (size_t idx = (size_t)blockIdx.x * 256 + threadIdx.x; idx < (size_t)T_ * DFF; idx += (size_t)gridDim.x * 256) {
        const int t = (int)(idx / DFF), j = (int)(idx % DFF);
        const bf16* u = U + (size_t)t * NUP;
        float g = cb[j], v = cb[DFF + j];
        g += cw[2 * NUP + j] * bf2f(u[j]); v += cw[2 * NUP + DFF + j] * bf2f(u[DFF + j]);
        if (t >= 1) { g += cw[NUP + j] * bf2f(u[j - NUP]); v += cw[NUP + DFF + j] * bf2f(u[DFF + j - NUP]); }
        if (t >= 2) { g += cw[j] * bf2f(u[j - 2 * NUP]); v += cw[DFF + j] * bf2f(u[DFF + j - 2 * NUP]); }
        ACT[(size_t)t * DFF + j] = (bf16)f2bf(siluf_(g) * v);
    }
}
}

namespace pg8 {
struct EpiRes {
    static constexpr bool PERM = false, AFTER_DRAIN = false;
    const float* base; float* out; const float* gate; int gstride;
    __device__ __forceinline__ void operator()(const f32x4 (&acc)[2][2][4][2], const Unit& u, int wr, int wc, int fr, int fq) const {
        const int b = (u.pm * BM) / 8192; const float* gp = gate + (size_t)b * gstride;
        const int col0 = u.pn * BM + wc * 32 + 4 * fq;
#pragma unroll
        for (int ai = 0; ai < 2; ++ai)
#pragma unroll
            for (int m = 0; m < 4; ++m) { const size_t off = (size_t)(u.pm * BM + ai * HALF + wr * 64 + m * 16 + fr) * 1024 + col0;
#pragma unroll
                for (int bj = 0; bj < 2; ++bj)
#pragma unroll
                    for (int n = 0; n < 2; ++n) { const int cc = bj * HALF + n * 16; const f32x4 gv = *(const f32x4*)(gp + col0 + cc); const f32x4 bs = *(const f32x4*)(base + off + cc);
                        *(f32x4*)(out + off + cc) = bs + gv * acc[ai][bj][m][n]; } }
    }
};
template <class Epi>
__global__ void __launch_bounds__(512, 2) k_gemm(Gemm g, Epi E) {
    extern __shared__ __attribute__((aligned(16))) unsigned char lds[];
    StaticOrder S; S.init(g.M, g.N, (int)gridDim.x, (int)blockIdx.x);
    gemm_phase<Epi, StaticOrder, true, true>((PG8_LAS unsigned char*)lds, g, S, E);
}
}

extern "C" void kernel_launch(void* const* d_in, const int* in_sizes, int n_in, void* d_out, int out_size, void* d_ws, size_t ws_size, hipStream_t stream) {
    using namespace hy;
    constexpr int LDS_BYTES = 131072 + 1024;
    static int ok = 0;
    if (ok == 0) {
        if (n_in != 31 || in_sizes[0] != M_ * D_ || out_size != M_ * D_ || ws_size < WS_END) { fprintf(stderr, "kernel_launch: unexpected shapes (n_in %d, in0 %d, out %d, ws %zu)\n", n_in, n_in > 0 ? in_sizes[0] : -1, out_size, ws_size); ok = -1; return; }
        hipError_t e1 = hipFuncSetAttribute((const void*)pg8::k_gemm<pg8::EpiBf16<0>>, hipFuncAttributeMaxDynamicSharedMemorySize, LDS_BYTES);
        hipError_t e2 = hipFuncSetAttribute((const void*)pg8::k_gemm<pg8::EpiRes>, hipFuncAttributeMaxDynamicSharedMemorySize, LDS_BYTES);
        if (e1 != hipSuccess || e2 != hipSuccess) { fprintf(stderr, "kernel_launch: hipFuncSetAttribute failed\n"); ok = -1; return; }
        ok = 1;
    }
    if (ok < 0) return;
    const float* const* in = (const float* const*)d_in;
    unsigned char* ws = (unsigned char*)d_ws;
    float* out = (float*)d_out;
    float* MOD = (float*)(ws + WS_MOD);
    bf16 *WIN = (bf16*)(ws + WS_WIN), *WOUT = (bf16*)(ws + WS_WOUT), *WUP = (bf16*)(ws + WS_WUP), *WDN = (bf16*)(ws + WS_WDN);
    bf16 *XB = (bf16*)(ws + WS_XB), *O = (bf16*)(ws + WS_O), *VF = (bf16*)(ws + WS_VF), *PG = (bf16*)(ws + WS_PG), *PR = (bf16*)(ws + WS_PR), *VL = (bf16*)(ws + WS_VL);
    bf16 *SAR = (bf16*)(ws + WS_SAR), *SAK = (bf16*)(ws + WS_SAK), *SAV = (bf16*)(ws + WS_SAV), *SAA = (bf16*)(ws + WS_SAA), *SAG = (bf16*)(ws + WS_SAG);
    float *GK = (float*)(ws + WS_GK), *LW = (float*)(ws + WS_LW), *INVN = (float*)(ws + WS_INVN), *Y = (float*)(ws + WS_Y);
    bf16 *ACT = (bf16*)(ws + WS_ACT), *U = (bf16*)(ws + WS_U);

    k_mod<<<dim3(96, 2), 256, 0, stream>>>(in[1], in[2], in[3], MOD);
    for (int l = 0; l < L_; ++l) {
        const float* modl = MOD + (size_t)l * 4 * 6144;
        k_wprep<<<dim3(NIN / 32, D_ / 32), 256, 0, stream>>>(in[5] + (size_t)l * D_ * IN_COLS, D_, IN_COLS, NIN, WIN, 1, l ? in[6] : nullptr);
        k_wprep<<<dim3(D_ / 32, D_ / 32), 256, 0, stream>>>(in[24] + (size_t)l * D_ * D_, D_, D_, D_, WOUT, 0, nullptr);
        k_wprep<<<dim3(NUP / 32, D_ / 32), 256, 0, stream>>>(in[26] + (size_t)l * D_ * NUP, D_, NUP, NUP, WUP, 0, nullptr);
        k_wprep<<<dim3(D_ / 32, DFF / 32), 256, 0, stream>>>(in[29] + (size_t)l * DFF * D_, DFF, D_, D_, WDN, 0, nullptr);
        const float* xres = l ? out : in[0];
        k_norm<<<256, 512, 0, stream>>>(xres, in[4] + l * D_, modl + 0 * D_, modl + 1 * D_, XB);
        { pg8::Gemm g{XB, WIN, M_, NIN, D_}; pg8::EpiBf16<0> E{PG, NPG, nullptr, NPG, (WS_PR - WS_PG) / 2, 1.f};
          pg8::k_gemm<pg8::EpiBf16<0>><<<256, 512, LDS_BYTES, stream>>>(g, E); }
        k_gkprep<<<1024, 256, 0, stream>>>(PG, in[7] + l * 16 * 256, in[8] + l * 256, GK, VL);
        k_gla_scan<<<256, 512, 0, stream>>>(PG, GK, O);
        k_gla_post<<<256, 512, 0, stream>>>(PG, in[9] + l * 128, O);
        { RwkvW W{in[10] + l * 1792, in[11], in[12] + l * 64 * 512, in[13] + l * 512, in[14] + l * 64 * 512, in[15] + l * 512, in[16] + l * 128 * 512, in[17], in[18], in[19] + l * 512};
          k_rwkv_prep<<<256, 512, 0, stream>>>(PR, VL, W, l, SAR, SAK, SAV, SAA, SAG, LW, INVN, VF); }
        k_rwkv_scan<<<256, 512, 0, stream>>>(SAR, SAK, SAV, SAA, LW, INVN, in[19] + l * 512, in[20] + l * 512, Y);
        k_rwkv_post<<<256, 512, 0, stream>>>(Y, SAR, SAK, SAV, SAA, SAG, in[20] + l * 512, in[21] + l * 512, in[22] + l * 512, in[23] + l * 512, O);
        { pg8::Gemm g{O, WOUT, M_, D_, D_}; pg8::EpiRes E{xres, out, modl + 2 * D_, 6144};
          pg8::k_gemm<pg8::EpiRes><<<256, 512, LDS_BYTES, stream>>>(g, E); }
        k_norm<<<256, 512, 0, stream>>>(out, in[25] + l * D_, modl + 3 * D_, modl + 4 * D_, XB);
        for (int b = 0; b < B_; ++b) {
            pg8::Gemm g{XB + (size_t)b * T_ * D_, WUP, T_, NUP, D_}; pg8::EpiBf16<0> E{U, NUP, nullptr, 0, 0, 1.f};
            pg8::k_gemm<pg8::EpiBf16<0>><<<256, 512, LDS_BYTES, stream>>>(g, E);
            k_conv<<<2048, 256, 0, stream>>>(U, in[27] + (size_t)l * 3 * NUP, in[28] + (size_t)l * NUP, ACT + (size_t)b * T_ * DFF);
        }
        { pg8::Gemm g{ACT, WDN, M_, D_, DFF}; pg8::EpiRes E{out, out, modl + 5 * D_, 6144};
          pg8::k_gemm<pg8::EpiRes><<<256, 512, LDS_BYTES, stream>>>(g, E); }
    }
    k_final<<<256, 512, 0, stream>>>(out, in[30]);
}
```

```cpp
#include <hip/hip_runtime.h>
#include <cstdio>
#include <cstdint>
namespace pg8 {
#define PG8_LAS __attribute__((address_space(3)))
typedef unsigned short bf16_t;
typedef short bf16x8 __attribute__((ext_vector_type(8)));
typedef float f32x4 __attribute__((ext_vector_type(4)));
typedef unsigned u32x4 __attribute__((ext_vector_type(4)));
constexpr int BM = 256, BK = 64, HALF = 128, HTB = HALF * BK * 2  , STAGE_BYTES = 8 * HTB, NXCD = 8, WGM = 8;

__host__ __device__ __forceinline__ int lds_byte(int r, int c) { const int st = (r >> 4) * 2 + (c >> 5), rr = r & 15, cc = c & 31, ob = rr * 64 + cc * 2; return st * 1024 + (ob ^ (((ob >> 9) & 1) << 5)); }
__host__ __device__ __forceinline__ void stage_rc(int b, int& R, int& C) { const int st = b / 1024, sb = b % 1024, swz = sb ^ (((sb >> 9) & 1) << 5); R = (st >> 1) * 16 + swz / 64; C = (st & 1) * 32 + (swz % 64) / 2; }
__host__ __device__ __forceinline__ int perm32(int rho) { const int n = rho >> 4, i = rho & 15; return 8 * (i >> 2) + 4 * n + (i & 3); }

struct Unit { int pm, pn; };
struct Gemm { const bf16_t* A; const bf16_t* Bt; int M, N, K; };

struct StaticOrder {
    int nM, nN, nwg, G, c;
    __host__ __device__ void init(int M, int N, int G_, int c_) { nM = M / BM; nN = N / BM; nwg = nM * nN; G = G_; c = c_; }
    __host__ __device__ bool next(int i, Unit& u) const {
        const long L = (long)i * G + c; if (L >= nwg) return false;
        int wgid = (int)L; { const int q = nwg / NXCD, r = nwg % NXCD, xcd = wgid % NXCD, off = wgid / NXCD; wgid = (xcd < r ? xcd * (q + 1) : r * (q + 1) + (xcd - r) * q) + off; }
        const int nig = WGM * nN, gid = wgid / nig, fm = gid * WGM, gsz = (nM - fm) < WGM ? (nM - fm) : WGM;
        u.pm = fm + ((wgid % nig) % gsz); u.pn = (wgid % nig) / gsz; return true;
    }
    __device__ __forceinline__ void a_ready(const Unit&) const {}
    __device__ __forceinline__ void done(const Unit&) const {}
};

__device__ __forceinline__ unsigned cvt_pk_bf16(float lo, float hi) { unsigned r; asm volatile("v_cvt_pk_bf16_f32 %0, %1, %2" : "=v"(r) : "v"(lo), "v"(hi)); return r; }
typedef float f32x2 __attribute__((ext_vector_type(2)));
__device__ __forceinline__ f32x2 gelu_pk(f32x2 v) {
    const f32x2 av = __builtin_elementwise_abs(v), d = av * 0.2316418882f + 1.0f;
    f32x2 t; t.x = __builtin_amdgcn_rcpf(d.x); t.y = __builtin_amdgcn_rcpf(d.y);
    f32x2 q = t * 0.5307027145f + (-0.7265760135f); q = q * t + 0.7107068705f; q = q * t + (-0.142248368f); q = q * t + 0.127414796f; q = q * t;
    const f32x2 s = (v * v) * (-0.72134752044f);
    f32x2 e; e.x = __builtin_amdgcn_exp2f(s.x); e.y = __builtin_amdgcn_exp2f(s.y);
    const f32x2 m = v * (q * e), r = v - m;
    f32x2 o; o.x = v.x < 0.f ? m.x : r.x; o.y = v.y < 0.f ? m.y : r.y; return o;
}

template <int ACT  > struct EpiBf16 {
    static constexpr bool PERM = true, AFTER_DRAIN = false; static_assert(ACT == 0 || ACT == 1, "EpiBf16: ACT is 0 (none) or 1 (gelu_pk)");
    bf16_t* O; int ldc; const float* bias; int split_cols; size_t split_stride; float scale0;
    __device__ __forceinline__ void operator()(const f32x4 (&acc)[2][2][4][2], const Unit& u, int wr, int wc, int fr, int fq) const {
        const int row0 = u.pm * BM + wr * 64 + fr; int colt = u.pn * BM; bf16_t* base = O;
        float sc = 1.f; if (split_cols) { const int t = colt / split_cols; base += (size_t)t * split_stride; colt -= t * split_cols; if (t == 0) sc = scale0; }
        const int col0 = colt + wc * 32 + 8 * fq, bcol0 = u.pn * BM + wc * 32 + 8 * fq;
        f32x4 bv[2][2];
#pragma unroll
        for (int bj = 0; bj < 2; ++bj)
#pragma unroll
            for (int n = 0; n < 2; ++n) bv[bj][n] = bias ? *(const f32x4*)(bias + bcol0 + bj * HALF + 4 * n) : (f32x4){0.f, 0.f, 0.f, 0.f};
#pragma unroll
        for (int ai = 0; ai < 2; ++ai)
#pragma unroll
            for (int m = 0; m < 4; ++m) { bf16_t* rowp = base + (size_t)(row0 + ai * HALF + m * 16) * ldc + col0;
#pragma unroll
                for (int bj = 0; bj < 2; ++bj) { f32x4 v0 = acc[ai][bj][m][0] + bv[bj][0], v1 = acc[ai][bj][m][1] + bv[bj][1];
                    if (ACT == 1) { f32x2 a = gelu_pk((f32x2){v0[0], v0[1]}), b = gelu_pk((f32x2){v0[2], v0[3]}), c = gelu_pk((f32x2){v1[0], v1[1]}), d = gelu_pk((f32x2){v1[2], v1[3]});
                        v0 = (f32x4){a.x, a.y, b.x, b.y}; v1 = (f32x4){c.x, c.y, d.x, d.y}; }
                    v0 = v0 * sc; v1 = v1 * sc; u32x4 w; w.x = cvt_pk_bf16(v0[0], v0[1]); w.y = cvt_pk_bf16(v0[2], v0[3]); w.z = cvt_pk_bf16(v1[0], v1[1]); w.w = cvt_pk_bf16(v1[2], v1[3]);
                    *(u32x4*)(rowp + bj * HALF) = w; } }
    }
};
template <class Epi, class Sched, bool ALIGN_EPI = false, bool SP2 = false>
__device__ __forceinline__ void gemm_phase(PG8_LAS unsigned char* lds, const Gemm g, const Sched& S, const Epi& E) {
    int tid_ = threadIdx.x; asm volatile("" : "+v"(tid_));
    const int tid = tid_, wid = __builtin_amdgcn_readfirstlane(tid >> 6), lane = tid & 63, wr = wid >> 2, wc = wid & 3, fr = lane & 15, fq = lane >> 4;
    const int K = g.K, nt = K / BK;
    unsigned voffA[2], voffB[2];
#pragma unroll
    for (int i = 0; i < 2; ++i) { int R, C; stage_rc(tid * 16 + i * 8192, R, C); const int Rb = Epi::PERM ? ((R & ~31) + perm32(R & 31)) : R;
        voffA[i] = (unsigned)(R * K + C) * 2u; voffB[i] = (unsigned)(Rb * K + C) * 2u; }
    const size_t kstep = (size_t)(BK * 2);
    const size_t hstep = (size_t)HALF * K * 2;
    const size_t tstep = 2 * hstep;
    const unsigned ldsw = (unsigned)wid * 1024u;
    const int aoff = lds_byte(wr * 64 + fr, fq * 8), boff = lds_byte(wc * 32 + fr, fq * 8);
#define PG8_SA(b, h) (((b) * 2 + (h)) * HTB)
#define PG8_SB(b, h) ((4 + (b) * 2 + (h)) * HTB)
#define PG8_STAGE(bufoff, gbase, voff) do { _Pragma("unroll") for (int _i = 0; _i < 2; ++_i) \
        __builtin_amdgcn_global_load_lds((const unsigned*)((const char*)(gbase) + (voff)[_i]), (PG8_LAS unsigned*)(lds + (bufoff) + ldsw + _i * 8192), 16, 0, 0); } while (0)
#define PG8_LDA(dst, b, h) do { _Pragma("unroll") for (int m = 0; m < 4; ++m) _Pragma("unroll") for (int k = 0; k < 2; ++k) dst[m][k] = *(const PG8_LAS bf16x8*)(lds + PG8_SA(b, h) + aoff + m * 2048 + k * 1024); } while (0)
#define PG8_LDB(dst, b, h) do { _Pragma("unroll") for (int n = 0; n < 2; ++n) _Pragma("unroll") for (int k = 0; k < 2; ++k) dst[n][k] = *(const PG8_LAS bf16x8*)(lds + PG8_SB(b, h) + boff + n * 2048 + k * 1024); } while (0)
#define PG8_MMA(ai, bj, At, Bt) do { __builtin_amdgcn_s_setprio(1); _Pragma("unroll") for (int m = 0; m < 4; ++m) _Pragma("unroll") for (int n = 0; n < 2; ++n) _Pragma("unroll") for (int k = 0; k < 2; ++k) \
        acc[ai][bj][m][n] = __builtin_amdgcn_mfma_f32_16x16x32_bf16(Bt[n][k], At[m][k], acc[ai][bj][m][n], 0, 0, 0); __builtin_amdgcn_s_setprio(0); } while (0)
#define PG8_WAIT_V(n) asm volatile("s_waitcnt vmcnt(" #n ")" ::: "memory")
#define PG8_WAIT_L(n) asm volatile("s_waitcnt lgkmcnt(" #n ")" ::: "memory")
#define PG8_BAR __builtin_amdgcn_s_barrier()
#define PG8_SCHED __builtin_amdgcn_sched_barrier(0)
    Unit cur, nxt; int ui = 0;
    if (!S.next(0, cur)) return;
    f32x4 acc[2][2][4][2];
#pragma unroll
    for (int a = 0; a < 2; ++a)
#pragma unroll
        for (int b = 0; b < 2; ++b)
#pragma unroll
            for (int m = 0; m < 4; ++m)
#pragma unroll
                for (int n = 0; n < 2; ++n) acc[a][b][m][n] = (f32x4){0.f, 0.f, 0.f, 0.f};
    bf16x8 At[4][2], B0[2][2], B1[2][2];
    const char* cA = (const char*)g.A + (size_t)cur.pm * tstep; const char* cB = (const char*)g.Bt + (size_t)cur.pn * tstep;
    S.a_ready(cur);
    if constexpr (SP2) {
        PG8_STAGE(PG8_SB(0, 0), cB, voffB); PG8_STAGE(PG8_SB(0, 1), cB + hstep, voffB); PG8_STAGE(PG8_SA(0, 0), cA, voffA); PG8_STAGE(PG8_SA(0, 1), cA + hstep, voffA);
        if (wr == 1) PG8_BAR;
        PG8_WAIT_V(2); PG8_BAR;
        PG8_STAGE(PG8_SB(1, 0), cB + kstep, voffB); PG8_STAGE(PG8_SA(1, 0), cA + kstep, voffA); PG8_STAGE(PG8_SB(1, 1), cB + hstep + kstep, voffB);
        PG8_WAIT_V(6); PG8_BAR;
    } else {
        PG8_STAGE(PG8_SB(0, 0), cB, voffB); PG8_STAGE(PG8_SA(0, 0), cA, voffA); PG8_STAGE(PG8_SB(0, 1), cB + hstep, voffB); PG8_STAGE(PG8_SA(0, 1), cA + hstep, voffA);
        if (wr == 1) PG8_BAR;
        PG8_WAIT_V(4); PG8_BAR;
        PG8_STAGE(PG8_SB(1, 0), cB + kstep, voffB); PG8_STAGE(PG8_SA(1, 0), cA + kstep, voffA); PG8_STAGE(PG8_SB(1, 1), cB + hstep + kstep, voffB);
        PG8_WAIT_V(6); PG8_BAR;
    }
    for (;;) {
        const bool has_next = S.next(ui + 1, nxt);
        const char* nA = has_next ? (const char*)g.A + (size_t)nxt.pm * tstep : cA; const char* nB = has_next ? (const char*)g.Bt + (size_t)nxt.pn * tstep : cB;
        for (int t = 0; t < nt; t += 2) {
            const bool last = (t == nt - 2);
            const char* a1 = cA + (size_t)(t + 1) * kstep;
            const char* a2 = last ? nA : cA + (size_t)(t + 2) * kstep; const char* b2 = last ? nB : cB + (size_t)(t + 2) * kstep;
            const char* a3 = a2 + kstep; const char* b3 = b2 + kstep;
            if (last && has_next) S.a_ready(nxt);
            if constexpr (SP2) {
            PG8_LDB(B0, 0, 0); PG8_LDB(B1, 0, 1); PG8_SCHED; PG8_LDA(At, 0, 0); PG8_STAGE(PG8_SA(1, 1), a1 + hstep, voffA);
            PG8_WAIT_V(8); PG8_WAIT_L(0); PG8_BAR; PG8_MMA(0, 0, At, B0); PG8_MMA(0, 1, At, B1); PG8_BAR; PG8_SCHED;
            PG8_LDA(At, 0, 1); PG8_STAGE(PG8_SB(0, 0), b2, voffB); PG8_STAGE(PG8_SB(0, 1), b2 + hstep, voffB); PG8_STAGE(PG8_SA(0, 0), a2, voffA);
            PG8_WAIT_V(8); PG8_WAIT_L(0); PG8_BAR; PG8_MMA(1, 0, At, B0); PG8_MMA(1, 1, At, B1); PG8_BAR; PG8_SCHED;
            PG8_LDB(B0, 1, 0); PG8_LDB(B1, 1, 1); PG8_SCHED; PG8_LDA(At, 1, 0); PG8_STAGE(PG8_SA(0, 1), a2 + hstep, voffA);
            PG8_WAIT_V(8); PG8_WAIT_L(0); PG8_BAR; PG8_MMA(0, 0, At, B0); PG8_MMA(0, 1, At, B1); PG8_BAR; PG8_SCHED;
            PG8_LDA(At, 1, 1); PG8_STAGE(PG8_SB(1, 0), b3, voffB); PG8_STAGE(PG8_SB(1, 1), b3 + hstep, voffB); PG8_STAGE(PG8_SA(1, 0), a3, voffA);
            PG8_WAIT_V(8); PG8_WAIT_L(0); PG8_BAR; PG8_MMA(1, 0, At, B0); PG8_MMA(1, 1, At, B1); PG8_BAR; PG8_SCHED;
            } else {
            PG8_LDB(B0, 0, 0); PG8_SCHED; PG8_LDA(At, 0, 0); PG8_STAGE(PG8_SA(1, 1), a1 + hstep, voffA);
            PG8_WAIT_L(8); PG8_BAR; PG8_WAIT_L(0); PG8_MMA(0, 0, At, B0); PG8_BAR; PG8_SCHED;
            PG8_LDB(B1, 0, 1); PG8_STAGE(PG8_SB(0, 0), b2, voffB);
            PG8_BAR; PG8_WAIT_L(0); PG8_MMA(0, 1, At, B1); PG8_BAR;
            PG8_LDA(At, 0, 1); PG8_STAGE(PG8_SA(0, 0), a2, voffA);
            PG8_BAR; PG8_WAIT_L(0); PG8_MMA(1, 0, At, B0); PG8_BAR; PG8_SCHED;
            PG8_STAGE(PG8_SB(0, 1), b2 + hstep, voffB);
            PG8_WAIT_V(6); PG8_BAR; PG8_MMA(1, 1, At, B1); PG8_BAR;
            PG8_LDB(B0, 1, 0); PG8_SCHED; PG8_LDA(At, 1, 0); PG8_STAGE(PG8_SA(0, 1), a2 + hstep, voffA);
            PG8_WAIT_L(8); PG8_BAR; PG8_WAIT_L(0); PG8_MMA(0, 0, At, B0); PG8_BAR; PG8_SCHED;
            PG8_LDB(B1, 1, 1); PG8_STAGE(PG8_SB(1, 0), b3, voffB);
            PG8_BAR; PG8_WAIT_L(0); PG8_MMA(0, 1, At, B1); PG8_BAR;
            PG8_LDA(At, 1, 1); PG8_STAGE(PG8_SA(1, 0), a3, voffA);
            PG8_BAR; PG8_WAIT_L(0); PG8_MMA(1, 0, At, B0); PG8_BAR; PG8_SCHED;
            PG8_STAGE(PG8_SB(1, 1), b3 + hstep, voffB);
            PG8_WAIT_V(6); PG8_BAR; PG8_MMA(1, 1, At, B1); PG8_BAR;
            }
        }
        if constexpr (ALIGN_EPI) { if (wr == 0) PG8_BAR; }
        if constexpr (!Epi::AFTER_DRAIN) { E(acc, cur, wr, wc, fr, fq); S.done(cur); }
        if (!has_next) break;
#pragma unroll
        for (int a = 0; a < 2; ++a)
#pragma unroll
            for (int b = 0; b < 2; ++b)
#pragma unroll
                for (int m = 0; m < 4; ++m)
#pragma unroll
                    for (int n = 0; n < 2; ++n) acc[a][b][m][n] = (f32x4){0.f, 0.f, 0.f, 0.f};
        cur = nxt; cA = nA; cB = nB; ++ui;
        if constexpr (ALIGN_EPI) { if (wr == 1) PG8_BAR; }
    }
    PG8_WAIT_V(0);
    if constexpr (!ALIGN_EPI) { if (wr == 0) PG8_BAR; }
    PG8_BAR;
    if constexpr (Epi::AFTER_DRAIN) { E.fused(acc, cur, wr, wc, fr, fq, lds, wid, lane); S.done(cur); }
#undef PG8_SA
#undef PG8_SB
#undef PG8_STAGE
#undef PG8_LDA
#undef PG8_LDB
#undef PG8_MMA
#undef PG8_WAIT_V
#undef PG8_WAIT_L
#undef PG8_BAR
#undef PG8_SCHED
}
}

namespace hy {
#define GAS __attribute__((address_space(1)))
#define LAS __attribute__((address_space(3)))
typedef unsigned short bf16;
typedef unsigned v4u __attribute__((ext_vector_type(4)));
typedef float f32x4 __attribute__((ext_vector_type(4)));
typedef short bf16x8 __attribute__((ext_vector_type(8)));
typedef GAS unsigned gu32;
typedef GAS unsigned long long gu64;
#define RLX_AGENT __ATOMIC_RELAXED, __HIP_MEMORY_SCOPE_AGENT
#define LDS_WAIT() asm volatile("s_waitcnt lgkmcnt(0)" ::: "memory")
#define VM_WAIT() asm volatile("s_waitcnt vmcnt(0)" ::: "memory")
__device__ __forceinline__ unsigned long long rt() { return __builtin_amdgcn_s_memrealtime(); }
__device__ __forceinline__ unsigned f2bf(float f) { unsigned u = __builtin_bit_cast(unsigned, f); return (u + 0x7fffu + ((u >> 16) & 1u)) >> 16; }
__device__ __forceinline__ unsigned pk2(float lo, float hi) { return f2bf(lo) | (f2bf(hi) << 16); }
#define XB_TMO      128
#define XB_XCNT(j)  (256  + 64 * (j))
#define XB_XSUB(j)  (1280 + 64 * (j))
#define XB_XGEN(j)  (2304 + 64 * (j))
#define XB_TOP      3328
#define XB_TOPGEN   3392
#define XCD_BAR_WORDS 3456
#define XB_SPIN_CAP (1u << 18)

__device__ __forceinline__ unsigned xb_ld(unsigned* p)              { return __hip_atomic_load(p, __ATOMIC_RELAXED, __HIP_MEMORY_SCOPE_AGENT); }
__device__ __forceinline__ unsigned xb_add(unsigned* p, unsigned v) { return __hip_atomic_fetch_add(p, v, __ATOMIC_RELAXED, __HIP_MEMORY_SCOPE_AGENT); }
__device__ __forceinline__ unsigned xb_xcc_id() { return (unsigned)__builtin_amdgcn_s_getreg((3 << 11) | 20) & 0xFu; }
#define XB_SPIN(cond, bar) do { unsigned _sp = 0; while (cond) { __builtin_amdgcn_s_sleep(1); \
    if ((++_sp & 255u) == 0u) { if (xb_ld(&(bar)[XB_TMO])) break; if (_sp > XB_SPIN_CAP) { atomicAdd(&(bar)[XB_TMO], 1u); break; } } } } while (0)

struct XcdBarrier {
    unsigned* bar; unsigned x;
    volatile LAS unsigned* st;
};

__device__ __forceinline__ XcdBarrier xcd_barrier_post(unsigned* bar, volatile LAS unsigned* st) {
    XcdBarrier b; b.bar = bar; b.x = xb_xcc_id(); b.st = st;
    if (threadIdx.x == 0) (void)xb_add(&bar[XB_XCNT(b.x)], 1u);
    return b;
}
__device__ __forceinline__ void xcd_barrier_complete(unsigned* bar, unsigned x, unsigned& nloc, unsigned& nx) {
    const unsigned G = gridDim.x * gridDim.y * gridDim.z;
    unsigned sum, cnt, mine, sp = 0u;
    for (;;) {
        sum = 0u; cnt = 0u; mine = 0u;
#pragma unroll
        for (unsigned j = 0; j < 16; ++j) { const unsigned c = xb_ld(&bar[XB_XCNT(j)]); sum += c; cnt += (c > 0u) ? 1u : 0u; mine = (j == x) ? c : mine; }
        if (sum == G) break;
        __builtin_amdgcn_s_sleep(1);
        if ((++sp & 255u) == 0u) { if (xb_ld(&bar[XB_TMO])) break; if (sp > XB_SPIN_CAP) { atomicAdd(&bar[XB_TMO], 1u); break; } }
    }
    nloc = mine > 0u ? mine : 1u; nx = cnt > 0u ? cnt : 1u;
}

__device__ __forceinline__ void xcd_barrier(const XcdBarrier& b) {
    asm volatile("s_waitcnt vmcnt(0)" ::: "memory");
    __syncthreads();
    if (threadIdx.x == 0) {
        unsigned* bar = b.bar;
        __builtin_amdgcn_s_waitcnt(0);
        unsigned nloc = b.st[0], nx = b.st[1];
        if (nloc == 0u) { xcd_barrier_complete(bar, b.x, nloc, nx); b.st[0] = nloc; b.st[1] = nx; }
        const unsigned old = xb_add(&bar[XB_XSUB(b.x)], 1u);
        const unsigned gen = old / nloc;
        if (old + 1u == (gen + 1u) * nloc) {
            __builtin_amdgcn_fence(__ATOMIC_RELEASE, "agent");
            asm volatile("s_waitcnt vmcnt(0)" ::: "memory");
            const unsigned og = xb_add(&bar[XB_TOP], 1u);
            const unsigned tg = og / nx;
            if (og + 1u == (tg + 1u) * nx) xb_add(&bar[XB_TOPGEN], 1u);
            else XB_SPIN(xb_ld(&bar[XB_TOPGEN]) == tg, bar);
            __builtin_amdgcn_fence(__ATOMIC_ACQUIRE, "agent");
            xb_add(&bar[XB_XGEN(b.x)], 1u);
            asm volatile("s_waitcnt vmcnt(0)" ::: "memory");
        } else {
            XB_SPIN(xb_ld(&bar[XB_XGEN(b.x)]) == gen, bar);
            __builtin_amdgcn_fence(__ATOMIC_ACQUIRE, "agent");
            asm volatile("s_waitcnt vmcnt(0)" ::: "memory");
        }
    }
    __syncthreads();
}

constexpr int B_ = 4, T_ = 8192, D_ = 1024, M_ = B_ * T_, L_ = 2;
constexpr int NIN = 3584, NPG = 1792, NPR = 1792;
constexpr int DFF = 2816, NUP = 5632, IN_COLS = 3344;
constexpr size_t MiB = 1u << 20;
constexpr size_t WS_CTL = 0, CTL_ZERO_BYTES = 65536;
constexpr int CW_BAR = 4096;
constexpr size_t WS_MOD = 1 * MiB;
constexpr size_t WS_WIN = 2 * MiB, WS_WOUT = 9 * MiB, WS_WUP = 11 * MiB, WS_WDN = 22 * MiB, WS_INVN = 28 * MiB, WS_VL = 29 * MiB;
constexpr size_t WS_XB = 32 * MiB, WS_O = 96 * MiB, WS_VF = 160 * MiB, WS_GK = 192 * MiB, WS_PG = 224 * MiB, WS_PR = 336 * MiB, WS_END = 512 * MiB;
constexpr size_t WS_LW = WS_XB, WS_SAR = 224 * MiB, WS_SAK = 256 * MiB, WS_SAV = 288 * MiB, WS_SAA = 448 * MiB, WS_SAG = 480 * MiB, WS_Y = WS_PR;
constexpr size_t WS_ACT = 224 * MiB, WS_U = 400 * MiB;
constexpr int RING_BYTES = 131072, MISC_OFF = RING_BYTES, LDS_BYTES = 147456;
constexpr int NT = 512;

__device__ __forceinline__ float bf2f(bf16 h) { return __builtin_bit_cast(float, (unsigned)h << 16); }
__device__ __forceinline__ float sigmoidf_(float x) { return 1.f / (1.f + __expf(-x)); }
__device__ __forceinline__ float siluf_(float x) { return x / (1.f + __expf(-x)); }
__device__ __forceinline__ float softplusf_(float x) { return fmaxf(x, 0.f) + log1pf(__expf(-fabsf(x))); }

template <int CTRL> __device__ __forceinline__ float dpp_f(float v) {
    return __builtin_bit_cast(float, __builtin_amdgcn_update_dpp(0, __builtin_bit_cast(int, v), CTRL, 0xf, 0xf, false));
}
__device__ __forceinline__ float wave_sum(float v) {
    v += dpp_f<0xB1>(v);
    v += dpp_f<0x4E>(v);
    v += dpp_f<0x141>(v);
    v += dpp_f<0x140>(v);
    v += __shfl_xor(v, 16);
    v += __shfl_xor(v, 32);
    return v;
}

struct Ctx { int bid, nb, tid, lane, wave; LAS unsigned char* lds; };

__device__ __forceinline__ void ph_mod(const Ctx& C, const float* c, const float* ada_w, const float* ada_b, float* MOD) {
    LAS float* sc = (LAS float*)C.lds;
    LAS float* red = (LAS float*)(C.lds + 16384);
    for (int i = C.tid; i < 4096; i += NT) sc[i] = siluf_(c[i]);
    __syncthreads();
    for (int item = C.bid; item < 192; item += C.nb) {
        const int l = item / 96, j0 = (item % 96) * 64;
        const float* W = ada_w + (size_t)l * 1024 * 6144 + j0 + C.lane;
        float a0 = 0.f, a1 = 0.f, a2 = 0.f, a3 = 0.f;
        for (int k = C.wave * 128; k < C.wave * 128 + 128; ++k) { const float wv = W[(size_t)k * 6144]; a0 += sc[k] * wv; a1 += sc[1024 + k] * wv; a2 += sc[2048 + k] * wv; a3 += sc[3072 + k] * wv; }
        red[(C.wave * 4 + 0) * 64 + C.lane] = a0; red[(C.wave * 4 + 1) * 64 + C.lane] = a1; red[(C.wave * 4 + 2) * 64 + C.lane] = a2; red[(C.wave * 4 + 3) * 64 + C.lane] = a3;
        __syncthreads();
        if (C.wave < 4) { const int b = C.wave; float s = ada_b[l * 6144 + j0 + C.lane];
#pragma unroll
            for (int w = 0; w < 8; ++w) s += red[(w * 4 + b) * 64 + C.lane];
            MOD[((size_t)l * 4 + b) * 6144 + j0 + C.lane] = s; }
        __syncthreads();
    }
}

__device__ __forceinline__ void wprep_mat(const Ctx& C, const float* W, int K, int Nsrc, int Ndst, bf16* Wt, int mode, const float* vres) {
    const int half = C.tid >> 8, t = C.tid & 255, tx = t & 31, ty = t >> 5;
    LAS float* tile = (LAS float*)C.lds + half * (32 * 33);
    const int nbn = Ndst / 32, ntile = nbn * (K / 32);
    const int niter = (ntile + 2 * C.nb - 1) / (2 * C.nb);
    for (int it = 0; it < niter; ++it) {
        const int item = (it * C.nb + C.bid) * 2 + half;
        const bool act = item < ntile;
        const int n0 = (item % nbn) * 32, k0 = (item / nbn) * 32, n = n0 + tx;
        if (act) {
#pragma unroll
            for (int i = 0; i < 4; ++i) { const int k = k0 + ty + 8 * i; float v = 0.f;
                if (mode == 0) v = W[(size_t)k * Nsrc + n];
                else { if (n < 1552) v = W[(size_t)k * Nsrc + n]; else if (n < 1584) v = vres ? vres[(size_t)k * 32 + (n - 1552)] : 0.f; else if (n < 1792) v = 0.f; else v = W[(size_t)k * Nsrc + (n - 240)]; }
                tile[(ty + 8 * i) * 33 + tx] = v; }
        }
        __syncthreads();
        if (act) {
#pragma unroll
            for (int i = 0; i < 4; ++i) { const int nn = n0 + ty + 8 * i; Wt[(size_t)nn * K + k0 + tx] = (bf16)f2bf(tile[tx * 33 + ty + 8 * i]); }
        }
        __syncthreads();
    }
}

__device__ __forceinline__ void ph_norm(const Ctx& C, const float* x, const float* g, const float* sh, const float* sc, bf16* XB) {
    const int gw = C.bid * 8 + C.wave, NGW = C.nb * 8, lane = C.lane;
    for (int m = gw; m < M_; m += NGW) {
        const int b = m / T_;
        const f32x4* xr = (const f32x4*)(x + (size_t)m * D_) + lane;
        f32x4 v[4]; float s = 0.f;
#pragma unroll
        for (int j = 0; j < 4; ++j) { v[j] = xr[64 * j]; s += (v[j].x * v[j].x + v[j].y * v[j].y) + (v[j].z * v[j].z + v[j].w * v[j].w); }
        const float rstd = 1.f / sqrtf(wave_sum(s) * (1.f / D_) + 1e-6f);
        unsigned long long* o8 = (unsigned long long*)(XB + (size_t)m * D_) + lane;
#pragma unroll
        for (int j = 0; j < 4; ++j) { const int col = 4 * lane + 256 * j;
            const f32x4 gv = *(const f32x4*)(g + col), shv = *(const f32x4*)(sh + b * 6144 + col), scv = *(const f32x4*)(sc + b * 6144 + col);
            const f32x4 h = v[j] * rstd * gv * (scv + 1.f) + shv;
            o8[64 * j] = (unsigned long long)(f2bf(h.x) | (f2bf(h.y) << 16)) | ((unsigned long long)(f2bf(h.z) | (f2bf(h.w) << 16)) << 32); }
    }
}
__device__ __forceinline__ void ph_final(const Ctx& C, float* x, const float* g) {
    const int gw = C.bid * 8 + C.wave, NGW = C.nb * 8, lane = C.lane;
    for (int m = gw; m < M_; m += NGW) {
        f32x4* xr = (f32x4*)(x + (size_t)m * D_) + lane;
        f32x4 v[4]; float s = 0.f;
#pragma unroll
        for (int j = 0; j < 4; ++j) { v[j] = xr[64 * j]; s += (v[j].x * v[j].x + v[j].y * v[j].y) + (v[j].z * v[j].z + v[j].w * v[j].w); }
        const float rstd = 1.f / sqrtf(wave_sum(s) * (1.f / D_) + 1e-6f);
#pragma unroll
        for (int j = 0; j < 4; ++j) { const f32x4 gv = *(const f32x4*)(g + 4 * lane + 256 * j); xr[64 * j] = v[j] * rstd * gv; }
    }
}

__device__ __forceinline__ void ph_gkprep(const Ctx& C, const bf16* PG, const float* gk_up, const float* gk_b, float* GK, bf16* VL) {
    const int half = C.tid >> 8, j = C.tid & 255;
    float wv[16];
#pragma unroll
    for (int i = 0; i < 16; ++i) wv[i] = gk_up[i * 256 + j];
    const float bj = gk_b[j];
    for (int m = C.bid * 2 + half; m < M_; m += C.nb * 2) {
        const bf16* row = PG + (size_t)m * NPG;
        float a = bj;
#pragma unroll
        for (int i = 0; i < 16; ++i) a += bf2f(row[1536 + i]) * wv[i];
        GK[(size_t)m * 256 + j] = -softplusf_(-a) * (1.f / 16.f);
        if (j < 32) VL[(size_t)m * 32 + j] = row[1552 + j];
    }
}

__device__ __forceinline__ void ph_gla_scan(const Ctx& C, const bf16* PG, const float* GK, bf16* O) {
    for (int wg = C.bid; wg < 256; wg += C.nb) {
        const int bh = wg >> 4, eb = wg & 15, b = bh >> 2, h = bh & 3, lane = C.lane, e = eb * 8 + C.wave;
        const bf16* pg = PG + (size_t)b * T_ * NPG;
        const float* gk = GK + (size_t)b * T_ * 256 + h * 64 + lane;
        bf16* o = O + (size_t)b * T_ * D_ + h * 128 + e;
        float S = 0.f;
        for (int t0 = 0; t0 < T_; t0 += 8) {
            float q[8], k[8], v[8], g[8];
#pragma unroll
            for (int i = 0; i < 8; ++i) { const bf16* row = pg + (size_t)(t0 + i) * NPG;
                q[i] = bf2f(row[h * 64 + lane]); k[i] = bf2f(row[256 + h * 64 + lane]); v[i] = bf2f(row[512 + h * 128 + e]); g[i] = gk[(size_t)(t0 + i) * 256]; }
#pragma unroll
            for (int i = 0; i < 8; ++i) { S = S * __expf(g[i]) + k[i] * v[i]; const float r = wave_sum(q[i] * S) * 0.125f; if (lane == 0) o[(size_t)(t0 + i) * D_] = (bf16)f2bf(r); }
        }
    }
}
__device__ __forceinline__ void ph_gla_post(const Ctx& C, const bf16* PG, const float* norm_g, bf16* O) {
    const int gw = C.bid * 8 + C.wave, NGW = C.nb * 8, lane = C.lane;
    for (int it = gw; it < M_ * 4; it += NGW) {
        const int m = it >> 2, h = it & 3;
        bf16* o = O + (size_t)m * D_ + h * 128; const bf16* g = PG + (size_t)m * NPG + 1024 + h * 128;
        const float o0 = bf2f(o[lane]), o1 = bf2f(o[64 + lane]);
        const float rstd = 1.f / sqrtf(wave_sum(o0 * o0 + o1 * o1) * (1.f / 128.f) + 1e-6f);
        o[lane] = (bf16)f2bf(o0 * rstd * norm_g[lane] * siluf_(bf2f(g[lane])));
        o[64 + lane] = (bf16)f2bf(o1 * rstd * norm_g[64 + lane] * siluf_(bf2f(g[64 + lane])));
    }
}

struct RwkvW { const float *mu, *mu_vres, *w_up, *w0, *a_up, *a0, *g_up, *v_up, *v0, *k_k; };
__device__ __forceinline__ void ph_rwkv_prep(const Ctx& C, const bf16* PR, const bf16* VL, const RwkvW& W, int layer,
                                             bf16* SAR, bf16* SAK, bf16* SAV, bf16* SAA, bf16* SAG, float* LW, float* INVN, bf16* VF) {
    LAS float* lin = (LAS float*)C.lds;
    const int j = C.tid, lane = C.lane, h = C.wave;
    const int NI = layer ? 288 : 256;
    for (int grp = C.bid; grp < M_ / 8; grp += C.nb) {
        const int m0 = grp * 8;
        __syncthreads();
        for (int idx = j; idx < 8 * NI; idx += NT) {
            const int tk = idx / NI, c = idx % NI, m = m0 + tk, t = m % T_;
            float cur, prev, mu;
            if (c < 256) { cur = bf2f(PR[(size_t)m * NPR + 1536 + c]); prev = t ? bf2f(PR[(size_t)(m - 1) * NPR + 1536 + c]) : 0.f; mu = W.mu[1536 + c]; }
            else { cur = bf2f(VL[(size_t)m * 32 + (c - 256)]); prev = t ? bf2f(VL[(size_t)(m - 1) * 32 + (c - 256)]) : 0.f; mu = W.mu_vres[c - 256]; }
            float p = cur + (prev - cur) * mu;
            if (c < 64) p = tanhf(p); else if (c >= 128 && c < 256) p = sigmoidf_(p);
            lin[c * 8 + tk] = p;
        }
        __syncthreads();
        float aw[8], aa[8], ag[8], av[8];
#pragma unroll
        for (int tk = 0; tk < 8; ++tk) { aw[tk] = 0.f; aa[tk] = 0.f; ag[tk] = 0.f; av[tk] = 0.f; }
        { const float* pw = W.w_up + j; const float* pa = W.a_up + j;
#pragma nounroll
        for (int i = 0; i < 64; ++i) { const float w1 = pw[0], w2 = pa[0]; pw += 512; pa += 512;
#pragma unroll
            for (int q = 0; q < 2; ++q) { const f32x4 x1 = *(const LAS f32x4*)&lin[i * 8 + 4 * q], x2 = *(const LAS f32x4*)&lin[(64 + i) * 8 + 4 * q];
                aw[4 * q] += x1.x * w1; aw[4 * q + 1] += x1.y * w1; aw[4 * q + 2] += x1.z * w1; aw[4 * q + 3] += x1.w * w1;
                aa[4 * q] += x2.x * w2; aa[4 * q + 1] += x2.y * w2; aa[4 * q + 2] += x2.z * w2; aa[4 * q + 3] += x2.w * w2; } } }
        { const float* pg = W.g_up + j;
#pragma nounroll
        for (int i = 0; i < 128; ++i) { const float w3 = pg[0]; pg += 512;
#pragma unroll
            for (int q = 0; q < 2; ++q) { const f32x4 x3 = *(const LAS f32x4*)&lin[(128 + i) * 8 + 4 * q];
                ag[4 * q] += x3.x * w3; ag[4 * q + 1] += x3.y * w3; ag[4 * q + 2] += x3.z * w3; ag[4 * q + 3] += x3.w * w3; } } }
        if (layer) { const float* pv = W.v_up + j;
#pragma nounroll
        for (int i = 0; i < 32; ++i) { const float w4 = pv[0]; pv += 512;
#pragma unroll
            for (int q = 0; q < 2; ++q) { const f32x4 x4 = *(const LAS f32x4*)&lin[(256 + i) * 8 + 4 * q];
                av[4 * q] += x4.x * w4; av[4 * q + 1] += x4.y * w4; av[4 * q + 2] += x4.z * w4; av[4 * q + 3] += x4.w * w4; } } }
        const float mur = W.mu[j], muk = W.mu[512 + j], muv = W.mu[1024 + j], w0 = W.w0[j], a0 = W.a0[j], kkc = W.k_k[j];
        const float v0 = layer ? W.v0[j] : 0.f;
#pragma unroll
        for (int tk = 0; tk < 8; ++tk) {
            const int m = m0 + tk, t = m % T_;
            const bf16* cr = PR + (size_t)m * NPR; const bf16* pr = cr - NPR;
            const float rc = bf2f(cr[j]), kc = bf2f(cr[512 + j]), vc = bf2f(cr[1024 + j]);
            const float rp = t ? bf2f(pr[j]) : 0.f, kp = t ? bf2f(pr[512 + j]) : 0.f, vp = t ? bf2f(pr[1024 + j]) : 0.f;
            const float r = rc + (rp - rc) * mur, k = kc + (kp - kc) * muk; float v = vc + (vp - vc) * muv;
            const float wlog = -softplusf_(-(w0 + aw[tk])) - 0.5f;
            const float lw = -__expf(wlog);
            const float as = sigmoidf_(a0 + aa[tk]);
            const size_t o = (size_t)m * 512 + j;
            if (layer) { const float vf = bf2f(VF[o]); v = v + (vf - v) * sigmoidf_(v0 + av[tk]); } else VF[o] = (bf16)f2bf(v);
            const float kk = k * kkc; const float ss = wave_sum(kk * kk);
            if (lane == 0) INVN[(size_t)m * 8 + h] = 1.f / sqrtf(fmaxf(ss, 1e-24f));
            SAR[o] = (bf16)f2bf(r); SAK[o] = (bf16)f2bf(k); SAV[o] = (bf16)f2bf(v); SAA[o] = (bf16)f2bf(as); SAG[o] = (bf16)f2bf(ag[tk]); LW[o] = lw;
        }
    }
    __syncthreads();
}

__device__ __forceinline__ void ph_rwkv_scan(const Ctx& C, const bf16* SAR, const bf16* SAK, const bf16* SAV, const bf16* SAA,
                                             const float* LW, const float* INVN, const float* k_k, const float* k_a, float* Y) {
    for (int wg = C.bid; wg < 256; wg += C.nb) {
        const int bh = wg >> 3, rb = wg & 7, b = bh >> 3, h = bh & 7, lane = C.lane, row = rb * 8 + C.wave;
        const size_t base = (size_t)b * T_ * 512 + h * 64;
        const float kkc = k_k[h * 64 + lane], kac = k_a[h * 64 + lane];
        float S = 0.f;
        for (int t0 = 0; t0 < T_; t0 += 8) {
            float r[8], k[8], a[8], w[8], v[8], n[8];
#pragma unroll
            for (int i = 0; i < 8; ++i) { const size_t o = base + (size_t)(t0 + i) * 512;
                r[i] = bf2f(SAR[o + lane]); k[i] = bf2f(SAK[o + lane]); a[i] = bf2f(SAA[o + lane]); w[i] = LW[o + lane]; v[i] = bf2f(SAV[o + row]); n[i] = INVN[((size_t)b * T_ + t0 + i) * 8 + h]; }
#pragma unroll
            for (int i = 0; i < 8; ++i) {
                const float kk = k[i] * kkc * n[i], bb = kk * a[i], km = k[i] * (1.f + (a[i] - 1.f) * kac), dec = __expf(w[i]);
                const float sa = -wave_sum(S * kk);
                S = S * dec + sa * bb + v[i] * km;
                const float y = wave_sum(S * r[i]);
                if (lane == 0) Y[base + (size_t)(t0 + i) * 512 + row] = y;
            }
        }
    }
}
__device__ __forceinline__ void ph_rwkv_post(const Ctx& C, const float* Y, const bf16* SAR, const bf16* SAK, const bf16* SAV, const bf16* SAA, const bf16* SAG,
                                             const float* k_a, const float* r_k, const float* gn_g, const float* gn_b, bf16* O) {
    const int gw = C.bid * 8 + C.wave, NGW = C.nb * 8, lane = C.lane;
    for (int it = gw; it < M_ * 8; it += NGW) {
        const int m = it >> 3, h = it & 7, c = h * 64 + lane; const size_t o = (size_t)m * 512 + c;
        const float y = Y[o];
        const float mean = wave_sum(y) * (1.f / 64.f), d = y - mean, var = wave_sum(d * d) * (1.f / 64.f);
        const float yn = d * (1.f / sqrtf(var + 64e-5f)) * gn_g[c] + gn_b[c];
        const float r = bf2f(SAR[o]), k = bf2f(SAK[o]), v = bf2f(SAV[o]), a = bf2f(SAA[o]), g = bf2f(SAG[o]);
        const float km = k * (1.f + (a - 1.f) * k_a[c]);
        const float rk = wave_sum(r * km * r_k[c]);
        O[(size_t)m * D_ + 512 + c] = (bf16)f2bf((yn + rk * v) * g);
    }
}

__device__ __forceinline__ void ph_conv(const Ctx& C, const bf16* U, const float* cw, const float* cb, bf16* ACT) {
    for (size_t idx = (size_t)C.bid * NT + C.tid; idx < (size_t)T_ * DFF; idx += (size_t)C.nb * NT) {
        const int t = (int)(idx / DFF), j = (int)(idx % DFF);
        const bf16* u = U + (size_t)t * NUP;
        float g = cb[j], v = cb[DFF + j];
        g += cw[2 * NUP + j] * bf2f(u[j]); v += cw[2 * NUP + DFF + j] * bf2f(u[DFF + j]);
        if (t >= 1) { g += cw[NUP + j] * bf2f(u[j - NUP]); v += cw[NUP + DFF + j] * bf2f(u[DFF + j - NUP]); }
        if (t >= 2) { g += cw[j] * bf2f(u[j - 2 * NUP]); v += cw[DFF + j] * bf2f(u[DFF + j - 2 * NUP]); }
        ACT[(size_t)t * DFF + j] = (bf16)f2bf(siluf_(g) * v);
    }
}
}

namespace pg8 {
struct EpiRes {
    static constexpr bool PERM = false, AFTER_DRAIN = false;
    const float* base; float* out; const float* gate; int gstride;
    __device__ __forceinline__ void operator()(const f32x4 (&acc)[2][2][4][2], const Unit& u, int wr, int wc, int fr, int fq) const {
        const int b = (u.pm * BM) / 8192; const float* gp = gate + (size_t)b * gstride;
        const int col0 = u.pn * BM + wc * 32 + 4 * fq;
#pragma unroll
        for (int ai = 0; ai < 2; ++ai)
#pragma unroll
            for (int m = 0; m < 4; ++m) { const size_t off = (size_t)(u.pm * BM + ai * HALF + wr * 64 + m * 16 + fr) * 1024 + col0;
#pragma unroll
                for (int bj = 0; bj < 2; ++bj)
#pragma unroll
                    for (int n = 0; n < 2; ++n) { const int cc = bj * HALF + n * 16; const f32x4 gv = *(const f32x4*)(gp + col0 + cc); const f32x4 bs = *(const f32x4*)(base + off + cc);
                        *(f32x4*)(out + off + cc) = bs + gv * acc[ai][bj][m][n]; } }
    }
};
}

namespace hy {
struct Args { const float* in[31]; float* out; unsigned char* ws; };
__global__ void __launch_bounds__(NT, 2) hy_fwd(Args A) {
    extern __shared__ __attribute__((aligned(16))) unsigned char lds_raw[];
    Ctx C; C.bid = blockIdx.x; C.nb = gridDim.x; C.tid = threadIdx.x; C.lane = C.tid & 63; C.wave = __builtin_amdgcn_readfirstlane(C.tid >> 6); C.lds = (LAS unsigned char*)lds_raw;
    volatile LAS unsigned* MISC = (volatile LAS unsigned*)(C.lds + MISC_OFF);
    for (int u = C.tid; u < (LDS_BYTES - MISC_OFF) / 4; u += NT) ((LAS unsigned*)(C.lds + MISC_OFF))[u] = 0u;
    __syncthreads();
    unsigned char* ws = A.ws;
    XcdBarrier bar = xcd_barrier_post((unsigned*)(ws + WS_CTL) + CW_BAR, MISC + 8);
#define PHASE_BEGIN() do { int t_ = threadIdx.x; asm volatile("" : "+v"(t_)); int b_ = blockIdx.x; asm volatile("" : "+s"(b_)); \
    C.tid = t_; C.lane = t_ & 63; C.wave = __builtin_amdgcn_readfirstlane(t_ >> 6); C.bid = b_; } while (0)
#define GRID_BAR() do { xcd_barrier(bar); PHASE_BEGIN(); } while (0)
    float* out = A.out;
#define in A.in
    float* MOD = (float*)(ws + WS_MOD);
    bf16 *WIN = (bf16*)(ws + WS_WIN), *WOUT = (bf16*)(ws + WS_WOUT), *WUP = (bf16*)(ws + WS_WUP), *WDN = (bf16*)(ws + WS_WDN);
    bf16 *XB = (bf16*)(ws + WS_XB), *O = (bf16*)(ws + WS_O), *VF = (bf16*)(ws + WS_VF), *PG = (bf16*)(ws + WS_PG), *PR = (bf16*)(ws + WS_PR), *VL = (bf16*)(ws + WS_VL);
    bf16 *SAR = (bf16*)(ws + WS_SAR), *SAK = (bf16*)(ws + WS_SAK), *SAV = (bf16*)(ws + WS_SAV), *SAA = (bf16*)(ws + WS_SAA), *SAG = (bf16*)(ws + WS_SAG);
    float *GK = (float*)(ws + WS_GK), *LW = (float*)(ws + WS_LW), *INVN = (float*)(ws + WS_INVN), *Y = (float*)(ws + WS_Y);
    bf16 *ACT = (bf16*)(ws + WS_ACT), *U = (bf16*)(ws + WS_U);

    ph_mod(C, in[1], in[2], in[3], MOD);
    for (int l = 0; l < L_; ++l) {
        const float* modl = MOD + (size_t)l * 4 * 6144;
        const float* xres = l ? out : in[0];
        wprep_mat(C, in[5] + (size_t)l * D_ * IN_COLS, D_, IN_COLS, NIN, WIN, 1, l ? in[6] : nullptr);
        wprep_mat(C, in[24] + (size_t)l * D_ * D_, D_, D_, D_, WOUT, 0, nullptr);
        wprep_mat(C, in[26] + (size_t)l * D_ * NUP, D_, NUP, NUP, WUP, 0, nullptr);
        wprep_mat(C, in[29] + (size_t)l * DFF * D_, DFF, D_, D_, WDN, 0, nullptr);
        GRID_BAR();
        ph_norm(C, xres, in[4] + l * D_, modl + 0 * D_, modl + 1 * D_, XB);
        GRID_BAR();
        { pg8::Gemm g{XB, WIN, M_, NIN, D_}; pg8::StaticOrder S; S.init(M_, NIN, C.nb, C.bid);
          pg8::EpiBf16<0> E{PG, NPG, nullptr, NPG, (WS_PR - WS_PG) / 2, 1.f};
          pg8::gemm_phase<pg8::EpiBf16<0>, pg8::StaticOrder, true, true>(C.lds, g, S, E); }
        GRID_BAR();
        ph_gkprep(C, PG, in[7] + l * 16 * 256, in[8] + l * 256, GK, VL);
        GRID_BAR();
        ph_gla_scan(C, PG, GK, O);
        GRID_BAR();
        ph_gla_post(C, PG, in[9] + l * 128, O);
        GRID_BAR();
        { RwkvW W{in[10] + l * 1792, in[11], in[12] + l * 64 * 512, in[13] + l * 512, in[14] + l * 64 * 512, in[15] + l * 512, in[16] + l * 128 * 512, in[17], in[18], in[19] + l * 512};
          ph_rwkv_prep(C, PR, VL, W, l, SAR, SAK, SAV, SAA, SAG, LW, INVN, VF); }
        GRID_BAR();
        ph_rwkv_scan(C, SAR, SAK, SAV, SAA, LW, INVN, in[19] + l * 512, in[20] + l * 512, Y);
        GRID_BAR();
        ph_rwkv_post(C, Y, SAR, SAK, SAV, SAA, SAG, in[20] + l * 512, in[21] + l * 512, in[22] + l * 512, in[23] + l * 512, O);
        GRID_BAR();
        { pg8::Gemm g{O, WOUT, M_, D_, D_}; pg8::StaticOrder S; S.init(M_, D_, C.nb, C.bid);
          pg8::EpiRes E{xres, out, modl + 2 * D_, 6144};
          pg8::gemm_phase<pg8::EpiRes, pg8::StaticOrder, true, true>(C.lds, g, S, E); }
        GRID_BAR();
        ph_norm(C, out, in[25] + l * D_, modl + 3 * D_, modl + 4 * D_, XB);
        GRID_BAR();
        for (int b = 0; b < B_; ++b) {
            { pg8::Gemm g{XB + (size_t)b * T_ * D_, WUP, T_, NUP, D_}; pg8::StaticOrder S; S.init(T_, NUP, C.nb, C.bid);
              pg8::EpiBf16<0> E{U, NUP, nullptr, 0, 0, 1.f};
              pg8::gemm_phase<pg8::EpiBf16<0>, pg8::StaticOrder, true, true>(C.lds, g, S, E); }
            GRID_BAR();
            ph_conv(C, U, in[27] + (size_t)l * 3 * NUP, in[28] + (size_t)l * NUP, ACT + (size_t)b * T_ * DFF);
            GRID_BAR();
        }
        { pg8::Gemm g{ACT, WDN, M_, D_, DFF}; pg8::StaticOrder S; S.init(M_, D_, C.nb, C.bid);
          pg8::EpiRes E{out, out, modl + 5 * D_, 6144};
          pg8::gemm_phase<pg8::EpiRes, pg8::StaticOrder, true, true>(C.lds, g, S, E); }
        GRID_BAR();
    }
    ph_final(C, out, in[30]);
#undef GRID_BAR
#undef PHASE_BEGIN
#undef in
}
}

extern "C" void kernel_launch(void* const* d_in, const int* in_sizes, int n_in, void* d_out, int out_size, void* d_ws, size_t ws_size, hipStream_t stream) {
    using namespace hy;
    static int grid = 0;
    if (grid == 0) {
        if (n_in != 31 || in_sizes[0] != M_ * D_ || out_size != M_ * D_ || ws_size < WS_END) { fprintf(stderr, "kernel_launch: unexpected shapes (n_in %d, in0 %d, out %d, ws %zu)\n", n_in, n_in > 0 ? in_sizes[0] : -1, out_size, ws_size); grid = -1; return; }
        if (hipFuncSetAttribute((const void*)hy_fwd, hipFuncAttributeMaxDynamicSharedMemorySize, LDS_BYTES) != hipSuccess) { fprintf(stderr, "kernel_launch: hipFuncSetAttribute failed\n"); grid = -1; return; }
        int dev = 0, cus = 0, per_cu = 0;
        (void)hipGetDevice(&dev); (void)hipDeviceGetAttribute(&cus, hipDeviceAttributeMultiprocessorCount, dev);
        (void)hipOccupancyMaxActiveBlocksPerMultiprocessor(&per_cu, (const void*)hy_fwd, NT, LDS_BYTES);
        if (per_cu < 1) fprintf(stderr, "kernel_launch: occupancy query reports %d blocks per CU\n", per_cu);
        (void)hipGetLastError();
        grid = cus > 0 ? cus : 256;
    }
    if (grid < 0) return;
    (void)hipMemsetAsync((char*)d_ws + WS_CTL, 0, CTL_ZERO_BYTES, stream);
    Args a{};
    for (int i = 0; i < 31; ++i) a.in[i] = (const float*)d_in[i];
    a.out = (float*)d_out; a.ws = (unsigned char*)d_ws;
    hipLaunchKernelGGL(hy_fwd, dim3(grid), dim3(NT), LDS_BYTES, stream, a);
}
```

```cpp
#include <hip/hip_runtime.h>
#include <cstdio>
#include <cstdint>
namespace pg8 {
#define PG8_LAS __attribute__((address_space(3)))
typedef unsigned short bf16_t;
typedef short bf16x8 __attribute__((ext_vector_type(8)));
typedef float f32x4 __attribute__((ext_vector_type(4)));
typedef unsigned u32x4 __attribute__((ext_vector_type(4)));
constexpr int BM = 256, BK = 64, HALF = 128, HTB = HALF * BK * 2  , STAGE_BYTES = 8 * HTB, NXCD = 8, WGM = 8;

__host__ __device__ __forceinline__ int lds_byte(int r, int c) { const int st = (r >> 4) * 2 + (c >> 5), rr = r & 15, cc = c & 31, ob = rr * 64 + cc * 2; return st * 1024 + (ob ^ (((ob >> 9) & 1) << 5)); }
__host__ __device__ __forceinline__ void stage_rc(int b, int& R, int& C) { const int st = b / 1024, sb = b % 1024, swz = sb ^ (((sb >> 9) & 1) << 5); R = (st >> 1) * 16 + swz / 64; C = (st & 1) * 32 + (swz % 64) / 2; }
__host__ __device__ __forceinline__ int perm32(int rho) { const int n = rho >> 4, i = rho & 15; return 8 * (i >> 2) + 4 * n + (i & 3); }

struct Unit { int pm, pn; };
struct Gemm { const bf16_t* A; const bf16_t* Bt; int M, N, K; };

struct StaticOrder {
    int nM, nN, nwg, G, c;
    __host__ __device__ void init(int M, int N, int G_, int c_) { nM = M / BM; nN = N / BM; nwg = nM * nN; G = G_; c = c_; }
    __host__ __device__ bool next(int i, Unit& u) const {
        const long L = (long)i * G + c; if (L >= nwg) return false;
        int wgid = (int)L; { const int q = nwg / NXCD, r = nwg % NXCD, xcd = wgid % NXCD, off = wgid / NXCD; wgid = (xcd < r ? xcd * (q + 1) : r * (q + 1) + (xcd - r) * q) + off; }
        const int nig = WGM * nN, gid = wgid / nig, fm = gid * WGM, gsz = (nM - fm) < WGM ? (nM - fm) : WGM;
        u.pm = fm + ((wgid % nig) % gsz); u.pn = (wgid % nig) / gsz; return true;
    }
    __device__ __forceinline__ void a_ready(const Unit&) const {}
    __device__ __forceinline__ void done(const Unit&) const {}
};

__device__ __forceinline__ unsigned cvt_pk_bf16(float lo, float hi) { unsigned r; asm volatile("v_cvt_pk_bf16_f32 %0, %1, %2" : "=v"(r) : "v"(lo), "v"(hi)); return r; }
typedef float f32x2 __attribute__((ext_vector_type(2)));
__device__ __forceinline__ f32x2 gelu_pk(f32x2 v) {
    const f32x2 av = __builtin_elementwise_abs(v), d = av * 0.2316418882f + 1.0f;
    f32x2 t; t.x = __builtin_amdgcn_rcpf(d.x); t.y = __builtin_amdgcn_rcpf(d.y);
    f32x2 q = t * 0.5307027145f + (-0.7265760135f); q = q * t + 0.7107068705f; q = q * t + (-0.142248368f); q = q * t + 0.127414796f; q = q * t;
    const f32x2 s = (v * v) * (-0.72134752044f);
    f32x2 e; e.x = __builtin_amdgcn_exp2f(s.x); e.y = __builtin_amdgcn_exp2f(s.y);
    const f32x2 m = v * (q * e), r = v - m;
    f32x2 o; o.x = v.x < 0.f ? m.x : r.x; o.y = v.y < 0.f ? m.y : r.y; return o;
}

template <int ACT  > struct EpiBf16 {
    static constexpr bool PERM = true, AFTER_DRAIN = false; static_assert(ACT == 0 || ACT == 1, "EpiBf16: ACT is 0 (none) or 1 (gelu_pk)");
    bf16_t* O; int ldc; const float* bias; int split_cols; size_t split_stride; float scale0;
    __device__ __forceinline__ void operator()(const f32x4 (&acc)[2][2][4][2], const Unit& u, int wr, int wc, int fr, int fq) const {
        const int row0 = u.pm * BM + wr * 64 + fr; int colt = u.pn * BM; bf16_t* base = O;
        float sc = 1.f; if (split_cols) { const int t = colt / split_cols; base += (size_t)t * split_stride; colt -= t * split_cols; if (t == 0) sc = scale0; }
        const int col0 = colt + wc * 32 + 8 * fq, bcol0 = u.pn * BM + wc * 32 + 8 * fq;
        f32x4 bv[2][2];
#pragma unroll
        for (int bj = 0; bj < 2; ++bj)
#pragma unroll
            for (int n = 0; n < 2; ++n) bv[bj][n] = bias ? *(const f32x4*)(bias + bcol0 + bj * HALF + 4 * n) : (f32x4){0.f, 0.f, 0.f, 0.f};
#pragma unroll
        for (int ai = 0; ai < 2; ++ai)
#pragma unroll
            for (int m = 0; m < 4; ++m) { bf16_t* rowp = base + (size_t)(row0 + ai * HALF + m * 16) * ldc + col0;
#pragma unroll
                for (int bj = 0; bj < 2; ++bj) { f32x4 v0 = acc[ai][bj][m][0] + bv[bj][0], v1 = acc[ai][bj][m][1] + bv[bj][1];
                    if (ACT == 1) { f32x2 a = gelu_pk((f32x2){v0[0], v0[1]}), b = gelu_pk((f32x2){v0[2], v0[3]}), c = gelu_pk((f32x2){v1[0], v1[1]}), d = gelu_pk((f32x2){v1[2], v1[3]});
                        v0 = (f32x4){a.x, a.y, b.x, b.y}; v1 = (f32x4){c.x, c.y, d.x, d.y}; }
                    v0 = v0 * sc; v1 = v1 * sc; u32x4 w; w.x = cvt_pk_bf16(v0[0], v0[1]); w.y = cvt_pk_bf16(v0[2], v0[3]); w.z = cvt_pk_bf16(v1[0], v1[1]); w.w = cvt_pk_bf16(v1[2], v1[3]);
                    *(u32x4*)(rowp + bj * HALF) = w; } }
    }
};
template <class Epi, class Sched, bool ALIGN_EPI = false, bool SP2 = false>
__device__ __forceinline__ void gemm_phase(PG8_LAS unsigned char* lds, const Gemm g, const Sched& S, const Epi& E) {
    int tid_ = threadIdx.x; asm volatile("" : "+v"(tid_));
    const int tid = tid_, wid = __builtin_amdgcn_readfirstlane(tid >> 6), lane = tid & 63, wr = wid >> 2, wc = wid & 3, fr = lane & 15, fq = lane >> 4;
    const int K = g.K, nt = K / BK;
    unsigned voffA[2], voffB[2];
#pragma unroll
    for (int i = 0; i < 2; ++i) { int R, C; stage_rc(tid * 16 + i * 8192, R, C); const int Rb = Epi::PERM ? ((R & ~31) + perm32(R & 31)) : R;
        voffA[i] = (unsigned)(R * K + C) * 2u; voffB[i] = (unsigned)(Rb * K + C) * 2u; }
    const size_t kstep = (size_t)(BK * 2);
    const size_t hstep = (size_t)HALF * K * 2;
    const size_t tstep = 2 * hstep;
    const unsigned ldsw = (unsigned)wid * 1024u;
    const int aoff = lds_byte(wr * 64 + fr, fq * 8), boff = lds_byte(wc * 32 + fr, fq * 8);
#define PG8_SA(b, h) (((b) * 2 + (h)) * HTB)
#define PG8_SB(b, h) ((4 + (b) * 2 + (h)) * HTB)
#define PG8_STAGE(bufoff, gbase, voff) do { _Pragma("unroll") for (int _i = 0; _i < 2; ++_i) \
        __builtin_amdgcn_global_load_lds((const unsigned*)((const char*)(gbase) + (voff)[_i]), (PG8_LAS unsigned*)(lds + (bufoff) + ldsw + _i * 8192), 16, 0, 0); } while (0)
#define PG8_LDA(dst, b, h) do { _Pragma("unroll") for (int m = 0; m < 4; ++m) _Pragma("unroll") for (int k = 0; k < 2; ++k) dst[m][k] = *(const PG8_LAS bf16x8*)(lds + PG8_SA(b, h) + aoff + m * 2048 + k * 1024); } while (0)
#define PG8_LDB(dst, b, h) do { _Pragma("unroll") for (int n = 0; n < 2; ++n) _Pragma("unroll") for (int k = 0; k < 2; ++k) dst[n][k] = *(const PG8_LAS bf16x8*)(lds + PG8_SB(b, h) + boff + n * 2048 + k * 1024); } while (0)
#define PG8_MMA(ai, bj, At, Bt) do { __builtin_amdgcn_s_setprio(1); _Pragma("unroll") for (int m = 0; m < 4; ++m) _Pragma("unroll") for (int n = 0; n < 2; ++n) _Pragma("unroll") for (int k = 0; k < 2; ++k) \
        acc[ai][bj][m][n] = __builtin_amdgcn_mfma_f32_16x16x32_bf16(Bt[n][k], At[m][k], acc[ai][bj][m][n], 0, 0, 0); __builtin_amdgcn_s_setprio(0); } while (0)
#define PG8_WAIT_V(n) asm volatile("s_waitcnt vmcnt(" #n ")" ::: "memory")
#define PG8_WAIT_L(n) asm volatile("s_waitcnt lgkmcnt(" #n ")" ::: "memory")
#define PG8_BAR __builtin_amdgcn_s_barrier()
#define PG8_SCHED __builtin_amdgcn_sched_barrier(0)
    Unit cur, nxt; int ui = 0;
    if (!S.next(0, cur)) return;
    f32x4 acc[2][2][4][2];
#pragma unroll
    for (int a = 0; a < 2; ++a)
#pragma unroll
        for (int b = 0; b < 2; ++b)
#pragma unroll
            for (int m = 0; m < 4; ++m)
#pragma unroll
                for (int n = 0; n < 2; ++n) acc[a][b][m][n] = (f32x4){0.f, 0.f, 0.f, 0.f};
    bf16x8 At[4][2], B0[2][2], B1[2][2];
    const char* cA = (const char*)g.A + (size_t)cur.pm * tstep; const char* cB = (const char*)g.Bt + (size_t)cur.pn * tstep;
    S.a_ready(cur);
    if constexpr (SP2) {
        PG8_STAGE(PG8_SB(0, 0), cB, voffB); PG8_STAGE(PG8_SB(0, 1), cB + hstep, voffB); PG8_STAGE(PG8_SA(0, 0), cA, voffA); PG8_STAGE(PG8_SA(0, 1), cA + hstep, voffA);
        if (wr == 1) PG8_BAR;
        PG8_WAIT_V(2); PG8_BAR;
        PG8_STAGE(PG8_SB(1, 0), cB + kstep, voffB); PG8_STAGE(PG8_SA(1, 0), cA + kstep, voffA); PG8_STAGE(PG8_SB(1, 1), cB + hstep + kstep, voffB);
        PG8_WAIT_V(6); PG8_BAR;
    } else {
        PG8_STAGE(PG8_SB(0, 0), cB, voffB); PG8_STAGE(PG8_SA(0, 0), cA, voffA); PG8_STAGE(PG8_SB(0, 1), cB + hstep, voffB); PG8_STAGE(PG8_SA(0, 1), cA + hstep, voffA);
        if (wr == 1) PG8_BAR;
        PG8_WAIT_V(4); PG8_BAR;
        PG8_STAGE(PG8_SB(1, 0), cB + kstep, voffB); PG8_STAGE(PG8_SA(1, 0), cA + kstep, voffA); PG8_STAGE(PG8_SB(1, 1), cB + hstep + kstep, voffB);
        PG8_WAIT_V(6); PG8_BAR;
    }
    for (;;) {
        const bool has_next = S.next(ui + 1, nxt);
        const char* nA = has_next ? (const char*)g.A + (size_t)nxt.pm * tstep : cA; const char* nB = has_next ? (const char*)g.Bt + (size_t)nxt.pn * tstep : cB;
        for (int t = 0; t < nt; t += 2) {
            const bool last = (t == nt - 2);
            const char* a1 = cA + (size_t)(t + 1) * kstep;
            const char* a2 = last ? nA : cA + (size_t)(t + 2) * kstep; const char* b2 = last ? nB : cB + (size_t)(t + 2) * kstep;
            const char* a3 = a2 + kstep; const char* b3 = b2 + kstep;
            if (last && has_next) S.a_ready(nxt);
            if constexpr (SP2) {
            PG8_LDB(B0, 0, 0); PG8_LDB(B1, 0, 1); PG8_SCHED; PG8_LDA(At, 0, 0); PG8_STAGE(PG8_SA(1, 1), a1 + hstep, voffA);
            PG8_WAIT_V(8); PG8_WAIT_L(0); PG8_BAR; PG8_MMA(0, 0, At, B0); PG8_MMA(0, 1, At, B1); PG8_BAR; PG8_SCHED;
            PG8_LDA(At, 0, 1); PG8_STAGE(PG8_SB(0, 0), b2, voffB); PG8_STAGE(PG8_SB(0, 1), b2 + hstep, voffB); PG8_STAGE(PG8_SA(0, 0), a2, voffA);
            PG8_WAIT_V(8); PG8_WAIT_L(0); PG8_BAR; PG8_MMA(1, 0, At, B0); PG8_MMA(1, 1, At, B1); PG8_BAR; PG8_SCHED;
            PG8_LDB(B0, 1, 0); PG8_LDB(B1, 1, 1); PG8_SCHED; PG8_LDA(At, 1, 0); PG8_STAGE(PG8_SA(0, 1), a2 + hstep, voffA);
            PG8_WAIT_V(8); PG8_WAIT_L(0); PG8_BAR; PG8_MMA(0, 0, At, B0); PG8_MMA(0, 1, At, B1); PG8_BAR; PG8_SCHED;
            PG8_LDA(At, 1, 1); PG8_STAGE(PG8_SB(1, 0), b3, voffB); PG8_STAGE(PG8_SB(1, 1), b3 + hstep, voffB); PG8_STAGE(PG8_SA(1, 0), a3, voffA);
            PG8_WAIT_V(8); PG8_WAIT_L(0); PG8_BAR; PG8_MMA(1, 0, At, B0); PG8_MMA(1, 1, At, B1); PG8_BAR; PG8_SCHED;
            } else {
            PG8_LDB(B0, 0, 0); PG8_SCHED; PG8_LDA(At, 0, 0); PG8_STAGE(PG8_SA(1, 1), a1 + hstep, voffA);
            PG8_WAIT_L(8); PG8_BAR; PG8_WAIT_L(0); PG8_MMA(0, 0, At, B0); PG8_BAR; PG8_SCHED;
            PG8_LDB(B1, 0, 1); PG8_STAGE(PG8_SB(0, 0), b2, voffB);
            PG8_BAR; PG8_WAIT_L(0); PG8_MMA(0, 1, At, B1); PG8_BAR;
            PG8_LDA(At, 0, 1); PG8_STAGE(PG8_SA(0, 0), a2, voffA);
            PG8_BAR; PG8_WAIT_L(0); PG8_MMA(1, 0, At, B0); PG8_BAR; PG8_SCHED;
            PG8_STAGE(PG8_SB(0, 1), b2 + hstep, voffB);
            PG8_WAIT_V(6); PG8_BAR; PG8_MMA(1, 1, At, B1); PG8_BAR;
            PG8_LDB(B0, 1, 0); PG8_SCHED; PG8_LDA(At, 1, 0); PG8_STAGE(PG8_SA(0, 1), a2 + hstep, voffA);
            PG8_WAIT_L(8); PG8_BAR; PG8_WAIT_L(0); PG8_MMA(0, 0, At, B0); PG8_BAR; PG8_SCHED;
            PG8_LDB(B1, 1, 1); PG8_STAGE(PG8_SB(1, 0), b3, voffB);
            PG8_BAR; PG8_WAIT_L(0); PG8_MMA(0, 1, At, B1); PG8_BAR;
            PG8_LDA(At, 1, 1); PG8_STAGE(PG8_SA(1, 0), a3, voffA);
            PG8_BAR; PG8_WAIT_L(0); PG8_MMA(1, 0, At, B0); PG8_BAR; PG8_SCHED;
            PG8_STAGE(PG8_SB(1, 1), b3 + hstep, voffB);
            PG8_WAIT_V(6); PG8_BAR; PG8_MMA(1, 1, At, B1); PG8_BAR;
            }
        }
        if constexpr (ALIGN_EPI) { if (wr == 0) PG8_BAR; }
        if constexpr (!Epi::AFTER_DRAIN) { E(acc, cur, wr, wc, fr, fq); S.done(cur); }
        if (!has_next) break;
#pragma unroll
        for (int a = 0; a < 2; ++a)
#pragma unroll
            for (int b = 0; b < 2; ++b)
#pragma unroll
                for (int m = 0; m < 4; ++m)
#pragma unroll
                    for (int n = 0; n < 2; ++n) acc[a][b][m][n] = (f32x4){0.f, 0.f, 0.f, 0.f};
        cur = nxt; cA = nA; cB = nB; ++ui;
        if constexpr (ALIGN_EPI) { if (wr == 1) PG8_BAR; }
    }
    PG8_WAIT_V(0);
    if constexpr (!ALIGN_EPI) { if (wr == 0) PG8_BAR; }
    PG8_BAR;
    if constexpr (Epi::AFTER_DRAIN) { E.fused(acc, cur, wr, wc, fr, fq, lds, wid, lane); S.done(cur); }
#undef PG8_SA
#undef PG8_SB
#undef PG8_STAGE
#undef PG8_LDA
#undef PG8_LDB
#undef PG8_MMA
#undef PG8_WAIT_V
#undef PG8_WAIT_L
#undef PG8_BAR
#undef PG8_SCHED
}
}

namespace hy {
#define GAS __attribute__((address_space(1)))
#define LAS __attribute__((address_space(3)))
typedef unsigned short bf16;
typedef unsigned v4u __attribute__((ext_vector_type(4)));
typedef float f32x4 __attribute__((ext_vector_type(4)));
typedef short bf16x8 __attribute__((ext_vector_type(8)));
typedef GAS unsigned gu32;
typedef GAS unsigned long long gu64;
#define RLX_AGENT __ATOMIC_RELAXED, __HIP_MEMORY_SCOPE_AGENT
#define LDS_WAIT() asm volatile("s_waitcnt lgkmcnt(0)" ::: "memory")
#define VM_WAIT() asm volatile("s_waitcnt vmcnt(0)" ::: "memory")
__device__ __forceinline__ unsigned long long rt() { return __builtin_amdgcn_s_memrealtime(); }
__device__ __forceinline__ unsigned f2bf(float f) { unsigned u = __builtin_bit_cast(unsigned, f); return (u + 0x7fffu + ((u >> 16) & 1u)) >> 16; }
__device__ __forceinline__ unsigned pk2(float lo, float hi) { return f2bf(lo) | (f2bf(hi) << 16); }
#define XB_TMO      128
#define XB_XCNT(j)  (256  + 64 * (j))
#define XB_XSUB(j)  (1280 + 64 * (j))
#define XB_XGEN(j)  (2304 + 64 * (j))
#define XB_TOP      3328
#define XB_TOPGEN   3392
#define XCD_BAR_WORDS 3456
#define XB_SPIN_CAP (1u << 18)

__device__ __forceinline__ unsigned xb_ld(unsigned* p)              { return __hip_atomic_load(p, __ATOMIC_RELAXED, __HIP_MEMORY_SCOPE_AGENT); }
__device__ __forceinline__ unsigned xb_add(unsigned* p, unsigned v) { return __hip_atomic_fetch_add(p, v, __ATOMIC_RELAXED, __HIP_MEMORY_SCOPE_AGENT); }
__device__ __forceinline__ unsigned xb_xcc_id() { return (unsigned)__builtin_amdgcn_s_getreg((3 << 11) | 20) & 0xFu; }
#define XB_SPIN(cond, bar) do { unsigned _sp = 0; while (cond) { __builtin_amdgcn_s_sleep(1); \
    if ((++_sp & 255u) == 0u) { if (xb_ld(&(bar)[XB_TMO])) break; if (_sp > XB_SPIN_CAP) { atomicAdd(&(bar)[XB_TMO], 1u); break; } } } } while (0)

struct XcdBarrier {
    unsigned* bar; unsigned x;
    volatile LAS unsigned* st;
};

__device__ __forceinline__ XcdBarrier xcd_barrier_post(unsigned* bar, volatile LAS unsigned* st) {
    XcdBarrier b; b.bar = bar; b.x = xb_xcc_id(); b.st = st;
    if (threadIdx.x == 0) (void)xb_add(&bar[XB_XCNT(b.x)], 1u);
    return b;
}
__device__ __forceinline__ void xcd_barrier_complete(unsigned* bar, unsigned x, unsigned& nloc, unsigned& nx) {
    const unsigned G = gridDim.x * gridDim.y * gridDim.z;
    unsigned sum, cnt, mine, sp = 0u;
    for (;;) {
        sum = 0u; cnt = 0u; mine = 0u;
#pragma unroll
        for (unsigned j = 0; j < 16; ++j) { const unsigned c = xb_ld(&bar[XB_XCNT(j)]); sum += c; cnt += (c > 0u) ? 1u : 0u; mine = (j == x) ? c : mine; }
        if (sum == G) break;
        __builtin_amdgcn_s_sleep(1);
        if ((++sp & 255u) == 0u) { if (xb_ld(&bar[XB_TMO])) break; if (sp > XB_SPIN_CAP) { atomicAdd(&bar[XB_TMO], 1u); break; } }
    }
    nloc = mine > 0u ? mine : 1u; nx = cnt > 0u ? cnt : 1u;
}

__device__ __forceinline__ void xcd_barrier(const XcdBarrier& b) {
    asm volatile("s_waitcnt vmcnt(0)" ::: "memory");
    __syncthreads();
    if (threadIdx.x == 0) {
        unsigned* bar = b.bar;
        __builtin_amdgcn_s_waitcnt(0);
        unsigned nloc = b.st[0], nx = b.st[1];
        if (nloc == 0u) { xcd_barrier_complete(bar, b.x, nloc, nx); b.st[0] = nloc; b.st[1] = nx; }
        const unsigned old = xb_add(&bar[XB_XSUB(b.x)], 1u);
        const unsigned gen = old / nloc;
        if (old + 1u == (gen + 1u) * nloc) {
            __builtin_amdgcn_fence(__ATOMIC_RELEASE, "agent");
            asm volatile("s_waitcnt vmcnt(0)" ::: "memory");
            const unsigned og = xb_add(&bar[XB_TOP], 1u);
            const unsigned tg = og / nx;
            if (og + 1u == (tg + 1u) * nx) xb_add(&bar[XB_TOPGEN], 1u);
            else XB_SPIN(xb_ld(&bar[XB_TOPGEN]) == tg, bar);
            __builtin_amdgcn_fence(__ATOMIC_ACQUIRE, "agent");
            xb_add(&bar[XB_XGEN(b.x)], 1u);
            asm volatile("s_waitcnt vmcnt(0)" ::: "memory");
        } else {
            XB_SPIN(xb_ld(&bar[XB_XGEN(b.x)]) == gen, bar);
            __builtin_amdgcn_fence(__ATOMIC_ACQUIRE, "agent");
            asm volatile("s_waitcnt vmcnt(0)" ::: "memory");
        }
    }
    __syncthreads();
}

constexpr int B_ = 4, T_ = 8192, D_ = 1024, M_ = B_ * T_, L_ = 2;
constexpr int NIN = 3584, NPG = 1792, NPR = 1792;
constexpr int DFF = 2816, NUP = 5632, IN_COLS = 3344;
constexpr size_t MiB = 1u << 20;
constexpr size_t WS_CTL = 0, CTL_ZERO_BYTES = 65536;
constexpr int CW_BAR = 4096;
constexpr size_t WS_MOD = 1 * MiB;
constexpr size_t WS_WIN = 2 * MiB, WS_WOUT = 9 * MiB, WS_WUP = 11 * MiB, WS_WDN = 22 * MiB, WS_INVN = 28 * MiB, WS_VL = 29 * MiB;
constexpr size_t WS_GAM = 31 * MiB;
constexpr size_t WS_XB = 32 * MiB, WS_O = 96 * MiB, WS_VF = 160 * MiB, WS_GK = 192 * MiB, WS_PG = 224 * MiB, WS_PR = 336 * MiB, WS_END = 512 * MiB;
constexpr size_t WS_LW = WS_XB, WS_SAR = 224 * MiB, WS_SAK = 256 * MiB, WS_SAV = 288 * MiB, WS_SAA = 448 * MiB, WS_SAG = 480 * MiB, WS_Y = WS_PR;
constexpr size_t WS_ACT = 224 * MiB, WS_U = 400 * MiB;
constexpr int RING_BYTES = 131072, MISC_OFF = RING_BYTES, LDS_BYTES = 147456;
constexpr int NT = 512;

__device__ __forceinline__ float bf2f(bf16 h) { return __builtin_bit_cast(float, (unsigned)h << 16); }
__device__ __forceinline__ float sigmoidf_(float x) { return 1.f / (1.f + __expf(-x)); }
__device__ __forceinline__ float siluf_(float x) { return x / (1.f + __expf(-x)); }
__device__ __forceinline__ float softplusf_(float x) { return fmaxf(x, 0.f) + log1pf(__expf(-fabsf(x))); }

typedef unsigned u32x2 __attribute__((ext_vector_type(2)));
template <int CTRL> __device__ __forceinline__ float dpp_f(float v) {
    return __builtin_bit_cast(float, __builtin_amdgcn_update_dpp(0, __builtin_bit_cast(int, v), CTRL, 0xf, 0xf, false));
}
__device__ __forceinline__ float wave_sum(float v) {
    v += dpp_f<0xB1>(v);
    v += dpp_f<0x4E>(v);
    v += dpp_f<0x141>(v);
    v += dpp_f<0x140>(v);
    v += __builtin_bit_cast(float, __builtin_amdgcn_update_dpp(0, __builtin_bit_cast(int, v), 0x142, 0xa, 0xf, false));
    v += __builtin_bit_cast(float, __builtin_amdgcn_update_dpp(0, __builtin_bit_cast(int, v), 0x143, 0xc, 0xf, false));
    return __builtin_bit_cast(float, __builtin_amdgcn_readlane(__builtin_bit_cast(int, v), 63));
}

struct Ctx { int bid, nb, tid, lane, wave; LAS unsigned char* lds; };

__device__ __forceinline__ void ph_mod(const Ctx& C, const float* c, const float* ada_w, const float* ada_b, float* MOD) {
    LAS float* sc = (LAS float*)C.lds;
    LAS float* red = (LAS float*)(C.lds + 16384);
    for (int i = C.tid; i < 4096; i += NT) sc[i] = siluf_(c[i]);
    __syncthreads();
    for (int item = C.bid; item < 192; item += C.nb) {
        const int l = item / 96, j0 = (item % 96) * 64;
        const float* W = ada_w + (size_t)l * 1024 * 6144 + j0 + C.lane;
        float a0 = 0.f, a1 = 0.f, a2 = 0.f, a3 = 0.f;
        for (int k = C.wave * 128; k < C.wave * 128 + 128; ++k) { const float wv = W[(size_t)k * 6144]; a0 += sc[k] * wv; a1 += sc[1024 + k] * wv; a2 += sc[2048 + k] * wv; a3 += sc[3072 + k] * wv; }
        red[(C.wave * 4 + 0) * 64 + C.lane] = a0; red[(C.wave * 4 + 1) * 64 + C.lane] = a1; red[(C.wave * 4 + 2) * 64 + C.lane] = a2; red[(C.wave * 4 + 3) * 64 + C.lane] = a3;
        __syncthreads();
        if (C.wave < 4) { const int b = C.wave; float s = ada_b[l * 6144 + j0 + C.lane];
#pragma unroll
            for (int w = 0; w < 8; ++w) s += red[(w * 4 + b) * 64 + C.lane];
            MOD[((size_t)l * 4 + b) * 6144 + j0 + C.lane] = s; }
        __syncthreads();
    }
}

__device__ __forceinline__ void wprep_mat(const Ctx& C, const float* W, int K, int Nsrc, int Ndst, bf16* Wt, int mode, const float* vres) {
    const int half = C.tid >> 8, t = C.tid & 255, tx = t & 31, ty = t >> 5;
    LAS float* tile = (LAS float*)C.lds + half * (32 * 33);
    const int nbn = Ndst / 32, ntile = nbn * (K / 32);
    const int niter = (ntile + 2 * C.nb - 1) / (2 * C.nb);
    for (int it = 0; it < niter; ++it) {
        const int item = (it * C.nb + C.bid) * 2 + half;
        const bool act = item < ntile;
        const int n0 = (item % nbn) * 32, k0 = (item / nbn) * 32, n = n0 + tx;
        if (act) {
#pragma unroll
            for (int i = 0; i < 4; ++i) { const int k = k0 + ty + 8 * i; float v = 0.f;
                if (mode == 0) v = W[(size_t)k * Nsrc + n];
                else { if (n < 1552) v = W[(size_t)k * Nsrc + n]; else if (n < 1584) v = vres ? vres[(size_t)k * 32 + (n - 1552)] : 0.f; else if (n < 1792) v = 0.f; else v = W[(size_t)k * Nsrc + (n - 240)]; }
                tile[(ty + 8 * i) * 33 + tx] = v; }
        }
        __syncthreads();
        if (act) {
#pragma unroll
            for (int i = 0; i < 4; ++i) { const int nn = n0 + ty + 8 * i; Wt[(size_t)nn * K + k0 + tx] = (bf16)f2bf(tile[tx * 33 + ty + 8 * i]); }
        }
        __syncthreads();
    }
}

__device__ __forceinline__ void ph_norm(const Ctx& C, const float* x, const float* g, const float* sh, const float* sc, bf16* XB) {
    const int gw = C.bid * 8 + C.wave, NGW = C.nb * 8, lane = C.lane;
    for (int m = gw; m < M_; m += NGW) {
        const int b = m / T_;
        const f32x4* xr = (const f32x4*)(x + (size_t)m * D_) + lane;
        f32x4 v[4]; float s = 0.f;
#pragma unroll
        for (int j = 0; j < 4; ++j) { v[j] = xr[64 * j]; s += (v[j].x * v[j].x + v[j].y * v[j].y) + (v[j].z * v[j].z + v[j].w * v[j].w); }
        const float rstd = 1.f / sqrtf(wave_sum(s) * (1.f / D_) + 1e-6f);
        unsigned long long* o8 = (unsigned long long*)(XB + (size_t)m * D_) + lane;
#pragma unroll
        for (int j = 0; j < 4; ++j) { const int col = 4 * lane + 256 * j;
            const f32x4 gv = *(const f32x4*)(g + col), shv = *(const f32x4*)(sh + b * 6144 + col), scv = *(const f32x4*)(sc + b * 6144 + col);
            const f32x4 h = v[j] * rstd * gv * (scv + 1.f) + shv;
            o8[64 * j] = (unsigned long long)(f2bf(h.x) | (f2bf(h.y) << 16)) | ((unsigned long long)(f2bf(h.z) | (f2bf(h.w) << 16)) << 32); }
    }
}
__device__ __forceinline__ void ph_final(const Ctx& C, float* x, const float* g) {
    const int gw = C.bid * 8 + C.wave, NGW = C.nb * 8, lane = C.lane;
    for (int m = gw; m < M_; m += NGW) {
        f32x4* xr = (f32x4*)(x + (size_t)m * D_) + lane;
        f32x4 v[4]; float s = 0.f;
#pragma unroll
        for (int j = 0; j < 4; ++j) { v[j] = xr[64 * j]; s += (v[j].x * v[j].x + v[j].y * v[j].y) + (v[j].z * v[j].z + v[j].w * v[j].w); }
        const float rstd = 1.f / sqrtf(wave_sum(s) * (1.f / D_) + 1e-6f);
#pragma unroll
        for (int j = 0; j < 4; ++j) { const f32x4 gv = *(const f32x4*)(g + 4 * lane + 256 * j); xr[64 * j] = v[j] * rstd * gv; }
    }
}


typedef short s16x8 __attribute__((ext_vector_type(8)));
__device__ __forceinline__ f32x4 mm16(const LAS bf16* A, int lda, const LAS bf16* B, int ldb, int K, f32x4 acc, int lane) {
    const int r = lane & 15, g = lane >> 4;
    const LAS bf16* ap = A + r * lda + 8 * g; const LAS bf16* bp = B + r * ldb + 8 * g;
    for (int k0 = 0; k0 < K; k0 += 32) { const s16x8 a = *(const LAS s16x8*)(ap + k0); const s16x8 b = *(const LAS s16x8*)(bp + k0); acc = __builtin_amdgcn_mfma_f32_16x16x32_bf16(a, b, acc, 0, 0, 0); }
    return acc;
}
__device__ __forceinline__ f32x4 mm16_ga(const bf16* A, int lda, const LAS bf16* B, int ldb, int K, f32x4 acc, int lane) {
    const int r = lane & 15, g = lane >> 4;
    const bf16* ap = A + r * lda + 8 * g; const LAS bf16* bp = B + r * ldb + 8 * g;
    for (int k0 = 0; k0 < K; k0 += 32) { const s16x8 a = *(const s16x8*)(ap + k0); const s16x8 b = *(const LAS s16x8*)(bp + k0); acc = __builtin_amdgcn_mfma_f32_16x16x32_bf16(a, b, acc, 0, 0, 0); }
    return acc;
}
__device__ __forceinline__ unsigned long long pack4(f32x4 v) { return (unsigned long long)(f2bf(v.x) | (f2bf(v.y) << 16)) | ((unsigned long long)(f2bf(v.z) | (f2bf(v.w) << 16)) << 32); }
__device__ __forceinline__ float logsigmoidf_(float x) { return fminf(x, 0.f) - log1pf(__expf(-fabsf(x))); }

constexpr int GL_LD = 72;
constexpr int GL_GK = 0;
constexpr int GL_SEG = 16384;
constexpr int GL_Z = 18432;
constexpr int GL_GUP = 20480;
constexpr int GL_I0 = 24832;
constexpr int GL_I1 = GL_I0 + 9216;
constexpr int GL_I2 = GL_I1 + 9216;
constexpr int GL_VT = GL_I2 + 9216;
constexpr int GL_SSQ = GL_VT + 18432;
static_assert(GL_SSQ + 512 <= RING_BYTES, "GLA LDS map");

__device__ __forceinline__ void gla_gates(const Ctx& C, const bf16* pg  , const float* gk_up, const float* gk_b, int h) {
    LAS float* GK = (LAS float*)(C.lds + GL_GK); LAS float* SEG = (LAS float*)(C.lds + GL_SEG); LAS bf16* Z = (LAS bf16*)(C.lds + GL_Z); LAS float* GUP = (LAS float*)(C.lds + GL_GUP);
    const int tid = C.tid;
    if (tid < 128) { const int t = tid >> 1, hh = tid & 1; *(LAS v4u*)(Z + t * 16 + hh * 8) = *(const v4u*)(pg + (size_t)t * NPG + 1536 + hh * 8); }
    for (int i = tid; i < 16 * 64; i += NT) GUP[i] = gk_up[(i >> 6) * 256 + h * 64 + (i & 63)];
    if (tid < 64) GUP[1024 + tid] = gk_b[h * 64 + tid];
    __syncthreads();
    { const int t = tid >> 3, d0 = (tid & 7) * 8; float a[8];
#pragma unroll
      for (int q = 0; q < 8; ++q) a[q] = GUP[1024 + d0 + q];
#pragma unroll
      for (int i = 0; i < 16; ++i) { const float zv = bf2f(Z[t * 16 + i]);
#pragma unroll
          for (int q = 0; q < 8; ++q) a[q] += zv * GUP[i * 64 + d0 + q]; }
#pragma unroll
      for (int q = 0; q < 8; ++q) GK[t * 64 + d0 + q] = logsigmoidf_(a[q]) * (1.f / 16.f); }
    __syncthreads();
    { const int d = tid & 63, seg = tid >> 6; float run = 0.f;
#pragma unroll
      for (int q = 0; q < 8; ++q) { run += GK[(seg * 8 + q) * 64 + d]; GK[(seg * 8 + q) * 64 + d] = run; }
      SEG[seg * 64 + d] = run; }
    __syncthreads();
    { const int d = tid & 63, seg = tid >> 6; float off = 0.f;
      for (int s = 0; s < seg; ++s) off += SEG[s * 64 + d];
#pragma unroll
      for (int q = 0; q < 8; ++q) GK[(seg * 8 + q) * 64 + d] += off; }
    __syncthreads();
}
__device__ __forceinline__ void gla_stage_vt(const Ctx& C, const bf16* pg, int h) {
    LAS bf16* VT = (LAS bf16*)(C.lds + GL_VT);
    const int j = C.tid >> 3, e0 = (C.tid & 7) * 16;
    const v4u x0 = *(const v4u*)(pg + (size_t)j * NPG + 512 + h * 128 + e0), x1 = *(const v4u*)(pg + (size_t)j * NPG + 512 + h * 128 + e0 + 8);
    const unsigned w[8] = {x0.x, x0.y, x0.z, x0.w, x1.x, x1.y, x1.z, x1.w};
#pragma unroll
    for (int q = 0; q < 8; ++q) { VT[(e0 + 2 * q) * GL_LD + j] = (bf16)(w[q] & 0xffffu); VT[(e0 + 2 * q + 1) * GL_LD + j] = (bf16)(w[q] >> 16); }
}

__device__ __forceinline__ void ph_gla_a(const Ctx& C, const bf16* PG, const float* gk_up, const float* gk_b, bf16* DS, float* GAM, bf16* VL) {
    LAS float* GK = (LAS float*)(C.lds + GL_GK); LAS bf16* KT = (LAS bf16*)(C.lds + GL_I0); LAS bf16* VT = (LAS bf16*)(C.lds + GL_VT);
    for (int item = C.bid; item < 2048; item += C.nb) {
        const int bh = item >> 7, c = item & 127, b = bh >> 2, h = bh & 3;
        const size_t m0 = (size_t)b * T_ + c * 64;
        const bf16* pg = PG + m0 * NPG;
        gla_gates(C, pg, gk_up, gk_b, h);
        { const int j = C.tid >> 3, d0 = (C.tid & 7) * 8;
          const v4u kx = *(const v4u*)(pg + (size_t)j * NPG + 256 + h * 64 + d0);
          const unsigned w[4] = {kx.x, kx.y, kx.z, kx.w};
#pragma unroll
          for (int q = 0; q < 4; ++q) { const float k0 = bf2f((bf16)(w[q] & 0xffffu)), k1 = bf2f((bf16)(w[q] >> 16));
              const int d = d0 + 2 * q;
              KT[d * GL_LD + j] = (bf16)f2bf(k0 * __expf(GK[63 * 64 + d] - GK[j * 64 + d]));
              KT[(d + 1) * GL_LD + j] = (bf16)f2bf(k1 * __expf(GK[63 * 64 + d + 1] - GK[j * 64 + d + 1])); } }
        gla_stage_vt(C, pg, h);
        if (C.tid < 64) GAM[(size_t)item * 64 + C.tid] = __expf(GK[63 * 64 + C.tid]);
        if (h == 0 && C.tid < 256) { const int t = C.tid >> 2, q = C.tid & 3; *(unsigned long long*)(VL + (m0 + t) * 32 + q * 8 + 0) = *(const unsigned long long*)(pg + (size_t)t * NPG + 1552 + q * 8);
                                     *(unsigned long long*)(VL + (m0 + t) * 32 + q * 8 + 4) = *(const unsigned long long*)(pg + (size_t)t * NPG + 1552 + q * 8 + 4); }
        __syncthreads();
        { const int n0 = C.wave * 16, lane = C.lane, cc = lane & 15, g = lane >> 4;
          bf16* out = DS + (size_t)item * 8192 + (size_t)(n0 + cc) * 64 + 4 * g;
#pragma unroll
          for (int mt = 0; mt < 4; ++mt) { f32x4 acc = {0.f, 0.f, 0.f, 0.f}; acc = mm16(KT + mt * 16 * GL_LD, GL_LD, VT + n0 * GL_LD, GL_LD, 64, acc, lane);
              *(unsigned long long*)(out + mt * 16) = pack4(acc); } }
        __syncthreads();
    }
}
__device__ __forceinline__ void ph_gla_b(const Ctx& C, bf16* DS, const float* GAM) {
    for (int idx = C.bid * NT + C.tid; idx < 16 * 8192; idx += C.nb * NT) {
        const int bh = idx >> 13, ed = idx & 8191, d = ed & 63;
        bf16* p = DS + (size_t)bh * 128 * 8192 + ed; const float* gp = GAM + (size_t)bh * 128 * 64 + d;
        float S = 0.f;
        for (int c0 = 0; c0 < 128; c0 += 8) {
            float ds[8], gm[8];
#pragma unroll
            for (int i = 0; i < 8; ++i) { ds[i] = bf2f(p[(size_t)(c0 + i) * 8192]); gm[i] = gp[(c0 + i) * 64]; }
#pragma unroll
            for (int i = 0; i < 8; ++i) { const float gs = gm[i] * S; p[(size_t)(c0 + i) * 8192] = (bf16)f2bf(gs); S = gs + ds[i]; }
        }
    }
}
__device__ __forceinline__ void ph_gla_c(const Ctx& C, const bf16* PG, const float* gk_up, const float* gk_b, const float* norm_g, const bf16* DS, bf16* O) {
    LAS float* GK = (LAS float*)(C.lds + GL_GK); LAS bf16* QP = (LAS bf16*)(C.lds + GL_I0); LAS bf16* KM = (LAS bf16*)(C.lds + GL_I1); LAS bf16* AI = (LAS bf16*)(C.lds + GL_I2);
    LAS bf16* VT = (LAS bf16*)(C.lds + GL_VT); LAS float* SSQ = (LAS float*)(C.lds + GL_SSQ);
    for (int item = C.bid; item < 2048; item += C.nb) {
        const int bh = item >> 7, c = item & 127, b = bh >> 2, h = bh & 3;
        const size_t m0 = (size_t)b * T_ + c * 64;
        const bf16* pg = PG + m0 * NPG;
        gla_gates(C, pg, gk_up, gk_b, h);
        { const int j = C.tid >> 3, d0 = (C.tid & 7) * 8;
          const v4u qx = *(const v4u*)(pg + (size_t)j * NPG + h * 64 + d0), kx = *(const v4u*)(pg + (size_t)j * NPG + 256 + h * 64 + d0);
          const unsigned qw[4] = {qx.x, qx.y, qx.z, qx.w}, kw[4] = {kx.x, kx.y, kx.z, kx.w};
          unsigned qo[4], ko[4];
#pragma unroll
          for (int q = 0; q < 4; ++q) { const int d = d0 + 2 * q;
              const float e0 = GK[63 * 64 + d] - GK[j * 64 + d], e1 = GK[63 * 64 + d + 1] - GK[j * 64 + d + 1];
              const float q0 = 0.125f * bf2f((bf16)(qw[q] & 0xffffu)) * __expf(-e0), q1 = 0.125f * bf2f((bf16)(qw[q] >> 16)) * __expf(-e1);
              const float k0 = bf2f((bf16)(kw[q] & 0xffffu)) * __expf(e0), k1 = bf2f((bf16)(kw[q] >> 16)) * __expf(e1);
              qo[q] = f2bf(q0) | (f2bf(q1) << 16); ko[q] = f2bf(k0) | (f2bf(k1) << 16); }
          *(LAS v4u*)(QP + j * GL_LD + d0) = (v4u){qo[0], qo[1], qo[2], qo[3]}; *(LAS v4u*)(KM + j * GL_LD + d0) = (v4u){ko[0], ko[1], ko[2], ko[3]}; }
        gla_stage_vt(C, pg, h);
        __syncthreads();
        { const int lane = C.lane, cc = lane & 15, g = lane >> 4, n0 = (C.wave >> 1) * 16;
#pragma unroll
          for (int q = 0; q < 2; ++q) { const int mt0 = ((C.wave & 1) * 2 + q) * 16; f32x4 acc = {0.f, 0.f, 0.f, 0.f};
              acc = mm16(KM + mt0 * GL_LD, GL_LD, QP + n0 * GL_LD, GL_LD, 64, acc, lane);
              const int i = n0 + cc, j = mt0 + 4 * g;
              acc.x = (j + 0 <= i) ? acc.x : 0.f; acc.y = (j + 1 <= i) ? acc.y : 0.f; acc.z = (j + 2 <= i) ? acc.z : 0.f; acc.w = (j + 3 <= i) ? acc.w : 0.f;
              *(LAS unsigned long long*)(AI + (n0 + cc) * GL_LD + mt0 + 4 * g) = pack4(acc); } }
        __syncthreads();
        { const int lane = C.lane, cc = lane & 15, g = lane >> 4, n0 = (C.wave & 3) * 16, eh = C.wave >> 2;
          const bf16* Sg = DS + (size_t)item * 8192;
          f32x4 acc[4]; float ss = 0.f;
#pragma unroll
          for (int mt = 0; mt < 4; ++mt) { const int e0 = eh * 64 + mt * 16; acc[mt] = (f32x4){0.f, 0.f, 0.f, 0.f};
              acc[mt] = mm16_ga(Sg + (size_t)e0 * 64, 64, QP + n0 * GL_LD, GL_LD, 64, acc[mt], lane);
              acc[mt] = mm16(VT + e0 * GL_LD, GL_LD, AI + n0 * GL_LD, GL_LD, 64, acc[mt], lane);
              ss += (acc[mt].x * acc[mt].x + acc[mt].y * acc[mt].y) + (acc[mt].z * acc[mt].z + acc[mt].w * acc[mt].w); }
          ss += __shfl_xor(ss, 16); ss += __shfl_xor(ss, 32);
          if (g == 0) SSQ[eh * 64 + n0 + cc] = ss;
          __syncthreads();
          const float rstd = 1.f / sqrtf((SSQ[n0 + cc] + SSQ[64 + n0 + cc]) * (1.f / 128.f) + 1e-6f);
          const size_t m = m0 + n0 + cc;
#pragma unroll
          for (int mt = 0; mt < 4; ++mt) { const int e = eh * 64 + mt * 16 + 4 * g;
              const unsigned long long gx = *(const unsigned long long*)(pg + (size_t)(n0 + cc) * NPG + 1024 + h * 128 + e);
              const f32x4 ng = *(const f32x4*)(norm_g + e);
              f32x4 o;
              o.x = acc[mt].x * rstd * ng.x * siluf_(bf2f((bf16)(gx & 0xffffu)));
              o.y = acc[mt].y * rstd * ng.y * siluf_(bf2f((bf16)((gx >> 16) & 0xffffu)));
              o.z = acc[mt].z * rstd * ng.z * siluf_(bf2f((bf16)((gx >> 32) & 0xffffu)));
              o.w = acc[mt].w * rstd * ng.w * siluf_(bf2f((bf16)(gx >> 48)));
              *(unsigned long long*)(O + m * D_ + h * 128 + e) = pack4(o); } }
        __syncthreads();
    }
}

struct RwkvW { const float *mu, *mu_vres, *w_up, *w0, *a_up, *a0, *g_up, *v_up, *v0, *k_k; };
__device__ __forceinline__ void ph_rwkv_prep(const Ctx& C, const bf16* PR, const bf16* VL, const RwkvW& W, int layer,
                                             bf16* SAR, bf16* SAK, bf16* SAV, bf16* SAA, bf16* SAG, float* LW, float* INVN, bf16* VF) {
    LAS float* lin = (LAS float*)C.lds;
    const int j = C.tid, lane = C.lane, h = C.wave;
    const int NI = layer ? 288 : 256;
    for (int grp = C.bid; grp < M_ / 8; grp += C.nb) {
        const int m0 = grp * 8;
        __syncthreads();
        for (int idx = j; idx < 8 * NI; idx += NT) {
            const int tk = idx / NI, c = idx % NI, m = m0 + tk, t = m % T_;
            float cur, prev, mu;
            if (c < 256) { cur = bf2f(PR[(size_t)m * NPR + 1536 + c]); prev = t ? bf2f(PR[(size_t)(m - 1) * NPR + 1536 + c]) : 0.f; mu = W.mu[1536 + c]; }
            else { cur = bf2f(VL[(size_t)m * 32 + (c - 256)]); prev = t ? bf2f(VL[(size_t)(m - 1) * 32 + (c - 256)]) : 0.f; mu = W.mu_vres[c - 256]; }
            float p = cur + (prev - cur) * mu;
            if (c < 64) p = tanhf(p); else if (c >= 128 && c < 256) p = sigmoidf_(p);
            lin[c * 8 + tk] = p;
        }
        __syncthreads();
        float aw[8], aa[8], ag[8], av[8];
#pragma unroll
        for (int tk = 0; tk < 8; ++tk) { aw[tk] = 0.f; aa[tk] = 0.f; ag[tk] = 0.f; av[tk] = 0.f; }
        { const float* pw = W.w_up + j; const float* pa = W.a_up + j;
#pragma nounroll
        for (int i = 0; i < 64; ++i) { const float w1 = pw[0], w2 = pa[0]; pw += 512; pa += 512;
#pragma unroll
            for (int q = 0; q < 2; ++q) { const f32x4 x1 = *(const LAS f32x4*)&lin[i * 8 + 4 * q], x2 = *(const LAS f32x4*)&lin[(64 + i) * 8 + 4 * q];
                aw[4 * q] += x1.x * w1; aw[4 * q + 1] += x1.y * w1; aw[4 * q + 2] += x1.z * w1; aw[4 * q + 3] += x1.w * w1;
                aa[4 * q] += x2.x * w2; aa[4 * q + 1] += x2.y * w2; aa[4 * q + 2] += x2.z * w2; aa[4 * q + 3] += x2.w * w2; } } }
        { const float* pg = W.g_up + j;
#pragma nounroll
        for (int i = 0; i < 128; ++i) { const float w3 = pg[0]; pg += 512;
#pragma unroll
            for (int q = 0; q < 2; ++q) { const f32x4 x3 = *(const LAS f32x4*)&lin[(128 + i) * 8 + 4 * q];
                ag[4 * q] += x3.x * w3; ag[4 * q + 1] += x3.y * w3; ag[4 * q + 2] += x3.z * w3; ag[4 * q + 3] += x3.w * w3; } } }
        if (layer) { const float* pv = W.v_up + j;
#pragma nounroll
        for (int i = 0; i < 32; ++i) { const float w4 = pv[0]; pv += 512;
#pragma unroll
            for (int q = 0; q < 2; ++q) { const f32x4 x4 = *(const LAS f32x4*)&lin[(256 + i) * 8 + 4 * q];
                av[4 * q] += x4.x * w4; av[4 * q + 1] += x4.y * w4; av[4 * q + 2] += x4.z * w4; av[4 * q + 3] += x4.w * w4; } } }
        const float mur = W.mu[j], muk = W.mu[512 + j], muv = W.mu[1024 + j], w0 = W.w0[j], a0 = W.a0[j], kkc = W.k_k[j];
        const float v0 = layer ? W.v0[j] : 0.f;
#pragma unroll
        for (int tk = 0; tk < 8; ++tk) {
            const int m = m0 + tk, t = m % T_;
            const bf16* cr = PR + (size_t)m * NPR; const bf16* pr = cr - NPR;
            const float rc = bf2f(cr[j]), kc = bf2f(cr[512 + j]), vc = bf2f(cr[1024 + j]);
            const float rp = t ? bf2f(pr[j]) : 0.f, kp = t ? bf2f(pr[512 + j]) : 0.f, vp = t ? bf2f(pr[1024 + j]) : 0.f;
            const float r = rc + (rp - rc) * mur, k = kc + (kp - kc) * muk; float v = vc + (vp - vc) * muv;
            const float wlog = -softplusf_(-(w0 + aw[tk])) - 0.5f;
            const float lw = -__expf(wlog);
            const float as = sigmoidf_(a0 + aa[tk]);
            const size_t o = (size_t)m * 512 + j;
            if (layer) { const float vf = bf2f(VF[o]); v = v + (vf - v) * sigmoidf_(v0 + av[tk]); } else VF[o] = (bf16)f2bf(v);
            const float kk = k * kkc; const float ss = wave_sum(kk * kk);
            if (lane == 0) INVN[(size_t)m * 8 + h] = 1.f / sqrtf(fmaxf(ss, 1e-24f));
            SAR[o] = (bf16)f2bf(r); SAK[o] = (bf16)f2bf(k); SAV[o] = (bf16)f2bf(v); SAA[o] = (bf16)f2bf(as); SAG[o] = (bf16)f2bf(ag[tk]); LW[o] = lw;
        }
    }
    __syncthreads();
}

__device__ __forceinline__ void ph_rwkv_scan(const Ctx& C, const bf16* SAR, const bf16* SAK, const bf16* SAV, const bf16* SAA,
                                             const float* LW, const float* INVN, const float* k_k, const float* k_a, float* Y) {
    for (int wg = C.bid; wg < 256; wg += C.nb) {
        const int bh = wg >> 3, rb = wg & 7, b = bh >> 3, h = bh & 7, lane = C.lane, row = rb * 8 + C.wave;
        const size_t base = (size_t)b * T_ * 512 + h * 64;
        const float kkc = k_k[h * 64 + lane], kac = k_a[h * 64 + lane];
        float S = 0.f;
        for (int t0 = 0; t0 < T_; t0 += 8) {
            float r[8], k[8], a[8], w[8], v[8], n[8];
#pragma unroll
            for (int i = 0; i < 8; ++i) { const size_t o = base + (size_t)(t0 + i) * 512;
                r[i] = bf2f(SAR[o + lane]); k[i] = bf2f(SAK[o + lane]); a[i] = bf2f(SAA[o + lane]); w[i] = LW[o + lane]; v[i] = bf2f(SAV[o + row]); n[i] = INVN[((size_t)b * T_ + t0 + i) * 8 + h]; }
#pragma unroll
            for (int i = 0; i < 8; ++i) {
                const float kk = k[i] * kkc * n[i], bb = kk * a[i], km = k[i] * (1.f + (a[i] - 1.f) * kac), dec = __expf(w[i]);
                const float sa = -wave_sum(S * kk);
                S = S * dec + sa * bb + v[i] * km;
                const float y = wave_sum(S * r[i]);
                if (lane == 0) Y[base + (size_t)(t0 + i) * 512 + row] = y;
            }
        }
    }
}
__device__ __forceinline__ void ph_rwkv_post(const Ctx& C, const float* Y, const bf16* SAR, const bf16* SAK, const bf16* SAV, const bf16* SAA, const bf16* SAG,
                                             const float* k_a, const float* r_k, const float* gn_g, const float* gn_b, bf16* O) {
    const int gw = C.bid * 8 + C.wave, NGW = C.nb * 8, lane = C.lane;
    for (int it = gw; it < M_ * 8; it += NGW) {
        const int m = it >> 3, h = it & 7, c = h * 64 + lane; const size_t o = (size_t)m * 512 + c;
        const float y = Y[o];
        const float mean = wave_sum(y) * (1.f / 64.f), d = y - mean, var = wave_sum(d * d) * (1.f / 64.f);
        const float yn = d * (1.f / sqrtf(var + 64e-5f)) * gn_g[c] + gn_b[c];
        const float r = bf2f(SAR[o]), k = bf2f(SAK[o]), v = bf2f(SAV[o]), a = bf2f(SAA[o]), g = bf2f(SAG[o]);
        const float km = k * (1.f + (a - 1.f) * k_a[c]);
        const float rk = wave_sum(r * km * r_k[c]);
        O[(size_t)m * D_ + 512 + c] = (bf16)f2bf((yn + rk * v) * g);
    }
}

__device__ __forceinline__ void ph_conv(const Ctx& C, const bf16* U, const float* cw, const float* cb, bf16* ACT) {
    for (size_t idx = (size_t)C.bid * NT + C.tid; idx < (size_t)T_ * DFF; idx += (size_t)C.nb * NT) {
        const int t = (int)(idx / DFF), j = (int)(idx % DFF);
        const bf16* u = U + (size_t)t * NUP;
        float g = cb[j], v = cb[DFF + j];
        g += cw[2 * NUP + j] * bf2f(u[j]); v += cw[2 * NUP + DFF + j] * bf2f(u[DFF + j]);
        if (t >= 1) { g += cw[NUP + j] * bf2f(u[j - NUP]); v += cw[NUP + DFF + j] * bf2f(u[DFF + j - NUP]); }
        if (t >= 2) { g += cw[j] * bf2f(u[j - 2 * NUP]); v += cw[DFF + j] * bf2f(u[DFF + j - 2 * NUP]); }
        ACT[(size_t)t * DFF + j] = (bf16)f2bf(siluf_(g) * v);
    }
}
}

namespace pg8 {
struct EpiRes {
    static constexpr bool PERM = false, AFTER_DRAIN = false;
    const float* base; float* out; const float* gate; int gstride;
    __device__ __forceinline__ void operator()(const f32x4 (&acc)[2][2][4][2], const Unit& u, int wr, int wc, int fr, int fq) const {
        const int b = (u.pm * BM) / 8192; const float* gp = gate + (size_t)b * gstride;
        const int col0 = u.pn * BM + wc * 32 + 4 * fq;
#pragma unroll
        for (int ai = 0; ai < 2; ++ai)
#pragma unroll
            for (int m = 0; m < 4; ++m) { const size_t off = (size_t)(u.pm * BM + ai * HALF + wr * 64 + m * 16 + fr) * 1024 + col0;
#pragma unroll
                for (int bj = 0; bj < 2; ++bj)
#pragma unroll
                    for (int n = 0; n < 2; ++n) { const int cc = bj * HALF + n * 16; const f32x4 gv = *(const f32x4*)(gp + col0 + cc); const f32x4 bs = *(const f32x4*)(base + off + cc);
                        *(f32x4*)(out + off + cc) = bs + gv * acc[ai][bj][m][n]; } }
    }
};
}

namespace hy {
struct Args { const float* in[31]; float* out; unsigned char* ws; };
__global__ void __launch_bounds__(NT, 2) hy_fwd(Args A) {
    extern __shared__ __attribute__((aligned(16))) unsigned char lds_raw[];
    Ctx C; C.bid = blockIdx.x; C.nb = gridDim.x; C.tid = threadIdx.x; C.lane = C.tid & 63; C.wave = __builtin_amdgcn_readfirstlane(C.tid >> 6); C.lds = (LAS unsigned char*)lds_raw;
    volatile LAS unsigned* MISC = (volatile LAS unsigned*)(C.lds + MISC_OFF);
    for (int u = C.tid; u < (LDS_BYTES - MISC_OFF) / 4; u += NT) ((LAS unsigned*)(C.lds + MISC_OFF))[u] = 0u;
    __syncthreads();
    unsigned char* ws = A.ws;
    XcdBarrier bar = xcd_barrier_post((unsigned*)(ws + WS_CTL) + CW_BAR, MISC + 8);
#define PHASE_BEGIN() do { int t_ = threadIdx.x; asm volatile("" : "+v"(t_)); int b_ = blockIdx.x; asm volatile("" : "+s"(b_)); \
    C.tid = t_; C.lane = t_ & 63; C.wave = __builtin_amdgcn_readfirstlane(t_ >> 6); C.bid = b_; } while (0)
#define GRID_BAR() do { xcd_barrier(bar); PHASE_BEGIN(); } while (0)
    float* out = A.out;
#define in A.in
    float* MOD = (float*)(ws + WS_MOD);
    bf16 *WIN = (bf16*)(ws + WS_WIN), *WOUT = (bf16*)(ws + WS_WOUT), *WUP = (bf16*)(ws + WS_WUP), *WDN = (bf16*)(ws + WS_WDN);
    bf16 *XB = (bf16*)(ws + WS_XB), *O = (bf16*)(ws + WS_O), *VF = (bf16*)(ws + WS_VF), *PG = (bf16*)(ws + WS_PG), *PR = (bf16*)(ws + WS_PR), *VL = (bf16*)(ws + WS_VL);
    bf16 *SAR = (bf16*)(ws + WS_SAR), *SAK = (bf16*)(ws + WS_SAK), *SAV = (bf16*)(ws + WS_SAV), *SAA = (bf16*)(ws + WS_SAA), *SAG = (bf16*)(ws + WS_SAG);
    bf16* DS = (bf16*)(ws + WS_GK); float* GAM = (float*)(ws + WS_GAM);
    float *LW = (float*)(ws + WS_LW), *INVN = (float*)(ws + WS_INVN), *Y = (float*)(ws + WS_Y);
    bf16 *ACT = (bf16*)(ws + WS_ACT), *U = (bf16*)(ws + WS_U);

    ph_mod(C, in[1], in[2], in[3], MOD);
    for (int l = 0; l < L_; ++l) {
        const float* modl = MOD + (size_t)l * 4 * 6144;
        const float* xres = l ? out : in[0];
        wprep_mat(C, in[5] + (size_t)l * D_ * IN_COLS, D_, IN_COLS, NIN, WIN, 1, l ? in[6] : nullptr);
        wprep_mat(C, in[24] + (size_t)l * D_ * D_, D_, D_, D_, WOUT, 0, nullptr);
        wprep_mat(C, in[26] + (size_t)l * D_ * NUP, D_, NUP, NUP, WUP, 0, nullptr);
        wprep_mat(C, in[29] + (size_t)l * DFF * D_, DFF, D_, D_, WDN, 0, nullptr);
        GRID_BAR();
        ph_norm(C, xres, in[4] + l * D_, modl + 0 * D_, modl + 1 * D_, XB);
        GRID_BAR();
        { pg8::Gemm g{XB, WIN, M_, NIN, D_}; pg8::StaticOrder S; S.init(M_, NIN, C.nb, C.bid);
          pg8::EpiBf16<0> E{PG, NPG, nullptr, NPG, (WS_PR - WS_PG) / 2, 1.f};
          pg8::gemm_phase<pg8::EpiBf16<0>, pg8::StaticOrder, true, true>(C.lds, g, S, E); }
        GRID_BAR();
        ph_gla_a(C, PG, in[7] + l * 16 * 256, in[8] + l * 256, DS, GAM, VL);
        GRID_BAR();
        ph_gla_b(C, DS, GAM);
        GRID_BAR();
        ph_gla_c(C, PG, in[7] + l * 16 * 256, in[8] + l * 256, in[9] + l * 128, DS, O);
        GRID_BAR();
        { RwkvW W{in[10] + l * 1792, in[11], in[12] + l * 64 * 512, in[13] + l * 512, in[14] + l * 64 * 512, in[15] + l * 512, in[16] + l * 128 * 512, in[17], in[18], in[19] + l * 512};
          ph_rwkv_prep(C, PR, VL, W, l, SAR, SAK, SAV, SAA, SAG, LW, INVN, VF); }
        GRID_BAR();
        ph_rwkv_scan(C, SAR, SAK, SAV, SAA, LW, INVN, in[19] + l * 512, in[20] + l * 512, Y);
        GRID_BAR();
        ph_rwkv_post(C, Y, SAR, SAK, SAV, SAA, SAG, in[20] + l * 512, in[21] + l * 512, in[22] + l * 512, in[23] + l * 512, O);
        GRID_BAR();
        { pg8::Gemm g{O, WOUT, M_, D_, D_}; pg8::StaticOrder S; S.init(M_, D_, C.nb, C.bid);
          pg8::EpiRes E{xres, out, modl + 2 * D_, 6144};
          pg8::gemm_phase<pg8::EpiRes, pg8::StaticOrder, true, true>(C.lds, g, S, E); }
        GRID_BAR();
        ph_norm(C, out, in[25] + l * D_, modl + 3 * D_, modl + 4 * D_, XB);
        GRID_BAR();
        for (int b = 0; b < B_; ++b) {
            { pg8::Gemm g{XB + (size_t)b * T_ * D_, WUP, T_, NUP, D_}; pg8::StaticOrder S; S.init(T_, NUP, C.nb, C.bid);
              pg8::EpiBf16<0> E{U, NUP, nullptr, 0, 0, 1.f};
              pg8::gemm_phase<pg8::EpiBf16<0>, pg8::StaticOrder, true, true>(C.lds, g, S, E); }
            GRID_BAR();
            ph_conv(C, U, in[27] + (size_t)l * 3 * NUP, in[28] + (size_t)l * NUP, ACT + (size_t)b * T_ * DFF);
            GRID_BAR();
        }
        { pg8::Gemm g{ACT, WDN, M_, D_, DFF}; pg8::StaticOrder S; S.init(M_, D_, C.nb, C.bid);
          pg8::EpiRes E{out, out, modl + 5 * D_, 6144};
          pg8::gemm_phase<pg8::EpiRes, pg8::StaticOrder, true, true>(C.lds, g, S, E); }
        GRID_BAR();
    }
    ph_final(C, out, in[30]);
#undef GRID_BAR
#undef PHASE_BEGIN
#undef in
}
}

extern "C" void kernel_launch(void* const* d_in, const int* in_sizes, int n_in, void* d_out, int out_size, void* d_ws, size_t ws_size, hipStream_t stream) {
    using namespace hy;
    static int grid = 0;
    if (grid == 0) {
        if (n_in != 31 || in_sizes[0] != M_ * D_ || out_size != M_ * D_ || ws_size < WS_END) { fprintf(stderr, "kernel_launch: unexpected shapes (n_in %d, in0 %d, out %d, ws %zu)\n", n_in, n_in > 0 ? in_sizes[0] : -1, out_size, ws_size); grid = -1; return; }
        if (hipFuncSetAttribute((const void*)hy_fwd, hipFuncAttributeMaxDynamicSharedMemorySize, LDS_BYTES) != hipSuccess) { fprintf(stderr, "kernel_launch: hipFuncSetAttribute failed\n"); grid = -1; return; }
        int dev = 0, cus = 0, per_cu = 0;
        (void)hipGetDevice(&dev); (void)hipDeviceGetAttribute(&cus, hipDeviceAttributeMultiprocessorCount, dev);
        (void)hipOccupancyMaxActiveBlocksPerMultiprocessor(&per_cu, (const void*)hy_fwd, NT, LDS_BYTES);
        if (per_cu < 1) fprintf(stderr, "kernel_launch: occupancy query reports %d blocks per CU\n", per_cu);
        (void)hipGetLastError();
        grid = cus > 0 ? cus : 256;
    }
    if (grid < 0) return;
    (void)hipMemsetAsync((char*)d_ws + WS_CTL, 0, CTL_ZERO_BYTES, stream);
    Args a{};
    for (int i = 0; i < 31; ++i) a.in[i] = (const float*)d_in[i];
    a.out = (float*)d_out; a.ws = (unsigned char*)d_ws;
    hipLaunchKernelGGL(hy_fwd, dim3(grid), dim3(NT), LDS_BYTES, stream, a);
}
```

```cpp
#include <hip/hip_runtime.h>
#include <cstdio>
#include <cstdint>
namespace pg8 {
#define PG8_LAS __attribute__((address_space(3)))
typedef unsigned short bf16_t;
typedef short bf16x8 __attribute__((ext_vector_type(8)));
typedef float f32x4 __attribute__((ext_vector_type(4)));
typedef unsigned u32x4 __attribute__((ext_vector_type(4)));
constexpr int BM = 256, BK = 64, HALF = 128, HTB = HALF * BK * 2  , STAGE_BYTES = 8 * HTB, NXCD = 8, WGM = 8;

__host__ __device__ __forceinline__ int lds_byte(int r, int c) { const int st = (r >> 4) * 2 + (c >> 5), rr = r & 15, cc = c & 31, ob = rr * 64 + cc * 2; return st * 1024 + (ob ^ (((ob >> 9) & 1) << 5)); }
__host__ __device__ __forceinline__ void stage_rc(int b, int& R, int& C) { const int st = b / 1024, sb = b % 1024, swz = sb ^ (((sb >> 9) & 1) << 5); R = (st >> 1) * 16 + swz / 64; C = (st & 1) * 32 + (swz % 64) / 2; }
__host__ __device__ __forceinline__ int perm32(int rho) { const int n = rho >> 4, i = rho & 15; return 8 * (i >> 2) + 4 * n + (i & 3); }

struct Unit { int pm, pn; };
struct Gemm { const bf16_t* A; const bf16_t* Bt; int M, N, K; };

struct StaticOrder {
    int nM, nN, nwg, G, c;
    __host__ __device__ void init(int M, int N, int G_, int c_) { nM = M / BM; nN = N / BM; nwg = nM * nN; G = G_; c = c_; }
    __host__ __device__ bool next(int i, Unit& u) const {
        const long L = (long)i * G + c; if (L >= nwg) return false;
        int wgid = (int)L; { const int q = nwg / NXCD, r = nwg % NXCD, xcd = wgid % NXCD, off = wgid / NXCD; wgid = (xcd < r ? xcd * (q + 1) : r * (q + 1) + (xcd - r) * q) + off; }
        const int nig = WGM * nN, gid = wgid / nig, fm = gid * WGM, gsz = (nM - fm) < WGM ? (nM - fm) : WGM;
        u.pm = fm + ((wgid % nig) % gsz); u.pn = (wgid % nig) / gsz; return true;
    }
    __device__ __forceinline__ void a_ready(const Unit&) const {}
    __device__ __forceinline__ void done(const Unit&) const {}
};

__device__ __forceinline__ unsigned cvt_pk_bf16(float lo, float hi) { unsigned r; asm volatile("v_cvt_pk_bf16_f32 %0, %1, %2" : "=v"(r) : "v"(lo), "v"(hi)); return r; }
typedef float f32x2 __attribute__((ext_vector_type(2)));
__device__ __forceinline__ f32x2 gelu_pk(f32x2 v) {
    const f32x2 av = __builtin_elementwise_abs(v), d = av * 0.2316418882f + 1.0f;
    f32x2 t; t.x = __builtin_amdgcn_rcpf(d.x); t.y = __builtin_amdgcn_rcpf(d.y);
    f32x2 q = t * 0.5307027145f + (-0.7265760135f); q = q * t + 0.7107068705f; q = q * t + (-0.142248368f); q = q * t + 0.127414796f; q = q * t;
    const f32x2 s = (v * v) * (-0.72134752044f);
    f32x2 e; e.x = __builtin_amdgcn_exp2f(s.x); e.y = __builtin_amdgcn_exp2f(s.y);
    const f32x2 m = v * (q * e), r = v - m;
    f32x2 o; o.x = v.x < 0.f ? m.x : r.x; o.y = v.y < 0.f ? m.y : r.y; return o;
}

template <int ACT  > struct EpiBf16 {
    static constexpr bool PERM = true, AFTER_DRAIN = false; static_assert(ACT == 0 || ACT == 1, "EpiBf16: ACT is 0 (none) or 1 (gelu_pk)");
    bf16_t* O; int ldc; const float* bias; int split_cols; size_t split_stride; float scale0;
    __device__ __forceinline__ void operator()(const f32x4 (&acc)[2][2][4][2], const Unit& u, int wr, int wc, int fr, int fq) const {
        const int row0 = u.pm * BM + wr * 64 + fr; int colt = u.pn * BM; bf16_t* base = O;
        float sc = 1.f; if (split_cols) { const int t = colt / split_cols; base += (size_t)t * split_stride; colt -= t * split_cols; if (t == 0) sc = scale0; }
        const int col0 = colt + wc * 32 + 8 * fq, bcol0 = u.pn * BM + wc * 32 + 8 * fq;
        f32x4 bv[2][2];
#pragma unroll
        for (int bj = 0; bj < 2; ++bj)
#pragma unroll
            for (int n = 0; n < 2; ++n) bv[bj][n] = bias ? *(const f32x4*)(bias + bcol0 + bj * HALF + 4 * n) : (f32x4){0.f, 0.f, 0.f, 0.f};
#pragma unroll
        for (int ai = 0; ai < 2; ++ai)
#pragma unroll
            for (int m = 0; m < 4; ++m) { bf16_t* rowp = base + (size_t)(row0 + ai * HALF + m * 16) * ldc + col0;
#pragma unroll
                for (int bj = 0; bj < 2; ++bj) { f32x4 v0 = acc[ai][bj][m][0] + bv[bj][0], v1 = acc[ai][bj][m][1] + bv[bj][1];
                    if (ACT == 1) { f32x2 a = gelu_pk((f32x2){v0[0], v0[1]}), b = gelu_pk((f32x2){v0[2], v0[3]}), c = gelu_pk((f32x2){v1[0], v1[1]}), d = gelu_pk((f32x2){v1[2], v1[3]});
                        v0 = (f32x4){a.x, a.y, b.x, b.y}; v1 = (f32x4){c.x, c.y, d.x, d.y}; }
                    v0 = v0 * sc; v1 = v1 * sc; u32x4 w; w.x = cvt_pk_bf16(v0[0], v0[1]); w.y = cvt_pk_bf16(v0[2], v0[3]); w.z = cvt_pk_bf16(v1[0], v1[1]); w.w = cvt_pk_bf16(v1[2], v1[3]);
                    *(u32x4*)(rowp + bj * HALF) = w; } }
    }
};
template <class Epi, class Sched, bool ALIGN_EPI = false, bool SP2 = false>
__device__ __forceinline__ void gemm_phase(PG8_LAS unsigned char* lds, const Gemm g, const Sched& S, const Epi& E) {
    int tid_ = threadIdx.x; asm volatile("" : "+v"(tid_));
    const int tid = tid_, wid = __builtin_amdgcn_readfirstlane(tid >> 6), lane = tid & 63, wr = wid >> 2, wc = wid & 3, fr = lane & 15, fq = lane >> 4;
    const int K = g.K, nt = K / BK;
    unsigned voffA[2], voffB[2];
#pragma unroll
    for (int i = 0; i < 2; ++i) { int R, C; stage_rc(tid * 16 + i * 8192, R, C); const int Rb = Epi::PERM ? ((R & ~31) + perm32(R & 31)) : R;
        voffA[i] = (unsigned)(R * K + C) * 2u; voffB[i] = (unsigned)(Rb * K + C) * 2u; }
    const size_t kstep = (size_t)(BK * 2);
    const size_t hstep = (size_t)HALF * K * 2;
    const size_t tstep = 2 * hstep;
    const unsigned ldsw = (unsigned)wid * 1024u;
    const int aoff = lds_byte(wr * 64 + fr, fq * 8), boff = lds_byte(wc * 32 + fr, fq * 8);
#define PG8_SA(b, h) (((b) * 2 + (h)) * HTB)
#define PG8_SB(b, h) ((4 + (b) * 2 + (h)) * HTB)
#define PG8_STAGE(bufoff, gbase, voff) do { _Pragma("unroll") for (int _i = 0; _i < 2; ++_i) \
        __builtin_amdgcn_global_load_lds((const unsigned*)((const char*)(gbase) + (voff)[_i]), (PG8_LAS unsigned*)(lds + (bufoff) + ldsw + _i * 8192), 16, 0, 0); } while (0)
#define PG8_LDA(dst, b, h) do { _Pragma("unroll") for (int m = 0; m < 4; ++m) _Pragma("unroll") for (int k = 0; k < 2; ++k) dst[m][k] = *(const PG8_LAS bf16x8*)(lds + PG8_SA(b, h) + aoff + m * 2048 + k * 1024); } while (0)
#define PG8_LDB(dst, b, h) do { _Pragma("unroll") for (int n = 0; n < 2; ++n) _Pragma("unroll") for (int k = 0; k < 2; ++k) dst[n][k] = *(const PG8_LAS bf16x8*)(lds + PG8_SB(b, h) + boff + n * 2048 + k * 1024); } while (0)
#define PG8_MMA(ai, bj, At, Bt) do { __builtin_amdgcn_s_setprio(1); _Pragma("unroll") for (int m = 0; m < 4; ++m) _Pragma("unroll") for (int n = 0; n < 2; ++n) _Pragma("unroll") for (int k = 0; k < 2; ++k) \
        acc[ai][bj][m][n] = __builtin_amdgcn_mfma_f32_16x16x32_bf16(Bt[n][k], At[m][k], acc[ai][bj][m][n], 0, 0, 0); __builtin_amdgcn_s_setprio(0); } while (0)
#define PG8_WAIT_V(n) asm volatile("s_waitcnt vmcnt(" #n ")" ::: "memory")
#define PG8_WAIT_L(n) asm volatile("s_waitcnt lgkmcnt(" #n ")" ::: "memory")
#define PG8_BAR __builtin_amdgcn_s_barrier()
#define PG8_SCHED __builtin_amdgcn_sched_barrier(0)
    Unit cur, nxt; int ui = 0;
    if (!S.next(0, cur)) return;
    f32x4 acc[2][2][4][2];
#pragma unroll
    for (int a = 0; a < 2; ++a)
#pragma unroll
        for (int b = 0; b < 2; ++b)
#pragma unroll
            for (int m = 0; m < 4; ++m)
#pragma unroll
                for (int n = 0; n < 2; ++n) acc[a][b][m][n] = (f32x4){0.f, 0.f, 0.f, 0.f};
    bf16x8 At[4][2], B0[2][2], B1[2][2];
    const char* cA = (const char*)g.A + (size_t)cur.pm * tstep; const char* cB = (const char*)g.Bt + (size_t)cur.pn * tstep;
    S.a_ready(cur);
    if constexpr (SP2) {
        PG8_STAGE(PG8_SB(0, 0), cB, voffB); PG8_STAGE(PG8_SB(0, 1), cB + hstep, voffB); PG8_STAGE(PG8_SA(0, 0), cA, voffA); PG8_STAGE(PG8_SA(0, 1), cA + hstep, voffA);
        if (wr == 1) PG8_BAR;
        PG8_WAIT_V(2); PG8_BAR;
        PG8_STAGE(PG8_SB(1, 0), cB + kstep, voffB); PG8_STAGE(PG8_SA(1, 0), cA + kstep, voffA); PG8_STAGE(PG8_SB(1, 1), cB + hstep + kstep, voffB);
        PG8_WAIT_V(6); PG8_BAR;
    } else {
        PG8_STAGE(PG8_SB(0, 0), cB, voffB); PG8_STAGE(PG8_SA(0, 0), cA, voffA); PG8_STAGE(PG8_SB(0, 1), cB + hstep, voffB); PG8_STAGE(PG8_SA(0, 1), cA + hstep, voffA);
        if (wr == 1) PG8_BAR;
        PG8_WAIT_V(4); PG8_BAR;
        PG8_STAGE(PG8_SB(1, 0), cB + kstep, voffB); PG8_STAGE(PG8_SA(1, 0), cA + kstep, voffA); PG8_STAGE(PG8_SB(1, 1), cB + hstep + kstep, voffB);
        PG8_WAIT_V(6); PG8_BAR;
    }
    for (;;) {
        const bool has_next = S.next(ui + 1, nxt);
        const char* nA = has_next ? (const char*)g.A + (size_t)nxt.pm * tstep : cA; const char* nB = has_next ? (const char*)g.Bt + (size_t)nxt.pn * tstep : cB;
        for (int t = 0; t < nt; t += 2) {
            const bool last = (t == nt - 2);
            const char* a1 = cA + (size_t)(t + 1) * kstep;
            const char* a2 = last ? nA : cA + (size_t)(t + 2) * kstep; const char* b2 = last ? nB : cB + (size_t)(t + 2) * kstep;
            const char* a3 = a2 + kstep; const char* b3 = b2 + kstep;
            if (last && has_next) S.a_ready(nxt);
            if constexpr (SP2) {
            PG8_LDB(B0, 0, 0); PG8_LDB(B1, 0, 1); PG8_SCHED; PG8_LDA(At, 0, 0); PG8_STAGE(PG8_SA(1, 1), a1 + hstep, voffA);
            PG8_WAIT_V(8); PG8_WAIT_L(0); PG8_BAR; PG8_MMA(0, 0, At, B0); PG8_MMA(0, 1, At, B1); PG8_BAR; PG8_SCHED;
            PG8_LDA(At, 0, 1); PG8_STAGE(PG8_SB(0, 0), b2, voffB); PG8_STAGE(PG8_SB(0, 1), b2 + hstep, voffB); PG8_STAGE(PG8_SA(0, 0), a2, voffA);
            PG8_WAIT_V(8); PG8_WAIT_L(0); PG8_BAR; PG8_MMA(1, 0, At, B0); PG8_MMA(1, 1, At, B1); PG8_BAR; PG8_SCHED;
            PG8_LDB(B0, 1, 0); PG8_LDB(B1, 1, 1); PG8_SCHED; PG8_LDA(At, 1, 0); PG8_STAGE(PG8_SA(0, 1), a2 + hstep, voffA);
            PG8_WAIT_V(8); PG8_WAIT_L(0); PG8_BAR; PG8_MMA(0, 0, At, B0); PG8_MMA(0, 1, At, B1); PG8_BAR; PG8_SCHED;
            PG8_LDA(At, 1, 1); PG8_STAGE(PG8_SB(1, 0), b3, voffB); PG8_STAGE(PG8_SB(1, 1), b3 + hstep, voffB); PG8_STAGE(PG8_SA(1, 0), a3, voffA);
            PG8_WAIT_V(8); PG8_WAIT_L(0); PG8_BAR; PG8_MMA(1, 0, At, B0); PG8_MMA(1, 1, At, B1); PG8_BAR; PG8_SCHED;
            } else {
            PG8_LDB(B0, 0, 0); PG8_SCHED; PG8_LDA(At, 0, 0); PG8_STAGE(PG8_SA(1, 1), a1 + hstep, voffA);
            PG8_WAIT_L(8); PG8_BAR; PG8_WAIT_L(0); PG8_MMA(0, 0, At, B0); PG8_BAR; PG8_SCHED;
            PG8_LDB(B1, 0, 1); PG8_STAGE(PG8_SB(0, 0), b2, voffB);
            PG8_BAR; PG8_WAIT_L(0); PG8_MMA(0, 1, At, B1); PG8_BAR;
            PG8_LDA(At, 0, 1); PG8_STAGE(PG8_SA(0, 0), a2, voffA);
            PG8_BAR; PG8_WAIT_L(0); PG8_MMA(1, 0, At, B0); PG8_BAR; PG8_SCHED;
            PG8_STAGE(PG8_SB(0, 1), b2 + hstep, voffB);
            PG8_WAIT_V(6); PG8_BAR; PG8_MMA(1, 1, At, B1); PG8_BAR;
            PG8_LDB(B0, 1, 0); PG8_SCHED; PG8_LDA(At, 1, 0); PG8_STAGE(PG8_SA(0, 1), a2 + hstep, voffA);
            PG8_WAIT_L(8); PG8_BAR; PG8_WAIT_L(0); PG8_MMA(0, 0, At, B0); PG8_BAR; PG8_SCHED;
            PG8_LDB(B1, 1, 1); PG8_STAGE(PG8_SB(1, 0), b3, voffB);
            PG8_BAR; PG8_WAIT_L(0); PG8_MMA(0, 1, At, B1); PG8_BAR;
            PG8_LDA(At, 1, 1); PG8_STAGE(PG8_SA(1, 0), a3, voffA);
            PG8_BAR; PG8_WAIT_L(0); PG8_MMA(1, 0, At, B0); PG8_BAR; PG8_SCHED;
            PG8_STAGE(PG8_SB(1, 1), b3 + hstep, voffB);
            PG8_WAIT_V(6); PG8_BAR; PG8_MMA(1, 1, At, B1); PG8_BAR;
            }
        }
        if constexpr (ALIGN_EPI) { if (wr == 0) PG8_BAR; }
        if constexpr (!Epi::AFTER_DRAIN) { E(acc, cur, wr, wc, fr, fq); S.done(cur); }
        if (!has_next) break;
#pragma unroll
        for (int a = 0; a < 2; ++a)
#pragma unroll
            for (int b = 0; b < 2; ++b)
#pragma unroll
                for (int m = 0; m < 4; ++m)
#pragma unroll
                    for (int n = 0; n < 2; ++n) acc[a][b][m][n] = (f32x4){0.f, 0.f, 0.f, 0.f};
        cur = nxt; cA = nA; cB = nB; ++ui;
        if constexpr (ALIGN_EPI) { if (wr == 1) PG8_BAR; }
    }
    PG8_WAIT_V(0);
    if constexpr (!ALIGN_EPI) { if (wr == 0) PG8_BAR; }
    PG8_BAR;
    if constexpr (Epi::AFTER_DRAIN) { E.fused(acc, cur, wr, wc, fr, fq, lds, wid, lane); S.done(cur); }
#undef PG8_SA
#undef PG8_SB
#undef PG8_STAGE
#undef PG8_LDA
#undef PG8_LDB
#undef PG8_MMA
#undef PG8_WAIT_V
#undef PG8_WAIT_L
#undef PG8_BAR
#undef PG8_SCHED
}
}

namespace hy {
#define GAS __attribute__((address_space(1)))
#define LAS __attribute__((address_space(3)))
typedef unsigned short bf16;
typedef unsigned v4u __attribute__((ext_vector_type(4)));
typedef float f32x4 __attribute__((ext_vector_type(4)));
typedef short bf16x8 __attribute__((ext_vector_type(8)));
typedef GAS unsigned gu32;
typedef GAS unsigned long long gu64;
#define RLX_AGENT __ATOMIC_RELAXED, __HIP_MEMORY_SCOPE_AGENT
#define LDS_WAIT() asm volatile("s_waitcnt lgkmcnt(0)" ::: "memory")
#define VM_WAIT() asm volatile("s_waitcnt vmcnt(0)" ::: "memory")
__device__ __forceinline__ unsigned long long rt() { return __builtin_amdgcn_s_memrealtime(); }
__device__ __forceinline__ unsigned f2bf(float f) { unsigned u = __builtin_bit_cast(unsigned, f); return (u + 0x7fffu + ((u >> 16) & 1u)) >> 16; }
__device__ __forceinline__ unsigned pk2(float lo, float hi) { return f2bf(lo) | (f2bf(hi) << 16); }
#define XB_TMO      128
#define XB_XCNT(j)  (256  + 64 * (j))
#define XB_XSUB(j)  (1280 + 64 * (j))
#define XB_XGEN(j)  (2304 + 64 * (j))
#define XB_TOP      3328
#define XB_TOPGEN   3392
#define XCD_BAR_WORDS 3456
#define XB_SPIN_CAP (1u << 18)

__device__ __forceinline__ unsigned xb_ld(unsigned* p)              { return __hip_atomic_load(p, __ATOMIC_RELAXED, __HIP_MEMORY_SCOPE_AGENT); }
__device__ __forceinline__ unsigned xb_add(unsigned* p, unsigned v) { return __hip_atomic_fetch_add(p, v, __ATOMIC_RELAXED, __HIP_MEMORY_SCOPE_AGENT); }
__device__ __forceinline__ unsigned xb_xcc_id() { return (unsigned)__builtin_amdgcn_s_getreg((3 << 11) | 20) & 0xFu; }
#define XB_SPIN(cond, bar) do { unsigned _sp = 0; while (cond) { __builtin_amdgcn_s_sleep(1); \
    if ((++_sp & 255u) == 0u) { if (xb_ld(&(bar)[XB_TMO])) break; if (_sp > XB_SPIN_CAP) { atomicAdd(&(bar)[XB_TMO], 1u); break; } } } } while (0)

struct XcdBarrier {
    unsigned* bar; unsigned x;
    volatile LAS unsigned* st;
};

__device__ __forceinline__ XcdBarrier xcd_barrier_post(unsigned* bar, volatile LAS unsigned* st) {
    XcdBarrier b; b.bar = bar; b.x = xb_xcc_id(); b.st = st;
    if (threadIdx.x == 0) (void)xb_add(&bar[XB_XCNT(b.x)], 1u);
    return b;
}
__device__ __forceinline__ void xcd_barrier_complete(unsigned* bar, unsigned x, unsigned& nloc, unsigned& nx) {
    const unsigned G = gridDim.x * gridDim.y * gridDim.z;
    unsigned sum, cnt, mine, sp = 0u;
    for (;;) {
        sum = 0u; cnt = 0u; mine = 0u;
#pragma unroll
        for (unsigned j = 0; j < 16; ++j) { const unsigned c = xb_ld(&bar[XB_XCNT(j)]); sum += c; cnt += (c > 0u) ? 1u : 0u; mine = (j == x) ? c : mine; }
        if (sum == G) break;
        __builtin_amdgcn_s_sleep(1);
        if ((++sp & 255u) == 0u) { if (xb_ld(&bar[XB_TMO])) break; if (sp > XB_SPIN_CAP) { atomicAdd(&bar[XB_TMO], 1u); break; } }
    }
    nloc = mine > 0u ? mine : 1u; nx = cnt > 0u ? cnt : 1u;
}

__device__ __forceinline__ void xcd_barrier(const XcdBarrier& b) {
    asm volatile("s_waitcnt vmcnt(0)" ::: "memory");
    __syncthreads();
    if (threadIdx.x == 0) {
        unsigned* bar = b.bar;
        __builtin_amdgcn_s_waitcnt(0);
        unsigned nloc = b.st[0], nx = b.st[1];
        if (nloc == 0u) { xcd_barrier_complete(bar, b.x, nloc, nx); b.st[0] = nloc; b.st[1] = nx; }
        const unsigned old = xb_add(&bar[XB_XSUB(b.x)], 1u);
        const unsigned gen = old / nloc;
        if (old + 1u == (gen + 1u) * nloc) {
            __builtin_amdgcn_fence(__ATOMIC_RELEASE, "agent");
            asm volatile("s_waitcnt vmcnt(0)" ::: "memory");
            const unsigned og = xb_add(&bar[XB_TOP], 1u);
            const unsigned tg = og / nx;
            if (og + 1u == (tg + 1u) * nx) xb_add(&bar[XB_TOPGEN], 1u);
            else XB_SPIN(xb_ld(&bar[XB_TOPGEN]) == tg, bar);
            __builtin_amdgcn_fence(__ATOMIC_ACQUIRE, "agent");
            xb_add(&bar[XB_XGEN(b.x)], 1u);
            asm volatile("s_waitcnt vmcnt(0)" ::: "memory");
        } else {
            XB_SPIN(xb_ld(&bar[XB_XGEN(b.x)]) == gen, bar);
            __builtin_amdgcn_fence(__ATOMIC_ACQUIRE, "agent");
            asm volatile("s_waitcnt vmcnt(0)" ::: "memory");
        }
    }
    __syncthreads();
}

constexpr int B_ = 4, T_ = 8192, D_ = 1024, M_ = B_ * T_, L_ = 2;
constexpr int NIN = 3584, NPG = 1792, NPR = 1792;
constexpr int DFF = 2816, NUP = 5632, IN_COLS = 3344;
constexpr size_t MiB = 1u << 20;
constexpr size_t WS_CTL = 0, CTL_ZERO_BYTES = 65536;
constexpr int CW_BAR = 4096;
constexpr size_t WS_RK = MiB / 4;
constexpr size_t WS_MOD = 3 * MiB / 2;
constexpr size_t WS_WIN = 2 * MiB, WS_WOUT = 9 * MiB, WS_WUP = 11 * MiB, WS_WDN = 22 * MiB, WS_LORA = 55 * MiB / 2, WS_GAMC = 28 * MiB, WS_VL = 29 * MiB;
constexpr size_t WS_GAM = 31 * MiB;
constexpr size_t WS_XB = 32 * MiB, WS_O = 96 * MiB, WS_VF = 160 * MiB, WS_GK = 192 * MiB, WS_PG = 224 * MiB, WS_PR = 336 * MiB, WS_END = 512 * MiB;
constexpr size_t WS_RH = WS_XB, WS_YH = WS_XB + 32 * MiB, WS_PP = WS_O, WS_QQ = WS_O + 32 * MiB, WS_GG = 448 * MiB, WS_S0 = 480 * MiB;
constexpr size_t WS_ACT = 224 * MiB, WS_U = 400 * MiB;
constexpr int RING_BYTES = 131072, MISC_OFF = 139264, LDS_BYTES = 147456;
constexpr int NT = 512;

__device__ __forceinline__ float bf2f(bf16 h) { return __builtin_bit_cast(float, (unsigned)h << 16); }
__device__ __forceinline__ float sigmoidf_(float x) { return 1.f / (1.f + __expf(-x)); }
__device__ __forceinline__ float siluf_(float x) { return x / (1.f + __expf(-x)); }
__device__ __forceinline__ float softplusf_(float x) { return fmaxf(x, 0.f) + log1pf(__expf(-fabsf(x))); }

typedef unsigned u32x2 __attribute__((ext_vector_type(2)));
template <int CTRL> __device__ __forceinline__ float dpp_f(float v) {
    return __builtin_bit_cast(float, __builtin_amdgcn_update_dpp(0, __builtin_bit_cast(int, v), CTRL, 0xf, 0xf, false));
}
__device__ __forceinline__ float wave_sum(float v) {
    v += dpp_f<0xB1>(v);
    v += dpp_f<0x4E>(v);
    v += dpp_f<0x141>(v);
    v += dpp_f<0x140>(v);
    v += __builtin_bit_cast(float, __builtin_amdgcn_update_dpp(0, __builtin_bit_cast(int, v), 0x142, 0xa, 0xf, false));
    v += __builtin_bit_cast(float, __builtin_amdgcn_update_dpp(0, __builtin_bit_cast(int, v), 0x143, 0xc, 0xf, false));
    return __builtin_bit_cast(float, __builtin_amdgcn_readlane(__builtin_bit_cast(int, v), 63));
}

struct Ctx { int bid, nb, tid, lane, wave; LAS unsigned char* lds; };

__device__ __forceinline__ void ph_mod(const Ctx& C, const float* c, const float* ada_w, const float* ada_b, float* MOD) {
    LAS float* sc = (LAS float*)C.lds;
    LAS float* red = (LAS float*)(C.lds + 16384);
    for (int i = C.tid; i < 4096; i += NT) sc[i] = siluf_(c[i]);
    __syncthreads();
    for (int item = C.bid; item < 192; item += C.nb) {
        const int l = item / 96, j0 = (item % 96) * 64;
        const float* W = ada_w + (size_t)l * 1024 * 6144 + j0 + C.lane;
        float a0 = 0.f, a1 = 0.f, a2 = 0.f, a3 = 0.f;
        for (int k = C.wave * 128; k < C.wave * 128 + 128; ++k) { const float wv = W[(size_t)k * 6144]; a0 += sc[k] * wv; a1 += sc[1024 + k] * wv; a2 += sc[2048 + k] * wv; a3 += sc[3072 + k] * wv; }
        red[(C.wave * 4 + 0) * 64 + C.lane] = a0; red[(C.wave * 4 + 1) * 64 + C.lane] = a1; red[(C.wave * 4 + 2) * 64 + C.lane] = a2; red[(C.wave * 4 + 3) * 64 + C.lane] = a3;
        __syncthreads();
        if (C.wave < 4) { const int b = C.wave; float s = ada_b[l * 6144 + j0 + C.lane];
#pragma unroll
            for (int w = 0; w < 8; ++w) s += red[(w * 4 + b) * 64 + C.lane];
            MOD[((size_t)l * 4 + b) * 6144 + j0 + C.lane] = s; }
        __syncthreads();
    }
}

__device__ __forceinline__ void wprep_mat(const Ctx& C, const float* W, int K, int Nsrc, int Ndst, bf16* Wt, int mode, const float* vres) {
    const int half = C.tid >> 8, t = C.tid & 255, tx = t & 31, ty = t >> 5;
    LAS float* tile = (LAS float*)C.lds + half * (32 * 33);
    const int nbn = Ndst / 32, ntile = nbn * (K / 32);
    const int niter = (ntile + 2 * C.nb - 1) / (2 * C.nb);
    for (int it = 0; it < niter; ++it) {
        const int item = (it * C.nb + C.bid) * 2 + half;
        const bool act = item < ntile;
        const int n0 = (item % nbn) * 32, k0 = (item / nbn) * 32, n = n0 + tx;
        if (act) {
#pragma unroll
            for (int i = 0; i < 4; ++i) { const int k = k0 + ty + 8 * i; float v = 0.f;
                if (mode == 0) v = W[(size_t)k * Nsrc + n];
                else { if (n < 1552) v = W[(size_t)k * Nsrc + n]; else if (n < 1584) v = vres ? vres[(size_t)k * 32 + (n - 1552)] : 0.f; else if (n < 1792) v = 0.f; else v = W[(size_t)k * Nsrc + (n - 240)]; }
                tile[(ty + 8 * i) * 33 + tx] = v; }
        }
        __syncthreads();
        if (act) {
#pragma unroll
            for (int i = 0; i < 4; ++i) { const int nn = n0 + ty + 8 * i; Wt[(size_t)nn * K + k0 + tx] = (bf16)f2bf(tile[tx * 33 + ty + 8 * i]); }
        }
        __syncthreads();
    }
}

__device__ __forceinline__ void ph_norm(const Ctx& C, const float* x, const float* g, const float* sh, const float* sc, bf16* XB) {
    const int gw = C.bid * 8 + C.wave, NGW = C.nb * 8, lane = C.lane;
    for (int m = gw; m < M_; m += NGW) {
        const int b = m / T_;
        const f32x4* xr = (const f32x4*)(x + (size_t)m * D_) + lane;
        f32x4 v[4]; float s = 0.f;
#pragma unroll
        for (int j = 0; j < 4; ++j) { v[j] = xr[64 * j]; s += (v[j].x * v[j].x + v[j].y * v[j].y) + (v[j].z * v[j].z + v[j].w * v[j].w); }
        const float rstd = 1.f / sqrtf(wave_sum(s) * (1.f / D_) + 1e-6f);
        unsigned long long* o8 = (unsigned long long*)(XB + (size_t)m * D_) + lane;
#pragma unroll
        for (int j = 0; j < 4; ++j) { const int col = 4 * lane + 256 * j;
            const f32x4 gv = *(const f32x4*)(g + col), shv = *(const f32x4*)(sh + b * 6144 + col), scv = *(const f32x4*)(sc + b * 6144 + col);
            const f32x4 h = v[j] * rstd * gv * (scv + 1.f) + shv;
            o8[64 * j] = (unsigned long long)(f2bf(h.x) | (f2bf(h.y) << 16)) | ((unsigned long long)(f2bf(h.z) | (f2bf(h.w) << 16)) << 32); }
    }
}
__device__ __forceinline__ void ph_final(const Ctx& C, float* x, const float* g) {
    const int gw = C.bid * 8 + C.wave, NGW = C.nb * 8, lane = C.lane;
    for (int m = gw; m < M_; m += NGW) {
        f32x4* xr = (f32x4*)(x + (size_t)m * D_) + lane;
        f32x4 v[4]; float s = 0.f;
#pragma unroll
        for (int j = 0; j < 4; ++j) { v[j] = xr[64 * j]; s += (v[j].x * v[j].x + v[j].y * v[j].y) + (v[j].z * v[j].z + v[j].w * v[j].w); }
        const float rstd = 1.f / sqrtf(wave_sum(s) * (1.f / D_) + 1e-6f);
#pragma unroll
        for (int j = 0; j < 4; ++j) { const f32x4 gv = *(const f32x4*)(g + 4 * lane + 256 * j); xr[64 * j] = v[j] * rstd * gv; }
    }
}


typedef short s16x8 __attribute__((ext_vector_type(8)));
__device__ __forceinline__ f32x4 mm16(const LAS bf16* A, int lda, const LAS bf16* B, int ldb, int K, f32x4 acc, int lane) {
    const int r = lane & 15, g = lane >> 4;
    const LAS bf16* ap = A + r * lda + 8 * g; const LAS bf16* bp = B + r * ldb + 8 * g;
    for (int k0 = 0; k0 < K; k0 += 32) { const s16x8 a = *(const LAS s16x8*)(ap + k0); const s16x8 b = *(const LAS s16x8*)(bp + k0); acc = __builtin_amdgcn_mfma_f32_16x16x32_bf16(a, b, acc, 0, 0, 0); }
    return acc;
}
__device__ __forceinline__ f32x4 mm16_ga(const bf16* A, int lda, const LAS bf16* B, int ldb, int K, f32x4 acc, int lane) {
    const int r = lane & 15, g = lane >> 4;
    const bf16* ap = A + r * lda + 8 * g; const LAS bf16* bp = B + r * ldb + 8 * g;
    for (int k0 = 0; k0 < K; k0 += 32) { const s16x8 a = *(const s16x8*)(ap + k0); const s16x8 b = *(const LAS s16x8*)(bp + k0); acc = __builtin_amdgcn_mfma_f32_16x16x32_bf16(a, b, acc, 0, 0, 0); }
    return acc;
}
__device__ __forceinline__ unsigned long long pack4(f32x4 v) { return (unsigned long long)(f2bf(v.x) | (f2bf(v.y) << 16)) | ((unsigned long long)(f2bf(v.z) | (f2bf(v.w) << 16)) << 32); }
__device__ __forceinline__ float logsigmoidf_(float x) { return fminf(x, 0.f) - log1pf(__expf(-fabsf(x))); }

constexpr int GL_LD = 72;
constexpr int GL_GK = 0;
constexpr int GL_SEG = 16384;
constexpr int GL_Z = 18432;
constexpr int GL_GUP = 20480;
constexpr int GL_I0 = 24832;
constexpr int GL_I1 = GL_I0 + 9216;
constexpr int GL_I2 = GL_I1 + 9216;
constexpr int GL_VT = GL_I2 + 9216;
constexpr int GL_SSQ = GL_VT + 18432;
static_assert(GL_SSQ + 512 <= RING_BYTES, "GLA LDS map");

__device__ __forceinline__ void gla_gates(const Ctx& C, const bf16* pg  , const float* gk_up, const float* gk_b, int h) {
    LAS float* GK = (LAS float*)(C.lds + GL_GK); LAS float* SEG = (LAS float*)(C.lds + GL_SEG); LAS bf16* Z = (LAS bf16*)(C.lds + GL_Z); LAS float* GUP = (LAS float*)(C.lds + GL_GUP);
    const int tid = C.tid;
    if (tid < 128) { const int t = tid >> 1, hh = tid & 1; *(LAS v4u*)(Z + t * 16 + hh * 8) = *(const v4u*)(pg + (size_t)t * NPG + 1536 + hh * 8); }
    for (int i = tid; i < 16 * 64; i += NT) GUP[i] = gk_up[(i >> 6) * 256 + h * 64 + (i & 63)];
    if (tid < 64) GUP[1024 + tid] = gk_b[h * 64 + tid];
    __syncthreads();
    { const int t = tid >> 3, d0 = (tid & 7) * 8; float a[8];
#pragma unroll
      for (int q = 0; q < 8; ++q) a[q] = GUP[1024 + d0 + q];
#pragma unroll
      for (int i = 0; i < 16; ++i) { const float zv = bf2f(Z[t * 16 + i]);
#pragma unroll
          for (int q = 0; q < 8; ++q) a[q] += zv * GUP[i * 64 + d0 + q]; }
#pragma unroll
      for (int q = 0; q < 8; ++q) GK[t * 64 + d0 + q] = logsigmoidf_(a[q]) * (1.f / 16.f); }
    __syncthreads();
    { const int d = tid & 63, seg = tid >> 6; float run = 0.f;
#pragma unroll
      for (int q = 0; q < 8; ++q) { run += GK[(seg * 8 + q) * 64 + d]; GK[(seg * 8 + q) * 64 + d] = run; }
      SEG[seg * 64 + d] = run; }
    __syncthreads();
    { const int d = tid & 63, seg = tid >> 6; float off = 0.f;
      for (int s = 0; s < seg; ++s) off += SEG[s * 64 + d];
#pragma unroll
      for (int q = 0; q < 8; ++q) GK[(seg * 8 + q) * 64 + d] += off; }
    __syncthreads();
}
__device__ __forceinline__ void gla_stage_vt(const Ctx& C, const bf16* pg, int h) {
    LAS bf16* VT = (LAS bf16*)(C.lds + GL_VT);
    const int j = C.tid >> 3, e0 = (C.tid & 7) * 16;
    const v4u x0 = *(const v4u*)(pg + (size_t)j * NPG + 512 + h * 128 + e0), x1 = *(const v4u*)(pg + (size_t)j * NPG + 512 + h * 128 + e0 + 8);
    const unsigned w[8] = {x0.x, x0.y, x0.z, x0.w, x1.x, x1.y, x1.z, x1.w};
#pragma unroll
    for (int q = 0; q < 8; ++q) { VT[(e0 + 2 * q) * GL_LD + j] = (bf16)(w[q] & 0xffffu); VT[(e0 + 2 * q + 1) * GL_LD + j] = (bf16)(w[q] >> 16); }
}

__device__ __forceinline__ void ph_gla_a(const Ctx& C, const bf16* PG, const float* gk_up, const float* gk_b, bf16* DS, float* GAM, bf16* VL) {
    LAS float* GK = (LAS float*)(C.lds + GL_GK); LAS bf16* KT = (LAS bf16*)(C.lds + GL_I0); LAS bf16* VT = (LAS bf16*)(C.lds + GL_VT);
    for (int item = C.bid; item < 2048; item += C.nb) {
        const int bh = item >> 7, c = item & 127, b = bh >> 2, h = bh & 3;
        const size_t m0 = (size_t)b * T_ + c * 64;
        const bf16* pg = PG + m0 * NPG;
        gla_gates(C, pg, gk_up, gk_b, h);
        { const int j = C.tid >> 3, d0 = (C.tid & 7) * 8;
          const v4u kx = *(const v4u*)(pg + (size_t)j * NPG + 256 + h * 64 + d0);
          const unsigned w[4] = {kx.x, kx.y, kx.z, kx.w};
#pragma unroll
          for (int q = 0; q < 4; ++q) { const float k0 = bf2f((bf16)(w[q] & 0xffffu)), k1 = bf2f((bf16)(w[q] >> 16));
              const int d = d0 + 2 * q;
              KT[d * GL_LD + j] = (bf16)f2bf(k0 * __expf(GK[63 * 64 + d] - GK[j * 64 + d]));
              KT[(d + 1) * GL_LD + j] = (bf16)f2bf(k1 * __expf(GK[63 * 64 + d + 1] - GK[j * 64 + d + 1])); } }
        gla_stage_vt(C, pg, h);
        if (C.tid < 64) GAM[(size_t)item * 64 + C.tid] = __expf(GK[63 * 64 + C.tid]);
        if (h == 0 && C.tid < 256) { const int t = C.tid >> 2, q = C.tid & 3; *(unsigned long long*)(VL + (m0 + t) * 32 + q * 8 + 0) = *(const unsigned long long*)(pg + (size_t)t * NPG + 1552 + q * 8);
                                     *(unsigned long long*)(VL + (m0 + t) * 32 + q * 8 + 4) = *(const unsigned long long*)(pg + (size_t)t * NPG + 1552 + q * 8 + 4); }
        __syncthreads();
        { const int n0 = C.wave * 16, lane = C.lane, cc = lane & 15, g = lane >> 4;
          bf16* out = DS + (size_t)item * 8192 + (size_t)(n0 + cc) * 64 + 4 * g;
#pragma unroll
          for (int mt = 0; mt < 4; ++mt) { f32x4 acc = {0.f, 0.f, 0.f, 0.f}; acc = mm16(KT + mt * 16 * GL_LD, GL_LD, VT + n0 * GL_LD, GL_LD, 64, acc, lane);
              *(unsigned long long*)(out + mt * 16) = pack4(acc); } }
        __syncthreads();
    }
}
__device__ __forceinline__ void ph_gla_b(const Ctx& C, bf16* DS, const float* GAM) {
    for (int idx = C.bid * NT + C.tid; idx < 16 * 8192; idx += C.nb * NT) {
        const int bh = idx >> 13, ed = idx & 8191, d = ed & 63;
        bf16* p = DS + (size_t)bh * 128 * 8192 + ed; const float* gp = GAM + (size_t)bh * 128 * 64 + d;
        float S = 0.f;
        for (int c0 = 0; c0 < 128; c0 += 8) {
            float ds[8], gm[8];
#pragma unroll
            for (int i = 0; i < 8; ++i) { ds[i] = bf2f(p[(size_t)(c0 + i) * 8192]); gm[i] = gp[(c0 + i) * 64]; }
#pragma unroll
            for (int i = 0; i < 8; ++i) { const float gs = gm[i] * S; p[(size_t)(c0 + i) * 8192] = (bf16)f2bf(gs); S = gs + ds[i]; }
        }
    }
}
__device__ __forceinline__ void ph_gla_c(const Ctx& C, const bf16* PG, const float* gk_up, const float* gk_b, const float* norm_g, const bf16* DS, bf16* O) {
    LAS float* GK = (LAS float*)(C.lds + GL_GK); LAS bf16* QP = (LAS bf16*)(C.lds + GL_I0); LAS bf16* KM = (LAS bf16*)(C.lds + GL_I1); LAS bf16* AI = (LAS bf16*)(C.lds + GL_I2);
    LAS bf16* VT = (LAS bf16*)(C.lds + GL_VT); LAS float* SSQ = (LAS float*)(C.lds + GL_SSQ);
    for (int item = C.bid; item < 2048; item += C.nb) {
        const int bh = item >> 7, c = item & 127, b = bh >> 2, h = bh & 3;
        const size_t m0 = (size_t)b * T_ + c * 64;
        const bf16* pg = PG + m0 * NPG;
        gla_gates(C, pg, gk_up, gk_b, h);
        { const int j = C.tid >> 3, d0 = (C.tid & 7) * 8;
          const v4u qx = *(const v4u*)(pg + (size_t)j * NPG + h * 64 + d0), kx = *(const v4u*)(pg + (size_t)j * NPG + 256 + h * 64 + d0);
          const unsigned qw[4] = {qx.x, qx.y, qx.z, qx.w}, kw[4] = {kx.x, kx.y, kx.z, kx.w};
          unsigned qo[4], ko[4];
#pragma unroll
          for (int q = 0; q < 4; ++q) { const int d = d0 + 2 * q;
              const float e0 = GK[63 * 64 + d] - GK[j * 64 + d], e1 = GK[63 * 64 + d + 1] - GK[j * 64 + d + 1];
              const float q0 = 0.125f * bf2f((bf16)(qw[q] & 0xffffu)) * __expf(-e0), q1 = 0.125f * bf2f((bf16)(qw[q] >> 16)) * __expf(-e1);
              const float k0 = bf2f((bf16)(kw[q] & 0xffffu)) * __expf(e0), k1 = bf2f((bf16)(kw[q] >> 16)) * __expf(e1);
              qo[q] = f2bf(q0) | (f2bf(q1) << 16); ko[q] = f2bf(k0) | (f2bf(k1) << 16); }
          *(LAS v4u*)(QP + j * GL_LD + d0) = (v4u){qo[0], qo[1], qo[2], qo[3]}; *(LAS v4u*)(KM + j * GL_LD + d0) = (v4u){ko[0], ko[1], ko[2], ko[3]}; }
        gla_stage_vt(C, pg, h);
        __syncthreads();
        { const int lane = C.lane, cc = lane & 15, g = lane >> 4, n0 = (C.wave >> 1) * 16;
#pragma unroll
          for (int q = 0; q < 2; ++q) { const int mt0 = ((C.wave & 1) * 2 + q) * 16; f32x4 acc = {0.f, 0.f, 0.f, 0.f};
              acc = mm16(KM + mt0 * GL_LD, GL_LD, QP + n0 * GL_LD, GL_LD, 64, acc, lane);
              const int i = n0 + cc, j = mt0 + 4 * g;
              acc.x = (j + 0 <= i) ? acc.x : 0.f; acc.y = (j + 1 <= i) ? acc.y : 0.f; acc.z = (j + 2 <= i) ? acc.z : 0.f; acc.w = (j + 3 <= i) ? acc.w : 0.f;
              *(LAS unsigned long long*)(AI + (n0 + cc) * GL_LD + mt0 + 4 * g) = pack4(acc); } }
        __syncthreads();
        { const int lane = C.lane, cc = lane & 15, g = lane >> 4, n0 = (C.wave & 3) * 16, eh = C.wave >> 2;
          const bf16* Sg = DS + (size_t)item * 8192;
          f32x4 acc[4]; float ss = 0.f;
#pragma unroll
          for (int mt = 0; mt < 4; ++mt) { const int e0 = eh * 64 + mt * 16; acc[mt] = (f32x4){0.f, 0.f, 0.f, 0.f};
              acc[mt] = mm16_ga(Sg + (size_t)e0 * 64, 64, QP + n0 * GL_LD, GL_LD, 64, acc[mt], lane);
              acc[mt] = mm16(VT + e0 * GL_LD, GL_LD, AI + n0 * GL_LD, GL_LD, 64, acc[mt], lane);
              ss += (acc[mt].x * acc[mt].x + acc[mt].y * acc[mt].y) + (acc[mt].z * acc[mt].z + acc[mt].w * acc[mt].w); }
          ss += __shfl_xor(ss, 16); ss += __shfl_xor(ss, 32);
          if (g == 0) SSQ[eh * 64 + n0 + cc] = ss;
          __syncthreads();
          const float rstd = 1.f / sqrtf((SSQ[n0 + cc] + SSQ[64 + n0 + cc]) * (1.f / 128.f) + 1e-6f);
          const size_t m = m0 + n0 + cc;
#pragma unroll
          for (int mt = 0; mt < 4; ++mt) { const int e = eh * 64 + mt * 16 + 4 * g;
              const unsigned long long gx = *(const unsigned long long*)(pg + (size_t)(n0 + cc) * NPG + 1024 + h * 128 + e);
              const f32x4 ng = *(const f32x4*)(norm_g + e);
              f32x4 o;
              o.x = acc[mt].x * rstd * ng.x * siluf_(bf2f((bf16)(gx & 0xffffu)));
              o.y = acc[mt].y * rstd * ng.y * siluf_(bf2f((bf16)((gx >> 16) & 0xffffu)));
              o.z = acc[mt].z * rstd * ng.z * siluf_(bf2f((bf16)((gx >> 32) & 0xffffu)));
              o.w = acc[mt].w * rstd * ng.w * siluf_(bf2f((bf16)(gx >> 48)));
              *(unsigned long long*)(O + m * D_ + h * 128 + e) = pack4(o); } }
        __syncthreads();
    }
}


struct RwkvW { const float *mu, *mu_vres, *w0, *a0, *v0, *k_k, *k_a, *r_k; const bf16 *wupT, *aupT, *gupT, *vupT; };
constexpr int RW_LD = 72, RW_XLD = 296, RW_FLD = 68;
constexpr int RW_R0 = 0;
constexpr int RW_SEG = 16384;
constexpr int RW_R1 = 37888;
constexpr int RW_R2 = RW_R1 + 27648;
constexpr int RW_R3 = RW_R2 + 9216;
constexpr int RW_R4 = RW_R3 + 27648;
constexpr int RW_END = RW_R4 + 128 * RW_FLD * 4;
static_assert(RW_END <= RING_BYTES + 8192 && RW_END <= MISC_OFF, "RWKV LDS map");

__device__ __forceinline__ float sum8(float v) { v += dpp_f<0xB1>(v); v += dpp_f<0x4E>(v); v += dpp_f<0x141>(v); return v; }
__device__ __forceinline__ void unpack8(const v4u x, float (&o)[8]) {
    o[0] = bf2f((bf16)(x.x & 0xffffu)); o[1] = bf2f((bf16)(x.x >> 16)); o[2] = bf2f((bf16)(x.y & 0xffffu)); o[3] = bf2f((bf16)(x.y >> 16));
    o[4] = bf2f((bf16)(x.z & 0xffffu)); o[5] = bf2f((bf16)(x.z >> 16)); o[6] = bf2f((bf16)(x.w & 0xffffu)); o[7] = bf2f((bf16)(x.w >> 16)); }
__device__ __forceinline__ v4u pack8(const float (&o)[8]) { return (v4u){f2bf(o[0]) | (f2bf(o[1]) << 16), f2bf(o[2]) | (f2bf(o[3]) << 16), f2bf(o[4]) | (f2bf(o[5]) << 16), f2bf(o[6]) | (f2bf(o[7]) << 16)}; }
__device__ __forceinline__ f32x4 mm16_gb(const LAS bf16* A, int lda, const bf16* B, int ldb, int K, f32x4 acc, int lane) {
    const int r = lane & 15, g = lane >> 4;
    const LAS bf16* ap = A + r * lda + 8 * g; const bf16* bp = B + r * ldb + 8 * g;
    for (int k0 = 0; k0 < K; k0 += 32) { const s16x8 a = *(const LAS s16x8*)(ap + k0); const s16x8 b = *(const s16x8*)(bp + k0); acc = __builtin_amdgcn_mfma_f32_16x16x32_bf16(a, b, acc, 0, 0, 0); }
    return acc;
}

__device__ __forceinline__ void ph_rwkv_a(const Ctx& C, const bf16* PR, const bf16* VL  , const RwkvW& W, int layer,
                                          bf16* PP, bf16* QQ, bf16* RH, bf16* YH, float* GAMC, float* RK, bf16* GG, bf16* VF) {
    LAS unsigned char* L = C.lds;
    LAS bf16* X = (LAS bf16*)(L + RW_R0); LAS float* CUM = (LAS float*)(L + RW_R0); LAS float* SEG = (LAS float*)(L + RW_SEG);
    LAS bf16* NI = (LAS bf16*)(L + RW_R0), *AAK = NI + 64 * RW_LD, *ARB = AAK + 64 * RW_LD, *ARK = ARB + 64 * RW_LD;
    LAS bf16* PRE = (LAS bf16*)(L + RW_R1);
    LAS bf16* AT = (LAS bf16*)(L + RW_R1), *BT = AT + 64 * RW_LD, *KT = BT + 64 * RW_LD, *RT = (LAS bf16*)(L + RW_R2);
    LAS bf16* XB16 = (LAS bf16*)(L + RW_R1);
    LAS bf16* BHc = (LAS bf16*)(L + RW_R3), *KHc = BHc + 64 * RW_LD, *VTc = KHc + 64 * RW_LD;
    LAS float* XT = (LAS float*)(L + RW_R4);
    const int tid = C.tid, lane = C.lane, wave = C.wave, cc = lane & 15, g = lane >> 4;
    for (int item = C.bid; item < 4096; item += C.nb) {
        const int h = item & 7, c = (item >> 3) & 127, b = item >> 10;
        const size_t m0 = (size_t)b * T_ + c * 64;
        for (int idx = tid; idx < 64 * 36; idx += NT) {
            const int t = idx / 36, q = idx % 36, col = q * 8; const size_t m = m0 + t; const bool first = (c == 0 && t == 0);
            v4u cur, prv; float mu[8];
            if (q < 32) { cur = *(const v4u*)(PR + m * NPR + 1536 + col); prv = first ? (v4u){0u, 0u, 0u, 0u} : *(const v4u*)(PR + (m - 1) * NPR + 1536 + col);
#pragma unroll
                for (int i = 0; i < 8; ++i) mu[i] = W.mu[1536 + col + i]; }
            else if (layer) { cur = *(const v4u*)(VL + m * NPG + 1552 + (col - 256)); prv = first ? (v4u){0u, 0u, 0u, 0u} : *(const v4u*)(VL + (m - 1) * NPG + 1552 + (col - 256));
#pragma unroll
                for (int i = 0; i < 8; ++i) mu[i] = W.mu_vres[col - 256 + i]; }
            else { cur = (v4u){0u, 0u, 0u, 0u}; prv = cur;
#pragma unroll
                for (int i = 0; i < 8; ++i) mu[i] = 0.f; }
            float cv[8], pv[8]; unpack8(cur, cv); unpack8(prv, pv);
#pragma unroll
            for (int i = 0; i < 8; ++i) { float p = cv[i] + (pv[i] - cv[i]) * mu[i]; if (q < 8) p = tanhf(p); else if (q >= 16 && q < 32) p = sigmoidf_(p); cv[i] = p; }
            *(LAS v4u*)(X + t * RW_XLD + col) = pack8(cv);
        }
        __syncthreads();
        {
            const int lsel = wave >> 1;
            const bf16* WT = lsel == 0 ? W.wupT : lsel == 1 ? W.aupT : lsel == 2 ? W.gupT : W.vupT;
            const int Kl = lsel == 2 ? 128 : lsel == 3 ? 32 : 64, xoff = lsel == 0 ? 0 : lsel == 1 ? 64 : lsel == 2 ? 128 : 256;
            LAS bf16* outp = PRE + lsel * 64 * RW_LD;
#pragma unroll 1
            for (int q = 0; q < 8; ++q) { const int tile = (wave & 1) * 8 + q, mt = tile >> 2, nt = tile & 3;
                f32x4 acc = {0.f, 0.f, 0.f, 0.f};
                if (lsel != 3 || layer) {
                    const bf16* ap = WT + (size_t)(h * 64 + mt * 16 + cc) * Kl + 8 * g; const LAS bf16* bp = X + (nt * 16 + cc) * RW_XLD + xoff + 8 * g;
                    for (int k0 = 0; k0 < Kl; k0 += 32) { const s16x8 a = *(const s16x8*)(ap + k0); const s16x8 bb = *(const LAS s16x8*)(bp + k0); acc = __builtin_amdgcn_mfma_f32_16x16x32_bf16(a, bb, acc, 0, 0, 0); }
                }
                *(LAS unsigned long long*)(outp + (nt * 16 + cc) * RW_LD + mt * 16 + 4 * g) = pack4(acc); }
        }
        __syncthreads();
        const int t = tid >> 3, d0 = (tid & 7) * 8, ch = h * 64 + d0; const size_t m = m0 + t; const bool first = (c == 0 && t == 0);
        float av[8], bv[8], kv[8], rv[8], lw[8], vv[8];
        {
            float rc[8], rp[8], kc[8], kp[8], vc[8], vp[8], pw[8], pa[8], pg_[8], pvg[8];
            unpack8(*(const v4u*)(PR + m * NPR + ch), rc); unpack8(*(const v4u*)(PR + m * NPR + 512 + ch), kc); unpack8(*(const v4u*)(PR + m * NPR + 1024 + ch), vc);
            if (first) {
#pragma unroll
                for (int i = 0; i < 8; ++i) { rp[i] = 0.f; kp[i] = 0.f; vp[i] = 0.f; } }
            else { unpack8(*(const v4u*)(PR + (m - 1) * NPR + ch), rp); unpack8(*(const v4u*)(PR + (m - 1) * NPR + 512 + ch), kp); unpack8(*(const v4u*)(PR + (m - 1) * NPR + 1024 + ch), vp); }
            unpack8(*(const LAS v4u*)(PRE + (0 * 64 + t) * RW_LD + d0), pw); unpack8(*(const LAS v4u*)(PRE + (1 * 64 + t) * RW_LD + d0), pa);
            unpack8(*(const LAS v4u*)(PRE + (2 * 64 + t) * RW_LD + d0), pg_); unpack8(*(const LAS v4u*)(PRE + (3 * 64 + t) * RW_LD + d0), pvg);
            float vf[8];
            if (layer) unpack8(*(const v4u*)(VF + m * 512 + ch), vf);
            float ssq = 0.f, rks = 0.f, asg[8], gg[8];
#pragma unroll
            for (int i = 0; i < 8; ++i) {
                const float r = rc[i] + (rp[i] - rc[i]) * W.mu[ch + i], k = kc[i] + (kp[i] - kc[i]) * W.mu[512 + ch + i]; float v = vc[i] + (vp[i] - vc[i]) * W.mu[1024 + ch + i];
                lw[i] = -__expf(-softplusf_(-(W.w0[ch + i] + pw[i])) - 0.5f);
                asg[i] = sigmoidf_(W.a0[ch + i] + pa[i]);
                if (layer) v = v + (vf[i] - v) * sigmoidf_(W.v0[ch + i] + pvg[i]);
                const float kk = k * W.k_k[ch + i]; ssq += kk * kk;
                kv[i] = k * (1.f + (asg[i] - 1.f) * W.k_a[ch + i]); rv[i] = r; vv[i] = v; gg[i] = pg_[i]; av[i] = kk;
                rks += r * kv[i] * W.r_k[ch + i];
            }
            ssq = sum8(ssq); rks = sum8(rks);
            const float inv = 1.f / sqrtf(fmaxf(ssq, 1e-24f));
#pragma unroll
            for (int i = 0; i < 8; ++i) { const float kk = av[i] * inv; av[i] = -kk; bv[i] = kk * asg[i]; }
            if ((tid & 7) == 0) RK[m * 8 + h] = rks;
            *(v4u*)(GG + m * 512 + ch) = pack8(gg);
            *(v4u*)(VF + m * 512 + ch) = pack8(vv);
#pragma unroll
            for (int i = 0; i < 8; ++i) vv[i] = bf2f((bf16)f2bf(vv[i]));
        }
        __syncthreads();
#pragma unroll
        for (int i = 0; i < 8; ++i) CUM[t * 64 + d0 + i] = lw[i];
        __syncthreads();
        { const int d = tid & 63, seg = tid >> 6; float run = 0.f;
#pragma unroll
          for (int q = 0; q < 8; ++q) { run += CUM[(seg * 8 + q) * 64 + d]; CUM[(seg * 8 + q) * 64 + d] = run; }
          SEG[seg * 64 + d] = run; }
        __syncthreads();
        { const int d = tid & 63, seg = tid >> 6; float off = 0.f;
          for (int s = 0; s < seg; ++s) off += SEG[s * 64 + d];
#pragma unroll
          for (int q = 0; q < 8; ++q) CUM[(seg * 8 + q) * 64 + d] += off; }
        __syncthreads();
        {
            float at[8], bt[8], kt[8], rt[8];
#pragma unroll
            for (int i = 0; i < 8; ++i) { const float cu = CUM[t * 64 + d0 + i], cC = CUM[63 * 64 + d0 + i], en = __expf(-cu), ec = __expf(cC - cu);
                at[i] = av[i] * __expf(cu - lw[i]); bt[i] = bv[i] * en; kt[i] = kv[i] * en; rt[i] = rv[i] * __expf(cu);
                BHc[(d0 + i) * RW_LD + t] = (bf16)f2bf(bv[i] * ec); KHc[(d0 + i) * RW_LD + t] = (bf16)f2bf(kv[i] * ec); VTc[(d0 + i) * RW_LD + t] = (bf16)f2bf(vv[i]);
                XT[(d0 + i) * RW_FLD + t] = bf2f((bf16)f2bf(at[i]));
                if (t == 63) GAMC[(size_t)item * 64 + d0 + i] = __expf(cC); }
            *(LAS v4u*)(AT + t * RW_LD + d0) = pack8(at); *(LAS v4u*)(BT + t * RW_LD + d0) = pack8(bt); *(LAS v4u*)(KT + t * RW_LD + d0) = pack8(kt); *(LAS v4u*)(RT + t * RW_LD + d0) = pack8(rt);
        }
        __syncthreads();
        {
            const int msel = wave >> 1;
            const LAS bf16* As = (msel == 0 || msel == 2) ? BT : KT; const LAS bf16* Bs = (msel < 2) ? AT : RT;
            f32x4 accs[8];
#pragma unroll
            for (int q = 0; q < 8; ++q) { const int tile = (wave & 1) * 8 + q, mt = tile >> 2, nt = tile & 3; accs[q] = (f32x4){0.f, 0.f, 0.f, 0.f};
                accs[q] = mm16(As + mt * 16 * RW_LD, RW_LD, Bs + nt * 16 * RW_LD, RW_LD, 64, accs[q], lane);
                const int tt = nt * 16 + cc, s0 = mt * 16 + 4 * g, lim = (msel < 2) ? tt - 1 : tt;
                accs[q].x = (s0 + 0 <= lim) ? accs[q].x : 0.f; accs[q].y = (s0 + 1 <= lim) ? accs[q].y : 0.f; accs[q].z = (s0 + 2 <= lim) ? accs[q].z : 0.f; accs[q].w = (s0 + 3 <= lim) ? accs[q].w : 0.f; }
            __syncthreads();
            LAS bf16* outp = NI + msel * 64 * RW_LD;
#pragma unroll
            for (int q = 0; q < 8; ++q) { const int tile = (wave & 1) * 8 + q, mt = tile >> 2, nt = tile & 3;
                *(LAS unsigned long long*)(outp + (nt * 16 + cc) * RW_LD + mt * 16 + 4 * g) = pack4(accs[q]); }
        }
        __syncthreads();
#pragma unroll
        for (int q = 0; q < 2; ++q) { const int tile = wave * 2 + q, mt = tile >> 2, nt = tile & 3;
            f32x4 acc = {0.f, 0.f, 0.f, 0.f}; acc = mm16(AAK + mt * 16 * RW_LD, RW_LD, VTc + nt * 16 * RW_LD, RW_LD, 64, acc, lane);
            *(LAS f32x4*)(XT + (64 + nt * 16 + cc) * RW_FLD + mt * 16 + 4 * g) = acc; }
        __syncthreads();
#pragma unroll 1
        for (int i = 0; i < 4; ++i) {
            if (i > 0) {
                f32x4 acc = *(const LAS f32x4*)(XT + (wave * 16 + cc) * RW_FLD + 16 * i + 4 * g);
                const int klim = 16 * i;
                for (int k0 = 0; k0 < klim; k0 += 32) { s16x8 a = *(const LAS s16x8*)(NI + (16 * i + cc) * RW_LD + k0 + 8 * g); s16x8 bb = *(const LAS s16x8*)(XB16 + (wave * 16 + cc) * RW_LD + k0 + 8 * g);
                    if (k0 + 8 * g >= klim) { a = (s16x8){0, 0, 0, 0, 0, 0, 0, 0}; bb = a; }
                    acc = __builtin_amdgcn_mfma_f32_16x16x32_bf16(a, bb, acc, 0, 0, 0); }
                *(LAS f32x4*)(XT + (wave * 16 + cc) * RW_FLD + 16 * i + 4 * g) = acc;
                __syncthreads();
            }
            if (tid < 128) {
                float x[16];
#pragma unroll
                for (int q = 0; q < 4; ++q) { const f32x4 v4 = *(const LAS f32x4*)(XT + tid * RW_FLD + 16 * i + 4 * q); x[4 * q] = v4.x; x[4 * q + 1] = v4.y; x[4 * q + 2] = v4.z; x[4 * q + 3] = v4.w; }
#pragma unroll
                for (int tt = 1; tt < 16; ++tt) { float nr[16]; { float lo[8], hi[8]; unpack8(*(const LAS v4u*)(NI + (16 * i + tt) * RW_LD + 16 * i), lo); unpack8(*(const LAS v4u*)(NI + (16 * i + tt) * RW_LD + 16 * i + 8), hi);
#pragma unroll
                        for (int s = 0; s < 8; ++s) { nr[s] = lo[s]; nr[8 + s] = hi[s]; } }
                    float a = x[tt];
#pragma unroll
                    for (int s = 0; s < tt; ++s) a += nr[s] * x[s];
                    x[tt] = a; }
                float lo[8], hi[8];
#pragma unroll
                for (int s = 0; s < 8; ++s) { lo[s] = x[s]; hi[s] = x[8 + s]; }
                *(LAS v4u*)(XB16 + tid * RW_LD + 16 * i) = pack8(lo); *(LAS v4u*)(XB16 + tid * RW_LD + 16 * i + 8) = pack8(hi);
            }
            __syncthreads();
        }
        {
            const int osel = wave >> 1; const size_t ob = (size_t)item * 4096;
#pragma unroll 1
            for (int q = 0; q < 8; ++q) { const int tile = (wave & 1) * 8 + q, mt = tile >> 2, nt = tile & 3; f32x4 acc = {0.f, 0.f, 0.f, 0.f};
                if (osel == 0) {
                    acc = mm16(XB16 + mt * 16 * RW_LD, RW_LD, BHc + nt * 16 * RW_LD, RW_LD, 64, acc, lane);
                    *(unsigned long long*)(PP + ob + (nt * 16 + cc) * 64 + mt * 16 + 4 * g) = pack4(acc);
                } else if (osel == 1) {
                    acc = mm16(BHc + mt * 16 * RW_LD, RW_LD, XB16 + (64 + nt * 16) * RW_LD, RW_LD, 64, acc, lane);
                    acc = mm16(KHc + mt * 16 * RW_LD, RW_LD, VTc + nt * 16 * RW_LD, RW_LD, 64, acc, lane);
                    *(unsigned long long*)(QQ + ob + (nt * 16 + cc) * 64 + mt * 16 + 4 * g) = pack4(acc);
                } else if (osel == 2) {
                    acc = mm16(XB16 + mt * 16 * RW_LD, RW_LD, ARB + nt * 16 * RW_LD, RW_LD, 64, acc, lane);
                    const unsigned long long rr = *(const LAS unsigned long long*)(RT + (nt * 16 + cc) * RW_LD + mt * 16 + 4 * g);
                    acc.x += bf2f((bf16)(rr & 0xffffu)); acc.y += bf2f((bf16)((rr >> 16) & 0xffffu)); acc.z += bf2f((bf16)((rr >> 32) & 0xffffu)); acc.w += bf2f((bf16)(rr >> 48));
                    *(unsigned long long*)(RH + ob + (nt * 16 + cc) * 64 + mt * 16 + 4 * g) = pack4(acc);
                } else {
                    acc = mm16(XB16 + (64 + mt * 16) * RW_LD, RW_LD, ARB + nt * 16 * RW_LD, RW_LD, 64, acc, lane);
                    acc = mm16(VTc + mt * 16 * RW_LD, RW_LD, ARK + nt * 16 * RW_LD, RW_LD, 64, acc, lane);
                    *(unsigned long long*)(YH + ob + (nt * 16 + cc) * 64 + mt * 16 + 4 * g) = pack4(acc);
                } }
        }
        __syncthreads();
    }
}

struct ChainOps { s16x8 a[4][2]; unsigned long long q[4]; f32x4 gm[4]; };
__device__ __forceinline__ void chain_load(ChainOps& o, const bf16* PP, const bf16* QQ, const float* GAMC, int item, int vt, int cc, int g) {
    const size_t ob = (size_t)item * 4096;
#pragma unroll
    for (int mt = 0; mt < 4; ++mt) {
        o.a[mt][0] = *(const s16x8*)(PP + ob + (mt * 16 + cc) * 64 + 8 * g); o.a[mt][1] = *(const s16x8*)(PP + ob + (mt * 16 + cc) * 64 + 32 + 8 * g);
        o.q[mt] = *(const unsigned long long*)(QQ + ob + (vt * 16 + cc) * 64 + mt * 16 + 4 * g);
        o.gm[mt] = *(const f32x4*)(GAMC + (size_t)item * 64 + mt * 16 + 4 * g); }
}
__device__ __forceinline__ void ph_rwkv_b(const Ctx& C, int wgi  , const bf16* PP, const bf16* QQ, const float* GAMC, bf16* S0) {
    const int lane = C.lane, wave = C.wave, cc = lane & 15, g = lane >> 4;
    const int bh = wgi * 2 + (wave >> 2), vt = wave & 3, b = bh >> 3, h = bh & 7;
    LAS bf16* SI = (LAS bf16*)(C.lds) + wave * 16 * RW_LD;
    f32x4 st[4];
#pragma unroll
    for (int mt = 0; mt < 4; ++mt) st[mt] = (f32x4){0.f, 0.f, 0.f, 0.f};
    ChainOps cur, nxt;
    chain_load(cur, PP, QQ, GAMC, (b * 128 + 0) * 8 + h, vt, cc, g);
    for (int c = 0; c < 128; ++c) {
        const int item = (b * 128 + c) * 8 + h; const size_t ob = (size_t)item * 4096;
        const int cn = c + 1 < 128 ? c + 1 : c;
        chain_load(nxt, PP, QQ, GAMC, (b * 128 + cn) * 8 + h, vt, cc, g);
#pragma unroll
        for (int mt = 0; mt < 4; ++mt) { const unsigned long long pk = pack4(st[mt]);
            *(unsigned long long*)(S0 + ob + (vt * 16 + cc) * 64 + mt * 16 + 4 * g) = pk; *(LAS unsigned long long*)(SI + cc * RW_LD + mt * 16 + 4 * g) = pk; }
        asm volatile("s_waitcnt lgkmcnt(0)" ::: "memory");
        const s16x8 b0 = *(const LAS s16x8*)(SI + cc * RW_LD + 8 * g), b1 = *(const LAS s16x8*)(SI + cc * RW_LD + 32 + 8 * g);
#pragma unroll
        for (int mt = 0; mt < 4; ++mt) {
            f32x4 acc; acc.x = cur.gm[mt].x * st[mt].x + bf2f((bf16)(cur.q[mt] & 0xffffu)); acc.y = cur.gm[mt].y * st[mt].y + bf2f((bf16)((cur.q[mt] >> 16) & 0xffffu));
            acc.z = cur.gm[mt].z * st[mt].z + bf2f((bf16)((cur.q[mt] >> 32) & 0xffffu)); acc.w = cur.gm[mt].w * st[mt].w + bf2f((bf16)(cur.q[mt] >> 48));
            acc = __builtin_amdgcn_mfma_f32_16x16x32_bf16(cur.a[mt][0], b0, acc, 0, 0, 0); acc = __builtin_amdgcn_mfma_f32_16x16x32_bf16(cur.a[mt][1], b1, acc, 0, 0, 0);
            st[mt] = acc; }
        asm volatile("s_waitcnt lgkmcnt(0)" ::: "memory");
        cur = nxt;
    }
}

__device__ __forceinline__ void ph_rwkv_c(const Ctx& C, const bf16* S0, const bf16* RH, const bf16* YH, const float* RK, const bf16* GG, const bf16* VF,
                                          const float* gn_g, const float* gn_b, bf16* O) {
    const int lane = C.lane, cc = lane & 15, g = lane >> 4;
    for (int item = C.bid * 8 + C.wave; item < 4096; item += C.nb * 8) {
        const int h = item & 7, c = (item >> 3) & 127, b = item >> 10; const size_t m0 = (size_t)b * T_ + c * 64, ob = (size_t)item * 4096;
        s16x8 af[4][2], bfr[4][2];
#pragma unroll
        for (int q = 0; q < 4; ++q)
#pragma unroll
            for (int k = 0; k < 2; ++k) { af[q][k] = *(const s16x8*)(S0 + ob + (q * 16 + cc) * 64 + k * 32 + 8 * g); bfr[q][k] = *(const s16x8*)(RH + ob + (q * 16 + cc) * 64 + k * 32 + 8 * g); }
#pragma unroll
        for (int nt = 0; nt < 4; ++nt) {
            const size_t m = m0 + nt * 16 + cc;
            f32x4 y[4]; float s1 = 0.f;
#pragma unroll
            for (int mt = 0; mt < 4; ++mt) { const unsigned long long yh = *(const unsigned long long*)(YH + ob + (nt * 16 + cc) * 64 + mt * 16 + 4 * g);
                f32x4 acc; acc.x = bf2f((bf16)(yh & 0xffffu)); acc.y = bf2f((bf16)((yh >> 16) & 0xffffu)); acc.z = bf2f((bf16)((yh >> 32) & 0xffffu)); acc.w = bf2f((bf16)(yh >> 48));
                acc = __builtin_amdgcn_mfma_f32_16x16x32_bf16(af[mt][0], bfr[nt][0], acc, 0, 0, 0); acc = __builtin_amdgcn_mfma_f32_16x16x32_bf16(af[mt][1], bfr[nt][1], acc, 0, 0, 0);
                y[mt] = acc; s1 += (acc.x + acc.y) + (acc.z + acc.w); }
            s1 += __shfl_xor(s1, 16); s1 += __shfl_xor(s1, 32);
            const float mean = s1 * (1.f / 64.f); float s2 = 0.f;
#pragma unroll
            for (int mt = 0; mt < 4; ++mt) { y[mt] = y[mt] - mean; s2 += (y[mt].x * y[mt].x + y[mt].y * y[mt].y) + (y[mt].z * y[mt].z + y[mt].w * y[mt].w); }
            s2 += __shfl_xor(s2, 16); s2 += __shfl_xor(s2, 32);
            const float rstd = 1.f / sqrtf(s2 * (1.f / 64.f) + 64e-5f), rk = RK[m * 8 + h];
#pragma unroll
            for (int mt = 0; mt < 4; ++mt) { const int v = h * 64 + mt * 16 + 4 * g;
                const f32x4 gg4 = *(const f32x4*)(gn_g + v), gb4 = *(const f32x4*)(gn_b + v);
                const unsigned long long vx = *(const unsigned long long*)(VF + m * 512 + v), gx = *(const unsigned long long*)(GG + m * 512 + v);
                f32x4 o;
                o.x = (y[mt].x * rstd * gg4.x + gb4.x + rk * bf2f((bf16)(vx & 0xffffu))) * bf2f((bf16)(gx & 0xffffu));
                o.y = (y[mt].y * rstd * gg4.y + gb4.y + rk * bf2f((bf16)((vx >> 16) & 0xffffu))) * bf2f((bf16)((gx >> 16) & 0xffffu));
                o.z = (y[mt].z * rstd * gg4.z + gb4.z + rk * bf2f((bf16)((vx >> 32) & 0xffffu))) * bf2f((bf16)((gx >> 32) & 0xffffu));
                o.w = (y[mt].w * rstd * gg4.w + gb4.w + rk * bf2f((bf16)(vx >> 48))) * bf2f((bf16)(gx >> 48));
                *(unsigned long long*)(O + m * D_ + 512 + v) = pack4(o); }
        }
    }
}

__device__ __forceinline__ void ph_conv(const Ctx& C, const bf16* U, const float* cw, const float* cb, bf16* ACT) {
    for (size_t idx = (size_t)C.bid * NT + C.tid; idx < (size_t)T_ * DFF; idx += (size_t)C.nb * NT) {
        const int t = (int)(idx / DFF), j = (int)(idx % DFF);
        const bf16* u = U + (size_t)t * NUP;
        float g = cb[j], v = cb[DFF + j];
        g += cw[2 * NUP + j] * bf2f(u[j]); v += cw[2 * NUP + DFF + j] * bf2f(u[DFF + j]);
        if (t >= 1) { g += cw[NUP + j] * bf2f(u[j - NUP]); v += cw[NUP + DFF + j] * bf2f(u[DFF + j - NUP]); }
        if (t >= 2) { g += cw[j] * bf2f(u[j - 2 * NUP]); v += cw[DFF + j] * bf2f(u[DFF + j - 2 * NUP]); }
        ACT[(size_t)t * DFF + j] = (bf16)f2bf(siluf_(g) * v);
    }
}
}

namespace pg8 {
struct EpiRes {
    static constexpr bool PERM = false, AFTER_DRAIN = false;
    const float* base; float* out; const float* gate; int gstride;
    __device__ __forceinline__ void operator()(const f32x4 (&acc)[2][2][4][2], const Unit& u, int wr, int wc, int fr, int fq) const {
        const int b = (u.pm * BM) / 8192; const float* gp = gate + (size_t)b * gstride;
        const int col0 = u.pn * BM + wc * 32 + 4 * fq;
#pragma unroll
        for (int ai = 0; ai < 2; ++ai)
#pragma unroll
            for (int m = 0; m < 4; ++m) { const size_t off = (size_t)(u.pm * BM + ai * HALF + wr * 64 + m * 16 + fr) * 1024 + col0;
#pragma unroll
                for (int bj = 0; bj < 2; ++bj)
#pragma unroll
                    for (int n = 0; n < 2; ++n) { const int cc = bj * HALF + n * 16; const f32x4 gv = *(const f32x4*)(gp + col0 + cc); const f32x4 bs = *(const f32x4*)(base + off + cc);
                        *(f32x4*)(out + off + cc) = bs + gv * acc[ai][bj][m][n]; } }
    }
};
}

namespace hy {
struct Args { const float* in[31]; float* out; unsigned char* ws; };
__global__ void __launch_bounds__(NT, 2) hy_fwd(Args A) {
    extern __shared__ __attribute__((aligned(16))) unsigned char lds_raw[];
    Ctx C; C.bid = blockIdx.x; C.nb = gridDim.x; C.tid = threadIdx.x; C.lane = C.tid & 63; C.wave = __builtin_amdgcn_readfirstlane(C.tid >> 6); C.lds = (LAS unsigned char*)lds_raw;
    volatile LAS unsigned* MISC = (volatile LAS unsigned*)(C.lds + MISC_OFF);
    for (int u = C.tid; u < (LDS_BYTES - MISC_OFF) / 4; u += NT) ((LAS unsigned*)(C.lds + MISC_OFF))[u] = 0u;
    __syncthreads();
    unsigned char* ws = A.ws;
    XcdBarrier bar = xcd_barrier_post((unsigned*)(ws + WS_CTL) + CW_BAR, MISC + 8);
#define PHASE_BEGIN() do { int t_ = threadIdx.x; asm volatile("" : "+v"(t_)); int b_ = blockIdx.x; asm volatile("" : "+s"(b_)); \
    C.tid = t_; C.lane = t_ & 63; C.wave = __builtin_amdgcn_readfirstlane(t_ >> 6); C.bid = b_; } while (0)
#define GRID_BAR() do { xcd_barrier(bar); PHASE_BEGIN(); } while (0)
    float* out = A.out;
#define in A.in
    float* MOD = (float*)(ws + WS_MOD);
    bf16 *WIN = (bf16*)(ws + WS_WIN), *WOUT = (bf16*)(ws + WS_WOUT), *WUP = (bf16*)(ws + WS_WUP), *WDN = (bf16*)(ws + WS_WDN);
    bf16 *XB = (bf16*)(ws + WS_XB), *O = (bf16*)(ws + WS_O), *VF = (bf16*)(ws + WS_VF), *PG = (bf16*)(ws + WS_PG), *PR = (bf16*)(ws + WS_PR), *VL = (bf16*)(ws + WS_VL);
    bf16 *RH = (bf16*)(ws + WS_RH), *YH = (bf16*)(ws + WS_YH), *PP = (bf16*)(ws + WS_PP), *QQ = (bf16*)(ws + WS_QQ), *GG = (bf16*)(ws + WS_GG), *S0 = (bf16*)(ws + WS_S0);
    float *GAMC = (float*)(ws + WS_GAMC), *RK = (float*)(ws + WS_RK);
    bf16* LORA = (bf16*)(ws + WS_LORA);
    bf16* DS = (bf16*)(ws + WS_GK); float* GAM = (float*)(ws + WS_GAM);
    bf16 *ACT = (bf16*)(ws + WS_ACT), *U = (bf16*)(ws + WS_U);

    ph_mod(C, in[1], in[2], in[3], MOD);
    for (int l = 0; l < L_; ++l) {
        const float* modl = MOD + (size_t)l * 4 * 6144;
        const float* xres = l ? out : in[0];
        wprep_mat(C, in[5] + (size_t)l * D_ * IN_COLS, D_, IN_COLS, NIN, WIN, 1, l ? in[6] : nullptr);
        wprep_mat(C, in[24] + (size_t)l * D_ * D_, D_, D_, D_, WOUT, 0, nullptr);
        wprep_mat(C, in[26] + (size_t)l * D_ * NUP, D_, NUP, NUP, WUP, 0, nullptr);
        wprep_mat(C, in[29] + (size_t)l * DFF * D_, DFF, D_, D_, WDN, 0, nullptr);
        wprep_mat(C, in[12] + (size_t)l * 64 * 512, 64, 512, 512, LORA, 0, nullptr);
        wprep_mat(C, in[14] + (size_t)l * 64 * 512, 64, 512, 512, LORA + 512 * 64, 0, nullptr);
        wprep_mat(C, in[16] + (size_t)l * 128 * 512, 128, 512, 512, LORA + 2 * 512 * 64, 0, nullptr);
        if (l) wprep_mat(C, in[17], 32, 512, 512, LORA + 2 * 512 * 64 + 512 * 128, 0, nullptr);
        GRID_BAR();
        ph_norm(C, xres, in[4] + l * D_, modl + 0 * D_, modl + 1 * D_, XB);
        GRID_BAR();
        { pg8::Gemm g{XB, WIN, M_, NIN, D_}; pg8::StaticOrder S; S.init(M_, NIN, C.nb, C.bid);
          pg8::EpiBf16<0> E{PG, NPG, nullptr, NPG, (WS_PR - WS_PG) / 2, 1.f};
          pg8::gemm_phase<pg8::EpiBf16<0>, pg8::StaticOrder, true, true>(C.lds, g, S, E); }
        GRID_BAR();
        ph_gla_a(C, PG, in[7] + l * 16 * 256, in[8] + l * 256, DS, GAM, VL);
        { RwkvW W{in[10] + l * 1792, in[11], in[13] + l * 512, in[15] + l * 512, in[18], in[19] + l * 512, in[20] + l * 512, in[21] + l * 512,
                  LORA, LORA + 512 * 64, LORA + 2 * 512 * 64, LORA + 2 * 512 * 64 + 512 * 128};
          ph_rwkv_a(C, PR, PG, W, l, PP, QQ, RH, YH, GAMC, RK, GG, VF); }
        GRID_BAR();
        if (C.bid < 16) ph_rwkv_b(C, C.bid, PP, QQ, GAMC, S0);
        else { Ctx C2 = C; C2.bid = C.bid - 16; C2.nb = C.nb - 16; ph_gla_b(C2, DS, GAM); }
        GRID_BAR();
        ph_gla_c(C, PG, in[7] + l * 16 * 256, in[8] + l * 256, in[9] + l * 128, DS, O);
        ph_rwkv_c(C, S0, RH, YH, RK, GG, VF, in[22] + l * 512, in[23] + l * 512, O);
        GRID_BAR();
        { pg8::Gemm g{O, WOUT, M_, D_, D_}; pg8::StaticOrder S; S.init(M_, D_, C.nb, C.bid);
          pg8::EpiRes E{xres, out, modl + 2 * D_, 6144};
          pg8::gemm_phase<pg8::EpiRes, pg8::StaticOrder, true, true>(C.lds, g, S, E); }
        GRID_BAR();
        ph_norm(C, out, in[25] + l * D_, modl + 3 * D_, modl + 4 * D_, XB);
        GRID_BAR();
        for (int b = 0; b < B_; ++b) {
            { pg8::Gemm g{XB + (size_t)b * T_ * D_, WUP, T_, NUP, D_}; pg8::StaticOrder S; S.init(T_, NUP, C.nb, C.bid);
              pg8::EpiBf16<0> E{U, NUP, nullptr, 0, 0, 1.f};
              pg8::gemm_phase<pg8::EpiBf16<0>, pg8::StaticOrder, true, true>(C.lds, g, S, E); }
            GRID_BAR();
            ph_conv(C, U, in[27] + (size_t)l * 3 * NUP, in[28] + (size_t)l * NUP, ACT + (size_t)b * T_ * DFF);
            GRID_BAR();
        }
        { pg8::Gemm g{ACT, WDN, M_, D_, DFF}; pg8::StaticOrder S; S.init(M_, D_, C.nb, C.bid);
          pg8::EpiRes E{out, out, modl + 5 * D_, 6144};
          pg8::gemm_phase<pg8::EpiRes, pg8::StaticOrder, true, true>(C.lds, g, S, E); }
        GRID_BAR();
    }
    ph_final(C, out, in[30]);
#undef GRID_BAR
#undef PHASE_BEGIN
#undef in
}
}

extern "C" void kernel_launch(void* const* d_in, const int* in_sizes, int n_in, void* d_out, int out_size, void* d_ws, size_t ws_size, hipStream_t stream) {
    using namespace hy;
    static int grid = 0;
    if (grid == 0) {
        if (n_in != 31 || in_sizes[0] != M_ * D_ || out_size != M_ * D_ || ws_size < WS_END) { fprintf(stderr, "kernel_launch: unexpected shapes (n_in %d, in0 %d, out %d, ws %zu)\n", n_in, n_in > 0 ? in_sizes[0] : -1, out_size, ws_size); grid = -1; return; }
        if (hipFuncSetAttribute((const void*)hy_fwd, hipFuncAttributeMaxDynamicSharedMemorySize, LDS_BYTES) != hipSuccess) { fprintf(stderr, "kernel_launch: hipFuncSetAttribute failed\n"); grid = -1; return; }
        int dev = 0, cus = 0, per_cu = 0;
        (void)hipGetDevice(&dev); (void)hipDeviceGetAttribute(&cus, hipDeviceAttributeMultiprocessorCount, dev);
        (void)hipOccupancyMaxActiveBlocksPerMultiprocessor(&per_cu, (const void*)hy_fwd, NT, LDS_BYTES);
        if (per_cu < 1) fprintf(stderr, "kernel_launch: occupancy query reports %d blocks per CU\n", per_cu);
        (void)hipGetLastError();
        grid = cus > 0 ? cus : 256;
    }
    if (grid < 0) return;
    (void)hipMemsetAsync((char*)d_ws + WS_CTL, 0, CTL_ZERO_BYTES, stream);
    Args a{};
    for (int i = 0; i < 31; ++i) a.in[i] = (const float*)d_in[i];
    a.out = (float*)d_out; a.ws = (unsigned char*)d_ws;
    hipLaunchKernelGGL(hy_fwd, dim3(grid), dim3(NT), LDS_BYTES, stream, a);
}
```

```cpp
#include <hip/hip_runtime.h>
#include <cstdio>
#include <cstdint>
namespace pg8 {
#define PG8_LAS __attribute__((address_space(3)))
typedef unsigned short bf16_t;
typedef short bf16x8 __attribute__((ext_vector_type(8)));
typedef float f32x4 __attribute__((ext_vector_type(4)));
typedef unsigned u32x4 __attribute__((ext_vector_type(4)));
constexpr int BM = 256, BK = 64, HALF = 128, HTB = HALF * BK * 2  , STAGE_BYTES = 8 * HTB, NXCD = 8, WGM = 8;

__host__ __device__ __forceinline__ int lds_byte(int r, int c) { const int st = (r >> 4) * 2 + (c >> 5), rr = r & 15, cc = c & 31, ob = rr * 64 + cc * 2; return st * 1024 + (ob ^ (((ob >> 9) & 1) << 5)); }
__host__ __device__ __forceinline__ void stage_rc(int b, int& R, int& C) { const int st = b / 1024, sb = b % 1024, swz = sb ^ (((sb >> 9) & 1) << 5); R = (st >> 1) * 16 + swz / 64; C = (st & 1) * 32 + (swz % 64) / 2; }
__host__ __device__ __forceinline__ int perm32(int rho) { const int n = rho >> 4, i = rho & 15; return 8 * (i >> 2) + 4 * n + (i & 3); }

struct Unit { int pm, pn; };
struct Gemm { const bf16_t* A; const bf16_t* Bt; int M, N, K; };

struct StaticOrder {
    int nM, nN, nwg, G, c;
    __host__ __device__ void init(int M, int N, int G_, int c_) { nM = M / BM; nN = N / BM; nwg = nM * nN; G = G_; c = c_; }
    __host__ __device__ bool next(int i, Unit& u) const {
        const long L = (long)i * G + c; if (L >= nwg) return false;
        int wgid = (int)L; { const int q = nwg / NXCD, r = nwg % NXCD, xcd = wgid % NXCD, off = wgid / NXCD; wgid = (xcd < r ? xcd * (q + 1) : r * (q + 1) + (xcd - r) * q) + off; }
        const int nig = WGM * nN, gid = wgid / nig, fm = gid * WGM, gsz = (nM - fm) < WGM ? (nM - fm) : WGM;
        u.pm = fm + ((wgid % nig) % gsz); u.pn = (wgid % nig) / gsz; return true;
    }
    __device__ __forceinline__ void a_ready(const Unit&) const {}
    __device__ __forceinline__ void done(const Unit&) const {}
};

__device__ __forceinline__ unsigned cvt_pk_bf16(float lo, float hi) { unsigned r; asm volatile("v_cvt_pk_bf16_f32 %0, %1, %2" : "=v"(r) : "v"(lo), "v"(hi)); return r; }
typedef float f32x2 __attribute__((ext_vector_type(2)));
__device__ __forceinline__ f32x2 gelu_pk(f32x2 v) {
    const f32x2 av = __builtin_elementwise_abs(v), d = av * 0.2316418882f + 1.0f;
    f32x2 t; t.x = __builtin_amdgcn_rcpf(d.x); t.y = __builtin_amdgcn_rcpf(d.y);
    f32x2 q = t * 0.5307027145f + (-0.7265760135f); q = q * t + 0.7107068705f; q = q * t + (-0.142248368f); q = q * t + 0.127414796f; q = q * t;
    const f32x2 s = (v * v) * (-0.72134752044f);
    f32x2 e; e.x = __builtin_amdgcn_exp2f(s.x); e.y = __builtin_amdgcn_exp2f(s.y);
    const f32x2 m = v * (q * e), r = v - m;
    f32x2 o; o.x = v.x < 0.f ? m.x : r.x; o.y = v.y < 0.f ? m.y : r.y; return o;
}

template <int ACT  > struct EpiBf16 {
    static constexpr bool PERM = true, AFTER_DRAIN = false; static_assert(ACT == 0 || ACT == 1, "EpiBf16: ACT is 0 (none) or 1 (gelu_pk)");
    bf16_t* O; int ldc; const float* bias; int split_cols; size_t split_stride; float scale0;
    __device__ __forceinline__ void operator()(const f32x4 (&acc)[2][2][4][2], const Unit& u, int wr, int wc, int fr, int fq) const {
        const int row0 = u.pm * BM + wr * 64 + fr; int colt = u.pn * BM; bf16_t* base = O;
        float sc = 1.f; if (split_cols) { const int t = colt / split_cols; base += (size_t)t * split_stride; colt -= t * split_cols; if (t == 0) sc = scale0; }
        const int col0 = colt + wc * 32 + 8 * fq, bcol0 = u.pn * BM + wc * 32 + 8 * fq;
        f32x4 bv[2][2];
#pragma unroll
        for (int bj = 0; bj < 2; ++bj)
#pragma unroll
            for (int n = 0; n < 2; ++n) bv[bj][n] = bias ? *(const f32x4*)(bias + bcol0 + bj * HALF + 4 * n) : (f32x4){0.f, 0.f, 0.f, 0.f};
#pragma unroll
        for (int ai = 0; ai < 2; ++ai)
#pragma unroll
            for (int m = 0; m < 4; ++m) { bf16_t* rowp = base + (size_t)(row0 + ai * HALF + m * 16) * ldc + col0;
#pragma unroll
                for (int bj = 0; bj < 2; ++bj) { f32x4 v0 = acc[ai][bj][m][0] + bv[bj][0], v1 = acc[ai][bj][m][1] + bv[bj][1];
                    if (ACT == 1) { f32x2 a = gelu_pk((f32x2){v0[0], v0[1]}), b = gelu_pk((f32x2){v0[2], v0[3]}), c = gelu_pk((f32x2){v1[0], v1[1]}), d = gelu_pk((f32x2){v1[2], v1[3]});
                        v0 = (f32x4){a.x, a.y, b.x, b.y}; v1 = (f32x4){c.x, c.y, d.x, d.y}; }
                    v0 = v0 * sc; v1 = v1 * sc; u32x4 w; w.x = cvt_pk_bf16(v0[0], v0[1]); w.y = cvt_pk_bf16(v0[2], v0[3]); w.z = cvt_pk_bf16(v1[0], v1[1]); w.w = cvt_pk_bf16(v1[2], v1[3]);
                    *(u32x4*)(rowp + bj * HALF) = w; } }
    }
};
template <class Epi, class Sched, bool ALIGN_EPI = false, bool SP2 = false>
__device__ __forceinline__ void gemm_phase(PG8_LAS unsigned char* lds, const Gemm g, const Sched& S, const Epi& E) {
    int tid_ = threadIdx.x; asm volatile("" : "+v"(tid_));
    const int tid = tid_, wid = __builtin_amdgcn_readfirstlane(tid >> 6), lane = tid & 63, wr = wid >> 2, wc = wid & 3, fr = lane & 15, fq = lane >> 4;
    const int K = g.K, nt = K / BK;
    unsigned voffA[2], voffB[2];
#pragma unroll
    for (int i = 0; i < 2; ++i) { int R, C; stage_rc(tid * 16 + i * 8192, R, C); const int Rb = Epi::PERM ? ((R & ~31) + perm32(R & 31)) : R;
        voffA[i] = (unsigned)(R * K + C) * 2u; voffB[i] = (unsigned)(Rb * K + C) * 2u; }
    const size_t kstep = (size_t)(BK * 2);
    const size_t hstep = (size_t)HALF * K * 2;
    const size_t tstep = 2 * hstep;
    const unsigned ldsw = (unsigned)wid * 1024u;
    const int aoff = lds_byte(wr * 64 + fr, fq * 8), boff = lds_byte(wc * 32 + fr, fq * 8);
#define PG8_SA(b, h) (((b) * 2 + (h)) * HTB)
#define PG8_SB(b, h) ((4 + (b) * 2 + (h)) * HTB)
#define PG8_STAGE(bufoff, gbase, voff) do { _Pragma("unroll") for (int _i = 0; _i < 2; ++_i) \
        __builtin_amdgcn_global_load_lds((const unsigned*)((const char*)(gbase) + (voff)[_i]), (PG8_LAS unsigned*)(lds + (bufoff) + ldsw + _i * 8192), 16, 0, 0); } while (0)
#define PG8_LDA(dst, b, h) do { _Pragma("unroll") for (int m = 0; m < 4; ++m) _Pragma("unroll") for (int k = 0; k < 2; ++k) dst[m][k] = *(const PG8_LAS bf16x8*)(lds + PG8_SA(b, h) + aoff + m * 2048 + k * 1024); } while (0)
#define PG8_LDB(dst, b, h) do { _Pragma("unroll") for (int n = 0; n < 2; ++n) _Pragma("unroll") for (int k = 0; k < 2; ++k) dst[n][k] = *(const PG8_LAS bf16x8*)(lds + PG8_SB(b, h) + boff + n * 2048 + k * 1024); } while (0)
#define PG8_MMA(ai, bj, At, Bt) do { __builtin_amdgcn_s_setprio(1); _Pragma("unroll") for (int m = 0; m < 4; ++m) _Pragma("unroll") for (int n = 0; n < 2; ++n) _Pragma("unroll") for (int k = 0; k < 2; ++k) \
        acc[ai][bj][m][n] = __builtin_amdgcn_mfma_f32_16x16x32_bf16(Bt[n][k], At[m][k], acc[ai][bj][m][n], 0, 0, 0); __builtin_amdgcn_s_setprio(0); } while (0)
#define PG8_WAIT_V(n) asm volatile("s_waitcnt vmcnt(" #n ")" ::: "memory")
#define PG8_WAIT_L(n) asm volatile("s_waitcnt lgkmcnt(" #n ")" ::: "memory")
#define PG8_BAR __builtin_amdgcn_s_barrier()
#define PG8_SCHED __builtin_amdgcn_sched_barrier(0)
    Unit cur, nxt; int ui = 0;
    if (!S.next(0, cur)) return;
    f32x4 acc[2][2][4][2];
#pragma unroll
    for (int a = 0; a < 2; ++a)
#pragma unroll
        for (int b = 0; b < 2; ++b)
#pragma unroll
            for (int m = 0; m < 4; ++m)
#pragma unroll
                for (int n = 0; n < 2; ++n) acc[a][b][m][n] = (f32x4){0.f, 0.f, 0.f, 0.f};
    bf16x8 At[4][2], B0[2][2], B1[2][2];
    const char* cA = (const char*)g.A + (size_t)cur.pm * tstep; const char* cB = (const char*)g.Bt + (size_t)cur.pn * tstep;
    S.a_ready(cur);
    if constexpr (SP2) {
        PG8_STAGE(PG8_SB(0, 0), cB, voffB); PG8_STAGE(PG8_SB(0, 1), cB + hstep, voffB); PG8_STAGE(PG8_SA(0, 0), cA, voffA); PG8_STAGE(PG8_SA(0, 1), cA + hstep, voffA);
        if (wr == 1) PG8_BAR;
        PG8_WAIT_V(2); PG8_BAR;
        PG8_STAGE(PG8_SB(1, 0), cB + kstep, voffB); PG8_STAGE(PG8_SA(1, 0), cA + kstep, voffA); PG8_STAGE(PG8_SB(1, 1), cB + hstep + kstep, voffB);
        PG8_WAIT_V(6); PG8_BAR;
    } else {
        PG8_STAGE(PG8_SB(0, 0), cB, voffB); PG8_STAGE(PG8_SA(0, 0), cA, voffA); PG8_STAGE(PG8_SB(0, 1), cB + hstep, voffB); PG8_STAGE(PG8_SA(0, 1), cA + hstep, voffA);
        if (wr == 1) PG8_BAR;
        PG8_WAIT_V(4); PG8_BAR;
        PG8_STAGE(PG8_SB(1, 0), cB + kstep, voffB); PG8_STAGE(PG8_SA(1, 0), cA + kstep, voffA); PG8_STAGE(PG8_SB(1, 1), cB + hstep + kstep, voffB);
        PG8_WAIT_V(6); PG8_BAR;
    }
    for (;;) {
        const bool has_next = S.next(ui + 1, nxt);
        const char* nA = has_next ? (const char*)g.A + (size_t)nxt.pm * tstep : cA; const char* nB = has_next ? (const char*)g.Bt + (size_t)nxt.pn * tstep : cB;
        for (int t = 0; t < nt; t += 2) {
            const bool last = (t == nt - 2);
            const char* a1 = cA + (size_t)(t + 1) * kstep;
            const char* a2 = last ? nA : cA + (size_t)(t + 2) * kstep; const char* b2 = last ? nB : cB + (size_t)(t + 2) * kstep;
            const char* a3 = a2 + kstep; const char* b3 = b2 + kstep;
            if (last && has_next) S.a_ready(nxt);
            if constexpr (SP2) {
            PG8_LDB(B0, 0, 0); PG8_LDB(B1, 0, 1); PG8_SCHED; PG8_LDA(At, 0, 0); PG8_STAGE(PG8_SA(1, 1), a1 + hstep, voffA);
            PG8_WAIT_V(8); PG8_WAIT_L(0); PG8_BAR; PG8_MMA(0, 0, At, B0); PG8_MMA(0, 1, At, B1); PG8_BAR; PG8_SCHED;
            PG8_LDA(At, 0, 1); PG8_STAGE(PG8_SB(0, 0), b2, voffB); PG8_STAGE(PG8_SB(0, 1), b2 + hstep, voffB); PG8_STAGE(PG8_SA(0, 0), a2, voffA);
            PG8_WAIT_V(8); PG8_WAIT_L(0); PG8_BAR; PG8_MMA(1, 0, At, B0); PG8_MMA(1, 1, At, B1); PG8_BAR; PG8_SCHED;
            PG8_LDB(B0, 1, 0); PG8_LDB(B1, 1, 1); PG8_SCHED; PG8_LDA(At, 1, 0); PG8_STAGE(PG8_SA(0, 1), a2 + hstep, voffA);
            PG8_WAIT_V(8); PG8_WAIT_L(0); PG8_BAR; PG8_MMA(0, 0, At, B0); PG8_MMA(0, 1, At, B1); PG8_BAR; PG8_SCHED;
            PG8_LDA(At, 1, 1); PG8_STAGE(PG8_SB(1, 0), b3, voffB); PG8_STAGE(PG8_SB(1, 1), b3 + hstep, voffB); PG8_STAGE(PG8_SA(1, 0), a3, voffA);
            PG8_WAIT_V(8); PG8_WAIT_L(0); PG8_BAR; PG8_MMA(1, 0, At, B0); PG8_MMA(1, 1, At, B1); PG8_BAR; PG8_SCHED;
            } else {
            PG8_LDB(B0, 0, 0); PG8_SCHED; PG8_LDA(At, 0, 0); PG8_STAGE(PG8_SA(1, 1), a1 + hstep, voffA);
            PG8_WAIT_L(8); PG8_BAR; PG8_WAIT_L(0); PG8_MMA(0, 0, At, B0); PG8_BAR; PG8_SCHED;
            PG8_LDB(B1, 0, 1); PG8_STAGE(PG8_SB(0, 0), b2, voffB);
            PG8_BAR; PG8_WAIT_L(0); PG8_MMA(0, 1, At, B1); PG8_BAR;
            PG8_LDA(At, 0, 1); PG8_STAGE(PG8_SA(0, 0), a2, voffA);
            PG8_BAR; PG8_WAIT_L(0); PG8_MMA(1, 0, At, B0); PG8_BAR; PG8_SCHED;
            PG8_STAGE(PG8_SB(0, 1), b2 + hstep, voffB);
            PG8_WAIT_V(6); PG8_BAR; PG8_MMA(1, 1, At, B1); PG8_BAR;
            PG8_LDB(B0, 1, 0); PG8_SCHED; PG8_LDA(At, 1, 0); PG8_STAGE(PG8_SA(0, 1), a2 + hstep, voffA);
            PG8_WAIT_L(8); PG8_BAR; PG8_WAIT_L(0); PG8_MMA(0, 0, At, B0); PG8_BAR; PG8_SCHED;
            PG8_LDB(B1, 1, 1); PG8_STAGE(PG8_SB(1, 0), b3, voffB);
            PG8_BAR; PG8_WAIT_L(0); PG8_MMA(0, 1, At, B1); PG8_BAR;
            PG8_LDA(At, 1, 1); PG8_STAGE(PG8_SA(1, 0), a3, voffA);
            PG8_BAR; PG8_WAIT_L(0); PG8_MMA(1, 0, At, B0); PG8_BAR; PG8_SCHED;
            PG8_STAGE(PG8_SB(1, 1), b3 + hstep, voffB);
            PG8_WAIT_V(6); PG8_BAR; PG8_MMA(1, 1, At, B1); PG8_BAR;
            }
        }
        if constexpr (ALIGN_EPI) { if (wr == 0) PG8_BAR; }
        if constexpr (!Epi::AFTER_DRAIN) { E(acc, cur, wr, wc, fr, fq); S.done(cur); }
        if (!has_next) break;
#pragma unroll
        for (int a = 0; a < 2; ++a)
#pragma unroll
            for (int b = 0; b < 2; ++b)
#pragma unroll
                for (int m = 0; m < 4; ++m)
#pragma unroll
                    for (int n = 0; n < 2; ++n) acc[a][b][m][n] = (f32x4){0.f, 0.f, 0.f, 0.f};
        cur = nxt; cA = nA; cB = nB; ++ui;
        if constexpr (ALIGN_EPI) { if (wr == 1) PG8_BAR; }
    }
    PG8_WAIT_V(0);
    if constexpr (!ALIGN_EPI) { if (wr == 0) PG8_BAR; }
    PG8_BAR;
    if constexpr (Epi::AFTER_DRAIN) { E.fused(acc, cur, wr, wc, fr, fq, lds, wid, lane); S.done(cur); }
#undef PG8_SA
#undef PG8_SB
#undef PG8_STAGE
#undef PG8_LDA
#undef PG8_LDB
#undef PG8_MMA
#undef PG8_WAIT_V
#undef PG8_WAIT_L
#undef PG8_BAR
#undef PG8_SCHED
}
}

namespace hy {
#define GAS __attribute__((address_space(1)))
#define LAS __attribute__((address_space(3)))
typedef unsigned short bf16;
typedef unsigned v4u __attribute__((ext_vector_type(4)));
typedef float f32x4 __attribute__((ext_vector_type(4)));
typedef short bf16x8 __attribute__((ext_vector_type(8)));
typedef GAS unsigned gu32;
typedef GAS unsigned long long gu64;
#define RLX_AGENT __ATOMIC_RELAXED, __HIP_MEMORY_SCOPE_AGENT
#define LDS_WAIT() asm volatile("s_waitcnt lgkmcnt(0)" ::: "memory")
#define VM_WAIT() asm volatile("s_waitcnt vmcnt(0)" ::: "memory")
__device__ __forceinline__ unsigned long long rt() { return __builtin_amdgcn_s_memrealtime(); }
__device__ __forceinline__ unsigned f2bf(float f) { unsigned u = __builtin_bit_cast(unsigned, f); return (u + 0x7fffu + ((u >> 16) & 1u)) >> 16; }
__device__ __forceinline__ unsigned pk2(float lo, float hi) { return f2bf(lo) | (f2bf(hi) << 16); }
#define XB_TMO      128
#define XB_XCNT(j)  (256  + 64 * (j))
#define XB_XSUB(j)  (1280 + 64 * (j))
#define XB_XGEN(j)  (2304 + 64 * (j))
#define XB_TOP      3328
#define XB_TOPGEN   3392
#define XCD_BAR_WORDS 3456
#define XB_SPIN_CAP (1u << 18)

__device__ __forceinline__ unsigned xb_ld(unsigned* p)              { return __hip_atomic_load(p, __ATOMIC_RELAXED, __HIP_MEMORY_SCOPE_AGENT); }
__device__ __forceinline__ unsigned xb_add(unsigned* p, unsigned v) { return __hip_atomic_fetch_add(p, v, __ATOMIC_RELAXED, __HIP_MEMORY_SCOPE_AGENT); }
__device__ __forceinline__ unsigned xb_xcc_id() { return (unsigned)__builtin_amdgcn_s_getreg((3 << 11) | 20) & 0xFu; }
#define XB_SPIN(cond, bar) do { unsigned _sp = 0; while (cond) { __builtin_amdgcn_s_sleep(1); \
    if ((++_sp & 255u) == 0u) { if (xb_ld(&(bar)[XB_TMO])) break; if (_sp > XB_SPIN_CAP) { atomicAdd(&(bar)[XB_TMO], 1u); break; } } } } while (0)

struct XcdBarrier {
    unsigned* bar; unsigned x;
    volatile LAS unsigned* st;
};

__device__ __forceinline__ XcdBarrier xcd_barrier_post(unsigned* bar, volatile LAS unsigned* st) {
    XcdBarrier b; b.bar = bar; b.x = xb_xcc_id(); b.st = st;
    if (threadIdx.x == 0) (void)xb_add(&bar[XB_XCNT(b.x)], 1u);
    return b;
}
__device__ __forceinline__ void xcd_barrier_complete(unsigned* bar, unsigned x, unsigned& nloc, unsigned& nx) {
    const unsigned G = gridDim.x * gridDim.y * gridDim.z;
    unsigned sum, cnt, mine, sp = 0u;
    for (;;) {
        sum = 0u; cnt = 0u; mine = 0u;
#pragma unroll
        for (unsigned j = 0; j < 16; ++j) { const unsigned c = xb_ld(&bar[XB_XCNT(j)]); sum += c; cnt += (c > 0u) ? 1u : 0u; mine = (j == x) ? c : mine; }
        if (sum == G) break;
        __builtin_amdgcn_s_sleep(1);
        if ((++sp & 255u) == 0u) { if (xb_ld(&bar[XB_TMO])) break; if (sp > XB_SPIN_CAP) { atomicAdd(&bar[XB_TMO], 1u); break; } }
    }
    nloc = mine > 0u ? mine : 1u; nx = cnt > 0u ? cnt : 1u;
}

__device__ __forceinline__ void xcd_barrier(const XcdBarrier& b) {
    asm volatile("s_waitcnt vmcnt(0)" ::: "memory");
    __syncthreads();
    if (threadIdx.x == 0) {
        unsigned* bar = b.bar;
        __builtin_amdgcn_s_waitcnt(0);
        unsigned nloc = b.st[0], nx = b.st[1];
        if (nloc == 0u) { xcd_barrier_complete(bar, b.x, nloc, nx); b.st[0] = nloc; b.st[1] = nx; }
        const unsigned old = xb_add(&bar[XB_XSUB(b.x)], 1u);
        const unsigned gen = old / nloc;
        if (old + 1u == (gen + 1u) * nloc) {
            __builtin_amdgcn_fence(__ATOMIC_RELEASE, "agent");
            asm volatile("s_waitcnt vmcnt(0)" ::: "memory");
            const unsigned og = xb_add(&bar[XB_TOP], 1u);
            const unsigned tg = og / nx;
            if (og + 1u == (tg + 1u) * nx) xb_add(&bar[XB_TOPGEN], 1u);
            else XB_SPIN(xb_ld(&bar[XB_TOPGEN]) == tg, bar);
            __builtin_amdgcn_fence(__ATOMIC_ACQUIRE, "agent");
            xb_add(&bar[XB_XGEN(b.x)], 1u);
            asm volatile("s_waitcnt vmcnt(0)" ::: "memory");
        } else {
            XB_SPIN(xb_ld(&bar[XB_XGEN(b.x)]) == gen, bar);
            __builtin_amdgcn_fence(__ATOMIC_ACQUIRE, "agent");
            asm volatile("s_waitcnt vmcnt(0)" ::: "memory");
        }
    }
    __syncthreads();
}

constexpr int B_ = 4, T_ = 8192, D_ = 1024, M_ = B_ * T_, L_ = 2;
constexpr int NIN = 3584, NPG = 1792, NPR = 1792;
constexpr int DFF = 2816, NUP = 5632, IN_COLS = 3344;
constexpr size_t MiB = 1u << 20;
constexpr size_t WS_CTL = 0, CTL_ZERO_BYTES = 65536;
constexpr int CW_BAR = 4096;
constexpr size_t WS_RK = MiB / 4;
constexpr size_t WS_MOD = 3 * MiB / 2;
constexpr size_t WS_WIN = 2 * MiB, WS_WOUT = 9 * MiB, WS_WUP = 11 * MiB, WS_WDN = 22 * MiB, WS_LORA = 55 * MiB / 2, WS_GAMC = 28 * MiB, WS_VL = 29 * MiB;
constexpr size_t WS_GAM = 31 * MiB;
constexpr size_t WS_XB = 32 * MiB, WS_O = 96 * MiB, WS_VF = 160 * MiB, WS_GK = 192 * MiB, WS_PG = 224 * MiB, WS_PR = 336 * MiB, WS_END = 512 * MiB;
constexpr size_t WS_RH = WS_XB, WS_YH = WS_XB + 32 * MiB, WS_PP = WS_O, WS_QQ = WS_O + 32 * MiB, WS_GG = 448 * MiB, WS_S0 = 480 * MiB;
constexpr size_t WS_ACT = 224 * MiB, WS_U = 400 * MiB;
constexpr int RING_BYTES = 131072, MISC_OFF = 139264, LDS_BYTES = 147456;
constexpr int NT = 512;

__device__ __forceinline__ float bf2f(bf16 h) { return __builtin_bit_cast(float, (unsigned)h << 16); }
__device__ __forceinline__ float sigmoidf_(float x) { return 1.f / (1.f + __expf(-x)); }
__device__ __forceinline__ float siluf_(float x) { return x / (1.f + __expf(-x)); }
__device__ __forceinline__ float softplusf_(float x) { return fmaxf(x, 0.f) + log1pf(__expf(-fabsf(x))); }

typedef unsigned u32x2 __attribute__((ext_vector_type(2)));
template <int CTRL> __device__ __forceinline__ float dpp_f(float v) {
    return __builtin_bit_cast(float, __builtin_amdgcn_update_dpp(0, __builtin_bit_cast(int, v), CTRL, 0xf, 0xf, false));
}
__device__ __forceinline__ float wave_sum(float v) {
    v += dpp_f<0xB1>(v);
    v += dpp_f<0x4E>(v);
    v += dpp_f<0x141>(v);
    v += dpp_f<0x140>(v);
    v += __builtin_bit_cast(float, __builtin_amdgcn_update_dpp(0, __builtin_bit_cast(int, v), 0x142, 0xa, 0xf, false));
    v += __builtin_bit_cast(float, __builtin_amdgcn_update_dpp(0, __builtin_bit_cast(int, v), 0x143, 0xc, 0xf, false));
    return __builtin_bit_cast(float, __builtin_amdgcn_readlane(__builtin_bit_cast(int, v), 63));
}

struct Ctx { int bid, nb, tid, lane, wave; LAS unsigned char* lds; };

__device__ __forceinline__ void ph_mod(const Ctx& C, const float* c, const float* ada_w, const float* ada_b, float* MOD) {
    LAS float* sc = (LAS float*)C.lds;
    LAS float* red = (LAS float*)(C.lds + 16384);
    for (int i = C.tid; i < 4096; i += NT) sc[i] = siluf_(c[i]);
    __syncthreads();
    for (int item = C.bid; item < 192; item += C.nb) {
        const int l = item / 96, j0 = (item % 96) * 64;
        const float* W = ada_w + (size_t)l * 1024 * 6144 + j0 + C.lane;
        float a0 = 0.f, a1 = 0.f, a2 = 0.f, a3 = 0.f;
        for (int k = C.wave * 128; k < C.wave * 128 + 128; ++k) { const float wv = W[(size_t)k * 6144]; a0 += sc[k] * wv; a1 += sc[1024 + k] * wv; a2 += sc[2048 + k] * wv; a3 += sc[3072 + k] * wv; }
        red[(C.wave * 4 + 0) * 64 + C.lane] = a0; red[(C.wave * 4 + 1) * 64 + C.lane] = a1; red[(C.wave * 4 + 2) * 64 + C.lane] = a2; red[(C.wave * 4 + 3) * 64 + C.lane] = a3;
        __syncthreads();
        if (C.wave < 4) { const int b = C.wave; float s = ada_b[l * 6144 + j0 + C.lane];
#pragma unroll
            for (int w = 0; w < 8; ++w) s += red[(w * 4 + b) * 64 + C.lane];
            MOD[((size_t)l * 4 + b) * 6144 + j0 + C.lane] = s; }
        __syncthreads();
    }
}

__device__ __forceinline__ void wprep_mat(const Ctx& C, const float* W, int K, int Nsrc, int Ndst, bf16* Wt, int mode, const float* vres) {
    const int half = C.tid >> 8, t = C.tid & 255, tx = t & 31, ty = t >> 5;
    LAS float* tile = (LAS float*)C.lds + half * (32 * 33);
    const int nbn = Ndst / 32, ntile = nbn * (K / 32);
    const int niter = (ntile + 2 * C.nb - 1) / (2 * C.nb);
    for (int it = 0; it < niter; ++it) {
        const int item = (it * C.nb + C.bid) * 2 + half;
        const bool act = item < ntile;
        const int n0 = (item % nbn) * 32, k0 = (item / nbn) * 32, n = n0 + tx;
        if (act) {
#pragma unroll
            for (int i = 0; i < 4; ++i) { const int k = k0 + ty + 8 * i; float v = 0.f;
                if (mode == 0) v = W[(size_t)k * Nsrc + n];
                else { if (n < 1552) v = W[(size_t)k * Nsrc + n]; else if (n < 1584) v = vres ? vres[(size_t)k * 32 + (n - 1552)] : 0.f; else if (n < 1792) v = 0.f; else v = W[(size_t)k * Nsrc + (n - 240)]; }
                tile[(ty + 8 * i) * 33 + tx] = v; }
        }
        __syncthreads();
        if (act) {
#pragma unroll
            for (int i = 0; i < 4; ++i) { const int nn = n0 + ty + 8 * i; Wt[(size_t)nn * K + k0 + tx] = (bf16)f2bf(tile[tx * 33 + ty + 8 * i]); }
        }
        __syncthreads();
    }
}

__device__ __forceinline__ void ph_norm(const Ctx& C, const float* x, const float* g, const float* sh, const float* sc, bf16* XB) {
    const int gw = C.bid * 8 + C.wave, NGW = C.nb * 8, lane = C.lane;
    for (int m = gw; m < M_; m += NGW) {
        const int b = m / T_;
        const f32x4* xr = (const f32x4*)(x + (size_t)m * D_) + lane;
        f32x4 v[4]; float s = 0.f;
#pragma unroll
        for (int j = 0; j < 4; ++j) { v[j] = xr[64 * j]; s += (v[j].x * v[j].x + v[j].y * v[j].y) + (v[j].z * v[j].z + v[j].w * v[j].w); }
        const float rstd = 1.f / sqrtf(wave_sum(s) * (1.f / D_) + 1e-6f);
        unsigned long long* o8 = (unsigned long long*)(XB + (size_t)m * D_) + lane;
#pragma unroll
        for (int j = 0; j < 4; ++j) { const int col = 4 * lane + 256 * j;
            const f32x4 gv = *(const f32x4*)(g + col), shv = *(const f32x4*)(sh + b * 6144 + col), scv = *(const f32x4*)(sc + b * 6144 + col);
            const f32x4 h = v[j] * rstd * gv * (scv + 1.f) + shv;
            o8[64 * j] = (unsigned long long)(f2bf(h.x) | (f2bf(h.y) << 16)) | ((unsigned long long)(f2bf(h.z) | (f2bf(h.w) << 16)) << 32); }
    }
}
__device__ __forceinline__ void ph_final(const Ctx& C, float* x, const float* g) {
    const int gw = C.bid * 8 + C.wave, NGW = C.nb * 8, lane = C.lane;
    for (int m = gw; m < M_; m += NGW) {
        f32x4* xr = (f32x4*)(x + (size_t)m * D_) + lane;
        f32x4 v[4]; float s = 0.f;
#pragma unroll
        for (int j = 0; j < 4; ++j) { v[j] = xr[64 * j]; s += (v[j].x * v[j].x + v[j].y * v[j].y) + (v[j].z * v[j].z + v[j].w * v[j].w); }
        const float rstd = 1.f / sqrtf(wave_sum(s) * (1.f / D_) + 1e-6f);
#pragma unroll
        for (int j = 0; j < 4; ++j) { const f32x4 gv = *(const f32x4*)(g + 4 * lane + 256 * j); xr[64 * j] = v[j] * rstd * gv; }
    }
}


typedef short s16x8 __attribute__((ext_vector_type(8)));
__device__ __forceinline__ f32x4 mm16(const LAS bf16* A, int lda, const LAS bf16* B, int ldb, int K, f32x4 acc, int lane) {
    const int r = lane & 15, g = lane >> 4;
    const LAS bf16* ap = A + r * lda + 8 * g; const LAS bf16* bp = B + r * ldb + 8 * g;
    for (int k0 = 0; k0 < K; k0 += 32) { const s16x8 a = *(const LAS s16x8*)(ap + k0); const s16x8 b = *(const LAS s16x8*)(bp + k0); acc = __builtin_amdgcn_mfma_f32_16x16x32_bf16(a, b, acc, 0, 0, 0); }
    return acc;
}
__device__ __forceinline__ f32x4 mm16_ga(const bf16* A, int lda, const LAS bf16* B, int ldb, int K, f32x4 acc, int lane) {
    const int r = lane & 15, g = lane >> 4;
    const bf16* ap = A + r * lda + 8 * g; const LAS bf16* bp = B + r * ldb + 8 * g;
    for (int k0 = 0; k0 < K; k0 += 32) { const s16x8 a = *(const s16x8*)(ap + k0); const s16x8 b = *(const LAS s16x8*)(bp + k0); acc = __builtin_amdgcn_mfma_f32_16x16x32_bf16(a, b, acc, 0, 0, 0); }
    return acc;
}
__device__ __forceinline__ unsigned long long pack4(f32x4 v) { return (unsigned long long)(f2bf(v.x) | (f2bf(v.y) << 16)) | ((unsigned long long)(f2bf(v.z) | (f2bf(v.w) << 16)) << 32); }
__device__ __forceinline__ float logsigmoidf_(float x) { return fminf(x, 0.f) - log1pf(__expf(-fabsf(x))); }

constexpr int GL_LD = 72;
constexpr int GL_GK = 0;
constexpr int GL_SEG = 16384;
constexpr int GL_Z = 18432;
constexpr int GL_GUP = 20480;
constexpr int GL_I0 = 24832;
constexpr int GL_I1 = GL_I0 + 9216;
constexpr int GL_I2 = GL_I1 + 9216;
constexpr int GL_VT = GL_I2 + 9216;
constexpr int GL_SSQ = GL_VT + 18432;
static_assert(GL_SSQ + 512 <= RING_BYTES, "GLA LDS map");

__device__ __forceinline__ void gla_gates(const Ctx& C, const bf16* pg  , const float* gk_up, const float* gk_b, int h) {
    LAS float* GK = (LAS float*)(C.lds + GL_GK); LAS float* SEG = (LAS float*)(C.lds + GL_SEG); LAS bf16* Z = (LAS bf16*)(C.lds + GL_Z); LAS float* GUP = (LAS float*)(C.lds + GL_GUP);
    const int tid = C.tid;
    if (tid < 128) { const int t = tid >> 1, hh = tid & 1; *(LAS v4u*)(Z + t * 16 + hh * 8) = *(const v4u*)(pg + (size_t)t * NPG + 1536 + hh * 8); }
    for (int i = tid; i < 16 * 64; i += NT) GUP[i] = gk_up[(i >> 6) * 256 + h * 64 + (i & 63)];
    if (tid < 64) GUP[1024 + tid] = gk_b[h * 64 + tid];
    __syncthreads();
    { const int t = tid >> 3, d0 = (tid & 7) * 8; float a[8];
#pragma unroll
      for (int q = 0; q < 8; ++q) a[q] = GUP[1024 + d0 + q];
#pragma unroll
      for (int i = 0; i < 16; ++i) { const float zv = bf2f(Z[t * 16 + i]);
#pragma unroll
          for (int q = 0; q < 8; ++q) a[q] += zv * GUP[i * 64 + d0 + q]; }
#pragma unroll
      for (int q = 0; q < 8; ++q) GK[t * 64 + d0 + q] = logsigmoidf_(a[q]) * (1.f / 16.f); }
    __syncthreads();
    { const int d = tid & 63, seg = tid >> 6; float run = 0.f;
#pragma unroll
      for (int q = 0; q < 8; ++q) { run += GK[(seg * 8 + q) * 64 + d]; GK[(seg * 8 + q) * 64 + d] = run; }
      SEG[seg * 64 + d] = run; }
    __syncthreads();
    { const int d = tid & 63, seg = tid >> 6; float off = 0.f;
      for (int s = 0; s < seg; ++s) off += SEG[s * 64 + d];
#pragma unroll
      for (int q = 0; q < 8; ++q) GK[(seg * 8 + q) * 64 + d] += off; }
    __syncthreads();
}
__device__ __forceinline__ void gla_stage_vt(const Ctx& C, const bf16* pg, int h) {
    LAS bf16* VT = (LAS bf16*)(C.lds + GL_VT);
    const int j = C.tid >> 3, e0 = (C.tid & 7) * 16;
    const v4u x0 = *(const v4u*)(pg + (size_t)j * NPG + 512 + h * 128 + e0), x1 = *(const v4u*)(pg + (size_t)j * NPG + 512 + h * 128 + e0 + 8);
    const unsigned w[8] = {x0.x, x0.y, x0.z, x0.w, x1.x, x1.y, x1.z, x1.w};
#pragma unroll
    for (int q = 0; q < 8; ++q) { VT[(e0 + 2 * q) * GL_LD + j] = (bf16)(w[q] & 0xffffu); VT[(e0 + 2 * q + 1) * GL_LD + j] = (bf16)(w[q] >> 16); }
}

__device__ __forceinline__ void ph_gla_a(const Ctx& C, const bf16* PG, const float* gk_up, const float* gk_b, bf16* DS, float* GAM, bf16* VL) {
    LAS float* GK = (LAS float*)(C.lds + GL_GK); LAS bf16* KT = (LAS bf16*)(C.lds + GL_I0); LAS bf16* VT = (LAS bf16*)(C.lds + GL_VT);
    for (int item = C.bid; item < 2048; item += C.nb) {
        const int bh = item >> 7, c = item & 127, b = bh >> 2, h = bh & 3;
        const size_t m0 = (size_t)b * T_ + c * 64;
        const bf16* pg = PG + m0 * NPG;
        gla_gates(C, pg, gk_up, gk_b, h);
        { const int j = C.tid >> 3, d0 = (C.tid & 7) * 8;
          const v4u kx = *(const v4u*)(pg + (size_t)j * NPG + 256 + h * 64 + d0);
          const unsigned w[4] = {kx.x, kx.y, kx.z, kx.w};
#pragma unroll
          for (int q = 0; q < 4; ++q) { const float k0 = bf2f((bf16)(w[q] & 0xffffu)), k1 = bf2f((bf16)(w[q] >> 16));
              const int d = d0 + 2 * q;
              KT[d * GL_LD + j] = (bf16)f2bf(k0 * __expf(GK[63 * 64 + d] - GK[j * 64 + d]));
              KT[(d + 1) * GL_LD + j] = (bf16)f2bf(k1 * __expf(GK[63 * 64 + d + 1] - GK[j * 64 + d + 1])); } }
        gla_stage_vt(C, pg, h);
        if (C.tid < 64) GAM[(size_t)item * 64 + C.tid] = __expf(GK[63 * 64 + C.tid]);
        if (h == 0 && C.tid < 256) { const int t = C.tid >> 2, q = C.tid & 3; *(unsigned long long*)(VL + (m0 + t) * 32 + q * 8 + 0) = *(const unsigned long long*)(pg + (size_t)t * NPG + 1552 + q * 8);
                                     *(unsigned long long*)(VL + (m0 + t) * 32 + q * 8 + 4) = *(const unsigned long long*)(pg + (size_t)t * NPG + 1552 + q * 8 + 4); }
        __syncthreads();
        { const int n0 = C.wave * 16, lane = C.lane, cc = lane & 15, g = lane >> 4;
          bf16* out = DS + (size_t)item * 8192 + (size_t)(n0 + cc) * 64 + 4 * g;
#pragma unroll
          for (int mt = 0; mt < 4; ++mt) { f32x4 acc = {0.f, 0.f, 0.f, 0.f}; acc = mm16(KT + mt * 16 * GL_LD, GL_LD, VT + n0 * GL_LD, GL_LD, 64, acc, lane);
              *(unsigned long long*)(out + mt * 16) = pack4(acc); } }
        __syncthreads();
    }
}
__device__ __forceinline__ void ph_gla_b(const Ctx& C, bf16* DS, const float* GAM) {
    for (int idx = C.bid * NT + C.tid; idx < 16 * 8192; idx += C.nb * NT) {
        const int bh = idx >> 13, ed = idx & 8191, d = ed & 63;
        bf16* p = DS + (size_t)bh * 128 * 8192 + ed; const float* gp = GAM + (size_t)bh * 128 * 64 + d;
        float S = 0.f;
        for (int c0 = 0; c0 < 128; c0 += 8) {
            float ds[8], gm[8];
#pragma unroll
            for (int i = 0; i < 8; ++i) { ds[i] = bf2f(p[(size_t)(c0 + i) * 8192]); gm[i] = gp[(c0 + i) * 64]; }
#pragma unroll
            for (int i = 0; i < 8; ++i) { const float gs = gm[i] * S; p[(size_t)(c0 + i) * 8192] = (bf16)f2bf(gs); S = gs + ds[i]; }
        }
    }
}
__device__ __forceinline__ void ph_gla_c(const Ctx& C, const bf16* PG, const float* gk_up, const float* gk_b, const float* norm_g, const bf16* DS, bf16* O) {
    LAS float* GK = (LAS float*)(C.lds + GL_GK); LAS bf16* QP = (LAS bf16*)(C.lds + GL_I0); LAS bf16* KM = (LAS bf16*)(C.lds + GL_I1); LAS bf16* AI = (LAS bf16*)(C.lds + GL_I2);
    LAS bf16* VT = (LAS bf16*)(C.lds + GL_VT); LAS float* SSQ = (LAS float*)(C.lds + GL_SSQ);
    for (int item = C.bid; item < 2048; item += C.nb) {
        const int bh = item >> 7, c = item & 127, b = bh >> 2, h = bh & 3;
        const size_t m0 = (size_t)b * T_ + c * 64;
        const bf16* pg = PG + m0 * NPG;
        gla_gates(C, pg, gk_up, gk_b, h);
        { const int j = C.tid >> 3, d0 = (C.tid & 7) * 8;
          const v4u qx = *(const v4u*)(pg + (size_t)j * NPG + h * 64 + d0), kx = *(const v4u*)(pg + (size_t)j * NPG + 256 + h * 64 + d0);
          const unsigned qw[4] = {qx.x, qx.y, qx.z, qx.w}, kw[4] = {kx.x, kx.y, kx.z, kx.w};
          unsigned qo[4], ko[4];
#pragma unroll
          for (int q = 0; q < 4; ++q) { const int d = d0 + 2 * q;
              const float e0 = GK[63 * 64 + d] - GK[j * 64 + d], e1 = GK[63 * 64 + d + 1] - GK[j * 64 + d + 1];
              const float q0 = 0.125f * bf2f((bf16)(qw[q] & 0xffffu)) * __expf(-e0), q1 = 0.125f * bf2f((bf16)(qw[q] >> 16)) * __expf(-e1);
              const float k0 = bf2f((bf16)(kw[q] & 0xffffu)) * __expf(e0), k1 = bf2f((bf16)(kw[q] >> 16)) * __expf(e1);
              qo[q] = f2bf(q0) | (f2bf(q1) << 16); ko[q] = f2bf(k0) | (f2bf(k1) << 16); }
          *(LAS v4u*)(QP + j * GL_LD + d0) = (v4u){qo[0], qo[1], qo[2], qo[3]}; *(LAS v4u*)(KM + j * GL_LD + d0) = (v4u){ko[0], ko[1], ko[2], ko[3]}; }
        gla_stage_vt(C, pg, h);
        __syncthreads();
        { const int lane = C.lane, cc = lane & 15, g = lane >> 4, n0 = (C.wave >> 1) * 16;
#pragma unroll
          for (int q = 0; q < 2; ++q) { const int mt0 = ((C.wave & 1) * 2 + q) * 16; f32x4 acc = {0.f, 0.f, 0.f, 0.f};
              acc = mm16(KM + mt0 * GL_LD, GL_LD, QP + n0 * GL_LD, GL_LD, 64, acc, lane);
              const int i = n0 + cc, j = mt0 + 4 * g;
              acc.x = (j + 0 <= i) ? acc.x : 0.f; acc.y = (j + 1 <= i) ? acc.y : 0.f; acc.z = (j + 2 <= i) ? acc.z : 0.f; acc.w = (j + 3 <= i) ? acc.w : 0.f;
              *(LAS unsigned long long*)(AI + (n0 + cc) * GL_LD + mt0 + 4 * g) = pack4(acc); } }
        __syncthreads();
        { const int lane = C.lane, cc = lane & 15, g = lane >> 4, n0 = (C.wave & 3) * 16, eh = C.wave >> 2;
          const bf16* Sg = DS + (size_t)item * 8192;
          f32x4 acc[4]; float ss = 0.f;
#pragma unroll
          for (int mt = 0; mt < 4; ++mt) { const int e0 = eh * 64 + mt * 16; acc[mt] = (f32x4){0.f, 0.f, 0.f, 0.f};
              acc[mt] = mm16_ga(Sg + (size_t)e0 * 64, 64, QP + n0 * GL_LD, GL_LD, 64, acc[mt], lane);
              acc[mt] = mm16(VT + e0 * GL_LD, GL_LD, AI + n0 * GL_LD, GL_LD, 64, acc[mt], lane);
              ss += (acc[mt].x * acc[mt].x + acc[mt].y * acc[mt].y) + (acc[mt].z * acc[mt].z + acc[mt].w * acc[mt].w); }
          ss += __shfl_xor(ss, 16); ss += __shfl_xor(ss, 32);
          if (g == 0) SSQ[eh * 64 + n0 + cc] = ss;
          __syncthreads();
          const float rstd = 1.f / sqrtf((SSQ[n0 + cc] + SSQ[64 + n0 + cc]) * (1.f / 128.f) + 1e-6f);
          const size_t m = m0 + n0 + cc;
#pragma unroll
          for (int mt = 0; mt < 4; ++mt) { const int e = eh * 64 + mt * 16 + 4 * g;
              const unsigned long long gx = *(const unsigned long long*)(pg + (size_t)(n0 + cc) * NPG + 1024 + h * 128 + e);
              const f32x4 ng = *(const f32x4*)(norm_g + e);
              f32x4 o;
              o.x = acc[mt].x * rstd * ng.x * siluf_(bf2f((bf16)(gx & 0xffffu)));
              o.y = acc[mt].y * rstd * ng.y * siluf_(bf2f((bf16)((gx >> 16) & 0xffffu)));
              o.z = acc[mt].z * rstd * ng.z * siluf_(bf2f((bf16)((gx >> 32) & 0xffffu)));
              o.w = acc[mt].w * rstd * ng.w * siluf_(bf2f((bf16)(gx >> 48)));
              *(unsigned long long*)(O + m * D_ + h * 128 + e) = pack4(o); } }
        __syncthreads();
    }
}


struct RwkvW { const float *mu, *mu_vres, *w0, *a0, *v0, *k_k, *k_a, *r_k; const bf16 *wupT, *aupT, *gupT, *vupT; };
constexpr int RW_LD = 72, RW_XLD = 296, RW_FLD = 68;
constexpr int RW_R0 = 0;
constexpr int RW_SEG = 16384;
constexpr int RW_R1 = 37888;
constexpr int RW_R2 = RW_R1 + 27648;
constexpr int RW_R3 = RW_R2 + 9216;
constexpr int RW_R4 = RW_R3 + 27648;
constexpr int RW_END = RW_R4 + 128 * RW_FLD * 4;
static_assert(RW_END <= RING_BYTES + 8192 && RW_END <= MISC_OFF, "RWKV LDS map");

__device__ __forceinline__ float sum8(float v) { v += dpp_f<0xB1>(v); v += dpp_f<0x4E>(v); v += dpp_f<0x141>(v); return v; }
__device__ __forceinline__ void unpack8(const v4u x, float (&o)[8]) {
    o[0] = bf2f((bf16)(x.x & 0xffffu)); o[1] = bf2f((bf16)(x.x >> 16)); o[2] = bf2f((bf16)(x.y & 0xffffu)); o[3] = bf2f((bf16)(x.y >> 16));
    o[4] = bf2f((bf16)(x.z & 0xffffu)); o[5] = bf2f((bf16)(x.z >> 16)); o[6] = bf2f((bf16)(x.w & 0xffffu)); o[7] = bf2f((bf16)(x.w >> 16)); }
__device__ __forceinline__ v4u pack8(const float (&o)[8]) { return (v4u){f2bf(o[0]) | (f2bf(o[1]) << 16), f2bf(o[2]) | (f2bf(o[3]) << 16), f2bf(o[4]) | (f2bf(o[5]) << 16), f2bf(o[6]) | (f2bf(o[7]) << 16)}; }
__device__ __forceinline__ f32x4 mm16_gb(const LAS bf16* A, int lda, const bf16* B, int ldb, int K, f32x4 acc, int lane) {
    const int r = lane & 15, g = lane >> 4;
    const LAS bf16* ap = A + r * lda + 8 * g; const bf16* bp = B + r * ldb + 8 * g;
    for (int k0 = 0; k0 < K; k0 += 32) { const s16x8 a = *(const LAS s16x8*)(ap + k0); const s16x8 b = *(const s16x8*)(bp + k0); acc = __builtin_amdgcn_mfma_f32_16x16x32_bf16(a, b, acc, 0, 0, 0); }
    return acc;
}

__device__ __forceinline__ void ph_rwkv_a(const Ctx& C, const bf16* PR, const bf16* VL  , const RwkvW& W, int layer,
                                          bf16* PP, bf16* QQ, bf16* RH, bf16* YH, float* GAMC, float* RK, bf16* GG, bf16* VF, bool store_v = true) {
    LAS unsigned char* L = C.lds;
    LAS bf16* X = (LAS bf16*)(L + RW_R0); LAS float* CUM = (LAS float*)(L + RW_R0); LAS float* SEG = (LAS float*)(L + RW_SEG);
    LAS bf16* NI = (LAS bf16*)(L + RW_R0), *AAK = NI + 64 * RW_LD, *ARB = AAK + 64 * RW_LD, *ARK = ARB + 64 * RW_LD;
    LAS bf16* PRE = (LAS bf16*)(L + RW_R1);
    LAS bf16* AT = (LAS bf16*)(L + RW_R1), *BT = AT + 64 * RW_LD, *KT = BT + 64 * RW_LD, *RT = (LAS bf16*)(L + RW_R2);
    LAS bf16* XB16 = (LAS bf16*)(L + RW_R1);
    LAS bf16* BHc = (LAS bf16*)(L + RW_R3), *KHc = BHc + 64 * RW_LD, *VTc = KHc + 64 * RW_LD;
    LAS float* XT = (LAS float*)(L + RW_R4);
    const int tid = C.tid, lane = C.lane, wave = C.wave, cc = lane & 15, g = lane >> 4;
    for (int item = C.bid; item < 4096; item += C.nb) {
        const int h = item & 7, c = (item >> 3) & 127, b = item >> 10;
        const size_t m0 = (size_t)b * T_ + c * 64;
        for (int idx = tid; idx < 64 * 36; idx += NT) {
            const int t = idx / 36, q = idx % 36, col = q * 8; const size_t m = m0 + t; const bool first = (c == 0 && t == 0);
            v4u cur, prv; float mu[8];
            if (q < 32) { cur = *(const v4u*)(PR + m * NPR + 1536 + col); prv = first ? (v4u){0u, 0u, 0u, 0u} : *(const v4u*)(PR + (m - 1) * NPR + 1536 + col);
#pragma unroll
                for (int i = 0; i < 8; ++i) mu[i] = W.mu[1536 + col + i]; }
            else if (layer) { cur = *(const v4u*)(VL + m * NPG + 1552 + (col - 256)); prv = first ? (v4u){0u, 0u, 0u, 0u} : *(const v4u*)(VL + (m - 1) * NPG + 1552 + (col - 256));
#pragma unroll
                for (int i = 0; i < 8; ++i) mu[i] = W.mu_vres[col - 256 + i]; }
            else { cur = (v4u){0u, 0u, 0u, 0u}; prv = cur;
#pragma unroll
                for (int i = 0; i < 8; ++i) mu[i] = 0.f; }
            float cv[8], pv[8]; unpack8(cur, cv); unpack8(prv, pv);
#pragma unroll
            for (int i = 0; i < 8; ++i) { float p = cv[i] + (pv[i] - cv[i]) * mu[i]; if (q < 8) p = tanhf(p); else if (q >= 16 && q < 32) p = sigmoidf_(p); cv[i] = p; }
            *(LAS v4u*)(X + t * RW_XLD + col) = pack8(cv);
        }
        __syncthreads();
        {
            const int lsel = wave >> 1;
            const bf16* WT = lsel == 0 ? W.wupT : lsel == 1 ? W.aupT : lsel == 2 ? W.gupT : W.vupT;
            const int Kl = lsel == 2 ? 128 : lsel == 3 ? 32 : 64, xoff = lsel == 0 ? 0 : lsel == 1 ? 64 : lsel == 2 ? 128 : 256;
            LAS bf16* outp = PRE + lsel * 64 * RW_LD;
#pragma unroll 1
            for (int q = 0; q < 8; ++q) { const int tile = (wave & 1) * 8 + q, mt = tile >> 2, nt = tile & 3;
                f32x4 acc = {0.f, 0.f, 0.f, 0.f};
                if (lsel != 3 || layer) {
                    const bf16* ap = WT + (size_t)(h * 64 + mt * 16 + cc) * Kl + 8 * g; const LAS bf16* bp = X + (nt * 16 + cc) * RW_XLD + xoff + 8 * g;
                    for (int k0 = 0; k0 < Kl; k0 += 32) { const s16x8 a = *(const s16x8*)(ap + k0); const s16x8 bb = *(const LAS s16x8*)(bp + k0); acc = __builtin_amdgcn_mfma_f32_16x16x32_bf16(a, bb, acc, 0, 0, 0); }
                }
                *(LAS unsigned long long*)(outp + (nt * 16 + cc) * RW_LD + mt * 16 + 4 * g) = pack4(acc); }
        }
        __syncthreads();
        const int t = tid >> 3, d0 = (tid & 7) * 8, ch = h * 64 + d0; const size_t m = m0 + t; const bool first = (c == 0 && t == 0);
        float av[8], bv[8], kv[8], rv[8], lw[8], vv[8];
        {
            float rc[8], rp[8], kc[8], kp[8], vc[8], vp[8], pw[8], pa[8], pg_[8], pvg[8];
            unpack8(*(const v4u*)(PR + m * NPR + ch), rc); unpack8(*(const v4u*)(PR + m * NPR + 512 + ch), kc); unpack8(*(const v4u*)(PR + m * NPR + 1024 + ch), vc);
            if (first) {
#pragma unroll
                for (int i = 0; i < 8; ++i) { rp[i] = 0.f; kp[i] = 0.f; vp[i] = 0.f; } }
            else { unpack8(*(const v4u*)(PR + (m - 1) * NPR + ch), rp); unpack8(*(const v4u*)(PR + (m - 1) * NPR + 512 + ch), kp); unpack8(*(const v4u*)(PR + (m - 1) * NPR + 1024 + ch), vp); }
            unpack8(*(const LAS v4u*)(PRE + (0 * 64 + t) * RW_LD + d0), pw); unpack8(*(const LAS v4u*)(PRE + (1 * 64 + t) * RW_LD + d0), pa);
            unpack8(*(const LAS v4u*)(PRE + (2 * 64 + t) * RW_LD + d0), pg_); unpack8(*(const LAS v4u*)(PRE + (3 * 64 + t) * RW_LD + d0), pvg);
            float vf[8];
            if (layer) unpack8(*(const v4u*)(VF + m * 512 + ch), vf);
            float ssq = 0.f, rks = 0.f, asg[8], gg[8];
#pragma unroll
            for (int i = 0; i < 8; ++i) {
                const float r = rc[i] + (rp[i] - rc[i]) * W.mu[ch + i], k = kc[i] + (kp[i] - kc[i]) * W.mu[512 + ch + i]; float v = vc[i] + (vp[i] - vc[i]) * W.mu[1024 + ch + i];
                lw[i] = -__expf(-softplusf_(-(W.w0[ch + i] + pw[i])) - 0.5f);
                asg[i] = sigmoidf_(W.a0[ch + i] + pa[i]);
                if (layer) v = v + (vf[i] - v) * sigmoidf_(W.v0[ch + i] + pvg[i]);
                const float kk = k * W.k_k[ch + i]; ssq += kk * kk;
                kv[i] = k * (1.f + (asg[i] - 1.f) * W.k_a[ch + i]); rv[i] = r; vv[i] = v; gg[i] = pg_[i]; av[i] = kk;
                rks += r * kv[i] * W.r_k[ch + i];
            }
            ssq = sum8(ssq); rks = sum8(rks);
            const float inv = 1.f / sqrtf(fmaxf(ssq, 1e-24f));
#pragma unroll
            for (int i = 0; i < 8; ++i) { const float kk = av[i] * inv; av[i] = -kk; bv[i] = kk * asg[i]; }
            if ((tid & 7) == 0) RK[m * 8 + h] = rks;
            *(v4u*)(GG + m * 512 + ch) = pack8(gg);
            if (store_v) *(v4u*)(VF + m * 512 + ch) = pack8(vv);
#pragma unroll
            for (int i = 0; i < 8; ++i) vv[i] = bf2f((bf16)f2bf(vv[i]));
        }
        __syncthreads();
#pragma unroll
        for (int i = 0; i < 8; ++i) CUM[t * 64 + d0 + i] = lw[i];
        __syncthreads();
        { const int d = tid & 63, seg = tid >> 6; float run = 0.f;
#pragma unroll
          for (int q = 0; q < 8; ++q) { run += CUM[(seg * 8 + q) * 64 + d]; CUM[(seg * 8 + q) * 64 + d] = run; }
          SEG[seg * 64 + d] = run; }
        __syncthreads();
        { const int d = tid & 63, seg = tid >> 6; float off = 0.f;
          for (int s = 0; s < seg; ++s) off += SEG[s * 64 + d];
#pragma unroll
          for (int q = 0; q < 8; ++q) CUM[(seg * 8 + q) * 64 + d] += off; }
        __syncthreads();
        {
            float at[8], bt[8], kt[8], rt[8];
#pragma unroll
            for (int i = 0; i < 8; ++i) { const float cu = CUM[t * 64 + d0 + i], cC = CUM[63 * 64 + d0 + i], en = __expf(-cu), ec = __expf(cC - cu);
                at[i] = av[i] * __expf(cu - lw[i]); bt[i] = bv[i] * en; kt[i] = kv[i] * en; rt[i] = rv[i] * __expf(cu);
                BHc[(d0 + i) * RW_LD + t] = (bf16)f2bf(bv[i] * ec); KHc[(d0 + i) * RW_LD + t] = (bf16)f2bf(kv[i] * ec); VTc[(d0 + i) * RW_LD + t] = (bf16)f2bf(vv[i]);
                XT[(d0 + i) * RW_FLD + t] = bf2f((bf16)f2bf(at[i]));
                if (t == 63) GAMC[(size_t)item * 64 + d0 + i] = __expf(cC); }
            *(LAS v4u*)(AT + t * RW_LD + d0) = pack8(at); *(LAS v4u*)(BT + t * RW_LD + d0) = pack8(bt); *(LAS v4u*)(KT + t * RW_LD + d0) = pack8(kt); *(LAS v4u*)(RT + t * RW_LD + d0) = pack8(rt);
        }
        __syncthreads();
        {
            const int msel = wave >> 1;
            const LAS bf16* As = (msel == 0 || msel == 2) ? BT : KT; const LAS bf16* Bs = (msel < 2) ? AT : RT;
            f32x4 accs[8];
#pragma unroll
            for (int q = 0; q < 8; ++q) { const int tile = (wave & 1) * 8 + q, mt = tile >> 2, nt = tile & 3; accs[q] = (f32x4){0.f, 0.f, 0.f, 0.f};
                accs[q] = mm16(As + mt * 16 * RW_LD, RW_LD, Bs + nt * 16 * RW_LD, RW_LD, 64, accs[q], lane);
                const int tt = nt * 16 + cc, s0 = mt * 16 + 4 * g, lim = (msel < 2) ? tt - 1 : tt;
                accs[q].x = (s0 + 0 <= lim) ? accs[q].x : 0.f; accs[q].y = (s0 + 1 <= lim) ? accs[q].y : 0.f; accs[q].z = (s0 + 2 <= lim) ? accs[q].z : 0.f; accs[q].w = (s0 + 3 <= lim) ? accs[q].w : 0.f; }
            __syncthreads();
            LAS bf16* outp = NI + msel * 64 * RW_LD;
#pragma unroll
            for (int q = 0; q < 8; ++q) { const int tile = (wave & 1) * 8 + q, mt = tile >> 2, nt = tile & 3;
                *(LAS unsigned long long*)(outp + (nt * 16 + cc) * RW_LD + mt * 16 + 4 * g) = pack4(accs[q]); }
        }
        __syncthreads();
#pragma unroll
        for (int q = 0; q < 2; ++q) { const int tile = wave * 2 + q, mt = tile >> 2, nt = tile & 3;
            f32x4 acc = {0.f, 0.f, 0.f, 0.f}; acc = mm16(AAK + mt * 16 * RW_LD, RW_LD, VTc + nt * 16 * RW_LD, RW_LD, 64, acc, lane);
            *(LAS f32x4*)(XT + (64 + nt * 16 + cc) * RW_FLD + mt * 16 + 4 * g) = acc; }
        __syncthreads();
#pragma unroll 1
        for (int i = 0; i < 4; ++i) {
            if (i > 0) {
                f32x4 acc = *(const LAS f32x4*)(XT + (wave * 16 + cc) * RW_FLD + 16 * i + 4 * g);
                const int klim = 16 * i;
                for (int k0 = 0; k0 < klim; k0 += 32) { s16x8 a = *(const LAS s16x8*)(NI + (16 * i + cc) * RW_LD + k0 + 8 * g); s16x8 bb = *(const LAS s16x8*)(XB16 + (wave * 16 + cc) * RW_LD + k0 + 8 * g);
                    if (k0 + 8 * g >= klim) { a = (s16x8){0, 0, 0, 0, 0, 0, 0, 0}; bb = a; }
                    acc = __builtin_amdgcn_mfma_f32_16x16x32_bf16(a, bb, acc, 0, 0, 0); }
                *(LAS f32x4*)(XT + (wave * 16 + cc) * RW_FLD + 16 * i + 4 * g) = acc;
                __syncthreads();
            }
            if (tid < 128) {
                float x[16];
#pragma unroll
                for (int q = 0; q < 4; ++q) { const f32x4 v4 = *(const LAS f32x4*)(XT + tid * RW_FLD + 16 * i + 4 * q); x[4 * q] = v4.x; x[4 * q + 1] = v4.y; x[4 * q + 2] = v4.z; x[4 * q + 3] = v4.w; }
#pragma unroll
                for (int tt = 1; tt < 16; ++tt) { float nr[16]; { float lo[8], hi[8]; unpack8(*(const LAS v4u*)(NI + (16 * i + tt) * RW_LD + 16 * i), lo); unpack8(*(const LAS v4u*)(NI + (16 * i + tt) * RW_LD + 16 * i + 8), hi);
#pragma unroll
                        for (int s = 0; s < 8; ++s) { nr[s] = lo[s]; nr[8 + s] = hi[s]; } }
                    float a = x[tt];
#pragma unroll
                    for (int s = 0; s < tt; ++s) a += nr[s] * x[s];
                    x[tt] = a; }
                float lo[8], hi[8];
#pragma unroll
                for (int s = 0; s < 8; ++s) { lo[s] = x[s]; hi[s] = x[8 + s]; }
                *(LAS v4u*)(XB16 + tid * RW_LD + 16 * i) = pack8(lo); *(LAS v4u*)(XB16 + tid * RW_LD + 16 * i + 8) = pack8(hi);
            }
            __syncthreads();
        }
        {
            const int osel = wave >> 1; const size_t ob = (size_t)item * 4096;
#pragma unroll 1
            for (int q = 0; q < 8; ++q) { const int tile = (wave & 1) * 8 + q, mt = tile >> 2, nt = tile & 3; f32x4 acc = {0.f, 0.f, 0.f, 0.f};
                if (osel == 0) {
                    acc = mm16(XB16 + mt * 16 * RW_LD, RW_LD, BHc + nt * 16 * RW_LD, RW_LD, 64, acc, lane);
                    *(unsigned long long*)(PP + ob + (nt * 16 + cc) * 64 + mt * 16 + 4 * g) = pack4(acc);
                } else if (osel == 1) {
                    acc = mm16(BHc + mt * 16 * RW_LD, RW_LD, XB16 + (64 + nt * 16) * RW_LD, RW_LD, 64, acc, lane);
                    acc = mm16(KHc + mt * 16 * RW_LD, RW_LD, VTc + nt * 16 * RW_LD, RW_LD, 64, acc, lane);
                    *(unsigned long long*)(QQ + ob + (nt * 16 + cc) * 64 + mt * 16 + 4 * g) = pack4(acc);
                } else if (osel == 2) {
                    acc = mm16(XB16 + mt * 16 * RW_LD, RW_LD, ARB + nt * 16 * RW_LD, RW_LD, 64, acc, lane);
                    const unsigned long long rr = *(const LAS unsigned long long*)(RT + (nt * 16 + cc) * RW_LD + mt * 16 + 4 * g);
                    acc.x += bf2f((bf16)(rr & 0xffffu)); acc.y += bf2f((bf16)((rr >> 16) & 0xffffu)); acc.z += bf2f((bf16)((rr >> 32) & 0xffffu)); acc.w += bf2f((bf16)(rr >> 48));
                    *(unsigned long long*)(RH + ob + (nt * 16 + cc) * 64 + mt * 16 + 4 * g) = pack4(acc);
                } else {
                    acc = mm16(XB16 + (64 + mt * 16) * RW_LD, RW_LD, ARB + nt * 16 * RW_LD, RW_LD, 64, acc, lane);
                    acc = mm16(VTc + mt * 16 * RW_LD, RW_LD, ARK + nt * 16 * RW_LD, RW_LD, 64, acc, lane);
                    *(unsigned long long*)(YH + ob + (nt * 16 + cc) * 64 + mt * 16 + 4 * g) = pack4(acc);
                } }
        }
        __syncthreads();
    }
}

struct ChainOps { s16x8 a[4][2]; unsigned long long q[4]; f32x4 gm[4]; };
__device__ __forceinline__ void chain_load(ChainOps& o, const bf16* PP, const bf16* QQ, const float* GAMC, int item, int vt, int cc, int g) {
    const size_t ob = (size_t)item * 4096;
#pragma unroll
    for (int mt = 0; mt < 4; ++mt) {
        o.a[mt][0] = *(const s16x8*)(PP + ob + (mt * 16 + cc) * 64 + 8 * g); o.a[mt][1] = *(const s16x8*)(PP + ob + (mt * 16 + cc) * 64 + 32 + 8 * g);
        o.q[mt] = *(const unsigned long long*)(QQ + ob + (vt * 16 + cc) * 64 + mt * 16 + 4 * g);
        o.gm[mt] = *(const f32x4*)(GAMC + (size_t)item * 64 + mt * 16 + 4 * g); }
}
__device__ __forceinline__ void ph_rwkv_b(const Ctx& C, int wgi  , const bf16* PP, const bf16* QQ, const float* GAMC, bf16* S0) {
    const int lane = C.lane, wave = C.wave, cc = lane & 15, g = lane >> 4;
    const int bh = wgi * 2 + (wave >> 2), vt = wave & 3, b = bh >> 3, h = bh & 7;
    LAS bf16* SI = (LAS bf16*)(C.lds) + wave * 16 * RW_LD;
    f32x4 st[4];
#pragma unroll
    for (int mt = 0; mt < 4; ++mt) st[mt] = (f32x4){0.f, 0.f, 0.f, 0.f};
    ChainOps cur, nxt;
    chain_load(cur, PP, QQ, GAMC, (b * 128 + 0) * 8 + h, vt, cc, g);
    for (int c = 0; c < 128; ++c) {
        const int item = (b * 128 + c) * 8 + h; const size_t ob = (size_t)item * 4096;
        const int cn = c + 1 < 128 ? c + 1 : c;
        chain_load(nxt, PP, QQ, GAMC, (b * 128 + cn) * 8 + h, vt, cc, g);
#pragma unroll
        for (int mt = 0; mt < 4; ++mt) { const unsigned long long pk = pack4(st[mt]);
            *(unsigned long long*)(S0 + ob + (vt * 16 + cc) * 64 + mt * 16 + 4 * g) = pk; *(LAS unsigned long long*)(SI + cc * RW_LD + mt * 16 + 4 * g) = pk; }
        asm volatile("s_waitcnt lgkmcnt(0)" ::: "memory");
        const s16x8 b0 = *(const LAS s16x8*)(SI + cc * RW_LD + 8 * g), b1 = *(const LAS s16x8*)(SI + cc * RW_LD + 32 + 8 * g);
#pragma unroll
        for (int mt = 0; mt < 4; ++mt) {
            f32x4 acc; acc.x = cur.gm[mt].x * st[mt].x + bf2f((bf16)(cur.q[mt] & 0xffffu)); acc.y = cur.gm[mt].y * st[mt].y + bf2f((bf16)((cur.q[mt] >> 16) & 0xffffu));
            acc.z = cur.gm[mt].z * st[mt].z + bf2f((bf16)((cur.q[mt] >> 32) & 0xffffu)); acc.w = cur.gm[mt].w * st[mt].w + bf2f((bf16)(cur.q[mt] >> 48));
            acc = __builtin_amdgcn_mfma_f32_16x16x32_bf16(cur.a[mt][0], b0, acc, 0, 0, 0); acc = __builtin_amdgcn_mfma_f32_16x16x32_bf16(cur.a[mt][1], b1, acc, 0, 0, 0);
            st[mt] = acc; }
        asm volatile("s_waitcnt lgkmcnt(0)" ::: "memory");
        cur = nxt;
    }
}

__device__ __forceinline__ void ph_rwkv_c(const Ctx& C, const bf16* S0, const bf16* RH, const bf16* YH, const float* RK, const bf16* GG, const bf16* VF,
                                          const float* gn_g, const float* gn_b, bf16* O) {
    const int lane = C.lane, cc = lane & 15, g = lane >> 4;
    for (int item = C.bid * 8 + C.wave; item < 4096; item += C.nb * 8) {
        const int h = item & 7, c = (item >> 3) & 127, b = item >> 10; const size_t m0 = (size_t)b * T_ + c * 64, ob = (size_t)item * 4096;
        s16x8 af[4][2], bfr[4][2];
#pragma unroll
        for (int q = 0; q < 4; ++q)
#pragma unroll
            for (int k = 0; k < 2; ++k) { af[q][k] = *(const s16x8*)(S0 + ob + (q * 16 + cc) * 64 + k * 32 + 8 * g); bfr[q][k] = *(const s16x8*)(RH + ob + (q * 16 + cc) * 64 + k * 32 + 8 * g); }
#pragma unroll
        for (int nt = 0; nt < 4; ++nt) {
            const size_t m = m0 + nt * 16 + cc;
            f32x4 y[4]; float s1 = 0.f;
#pragma unroll
            for (int mt = 0; mt < 4; ++mt) { const unsigned long long yh = *(const unsigned long long*)(YH + ob + (nt * 16 + cc) * 64 + mt * 16 + 4 * g);
                f32x4 acc; acc.x = bf2f((bf16)(yh & 0xffffu)); acc.y = bf2f((bf16)((yh >> 16) & 0xffffu)); acc.z = bf2f((bf16)((yh >> 32) & 0xffffu)); acc.w = bf2f((bf16)(yh >> 48));
                acc = __builtin_amdgcn_mfma_f32_16x16x32_bf16(af[mt][0], bfr[nt][0], acc, 0, 0, 0); acc = __builtin_amdgcn_mfma_f32_16x16x32_bf16(af[mt][1], bfr[nt][1], acc, 0, 0, 0);
                y[mt] = acc; s1 += (acc.x + acc.y) + (acc.z + acc.w); }
            s1 += __shfl_xor(s1, 16); s1 += __shfl_xor(s1, 32);
            const float mean = s1 * (1.f / 64.f); float s2 = 0.f;
#pragma unroll
            for (int mt = 0; mt < 4; ++mt) { y[mt] = y[mt] - mean; s2 += (y[mt].x * y[mt].x + y[mt].y * y[mt].y) + (y[mt].z * y[mt].z + y[mt].w * y[mt].w); }
            s2 += __shfl_xor(s2, 16); s2 += __shfl_xor(s2, 32);
            const float rstd = 1.f / sqrtf(s2 * (1.f / 64.f) + 64e-5f), rk = RK[m * 8 + h];
#pragma unroll
            for (int mt = 0; mt < 4; ++mt) { const int v = h * 64 + mt * 16 + 4 * g;
                const f32x4 gg4 = *(const f32x4*)(gn_g + v), gb4 = *(const f32x4*)(gn_b + v);
                const unsigned long long vx = *(const unsigned long long*)(VF + m * 512 + v), gx = *(const unsigned long long*)(GG + m * 512 + v);
                f32x4 o;
                o.x = (y[mt].x * rstd * gg4.x + gb4.x + rk * bf2f((bf16)(vx & 0xffffu))) * bf2f((bf16)(gx & 0xffffu));
                o.y = (y[mt].y * rstd * gg4.y + gb4.y + rk * bf2f((bf16)((vx >> 16) & 0xffffu))) * bf2f((bf16)((gx >> 16) & 0xffffu));
                o.z = (y[mt].z * rstd * gg4.z + gb4.z + rk * bf2f((bf16)((vx >> 32) & 0xffffu))) * bf2f((bf16)((gx >> 32) & 0xffffu));
                o.w = (y[mt].w * rstd * gg4.w + gb4.w + rk * bf2f((bf16)(vx >> 48))) * bf2f((bf16)(gx >> 48));
                *(unsigned long long*)(O + m * D_ + 512 + v) = pack4(o); }
        }
    }
}

__device__ __forceinline__ void ph_conv(const Ctx& C, const bf16* U, const float* cw, const float* cb, bf16* ACT) {
    constexpr int TR = 32, NJB = DFF / 8, NTR = T_ / TR;
    for (int item = C.bid * NT + C.tid; item < NJB * NTR; item += C.nb * NT) {
        const int jb = item % NJB, tr = item / NJB, j = jb * 8, t0 = tr * TR;
        float wg[3][8], wv[3][8], bg[8], bv[8];
#pragma unroll
        for (int i = 0; i < 8; ++i) { bg[i] = cb[j + i]; bv[i] = cb[DFF + j + i];
#pragma unroll
            for (int k = 0; k < 3; ++k) { wg[k][i] = cw[k * NUP + j + i]; wv[k][i] = cw[k * NUP + DFF + j + i]; } }
        float g2[8], g1[8], v2[8], v1[8];
        if (t0 == 0) {
#pragma unroll
            for (int i = 0; i < 8; ++i) { g2[i] = 0.f; g1[i] = 0.f; v2[i] = 0.f; v1[i] = 0.f; } }
        else { unpack8(*(const v4u*)(U + (size_t)(t0 - 2) * NUP + j), g2); unpack8(*(const v4u*)(U + (size_t)(t0 - 1) * NUP + j), g1);
               unpack8(*(const v4u*)(U + (size_t)(t0 - 2) * NUP + DFF + j), v2); unpack8(*(const v4u*)(U + (size_t)(t0 - 1) * NUP + DFF + j), v1); }
#pragma unroll 4
        for (int tt = 0; tt < TR; ++tt) {
            const int t = t0 + tt; float g0[8], v0[8], o[8];
            unpack8(*(const v4u*)(U + (size_t)t * NUP + j), g0); unpack8(*(const v4u*)(U + (size_t)t * NUP + DFF + j), v0);
#pragma unroll
            for (int i = 0; i < 8; ++i) { const float gc = bg[i] + wg[0][i] * g2[i] + wg[1][i] * g1[i] + wg[2][i] * g0[i], vc = bv[i] + wv[0][i] * v2[i] + wv[1][i] * v1[i] + wv[2][i] * v0[i];
                o[i] = siluf_(gc) * vc; g2[i] = g1[i]; g1[i] = g0[i]; v2[i] = v1[i]; v1[i] = v0[i]; }
            *(v4u*)(ACT + (size_t)t * DFF + j) = pack8(o);
        }
    }
}
}

namespace pg8 {
struct EpiRes {
    static constexpr bool PERM = false, AFTER_DRAIN = false;
    const float* base; float* out; const float* gate; int gstride;
    __device__ __forceinline__ void operator()(const f32x4 (&acc)[2][2][4][2], const Unit& u, int wr, int wc, int fr, int fq) const {
        const int b = (u.pm * BM) / 8192; const float* gp = gate + (size_t)b * gstride;
        const int col0 = u.pn * BM + wc * 32 + 4 * fq;
#pragma unroll
        for (int ai = 0; ai < 2; ++ai)
#pragma unroll
            for (int m = 0; m < 4; ++m) { const size_t off = (size_t)(u.pm * BM + ai * HALF + wr * 64 + m * 16 + fr) * 1024 + col0;
#pragma unroll
                for (int bj = 0; bj < 2; ++bj)
#pragma unroll
                    for (int n = 0; n < 2; ++n) { const int cc = bj * HALF + n * 16; const f32x4 gv = *(const f32x4*)(gp + col0 + cc); const f32x4 bs = *(const f32x4*)(base + off + cc);
                        *(f32x4*)(out + off + cc) = bs + gv * acc[ai][bj][m][n]; } }
    }
};
}

namespace hy {
struct Args { const float* in[31]; float* out; unsigned char* ws; };
__global__ void __launch_bounds__(NT, 2) hy_fwd(Args A) {
    extern __shared__ __attribute__((aligned(16))) unsigned char lds_raw[];
    Ctx C; C.bid = blockIdx.x; C.nb = gridDim.x; C.tid = threadIdx.x; C.lane = C.tid & 63; C.wave = __builtin_amdgcn_readfirstlane(C.tid >> 6); C.lds = (LAS unsigned char*)lds_raw;
    volatile LAS unsigned* MISC = (volatile LAS unsigned*)(C.lds + MISC_OFF);
    for (int u = C.tid; u < (LDS_BYTES - MISC_OFF) / 4; u += NT) ((LAS unsigned*)(C.lds + MISC_OFF))[u] = 0u;
    __syncthreads();
    unsigned char* ws = A.ws;
    XcdBarrier bar = xcd_barrier_post((unsigned*)(ws + WS_CTL) + CW_BAR, MISC + 8);
#define PHASE_BEGIN() do { int t_ = threadIdx.x; asm volatile("" : "+v"(t_)); int b_ = blockIdx.x; asm volatile("" : "+s"(b_)); \
    C.tid = t_; C.lane = t_ & 63; C.wave = __builtin_amdgcn_readfirstlane(t_ >> 6); C.bid = b_; } while (0)
#ifdef HY_DIAG
    unsigned long long ts_last = __builtin_amdgcn_s_memrealtime(); float tacc[10] = {0.f, 0.f, 0.f, 0.f, 0.f, 0.f, 0.f, 0.f, 0.f, 0.f};
#define GRID_BAR(cat) do { xcd_barrier(bar); PHASE_BEGIN(); { const unsigned long long n_ = __builtin_amdgcn_s_memrealtime(); tacc[cat] += (float)(n_ - ts_last); ts_last = n_; } } while (0)
#else
#define GRID_BAR(cat) do { xcd_barrier(bar); PHASE_BEGIN(); } while (0)
#endif
#ifndef HY_REPCAT
#define HY_REPCAT (-1)
#endif
#define NREP(cat) ((HY_REPCAT == (cat)) ? 2 : 1)
    float* out = A.out;
#define in A.in
    float* MOD = (float*)(ws + WS_MOD);
    bf16 *WIN = (bf16*)(ws + WS_WIN), *WOUT = (bf16*)(ws + WS_WOUT), *WUP = (bf16*)(ws + WS_WUP), *WDN = (bf16*)(ws + WS_WDN);
    bf16 *XB = (bf16*)(ws + WS_XB), *O = (bf16*)(ws + WS_O), *VF = (bf16*)(ws + WS_VF), *PG = (bf16*)(ws + WS_PG), *PR = (bf16*)(ws + WS_PR), *VL = (bf16*)(ws + WS_VL);
    bf16 *RH = (bf16*)(ws + WS_RH), *YH = (bf16*)(ws + WS_YH), *PP = (bf16*)(ws + WS_PP), *QQ = (bf16*)(ws + WS_QQ), *GG = (bf16*)(ws + WS_GG), *S0 = (bf16*)(ws + WS_S0);
    float *GAMC = (float*)(ws + WS_GAMC), *RK = (float*)(ws + WS_RK);
    bf16* LORA = (bf16*)(ws + WS_LORA);
    bf16* DS = (bf16*)(ws + WS_GK); float* GAM = (float*)(ws + WS_GAM);
    bf16 *ACT = (bf16*)(ws + WS_ACT), *U = (bf16*)(ws + WS_U);

    ph_mod(C, in[1], in[2], in[3], MOD);
    for (int l = 0; l < L_; ++l) {
        const float* modl = MOD + (size_t)l * 4 * 6144;
        const float* xres = l ? out : in[0];
        for (int r_ = 0; r_ < NREP(0); ++r_) {
        wprep_mat(C, in[5] + (size_t)l * D_ * IN_COLS, D_, IN_COLS, NIN, WIN, 1, l ? in[6] : nullptr);
        wprep_mat(C, in[24] + (size_t)l * D_ * D_, D_, D_, D_, WOUT, 0, nullptr);
        wprep_mat(C, in[26] + (size_t)l * D_ * NUP, D_, NUP, NUP, WUP, 0, nullptr);
        wprep_mat(C, in[29] + (size_t)l * DFF * D_, DFF, D_, D_, WDN, 0, nullptr);
        wprep_mat(C, in[12] + (size_t)l * 64 * 512, 64, 512, 512, LORA, 0, nullptr);
        wprep_mat(C, in[14] + (size_t)l * 64 * 512, 64, 512, 512, LORA + 512 * 64, 0, nullptr);
        wprep_mat(C, in[16] + (size_t)l * 128 * 512, 128, 512, 512, LORA + 2 * 512 * 64, 0, nullptr);
        if (l) wprep_mat(C, in[17], 32, 512, 512, LORA + 2 * 512 * 64 + 512 * 128, 0, nullptr);
        }
        GRID_BAR(0);
        for (int r_ = 0; r_ < NREP(1); ++r_) ph_norm(C, xres, in[4] + l * D_, modl + 0 * D_, modl + 1 * D_, XB);
        GRID_BAR(1);
        for (int r_ = 0; r_ < NREP(2); ++r_) { pg8::Gemm g{XB, WIN, M_, NIN, D_}; pg8::StaticOrder S; S.init(M_, NIN, C.nb, C.bid);
          pg8::EpiBf16<0> E{PG, NPG, nullptr, NPG, (WS_PR - WS_PG) / 2, 1.f};
          pg8::gemm_phase<pg8::EpiBf16<0>, pg8::StaticOrder, true, true>(C.lds, g, S, E); }
        GRID_BAR(2);
        for (int r_ = 0; r_ < NREP(3); ++r_) {
        ph_gla_a(C, PG, in[7] + l * 16 * 256, in[8] + l * 256, DS, GAM, VL);
        { RwkvW W{in[10] + l * 1792, in[11], in[13] + l * 512, in[15] + l * 512, in[18], in[19] + l * 512, in[20] + l * 512, in[21] + l * 512,
                  LORA, LORA + 512 * 64, LORA + 2 * 512 * 64, LORA + 2 * 512 * 64 + 512 * 128};
          ph_rwkv_a(C, PR, PG, W, l, PP, QQ, RH, YH, GAMC, RK, GG, VF, r_ == NREP(3) - 1); } }
        GRID_BAR(3);
        for (int r_ = 0; r_ < NREP(4); ++r_) if (C.bid < 16) ph_rwkv_b(C, C.bid, PP, QQ, GAMC, S0);
        else { Ctx C2 = C; C2.bid = C.bid - 16; C2.nb = C.nb - 16; ph_gla_b(C2, DS, GAM); }
        GRID_BAR(4);
        for (int r_ = 0; r_ < NREP(5); ++r_) {
        ph_gla_c(C, PG, in[7] + l * 16 * 256, in[8] + l * 256, in[9] + l * 128, DS, O);
        ph_rwkv_c(C, S0, RH, YH, RK, GG, VF, in[22] + l * 512, in[23] + l * 512, O); }
        GRID_BAR(5);
        { pg8::Gemm g{O, WOUT, M_, D_, D_}; pg8::StaticOrder S; S.init(M_, D_, C.nb, C.bid);
          pg8::EpiRes E{xres, out, modl + 2 * D_, 6144};
          pg8::gemm_phase<pg8::EpiRes, pg8::StaticOrder, true, true>(C.lds, g, S, E); }
        GRID_BAR(6);
        for (int r_ = 0; r_ < NREP(1); ++r_) ph_norm(C, out, in[25] + l * D_, modl + 3 * D_, modl + 4 * D_, XB);
        GRID_BAR(1);
        for (int b = 0; b < B_; ++b) {
            for (int r_ = 0; r_ < NREP(7); ++r_) { pg8::Gemm g{XB + (size_t)b * T_ * D_, WUP, T_, NUP, D_}; pg8::StaticOrder S; S.init(T_, NUP, C.nb, C.bid);
              pg8::EpiBf16<0> E{U, NUP, nullptr, 0, 0, 1.f};
              pg8::gemm_phase<pg8::EpiBf16<0>, pg8::StaticOrder, true, true>(C.lds, g, S, E); }
            GRID_BAR(7);
            for (int r_ = 0; r_ < NREP(8); ++r_) ph_conv(C, U, in[27] + (size_t)l * 3 * NUP, in[28] + (size_t)l * NUP, ACT + (size_t)b * T_ * DFF);
            GRID_BAR(8);
        }
        { pg8::Gemm g{ACT, WDN, M_, D_, DFF}; pg8::StaticOrder S; S.init(M_, D_, C.nb, C.bid);
          pg8::EpiRes E{out, out, modl + 5 * D_, 6144};
          pg8::gemm_phase<pg8::EpiRes, pg8::StaticOrder, true, true>(C.lds, g, S, E); }
        GRID_BAR(9);
    }
    ph_final(C, out, in[30]);
#ifdef HY_DIAG
    GRID_BAR(1);
    if (C.bid == 0) { if (C.tid == 0) out[0] = tacc[HY_DIAG_A] * 0.1f; for (int i = 1 + C.tid; i <= 10000; i += NT) out[i] = tacc[HY_DIAG_B] * 0.01f; }
#endif
#undef GRID_BAR
#undef PHASE_BEGIN
#undef in
}
}

extern "C" void kernel_launch(void* const* d_in, const int* in_sizes, int n_in, void* d_out, int out_size, void* d_ws, size_t ws_size, hipStream_t stream) {
    using namespace hy;
    static int grid = 0;
    if (grid == 0) {
        if (n_in != 31 || in_sizes[0] != M_ * D_ || out_size != M_ * D_ || ws_size < WS_END) { fprintf(stderr, "kernel_launch: unexpected shapes (n_in %d, in0 %d, out %d, ws %zu)\n", n_in, n_in > 0 ? in_sizes[0] : -1, out_size, ws_size); grid = -1; return; }
        if (hipFuncSetAttribute((const void*)hy_fwd, hipFuncAttributeMaxDynamicSharedMemorySize, LDS_BYTES) != hipSuccess) { fprintf(stderr, "kernel_launch: hipFuncSetAttribute failed\n"); grid = -1; return; }
        int dev = 0, cus = 0, per_cu = 0;
        (void)hipGetDevice(&dev); (void)hipDeviceGetAttribute(&cus, hipDeviceAttributeMultiprocessorCount, dev);
        (void)hipOccupancyMaxActiveBlocksPerMultiprocessor(&per_cu, (const void*)hy_fwd, NT, LDS_BYTES);
        if (per_cu < 1) fprintf(stderr, "kernel_launch: occupancy query reports %d blocks per CU\n", per_cu);
        (void)hipGetLastError();
        grid = cus > 0 ? cus : 256;
    }
    if (grid < 0) return;
    (void)hipMemsetAsync((char*)d_ws + WS_CTL, 0, CTL_ZERO_BYTES, stream);
    Args a{};
    for (int i = 0; i < 31; ++i) a.in[i] = (const float*)d_in[i];
    a.out = (float*)d_out; a.ws = (unsigned char*)d_ws;
    hipLaunchKernelGGL(hy_fwd, dim3(grid), dim3(NT), LDS_BYTES, stream, a);
}
```

```cpp
#include <hip/hip_runtime.h>
#include <cstdio>
#include <cstdint>
namespace pg8 {
#define PG8_LAS __attribute__((address_space(3)))
typedef unsigned short bf16_t;
typedef short bf16x8 __attribute__((ext_vector_type(8)));
typedef float f32x4 __attribute__((ext_vector_type(4)));
typedef unsigned u32x4 __attribute__((ext_vector_type(4)));
constexpr int BM = 256, BK = 64, HALF = 128, HTB = HALF * BK * 2  , STAGE_BYTES = 8 * HTB, NXCD = 8, WGM = 8;

__host__ __device__ __forceinline__ int lds_byte(int r, int c) { const int st = (r >> 4) * 2 + (c >> 5), rr = r & 15, cc = c & 31, ob = rr * 64 + cc * 2; return st * 1024 + (ob ^ (((ob >> 9) & 1) << 5)); }
__host__ __device__ __forceinline__ void stage_rc(int b, int& R, int& C) { const int st = b / 1024, sb = b % 1024, swz = sb ^ (((sb >> 9) & 1) << 5); R = (st >> 1) * 16 + swz / 64; C = (st & 1) * 32 + (swz % 64) / 2; }
__host__ __device__ __forceinline__ int perm32(int rho) { const int n = rho >> 4, i = rho & 15; return 8 * (i >> 2) + 4 * n + (i & 3); }

struct Unit { int pm, pn; };
struct Gemm { const bf16_t* A; const bf16_t* Bt; int M, N, K; };

struct StaticOrder {
    int nM, nN, nwg, G, c;
    __host__ __device__ void init(int M, int N, int G_, int c_) { nM = M / BM; nN = N / BM; nwg = nM * nN; G = G_; c = c_; }
    __host__ __device__ bool next(int i, Unit& u) const {
        const long L = (long)i * G + c; if (L >= nwg) return false;
        int wgid = (int)L; { const int q = nwg / NXCD, r = nwg % NXCD, xcd = wgid % NXCD, off = wgid / NXCD; wgid = (xcd < r ? xcd * (q + 1) : r * (q + 1) + (xcd - r) * q) + off; }
        const int nig = WGM * nN, gid = wgid / nig, fm = gid * WGM, gsz = (nM - fm) < WGM ? (nM - fm) : WGM;
        u.pm = fm + ((wgid % nig) % gsz); u.pn = (wgid % nig) / gsz; return true;
    }
    __device__ __forceinline__ void a_ready(const Unit&) const {}
    __device__ __forceinline__ void done(const Unit&) const {}
};

__device__ __forceinline__ unsigned cvt_pk_bf16(float lo, float hi) { unsigned r; asm volatile("v_cvt_pk_bf16_f32 %0, %1, %2" : "=v"(r) : "v"(lo), "v"(hi)); return r; }
typedef float f32x2 __attribute__((ext_vector_type(2)));
__device__ __forceinline__ f32x2 gelu_pk(f32x2 v) {
    const f32x2 av = __builtin_elementwise_abs(v), d = av * 0.2316418882f + 1.0f;
    f32x2 t; t.x = __builtin_amdgcn_rcpf(d.x); t.y = __builtin_amdgcn_rcpf(d.y);
    f32x2 q = t * 0.5307027145f + (-0.7265760135f); q = q * t + 0.7107068705f; q = q * t + (-0.142248368f); q = q * t + 0.127414796f; q = q * t;
    const f32x2 s = (v * v) * (-0.72134752044f);
    f32x2 e; e.x = __builtin_amdgcn_exp2f(s.x); e.y = __builtin_amdgcn_exp2f(s.y);
    const f32x2 m = v * (q * e), r = v - m;
    f32x2 o; o.x = v.x < 0.f ? m.x : r.x; o.y = v.y < 0.f ? m.y : r.y; return o;
}

template <int ACT  > struct EpiBf16 {
    static constexpr bool PERM = true, AFTER_DRAIN = false; static_assert(ACT == 0 || ACT == 1, "EpiBf16: ACT is 0 (none) or 1 (gelu_pk)");
    bf16_t* O; int ldc; const float* bias; int split_cols; size_t split_stride; float scale0;
    __device__ __forceinline__ void operator()(const f32x4 (&acc)[2][2][4][2], const Unit& u, int wr, int wc, int fr, int fq) const {
        const int row0 = u.pm * BM + wr * 64 + fr; int colt = u.pn * BM; bf16_t* base = O;
        float sc = 1.f; if (split_cols) { const int t = colt / split_cols; base += (size_t)t * split_stride; colt -= t * split_cols; if (t == 0) sc = scale0; }
        const int col0 = colt + wc * 32 + 8 * fq, bcol0 = u.pn * BM + wc * 32 + 8 * fq;
        f32x4 bv[2][2];
#pragma unroll
        for (int bj = 0; bj < 2; ++bj)
#pragma unroll
            for (int n = 0; n < 2; ++n) bv[bj][n] = bias ? *(const f32x4*)(bias + bcol0 + bj * HALF + 4 * n) : (f32x4){0.f, 0.f, 0.f, 0.f};
#pragma unroll
        for (int ai = 0; ai < 2; ++ai)
#pragma unroll
            for (int m = 0; m < 4; ++m) { bf16_t* rowp = base + (size_t)(row0 + ai * HALF + m * 16) * ldc + col0;
#pragma unroll
                for (int bj = 0; bj < 2; ++bj) { f32x4 v0 = acc[ai][bj][m][0] + bv[bj][0], v1 = acc[ai][bj][m][1] + bv[bj][1];
                    if (ACT == 1) { f32x2 a = gelu_pk((f32x2){v0[0], v0[1]}), b = gelu_pk((f32x2){v0[2], v0[3]}), c = gelu_pk((f32x2){v1[0], v1[1]}), d = gelu_pk((f32x2){v1[2], v1[3]});
                        v0 = (f32x4){a.x, a.y, b.x, b.y}; v1 = (f32x4){c.x, c.y, d.x, d.y}; }
                    v0 = v0 * sc; v1 = v1 * sc; u32x4 w; w.x = cvt_pk_bf16(v0[0], v0[1]); w.y = cvt_pk_bf16(v0[2], v0[3]); w.z = cvt_pk_bf16(v1[0], v1[1]); w.w = cvt_pk_bf16(v1[2], v1[3]);
                    *(u32x4*)(rowp + bj * HALF) = w; } }
    }
};
template <class Epi, class Sched, bool ALIGN_EPI = false, bool SP2 = false>
__device__ __forceinline__ void gemm_phase(PG8_LAS unsigned char* lds, const Gemm g, const Sched& S, const Epi& E) {
    int tid_ = threadIdx.x; asm volatile("" : "+v"(tid_));
    const int tid = tid_, wid = __builtin_amdgcn_readfirstlane(tid >> 6), lane = tid & 63, wr = wid >> 2, wc = wid & 3, fr = lane & 15, fq = lane >> 4;
    const int K = g.K, nt = K / BK;
    unsigned voffA[2], voffB[2];
#pragma unroll
    for (int i = 0; i < 2; ++i) { int R, C; stage_rc(tid * 16 + i * 8192, R, C); const int Rb = Epi::PERM ? ((R & ~31) + perm32(R & 31)) : R;
        voffA[i] = (unsigned)(R * K + C) * 2u; voffB[i] = (unsigned)(Rb * K + C) * 2u; }
    const size_t kstep = (size_t)(BK * 2);
    const size_t hstep = (size_t)HALF * K * 2;
    const size_t tstep = 2 * hstep;
    const unsigned ldsw = (unsigned)wid * 1024u;
    const int aoff = lds_byte(wr * 64 + fr, fq * 8), boff = lds_byte(wc * 32 + fr, fq * 8);
#define PG8_SA(b, h) (((b) * 2 + (h)) * HTB)
#define PG8_SB(b, h) ((4 + (b) * 2 + (h)) * HTB)
#define PG8_STAGE(bufoff, gbase, voff) do { _Pragma("unroll") for (int _i = 0; _i < 2; ++_i) \
        __builtin_amdgcn_global_load_lds((const unsigned*)((const char*)(gbase) + (voff)[_i]), (PG8_LAS unsigned*)(lds + (bufoff) + ldsw + _i * 8192), 16, 0, 0); } while (0)
#define PG8_LDA(dst, b, h) do { _Pragma("unroll") for (int m = 0; m < 4; ++m) _Pragma("unroll") for (int k = 0; k < 2; ++k) dst[m][k] = *(const PG8_LAS bf16x8*)(lds + PG8_SA(b, h) + aoff + m * 2048 + k * 1024); } while (0)
#define PG8_LDB(dst, b, h) do { _Pragma("unroll") for (int n = 0; n < 2; ++n) _Pragma("unroll") for (int k = 0; k < 2; ++k) dst[n][k] = *(const PG8_LAS bf16x8*)(lds + PG8_SB(b, h) + boff + n * 2048 + k * 1024); } while (0)
#define PG8_MMA(ai, bj, At, Bt) do { __builtin_amdgcn_s_setprio(1); _Pragma("unroll") for (int m = 0; m < 4; ++m) _Pragma("unroll") for (int n = 0; n < 2; ++n) _Pragma("unroll") for (int k = 0; k < 2; ++k) \
        acc[ai][bj][m][n] = __builtin_amdgcn_mfma_f32_16x16x32_bf16(Bt[n][k], At[m][k], acc[ai][bj][m][n], 0, 0, 0); __builtin_amdgcn_s_setprio(0); } while (0)
#define PG8_WAIT_V(n) asm volatile("s_waitcnt vmcnt(" #n ")" ::: "memory")
#define PG8_WAIT_L(n) asm volatile("s_waitcnt lgkmcnt(" #n ")" ::: "memory")
#define PG8_BAR __builtin_amdgcn_s_barrier()
#define PG8_SCHED __builtin_amdgcn_sched_barrier(0)
    Unit cur, nxt; int ui = 0;
    if (!S.next(0, cur)) return;
    f32x4 acc[2][2][4][2];
#pragma unroll
    for (int a = 0; a < 2; ++a)
#pragma unroll
        for (int b = 0; b < 2; ++b)
#pragma unroll
            for (int m = 0; m < 4; ++m)
#pragma unroll
                for (int n = 0; n < 2; ++n) acc[a][b][m][n] = (f32x4){0.f, 0.f, 0.f, 0.f};
    bf16x8 At[4][2], B0[2][2], B1[2][2];
    const char* cA = (const char*)g.A + (size_t)cur.pm * tstep; const char* cB = (const char*)g.Bt + (size_t)cur.pn * tstep;
    S.a_ready(cur);
    if constexpr (SP2) {
        PG8_STAGE(PG8_SB(0, 0), cB, voffB); PG8_STAGE(PG8_SB(0, 1), cB + hstep, voffB); PG8_STAGE(PG8_SA(0, 0), cA, voffA); PG8_STAGE(PG8_SA(0, 1), cA + hstep, voffA);
        if (wr == 1) PG8_BAR;
        PG8_WAIT_V(2); PG8_BAR;
        PG8_STAGE(PG8_SB(1, 0), cB + kstep, voffB); PG8_STAGE(PG8_SA(1, 0), cA + kstep, voffA); PG8_STAGE(PG8_SB(1, 1), cB + hstep + kstep, voffB);
        PG8_WAIT_V(6); PG8_BAR;
    } else {
        PG8_STAGE(PG8_SB(0, 0), cB, voffB); PG8_STAGE(PG8_SA(0, 0), cA, voffA); PG8_STAGE(PG8_SB(0, 1), cB + hstep, voffB); PG8_STAGE(PG8_SA(0, 1), cA + hstep, voffA);
        if (wr == 1) PG8_BAR;
        PG8_WAIT_V(4); PG8_BAR;
        PG8_STAGE(PG8_SB(1, 0), cB + kstep, voffB); PG8_STAGE(PG8_SA(1, 0), cA + kstep, voffA); PG8_STAGE(PG8_SB(1, 1), cB + hstep + kstep, voffB);
        PG8_WAIT_V(6); PG8_BAR;
    }
    for (;;) {
        const bool has_next = S.next(ui + 1, nxt);
        const char* nA = has_next ? (const char*)g.A + (size_t)nxt.pm * tstep : cA; const char* nB = has_next ? (const char*)g.Bt + (size_t)nxt.pn * tstep : cB;
        for (int t = 0; t < nt; t += 2) {
            const bool last = (t == nt - 2);
            const char* a1 = cA + (size_t)(t + 1) * kstep;
            const char* a2 = last ? nA : cA + (size_t)(t + 2) * kstep; const char* b2 = last ? nB : cB + (size_t)(t + 2) * kstep;
            const char* a3 = a2 + kstep; const char* b3 = b2 + kstep;
            if (last && has_next) S.a_ready(nxt);
            if constexpr (SP2) {
            PG8_LDB(B0, 0, 0); PG8_LDB(B1, 0, 1); PG8_SCHED; PG8_LDA(At, 0, 0); PG8_STAGE(PG8_SA(1, 1), a1 + hstep, voffA);
            PG8_WAIT_V(8); PG8_WAIT_L(0); PG8_BAR; PG8_MMA(0, 0, At, B0); PG8_MMA(0, 1, At, B1); PG8_BAR; PG8_SCHED;
            PG8_LDA(At, 0, 1); PG8_STAGE(PG8_SB(0, 0), b2, voffB); PG8_STAGE(PG8_SB(0, 1), b2 + hstep, voffB); PG8_STAGE(PG8_SA(0, 0), a2, voffA);
            PG8_WAIT_V(8); PG8_WAIT_L(0); PG8_BAR; PG8_MMA(1, 0, At, B0); PG8_MMA(1, 1, At, B1); PG8_BAR; PG8_SCHED;
            PG8_LDB(B0, 1, 0); PG8_LDB(B1, 1, 1); PG8_SCHED; PG8_LDA(At, 1, 0); PG8_STAGE(PG8_SA(0, 1), a2 + hstep, voffA);
            PG8_WAIT_V(8); PG8_WAIT_L(0); PG8_BAR; PG8_MMA(0, 0, At, B0); PG8_MMA(0, 1, At, B1); PG8_BAR; PG8_SCHED;
            PG8_LDA(At, 1, 1); PG8_STAGE(PG8_SB(1, 0), b3, voffB); PG8_STAGE(PG8_SB(1, 1), b3 + hstep, voffB); PG8_STAGE(PG8_SA(1, 0), a3, voffA);
            PG8_WAIT_V(8); PG8_WAIT_L(0); PG8_BAR; PG8_MMA(1, 0, At, B0); PG8_MMA(1, 1, At, B1); PG8_BAR; PG8_SCHED;
            } else {
            PG8_LDB(B0, 0, 0); PG8_SCHED; PG8_LDA(At, 0, 0); PG8_STAGE(PG8_SA(1, 1), a1 + hstep, voffA);
            PG8_WAIT_L(8); PG8_BAR; PG8_WAIT_L(0); PG8_MMA(0, 0, At, B0); PG8_BAR; PG8_SCHED;
            PG8_LDB(B1, 0, 1); PG8_STAGE(PG8_SB(0, 0), b2, voffB);
            PG8_BAR; PG8_WAIT_L(0); PG8_MMA(0, 1, At, B1); PG8_BAR;
            PG8_LDA(At, 0, 1); PG8_STAGE(PG8_SA(0, 0), a2, voffA);
            PG8_BAR; PG8_WAIT_L(0); PG8_MMA(1, 0, At, B0); PG8_BAR; PG8_SCHED;
            PG8_STAGE(PG8_SB(0, 1), b2 + hstep, voffB);
            PG8_WAIT_V(6); PG8_BAR; PG8_MMA(1, 1, At, B1); PG8_BAR;
            PG8_LDB(B0, 1, 0); PG8_SCHED; PG8_LDA(At, 1, 0); PG8_STAGE(PG8_SA(0, 1), a2 + hstep, voffA);
            PG8_WAIT_L(8); PG8_BAR; PG8_WAIT_L(0); PG8_MMA(0, 0, At, B0); PG8_BAR; PG8_SCHED;
            PG8_LDB(B1, 1, 1); PG8_STAGE(PG8_SB(1, 0), b3, voffB);
            PG8_BAR; PG8_WAIT_L(0); PG8_MMA(0, 1, At, B1); PG8_BAR;
            PG8_LDA(At, 1, 1); PG8_STAGE(PG8_SA(1, 0), a3, voffA);
            PG8_BAR; PG8_WAIT_L(0); PG8_MMA(1, 0, At, B0); PG8_BAR; PG8_SCHED;
            PG8_STAGE(PG8_SB(1, 1), b3 + hstep, voffB);
            PG8_WAIT_V(6); PG8_BAR; PG8_MMA(1, 1, At, B1); PG8_BAR;
            }
        }
        if constexpr (ALIGN_EPI) { if (wr == 0) PG8_BAR; }
        if constexpr (!Epi::AFTER_DRAIN) { E(acc, cur, wr, wc, fr, fq); S.done(cur); }
        if (!has_next) break;
#pragma unroll
        for (int a = 0; a < 2; ++a)
#pragma unroll
            for (int b = 0; b < 2; ++b)
#pragma unroll
                for (int m = 0; m < 4; ++m)
#pragma unroll
                    for (int n = 0; n < 2; ++n) acc[a][b][m][n] = (f32x4){0.f, 0.f, 0.f, 0.f};
        cur = nxt; cA = nA; cB = nB; ++ui;
        if constexpr (ALIGN_EPI) { if (wr == 1) PG8_BAR; }
    }
    PG8_WAIT_V(0);
    if constexpr (!ALIGN_EPI) { if (wr == 0) PG8_BAR; }
    PG8_BAR;
    if constexpr (Epi::AFTER_DRAIN) { E.fused(acc, cur, wr, wc, fr, fq, lds, wid, lane); S.done(cur); }
#undef PG8_SA
#undef PG8_SB
#undef PG8_STAGE
#undef PG8_LDA
#undef PG8_LDB
#undef PG8_MMA
#undef PG8_WAIT_V
#undef PG8_WAIT_L
#undef PG8_BAR
#undef PG8_SCHED
}
}

namespace hy {
#define GAS __attribute__((address_space(1)))
#define LAS __attribute__((address_space(3)))
typedef unsigned short bf16;
typedef unsigned v4u __attribute__((ext_vector_type(4)));
typedef float f32x4 __attribute__((ext_vector_type(4)));
typedef short bf16x8 __attribute__((ext_vector_type(8)));
typedef GAS unsigned gu32;
typedef GAS unsigned long long gu64;
#define RLX_AGENT __ATOMIC_RELAXED, __HIP_MEMORY_SCOPE_AGENT
#define LDS_WAIT() asm volatile("s_waitcnt lgkmcnt(0)" ::: "memory")
#define VM_WAIT() asm volatile("s_waitcnt vmcnt(0)" ::: "memory")
__device__ __forceinline__ unsigned long long rt() { return __builtin_amdgcn_s_memrealtime(); }
__device__ __forceinline__ unsigned f2bf(float f) { unsigned u = __builtin_bit_cast(unsigned, f); return (u + 0x7fffu + ((u >> 16) & 1u)) >> 16; }
__device__ __forceinline__ unsigned pk2(float lo, float hi) { return f2bf(lo) | (f2bf(hi) << 16); }
#define XB_TMO      128
#define XB_XCNT(j)  (256  + 64 * (j))
#define XB_XSUB(j)  (1280 + 64 * (j))
#define XB_XGEN(j)  (2304 + 64 * (j))
#define XB_TOP      3328
#define XB_TOPGEN   3392
#define XCD_BAR_WORDS 3456
#define XB_SPIN_CAP (1u << 18)

__device__ __forceinline__ unsigned xb_ld(unsigned* p)              { return __hip_atomic_load(p, __ATOMIC_RELAXED, __HIP_MEMORY_SCOPE_AGENT); }
__device__ __forceinline__ unsigned xb_add(unsigned* p, unsigned v) { return __hip_atomic_fetch_add(p, v, __ATOMIC_RELAXED, __HIP_MEMORY_SCOPE_AGENT); }
__device__ __forceinline__ unsigned xb_xcc_id() { return (unsigned)__builtin_amdgcn_s_getreg((3 << 11) | 20) & 0xFu; }
#define XB_SPIN(cond, bar) do { unsigned _sp = 0; while (cond) { __builtin_amdgcn_s_sleep(1); \
    if ((++_sp & 255u) == 0u) { if (xb_ld(&(bar)[XB_TMO])) break; if (_sp > XB_SPIN_CAP) { atomicAdd(&(bar)[XB_TMO], 1u); break; } } } } while (0)

struct XcdBarrier {
    unsigned* bar; unsigned x;
    volatile LAS unsigned* st;
};

__device__ __forceinline__ XcdBarrier xcd_barrier_post(unsigned* bar, volatile LAS unsigned* st) {
    XcdBarrier b; b.bar = bar; b.x = xb_xcc_id(); b.st = st;
    if (threadIdx.x == 0) (void)xb_add(&bar[XB_XCNT(b.x)], 1u);
    return b;
}
__device__ __forceinline__ void xcd_barrier_complete(unsigned* bar, unsigned x, unsigned& nloc, unsigned& nx) {
    const unsigned G = gridDim.x * gridDim.y * gridDim.z;
    unsigned sum, cnt, mine, sp = 0u;
    for (;;) {
        sum = 0u; cnt = 0u; mine = 0u;
#pragma unroll
        for (unsigned j = 0; j < 16; ++j) { const unsigned c = xb_ld(&bar[XB_XCNT(j)]); sum += c; cnt += (c > 0u) ? 1u : 0u; mine = (j == x) ? c : mine; }
        if (sum == G) break;
        __builtin_amdgcn_s_sleep(1);
        if ((++sp & 255u) == 0u) { if (xb_ld(&bar[XB_TMO])) break; if (sp > XB_SPIN_CAP) { atomicAdd(&bar[XB_TMO], 1u); break; } }
    }
    nloc = mine > 0u ? mine : 1u; nx = cnt > 0u ? cnt : 1u;
}

__device__ __forceinline__ void xcd_barrier(const XcdBarrier& b) {
    asm volatile("s_waitcnt vmcnt(0)" ::: "memory");
    __syncthreads();
    if (threadIdx.x == 0) {
        unsigned* bar = b.bar;
        __builtin_amdgcn_s_waitcnt(0);
        unsigned nloc = b.st[0], nx = b.st[1];
        if (nloc == 0u) { xcd_barrier_complete(bar, b.x, nloc, nx); b.st[0] = nloc; b.st[1] = nx; }
        const unsigned old = xb_add(&bar[XB_XSUB(b.x)], 1u);
        const unsigned gen = old / nloc;
        if (old + 1u == (gen + 1u) * nloc) {
            __builtin_amdgcn_fence(__ATOMIC_RELEASE, "agent");
            asm volatile("s_waitcnt vmcnt(0)" ::: "memory");
            const unsigned og = xb_add(&bar[XB_TOP], 1u);
            const unsigned tg = og / nx;
            if (og + 1u == (tg + 1u) * nx) xb_add(&bar[XB_TOPGEN], 1u);
            else XB_SPIN(xb_ld(&bar[XB_TOPGEN]) == tg, bar);
            __builtin_amdgcn_fence(__ATOMIC_ACQUIRE, "agent");
            xb_add(&bar[XB_XGEN(b.x)], 1u);
            asm volatile("s_waitcnt vmcnt(0)" ::: "memory");
        } else {
            XB_SPIN(xb_ld(&bar[XB_XGEN(b.x)]) == gen, bar);
            __builtin_amdgcn_fence(__ATOMIC_ACQUIRE, "agent");
            asm volatile("s_waitcnt vmcnt(0)" ::: "memory");
        }
    }
    __syncthreads();
}

constexpr int B_ = 4, T_ = 8192, D_ = 1024, M_ = B_ * T_, L_ = 2;
constexpr int NIN = 3584, NPG = 1792, NPR = 1792;
constexpr int DFF = 2816, NUP = 5632, IN_COLS = 3344;
constexpr size_t MiB = 1u << 20;
constexpr size_t WS_CTL = 0, CTL_ZERO_BYTES = 65536;
constexpr int CW_BAR = 4096;
constexpr size_t WS_RK = MiB / 4;
constexpr size_t WS_MOD = 3 * MiB / 2;
constexpr size_t WS_WIN = 2 * MiB, WS_WOUT = 9 * MiB, WS_WUP = 11 * MiB, WS_WDN = 22 * MiB, WS_LORA = 55 * MiB / 2, WS_GAMC = 28 * MiB, WS_VL = 29 * MiB;
constexpr size_t WS_GAM = 31 * MiB;
constexpr size_t WS_XB = 32 * MiB, WS_O = 96 * MiB, WS_VF = 160 * MiB, WS_GK = 192 * MiB, WS_PG = 224 * MiB, WS_PR = 336 * MiB, WS_END = 512 * MiB;
constexpr size_t WS_RH = WS_XB, WS_YH = WS_XB + 32 * MiB, WS_PP = WS_O, WS_QQ = WS_O + 32 * MiB, WS_GG = 448 * MiB, WS_S0 = 480 * MiB;
constexpr size_t WS_ACT = 224 * MiB, WS_U = 400 * MiB;
constexpr int RING_BYTES = 131072, MISC_OFF = 139264, LDS_BYTES = 147456;
constexpr int NT = 512;

__device__ __forceinline__ float bf2f(bf16 h) { return __builtin_bit_cast(float, (unsigned)h << 16); }
__device__ __forceinline__ float sigmoidf_(float x) { return 1.f / (1.f + __expf(-x)); }
__device__ __forceinline__ float siluf_(float x) { return x / (1.f + __expf(-x)); }
__device__ __forceinline__ float softplusf_(float x) { return fmaxf(x, 0.f) + log1pf(__expf(-fabsf(x))); }

typedef unsigned u32x2 __attribute__((ext_vector_type(2)));
template <int CTRL> __device__ __forceinline__ float dpp_f(float v) {
    return __builtin_bit_cast(float, __builtin_amdgcn_update_dpp(0, __builtin_bit_cast(int, v), CTRL, 0xf, 0xf, false));
}
__device__ __forceinline__ float wave_sum(float v) {
    v += dpp_f<0xB1>(v);
    v += dpp_f<0x4E>(v);
    v += dpp_f<0x141>(v);
    v += dpp_f<0x140>(v);
    v += __builtin_bit_cast(float, __builtin_amdgcn_update_dpp(0, __builtin_bit_cast(int, v), 0x142, 0xa, 0xf, false));
    v += __builtin_bit_cast(float, __builtin_amdgcn_update_dpp(0, __builtin_bit_cast(int, v), 0x143, 0xc, 0xf, false));
    return __builtin_bit_cast(float, __builtin_amdgcn_readlane(__builtin_bit_cast(int, v), 63));
}

struct Ctx { int bid, nb, tid, lane, wave; LAS unsigned char* lds; };

__device__ __forceinline__ void ph_mod(const Ctx& C, const float* c, const float* ada_w, const float* ada_b, float* MOD) {
    LAS float* sc = (LAS float*)C.lds;
    LAS float* red = (LAS float*)(C.lds + 16384);
    for (int i = C.tid; i < 4096; i += NT) sc[i] = siluf_(c[i]);
    __syncthreads();
    for (int item = C.bid; item < 192; item += C.nb) {
        const int l = item / 96, j0 = (item % 96) * 64;
        const float* W = ada_w + (size_t)l * 1024 * 6144 + j0 + C.lane;
        float a0 = 0.f, a1 = 0.f, a2 = 0.f, a3 = 0.f;
        for (int k = C.wave * 128; k < C.wave * 128 + 128; ++k) { const float wv = W[(size_t)k * 6144]; a0 += sc[k] * wv; a1 += sc[1024 + k] * wv; a2 += sc[2048 + k] * wv; a3 += sc[3072 + k] * wv; }
        red[(C.wave * 4 + 0) * 64 + C.lane] = a0; red[(C.wave * 4 + 1) * 64 + C.lane] = a1; red[(C.wave * 4 + 2) * 64 + C.lane] = a2; red[(C.wave * 4 + 3) * 64 + C.lane] = a3;
        __syncthreads();
        if (C.wave < 4) { const int b = C.wave; float s = ada_b[l * 6144 + j0 + C.lane];
#pragma unroll
            for (int w = 0; w < 8; ++w) s += red[(w * 4 + b) * 64 + C.lane];
            MOD[((size_t)l * 4 + b) * 6144 + j0 + C.lane] = s; }
        __syncthreads();
    }
}

__device__ __forceinline__ void wprep_mat(const Ctx& C, const float* W, int K, int Nsrc, int Ndst, bf16* Wt, int mode, const float* vres) {
    const int half = C.tid >> 8, t = C.tid & 255, tx = t & 31, ty = t >> 5;
    LAS float* tile = (LAS float*)C.lds + half * (32 * 33);
    const int nbn = Ndst / 32, ntile = nbn * (K / 32);
    const int niter = (ntile + 2 * C.nb - 1) / (2 * C.nb);
    for (int it = 0; it < niter; ++it) {
        const int item = (it * C.nb + C.bid) * 2 + half;
        const bool act = item < ntile;
        const int n0 = (item % nbn) * 32, k0 = (item / nbn) * 32, n = n0 + tx;
        if (act) {
#pragma unroll
            for (int i = 0; i < 4; ++i) { const int k = k0 + ty + 8 * i; float v = 0.f;
                if (mode == 0) v = W[(size_t)k * Nsrc + n];
                else { if (n < 1552) v = W[(size_t)k * Nsrc + n]; else if (n < 1584) v = vres ? vres[(size_t)k * 32 + (n - 1552)] : 0.f; else if (n < 1792) v = 0.f; else v = W[(size_t)k * Nsrc + (n - 240)]; }
                tile[(ty + 8 * i) * 33 + tx] = v; }
        }
        __syncthreads();
        if (act) {
#pragma unroll
            for (int i = 0; i < 4; ++i) { const int nn = n0 + ty + 8 * i; Wt[(size_t)nn * K + k0 + tx] = (bf16)f2bf(tile[tx * 33 + ty + 8 * i]); }
        }
        __syncthreads();
    }
}

__device__ __forceinline__ void ph_norm(const Ctx& C, const float* x, const float* g, const float* sh, const float* sc, bf16* XB) {
    const int gw = C.bid * 8 + C.wave, NGW = C.nb * 8, lane = C.lane;
    for (int m = gw; m < M_; m += NGW) {
        const int b = m / T_;
        const f32x4* xr = (const f32x4*)(x + (size_t)m * D_) + lane;
        f32x4 v[4]; float s = 0.f;
#pragma unroll
        for (int j = 0; j < 4; ++j) { v[j] = xr[64 * j]; s += (v[j].x * v[j].x + v[j].y * v[j].y) + (v[j].z * v[j].z + v[j].w * v[j].w); }
        const float rstd = 1.f / sqrtf(wave_sum(s) * (1.f / D_) + 1e-6f);
        unsigned long long* o8 = (unsigned long long*)(XB + (size_t)m * D_) + lane;
#pragma unroll
        for (int j = 0; j < 4; ++j) { const int col = 4 * lane + 256 * j;
            const f32x4 gv = *(const f32x4*)(g + col), shv = *(const f32x4*)(sh + b * 6144 + col), scv = *(const f32x4*)(sc + b * 6144 + col);
            const f32x4 h = v[j] * rstd * gv * (scv + 1.f) + shv;
            o8[64 * j] = (unsigned long long)(f2bf(h.x) | (f2bf(h.y) << 16)) | ((unsigned long long)(f2bf(h.z) | (f2bf(h.w) << 16)) << 32); }
    }
}
__device__ __forceinline__ void ph_final(const Ctx& C, float* x, const float* g) {
    const int gw = C.bid * 8 + C.wave, NGW = C.nb * 8, lane = C.lane;
    for (int m = gw; m < M_; m += NGW) {
        f32x4* xr = (f32x4*)(x + (size_t)m * D_) + lane;
        f32x4 v[4]; float s = 0.f;
#pragma unroll
        for (int j = 0; j < 4; ++j) { v[j] = xr[64 * j]; s += (v[j].x * v[j].x + v[j].y * v[j].y) + (v[j].z * v[j].z + v[j].w * v[j].w); }
        const float rstd = 1.f / sqrtf(wave_sum(s) * (1.f / D_) + 1e-6f);
#pragma unroll
        for (int j = 0; j < 4; ++j) { const f32x4 gv = *(const f32x4*)(g + 4 * lane + 256 * j); xr[64 * j] = v[j] * rstd * gv; }
    }
}


typedef short s16x8 __attribute__((ext_vector_type(8)));
__device__ __forceinline__ f32x4 mm16(const LAS bf16* A, int lda, const LAS bf16* B, int ldb, int K, f32x4 acc, int lane) {
    const int r = lane & 15, g = lane >> 4;
    const LAS bf16* ap = A + r * lda + 8 * g; const LAS bf16* bp = B + r * ldb + 8 * g;
    for (int k0 = 0; k0 < K; k0 += 32) { const s16x8 a = *(const LAS s16x8*)(ap + k0); const s16x8 b = *(const LAS s16x8*)(bp + k0); acc = __builtin_amdgcn_mfma_f32_16x16x32_bf16(a, b, acc, 0, 0, 0); }
    return acc;
}
__device__ __forceinline__ f32x4 mm16_ga(const bf16* A, int lda, const LAS bf16* B, int ldb, int K, f32x4 acc, int lane) {
    const int r = lane & 15, g = lane >> 4;
    const bf16* ap = A + r * lda + 8 * g; const LAS bf16* bp = B + r * ldb + 8 * g;
    for (int k0 = 0; k0 < K; k0 += 32) { const s16x8 a = *(const s16x8*)(ap + k0); const s16x8 b = *(const LAS s16x8*)(bp + k0); acc = __builtin_amdgcn_mfma_f32_16x16x32_bf16(a, b, acc, 0, 0, 0); }
    return acc;
}
__device__ __forceinline__ unsigned long long pack4(f32x4 v) { return (unsigned long long)(f2bf(v.x) | (f2bf(v.y) << 16)) | ((unsigned long long)(f2bf(v.z) | (f2bf(v.w) << 16)) << 32); }
__device__ __forceinline__ float logsigmoidf_(float x) { return fminf(x, 0.f) - log1pf(__expf(-fabsf(x))); }

constexpr int GL_LD = 72;
constexpr int GL_GK = 0;
constexpr int GL_SEG = 16384;
constexpr int GL_Z = 18432;
constexpr int GL_GUP = 20480;
constexpr int GL_I0 = 24832;
constexpr int GL_I1 = GL_I0 + 9216;
constexpr int GL_I2 = GL_I1 + 9216;
constexpr int GL_VT = GL_I2 + 9216;
constexpr int GL_SSQ = GL_VT + 18432;
static_assert(GL_SSQ + 512 <= RING_BYTES, "GLA LDS map");

__device__ __forceinline__ void gla_gates(const Ctx& C, const bf16* pg  , const float* gk_up, const float* gk_b, int h) {
    LAS float* GK = (LAS float*)(C.lds + GL_GK); LAS float* SEG = (LAS float*)(C.lds + GL_SEG); LAS bf16* Z = (LAS bf16*)(C.lds + GL_Z); LAS float* GUP = (LAS float*)(C.lds + GL_GUP);
    const int tid = C.tid;
    if (tid < 128) { const int t = tid >> 1, hh = tid & 1; *(LAS v4u*)(Z + t * 16 + hh * 8) = *(const v4u*)(pg + (size_t)t * NPG + 1536 + hh * 8); }
    for (int i = tid; i < 16 * 64; i += NT) GUP[i] = gk_up[(i >> 6) * 256 + h * 64 + (i & 63)];
    if (tid < 64) GUP[1024 + tid] = gk_b[h * 64 + tid];
    __syncthreads();
    { const int t = tid >> 3, d0 = (tid & 7) * 8; float a[8];
#pragma unroll
      for (int q = 0; q < 8; ++q) a[q] = GUP[1024 + d0 + q];
#pragma unroll
      for (int i = 0; i < 16; ++i) { const float zv = bf2f(Z[t * 16 + i]);
#pragma unroll
          for (int q = 0; q < 8; ++q) a[q] += zv * GUP[i * 64 + d0 + q]; }
#pragma unroll
      for (int q = 0; q < 8; ++q) GK[t * 64 + d0 + q] = logsigmoidf_(a[q]) * (1.f / 16.f); }
    __syncthreads();
    { const int d = tid & 63, seg = tid >> 6; float run = 0.f;
#pragma unroll
      for (int q = 0; q < 8; ++q) { run += GK[(seg * 8 + q) * 64 + d]; GK[(seg * 8 + q) * 64 + d] = run; }
      SEG[seg * 64 + d] = run; }
    __syncthreads();
    { const int d = tid & 63, seg = tid >> 6; float off = 0.f;
      for (int s = 0; s < seg; ++s) off += SEG[s * 64 + d];
#pragma unroll
      for (int q = 0; q < 8; ++q) GK[(seg * 8 + q) * 64 + d] += off; }
    __syncthreads();
}
__device__ __forceinline__ void gla_stage_vt(const Ctx& C, const bf16* pg, int h) {
    LAS bf16* VT = (LAS bf16*)(C.lds + GL_VT);
    const int j = C.tid >> 3, e0 = (C.tid & 7) * 16;
    const v4u x0 = *(const v4u*)(pg + (size_t)j * NPG + 512 + h * 128 + e0), x1 = *(const v4u*)(pg + (size_t)j * NPG + 512 + h * 128 + e0 + 8);
    const unsigned w[8] = {x0.x, x0.y, x0.z, x0.w, x1.x, x1.y, x1.z, x1.w};
#pragma unroll
    for (int q = 0; q < 8; ++q) { VT[(e0 + 2 * q) * GL_LD + j] = (bf16)(w[q] & 0xffffu); VT[(e0 + 2 * q + 1) * GL_LD + j] = (bf16)(w[q] >> 16); }
}

__device__ __forceinline__ void ph_gla_a(const Ctx& C, const bf16* PG, const float* gk_up, const float* gk_b, bf16* DS, float* GAM, bf16* VL) {
    LAS float* GK = (LAS float*)(C.lds + GL_GK); LAS bf16* KT = (LAS bf16*)(C.lds + GL_I0); LAS bf16* VT = (LAS bf16*)(C.lds + GL_VT);
    for (int item = C.bid; item < 2048; item += C.nb) {
        const int bh = item >> 7, c = item & 127, b = bh >> 2, h = bh & 3;
        const size_t m0 = (size_t)b * T_ + c * 64;
        const bf16* pg = PG + m0 * NPG;
        gla_gates(C, pg, gk_up, gk_b, h);
        { const int j = C.tid >> 3, d0 = (C.tid & 7) * 8;
          const v4u kx = *(const v4u*)(pg + (size_t)j * NPG + 256 + h * 64 + d0);
          const unsigned w[4] = {kx.x, kx.y, kx.z, kx.w};
#pragma unroll
          for (int q = 0; q < 4; ++q) { const float k0 = bf2f((bf16)(w[q] & 0xffffu)), k1 = bf2f((bf16)(w[q] >> 16));
              const int d = d0 + 2 * q;
              KT[d * GL_LD + j] = (bf16)f2bf(k0 * __expf(GK[63 * 64 + d] - GK[j * 64 + d]));
              KT[(d + 1) * GL_LD + j] = (bf16)f2bf(k1 * __expf(GK[63 * 64 + d + 1] - GK[j * 64 + d + 1])); } }
        gla_stage_vt(C, pg, h);
        if (C.tid < 64) GAM[(size_t)item * 64 + C.tid] = __expf(GK[63 * 64 + C.tid]);
        if (h == 0 && C.tid < 256) { const int t = C.tid >> 2, q = C.tid & 3; *(unsigned long long*)(VL + (m0 + t) * 32 + q * 8 + 0) = *(const unsigned long long*)(pg + (size_t)t * NPG + 1552 + q * 8);
                                     *(unsigned long long*)(VL + (m0 + t) * 32 + q * 8 + 4) = *(const unsigned long long*)(pg + (size_t)t * NPG + 1552 + q * 8 + 4); }
        __syncthreads();
        { const int n0 = C.wave * 16, lane = C.lane, cc = lane & 15, g = lane >> 4;
          bf16* out = DS + (size_t)item * 8192 + (size_t)(n0 + cc) * 64 + 4 * g;
#pragma unroll
          for (int mt = 0; mt < 4; ++mt) { f32x4 acc = {0.f, 0.f, 0.f, 0.f}; acc = mm16(KT + mt * 16 * GL_LD, GL_LD, VT + n0 * GL_LD, GL_LD, 64, acc, lane);
              *(unsigned long long*)(out + mt * 16) = pack4(acc); } }
        __syncthreads();
    }
}
__device__ __forceinline__ void ph_gla_b(const Ctx& C, bf16* DS, const float* GAM) {
    for (int idx = C.bid * NT + C.tid; idx < 16 * 8192; idx += C.nb * NT) {
        const int bh = idx >> 13, ed = idx & 8191, d = ed & 63;
        bf16* p = DS + (size_t)bh * 128 * 8192 + ed; const float* gp = GAM + (size_t)bh * 128 * 64 + d;
        float S = 0.f;
        for (int c0 = 0; c0 < 128; c0 += 8) {
            float ds[8], gm[8];
#pragma unroll
            for (int i = 0; i < 8; ++i) { ds[i] = bf2f(p[(size_t)(c0 + i) * 8192]); gm[i] = gp[(c0 + i) * 64]; }
#pragma unroll
            for (int i = 0; i < 8; ++i) { const float gs = gm[i] * S; p[(size_t)(c0 + i) * 8192] = (bf16)f2bf(gs); S = gs + ds[i]; }
        }
    }
}
__device__ __forceinline__ void ph_gla_c(const Ctx& C, const bf16* PG, const float* gk_up, const float* gk_b, const float* norm_g, const bf16* DS, bf16* O) {
    LAS float* GK = (LAS float*)(C.lds + GL_GK); LAS bf16* QP = (LAS bf16*)(C.lds + GL_I0); LAS bf16* KM = (LAS bf16*)(C.lds + GL_I1); LAS bf16* AI = (LAS bf16*)(C.lds + GL_I2);
    LAS bf16* VT = (LAS bf16*)(C.lds + GL_VT); LAS float* SSQ = (LAS float*)(C.lds + GL_SSQ);
    for (int item = C.bid; item < 2048; item += C.nb) {
        const int bh = item >> 7, c = item & 127, b = bh >> 2, h = bh & 3;
        const size_t m0 = (size_t)b * T_ + c * 64;
        const bf16* pg = PG + m0 * NPG;
        gla_gates(C, pg, gk_up, gk_b, h);
        { const int j = C.tid >> 3, d0 = (C.tid & 7) * 8;
          const v4u qx = *(const v4u*)(pg + (size_t)j * NPG + h * 64 + d0), kx = *(const v4u*)(pg + (size_t)j * NPG + 256 + h * 64 + d0);
          const unsigned qw[4] = {qx.x, qx.y, qx.z, qx.w}, kw[4] = {kx.x, kx.y, kx.z, kx.w};
          unsigned qo[4], ko[4];
#pragma unroll
          for (int q = 0; q < 4; ++q) { const int d = d0 + 2 * q;
              const float e0 = GK[63 * 64 + d] - GK[j * 64 + d], e1 = GK[63 * 64 + d + 1] - GK[j * 64 + d + 1];
              const float q0 = 0.125f * bf2f((bf16)(qw[q] & 0xffffu)) * __expf(-e0), q1 = 0.125f * bf2f((bf16)(qw[q] >> 16)) * __expf(-e1);
              const float k0 = bf2f((bf16)(kw[q] & 0xffffu)) * __expf(e0), k1 = bf2f((bf16)(kw[q] >> 16)) * __expf(e1);
              qo[q] = f2bf(q0) | (f2bf(q1) << 16); ko[q] = f2bf(k0) | (f2bf(k1) << 16); }
          *(LAS v4u*)(QP + j * GL_LD + d0) = (v4u){qo[0], qo[1], qo[2], qo[3]}; *(LAS v4u*)(KM + j * GL_LD + d0) = (v4u){ko[0], ko[1], ko[2], ko[3]}; }
        gla_stage_vt(C, pg, h);
        __syncthreads();
        { const int lane = C.lane, cc = lane & 15, g = lane >> 4, n0 = (C.wave >> 1) * 16;
#pragma unroll
          for (int q = 0; q < 2; ++q) { const int mt0 = ((C.wave & 1) * 2 + q) * 16; f32x4 acc = {0.f, 0.f, 0.f, 0.f};
              acc = mm16(KM + mt0 * GL_LD, GL_LD, QP + n0 * GL_LD, GL_LD, 64, acc, lane);
              const int i = n0 + cc, j = mt0 + 4 * g;
              acc.x = (j + 0 <= i) ? acc.x : 0.f; acc.y = (j + 1 <= i) ? acc.y : 0.f; acc.z = (j + 2 <= i) ? acc.z : 0.f; acc.w = (j + 3 <= i) ? acc.w : 0.f;
              *(LAS unsigned long long*)(AI + (n0 + cc) * GL_LD + mt0 + 4 * g) = pack4(acc); } }
        __syncthreads();
        { const int lane = C.lane, cc = lane & 15, g = lane >> 4, n0 = (C.wave & 3) * 16, eh = C.wave >> 2;
          const bf16* Sg = DS + (size_t)item * 8192;
          f32x4 acc[4]; float ss = 0.f;
#pragma unroll
          for (int mt = 0; mt < 4; ++mt) { const int e0 = eh * 64 + mt * 16; acc[mt] = (f32x4){0.f, 0.f, 0.f, 0.f};
              acc[mt] = mm16_ga(Sg + (size_t)e0 * 64, 64, QP + n0 * GL_LD, GL_LD, 64, acc[mt], lane);
              acc[mt] = mm16(VT + e0 * GL_LD, GL_LD, AI + n0 * GL_LD, GL_LD, 64, acc[mt], lane);
              ss += (acc[mt].x * acc[mt].x + acc[mt].y * acc[mt].y) + (acc[mt].z * acc[mt].z + acc[mt].w * acc[mt].w); }
          ss += __shfl_xor(ss, 16); ss += __shfl_xor(ss, 32);
          if (g == 0) SSQ[eh * 64 + n0 + cc] = ss;
          __syncthreads();
          const float rstd = 1.f / sqrtf((SSQ[n0 + cc] + SSQ[64 + n0 + cc]) * (1.f / 128.f) + 1e-6f);
          const size_t m = m0 + n0 + cc;
#pragma unroll
          for (int mt = 0; mt < 4; ++mt) { const int e = eh * 64 + mt * 16 + 4 * g;
              const unsigned long long gx = *(const unsigned long long*)(pg + (size_t)(n0 + cc) * NPG + 1024 + h * 128 + e);
              const f32x4 ng = *(const f32x4*)(norm_g + e);
              f32x4 o;
              o.x = acc[mt].x * rstd * ng.x * siluf_(bf2f((bf16)(gx & 0xffffu)));
              o.y = acc[mt].y * rstd * ng.y * siluf_(bf2f((bf16)((gx >> 16) & 0xffffu)));
              o.z = acc[mt].z * rstd * ng.z * siluf_(bf2f((bf16)((gx >> 32) & 0xffffu)));
              o.w = acc[mt].w * rstd * ng.w * siluf_(bf2f((bf16)(gx >> 48)));
              *(unsigned long long*)(O + m * D_ + h * 128 + e) = pack4(o); } }
        __syncthreads();
    }
}


struct RwkvW { const float *mu, *mu_vres, *w0, *a0, *v0, *k_k, *k_a, *r_k; const bf16 *wupT, *aupT, *gupT, *vupT; };
constexpr int RW_LD = 72, RW_XLD = 296, RW_FLD = 68;
constexpr int RW_R0 = 0;
constexpr int RW_SEG = 16384;
constexpr int RW_R1 = 37888;
constexpr int RW_R2 = RW_R1 + 27648;
constexpr int RW_R3 = RW_R2 + 9216;
constexpr int RW_R4 = RW_R3 + 27648;
constexpr int RW_TI = RW_R4 + 128 * RW_FLD * 4;
constexpr int RW_END = RW_TI + 2048;
static_assert(RW_END <= RING_BYTES + 8192 && RW_END <= MISC_OFF, "RWKV LDS map");

typedef short s16x4 __attribute__((ext_vector_type(4)));
__device__ __forceinline__ float tanh_fast(float x) { const float e = __expf(2.f * x); return 1.f - 2.f / (e + 1.f); }
__device__ __forceinline__ float softplus_fast(float x) { return fmaxf(x, 0.f) + __logf(1.f + __expf(-fabsf(x))); }
__device__ __forceinline__ s16x4 cvt4(f32x4 v) { const unsigned long long p = pack4(v); return __builtin_bit_cast(s16x4, p); }
__device__ __forceinline__ void ld8f(const float* p, float (&o)[8]) { const f32x4 a = *(const f32x4*)p, b = *(const f32x4*)(p + 4); o[0] = a.x; o[1] = a.y; o[2] = a.z; o[3] = a.w; o[4] = b.x; o[5] = b.y; o[6] = b.z; o[7] = b.w; }
__device__ __forceinline__ float sum8(float v) { v += dpp_f<0xB1>(v); v += dpp_f<0x4E>(v); v += dpp_f<0x141>(v); return v; }
__device__ __forceinline__ void unpack8(const v4u x, float (&o)[8]) {
    o[0] = bf2f((bf16)(x.x & 0xffffu)); o[1] = bf2f((bf16)(x.x >> 16)); o[2] = bf2f((bf16)(x.y & 0xffffu)); o[3] = bf2f((bf16)(x.y >> 16));
    o[4] = bf2f((bf16)(x.z & 0xffffu)); o[5] = bf2f((bf16)(x.z >> 16)); o[6] = bf2f((bf16)(x.w & 0xffffu)); o[7] = bf2f((bf16)(x.w >> 16)); }
__device__ __forceinline__ v4u pack8(const float (&o)[8]) { return (v4u){f2bf(o[0]) | (f2bf(o[1]) << 16), f2bf(o[2]) | (f2bf(o[3]) << 16), f2bf(o[4]) | (f2bf(o[5]) << 16), f2bf(o[6]) | (f2bf(o[7]) << 16)}; }
__device__ __forceinline__ f32x4 mm16_gb(const LAS bf16* A, int lda, const bf16* B, int ldb, int K, f32x4 acc, int lane) {
    const int r = lane & 15, g = lane >> 4;
    const LAS bf16* ap = A + r * lda + 8 * g; const bf16* bp = B + r * ldb + 8 * g;
    for (int k0 = 0; k0 < K; k0 += 32) { const s16x8 a = *(const LAS s16x8*)(ap + k0); const s16x8 b = *(const s16x8*)(bp + k0); acc = __builtin_amdgcn_mfma_f32_16x16x32_bf16(a, b, acc, 0, 0, 0); }
    return acc;
}

__device__ __forceinline__ void ph_rwkv_a(const Ctx& C, const bf16* PR, const bf16* VL  , const RwkvW& W, int layer,
                                          bf16* PP, bf16* QQ, bf16* RH, bf16* YH, float* GAMC, float* RK, bf16* GG, bf16* VF, bool store_v = true) {
    LAS unsigned char* L = C.lds;
    LAS bf16* X = (LAS bf16*)(L + RW_R0); LAS float* CUM = (LAS float*)(L + RW_R0); LAS float* SEG = (LAS float*)(L + RW_SEG);
    LAS bf16* NI = (LAS bf16*)(L + RW_R0), *AAK = NI + 64 * RW_LD, *ARB = AAK + 64 * RW_LD, *ARK = ARB + 64 * RW_LD;
    LAS bf16* PRE = (LAS bf16*)(L + RW_R1);
    LAS bf16* AT = (LAS bf16*)(L + RW_R1), *BT = AT + 64 * RW_LD, *KT = BT + 64 * RW_LD, *RT = (LAS bf16*)(L + RW_R2);
    LAS bf16* XB16 = (LAS bf16*)(L + RW_R1);
    LAS bf16* BHc = (LAS bf16*)(L + RW_R3), *KHc = BHc + 64 * RW_LD, *VTc = KHc + 64 * RW_LD;
    LAS float* XT = (LAS float*)(L + RW_R4); LAS bf16* TI = (LAS bf16*)(L + RW_TI);
    const int wave = C.wave;
    for (int item = C.bid; item < 4096; item += C.nb) {
        int tid_ = C.tid; asm volatile("" : "+v"(tid_));
        const int tid = tid_, lane = tid & 63, cc = lane & 15, g = lane >> 4;
        const int h = item & 7, c = (item >> 3) & 127, b = item >> 10;
        const size_t m0 = (size_t)b * T_ + c * 64;
        for (int idx = tid; idx < 64 * 36; idx += NT) {
            const int t = idx / 36, q = idx % 36, col = q * 8; const size_t m = m0 + t; const bool first = (c == 0 && t == 0);
            v4u cur, prv; float mu[8];
            if (q < 32) { cur = *(const v4u*)(PR + m * NPR + 1536 + col); prv = first ? (v4u){0u, 0u, 0u, 0u} : *(const v4u*)(PR + (m - 1) * NPR + 1536 + col);
                ld8f(W.mu + 1536 + col, mu); }
            else if (layer) { cur = *(const v4u*)(VL + m * NPG + 1552 + (col - 256)); prv = first ? (v4u){0u, 0u, 0u, 0u} : *(const v4u*)(VL + (m - 1) * NPG + 1552 + (col - 256));
                ld8f(W.mu_vres + (col - 256), mu); }
            else { cur = (v4u){0u, 0u, 0u, 0u}; prv = cur;
#pragma unroll
                for (int i = 0; i < 8; ++i) mu[i] = 0.f; }
            float cv[8], pv[8]; unpack8(cur, cv); unpack8(prv, pv);
#pragma unroll
            for (int i = 0; i < 8; ++i) { float p = cv[i] + (pv[i] - cv[i]) * mu[i]; if (q < 8) p = tanh_fast(p); else if (q >= 16 && q < 32) p = sigmoidf_(p); cv[i] = p; }
            *(LAS v4u*)(X + t * RW_XLD + col) = pack8(cv);
        }
        __syncthreads();
        {
            const int lsel = wave >> 1;
            const bf16* WT = lsel == 0 ? W.wupT : lsel == 1 ? W.aupT : lsel == 2 ? W.gupT : W.vupT;
            const int Kl = lsel == 2 ? 128 : lsel == 3 ? 32 : 64, xoff = lsel == 0 ? 0 : lsel == 1 ? 64 : lsel == 2 ? 128 : 256;
            LAS bf16* outp = PRE + lsel * 64 * RW_LD;
            const bool live = (lsel != 3 || layer);
#pragma unroll
            for (int mq = 0; mq < 2; ++mq) { const int mt = (wave & 1) * 2 + mq;
                s16x8 af[4];
                const bf16* ap = WT + (size_t)(h * 64 + mt * 16 + cc) * Kl + 8 * g;
#pragma unroll
                for (int ks = 0; ks < 4; ++ks) af[ks] = (live && ks * 32 < Kl) ? *(const s16x8*)(ap + ks * 32) : (s16x8){0, 0, 0, 0, 0, 0, 0, 0};
#pragma unroll
                for (int nt = 0; nt < 4; ++nt) { f32x4 acc = {0.f, 0.f, 0.f, 0.f};
                    const LAS bf16* bp = X + (nt * 16 + cc) * RW_XLD + xoff + 8 * g;
#pragma unroll
                    for (int ks = 0; ks < 4; ++ks) if (ks * 32 < Kl) { const s16x8 bb = *(const LAS s16x8*)(bp + ks * 32); acc = __builtin_amdgcn_mfma_f32_16x16x32_bf16(af[ks], bb, acc, 0, 0, 0); }
                    *(LAS unsigned long long*)(outp + (nt * 16 + cc) * RW_LD + mt * 16 + 4 * g) = pack4(acc); } }
        }
        __syncthreads();
        const int t = tid >> 3, d0 = (tid & 7) * 8, ch = h * 64 + d0; const size_t m = m0 + t; const bool first = (c == 0 && t == 0);
        float av[8], bv[8], kv[8], rv[8], lw[8], vv[8];
        {
            float rc[8], rp[8], kc[8], kp[8], vc[8], vp[8], pw[8], pa[8], pg_[8], pvg[8];
            unpack8(*(const v4u*)(PR + m * NPR + ch), rc); unpack8(*(const v4u*)(PR + m * NPR + 512 + ch), kc); unpack8(*(const v4u*)(PR + m * NPR + 1024 + ch), vc);
            if (first) {
#pragma unroll
                for (int i = 0; i < 8; ++i) { rp[i] = 0.f; kp[i] = 0.f; vp[i] = 0.f; } }
            else { unpack8(*(const v4u*)(PR + (m - 1) * NPR + ch), rp); unpack8(*(const v4u*)(PR + (m - 1) * NPR + 512 + ch), kp); unpack8(*(const v4u*)(PR + (m - 1) * NPR + 1024 + ch), vp); }
            unpack8(*(const LAS v4u*)(PRE + (0 * 64 + t) * RW_LD + d0), pw); unpack8(*(const LAS v4u*)(PRE + (1 * 64 + t) * RW_LD + d0), pa);
            unpack8(*(const LAS v4u*)(PRE + (2 * 64 + t) * RW_LD + d0), pg_); unpack8(*(const LAS v4u*)(PRE + (3 * 64 + t) * RW_LD + d0), pvg);
            float vf[8];
            if (layer) unpack8(*(const v4u*)(VF + m * 512 + ch), vf);
            float ssq = 0.f, rks = 0.f, asg[8], gg[8];
            float mur[8], muk[8], muv[8], w0c[8], a0c[8], v0c[8], kkc[8], kac[8], rkc[8];
            ld8f(W.mu + ch, mur); ld8f(W.mu + 512 + ch, muk); ld8f(W.mu + 1024 + ch, muv); ld8f(W.w0 + ch, w0c); ld8f(W.a0 + ch, a0c);
            ld8f(W.k_k + ch, kkc); ld8f(W.k_a + ch, kac); ld8f(W.r_k + ch, rkc);
            if (layer) ld8f(W.v0 + ch, v0c);
#pragma unroll
            for (int i = 0; i < 8; ++i) {
                const float r = rc[i] + (rp[i] - rc[i]) * mur[i], k = kc[i] + (kp[i] - kc[i]) * muk[i]; float v = vc[i] + (vp[i] - vc[i]) * muv[i];
                lw[i] = -__expf(-softplus_fast(-(w0c[i] + pw[i])) - 0.5f);
                asg[i] = sigmoidf_(a0c[i] + pa[i]);
                if (layer) v = v + (vf[i] - v) * sigmoidf_(v0c[i] + pvg[i]);
                const float kk = k * kkc[i]; ssq += kk * kk;
                kv[i] = k * (1.f + (asg[i] - 1.f) * kac[i]); rv[i] = r; vv[i] = v; gg[i] = pg_[i]; av[i] = kk;
                rks += r * kv[i] * rkc[i];
            }
            ssq = sum8(ssq); rks = sum8(rks);
            const float inv = 1.f / sqrtf(fmaxf(ssq, 1e-24f));
#pragma unroll
            for (int i = 0; i < 8; ++i) { const float kk = av[i] * inv; av[i] = -kk; bv[i] = kk * asg[i]; }
            if ((tid & 7) == 0) RK[m * 8 + h] = rks;
            *(v4u*)(GG + m * 512 + ch) = pack8(gg);
            if (store_v) *(v4u*)(VF + m * 512 + ch) = pack8(vv);
#pragma unroll
            for (int i = 0; i < 8; ++i) vv[i] = bf2f((bf16)f2bf(vv[i]));
        }
        __syncthreads();
#pragma unroll
        for (int i = 0; i < 8; ++i) CUM[t * 64 + d0 + i] = lw[i];
        __syncthreads();
        { const int d = tid & 63, seg = tid >> 6; float run = 0.f;
#pragma unroll
          for (int q = 0; q < 8; ++q) { run += CUM[(seg * 8 + q) * 64 + d]; CUM[(seg * 8 + q) * 64 + d] = run; }
          SEG[seg * 64 + d] = run; }
        __syncthreads();
        { const int d = tid & 63, seg = tid >> 6; float off = 0.f;
          for (int s = 0; s < seg; ++s) off += SEG[s * 64 + d];
#pragma unroll
          for (int q = 0; q < 8; ++q) CUM[(seg * 8 + q) * 64 + d] += off; }
        __syncthreads();
        {
            float at[8], bt[8], kt[8], rt[8];
#pragma unroll
            for (int i = 0; i < 8; ++i) { const float cu = CUM[t * 64 + d0 + i], cC = CUM[63 * 64 + d0 + i], en = __expf(-cu), ec = __expf(cC - cu);
                at[i] = av[i] * __expf(cu - lw[i]); bt[i] = bv[i] * en; kt[i] = kv[i] * en; rt[i] = rv[i] * __expf(cu);
                BHc[(d0 + i) * RW_LD + t] = (bf16)f2bf(bv[i] * ec); KHc[(d0 + i) * RW_LD + t] = (bf16)f2bf(kv[i] * ec); VTc[(d0 + i) * RW_LD + t] = (bf16)f2bf(vv[i]);
                XT[(d0 + i) * RW_FLD + t] = bf2f((bf16)f2bf(at[i]));
                if (t == 63) GAMC[(size_t)item * 64 + d0 + i] = __expf(cC); }
            *(LAS v4u*)(AT + t * RW_LD + d0) = pack8(at); *(LAS v4u*)(BT + t * RW_LD + d0) = pack8(bt); *(LAS v4u*)(KT + t * RW_LD + d0) = pack8(kt); *(LAS v4u*)(RT + t * RW_LD + d0) = pack8(rt);
        }
        __syncthreads();
        {
            const int msel = wave >> 1;
            const LAS bf16* As = (msel == 0 || msel == 2) ? BT : KT; const LAS bf16* Bs = (msel < 2) ? AT : RT;
            f32x4 accs[8];
#pragma unroll
            for (int q = 0; q < 8; ++q) { const int tile = (wave & 1) * 8 + q, mt = tile >> 2, nt = tile & 3; accs[q] = (f32x4){0.f, 0.f, 0.f, 0.f};
                accs[q] = mm16(As + mt * 16 * RW_LD, RW_LD, Bs + nt * 16 * RW_LD, RW_LD, 64, accs[q], lane);
                const int tt = nt * 16 + cc, s0 = mt * 16 + 4 * g, lim = (msel < 2) ? tt - 1 : tt;
                accs[q].x = (s0 + 0 <= lim) ? accs[q].x : 0.f; accs[q].y = (s0 + 1 <= lim) ? accs[q].y : 0.f; accs[q].z = (s0 + 2 <= lim) ? accs[q].z : 0.f; accs[q].w = (s0 + 3 <= lim) ? accs[q].w : 0.f; }
            __syncthreads();
            LAS bf16* outp = NI + msel * 64 * RW_LD;
#pragma unroll
            for (int q = 0; q < 8; ++q) { const int tile = (wave & 1) * 8 + q, mt = tile >> 2, nt = tile & 3;
                *(LAS unsigned long long*)(outp + (nt * 16 + cc) * RW_LD + mt * 16 + 4 * g) = pack4(accs[q]); }
        }
        __syncthreads();
        if (wave == 0) {
            const int blk = lane >> 4, col = lane & 15; float x[16];
#pragma unroll
            for (int tt = 0; tt < 16; ++tt) { float nr[16]; { float lo[8], hi[8]; unpack8(*(const LAS v4u*)(NI + (16 * blk + tt) * RW_LD + 16 * blk), lo); unpack8(*(const LAS v4u*)(NI + (16 * blk + tt) * RW_LD + 16 * blk + 8), hi);
#pragma unroll
                    for (int q = 0; q < 8; ++q) { nr[q] = lo[q]; nr[8 + q] = hi[q]; } }
                float a = (tt == col) ? 1.f : 0.f;
#pragma unroll
                for (int q = 0; q < tt; ++q) a += nr[q] * x[q];
                x[tt] = a; TI[(blk * 16 + tt) * 16 + col] = (bf16)f2bf(a); }
        } else {
            for (int tile = wave - 1; tile < 16; tile += 7) { const int mt = tile >> 2, nt = tile & 3;
                f32x4 acc = {0.f, 0.f, 0.f, 0.f}; acc = mm16(AAK + mt * 16 * RW_LD, RW_LD, VTc + nt * 16 * RW_LD, RW_LD, 64, acc, lane);
                *(LAS f32x4*)(XT + (64 + nt * 16 + cc) * RW_FLD + mt * 16 + 4 * g) = acc; }
        }
        __syncthreads();
        {
            s16x4 xb[4];
#pragma unroll
            for (int i = 0; i < 4; ++i) {
                f32x4 acc = *(const LAS f32x4*)(XT + (wave * 16 + cc) * RW_FLD + 16 * i + 4 * g);
#pragma unroll
                for (int k = 0; k < i; ++k) { const s16x4 a = *(const LAS s16x4*)(NI + (16 * i + cc) * RW_LD + 16 * k + 4 * g); acc = __builtin_amdgcn_mfma_f32_16x16x16bf16_1k(a, xb[k], acc, 0, 0, 0); }
                const s16x4 yb = cvt4(acc), ta = *(const LAS s16x4*)(TI + (i * 16 + cc) * 16 + 4 * g);
                const f32x4 xi = __builtin_amdgcn_mfma_f32_16x16x16bf16_1k(ta, yb, (f32x4){0.f, 0.f, 0.f, 0.f}, 0, 0, 0);
                xb[i] = cvt4(xi);
            }
            __syncthreads();
#pragma unroll
            for (int i = 0; i < 4; ++i) *(LAS s16x4*)(XB16 + (wave * 16 + cc) * RW_LD + 16 * i + 4 * g) = xb[i];
        }
        __syncthreads();
        {
            const int osel = wave >> 1; const size_t ob = (size_t)item * 4096;
#pragma unroll 1
            for (int q = 0; q < 8; ++q) { const int tile = (wave & 1) * 8 + q, mt = tile >> 2, nt = tile & 3; f32x4 acc = {0.f, 0.f, 0.f, 0.f};
                if (osel == 0) {
                    acc = mm16(XB16 + mt * 16 * RW_LD, RW_LD, BHc + nt * 16 * RW_LD, RW_LD, 64, acc, lane);
                    *(unsigned long long*)(PP + ob + (nt * 16 + cc) * 64 + mt * 16 + 4 * g) = pack4(acc);
                } else if (osel == 1) {
                    acc = mm16(BHc + mt * 16 * RW_LD, RW_LD, XB16 + (64 + nt * 16) * RW_LD, RW_LD, 64, acc, lane);
                    acc = mm16(KHc + mt * 16 * RW_LD, RW_LD, VTc + nt * 16 * RW_LD, RW_LD, 64, acc, lane);
                    *(unsigned long long*)(QQ + ob + (nt * 16 + cc) * 64 + mt * 16 + 4 * g) = pack4(acc);
                } else if (osel == 2) {
                    acc = mm16(XB16 + mt * 16 * RW_LD, RW_LD, ARB + nt * 16 * RW_LD, RW_LD, 64, acc, lane);
                    const unsigned long long rr = *(const LAS unsigned long long*)(RT + (nt * 16 + cc) * RW_LD + mt * 16 + 4 * g);
                    acc.x += bf2f((bf16)(rr & 0xffffu)); acc.y += bf2f((bf16)((rr >> 16) & 0xffffu)); acc.z += bf2f((bf16)((rr >> 32) & 0xffffu)); acc.w += bf2f((bf16)(rr >> 48));
                    *(unsigned long long*)(RH + ob + (nt * 16 + cc) * 64 + mt * 16 + 4 * g) = pack4(acc);
                } else {
                    acc = mm16(XB16 + (64 + mt * 16) * RW_LD, RW_LD, ARB + nt * 16 * RW_LD, RW_LD, 64, acc, lane);
                    acc = mm16(VTc + mt * 16 * RW_LD, RW_LD, ARK + nt * 16 * RW_LD, RW_LD, 64, acc, lane);
                    *(unsigned long long*)(YH + ob + (nt * 16 + cc) * 64 + mt * 16 + 4 * g) = pack4(acc);
                } }
        }
        __syncthreads();
    }
}

struct ChainOps { s16x8 a[4][2]; unsigned long long q[4]; f32x4 gm[4]; };
__device__ __forceinline__ void chain_load(ChainOps& o, const bf16* PP, const bf16* QQ, const float* GAMC, int item, int vt, int cc, int g) {
    const size_t ob = (size_t)item * 4096;
#pragma unroll
    for (int mt = 0; mt < 4; ++mt) {
        o.a[mt][0] = *(const s16x8*)(PP + ob + (mt * 16 + cc) * 64 + 8 * g); o.a[mt][1] = *(const s16x8*)(PP + ob + (mt * 16 + cc) * 64 + 32 + 8 * g);
        o.q[mt] = *(const unsigned long long*)(QQ + ob + (vt * 16 + cc) * 64 + mt * 16 + 4 * g);
        o.gm[mt] = *(const f32x4*)(GAMC + (size_t)item * 64 + mt * 16 + 4 * g); }
}
__device__ __forceinline__ void ph_rwkv_b(const Ctx& C, int wgi  , const bf16* PP, const bf16* QQ, const float* GAMC, bf16* S0) {
    const int lane = C.lane, wave = C.wave, cc = lane & 15, g = lane >> 4;
    const int bh = wgi * 2 + (wave >> 2), vt = wave & 3, b = bh >> 3, h = bh & 7;
    LAS bf16* SI = (LAS bf16*)(C.lds) + wave * 16 * RW_LD;
    f32x4 st[4];
#pragma unroll
    for (int mt = 0; mt < 4; ++mt) st[mt] = (f32x4){0.f, 0.f, 0.f, 0.f};
    ChainOps cur, nxt;
    chain_load(cur, PP, QQ, GAMC, (b * 128 + 0) * 8 + h, vt, cc, g);
    for (int c = 0; c < 128; ++c) {
        const int item = (b * 128 + c) * 8 + h; const size_t ob = (size_t)item * 4096;
        const int cn = c + 1 < 128 ? c + 1 : c;
        chain_load(nxt, PP, QQ, GAMC, (b * 128 + cn) * 8 + h, vt, cc, g);
#pragma unroll
        for (int mt = 0; mt < 4; ++mt) { const unsigned long long pk = pack4(st[mt]);
            *(unsigned long long*)(S0 + ob + (vt * 16 + cc) * 64 + mt * 16 + 4 * g) = pk; *(LAS unsigned long long*)(SI + cc * RW_LD + mt * 16 + 4 * g) = pk; }
        asm volatile("s_waitcnt lgkmcnt(0)" ::: "memory");
        const s16x8 b0 = *(const LAS s16x8*)(SI + cc * RW_LD + 8 * g), b1 = *(const LAS s16x8*)(SI + cc * RW_LD + 32 + 8 * g);
#pragma unroll
        for (int mt = 0; mt < 4; ++mt) {
            f32x4 acc; acc.x = cur.gm[mt].x * st[mt].x + bf2f((bf16)(cur.q[mt] & 0xffffu)); acc.y = cur.gm[mt].y * st[mt].y + bf2f((bf16)((cur.q[mt] >> 16) & 0xffffu));
            acc.z = cur.gm[mt].z * st[mt].z + bf2f((bf16)((cur.q[mt] >> 32) & 0xffffu)); acc.w = cur.gm[mt].w * st[mt].w + bf2f((bf16)(cur.q[mt] >> 48));
            acc = __builtin_amdgcn_mfma_f32_16x16x32_bf16(cur.a[mt][0], b0, acc, 0, 0, 0); acc = __builtin_amdgcn_mfma_f32_16x16x32_bf16(cur.a[mt][1], b1, acc, 0, 0, 0);
            st[mt] = acc; }
        asm volatile("s_waitcnt lgkmcnt(0)" ::: "memory");
        cur = nxt;
    }
}

__device__ __forceinline__ void ph_rwkv_c(const Ctx& C, const bf16* S0, const bf16* RH, const bf16* YH, const float* RK, const bf16* GG, const bf16* VF,
                                          const float* gn_g, const float* gn_b, bf16* O) {
    const int lane = C.lane, cc = lane & 15, g = lane >> 4;
    for (int item = C.bid * 8 + C.wave; item < 4096; item += C.nb * 8) {
        const int h = item & 7, c = (item >> 3) & 127, b = item >> 10; const size_t m0 = (size_t)b * T_ + c * 64, ob = (size_t)item * 4096;
        s16x8 af[4][2], bfr[4][2];
#pragma unroll
        for (int q = 0; q < 4; ++q)
#pragma unroll
            for (int k = 0; k < 2; ++k) { af[q][k] = *(const s16x8*)(S0 + ob + (q * 16 + cc) * 64 + k * 32 + 8 * g); bfr[q][k] = *(const s16x8*)(RH + ob + (q * 16 + cc) * 64 + k * 32 + 8 * g); }
#pragma unroll
        for (int nt = 0; nt < 4; ++nt) {
            const size_t m = m0 + nt * 16 + cc;
            f32x4 y[4]; float s1 = 0.f;
#pragma unroll
            for (int mt = 0; mt < 4; ++mt) { const unsigned long long yh = *(const unsigned long long*)(YH + ob + (nt * 16 + cc) * 64 + mt * 16 + 4 * g);
                f32x4 acc; acc.x = bf2f((bf16)(yh & 0xffffu)); acc.y = bf2f((bf16)((yh >> 16) & 0xffffu)); acc.z = bf2f((bf16)((yh >> 32) & 0xffffu)); acc.w = bf2f((bf16)(yh >> 48));
                acc = __builtin_amdgcn_mfma_f32_16x16x32_bf16(af[mt][0], bfr[nt][0], acc, 0, 0, 0); acc = __builtin_amdgcn_mfma_f32_16x16x32_bf16(af[mt][1], bfr[nt][1], acc, 0, 0, 0);
                y[mt] = acc; s1 += (acc.x + acc.y) + (acc.z + acc.w); }
            s1 += __shfl_xor(s1, 16); s1 += __shfl_xor(s1, 32);
            const float mean = s1 * (1.f / 64.f); float s2 = 0.f;
#pragma unroll
            for (int mt = 0; mt < 4; ++mt) { y[mt] = y[mt] - mean; s2 += (y[mt].x * y[mt].x + y[mt].y * y[mt].y) + (y[mt].z * y[mt].z + y[mt].w * y[mt].w); }
            s2 += __shfl_xor(s2, 16); s2 += __shfl_xor(s2, 32);
            const float rstd = 1.f / sqrtf(s2 * (1.f / 64.f) + 64e-5f), rk = RK[m * 8 + h];
#pragma unroll
            for (int mt = 0; mt < 4; ++mt) { const int v = h * 64 + mt * 16 + 4 * g;
                const f32x4 gg4 = *(const f32x4*)(gn_g + v), gb4 = *(const f32x4*)(gn_b + v);
                const unsigned long long vx = *(const unsigned long long*)(VF + m * 512 + v), gx = *(const unsigned long long*)(GG + m * 512 + v);
                f32x4 o;
                o.x = (y[mt].x * rstd * gg4.x + gb4.x + rk * bf2f((bf16)(vx & 0xffffu))) * bf2f((bf16)(gx & 0xffffu));
                o.y = (y[mt].y * rstd * gg4.y + gb4.y + rk * bf2f((bf16)((vx >> 16) & 0xffffu))) * bf2f((bf16)((gx >> 16) & 0xffffu));
                o.z = (y[mt].z * rstd * gg4.z + gb4.z + rk * bf2f((bf16)((vx >> 32) & 0xffffu))) * bf2f((bf16)((gx >> 32) & 0xffffu));
                o.w = (y[mt].w * rstd * gg4.w + gb4.w + rk * bf2f((bf16)(vx >> 48))) * bf2f((bf16)(gx >> 48));
                *(unsigned long long*)(O + m * D_ + 512 + v) = pack4(o); }
        }
    }
}

__device__ __forceinline__ void ph_conv(const Ctx& C, const bf16* U, const float* cw, const float* cb, bf16* ACT) {
    constexpr int TR = 32, NJB = DFF / 8, NTR = T_ / TR;
    for (int item = C.bid * NT + C.tid; item < NJB * NTR; item += C.nb * NT) {
        const int jb = item % NJB, tr = item / NJB, j = jb * 8, t0 = tr * TR;
        float wg[3][8], wv[3][8], bg[8], bv[8];
#pragma unroll
        for (int i = 0; i < 8; ++i) { bg[i] = cb[j + i]; bv[i] = cb[DFF + j + i];
#pragma unroll
            for (int k = 0; k < 3; ++k) { wg[k][i] = cw[k * NUP + j + i]; wv[k][i] = cw[k * NUP + DFF + j + i]; } }
        float g2[8], g1[8], v2[8], v1[8];
        if (t0 == 0) {
#pragma unroll
            for (int i = 0; i < 8; ++i) { g2[i] = 0.f; g1[i] = 0.f; v2[i] = 0.f; v1[i] = 0.f; } }
        else { unpack8(*(const v4u*)(U + (size_t)(t0 - 2) * NUP + j), g2); unpack8(*(const v4u*)(U + (size_t)(t0 - 1) * NUP + j), g1);
               unpack8(*(const v4u*)(U + (size_t)(t0 - 2) * NUP + DFF + j), v2); unpack8(*(const v4u*)(U + (size_t)(t0 - 1) * NUP + DFF + j), v1); }
#pragma unroll 4
        for (int tt = 0; tt < TR; ++tt) {
            const int t = t0 + tt; float g0[8], v0[8], o[8];
            unpack8(*(const v4u*)(U + (size_t)t * NUP + j), g0); unpack8(*(const v4u*)(U + (size_t)t * NUP + DFF + j), v0);
#pragma unroll
            for (int i = 0; i < 8; ++i) { const float gc = bg[i] + wg[0][i] * g2[i] + wg[1][i] * g1[i] + wg[2][i] * g0[i], vc = bv[i] + wv[0][i] * v2[i] + wv[1][i] * v1[i] + wv[2][i] * v0[i];
                o[i] = siluf_(gc) * vc; g2[i] = g1[i]; g1[i] = g0[i]; v2[i] = v1[i]; v1[i] = v0[i]; }
            *(v4u*)(ACT + (size_t)t * DFF + j) = pack8(o);
        }
    }
}
}

namespace pg8 {
struct EpiRes {
    static constexpr bool PERM = false, AFTER_DRAIN = false;
    const float* base; float* out; const float* gate; int gstride;
    __device__ __forceinline__ void operator()(const f32x4 (&acc)[2][2][4][2], const Unit& u, int wr, int wc, int fr, int fq) const {
        const int b = (u.pm * BM) / 8192; const float* gp = gate + (size_t)b * gstride;
        const int col0 = u.pn * BM + wc * 32 + 4 * fq;
#pragma unroll
        for (int ai = 0; ai < 2; ++ai)
#pragma unroll
            for (int m = 0; m < 4; ++m) { const size_t off = (size_t)(u.pm * BM + ai * HALF + wr * 64 + m * 16 + fr) * 1024 + col0;
#pragma unroll
                for (int bj = 0; bj < 2; ++bj)
#pragma unroll
                    for (int n = 0; n < 2; ++n) { const int cc = bj * HALF + n * 16; const f32x4 gv = *(const f32x4*)(gp + col0 + cc); const f32x4 bs = *(const f32x4*)(base + off + cc);
                        *(f32x4*)(out + off + cc) = bs + gv * acc[ai][bj][m][n]; } }
    }
};
}

namespace hy {
struct Args { const float* in[31]; float* out; unsigned char* ws; };
__global__ void __launch_bounds__(NT, 2) hy_fwd(Args A) {
    extern __shared__ __attribute__((aligned(16))) unsigned char lds_raw[];
    Ctx C; C.bid = blockIdx.x; C.nb = gridDim.x; C.tid = threadIdx.x; C.lane = C.tid & 63; C.wave = __builtin_amdgcn_readfirstlane(C.tid >> 6); C.lds = (LAS unsigned char*)lds_raw;
    volatile LAS unsigned* MISC = (volatile LAS unsigned*)(C.lds + MISC_OFF);
    for (int u = C.tid; u < (LDS_BYTES - MISC_OFF) / 4; u += NT) ((LAS unsigned*)(C.lds + MISC_OFF))[u] = 0u;
    __syncthreads();
    unsigned char* ws = A.ws;
    XcdBarrier bar = xcd_barrier_post((unsigned*)(ws + WS_CTL) + CW_BAR, MISC + 8);
#define PHASE_BEGIN() do { int t_ = threadIdx.x; asm volatile("" : "+v"(t_)); int b_ = blockIdx.x; asm volatile("" : "+s"(b_)); \
    C.tid = t_; C.lane = t_ & 63; C.wave = __builtin_amdgcn_readfirstlane(t_ >> 6); C.bid = b_; } while (0)
#ifdef HY_DIAG
    unsigned long long ts_last = __builtin_amdgcn_s_memrealtime(); float tacc[10] = {0.f, 0.f, 0.f, 0.f, 0.f, 0.f, 0.f, 0.f, 0.f, 0.f};
#define GRID_BAR(cat) do { xcd_barrier(bar); PHASE_BEGIN(); { const unsigned long long n_ = __builtin_amdgcn_s_memrealtime(); tacc[cat] += (float)(n_ - ts_last); ts_last = n_; } } while (0)
#else
#define GRID_BAR(cat) do { xcd_barrier(bar); PHASE_BEGIN(); } while (0)
#endif
#ifndef HY_REPCAT
#define HY_REPCAT (-1)
#endif
#define NREP(cat) ((HY_REPCAT == (cat)) ? 2 : 1)
    float* out = A.out;
#define in A.in
    float* MOD = (float*)(ws + WS_MOD);
    bf16 *WIN = (bf16*)(ws + WS_WIN), *WOUT = (bf16*)(ws + WS_WOUT), *WUP = (bf16*)(ws + WS_WUP), *WDN = (bf16*)(ws + WS_WDN);
    bf16 *XB = (bf16*)(ws + WS_XB), *O = (bf16*)(ws + WS_O), *VF = (bf16*)(ws + WS_VF), *PG = (bf16*)(ws + WS_PG), *PR = (bf16*)(ws + WS_PR), *VL = (bf16*)(ws + WS_VL);
    bf16 *RH = (bf16*)(ws + WS_RH), *YH = (bf16*)(ws + WS_YH), *PP = (bf16*)(ws + WS_PP), *QQ = (bf16*)(ws + WS_QQ), *GG = (bf16*)(ws + WS_GG), *S0 = (bf16*)(ws + WS_S0);
    float *GAMC = (float*)(ws + WS_GAMC), *RK = (float*)(ws + WS_RK);
    bf16* LORA = (bf16*)(ws + WS_LORA);
    bf16* DS = (bf16*)(ws + WS_GK); float* GAM = (float*)(ws + WS_GAM);
    bf16 *ACT = (bf16*)(ws + WS_ACT), *U = (bf16*)(ws + WS_U);

    ph_mod(C, in[1], in[2], in[3], MOD);
    for (int l = 0; l < L_; ++l) {
        const float* modl = MOD + (size_t)l * 4 * 6144;
        const float* xres = l ? out : in[0];
        for (int r_ = 0; r_ < NREP(0); ++r_) {
        wprep_mat(C, in[5] + (size_t)l * D_ * IN_COLS, D_, IN_COLS, NIN, WIN, 1, l ? in[6] : nullptr);
        wprep_mat(C, in[24] + (size_t)l * D_ * D_, D_, D_, D_, WOUT, 0, nullptr);
        wprep_mat(C, in[26] + (size_t)l * D_ * NUP, D_, NUP, NUP, WUP, 0, nullptr);
        wprep_mat(C, in[29] + (size_t)l * DFF * D_, DFF, D_, D_, WDN, 0, nullptr);
        wprep_mat(C, in[12] + (size_t)l * 64 * 512, 64, 512, 512, LORA, 0, nullptr);
        wprep_mat(C, in[14] + (size_t)l * 64 * 512, 64, 512, 512, LORA + 512 * 64, 0, nullptr);
        wprep_mat(C, in[16] + (size_t)l * 128 * 512, 128, 512, 512, LORA + 2 * 512 * 64, 0, nullptr);
        if (l) wprep_mat(C, in[17], 32, 512, 512, LORA + 2 * 512 * 64 + 512 * 128, 0, nullptr);
        }
        GRID_BAR(0);
        for (int r_ = 0; r_ < NREP(1); ++r_) ph_norm(C, xres, in[4] + l * D_, modl + 0 * D_, modl + 1 * D_, XB);
        GRID_BAR(1);
        for (int r_ = 0; r_ < NREP(2); ++r_) { pg8::Gemm g{XB, WIN, M_, NIN, D_}; pg8::StaticOrder S; S.init(M_, NIN, C.nb, C.bid);
          pg8::EpiBf16<0> E{PG, NPG, nullptr, NPG, (WS_PR - WS_PG) / 2, 1.f};
          pg8::gemm_phase<pg8::EpiBf16<0>, pg8::StaticOrder, true, true>(C.lds, g, S, E); }
        GRID_BAR(2);
        for (int r_ = 0; r_ < NREP(3); ++r_) {
        ph_gla_a(C, PG, in[7] + l * 16 * 256, in[8] + l * 256, DS, GAM, VL);
        { RwkvW W{in[10] + l * 1792, in[11], in[13] + l * 512, in[15] + l * 512, in[18], in[19] + l * 512, in[20] + l * 512, in[21] + l * 512,
                  LORA, LORA + 512 * 64, LORA + 2 * 512 * 64, LORA + 2 * 512 * 64 + 512 * 128};
          ph_rwkv_a(C, PR, PG, W, l, PP, QQ, RH, YH, GAMC, RK, GG, VF, r_ == NREP(3) - 1); } }
        GRID_BAR(3);
        if (C.bid < 16) { for (int r_ = 0; r_ < NREP(4); ++r_) ph_rwkv_b(C, C.bid, PP, QQ, GAMC, S0); }
        else { Ctx C2 = C; C2.bid = C.bid - 16; C2.nb = C.nb - 16; ph_gla_b(C2, DS, GAM); }
        GRID_BAR(4);
        for (int r_ = 0; r_ < NREP(5); ++r_) {
        ph_gla_c(C, PG, in[7] + l * 16 * 256, in[8] + l * 256, in[9] + l * 128, DS, O);
        ph_rwkv_c(C, S0, RH, YH, RK, GG, VF, in[22] + l * 512, in[23] + l * 512, O); }
        GRID_BAR(5);
        { pg8::Gemm g{O, WOUT, M_, D_, D_}; pg8::StaticOrder S; S.init(M_, D_, C.nb, C.bid);
          pg8::EpiRes E{xres, out, modl + 2 * D_, 6144};
          pg8::gemm_phase<pg8::EpiRes, pg8::StaticOrder, true, true>(C.lds, g, S, E); }
        GRID_BAR(6);
        for (int r_ = 0; r_ < NREP(1); ++r_) ph_norm(C, out, in[25] + l * D_, modl + 3 * D_, modl + 4 * D_, XB);
        GRID_BAR(1);
        for (int b = 0; b < B_; ++b) {
            for (int r_ = 0; r_ < NREP(7); ++r_) { pg8::Gemm g{XB + (size_t)b * T_ * D_, WUP, T_, NUP, D_}; pg8::StaticOrder S; S.init(T_, NUP, C.nb, C.bid);
              pg8::EpiBf16<0> E{U, NUP, nullptr, 0, 0, 1.f};
              pg8::gemm_phase<pg8::EpiBf16<0>, pg8::StaticOrder, true, true>(C.lds, g, S, E); }
            GRID_BAR(7);
            for (int r_ = 0; r_ < NREP(8); ++r_) ph_conv(C, U, in[27] + (size_t)l * 3 * NUP, in[28] + (size_t)l * NUP, ACT + (size_t)b * T_ * DFF);
            GRID_BAR(8);
        }
        { pg8::Gemm g{ACT, WDN, M_, D_, DFF}; pg8::StaticOrder S; S.init(M_, D_, C.nb, C.bid);
          pg8::EpiRes E{out, out, modl + 5 * D_, 6144};
          pg8::gemm_phase<pg8::EpiRes, pg8::StaticOrder, true, true>(C.lds, g, S, E); }
        GRID_BAR(9);
    }
    ph_final(C, out, in[30]);
#ifdef HY_DIAG
    GRID_BAR(1);
    if (C.bid == 0) { if (C.tid == 0) out[0] = tacc[HY_DIAG_A] * 0.1f; for (int i = 1 + C.tid; i <= 10000; i += NT) out[i] = tacc[HY_DIAG_B] * 0.01f; }
#endif
#undef GRID_BAR
#undef PHASE_BEGIN
#undef in
}
}

extern "C" void kernel_launch(void* const* d_in, const int* in_sizes, int n_in, void* d_out, int out_size, void* d_ws, size_t ws_size, hipStream_t stream) {
    using namespace hy;
    static int grid = 0;
    if (grid == 0) {
        if (n_in != 31 || in_sizes[0] != M_ * D_ || out_size != M_ * D_ || ws_size < WS_END) { fprintf(stderr, "kernel_launch: unexpected shapes (n_in %d, in0 %d, out %d, ws %zu)\n", n_in, n_in > 0 ? in_sizes[0] : -1, out_size, ws_size); grid = -1; return; }
        if (hipFuncSetAttribute((const void*)hy_fwd, hipFuncAttributeMaxDynamicSharedMemorySize, LDS_BYTES) != hipSuccess) { fprintf(stderr, "kernel_launch: hipFuncSetAttribute failed\n"); grid = -1; return; }
        int dev = 0, cus = 0, per_cu = 0;
        (void)hipGetDevice(&dev); (void)hipDeviceGetAttribute(&cus, hipDeviceAttributeMultiprocessorCount, dev);
        (void)hipOccupancyMaxActiveBlocksPerMultiprocessor(&per_cu, (const void*)hy_fwd, NT, LDS_BYTES);
        if (per_cu < 1) fprintf(stderr, "kernel_launch: occupancy query reports %d blocks per CU\n", per_cu);
        (void)hipGetLastError();
        grid = cus > 0 ? cus : 256;
    }
    if (grid < 0) return;
    (void)hipMemsetAsync((char*)d_ws + WS_CTL, 0, CTL_ZERO_BYTES, stream);
    Args a{};
    for (int i = 0; i < 31; ++i) a.in[i] = (const float*)d_in[i];
    a.out = (float*)d_out; a.ws = (unsigned char*)d_ws;
    hipLaunchKernelGGL(hy_fwd, dim3(grid), dim3(NT), LDS_BYTES, stream, a);
}
```

```cpp
#include <hip/hip_runtime.h>
#include <cstdio>
#include <cstdint>
namespace pg8 {
#define PG8_LAS __attribute__((address_space(3)))
typedef unsigned short bf16_t;
typedef short bf16x8 __attribute__((ext_vector_type(8)));
typedef float f32x4 __attribute__((ext_vector_type(4)));
typedef unsigned u32x4 __attribute__((ext_vector_type(4)));
constexpr int BM = 256, BK = 64, HALF = 128, HTB = HALF * BK * 2  , STAGE_BYTES = 8 * HTB, NXCD = 8, WGM = 8;

__host__ __device__ __forceinline__ int lds_byte(int r, int c) { const int st = (r >> 4) * 2 + (c >> 5), rr = r & 15, cc = c & 31, ob = rr * 64 + cc * 2; return st * 1024 + (ob ^ (((ob >> 9) & 1) << 5)); }
__host__ __device__ __forceinline__ void stage_rc(int b, int& R, int& C) { const int st = b / 1024, sb = b % 1024, swz = sb ^ (((sb >> 9) & 1) << 5); R = (st >> 1) * 16 + swz / 64; C = (st & 1) * 32 + (swz % 64) / 2; }
__host__ __device__ __forceinline__ int perm32(int rho) { const int n = rho >> 4, i = rho & 15; return 8 * (i >> 2) + 4 * n + (i & 3); }

struct Unit { int pm, pn; };
struct Gemm { const bf16_t* A; const bf16_t* Bt; int M, N, K; };

struct StaticOrder {
    int nM, nN, nwg, G, c;
    __host__ __device__ void init(int M, int N, int G_, int c_) { nM = M / BM; nN = N / BM; nwg = nM * nN; G = G_; c = c_; }
    __host__ __device__ bool next(int i, Unit& u) const {
        const long L = (long)i * G + c; if (L >= nwg) return false;
        int wgid = (int)L; { const int q = nwg / NXCD, r = nwg % NXCD, xcd = wgid % NXCD, off = wgid / NXCD; wgid = (xcd < r ? xcd * (q + 1) : r * (q + 1) + (xcd - r) * q) + off; }
        const int nig = WGM * nN, gid = wgid / nig, fm = gid * WGM, gsz = (nM - fm) < WGM ? (nM - fm) : WGM;
        u.pm = fm + ((wgid % nig) % gsz); u.pn = (wgid % nig) / gsz; return true;
    }
    __device__ __forceinline__ void a_ready(const Unit&) const {}
    __device__ __forceinline__ void done(const Unit&) const {}
};

__device__ __forceinline__ unsigned cvt_pk_bf16(float lo, float hi) { unsigned r; asm volatile("v_cvt_pk_bf16_f32 %0, %1, %2" : "=v"(r) : "v"(lo), "v"(hi)); return r; }
typedef float f32x2 __attribute__((ext_vector_type(2)));
__device__ __forceinline__ f32x2 gelu_pk(f32x2 v) {
    const f32x2 av = __builtin_elementwise_abs(v), d = av * 0.2316418882f + 1.0f;
    f32x2 t; t.x = __builtin_amdgcn_rcpf(d.x); t.y = __builtin_amdgcn_rcpf(d.y);
    f32x2 q = t * 0.5307027145f + (-0.7265760135f); q = q * t + 0.7107068705f; q = q * t + (-0.142248368f); q = q * t + 0.127414796f; q = q * t;
    const f32x2 s = (v * v) * (-0.72134752044f);
    f32x2 e; e.x = __builtin_amdgcn_exp2f(s.x); e.y = __builtin_amdgcn_exp2f(s.y);
    const f32x2 m = v * (q * e), r = v - m;
    f32x2 o; o.x = v.x < 0.f ? m.x : r.x; o.y = v.y < 0.f ? m.y : r.y; return o;
}

template <int ACT  > struct EpiBf16 {
    static constexpr bool PERM = true, AFTER_DRAIN = false; static_assert(ACT == 0 || ACT == 1, "EpiBf16: ACT is 0 (none) or 1 (gelu_pk)");
    bf16_t* O; int ldc; const float* bias; int split_cols; size_t split_stride; float scale0;
    __device__ __forceinline__ void operator()(const f32x4 (&acc)[2][2][4][2], const Unit& u, int wr, int wc, int fr, int fq) const {
        const int row0 = u.pm * BM + wr * 64 + fr; int colt = u.pn * BM; bf16_t* base = O;
        float sc = 1.f; if (split_cols) { const int t = colt / split_cols; base += (size_t)t * split_stride; colt -= t * split_cols; if (t == 0) sc = scale0; }
        const int col0 = colt + wc * 32 + 8 * fq, bcol0 = u.pn * BM + wc * 32 + 8 * fq;
        f32x4 bv[2][2];
#pragma unroll
        for (int bj = 0; bj < 2; ++bj)
#pragma unroll
            for (int n = 0; n < 2; ++n) bv[bj][n] = bias ? *(const f32x4*)(bias + bcol0 + bj * HALF + 4 * n) : (f32x4){0.f, 0.f, 0.f, 0.f};
#pragma unroll
        for (int ai = 0; ai < 2; ++ai)
#pragma unroll
            for (int m = 0; m < 4; ++m) { bf16_t* rowp = base + (size_t)(row0 + ai * HALF + m * 16) * ldc + col0;
#pragma unroll
                for (int bj = 0; bj < 2; ++bj) { f32x4 v0 = acc[ai][bj][m][0] + bv[bj][0], v1 = acc[ai][bj][m][1] + bv[bj][1];
                    if (ACT == 1) { f32x2 a = gelu_pk((f32x2){v0[0], v0[1]}), b = gelu_pk((f32x2){v0[2], v0[3]}), c = gelu_pk((f32x2){v1[0], v1[1]}), d = gelu_pk((f32x2){v1[2], v1[3]});
                        v0 = (f32x4){a.x, a.y, b.x, b.y}; v1 = (f32x4){c.x, c.y, d.x, d.y}; }
                    v0 = v0 * sc; v1 = v1 * sc; u32x4 w; w.x = cvt_pk_bf16(v0[0], v0[1]); w.y = cvt_pk_bf16(v0[2], v0[3]); w.z = cvt_pk_bf16(v1[0], v1[1]); w.w = cvt_pk_bf16(v1[2], v1[3]);
                    *(u32x4*)(rowp + bj * HALF) = w; } }
    }
};
template <class Epi, class Sched, bool ALIGN_EPI = false, bool SP2 = false>
__device__ __forceinline__ void gemm_phase(PG8_LAS unsigned char* lds, const Gemm g, const Sched& S, const Epi& E) {
    int tid_ = threadIdx.x; asm volatile("" : "+v"(tid_));
    const int tid = tid_, wid = __builtin_amdgcn_readfirstlane(tid >> 6), lane = tid & 63, wr = wid >> 2, wc = wid & 3, fr = lane & 15, fq = lane >> 4;
    const int K = g.K, nt = K / BK;
    unsigned voffA[2], voffB[2];
#pragma unroll
    for (int i = 0; i < 2; ++i) { int R, C; stage_rc(tid * 16 + i * 8192, R, C); const int Rb = Epi::PERM ? ((R & ~31) + perm32(R & 31)) : R;
        voffA[i] = (unsigned)(R * K + C) * 2u; voffB[i] = (unsigned)(Rb * K + C) * 2u; }
    const size_t kstep = (size_t)(BK * 2);
    const size_t hstep = (size_t)HALF * K * 2;
    const size_t tstep = 2 * hstep;
    const unsigned ldsw = (unsigned)wid * 1024u;
    const int aoff = lds_byte(wr * 64 + fr, fq * 8), boff = lds_byte(wc * 32 + fr, fq * 8);
#define PG8_SA(b, h) (((b) * 2 + (h)) * HTB)
#define PG8_SB(b, h) ((4 + (b) * 2 + (h)) * HTB)
#define PG8_STAGE(bufoff, gbase, voff) do { _Pragma("unroll") for (int _i = 0; _i < 2; ++_i) \
        __builtin_amdgcn_global_load_lds((const unsigned*)((const char*)(gbase) + (voff)[_i]), (PG8_LAS unsigned*)(lds + (bufoff) + ldsw + _i * 8192), 16, 0, 0); } while (0)
#define PG8_LDA(dst, b, h) do { _Pragma("unroll") for (int m = 0; m < 4; ++m) _Pragma("unroll") for (int k = 0; k < 2; ++k) dst[m][k] = *(const PG8_LAS bf16x8*)(lds + PG8_SA(b, h) + aoff + m * 2048 + k * 1024); } while (0)
#define PG8_LDB(dst, b, h) do { _Pragma("unroll") for (int n = 0; n < 2; ++n) _Pragma("unroll") for (int k = 0; k < 2; ++k) dst[n][k] = *(const PG8_LAS bf16x8*)(lds + PG8_SB(b, h) + boff + n * 2048 + k * 1024); } while (0)
#define PG8_MMA(ai, bj, At, Bt) do { __builtin_amdgcn_s_setprio(1); _Pragma("unroll") for (int m = 0; m < 4; ++m) _Pragma("unroll") for (int n = 0; n < 2; ++n) _Pragma("unroll") for (int k = 0; k < 2; ++k) \
        acc[ai][bj][m][n] = __builtin_amdgcn_mfma_f32_16x16x32_bf16(Bt[n][k], At[m][k], acc[ai][bj][m][n], 0, 0, 0); __builtin_amdgcn_s_setprio(0); } while (0)
#define PG8_WAIT_V(n) asm volatile("s_waitcnt vmcnt(" #n ")" ::: "memory")
#define PG8_WAIT_L(n) asm volatile("s_waitcnt lgkmcnt(" #n ")" ::: "memory")
#define PG8_BAR __builtin_amdgcn_s_barrier()
#define PG8_SCHED __builtin_amdgcn_sched_barrier(0)
    Unit cur, nxt; int ui = 0;
    if (!S.next(0, cur)) return;
    f32x4 acc[2][2][4][2];
#pragma unroll
    for (int a = 0; a < 2; ++a)
#pragma unroll
        for (int b = 0; b < 2; ++b)
#pragma unroll
            for (int m = 0; m < 4; ++m)
#pragma unroll
                for (int n = 0; n < 2; ++n) acc[a][b][m][n] = (f32x4){0.f, 0.f, 0.f, 0.f};
    bf16x8 At[4][2], B0[2][2], B1[2][2];
    const char* cA = (const char*)g.A + (size_t)cur.pm * tstep; const char* cB = (const char*)g.Bt + (size_t)cur.pn * tstep;
    S.a_ready(cur);
    if constexpr (SP2) {
        PG8_STAGE(PG8_SB(0, 0), cB, voffB); PG8_STAGE(PG8_SB(0, 1), cB + hstep, voffB); PG8_STAGE(PG8_SA(0, 0), cA, voffA); PG8_STAGE(PG8_SA(0, 1), cA + hstep, voffA);
        if (wr == 1) PG8_BAR;
        PG8_WAIT_V(2); PG8_BAR;
        PG8_STAGE(PG8_SB(1, 0), cB + kstep, voffB); PG8_STAGE(PG8_SA(1, 0), cA + kstep, voffA); PG8_STAGE(PG8_SB(1, 1), cB + hstep + kstep, voffB);
        PG8_WAIT_V(6); PG8_BAR;
    } else {
        PG8_STAGE(PG8_SB(0, 0), cB, voffB); PG8_STAGE(PG8_SA(0, 0), cA, voffA); PG8_STAGE(PG8_SB(0, 1), cB + hstep, voffB); PG8_STAGE(PG8_SA(0, 1), cA + hstep, voffA);
        if (wr == 1) PG8_BAR;
        PG8_WAIT_V(4); PG8_BAR;
        PG8_STAGE(PG8_SB(1, 0), cB + kstep, voffB); PG8_STAGE(PG8_SA(1, 0), cA + kstep, voffA); PG8_STAGE(PG8_SB(1, 1), cB + hstep + kstep, voffB);
        PG8_WAIT_V(6); PG8_BAR;
    }
    for (;;) {
        const bool has_next = S.next(ui + 1, nxt);
        const char* nA = has_next ? (const char*)g.A + (size_t)nxt.pm * tstep : cA; const char* nB = has_next ? (const char*)g.Bt + (size_t)nxt.pn * tstep : cB;
        for (int t = 0; t < nt; t += 2) {
            const bool last = (t == nt - 2);
            const char* a1 = cA + (size_t)(t + 1) * kstep;
            const char* a2 = last ? nA : cA + (size_t)(t + 2) * kstep; const char* b2 = last ? nB : cB + (size_t)(t + 2) * kstep;
            const char* a3 = a2 + kstep; const char* b3 = b2 + kstep;
            if (last && has_next) S.a_ready(nxt);
            if constexpr (SP2) {
            PG8_LDB(B0, 0, 0); PG8_LDB(B1, 0, 1); PG8_SCHED; PG8_LDA(At, 0, 0); PG8_STAGE(PG8_SA(1, 1), a1 + hstep, voffA);
            PG8_WAIT_V(8); PG8_WAIT_L(0); PG8_BAR; PG8_MMA(0, 0, At, B0); PG8_MMA(0, 1, At, B1); PG8_BAR; PG8_SCHED;
            PG8_LDA(At, 0, 1); PG8_STAGE(PG8_SB(0, 0), b2, voffB); PG8_STAGE(PG8_SB(0, 1), b2 + hstep, voffB); PG8_STAGE(PG8_SA(0, 0), a2, voffA);
            PG8_WAIT_V(8); PG8_WAIT_L(0); PG8_BAR; PG8_MMA(1, 0, At, B0); PG8_MMA(1, 1, At, B1); PG8_BAR; PG8_SCHED;
            PG8_LDB(B0, 1, 0); PG8_LDB(B1, 1, 1); PG8_SCHED; PG8_LDA(At, 1, 0); PG8_STAGE(PG8_SA(0, 1), a2 + hstep, voffA);
            PG8_WAIT_V(8); PG8_WAIT_L(0); PG8_BAR; PG8_MMA(0, 0, At, B0); PG8_MMA(0, 1, At, B1); PG8_BAR; PG8_SCHED;
            PG8_LDA(At, 1, 1); PG8_STAGE(PG8_SB(1, 0), b3, voffB); PG8_STAGE(PG8_SB(1, 1), b3 + hstep, voffB); PG8_STAGE(PG8_SA(1, 0), a3, voffA);
            PG8_WAIT_V(8); PG8_WAIT_L(0); PG8_BAR; PG8_MMA(1, 0, At, B0); PG8_MMA(1, 1, At, B1); PG8_BAR; PG8_SCHED;
            } else {
            PG8_LDB(B0, 0, 0); PG8_SCHED; PG8_LDA(At, 0, 0); PG8_STAGE(PG8_SA(1, 1), a1 + hstep, voffA);
            PG8_WAIT_L(8); PG8_BAR; PG8_WAIT_L(0); PG8_MMA(0, 0, At, B0); PG8_BAR; PG8_SCHED;
            PG8_LDB(B1, 0, 1); PG8_STAGE(PG8_SB(0, 0), b2, voffB);
            PG8_BAR; PG8_WAIT_L(0); PG8_MMA(0, 1, At, B1); PG8_BAR;
            PG8_LDA(At, 0, 1); PG8_STAGE(PG8_SA(0, 0), a2, voffA);
            PG8_BAR; PG8_WAIT_L(0); PG8_MMA(1, 0, At, B0); PG8_BAR; PG8_SCHED;
            PG8_STAGE(PG8_SB(0, 1), b2 + hstep, voffB);
            PG8_WAIT_V(6); PG8_BAR; PG8_MMA(1, 1, At, B1); PG8_BAR;
            PG8_LDB(B0, 1, 0); PG8_SCHED; PG8_LDA(At, 1, 0); PG8_STAGE(PG8_SA(0, 1), a2 + hstep, voffA);
            PG8_WAIT_L(8); PG8_BAR; PG8_WAIT_L(0); PG8_MMA(0, 0, At, B0); PG8_BAR; PG8_SCHED;
            PG8_LDB(B1, 1, 1); PG8_STAGE(PG8_SB(1, 0), b3, voffB);
            PG8_BAR; PG8_WAIT_L(0); PG8_MMA(0, 1, At, B1); PG8_BAR;
            PG8_LDA(At, 1, 1); PG8_STAGE(PG8_SA(1, 0), a3, voffA);
            PG8_BAR; PG8_WAIT_L(0); PG8_MMA(1, 0, At, B0); PG8_BAR; PG8_SCHED;
            PG8_STAGE(PG8_SB(1, 1), b3 + hstep, voffB);
            PG8_WAIT_V(6); PG8_BAR; PG8_MMA(1, 1, At, B1); PG8_BAR;
            }
        }
        if constexpr (ALIGN_EPI) { if (wr == 0) PG8_BAR; }
        if constexpr (!Epi::AFTER_DRAIN) { E(acc, cur, wr, wc, fr, fq); S.done(cur); }
        if (!has_next) break;
#pragma unroll
        for (int a = 0; a < 2; ++a)
#pragma unroll
            for (int b = 0; b < 2; ++b)
#pragma unroll
                for (int m = 0; m < 4; ++m)
#pragma unroll
                    for (int n = 0; n < 2; ++n) acc[a][b][m][n] = (f32x4){0.f, 0.f, 0.f, 0.f};
        cur = nxt; cA = nA; cB = nB; ++ui;
        if constexpr (ALIGN_EPI) { if (wr == 1) PG8_BAR; }
    }
    PG8_WAIT_V(0);
    if constexpr (!ALIGN_EPI) { if (wr == 0) PG8_BAR; }
    PG8_BAR;
    if constexpr (Epi::AFTER_DRAIN) { E.fused(acc, cur, wr, wc, fr, fq, lds, wid, lane); S.done(cur); }
#undef PG8_SA
#undef PG8_SB
#undef PG8_STAGE
#undef PG8_LDA
#undef PG8_LDB
#undef PG8_MMA
#undef PG8_WAIT_V
#undef PG8_WAIT_L
#undef PG8_BAR
#undef PG8_SCHED
}
}

namespace hy {
#define GAS __attribute__((address_space(1)))
#define LAS __attribute__((address_space(3)))
typedef unsigned short bf16;
typedef unsigned v4u __attribute__((ext_vector_type(4)));
typedef float f32x4 __attribute__((ext_vector_type(4)));
typedef short bf16x8 __attribute__((ext_vector_type(8)));
typedef GAS unsigned gu32;
typedef GAS unsigned long long gu64;
#define RLX_AGENT __ATOMIC_RELAXED, __HIP_MEMORY_SCOPE_AGENT
#define LDS_WAIT() asm volatile("s_waitcnt lgkmcnt(0)" ::: "memory")
#define VM_WAIT() asm volatile("s_waitcnt vmcnt(0)" ::: "memory")
__device__ __forceinline__ unsigned long long rt() { return __builtin_amdgcn_s_memrealtime(); }
__device__ __forceinline__ unsigned f2bf(float f) { unsigned u = __builtin_bit_cast(unsigned, f); return (u + 0x7fffu + ((u >> 16) & 1u)) >> 16; }
__device__ __forceinline__ unsigned pk2(float lo, float hi) { return f2bf(lo) | (f2bf(hi) << 16); }
#define XB_TMO      128
#define XB_XCNT(j)  (256  + 64 * (j))
#define XB_XSUB(j)  (1280 + 64 * (j))
#define XB_XGEN(j)  (2304 + 64 * (j))
#define XB_TOP      3328
#define XB_TOPGEN   3392
#define XCD_BAR_WORDS 3456
#define XB_SPIN_CAP (1u << 18)

__device__ __forceinline__ unsigned xb_ld(unsigned* p)              { return __hip_atomic_load(p, __ATOMIC_RELAXED, __HIP_MEMORY_SCOPE_AGENT); }
__device__ __forceinline__ unsigned xb_add(unsigned* p, unsigned v) { return __hip_atomic_fetch_add(p, v, __ATOMIC_RELAXED, __HIP_MEMORY_SCOPE_AGENT); }
__device__ __forceinline__ unsigned xb_xcc_id() { return (unsigned)__builtin_amdgcn_s_getreg((3 << 11) | 20) & 0xFu; }
#define XB_SPIN(cond, bar) do { unsigned _sp = 0; while (cond) { __builtin_amdgcn_s_sleep(1); \
    if ((++_sp & 255u) == 0u) { if (xb_ld(&(bar)[XB_TMO])) break; if (_sp > XB_SPIN_CAP) { atomicAdd(&(bar)[XB_TMO], 1u); break; } } } } while (0)

struct XcdBarrier {
    unsigned* bar; unsigned x;
    volatile LAS unsigned* st;
};

__device__ __forceinline__ XcdBarrier xcd_barrier_post(unsigned* bar, volatile LAS unsigned* st) {
    XcdBarrier b; b.bar = bar; b.x = xb_xcc_id(); b.st = st;
    if (threadIdx.x == 0) (void)xb_add(&bar[XB_XCNT(b.x)], 1u);
    return b;
}
__device__ __forceinline__ void xcd_barrier_complete(unsigned* bar, unsigned x, unsigned& nloc, unsigned& nx) {
    const unsigned G = gridDim.x * gridDim.y * gridDim.z;
    unsigned sum, cnt, mine, sp = 0u;
    for (;;) {
        sum = 0u; cnt = 0u; mine = 0u;
#pragma unroll
        for (unsigned j = 0; j < 16; ++j) { const unsigned c = xb_ld(&bar[XB_XCNT(j)]); sum += c; cnt += (c > 0u) ? 1u : 0u; mine = (j == x) ? c : mine; }
        if (sum == G) break;
        __builtin_amdgcn_s_sleep(1);
        if ((++sp & 255u) == 0u) { if (xb_ld(&bar[XB_TMO])) break; if (sp > XB_SPIN_CAP) { atomicAdd(&bar[XB_TMO], 1u); break; } }
    }
    nloc = mine > 0u ? mine : 1u; nx = cnt > 0u ? cnt : 1u;
}

__device__ __forceinline__ void xcd_barrier(const XcdBarrier& b) {
    asm volatile("s_waitcnt vmcnt(0)" ::: "memory");
    __syncthreads();
    if (threadIdx.x == 0) {
        unsigned* bar = b.bar;
        __builtin_amdgcn_s_waitcnt(0);
        unsigned nloc = b.st[0], nx = b.st[1];
        if (nloc == 0u) { xcd_barrier_complete(bar, b.x, nloc, nx); b.st[0] = nloc; b.st[1] = nx; }
        const unsigned old = xb_add(&bar[XB_XSUB(b.x)], 1u);
        const unsigned gen = old / nloc;
        if (old + 1u == (gen + 1u) * nloc) {
            __builtin_amdgcn_fence(__ATOMIC_RELEASE, "agent");
            asm volatile("s_waitcnt vmcnt(0)" ::: "memory");
            const unsigned og = xb_add(&bar[XB_TOP], 1u);
            const unsigned tg = og / nx;
            if (og + 1u == (tg + 1u) * nx) xb_add(&bar[XB_TOPGEN], 1u);
            else XB_SPIN(xb_ld(&bar[XB_TOPGEN]) == tg, bar);
            __builtin_amdgcn_fence(__ATOMIC_ACQUIRE, "agent");
            xb_add(&bar[XB_XGEN(b.x)], 1u);
            asm volatile("s_waitcnt vmcnt(0)" ::: "memory");
        } else {
            XB_SPIN(xb_ld(&bar[XB_XGEN(b.x)]) == gen, bar);
            __builtin_amdgcn_fence(__ATOMIC_ACQUIRE, "agent");
            asm volatile("s_waitcnt vmcnt(0)" ::: "memory");
        }
    }
    __syncthreads();
}

constexpr int B_ = 4, T_ = 8192, D_ = 1024, M_ = B_ * T_, L_ = 2;
constexpr int NIN = 3584, NPG = 1792, NPR = 1792;
constexpr int DFF = 2816, NUP = 5632, IN_COLS = 3344;
constexpr size_t MiB = 1u << 20;
constexpr size_t WS_CTL = 0, CTL_ZERO_BYTES = 65536;
constexpr int CW_BAR = 4096;
constexpr size_t WS_RK = MiB / 4;
constexpr size_t WS_MOD = 3 * MiB / 2;
constexpr size_t WS_WIN = 2 * MiB, WS_WOUT = 9 * MiB, WS_WUP = 11 * MiB, WS_WDN = 22 * MiB, WS_LORA = 55 * MiB / 2, WS_GAMC = 28 * MiB, WS_VL = 29 * MiB;
constexpr size_t WS_GAM = 31 * MiB;
constexpr size_t WS_XB = 32 * MiB, WS_O = 96 * MiB, WS_VF = 160 * MiB, WS_GK = 192 * MiB, WS_PG = 224 * MiB, WS_PR = 336 * MiB, WS_END = 512 * MiB;
constexpr size_t WS_RH = WS_XB, WS_YH = WS_XB + 32 * MiB, WS_PP = WS_O, WS_QQ = WS_O + 32 * MiB, WS_GG = 448 * MiB, WS_S0 = 480 * MiB;
constexpr size_t WS_ACT = 224 * MiB, WS_U = 400 * MiB;
constexpr int RING_BYTES = 131072, MISC_OFF = 139264, LDS_BYTES = 147456;
constexpr int NT = 512;

__device__ __forceinline__ float bf2f(bf16 h) { return __builtin_bit_cast(float, (unsigned)h << 16); }
__device__ __forceinline__ float sigmoidf_(float x) { return 1.f / (1.f + __expf(-x)); }
__device__ __forceinline__ float siluf_(float x) { return x / (1.f + __expf(-x)); }
__device__ __forceinline__ float softplusf_(float x) { return fmaxf(x, 0.f) + log1pf(__expf(-fabsf(x))); }

typedef unsigned u32x2 __attribute__((ext_vector_type(2)));
template <int CTRL> __device__ __forceinline__ float dpp_f(float v) {
    return __builtin_bit_cast(float, __builtin_amdgcn_update_dpp(0, __builtin_bit_cast(int, v), CTRL, 0xf, 0xf, false));
}
__device__ __forceinline__ float wave_sum(float v) {
    v += dpp_f<0xB1>(v);
    v += dpp_f<0x4E>(v);
    v += dpp_f<0x141>(v);
    v += dpp_f<0x140>(v);
    v += __builtin_bit_cast(float, __builtin_amdgcn_update_dpp(0, __builtin_bit_cast(int, v), 0x142, 0xa, 0xf, false));
    v += __builtin_bit_cast(float, __builtin_amdgcn_update_dpp(0, __builtin_bit_cast(int, v), 0x143, 0xc, 0xf, false));
    return __builtin_bit_cast(float, __builtin_amdgcn_readlane(__builtin_bit_cast(int, v), 63));
}

struct Ctx { int bid, nb, tid, lane, wave; LAS unsigned char* lds; };

__device__ __forceinline__ void ph_mod(const Ctx& C, const float* c, const float* ada_w, const float* ada_b, float* MOD) {
    LAS float* sc = (LAS float*)C.lds;
    LAS float* red = (LAS float*)(C.lds + 16384);
    for (int i = C.tid; i < 4096; i += NT) sc[i] = siluf_(c[i]);
    __syncthreads();
    for (int item = C.bid; item < 192; item += C.nb) {
        const int l = item / 96, j0 = (item % 96) * 64;
        const float* W = ada_w + (size_t)l * 1024 * 6144 + j0 + C.lane;
        float a0 = 0.f, a1 = 0.f, a2 = 0.f, a3 = 0.f;
        for (int k = C.wave * 128; k < C.wave * 128 + 128; ++k) { const float wv = W[(size_t)k * 6144]; a0 += sc[k] * wv; a1 += sc[1024 + k] * wv; a2 += sc[2048 + k] * wv; a3 += sc[3072 + k] * wv; }
        red[(C.wave * 4 + 0) * 64 + C.lane] = a0; red[(C.wave * 4 + 1) * 64 + C.lane] = a1; red[(C.wave * 4 + 2) * 64 + C.lane] = a2; red[(C.wave * 4 + 3) * 64 + C.lane] = a3;
        __syncthreads();
        if (C.wave < 4) { const int b = C.wave; float s = ada_b[l * 6144 + j0 + C.lane];
#pragma unroll
            for (int w = 0; w < 8; ++w) s += red[(w * 4 + b) * 64 + C.lane];
            MOD[((size_t)l * 4 + b) * 6144 + j0 + C.lane] = s; }
        __syncthreads();
    }
}

__device__ __forceinline__ void wprep_mat(const Ctx& C, const float* W, int K, int Nsrc, int Ndst, bf16* Wt, int mode, const float* vres) {
    const int half = C.tid >> 8, t = C.tid & 255, tx = t & 31, ty = t >> 5;
    LAS float* tile = (LAS float*)C.lds + half * (32 * 33);
    const int nbn = Ndst / 32, ntile = nbn * (K / 32);
    const int niter = (ntile + 2 * C.nb - 1) / (2 * C.nb);
    for (int it = 0; it < niter; ++it) {
        const int item = (it * C.nb + C.bid) * 2 + half;
        const bool act = item < ntile;
        const int n0 = (item % nbn) * 32, k0 = (item / nbn) * 32, n = n0 + tx;
        if (act) {
#pragma unroll
            for (int i = 0; i < 4; ++i) { const int k = k0 + ty + 8 * i; float v = 0.f;
                if (mode == 0) v = W[(size_t)k * Nsrc + n];
                else { if (n < 1552) v = W[(size_t)k * Nsrc + n]; else if (n < 1584) v = vres ? vres[(size_t)k * 32 + (n - 1552)] : 0.f; else if (n < 1792) v = 0.f; else v = W[(size_t)k * Nsrc + (n - 240)]; }
                tile[(ty + 8 * i) * 33 + tx] = v; }
        }
        __syncthreads();
        if (act) {
#pragma unroll
            for (int i = 0; i < 4; ++i) { const int nn = n0 + ty + 8 * i; Wt[(size_t)nn * K + k0 + tx] = (bf16)f2bf(tile[tx * 33 + ty + 8 * i]); }
        }
        __syncthreads();
    }
}

__device__ __forceinline__ void ph_norm(const Ctx& C, const float* x, const float* g, const float* sh, const float* sc, bf16* XB) {
    const int gw = C.bid * 8 + C.wave, NGW = C.nb * 8, lane = C.lane;
    for (int m = gw; m < M_; m += NGW) {
        const int b = m / T_;
        const f32x4* xr = (const f32x4*)(x + (size_t)m * D_) + lane;
        f32x4 v[4]; float s = 0.f;
#pragma unroll
        for (int j = 0; j < 4; ++j) { v[j] = xr[64 * j]; s += (v[j].x * v[j].x + v[j].y * v[j].y) + (v[j].z * v[j].z + v[j].w * v[j].w); }
        const float rstd = 1.f / sqrtf(wave_sum(s) * (1.f / D_) + 1e-6f);
        unsigned long long* o8 = (unsigned long long*)(XB + (size_t)m * D_) + lane;
#pragma unroll
        for (int j = 0; j < 4; ++j) { const int col = 4 * lane + 256 * j;
            const f32x4 gv = *(const f32x4*)(g + col), shv = *(const f32x4*)(sh + b * 6144 + col), scv = *(const f32x4*)(sc + b * 6144 + col);
            const f32x4 h = v[j] * rstd * gv * (scv + 1.f) + shv;
            o8[64 * j] = (unsigned long long)(f2bf(h.x) | (f2bf(h.y) << 16)) | ((unsigned long long)(f2bf(h.z) | (f2bf(h.w) << 16)) << 32); }
    }
}
__device__ __forceinline__ void ph_final(const Ctx& C, float* x, const float* g) {
    const int gw = C.bid * 8 + C.wave, NGW = C.nb * 8, lane = C.lane;
    for (int m = gw; m < M_; m += NGW) {
        f32x4* xr = (f32x4*)(x + (size_t)m * D_) + lane;
        f32x4 v[4]; float s = 0.f;
#pragma unroll
        for (int j = 0; j < 4; ++j) { v[j] = xr[64 * j]; s += (v[j].x * v[j].x + v[j].y * v[j].y) + (v[j].z * v[j].z + v[j].w * v[j].w); }
        const float rstd = 1.f / sqrtf(wave_sum(s) * (1.f / D_) + 1e-6f);
#pragma unroll
        for (int j = 0; j < 4; ++j) { const f32x4 gv = *(const f32x4*)(g + 4 * lane + 256 * j); xr[64 * j] = v[j] * rstd * gv; }
    }
}


typedef short s16x8 __attribute__((ext_vector_type(8)));
__device__ __forceinline__ f32x4 mm16(const LAS bf16* A, int lda, const LAS bf16* B, int ldb, int K, f32x4 acc, int lane) {
    const int r = lane & 15, g = lane >> 4;
    const LAS bf16* ap = A + r * lda + 8 * g; const LAS bf16* bp = B + r * ldb + 8 * g;
    for (int k0 = 0; k0 < K; k0 += 32) { const s16x8 a = *(const LAS s16x8*)(ap + k0); const s16x8 b = *(const LAS s16x8*)(bp + k0); acc = __builtin_amdgcn_mfma_f32_16x16x32_bf16(a, b, acc, 0, 0, 0); }
    return acc;
}
__device__ __forceinline__ f32x4 mm16_ga(const bf16* A, int lda, const LAS bf16* B, int ldb, int K, f32x4 acc, int lane) {
    const int r = lane & 15, g = lane >> 4;
    const bf16* ap = A + r * lda + 8 * g; const LAS bf16* bp = B + r * ldb + 8 * g;
    for (int k0 = 0; k0 < K; k0 += 32) { const s16x8 a = *(const s16x8*)(ap + k0); const s16x8 b = *(const LAS s16x8*)(bp + k0); acc = __builtin_amdgcn_mfma_f32_16x16x32_bf16(a, b, acc, 0, 0, 0); }
    return acc;
}
__device__ __forceinline__ unsigned long long pack4(f32x4 v) { return (unsigned long long)(f2bf(v.x) | (f2bf(v.y) << 16)) | ((unsigned long long)(f2bf(v.z) | (f2bf(v.w) << 16)) << 32); }
__device__ __forceinline__ float logsigmoidf_(float x) { return fminf(x, 0.f) - log1pf(__expf(-fabsf(x))); }

constexpr int GL_LD = 72;
constexpr int GL_GK = 0;
constexpr int GL_SEG = 16384;
constexpr int GL_Z = 18432;
constexpr int GL_GUP = 20480;
constexpr int GL_I0 = 24832;
constexpr int GL_I1 = GL_I0 + 9216;
constexpr int GL_I2 = GL_I1 + 9216;
constexpr int GL_VT = GL_I2 + 9216;
constexpr int GL_SSQ = GL_VT + 18432;
static_assert(GL_SSQ + 512 <= RING_BYTES, "GLA LDS map");

__device__ __forceinline__ void gla_gates(const Ctx& C, const bf16* pg  , const float* gk_up, const float* gk_b, int h) {
    LAS float* GK = (LAS float*)(C.lds + GL_GK); LAS float* SEG = (LAS float*)(C.lds + GL_SEG); LAS bf16* Z = (LAS bf16*)(C.lds + GL_Z); LAS float* GUP = (LAS float*)(C.lds + GL_GUP);
    const int tid = C.tid;
    if (tid < 128) { const int t = tid >> 1, hh = tid & 1; *(LAS v4u*)(Z + t * 16 + hh * 8) = *(const v4u*)(pg + (size_t)t * NPG + 1536 + hh * 8); }
    for (int i = tid; i < 16 * 64; i += NT) GUP[i] = gk_up[(i >> 6) * 256 + h * 64 + (i & 63)];
    if (tid < 64) GUP[1024 + tid] = gk_b[h * 64 + tid];
    __syncthreads();
    { const int t = tid >> 3, d0 = (tid & 7) * 8; float a[8];
#pragma unroll
      for (int q = 0; q < 8; ++q) a[q] = GUP[1024 + d0 + q];
#pragma unroll
      for (int i = 0; i < 16; ++i) { const float zv = bf2f(Z[t * 16 + i]);
#pragma unroll
          for (int q = 0; q < 8; ++q) a[q] += zv * GUP[i * 64 + d0 + q]; }
#pragma unroll
      for (int q = 0; q < 8; ++q) GK[t * 64 + d0 + q] = logsigmoidf_(a[q]) * (1.f / 16.f); }
    __syncthreads();
    { const int d = tid & 63, seg = tid >> 6; float run = 0.f;
#pragma unroll
      for (int q = 0; q < 8; ++q) { run += GK[(seg * 8 + q) * 64 + d]; GK[(seg * 8 + q) * 64 + d] = run; }
      SEG[seg * 64 + d] = run; }
    __syncthreads();
    { const int d = tid & 63, seg = tid >> 6; float off = 0.f;
      for (int s = 0; s < seg; ++s) off += SEG[s * 64 + d];
#pragma unroll
      for (int q = 0; q < 8; ++q) GK[(seg * 8 + q) * 64 + d] += off; }
    __syncthreads();
}
__device__ __forceinline__ void gla_stage_vt(const Ctx& C, const bf16* pg, int h) {
    LAS bf16* VT = (LAS bf16*)(C.lds + GL_VT);
    const int j = C.tid >> 3, e0 = (C.tid & 7) * 16;
    const v4u x0 = *(const v4u*)(pg + (size_t)j * NPG + 512 + h * 128 + e0), x1 = *(const v4u*)(pg + (size_t)j * NPG + 512 + h * 128 + e0 + 8);
    const unsigned w[8] = {x0.x, x0.y, x0.z, x0.w, x1.x, x1.y, x1.z, x1.w};
#pragma unroll
    for (int q = 0; q < 8; ++q) { VT[(e0 + 2 * q) * GL_LD + j] = (bf16)(w[q] & 0xffffu); VT[(e0 + 2 * q + 1) * GL_LD + j] = (bf16)(w[q] >> 16); }
}

__device__ __forceinline__ void ph_gla_a(const Ctx& C, const bf16* PG, const float* gk_up, const float* gk_b, bf16* DS, float* GAM, bf16* VL) {
    LAS float* GK = (LAS float*)(C.lds + GL_GK); LAS bf16* KT = (LAS bf16*)(C.lds + GL_I0); LAS bf16* VT = (LAS bf16*)(C.lds + GL_VT);
    for (int item = C.bid; item < 2048; item += C.nb) {
        const int bh = item >> 7, c = item & 127, b = bh >> 2, h = bh & 3;
        const size_t m0 = (size_t)b * T_ + c * 64;
        const bf16* pg = PG + m0 * NPG;
        gla_gates(C, pg, gk_up, gk_b, h);
        { const int j = C.tid >> 3, d0 = (C.tid & 7) * 8;
          const v4u kx = *(const v4u*)(pg + (size_t)j * NPG + 256 + h * 64 + d0);
          const unsigned w[4] = {kx.x, kx.y, kx.z, kx.w};
#pragma unroll
          for (int q = 0; q < 4; ++q) { const float k0 = bf2f((bf16)(w[q] & 0xffffu)), k1 = bf2f((bf16)(w[q] >> 16));
              const int d = d0 + 2 * q;
              KT[d * GL_LD + j] = (bf16)f2bf(k0 * __expf(GK[63 * 64 + d] - GK[j * 64 + d]));
              KT[(d + 1) * GL_LD + j] = (bf16)f2bf(k1 * __expf(GK[63 * 64 + d + 1] - GK[j * 64 + d + 1])); } }
        gla_stage_vt(C, pg, h);
        if (C.tid < 64) GAM[(size_t)item * 64 + C.tid] = __expf(GK[63 * 64 + C.tid]);
        if (h == 0 && C.tid < 256) { const int t = C.tid >> 2, q = C.tid & 3; *(unsigned long long*)(VL + (m0 + t) * 32 + q * 8 + 0) = *(const unsigned long long*)(pg + (size_t)t * NPG + 1552 + q * 8);
                                     *(unsigned long long*)(VL + (m0 + t) * 32 + q * 8 + 4) = *(const unsigned long long*)(pg + (size_t)t * NPG + 1552 + q * 8 + 4); }
        __syncthreads();
        { const int n0 = C.wave * 16, lane = C.lane, cc = lane & 15, g = lane >> 4;
          bf16* out = DS + (size_t)item * 8192 + (size_t)(n0 + cc) * 64 + 4 * g;
#pragma unroll
          for (int mt = 0; mt < 4; ++mt) { f32x4 acc = {0.f, 0.f, 0.f, 0.f}; acc = mm16(KT + mt * 16 * GL_LD, GL_LD, VT + n0 * GL_LD, GL_LD, 64, acc, lane);
              *(unsigned long long*)(out + mt * 16) = pack4(acc); } }
        __syncthreads();
    }
}
__device__ __forceinline__ void ph_gla_b(const Ctx& C, bf16* DS, const float* GAM) {
    for (int idx = C.bid * NT + C.tid; idx < 16 * 8192; idx += C.nb * NT) {
        const int bh = idx >> 13, ed = idx & 8191, d = ed & 63;
        bf16* p = DS + (size_t)bh * 128 * 8192 + ed; const float* gp = GAM + (size_t)bh * 128 * 64 + d;
        float S = 0.f;
        for (int c0 = 0; c0 < 128; c0 += 8) {
            float ds[8], gm[8];
#pragma unroll
            for (int i = 0; i < 8; ++i) { ds[i] = bf2f(p[(size_t)(c0 + i) * 8192]); gm[i] = gp[(c0 + i) * 64]; }
#pragma unroll
            for (int i = 0; i < 8; ++i) { const float gs = gm[i] * S; p[(size_t)(c0 + i) * 8192] = (bf16)f2bf(gs); S = gs + ds[i]; }
        }
    }
}
__device__ __forceinline__ void ph_gla_c(const Ctx& C, const bf16* PG, const float* gk_up, const float* gk_b, const float* norm_g, const bf16* DS, bf16* O) {
    LAS float* GK = (LAS float*)(C.lds + GL_GK); LAS bf16* QP = (LAS bf16*)(C.lds + GL_I0); LAS bf16* KM = (LAS bf16*)(C.lds + GL_I1); LAS bf16* AI = (LAS bf16*)(C.lds + GL_I2);
    LAS bf16* VT = (LAS bf16*)(C.lds + GL_VT); LAS float* SSQ = (LAS float*)(C.lds + GL_SSQ);
    for (int item = C.bid; item < 2048; item += C.nb) {
        const int bh = item >> 7, c = item & 127, b = bh >> 2, h = bh & 3;
        const size_t m0 = (size_t)b * T_ + c * 64;
        const bf16* pg = PG + m0 * NPG;
        gla_gates(C, pg, gk_up, gk_b, h);
        { const int j = C.tid >> 3, d0 = (C.tid & 7) * 8;
          const v4u qx = *(const v4u*)(pg + (size_t)j * NPG + h * 64 + d0), kx = *(const v4u*)(pg + (size_t)j * NPG + 256 + h * 64 + d0);
          const unsigned qw[4] = {qx.x, qx.y, qx.z, qx.w}, kw[4] = {kx.x, kx.y, kx.z, kx.w};
          unsigned qo[4], ko[4];
#pragma unroll
          for (int q = 0; q < 4; ++q) { const int d = d0 + 2 * q;
              const float e0 = GK[63 * 64 + d] - GK[j * 64 + d], e1 = GK[63 * 64 + d + 1] - GK[j * 64 + d + 1];
              const float q0 = 0.125f * bf2f((bf16)(qw[q] & 0xffffu)) * __expf(-e0), q1 = 0.125f * bf2f((bf16)(qw[q] >> 16)) * __expf(-e1);
              const float k0 = bf2f((bf16)(kw[q] & 0xffffu)) * __expf(e0), k1 = bf2f((bf16)(kw[q] >> 16)) * __expf(e1);
              qo[q] = f2bf(q0) | (f2bf(q1) << 16); ko[q] = f2bf(k0) | (f2bf(k1) << 16); }
          *(LAS v4u*)(QP + j * GL_LD + d0) = (v4u){qo[0], qo[1], qo[2], qo[3]}; *(LAS v4u*)(KM + j * GL_LD + d0) = (v4u){ko[0], ko[1], ko[2], ko[3]}; }
        gla_stage_vt(C, pg, h);
        __syncthreads();
        { const int lane = C.lane, cc = lane & 15, g = lane >> 4, n0 = (C.wave >> 1) * 16;
#pragma unroll
          for (int q = 0; q < 2; ++q) { const int mt0 = ((C.wave & 1) * 2 + q) * 16; f32x4 acc = {0.f, 0.f, 0.f, 0.f};
              acc = mm16(KM + mt0 * GL_LD, GL_LD, QP + n0 * GL_LD, GL_LD, 64, acc, lane);
              const int i = n0 + cc, j = mt0 + 4 * g;
              acc.x = (j + 0 <= i) ? acc.x : 0.f; acc.y = (j + 1 <= i) ? acc.y : 0.f; acc.z = (j + 2 <= i) ? acc.z : 0.f; acc.w = (j + 3 <= i) ? acc.w : 0.f;
              *(LAS unsigned long long*)(AI + (n0 + cc) * GL_LD + mt0 + 4 * g) = pack4(acc); } }
        __syncthreads();
        { const int lane = C.lane, cc = lane & 15, g = lane >> 4, n0 = (C.wave & 3) * 16, eh = C.wave >> 2;
          const bf16* Sg = DS + (size_t)item * 8192;
          f32x4 acc[4]; float ss = 0.f;
#pragma unroll
          for (int mt = 0; mt < 4; ++mt) { const int e0 = eh * 64 + mt * 16; acc[mt] = (f32x4){0.f, 0.f, 0.f, 0.f};
              acc[mt] = mm16_ga(Sg + (size_t)e0 * 64, 64, QP + n0 * GL_LD, GL_LD, 64, acc[mt], lane);
              acc[mt] = mm16(VT + e0 * GL_LD, GL_LD, AI + n0 * GL_LD, GL_LD, 64, acc[mt], lane);
              ss += (acc[mt].x * acc[mt].x + acc[mt].y * acc[mt].y) + (acc[mt].z * acc[mt].z + acc[mt].w * acc[mt].w); }
          ss += __shfl_xor(ss, 16); ss += __shfl_xor(ss, 32);
          if (g == 0) SSQ[eh * 64 + n0 + cc] = ss;
          __syncthreads();
          const float rstd = 1.f / sqrtf((SSQ[n0 + cc] + SSQ[64 + n0 + cc]) * (1.f / 128.f) + 1e-6f);
          const size_t m = m0 + n0 + cc;
#pragma unroll
          for (int mt = 0; mt < 4; ++mt) { const int e = eh * 64 + mt * 16 + 4 * g;
              const unsigned long long gx = *(const unsigned long long*)(pg + (size_t)(n0 + cc) * NPG + 1024 + h * 128 + e);
              const f32x4 ng = *(const f32x4*)(norm_g + e);
              f32x4 o;
              o.x = acc[mt].x * rstd * ng.x * siluf_(bf2f((bf16)(gx & 0xffffu)));
              o.y = acc[mt].y * rstd * ng.y * siluf_(bf2f((bf16)((gx >> 16) & 0xffffu)));
              o.z = acc[mt].z * rstd * ng.z * siluf_(bf2f((bf16)((gx >> 32) & 0xffffu)));
              o.w = acc[mt].w * rstd * ng.w * siluf_(bf2f((bf16)(gx >> 48)));
              *(unsigned long long*)(O + m * D_ + h * 128 + e) = pack4(o); } }
        __syncthreads();
    }
}


struct RwkvW { const float *mu, *mu_vres, *w0, *a0, *v0, *k_k, *k_a, *r_k; const bf16 *wupT, *aupT, *gupT, *vupT; };
constexpr int RW_LD = 72, RW_XLD = 296, RW_FLD = 68;
constexpr int RW_R0 = 0;
constexpr int RW_SEG = 16384;
constexpr int RW_R1 = 37888;
constexpr int RW_R2 = RW_R1 + 27648;
constexpr int RW_R3 = RW_R2 + 9216;
constexpr int RW_R4 = RW_R3 + 27648;
constexpr int RW_TI = RW_R4 + 128 * RW_FLD * 4;
constexpr int RW_END = RW_TI + 2048;
static_assert(RW_END <= RING_BYTES + 8192 && RW_END <= MISC_OFF, "RWKV LDS map");

typedef short s16x4 __attribute__((ext_vector_type(4)));
__device__ __forceinline__ float tanh_fast(float x) { const float e = __expf(2.f * x); return 1.f - 2.f / (e + 1.f); }
__device__ __forceinline__ float softplus_fast(float x) { return fmaxf(x, 0.f) + __logf(1.f + __expf(-fabsf(x))); }
__device__ __forceinline__ s16x4 cvt4(f32x4 v) { const unsigned long long p = pack4(v); return __builtin_bit_cast(s16x4, p); }
__device__ __forceinline__ void ld8f(const float* p, float (&o)[8]) { const f32x4 a = *(const f32x4*)p, b = *(const f32x4*)(p + 4); o[0] = a.x; o[1] = a.y; o[2] = a.z; o[3] = a.w; o[4] = b.x; o[5] = b.y; o[6] = b.z; o[7] = b.w; }
__device__ __forceinline__ float sum8(float v) { v += dpp_f<0xB1>(v); v += dpp_f<0x4E>(v); v += dpp_f<0x141>(v); return v; }
__device__ __forceinline__ void unpack8(const v4u x, float (&o)[8]) {
    o[0] = bf2f((bf16)(x.x & 0xffffu)); o[1] = bf2f((bf16)(x.x >> 16)); o[2] = bf2f((bf16)(x.y & 0xffffu)); o[3] = bf2f((bf16)(x.y >> 16));
    o[4] = bf2f((bf16)(x.z & 0xffffu)); o[5] = bf2f((bf16)(x.z >> 16)); o[6] = bf2f((bf16)(x.w & 0xffffu)); o[7] = bf2f((bf16)(x.w >> 16)); }
__device__ __forceinline__ v4u pack8(const float (&o)[8]) { return (v4u){f2bf(o[0]) | (f2bf(o[1]) << 16), f2bf(o[2]) | (f2bf(o[3]) << 16), f2bf(o[4]) | (f2bf(o[5]) << 16), f2bf(o[6]) | (f2bf(o[7]) << 16)}; }
__device__ __forceinline__ f32x4 mm16_gb(const LAS bf16* A, int lda, const bf16* B, int ldb, int K, f32x4 acc, int lane) {
    const int r = lane & 15, g = lane >> 4;
    const LAS bf16* ap = A + r * lda + 8 * g; const bf16* bp = B + r * ldb + 8 * g;
    for (int k0 = 0; k0 < K; k0 += 32) { const s16x8 a = *(const LAS s16x8*)(ap + k0); const s16x8 b = *(const s16x8*)(bp + k0); acc = __builtin_amdgcn_mfma_f32_16x16x32_bf16(a, b, acc, 0, 0, 0); }
    return acc;
}

__device__ __forceinline__ void ph_rwkv_a(const Ctx& C, const bf16* PR, const bf16* VL  , const RwkvW& W, int layer,
                                          bf16* PP, bf16* QQ, bf16* RH, bf16* YH, float* GAMC, float* RK, bf16* GG, bf16* VF, bool store_v = true) {
    LAS unsigned char* L = C.lds;
    LAS bf16* X = (LAS bf16*)(L + RW_R0); LAS float* CUM = (LAS float*)(L + RW_R0); LAS float* SEG = (LAS float*)(L + RW_SEG);
    LAS bf16* NI = (LAS bf16*)(L + RW_R0), *AAK = NI + 64 * RW_LD, *ARB = AAK + 64 * RW_LD, *ARK = ARB + 64 * RW_LD;
    LAS bf16* PRE = (LAS bf16*)(L + RW_R1);
    LAS bf16* AT = (LAS bf16*)(L + RW_R1), *BT = AT + 64 * RW_LD, *KT = BT + 64 * RW_LD, *RT = (LAS bf16*)(L + RW_R2);
    LAS bf16* XB16 = (LAS bf16*)(L + RW_R1);
    LAS bf16* BHc = (LAS bf16*)(L + RW_R3), *KHc = BHc + 64 * RW_LD, *VTc = KHc + 64 * RW_LD;
    LAS float* XT = (LAS float*)(L + RW_R4); LAS bf16* TI = (LAS bf16*)(L + RW_TI);
    const int wave = C.wave;
    for (int item = C.bid; item < 4096; item += C.nb) {
        int tid_ = C.tid; asm volatile("" : "+v"(tid_));
        const int tid = tid_, lane = tid & 63, cc = lane & 15, g = lane >> 4;
        const int h = item & 7, c = (item >> 3) & 127, b = item >> 10;
        const size_t m0 = (size_t)b * T_ + c * 64;
        for (int idx = tid; idx < 64 * 36; idx += NT) {
            const int t = idx / 36, q = idx % 36, col = q * 8; const size_t m = m0 + t; const bool first = (c == 0 && t == 0);
            v4u cur, prv; float mu[8];
            if (q < 32) { cur = *(const v4u*)(PR + m * NPR + 1536 + col); prv = first ? (v4u){0u, 0u, 0u, 0u} : *(const v4u*)(PR + (m - 1) * NPR + 1536 + col);
                ld8f(W.mu + 1536 + col, mu); }
            else if (layer) { cur = *(const v4u*)(VL + m * NPG + 1552 + (col - 256)); prv = first ? (v4u){0u, 0u, 0u, 0u} : *(const v4u*)(VL + (m - 1) * NPG + 1552 + (col - 256));
                ld8f(W.mu_vres + (col - 256), mu); }
            else { cur = (v4u){0u, 0u, 0u, 0u}; prv = cur;
#pragma unroll
                for (int i = 0; i < 8; ++i) mu[i] = 0.f; }
            float cv[8], pv[8]; unpack8(cur, cv); unpack8(prv, pv);
#pragma unroll
            for (int i = 0; i < 8; ++i) { float p = cv[i] + (pv[i] - cv[i]) * mu[i]; if (q < 8) p = tanh_fast(p); else if (q >= 16 && q < 32) p = sigmoidf_(p); cv[i] = p; }
            *(LAS v4u*)(X + t * RW_XLD + col) = pack8(cv);
        }
        __syncthreads();
        {
            const int lsel = wave >> 1;
            const bf16* WT = lsel == 0 ? W.wupT : lsel == 1 ? W.aupT : lsel == 2 ? W.gupT : W.vupT;
            const int Kl = lsel == 2 ? 128 : lsel == 3 ? 32 : 64, xoff = lsel == 0 ? 0 : lsel == 1 ? 64 : lsel == 2 ? 128 : 256;
            LAS bf16* outp = PRE + lsel * 64 * RW_LD;
            const bool live = (lsel != 3 || layer);
#pragma unroll
            for (int mq = 0; mq < 2; ++mq) { const int mt = (wave & 1) * 2 + mq;
                s16x8 af[4];
                const bf16* ap = WT + (size_t)(h * 64 + mt * 16 + cc) * Kl + 8 * g;
#pragma unroll
                for (int ks = 0; ks < 4; ++ks) af[ks] = (live && ks * 32 < Kl) ? *(const s16x8*)(ap + ks * 32) : (s16x8){0, 0, 0, 0, 0, 0, 0, 0};
#pragma unroll
                for (int nt = 0; nt < 4; ++nt) { f32x4 acc = {0.f, 0.f, 0.f, 0.f};
                    const LAS bf16* bp = X + (nt * 16 + cc) * RW_XLD + xoff + 8 * g;
#pragma unroll
                    for (int ks = 0; ks < 4; ++ks) if (ks * 32 < Kl) { const s16x8 bb = *(const LAS s16x8*)(bp + ks * 32); acc = __builtin_amdgcn_mfma_f32_16x16x32_bf16(af[ks], bb, acc, 0, 0, 0); }
                    *(LAS unsigned long long*)(outp + (nt * 16 + cc) * RW_LD + mt * 16 + 4 * g) = pack4(acc); } }
        }
        __syncthreads();
        const int t = tid >> 3, d0 = (tid & 7) * 8, ch = h * 64 + d0; const size_t m = m0 + t; const bool first = (c == 0 && t == 0);
        float av[8], bv[8], kv[8], rv[8], lw[8], vv[8];
        {
            float rc[8], rp[8], kc[8], kp[8], vc[8], vp[8], pw[8], pa[8], pg_[8], pvg[8];
            unpack8(*(const v4u*)(PR + m * NPR + ch), rc); unpack8(*(const v4u*)(PR + m * NPR + 512 + ch), kc); unpack8(*(const v4u*)(PR + m * NPR + 1024 + ch), vc);
            if (first) {
#pragma unroll
                for (int i = 0; i < 8; ++i) { rp[i] = 0.f; kp[i] = 0.f; vp[i] = 0.f; } }
            else { unpack8(*(const v4u*)(PR + (m - 1) * NPR + ch), rp); unpack8(*(const v4u*)(PR + (m - 1) * NPR + 512 + ch), kp); unpack8(*(const v4u*)(PR + (m - 1) * NPR + 1024 + ch), vp); }
            unpack8(*(const LAS v4u*)(PRE + (0 * 64 + t) * RW_LD + d0), pw); unpack8(*(const LAS v4u*)(PRE + (1 * 64 + t) * RW_LD + d0), pa);
            unpack8(*(const LAS v4u*)(PRE + (2 * 64 + t) * RW_LD + d0), pg_); unpack8(*(const LAS v4u*)(PRE + (3 * 64 + t) * RW_LD + d0), pvg);
            float vf[8];
            if (layer) unpack8(*(const v4u*)(VF + m * 512 + ch), vf);
            float ssq = 0.f, rks = 0.f, asg[8], gg[8];
            float mur[8], muk[8], muv[8], w0c[8], a0c[8], v0c[8], kkc[8], kac[8], rkc[8];
            ld8f(W.mu + ch, mur); ld8f(W.mu + 512 + ch, muk); ld8f(W.mu + 1024 + ch, muv); ld8f(W.w0 + ch, w0c); ld8f(W.a0 + ch, a0c);
            ld8f(W.k_k + ch, kkc); ld8f(W.k_a + ch, kac); ld8f(W.r_k + ch, rkc);
            if (layer) ld8f(W.v0 + ch, v0c);
#pragma unroll
            for (int i = 0; i < 8; ++i) {
                const float r = rc[i] + (rp[i] - rc[i]) * mur[i], k = kc[i] + (kp[i] - kc[i]) * muk[i]; float v = vc[i] + (vp[i] - vc[i]) * muv[i];
                lw[i] = -__expf(-softplus_fast(-(w0c[i] + pw[i])) - 0.5f);
                asg[i] = sigmoidf_(a0c[i] + pa[i]);
                if (layer) v = v + (vf[i] - v) * sigmoidf_(v0c[i] + pvg[i]);
                const float kk = k * kkc[i]; ssq += kk * kk;
                kv[i] = k * (1.f + (asg[i] - 1.f) * kac[i]); rv[i] = r; vv[i] = v; gg[i] = pg_[i]; av[i] = kk;
                rks += r * kv[i] * rkc[i];
            }
            ssq = sum8(ssq); rks = sum8(rks);
            const float inv = 1.f / sqrtf(fmaxf(ssq, 1e-24f));
#pragma unroll
            for (int i = 0; i < 8; ++i) { const float kk = av[i] * inv; av[i] = -kk; bv[i] = kk * asg[i]; }
            if ((tid & 7) == 0) RK[m * 8 + h] = rks;
            *(v4u*)(GG + m * 512 + ch) = pack8(gg);
            if (store_v) *(v4u*)(VF + m * 512 + ch) = pack8(vv);
#pragma unroll
            for (int i = 0; i < 8; ++i) vv[i] = bf2f((bf16)f2bf(vv[i]));
        }
        __syncthreads();
#pragma unroll
        for (int i = 0; i < 8; ++i) CUM[t * 64 + d0 + i] = lw[i];
        __syncthreads();
        { const int d = tid & 63, seg = tid >> 6; float run = 0.f;
#pragma unroll
          for (int q = 0; q < 8; ++q) { run += CUM[(seg * 8 + q) * 64 + d]; CUM[(seg * 8 + q) * 64 + d] = run; }
          SEG[seg * 64 + d] = run; }
        __syncthreads();
        { const int d = tid & 63, seg = tid >> 6; float off = 0.f;
          for (int s = 0; s < seg; ++s) off += SEG[s * 64 + d];
#pragma unroll
          for (int q = 0; q < 8; ++q) CUM[(seg * 8 + q) * 64 + d] += off; }
        __syncthreads();
        {
            float at[8], bt[8], kt[8], rt[8];
#pragma unroll
            for (int i = 0; i < 8; ++i) { const float cu = CUM[t * 64 + d0 + i], cC = CUM[63 * 64 + d0 + i], en = __expf(-cu), ec = __expf(cC - cu);
                at[i] = av[i] * __expf(cu - lw[i]); bt[i] = bv[i] * en; kt[i] = kv[i] * en; rt[i] = rv[i] * __expf(cu);
                BHc[(d0 + i) * RW_LD + t] = (bf16)f2bf(bv[i] * ec); KHc[(d0 + i) * RW_LD + t] = (bf16)f2bf(kv[i] * ec); VTc[(d0 + i) * RW_LD + t] = (bf16)f2bf(vv[i]);
                XT[(d0 + i) * RW_FLD + t] = bf2f((bf16)f2bf(at[i]));
                if (t == 63) GAMC[(size_t)item * 64 + d0 + i] = __expf(cC); }
            *(LAS v4u*)(AT + t * RW_LD + d0) = pack8(at); *(LAS v4u*)(BT + t * RW_LD + d0) = pack8(bt); *(LAS v4u*)(KT + t * RW_LD + d0) = pack8(kt); *(LAS v4u*)(RT + t * RW_LD + d0) = pack8(rt);
        }
        __syncthreads();
        {
            const int msel = wave >> 1;
            const LAS bf16* As = (msel == 0 || msel == 2) ? BT : KT; const LAS bf16* Bs = (msel < 2) ? AT : RT;
            f32x4 accs[8];
#pragma unroll
            for (int q = 0; q < 8; ++q) { const int tile = (wave & 1) * 8 + q, mt = tile >> 2, nt = tile & 3; accs[q] = (f32x4){0.f, 0.f, 0.f, 0.f};
                accs[q] = mm16(As + mt * 16 * RW_LD, RW_LD, Bs + nt * 16 * RW_LD, RW_LD, 64, accs[q], lane);
                const int tt = nt * 16 + cc, s0 = mt * 16 + 4 * g, lim = (msel < 2) ? tt - 1 : tt;
                accs[q].x = (s0 + 0 <= lim) ? accs[q].x : 0.f; accs[q].y = (s0 + 1 <= lim) ? accs[q].y : 0.f; accs[q].z = (s0 + 2 <= lim) ? accs[q].z : 0.f; accs[q].w = (s0 + 3 <= lim) ? accs[q].w : 0.f; }
            __syncthreads();
            LAS bf16* outp = NI + msel * 64 * RW_LD;
#pragma unroll
            for (int q = 0; q < 8; ++q) { const int tile = (wave & 1) * 8 + q, mt = tile >> 2, nt = tile & 3;
                *(LAS unsigned long long*)(outp + (nt * 16 + cc) * RW_LD + mt * 16 + 4 * g) = pack4(accs[q]); }
        }
        __syncthreads();
        if (wave == 0) {
            const int blk = lane >> 4, col = lane & 15; float x[16];
#pragma unroll
            for (int tt = 0; tt < 16; ++tt) { float nr[16]; { float lo[8], hi[8]; unpack8(*(const LAS v4u*)(NI + (16 * blk + tt) * RW_LD + 16 * blk), lo); unpack8(*(const LAS v4u*)(NI + (16 * blk + tt) * RW_LD + 16 * blk + 8), hi);
#pragma unroll
                    for (int q = 0; q < 8; ++q) { nr[q] = lo[q]; nr[8 + q] = hi[q]; } }
                float a = (tt == col) ? 1.f : 0.f;
#pragma unroll
                for (int q = 0; q < tt; ++q) a += nr[q] * x[q];
                x[tt] = a; TI[(blk * 16 + tt) * 16 + col] = (bf16)f2bf(a); }
        } else {
            for (int tile = wave - 1; tile < 16; tile += 7) { const int mt = tile >> 2, nt = tile & 3;
                f32x4 acc = {0.f, 0.f, 0.f, 0.f}; acc = mm16(AAK + mt * 16 * RW_LD, RW_LD, VTc + nt * 16 * RW_LD, RW_LD, 64, acc, lane);
                *(LAS f32x4*)(XT + (64 + nt * 16 + cc) * RW_FLD + mt * 16 + 4 * g) = acc; }
        }
        __syncthreads();
        {
            s16x4 xb[4];
#pragma unroll
            for (int i = 0; i < 4; ++i) {
                f32x4 acc = *(const LAS f32x4*)(XT + (wave * 16 + cc) * RW_FLD + 16 * i + 4 * g);
#pragma unroll
                for (int k = 0; k < i; ++k) { const s16x4 a = *(const LAS s16x4*)(NI + (16 * i + cc) * RW_LD + 16 * k + 4 * g); acc = __builtin_amdgcn_mfma_f32_16x16x16bf16_1k(a, xb[k], acc, 0, 0, 0); }
                const s16x4 yb = cvt4(acc), ta = *(const LAS s16x4*)(TI + (i * 16 + cc) * 16 + 4 * g);
                const f32x4 xi = __builtin_amdgcn_mfma_f32_16x16x16bf16_1k(ta, yb, (f32x4){0.f, 0.f, 0.f, 0.f}, 0, 0, 0);
                xb[i] = cvt4(xi);
            }
            __syncthreads();
#pragma unroll
            for (int i = 0; i < 4; ++i) *(LAS s16x4*)(XB16 + (wave * 16 + cc) * RW_LD + 16 * i + 4 * g) = xb[i];
        }
        __syncthreads();
        {
            const int osel = wave >> 1; const size_t ob = (size_t)item * 4096;
#pragma unroll 1
            for (int q = 0; q < 8; ++q) { const int tile = (wave & 1) * 8 + q, mt = tile >> 2, nt = tile & 3; f32x4 acc = {0.f, 0.f, 0.f, 0.f};
                if (osel == 0) {
                    acc = mm16(XB16 + mt * 16 * RW_LD, RW_LD, BHc + nt * 16 * RW_LD, RW_LD, 64, acc, lane);
                    *(unsigned long long*)(PP + ob + (nt * 16 + cc) * 64 + mt * 16 + 4 * g) = pack4(acc);
                } else if (osel == 1) {
                    acc = mm16(BHc + mt * 16 * RW_LD, RW_LD, XB16 + (64 + nt * 16) * RW_LD, RW_LD, 64, acc, lane);
                    acc = mm16(KHc + mt * 16 * RW_LD, RW_LD, VTc + nt * 16 * RW_LD, RW_LD, 64, acc, lane);
                    *(unsigned long long*)(QQ + ob + (nt * 16 + cc) * 64 + mt * 16 + 4 * g) = pack4(acc);
                } else if (osel == 2) {
                    acc = mm16(XB16 + mt * 16 * RW_LD, RW_LD, ARB + nt * 16 * RW_LD, RW_LD, 64, acc, lane);
                    const unsigned long long rr = *(const LAS unsigned long long*)(RT + (nt * 16 + cc) * RW_LD + mt * 16 + 4 * g);
                    acc.x += bf2f((bf16)(rr & 0xffffu)); acc.y += bf2f((bf16)((rr >> 16) & 0xffffu)); acc.z += bf2f((bf16)((rr >> 32) & 0xffffu)); acc.w += bf2f((bf16)(rr >> 48));
                    *(unsigned long long*)(RH + ob + (nt * 16 + cc) * 64 + mt * 16 + 4 * g) = pack4(acc);
                } else {
                    acc = mm16(XB16 + (64 + mt * 16) * RW_LD, RW_LD, ARB + nt * 16 * RW_LD, RW_LD, 64, acc, lane);
                    acc = mm16(VTc + mt * 16 * RW_LD, RW_LD, ARK + nt * 16 * RW_LD, RW_LD, 64, acc, lane);
                    *(unsigned long long*)(YH + ob + (nt * 16 + cc) * 64 + mt * 16 + 4 * g) = pack4(acc);
                } }
        }
        __syncthreads();
    }
}

constexpr int CH_R = 6, CH_SLOT = 9216 + 9216 + 256;
constexpr int CH_RING = 0, CH_SI = CH_R * CH_SLOT, CH_FLAGS = CH_SI + 4 * 2304;
static_assert(CH_FLAGS + 64 <= MISC_OFF, "chain LDS map");
struct ChainRegs { v4u p[8], q[8]; f32x4 gm; };
__device__ __forceinline__ void chain_fetch(ChainRegs& o, const bf16* PP, const bf16* QQ, const float* GAMC, int item, int lane) {
    const size_t ob = (size_t)item * 4096;
#pragma unroll
    for (int i = 0; i < 8; ++i) { o.p[i] = *(const v4u*)(PP + ob + (size_t)(i * 64 + lane) * 8); o.q[i] = *(const v4u*)(QQ + ob + (size_t)(i * 64 + lane) * 8); }
    o.gm = *(const f32x4*)(GAMC + (size_t)item * 64 + (lane & 15) * 4);
}
__device__ __forceinline__ void chain_commit(const ChainRegs& o, LAS unsigned char* L, int c, int lane) {
    volatile LAS unsigned* flags = (volatile LAS unsigned*)(L + CH_FLAGS);
    const int slot = c % CH_R;
    if (c >= CH_R) { const unsigned need = (unsigned)(c - CH_R + 1);
        for (;;) { const unsigned m0 = flags[CH_R + 0], m1 = flags[CH_R + 1], m2 = flags[CH_R + 2], m3 = flags[CH_R + 3];
            if (m0 >= need && m1 >= need && m2 >= need && m3 >= need) break; __builtin_amdgcn_s_sleep(1); } }
    asm volatile("" ::: "memory");
    LAS unsigned char* sl = L + CH_RING + slot * CH_SLOT;
#pragma unroll
    for (int i = 0; i < 8; ++i) { const int idx = i * 64 + lane, row = idx >> 3, c16 = idx & 7;
        *(LAS v4u*)(sl + row * 144 + c16 * 16) = o.p[i]; *(LAS v4u*)(sl + 9216 + row * 144 + c16 * 16) = o.q[i]; }
    if (lane < 16) *(LAS f32x4*)(sl + 18432 + lane * 16) = o.gm;
    asm volatile("s_waitcnt lgkmcnt(0)" ::: "memory");
    if (lane == 0) flags[slot] = (unsigned)(c + 1);
}
__device__ __forceinline__ void ph_rwkv_b(const Ctx& C, int bh  , const bf16* PP, const bf16* QQ, const float* GAMC, bf16* S0) {
    const int lane = C.lane, wave = C.wave, cc = lane & 15, g = lane >> 4, b = bh >> 3, h = bh & 7;
    LAS unsigned char* L = C.lds;
    volatile LAS unsigned* flags = (volatile LAS unsigned*)(L + CH_FLAGS);
    if (C.tid < 16) flags[C.tid] = 0u;
    __syncthreads();
    if (wave >= 4) {
        const int j = wave - 4;
        ChainRegs A, B;
        int lc = j;
        chain_fetch(A, PP, QQ, GAMC, (b * 128 + lc) * 8 + h, lane);
        for (;;) {
            if (lc + 4 < 128) chain_fetch(B, PP, QQ, GAMC, (b * 128 + lc + 4) * 8 + h, lane);
            chain_commit(A, L, lc, lane);
            lc += 4; if (lc >= 128) break;
            if (lc + 4 < 128) chain_fetch(A, PP, QQ, GAMC, (b * 128 + lc + 4) * 8 + h, lane);
            chain_commit(B, L, lc, lane);
            lc += 4; if (lc >= 128) break;
        }
    } else {
        const int vt = wave;
        LAS bf16* SI = (LAS bf16*)(L + CH_SI + vt * 2304);
        f32x4 st[4];
#pragma unroll
        for (int mt = 0; mt < 4; ++mt) st[mt] = (f32x4){0.f, 0.f, 0.f, 0.f};
        for (int c = 0; c < 128; ++c) {
            const int item = (b * 128 + c) * 8 + h, slot = c % CH_R; const size_t ob = (size_t)item * 4096;
#pragma unroll
            for (int mt = 0; mt < 4; ++mt) { const unsigned long long pk = pack4(st[mt]);
                *(unsigned long long*)(S0 + ob + (vt * 16 + cc) * 64 + mt * 16 + 4 * g) = pk; *(LAS unsigned long long*)(SI + cc * RW_LD + mt * 16 + 4 * g) = pk; }
            while (flags[slot] < (unsigned)(c + 1)) __builtin_amdgcn_s_sleep(1);
            asm volatile("s_waitcnt lgkmcnt(0)" ::: "memory");
            const LAS unsigned char* sl = L + CH_RING + slot * CH_SLOT;
            const LAS bf16* Pi = (const LAS bf16*)sl; const LAS bf16* Qi = (const LAS bf16*)(sl + 9216); const LAS float* Gi = (const LAS float*)(sl + 18432);
            const s16x8 b0 = *(const LAS s16x8*)(SI + cc * RW_LD + 8 * g), b1 = *(const LAS s16x8*)(SI + cc * RW_LD + 32 + 8 * g);
#pragma unroll
            for (int mt = 0; mt < 4; ++mt) {
                const f32x4 gm = *(const LAS f32x4*)(Gi + mt * 16 + 4 * g);
                const unsigned long long qq = *(const LAS unsigned long long*)(Qi + (vt * 16 + cc) * RW_LD + mt * 16 + 4 * g);
                const s16x8 a0 = *(const LAS s16x8*)(Pi + (mt * 16 + cc) * RW_LD + 8 * g), a1 = *(const LAS s16x8*)(Pi + (mt * 16 + cc) * RW_LD + 32 + 8 * g);
                f32x4 acc; acc.x = gm.x * st[mt].x + bf2f((bf16)(qq & 0xffffu)); acc.y = gm.y * st[mt].y + bf2f((bf16)((qq >> 16) & 0xffffu));
                acc.z = gm.z * st[mt].z + bf2f((bf16)((qq >> 32) & 0xffffu)); acc.w = gm.w * st[mt].w + bf2f((bf16)(qq >> 48));
                acc = __builtin_amdgcn_mfma_f32_16x16x32_bf16(a0, b0, acc, 0, 0, 0); acc = __builtin_amdgcn_mfma_f32_16x16x32_bf16(a1, b1, acc, 0, 0, 0);
                st[mt] = acc; }
            asm volatile("s_waitcnt lgkmcnt(0)" ::: "memory");
            if (lane == 0) flags[CH_R + vt] = (unsigned)(c + 1);
        }
    }
    __syncthreads();
}

__device__ __forceinline__ void ph_rwkv_c(const Ctx& C, const bf16* S0, const bf16* RH, const bf16* YH, const float* RK, const bf16* GG, const bf16* VF,
                                          const float* gn_g, const float* gn_b, bf16* O) {
    const int lane = C.lane, cc = lane & 15, g = lane >> 4;
    for (int item = C.bid * 8 + C.wave; item < 4096; item += C.nb * 8) {
        const int h = item & 7, c = (item >> 3) & 127, b = item >> 10; const size_t m0 = (size_t)b * T_ + c * 64, ob = (size_t)item * 4096;
        s16x8 af[4][2], bfr[4][2];
#pragma unroll
        for (int q = 0; q < 4; ++q)
#pragma unroll
            for (int k = 0; k < 2; ++k) { af[q][k] = *(const s16x8*)(S0 + ob + (q * 16 + cc) * 64 + k * 32 + 8 * g); bfr[q][k] = *(const s16x8*)(RH + ob + (q * 16 + cc) * 64 + k * 32 + 8 * g); }
#pragma unroll
        for (int nt = 0; nt < 4; ++nt) {
            const size_t m = m0 + nt * 16 + cc;
            f32x4 y[4]; float s1 = 0.f;
#pragma unroll
            for (int mt = 0; mt < 4; ++mt) { const unsigned long long yh = *(const unsigned long long*)(YH + ob + (nt * 16 + cc) * 64 + mt * 16 + 4 * g);
                f32x4 acc; acc.x = bf2f((bf16)(yh & 0xffffu)); acc.y = bf2f((bf16)((yh >> 16) & 0xffffu)); acc.z = bf2f((bf16)((yh >> 32) & 0xffffu)); acc.w = bf2f((bf16)(yh >> 48));
                acc = __builtin_amdgcn_mfma_f32_16x16x32_bf16(af[mt][0], bfr[nt][0], acc, 0, 0, 0); acc = __builtin_amdgcn_mfma_f32_16x16x32_bf16(af[mt][1], bfr[nt][1], acc, 0, 0, 0);
                y[mt] = acc; s1 += (acc.x + acc.y) + (acc.z + acc.w); }
            s1 += __shfl_xor(s1, 16); s1 += __shfl_xor(s1, 32);
            const float mean = s1 * (1.f / 64.f); float s2 = 0.f;
#pragma unroll
            for (int mt = 0; mt < 4; ++mt) { y[mt] = y[mt] - mean; s2 += (y[mt].x * y[mt].x + y[mt].y * y[mt].y) + (y[mt].z * y[mt].z + y[mt].w * y[mt].w); }
            s2 += __shfl_xor(s2, 16); s2 += __shfl_xor(s2, 32);
            const float rstd = 1.f / sqrtf(s2 * (1.f / 64.f) + 64e-5f), rk = RK[m * 8 + h];
#pragma unroll
            for (int mt = 0; mt < 4; ++mt) { const int v = h * 64 + mt * 16 + 4 * g;
                const f32x4 gg4 = *(const f32x4*)(gn_g + v), gb4 = *(const f32x4*)(gn_b + v);
                const unsigned long long vx = *(const unsigned long long*)(VF + m * 512 + v), gx = *(const unsigned long long*)(GG + m * 512 + v);
                f32x4 o;
                o.x = (y[mt].x * rstd * gg4.x + gb4.x + rk * bf2f((bf16)(vx & 0xffffu))) * bf2f((bf16)(gx & 0xffffu));
                o.y = (y[mt].y * rstd * gg4.y + gb4.y + rk * bf2f((bf16)((vx >> 16) & 0xffffu))) * bf2f((bf16)((gx >> 16) & 0xffffu));
                o.z = (y[mt].z * rstd * gg4.z + gb4.z + rk * bf2f((bf16)((vx >> 32) & 0xffffu))) * bf2f((bf16)((gx >> 32) & 0xffffu));
                o.w = (y[mt].w * rstd * gg4.w + gb4.w + rk * bf2f((bf16)(vx >> 48))) * bf2f((bf16)(gx >> 48));
                *(unsigned long long*)(O + m * D_ + 512 + v) = pack4(o); }
        }
    }
}

__device__ __forceinline__ void ph_conv(const Ctx& C, const bf16* U, const float* cw, const float* cb, bf16* ACT) {
    constexpr int TR = 32, NJB = DFF / 8, NTR = T_ / TR;
    for (int item = C.bid * NT + C.tid; item < NJB * NTR; item += C.nb * NT) {
        const int jb = item % NJB, tr = item / NJB, j = jb * 8, t0 = tr * TR;
        float wg[3][8], wv[3][8], bg[8], bv[8];
#pragma unroll
        for (int i = 0; i < 8; ++i) { bg[i] = cb[j + i]; bv[i] = cb[DFF + j + i];
#pragma unroll
            for (int k = 0; k < 3; ++k) { wg[k][i] = cw[k * NUP + j + i]; wv[k][i] = cw[k * NUP + DFF + j + i]; } }
        float g2[8], g1[8], v2[8], v1[8];
        if (t0 == 0) {
#pragma unroll
            for (int i = 0; i < 8; ++i) { g2[i] = 0.f; g1[i] = 0.f; v2[i] = 0.f; v1[i] = 0.f; } }
        else { unpack8(*(const v4u*)(U + (size_t)(t0 - 2) * NUP + j), g2); unpack8(*(const v4u*)(U + (size_t)(t0 - 1) * NUP + j), g1);
               unpack8(*(const v4u*)(U + (size_t)(t0 - 2) * NUP + DFF + j), v2); unpack8(*(const v4u*)(U + (size_t)(t0 - 1) * NUP + DFF + j), v1); }
#pragma unroll 4
        for (int tt = 0; tt < TR; ++tt) {
            const int t = t0 + tt; float g0[8], v0[8], o[8];
            unpack8(*(const v4u*)(U + (size_t)t * NUP + j), g0); unpack8(*(const v4u*)(U + (size_t)t * NUP + DFF + j), v0);
#pragma unroll
            for (int i = 0; i < 8; ++i) { const float gc = bg[i] + wg[0][i] * g2[i] + wg[1][i] * g1[i] + wg[2][i] * g0[i], vc = bv[i] + wv[0][i] * v2[i] + wv[1][i] * v1[i] + wv[2][i] * v0[i];
                o[i] = siluf_(gc) * vc; g2[i] = g1[i]; g1[i] = g0[i]; v2[i] = v1[i]; v1[i] = v0[i]; }
            *(v4u*)(ACT + (size_t)t * DFF + j) = pack8(o);
        }
    }
}
}

namespace pg8 {
struct EpiRes {
    static constexpr bool PERM = false, AFTER_DRAIN = false;
    const float* base; float* out; const float* gate; int gstride;
    __device__ __forceinline__ void operator()(const f32x4 (&acc)[2][2][4][2], const Unit& u, int wr, int wc, int fr, int fq) const {
        const int b = (u.pm * BM) / 8192; const float* gp = gate + (size_t)b * gstride;
        const int col0 = u.pn * BM + wc * 32 + 4 * fq;
#pragma unroll
        for (int ai = 0; ai < 2; ++ai)
#pragma unroll
            for (int m = 0; m < 4; ++m) { const size_t off = (size_t)(u.pm * BM + ai * HALF + wr * 64 + m * 16 + fr) * 1024 + col0;
#pragma unroll
                for (int bj = 0; bj < 2; ++bj)
#pragma unroll
                    for (int n = 0; n < 2; ++n) { const int cc = bj * HALF + n * 16; const f32x4 gv = *(const f32x4*)(gp + col0 + cc); const f32x4 bs = *(const f32x4*)(base + off + cc);
                        *(f32x4*)(out + off + cc) = bs + gv * acc[ai][bj][m][n]; } }
    }
};
}

namespace hy {
struct Args { const float* in[31]; float* out; unsigned char* ws; };
__global__ void __launch_bounds__(NT, 2) hy_fwd(Args A) {
    extern __shared__ __attribute__((aligned(16))) unsigned char lds_raw[];
    Ctx C; C.bid = blockIdx.x; C.nb = gridDim.x; C.tid = threadIdx.x; C.lane = C.tid & 63; C.wave = __builtin_amdgcn_readfirstlane(C.tid >> 6); C.lds = (LAS unsigned char*)lds_raw;
    volatile LAS unsigned* MISC = (volatile LAS unsigned*)(C.lds + MISC_OFF);
    for (int u = C.tid; u < (LDS_BYTES - MISC_OFF) / 4; u += NT) ((LAS unsigned*)(C.lds + MISC_OFF))[u] = 0u;
    __syncthreads();
    unsigned char* ws = A.ws;
    XcdBarrier bar = xcd_barrier_post((unsigned*)(ws + WS_CTL) + CW_BAR, MISC + 8);
#define PHASE_BEGIN() do { int t_ = threadIdx.x; asm volatile("" : "+v"(t_)); int b_ = blockIdx.x; asm volatile("" : "+s"(b_)); \
    C.tid = t_; C.lane = t_ & 63; C.wave = __builtin_amdgcn_readfirstlane(t_ >> 6); C.bid = b_; } while (0)
#ifdef HY_DIAG
    unsigned long long ts_last = __builtin_amdgcn_s_memrealtime(); float tacc[10] = {0.f, 0.f, 0.f, 0.f, 0.f, 0.f, 0.f, 0.f, 0.f, 0.f};
#define GRID_BAR(cat) do { xcd_barrier(bar); PHASE_BEGIN(); { const unsigned long long n_ = __builtin_amdgcn_s_memrealtime(); tacc[cat] += (float)(n_ - ts_last); ts_last = n_; } } while (0)
#else
#define GRID_BAR(cat) do { xcd_barrier(bar); PHASE_BEGIN(); } while (0)
#endif
#ifndef HY_REPCAT
#define HY_REPCAT (-1)
#endif
#define NREP(cat) ((HY_REPCAT == (cat)) ? 2 : 1)
    float* out = A.out;
#define in A.in
    float* MOD = (float*)(ws + WS_MOD);
    bf16 *WIN = (bf16*)(ws + WS_WIN), *WOUT = (bf16*)(ws + WS_WOUT), *WUP = (bf16*)(ws + WS_WUP), *WDN = (bf16*)(ws + WS_WDN);
    bf16 *XB = (bf16*)(ws + WS_XB), *O = (bf16*)(ws + WS_O), *VF = (bf16*)(ws + WS_VF), *PG = (bf16*)(ws + WS_PG), *PR = (bf16*)(ws + WS_PR), *VL = (bf16*)(ws + WS_VL);
    bf16 *RH = (bf16*)(ws + WS_RH), *YH = (bf16*)(ws + WS_YH), *PP = (bf16*)(ws + WS_PP), *QQ = (bf16*)(ws + WS_QQ), *GG = (bf16*)(ws + WS_GG), *S0 = (bf16*)(ws + WS_S0);
    float *GAMC = (float*)(ws + WS_GAMC), *RK = (float*)(ws + WS_RK);
    bf16* LORA = (bf16*)(ws + WS_LORA);
    bf16* DS = (bf16*)(ws + WS_GK); float* GAM = (float*)(ws + WS_GAM);
    bf16 *ACT = (bf16*)(ws + WS_ACT), *U = (bf16*)(ws + WS_U);

    ph_mod(C, in[1], in[2], in[3], MOD);
    for (int l = 0; l < L_; ++l) {
        const float* modl = MOD + (size_t)l * 4 * 6144;
        const float* xres = l ? out : in[0];
        for (int r_ = 0; r_ < NREP(0); ++r_) {
        wprep_mat(C, in[5] + (size_t)l * D_ * IN_COLS, D_, IN_COLS, NIN, WIN, 1, l ? in[6] : nullptr);
        wprep_mat(C, in[24] + (size_t)l * D_ * D_, D_, D_, D_, WOUT, 0, nullptr);
        wprep_mat(C, in[26] + (size_t)l * D_ * NUP, D_, NUP, NUP, WUP, 0, nullptr);
        wprep_mat(C, in[29] + (size_t)l * DFF * D_, DFF, D_, D_, WDN, 0, nullptr);
        wprep_mat(C, in[12] + (size_t)l * 64 * 512, 64, 512, 512, LORA, 0, nullptr);
        wprep_mat(C, in[14] + (size_t)l * 64 * 512, 64, 512, 512, LORA + 512 * 64, 0, nullptr);
        wprep_mat(C, in[16] + (size_t)l * 128 * 512, 128, 512, 512, LORA + 2 * 512 * 64, 0, nullptr);
        if (l) wprep_mat(C, in[17], 32, 512, 512, LORA + 2 * 512 * 64 + 512 * 128, 0, nullptr);
        }
        GRID_BAR(0);
        for (int r_ = 0; r_ < NREP(1); ++r_) ph_norm(C, xres, in[4] + l * D_, modl + 0 * D_, modl + 1 * D_, XB);
        GRID_BAR(1);
        for (int r_ = 0; r_ < NREP(2); ++r_) { pg8::Gemm g{XB, WIN, M_, NIN, D_}; pg8::StaticOrder S; S.init(M_, NIN, C.nb, C.bid);
          pg8::EpiBf16<0> E{PG, NPG, nullptr, NPG, (WS_PR - WS_PG) / 2, 1.f};
          pg8::gemm_phase<pg8::EpiBf16<0>, pg8::StaticOrder, true, true>(C.lds, g, S, E); }
        GRID_BAR(2);
        for (int r_ = 0; r_ < NREP(3); ++r_) {
        ph_gla_a(C, PG, in[7] + l * 16 * 256, in[8] + l * 256, DS, GAM, VL);
        { RwkvW W{in[10] + l * 1792, in[11], in[13] + l * 512, in[15] + l * 512, in[18], in[19] + l * 512, in[20] + l * 512, in[21] + l * 512,
                  LORA, LORA + 512 * 64, LORA + 2 * 512 * 64, LORA + 2 * 512 * 64 + 512 * 128};
          ph_rwkv_a(C, PR, PG, W, l, PP, QQ, RH, YH, GAMC, RK, GG, VF, r_ == NREP(3) - 1); } }
        GRID_BAR(3);
        if (C.bid < 32) { for (int r_ = 0; r_ < NREP(4); ++r_) ph_rwkv_b(C, C.bid, PP, QQ, GAMC, S0); }
        else { Ctx C2 = C; C2.bid = C.bid - 32; C2.nb = C.nb - 32; ph_gla_b(C2, DS, GAM); }
        GRID_BAR(4);
        for (int r_ = 0; r_ < NREP(5); ++r_) {
        ph_gla_c(C, PG, in[7] + l * 16 * 256, in[8] + l * 256, in[9] + l * 128, DS, O);
        ph_rwkv_c(C, S0, RH, YH, RK, GG, VF, in[22] + l * 512, in[23] + l * 512, O); }
        GRID_BAR(5);
        { pg8::Gemm g{O, WOUT, M_, D_, D_}; pg8::StaticOrder S; S.init(M_, D_, C.nb, C.bid);
          pg8::EpiRes E{xres, out, modl + 2 * D_, 6144};
          pg8::gemm_phase<pg8::EpiRes, pg8::StaticOrder, true, true>(C.lds, g, S, E); }
        GRID_BAR(6);
        for (int r_ = 0; r_ < NREP(1); ++r_) ph_norm(C, out, in[25] + l * D_, modl + 3 * D_, modl + 4 * D_, XB);
        GRID_BAR(1);
        for (int b = 0; b < B_; ++b) {
            for (int r_ = 0; r_ < NREP(7); ++r_) { pg8::Gemm g{XB + (size_t)b * T_ * D_, WUP, T_, NUP, D_}; pg8::StaticOrder S; S.init(T_, NUP, C.nb, C.bid);
              pg8::EpiBf16<0> E{U, NUP, nullptr, 0, 0, 1.f};
              pg8::gemm_phase<pg8::EpiBf16<0>, pg8::StaticOrder, true, true>(C.lds, g, S, E); }
            GRID_BAR(7);
            for (int r_ = 0; r_ < NREP(8); ++r_) ph_conv(C, U, in[27] + (size_t)l * 3 * NUP, in[28] + (size_t)l * NUP, ACT + (size_t)b * T_ * DFF);
            GRID_BAR(8);
        }
        { pg8::Gemm g{ACT, WDN, M_, D_, DFF}; pg8::StaticOrder S; S.init(M_, D_, C.nb, C.bid);
          pg8::EpiRes E{out, out, modl + 5 * D_, 6144};
          pg8::gemm_phase<pg8::EpiRes, pg8::StaticOrder, true, true>(C.lds, g, S, E); }
        GRID_BAR(9);
    }
    ph_final(C, out, in[30]);
#ifdef HY_DIAG
    GRID_BAR(1);
    if (C.bid == 0) { if (C.tid == 0) out[0] = tacc[HY_DIAG_A] * 0.1f; for (int i = 1 + C.tid; i <= 10000; i += NT) out[i] = tacc[HY_DIAG_B] * 0.01f; }
#endif
#undef GRID_BAR
#undef PHASE_BEGIN
#undef in
}
}

extern "C" void kernel_launch(void* const* d_in, const int* in_sizes, int n_in, void* d_out, int out_size, void* d_ws, size_t ws_size, hipStream_t stream) {
    using namespace hy;
    static int grid = 0;
    if (grid == 0) {
        if (n_in != 31 || in_sizes[0] != M_ * D_ || out_size != M_ * D_ || ws_size < WS_END) { fprintf(stderr, "kernel_launch: unexpected shapes (n_in %d, in0 %d, out %d, ws %zu)\n", n_in, n_in > 0 ? in_sizes[0] : -1, out_size, ws_size); grid = -1; return; }
        if (hipFuncSetAttribute((const void*)hy_fwd, hipFuncAttributeMaxDynamicSharedMemorySize, LDS_BYTES) != hipSuccess) { fprintf(stderr, "kernel_launch: hipFuncSetAttribute failed\n"); grid = -1; return; }
        int dev = 0, cus = 0, per_cu = 0;
        (void)hipGetDevice(&dev); (void)hipDeviceGetAttribute(&cus, hipDeviceAttributeMultiprocessorCount, dev);
        (void)hipOccupancyMaxActiveBlocksPerMultiprocessor(&per_cu, (const void*)hy_fwd, NT, LDS_BYTES);
        if (per_cu < 1) fprintf(stderr, "kernel_launch: occupancy query reports %d blocks per CU\n", per_cu);
        (void)hipGetLastError();
        grid = cus > 0 ? cus : 256;
    }
    if (grid < 0) return;
    (void)hipMemsetAsync((char*)d_ws + WS_CTL, 0, CTL_ZERO_BYTES, stream);
    Args a{};
    for (int i = 0; i < 31; ++i) a.in[i] = (const float*)d_in[i];
    a.out = (float*)d_out; a.ws = (unsigned char*)d_ws;
    hipLaunchKernelGGL(hy_fwd, dim3(grid), dim3(NT), LDS_BYTES, stream, a);
}
```

```cpp
#include <hip/hip_runtime.h>
#include <cstdio>
#include <cstdint>
namespace pg8 {
#define PG8_LAS __attribute__((address_space(3)))
typedef unsigned short bf16_t;
typedef short bf16x8 __attribute__((ext_vector_type(8)));
typedef float f32x4 __attribute__((ext_vector_type(4)));
typedef unsigned u32x4 __attribute__((ext_vector_type(4)));
constexpr int BM = 256, BK = 64, HALF = 128, HTB = HALF * BK * 2  , STAGE_BYTES = 8 * HTB, NXCD = 8, WGM = 8;

__host__ __device__ __forceinline__ int lds_byte(int r, int c) { const int st = (r >> 4) * 2 + (c >> 5), rr = r & 15, cc = c & 31, ob = rr * 64 + cc * 2; return st * 1024 + (ob ^ (((ob >> 9) & 1) << 5)); }
__host__ __device__ __forceinline__ void stage_rc(int b, int& R, int& C) { const int st = b / 1024, sb = b % 1024, swz = sb ^ (((sb >> 9) & 1) << 5); R = (st >> 1) * 16 + swz / 64; C = (st & 1) * 32 + (swz % 64) / 2; }
__host__ __device__ __forceinline__ int perm32(int rho) { const int n = rho >> 4, i = rho & 15; return 8 * (i >> 2) + 4 * n + (i & 3); }

struct Unit { int pm, pn; };
struct Gemm { const bf16_t* A; const bf16_t* Bt; int M, N, K; };

struct StaticOrder {
    int nM, nN, nwg, G, c;
    __host__ __device__ void init(int M, int N, int G_, int c_) { nM = M / BM; nN = N / BM; nwg = nM * nN; G = G_; c = c_; }
    __host__ __device__ bool next(int i, Unit& u) const {
        const long L = (long)i * G + c; if (L >= nwg) return false;
        int wgid = (int)L; { const int q = nwg / NXCD, r = nwg % NXCD, xcd = wgid % NXCD, off = wgid / NXCD; wgid = (xcd < r ? xcd * (q + 1) : r * (q + 1) + (xcd - r) * q) + off; }
        const int nig = WGM * nN, gid = wgid / nig, fm = gid * WGM, gsz = (nM - fm) < WGM ? (nM - fm) : WGM;
        u.pm = fm + ((wgid % nig) % gsz); u.pn = (wgid % nig) / gsz; return true;
    }
    __device__ __forceinline__ void a_ready(const Unit&) const {}
    __device__ __forceinline__ void done(const Unit&) const {}
};

__device__ __forceinline__ unsigned cvt_pk_bf16(float lo, float hi) { unsigned r; asm volatile("v_cvt_pk_bf16_f32 %0, %1, %2" : "=v"(r) : "v"(lo), "v"(hi)); return r; }
typedef float f32x2 __attribute__((ext_vector_type(2)));
__device__ __forceinline__ f32x2 gelu_pk(f32x2 v) {
    const f32x2 av = __builtin_elementwise_abs(v), d = av * 0.2316418882f + 1.0f;
    f32x2 t; t.x = __builtin_amdgcn_rcpf(d.x); t.y = __builtin_amdgcn_rcpf(d.y);
    f32x2 q = t * 0.5307027145f + (-0.7265760135f); q = q * t + 0.7107068705f; q = q * t + (-0.142248368f); q = q * t + 0.127414796f; q = q * t;
    const f32x2 s = (v * v) * (-0.72134752044f);
    f32x2 e; e.x = __builtin_amdgcn_exp2f(s.x); e.y = __builtin_amdgcn_exp2f(s.y);
    const f32x2 m = v * (q * e), r = v - m;
    f32x2 o; o.x = v.x < 0.f ? m.x : r.x; o.y = v.y < 0.f ? m.y : r.y; return o;
}

template <int ACT  > struct EpiBf16 {
    static constexpr bool PERM = true, AFTER_DRAIN = false; static_assert(ACT == 0 || ACT == 1, "EpiBf16: ACT is 0 (none) or 1 (gelu_pk)");
    bf16_t* O; int ldc; const float* bias; int split_cols; size_t split_stride; float scale0;
    __device__ __forceinline__ void operator()(const f32x4 (&acc)[2][2][4][2], const Unit& u, int wr, int wc, int fr, int fq) const {
        const int row0 = u.pm * BM + wr * 64 + fr; int colt = u.pn * BM; bf16_t* base = O;
        float sc = 1.f; if (split_cols) { const int t = colt / split_cols; base += (size_t)t * split_stride; colt -= t * split_cols; if (t == 0) sc = scale0; }
        const int col0 = colt + wc * 32 + 8 * fq, bcol0 = u.pn * BM + wc * 32 + 8 * fq;
        f32x4 bv[2][2];
#pragma unroll
        for (int bj = 0; bj < 2; ++bj)
#pragma unroll
            for (int n = 0; n < 2; ++n) bv[bj][n] = bias ? *(const f32x4*)(bias + bcol0 + bj * HALF + 4 * n) : (f32x4){0.f, 0.f, 0.f, 0.f};
#pragma unroll
        for (int ai = 0; ai < 2; ++ai)
#pragma unroll
            for (int m = 0; m < 4; ++m) { bf16_t* rowp = base + (size_t)(row0 + ai * HALF + m * 16) * ldc + col0;
#pragma unroll
                for (int bj = 0; bj < 2; ++bj) { f32x4 v0 = acc[ai][bj][m][0] + bv[bj][0], v1 = acc[ai][bj][m][1] + bv[bj][1];
                    if (ACT == 1) { f32x2 a = gelu_pk((f32x2){v0[0], v0[1]}), b = gelu_pk((f32x2){v0[2], v0[3]}), c = gelu_pk((f32x2){v1[0], v1[1]}), d = gelu_pk((f32x2){v1[2], v1[3]});
                        v0 = (f32x4){a.x, a.y, b.x, b.y}; v1 = (f32x4){c.x, c.y, d.x, d.y}; }
                    v0 = v0 * sc; v1 = v1 * sc; u32x4 w; w.x = cvt_pk_bf16(v0[0], v0[1]); w.y = cvt_pk_bf16(v0[2], v0[3]); w.z = cvt_pk_bf16(v1[0], v1[1]); w.w = cvt_pk_bf16(v1[2], v1[3]);
                    *(u32x4*)(rowp + bj * HALF) = w; } }
    }
};
template <class Epi, class Sched, bool ALIGN_EPI = false, bool SP2 = false>
__device__ __forceinline__ void gemm_phase(PG8_LAS unsigned char* lds, const Gemm g, const Sched& S, const Epi& E) {
    int tid_ = threadIdx.x; asm volatile("" : "+v"(tid_));
    const int tid = tid_, wid = __builtin_amdgcn_readfirstlane(tid >> 6), lane = tid & 63, wr = wid >> 2, wc = wid & 3, fr = lane & 15, fq = lane >> 4;
    const int K = g.K, nt = K / BK;
    unsigned voffA[2], voffB[2];
#pragma unroll
    for (int i = 0; i < 2; ++i) { int R, C; stage_rc(tid * 16 + i * 8192, R, C); const int Rb = Epi::PERM ? ((R & ~31) + perm32(R & 31)) : R;
        voffA[i] = (unsigned)(R * K + C) * 2u; voffB[i] = (unsigned)(Rb * K + C) * 2u; }
    const size_t kstep = (size_t)(BK * 2);
    const size_t hstep = (size_t)HALF * K * 2;
    const size_t tstep = 2 * hstep;
    const unsigned ldsw = (unsigned)wid * 1024u;
    const int aoff = lds_byte(wr * 64 + fr, fq * 8), boff = lds_byte(wc * 32 + fr, fq * 8);
#define PG8_SA(b, h) (((b) * 2 + (h)) * HTB)
#define PG8_SB(b, h) ((4 + (b) * 2 + (h)) * HTB)
#define PG8_STAGE(bufoff, gbase, voff) do { _Pragma("unroll") for (int _i = 0; _i < 2; ++_i) \
        __builtin_amdgcn_global_load_lds((const unsigned*)((const char*)(gbase) + (voff)[_i]), (PG8_LAS unsigned*)(lds + (bufoff) + ldsw + _i * 8192), 16, 0, 0); } while (0)
#define PG8_LDA(dst, b, h) do { _Pragma("unroll") for (int m = 0; m < 4; ++m) _Pragma("unroll") for (int k = 0; k < 2; ++k) dst[m][k] = *(const PG8_LAS bf16x8*)(lds + PG8_SA(b, h) + aoff + m * 2048 + k * 1024); } while (0)
#define PG8_LDB(dst, b, h) do { _Pragma("unroll") for (int n = 0; n < 2; ++n) _Pragma("unroll") for (int k = 0; k < 2; ++k) dst[n][k] = *(const PG8_LAS bf16x8*)(lds + PG8_SB(b, h) + boff + n * 2048 + k * 1024); } while (0)
#define PG8_MMA(ai, bj, At, Bt) do { __builtin_amdgcn_s_setprio(1); _Pragma("unroll") for (int m = 0; m < 4; ++m) _Pragma("unroll") for (int n = 0; n < 2; ++n) _Pragma("unroll") for (int k = 0; k < 2; ++k) \
        acc[ai][bj][m][n] = __builtin_amdgcn_mfma_f32_16x16x32_bf16(Bt[n][k], At[m][k], acc[ai][bj][m][n], 0, 0, 0); __builtin_amdgcn_s_setprio(0); } while (0)
#define PG8_WAIT_V(n) asm volatile("s_waitcnt vmcnt(" #n ")" ::: "memory")
#define PG8_WAIT_L(n) asm volatile("s_waitcnt lgkmcnt(" #n ")" ::: "memory")
#define PG8_BAR __builtin_amdgcn_s_barrier()
#define PG8_SCHED __builtin_amdgcn_sched_barrier(0)
    Unit cur, nxt; int ui = 0;
    if (!S.next(0, cur)) return;
    f32x4 acc[2][2][4][2];
#pragma unroll
    for (int a = 0; a < 2; ++a)
#pragma unroll
        for (int b = 0; b < 2; ++b)
#pragma unroll
            for (int m = 0; m < 4; ++m)
#pragma unroll
                for (int n = 0; n < 2; ++n) acc[a][b][m][n] = (f32x4){0.f, 0.f, 0.f, 0.f};
    bf16x8 At[4][2], B0[2][2], B1[2][2];
    const char* cA = (const char*)g.A + (size_t)cur.pm * tstep; const char* cB = (const char*)g.Bt + (size_t)cur.pn * tstep;
    S.a_ready(cur);
    if constexpr (SP2) {
        PG8_STAGE(PG8_SB(0, 0), cB, voffB); PG8_STAGE(PG8_SB(0, 1), cB + hstep, voffB); PG8_STAGE(PG8_SA(0, 0), cA, voffA); PG8_STAGE(PG8_SA(0, 1), cA + hstep, voffA);
        if (wr == 1) PG8_BAR;
        PG8_WAIT_V(2); PG8_BAR;
        PG8_STAGE(PG8_SB(1, 0), cB + kstep, voffB); PG8_STAGE(PG8_SA(1, 0), cA + kstep, voffA); PG8_STAGE(PG8_SB(1, 1), cB + hstep + kstep, voffB);
        PG8_WAIT_V(6); PG8_BAR;
    } else {
        PG8_STAGE(PG8_SB(0, 0), cB, voffB); PG8_STAGE(PG8_SA(0, 0), cA, voffA); PG8_STAGE(PG8_SB(0, 1), cB + hstep, voffB); PG8_STAGE(PG8_SA(0, 1), cA + hstep, voffA);
        if (wr == 1) PG8_BAR;
        PG8_WAIT_V(4); PG8_BAR;
        PG8_STAGE(PG8_SB(1, 0), cB + kstep, voffB); PG8_STAGE(PG8_SA(1, 0), cA + kstep, voffA); PG8_STAGE(PG8_SB(1, 1), cB + hstep + kstep, voffB);
        PG8_WAIT_V(6); PG8_BAR;
    }
    for (;;) {
        const bool has_next = S.next(ui + 1, nxt);
        const char* nA = has_next ? (const char*)g.A + (size_t)nxt.pm * tstep : cA; const char* nB = has_next ? (const char*)g.Bt + (size_t)nxt.pn * tstep : cB;
        for (int t = 0; t < nt; t += 2) {
            const bool last = (t == nt - 2);
            const char* a1 = cA + (size_t)(t + 1) * kstep;
            const char* a2 = last ? nA : cA + (size_t)(t + 2) * kstep; const char* b2 = last ? nB : cB + (size_t)(t + 2) * kstep;
            const char* a3 = a2 + kstep; const char* b3 = b2 + kstep;
            if (last && has_next) S.a_ready(nxt);
            if constexpr (SP2) {
            PG8_LDB(B0, 0, 0); PG8_LDB(B1, 0, 1); PG8_SCHED; PG8_LDA(At, 0, 0); PG8_STAGE(PG8_SA(1, 1), a1 + hstep, voffA);
            PG8_WAIT_V(8); PG8_WAIT_L(0); PG8_BAR; PG8_MMA(0, 0, At, B0); PG8_MMA(0, 1, At, B1); PG8_BAR; PG8_SCHED;
            PG8_LDA(At, 0, 1); PG8_STAGE(PG8_SB(0, 0), b2, voffB); PG8_STAGE(PG8_SB(0, 1), b2 + hstep, voffB); PG8_STAGE(PG8_SA(0, 0), a2, voffA);
            PG8_WAIT_V(8); PG8_WAIT_L(0); PG8_BAR; PG8_MMA(1, 0, At, B0); PG8_MMA(1, 1, At, B1); PG8_BAR; PG8_SCHED;
            PG8_LDB(B0, 1, 0); PG8_LDB(B1, 1, 1); PG8_SCHED; PG8_LDA(At, 1, 0); PG8_STAGE(PG8_SA(0, 1), a2 + hstep, voffA);
            PG8_WAIT_V(8); PG8_WAIT_L(0); PG8_BAR; PG8_MMA(0, 0, At, B0); PG8_MMA(0, 1, At, B1); PG8_BAR; PG8_SCHED;
            PG8_LDA(At, 1, 1); PG8_STAGE(PG8_SB(1, 0), b3, voffB); PG8_STAGE(PG8_SB(1, 1), b3 + hstep, voffB); PG8_STAGE(PG8_SA(1, 0), a3, voffA);
            PG8_WAIT_V(8); PG8_WAIT_L(0); PG8_BAR; PG8_MMA(1, 0, At, B0); PG8_MMA(1, 1, At, B1); PG8_BAR; PG8_SCHED;
            } else {
            PG8_LDB(B0, 0, 0); PG8_SCHED; PG8_LDA(At, 0, 0); PG8_STAGE(PG8_SA(1, 1), a1 + hstep, voffA);
            PG8_WAIT_L(8); PG8_BAR; PG8_WAIT_L(0); PG8_MMA(0, 0, At, B0); PG8_BAR; PG8_SCHED;
            PG8_LDB(B1, 0, 1); PG8_STAGE(PG8_SB(0, 0), b2, voffB);
            PG8_BAR; PG8_WAIT_L(0); PG8_MMA(0, 1, At, B1); PG8_BAR;
            PG8_LDA(At, 0, 1); PG8_STAGE(PG8_SA(0, 0), a2, voffA);
            PG8_BAR; PG8_WAIT_L(0); PG8_MMA(1, 0, At, B0); PG8_BAR; PG8_SCHED;
            PG8_STAGE(PG8_SB(0, 1), b2 + hstep, voffB);
            PG8_WAIT_V(6); PG8_BAR; PG8_MMA(1, 1, At, B1); PG8_BAR;
            PG8_LDB(B0, 1, 0); PG8_SCHED; PG8_LDA(At, 1, 0); PG8_STAGE(PG8_SA(0, 1), a2 + hstep, voffA);
            PG8_WAIT_L(8); PG8_BAR; PG8_WAIT_L(0); PG8_MMA(0, 0, At, B0); PG8_BAR; PG8_SCHED;
            PG8_LDB(B1, 1, 1); PG8_STAGE(PG8_SB(1, 0), b3, voffB);
            PG8_BAR; PG8_WAIT_L(0); PG8_MMA(0, 1, At, B1); PG8_BAR;
            PG8_LDA(At, 1, 1); PG8_STAGE(PG8_SA(1, 0), a3, voffA);
            PG8_BAR; PG8_WAIT_L(0); PG8_MMA(1, 0, At, B0); PG8_BAR; PG8_SCHED;
            PG8_STAGE(PG8_SB(1, 1), b3 + hstep, voffB);
            PG8_WAIT_V(6); PG8_BAR; PG8_MMA(1, 1, At, B1); PG8_BAR;
            }
        }
        if constexpr (ALIGN_EPI) { if (wr == 0) PG8_BAR; }
        if constexpr (!Epi::AFTER_DRAIN) { E(acc, cur, wr, wc, fr, fq); S.done(cur); }
        if (!has_next) break;
#pragma unroll
        for (int a = 0; a < 2; ++a)
#pragma unroll
            for (int b = 0; b < 2; ++b)
#pragma unroll
                for (int m = 0; m < 4; ++m)
#pragma unroll
                    for (int n = 0; n < 2; ++n) acc[a][b][m][n] = (f32x4){0.f, 0.f, 0.f, 0.f};
        cur = nxt; cA = nA; cB = nB; ++ui;
        if constexpr (ALIGN_EPI) { if (wr == 1) PG8_BAR; }
    }
    PG8_WAIT_V(0);
    if constexpr (!ALIGN_EPI) { if (wr == 0) PG8_BAR; }
    PG8_BAR;
    if constexpr (Epi::AFTER_DRAIN) { E.fused(acc, cur, wr, wc, fr, fq, lds, wid, lane); S.done(cur); }
#undef PG8_SA
#undef PG8_SB
#undef PG8_STAGE
#undef PG8_LDA
#undef PG8_LDB
#undef PG8_MMA
#undef PG8_WAIT_V
#undef PG8_WAIT_L
#undef PG8_BAR
#undef PG8_SCHED
}
}

namespace hy {
#define GAS __attribute__((address_space(1)))
#define LAS __attribute__((address_space(3)))
typedef unsigned short bf16;
typedef unsigned v4u __attribute__((ext_vector_type(4)));
typedef float f32x4 __attribute__((ext_vector_type(4)));
typedef short bf16x8 __attribute__((ext_vector_type(8)));
typedef GAS unsigned gu32;
typedef GAS unsigned long long gu64;
#define RLX_AGENT __ATOMIC_RELAXED, __HIP_MEMORY_SCOPE_AGENT
#define LDS_WAIT() asm volatile("s_waitcnt lgkmcnt(0)" ::: "memory")
#define VM_WAIT() asm volatile("s_waitcnt vmcnt(0)" ::: "memory")
__device__ __forceinline__ unsigned long long rt() { return __builtin_amdgcn_s_memrealtime(); }
__device__ __forceinline__ unsigned f2bf(float f) { unsigned u = __builtin_bit_cast(unsigned, f); return (u + 0x7fffu + ((u >> 16) & 1u)) >> 16; }
__device__ __forceinline__ unsigned pk2(float lo, float hi) { return f2bf(lo) | (f2bf(hi) << 16); }
#define XB_TMO      128
#define XB_XCNT(j)  (256  + 64 * (j))
#define XB_XSUB(j)  (1280 + 64 * (j))
#define XB_XGEN(j)  (2304 + 64 * (j))
#define XB_TOP      3328
#define XB_TOPGEN   3392
#define XCD_BAR_WORDS 3456
#define XB_SPIN_CAP (1u << 18)

__device__ __forceinline__ unsigned xb_ld(unsigned* p)              { return __hip_atomic_load(p, __ATOMIC_RELAXED, __HIP_MEMORY_SCOPE_AGENT); }
__device__ __forceinline__ unsigned xb_add(unsigned* p, unsigned v) { return __hip_atomic_fetch_add(p, v, __ATOMIC_RELAXED, __HIP_MEMORY_SCOPE_AGENT); }
__device__ __forceinline__ unsigned xb_xcc_id() { return (unsigned)__builtin_amdgcn_s_getreg((3 << 11) | 20) & 0xFu; }
#define XB_SPIN(cond, bar) do { unsigned _sp = 0; while (cond) { __builtin_amdgcn_s_sleep(1); \
    if ((++_sp & 255u) == 0u) { if (xb_ld(&(bar)[XB_TMO])) break; if (_sp > XB_SPIN_CAP) { atomicAdd(&(bar)[XB_TMO], 1u); break; } } } } while (0)

struct XcdBarrier {
    unsigned* bar; unsigned x;
    volatile LAS unsigned* st;
};

__device__ __forceinline__ XcdBarrier xcd_barrier_post(unsigned* bar, volatile LAS unsigned* st) {
    XcdBarrier b; b.bar = bar; b.x = xb_xcc_id(); b.st = st;
    if (threadIdx.x == 0) (void)xb_add(&bar[XB_XCNT(b.x)], 1u);
    return b;
}
__device__ __forceinline__ void xcd_barrier_complete(unsigned* bar, unsigned x, unsigned& nloc, unsigned& nx) {
    const unsigned G = gridDim.x * gridDim.y * gridDim.z;
    unsigned sum, cnt, mine, sp = 0u;
    for (;;) {
        sum = 0u; cnt = 0u; mine = 0u;
#pragma unroll
        for (unsigned j = 0; j < 16; ++j) { const unsigned c = xb_ld(&bar[XB_XCNT(j)]); sum += c; cnt += (c > 0u) ? 1u : 0u; mine = (j == x) ? c : mine; }
        if (sum == G) break;
        __builtin_amdgcn_s_sleep(1);
        if ((++sp & 255u) == 0u) { if (xb_ld(&bar[XB_TMO])) break; if (sp > XB_SPIN_CAP) { atomicAdd(&bar[XB_TMO], 1u); break; } }
    }
    nloc = mine > 0u ? mine : 1u; nx = cnt > 0u ? cnt : 1u;
}

__device__ __forceinline__ void xcd_barrier(const XcdBarrier& b) {
    asm volatile("s_waitcnt vmcnt(0)" ::: "memory");
    __syncthreads();
    if (threadIdx.x == 0) {
        unsigned* bar = b.bar;
        __builtin_amdgcn_s_waitcnt(0);
        unsigned nloc = b.st[0], nx = b.st[1];
        if (nloc == 0u) { xcd_barrier_complete(bar, b.x, nloc, nx); b.st[0] = nloc; b.st[1] = nx; }
        const unsigned old = xb_add(&bar[XB_XSUB(b.x)], 1u);
        const unsigned gen = old / nloc;
        if (old + 1u == (gen + 1u) * nloc) {
            __builtin_amdgcn_fence(__ATOMIC_RELEASE, "agent");
            asm volatile("s_waitcnt vmcnt(0)" ::: "memory");
            const unsigned og = xb_add(&bar[XB_TOP], 1u);
            const unsigned tg = og / nx;
            if (og + 1u == (tg + 1u) * nx) xb_add(&bar[XB_TOPGEN], 1u);
            else XB_SPIN(xb_ld(&bar[XB_TOPGEN]) == tg, bar);
            __builtin_amdgcn_fence(__ATOMIC_ACQUIRE, "agent");
            xb_add(&bar[XB_XGEN(b.x)], 1u);
            asm volatile("s_waitcnt vmcnt(0)" ::: "memory");
        } else {
            XB_SPIN(xb_ld(&bar[XB_XGEN(b.x)]) == gen, bar);
            __builtin_amdgcn_fence(__ATOMIC_ACQUIRE, "agent");
            asm volatile("s_waitcnt vmcnt(0)" ::: "memory");
        }
    }
    __syncthreads();
}

constexpr int B_ = 4, T_ = 8192, D_ = 1024, M_ = B_ * T_, L_ = 2;
constexpr int NIN = 3584, NPG = 1792, NPR = 1792;
constexpr int DFF = 2816, NUP = 5632, IN_COLS = 3344;
constexpr size_t MiB = 1u << 20;
constexpr size_t WS_CTL = 0, CTL_ZERO_BYTES = 65536;
constexpr int CW_BAR = 4096;
constexpr size_t WS_RK = MiB / 4;
constexpr size_t WS_MOD = 3 * MiB / 2;
constexpr size_t WS_WIN = 2 * MiB, WS_WOUT = 9 * MiB, WS_WUP = 11 * MiB, WS_WDN = 22 * MiB, WS_LORA = 55 * MiB / 2, WS_GAMC = 28 * MiB, WS_VL = 29 * MiB;
constexpr size_t WS_GAM = 31 * MiB;
constexpr size_t WS_XB = 32 * MiB, WS_O = 96 * MiB, WS_VF = 160 * MiB, WS_GK = 192 * MiB, WS_PG = 224 * MiB, WS_PR = 336 * MiB, WS_END = 512 * MiB;
constexpr size_t WS_RH = WS_XB, WS_YH = WS_XB + 32 * MiB, WS_PP = WS_O, WS_QQ = WS_O + 32 * MiB, WS_GG = 448 * MiB, WS_S0 = 480 * MiB;
constexpr size_t WS_ACT = 224 * MiB, WS_U = 400 * MiB;
constexpr int RING_BYTES = 131072, MISC_OFF = 139264, LDS_BYTES = 147456;
constexpr int NT = 512;

__device__ __forceinline__ float bf2f(bf16 h) { return __builtin_bit_cast(float, (unsigned)h << 16); }
__device__ __forceinline__ float sigmoidf_(float x) { return 1.f / (1.f + __expf(-x)); }
__device__ __forceinline__ float siluf_(float x) { return x / (1.f + __expf(-x)); }
__device__ __forceinline__ float softplusf_(float x) { return fmaxf(x, 0.f) + log1pf(__expf(-fabsf(x))); }

typedef unsigned u32x2 __attribute__((ext_vector_type(2)));
template <int CTRL> __device__ __forceinline__ float dpp_f(float v) {
    return __builtin_bit_cast(float, __builtin_amdgcn_update_dpp(0, __builtin_bit_cast(int, v), CTRL, 0xf, 0xf, false));
}
__device__ __forceinline__ float wave_sum(float v) {
    v += dpp_f<0xB1>(v);
    v += dpp_f<0x4E>(v);
    v += dpp_f<0x141>(v);
    v += dpp_f<0x140>(v);
    v += __builtin_bit_cast(float, __builtin_amdgcn_update_dpp(0, __builtin_bit_cast(int, v), 0x142, 0xa, 0xf, false));
    v += __builtin_bit_cast(float, __builtin_amdgcn_update_dpp(0, __builtin_bit_cast(int, v), 0x143, 0xc, 0xf, false));
    return __builtin_bit_cast(float, __builtin_amdgcn_readlane(__builtin_bit_cast(int, v), 63));
}

struct Ctx { int bid, nb, tid, lane, wave; LAS unsigned char* lds; };

__device__ __forceinline__ void ph_mod(const Ctx& C, const float* c, const float* ada_w, const float* ada_b, float* MOD) {
    LAS float* sc = (LAS float*)C.lds;
    LAS float* red = (LAS float*)(C.lds + 16384);
    for (int i = C.tid; i < 4096; i += NT) sc[i] = siluf_(c[i]);
    __syncthreads();
    for (int item = C.bid; item < 192; item += C.nb) {
        const int l = item / 96, j0 = (item % 96) * 64;
        const float* W = ada_w + (size_t)l * 1024 * 6144 + j0 + C.lane;
        float a0 = 0.f, a1 = 0.f, a2 = 0.f, a3 = 0.f;
        for (int k = C.wave * 128; k < C.wave * 128 + 128; ++k) { const float wv = W[(size_t)k * 6144]; a0 += sc[k] * wv; a1 += sc[1024 + k] * wv; a2 += sc[2048 + k] * wv; a3 += sc[3072 + k] * wv; }
        red[(C.wave * 4 + 0) * 64 + C.lane] = a0; red[(C.wave * 4 + 1) * 64 + C.lane] = a1; red[(C.wave * 4 + 2) * 64 + C.lane] = a2; red[(C.wave * 4 + 3) * 64 + C.lane] = a3;
        __syncthreads();
        if (C.wave < 4) { const int b = C.wave; float s = ada_b[l * 6144 + j0 + C.lane];
#pragma unroll
            for (int w = 0; w < 8; ++w) s += red[(w * 4 + b) * 64 + C.lane];
            MOD[((size_t)l * 4 + b) * 6144 + j0 + C.lane] = s; }
        __syncthreads();
    }
}

__device__ __forceinline__ void wprep_mat(const Ctx& C, const float* W, int K, int Nsrc, int Ndst, bf16* Wt, int mode, const float* vres) {
    const int half = C.tid >> 8, t = C.tid & 255, tx = t & 31, ty = t >> 5;
    LAS float* tile = (LAS float*)C.lds + half * (32 * 33);
    const int nbn = Ndst / 32, ntile = nbn * (K / 32);
    const int niter = (ntile + 2 * C.nb - 1) / (2 * C.nb);
    for (int it = 0; it < niter; ++it) {
        const int item = (it * C.nb + C.bid) * 2 + half;
        const bool act = item < ntile;
        const int n0 = (item % nbn) * 32, k0 = (item / nbn) * 32, n = n0 + tx;
        if (act) {
#pragma unroll
            for (int i = 0; i < 4; ++i) { const int k = k0 + ty + 8 * i; float v = 0.f;
                if (mode == 0) v = W[(size_t)k * Nsrc + n];
                else if (mode == 2) { const int tl = n >> 8, w = n & 255; v = W[(size_t)k * Nsrc + (w < 128 ? tl * 128 + w : 2816 + tl * 128 + (w - 128))]; }
                else { if (n < 1552) v = W[(size_t)k * Nsrc + n]; else if (n < 1584) v = vres ? vres[(size_t)k * 32 + (n - 1552)] : 0.f; else if (n < 1792) v = 0.f; else v = W[(size_t)k * Nsrc + (n - 240)]; }
                tile[(ty + 8 * i) * 33 + tx] = v; }
        }
        __syncthreads();
        if (act) {
#pragma unroll
            for (int i = 0; i < 4; ++i) { const int nn = n0 + ty + 8 * i; Wt[(size_t)nn * K + k0 + tx] = (bf16)f2bf(tile[tx * 33 + ty + 8 * i]); }
        }
        __syncthreads();
    }
}

__device__ __forceinline__ void ph_norm(const Ctx& C, const float* x, const float* g, const float* sh, const float* sc, bf16* XB) {
    const int gw = C.bid * 8 + C.wave, NGW = C.nb * 8, lane = C.lane;
    for (int m = gw; m < M_; m += NGW) {
        const int b = m / T_;
        const f32x4* xr = (const f32x4*)(x + (size_t)m * D_) + lane;
        f32x4 v[4]; float s = 0.f;
#pragma unroll
        for (int j = 0; j < 4; ++j) { v[j] = xr[64 * j]; s += (v[j].x * v[j].x + v[j].y * v[j].y) + (v[j].z * v[j].z + v[j].w * v[j].w); }
        const float rstd = 1.f / sqrtf(wave_sum(s) * (1.f / D_) + 1e-6f);
        unsigned long long* o8 = (unsigned long long*)(XB + (size_t)m * D_) + lane;
#pragma unroll
        for (int j = 0; j < 4; ++j) { const int col = 4 * lane + 256 * j;
            const f32x4 gv = *(const f32x4*)(g + col), shv = *(const f32x4*)(sh + b * 6144 + col), scv = *(const f32x4*)(sc + b * 6144 + col);
            const f32x4 h = v[j] * rstd * gv * (scv + 1.f) + shv;
            o8[64 * j] = (unsigned long long)(f2bf(h.x) | (f2bf(h.y) << 16)) | ((unsigned long long)(f2bf(h.z) | (f2bf(h.w) << 16)) << 32); }
    }
}
__device__ __forceinline__ void ph_final(const Ctx& C, float* x, const float* g) {
    const int gw = C.bid * 8 + C.wave, NGW = C.nb * 8, lane = C.lane;
    for (int m = gw; m < M_; m += NGW) {
        f32x4* xr = (f32x4*)(x + (size_t)m * D_) + lane;
        f32x4 v[4]; float s = 0.f;
#pragma unroll
        for (int j = 0; j < 4; ++j) { v[j] = xr[64 * j]; s += (v[j].x * v[j].x + v[j].y * v[j].y) + (v[j].z * v[j].z + v[j].w * v[j].w); }
        const float rstd = 1.f / sqrtf(wave_sum(s) * (1.f / D_) + 1e-6f);
#pragma unroll
        for (int j = 0; j < 4; ++j) { const f32x4 gv = *(const f32x4*)(g + 4 * lane + 256 * j); xr[64 * j] = v[j] * rstd * gv; }
    }
}


typedef short s16x8 __attribute__((ext_vector_type(8)));
__device__ __forceinline__ f32x4 mm16(const LAS bf16* A, int lda, const LAS bf16* B, int ldb, int K, f32x4 acc, int lane) {
    const int r = lane & 15, g = lane >> 4;
    const LAS bf16* ap = A + r * lda + 8 * g; const LAS bf16* bp = B + r * ldb + 8 * g;
    for (int k0 = 0; k0 < K; k0 += 32) { const s16x8 a = *(const LAS s16x8*)(ap + k0); const s16x8 b = *(const LAS s16x8*)(bp + k0); acc = __builtin_amdgcn_mfma_f32_16x16x32_bf16(a, b, acc, 0, 0, 0); }
    return acc;
}
__device__ __forceinline__ f32x4 mm16_ga(const bf16* A, int lda, const LAS bf16* B, int ldb, int K, f32x4 acc, int lane) {
    const int r = lane & 15, g = lane >> 4;
    const bf16* ap = A + r * lda + 8 * g; const LAS bf16* bp = B + r * ldb + 8 * g;
    for (int k0 = 0; k0 < K; k0 += 32) { const s16x8 a = *(const s16x8*)(ap + k0); const s16x8 b = *(const LAS s16x8*)(bp + k0); acc = __builtin_amdgcn_mfma_f32_16x16x32_bf16(a, b, acc, 0, 0, 0); }
    return acc;
}
__device__ __forceinline__ unsigned long long pack4(f32x4 v) { return (unsigned long long)(f2bf(v.x) | (f2bf(v.y) << 16)) | ((unsigned long long)(f2bf(v.z) | (f2bf(v.w) << 16)) << 32); }
__device__ __forceinline__ float logsigmoidf_(float x) { return fminf(x, 0.f) - log1pf(__expf(-fabsf(x))); }

constexpr int GL_LD = 72;
constexpr int GL_GK = 0;
constexpr int GL_SEG = 16384;
constexpr int GL_Z = 18432;
constexpr int GL_GUP = 20480;
constexpr int GL_I0 = 24832;
constexpr int GL_I1 = GL_I0 + 9216;
constexpr int GL_I2 = GL_I1 + 9216;
constexpr int GL_VT = GL_I2 + 9216;
constexpr int GL_SSQ = GL_VT + 18432;
static_assert(GL_SSQ + 512 <= RING_BYTES, "GLA LDS map");

__device__ __forceinline__ void gla_gates(const Ctx& C, const bf16* pg  , const float* gk_up, const float* gk_b, int h) {
    LAS float* GK = (LAS float*)(C.lds + GL_GK); LAS float* SEG = (LAS float*)(C.lds + GL_SEG); LAS bf16* Z = (LAS bf16*)(C.lds + GL_Z); LAS float* GUP = (LAS float*)(C.lds + GL_GUP);
    const int tid = C.tid;
    if (tid < 128) { const int t = tid >> 1, hh = tid & 1; *(LAS v4u*)(Z + t * 16 + hh * 8) = *(const v4u*)(pg + (size_t)t * NPG + 1536 + hh * 8); }
    for (int i = tid; i < 16 * 64; i += NT) GUP[i] = gk_up[(i >> 6) * 256 + h * 64 + (i & 63)];
    if (tid < 64) GUP[1024 + tid] = gk_b[h * 64 + tid];
    __syncthreads();
    { const int t = tid >> 3, d0 = (tid & 7) * 8; float a[8];
#pragma unroll
      for (int q = 0; q < 8; ++q) a[q] = GUP[1024 + d0 + q];
#pragma unroll
      for (int i = 0; i < 16; ++i) { const float zv = bf2f(Z[t * 16 + i]);
#pragma unroll
          for (int q = 0; q < 8; ++q) a[q] += zv * GUP[i * 64 + d0 + q]; }
#pragma unroll
      for (int q = 0; q < 8; ++q) GK[t * 64 + d0 + q] = logsigmoidf_(a[q]) * (1.f / 16.f); }
    __syncthreads();
    { const int d = tid & 63, seg = tid >> 6; float run = 0.f;
#pragma unroll
      for (int q = 0; q < 8; ++q) { run += GK[(seg * 8 + q) * 64 + d]; GK[(seg * 8 + q) * 64 + d] = run; }
      SEG[seg * 64 + d] = run; }
    __syncthreads();
    { const int d = tid & 63, seg = tid >> 6; float off = 0.f;
      for (int s = 0; s < seg; ++s) off += SEG[s * 64 + d];
#pragma unroll
      for (int q = 0; q < 8; ++q) GK[(seg * 8 + q) * 64 + d] += off; }
    __syncthreads();
}
__device__ __forceinline__ void gla_stage_vt(const Ctx& C, const bf16* pg, int h) {
    LAS bf16* VT = (LAS bf16*)(C.lds + GL_VT);
    const int j = C.tid >> 3, e0 = (C.tid & 7) * 16;
    const v4u x0 = *(const v4u*)(pg + (size_t)j * NPG + 512 + h * 128 + e0), x1 = *(const v4u*)(pg + (size_t)j * NPG + 512 + h * 128 + e0 + 8);
    const unsigned w[8] = {x0.x, x0.y, x0.z, x0.w, x1.x, x1.y, x1.z, x1.w};
#pragma unroll
    for (int q = 0; q < 8; ++q) { VT[(e0 + 2 * q) * GL_LD + j] = (bf16)(w[q] & 0xffffu); VT[(e0 + 2 * q + 1) * GL_LD + j] = (bf16)(w[q] >> 16); }
}

__device__ __forceinline__ void ph_gla_a(const Ctx& C, const bf16* PG, const float* gk_up, const float* gk_b, bf16* DS, float* GAM, bf16* VL) {
    LAS float* GK = (LAS float*)(C.lds + GL_GK); LAS bf16* KT = (LAS bf16*)(C.lds + GL_I0); LAS bf16* VT = (LAS bf16*)(C.lds + GL_VT);
    for (int item = C.bid; item < 2048; item += C.nb) {
        const int bh = item >> 7, c = item & 127, b = bh >> 2, h = bh & 3;
        const size_t m0 = (size_t)b * T_ + c * 64;
        const bf16* pg = PG + m0 * NPG;
        gla_gates(C, pg, gk_up, gk_b, h);
        { const int j = C.tid >> 3, d0 = (C.tid & 7) * 8;
          const v4u kx = *(const v4u*)(pg + (size_t)j * NPG + 256 + h * 64 + d0);
          const unsigned w[4] = {kx.x, kx.y, kx.z, kx.w};
#pragma unroll
          for (int q = 0; q < 4; ++q) { const float k0 = bf2f((bf16)(w[q] & 0xffffu)), k1 = bf2f((bf16)(w[q] >> 16));
              const int d = d0 + 2 * q;
              KT[d * GL_LD + j] = (bf16)f2bf(k0 * __expf(GK[63 * 64 + d] - GK[j * 64 + d]));
              KT[(d + 1) * GL_LD + j] = (bf16)f2bf(k1 * __expf(GK[63 * 64 + d + 1] - GK[j * 64 + d + 1])); } }
        gla_stage_vt(C, pg, h);
        if (C.tid < 64) GAM[(size_t)item * 64 + C.tid] = __expf(GK[63 * 64 + C.tid]);
        if (h == 0 && C.tid < 256) { const int t = C.tid >> 2, q = C.tid & 3; *(unsigned long long*)(VL + (m0 + t) * 32 + q * 8 + 0) = *(const unsigned long long*)(pg + (size_t)t * NPG + 1552 + q * 8);
                                     *(unsigned long long*)(VL + (m0 + t) * 32 + q * 8 + 4) = *(const unsigned long long*)(pg + (size_t)t * NPG + 1552 + q * 8 + 4); }
        __syncthreads();
        { const int n0 = C.wave * 16, lane = C.lane, cc = lane & 15, g = lane >> 4;
          bf16* out = DS + (size_t)item * 8192 + (size_t)(n0 + cc) * 64 + 4 * g;
#pragma unroll
          for (int mt = 0; mt < 4; ++mt) { f32x4 acc = {0.f, 0.f, 0.f, 0.f}; acc = mm16(KT + mt * 16 * GL_LD, GL_LD, VT + n0 * GL_LD, GL_LD, 64, acc, lane);
              *(unsigned long long*)(out + mt * 16) = pack4(acc); } }
        __syncthreads();
    }
}
__device__ __forceinline__ void ph_gla_b(const Ctx& C, bf16* DS, const float* GAM) {
    for (int idx = C.bid * NT + C.tid; idx < 16 * 8192; idx += C.nb * NT) {
        const int bh = idx >> 13, ed = idx & 8191, d = ed & 63;
        bf16* p = DS + (size_t)bh * 128 * 8192 + ed; const float* gp = GAM + (size_t)bh * 128 * 64 + d;
        float S = 0.f;
        for (int c0 = 0; c0 < 128; c0 += 8) {
            float ds[8], gm[8];
#pragma unroll
            for (int i = 0; i < 8; ++i) { ds[i] = bf2f(p[(size_t)(c0 + i) * 8192]); gm[i] = gp[(c0 + i) * 64]; }
#pragma unroll
            for (int i = 0; i < 8; ++i) { const float gs = gm[i] * S; p[(size_t)(c0 + i) * 8192] = (bf16)f2bf(gs); S = gs + ds[i]; }
        }
    }
}
__device__ __forceinline__ void ph_gla_c(const Ctx& C, const bf16* PG, const float* gk_up, const float* gk_b, const float* norm_g, const bf16* DS, bf16* O) {
    LAS float* GK = (LAS float*)(C.lds + GL_GK); LAS bf16* QP = (LAS bf16*)(C.lds + GL_I0); LAS bf16* KM = (LAS bf16*)(C.lds + GL_I1); LAS bf16* AI = (LAS bf16*)(C.lds + GL_I2);
    LAS bf16* VT = (LAS bf16*)(C.lds + GL_VT); LAS float* SSQ = (LAS float*)(C.lds + GL_SSQ);
    for (int item = C.bid; item < 2048; item += C.nb) {
        const int bh = item >> 7, c = item & 127, b = bh >> 2, h = bh & 3;
        const size_t m0 = (size_t)b * T_ + c * 64;
        const bf16* pg = PG + m0 * NPG;
        gla_gates(C, pg, gk_up, gk_b, h);
        { const int j = C.tid >> 3, d0 = (C.tid & 7) * 8;
          const v4u qx = *(const v4u*)(pg + (size_t)j * NPG + h * 64 + d0), kx = *(const v4u*)(pg + (size_t)j * NPG + 256 + h * 64 + d0);
          const unsigned qw[4] = {qx.x, qx.y, qx.z, qx.w}, kw[4] = {kx.x, kx.y, kx.z, kx.w};
          unsigned qo[4], ko[4];
#pragma unroll
          for (int q = 0; q < 4; ++q) { const int d = d0 + 2 * q;
              const float e0 = GK[63 * 64 + d] - GK[j * 64 + d], e1 = GK[63 * 64 + d + 1] - GK[j * 64 + d + 1];
              const float q0 = 0.125f * bf2f((bf16)(qw[q] & 0xffffu)) * __expf(-e0), q1 = 0.125f * bf2f((bf16)(qw[q] >> 16)) * __expf(-e1);
              const float k0 = bf2f((bf16)(kw[q] & 0xffffu)) * __expf(e0), k1 = bf2f((bf16)(kw[q] >> 16)) * __expf(e1);
              qo[q] = f2bf(q0) | (f2bf(q1) << 16); ko[q] = f2bf(k0) | (f2bf(k1) << 16); }
          *(LAS v4u*)(QP + j * GL_LD + d0) = (v4u){qo[0], qo[1], qo[2], qo[3]}; *(LAS v4u*)(KM + j * GL_LD + d0) = (v4u){ko[0], ko[1], ko[2], ko[3]}; }
        gla_stage_vt(C, pg, h);
        __syncthreads();
        { const int lane = C.lane, cc = lane & 15, g = lane >> 4, n0 = (C.wave >> 1) * 16;
#pragma unroll
          for (int q = 0; q < 2; ++q) { const int mt0 = ((C.wave & 1) * 2 + q) * 16; f32x4 acc = {0.f, 0.f, 0.f, 0.f};
              acc = mm16(KM + mt0 * GL_LD, GL_LD, QP + n0 * GL_LD, GL_LD, 64, acc, lane);
              const int i = n0 + cc, j = mt0 + 4 * g;
              acc.x = (j + 0 <= i) ? acc.x : 0.f; acc.y = (j + 1 <= i) ? acc.y : 0.f; acc.z = (j + 2 <= i) ? acc.z : 0.f; acc.w = (j + 3 <= i) ? acc.w : 0.f;
              *(LAS unsigned long long*)(AI + (n0 + cc) * GL_LD + mt0 + 4 * g) = pack4(acc); } }
        __syncthreads();
        { const int lane = C.lane, cc = lane & 15, g = lane >> 4, n0 = (C.wave & 3) * 16, eh = C.wave >> 2;
          const bf16* Sg = DS + (size_t)item * 8192;
          f32x4 acc[4]; float ss = 0.f;
#pragma unroll
          for (int mt = 0; mt < 4; ++mt) { const int e0 = eh * 64 + mt * 16; acc[mt] = (f32x4){0.f, 0.f, 0.f, 0.f};
              acc[mt] = mm16_ga(Sg + (size_t)e0 * 64, 64, QP + n0 * GL_LD, GL_LD, 64, acc[mt], lane);
              acc[mt] = mm16(VT + e0 * GL_LD, GL_LD, AI + n0 * GL_LD, GL_LD, 64, acc[mt], lane);
              ss += (acc[mt].x * acc[mt].x + acc[mt].y * acc[mt].y) + (acc[mt].z * acc[mt].z + acc[mt].w * acc[mt].w); }
          ss += __shfl_xor(ss, 16); ss += __shfl_xor(ss, 32);
          if (g == 0) SSQ[eh * 64 + n0 + cc] = ss;
          __syncthreads();
          const float rstd = 1.f / sqrtf((SSQ[n0 + cc] + SSQ[64 + n0 + cc]) * (1.f / 128.f) + 1e-6f);
          const size_t m = m0 + n0 + cc;
#pragma unroll
          for (int mt = 0; mt < 4; ++mt) { const int e = eh * 64 + mt * 16 + 4 * g;
              const unsigned long long gx = *(const unsigned long long*)(pg + (size_t)(n0 + cc) * NPG + 1024 + h * 128 + e);
              const f32x4 ng = *(const f32x4*)(norm_g + e);
              f32x4 o;
              o.x = acc[mt].x * rstd * ng.x * siluf_(bf2f((bf16)(gx & 0xffffu)));
              o.y = acc[mt].y * rstd * ng.y * siluf_(bf2f((bf16)((gx >> 16) & 0xffffu)));
              o.z = acc[mt].z * rstd * ng.z * siluf_(bf2f((bf16)((gx >> 32) & 0xffffu)));
              o.w = acc[mt].w * rstd * ng.w * siluf_(bf2f((bf16)(gx >> 48)));
              *(unsigned long long*)(O + m * D_ + h * 128 + e) = pack4(o); } }
        __syncthreads();
    }
}


struct RwkvW { const float *mu, *mu_vres, *w0, *a0, *v0, *k_k, *k_a, *r_k; const bf16 *wupT, *aupT, *gupT, *vupT; };
constexpr int RW_LD = 72, RW_XLD = 296, RW_FLD = 68;
constexpr int RW_R0 = 0;
constexpr int RW_SEG = 16384;
constexpr int RW_R1 = 37888;
constexpr int RW_R2 = RW_R1 + 27648;
constexpr int RW_R3 = RW_R2 + 9216;
constexpr int RW_R4 = RW_R3 + 27648;
constexpr int RW_TI = RW_R4 + 128 * RW_FLD * 4;
constexpr int RW_END = RW_TI + 2048;
static_assert(RW_END <= RING_BYTES + 8192 && RW_END <= MISC_OFF, "RWKV LDS map");

typedef short s16x4 __attribute__((ext_vector_type(4)));
__device__ __forceinline__ float tanh_fast(float x) { const float e = __expf(2.f * x); return 1.f - 2.f / (e + 1.f); }
__device__ __forceinline__ float softplus_fast(float x) { return fmaxf(x, 0.f) + __logf(1.f + __expf(-fabsf(x))); }
__device__ __forceinline__ s16x4 cvt4(f32x4 v) { const unsigned long long p = pack4(v); return __builtin_bit_cast(s16x4, p); }
__device__ __forceinline__ void ld8f(const float* p, float (&o)[8]) { const f32x4 a = *(const f32x4*)p, b = *(const f32x4*)(p + 4); o[0] = a.x; o[1] = a.y; o[2] = a.z; o[3] = a.w; o[4] = b.x; o[5] = b.y; o[6] = b.z; o[7] = b.w; }
__device__ __forceinline__ float sum8(float v) { v += dpp_f<0xB1>(v); v += dpp_f<0x4E>(v); v += dpp_f<0x141>(v); return v; }
__device__ __forceinline__ void unpack8(const v4u x, float (&o)[8]) {
    o[0] = bf2f((bf16)(x.x & 0xffffu)); o[1] = bf2f((bf16)(x.x >> 16)); o[2] = bf2f((bf16)(x.y & 0xffffu)); o[3] = bf2f((bf16)(x.y >> 16));
    o[4] = bf2f((bf16)(x.z & 0xffffu)); o[5] = bf2f((bf16)(x.z >> 16)); o[6] = bf2f((bf16)(x.w & 0xffffu)); o[7] = bf2f((bf16)(x.w >> 16)); }
__device__ __forceinline__ v4u pack8(const float (&o)[8]) { return (v4u){f2bf(o[0]) | (f2bf(o[1]) << 16), f2bf(o[2]) | (f2bf(o[3]) << 16), f2bf(o[4]) | (f2bf(o[5]) << 16), f2bf(o[6]) | (f2bf(o[7]) << 16)}; }
__device__ __forceinline__ f32x4 mm16_gb(const LAS bf16* A, int lda, const bf16* B, int ldb, int K, f32x4 acc, int lane) {
    const int r = lane & 15, g = lane >> 4;
    const LAS bf16* ap = A + r * lda + 8 * g; const bf16* bp = B + r * ldb + 8 * g;
    for (int k0 = 0; k0 < K; k0 += 32) { const s16x8 a = *(const LAS s16x8*)(ap + k0); const s16x8 b = *(const s16x8*)(bp + k0); acc = __builtin_amdgcn_mfma_f32_16x16x32_bf16(a, b, acc, 0, 0, 0); }
    return acc;
}

__device__ __forceinline__ void ph_rwkv_a(const Ctx& C, const bf16* PR, const bf16* VL  , const RwkvW& W, int layer,
                                          bf16* PP, bf16* QQ, bf16* RH, bf16* YH, float* GAMC, float* RK, bf16* GG, bf16* VF, bool store_v = true) {
    LAS unsigned char* L = C.lds;
    LAS bf16* X = (LAS bf16*)(L + RW_R0); LAS float* CUM = (LAS float*)(L + RW_R0); LAS float* SEG = (LAS float*)(L + RW_SEG);
    LAS bf16* NI = (LAS bf16*)(L + RW_R0), *AAK = NI + 64 * RW_LD, *ARB = AAK + 64 * RW_LD, *ARK = ARB + 64 * RW_LD;
    LAS bf16* PRE = (LAS bf16*)(L + RW_R1);
    LAS bf16* AT = (LAS bf16*)(L + RW_R1), *BT = AT + 64 * RW_LD, *KT = BT + 64 * RW_LD, *RT = (LAS bf16*)(L + RW_R2);
    LAS bf16* XB16 = (LAS bf16*)(L + RW_R1);
    LAS bf16* BHc = (LAS bf16*)(L + RW_R3), *KHc = BHc + 64 * RW_LD, *VTc = KHc + 64 * RW_LD;
    LAS float* XT = (LAS float*)(L + RW_R4); LAS bf16* TI = (LAS bf16*)(L + RW_TI);
    const int wave = C.wave;
    for (int item = C.bid; item < 4096; item += C.nb) {
        int tid_ = C.tid; asm volatile("" : "+v"(tid_));
        const int tid = tid_, lane = tid & 63, cc = lane & 15, g = lane >> 4;
        const int h = item & 7, c = (item >> 3) & 127, b = item >> 10;
        const size_t m0 = (size_t)b * T_ + c * 64;
        for (int idx = tid; idx < 64 * 36; idx += NT) {
            const int t = idx / 36, q = idx % 36, col = q * 8; const size_t m = m0 + t; const bool first = (c == 0 && t == 0);
            v4u cur, prv; float mu[8];
            if (q < 32) { cur = *(const v4u*)(PR + m * NPR + 1536 + col); prv = first ? (v4u){0u, 0u, 0u, 0u} : *(const v4u*)(PR + (m - 1) * NPR + 1536 + col);
                ld8f(W.mu + 1536 + col, mu); }
            else if (layer) { cur = *(const v4u*)(VL + m * NPG + 1552 + (col - 256)); prv = first ? (v4u){0u, 0u, 0u, 0u} : *(const v4u*)(VL + (m - 1) * NPG + 1552 + (col - 256));
                ld8f(W.mu_vres + (col - 256), mu); }
            else { cur = (v4u){0u, 0u, 0u, 0u}; prv = cur;
#pragma unroll
                for (int i = 0; i < 8; ++i) mu[i] = 0.f; }
            float cv[8], pv[8]; unpack8(cur, cv); unpack8(prv, pv);
#pragma unroll
            for (int i = 0; i < 8; ++i) { float p = cv[i] + (pv[i] - cv[i]) * mu[i]; if (q < 8) p = tanh_fast(p); else if (q >= 16 && q < 32) p = sigmoidf_(p); cv[i] = p; }
            *(LAS v4u*)(X + t * RW_XLD + col) = pack8(cv);
        }
        __syncthreads();
        {
            const int lsel = wave >> 1;
            const bf16* WT = lsel == 0 ? W.wupT : lsel == 1 ? W.aupT : lsel == 2 ? W.gupT : W.vupT;
            const int Kl = lsel == 2 ? 128 : lsel == 3 ? 32 : 64, xoff = lsel == 0 ? 0 : lsel == 1 ? 64 : lsel == 2 ? 128 : 256;
            LAS bf16* outp = PRE + lsel * 64 * RW_LD;
            const bool live = (lsel != 3 || layer);
#pragma unroll
            for (int mq = 0; mq < 2; ++mq) { const int mt = (wave & 1) * 2 + mq;
                s16x8 af[4];
                const bf16* ap = WT + (size_t)(h * 64 + mt * 16 + cc) * Kl + 8 * g;
#pragma unroll
                for (int ks = 0; ks < 4; ++ks) af[ks] = (live && ks * 32 < Kl) ? *(const s16x8*)(ap + ks * 32) : (s16x8){0, 0, 0, 0, 0, 0, 0, 0};
#pragma unroll
                for (int nt = 0; nt < 4; ++nt) { f32x4 acc = {0.f, 0.f, 0.f, 0.f};
                    const LAS bf16* bp = X + (nt * 16 + cc) * RW_XLD + xoff + 8 * g;
#pragma unroll
                    for (int ks = 0; ks < 4; ++ks) if (ks * 32 < Kl) { const s16x8 bb = *(const LAS s16x8*)(bp + ks * 32); acc = __builtin_amdgcn_mfma_f32_16x16x32_bf16(af[ks], bb, acc, 0, 0, 0); }
                    *(LAS unsigned long long*)(outp + (nt * 16 + cc) * RW_LD + mt * 16 + 4 * g) = pack4(acc); } }
        }
        __syncthreads();
        const int t = tid >> 3, d0 = (tid & 7) * 8, ch = h * 64 + d0; const size_t m = m0 + t; const bool first = (c == 0 && t == 0);
        float av[8], bv[8], kv[8], rv[8], lw[8], vv[8];
        {
            float rc[8], rp[8], kc[8], kp[8], vc[8], vp[8], pw[8], pa[8], pg_[8], pvg[8];
            unpack8(*(const v4u*)(PR + m * NPR + ch), rc); unpack8(*(const v4u*)(PR + m * NPR + 512 + ch), kc); unpack8(*(const v4u*)(PR + m * NPR + 1024 + ch), vc);
            if (first) {
#pragma unroll
                for (int i = 0; i < 8; ++i) { rp[i] = 0.f; kp[i] = 0.f; vp[i] = 0.f; } }
            else { unpack8(*(const v4u*)(PR + (m - 1) * NPR + ch), rp); unpack8(*(const v4u*)(PR + (m - 1) * NPR + 512 + ch), kp); unpack8(*(const v4u*)(PR + (m - 1) * NPR + 1024 + ch), vp); }
            unpack8(*(const LAS v4u*)(PRE + (0 * 64 + t) * RW_LD + d0), pw); unpack8(*(const LAS v4u*)(PRE + (1 * 64 + t) * RW_LD + d0), pa);
            unpack8(*(const LAS v4u*)(PRE + (2 * 64 + t) * RW_LD + d0), pg_); unpack8(*(const LAS v4u*)(PRE + (3 * 64 + t) * RW_LD + d0), pvg);
            float vf[8];
            if (layer) unpack8(*(const v4u*)(VF + m * 512 + ch), vf);
            float ssq = 0.f, rks = 0.f, asg[8], gg[8];
            float mur[8], muk[8], muv[8], w0c[8], a0c[8], v0c[8], kkc[8], kac[8], rkc[8];
            ld8f(W.mu + ch, mur); ld8f(W.mu + 512 + ch, muk); ld8f(W.mu + 1024 + ch, muv); ld8f(W.w0 + ch, w0c); ld8f(W.a0 + ch, a0c);
            ld8f(W.k_k + ch, kkc); ld8f(W.k_a + ch, kac); ld8f(W.r_k + ch, rkc);
            if (layer) ld8f(W.v0 + ch, v0c);
#pragma unroll
            for (int i = 0; i < 8; ++i) {
                const float r = rc[i] + (rp[i] - rc[i]) * mur[i], k = kc[i] + (kp[i] - kc[i]) * muk[i]; float v = vc[i] + (vp[i] - vc[i]) * muv[i];
                lw[i] = -__expf(-softplus_fast(-(w0c[i] + pw[i])) - 0.5f);
                asg[i] = sigmoidf_(a0c[i] + pa[i]);
                if (layer) v = v + (vf[i] - v) * sigmoidf_(v0c[i] + pvg[i]);
                const float kk = k * kkc[i]; ssq += kk * kk;
                kv[i] = k * (1.f + (asg[i] - 1.f) * kac[i]); rv[i] = r; vv[i] = v; gg[i] = pg_[i]; av[i] = kk;
                rks += r * kv[i] * rkc[i];
            }
            ssq = sum8(ssq); rks = sum8(rks);
            const float inv = 1.f / sqrtf(fmaxf(ssq, 1e-24f));
#pragma unroll
            for (int i = 0; i < 8; ++i) { const float kk = av[i] * inv; av[i] = -kk; bv[i] = kk * asg[i]; }
            if ((tid & 7) == 0) RK[m * 8 + h] = rks;
            *(v4u*)(GG + m * 512 + ch) = pack8(gg);
            if (store_v) *(v4u*)(VF + m * 512 + ch) = pack8(vv);
#pragma unroll
            for (int i = 0; i < 8; ++i) vv[i] = bf2f((bf16)f2bf(vv[i]));
        }
        __syncthreads();
#pragma unroll
        for (int i = 0; i < 8; ++i) CUM[t * 64 + d0 + i] = lw[i];
        __syncthreads();
        { const int d = tid & 63, seg = tid >> 6; float run = 0.f;
#pragma unroll
          for (int q = 0; q < 8; ++q) { run += CUM[(seg * 8 + q) * 64 + d]; CUM[(seg * 8 + q) * 64 + d] = run; }
          SEG[seg * 64 + d] = run; }
        __syncthreads();
        { const int d = tid & 63, seg = tid >> 6; float off = 0.f;
          for (int s = 0; s < seg; ++s) off += SEG[s * 64 + d];
#pragma unroll
          for (int q = 0; q < 8; ++q) CUM[(seg * 8 + q) * 64 + d] += off; }
        __syncthreads();
        {
            float at[8], bt[8], kt[8], rt[8];
#pragma unroll
            for (int i = 0; i < 8; ++i) { const float cu = CUM[t * 64 + d0 + i], cC = CUM[63 * 64 + d0 + i], en = __expf(-cu), ec = __expf(cC - cu);
                at[i] = av[i] * __expf(cu - lw[i]); bt[i] = bv[i] * en; kt[i] = kv[i] * en; rt[i] = rv[i] * __expf(cu);
                BHc[(d0 + i) * RW_LD + t] = (bf16)f2bf(bv[i] * ec); KHc[(d0 + i) * RW_LD + t] = (bf16)f2bf(kv[i] * ec); VTc[(d0 + i) * RW_LD + t] = (bf16)f2bf(vv[i]);
                XT[(d0 + i) * RW_FLD + t] = bf2f((bf16)f2bf(at[i]));
                if (t == 63) GAMC[(size_t)item * 64 + d0 + i] = __expf(cC); }
            *(LAS v4u*)(AT + t * RW_LD + d0) = pack8(at); *(LAS v4u*)(BT + t * RW_LD + d0) = pack8(bt); *(LAS v4u*)(KT + t * RW_LD + d0) = pack8(kt); *(LAS v4u*)(RT + t * RW_LD + d0) = pack8(rt);
        }
        __syncthreads();
        {
            const int msel = wave >> 1;
            const LAS bf16* As = (msel == 0 || msel == 2) ? BT : KT; const LAS bf16* Bs = (msel < 2) ? AT : RT;
            f32x4 accs[8];
#pragma unroll
            for (int q = 0; q < 8; ++q) { const int tile = (wave & 1) * 8 + q, mt = tile >> 2, nt = tile & 3; accs[q] = (f32x4){0.f, 0.f, 0.f, 0.f};
                accs[q] = mm16(As + mt * 16 * RW_LD, RW_LD, Bs + nt * 16 * RW_LD, RW_LD, 64, accs[q], lane);
                const int tt = nt * 16 + cc, s0 = mt * 16 + 4 * g, lim = (msel < 2) ? tt - 1 : tt;
                accs[q].x = (s0 + 0 <= lim) ? accs[q].x : 0.f; accs[q].y = (s0 + 1 <= lim) ? accs[q].y : 0.f; accs[q].z = (s0 + 2 <= lim) ? accs[q].z : 0.f; accs[q].w = (s0 + 3 <= lim) ? accs[q].w : 0.f; }
            __syncthreads();
            LAS bf16* outp = NI + msel * 64 * RW_LD;
#pragma unroll
            for (int q = 0; q < 8; ++q) { const int tile = (wave & 1) * 8 + q, mt = tile >> 2, nt = tile & 3;
                *(LAS unsigned long long*)(outp + (nt * 16 + cc) * RW_LD + mt * 16 + 4 * g) = pack4(accs[q]); }
        }
        __syncthreads();
        if (wave == 0) {
            const int blk = lane >> 4, col = lane & 15; float x[16];
#pragma unroll
            for (int tt = 0; tt < 16; ++tt) { float nr[16]; { float lo[8], hi[8]; unpack8(*(const LAS v4u*)(NI + (16 * blk + tt) * RW_LD + 16 * blk), lo); unpack8(*(const LAS v4u*)(NI + (16 * blk + tt) * RW_LD + 16 * blk + 8), hi);
#pragma unroll
                    for (int q = 0; q < 8; ++q) { nr[q] = lo[q]; nr[8 + q] = hi[q]; } }
                float a = (tt == col) ? 1.f : 0.f;
#pragma unroll
                for (int q = 0; q < tt; ++q) a += nr[q] * x[q];
                x[tt] = a; TI[(blk * 16 + tt) * 16 + col] = (bf16)f2bf(a); }
        } else {
            for (int tile = wave - 1; tile < 16; tile += 7) { const int mt = tile >> 2, nt = tile & 3;
                f32x4 acc = {0.f, 0.f, 0.f, 0.f}; acc = mm16(AAK + mt * 16 * RW_LD, RW_LD, VTc + nt * 16 * RW_LD, RW_LD, 64, acc, lane);
                *(LAS f32x4*)(XT + (64 + nt * 16 + cc) * RW_FLD + mt * 16 + 4 * g) = acc; }
        }
        __syncthreads();
        {
            s16x4 xb[4];
#pragma unroll
            for (int i = 0; i < 4; ++i) {
                f32x4 acc = *(const LAS f32x4*)(XT + (wave * 16 + cc) * RW_FLD + 16 * i + 4 * g);
#pragma unroll
                for (int k = 0; k < i; ++k) { const s16x4 a = *(const LAS s16x4*)(NI + (16 * i + cc) * RW_LD + 16 * k + 4 * g); acc = __builtin_amdgcn_mfma_f32_16x16x16bf16_1k(a, xb[k], acc, 0, 0, 0); }
                const s16x4 yb = cvt4(acc), ta = *(const LAS s16x4*)(TI + (i * 16 + cc) * 16 + 4 * g);
                const f32x4 xi = __builtin_amdgcn_mfma_f32_16x16x16bf16_1k(ta, yb, (f32x4){0.f, 0.f, 0.f, 0.f}, 0, 0, 0);
                xb[i] = cvt4(xi);
            }
            __syncthreads();
#pragma unroll
            for (int i = 0; i < 4; ++i) *(LAS s16x4*)(XB16 + (wave * 16 + cc) * RW_LD + 16 * i + 4 * g) = xb[i];
        }
        __syncthreads();
        {
            const int osel = wave >> 1; const size_t ob = (size_t)item * 4096;
#pragma unroll 1
            for (int q = 0; q < 8; ++q) { const int tile = (wave & 1) * 8 + q, mt = tile >> 2, nt = tile & 3; f32x4 acc = {0.f, 0.f, 0.f, 0.f};
                if (osel == 0) {
                    acc = mm16(XB16 + mt * 16 * RW_LD, RW_LD, BHc + nt * 16 * RW_LD, RW_LD, 64, acc, lane);
                    *(unsigned long long*)(PP + ob + (nt * 16 + cc) * 64 + mt * 16 + 4 * g) = pack4(acc);
                } else if (osel == 1) {
                    acc = mm16(BHc + mt * 16 * RW_LD, RW_LD, XB16 + (64 + nt * 16) * RW_LD, RW_LD, 64, acc, lane);
                    acc = mm16(KHc + mt * 16 * RW_LD, RW_LD, VTc + nt * 16 * RW_LD, RW_LD, 64, acc, lane);
                    *(unsigned long long*)(QQ + ob + (nt * 16 + cc) * 64 + mt * 16 + 4 * g) = pack4(acc);
                } else if (osel == 2) {
                    acc = mm16(XB16 + mt * 16 * RW_LD, RW_LD, ARB + nt * 16 * RW_LD, RW_LD, 64, acc, lane);
                    const unsigned long long rr = *(const LAS unsigned long long*)(RT + (nt * 16 + cc) * RW_LD + mt * 16 + 4 * g);
                    acc.x += bf2f((bf16)(rr & 0xffffu)); acc.y += bf2f((bf16)((rr >> 16) & 0xffffu)); acc.z += bf2f((bf16)((rr >> 32) & 0xffffu)); acc.w += bf2f((bf16)(rr >> 48));
                    *(unsigned long long*)(RH + ob + (nt * 16 + cc) * 64 + mt * 16 + 4 * g) = pack4(acc);
                } else {
                    acc = mm16(XB16 + (64 + mt * 16) * RW_LD, RW_LD, ARB + nt * 16 * RW_LD, RW_LD, 64, acc, lane);
                    acc = mm16(VTc + mt * 16 * RW_LD, RW_LD, ARK + nt * 16 * RW_LD, RW_LD, 64, acc, lane);
                    *(unsigned long long*)(YH + ob + (nt * 16 + cc) * 64 + mt * 16 + 4 * g) = pack4(acc);
                } }
        }
        __syncthreads();
    }
}

constexpr int CH_R = 6, CH_SLOT = 9216 + 9216 + 256;
constexpr int CH_RING = 0, CH_SI = CH_R * CH_SLOT, CH_FLAGS = CH_SI + 4 * 2304;
static_assert(CH_FLAGS + 64 <= MISC_OFF, "chain LDS map");
struct ChainRegs { v4u p[8], q[8]; f32x4 gm; };
__device__ __forceinline__ void chain_fetch(ChainRegs& o, const bf16* PP, const bf16* QQ, const float* GAMC, int item, int lane) {
    const size_t ob = (size_t)item * 4096;
#pragma unroll
    for (int i = 0; i < 8; ++i) { o.p[i] = *(const v4u*)(PP + ob + (size_t)(i * 64 + lane) * 8); o.q[i] = *(const v4u*)(QQ + ob + (size_t)(i * 64 + lane) * 8); }
    o.gm = *(const f32x4*)(GAMC + (size_t)item * 64 + (lane & 15) * 4);
}
__device__ __forceinline__ void chain_commit(const ChainRegs& o, LAS unsigned char* L, int c, int lane) {
    volatile LAS unsigned* flags = (volatile LAS unsigned*)(L + CH_FLAGS);
    const int slot = c % CH_R;
    if (c >= CH_R) { const unsigned need = (unsigned)(c - CH_R + 1);
        for (;;) { const unsigned m0 = flags[CH_R + 0], m1 = flags[CH_R + 1], m2 = flags[CH_R + 2], m3 = flags[CH_R + 3];
            if (m0 >= need && m1 >= need && m2 >= need && m3 >= need) break; __builtin_amdgcn_s_sleep(1); } }
    asm volatile("" ::: "memory");
    LAS unsigned char* sl = L + CH_RING + slot * CH_SLOT;
#pragma unroll
    for (int i = 0; i < 8; ++i) { const int idx = i * 64 + lane, row = idx >> 3, c16 = idx & 7;
        *(LAS v4u*)(sl + row * 144 + c16 * 16) = o.p[i]; *(LAS v4u*)(sl + 9216 + row * 144 + c16 * 16) = o.q[i]; }
    if (lane < 16) *(LAS f32x4*)(sl + 18432 + lane * 16) = o.gm;
    asm volatile("s_waitcnt lgkmcnt(0)" ::: "memory");
    if (lane == 0) flags[slot] = (unsigned)(c + 1);
}
__device__ __forceinline__ void ph_rwkv_b(const Ctx& C, int bh  , const bf16* PP, const bf16* QQ, const float* GAMC, bf16* S0) {
    const int lane = C.lane, wave = C.wave, cc = lane & 15, g = lane >> 4, b = bh >> 3, h = bh & 7;
    LAS unsigned char* L = C.lds;
    volatile LAS unsigned* flags = (volatile LAS unsigned*)(L + CH_FLAGS);
    if (C.tid < 16) flags[C.tid] = 0u;
    __syncthreads();
    if (wave >= 4) {
        const int j = wave - 4;
        ChainRegs A, B;
        int lc = j;
        chain_fetch(A, PP, QQ, GAMC, (b * 128 + lc) * 8 + h, lane);
        for (;;) {
            if (lc + 4 < 128) chain_fetch(B, PP, QQ, GAMC, (b * 128 + lc + 4) * 8 + h, lane);
            chain_commit(A, L, lc, lane);
            lc += 4; if (lc >= 128) break;
            if (lc + 4 < 128) chain_fetch(A, PP, QQ, GAMC, (b * 128 + lc + 4) * 8 + h, lane);
            chain_commit(B, L, lc, lane);
            lc += 4; if (lc >= 128) break;
        }
    } else {
        const int vt = wave;
        LAS bf16* SI = (LAS bf16*)(L + CH_SI + vt * 2304);
        f32x4 st[4];
#pragma unroll
        for (int mt = 0; mt < 4; ++mt) st[mt] = (f32x4){0.f, 0.f, 0.f, 0.f};
        for (int c = 0; c < 128; ++c) {
            const int item = (b * 128 + c) * 8 + h, slot = c % CH_R; const size_t ob = (size_t)item * 4096;
#pragma unroll
            for (int mt = 0; mt < 4; ++mt) { const unsigned long long pk = pack4(st[mt]);
                *(unsigned long long*)(S0 + ob + (vt * 16 + cc) * 64 + mt * 16 + 4 * g) = pk; *(LAS unsigned long long*)(SI + cc * RW_LD + mt * 16 + 4 * g) = pk; }
            while (flags[slot] < (unsigned)(c + 1)) __builtin_amdgcn_s_sleep(1);
            asm volatile("s_waitcnt lgkmcnt(0)" ::: "memory");
            const LAS unsigned char* sl = L + CH_RING + slot * CH_SLOT;
            const LAS bf16* Pi = (const LAS bf16*)sl; const LAS bf16* Qi = (const LAS bf16*)(sl + 9216); const LAS float* Gi = (const LAS float*)(sl + 18432);
            const s16x8 b0 = *(const LAS s16x8*)(SI + cc * RW_LD + 8 * g), b1 = *(const LAS s16x8*)(SI + cc * RW_LD + 32 + 8 * g);
#pragma unroll
            for (int mt = 0; mt < 4; ++mt) {
                const f32x4 gm = *(const LAS f32x4*)(Gi + mt * 16 + 4 * g);
                const unsigned long long qq = *(const LAS unsigned long long*)(Qi + (vt * 16 + cc) * RW_LD + mt * 16 + 4 * g);
                const s16x8 a0 = *(const LAS s16x8*)(Pi + (mt * 16 + cc) * RW_LD + 8 * g), a1 = *(const LAS s16x8*)(Pi + (mt * 16 + cc) * RW_LD + 32 + 8 * g);
                f32x4 acc; acc.x = gm.x * st[mt].x + bf2f((bf16)(qq & 0xffffu)); acc.y = gm.y * st[mt].y + bf2f((bf16)((qq >> 16) & 0xffffu));
                acc.z = gm.z * st[mt].z + bf2f((bf16)((qq >> 32) & 0xffffu)); acc.w = gm.w * st[mt].w + bf2f((bf16)(qq >> 48));
                acc = __builtin_amdgcn_mfma_f32_16x16x32_bf16(a0, b0, acc, 0, 0, 0); acc = __builtin_amdgcn_mfma_f32_16x16x32_bf16(a1, b1, acc, 0, 0, 0);
                st[mt] = acc; }
            asm volatile("s_waitcnt lgkmcnt(0)" ::: "memory");
            if (lane == 0) flags[CH_R + vt] = (unsigned)(c + 1);
        }
    }
    __syncthreads();
}

__device__ __forceinline__ void ph_rwkv_c(const Ctx& C, const bf16* S0, const bf16* RH, const bf16* YH, const float* RK, const bf16* GG, const bf16* VF,
                                          const float* gn_g, const float* gn_b, bf16* O) {
    const int lane = C.lane, cc = lane & 15, g = lane >> 4;
    for (int item = C.bid * 8 + C.wave; item < 4096; item += C.nb * 8) {
        const int h = item & 7, c = (item >> 3) & 127, b = item >> 10; const size_t m0 = (size_t)b * T_ + c * 64, ob = (size_t)item * 4096;
        s16x8 af[4][2], bfr[4][2];
#pragma unroll
        for (int q = 0; q < 4; ++q)
#pragma unroll
            for (int k = 0; k < 2; ++k) { af[q][k] = *(const s16x8*)(S0 + ob + (q * 16 + cc) * 64 + k * 32 + 8 * g); bfr[q][k] = *(const s16x8*)(RH + ob + (q * 16 + cc) * 64 + k * 32 + 8 * g); }
#pragma unroll
        for (int nt = 0; nt < 4; ++nt) {
            const size_t m = m0 + nt * 16 + cc;
            f32x4 y[4]; float s1 = 0.f;
#pragma unroll
            for (int mt = 0; mt < 4; ++mt) { const unsigned long long yh = *(const unsigned long long*)(YH + ob + (nt * 16 + cc) * 64 + mt * 16 + 4 * g);
                f32x4 acc; acc.x = bf2f((bf16)(yh & 0xffffu)); acc.y = bf2f((bf16)((yh >> 16) & 0xffffu)); acc.z = bf2f((bf16)((yh >> 32) & 0xffffu)); acc.w = bf2f((bf16)(yh >> 48));
                acc = __builtin_amdgcn_mfma_f32_16x16x32_bf16(af[mt][0], bfr[nt][0], acc, 0, 0, 0); acc = __builtin_amdgcn_mfma_f32_16x16x32_bf16(af[mt][1], bfr[nt][1], acc, 0, 0, 0);
                y[mt] = acc; s1 += (acc.x + acc.y) + (acc.z + acc.w); }
            s1 += __shfl_xor(s1, 16); s1 += __shfl_xor(s1, 32);
            const float mean = s1 * (1.f / 64.f); float s2 = 0.f;
#pragma unroll
            for (int mt = 0; mt < 4; ++mt) { y[mt] = y[mt] - mean; s2 += (y[mt].x * y[mt].x + y[mt].y * y[mt].y) + (y[mt].z * y[mt].z + y[mt].w * y[mt].w); }
            s2 += __shfl_xor(s2, 16); s2 += __shfl_xor(s2, 32);
            const float rstd = 1.f / sqrtf(s2 * (1.f / 64.f) + 64e-5f), rk = RK[m * 8 + h];
#pragma unroll
            for (int mt = 0; mt < 4; ++mt) { const int v = h * 64 + mt * 16 + 4 * g;
                const f32x4 gg4 = *(const f32x4*)(gn_g + v), gb4 = *(const f32x4*)(gn_b + v);
                const unsigned long long vx = *(const unsigned long long*)(VF + m * 512 + v), gx = *(const unsigned long long*)(GG + m * 512 + v);
                f32x4 o;
                o.x = (y[mt].x * rstd * gg4.x + gb4.x + rk * bf2f((bf16)(vx & 0xffffu))) * bf2f((bf16)(gx & 0xffffu));
                o.y = (y[mt].y * rstd * gg4.y + gb4.y + rk * bf2f((bf16)((vx >> 16) & 0xffffu))) * bf2f((bf16)((gx >> 16) & 0xffffu));
                o.z = (y[mt].z * rstd * gg4.z + gb4.z + rk * bf2f((bf16)((vx >> 32) & 0xffffu))) * bf2f((bf16)((gx >> 32) & 0xffffu));
                o.w = (y[mt].w * rstd * gg4.w + gb4.w + rk * bf2f((bf16)(vx >> 48))) * bf2f((bf16)(gx >> 48));
                *(unsigned long long*)(O + m * D_ + 512 + v) = pack4(o); }
        }
    }
}

__device__ __forceinline__ void ph_convfix(const Ctx& C, const float* HALO, const float* FIXU, const float* cw, const float* cb, bf16* ACT) {
    for (int idx = C.bid * NT + C.tid; idx < 128 * 22 * 2 * 128; idx += C.nb * NT) {
        const int j = idx & 127, rr = (idx >> 7) & 1, tile = idx >> 8, pm = tile / 22, pn = tile % 22;
        const bool seq0 = (pm & 31) == 0;
        const float* fx = FIXU + (size_t)tile * 512; const float* hl = HALO + (size_t)(tile - 22) * 512;
        const float u0g = fx[rr * 256 + j], u0v = fx[rr * 256 + 128 + j];
        float u1g, u1v, u2g, u2v;
        if (rr == 0) { u1g = seq0 ? 0.f : hl[256 + j]; u1v = seq0 ? 0.f : hl[256 + 128 + j]; u2g = seq0 ? 0.f : hl[j]; u2v = seq0 ? 0.f : hl[128 + j]; }
        else { u1g = fx[j]; u1v = fx[128 + j]; u2g = seq0 ? 0.f : hl[256 + j]; u2v = seq0 ? 0.f : hl[256 + 128 + j]; }
        const int jg = pn * 128 + j, jv = DFF + jg;
        const float gc = cb[jg] + cw[jg] * u2g + cw[NUP + jg] * u1g + cw[2 * NUP + jg] * u0g, vc = cb[jv] + cw[jv] * u2v + cw[NUP + jv] * u1v + cw[2 * NUP + jv] * u0v;
        ACT[(size_t)(pm * 256 + rr) * DFF + jg] = (bf16)f2bf(siluf_(gc) * vc);
    }
}
}

namespace pg8 {
struct EpiRes {
    static constexpr bool PERM = false, AFTER_DRAIN = false;
    const float* base; float* out; const float* gate; int gstride;
    __device__ __forceinline__ void operator()(const f32x4 (&acc)[2][2][4][2], const Unit& u, int wr, int wc, int fr, int fq) const {
        const int b = (u.pm * BM) / 8192; const float* gp = gate + (size_t)b * gstride;
        const int col0 = u.pn * BM + wc * 32 + 4 * fq;
#pragma unroll
        for (int ai = 0; ai < 2; ++ai)
#pragma unroll
            for (int m = 0; m < 4; ++m) { const size_t off = (size_t)(u.pm * BM + ai * HALF + wr * 64 + m * 16 + fr) * 1024 + col0;
#pragma unroll
                for (int bj = 0; bj < 2; ++bj)
#pragma unroll
                    for (int n = 0; n < 2; ++n) { const int cc = bj * HALF + n * 16; const f32x4 gv = *(const f32x4*)(gp + col0 + cc); const f32x4 bs = *(const f32x4*)(base + off + cc);
                        *(f32x4*)(out + off + cc) = bs + gv * acc[ai][bj][m][n]; } }
    }
};

struct EpiConv {
    static constexpr bool PERM = true, AFTER_DRAIN = false;
    bf16_t* ACT; const float* cw; const float* cb; float* HALO; float* FIXU; PG8_LAS float* EX; int nN;
    template <int CTRL> static __device__ __forceinline__ float rot(float x) { return __builtin_bit_cast(float, __builtin_amdgcn_update_dpp(0, __builtin_bit_cast(int, x), CTRL, 0xf, 0xf, false)); }
    template <int CTRL> static __device__ __forceinline__ f32x4 rot4(f32x4 x) { return (f32x4){rot<CTRL>(x.x), rot<CTRL>(x.y), rot<CTRL>(x.z), rot<CTRL>(x.w)}; }
    __device__ __forceinline__ void operator()(const f32x4 (&acc)[2][2][4][2], const Unit& u, int wr, int wc, int fr, int fq) const {
        const int colw = wc * 32 + 8 * fq, tile = u.pm * nN + u.pn;
        if (fr >= 14) {
#pragma unroll
            for (int ai = 0; ai < 2; ++ai)
#pragma unroll
                for (int bj = 0; bj < 2; ++bj)
#pragma unroll
                    for (int n = 0; n < 2; ++n) { *(PG8_LAS f32x4*)(EX + ((ai * 2 + wr) * 2 + (fr - 14)) * 256 + bj * 128 + colw + 4 * n) = acc[ai][bj][3][n];
                        if (ai == 1 && wr == 1) *(f32x4*)(HALO + ((size_t)tile * 2 + (fr - 14)) * 256 + bj * 128 + colw + 4 * n) = acc[1][bj][3][n]; }
        }
        if (fr < 2 && wr == 0) {
#pragma unroll
            for (int bj = 0; bj < 2; ++bj)
#pragma unroll
                for (int n = 0; n < 2; ++n) *(f32x4*)(FIXU + ((size_t)tile * 2 + fr) * 256 + bj * 128 + colw + 4 * n) = acc[0][bj][0][n];
        }
        asm volatile("s_waitcnt lgkmcnt(0)" ::: "memory"); __builtin_amdgcn_s_barrier(); asm volatile("" ::: "memory");
#pragma unroll
        for (int n = 0; n < 2; ++n) {
            const int jg = u.pn * 128 + colw + 4 * n, jv = 2816 + jg;
#pragma unroll
            for (int ai = 0; ai < 2; ++ai)
#pragma unroll
                for (int m = 0; m < 4; ++m) {
                    const int src = ai * 2 + wr - 1;
                    f32x4 res[2];
#pragma unroll
                    for (int bj = 0; bj < 2; ++bj) {
                        const int jc = bj ? jv : jg;
                        const f32x4 x = acc[ai][bj][m][n];
                        f32x4 x1 = rot4<0x121>(x), x2 = rot4<0x122>(x);
                        if (m > 0) { const f32x4 q = acc[ai][bj][m > 0 ? m - 1 : 0][n]; const f32x4 q1 = rot4<0x121>(q), q2 = rot4<0x122>(q);
                            if (fr == 0) x1 = q1; if (fr < 2) x2 = q2; }
                        else if (fr < 2) { f32x4 e14 = {0.f, 0.f, 0.f, 0.f}, e15 = e14;
                            if (src >= 0) { e14 = *(const PG8_LAS f32x4*)(EX + (src * 2 + 0) * 256 + bj * 128 + colw + 4 * n); e15 = *(const PG8_LAS f32x4*)(EX + (src * 2 + 1) * 256 + bj * 128 + colw + 4 * n); }
                            if (fr == 0) { x1 = e15; x2 = e14; } else x2 = e15; }
                        const f32x4 w0 = *(const f32x4*)(cw + jc), w1 = *(const f32x4*)(cw + 5632 + jc), w2 = *(const f32x4*)(cw + 2 * 5632 + jc), bb = *(const f32x4*)(cb + jc);
                        res[bj] = bb + w0 * x2 + w1 * x1 + w2 * x;
                    }
                    const f32x4 gc = res[0], vc = res[1];
                    f32x4 o;
                    o.x = gc.x * __builtin_amdgcn_rcpf(1.f + __expf(-gc.x)) * vc.x; o.y = gc.y * __builtin_amdgcn_rcpf(1.f + __expf(-gc.y)) * vc.y;
                    o.z = gc.z * __builtin_amdgcn_rcpf(1.f + __expf(-gc.z)) * vc.z; o.w = gc.w * __builtin_amdgcn_rcpf(1.f + __expf(-gc.w)) * vc.w;
                    typedef unsigned u32x2 __attribute__((ext_vector_type(2)));
                    u32x2 w; w.x = cvt_pk_bf16(o.x, o.y); w.y = cvt_pk_bf16(o.z, o.w);
                    *(u32x2*)(ACT + (size_t)(u.pm * BM + ai * HALF + wr * 64 + m * 16 + fr) * 2816 + u.pn * 128 + colw + 4 * n) = w;
                }
        }
    }
};
}

namespace hy {
struct Args { const float* in[31]; float* out; unsigned char* ws; };
__global__ void __launch_bounds__(NT, 2) hy_fwd(Args A) {
    extern __shared__ __attribute__((aligned(16))) unsigned char lds_raw[];
    Ctx C; C.bid = blockIdx.x; C.nb = gridDim.x; C.tid = threadIdx.x; C.lane = C.tid & 63; C.wave = __builtin_amdgcn_readfirstlane(C.tid >> 6); C.lds = (LAS unsigned char*)lds_raw;
    volatile LAS unsigned* MISC = (volatile LAS unsigned*)(C.lds + MISC_OFF);
    for (int u = C.tid; u < (LDS_BYTES - MISC_OFF) / 4; u += NT) ((LAS unsigned*)(C.lds + MISC_OFF))[u] = 0u;
    __syncthreads();
    unsigned char* ws = A.ws;
    XcdBarrier bar = xcd_barrier_post((unsigned*)(ws + WS_CTL) + CW_BAR, MISC + 8);
#define PHASE_BEGIN() do { int t_ = threadIdx.x; asm volatile("" : "+v"(t_)); int b_ = blockIdx.x; asm volatile("" : "+s"(b_)); \
    C.tid = t_; C.lane = t_ & 63; C.wave = __builtin_amdgcn_readfirstlane(t_ >> 6); C.bid = b_; } while (0)
#ifdef HY_DIAG
    unsigned long long ts_last = __builtin_amdgcn_s_memrealtime(); float tacc[10] = {0.f, 0.f, 0.f, 0.f, 0.f, 0.f, 0.f, 0.f, 0.f, 0.f};
#define GRID_BAR(cat) do { xcd_barrier(bar); PHASE_BEGIN(); { const unsigned long long n_ = __builtin_amdgcn_s_memrealtime(); tacc[cat] += (float)(n_ - ts_last); ts_last = n_; } } while (0)
#else
#define GRID_BAR(cat) do { xcd_barrier(bar); PHASE_BEGIN(); } while (0)
#endif
#ifndef HY_REPCAT
#define HY_REPCAT (-1)
#endif
#define NREP(cat) ((HY_REPCAT == (cat)) ? 2 : 1)
    float* out = A.out;
#define in A.in
    float* MOD = (float*)(ws + WS_MOD);
    bf16 *WIN = (bf16*)(ws + WS_WIN), *WOUT = (bf16*)(ws + WS_WOUT), *WUP = (bf16*)(ws + WS_WUP), *WDN = (bf16*)(ws + WS_WDN);
    bf16 *XB = (bf16*)(ws + WS_XB), *O = (bf16*)(ws + WS_O), *VF = (bf16*)(ws + WS_VF), *PG = (bf16*)(ws + WS_PG), *PR = (bf16*)(ws + WS_PR), *VL = (bf16*)(ws + WS_VL);
    bf16 *RH = (bf16*)(ws + WS_RH), *YH = (bf16*)(ws + WS_YH), *PP = (bf16*)(ws + WS_PP), *QQ = (bf16*)(ws + WS_QQ), *GG = (bf16*)(ws + WS_GG), *S0 = (bf16*)(ws + WS_S0);
    float *GAMC = (float*)(ws + WS_GAMC), *RK = (float*)(ws + WS_RK);
    bf16* LORA = (bf16*)(ws + WS_LORA);
    bf16* DS = (bf16*)(ws + WS_GK); float* GAM = (float*)(ws + WS_GAM);
    bf16* ACT = (bf16*)(ws + WS_ACT); float *HALO = (float*)(ws + WS_U), *FIXU = (float*)(ws + WS_U + 8 * MiB);

    ph_mod(C, in[1], in[2], in[3], MOD);
    for (int l = 0; l < L_; ++l) {
        const float* modl = MOD + (size_t)l * 4 * 6144;
        const float* xres = l ? out : in[0];
        for (int r_ = 0; r_ < NREP(0); ++r_) {
        wprep_mat(C, in[5] + (size_t)l * D_ * IN_COLS, D_, IN_COLS, NIN, WIN, 1, l ? in[6] : nullptr);
        wprep_mat(C, in[24] + (size_t)l * D_ * D_, D_, D_, D_, WOUT, 0, nullptr);
        wprep_mat(C, in[26] + (size_t)l * D_ * NUP, D_, NUP, NUP, WUP, 2, nullptr);
        wprep_mat(C, in[29] + (size_t)l * DFF * D_, DFF, D_, D_, WDN, 0, nullptr);
        wprep_mat(C, in[12] + (size_t)l * 64 * 512, 64, 512, 512, LORA, 0, nullptr);
        wprep_mat(C, in[14] + (size_t)l * 64 * 512, 64, 512, 512, LORA + 512 * 64, 0, nullptr);
        wprep_mat(C, in[16] + (size_t)l * 128 * 512, 128, 512, 512, LORA + 2 * 512 * 64, 0, nullptr);
        if (l) wprep_mat(C, in[17], 32, 512, 512, LORA + 2 * 512 * 64 + 512 * 128, 0, nullptr);
        }
        GRID_BAR(0);
        for (int r_ = 0; r_ < NREP(1); ++r_) ph_norm(C, xres, in[4] + l * D_, modl + 0 * D_, modl + 1 * D_, XB);
        GRID_BAR(1);
        for (int r_ = 0; r_ < NREP(2); ++r_) { pg8::Gemm g{XB, WIN, M_, NIN, D_}; pg8::StaticOrder S; S.init(M_, NIN, C.nb, C.bid);
          pg8::EpiBf16<0> E{PG, NPG, nullptr, NPG, (WS_PR - WS_PG) / 2, 1.f};
          pg8::gemm_phase<pg8::EpiBf16<0>, pg8::StaticOrder, true, true>(C.lds, g, S, E); }
        GRID_BAR(2);
        for (int r_ = 0; r_ < NREP(3); ++r_) {
        ph_gla_a(C, PG, in[7] + l * 16 * 256, in[8] + l * 256, DS, GAM, VL);
        { RwkvW W{in[10] + l * 1792, in[11], in[13] + l * 512, in[15] + l * 512, in[18], in[19] + l * 512, in[20] + l * 512, in[21] + l * 512,
                  LORA, LORA + 512 * 64, LORA + 2 * 512 * 64, LORA + 2 * 512 * 64 + 512 * 128};
          ph_rwkv_a(C, PR, PG, W, l, PP, QQ, RH, YH, GAMC, RK, GG, VF, r_ == NREP(3) - 1); } }
        GRID_BAR(3);
        if (C.bid < 32) { for (int r_ = 0; r_ < NREP(4); ++r_) ph_rwkv_b(C, C.bid, PP, QQ, GAMC, S0); }
        else { Ctx C2 = C; C2.bid = C.bid - 32; C2.nb = C.nb - 32; ph_gla_b(C2, DS, GAM); }
        GRID_BAR(4);
        for (int r_ = 0; r_ < NREP(5); ++r_) {
        ph_gla_c(C, PG, in[7] + l * 16 * 256, in[8] + l * 256, in[9] + l * 128, DS, O);
        ph_rwkv_c(C, S0, RH, YH, RK, GG, VF, in[22] + l * 512, in[23] + l * 512, O); }
        GRID_BAR(5);
        { pg8::Gemm g{O, WOUT, M_, D_, D_}; pg8::StaticOrder S; S.init(M_, D_, C.nb, C.bid);
          pg8::EpiRes E{xres, out, modl + 2 * D_, 6144};
          pg8::gemm_phase<pg8::EpiRes, pg8::StaticOrder, true, true>(C.lds, g, S, E); }
        GRID_BAR(6);
        for (int r_ = 0; r_ < NREP(1); ++r_) ph_norm(C, out, in[25] + l * D_, modl + 3 * D_, modl + 4 * D_, XB);
        GRID_BAR(1);
        for (int r_ = 0; r_ < NREP(7); ++r_) { pg8::Gemm g{XB, WUP, M_, NUP, D_}; pg8::StaticOrder S; S.init(M_, NUP, C.nb, C.bid);
          pg8::EpiConv E{ACT, in[27] + (size_t)l * 3 * NUP, in[28] + (size_t)l * NUP, HALO, FIXU, (PG8_LAS float*)(C.lds + RING_BYTES), NUP / 256};
          pg8::gemm_phase<pg8::EpiConv, pg8::StaticOrder, true, true>(C.lds, g, S, E); }
        GRID_BAR(7);
        for (int r_ = 0; r_ < NREP(8); ++r_) ph_convfix(C, HALO, FIXU, in[27] + (size_t)l * 3 * NUP, in[28] + (size_t)l * NUP, ACT);
        GRID_BAR(8);
        { pg8::Gemm g{ACT, WDN, M_, D_, DFF}; pg8::StaticOrder S; S.init(M_, D_, C.nb, C.bid);
          pg8::EpiRes E{out, out, modl + 5 * D_, 6144};
          pg8::gemm_phase<pg8::EpiRes, pg8::StaticOrder, true, true>(C.lds, g, S, E); }
        GRID_BAR(9);
    }
    ph_final(C, out, in[30]);
#ifdef HY_DIAG
    GRID_BAR(1);
    if (C.bid == 0) { if (C.tid == 0) out[0] = tacc[HY_DIAG_A] * 0.1f; for (int i = 1 + C.tid; i <= 10000; i += NT) out[i] = tacc[HY_DIAG_B] * 0.01f; }
#endif
#undef GRID_BAR
#undef PHASE_BEGIN
#undef in
}
}

extern "C" void kernel_launch(void* const* d_in, const int* in_sizes, int n_in, void* d_out, int out_size, void* d_ws, size_t ws_size, hipStream_t stream) {
    using namespace hy;
    static int grid = 0;
    if (grid == 0) {
        if (n_in != 31 || in_sizes[0] != M_ * D_ || out_size != M_ * D_ || ws_size < WS_END) { fprintf(stderr, "kernel_launch: unexpected shapes (n_in %d, in0 %d, out %d, ws %zu)\n", n_in, n_in > 0 ? in_sizes[0] : -1, out_size, ws_size); grid = -1; return; }
        if (hipFuncSetAttribute((const void*)hy_fwd, hipFuncAttributeMaxDynamicSharedMemorySize, LDS_BYTES) != hipSuccess) { fprintf(stderr, "kernel_launch: hipFuncSetAttribute failed\n"); grid = -1; return; }
        int dev = 0, cus = 0, per_cu = 0;
        (void)hipGetDevice(&dev); (void)hipDeviceGetAttribute(&cus, hipDeviceAttributeMultiprocessorCount, dev);
        (void)hipOccupancyMaxActiveBlocksPerMultiprocessor(&per_cu, (const void*)hy_fwd, NT, LDS_BYTES);
        if (per_cu < 1) fprintf(stderr, "kernel_launch: occupancy query reports %d blocks per CU\n", per_cu);
        (void)hipGetLastError();
        grid = cus > 0 ? cus : 256;
    }
    if (grid < 0) return;
    (void)hipMemsetAsync((char*)d_ws + WS_CTL, 0, CTL_ZERO_BYTES, stream);
    Args a{};
    for (int i = 0; i < 31; ++i) a.in[i] = (const float*)d_in[i];
    a.out = (float*)d_out; a.ws = (unsigned char*)d_ws;
    hipLaunchKernelGGL(hy_fwd, dim3(grid), dim3(NT), LDS_BYTES, stream, a);
}
```

```cpp
#include <hip/hip_runtime.h>
#include <cstdio>
#include <cstdint>
namespace pg8 {
#define PG8_LAS __attribute__((address_space(3)))
typedef unsigned short bf16_t;
typedef short bf16x8 __attribute__((ext_vector_type(8)));
typedef float f32x4 __attribute__((ext_vector_type(4)));
typedef unsigned u32x4 __attribute__((ext_vector_type(4)));
constexpr int BM = 256, BK = 64, HALF = 128, HTB = HALF * BK * 2  , STAGE_BYTES = 8 * HTB, NXCD = 8, WGM = 8;

__host__ __device__ __forceinline__ int lds_byte(int r, int c) { const int st = (r >> 4) * 2 + (c >> 5), rr = r & 15, cc = c & 31, ob = rr * 64 + cc * 2; return st * 1024 + (ob ^ (((ob >> 9) & 1) << 5)); }
__host__ __device__ __forceinline__ void stage_rc(int b, int& R, int& C) { const int st = b / 1024, sb = b % 1024, swz = sb ^ (((sb >> 9) & 1) << 5); R = (st >> 1) * 16 + swz / 64; C = (st & 1) * 32 + (swz % 64) / 2; }
__host__ __device__ __forceinline__ int perm32(int rho) { const int n = rho >> 4, i = rho & 15; return 8 * (i >> 2) + 4 * n + (i & 3); }

struct Unit { int pm, pn; };
struct Gemm { const bf16_t* A; const bf16_t* Bt; int M, N, K; };

struct StaticOrder {
    int nM, nN, nwg, G, c;
    __host__ __device__ void init(int M, int N, int G_, int c_) { nM = M / BM; nN = N / BM; nwg = nM * nN; G = G_; c = c_; }
    __host__ __device__ bool next(int i, Unit& u) const {
        const long L = (long)i * G + c; if (L >= nwg) return false;
        int wgid = (int)L; { const int q = nwg / NXCD, r = nwg % NXCD, xcd = wgid % NXCD, off = wgid / NXCD; wgid = (xcd < r ? xcd * (q + 1) : r * (q + 1) + (xcd - r) * q) + off; }
        const int nig = WGM * nN, gid = wgid / nig, fm = gid * WGM, gsz = (nM - fm) < WGM ? (nM - fm) : WGM;
        u.pm = fm + ((wgid % nig) % gsz); u.pn = (wgid % nig) / gsz; return true;
    }
    __device__ __forceinline__ void a_ready(const Unit&) const {}
    __device__ __forceinline__ void done(const Unit&) const {}
};

__device__ __forceinline__ unsigned cvt_pk_bf16(float lo, float hi) { unsigned r; asm volatile("v_cvt_pk_bf16_f32 %0, %1, %2" : "=v"(r) : "v"(lo), "v"(hi)); return r; }
typedef float f32x2 __attribute__((ext_vector_type(2)));
__device__ __forceinline__ f32x2 gelu_pk(f32x2 v) {
    const f32x2 av = __builtin_elementwise_abs(v), d = av * 0.2316418882f + 1.0f;
    f32x2 t; t.x = __builtin_amdgcn_rcpf(d.x); t.y = __builtin_amdgcn_rcpf(d.y);
    f32x2 q = t * 0.5307027145f + (-0.7265760135f); q = q * t + 0.7107068705f; q = q * t + (-0.142248368f); q = q * t + 0.127414796f; q = q * t;
    const f32x2 s = (v * v) * (-0.72134752044f);
    f32x2 e; e.x = __builtin_amdgcn_exp2f(s.x); e.y = __builtin_amdgcn_exp2f(s.y);
    const f32x2 m = v * (q * e), r = v - m;
    f32x2 o; o.x = v.x < 0.f ? m.x : r.x; o.y = v.y < 0.f ? m.y : r.y; return o;
}

template <int ACT  > struct EpiBf16 {
    static constexpr bool PERM = true, AFTER_DRAIN = false; static_assert(ACT == 0 || ACT == 1, "EpiBf16: ACT is 0 (none) or 1 (gelu_pk)");
    bf16_t* O; int ldc; const float* bias; int split_cols; size_t split_stride; float scale0;
    __device__ __forceinline__ void operator()(const f32x4 (&acc)[2][2][4][2], const Unit& u, int wr, int wc, int fr, int fq) const {
        const int row0 = u.pm * BM + wr * 64 + fr; int colt = u.pn * BM; bf16_t* base = O;
        float sc = 1.f; if (split_cols) { const int t = colt / split_cols; base += (size_t)t * split_stride; colt -= t * split_cols; if (t == 0) sc = scale0; }
        const int col0 = colt + wc * 32 + 8 * fq, bcol0 = u.pn * BM + wc * 32 + 8 * fq;
        f32x4 bv[2][2];
#pragma unroll
        for (int bj = 0; bj < 2; ++bj)
#pragma unroll
            for (int n = 0; n < 2; ++n) bv[bj][n] = bias ? *(const f32x4*)(bias + bcol0 + bj * HALF + 4 * n) : (f32x4){0.f, 0.f, 0.f, 0.f};
#pragma unroll
        for (int ai = 0; ai < 2; ++ai)
#pragma unroll
            for (int m = 0; m < 4; ++m) { bf16_t* rowp = base + (size_t)(row0 + ai * HALF + m * 16) * ldc + col0;
#pragma unroll
                for (int bj = 0; bj < 2; ++bj) { f32x4 v0 = acc[ai][bj][m][0] + bv[bj][0], v1 = acc[ai][bj][m][1] + bv[bj][1];
                    if (ACT == 1) { f32x2 a = gelu_pk((f32x2){v0[0], v0[1]}), b = gelu_pk((f32x2){v0[2], v0[3]}), c = gelu_pk((f32x2){v1[0], v1[1]}), d = gelu_pk((f32x2){v1[2], v1[3]});
                        v0 = (f32x4){a.x, a.y, b.x, b.y}; v1 = (f32x4){c.x, c.y, d.x, d.y}; }
                    v0 = v0 * sc; v1 = v1 * sc; u32x4 w; w.x = cvt_pk_bf16(v0[0], v0[1]); w.y = cvt_pk_bf16(v0[2], v0[3]); w.z = cvt_pk_bf16(v1[0], v1[1]); w.w = cvt_pk_bf16(v1[2], v1[3]);
                    *(u32x4*)(rowp + bj * HALF) = w; } }
    }
};
template <class Epi, class Sched, bool ALIGN_EPI = false, bool SP2 = false>
__device__ __forceinline__ void gemm_phase(PG8_LAS unsigned char* lds, const Gemm g, const Sched& S, const Epi& E) {
    int tid_ = threadIdx.x; asm volatile("" : "+v"(tid_));
    const int tid = tid_, wid = __builtin_amdgcn_readfirstlane(tid >> 6), lane = tid & 63, wr = wid >> 2, wc = wid & 3, fr = lane & 15, fq = lane >> 4;
    const int K = g.K, nt = K / BK;
    unsigned voffA[2], voffB[2];
#pragma unroll
    for (int i = 0; i < 2; ++i) { int R, C; stage_rc(tid * 16 + i * 8192, R, C); const int Rb = Epi::PERM ? ((R & ~31) + perm32(R & 31)) : R;
        voffA[i] = (unsigned)(R * K + C) * 2u; voffB[i] = (unsigned)(Rb * K + C) * 2u; }
    const size_t kstep = (size_t)(BK * 2);
    const size_t hstep = (size_t)HALF * K * 2;
    const size_t tstep = 2 * hstep;
    const unsigned ldsw = (unsigned)wid * 1024u;
    const int aoff = lds_byte(wr * 64 + fr, fq * 8), boff = lds_byte(wc * 32 + fr, fq * 8);
#define PG8_SA(b, h) (((b) * 2 + (h)) * HTB)
#define PG8_SB(b, h) ((4 + (b) * 2 + (h)) * HTB)
#define PG8_STAGE(bufoff, gbase, voff) do { _Pragma("unroll") for (int _i = 0; _i < 2; ++_i) \
        __builtin_amdgcn_global_load_lds((const unsigned*)((const char*)(gbase) + (voff)[_i]), (PG8_LAS unsigned*)(lds + (bufoff) + ldsw + _i * 8192), 16, 0, 0); } while (0)
#define PG8_LDA(dst, b, h) do { _Pragma("unroll") for (int m = 0; m < 4; ++m) _Pragma("unroll") for (int k = 0; k < 2; ++k) dst[m][k] = *(const PG8_LAS bf16x8*)(lds + PG8_SA(b, h) + aoff + m * 2048 + k * 1024); } while (0)
#define PG8_LDB(dst, b, h) do { _Pragma("unroll") for (int n = 0; n < 2; ++n) _Pragma("unroll") for (int k = 0; k < 2; ++k) dst[n][k] = *(const PG8_LAS bf16x8*)(lds + PG8_SB(b, h) + boff + n * 2048 + k * 1024); } while (0)
#define PG8_MMA(ai, bj, At, Bt) do { __builtin_amdgcn_s_setprio(1); _Pragma("unroll") for (int m = 0; m < 4; ++m) _Pragma("unroll") for (int n = 0; n < 2; ++n) _Pragma("unroll") for (int k = 0; k < 2; ++k) \
        acc[ai][bj][m][n] = __builtin_amdgcn_mfma_f32_16x16x32_bf16(Bt[n][k], At[m][k], acc[ai][bj][m][n], 0, 0, 0); __builtin_amdgcn_s_setprio(0); } while (0)
#define PG8_WAIT_V(n) asm volatile("s_waitcnt vmcnt(" #n ")" ::: "memory")
#define PG8_WAIT_L(n) asm volatile("s_waitcnt lgkmcnt(" #n ")" ::: "memory")
#define PG8_BAR __builtin_amdgcn_s_barrier()
#define PG8_SCHED __builtin_amdgcn_sched_barrier(0)
    Unit cur, nxt; int ui = 0;
    if (!S.next(0, cur)) return;
    f32x4 acc[2][2][4][2];
#pragma unroll
    for (int a = 0; a < 2; ++a)
#pragma unroll
        for (int b = 0; b < 2; ++b)
#pragma unroll
            for (int m = 0; m < 4; ++m)
#pragma unroll
                for (int n = 0; n < 2; ++n) acc[a][b][m][n] = (f32x4){0.f, 0.f, 0.f, 0.f};
    bf16x8 At[4][2], B0[2][2], B1[2][2];
    const char* cA = (const char*)g.A + (size_t)cur.pm * tstep; const char* cB = (const char*)g.Bt + (size_t)cur.pn * tstep;
    S.a_ready(cur);
    if constexpr (SP2) {
        PG8_STAGE(PG8_SB(0, 0), cB, voffB); PG8_STAGE(PG8_SB(0, 1), cB + hstep, voffB); PG8_STAGE(PG8_SA(0, 0), cA, voffA); PG8_STAGE(PG8_SA(0, 1), cA + hstep, voffA);
        if (wr == 1) PG8_BAR;
        PG8_WAIT_V(2); PG8_BAR;
        PG8_STAGE(PG8_SB(1, 0), cB + kstep, voffB); PG8_STAGE(PG8_SA(1, 0), cA + kstep, voffA); PG8_STAGE(PG8_SB(1, 1), cB + hstep + kstep, voffB);
        PG8_WAIT_V(6); PG8_BAR;
    } else {
        PG8_STAGE(PG8_SB(0, 0), cB, voffB); PG8_STAGE(PG8_SA(0, 0), cA, voffA); PG8_STAGE(PG8_SB(0, 1), cB + hstep, voffB); PG8_STAGE(PG8_SA(0, 1), cA + hstep, voffA);
        if (wr == 1) PG8_BAR;
        PG8_WAIT_V(4); PG8_BAR;
        PG8_STAGE(PG8_SB(1, 0), cB + kstep, voffB); PG8_STAGE(PG8_SA(1, 0), cA + kstep, voffA); PG8_STAGE(PG8_SB(1, 1), cB + hstep + kstep, voffB);
        PG8_WAIT_V(6); PG8_BAR;
    }
    for (;;) {
        const bool has_next = S.next(ui + 1, nxt);
        const char* nA = has_next ? (const char*)g.A + (size_t)nxt.pm * tstep : cA; const char* nB = has_next ? (const char*)g.Bt + (size_t)nxt.pn * tstep : cB;
        for (int t = 0; t < nt; t += 2) {
            const bool last = (t == nt - 2);
            const char* a1 = cA + (size_t)(t + 1) * kstep;
            const char* a2 = last ? nA : cA + (size_t)(t + 2) * kstep; const char* b2 = last ? nB : cB + (size_t)(t + 2) * kstep;
            const char* a3 = a2 + kstep; const char* b3 = b2 + kstep;
            if (last && has_next) S.a_ready(nxt);
            if constexpr (SP2) {
            PG8_LDB(B0, 0, 0); PG8_LDB(B1, 0, 1); PG8_SCHED; PG8_LDA(At, 0, 0); PG8_STAGE(PG8_SA(1, 1), a1 + hstep, voffA);
            PG8_WAIT_V(8); PG8_WAIT_L(0); PG8_BAR; PG8_MMA(0, 0, At, B0); PG8_MMA(0, 1, At, B1); PG8_BAR; PG8_SCHED;
            PG8_LDA(At, 0, 1); PG8_STAGE(PG8_SB(0, 0), b2, voffB); PG8_STAGE(PG8_SB(0, 1), b2 + hstep, voffB); PG8_STAGE(PG8_SA(0, 0), a2, voffA);
            PG8_WAIT_V(8); PG8_WAIT_L(0); PG8_BAR; PG8_MMA(1, 0, At, B0); PG8_MMA(1, 1, At, B1); PG8_BAR; PG8_SCHED;
            PG8_LDB(B0, 1, 0); PG8_LDB(B1, 1, 1); PG8_SCHED; PG8_LDA(At, 1, 0); PG8_STAGE(PG8_SA(0, 1), a2 + hstep, voffA);
            PG8_WAIT_V(8); PG8_WAIT_L(0); PG8_BAR; PG8_MMA(0, 0, At, B0); PG8_MMA(0, 1, At, B1); PG8_BAR; PG8_SCHED;
            PG8_LDA(At, 1, 1); PG8_STAGE(PG8_SB(1, 0), b3, voffB); PG8_STAGE(PG8_SB(1, 1), b3 + hstep, voffB); PG8_STAGE(PG8_SA(1, 0), a3, voffA);
            PG8_WAIT_V(8); PG8_WAIT_L(0); PG8_BAR; PG8_MMA(1, 0, At, B0); PG8_MMA(1, 1, At, B1); PG8_BAR; PG8_SCHED;
            } else {
            PG8_LDB(B0, 0, 0); PG8_SCHED; PG8_LDA(At, 0, 0); PG8_STAGE(PG8_SA(1, 1), a1 + hstep, voffA);
            PG8_WAIT_L(8); PG8_BAR; PG8_WAIT_L(0); PG8_MMA(0, 0, At, B0); PG8_BAR; PG8_SCHED;
            PG8_LDB(B1, 0, 1); PG8_STAGE(PG8_SB(0, 0), b2, voffB);
            PG8_BAR; PG8_WAIT_L(0); PG8_MMA(0, 1, At, B1); PG8_BAR;
            PG8_LDA(At, 0, 1); PG8_STAGE(PG8_SA(0, 0), a2, voffA);
            PG8_BAR; PG8_WAIT_L(0); PG8_MMA(1, 0, At, B0); PG8_BAR; PG8_SCHED;
            PG8_STAGE(PG8_SB(0, 1), b2 + hstep, voffB);
            PG8_WAIT_V(6); PG8_BAR; PG8_MMA(1, 1, At, B1); PG8_BAR;
            PG8_LDB(B0, 1, 0); PG8_SCHED; PG8_LDA(At, 1, 0); PG8_STAGE(PG8_SA(0, 1), a2 + hstep, voffA);
            PG8_WAIT_L(8); PG8_BAR; PG8_WAIT_L(0); PG8_MMA(0, 0, At, B0); PG8_BAR; PG8_SCHED;
            PG8_LDB(B1, 1, 1); PG8_STAGE(PG8_SB(1, 0), b3, voffB);
            PG8_BAR; PG8_WAIT_L(0); PG8_MMA(0, 1, At, B1); PG8_BAR;
            PG8_LDA(At, 1, 1); PG8_STAGE(PG8_SA(1, 0), a3, voffA);
            PG8_BAR; PG8_WAIT_L(0); PG8_MMA(1, 0, At, B0); PG8_BAR; PG8_SCHED;
            PG8_STAGE(PG8_SB(1, 1), b3 + hstep, voffB);
            PG8_WAIT_V(6); PG8_BAR; PG8_MMA(1, 1, At, B1); PG8_BAR;
            }
        }
        if constexpr (ALIGN_EPI) { if (wr == 0) PG8_BAR; }
        if constexpr (!Epi::AFTER_DRAIN) { E(acc, cur, wr, wc, fr, fq); S.done(cur); }
        if (!has_next) break;
#pragma unroll
        for (int a = 0; a < 2; ++a)
#pragma unroll
            for (int b = 0; b < 2; ++b)
#pragma unroll
                for (int m = 0; m < 4; ++m)
#pragma unroll
                    for (int n = 0; n < 2; ++n) acc[a][b][m][n] = (f32x4){0.f, 0.f, 0.f, 0.f};
        cur = nxt; cA = nA; cB = nB; ++ui;
        if constexpr (ALIGN_EPI) { if (wr == 1) PG8_BAR; }
    }
    PG8_WAIT_V(0);
    if constexpr (!ALIGN_EPI) { if (wr == 0) PG8_BAR; }
    PG8_BAR;
    if constexpr (Epi::AFTER_DRAIN) { E.fused(acc, cur, wr, wc, fr, fq, lds, wid, lane); S.done(cur); }
#undef PG8_SA
#undef PG8_SB
#undef PG8_STAGE
#undef PG8_LDA
#undef PG8_LDB
#undef PG8_MMA
#undef PG8_WAIT_V
#undef PG8_WAIT_L
#undef PG8_BAR
#undef PG8_SCHED
}
}

namespace hy {
#define GAS __attribute__((address_space(1)))
#define LAS __attribute__((address_space(3)))
typedef unsigned short bf16;
typedef unsigned v4u __attribute__((ext_vector_type(4)));
typedef float f32x4 __attribute__((ext_vector_type(4)));
typedef short bf16x8 __attribute__((ext_vector_type(8)));
typedef GAS unsigned gu32;
typedef GAS unsigned long long gu64;
#define RLX_AGENT __ATOMIC_RELAXED, __HIP_MEMORY_SCOPE_AGENT
#define LDS_WAIT() asm volatile("s_waitcnt lgkmcnt(0)" ::: "memory")
#define VM_WAIT() asm volatile("s_waitcnt vmcnt(0)" ::: "memory")
__device__ __forceinline__ unsigned long long rt() { return __builtin_amdgcn_s_memrealtime(); }
typedef __bf16 hwbf2 __attribute__((ext_vector_type(2))); typedef float hwf2 __attribute__((ext_vector_type(2)));
__device__ __forceinline__ unsigned f2bf(float f) { return (unsigned)__builtin_bit_cast(unsigned short, (__bf16)f); }
__device__ __forceinline__ unsigned pk2(float lo, float hi) { const hwf2 v = {lo, hi}; return __builtin_bit_cast(unsigned, __builtin_convertvector(v, hwbf2)); }
#define XB_TMO      128
#define XB_XCNT(j)  (256  + 64 * (j))
#define XB_XSUB(j)  (1280 + 64 * (j))
#define XB_XGEN(j)  (2304 + 64 * (j))
#define XB_TOP      3328
#define XB_TOPGEN   3392
#define XCD_BAR_WORDS 3456
#define XB_SPIN_CAP (1u << 18)

__device__ __forceinline__ unsigned xb_ld(unsigned* p)              { return __hip_atomic_load(p, __ATOMIC_RELAXED, __HIP_MEMORY_SCOPE_AGENT); }
__device__ __forceinline__ unsigned xb_add(unsigned* p, unsigned v) { return __hip_atomic_fetch_add(p, v, __ATOMIC_RELAXED, __HIP_MEMORY_SCOPE_AGENT); }
__device__ __forceinline__ unsigned xb_xcc_id() { return (unsigned)__builtin_amdgcn_s_getreg((3 << 11) | 20) & 0xFu; }
#define XB_SPIN(cond, bar) do { unsigned _sp = 0; while (cond) { __builtin_amdgcn_s_sleep(1); \
    if ((++_sp & 255u) == 0u) { if (xb_ld(&(bar)[XB_TMO])) break; if (_sp > XB_SPIN_CAP) { atomicAdd(&(bar)[XB_TMO], 1u); break; } } } } while (0)

struct XcdBarrier {
    unsigned* bar; unsigned x;
    volatile LAS unsigned* st;
};

__device__ __forceinline__ XcdBarrier xcd_barrier_post(unsigned* bar, volatile LAS unsigned* st) {
    XcdBarrier b; b.bar = bar; b.x = xb_xcc_id(); b.st = st;
    if (threadIdx.x == 0) (void)xb_add(&bar[XB_XCNT(b.x)], 1u);
    return b;
}
__device__ __forceinline__ void xcd_barrier_complete(unsigned* bar, unsigned x, unsigned& nloc, unsigned& nx) {
    const unsigned G = gridDim.x * gridDim.y * gridDim.z;
    unsigned sum, cnt, mine, sp = 0u;
    for (;;) {
        sum = 0u; cnt = 0u; mine = 0u;
#pragma unroll
        for (unsigned j = 0; j < 16; ++j) { const unsigned c = xb_ld(&bar[XB_XCNT(j)]); sum += c; cnt += (c > 0u) ? 1u : 0u; mine = (j == x) ? c : mine; }
        if (sum == G) break;
        __builtin_amdgcn_s_sleep(1);
        if ((++sp & 255u) == 0u) { if (xb_ld(&bar[XB_TMO])) break; if (sp > XB_SPIN_CAP) { atomicAdd(&bar[XB_TMO], 1u); break; } }
    }
    nloc = mine > 0u ? mine : 1u; nx = cnt > 0u ? cnt : 1u;
}

__device__ __forceinline__ void xcd_barrier(const XcdBarrier& b) {
    asm volatile("s_waitcnt vmcnt(0)" ::: "memory");
    __syncthreads();
    if (threadIdx.x == 0) {
        unsigned* bar = b.bar;
        __builtin_amdgcn_s_waitcnt(0);
        unsigned nloc = b.st[0], nx = b.st[1];
        if (nloc == 0u) { xcd_barrier_complete(bar, b.x, nloc, nx); b.st[0] = nloc; b.st[1] = nx; }
        const unsigned old = xb_add(&bar[XB_XSUB(b.x)], 1u);
        const unsigned gen = old / nloc;
        if (old + 1u == (gen + 1u) * nloc) {
            __builtin_amdgcn_fence(__ATOMIC_RELEASE, "agent");
            asm volatile("s_waitcnt vmcnt(0)" ::: "memory");
            const unsigned og = xb_add(&bar[XB_TOP], 1u);
            const unsigned tg = og / nx;
            if (og + 1u == (tg + 1u) * nx) xb_add(&bar[XB_TOPGEN], 1u);
            else XB_SPIN(xb_ld(&bar[XB_TOPGEN]) == tg, bar);
            __builtin_amdgcn_fence(__ATOMIC_ACQUIRE, "agent");
            xb_add(&bar[XB_XGEN(b.x)], 1u);
            asm volatile("s_waitcnt vmcnt(0)" ::: "memory");
        } else {
            XB_SPIN(xb_ld(&bar[XB_XGEN(b.x)]) == gen, bar);
            __builtin_amdgcn_fence(__ATOMIC_ACQUIRE, "agent");
            asm volatile("s_waitcnt vmcnt(0)" ::: "memory");
        }
    }
    __syncthreads();
}

constexpr int B_ = 4, T_ = 8192, D_ = 1024, M_ = B_ * T_, L_ = 2;
constexpr int NIN = 3584, NPG = 1792, NPR = 1792;
constexpr int DFF = 2816, NUP = 5632, IN_COLS = 3344;
constexpr size_t MiB = 1u << 20;
constexpr size_t WS_CTL = 0, CTL_ZERO_BYTES = 65536;
constexpr int CW_BAR = 4096;
constexpr size_t WS_RK = MiB / 4;
constexpr size_t WS_MOD = 3 * MiB / 2;
constexpr size_t WS_WIN = 2 * MiB, WS_WOUT = 9 * MiB, WS_WUP = 11 * MiB, WS_WDN = 22 * MiB, WS_LORA = 55 * MiB / 2, WS_GAMC = 28 * MiB, WS_VL = 29 * MiB;
constexpr size_t WS_GAM = 31 * MiB;
constexpr size_t WS_XB = 32 * MiB, WS_O = 96 * MiB, WS_VF = 160 * MiB, WS_GK = 192 * MiB, WS_PG = 224 * MiB, WS_PR = 336 * MiB, WS_END = 512 * MiB;
constexpr size_t WS_RH = WS_XB, WS_YH = WS_XB + 32 * MiB, WS_PP = WS_O, WS_QQ = WS_O + 32 * MiB, WS_GG = 448 * MiB, WS_S0 = 480 * MiB;
constexpr size_t WS_ACT = 224 * MiB, WS_U = 400 * MiB;
constexpr int RING_BYTES = 131072, MISC_OFF = 141312, LDS_BYTES = 147456;
constexpr int NT = 512;

__device__ __forceinline__ float bf2f(bf16 h) { return __builtin_bit_cast(float, (unsigned)h << 16); }
__device__ __forceinline__ float sigmoidf_(float x) { return 1.f / (1.f + __expf(-x)); }
__device__ __forceinline__ float siluf_(float x) { return x / (1.f + __expf(-x)); }
__device__ __forceinline__ float softplusf_(float x) { return fmaxf(x, 0.f) + log1pf(__expf(-fabsf(x))); }

typedef unsigned u32x2 __attribute__((ext_vector_type(2)));
template <int CTRL> __device__ __forceinline__ float dpp_f(float v) {
    return __builtin_bit_cast(float, __builtin_amdgcn_update_dpp(0, __builtin_bit_cast(int, v), CTRL, 0xf, 0xf, false));
}
__device__ __forceinline__ float wave_sum(float v) {
    v += dpp_f<0xB1>(v);
    v += dpp_f<0x4E>(v);
    v += dpp_f<0x141>(v);
    v += dpp_f<0x140>(v);
    v += __builtin_bit_cast(float, __builtin_amdgcn_update_dpp(0, __builtin_bit_cast(int, v), 0x142, 0xa, 0xf, false));
    v += __builtin_bit_cast(float, __builtin_amdgcn_update_dpp(0, __builtin_bit_cast(int, v), 0x143, 0xc, 0xf, false));
    return __builtin_bit_cast(float, __builtin_amdgcn_readlane(__builtin_bit_cast(int, v), 63));
}

struct Ctx { int bid, nb, tid, lane, wave; LAS unsigned char* lds; };

__device__ __forceinline__ void ph_mod(const Ctx& C, const float* c, const float* ada_w, const float* ada_b, float* MOD) {
    LAS float* sc = (LAS float*)C.lds;
    LAS float* red = (LAS float*)(C.lds + 16384);
    for (int i = C.tid; i < 4096; i += NT) sc[i] = siluf_(c[i]);
    __syncthreads();
    for (int item = C.bid; item < 192; item += C.nb) {
        const int l = item / 96, j0 = (item % 96) * 64;
        const float* W = ada_w + (size_t)l * 1024 * 6144 + j0 + C.lane;
        float a0 = 0.f, a1 = 0.f, a2 = 0.f, a3 = 0.f;
        for (int k = C.wave * 128; k < C.wave * 128 + 128; ++k) { const float wv = W[(size_t)k * 6144]; a0 += sc[k] * wv; a1 += sc[1024 + k] * wv; a2 += sc[2048 + k] * wv; a3 += sc[3072 + k] * wv; }
        red[(C.wave * 4 + 0) * 64 + C.lane] = a0; red[(C.wave * 4 + 1) * 64 + C.lane] = a1; red[(C.wave * 4 + 2) * 64 + C.lane] = a2; red[(C.wave * 4 + 3) * 64 + C.lane] = a3;
        __syncthreads();
        if (C.wave < 4) { const int b = C.wave; float s = ada_b[l * 6144 + j0 + C.lane];
#pragma unroll
            for (int w = 0; w < 8; ++w) s += red[(w * 4 + b) * 64 + C.lane];
            MOD[((size_t)l * 4 + b) * 6144 + j0 + C.lane] = s; }
        __syncthreads();
    }
}

__device__ __forceinline__ void wprep_mat(const Ctx& C, const float* W, int K, int Nsrc, int Ndst, bf16* Wt, int mode, const float* vres) {
    const int half = C.tid >> 8, t = C.tid & 255, tx = t & 31, ty = t >> 5;
    LAS float* tile = (LAS float*)C.lds + half * (32 * 33);
    const int nbn = Ndst / 32, ntile = nbn * (K / 32);
    const int niter = (ntile + 2 * C.nb - 1) / (2 * C.nb);
    for (int it = 0; it < niter; ++it) {
        const int item = (it * C.nb + C.bid) * 2 + half;
        const bool act = item < ntile;
        const int n0 = (item % nbn) * 32, k0 = (item / nbn) * 32, n = n0 + tx;
        if (act) {
#pragma unroll
            for (int i = 0; i < 4; ++i) { const int k = k0 + ty + 8 * i; float v = 0.f;
                if (mode == 0) v = W[(size_t)k * Nsrc + n];
                else if (mode == 2) { const int tl = n >> 8, w = n & 255; v = W[(size_t)k * Nsrc + (w < 128 ? tl * 128 + w : 2816 + tl * 128 + (w - 128))]; }
                else { if (n < 1552) v = W[(size_t)k * Nsrc + n]; else if (n < 1584) v = vres ? vres[(size_t)k * 32 + (n - 1552)] : 0.f; else if (n < 1792) v = 0.f; else v = W[(size_t)k * Nsrc + (n - 240)]; }
                tile[(ty + 8 * i) * 33 + tx] = v; }
        }
        __syncthreads();
        if (act) {
#pragma unroll
            for (int i = 0; i < 4; ++i) { const int nn = n0 + ty + 8 * i; Wt[(size_t)nn * K + k0 + tx] = (bf16)f2bf(tile[tx * 33 + ty + 8 * i]); }
        }
        __syncthreads();
    }
}

__device__ __forceinline__ void ph_norm(const Ctx& C, const float* x, const float* g, const float* sh, const float* sc, bf16* XB) {
    const int gw = C.bid * 8 + C.wave, NGW = C.nb * 8, lane = C.lane;
    for (int m = gw; m < M_; m += NGW) {
        const int b = m / T_;
        const f32x4* xr = (const f32x4*)(x + (size_t)m * D_) + lane;
        f32x4 v[4]; float s = 0.f;
#pragma unroll
        for (int j = 0; j < 4; ++j) { v[j] = xr[64 * j]; s += (v[j].x * v[j].x + v[j].y * v[j].y) + (v[j].z * v[j].z + v[j].w * v[j].w); }
        const float rstd = 1.f / sqrtf(wave_sum(s) * (1.f / D_) + 1e-6f);
        unsigned long long* o8 = (unsigned long long*)(XB + (size_t)m * D_) + lane;
#pragma unroll
        for (int j = 0; j < 4; ++j) { const int col = 4 * lane + 256 * j;
            const f32x4 gv = *(const f32x4*)(g + col), shv = *(const f32x4*)(sh + b * 6144 + col), scv = *(const f32x4*)(sc + b * 6144 + col);
            const f32x4 h = v[j] * rstd * gv * (scv + 1.f) + shv;
            o8[64 * j] = (unsigned long long)pk2(h.x, h.y) | ((unsigned long long)pk2(h.z, h.w) << 32); }
    }
}
__device__ __forceinline__ void ph_final(const Ctx& C, float* x, const float* g) {
    const int gw = C.bid * 8 + C.wave, NGW = C.nb * 8, lane = C.lane;
    for (int m = gw; m < M_; m += NGW) {
        f32x4* xr = (f32x4*)(x + (size_t)m * D_) + lane;
        f32x4 v[4]; float s = 0.f;
#pragma unroll
        for (int j = 0; j < 4; ++j) { v[j] = xr[64 * j]; s += (v[j].x * v[j].x + v[j].y * v[j].y) + (v[j].z * v[j].z + v[j].w * v[j].w); }
        const float rstd = 1.f / sqrtf(wave_sum(s) * (1.f / D_) + 1e-6f);
#pragma unroll
        for (int j = 0; j < 4; ++j) { const f32x4 gv = *(const f32x4*)(g + 4 * lane + 256 * j); xr[64 * j] = v[j] * rstd * gv; }
    }
}


typedef short s16x8 __attribute__((ext_vector_type(8)));
__device__ __forceinline__ f32x4 mm16(const LAS bf16* A, int lda, const LAS bf16* B, int ldb, int K, f32x4 acc, int lane) {
    const int r = lane & 15, g = lane >> 4;
    const LAS bf16* ap = A + r * lda + 8 * g; const LAS bf16* bp = B + r * ldb + 8 * g;
    for (int k0 = 0; k0 < K; k0 += 32) { const s16x8 a = *(const LAS s16x8*)(ap + k0); const s16x8 b = *(const LAS s16x8*)(bp + k0); acc = __builtin_amdgcn_mfma_f32_16x16x32_bf16(a, b, acc, 0, 0, 0); }
    return acc;
}
__device__ __forceinline__ f32x4 mm16_ga(const bf16* A, int lda, const LAS bf16* B, int ldb, int K, f32x4 acc, int lane) {
    const int r = lane & 15, g = lane >> 4;
    const bf16* ap = A + r * lda + 8 * g; const LAS bf16* bp = B + r * ldb + 8 * g;
    for (int k0 = 0; k0 < K; k0 += 32) { const s16x8 a = *(const s16x8*)(ap + k0); const s16x8 b = *(const LAS s16x8*)(bp + k0); acc = __builtin_amdgcn_mfma_f32_16x16x32_bf16(a, b, acc, 0, 0, 0); }
    return acc;
}
__device__ __forceinline__ unsigned long long pack4(f32x4 v) { return (unsigned long long)pk2(v.x, v.y) | ((unsigned long long)pk2(v.z, v.w) << 32); }
__device__ __forceinline__ float logsigmoidf_(float x) { return fminf(x, 0.f) - __logf(1.f + __expf(-fabsf(x))); }

constexpr int GL_LD = 72;
constexpr int GL_GK = 0;
constexpr int GL_SEG = 16384;
constexpr int GL_Z = 18432;
constexpr int GL_GUP = 20480;
constexpr int GL_I0 = 24832;
constexpr int GL_I1 = GL_I0 + 9216;
constexpr int GL_I2 = GL_I1 + 9216;
constexpr int GL_VT = GL_I2 + 9216;
constexpr int GL_SSQ = GL_VT + 18432;
static_assert(GL_SSQ + 512 <= RING_BYTES, "GLA LDS map");

__device__ __forceinline__ void gla_gates(const Ctx& C, const bf16* pg  , const float* gk_up, const float* gk_b, int h) {
    LAS float* GK = (LAS float*)(C.lds + GL_GK); LAS float* SEG = (LAS float*)(C.lds + GL_SEG); LAS bf16* Z = (LAS bf16*)(C.lds + GL_Z); LAS float* GUP = (LAS float*)(C.lds + GL_GUP);
    const int tid = C.tid;
    if (tid < 128) { const int t = tid >> 1, hh = tid & 1; *(LAS v4u*)(Z + t * 16 + hh * 8) = *(const v4u*)(pg + (size_t)t * NPG + 1536 + hh * 8); }
    for (int i = tid; i < 16 * 64; i += NT) GUP[i] = gk_up[(i >> 6) * 256 + h * 64 + (i & 63)];
    if (tid < 64) GUP[1024 + tid] = gk_b[h * 64 + tid];
    __syncthreads();
    { const int t = tid >> 3, d0 = (tid & 7) * 8; float a[8];
#pragma unroll
      for (int q = 0; q < 8; ++q) a[q] = GUP[1024 + d0 + q];
#pragma unroll
      for (int i = 0; i < 16; ++i) { const float zv = bf2f(Z[t * 16 + i]);
#pragma unroll
          for (int q = 0; q < 8; ++q) a[q] += zv * GUP[i * 64 + d0 + q]; }
#pragma unroll
      for (int q = 0; q < 8; ++q) GK[t * 64 + d0 + q] = logsigmoidf_(a[q]) * (1.f / 16.f); }
    __syncthreads();
    { const int d = tid & 63, seg = tid >> 6; float run = 0.f;
#pragma unroll
      for (int q = 0; q < 8; ++q) { run += GK[(seg * 8 + q) * 64 + d]; GK[(seg * 8 + q) * 64 + d] = run; }
      SEG[seg * 64 + d] = run; }
    __syncthreads();
    { const int d = tid & 63, seg = tid >> 6; float off = 0.f;
      for (int s = 0; s < seg; ++s) off += SEG[s * 64 + d];
#pragma unroll
      for (int q = 0; q < 8; ++q) GK[(seg * 8 + q) * 64 + d] += off; }
    __syncthreads();
}
__device__ __forceinline__ void gla_stage_vt(const Ctx& C, const bf16* pg, int h) {
    LAS bf16* VT = (LAS bf16*)(C.lds + GL_VT);
    const int j = C.tid >> 3, e0 = (C.tid & 7) * 16;
    const v4u x0 = *(const v4u*)(pg + (size_t)j * NPG + 512 + h * 128 + e0), x1 = *(const v4u*)(pg + (size_t)j * NPG + 512 + h * 128 + e0 + 8);
    const unsigned w[8] = {x0.x, x0.y, x0.z, x0.w, x1.x, x1.y, x1.z, x1.w};
#pragma unroll
    for (int q = 0; q < 8; ++q) { VT[(e0 + 2 * q) * GL_LD + j] = (bf16)(w[q] & 0xffffu); VT[(e0 + 2 * q + 1) * GL_LD + j] = (bf16)(w[q] >> 16); }
}

__device__ __forceinline__ void ph_gla_a(const Ctx& C, const bf16* PG, const float* gk_up, const float* gk_b, bf16* DS, float* GAM, bf16* VL) {
    LAS float* GK = (LAS float*)(C.lds + GL_GK); LAS bf16* KT = (LAS bf16*)(C.lds + GL_I0); LAS bf16* VT = (LAS bf16*)(C.lds + GL_VT);
    for (int item = C.bid; item < 2048; item += C.nb) {
        const int bh = item >> 7, c = item & 127, b = bh >> 2, h = bh & 3;
        const size_t m0 = (size_t)b * T_ + c * 64;
        const bf16* pg = PG + m0 * NPG;
        gla_gates(C, pg, gk_up, gk_b, h);
        { const int j = C.tid >> 3, d0 = (C.tid & 7) * 8;
          const v4u kx = *(const v4u*)(pg + (size_t)j * NPG + 256 + h * 64 + d0);
          const unsigned w[4] = {kx.x, kx.y, kx.z, kx.w};
#pragma unroll
          for (int q = 0; q < 4; ++q) { const float k0 = bf2f((bf16)(w[q] & 0xffffu)), k1 = bf2f((bf16)(w[q] >> 16));
              const int d = d0 + 2 * q;
              KT[d * GL_LD + j] = (bf16)f2bf(k0 * __expf(GK[63 * 64 + d] - GK[j * 64 + d]));
              KT[(d + 1) * GL_LD + j] = (bf16)f2bf(k1 * __expf(GK[63 * 64 + d + 1] - GK[j * 64 + d + 1])); } }
        gla_stage_vt(C, pg, h);
        if (C.tid < 64) GAM[(size_t)item * 64 + C.tid] = __expf(GK[63 * 64 + C.tid]);
        if (h == 0 && C.tid < 256) { const int t = C.tid >> 2, q = C.tid & 3; *(unsigned long long*)(VL + (m0 + t) * 32 + q * 8 + 0) = *(const unsigned long long*)(pg + (size_t)t * NPG + 1552 + q * 8);
                                     *(unsigned long long*)(VL + (m0 + t) * 32 + q * 8 + 4) = *(const unsigned long long*)(pg + (size_t)t * NPG + 1552 + q * 8 + 4); }
        __syncthreads();
        { const int n0 = C.wave * 16, lane = C.lane, cc = lane & 15, g = lane >> 4;
          bf16* out = DS + (size_t)item * 8192 + (size_t)(n0 + cc) * 64 + 4 * g;
#pragma unroll
          for (int mt = 0; mt < 4; ++mt) { f32x4 acc = {0.f, 0.f, 0.f, 0.f}; acc = mm16(KT + mt * 16 * GL_LD, GL_LD, VT + n0 * GL_LD, GL_LD, 64, acc, lane);
              *(unsigned long long*)(out + mt * 16) = pack4(acc); } }
        __syncthreads();
    }
}
__device__ __forceinline__ void ph_gla_b(const Ctx& C, bf16* DS, const float* GAM) {
    for (int idx = C.bid * NT + C.tid; idx < 16 * 8192; idx += C.nb * NT) {
        const int bh = idx >> 13, ed = idx & 8191, d = ed & 63;
        bf16* p = DS + (size_t)bh * 128 * 8192 + ed; const float* gp = GAM + (size_t)bh * 128 * 64 + d;
        float S = 0.f;
        for (int c0 = 0; c0 < 128; c0 += 8) {
            float ds[8], gm[8];
#pragma unroll
            for (int i = 0; i < 8; ++i) { ds[i] = bf2f(p[(size_t)(c0 + i) * 8192]); gm[i] = gp[(c0 + i) * 64]; }
#pragma unroll
            for (int i = 0; i < 8; ++i) { const float gs = gm[i] * S; p[(size_t)(c0 + i) * 8192] = (bf16)f2bf(gs); S = gs + ds[i]; }
        }
    }
}
__device__ __forceinline__ void ph_gla_c(const Ctx& C, const bf16* PG, const float* gk_up, const float* gk_b, const float* norm_g, const bf16* DS, bf16* O) {
    LAS float* GK = (LAS float*)(C.lds + GL_GK); LAS bf16* QP = (LAS bf16*)(C.lds + GL_I0); LAS bf16* KM = (LAS bf16*)(C.lds + GL_I1); LAS bf16* AI = (LAS bf16*)(C.lds + GL_I2);
    LAS bf16* VT = (LAS bf16*)(C.lds + GL_VT); LAS float* SSQ = (LAS float*)(C.lds + GL_SSQ);
    for (int item = C.bid; item < 2048; item += C.nb) {
        const int bh = item >> 7, c = item & 127, b = bh >> 2, h = bh & 3;
        const size_t m0 = (size_t)b * T_ + c * 64;
        const bf16* pg = PG + m0 * NPG;
        gla_gates(C, pg, gk_up, gk_b, h);
        { const int j = C.tid >> 3, d0 = (C.tid & 7) * 8;
          const v4u qx = *(const v4u*)(pg + (size_t)j * NPG + h * 64 + d0), kx = *(const v4u*)(pg + (size_t)j * NPG + 256 + h * 64 + d0);
          const unsigned qw[4] = {qx.x, qx.y, qx.z, qx.w}, kw[4] = {kx.x, kx.y, kx.z, kx.w};
          unsigned qo[4], ko[4];
#pragma unroll
          for (int q = 0; q < 4; ++q) { const int d = d0 + 2 * q;
              const float e0 = GK[63 * 64 + d] - GK[j * 64 + d], e1 = GK[63 * 64 + d + 1] - GK[j * 64 + d + 1];
              const float q0 = 0.125f * bf2f((bf16)(qw[q] & 0xffffu)) * __expf(-e0), q1 = 0.125f * bf2f((bf16)(qw[q] >> 16)) * __expf(-e1);
              const float k0 = bf2f((bf16)(kw[q] & 0xffffu)) * __expf(e0), k1 = bf2f((bf16)(kw[q] >> 16)) * __expf(e1);
              qo[q] = pk2(q0, q1); ko[q] = pk2(k0, k1); }
          *(LAS v4u*)(QP + j * GL_LD + d0) = (v4u){qo[0], qo[1], qo[2], qo[3]}; *(LAS v4u*)(KM + j * GL_LD + d0) = (v4u){ko[0], ko[1], ko[2], ko[3]}; }
        gla_stage_vt(C, pg, h);
        __syncthreads();
        { const int lane = C.lane, cc = lane & 15, g = lane >> 4, n0 = (C.wave >> 1) * 16;
#pragma unroll
          for (int q = 0; q < 2; ++q) { const int mt0 = ((C.wave & 1) * 2 + q) * 16; f32x4 acc = {0.f, 0.f, 0.f, 0.f};
              acc = mm16(KM + mt0 * GL_LD, GL_LD, QP + n0 * GL_LD, GL_LD, 64, acc, lane);
              const int i = n0 + cc, j = mt0 + 4 * g;
              acc.x = (j + 0 <= i) ? acc.x : 0.f; acc.y = (j + 1 <= i) ? acc.y : 0.f; acc.z = (j + 2 <= i) ? acc.z : 0.f; acc.w = (j + 3 <= i) ? acc.w : 0.f;
              *(LAS unsigned long long*)(AI + (n0 + cc) * GL_LD + mt0 + 4 * g) = pack4(acc); } }
        __syncthreads();
        { const int lane = C.lane, cc = lane & 15, g = lane >> 4, n0 = (C.wave & 3) * 16, eh = C.wave >> 2;
          const bf16* Sg = DS + (size_t)item * 8192;
          f32x4 acc[4]; float ss = 0.f;
#pragma unroll
          for (int mt = 0; mt < 4; ++mt) { const int e0 = eh * 64 + mt * 16; acc[mt] = (f32x4){0.f, 0.f, 0.f, 0.f};
              acc[mt] = mm16_ga(Sg + (size_t)e0 * 64, 64, QP + n0 * GL_LD, GL_LD, 64, acc[mt], lane);
              acc[mt] = mm16(VT + e0 * GL_LD, GL_LD, AI + n0 * GL_LD, GL_LD, 64, acc[mt], lane);
              ss += (acc[mt].x * acc[mt].x + acc[mt].y * acc[mt].y) + (acc[mt].z * acc[mt].z + acc[mt].w * acc[mt].w); }
          ss += __shfl_xor(ss, 16); ss += __shfl_xor(ss, 32);
          if (g == 0) SSQ[eh * 64 + n0 + cc] = ss;
          __syncthreads();
          const float rstd = 1.f / sqrtf((SSQ[n0 + cc] + SSQ[64 + n0 + cc]) * (1.f / 128.f) + 1e-6f);
          const size_t m = m0 + n0 + cc;
#pragma unroll
          for (int mt = 0; mt < 4; ++mt) { const int e = eh * 64 + mt * 16 + 4 * g;
              const unsigned long long gx = *(const unsigned long long*)(pg + (size_t)(n0 + cc) * NPG + 1024 + h * 128 + e);
              const f32x4 ng = *(const f32x4*)(norm_g + e);
              f32x4 o;
              o.x = acc[mt].x * rstd * ng.x * siluf_(bf2f((bf16)(gx & 0xffffu)));
              o.y = acc[mt].y * rstd * ng.y * siluf_(bf2f((bf16)((gx >> 16) & 0xffffu)));
              o.z = acc[mt].z * rstd * ng.z * siluf_(bf2f((bf16)((gx >> 32) & 0xffffu)));
              o.w = acc[mt].w * rstd * ng.w * siluf_(bf2f((bf16)(gx >> 48)));
              *(unsigned long long*)(O + m * D_ + h * 128 + e) = pack4(o); } }
        __syncthreads();
    }
}


struct RwkvW { const float *mu, *mu_vres, *w0, *a0, *v0, *k_k, *k_a, *r_k; const bf16 *wupT, *aupT, *gupT, *vupT; };
constexpr int RW_LD = 72, RW_XLD = 296, RW_FLD = 68;
constexpr int RW_R0 = 0;
constexpr int RW_SEG = 16384;
constexpr int RW_R1 = 37888;
constexpr int RW_R2 = RW_R1 + 27648;
constexpr int RW_R3 = RW_R2 + 9216;
constexpr int RW_R4 = RW_R3 + 27648;
constexpr int RW_TI = RW_R4 + 128 * RW_FLD * 4;
constexpr int RW_MU = RW_TI + 2048;
constexpr int RW_END = RW_MU + 2048;
static_assert(RW_END <= MISC_OFF, "RWKV LDS map");

typedef short s16x4 __attribute__((ext_vector_type(4)));
__device__ __forceinline__ float tanh_fast(float x) { const float e = __expf(2.f * x); return 1.f - 2.f / (e + 1.f); }
__device__ __forceinline__ float softplus_fast(float x) { return fmaxf(x, 0.f) + __logf(1.f + __expf(-fabsf(x))); }
__device__ __forceinline__ s16x4 cvt4(f32x4 v) { const unsigned long long p = pack4(v); return __builtin_bit_cast(s16x4, p); }
__device__ __forceinline__ void ld8f(const float* p, float (&o)[8]) { const f32x4 a = *(const f32x4*)p, b = *(const f32x4*)(p + 4); o[0] = a.x; o[1] = a.y; o[2] = a.z; o[3] = a.w; o[4] = b.x; o[5] = b.y; o[6] = b.z; o[7] = b.w; }
__device__ __forceinline__ float sum8(float v) { v += dpp_f<0xB1>(v); v += dpp_f<0x4E>(v); v += dpp_f<0x141>(v); return v; }
__device__ __forceinline__ void unpack8(const v4u x, float (&o)[8]) {
    o[0] = bf2f((bf16)(x.x & 0xffffu)); o[1] = bf2f((bf16)(x.x >> 16)); o[2] = bf2f((bf16)(x.y & 0xffffu)); o[3] = bf2f((bf16)(x.y >> 16));
    o[4] = bf2f((bf16)(x.z & 0xffffu)); o[5] = bf2f((bf16)(x.z >> 16)); o[6] = bf2f((bf16)(x.w & 0xffffu)); o[7] = bf2f((bf16)(x.w >> 16)); }
__device__ __forceinline__ v4u pack8(const float (&o)[8]) { return (v4u){pk2(o[0], o[1]), pk2(o[2], o[3]), pk2(o[4], o[5]), pk2(o[6], o[7])}; }
__device__ __forceinline__ f32x4 mm16_gb(const LAS bf16* A, int lda, const bf16* B, int ldb, int K, f32x4 acc, int lane) {
    const int r = lane & 15, g = lane >> 4;
    const LAS bf16* ap = A + r * lda + 8 * g; const bf16* bp = B + r * ldb + 8 * g;
    for (int k0 = 0; k0 < K; k0 += 32) { const s16x8 a = *(const LAS s16x8*)(ap + k0); const s16x8 b = *(const s16x8*)(bp + k0); acc = __builtin_amdgcn_mfma_f32_16x16x32_bf16(a, b, acc, 0, 0, 0); }
    return acc;
}

__device__ __forceinline__ void ph_rwkv_a(const Ctx& C, const bf16* PR, const bf16* VL  , const RwkvW& W, int layer,
                                          bf16* PP, bf16* QQ, bf16* RH, bf16* YH, float* GAMC, float* RK, bf16* GG, bf16* VF, bool store_v = true) {
    LAS unsigned char* L = C.lds;
    LAS bf16* X = (LAS bf16*)(L + RW_R0); LAS float* CUM = (LAS float*)(L + RW_R0); LAS float* SEG = (LAS float*)(L + RW_SEG);
    LAS bf16* NI = (LAS bf16*)(L + RW_R0), *AAK = NI + 64 * RW_LD, *ARB = AAK + 64 * RW_LD, *ARK = ARB + 64 * RW_LD;
    LAS bf16* PRE = (LAS bf16*)(L + RW_R1);
    LAS bf16* AT = (LAS bf16*)(L + RW_R1), *BT = AT + 64 * RW_LD, *KT = BT + 64 * RW_LD, *RT = (LAS bf16*)(L + RW_R2);
    LAS bf16* XB16 = (LAS bf16*)(L + RW_R1);
    LAS bf16* BHc = (LAS bf16*)(L + RW_R3), *KHc = BHc + 64 * RW_LD, *VTc = KHc + 64 * RW_LD;
    LAS float* XT = (LAS float*)(L + RW_R4); LAS bf16* TI = (LAS bf16*)(L + RW_TI);
    const int wave = C.wave;
    LAS float* MU = (LAS float*)(L + RW_MU);
    for (int i = C.tid; i < 288; i += NT) MU[i] = i < 256 ? W.mu[1536 + i] : (layer ? W.mu_vres[i - 256] : 0.f);
    __syncthreads();
    for (int item = C.bid; item < 4096; item += C.nb) {
        int tid_ = C.tid; asm volatile("" : "+v"(tid_));
        const int tid = tid_, lane = tid & 63, cc = lane & 15, g = lane >> 4;
        const int h = item & 7, c = (item >> 3) & 127, b = item >> 10;
        const size_t m0 = (size_t)b * T_ + c * 64;
        v4u xc[5], xp[5];
#pragma unroll
        for (int it = 0; it < 5; ++it) { const int idx = tid + it * NT; xc[it] = (v4u){0u, 0u, 0u, 0u}; xp[it] = xc[it];
            if (idx < 64 * 36) { const int t1 = idx / 36, q = idx % 36, col = q * 8; const size_t m1 = m0 + t1; const bool first1 = (c == 0 && t1 == 0);
                if (q < 32) { xc[it] = *(const v4u*)(PR + m1 * NPR + 1536 + col); if (!first1) xp[it] = *(const v4u*)(PR + (m1 - 1) * NPR + 1536 + col); }
                else if (layer) { xc[it] = *(const v4u*)(VL + m1 * NPG + 1552 + (col - 256)); if (!first1) xp[it] = *(const v4u*)(VL + (m1 - 1) * NPG + 1552 + (col - 256)); } } }
        const int t = tid >> 3, d0 = (tid & 7) * 8, ch = h * 64 + d0; const size_t m = m0 + t; const bool first = (c == 0 && t == 0);
        v4u rcx = *(const v4u*)(PR + m * NPR + ch), kcx = *(const v4u*)(PR + m * NPR + 512 + ch), vcx = *(const v4u*)(PR + m * NPR + 1024 + ch);
        v4u rpx = (v4u){0u, 0u, 0u, 0u}, kpx = rpx, vpx = rpx, vfx = rpx;
        if (!first) { rpx = *(const v4u*)(PR + (m - 1) * NPR + ch); kpx = *(const v4u*)(PR + (m - 1) * NPR + 512 + ch); vpx = *(const v4u*)(PR + (m - 1) * NPR + 1024 + ch); }
        if (layer) vfx = *(const v4u*)(VF + m * 512 + ch);
#pragma unroll
        for (int it = 0; it < 5; ++it) { const int idx = tid + it * NT;
            if (idx < 64 * 36) { const int t1 = idx / 36, q = idx % 36, col = q * 8;
                float cv[8], pv[8], mu[8]; unpack8(xc[it], cv); unpack8(xp[it], pv);
                { const f32x4 ma = *(const LAS f32x4*)(MU + col), mb = *(const LAS f32x4*)(MU + col + 4); mu[0] = ma.x; mu[1] = ma.y; mu[2] = ma.z; mu[3] = ma.w; mu[4] = mb.x; mu[5] = mb.y; mu[6] = mb.z; mu[7] = mb.w; }
#pragma unroll
                for (int i = 0; i < 8; ++i) { float p = cv[i] + (pv[i] - cv[i]) * mu[i]; if (q < 8) p = tanh_fast(p); else if (q >= 16 && q < 32) p = sigmoidf_(p); cv[i] = p; }
                *(LAS v4u*)(X + t1 * RW_XLD + col) = pack8(cv); } }
        __syncthreads();
        {
            const int lsel = wave >> 1;
            const bf16* WT = lsel == 0 ? W.wupT : lsel == 1 ? W.aupT : lsel == 2 ? W.gupT : W.vupT;
            const int Kl = lsel == 2 ? 128 : lsel == 3 ? 32 : 64, xoff = lsel == 0 ? 0 : lsel == 1 ? 64 : lsel == 2 ? 128 : 256;
            LAS bf16* outp = PRE + lsel * 64 * RW_LD;
            const bool live = (lsel != 3 || layer);
#pragma unroll
            for (int mq = 0; mq < 2; ++mq) { const int mt = (wave & 1) * 2 + mq;
                s16x8 af[4];
                const bf16* ap = WT + (size_t)(h * 64 + mt * 16 + cc) * Kl + 8 * g;
#pragma unroll
                for (int ks = 0; ks < 4; ++ks) af[ks] = (live && ks * 32 < Kl) ? *(const s16x8*)(ap + ks * 32) : (s16x8){0, 0, 0, 0, 0, 0, 0, 0};
#pragma unroll
                for (int nt = 0; nt < 4; ++nt) { f32x4 acc = {0.f, 0.f, 0.f, 0.f};
                    const LAS bf16* bp = X + (nt * 16 + cc) * RW_XLD + xoff + 8 * g;
#pragma unroll
                    for (int ks = 0; ks < 4; ++ks) if (ks * 32 < Kl) { const s16x8 bb = *(const LAS s16x8*)(bp + ks * 32); acc = __builtin_amdgcn_mfma_f32_16x16x32_bf16(af[ks], bb, acc, 0, 0, 0); }
                    *(LAS unsigned long long*)(outp + (nt * 16 + cc) * RW_LD + mt * 16 + 4 * g) = pack4(acc); } }
        }
        __syncthreads();
        float av[8], bv[8], kv[8], rv[8], lw[8], vv[8];
        {
            float rc[8], rp[8], kc[8], kp[8], vc[8], vp[8], pw[8], pa[8], pg_[8], pvg[8];
            unpack8(rcx, rc); unpack8(kcx, kc); unpack8(vcx, vc); unpack8(rpx, rp); unpack8(kpx, kp); unpack8(vpx, vp);
            unpack8(*(const LAS v4u*)(PRE + (0 * 64 + t) * RW_LD + d0), pw); unpack8(*(const LAS v4u*)(PRE + (1 * 64 + t) * RW_LD + d0), pa);
            unpack8(*(const LAS v4u*)(PRE + (2 * 64 + t) * RW_LD + d0), pg_); unpack8(*(const LAS v4u*)(PRE + (3 * 64 + t) * RW_LD + d0), pvg);
            float vf[8]; unpack8(vfx, vf);
            float ssq = 0.f, rks = 0.f, asg[8], gg[8];
            float mur[8], muk[8], muv[8], w0c[8], a0c[8], v0c[8], kkc[8], kac[8], rkc[8];
            ld8f(W.mu + ch, mur); ld8f(W.mu + 512 + ch, muk); ld8f(W.mu + 1024 + ch, muv); ld8f(W.w0 + ch, w0c); ld8f(W.a0 + ch, a0c);
            ld8f(W.k_k + ch, kkc); ld8f(W.k_a + ch, kac); ld8f(W.r_k + ch, rkc);
            if (layer) ld8f(W.v0 + ch, v0c);
#pragma unroll
            for (int i = 0; i < 8; ++i) {
                const float r = rc[i] + (rp[i] - rc[i]) * mur[i], k = kc[i] + (kp[i] - kc[i]) * muk[i]; float v = vc[i] + (vp[i] - vc[i]) * muv[i];
                lw[i] = -0.6065306597f * sigmoidf_(w0c[i] + pw[i]);
                asg[i] = sigmoidf_(a0c[i] + pa[i]);
                if (layer) v = v + (vf[i] - v) * sigmoidf_(v0c[i] + pvg[i]);
                const float kk = k * kkc[i]; ssq += kk * kk;
                kv[i] = k * (1.f + (asg[i] - 1.f) * kac[i]); rv[i] = r; vv[i] = v; gg[i] = pg_[i]; av[i] = kk;
                rks += r * kv[i] * rkc[i];
            }
            ssq = sum8(ssq); rks = sum8(rks);
            const float inv = 1.f / sqrtf(fmaxf(ssq, 1e-24f));
#pragma unroll
            for (int i = 0; i < 8; ++i) { const float kk = av[i] * inv; av[i] = -kk; bv[i] = kk * asg[i]; }
            if ((tid & 7) == 0) RK[m * 8 + h] = rks;
            *(v4u*)(GG + m * 512 + ch) = pack8(gg);
            if (store_v) *(v4u*)(VF + m * 512 + ch) = pack8(vv);
#pragma unroll
            for (int i = 0; i < 8; ++i) vv[i] = bf2f((bf16)f2bf(vv[i]));
        }
        __syncthreads();
#pragma unroll
        for (int i = 0; i < 8; ++i) CUM[t * 64 + d0 + i] = lw[i];
        __syncthreads();
        { const int d = tid & 63, seg = tid >> 6; float run = 0.f;
#pragma unroll
          for (int q = 0; q < 8; ++q) { run += CUM[(seg * 8 + q) * 64 + d]; CUM[(seg * 8 + q) * 64 + d] = run; }
          SEG[seg * 64 + d] = run; }
        __syncthreads();
        { const int d = tid & 63, seg = tid >> 6; float off = 0.f;
          for (int s = 0; s < seg; ++s) off += SEG[s * 64 + d];
#pragma unroll
          for (int q = 0; q < 8; ++q) CUM[(seg * 8 + q) * 64 + d] += off; }
        __syncthreads();
        {
            float at[8], bt[8], kt[8], rt[8];
#pragma unroll
            for (int i = 0; i < 8; ++i) { const float cu = CUM[t * 64 + d0 + i], cC = CUM[63 * 64 + d0 + i], en = __expf(-cu), ec = __expf(cC - cu);
                at[i] = av[i] * __expf(cu - lw[i]); bt[i] = bv[i] * en; kt[i] = kv[i] * en; rt[i] = rv[i] * __expf(cu);
                BHc[(d0 + i) * RW_LD + t] = (bf16)f2bf(bv[i] * ec); KHc[(d0 + i) * RW_LD + t] = (bf16)f2bf(kv[i] * ec); VTc[(d0 + i) * RW_LD + t] = (bf16)f2bf(vv[i]);
                XT[(d0 + i) * RW_FLD + t] = bf2f((bf16)f2bf(at[i]));
                if (t == 63) GAMC[(size_t)item * 64 + d0 + i] = __expf(cC); }
            *(LAS v4u*)(AT + t * RW_LD + d0) = pack8(at); *(LAS v4u*)(BT + t * RW_LD + d0) = pack8(bt); *(LAS v4u*)(KT + t * RW_LD + d0) = pack8(kt); *(LAS v4u*)(RT + t * RW_LD + d0) = pack8(rt);
        }
        __syncthreads();
        {
            const int msel = wave >> 1;
            const LAS bf16* As = (msel == 0 || msel == 2) ? BT : KT; const LAS bf16* Bs = (msel < 2) ? AT : RT;
            f32x4 accs[8];
#pragma unroll
            for (int q = 0; q < 8; ++q) { const int tile = (wave & 1) * 8 + q, mt = tile >> 2, nt = tile & 3; accs[q] = (f32x4){0.f, 0.f, 0.f, 0.f};
                accs[q] = mm16(As + mt * 16 * RW_LD, RW_LD, Bs + nt * 16 * RW_LD, RW_LD, 64, accs[q], lane);
                const int tt = nt * 16 + cc, s0 = mt * 16 + 4 * g, lim = (msel < 2) ? tt - 1 : tt;
                accs[q].x = (s0 + 0 <= lim) ? accs[q].x : 0.f; accs[q].y = (s0 + 1 <= lim) ? accs[q].y : 0.f; accs[q].z = (s0 + 2 <= lim) ? accs[q].z : 0.f; accs[q].w = (s0 + 3 <= lim) ? accs[q].w : 0.f; }
            __syncthreads();
            LAS bf16* outp = NI + msel * 64 * RW_LD;
#pragma unroll
            for (int q = 0; q < 8; ++q) { const int tile = (wave & 1) * 8 + q, mt = tile >> 2, nt = tile & 3;
                *(LAS unsigned long long*)(outp + (nt * 16 + cc) * RW_LD + mt * 16 + 4 * g) = pack4(accs[q]); }
        }
        __syncthreads();
        if (wave == 0) {
            const int blk = lane >> 4, col = lane & 15; float x[16];
#pragma unroll
            for (int tt = 0; tt < 16; ++tt) { float nr[16]; { float lo[8], hi[8]; unpack8(*(const LAS v4u*)(NI + (16 * blk + tt) * RW_LD + 16 * blk), lo); unpack8(*(const LAS v4u*)(NI + (16 * blk + tt) * RW_LD + 16 * blk + 8), hi);
#pragma unroll
                    for (int q = 0; q < 8; ++q) { nr[q] = lo[q]; nr[8 + q] = hi[q]; } }
                float a = (tt == col) ? 1.f : 0.f;
#pragma unroll
                for (int q = 0; q < tt; ++q) a += nr[q] * x[q];
                x[tt] = a; TI[(blk * 16 + tt) * 16 + col] = (bf16)f2bf(a); }
        } else {
            for (int tile = wave - 1; tile < 16; tile += 7) { const int mt = tile >> 2, nt = tile & 3;
                f32x4 acc = {0.f, 0.f, 0.f, 0.f}; acc = mm16(AAK + mt * 16 * RW_LD, RW_LD, VTc + nt * 16 * RW_LD, RW_LD, 64, acc, lane);
                *(LAS f32x4*)(XT + (64 + nt * 16 + cc) * RW_FLD + mt * 16 + 4 * g) = acc; }
        }
        __syncthreads();
        {
            s16x4 xb[4];
#pragma unroll
            for (int i = 0; i < 4; ++i) {
                f32x4 acc = *(const LAS f32x4*)(XT + (wave * 16 + cc) * RW_FLD + 16 * i + 4 * g);
#pragma unroll
                for (int k = 0; k < i; ++k) { const s16x4 a = *(const LAS s16x4*)(NI + (16 * i + cc) * RW_LD + 16 * k + 4 * g); acc = __builtin_amdgcn_mfma_f32_16x16x16bf16_1k(a, xb[k], acc, 0, 0, 0); }
                const s16x4 yb = cvt4(acc), ta = *(const LAS s16x4*)(TI + (i * 16 + cc) * 16 + 4 * g);
                const f32x4 xi = __builtin_amdgcn_mfma_f32_16x16x16bf16_1k(ta, yb, (f32x4){0.f, 0.f, 0.f, 0.f}, 0, 0, 0);
                xb[i] = cvt4(xi);
            }
            __syncthreads();
#pragma unroll
            for (int i = 0; i < 4; ++i) *(LAS s16x4*)(XB16 + (wave * 16 + cc) * RW_LD + 16 * i + 4 * g) = xb[i];
        }
        __syncthreads();
        {
            const int osel = wave >> 1; const size_t ob = (size_t)item * 4096;
#pragma unroll 1
            for (int q = 0; q < 8; ++q) { const int tile = (wave & 1) * 8 + q, mt = tile >> 2, nt = tile & 3; f32x4 acc = {0.f, 0.f, 0.f, 0.f};
                if (osel == 0) {
                    acc = mm16(XB16 + mt * 16 * RW_LD, RW_LD, BHc + nt * 16 * RW_LD, RW_LD, 64, acc, lane);
                    *(unsigned long long*)(PP + ob + (nt * 16 + cc) * 64 + mt * 16 + 4 * g) = pack4(acc);
                } else if (osel == 1) {
                    acc = mm16(BHc + mt * 16 * RW_LD, RW_LD, XB16 + (64 + nt * 16) * RW_LD, RW_LD, 64, acc, lane);
                    acc = mm16(KHc + mt * 16 * RW_LD, RW_LD, VTc + nt * 16 * RW_LD, RW_LD, 64, acc, lane);
                    *(unsigned long long*)(QQ + ob + (nt * 16 + cc) * 64 + mt * 16 + 4 * g) = pack4(acc);
                } else if (osel == 2) {
                    acc = mm16(XB16 + mt * 16 * RW_LD, RW_LD, ARB + nt * 16 * RW_LD, RW_LD, 64, acc, lane);
                    const unsigned long long rr = *(const LAS unsigned long long*)(RT + (nt * 16 + cc) * RW_LD + mt * 16 + 4 * g);
                    acc.x += bf2f((bf16)(rr & 0xffffu)); acc.y += bf2f((bf16)((rr >> 16) & 0xffffu)); acc.z += bf2f((bf16)((rr >> 32) & 0xffffu)); acc.w += bf2f((bf16)(rr >> 48));
                    *(unsigned long long*)(RH + ob + (nt * 16 + cc) * 64 + mt * 16 + 4 * g) = pack4(acc);
                } else {
                    acc = mm16(XB16 + (64 + mt * 16) * RW_LD, RW_LD, ARB + nt * 16 * RW_LD, RW_LD, 64, acc, lane);
                    acc = mm16(VTc + mt * 16 * RW_LD, RW_LD, ARK + nt * 16 * RW_LD, RW_LD, 64, acc, lane);
                    *(unsigned long long*)(YH + ob + (nt * 16 + cc) * 64 + mt * 16 + 4 * g) = pack4(acc);
                } }
        }
        __syncthreads();
    }
}

constexpr int CH_R = 6, CH_SLOT = 9216 + 9216 + 256;
constexpr int CH_RING = 0, CH_SI = CH_R * CH_SLOT, CH_FLAGS = CH_SI + 4 * 2304;
static_assert(CH_FLAGS + 64 <= MISC_OFF, "chain LDS map");
struct ChainRegs { v4u p[8], q[8]; f32x4 gm; };
__device__ __forceinline__ void chain_fetch(ChainRegs& o, const bf16* PP, const bf16* QQ, const float* GAMC, int item, int lane) {
    const size_t ob = (size_t)item * 4096;
#pragma unroll
    for (int i = 0; i < 8; ++i) { o.p[i] = *(const v4u*)(PP + ob + (size_t)(i * 64 + lane) * 8); o.q[i] = *(const v4u*)(QQ + ob + (size_t)(i * 64 + lane) * 8); }
    o.gm = *(const f32x4*)(GAMC + (size_t)item * 64 + (lane & 15) * 4);
}
__device__ __forceinline__ void chain_commit(const ChainRegs& o, LAS unsigned char* L, int c, int lane) {
    volatile LAS unsigned* flags = (volatile LAS unsigned*)(L + CH_FLAGS);
    const int slot = c % CH_R;
    if (c >= CH_R) { const unsigned need = (unsigned)(c - CH_R + 1);
        for (;;) { const unsigned m0 = flags[CH_R + 0], m1 = flags[CH_R + 1], m2 = flags[CH_R + 2], m3 = flags[CH_R + 3];
            if (m0 >= need && m1 >= need && m2 >= need && m3 >= need) break; __builtin_amdgcn_s_sleep(1); } }
    asm volatile("" ::: "memory");
    LAS unsigned char* sl = L + CH_RING + slot * CH_SLOT;
#pragma unroll
    for (int i = 0; i < 8; ++i) { const int idx = i * 64 + lane, row = idx >> 3, c16 = idx & 7;
        *(LAS v4u*)(sl + row * 144 + c16 * 16) = o.p[i]; *(LAS v4u*)(sl + 9216 + row * 144 + c16 * 16) = o.q[i]; }
    if (lane < 16) *(LAS f32x4*)(sl + 18432 + lane * 16) = o.gm;
    asm volatile("s_waitcnt lgkmcnt(0)" ::: "memory");
    if (lane == 0) flags[slot] = (unsigned)(c + 1);
}
__device__ __forceinline__ void ph_rwkv_b(const Ctx& C, int bh  , const bf16* PP, const bf16* QQ, const float* GAMC, bf16* S0) {
    const int lane = C.lane, wave = C.wave, cc = lane & 15, g = lane >> 4, b = bh >> 3, h = bh & 7;
    LAS unsigned char* L = C.lds;
    volatile LAS unsigned* flags = (volatile LAS unsigned*)(L + CH_FLAGS);
    if (C.tid < 16) flags[C.tid] = 0u;
    __syncthreads();
    if (wave >= 4) {
        const int j = wave - 4;
        ChainRegs A, B;
        int lc = j;
        chain_fetch(A, PP, QQ, GAMC, (b * 128 + lc) * 8 + h, lane);
        for (;;) {
            if (lc + 4 < 128) chain_fetch(B, PP, QQ, GAMC, (b * 128 + lc + 4) * 8 + h, lane);
            chain_commit(A, L, lc, lane);
            lc += 4; if (lc >= 128) break;
            if (lc + 4 < 128) chain_fetch(A, PP, QQ, GAMC, (b * 128 + lc + 4) * 8 + h, lane);
            chain_commit(B, L, lc, lane);
            lc += 4; if (lc >= 128) break;
        }
    } else {
        const int vt = wave;
        LAS bf16* SI = (LAS bf16*)(L + CH_SI + vt * 2304);
        f32x4 st[4];
#pragma unroll
        for (int mt = 0; mt < 4; ++mt) st[mt] = (f32x4){0.f, 0.f, 0.f, 0.f};
        for (int c = 0; c < 128; ++c) {
            const int item = (b * 128 + c) * 8 + h, slot = c % CH_R; const size_t ob = (size_t)item * 4096;
#pragma unroll
            for (int mt = 0; mt < 4; ++mt) { const unsigned long long pk = pack4(st[mt]);
                *(unsigned long long*)(S0 + ob + (vt * 16 + cc) * 64 + mt * 16 + 4 * g) = pk; *(LAS unsigned long long*)(SI + cc * RW_LD + mt * 16 + 4 * g) = pk; }
            while (flags[slot] < (unsigned)(c + 1)) __builtin_amdgcn_s_sleep(1);
            asm volatile("s_waitcnt lgkmcnt(0)" ::: "memory");
            const LAS unsigned char* sl = L + CH_RING + slot * CH_SLOT;
            const LAS bf16* Pi = (const LAS bf16*)sl; const LAS bf16* Qi = (const LAS bf16*)(sl + 9216); const LAS float* Gi = (const LAS float*)(sl + 18432);
            const s16x8 b0 = *(const LAS s16x8*)(SI + cc * RW_LD + 8 * g), b1 = *(const LAS s16x8*)(SI + cc * RW_LD + 32 + 8 * g);
#pragma unroll
            for (int mt = 0; mt < 4; ++mt) {
                const f32x4 gm = *(const LAS f32x4*)(Gi + mt * 16 + 4 * g);
                const unsigned long long qq = *(const LAS unsigned long long*)(Qi + (vt * 16 + cc) * RW_LD + mt * 16 + 4 * g);
                const s16x8 a0 = *(const LAS s16x8*)(Pi + (mt * 16 + cc) * RW_LD + 8 * g), a1 = *(const LAS s16x8*)(Pi + (mt * 16 + cc) * RW_LD + 32 + 8 * g);
                f32x4 acc; acc.x = gm.x * st[mt].x + bf2f((bf16)(qq & 0xffffu)); acc.y = gm.y * st[mt].y + bf2f((bf16)((qq >> 16) & 0xffffu));
                acc.z = gm.z * st[mt].z + bf2f((bf16)((qq >> 32) & 0xffffu)); acc.w = gm.w * st[mt].w + bf2f((bf16)(qq >> 48));
                acc = __builtin_amdgcn_mfma_f32_16x16x32_bf16(a0, b0, acc, 0, 0, 0); acc = __builtin_amdgcn_mfma_f32_16x16x32_bf16(a1, b1, acc, 0, 0, 0);
                st[mt] = acc; }
            asm volatile("s_waitcnt lgkmcnt(0)" ::: "memory");
            if (lane == 0) flags[CH_R + vt] = (unsigned)(c + 1);
        }
    }
    __syncthreads();
}

__device__ __forceinline__ void ph_rwkv_c(const Ctx& C, const bf16* S0, const bf16* RH, const bf16* YH, const float* RK, const bf16* GG, const bf16* VF,
                                          const float* gn_g, const float* gn_b, bf16* O) {
    const int lane = C.lane, cc = lane & 15, g = lane >> 4;
    for (int item = C.bid * 8 + C.wave; item < 4096; item += C.nb * 8) {
        const int h = item & 7, c = (item >> 3) & 127, b = item >> 10; const size_t m0 = (size_t)b * T_ + c * 64, ob = (size_t)item * 4096;
        s16x8 af[4][2], bfr[4][2];
#pragma unroll
        for (int q = 0; q < 4; ++q)
#pragma unroll
            for (int k = 0; k < 2; ++k) { af[q][k] = *(const s16x8*)(S0 + ob + (q * 16 + cc) * 64 + k * 32 + 8 * g); bfr[q][k] = *(const s16x8*)(RH + ob + (q * 16 + cc) * 64 + k * 32 + 8 * g); }
#pragma unroll
        for (int nt = 0; nt < 4; ++nt) {
            const size_t m = m0 + nt * 16 + cc;
            f32x4 y[4]; float s1 = 0.f;
#pragma unroll
            for (int mt = 0; mt < 4; ++mt) { const unsigned long long yh = *(const unsigned long long*)(YH + ob + (nt * 16 + cc) * 64 + mt * 16 + 4 * g);
                f32x4 acc; acc.x = bf2f((bf16)(yh & 0xffffu)); acc.y = bf2f((bf16)((yh >> 16) & 0xffffu)); acc.z = bf2f((bf16)((yh >> 32) & 0xffffu)); acc.w = bf2f((bf16)(yh >> 48));
                acc = __builtin_amdgcn_mfma_f32_16x16x32_bf16(af[mt][0], bfr[nt][0], acc, 0, 0, 0); acc = __builtin_amdgcn_mfma_f32_16x16x32_bf16(af[mt][1], bfr[nt][1], acc, 0, 0, 0);
                y[mt] = acc; s1 += (acc.x + acc.y) + (acc.z + acc.w); }
            s1 += __shfl_xor(s1, 16); s1 += __shfl_xor(s1, 32);
            const float mean = s1 * (1.f / 64.f); float s2 = 0.f;
#pragma unroll
            for (int mt = 0; mt < 4; ++mt) { y[mt] = y[mt] - mean; s2 += (y[mt].x * y[mt].x + y[mt].y * y[mt].y) + (y[mt].z * y[mt].z + y[mt].w * y[mt].w); }
            s2 += __shfl_xor(s2, 16); s2 += __shfl_xor(s2, 32);
            const float rstd = 1.f / sqrtf(s2 * (1.f / 64.f) + 64e-5f), rk = RK[m * 8 + h];
#pragma unroll
            for (int mt = 0; mt < 4; ++mt) { const int v = h * 64 + mt * 16 + 4 * g;
                const f32x4 gg4 = *(const f32x4*)(gn_g + v), gb4 = *(const f32x4*)(gn_b + v);
                const unsigned long long vx = *(const unsigned long long*)(VF + m * 512 + v), gx = *(const unsigned long long*)(GG + m * 512 + v);
                f32x4 o;
                o.x = (y[mt].x * rstd * gg4.x + gb4.x + rk * bf2f((bf16)(vx & 0xffffu))) * bf2f((bf16)(gx & 0xffffu));
                o.y = (y[mt].y * rstd * gg4.y + gb4.y + rk * bf2f((bf16)((vx >> 16) & 0xffffu))) * bf2f((bf16)((gx >> 16) & 0xffffu));
                o.z = (y[mt].z * rstd * gg4.z + gb4.z + rk * bf2f((bf16)((vx >> 32) & 0xffffu))) * bf2f((bf16)((gx >> 32) & 0xffffu));
                o.w = (y[mt].w * rstd * gg4.w + gb4.w + rk * bf2f((bf16)(vx >> 48))) * bf2f((bf16)(gx >> 48));
                *(unsigned long long*)(O + m * D_ + 512 + v) = pack4(o); }
        }
    }
}

__device__ __forceinline__ void ph_convfix(const Ctx& C, const float* HALO, const float* FIXU, const float* cw, const float* cb, bf16* ACT) {
    for (int idx = C.bid * NT + C.tid; idx < 128 * 22 * 2 * 128; idx += C.nb * NT) {
        const int j = idx & 127, rr = (idx >> 7) & 1, tile = idx >> 8, pm = tile / 22, pn = tile % 22;
        const bool seq0 = (pm & 31) == 0;
        const float* fx = FIXU + (size_t)tile * 512; const float* hl = HALO + (size_t)(tile - 22) * 512;
        const float u0g = fx[rr * 256 + j], u0v = fx[rr * 256 + 128 + j];
        float u1g, u1v, u2g, u2v;
        if (rr == 0) { u1g = seq0 ? 0.f : hl[256 + j]; u1v = seq0 ? 0.f : hl[256 + 128 + j]; u2g = seq0 ? 0.f : hl[j]; u2v = seq0 ? 0.f : hl[128 + j]; }
        else { u1g = fx[j]; u1v = fx[128 + j]; u2g = seq0 ? 0.f : hl[256 + j]; u2v = seq0 ? 0.f : hl[256 + 128 + j]; }
        const int jg = pn * 128 + j, jv = DFF + jg;
        const float gc = cb[jg] + cw[jg] * u2g + cw[NUP + jg] * u1g + cw[2 * NUP + jg] * u0g, vc = cb[jv] + cw[jv] * u2v + cw[NUP + jv] * u1v + cw[2 * NUP + jv] * u0v;
        ACT[(size_t)(pm * 256 + rr) * DFF + jg] = (bf16)f2bf(siluf_(gc) * vc);
    }
}
}

namespace pg8 {
struct EpiRes {
    static constexpr bool PERM = false, AFTER_DRAIN = false;
    const float* base; float* out; const float* gate; int gstride;
    __device__ __forceinline__ void operator()(const f32x4 (&acc)[2][2][4][2], const Unit& u, int wr, int wc, int fr, int fq) const {
        const int b = (u.pm * BM) / 8192; const float* gp = gate + (size_t)b * gstride;
        const int col0 = u.pn * BM + wc * 32 + 4 * fq;
#pragma unroll
        for (int ai = 0; ai < 2; ++ai)
#pragma unroll
            for (int m = 0; m < 4; ++m) { const size_t off = (size_t)(u.pm * BM + ai * HALF + wr * 64 + m * 16 + fr) * 1024 + col0;
#pragma unroll
                for (int bj = 0; bj < 2; ++bj)
#pragma unroll
                    for (int n = 0; n < 2; ++n) { const int cc = bj * HALF + n * 16; const f32x4 gv = *(const f32x4*)(gp + col0 + cc); const f32x4 bs = *(const f32x4*)(base + off + cc);
                        *(f32x4*)(out + off + cc) = bs + gv * acc[ai][bj][m][n]; } }
    }
};

struct EpiConv {
    static constexpr bool PERM = true, AFTER_DRAIN = false;
    bf16_t* ACT; const float* cw; const float* cb; float* HALO; float* FIXU; PG8_LAS float* EX; int nN;
    template <int CTRL> static __device__ __forceinline__ float rot(float x) { return __builtin_bit_cast(float, __builtin_amdgcn_update_dpp(0, __builtin_bit_cast(int, x), CTRL, 0xf, 0xf, false)); }
    template <int CTRL> static __device__ __forceinline__ f32x4 rot4(f32x4 x) { return (f32x4){rot<CTRL>(x.x), rot<CTRL>(x.y), rot<CTRL>(x.z), rot<CTRL>(x.w)}; }
    __device__ __forceinline__ void operator()(const f32x4 (&acc)[2][2][4][2], const Unit& u, int wr, int wc, int fr, int fq) const {
        const int colw = wc * 32 + 8 * fq, tile = u.pm * nN + u.pn;
        if (fr >= 14) {
#pragma unroll
            for (int ai = 0; ai < 2; ++ai)
#pragma unroll
                for (int bj = 0; bj < 2; ++bj)
#pragma unroll
                    for (int n = 0; n < 2; ++n) { *(PG8_LAS f32x4*)(EX + ((ai * 2 + wr) * 2 + (fr - 14)) * 256 + bj * 128 + colw + 4 * n) = acc[ai][bj][3][n];
                        if (ai == 1 && wr == 1) *(f32x4*)(HALO + ((size_t)tile * 2 + (fr - 14)) * 256 + bj * 128 + colw + 4 * n) = acc[1][bj][3][n]; }
        }
        if (fr < 2 && wr == 0) {
#pragma unroll
            for (int bj = 0; bj < 2; ++bj)
#pragma unroll
                for (int n = 0; n < 2; ++n) *(f32x4*)(FIXU + ((size_t)tile * 2 + fr) * 256 + bj * 128 + colw + 4 * n) = acc[0][bj][0][n];
        }
        asm volatile("s_waitcnt lgkmcnt(0)" ::: "memory"); __builtin_amdgcn_s_barrier(); asm volatile("" ::: "memory");
#pragma unroll
        for (int n = 0; n < 2; ++n) {
            const int jg = u.pn * 128 + colw + 4 * n, jv = 2816 + jg;
#pragma unroll
            for (int ai = 0; ai < 2; ++ai)
#pragma unroll
                for (int m = 0; m < 4; ++m) {
                    const int src = ai * 2 + wr - 1;
                    f32x4 res[2];
#pragma unroll
                    for (int bj = 0; bj < 2; ++bj) {
                        const int jc = bj ? jv : jg;
                        const f32x4 x = acc[ai][bj][m][n];
                        f32x4 x1 = rot4<0x121>(x), x2 = rot4<0x122>(x);
                        if (m > 0) { const f32x4 q = acc[ai][bj][m > 0 ? m - 1 : 0][n]; const f32x4 q1 = rot4<0x121>(q), q2 = rot4<0x122>(q);
                            if (fr == 0) x1 = q1; if (fr < 2) x2 = q2; }
                        else if (fr < 2) { f32x4 e14 = {0.f, 0.f, 0.f, 0.f}, e15 = e14;
                            if (src >= 0) { e14 = *(const PG8_LAS f32x4*)(EX + (src * 2 + 0) * 256 + bj * 128 + colw + 4 * n); e15 = *(const PG8_LAS f32x4*)(EX + (src * 2 + 1) * 256 + bj * 128 + colw + 4 * n); }
                            if (fr == 0) { x1 = e15; x2 = e14; } else x2 = e15; }
                        const f32x4 w0 = *(const f32x4*)(cw + jc), w1 = *(const f32x4*)(cw + 5632 + jc), w2 = *(const f32x4*)(cw + 2 * 5632 + jc), bb = *(const f32x4*)(cb + jc);
                        res[bj] = bb + w0 * x2 + w1 * x1 + w2 * x;
                    }
                    const f32x4 gc = res[0], vc = res[1];
                    f32x4 o;
                    o.x = gc.x * __builtin_amdgcn_rcpf(1.f + __expf(-gc.x)) * vc.x; o.y = gc.y * __builtin_amdgcn_rcpf(1.f + __expf(-gc.y)) * vc.y;
                    o.z = gc.z * __builtin_amdgcn_rcpf(1.f + __expf(-gc.z)) * vc.z; o.w = gc.w * __builtin_amdgcn_rcpf(1.f + __expf(-gc.w)) * vc.w;
                    typedef unsigned u32x2 __attribute__((ext_vector_type(2)));
                    u32x2 w; w.x = cvt_pk_bf16(o.x, o.y); w.y = cvt_pk_bf16(o.z, o.w);
                    *(u32x2*)(ACT + (size_t)(u.pm * BM + ai * HALF + wr * 64 + m * 16 + fr) * 2816 + u.pn * 128 + colw + 4 * n) = w;
                }
        }
    }
};
}

namespace hy {
struct Args { const float* in[31]; float* out; unsigned char* ws; };
__global__ void __launch_bounds__(NT, 2) hy_fwd(Args A) {
    extern __shared__ __attribute__((aligned(16))) unsigned char lds_raw[];
    Ctx C; C.bid = blockIdx.x; C.nb = gridDim.x; C.tid = threadIdx.x; C.lane = C.tid & 63; C.wave = __builtin_amdgcn_readfirstlane(C.tid >> 6); C.lds = (LAS unsigned char*)lds_raw;
    volatile LAS unsigned* MISC = (volatile LAS unsigned*)(C.lds + MISC_OFF);
    for (int u = C.tid; u < (LDS_BYTES - MISC_OFF) / 4; u += NT) ((LAS unsigned*)(C.lds + MISC_OFF))[u] = 0u;
    __syncthreads();
    unsigned char* ws = A.ws;
    XcdBarrier bar = xcd_barrier_post((unsigned*)(ws + WS_CTL) + CW_BAR, MISC + 8);
#define PHASE_BEGIN() do { int t_ = threadIdx.x; asm volatile("" : "+v"(t_)); int b_ = blockIdx.x; asm volatile("" : "+s"(b_)); \
    C.tid = t_; C.lane = t_ & 63; C.wave = __builtin_amdgcn_readfirstlane(t_ >> 6); C.bid = b_; } while (0)
#ifdef HY_DIAG
    unsigned long long ts_last = __builtin_amdgcn_s_memrealtime(); float tacc[10] = {0.f, 0.f, 0.f, 0.f, 0.f, 0.f, 0.f, 0.f, 0.f, 0.f};
#define GRID_BAR(cat) do { xcd_barrier(bar); PHASE_BEGIN(); { const unsigned long long n_ = __builtin_amdgcn_s_memrealtime(); tacc[cat] += (float)(n_ - ts_last); ts_last = n_; } } while (0)
#else
#define GRID_BAR(cat) do { xcd_barrier(bar); PHASE_BEGIN(); } while (0)
#endif
#ifndef HY_REPCAT
#define HY_REPCAT (-1)
#endif
#define NREP(cat) ((HY_REPCAT == (cat)) ? 2 : 1)
    float* out = A.out;
#define in A.in
    float* MOD = (float*)(ws + WS_MOD);
    bf16 *WIN = (bf16*)(ws + WS_WIN), *WOUT = (bf16*)(ws + WS_WOUT), *WUP = (bf16*)(ws + WS_WUP), *WDN = (bf16*)(ws + WS_WDN);
    bf16 *XB = (bf16*)(ws + WS_XB), *O = (bf16*)(ws + WS_O), *VF = (bf16*)(ws + WS_VF), *PG = (bf16*)(ws + WS_PG), *PR = (bf16*)(ws + WS_PR), *VL = (bf16*)(ws + WS_VL);
    bf16 *RH = (bf16*)(ws + WS_RH), *YH = (bf16*)(ws + WS_YH), *PP = (bf16*)(ws + WS_PP), *QQ = (bf16*)(ws + WS_QQ), *GG = (bf16*)(ws + WS_GG), *S0 = (bf16*)(ws + WS_S0);
    float *GAMC = (float*)(ws + WS_GAMC), *RK = (float*)(ws + WS_RK);
    bf16* LORA = (bf16*)(ws + WS_LORA);
    bf16* DS = (bf16*)(ws + WS_GK); float* GAM = (float*)(ws + WS_GAM);
    bf16* ACT = (bf16*)(ws + WS_ACT); float *HALO = (float*)(ws + WS_U), *FIXU = (float*)(ws + WS_U + 8 * MiB);

    ph_mod(C, in[1], in[2], in[3], MOD);
    for (int l = 0; l < L_; ++l) {
        const float* modl = MOD + (size_t)l * 4 * 6144;
        const float* xres = l ? out : in[0];
        for (int r_ = 0; r_ < NREP(0); ++r_) {
        wprep_mat(C, in[5] + (size_t)l * D_ * IN_COLS, D_, IN_COLS, NIN, WIN, 1, l ? in[6] : nullptr);
        wprep_mat(C, in[24] + (size_t)l * D_ * D_, D_, D_, D_, WOUT, 0, nullptr);
        wprep_mat(C, in[26] + (size_t)l * D_ * NUP, D_, NUP, NUP, WUP, 2, nullptr);
        wprep_mat(C, in[29] + (size_t)l * DFF * D_, DFF, D_, D_, WDN, 0, nullptr);
        wprep_mat(C, in[12] + (size_t)l * 64 * 512, 64, 512, 512, LORA, 0, nullptr);
        wprep_mat(C, in[14] + (size_t)l * 64 * 512, 64, 512, 512, LORA + 512 * 64, 0, nullptr);
        wprep_mat(C, in[16] + (size_t)l * 128 * 512, 128, 512, 512, LORA + 2 * 512 * 64, 0, nullptr);
        if (l) wprep_mat(C, in[17], 32, 512, 512, LORA + 2 * 512 * 64 + 512 * 128, 0, nullptr);
        }
        GRID_BAR(0);
        for (int r_ = 0; r_ < NREP(1); ++r_) ph_norm(C, xres, in[4] + l * D_, modl + 0 * D_, modl + 1 * D_, XB);
        GRID_BAR(1);
        for (int r_ = 0; r_ < NREP(2); ++r_) { pg8::Gemm g{XB, WIN, M_, NIN, D_}; pg8::StaticOrder S; S.init(M_, NIN, C.nb, C.bid);
          pg8::EpiBf16<0> E{PG, NPG, nullptr, NPG, (WS_PR - WS_PG) / 2, 1.f};
          pg8::gemm_phase<pg8::EpiBf16<0>, pg8::StaticOrder, true, true>(C.lds, g, S, E); }
        GRID_BAR(2);
        for (int r_ = 0; r_ < NREP(3); ++r_) {
        ph_gla_a(C, PG, in[7] + l * 16 * 256, in[8] + l * 256, DS, GAM, VL);
        { RwkvW W{in[10] + l * 1792, in[11], in[13] + l * 512, in[15] + l * 512, in[18], in[19] + l * 512, in[20] + l * 512, in[21] + l * 512,
                  LORA, LORA + 512 * 64, LORA + 2 * 512 * 64, LORA + 2 * 512 * 64 + 512 * 128};
          ph_rwkv_a(C, PR, PG, W, l, PP, QQ, RH, YH, GAMC, RK, GG, VF, r_ == NREP(3) - 1); } }
        GRID_BAR(3);
        if (C.bid < 32) { for (int r_ = 0; r_ < NREP(4); ++r_) ph_rwkv_b(C, C.bid, PP, QQ, GAMC, S0); }
        else { Ctx C2 = C; C2.bid = C.bid - 32; C2.nb = C.nb - 32; ph_gla_b(C2, DS, GAM); }
        GRID_BAR(4);
        for (int r_ = 0; r_ < NREP(5); ++r_) {
        ph_gla_c(C, PG, in[7] + l * 16 * 256, in[8] + l * 256, in[9] + l * 128, DS, O);
        ph_rwkv_c(C, S0, RH, YH, RK, GG, VF, in[22] + l * 512, in[23] + l * 512, O); }
        GRID_BAR(5);
        { pg8::Gemm g{O, WOUT, M_, D_, D_}; pg8::StaticOrder S; S.init(M_, D_, C.nb, C.bid);
          pg8::EpiRes E{xres, out, modl + 2 * D_, 6144};
          pg8::gemm_phase<pg8::EpiRes, pg8::StaticOrder, true, true>(C.lds, g, S, E); }
        GRID_BAR(6);
        for (int r_ = 0; r_ < NREP(1); ++r_) ph_norm(C, out, in[25] + l * D_, modl + 3 * D_, modl + 4 * D_, XB);
        GRID_BAR(1);
        for (int r_ = 0; r_ < NREP(7); ++r_) { pg8::Gemm g{XB, WUP, M_, NUP, D_}; pg8::StaticOrder S; S.init(M_, NUP, C.nb, C.bid);
          pg8::EpiConv E{ACT, in[27] + (size_t)l * 3 * NUP, in[28] + (size_t)l * NUP, HALO, FIXU, (PG8_LAS float*)(C.lds + RING_BYTES), NUP / 256};
          pg8::gemm_phase<pg8::EpiConv, pg8::StaticOrder, true, true>(C.lds, g, S, E); }
        GRID_BAR(7);
        for (int r_ = 0; r_ < NREP(8); ++r_) ph_convfix(C, HALO, FIXU, in[27] + (size_t)l * 3 * NUP, in[28] + (size_t)l * NUP, ACT);
        GRID_BAR(8);
        { pg8::Gemm g{ACT, WDN, M_, D_, DFF}; pg8::StaticOrder S; S.init(M_, D_, C.nb, C.bid);
          pg8::EpiRes E{out, out, modl + 5 * D_, 6144};
          pg8::gemm_phase<pg8::EpiRes, pg8::StaticOrder, true, true>(C.lds, g, S, E); }
        GRID_BAR(9);
    }
    ph_final(C, out, in[30]);
#ifdef HY_DIAG
    GRID_BAR(1);
    if (C.bid == 0) { if (C.tid == 0) out[0] = tacc[HY_DIAG_A] * 0.1f; for (int i = 1 + C.tid; i <= 10000; i += NT) out[i] = tacc[HY_DIAG_B] * 0.01f; }
#endif
#undef GRID_BAR
#undef PHASE_BEGIN
#undef in
}
}

extern "C" void kernel_launch(void* const* d_in, const int* in_sizes, int n_in, void* d_out, int out_size, void* d_ws, size_t ws_size, hipStream_t stream) {
    using namespace hy;
    static int grid = 0;
    if (grid == 0) {
        if (n_in != 31 || in_sizes[0] != M_ * D_ || out_size != M_ * D_ || ws_size < WS_END) { fprintf(stderr, "kernel_launch: unexpected shapes (n_in %d, in0 %d, out %d, ws %zu)\n", n_in, n_in > 0 ? in_sizes[0] : -1, out_size, ws_size); grid = -1; return; }
        if (hipFuncSetAttribute((const void*)hy_fwd, hipFuncAttributeMaxDynamicSharedMemorySize, LDS_BYTES) != hipSuccess) { fprintf(stderr, "kernel_launch: hipFuncSetAttribute failed\n"); grid = -1; return; }
        int dev = 0, cus = 0, per_cu = 0;
        (void)hipGetDevice(&dev); (void)hipDeviceGetAttribute(&cus, hipDeviceAttributeMultiprocessorCount, dev);
        (void)hipOccupancyMaxActiveBlocksPerMultiprocessor(&per_cu, (const void*)hy_fwd, NT, LDS_BYTES);
        if (per_cu < 1) fprintf(stderr, "kernel_launch: occupancy query reports %d blocks per CU\n", per_cu);
        (void)hipGetLastError();
        grid = cus > 0 ? cus : 256;
    }
    if (grid < 0) return;
    (void)hipMemsetAsync((char*)d_ws + WS_CTL, 0, CTL_ZERO_BYTES, stream);
    Args a{};
    for (int i = 0; i < 31; ++i) a.in[i] = (const float*)d_in[i];
    a.out = (float*)d_out; a.ws = (unsigned char*)d_ws;
    hipLaunchKernelGGL(hy_fwd, dim3(grid), dim3(NT), LDS_BYTES, stream, a);
}
```

```cpp
#include <hip/hip_runtime.h>
#include <cstdio>
#include <cstdint>
namespace pg8 {
#define PG8_LAS __attribute__((address_space(3)))
typedef unsigned short bf16_t;
typedef short bf16x8 __attribute__((ext_vector_type(8)));
typedef float f32x4 __attribute__((ext_vector_type(4)));
typedef unsigned u32x4 __attribute__((ext_vector_type(4)));
constexpr int BM = 256, BK = 64, HALF = 128, HTB = HALF * BK * 2  , STAGE_BYTES = 8 * HTB, NXCD = 8, WGM = 8;

__host__ __device__ __forceinline__ int lds_byte(int r, int c) { const int st = (r >> 4) * 2 + (c >> 5), rr = r & 15, cc = c & 31, ob = rr * 64 + cc * 2; return st * 1024 + (ob ^ (((ob >> 9) & 1) << 5)); }
__host__ __device__ __forceinline__ void stage_rc(int b, int& R, int& C) { const int st = b / 1024, sb = b % 1024, swz = sb ^ (((sb >> 9) & 1) << 5); R = (st >> 1) * 16 + swz / 64; C = (st & 1) * 32 + (swz % 64) / 2; }
__host__ __device__ __forceinline__ int perm32(int rho) { const int n = rho >> 4, i = rho & 15; return 8 * (i >> 2) + 4 * n + (i & 3); }

struct Unit { int pm, pn; };
struct Gemm { const bf16_t* A; const bf16_t* Bt; int M, N, K; };

struct StaticOrder {
    int nM, nN, nwg, G, c;
    __host__ __device__ void init(int M, int N, int G_, int c_) { nM = M / BM; nN = N / BM; nwg = nM * nN; G = G_; c = c_; }
    __host__ __device__ bool next(int i, Unit& u) const {
        const long L = (long)i * G + c; if (L >= nwg) return false;
        int wgid = (int)L; { const int q = nwg / NXCD, r = nwg % NXCD, xcd = wgid % NXCD, off = wgid / NXCD; wgid = (xcd < r ? xcd * (q + 1) : r * (q + 1) + (xcd - r) * q) + off; }
        const int nig = WGM * nN, gid = wgid / nig, fm = gid * WGM, gsz = (nM - fm) < WGM ? (nM - fm) : WGM;
        u.pm = fm + ((wgid % nig) % gsz); u.pn = (wgid % nig) / gsz; return true;
    }
    __device__ __forceinline__ void a_ready(const Unit&) const {}
    __device__ __forceinline__ void done(const Unit&) const {}
};

__device__ __forceinline__ unsigned cvt_pk_bf16(float lo, float hi) { unsigned r; asm volatile("v_cvt_pk_bf16_f32 %0, %1, %2" : "=v"(r) : "v"(lo), "v"(hi)); return r; }
typedef float f32x2 __attribute__((ext_vector_type(2)));
__device__ __forceinline__ f32x2 gelu_pk(f32x2 v) {
    const f32x2 av = __builtin_elementwise_abs(v), d = av * 0.2316418882f + 1.0f;
    f32x2 t; t.x = __builtin_amdgcn_rcpf(d.x); t.y = __builtin_amdgcn_rcpf(d.y);
    f32x2 q = t * 0.5307027145f + (-0.7265760135f); q = q * t + 0.7107068705f; q = q * t + (-0.142248368f); q = q * t + 0.127414796f; q = q * t;
    const f32x2 s = (v * v) * (-0.72134752044f);
    f32x2 e; e.x = __builtin_amdgcn_exp2f(s.x); e.y = __builtin_amdgcn_exp2f(s.y);
    const f32x2 m = v * (q * e), r = v - m;
    f32x2 o; o.x = v.x < 0.f ? m.x : r.x; o.y = v.y < 0.f ? m.y : r.y; return o;
}

template <int ACT  > struct EpiBf16 {
    static constexpr bool PERM = true, AFTER_DRAIN = false; static_assert(ACT == 0 || ACT == 1, "EpiBf16: ACT is 0 (none) or 1 (gelu_pk)");
    bf16_t* O; int ldc; const float* bias; int split_cols; size_t split_stride; float scale0;
    __device__ __forceinline__ void operator()(const f32x4 (&acc)[2][2][4][2], const Unit& u, int wr, int wc, int fr, int fq) const {
        const int row0 = u.pm * BM + wr * 64 + fr; int colt = u.pn * BM; bf16_t* base = O;
        float sc = 1.f; if (split_cols) { const int t = colt / split_cols; base += (size_t)t * split_stride; colt -= t * split_cols; if (t == 0) sc = scale0; }
        const int col0 = colt + wc * 32 + 8 * fq, bcol0 = u.pn * BM + wc * 32 + 8 * fq;
        f32x4 bv[2][2];
#pragma unroll
        for (int bj = 0; bj < 2; ++bj)
#pragma unroll
            for (int n = 0; n < 2; ++n) bv[bj][n] = bias ? *(const f32x4*)(bias + bcol0 + bj * HALF + 4 * n) : (f32x4){0.f, 0.f, 0.f, 0.f};
#pragma unroll
        for (int ai = 0; ai < 2; ++ai)
#pragma unroll
            for (int m = 0; m < 4; ++m) { bf16_t* rowp = base + (size_t)(row0 + ai * HALF + m * 16) * ldc + col0;
#pragma unroll
                for (int bj = 0; bj < 2; ++bj) { f32x4 v0 = acc[ai][bj][m][0] + bv[bj][0], v1 = acc[ai][bj][m][1] + bv[bj][1];
                    if (ACT == 1) { f32x2 a = gelu_pk((f32x2){v0[0], v0[1]}), b = gelu_pk((f32x2){v0[2], v0[3]}), c = gelu_pk((f32x2){v1[0], v1[1]}), d = gelu_pk((f32x2){v1[2], v1[3]});
                        v0 = (f32x4){a.x, a.y, b.x, b.y}; v1 = (f32x4){c.x, c.y, d.x, d.y}; }
                    v0 = v0 * sc; v1 = v1 * sc; u32x4 w; w.x = cvt_pk_bf16(v0[0], v0[1]); w.y = cvt_pk_bf16(v0[2], v0[3]); w.z = cvt_pk_bf16(v1[0], v1[1]); w.w = cvt_pk_bf16(v1[2], v1[3]);
                    *(u32x4*)(rowp + bj * HALF) = w; } }
    }
};
template <class Epi, class Sched, bool ALIGN_EPI = false, bool SP2 = false>
__device__ __forceinline__ void gemm_phase(PG8_LAS unsigned char* lds, const Gemm g, const Sched& S, const Epi& E) {
    int tid_ = threadIdx.x; asm volatile("" : "+v"(tid_));
    const int tid = tid_, wid = __builtin_amdgcn_readfirstlane(tid >> 6), lane = tid & 63, wr = wid >> 2, wc = wid & 3, fr = lane & 15, fq = lane >> 4;
    const int K = g.K, nt = K / BK;
    unsigned voffA[2], voffB[2];
#pragma unroll
    for (int i = 0; i < 2; ++i) { int R, C; stage_rc(tid * 16 + i * 8192, R, C); const int Rb = Epi::PERM ? ((R & ~31) + perm32(R & 31)) : R;
        voffA[i] = (unsigned)(R * K + C) * 2u; voffB[i] = (unsigned)(Rb * K + C) * 2u; }
    const size_t kstep = (size_t)(BK * 2);
    const size_t hstep = (size_t)HALF * K * 2;
    const size_t tstep = 2 * hstep;
    const unsigned ldsw = (unsigned)wid * 1024u;
    const int aoff = lds_byte(wr * 64 + fr, fq * 8), boff = lds_byte(wc * 32 + fr, fq * 8);
#define PG8_SA(b, h) (((b) * 2 + (h)) * HTB)
#define PG8_SB(b, h) ((4 + (b) * 2 + (h)) * HTB)
#define PG8_STAGE(bufoff, gbase, voff) do { _Pragma("unroll") for (int _i = 0; _i < 2; ++_i) \
        __builtin_amdgcn_global_load_lds((const unsigned*)((const char*)(gbase) + (voff)[_i]), (PG8_LAS unsigned*)(lds + (bufoff) + ldsw + _i * 8192), 16, 0, 0); } while (0)
#define PG8_LDA(dst, b, h) do { _Pragma("unroll") for (int m = 0; m < 4; ++m) _Pragma("unroll") for (int k = 0; k < 2; ++k) dst[m][k] = *(const PG8_LAS bf16x8*)(lds + PG8_SA(b, h) + aoff + m * 2048 + k * 1024); } while (0)
#define PG8_LDB(dst, b, h) do { _Pragma("unroll") for (int n = 0; n < 2; ++n) _Pragma("unroll") for (int k = 0; k < 2; ++k) dst[n][k] = *(const PG8_LAS bf16x8*)(lds + PG8_SB(b, h) + boff + n * 2048 + k * 1024); } while (0)
#define PG8_MMA(ai, bj, At, Bt) do { __builtin_amdgcn_s_setprio(1); _Pragma("unroll") for (int m = 0; m < 4; ++m) _Pragma("unroll") for (int n = 0; n < 2; ++n) _Pragma("unroll") for (int k = 0; k < 2; ++k) \
        acc[ai][bj][m][n] = __builtin_amdgcn_mfma_f32_16x16x32_bf16(Bt[n][k], At[m][k], acc[ai][bj][m][n], 0, 0, 0); __builtin_amdgcn_s_setprio(0); } while (0)
#define PG8_WAIT_V(n) asm volatile("s_waitcnt vmcnt(" #n ")" ::: "memory")
#define PG8_WAIT_L(n) asm volatile("s_waitcnt lgkmcnt(" #n ")" ::: "memory")
#define PG8_BAR __builtin_amdgcn_s_barrier()
#define PG8_SCHED __builtin_amdgcn_sched_barrier(0)
    Unit cur, nxt; int ui = 0;
    if (!S.next(0, cur)) return;
    f32x4 acc[2][2][4][2];
#pragma unroll
    for (int a = 0; a < 2; ++a)
#pragma unroll
        for (int b = 0; b < 2; ++b)
#pragma unroll
            for (int m = 0; m < 4; ++m)
#pragma unroll
                for (int n = 0; n < 2; ++n) acc[a][b][m][n] = (f32x4){0.f, 0.f, 0.f, 0.f};
    bf16x8 At[4][2], B0[2][2], B1[2][2];
    const char* cA = (const char*)g.A + (size_t)cur.pm * tstep; const char* cB = (const char*)g.Bt + (size_t)cur.pn * tstep;
    S.a_ready(cur);
    if constexpr (SP2) {
        PG8_STAGE(PG8_SB(0, 0), cB, voffB); PG8_STAGE(PG8_SB(0, 1), cB + hstep, voffB); PG8_STAGE(PG8_SA(0, 0), cA, voffA); PG8_STAGE(PG8_SA(0, 1), cA + hstep, voffA);
        if (wr == 1) PG8_BAR;
        PG8_WAIT_V(2); PG8_BAR;
        PG8_STAGE(PG8_SB(1, 0), cB + kstep, voffB); PG8_STAGE(PG8_SA(1, 0), cA + kstep, voffA); PG8_STAGE(PG8_SB(1, 1), cB + hstep + kstep, voffB);
        PG8_WAIT_V(6); PG8_BAR;
    } else {
        PG8_STAGE(PG8_SB(0, 0), cB, voffB); PG8_STAGE(PG8_SA(0, 0), cA, voffA); PG8_STAGE(PG8_SB(0, 1), cB + hstep, voffB); PG8_STAGE(PG8_SA(0, 1), cA + hstep, voffA);
        if (wr == 1) PG8_BAR;
        PG8_WAIT_V(4); PG8_BAR;
        PG8_STAGE(PG8_SB(1, 0), cB + kstep, voffB); PG8_STAGE(PG8_SA(1, 0), cA + kstep, voffA); PG8_STAGE(PG8_SB(1, 1), cB + hstep + kstep, voffB);
        PG8_WAIT_V(6); PG8_BAR;
    }
    for (;;) {
        const bool has_next = S.next(ui + 1, nxt);
        const char* nA = has_next ? (const char*)g.A + (size_t)nxt.pm * tstep : cA; const char* nB = has_next ? (const char*)g.Bt + (size_t)nxt.pn * tstep : cB;
        for (int t = 0; t < nt; t += 2) {
            const bool last = (t == nt - 2);
            const char* a1 = cA + (size_t)(t + 1) * kstep;
            const char* a2 = last ? nA : cA + (size_t)(t + 2) * kstep; const char* b2 = last ? nB : cB + (size_t)(t + 2) * kstep;
            const char* a3 = a2 + kstep; const char* b3 = b2 + kstep;
            if (last && has_next) S.a_ready(nxt);
            if constexpr (SP2) {
            PG8_LDB(B0, 0, 0); PG8_LDB(B1, 0, 1); PG8_SCHED; PG8_LDA(At, 0, 0); PG8_STAGE(PG8_SA(1, 1), a1 + hstep, voffA);
            PG8_WAIT_V(8); PG8_WAIT_L(0); PG8_BAR; PG8_MMA(0, 0, At, B0); PG8_MMA(0, 1, At, B1); PG8_BAR; PG8_SCHED;
            PG8_LDA(At, 0, 1); PG8_STAGE(PG8_SB(0, 0), b2, voffB); PG8_STAGE(PG8_SB(0, 1), b2 + hstep, voffB); PG8_STAGE(PG8_SA(0, 0), a2, voffA);
            PG8_WAIT_V(8); PG8_WAIT_L(0); PG8_BAR; PG8_MMA(1, 0, At, B0); PG8_MMA(1, 1, At, B1); PG8_BAR; PG8_SCHED;
            PG8_LDB(B0, 1, 0); PG8_LDB(B1, 1, 1); PG8_SCHED; PG8_LDA(At, 1, 0); PG8_STAGE(PG8_SA(0, 1), a2 + hstep, voffA);
            PG8_WAIT_V(8); PG8_WAIT_L(0); PG8_BAR; PG8_MMA(0, 0, At, B0); PG8_MMA(0, 1, At, B1); PG8_BAR; PG8_SCHED;
            PG8_LDA(At, 1, 1); PG8_STAGE(PG8_SB(1, 0), b3, voffB); PG8_STAGE(PG8_SB(1, 1), b3 + hstep, voffB); PG8_STAGE(PG8_SA(1, 0), a3, voffA);
            PG8_WAIT_V(8); PG8_WAIT_L(0); PG8_BAR; PG8_MMA(1, 0, At, B0); PG8_MMA(1, 1, At, B1); PG8_BAR; PG8_SCHED;
            } else {
            PG8_LDB(B0, 0, 0); PG8_SCHED; PG8_LDA(At, 0, 0); PG8_STAGE(PG8_SA(1, 1), a1 + hstep, voffA);
            PG8_WAIT_L(8); PG8_BAR; PG8_WAIT_L(0); PG8_MMA(0, 0, At, B0); PG8_BAR; PG8_SCHED;
            PG8_LDB(B1, 0, 1); PG8_STAGE(PG8_SB(0, 0), b2, voffB);
            PG8_BAR; PG8_WAIT_L(0); PG8_MMA(0, 1, At, B1); PG8_BAR;
            PG8_LDA(At, 0, 1); PG8_STAGE(PG8_SA(0, 0), a2, voffA);
            PG8_BAR; PG8_WAIT_L(0); PG8_MMA(1, 0, At, B0); PG8_BAR; PG8_SCHED;
            PG8_STAGE(PG8_SB(0, 1), b2 + hstep, voffB);
            PG8_WAIT_V(6); PG8_BAR; PG8_MMA(1, 1, At, B1); PG8_BAR;
            PG8_LDB(B0, 1, 0); PG8_SCHED; PG8_LDA(At, 1, 0); PG8_STAGE(PG8_SA(0, 1), a2 + hstep, voffA);
            PG8_WAIT_L(8); PG8_BAR; PG8_WAIT_L(0); PG8_MMA(0, 0, At, B0); PG8_BAR; PG8_SCHED;
            PG8_LDB(B1, 1, 1); PG8_STAGE(PG8_SB(1, 0), b3, voffB);
            PG8_BAR; PG8_WAIT_L(0); PG8_MMA(0, 1, At, B1); PG8_BAR;
            PG8_LDA(At, 1, 1); PG8_STAGE(PG8_SA(1, 0), a3, voffA);
            PG8_BAR; PG8_WAIT_L(0); PG8_MMA(1, 0, At, B0); PG8_BAR; PG8_SCHED;
            PG8_STAGE(PG8_SB(1, 1), b3 + hstep, voffB);
            PG8_WAIT_V(6); PG8_BAR; PG8_MMA(1, 1, At, B1); PG8_BAR;
            }
        }
        if constexpr (ALIGN_EPI) { if (wr == 0) PG8_BAR; }
        if constexpr (!Epi::AFTER_DRAIN) { E(acc, cur, wr, wc, fr, fq); S.done(cur); }
        if (!has_next) break;
#pragma unroll
        for (int a = 0; a < 2; ++a)
#pragma unroll
            for (int b = 0; b < 2; ++b)
#pragma unroll
                for (int m = 0; m < 4; ++m)
#pragma unroll
                    for (int n = 0; n < 2; ++n) acc[a][b][m][n] = (f32x4){0.f, 0.f, 0.f, 0.f};
        cur = nxt; cA = nA; cB = nB; ++ui;
        if constexpr (ALIGN_EPI) { if (wr == 1) PG8_BAR; }
    }
    PG8_WAIT_V(0);
    if constexpr (!ALIGN_EPI) { if (wr == 0) PG8_BAR; }
    PG8_BAR;
    if constexpr (Epi::AFTER_DRAIN) { E.fused(acc, cur, wr, wc, fr, fq, lds, wid, lane); S.done(cur); }
#undef PG8_SA
#undef PG8_SB
#undef PG8_STAGE
#undef PG8_LDA
#undef PG8_LDB
#undef PG8_MMA
#undef PG8_WAIT_V
#undef PG8_WAIT_L
#undef PG8_BAR
#undef PG8_SCHED
}
}

namespace hy {
#define GAS __attribute__((address_space(1)))
#define LAS __attribute__((address_space(3)))
typedef unsigned short bf16;
typedef unsigned v4u __attribute__((ext_vector_type(4)));
typedef float f32x4 __attribute__((ext_vector_type(4)));
typedef short bf16x8 __attribute__((ext_vector_type(8)));
typedef GAS unsigned gu32;
typedef GAS unsigned long long gu64;
#define RLX_AGENT __ATOMIC_RELAXED, __HIP_MEMORY_SCOPE_AGENT
#define LDS_WAIT() asm volatile("s_waitcnt lgkmcnt(0)" ::: "memory")
#define VM_WAIT() asm volatile("s_waitcnt vmcnt(0)" ::: "memory")
__device__ __forceinline__ unsigned long long rt() { return __builtin_amdgcn_s_memrealtime(); }
typedef __bf16 hwbf2 __attribute__((ext_vector_type(2))); typedef float hwf2 __attribute__((ext_vector_type(2)));
__device__ __forceinline__ unsigned f2bf(float f) { return (unsigned)__builtin_bit_cast(unsigned short, (__bf16)f); }
__device__ __forceinline__ unsigned pk2(float lo, float hi) { const hwf2 v = {lo, hi}; return __builtin_bit_cast(unsigned, __builtin_convertvector(v, hwbf2)); }
#define XB_TMO      128
#define XB_XCNT(j)  (256  + 64 * (j))
#define XB_XSUB(j)  (1280 + 64 * (j))
#define XB_XGEN(j)  (2304 + 64 * (j))
#define XB_TOP      3328
#define XB_TOPGEN   3392
#define XCD_BAR_WORDS 3456
#define XB_SPIN_CAP (1u << 18)

__device__ __forceinline__ unsigned xb_ld(unsigned* p)              { return __hip_atomic_load(p, __ATOMIC_RELAXED, __HIP_MEMORY_SCOPE_AGENT); }
__device__ __forceinline__ unsigned xb_add(unsigned* p, unsigned v) { return __hip_atomic_fetch_add(p, v, __ATOMIC_RELAXED, __HIP_MEMORY_SCOPE_AGENT); }
__device__ __forceinline__ unsigned xb_xcc_id() { return (unsigned)__builtin_amdgcn_s_getreg((3 << 11) | 20) & 0xFu; }
#define XB_SPIN(cond, bar) do { unsigned _sp = 0; while (cond) { __builtin_amdgcn_s_sleep(1); \
    if ((++_sp & 255u) == 0u) { if (xb_ld(&(bar)[XB_TMO])) break; if (_sp > XB_SPIN_CAP) { atomicAdd(&(bar)[XB_TMO], 1u); break; } } } } while (0)

struct XcdBarrier {
    unsigned* bar; unsigned x;
    volatile LAS unsigned* st;
};

__device__ __forceinline__ XcdBarrier xcd_barrier_post(unsigned* bar, volatile LAS unsigned* st) {
    XcdBarrier b; b.bar = bar; b.x = xb_xcc_id(); b.st = st;
    if (threadIdx.x == 0) (void)xb_add(&bar[XB_XCNT(b.x)], 1u);
    return b;
}
__device__ __forceinline__ void xcd_barrier_complete(unsigned* bar, unsigned x, unsigned& nloc, unsigned& nx) {
    const unsigned G = gridDim.x * gridDim.y * gridDim.z;
    unsigned sum, cnt, mine, sp = 0u;
    for (;;) {
        sum = 0u; cnt = 0u; mine = 0u;
#pragma unroll
        for (unsigned j = 0; j < 16; ++j) { const unsigned c = xb_ld(&bar[XB_XCNT(j)]); sum += c; cnt += (c > 0u) ? 1u : 0u; mine = (j == x) ? c : mine; }
        if (sum == G) break;
        __builtin_amdgcn_s_sleep(1);
        if ((++sp & 255u) == 0u) { if (xb_ld(&bar[XB_TMO])) break; if (sp > XB_SPIN_CAP) { atomicAdd(&bar[XB_TMO], 1u); break; } }
    }
    nloc = mine > 0u ? mine : 1u; nx = cnt > 0u ? cnt : 1u;
}

__device__ __forceinline__ void xcd_barrier(const XcdBarrier& b) {
    asm volatile("s_waitcnt vmcnt(0)" ::: "memory");
    __syncthreads();
    if (threadIdx.x == 0) {
        unsigned* bar = b.bar;
        __builtin_amdgcn_s_waitcnt(0);
        unsigned nloc = b.st[0], nx = b.st[1];
        if (nloc == 0u) { xcd_barrier_complete(bar, b.x, nloc, nx); b.st[0] = nloc; b.st[1] = nx; }
        const unsigned old = xb_add(&bar[XB_XSUB(b.x)], 1u);
        const unsigned gen = old / nloc;
        if (old + 1u == (gen + 1u) * nloc) {
            __builtin_amdgcn_fence(__ATOMIC_RELEASE, "agent");
            asm volatile("s_waitcnt vmcnt(0)" ::: "memory");
            const unsigned og = xb_add(&bar[XB_TOP], 1u);
            const unsigned tg = og / nx;
            if (og + 1u == (tg + 1u) * nx) xb_add(&bar[XB_TOPGEN], 1u);
            else XB_SPIN(xb_ld(&bar[XB_TOPGEN]) == tg, bar);
            __builtin_amdgcn_fence(__ATOMIC_ACQUIRE, "agent");
            xb_add(&bar[XB_XGEN(b.x)], 1u);
            asm volatile("s_waitcnt vmcnt(0)" ::: "memory");
        } else {
            XB_SPIN(xb_ld(&bar[XB_XGEN(b.x)]) == gen, bar);
            __builtin_amdgcn_fence(__ATOMIC_ACQUIRE, "agent");
            asm volatile("s_waitcnt vmcnt(0)" ::: "memory");
        }
    }
    __syncthreads();
}

constexpr int B_ = 4, T_ = 8192, D_ = 1024, M_ = B_ * T_, L_ = 2;
constexpr int NIN = 3584, NPG = 1792, NPR = 1792;
constexpr int DFF = 2816, NUP = 5632, IN_COLS = 3344;
constexpr size_t MiB = 1u << 20;
constexpr size_t WS_CTL = 0, CTL_ZERO_BYTES = 65536;
constexpr int CW_BAR = 4096;
constexpr size_t WS_RK = MiB / 4;
constexpr size_t WS_MOD = 3 * MiB / 2;
constexpr size_t WS_WIN = 2 * MiB, WS_WOUT = 9 * MiB, WS_WUP = 11 * MiB, WS_WDN = 22 * MiB, WS_LORA = 55 * MiB / 2, WS_GAMC = 28 * MiB, WS_VL = 29 * MiB;
constexpr size_t WS_GAM = 31 * MiB;
constexpr size_t WS_XB = 32 * MiB, WS_O = 96 * MiB, WS_VF = 160 * MiB, WS_GK = 192 * MiB, WS_PG = 224 * MiB, WS_PR = 336 * MiB, WS_END = 512 * MiB;
constexpr size_t WS_RH = WS_XB, WS_YH = WS_XB + 32 * MiB, WS_PP = WS_O, WS_QQ = WS_O + 32 * MiB, WS_GG = 448 * MiB, WS_S0 = 480 * MiB;
constexpr size_t WS_ACT = 224 * MiB, WS_U = 400 * MiB;
constexpr int RING_BYTES = 131072, MISC_OFF = 161792, LDS_BYTES = 163840;
constexpr int NT = 512;

__device__ __forceinline__ float bf2f(bf16 h) { return __builtin_bit_cast(float, (unsigned)h << 16); }
__device__ __forceinline__ float sigmoidf_(float x) { return 1.f / (1.f + __expf(-x)); }
__device__ __forceinline__ float siluf_(float x) { return x / (1.f + __expf(-x)); }
__device__ __forceinline__ float softplusf_(float x) { return fmaxf(x, 0.f) + log1pf(__expf(-fabsf(x))); }

typedef unsigned u32x2 __attribute__((ext_vector_type(2)));
template <int CTRL> __device__ __forceinline__ float dpp_f(float v) {
    return __builtin_bit_cast(float, __builtin_amdgcn_update_dpp(0, __builtin_bit_cast(int, v), CTRL, 0xf, 0xf, false));
}
__device__ __forceinline__ float wave_sum(float v) {
    v += dpp_f<0xB1>(v);
    v += dpp_f<0x4E>(v);
    v += dpp_f<0x141>(v);
    v += dpp_f<0x140>(v);
    v += __builtin_bit_cast(float, __builtin_amdgcn_update_dpp(0, __builtin_bit_cast(int, v), 0x142, 0xa, 0xf, false));
    v += __builtin_bit_cast(float, __builtin_amdgcn_update_dpp(0, __builtin_bit_cast(int, v), 0x143, 0xc, 0xf, false));
    return __builtin_bit_cast(float, __builtin_amdgcn_readlane(__builtin_bit_cast(int, v), 63));
}

struct Ctx { int bid, nb, tid, lane, wave; LAS unsigned char* lds; };

__device__ __forceinline__ void ph_mod(const Ctx& C, const float* c, const float* ada_w, const float* ada_b, float* MOD) {
    LAS float* sc = (LAS float*)C.lds;
    LAS float* red = (LAS float*)(C.lds + 16384);
    for (int i = C.tid; i < 4096; i += NT) sc[i] = siluf_(c[i]);
    __syncthreads();
    for (int item = C.bid; item < 192; item += C.nb) {
        const int l = item / 96, j0 = (item % 96) * 64;
        const float* W = ada_w + (size_t)l * 1024 * 6144 + j0 + C.lane;
        float a0 = 0.f, a1 = 0.f, a2 = 0.f, a3 = 0.f;
        for (int k = C.wave * 128; k < C.wave * 128 + 128; ++k) { const float wv = W[(size_t)k * 6144]; a0 += sc[k] * wv; a1 += sc[1024 + k] * wv; a2 += sc[2048 + k] * wv; a3 += sc[3072 + k] * wv; }
        red[(C.wave * 4 + 0) * 64 + C.lane] = a0; red[(C.wave * 4 + 1) * 64 + C.lane] = a1; red[(C.wave * 4 + 2) * 64 + C.lane] = a2; red[(C.wave * 4 + 3) * 64 + C.lane] = a3;
        __syncthreads();
        if (C.wave < 4) { const int b = C.wave; float s = ada_b[l * 6144 + j0 + C.lane];
#pragma unroll
            for (int w = 0; w < 8; ++w) s += red[(w * 4 + b) * 64 + C.lane];
            MOD[((size_t)l * 4 + b) * 6144 + j0 + C.lane] = s; }
        __syncthreads();
    }
}

__device__ __forceinline__ void wprep_mat(const Ctx& C, const float* W, int K, int Nsrc, int Ndst, bf16* Wt, int mode, const float* vres) {
    const int half = C.tid >> 8, t = C.tid & 255, tx = t & 31, ty = t >> 5;
    LAS float* tile = (LAS float*)C.lds + half * (32 * 33);
    const int nbn = Ndst / 32, ntile = nbn * (K / 32);
    const int niter = (ntile + 2 * C.nb - 1) / (2 * C.nb);
    for (int it = 0; it < niter; ++it) {
        const int item = (it * C.nb + C.bid) * 2 + half;
        const bool act = item < ntile;
        const int n0 = (item % nbn) * 32, k0 = (item / nbn) * 32, n = n0 + tx;
        if (act) {
#pragma unroll
            for (int i = 0; i < 4; ++i) { const int k = k0 + ty + 8 * i; float v = 0.f;
                if (mode == 0) v = W[(size_t)k * Nsrc + n];
                else if (mode == 2) { const int tl = n >> 8, w = n & 255; v = W[(size_t)k * Nsrc + (w < 128 ? tl * 128 + w : 2816 + tl * 128 + (w - 128))]; }
                else { if (n < 1552) v = W[(size_t)k * Nsrc + n]; else if (n < 1584) v = vres ? vres[(size_t)k * 32 + (n - 1552)] : 0.f; else if (n < 1792) v = 0.f; else v = W[(size_t)k * Nsrc + (n - 240)]; }
                tile[(ty + 8 * i) * 33 + tx] = v; }
        }
        __syncthreads();
        if (act) {
#pragma unroll
            for (int i = 0; i < 4; ++i) { const int nn = n0 + ty + 8 * i; Wt[(size_t)nn * K + k0 + tx] = (bf16)f2bf(tile[tx * 33 + ty + 8 * i]); }
        }
        __syncthreads();
    }
}

__device__ __forceinline__ void ph_norm(const Ctx& C, const float* x, const float* g, const float* sh, const float* sc, bf16* XB) {
    const int gw = C.bid * 8 + C.wave, NGW = C.nb * 8, lane = C.lane;
    for (int m = gw; m < M_; m += NGW) {
        const int b = m / T_;
        const f32x4* xr = (const f32x4*)(x + (size_t)m * D_) + lane;
        f32x4 v[4]; float s = 0.f;
#pragma unroll
        for (int j = 0; j < 4; ++j) { v[j] = xr[64 * j]; s += (v[j].x * v[j].x + v[j].y * v[j].y) + (v[j].z * v[j].z + v[j].w * v[j].w); }
        const float rstd = 1.f / sqrtf(wave_sum(s) * (1.f / D_) + 1e-6f);
        unsigned long long* o8 = (unsigned long long*)(XB + (size_t)m * D_) + lane;
#pragma unroll
        for (int j = 0; j < 4; ++j) { const int col = 4 * lane + 256 * j;
            const f32x4 gv = *(const f32x4*)(g + col), shv = *(const f32x4*)(sh + b * 6144 + col), scv = *(const f32x4*)(sc + b * 6144 + col);
            const f32x4 h = v[j] * rstd * gv * (scv + 1.f) + shv;
            o8[64 * j] = (unsigned long long)pk2(h.x, h.y) | ((unsigned long long)pk2(h.z, h.w) << 32); }
    }
}
__device__ __forceinline__ void ph_final(const Ctx& C, float* x, const float* g) {
    const int gw = C.bid * 8 + C.wave, NGW = C.nb * 8, lane = C.lane;
    for (int m = gw; m < M_; m += NGW) {
        f32x4* xr = (f32x4*)(x + (size_t)m * D_) + lane;
        f32x4 v[4]; float s = 0.f;
#pragma unroll
        for (int j = 0; j < 4; ++j) { v[j] = xr[64 * j]; s += (v[j].x * v[j].x + v[j].y * v[j].y) + (v[j].z * v[j].z + v[j].w * v[j].w); }
        const float rstd = 1.f / sqrtf(wave_sum(s) * (1.f / D_) + 1e-6f);
#pragma unroll
        for (int j = 0; j < 4; ++j) { const f32x4 gv = *(const f32x4*)(g + 4 * lane + 256 * j); xr[64 * j] = v[j] * rstd * gv; }
    }
}


typedef short s16x8 __attribute__((ext_vector_type(8)));
__device__ __forceinline__ f32x4 mm16(const LAS bf16* A, int lda, const LAS bf16* B, int ldb, int K, f32x4 acc, int lane) {
    const int r = lane & 15, g = lane >> 4;
    const LAS bf16* ap = A + r * lda + 8 * g; const LAS bf16* bp = B + r * ldb + 8 * g;
    for (int k0 = 0; k0 < K; k0 += 32) { const s16x8 a = *(const LAS s16x8*)(ap + k0); const s16x8 b = *(const LAS s16x8*)(bp + k0); acc = __builtin_amdgcn_mfma_f32_16x16x32_bf16(a, b, acc, 0, 0, 0); }
    return acc;
}
__device__ __forceinline__ f32x4 mm16_ga(const bf16* A, int lda, const LAS bf16* B, int ldb, int K, f32x4 acc, int lane) {
    const int r = lane & 15, g = lane >> 4;
    const bf16* ap = A + r * lda + 8 * g; const LAS bf16* bp = B + r * ldb + 8 * g;
    for (int k0 = 0; k0 < K; k0 += 32) { const s16x8 a = *(const s16x8*)(ap + k0); const s16x8 b = *(const LAS s16x8*)(bp + k0); acc = __builtin_amdgcn_mfma_f32_16x16x32_bf16(a, b, acc, 0, 0, 0); }
    return acc;
}
__device__ __forceinline__ unsigned long long pack4(f32x4 v) { return (unsigned long long)pk2(v.x, v.y) | ((unsigned long long)pk2(v.z, v.w) << 32); }
__device__ __forceinline__ float logsigmoidf_(float x) { return fminf(x, 0.f) - __logf(1.f + __expf(-fabsf(x))); }

constexpr int GL_LD = 72;
constexpr int GL_GK = 0;
constexpr int GL_SEG = 16384;
constexpr int GL_Z = 18432;
constexpr int GL_GUP = 20480;
constexpr int GL_I0 = 24832;
constexpr int GL_I1 = GL_I0 + 9216;
constexpr int GL_I2 = GL_I1 + 9216;
constexpr int GL_VT = GL_I2 + 9216;
constexpr int GL_SSQ = GL_VT + 18432;
static_assert(GL_SSQ + 512 <= RING_BYTES, "GLA LDS map");

__device__ __forceinline__ void gla_gates(const Ctx& C, const bf16* pg  , const float* gk_up, const float* gk_b, int h) {
    LAS float* GK = (LAS float*)(C.lds + GL_GK); LAS float* SEG = (LAS float*)(C.lds + GL_SEG); LAS bf16* Z = (LAS bf16*)(C.lds + GL_Z); LAS float* GUP = (LAS float*)(C.lds + GL_GUP);
    const int tid = C.tid;
    if (tid < 128) { const int t = tid >> 1, hh = tid & 1; *(LAS v4u*)(Z + t * 16 + hh * 8) = *(const v4u*)(pg + (size_t)t * NPG + 1536 + hh * 8); }
    for (int i = tid; i < 16 * 64; i += NT) GUP[i] = gk_up[(i >> 6) * 256 + h * 64 + (i & 63)];
    if (tid < 64) GUP[1024 + tid] = gk_b[h * 64 + tid];
    __syncthreads();
    { const int t = tid >> 3, d0 = (tid & 7) * 8; float a[8];
#pragma unroll
      for (int q = 0; q < 8; ++q) a[q] = GUP[1024 + d0 + q];
#pragma unroll
      for (int i = 0; i < 16; ++i) { const float zv = bf2f(Z[t * 16 + i]);
#pragma unroll
          for (int q = 0; q < 8; ++q) a[q] += zv * GUP[i * 64 + d0 + q]; }
#pragma unroll
      for (int q = 0; q < 8; ++q) GK[t * 64 + d0 + q] = logsigmoidf_(a[q]) * (1.f / 16.f); }
    __syncthreads();
    { const int d = tid & 63, seg = tid >> 6; float run = 0.f;
#pragma unroll
      for (int q = 0; q < 8; ++q) { run += GK[(seg * 8 + q) * 64 + d]; GK[(seg * 8 + q) * 64 + d] = run; }
      SEG[seg * 64 + d] = run; }
    __syncthreads();
    { const int d = tid & 63, seg = tid >> 6; float off = 0.f;
      for (int s = 0; s < seg; ++s) off += SEG[s * 64 + d];
#pragma unroll
      for (int q = 0; q < 8; ++q) GK[(seg * 8 + q) * 64 + d] += off; }
    __syncthreads();
}
__device__ __forceinline__ void gla_stage_vt(const Ctx& C, const bf16* pg, int h) {
    LAS bf16* VT = (LAS bf16*)(C.lds + GL_VT);
    const int j = C.tid >> 3, e0 = (C.tid & 7) * 16;
    const v4u x0 = *(const v4u*)(pg + (size_t)j * NPG + 512 + h * 128 + e0), x1 = *(const v4u*)(pg + (size_t)j * NPG + 512 + h * 128 + e0 + 8);
    const unsigned w[8] = {x0.x, x0.y, x0.z, x0.w, x1.x, x1.y, x1.z, x1.w};
#pragma unroll
    for (int q = 0; q < 8; ++q) { VT[(e0 + 2 * q) * GL_LD + j] = (bf16)(w[q] & 0xffffu); VT[(e0 + 2 * q + 1) * GL_LD + j] = (bf16)(w[q] >> 16); }
}

__device__ __forceinline__ void ph_gla_a(const Ctx& C, const bf16* PG, const float* gk_up, const float* gk_b, bf16* DS, float* GAM, bf16* VL) {
    LAS float* GK = (LAS float*)(C.lds + GL_GK); LAS bf16* KT = (LAS bf16*)(C.lds + GL_I0); LAS bf16* VT = (LAS bf16*)(C.lds + GL_VT);
    for (int item = C.bid; item < 2048; item += C.nb) {
        const int bh = item >> 7, c = item & 127, b = bh >> 2, h = bh & 3;
        const size_t m0 = (size_t)b * T_ + c * 64;
        const bf16* pg = PG + m0 * NPG;
        gla_gates(C, pg, gk_up, gk_b, h);
        { const int j = C.tid >> 3, d0 = (C.tid & 7) * 8;
          const v4u kx = *(const v4u*)(pg + (size_t)j * NPG + 256 + h * 64 + d0);
          const unsigned w[4] = {kx.x, kx.y, kx.z, kx.w};
#pragma unroll
          for (int q = 0; q < 4; ++q) { const float k0 = bf2f((bf16)(w[q] & 0xffffu)), k1 = bf2f((bf16)(w[q] >> 16));
              const int d = d0 + 2 * q;
              KT[d * GL_LD + j] = (bf16)f2bf(k0 * __expf(GK[63 * 64 + d] - GK[j * 64 + d]));
              KT[(d + 1) * GL_LD + j] = (bf16)f2bf(k1 * __expf(GK[63 * 64 + d + 1] - GK[j * 64 + d + 1])); } }
        gla_stage_vt(C, pg, h);
        if (C.tid < 64) GAM[(size_t)item * 64 + C.tid] = __expf(GK[63 * 64 + C.tid]);
        if (h == 0 && C.tid < 256) { const int t = C.tid >> 2, q = C.tid & 3; *(unsigned long long*)(VL + (m0 + t) * 32 + q * 8 + 0) = *(const unsigned long long*)(pg + (size_t)t * NPG + 1552 + q * 8);
                                     *(unsigned long long*)(VL + (m0 + t) * 32 + q * 8 + 4) = *(const unsigned long long*)(pg + (size_t)t * NPG + 1552 + q * 8 + 4); }
        __syncthreads();
        { const int n0 = C.wave * 16, lane = C.lane, cc = lane & 15, g = lane >> 4;
          bf16* out = DS + (size_t)item * 8192 + (size_t)(n0 + cc) * 64 + 4 * g;
#pragma unroll
          for (int mt = 0; mt < 4; ++mt) { f32x4 acc = {0.f, 0.f, 0.f, 0.f}; acc = mm16(KT + mt * 16 * GL_LD, GL_LD, VT + n0 * GL_LD, GL_LD, 64, acc, lane);
              *(unsigned long long*)(out + mt * 16) = pack4(acc); } }
        __syncthreads();
    }
}
__device__ __forceinline__ void ph_gla_b(const Ctx& C, bf16* DS, const float* GAM) {
    for (int idx = C.bid * NT + C.tid; idx < 16 * 8192; idx += C.nb * NT) {
        const int bh = idx >> 13, ed = idx & 8191, d = ed & 63;
        bf16* p = DS + (size_t)bh * 128 * 8192 + ed; const float* gp = GAM + (size_t)bh * 128 * 64 + d;
        float S = 0.f;
        for (int c0 = 0; c0 < 128; c0 += 8) {
            float ds[8], gm[8];
#pragma unroll
            for (int i = 0; i < 8; ++i) { ds[i] = bf2f(p[(size_t)(c0 + i) * 8192]); gm[i] = gp[(c0 + i) * 64]; }
#pragma unroll
            for (int i = 0; i < 8; ++i) { const float gs = gm[i] * S; p[(size_t)(c0 + i) * 8192] = (bf16)f2bf(gs); S = gs + ds[i]; }
        }
    }
}
__device__ __forceinline__ void ph_gla_c(const Ctx& C, const bf16* PG, const float* gk_up, const float* gk_b, const float* norm_g, const bf16* DS, bf16* O) {
    LAS float* GK = (LAS float*)(C.lds + GL_GK); LAS bf16* QP = (LAS bf16*)(C.lds + GL_I0); LAS bf16* KM = (LAS bf16*)(C.lds + GL_I1); LAS bf16* AI = (LAS bf16*)(C.lds + GL_I2);
    LAS bf16* VT = (LAS bf16*)(C.lds + GL_VT); LAS float* SSQ = (LAS float*)(C.lds + GL_SSQ);
    for (int item = C.bid; item < 2048; item += C.nb) {
        const int bh = item >> 7, c = item & 127, b = bh >> 2, h = bh & 3;
        const size_t m0 = (size_t)b * T_ + c * 64;
        const bf16* pg = PG + m0 * NPG;
        gla_gates(C, pg, gk_up, gk_b, h);
        { const int j = C.tid >> 3, d0 = (C.tid & 7) * 8;
          const v4u qx = *(const v4u*)(pg + (size_t)j * NPG + h * 64 + d0), kx = *(const v4u*)(pg + (size_t)j * NPG + 256 + h * 64 + d0);
          const unsigned qw[4] = {qx.x, qx.y, qx.z, qx.w}, kw[4] = {kx.x, kx.y, kx.z, kx.w};
          unsigned qo[4], ko[4];
#pragma unroll
          for (int q = 0; q < 4; ++q) { const int d = d0 + 2 * q;
              const float e0 = GK[63 * 64 + d] - GK[j * 64 + d], e1 = GK[63 * 64 + d + 1] - GK[j * 64 + d + 1];
              const float q0 = 0.125f * bf2f((bf16)(qw[q] & 0xffffu)) * __expf(-e0), q1 = 0.125f * bf2f((bf16)(qw[q] >> 16)) * __expf(-e1);
              const float k0 = bf2f((bf16)(kw[q] & 0xffffu)) * __expf(e0), k1 = bf2f((bf16)(kw[q] >> 16)) * __expf(e1);
              qo[q] = pk2(q0, q1); ko[q] = pk2(k0, k1); }
          *(LAS v4u*)(QP + j * GL_LD + d0) = (v4u){qo[0], qo[1], qo[2], qo[3]}; *(LAS v4u*)(KM + j * GL_LD + d0) = (v4u){ko[0], ko[1], ko[2], ko[3]}; }
        gla_stage_vt(C, pg, h);
        __syncthreads();
        { const int lane = C.lane, cc = lane & 15, g = lane >> 4, n0 = (C.wave >> 1) * 16;
#pragma unroll
          for (int q = 0; q < 2; ++q) { const int mt0 = ((C.wave & 1) * 2 + q) * 16; f32x4 acc = {0.f, 0.f, 0.f, 0.f};
              acc = mm16(KM + mt0 * GL_LD, GL_LD, QP + n0 * GL_LD, GL_LD, 64, acc, lane);
              const int i = n0 + cc, j = mt0 + 4 * g;
              acc.x = (j + 0 <= i) ? acc.x : 0.f; acc.y = (j + 1 <= i) ? acc.y : 0.f; acc.z = (j + 2 <= i) ? acc.z : 0.f; acc.w = (j + 3 <= i) ? acc.w : 0.f;
              *(LAS unsigned long long*)(AI + (n0 + cc) * GL_LD + mt0 + 4 * g) = pack4(acc); } }
        __syncthreads();
        { const int lane = C.lane, cc = lane & 15, g = lane >> 4, n0 = (C.wave & 3) * 16, eh = C.wave >> 2;
          const bf16* Sg = DS + (size_t)item * 8192;
          f32x4 acc[4]; float ss = 0.f;
#pragma unroll
          for (int mt = 0; mt < 4; ++mt) { const int e0 = eh * 64 + mt * 16; acc[mt] = (f32x4){0.f, 0.f, 0.f, 0.f};
              acc[mt] = mm16_ga(Sg + (size_t)e0 * 64, 64, QP + n0 * GL_LD, GL_LD, 64, acc[mt], lane);
              acc[mt] = mm16(VT + e0 * GL_LD, GL_LD, AI + n0 * GL_LD, GL_LD, 64, acc[mt], lane);
              ss += (acc[mt].x * acc[mt].x + acc[mt].y * acc[mt].y) + (acc[mt].z * acc[mt].z + acc[mt].w * acc[mt].w); }
          ss += __shfl_xor(ss, 16); ss += __shfl_xor(ss, 32);
          if (g == 0) SSQ[eh * 64 + n0 + cc] = ss;
          __syncthreads();
          const float rstd = 1.f / sqrtf((SSQ[n0 + cc] + SSQ[64 + n0 + cc]) * (1.f / 128.f) + 1e-6f);
          const size_t m = m0 + n0 + cc;
#pragma unroll
          for (int mt = 0; mt < 4; ++mt) { const int e = eh * 64 + mt * 16 + 4 * g;
              const unsigned long long gx = *(const unsigned long long*)(pg + (size_t)(n0 + cc) * NPG + 1024 + h * 128 + e);
              const f32x4 ng = *(const f32x4*)(norm_g + e);
              f32x4 o;
              o.x = acc[mt].x * rstd * ng.x * siluf_(bf2f((bf16)(gx & 0xffffu)));
              o.y = acc[mt].y * rstd * ng.y * siluf_(bf2f((bf16)((gx >> 16) & 0xffffu)));
              o.z = acc[mt].z * rstd * ng.z * siluf_(bf2f((bf16)((gx >> 32) & 0xffffu)));
              o.w = acc[mt].w * rstd * ng.w * siluf_(bf2f((bf16)(gx >> 48)));
              *(unsigned long long*)(O + m * D_ + h * 128 + e) = pack4(o); } }
        __syncthreads();
    }
}


struct RwkvW { const float *mu, *mu_vres, *w0, *a0, *v0, *k_k, *k_a, *r_k; const bf16 *wupT, *aupT, *gupT, *vupT; };
constexpr int RW_LD = 72, RW_XLD = 296;
constexpr int RW_R0 = 0;
constexpr int RW_SEG = 16384;
constexpr int RW_R1 = 36864;
constexpr int RW_R2 = RW_R1 + 27648;
constexpr int RW_R3 = RW_R2 + 9216;
constexpr int RW_R4 = RW_R3 + 27648;
constexpr int RW_TI = RW_R4 + 128 * RW_LD * 2;
constexpr int RW_MU = RW_TI + 2048;
constexpr int RW_X = RW_MU + 2048;
constexpr int RW_END = RW_X + 64 * RW_XLD * 2;
static_assert(RW_END <= MISC_OFF, "RWKV LDS map");

typedef short s16x4 __attribute__((ext_vector_type(4)));
__device__ __forceinline__ float tanh_fast(float x) { const float e = __expf(2.f * x); return 1.f - 2.f / (e + 1.f); }
__device__ __forceinline__ float softplus_fast(float x) { return fmaxf(x, 0.f) + __logf(1.f + __expf(-fabsf(x))); }
__device__ __forceinline__ s16x4 cvt4(f32x4 v) { const unsigned long long p = pack4(v); return __builtin_bit_cast(s16x4, p); }
__device__ __forceinline__ void ld8f(const float* p, float (&o)[8]) { const f32x4 a = *(const f32x4*)p, b = *(const f32x4*)(p + 4); o[0] = a.x; o[1] = a.y; o[2] = a.z; o[3] = a.w; o[4] = b.x; o[5] = b.y; o[6] = b.z; o[7] = b.w; }
__device__ __forceinline__ float sum8(float v) { v += dpp_f<0xB1>(v); v += dpp_f<0x4E>(v); v += dpp_f<0x141>(v); return v; }
__device__ __forceinline__ void unpack8(const v4u x, float (&o)[8]) {
    o[0] = bf2f((bf16)(x.x & 0xffffu)); o[1] = bf2f((bf16)(x.x >> 16)); o[2] = bf2f((bf16)(x.y & 0xffffu)); o[3] = bf2f((bf16)(x.y >> 16));
    o[4] = bf2f((bf16)(x.z & 0xffffu)); o[5] = bf2f((bf16)(x.z >> 16)); o[6] = bf2f((bf16)(x.w & 0xffffu)); o[7] = bf2f((bf16)(x.w >> 16)); }
__device__ __forceinline__ v4u pack8(const float (&o)[8]) { return (v4u){pk2(o[0], o[1]), pk2(o[2], o[3]), pk2(o[4], o[5]), pk2(o[6], o[7])}; }
__device__ __forceinline__ f32x4 mm16_gb(const LAS bf16* A, int lda, const bf16* B, int ldb, int K, f32x4 acc, int lane) {
    const int r = lane & 15, g = lane >> 4;
    const LAS bf16* ap = A + r * lda + 8 * g; const bf16* bp = B + r * ldb + 8 * g;
    for (int k0 = 0; k0 < K; k0 += 32) { const s16x8 a = *(const LAS s16x8*)(ap + k0); const s16x8 b = *(const s16x8*)(bp + k0); acc = __builtin_amdgcn_mfma_f32_16x16x32_bf16(a, b, acc, 0, 0, 0); }
    return acc;
}

__device__ __forceinline__ void ph_rwkv_a(const Ctx& C, const bf16* PR, const bf16* VL  , const RwkvW& W, int layer,
                                          bf16* PP, bf16* QQ, bf16* RH, bf16* YH, float* GAMC, float* RK, bf16* GG, bf16* VF, bool store_v = true) {
    LAS unsigned char* L = C.lds;
    LAS bf16* X = (LAS bf16*)(L + RW_X); LAS float* CUM = (LAS float*)(L + RW_R0); LAS float* SEG = (LAS float*)(L + RW_SEG);
    LAS bf16* NI = (LAS bf16*)(L + RW_R0), *AAK = NI + 64 * RW_LD, *ARB = AAK + 64 * RW_LD, *ARK = ARB + 64 * RW_LD;
    LAS bf16* PRE = (LAS bf16*)(L + RW_R1);
    LAS bf16* AT = (LAS bf16*)(L + RW_R1), *BT = AT + 64 * RW_LD, *KT = BT + 64 * RW_LD, *RT = (LAS bf16*)(L + RW_R2);
    LAS bf16* XB16 = (LAS bf16*)(L + RW_R1);
    LAS bf16* BHc = (LAS bf16*)(L + RW_R3), *KHc = BHc + 64 * RW_LD, *VTc = KHc + 64 * RW_LD;
    LAS bf16* XT = (LAS bf16*)(L + RW_R4); LAS bf16* TI = (LAS bf16*)(L + RW_TI);
    const int wave = C.wave;
    LAS float* MU = (LAS float*)(L + RW_MU);
    for (int i = C.tid; i < 288; i += NT) MU[i] = i < 256 ? W.mu[1536 + i] : (layer ? W.mu_vres[i - 256] : 0.f);
    __syncthreads();
    for (int bc = C.bid; bc < 512; bc += C.nb) {
        const int c = bc & 127, b = bc >> 7;
        const size_t m0 = (size_t)b * T_ + c * 64;
        { const int tid = C.tid;
          v4u xc[5], xp[5];
#pragma unroll
          for (int it = 0; it < 5; ++it) { const int idx = tid + it * NT; xc[it] = (v4u){0u, 0u, 0u, 0u}; xp[it] = xc[it];
            if (idx < 64 * 36) { const int t1 = idx / 36, q = idx % 36, col = q * 8; const size_t m1 = m0 + t1; const bool first1 = (c == 0 && t1 == 0);
                if (q < 32) { xc[it] = *(const v4u*)(PR + m1 * NPR + 1536 + col); if (!first1) xp[it] = *(const v4u*)(PR + (m1 - 1) * NPR + 1536 + col); }
                else if (layer) { xc[it] = *(const v4u*)(VL + m1 * NPG + 1552 + (col - 256)); if (!first1) xp[it] = *(const v4u*)(VL + (m1 - 1) * NPG + 1552 + (col - 256)); } } }
#pragma unroll
          for (int it = 0; it < 5; ++it) { const int idx = tid + it * NT;
            if (idx < 64 * 36) { const int t1 = idx / 36, q = idx % 36, col = q * 8;
                float cv[8], pv[8], mu[8]; unpack8(xc[it], cv); unpack8(xp[it], pv);
                { const f32x4 ma = *(const LAS f32x4*)(MU + col), mb = *(const LAS f32x4*)(MU + col + 4); mu[0] = ma.x; mu[1] = ma.y; mu[2] = ma.z; mu[3] = ma.w; mu[4] = mb.x; mu[5] = mb.y; mu[6] = mb.z; mu[7] = mb.w; }
#pragma unroll
                for (int i = 0; i < 8; ++i) { float p = cv[i] + (pv[i] - cv[i]) * mu[i]; if (q < 8) p = tanh_fast(p); else if (q >= 16 && q < 32) p = sigmoidf_(p); cv[i] = p; }
                *(LAS v4u*)(X + t1 * RW_XLD + col) = pack8(cv); } }
        }
        __syncthreads();
#pragma unroll 1
      for (int h = 0; h < 8; ++h) {
        const int item = bc * 8 + h;
        int tid_ = C.tid; asm volatile("" : "+v"(tid_));
        const int tid = tid_, lane = tid & 63, cc = lane & 15, g = lane >> 4;
        const int t = tid >> 3, d0 = (tid & 7) * 8, ch = h * 64 + d0; const size_t m = m0 + t; const bool first = (c == 0 && t == 0);
        v4u rcx = *(const v4u*)(PR + m * NPR + ch), kcx = *(const v4u*)(PR + m * NPR + 512 + ch), vcx = *(const v4u*)(PR + m * NPR + 1024 + ch);
        v4u rpx = (v4u){0u, 0u, 0u, 0u}, kpx = rpx, vpx = rpx, vfx = rpx;
        if (!first) { rpx = *(const v4u*)(PR + (m - 1) * NPR + ch); kpx = *(const v4u*)(PR + (m - 1) * NPR + 512 + ch); vpx = *(const v4u*)(PR + (m - 1) * NPR + 1024 + ch); }
        if (layer) vfx = *(const v4u*)(VF + m * 512 + ch);
        {
            const int lsel = wave >> 1;
            const bf16* WT = lsel == 0 ? W.wupT : lsel == 1 ? W.aupT : lsel == 2 ? W.gupT : W.vupT;
            const int Kl = lsel == 2 ? 128 : lsel == 3 ? 32 : 64, xoff = lsel == 0 ? 0 : lsel == 1 ? 64 : lsel == 2 ? 128 : 256;
            LAS bf16* outp = PRE + lsel * 64 * RW_LD;
            const bool live = (lsel != 3 || layer);
#pragma unroll
            for (int mq = 0; mq < 2; ++mq) { const int mt = (wave & 1) * 2 + mq;
                s16x8 af[4];
                const bf16* ap = WT + (size_t)(h * 64 + mt * 16 + cc) * Kl + 8 * g;
#pragma unroll
                for (int ks = 0; ks < 4; ++ks) af[ks] = (live && ks * 32 < Kl) ? *(const s16x8*)(ap + ks * 32) : (s16x8){0, 0, 0, 0, 0, 0, 0, 0};
#pragma unroll
                for (int nt = 0; nt < 4; ++nt) { f32x4 acc = {0.f, 0.f, 0.f, 0.f};
                    const LAS bf16* bp = X + (nt * 16 + cc) * RW_XLD + xoff + 8 * g;
#pragma unroll
                    for (int ks = 0; ks < 4; ++ks) if (ks * 32 < Kl) { const s16x8 bb = *(const LAS s16x8*)(bp + ks * 32); acc = __builtin_amdgcn_mfma_f32_16x16x32_bf16(af[ks], bb, acc, 0, 0, 0); }
                    *(LAS unsigned long long*)(outp + (nt * 16 + cc) * RW_LD + mt * 16 + 4 * g) = pack4(acc); } }
        }
        __syncthreads();
        float av[8], bv[8], kv[8], rv[8], lw[8], vv[8];
        {
            float rc[8], rp[8], kc[8], kp[8], vc[8], vp[8], pw[8], pa[8], pg_[8], pvg[8];
            unpack8(rcx, rc); unpack8(kcx, kc); unpack8(vcx, vc); unpack8(rpx, rp); unpack8(kpx, kp); unpack8(vpx, vp);
            unpack8(*(const LAS v4u*)(PRE + (0 * 64 + t) * RW_LD + d0), pw); unpack8(*(const LAS v4u*)(PRE + (1 * 64 + t) * RW_LD + d0), pa);
            unpack8(*(const LAS v4u*)(PRE + (2 * 64 + t) * RW_LD + d0), pg_); unpack8(*(const LAS v4u*)(PRE + (3 * 64 + t) * RW_LD + d0), pvg);
            float vf[8]; unpack8(vfx, vf);
            float ssq = 0.f, rks = 0.f, asg[8], gg[8];
            float mur[8], muk[8], muv[8], w0c[8], a0c[8], v0c[8], kkc[8], kac[8], rkc[8];
            ld8f(W.mu + ch, mur); ld8f(W.mu + 512 + ch, muk); ld8f(W.mu + 1024 + ch, muv); ld8f(W.w0 + ch, w0c); ld8f(W.a0 + ch, a0c);
            ld8f(W.k_k + ch, kkc); ld8f(W.k_a + ch, kac); ld8f(W.r_k + ch, rkc);
            if (layer) ld8f(W.v0 + ch, v0c);
#pragma unroll
            for (int i = 0; i < 8; ++i) {
                const float r = rc[i] + (rp[i] - rc[i]) * mur[i], k = kc[i] + (kp[i] - kc[i]) * muk[i]; float v = vc[i] + (vp[i] - vc[i]) * muv[i];
                lw[i] = -0.6065306597f * sigmoidf_(w0c[i] + pw[i]);
                asg[i] = sigmoidf_(a0c[i] + pa[i]);
                if (layer) v = v + (vf[i] - v) * sigmoidf_(v0c[i] + pvg[i]);
                const float kk = k * kkc[i]; ssq += kk * kk;
                kv[i] = k * (1.f + (asg[i] - 1.f) * kac[i]); rv[i] = r; vv[i] = v; gg[i] = pg_[i]; av[i] = kk;
                rks += r * kv[i] * rkc[i];
            }
            ssq = sum8(ssq); rks = sum8(rks);
            const float inv = 1.f / sqrtf(fmaxf(ssq, 1e-24f));
#pragma unroll
            for (int i = 0; i < 8; ++i) { const float kk = av[i] * inv; av[i] = -kk; bv[i] = kk * asg[i]; }
            if ((tid & 7) == 0) RK[m * 8 + h] = rks;
            *(v4u*)(GG + m * 512 + ch) = pack8(gg);
            if (store_v) *(v4u*)(VF + m * 512 + ch) = pack8(vv);
#pragma unroll
            for (int i = 0; i < 8; ++i) vv[i] = bf2f((bf16)f2bf(vv[i]));
        }
        __syncthreads();
#pragma unroll
        for (int i = 0; i < 8; ++i) CUM[t * 64 + d0 + i] = lw[i];
        __syncthreads();
        { const int d = tid & 63, seg = tid >> 6; float run = 0.f;
#pragma unroll
          for (int q = 0; q < 8; ++q) { run += CUM[(seg * 8 + q) * 64 + d]; CUM[(seg * 8 + q) * 64 + d] = run; }
          SEG[seg * 64 + d] = run; }
        __syncthreads();
        { const int d = tid & 63, seg = tid >> 6; float off = 0.f;
          for (int s = 0; s < seg; ++s) off += SEG[s * 64 + d];
#pragma unroll
          for (int q = 0; q < 8; ++q) CUM[(seg * 8 + q) * 64 + d] += off; }
        __syncthreads();
        {
            float at[8], bt[8], kt[8], rt[8];
#pragma unroll
            for (int i = 0; i < 8; ++i) { const float cu = CUM[t * 64 + d0 + i], cC = CUM[63 * 64 + d0 + i], en = __expf(-cu), ec = __expf(cC - cu);
                at[i] = av[i] * __expf(cu - lw[i]); bt[i] = bv[i] * en; kt[i] = kv[i] * en; rt[i] = rv[i] * __expf(cu);
                BHc[(d0 + i) * RW_LD + t] = (bf16)f2bf(bv[i] * ec); KHc[(d0 + i) * RW_LD + t] = (bf16)f2bf(kv[i] * ec); VTc[(d0 + i) * RW_LD + t] = (bf16)f2bf(vv[i]);
                XT[(d0 + i) * RW_LD + t] = (bf16)f2bf(at[i]);
                if (t == 63) GAMC[(size_t)item * 64 + d0 + i] = __expf(cC); }
            *(LAS v4u*)(AT + t * RW_LD + d0) = pack8(at); *(LAS v4u*)(BT + t * RW_LD + d0) = pack8(bt); *(LAS v4u*)(KT + t * RW_LD + d0) = pack8(kt); *(LAS v4u*)(RT + t * RW_LD + d0) = pack8(rt);
        }
        __syncthreads();
        {
            const int msel = wave >> 1;
            const LAS bf16* As = (msel == 0 || msel == 2) ? BT : KT; const LAS bf16* Bs = (msel < 2) ? AT : RT;
            f32x4 accs[8];
#pragma unroll
            for (int q = 0; q < 8; ++q) { const int tile = (wave & 1) * 8 + q, mt = tile >> 2, nt = tile & 3; accs[q] = (f32x4){0.f, 0.f, 0.f, 0.f};
                accs[q] = mm16(As + mt * 16 * RW_LD, RW_LD, Bs + nt * 16 * RW_LD, RW_LD, 64, accs[q], lane);
                const int tt = nt * 16 + cc, s0 = mt * 16 + 4 * g, lim = (msel < 2) ? tt - 1 : tt;
                accs[q].x = (s0 + 0 <= lim) ? accs[q].x : 0.f; accs[q].y = (s0 + 1 <= lim) ? accs[q].y : 0.f; accs[q].z = (s0 + 2 <= lim) ? accs[q].z : 0.f; accs[q].w = (s0 + 3 <= lim) ? accs[q].w : 0.f; }
            __syncthreads();
            LAS bf16* outp = NI + msel * 64 * RW_LD;
#pragma unroll
            for (int q = 0; q < 8; ++q) { const int tile = (wave & 1) * 8 + q, mt = tile >> 2, nt = tile & 3;
                *(LAS unsigned long long*)(outp + (nt * 16 + cc) * RW_LD + mt * 16 + 4 * g) = pack4(accs[q]); }
        }
        __syncthreads();
        if (wave == 0) {
            const int blk = lane >> 4, col = lane & 15; float x[16];
#pragma unroll
            for (int tt = 0; tt < 16; ++tt) { float nr[16]; { float lo[8], hi[8]; unpack8(*(const LAS v4u*)(NI + (16 * blk + tt) * RW_LD + 16 * blk), lo); unpack8(*(const LAS v4u*)(NI + (16 * blk + tt) * RW_LD + 16 * blk + 8), hi);
#pragma unroll
                    for (int q = 0; q < 8; ++q) { nr[q] = lo[q]; nr[8 + q] = hi[q]; } }
                float a = (tt == col) ? 1.f : 0.f;
#pragma unroll
                for (int q = 0; q < tt; ++q) a += nr[q] * x[q];
                x[tt] = a; TI[(blk * 16 + tt) * 16 + col] = (bf16)f2bf(a); }
        } else {
            for (int tile = wave - 1; tile < 16; tile += 7) { const int mt = tile >> 2, nt = tile & 3;
                f32x4 acc = {0.f, 0.f, 0.f, 0.f}; acc = mm16(AAK + mt * 16 * RW_LD, RW_LD, VTc + nt * 16 * RW_LD, RW_LD, 64, acc, lane);
                *(LAS unsigned long long*)(XT + (64 + nt * 16 + cc) * RW_LD + mt * 16 + 4 * g) = pack4(acc); }
        }
        __syncthreads();
        {
            s16x4 xb[4];
#pragma unroll
            for (int i = 0; i < 4; ++i) {
                f32x4 acc; { const unsigned long long xr = *(const LAS unsigned long long*)(XT + (wave * 16 + cc) * RW_LD + 16 * i + 4 * g);
                    acc.x = bf2f((bf16)(xr & 0xffffu)); acc.y = bf2f((bf16)((xr >> 16) & 0xffffu)); acc.z = bf2f((bf16)((xr >> 32) & 0xffffu)); acc.w = bf2f((bf16)(xr >> 48)); }
#pragma unroll
                for (int k = 0; k < i; ++k) { const s16x4 a = *(const LAS s16x4*)(NI + (16 * i + cc) * RW_LD + 16 * k + 4 * g); acc = __builtin_amdgcn_mfma_f32_16x16x16bf16_1k(a, xb[k], acc, 0, 0, 0); }
                const s16x4 yb = cvt4(acc), ta = *(const LAS s16x4*)(TI + (i * 16 + cc) * 16 + 4 * g);
                const f32x4 xi = __builtin_amdgcn_mfma_f32_16x16x16bf16_1k(ta, yb, (f32x4){0.f, 0.f, 0.f, 0.f}, 0, 0, 0);
                xb[i] = cvt4(xi);
            }
            __syncthreads();
#pragma unroll
            for (int i = 0; i < 4; ++i) *(LAS s16x4*)(XB16 + (wave * 16 + cc) * RW_LD + 16 * i + 4 * g) = xb[i];
        }
        __syncthreads();
        {
            const int osel = wave >> 1; const size_t ob = (size_t)item * 4096;
#pragma unroll 1
            for (int q = 0; q < 8; ++q) { const int tile = (wave & 1) * 8 + q, mt = tile >> 2, nt = tile & 3; f32x4 acc = {0.f, 0.f, 0.f, 0.f};
                if (osel == 0) {
                    acc = mm16(XB16 + mt * 16 * RW_LD, RW_LD, BHc + nt * 16 * RW_LD, RW_LD, 64, acc, lane);
                    *(unsigned long long*)(PP + ob + (nt * 16 + cc) * 64 + mt * 16 + 4 * g) = pack4(acc);
                } else if (osel == 1) {
                    acc = mm16(BHc + mt * 16 * RW_LD, RW_LD, XB16 + (64 + nt * 16) * RW_LD, RW_LD, 64, acc, lane);
                    acc = mm16(KHc + mt * 16 * RW_LD, RW_LD, VTc + nt * 16 * RW_LD, RW_LD, 64, acc, lane);
                    *(unsigned long long*)(QQ + ob + (nt * 16 + cc) * 64 + mt * 16 + 4 * g) = pack4(acc);
                } else if (osel == 2) {
                    acc = mm16(XB16 + mt * 16 * RW_LD, RW_LD, ARB + nt * 16 * RW_LD, RW_LD, 64, acc, lane);
                    const unsigned long long rr = *(const LAS unsigned long long*)(RT + (nt * 16 + cc) * RW_LD + mt * 16 + 4 * g);
                    acc.x += bf2f((bf16)(rr & 0xffffu)); acc.y += bf2f((bf16)((rr >> 16) & 0xffffu)); acc.z += bf2f((bf16)((rr >> 32) & 0xffffu)); acc.w += bf2f((bf16)(rr >> 48));
                    *(unsigned long long*)(RH + ob + (nt * 16 + cc) * 64 + mt * 16 + 4 * g) = pack4(acc);
                } else {
                    acc = mm16(XB16 + (64 + mt * 16) * RW_LD, RW_LD, ARB + nt * 16 * RW_LD, RW_LD, 64, acc, lane);
                    acc = mm16(VTc + mt * 16 * RW_LD, RW_LD, ARK + nt * 16 * RW_LD, RW_LD, 64, acc, lane);
                    *(unsigned long long*)(YH + ob + (nt * 16 + cc) * 64 + mt * 16 + 4 * g) = pack4(acc);
                } }
        }
        __syncthreads();
      }
    }
}

constexpr int CH_R = 6, CH_SLOT = 9216 + 9216 + 256;
constexpr int CH_RING = 0, CH_SI = CH_R * CH_SLOT, CH_FLAGS = CH_SI + 4 * 2304;
static_assert(CH_FLAGS + 64 <= MISC_OFF, "chain LDS map");
struct ChainRegs { v4u p[8], q[8]; f32x4 gm; };
__device__ __forceinline__ void chain_fetch(ChainRegs& o, const bf16* PP, const bf16* QQ, const float* GAMC, int item, int lane) {
    const size_t ob = (size_t)item * 4096;
#pragma unroll
    for (int i = 0; i < 8; ++i) { o.p[i] = *(const v4u*)(PP + ob + (size_t)(i * 64 + lane) * 8); o.q[i] = *(const v4u*)(QQ + ob + (size_t)(i * 64 + lane) * 8); }
    o.gm = *(const f32x4*)(GAMC + (size_t)item * 64 + (lane & 15) * 4);
}
__device__ __forceinline__ void chain_commit(const ChainRegs& o, LAS unsigned char* L, int c, int lane) {
    volatile LAS unsigned* flags = (volatile LAS unsigned*)(L + CH_FLAGS);
    const int slot = c % CH_R;
    if (c >= CH_R) { const unsigned need = (unsigned)(c - CH_R + 1);
        for (;;) { const unsigned m0 = flags[CH_R + 0], m1 = flags[CH_R + 1], m2 = flags[CH_R + 2], m3 = flags[CH_R + 3];
            if (m0 >= need && m1 >= need && m2 >= need && m3 >= need) break; __builtin_amdgcn_s_sleep(1); } }
    asm volatile("" ::: "memory");
    LAS unsigned char* sl = L + CH_RING + slot * CH_SLOT;
#pragma unroll
    for (int i = 0; i < 8; ++i) { const int idx = i * 64 + lane, row = idx >> 3, c16 = idx & 7;
        *(LAS v4u*)(sl + row * 144 + c16 * 16) = o.p[i]; *(LAS v4u*)(sl + 9216 + row * 144 + c16 * 16) = o.q[i]; }
    if (lane < 16) *(LAS f32x4*)(sl + 18432 + lane * 16) = o.gm;
    asm volatile("s_waitcnt lgkmcnt(0)" ::: "memory");
    if (lane == 0) flags[slot] = (unsigned)(c + 1);
}
__device__ __forceinline__ void ph_rwkv_b(const Ctx& C, int bh  , const bf16* PP, const bf16* QQ, const float* GAMC, bf16* S0) {
    const int lane = C.lane, wave = C.wave, cc = lane & 15, g = lane >> 4, b = bh >> 3, h = bh & 7;
    LAS unsigned char* L = C.lds;
    volatile LAS unsigned* flags = (volatile LAS unsigned*)(L + CH_FLAGS);
    if (C.tid < 16) flags[C.tid] = 0u;
    __syncthreads();
    if (wave >= 4) {
        const int j = wave - 4;
        ChainRegs A, B;
        int lc = j;
        chain_fetch(A, PP, QQ, GAMC, (b * 128 + lc) * 8 + h, lane);
        for (;;) {
            if (lc + 4 < 128) chain_fetch(B, PP, QQ, GAMC, (b * 128 + lc + 4) * 8 + h, lane);
            chain_commit(A, L, lc, lane);
            lc += 4; if (lc >= 128) break;
            if (lc + 4 < 128) chain_fetch(A, PP, QQ, GAMC, (b * 128 + lc + 4) * 8 + h, lane);
            chain_commit(B, L, lc, lane);
            lc += 4; if (lc >= 128) break;
        }
    } else {
        const int vt = wave;
        LAS bf16* SI = (LAS bf16*)(L + CH_SI + vt * 2304);
        f32x4 st[4];
#pragma unroll
        for (int mt = 0; mt < 4; ++mt) st[mt] = (f32x4){0.f, 0.f, 0.f, 0.f};
        for (int c = 0; c < 128; ++c) {
            const int item = (b * 128 + c) * 8 + h, slot = c % CH_R; const size_t ob = (size_t)item * 4096;
#pragma unroll
            for (int mt = 0; mt < 4; ++mt) { const unsigned long long pk = pack4(st[mt]);
                *(unsigned long long*)(S0 + ob + (vt * 16 + cc) * 64 + mt * 16 + 4 * g) = pk; *(LAS unsigned long long*)(SI + cc * RW_LD + mt * 16 + 4 * g) = pk; }
            while (flags[slot] < (unsigned)(c + 1)) __builtin_amdgcn_s_sleep(1);
            asm volatile("s_waitcnt lgkmcnt(0)" ::: "memory");
            const LAS unsigned char* sl = L + CH_RING + slot * CH_SLOT;
            const LAS bf16* Pi = (const LAS bf16*)sl; const LAS bf16* Qi = (const LAS bf16*)(sl + 9216); const LAS float* Gi = (const LAS float*)(sl + 18432);
            const s16x8 b0 = *(const LAS s16x8*)(SI + cc * RW_LD + 8 * g), b1 = *(const LAS s16x8*)(SI + cc * RW_LD + 32 + 8 * g);
#pragma unroll
            for (int mt = 0; mt < 4; ++mt) {
                const f32x4 gm = *(const LAS f32x4*)(Gi + mt * 16 + 4 * g);
                const unsigned long long qq = *(const LAS unsigned long long*)(Qi + (vt * 16 + cc) * RW_LD + mt * 16 + 4 * g);
                const s16x8 a0 = *(const LAS s16x8*)(Pi + (mt * 16 + cc) * RW_LD + 8 * g), a1 = *(const LAS s16x8*)(Pi + (mt * 16 + cc) * RW_LD + 32 + 8 * g);
                f32x4 acc; acc.x = gm.x * st[mt].x + bf2f((bf16)(qq & 0xffffu)); acc.y = gm.y * st[mt].y + bf2f((bf16)((qq >> 16) & 0xffffu));
                acc.z = gm.z * st[mt].z + bf2f((bf16)((qq >> 32) & 0xffffu)); acc.w = gm.w * st[mt].w + bf2f((bf16)(qq >> 48));
                acc = __builtin_amdgcn_mfma_f32_16x16x32_bf16(a0, b0, acc, 0, 0, 0); acc = __builtin_amdgcn_mfma_f32_16x16x32_bf16(a1, b1, acc, 0, 0, 0);
                st[mt] = acc; }
            asm volatile("s_waitcnt lgkmcnt(0)" ::: "memory");
            if (lane == 0) flags[CH_R + vt] = (unsigned)(c + 1);
        }
    }
    __syncthreads();
}

__device__ __forceinline__ void ph_rwkv_c(const Ctx& C, const bf16* S0, const bf16* RH, const bf16* YH, const float* RK, const bf16* GG, const bf16* VF,
                                          const float* gn_g, const float* gn_b, bf16* O) {
    const int lane = C.lane, cc = lane & 15, g = lane >> 4;
    for (int item = C.bid * 8 + C.wave; item < 4096; item += C.nb * 8) {
        const int h = item & 7, c = (item >> 3) & 127, b = item >> 10; const size_t m0 = (size_t)b * T_ + c * 64, ob = (size_t)item * 4096;
        s16x8 af[4][2], bfr[4][2];
#pragma unroll
        for (int q = 0; q < 4; ++q)
#pragma unroll
            for (int k = 0; k < 2; ++k) { af[q][k] = *(const s16x8*)(S0 + ob + (q * 16 + cc) * 64 + k * 32 + 8 * g); bfr[q][k] = *(const s16x8*)(RH + ob + (q * 16 + cc) * 64 + k * 32 + 8 * g); }
#pragma unroll
        for (int nt = 0; nt < 4; ++nt) {
            const size_t m = m0 + nt * 16 + cc;
            f32x4 y[4]; float s1 = 0.f;
#pragma unroll
            for (int mt = 0; mt < 4; ++mt) { const unsigned long long yh = *(const unsigned long long*)(YH + ob + (nt * 16 + cc) * 64 + mt * 16 + 4 * g);
                f32x4 acc; acc.x = bf2f((bf16)(yh & 0xffffu)); acc.y = bf2f((bf16)((yh >> 16) & 0xffffu)); acc.z = bf2f((bf16)((yh >> 32) & 0xffffu)); acc.w = bf2f((bf16)(yh >> 48));
                acc = __builtin_amdgcn_mfma_f32_16x16x32_bf16(af[mt][0], bfr[nt][0], acc, 0, 0, 0); acc = __builtin_amdgcn_mfma_f32_16x16x32_bf16(af[mt][1], bfr[nt][1], acc, 0, 0, 0);
                y[mt] = acc; s1 += (acc.x + acc.y) + (acc.z + acc.w); }
            s1 += __shfl_xor(s1, 16); s1 += __shfl_xor(s1, 32);
            const float mean = s1 * (1.f / 64.f); float s2 = 0.f;
#pragma unroll
            for (int mt = 0; mt < 4; ++mt) { y[mt] = y[mt] - mean; s2 += (y[mt].x * y[mt].x + y[mt].y * y[mt].y) + (y[mt].z * y[mt].z + y[mt].w * y[mt].w); }
            s2 += __shfl_xor(s2, 16); s2 += __shfl_xor(s2, 32);
            const float rstd = 1.f / sqrtf(s2 * (1.f / 64.f) + 64e-5f), rk = RK[m * 8 + h];
#pragma unroll
            for (int mt = 0; mt < 4; ++mt) { const int v = h * 64 + mt * 16 + 4 * g;
                const f32x4 gg4 = *(const f32x4*)(gn_g + v), gb4 = *(const f32x4*)(gn_b + v);
                const unsigned long long vx = *(const unsigned long long*)(VF + m * 512 + v), gx = *(const unsigned long long*)(GG + m * 512 + v);
                f32x4 o;
                o.x = (y[mt].x * rstd * gg4.x + gb4.x + rk * bf2f((bf16)(vx & 0xffffu))) * bf2f((bf16)(gx & 0xffffu));
                o.y = (y[mt].y * rstd * gg4.y + gb4.y + rk * bf2f((bf16)((vx >> 16) & 0xffffu))) * bf2f((bf16)((gx >> 16) & 0xffffu));
                o.z = (y[mt].z * rstd * gg4.z + gb4.z + rk * bf2f((bf16)((vx >> 32) & 0xffffu))) * bf2f((bf16)((gx >> 32) & 0xffffu));
                o.w = (y[mt].w * rstd * gg4.w + gb4.w + rk * bf2f((bf16)(vx >> 48))) * bf2f((bf16)(gx >> 48));
                *(unsigned long long*)(O + m * D_ + 512 + v) = pack4(o); }
        }
    }
}

__device__ __forceinline__ void ph_convfix(const Ctx& C, const float* HALO, const float* FIXU, const float* cw, const float* cb, bf16* ACT) {
    for (int idx = C.bid * NT + C.tid; idx < 128 * 22 * 2 * 128; idx += C.nb * NT) {
        const int j = idx & 127, rr = (idx >> 7) & 1, tile = idx >> 8, pm = tile / 22, pn = tile % 22;
        const bool seq0 = (pm & 31) == 0;
        const float* fx = FIXU + (size_t)tile * 512; const float* hl = HALO + (size_t)(tile - 22) * 512;
        const float u0g = fx[rr * 256 + j], u0v = fx[rr * 256 + 128 + j];
        float u1g, u1v, u2g, u2v;
        if (rr == 0) { u1g = seq0 ? 0.f : hl[256 + j]; u1v = seq0 ? 0.f : hl[256 + 128 + j]; u2g = seq0 ? 0.f : hl[j]; u2v = seq0 ? 0.f : hl[128 + j]; }
        else { u1g = fx[j]; u1v = fx[128 + j]; u2g = seq0 ? 0.f : hl[256 + j]; u2v = seq0 ? 0.f : hl[256 + 128 + j]; }
        const int jg = pn * 128 + j, jv = DFF + jg;
        const float gc = cb[jg] + cw[jg] * u2g + cw[NUP + jg] * u1g + cw[2 * NUP + jg] * u0g, vc = cb[jv] + cw[jv] * u2v + cw[NUP + jv] * u1v + cw[2 * NUP + jv] * u0v;
        ACT[(size_t)(pm * 256 + rr) * DFF + jg] = (bf16)f2bf(siluf_(gc) * vc);
    }
}
}

namespace pg8 {
struct EpiRes {
    static constexpr bool PERM = false, AFTER_DRAIN = false;
    const float* base; float* out; const float* gate; int gstride;
    __device__ __forceinline__ void operator()(const f32x4 (&acc)[2][2][4][2], const Unit& u, int wr, int wc, int fr, int fq) const {
        const int b = (u.pm * BM) / 8192; const float* gp = gate + (size_t)b * gstride;
        const int col0 = u.pn * BM + wc * 32 + 4 * fq;
#pragma unroll
        for (int ai = 0; ai < 2; ++ai)
#pragma unroll
            for (int m = 0; m < 4; ++m) { const size_t off = (size_t)(u.pm * BM + ai * HALF + wr * 64 + m * 16 + fr) * 1024 + col0;
#pragma unroll
                for (int bj = 0; bj < 2; ++bj)
#pragma unroll
                    for (int n = 0; n < 2; ++n) { const int cc = bj * HALF + n * 16; const f32x4 gv = *(const f32x4*)(gp + col0 + cc); const f32x4 bs = *(const f32x4*)(base + off + cc);
                        *(f32x4*)(out + off + cc) = bs + gv * acc[ai][bj][m][n]; } }
    }
};

struct EpiConv {
    static constexpr bool PERM = true, AFTER_DRAIN = false;
    bf16_t* ACT; const float* cw; const float* cb; float* HALO; float* FIXU; PG8_LAS float* EX; int nN;
    template <int CTRL> static __device__ __forceinline__ float rot(float x) { return __builtin_bit_cast(float, __builtin_amdgcn_update_dpp(0, __builtin_bit_cast(int, x), CTRL, 0xf, 0xf, false)); }
    template <int CTRL> static __device__ __forceinline__ f32x4 rot4(f32x4 x) { return (f32x4){rot<CTRL>(x.x), rot<CTRL>(x.y), rot<CTRL>(x.z), rot<CTRL>(x.w)}; }
    __device__ __forceinline__ void operator()(const f32x4 (&acc)[2][2][4][2], const Unit& u, int wr, int wc, int fr, int fq) const {
        const int colw = wc * 32 + 8 * fq, tile = u.pm * nN + u.pn;
        if (fr >= 14) {
#pragma unroll
            for (int ai = 0; ai < 2; ++ai)
#pragma unroll
                for (int bj = 0; bj < 2; ++bj)
#pragma unroll
                    for (int n = 0; n < 2; ++n) { *(PG8_LAS f32x4*)(EX + ((ai * 2 + wr) * 2 + (fr - 14)) * 256 + bj * 128 + colw + 4 * n) = acc[ai][bj][3][n];
                        if (ai == 1 && wr == 1) *(f32x4*)(HALO + ((size_t)tile * 2 + (fr - 14)) * 256 + bj * 128 + colw + 4 * n) = acc[1][bj][3][n]; }
        }
        if (fr < 2 && wr == 0) {
#pragma unroll
            for (int bj = 0; bj < 2; ++bj)
#pragma unroll
                for (int n = 0; n < 2; ++n) *(f32x4*)(FIXU + ((size_t)tile * 2 + fr) * 256 + bj * 128 + colw + 4 * n) = acc[0][bj][0][n];
        }
        asm volatile("s_waitcnt lgkmcnt(0)" ::: "memory"); __builtin_amdgcn_s_barrier(); asm volatile("" ::: "memory");
#pragma unroll
        for (int n = 0; n < 2; ++n) {
            const int jg = u.pn * 128 + colw + 4 * n, jv = 2816 + jg;
#pragma unroll
            for (int ai = 0; ai < 2; ++ai)
#pragma unroll
                for (int m = 0; m < 4; ++m) {
                    const int src = ai * 2 + wr - 1;
                    f32x4 res[2];
#pragma unroll
                    for (int bj = 0; bj < 2; ++bj) {
                        const int jc = bj ? jv : jg;
                        const f32x4 x = acc[ai][bj][m][n];
                        f32x4 x1 = rot4<0x121>(x), x2 = rot4<0x122>(x);
                        if (m > 0) { const f32x4 q = acc[ai][bj][m > 0 ? m - 1 : 0][n]; const f32x4 q1 = rot4<0x121>(q), q2 = rot4<0x122>(q);
                            if (fr == 0) x1 = q1; if (fr < 2) x2 = q2; }
                        else if (fr < 2) { f32x4 e14 = {0.f, 0.f, 0.f, 0.f}, e15 = e14;
                            if (src >= 0) { e14 = *(const PG8_LAS f32x4*)(EX + (src * 2 + 0) * 256 + bj * 128 + colw + 4 * n); e15 = *(const PG8_LAS f32x4*)(EX + (src * 2 + 1) * 256 + bj * 128 + colw + 4 * n); }
                            if (fr == 0) { x1 = e15; x2 = e14; } else x2 = e15; }
                        const f32x4 w0 = *(const f32x4*)(cw + jc), w1 = *(const f32x4*)(cw + 5632 + jc), w2 = *(const f32x4*)(cw + 2 * 5632 + jc), bb = *(const f32x4*)(cb + jc);
                        res[bj] = bb + w0 * x2 + w1 * x1 + w2 * x;
                    }
                    const f32x4 gc = res[0], vc = res[1];
                    f32x4 o;
                    o.x = gc.x * __builtin_amdgcn_rcpf(1.f + __expf(-gc.x)) * vc.x; o.y = gc.y * __builtin_amdgcn_rcpf(1.f + __expf(-gc.y)) * vc.y;
                    o.z = gc.z * __builtin_amdgcn_rcpf(1.f + __expf(-gc.z)) * vc.z; o.w = gc.w * __builtin_amdgcn_rcpf(1.f + __expf(-gc.w)) * vc.w;
                    typedef unsigned u32x2 __attribute__((ext_vector_type(2)));
                    u32x2 w; w.x = cvt_pk_bf16(o.x, o.y); w.y = cvt_pk_bf16(o.z, o.w);
                    *(u32x2*)(ACT + (size_t)(u.pm * BM + ai * HALF + wr * 64 + m * 16 + fr) * 2816 + u.pn * 128 + colw + 4 * n) = w;
                }
        }
    }
};
}

namespace hy {
struct Args { const float* in[31]; float* out; unsigned char* ws; };
__global__ void __launch_bounds__(NT, 2) hy_fwd(Args A) {
    extern __shared__ __attribute__((aligned(16))) unsigned char lds_raw[];
    Ctx C; C.bid = blockIdx.x; C.nb = gridDim.x; C.tid = threadIdx.x; C.lane = C.tid & 63; C.wave = __builtin_amdgcn_readfirstlane(C.tid >> 6); C.lds = (LAS unsigned char*)lds_raw;
    volatile LAS unsigned* MISC = (volatile LAS unsigned*)(C.lds + MISC_OFF);
    for (int u = C.tid; u < (LDS_BYTES - MISC_OFF) / 4; u += NT) ((LAS unsigned*)(C.lds + MISC_OFF))[u] = 0u;
    __syncthreads();
    unsigned char* ws = A.ws;
    XcdBarrier bar = xcd_barrier_post((unsigned*)(ws + WS_CTL) + CW_BAR, MISC + 8);
#define PHASE_BEGIN() do { int t_ = threadIdx.x; asm volatile("" : "+v"(t_)); int b_ = blockIdx.x; asm volatile("" : "+s"(b_)); \
    C.tid = t_; C.lane = t_ & 63; C.wave = __builtin_amdgcn_readfirstlane(t_ >> 6); C.bid = b_; } while (0)
#ifdef HY_DIAG
    unsigned long long ts_last = __builtin_amdgcn_s_memrealtime(); float tacc[10] = {0.f, 0.f, 0.f, 0.f, 0.f, 0.f, 0.f, 0.f, 0.f, 0.f};
#define GRID_BAR(cat) do { xcd_barrier(bar); PHASE_BEGIN(); { const unsigned long long n_ = __builtin_amdgcn_s_memrealtime(); tacc[cat] += (float)(n_ - ts_last); ts_last = n_; } } while (0)
#else
#define GRID_BAR(cat) do { xcd_barrier(bar); PHASE_BEGIN(); } while (0)
#endif
#ifndef HY_REPCAT
#define HY_REPCAT (-1)
#endif
#define NREP(cat) ((HY_REPCAT == (cat)) ? 2 : 1)
    float* out = A.out;
#define in A.in
    float* MOD = (float*)(ws + WS_MOD);
    bf16 *WIN = (bf16*)(ws + WS_WIN), *WOUT = (bf16*)(ws + WS_WOUT), *WUP = (bf16*)(ws + WS_WUP), *WDN = (bf16*)(ws + WS_WDN);
    bf16 *XB = (bf16*)(ws + WS_XB), *O = (bf16*)(ws + WS_O), *VF = (bf16*)(ws + WS_VF), *PG = (bf16*)(ws + WS_PG), *PR = (bf16*)(ws + WS_PR), *VL = (bf16*)(ws + WS_VL);
    bf16 *RH = (bf16*)(ws + WS_RH), *YH = (bf16*)(ws + WS_YH), *PP = (bf16*)(ws + WS_PP), *QQ = (bf16*)(ws + WS_QQ), *GG = (bf16*)(ws + WS_GG), *S0 = (bf16*)(ws + WS_S0);
    float *GAMC = (float*)(ws + WS_GAMC), *RK = (float*)(ws + WS_RK);
    bf16* LORA = (bf16*)(ws + WS_LORA);
    bf16* DS = (bf16*)(ws + WS_GK); float* GAM = (float*)(ws + WS_GAM);
    bf16* ACT = (bf16*)(ws + WS_ACT); float *HALO = (float*)(ws + WS_U), *FIXU = (float*)(ws + WS_U + 8 * MiB);

    ph_mod(C, in[1], in[2], in[3], MOD);
    for (int l = 0; l < L_; ++l) {
        const float* modl = MOD + (size_t)l * 4 * 6144;
        const float* xres = l ? out : in[0];
        for (int r_ = 0; r_ < NREP(0); ++r_) {
        wprep_mat(C, in[5] + (size_t)l * D_ * IN_COLS, D_, IN_COLS, NIN, WIN, 1, l ? in[6] : nullptr);
        wprep_mat(C, in[24] + (size_t)l * D_ * D_, D_, D_, D_, WOUT, 0, nullptr);
        wprep_mat(C, in[26] + (size_t)l * D_ * NUP, D_, NUP, NUP, WUP, 2, nullptr);
        wprep_mat(C, in[29] + (size_t)l * DFF * D_, DFF, D_, D_, WDN, 0, nullptr);
        wprep_mat(C, in[12] + (size_t)l * 64 * 512, 64, 512, 512, LORA, 0, nullptr);
        wprep_mat(C, in[14] + (size_t)l * 64 * 512, 64, 512, 512, LORA + 512 * 64, 0, nullptr);
        wprep_mat(C, in[16] + (size_t)l * 128 * 512, 128, 512, 512, LORA + 2 * 512 * 64, 0, nullptr);
        if (l) wprep_mat(C, in[17], 32, 512, 512, LORA + 2 * 512 * 64 + 512 * 128, 0, nullptr);
        }
        GRID_BAR(0);
        for (int r_ = 0; r_ < NREP(1); ++r_) ph_norm(C, xres, in[4] + l * D_, modl + 0 * D_, modl + 1 * D_, XB);
        GRID_BAR(1);
        for (int r_ = 0; r_ < NREP(2); ++r_) { pg8::Gemm g{XB, WIN, M_, NIN, D_}; pg8::StaticOrder S; S.init(M_, NIN, C.nb, C.bid);
          pg8::EpiBf16<0> E{PG, NPG, nullptr, NPG, (WS_PR - WS_PG) / 2, 1.f};
          pg8::gemm_phase<pg8::EpiBf16<0>, pg8::StaticOrder, true, true>(C.lds, g, S, E); }
        GRID_BAR(2);
        for (int r_ = 0; r_ < NREP(3); ++r_) {
        ph_gla_a(C, PG, in[7] + l * 16 * 256, in[8] + l * 256, DS, GAM, VL);
        { RwkvW W{in[10] + l * 1792, in[11], in[13] + l * 512, in[15] + l * 512, in[18], in[19] + l * 512, in[20] + l * 512, in[21] + l * 512,
                  LORA, LORA + 512 * 64, LORA + 2 * 512 * 64, LORA + 2 * 512 * 64 + 512 * 128};
          ph_rwkv_a(C, PR, PG, W, l, PP, QQ, RH, YH, GAMC, RK, GG, VF, r_ == NREP(3) - 1); } }
        GRID_BAR(3);
        if (C.bid < 32) { for (int r_ = 0; r_ < NREP(4); ++r_) ph_rwkv_b(C, C.bid, PP, QQ, GAMC, S0); }
        else { Ctx C2 = C; C2.bid = C.bid - 32; C2.nb = C.nb - 32; ph_gla_b(C2, DS, GAM); }
        GRID_BAR(4);
        for (int r_ = 0; r_ < NREP(5); ++r_) {
        ph_gla_c(C, PG, in[7] + l * 16 * 256, in[8] + l * 256, in[9] + l * 128, DS, O);
        ph_rwkv_c(C, S0, RH, YH, RK, GG, VF, in[22] + l * 512, in[23] + l * 512, O); }
        GRID_BAR(5);
        { pg8::Gemm g{O, WOUT, M_, D_, D_}; pg8::StaticOrder S; S.init(M_, D_, C.nb, C.bid);
          pg8::EpiRes E{xres, out, modl + 2 * D_, 6144};
          pg8::gemm_phase<pg8::EpiRes, pg8::StaticOrder, true, true>(C.lds, g, S, E); }
        GRID_BAR(6);
        for (int r_ = 0; r_ < NREP(1); ++r_) ph_norm(C, out, in[25] + l * D_, modl + 3 * D_, modl + 4 * D_, XB);
        GRID_BAR(1);
        for (int r_ = 0; r_ < NREP(7); ++r_) { pg8::Gemm g{XB, WUP, M_, NUP, D_}; pg8::StaticOrder S; S.init(M_, NUP, C.nb, C.bid);
          pg8::EpiConv E{ACT, in[27] + (size_t)l * 3 * NUP, in[28] + (size_t)l * NUP, HALO, FIXU, (PG8_LAS float*)(C.lds + RING_BYTES), NUP / 256};
          pg8::gemm_phase<pg8::EpiConv, pg8::StaticOrder, true, true>(C.lds, g, S, E); }
        GRID_BAR(7);
        for (int r_ = 0; r_ < NREP(8); ++r_) ph_convfix(C, HALO, FIXU, in[27] + (size_t)l * 3 * NUP, in[28] + (size_t)l * NUP, ACT);
        GRID_BAR(8);
        { pg8::Gemm g{ACT, WDN, M_, D_, DFF}; pg8::StaticOrder S; S.init(M_, D_, C.nb, C.bid);
          pg8::EpiRes E{out, out, modl + 5 * D_, 6144};
          pg8::gemm_phase<pg8::EpiRes, pg8::StaticOrder, true, true>(C.lds, g, S, E); }
        GRID_BAR(9);
    }
    ph_final(C, out, in[30]);
#ifdef HY_DIAG
    GRID_BAR(1);
    if (C.bid == 0) { if (C.tid == 0) out[0] = tacc[HY_DIAG_A] * 0.1f; for (int i = 1 + C.tid; i <= 10000; i += NT) out[i] = tacc[HY_DIAG_B] * 0.01f; }
#endif
#undef GRID_BAR
#undef PHASE_BEGIN
#undef in
}
}

extern "C" void kernel_launch(void* const* d_in, const int* in_sizes, int n_in, void* d_out, int out_size, void* d_ws, size_t ws_size, hipStream_t stream) {
    using namespace hy;
    static int grid = 0;
    if (grid == 0) {
        if (n_in != 31 || in_sizes[0] != M_ * D_ || out_size != M_ * D_ || ws_size < WS_END) { fprintf(stderr, "kernel_launch: unexpected shapes (n_in %d, in0 %d, out %d, ws %zu)\n", n_in, n_in > 0 ? in_sizes[0] : -1, out_size, ws_size); grid = -1; return; }
        if (hipFuncSetAttribute((const void*)hy_fwd, hipFuncAttributeMaxDynamicSharedMemorySize, LDS_BYTES) != hipSuccess) { fprintf(stderr, "kernel_launch: hipFuncSetAttribute failed\n"); grid = -1; return; }
        int dev = 0, cus = 0, per_cu = 0;
        (void)hipGetDevice(&dev); (void)hipDeviceGetAttribute(&cus, hipDeviceAttributeMultiprocessorCount, dev);
        (void)hipOccupancyMaxActiveBlocksPerMultiprocessor(&per_cu, (const void*)hy_fwd, NT, LDS_BYTES);
        if (per_cu < 1) fprintf(stderr, "kernel_launch: occupancy query reports %d blocks per CU\n", per_cu);
        (void)hipGetLastError();
        grid = cus > 0 ? cus : 256;
    }
    if (grid < 0) return;
    (void)hipMemsetAsync((char*)d_ws + WS_CTL, 0, CTL_ZERO_BYTES, stream);
    Args a{};
    for (int i = 0; i < 31; ++i) a.in[i] = (const float*)d_in[i];
    a.out = (float*)d_out; a.ws = (unsigned char*)d_ws;
    hipLaunchKernelGGL(hy_fwd, dim3(grid), dim3(NT), LDS_BYTES, stream, a);
}
```

```cpp
#include <hip/hip_runtime.h>
#include <cstdio>
#include <cstdint>
namespace pg8 {
#define PG8_LAS __attribute__((address_space(3)))
typedef unsigned short bf16_t;
typedef short bf16x8 __attribute__((ext_vector_type(8)));
typedef float f32x4 __attribute__((ext_vector_type(4)));
typedef unsigned u32x4 __attribute__((ext_vector_type(4)));
constexpr int BM = 256, BK = 64, HALF = 128, HTB = HALF * BK * 2  , STAGE_BYTES = 8 * HTB, NXCD = 8, WGM = 8;

__host__ __device__ __forceinline__ int lds_byte(int r, int c) { const int st = (r >> 4) * 2 + (c >> 5), rr = r & 15, cc = c & 31, ob = rr * 64 + cc * 2; return st * 1024 + (ob ^ (((ob >> 9) & 1) << 5)); }
__host__ __device__ __forceinline__ void stage_rc(int b, int& R, int& C) { const int st = b / 1024, sb = b % 1024, swz = sb ^ (((sb >> 9) & 1) << 5); R = (st >> 1) * 16 + swz / 64; C = (st & 1) * 32 + (swz % 64) / 2; }
__host__ __device__ __forceinline__ int perm32(int rho) { const int n = rho >> 4, i = rho & 15; return 8 * (i >> 2) + 4 * n + (i & 3); }

struct Unit { int pm, pn; };
struct Gemm { const bf16_t* A; const bf16_t* Bt; int M, N, K; };

struct StaticOrder {
    int nM, nN, nwg, G, c;
    __host__ __device__ void init(int M, int N, int G_, int c_) { nM = M / BM; nN = N / BM; nwg = nM * nN; G = G_; c = c_; }
    __host__ __device__ bool next(int i, Unit& u) const {
        const long L = (long)i * G + c; if (L >= nwg) return false;
        int wgid = (int)L; { const int q = nwg / NXCD, r = nwg % NXCD, xcd = wgid % NXCD, off = wgid / NXCD; wgid = (xcd < r ? xcd * (q + 1) : r * (q + 1) + (xcd - r) * q) + off; }
        const int nig = WGM * nN, gid = wgid / nig, fm = gid * WGM, gsz = (nM - fm) < WGM ? (nM - fm) : WGM;
        u.pm = fm + ((wgid % nig) % gsz); u.pn = (wgid % nig) / gsz; return true;
    }
    __device__ __forceinline__ void a_ready(const Unit&) const {}
    __device__ __forceinline__ void done(const Unit&) const {}
};

__device__ __forceinline__ unsigned cvt_pk_bf16(float lo, float hi) { unsigned r; asm volatile("v_cvt_pk_bf16_f32 %0, %1, %2" : "=v"(r) : "v"(lo), "v"(hi)); return r; }
typedef float f32x2 __attribute__((ext_vector_type(2)));
__device__ __forceinline__ f32x2 gelu_pk(f32x2 v) {
    const f32x2 av = __builtin_elementwise_abs(v), d = av * 0.2316418882f + 1.0f;
    f32x2 t; t.x = __builtin_amdgcn_rcpf(d.x); t.y = __builtin_amdgcn_rcpf(d.y);
    f32x2 q = t * 0.5307027145f + (-0.7265760135f); q = q * t + 0.7107068705f; q = q * t + (-0.142248368f); q = q * t + 0.127414796f; q = q * t;
    const f32x2 s = (v * v) * (-0.72134752044f);
    f32x2 e; e.x = __builtin_amdgcn_exp2f(s.x); e.y = __builtin_amdgcn_exp2f(s.y);
    const f32x2 m = v * (q * e), r = v - m;
    f32x2 o; o.x = v.x < 0.f ? m.x : r.x; o.y = v.y < 0.f ? m.y : r.y; return o;
}

template <int ACT  > struct EpiBf16 {
    static constexpr bool PERM = true, AFTER_DRAIN = false; static_assert(ACT == 0 || ACT == 1, "EpiBf16: ACT is 0 (none) or 1 (gelu_pk)");
    bf16_t* O; int ldc; const float* bias; int split_cols; size_t split_stride; float scale0;
    __device__ __forceinline__ void operator()(const f32x4 (&acc)[2][2][4][2], const Unit& u, int wr, int wc, int fr, int fq) const {
        const int row0 = u.pm * BM + wr * 64 + fr; int colt = u.pn * BM; bf16_t* base = O;
        float sc = 1.f; if (split_cols) { const int t = colt / split_cols; base += (size_t)t * split_stride; colt -= t * split_cols; if (t == 0) sc = scale0; }
        const int col0 = colt + wc * 32 + 8 * fq, bcol0 = u.pn * BM + wc * 32 + 8 * fq;
        f32x4 bv[2][2];
#pragma unroll
        for (int bj = 0; bj < 2; ++bj)
#pragma unroll
            for (int n = 0; n < 2; ++n) bv[bj][n] = bias ? *(const f32x4*)(bias + bcol0 + bj * HALF + 4 * n) : (f32x4){0.f, 0.f, 0.f, 0.f};
#pragma unroll
        for (int ai = 0; ai < 2; ++ai)
#pragma unroll
            for (int m = 0; m < 4; ++m) { bf16_t* rowp = base + (size_t)(row0 + ai * HALF + m * 16) * ldc + col0;
#pragma unroll
                for (int bj = 0; bj < 2; ++bj) { f32x4 v0 = acc[ai][bj][m][0] + bv[bj][0], v1 = acc[ai][bj][m][1] + bv[bj][1];
                    if (ACT == 1) { f32x2 a = gelu_pk((f32x2){v0[0], v0[1]}), b = gelu_pk((f32x2){v0[2], v0[3]}), c = gelu_pk((f32x2){v1[0], v1[1]}), d = gelu_pk((f32x2){v1[2], v1[3]});
                        v0 = (f32x4){a.x, a.y, b.x, b.y}; v1 = (f32x4){c.x, c.y, d.x, d.y}; }
                    v0 = v0 * sc; v1 = v1 * sc; u32x4 w; w.x = cvt_pk_bf16(v0[0], v0[1]); w.y = cvt_pk_bf16(v0[2], v0[3]); w.z = cvt_pk_bf16(v1[0], v1[1]); w.w = cvt_pk_bf16(v1[2], v1[3]);
                    *(u32x4*)(rowp + bj * HALF) = w; } }
    }
};
template <class Epi, class Sched, bool ALIGN_EPI = false, bool SP2 = false>
__device__ __forceinline__ void gemm_phase(PG8_LAS unsigned char* lds, const Gemm g, const Sched& S, const Epi& E) {
    int tid_ = threadIdx.x; asm volatile("" : "+v"(tid_));
    const int tid = tid_, wid = __builtin_amdgcn_readfirstlane(tid >> 6), lane = tid & 63, wr = wid >> 2, wc = wid & 3, fr = lane & 15, fq = lane >> 4;
    const int K = g.K, nt = K / BK;
    unsigned voffA[2], voffB[2];
#pragma unroll
    for (int i = 0; i < 2; ++i) { int R, C; stage_rc(tid * 16 + i * 8192, R, C); const int Rb = Epi::PERM ? ((R & ~31) + perm32(R & 31)) : R;
        voffA[i] = (unsigned)(R * K + C) * 2u; voffB[i] = (unsigned)(Rb * K + C) * 2u; }
    const size_t kstep = (size_t)(BK * 2);
    const size_t hstep = (size_t)HALF * K * 2;
    const size_t tstep = 2 * hstep;
    const unsigned ldsw = (unsigned)wid * 1024u;
    const int aoff = lds_byte(wr * 64 + fr, fq * 8), boff = lds_byte(wc * 32 + fr, fq * 8);
#define PG8_SA(b, h) (((b) * 2 + (h)) * HTB)
#define PG8_SB(b, h) ((4 + (b) * 2 + (h)) * HTB)
#define PG8_STAGE(bufoff, gbase, voff) do { _Pragma("unroll") for (int _i = 0; _i < 2; ++_i) \
        __builtin_amdgcn_global_load_lds((const unsigned*)((const char*)(gbase) + (voff)[_i]), (PG8_LAS unsigned*)(lds + (bufoff) + ldsw + _i * 8192), 16, 0, 0); } while (0)
#define PG8_LDA(dst, b, h) do { _Pragma("unroll") for (int m = 0; m < 4; ++m) _Pragma("unroll") for (int k = 0; k < 2; ++k) dst[m][k] = *(const PG8_LAS bf16x8*)(lds + PG8_SA(b, h) + aoff + m * 2048 + k * 1024); } while (0)
#define PG8_LDB(dst, b, h) do { _Pragma("unroll") for (int n = 0; n < 2; ++n) _Pragma("unroll") for (int k = 0; k < 2; ++k) dst[n][k] = *(const PG8_LAS bf16x8*)(lds + PG8_SB(b, h) + boff + n * 2048 + k * 1024); } while (0)
#define PG8_MMA(ai, bj, At, Bt) do { __builtin_amdgcn_s_setprio(1); _Pragma("unroll") for (int m = 0; m < 4; ++m) _Pragma("unroll") for (int n = 0; n < 2; ++n) _Pragma("unroll") for (int k = 0; k < 2; ++k) \
        acc[ai][bj][m][n] = __builtin_amdgcn_mfma_f32_16x16x32_bf16(Bt[n][k], At[m][k], acc[ai][bj][m][n], 0, 0, 0); __builtin_amdgcn_s_setprio(0); } while (0)
#define PG8_WAIT_V(n) asm volatile("s_waitcnt vmcnt(" #n ")" ::: "memory")
#define PG8_WAIT_L(n) asm volatile("s_waitcnt lgkmcnt(" #n ")" ::: "memory")
#define PG8_BAR __builtin_amdgcn_s_barrier()
#define PG8_SCHED __builtin_amdgcn_sched_barrier(0)
    Unit cur, nxt; int ui = 0;
    if (!S.next(0, cur)) return;
    f32x4 acc[2][2][4][2];
#pragma unroll
    for (int a = 0; a < 2; ++a)
#pragma unroll
        for (int b = 0; b < 2; ++b)
#pragma unroll
            for (int m = 0; m < 4; ++m)
#pragma unroll
                for (int n = 0; n < 2; ++n) acc[a][b][m][n] = (f32x4){0.f, 0.f, 0.f, 0.f};
    bf16x8 At[4][2], B0[2][2], B1[2][2];
    const char* cA = (const char*)g.A + (size_t)cur.pm * tstep; const char* cB = (const char*)g.Bt + (size_t)cur.pn * tstep;
    S.a_ready(cur);
    if constexpr (SP2) {
        PG8_STAGE(PG8_SB(0, 0), cB, voffB); PG8_STAGE(PG8_SB(0, 1), cB + hstep, voffB); PG8_STAGE(PG8_SA(0, 0), cA, voffA); PG8_STAGE(PG8_SA(0, 1), cA + hstep, voffA);
        if (wr == 1) PG8_BAR;
        PG8_WAIT_V(2); PG8_BAR;
        PG8_STAGE(PG8_SB(1, 0), cB + kstep, voffB); PG8_STAGE(PG8_SA(1, 0), cA + kstep, voffA); PG8_STAGE(PG8_SB(1, 1), cB + hstep + kstep, voffB);
        PG8_WAIT_V(6); PG8_BAR;
    } else {
        PG8_STAGE(PG8_SB(0, 0), cB, voffB); PG8_STAGE(PG8_SA(0, 0), cA, voffA); PG8_STAGE(PG8_SB(0, 1), cB + hstep, voffB); PG8_STAGE(PG8_SA(0, 1), cA + hstep, voffA);
        if (wr == 1) PG8_BAR;
        PG8_WAIT_V(4); PG8_BAR;
        PG8_STAGE(PG8_SB(1, 0), cB + kstep, voffB); PG8_STAGE(PG8_SA(1, 0), cA + kstep, voffA); PG8_STAGE(PG8_SB(1, 1), cB + hstep + kstep, voffB);
        PG8_WAIT_V(6); PG8_BAR;
    }
    for (;;) {
        const bool has_next = S.next(ui + 1, nxt);
        const char* nA = has_next ? (const char*)g.A + (size_t)nxt.pm * tstep : cA; const char* nB = has_next ? (const char*)g.Bt + (size_t)nxt.pn * tstep : cB;
        for (int t = 0; t < nt; t += 2) {
            const bool last = (t == nt - 2);
            const char* a1 = cA + (size_t)(t + 1) * kstep;
            const char* a2 = last ? nA : cA + (size_t)(t + 2) * kstep; const char* b2 = last ? nB : cB + (size_t)(t + 2) * kstep;
            const char* a3 = a2 + kstep; const char* b3 = b2 + kstep;
            if (last && has_next) S.a_ready(nxt);
            if constexpr (SP2) {
            PG8_LDB(B0, 0, 0); PG8_LDB(B1, 0, 1); PG8_SCHED; PG8_LDA(At, 0, 0); PG8_STAGE(PG8_SA(1, 1), a1 + hstep, voffA);
            PG8_WAIT_V(8); PG8_WAIT_L(0); PG8_BAR; PG8_MMA(0, 0, At, B0); PG8_MMA(0, 1, At, B1); PG8_BAR; PG8_SCHED;
            PG8_LDA(At, 0, 1); PG8_STAGE(PG8_SB(0, 0), b2, voffB); PG8_STAGE(PG8_SB(0, 1), b2 + hstep, voffB); PG8_STAGE(PG8_SA(0, 0), a2, voffA);
            PG8_WAIT_V(8); PG8_WAIT_L(0); PG8_BAR; PG8_MMA(1, 0, At, B0); PG8_MMA(1, 1, At, B1); PG8_BAR; PG8_SCHED;
            PG8_LDB(B0, 1, 0); PG8_LDB(B1, 1, 1); PG8_SCHED; PG8_LDA(At, 1, 0); PG8_STAGE(PG8_SA(0, 1), a2 + hstep, voffA);
            PG8_WAIT_V(8); PG8_WAIT_L(0); PG8_BAR; PG8_MMA(0, 0, At, B0); PG8_MMA(0, 1, At, B1); PG8_BAR; PG8_SCHED;
            PG8_LDA(At, 1, 1); PG8_STAGE(PG8_SB(1, 0), b3, voffB); PG8_STAGE(PG8_SB(1, 1), b3 + hstep, voffB); PG8_STAGE(PG8_SA(1, 0), a3, voffA);
            PG8_WAIT_V(8); PG8_WAIT_L(0); PG8_BAR; PG8_MMA(1, 0, At, B0); PG8_MMA(1, 1, At, B1); PG8_BAR; PG8_SCHED;
            } else {
            PG8_LDB(B0, 0, 0); PG8_SCHED; PG8_LDA(At, 0, 0); PG8_STAGE(PG8_SA(1, 1), a1 + hstep, voffA);
            PG8_WAIT_L(8); PG8_BAR; PG8_WAIT_L(0); PG8_MMA(0, 0, At, B0); PG8_BAR; PG8_SCHED;
            PG8_LDB(B1, 0, 1); PG8_STAGE(PG8_SB(0, 0), b2, voffB);
            PG8_BAR; PG8_WAIT_L(0); PG8_MMA(0, 1, At, B1); PG8_BAR;
            PG8_LDA(At, 0, 1); PG8_STAGE(PG8_SA(0, 0), a2, voffA);
            PG8_BAR; PG8_WAIT_L(0); PG8_MMA(1, 0, At, B0); PG8_BAR; PG8_SCHED;
            PG8_STAGE(PG8_SB(0, 1), b2 + hstep, voffB);
            PG8_WAIT_V(6); PG8_BAR; PG8_MMA(1, 1, At, B1); PG8_BAR;
            PG8_LDB(B0, 1, 0); PG8_SCHED; PG8_LDA(At, 1, 0); PG8_STAGE(PG8_SA(0, 1), a2 + hstep, voffA);
            PG8_WAIT_L(8); PG8_BAR; PG8_WAIT_L(0); PG8_MMA(0, 0, At, B0); PG8_BAR; PG8_SCHED;
            PG8_LDB(B1, 1, 1); PG8_STAGE(PG8_SB(1, 0), b3, voffB);
            PG8_BAR; PG8_WAIT_L(0); PG8_MMA(0, 1, At, B1); PG8_BAR;
            PG8_LDA(At, 1, 1); PG8_STAGE(PG8_SA(1, 0), a3, voffA);
            PG8_BAR; PG8_WAIT_L(0); PG8_MMA(1, 0, At, B0); PG8_BAR; PG8_SCHED;
            PG8_STAGE(PG8_SB(1, 1), b3 + hstep, voffB);
            PG8_WAIT_V(6); PG8_BAR; PG8_MMA(1, 1, At, B1); PG8_BAR;
            }
        }
        if constexpr (ALIGN_EPI) { if (wr == 0) PG8_BAR; }
        if constexpr (!Epi::AFTER_DRAIN) { E(acc, cur, wr, wc, fr, fq); S.done(cur); }
        if (!has_next) break;
#pragma unroll
        for (int a = 0; a < 2; ++a)
#pragma unroll
            for (int b = 0; b < 2; ++b)
#pragma unroll
                for (int m = 0; m < 4; ++m)
#pragma unroll
                    for (int n = 0; n < 2; ++n) acc[a][b][m][n] = (f32x4){0.f, 0.f, 0.f, 0.f};
        cur = nxt; cA = nA; cB = nB; ++ui;
        if constexpr (ALIGN_EPI) { if (wr == 1) PG8_BAR; }
    }
    PG8_WAIT_V(0);
    if constexpr (!ALIGN_EPI) { if (wr == 0) PG8_BAR; }
    PG8_BAR;
    if constexpr (Epi::AFTER_DRAIN) { E.fused(acc, cur, wr, wc, fr, fq, lds, wid, lane); S.done(cur); }
#undef PG8_SA
#undef PG8_SB
#undef PG8_STAGE
#undef PG8_LDA
#undef PG8_LDB
#undef PG8_MMA
#undef PG8_WAIT_V
#undef PG8_WAIT_L
#undef PG8_BAR
#undef PG8_SCHED
}
}

namespace hy {
#define GAS __attribute__((address_space(1)))
#define LAS __attribute__((address_space(3)))
typedef unsigned short bf16;
typedef unsigned v4u __attribute__((ext_vector_type(4)));
typedef float f32x4 __attribute__((ext_vector_type(4)));
typedef short bf16x8 __attribute__((ext_vector_type(8)));
typedef GAS unsigned gu32;
typedef GAS unsigned long long gu64;
#define RLX_AGENT __ATOMIC_RELAXED, __HIP_MEMORY_SCOPE_AGENT
#define LDS_WAIT() asm volatile("s_waitcnt lgkmcnt(0)" ::: "memory")
#define VM_WAIT() asm volatile("s_waitcnt vmcnt(0)" ::: "memory")
__device__ __forceinline__ unsigned long long rt() { return __builtin_amdgcn_s_memrealtime(); }
typedef __bf16 hwbf2 __attribute__((ext_vector_type(2))); typedef float hwf2 __attribute__((ext_vector_type(2)));
__device__ __forceinline__ unsigned f2bf(float f) { return (unsigned)__builtin_bit_cast(unsigned short, (__bf16)f); }
__device__ __forceinline__ unsigned pk2(float lo, float hi) { const hwf2 v = {lo, hi}; return __builtin_bit_cast(unsigned, __builtin_convertvector(v, hwbf2)); }
#define XB_TMO      128
#define XB_XCNT(j)  (256  + 64 * (j))
#define XB_XSUB(j)  (1280 + 64 * (j))
#define XB_XGEN(j)  (2304 + 64 * (j))
#define XB_TOP      3328
#define XB_TOPGEN   3392
#define XCD_BAR_WORDS 3456
#define XB_SPIN_CAP (1u << 18)

__device__ __forceinline__ unsigned xb_ld(unsigned* p)              { return __hip_atomic_load(p, __ATOMIC_RELAXED, __HIP_MEMORY_SCOPE_AGENT); }
__device__ __forceinline__ unsigned xb_add(unsigned* p, unsigned v) { return __hip_atomic_fetch_add(p, v, __ATOMIC_RELAXED, __HIP_MEMORY_SCOPE_AGENT); }
__device__ __forceinline__ unsigned xb_xcc_id() { return (unsigned)__builtin_amdgcn_s_getreg((3 << 11) | 20) & 0xFu; }
#define XB_SPIN(cond, bar) do { unsigned _sp = 0; while (cond) { __builtin_amdgcn_s_sleep(1); \
    if ((++_sp & 255u) == 0u) { if (xb_ld(&(bar)[XB_TMO])) break; if (_sp > XB_SPIN_CAP) { atomicAdd(&(bar)[XB_TMO], 1u); break; } } } } while (0)

struct XcdBarrier {
    unsigned* bar; unsigned x;
    volatile LAS unsigned* st;
};

__device__ __forceinline__ XcdBarrier xcd_barrier_post(unsigned* bar, volatile LAS unsigned* st) {
    XcdBarrier b; b.bar = bar; b.x = xb_xcc_id(); b.st = st;
    if (threadIdx.x == 0) (void)xb_add(&bar[XB_XCNT(b.x)], 1u);
    return b;
}
__device__ __forceinline__ void xcd_barrier_complete(unsigned* bar, unsigned x, unsigned& nloc, unsigned& nx) {
    const unsigned G = gridDim.x * gridDim.y * gridDim.z;
    unsigned sum, cnt, mine, sp = 0u;
    for (;;) {
        sum = 0u; cnt = 0u; mine = 0u;
#pragma unroll
        for (unsigned j = 0; j < 16; ++j) { const unsigned c = xb_ld(&bar[XB_XCNT(j)]); sum += c; cnt += (c > 0u) ? 1u : 0u; mine = (j == x) ? c : mine; }
        if (sum == G) break;
        __builtin_amdgcn_s_sleep(1);
        if ((++sp & 255u) == 0u) { if (xb_ld(&bar[XB_TMO])) break; if (sp > XB_SPIN_CAP) { atomicAdd(&bar[XB_TMO], 1u); break; } }
    }
    nloc = mine > 0u ? mine : 1u; nx = cnt > 0u ? cnt : 1u;
}

__device__ __forceinline__ void xcd_barrier(const XcdBarrier& b) {
    asm volatile("s_waitcnt vmcnt(0)" ::: "memory");
    __syncthreads();
    if (threadIdx.x == 0) {
        unsigned* bar = b.bar;
        __builtin_amdgcn_s_waitcnt(0);
        unsigned nloc = b.st[0], nx = b.st[1];
        if (nloc == 0u) { xcd_barrier_complete(bar, b.x, nloc, nx); b.st[0] = nloc; b.st[1] = nx; }
        const unsigned old = xb_add(&bar[XB_XSUB(b.x)], 1u);
        const unsigned gen = old / nloc;
        if (old + 1u == (gen + 1u) * nloc) {
            __builtin_amdgcn_fence(__ATOMIC_RELEASE, "agent");
            asm volatile("s_waitcnt vmcnt(0)" ::: "memory");
            const unsigned og = xb_add(&bar[XB_TOP], 1u);
            const unsigned tg = og / nx;
            if (og + 1u == (tg + 1u) * nx) xb_add(&bar[XB_TOPGEN], 1u);
            else XB_SPIN(xb_ld(&bar[XB_TOPGEN]) == tg, bar);
            __builtin_amdgcn_fence(__ATOMIC_ACQUIRE, "agent");
            xb_add(&bar[XB_XGEN(b.x)], 1u);
            asm volatile("s_waitcnt vmcnt(0)" ::: "memory");
        } else {
            XB_SPIN(xb_ld(&bar[XB_XGEN(b.x)]) == gen, bar);
            __builtin_amdgcn_fence(__ATOMIC_ACQUIRE, "agent");
            asm volatile("s_waitcnt vmcnt(0)" ::: "memory");
        }
    }
    __syncthreads();
}

constexpr int B_ = 4, T_ = 8192, D_ = 1024, M_ = B_ * T_, L_ = 2;
constexpr int NIN = 3584, NPG = 1792, NPR = 1792;
constexpr int DFF = 2816, NUP = 5632, IN_COLS = 3344;
constexpr size_t MiB = 1u << 20;
constexpr size_t WS_CTL = 0, CTL_ZERO_BYTES = 65536;
constexpr int CW_BAR = 4096;
constexpr size_t WS_RK = MiB / 4;
constexpr size_t WS_MOD = 3 * MiB / 2;
constexpr size_t WS_WIN = 2 * MiB, WS_WOUT = 9 * MiB, WS_WUP = 11 * MiB, WS_WDN = 22 * MiB, WS_LORA = 55 * MiB / 2, WS_GAMC = 28 * MiB, WS_VL = 29 * MiB;
constexpr size_t WS_GAM = 31 * MiB;
constexpr size_t WS_XB = 32 * MiB, WS_O = 96 * MiB, WS_VF = 160 * MiB, WS_GK = 192 * MiB, WS_PG = 224 * MiB, WS_PR = 336 * MiB, WS_END = 512 * MiB;
constexpr size_t WS_RH = WS_XB, WS_YH = WS_XB + 32 * MiB, WS_PP = WS_O, WS_QQ = WS_O + 32 * MiB, WS_GG = 448 * MiB, WS_S0 = 480 * MiB;
constexpr size_t WS_ACT = 224 * MiB, WS_U = 400 * MiB;
constexpr int RING_BYTES = 131072, MISC_OFF = 161792, LDS_BYTES = 163840;
constexpr int NT = 512;

__device__ __forceinline__ float bf2f(bf16 h) { return __builtin_bit_cast(float, (unsigned)h << 16); }
__device__ __forceinline__ float sigmoidf_(float x) { return 1.f / (1.f + __expf(-x)); }
__device__ __forceinline__ float siluf_(float x) { return x / (1.f + __expf(-x)); }
__device__ __forceinline__ float softplusf_(float x) { return fmaxf(x, 0.f) + log1pf(__expf(-fabsf(x))); }

typedef unsigned u32x2 __attribute__((ext_vector_type(2)));
template <int CTRL> __device__ __forceinline__ float dpp_f(float v) {
    return __builtin_bit_cast(float, __builtin_amdgcn_update_dpp(0, __builtin_bit_cast(int, v), CTRL, 0xf, 0xf, false));
}
__device__ __forceinline__ float wave_sum(float v) {
    v += dpp_f<0xB1>(v);
    v += dpp_f<0x4E>(v);
    v += dpp_f<0x141>(v);
    v += dpp_f<0x140>(v);
    v += __builtin_bit_cast(float, __builtin_amdgcn_update_dpp(0, __builtin_bit_cast(int, v), 0x142, 0xa, 0xf, false));
    v += __builtin_bit_cast(float, __builtin_amdgcn_update_dpp(0, __builtin_bit_cast(int, v), 0x143, 0xc, 0xf, false));
    return __builtin_bit_cast(float, __builtin_amdgcn_readlane(__builtin_bit_cast(int, v), 63));
}

struct Ctx { int bid, nb, tid, lane, wave; LAS unsigned char* lds; };

__device__ __forceinline__ void ph_mod(const Ctx& C, const float* c, const float* ada_w, const float* ada_b, float* MOD) {
    LAS float* sc = (LAS float*)C.lds;
    LAS float* red = (LAS float*)(C.lds + 16384);
    for (int i = C.tid; i < 4096; i += NT) sc[i] = siluf_(c[i]);
    __syncthreads();
    for (int item = C.bid; item < 192; item += C.nb) {
        const int l = item / 96, j0 = (item % 96) * 64;
        const float* W = ada_w + (size_t)l * 1024 * 6144 + j0 + C.lane;
        float a0 = 0.f, a1 = 0.f, a2 = 0.f, a3 = 0.f;
        for (int k = C.wave * 128; k < C.wave * 128 + 128; ++k) { const float wv = W[(size_t)k * 6144]; a0 += sc[k] * wv; a1 += sc[1024 + k] * wv; a2 += sc[2048 + k] * wv; a3 += sc[3072 + k] * wv; }
        red[(C.wave * 4 + 0) * 64 + C.lane] = a0; red[(C.wave * 4 + 1) * 64 + C.lane] = a1; red[(C.wave * 4 + 2) * 64 + C.lane] = a2; red[(C.wave * 4 + 3) * 64 + C.lane] = a3;
        __syncthreads();
        if (C.wave < 4) { const int b = C.wave; float s = ada_b[l * 6144 + j0 + C.lane];
#pragma unroll
            for (int w = 0; w < 8; ++w) s += red[(w * 4 + b) * 64 + C.lane];
            MOD[((size_t)l * 4 + b) * 6144 + j0 + C.lane] = s; }
        __syncthreads();
    }
}

__device__ __forceinline__ void wprep_mat(const Ctx& C, const float* W, int K, int Nsrc, int Ndst, bf16* Wt, int mode, const float* vres) {
    const int half = C.tid >> 8, t = C.tid & 255, tx = t & 31, ty = t >> 5;
    LAS float* tile = (LAS float*)C.lds + half * (32 * 33);
    const int nbn = Ndst / 32, ntile = nbn * (K / 32);
    const int niter = (ntile + 2 * C.nb - 1) / (2 * C.nb);
    for (int it = 0; it < niter; ++it) {
        const int item = (it * C.nb + C.bid) * 2 + half;
        const bool act = item < ntile;
        const int n0 = (item % nbn) * 32, k0 = (item / nbn) * 32, n = n0 + tx;
        if (act) {
#pragma unroll
            for (int i = 0; i < 4; ++i) { const int k = k0 + ty + 8 * i; float v = 0.f;
                if (mode == 0) v = W[(size_t)k * Nsrc + n];
                else if (mode == 2) { const int tl = n >> 8, w = n & 255; v = W[(size_t)k * Nsrc + (w < 128 ? tl * 128 + w : 2816 + tl * 128 + (w - 128))]; }
                else { if (n < 1552) v = W[(size_t)k * Nsrc + n]; else if (n < 1584) v = vres ? vres[(size_t)k * 32 + (n - 1552)] : 0.f; else if (n < 1792) v = 0.f; else v = W[(size_t)k * Nsrc + (n - 240)]; }
                tile[(ty + 8 * i) * 33 + tx] = v; }
        }
        __syncthreads();
        if (act) {
#pragma unroll
            for (int i = 0; i < 4; ++i) { const int nn = n0 + ty + 8 * i; Wt[(size_t)nn * K + k0 + tx] = (bf16)f2bf(tile[tx * 33 + ty + 8 * i]); }
        }
        __syncthreads();
    }
}

__device__ __forceinline__ void ph_norm(const Ctx& C, const float* x, const float* g, const float* sh, const float* sc, bf16* XB) {
    const int gw = C.bid * 8 + C.wave, NGW = C.nb * 8, lane = C.lane;
    for (int m = gw; m < M_; m += NGW) {
        const int b = m / T_;
        const f32x4* xr = (const f32x4*)(x + (size_t)m * D_) + lane;
        f32x4 v[4]; float s = 0.f;
#pragma unroll
        for (int j = 0; j < 4; ++j) { v[j] = xr[64 * j]; s += (v[j].x * v[j].x + v[j].y * v[j].y) + (v[j].z * v[j].z + v[j].w * v[j].w); }
        const float rstd = 1.f / sqrtf(wave_sum(s) * (1.f / D_) + 1e-6f);
        unsigned long long* o8 = (unsigned long long*)(XB + (size_t)m * D_) + lane;
#pragma unroll
        for (int j = 0; j < 4; ++j) { const int col = 4 * lane + 256 * j;
            const f32x4 gv = *(const f32x4*)(g + col), shv = *(const f32x4*)(sh + b * 6144 + col), scv = *(const f32x4*)(sc + b * 6144 + col);
            const f32x4 h = v[j] * rstd * gv * (scv + 1.f) + shv;
            o8[64 * j] = (unsigned long long)pk2(h.x, h.y) | ((unsigned long long)pk2(h.z, h.w) << 32); }
    }
}
__device__ __forceinline__ void ph_final(const Ctx& C, float* x, const float* g) {
    const int gw = C.bid * 8 + C.wave, NGW = C.nb * 8, lane = C.lane;
    for (int m = gw; m < M_; m += NGW) {
        f32x4* xr = (f32x4*)(x + (size_t)m * D_) + lane;
        f32x4 v[4]; float s = 0.f;
#pragma unroll
        for (int j = 0; j < 4; ++j) { v[j] = xr[64 * j]; s += (v[j].x * v[j].x + v[j].y * v[j].y) + (v[j].z * v[j].z + v[j].w * v[j].w); }
        const float rstd = 1.f / sqrtf(wave_sum(s) * (1.f / D_) + 1e-6f);
#pragma unroll
        for (int j = 0; j < 4; ++j) { const f32x4 gv = *(const f32x4*)(g + 4 * lane + 256 * j); xr[64 * j] = v[j] * rstd * gv; }
    }
}


typedef short s16x8 __attribute__((ext_vector_type(8)));
__device__ __forceinline__ f32x4 mm16(const LAS bf16* A, int lda, const LAS bf16* B, int ldb, int K, f32x4 acc, int lane) {
    const int r = lane & 15, g = lane >> 4;
    const LAS bf16* ap = A + r * lda + 8 * g; const LAS bf16* bp = B + r * ldb + 8 * g;
    for (int k0 = 0; k0 < K; k0 += 32) { const s16x8 a = *(const LAS s16x8*)(ap + k0); const s16x8 b = *(const LAS s16x8*)(bp + k0); acc = __builtin_amdgcn_mfma_f32_16x16x32_bf16(a, b, acc, 0, 0, 0); }
    return acc;
}
__device__ __forceinline__ f32x4 mm16_ga(const bf16* A, int lda, const LAS bf16* B, int ldb, int K, f32x4 acc, int lane) {
    const int r = lane & 15, g = lane >> 4;
    const bf16* ap = A + r * lda + 8 * g; const LAS bf16* bp = B + r * ldb + 8 * g;
    for (int k0 = 0; k0 < K; k0 += 32) { const s16x8 a = *(const s16x8*)(ap + k0); const s16x8 b = *(const LAS s16x8*)(bp + k0); acc = __builtin_amdgcn_mfma_f32_16x16x32_bf16(a, b, acc, 0, 0, 0); }
    return acc;
}
__device__ __forceinline__ unsigned long long pack4(f32x4 v) { return (unsigned long long)pk2(v.x, v.y) | ((unsigned long long)pk2(v.z, v.w) << 32); }
__device__ __forceinline__ float logsigmoidf_(float x) { return fminf(x, 0.f) - __logf(1.f + __expf(-fabsf(x))); }

constexpr int GL_LD = 72;
constexpr int GL_GK = 0;
constexpr int GL_SEG = 16384;
constexpr int GL_Z = 18432;
constexpr int GL_GUP = 20480;
constexpr int GL_I0 = 24832;
constexpr int GL_I1 = GL_I0 + 9216;
constexpr int GL_I2 = GL_I1 + 9216;
constexpr int GL_VT = GL_I2 + 9216;
constexpr int GL_SSQ = GL_VT + 18432;
static_assert(GL_SSQ + 512 <= RING_BYTES, "GLA LDS map");

struct GlaRaw { v4u z, k, q, v0, v1; float g0, g1, gb; };
__device__ __forceinline__ void gla_fetch(GlaRaw& R, const Ctx& C, const bf16* pg, const float* gk_up, const float* gk_b, int h, bool want_q) {
    const int tid = C.tid, j = tid >> 3, d0 = (tid & 7) * 8, e0 = (tid & 7) * 16;
    R.z = (v4u){0u, 0u, 0u, 0u}; R.q = R.z;
    if (tid < 128) R.z = *(const v4u*)(pg + (size_t)(tid >> 1) * NPG + 1536 + (tid & 1) * 8);
    R.g0 = gk_up[(tid >> 6) * 256 + h * 64 + (tid & 63)]; R.g1 = gk_up[((tid + NT) >> 6) * 256 + h * 64 + (tid & 63)]; R.gb = gk_b[h * 64 + (tid & 63)];
    R.k = *(const v4u*)(pg + (size_t)j * NPG + 256 + h * 64 + d0);
    if (want_q) R.q = *(const v4u*)(pg + (size_t)j * NPG + h * 64 + d0);
    R.v0 = *(const v4u*)(pg + (size_t)j * NPG + 512 + h * 128 + e0); R.v1 = *(const v4u*)(pg + (size_t)j * NPG + 512 + h * 128 + e0 + 8);
}
__device__ __forceinline__ void gla_gates(const Ctx& C, const GlaRaw& R) {
    LAS float* GK = (LAS float*)(C.lds + GL_GK); LAS float* SEG = (LAS float*)(C.lds + GL_SEG); LAS bf16* Z = (LAS bf16*)(C.lds + GL_Z); LAS float* GUP = (LAS float*)(C.lds + GL_GUP);
    const int tid = C.tid;
    if (tid < 128) { const int t = tid >> 1, hh = tid & 1; *(LAS v4u*)(Z + t * 16 + hh * 8) = R.z; }
    GUP[tid] = R.g0; GUP[tid + NT] = R.g1;
    if (tid < 64) GUP[1024 + tid] = R.gb;
    __syncthreads();
    { const int t = tid >> 3, d0 = (tid & 7) * 8; float a[8];
#pragma unroll
      for (int q = 0; q < 8; ++q) a[q] = GUP[1024 + d0 + q];
#pragma unroll
      for (int i = 0; i < 16; ++i) { const float zv = bf2f(Z[t * 16 + i]);
#pragma unroll
          for (int q = 0; q < 8; ++q) a[q] += zv * GUP[i * 64 + d0 + q]; }
#pragma unroll
      for (int q = 0; q < 8; ++q) GK[t * 64 + d0 + q] = logsigmoidf_(a[q]) * (1.f / 16.f); }
    __syncthreads();
    { const int d = tid & 63, seg = tid >> 6; float run = 0.f;
#pragma unroll
      for (int q = 0; q < 8; ++q) { run += GK[(seg * 8 + q) * 64 + d]; GK[(seg * 8 + q) * 64 + d] = run; }
      SEG[seg * 64 + d] = run; }
    __syncthreads();
    { const int d = tid & 63, seg = tid >> 6; float off = 0.f;
      for (int s = 0; s < seg; ++s) off += SEG[s * 64 + d];
#pragma unroll
      for (int q = 0; q < 8; ++q) GK[(seg * 8 + q) * 64 + d] += off; }
    __syncthreads();
}
__device__ __forceinline__ void gla_stage_vt(const Ctx& C, const GlaRaw& R) {
    LAS bf16* VT = (LAS bf16*)(C.lds + GL_VT);
    const int j = C.tid >> 3, e0 = (C.tid & 7) * 16;
    const unsigned w[8] = {R.v0.x, R.v0.y, R.v0.z, R.v0.w, R.v1.x, R.v1.y, R.v1.z, R.v1.w};
#pragma unroll
    for (int q = 0; q < 8; ++q) { VT[(e0 + 2 * q) * GL_LD + j] = (bf16)(w[q] & 0xffffu); VT[(e0 + 2 * q + 1) * GL_LD + j] = (bf16)(w[q] >> 16); }
}

__device__ __forceinline__ void ph_gla_a(const Ctx& C, const bf16* PG, const float* gk_up, const float* gk_b, bf16* DS, float* GAM) {
    LAS float* GK = (LAS float*)(C.lds + GL_GK); LAS bf16* KT = (LAS bf16*)(C.lds + GL_I0); LAS bf16* VT = (LAS bf16*)(C.lds + GL_VT);
    for (int item = C.bid; item < 2048; item += C.nb) {
        const int bh = item >> 7, c = item & 127, b = bh >> 2, h = bh & 3;
        const size_t m0 = (size_t)b * T_ + c * 64;
        const bf16* pg = PG + m0 * NPG;
        GlaRaw R; gla_fetch(R, C, pg, gk_up, gk_b, h, false);
        gla_gates(C, R);
        { const int j = C.tid >> 3, d0 = (C.tid & 7) * 8;
          const unsigned w[4] = {R.k.x, R.k.y, R.k.z, R.k.w};
#pragma unroll
          for (int q = 0; q < 4; ++q) { const float k0 = bf2f((bf16)(w[q] & 0xffffu)), k1 = bf2f((bf16)(w[q] >> 16));
              const int d = d0 + 2 * q;
              KT[d * GL_LD + j] = (bf16)f2bf(k0 * __expf(GK[63 * 64 + d] - GK[j * 64 + d]));
              KT[(d + 1) * GL_LD + j] = (bf16)f2bf(k1 * __expf(GK[63 * 64 + d + 1] - GK[j * 64 + d + 1])); } }
        gla_stage_vt(C, R);
        if (C.tid < 64) GAM[(size_t)item * 64 + C.tid] = __expf(GK[63 * 64 + C.tid]);
        __syncthreads();
        { const int n0 = C.wave * 16, lane = C.lane, cc = lane & 15, g = lane >> 4;
          bf16* out = DS + (size_t)item * 8192 + (size_t)(n0 + cc) * 64 + 4 * g;
#pragma unroll
          for (int mt = 0; mt < 4; ++mt) { f32x4 acc = {0.f, 0.f, 0.f, 0.f}; acc = mm16(KT + mt * 16 * GL_LD, GL_LD, VT + n0 * GL_LD, GL_LD, 64, acc, lane);
              *(unsigned long long*)(out + mt * 16) = pack4(acc); } }
        __syncthreads();
    }
}
__device__ __forceinline__ void ph_gla_b(const Ctx& C, bf16* DS, const float* GAM) {
    for (int idx = C.bid * NT + C.tid; idx < 16 * 8192; idx += C.nb * NT) {
        const int bh = idx >> 13, ed = idx & 8191, d = ed & 63;
        bf16* p = DS + (size_t)bh * 128 * 8192 + ed; const float* gp = GAM + (size_t)bh * 128 * 64 + d;
        float S = 0.f;
        for (int c0 = 0; c0 < 128; c0 += 8) {
            float ds[8], gm[8];
#pragma unroll
            for (int i = 0; i < 8; ++i) { ds[i] = bf2f(p[(size_t)(c0 + i) * 8192]); gm[i] = gp[(c0 + i) * 64]; }
#pragma unroll
            for (int i = 0; i < 8; ++i) { const float gs = gm[i] * S; p[(size_t)(c0 + i) * 8192] = (bf16)f2bf(gs); S = gs + ds[i]; }
        }
    }
}
__device__ __forceinline__ void ph_gla_c(const Ctx& C, const bf16* PG, const float* gk_up, const float* gk_b, const float* norm_g, const bf16* DS, bf16* O) {
    LAS float* GK = (LAS float*)(C.lds + GL_GK); LAS bf16* QP = (LAS bf16*)(C.lds + GL_I0); LAS bf16* KM = (LAS bf16*)(C.lds + GL_I1); LAS bf16* AI = (LAS bf16*)(C.lds + GL_I2);
    LAS bf16* VT = (LAS bf16*)(C.lds + GL_VT); LAS float* SSQ = (LAS float*)(C.lds + GL_SSQ);
    for (int item = C.bid; item < 2048; item += C.nb) {
        const int bh = item >> 7, c = item & 127, b = bh >> 2, h = bh & 3;
        const size_t m0 = (size_t)b * T_ + c * 64;
        const bf16* pg = PG + m0 * NPG;
        GlaRaw R; gla_fetch(R, C, pg, gk_up, gk_b, h, true);
        s16x8 sfrag[4][2];
        { const int lane = C.lane, cc = lane & 15, g = lane >> 4, eh = C.wave >> 2; const bf16* Sg = DS + (size_t)item * 8192;
#pragma unroll
          for (int mt = 0; mt < 4; ++mt) { sfrag[mt][0] = *(const s16x8*)(Sg + (size_t)(eh * 64 + mt * 16 + cc) * 64 + 8 * g); sfrag[mt][1] = *(const s16x8*)(Sg + (size_t)(eh * 64 + mt * 16 + cc) * 64 + 32 + 8 * g); } }
        gla_gates(C, R);
        { const int j = C.tid >> 3, d0 = (C.tid & 7) * 8;
          const v4u qx = R.q, kx = R.k;
          const unsigned qw[4] = {qx.x, qx.y, qx.z, qx.w}, kw[4] = {kx.x, kx.y, kx.z, kx.w};
          unsigned qo[4], ko[4];
#pragma unroll
          for (int q = 0; q < 4; ++q) { const int d = d0 + 2 * q;
              const float e0 = GK[63 * 64 + d] - GK[j * 64 + d], e1 = GK[63 * 64 + d + 1] - GK[j * 64 + d + 1];
              const float q0 = 0.125f * bf2f((bf16)(qw[q] & 0xffffu)) * __expf(-e0), q1 = 0.125f * bf2f((bf16)(qw[q] >> 16)) * __expf(-e1);
              const float k0 = bf2f((bf16)(kw[q] & 0xffffu)) * __expf(e0), k1 = bf2f((bf16)(kw[q] >> 16)) * __expf(e1);
              qo[q] = pk2(q0, q1); ko[q] = pk2(k0, k1); }
          *(LAS v4u*)(QP + j * GL_LD + d0) = (v4u){qo[0], qo[1], qo[2], qo[3]}; *(LAS v4u*)(KM + j * GL_LD + d0) = (v4u){ko[0], ko[1], ko[2], ko[3]}; }
        gla_stage_vt(C, R);
        __syncthreads();
        { const int lane = C.lane, cc = lane & 15, g = lane >> 4, n0 = (C.wave >> 1) * 16;
#pragma unroll
          for (int q = 0; q < 2; ++q) { const int mt0 = ((C.wave & 1) * 2 + q) * 16; f32x4 acc = {0.f, 0.f, 0.f, 0.f};
              acc = mm16(KM + mt0 * GL_LD, GL_LD, QP + n0 * GL_LD, GL_LD, 64, acc, lane);
              const int i = n0 + cc, j = mt0 + 4 * g;
              acc.x = (j + 0 <= i) ? acc.x : 0.f; acc.y = (j + 1 <= i) ? acc.y : 0.f; acc.z = (j + 2 <= i) ? acc.z : 0.f; acc.w = (j + 3 <= i) ? acc.w : 0.f;
              *(LAS unsigned long long*)(AI + (n0 + cc) * GL_LD + mt0 + 4 * g) = pack4(acc); } }
        __syncthreads();
        { const int lane = C.lane, cc = lane & 15, g = lane >> 4, n0 = (C.wave & 3) * 16, eh = C.wave >> 2;
          f32x4 acc[4]; float ss = 0.f;
#pragma unroll
          for (int mt = 0; mt < 4; ++mt) { const int e0 = eh * 64 + mt * 16; acc[mt] = (f32x4){0.f, 0.f, 0.f, 0.f};
              { const LAS bf16* bp = QP + (n0 + cc) * GL_LD + 8 * g;
                acc[mt] = __builtin_amdgcn_mfma_f32_16x16x32_bf16(sfrag[mt][0], *(const LAS s16x8*)bp, acc[mt], 0, 0, 0); acc[mt] = __builtin_amdgcn_mfma_f32_16x16x32_bf16(sfrag[mt][1], *(const LAS s16x8*)(bp + 32), acc[mt], 0, 0, 0); }
              acc[mt] = mm16(VT + e0 * GL_LD, GL_LD, AI + n0 * GL_LD, GL_LD, 64, acc[mt], lane);
              ss += (acc[mt].x * acc[mt].x + acc[mt].y * acc[mt].y) + (acc[mt].z * acc[mt].z + acc[mt].w * acc[mt].w); }
          ss += __shfl_xor(ss, 16); ss += __shfl_xor(ss, 32);
          if (g == 0) SSQ[eh * 64 + n0 + cc] = ss;
          __syncthreads();
          const float rstd = 1.f / sqrtf((SSQ[n0 + cc] + SSQ[64 + n0 + cc]) * (1.f / 128.f) + 1e-6f);
          const size_t m = m0 + n0 + cc;
#pragma unroll
          for (int mt = 0; mt < 4; ++mt) { const int e = eh * 64 + mt * 16 + 4 * g;
              const unsigned long long gx = *(const unsigned long long*)(pg + (size_t)(n0 + cc) * NPG + 1024 + h * 128 + e);
              const f32x4 ng = *(const f32x4*)(norm_g + e);
              f32x4 o;
              o.x = acc[mt].x * rstd * ng.x * siluf_(bf2f((bf16)(gx & 0xffffu)));
              o.y = acc[mt].y * rstd * ng.y * siluf_(bf2f((bf16)((gx >> 16) & 0xffffu)));
              o.z = acc[mt].z * rstd * ng.z * siluf_(bf2f((bf16)((gx >> 32) & 0xffffu)));
              o.w = acc[mt].w * rstd * ng.w * siluf_(bf2f((bf16)(gx >> 48)));
              *(unsigned long long*)(O + m * D_ + h * 128 + e) = pack4(o); } }
        __syncthreads();
    }
}


struct RwkvW { const float *mu, *mu_vres, *w0, *a0, *v0, *k_k, *k_a, *r_k; const bf16 *wupT, *aupT, *gupT, *vupT; };
constexpr int RW_LD = 72, RW_XLD = 296;
constexpr int RW_R0 = 0;
constexpr int RW_SEG = 16384;
constexpr int RW_R1 = 36864;
constexpr int RW_R2 = RW_R1 + 27648;
constexpr int RW_R3 = RW_R2 + 9216;
constexpr int RW_R4 = RW_R3 + 27648;
constexpr int RW_TI = RW_R4 + 128 * RW_LD * 2;
constexpr int RW_MU = RW_TI + 2048;
constexpr int RW_X = RW_MU + 2048;
constexpr int RW_END = RW_X + 64 * RW_XLD * 2;
static_assert(RW_END <= MISC_OFF, "RWKV LDS map");

typedef short s16x4 __attribute__((ext_vector_type(4)));
__device__ __forceinline__ float tanh_fast(float x) { const float e = __expf(2.f * x); return 1.f - 2.f / (e + 1.f); }
__device__ __forceinline__ float softplus_fast(float x) { return fmaxf(x, 0.f) + __logf(1.f + __expf(-fabsf(x))); }
__device__ __forceinline__ s16x4 cvt4(f32x4 v) { const unsigned long long p = pack4(v); return __builtin_bit_cast(s16x4, p); }
__device__ __forceinline__ void ld8f(const float* p, float (&o)[8]) { const f32x4 a = *(const f32x4*)p, b = *(const f32x4*)(p + 4); o[0] = a.x; o[1] = a.y; o[2] = a.z; o[3] = a.w; o[4] = b.x; o[5] = b.y; o[6] = b.z; o[7] = b.w; }
__device__ __forceinline__ float sum8(float v) { v += dpp_f<0xB1>(v); v += dpp_f<0x4E>(v); v += dpp_f<0x141>(v); return v; }
__device__ __forceinline__ void unpack8(const v4u x, float (&o)[8]) {
    o[0] = bf2f((bf16)(x.x & 0xffffu)); o[1] = bf2f((bf16)(x.x >> 16)); o[2] = bf2f((bf16)(x.y & 0xffffu)); o[3] = bf2f((bf16)(x.y >> 16));
    o[4] = bf2f((bf16)(x.z & 0xffffu)); o[5] = bf2f((bf16)(x.z >> 16)); o[6] = bf2f((bf16)(x.w & 0xffffu)); o[7] = bf2f((bf16)(x.w >> 16)); }
__device__ __forceinline__ v4u pack8(const float (&o)[8]) { return (v4u){pk2(o[0], o[1]), pk2(o[2], o[3]), pk2(o[4], o[5]), pk2(o[6], o[7])}; }
__device__ __forceinline__ f32x4 mm16_gb(const LAS bf16* A, int lda, const bf16* B, int ldb, int K, f32x4 acc, int lane) {
    const int r = lane & 15, g = lane >> 4;
    const LAS bf16* ap = A + r * lda + 8 * g; const bf16* bp = B + r * ldb + 8 * g;
    for (int k0 = 0; k0 < K; k0 += 32) { const s16x8 a = *(const LAS s16x8*)(ap + k0); const s16x8 b = *(const s16x8*)(bp + k0); acc = __builtin_amdgcn_mfma_f32_16x16x32_bf16(a, b, acc, 0, 0, 0); }
    return acc;
}

__device__ __forceinline__ void ph_rwkv_a(const Ctx& C, const bf16* PR, const bf16* VL  , const RwkvW& W, int layer,
                                          bf16* PP, bf16* QQ, bf16* RH, bf16* YH, float* GAMC, float* RK, bf16* GG, bf16* VF, bool store_v = true) {
    LAS unsigned char* L = C.lds;
    LAS bf16* X = (LAS bf16*)(L + RW_X); LAS float* CUM = (LAS float*)(L + RW_R0); LAS float* SEG = (LAS float*)(L + RW_SEG);
    LAS bf16* NI = (LAS bf16*)(L + RW_R0), *AAK = NI + 64 * RW_LD, *ARB = AAK + 64 * RW_LD, *ARK = ARB + 64 * RW_LD;
    LAS bf16* PRE = (LAS bf16*)(L + RW_R1);
    LAS bf16* AT = (LAS bf16*)(L + RW_R1), *BT = AT + 64 * RW_LD, *KT = BT + 64 * RW_LD, *RT = (LAS bf16*)(L + RW_R2);
    LAS bf16* XB16 = (LAS bf16*)(L + RW_R1);
    LAS bf16* BHc = (LAS bf16*)(L + RW_R3), *KHc = BHc + 64 * RW_LD, *VTc = KHc + 64 * RW_LD;
    LAS bf16* XT = (LAS bf16*)(L + RW_R4); LAS bf16* TI = (LAS bf16*)(L + RW_TI);
    const int wave = C.wave;
    LAS float* MU = (LAS float*)(L + RW_MU);
    for (int i = C.tid; i < 288; i += NT) MU[i] = i < 256 ? W.mu[1536 + i] : (layer ? W.mu_vres[i - 256] : 0.f);
    __syncthreads();
    for (int bc = C.bid; bc < 512; bc += C.nb) {
        const int c = bc & 127, b = bc >> 7;
        const size_t m0 = (size_t)b * T_ + c * 64;
        { const int tid = C.tid;
          v4u xc[5], xp[5];
#pragma unroll
          for (int it = 0; it < 5; ++it) { const int idx = tid + it * NT; xc[it] = (v4u){0u, 0u, 0u, 0u}; xp[it] = xc[it];
            if (idx < 64 * 36) { const int t1 = idx / 36, q = idx % 36, col = q * 8; const size_t m1 = m0 + t1; const bool first1 = (c == 0 && t1 == 0);
                if (q < 32) { xc[it] = *(const v4u*)(PR + m1 * NPR + 1536 + col); if (!first1) xp[it] = *(const v4u*)(PR + (m1 - 1) * NPR + 1536 + col); }
                else if (layer) { xc[it] = *(const v4u*)(VL + m1 * NPG + 1552 + (col - 256)); if (!first1) xp[it] = *(const v4u*)(VL + (m1 - 1) * NPG + 1552 + (col - 256)); } } }
#pragma unroll
          for (int it = 0; it < 5; ++it) { const int idx = tid + it * NT;
            if (idx < 64 * 36) { const int t1 = idx / 36, q = idx % 36, col = q * 8;
                float cv[8], pv[8], mu[8]; unpack8(xc[it], cv); unpack8(xp[it], pv);
                { const f32x4 ma = *(const LAS f32x4*)(MU + col), mb = *(const LAS f32x4*)(MU + col + 4); mu[0] = ma.x; mu[1] = ma.y; mu[2] = ma.z; mu[3] = ma.w; mu[4] = mb.x; mu[5] = mb.y; mu[6] = mb.z; mu[7] = mb.w; }
#pragma unroll
                for (int i = 0; i < 8; ++i) { float p = cv[i] + (pv[i] - cv[i]) * mu[i]; if (q < 8) p = tanh_fast(p); else if (q >= 16 && q < 32) p = sigmoidf_(p); cv[i] = p; }
                *(LAS v4u*)(X + t1 * RW_XLD + col) = pack8(cv); } }
        }
        __syncthreads();
#pragma unroll 1
      for (int h = 0; h < 8; ++h) {
        const int item = bc * 8 + h;
        int tid_ = C.tid; asm volatile("" : "+v"(tid_));
        const int tid = tid_, lane = tid & 63, cc = lane & 15, g = lane >> 4;
        const int t = tid >> 3, d0 = (tid & 7) * 8, ch = h * 64 + d0; const size_t m = m0 + t; const bool first = (c == 0 && t == 0);
        v4u rcx = *(const v4u*)(PR + m * NPR + ch), kcx = *(const v4u*)(PR + m * NPR + 512 + ch), vcx = *(const v4u*)(PR + m * NPR + 1024 + ch);
        v4u rpx = (v4u){0u, 0u, 0u, 0u}, kpx = rpx, vpx = rpx, vfx = rpx;
        if (!first) { rpx = *(const v4u*)(PR + (m - 1) * NPR + ch); kpx = *(const v4u*)(PR + (m - 1) * NPR + 512 + ch); vpx = *(const v4u*)(PR + (m - 1) * NPR + 1024 + ch); }
        if (layer) vfx = *(const v4u*)(VF + m * 512 + ch);
        {
            const int lsel = wave >> 1;
            const bf16* WT = lsel == 0 ? W.wupT : lsel == 1 ? W.aupT : lsel == 2 ? W.gupT : W.vupT;
            const int Kl = lsel == 2 ? 128 : lsel == 3 ? 32 : 64, xoff = lsel == 0 ? 0 : lsel == 1 ? 64 : lsel == 2 ? 128 : 256;
            LAS bf16* outp = PRE + lsel * 64 * RW_LD;
            const bool live = (lsel != 3 || layer);
#pragma unroll
            for (int mq = 0; mq < 2; ++mq) { const int mt = (wave & 1) * 2 + mq;
                s16x8 af[4];
                const bf16* ap = WT + (size_t)(h * 64 + mt * 16 + cc) * Kl + 8 * g;
#pragma unroll
                for (int ks = 0; ks < 4; ++ks) af[ks] = (live && ks * 32 < Kl) ? *(const s16x8*)(ap + ks * 32) : (s16x8){0, 0, 0, 0, 0, 0, 0, 0};
#pragma unroll
                for (int nt = 0; nt < 4; ++nt) { f32x4 acc = {0.f, 0.f, 0.f, 0.f};
                    const LAS bf16* bp = X + (nt * 16 + cc) * RW_XLD + xoff + 8 * g;
#pragma unroll
                    for (int ks = 0; ks < 4; ++ks) if (ks * 32 < Kl) { const s16x8 bb = *(const LAS s16x8*)(bp + ks * 32); acc = __builtin_amdgcn_mfma_f32_16x16x32_bf16(af[ks], bb, acc, 0, 0, 0); }
                    *(LAS unsigned long long*)(outp + (nt * 16 + cc) * RW_LD + mt * 16 + 4 * g) = pack4(acc); } }
        }
        __syncthreads();
        float av[8], bv[8], kv[8], rv[8], lw[8], vv[8];
        {
            float rc[8], rp[8], kc[8], kp[8], vc[8], vp[8], pw[8], pa[8], pg_[8], pvg[8];
            unpack8(rcx, rc); unpack8(kcx, kc); unpack8(vcx, vc); unpack8(rpx, rp); unpack8(kpx, kp); unpack8(vpx, vp);
            unpack8(*(const LAS v4u*)(PRE + (0 * 64 + t) * RW_LD + d0), pw); unpack8(*(const LAS v4u*)(PRE + (1 * 64 + t) * RW_LD + d0), pa);
            unpack8(*(const LAS v4u*)(PRE + (2 * 64 + t) * RW_LD + d0), pg_); unpack8(*(const LAS v4u*)(PRE + (3 * 64 + t) * RW_LD + d0), pvg);
            float vf[8]; unpack8(vfx, vf);
            float ssq = 0.f, rks = 0.f, asg[8], gg[8];
            float mur[8], muk[8], muv[8], w0c[8], a0c[8], v0c[8], kkc[8], kac[8], rkc[8];
            ld8f(W.mu + ch, mur); ld8f(W.mu + 512 + ch, muk); ld8f(W.mu + 1024 + ch, muv); ld8f(W.w0 + ch, w0c); ld8f(W.a0 + ch, a0c);
            ld8f(W.k_k + ch, kkc); ld8f(W.k_a + ch, kac); ld8f(W.r_k + ch, rkc);
            if (layer) ld8f(W.v0 + ch, v0c);
#pragma unroll
            for (int i = 0; i < 8; ++i) {
                const float r = rc[i] + (rp[i] - rc[i]) * mur[i], k = kc[i] + (kp[i] - kc[i]) * muk[i]; float v = vc[i] + (vp[i] - vc[i]) * muv[i];
                lw[i] = -0.6065306597f * sigmoidf_(w0c[i] + pw[i]);
                asg[i] = sigmoidf_(a0c[i] + pa[i]);
                if (layer) v = v + (vf[i] - v) * sigmoidf_(v0c[i] + pvg[i]);
                const float kk = k * kkc[i]; ssq += kk * kk;
                kv[i] = k * (1.f + (asg[i] - 1.f) * kac[i]); rv[i] = r; vv[i] = v; gg[i] = pg_[i]; av[i] = kk;
                rks += r * kv[i] * rkc[i];
            }
            ssq = sum8(ssq); rks = sum8(rks);
            const float inv = 1.f / sqrtf(fmaxf(ssq, 1e-24f));
#pragma unroll
            for (int i = 0; i < 8; ++i) { const float kk = av[i] * inv; av[i] = -kk; bv[i] = kk * asg[i]; }
            if ((tid & 7) == 0) RK[m * 8 + h] = rks;
            *(v4u*)(GG + m * 512 + ch) = pack8(gg);
            if (store_v) *(v4u*)(VF + m * 512 + ch) = pack8(vv);
#pragma unroll
            for (int i = 0; i < 8; ++i) vv[i] = bf2f((bf16)f2bf(vv[i]));
        }
        __syncthreads();
#pragma unroll
        for (int i = 0; i < 8; ++i) CUM[t * 64 + d0 + i] = lw[i];
        __syncthreads();
        { const int d = tid & 63, seg = tid >> 6; float run = 0.f;
#pragma unroll
          for (int q = 0; q < 8; ++q) { run += CUM[(seg * 8 + q) * 64 + d]; CUM[(seg * 8 + q) * 64 + d] = run; }
          SEG[seg * 64 + d] = run; }
        __syncthreads();
        { const int d = tid & 63, seg = tid >> 6; float off = 0.f;
          for (int s = 0; s < seg; ++s) off += SEG[s * 64 + d];
#pragma unroll
          for (int q = 0; q < 8; ++q) CUM[(seg * 8 + q) * 64 + d] += off; }
        __syncthreads();
        {
            float at[8], bt[8], kt[8], rt[8];
#pragma unroll
            for (int i = 0; i < 8; ++i) { const float cu = CUM[t * 64 + d0 + i], cC = CUM[63 * 64 + d0 + i], en = __expf(-cu), ec = __expf(cC - cu);
                at[i] = av[i] * __expf(cu - lw[i]); bt[i] = bv[i] * en; kt[i] = kv[i] * en; rt[i] = rv[i] * __expf(cu);
                BHc[(d0 + i) * RW_LD + t] = (bf16)f2bf(bv[i] * ec); KHc[(d0 + i) * RW_LD + t] = (bf16)f2bf(kv[i] * ec); VTc[(d0 + i) * RW_LD + t] = (bf16)f2bf(vv[i]);
                XT[(d0 + i) * RW_LD + t] = (bf16)f2bf(at[i]);
                if (t == 63) GAMC[(size_t)item * 64 + d0 + i] = __expf(cC); }
            *(LAS v4u*)(AT + t * RW_LD + d0) = pack8(at); *(LAS v4u*)(BT + t * RW_LD + d0) = pack8(bt); *(LAS v4u*)(KT + t * RW_LD + d0) = pack8(kt); *(LAS v4u*)(RT + t * RW_LD + d0) = pack8(rt);
        }
        __syncthreads();
        {
            const int msel = wave >> 1;
            const LAS bf16* As = (msel == 0 || msel == 2) ? BT : KT; const LAS bf16* Bs = (msel < 2) ? AT : RT;
            f32x4 accs[8];
#pragma unroll
            for (int q = 0; q < 8; ++q) { const int tile = (wave & 1) * 8 + q, mt = tile >> 2, nt = tile & 3; accs[q] = (f32x4){0.f, 0.f, 0.f, 0.f};
                accs[q] = mm16(As + mt * 16 * RW_LD, RW_LD, Bs + nt * 16 * RW_LD, RW_LD, 64, accs[q], lane);
                const int tt = nt * 16 + cc, s0 = mt * 16 + 4 * g, lim = (msel < 2) ? tt - 1 : tt;
                accs[q].x = (s0 + 0 <= lim) ? accs[q].x : 0.f; accs[q].y = (s0 + 1 <= lim) ? accs[q].y : 0.f; accs[q].z = (s0 + 2 <= lim) ? accs[q].z : 0.f; accs[q].w = (s0 + 3 <= lim) ? accs[q].w : 0.f; }
            __syncthreads();
            LAS bf16* outp = NI + msel * 64 * RW_LD;
#pragma unroll
            for (int q = 0; q < 8; ++q) { const int tile = (wave & 1) * 8 + q, mt = tile >> 2, nt = tile & 3;
                *(LAS unsigned long long*)(outp + (nt * 16 + cc) * RW_LD + mt * 16 + 4 * g) = pack4(accs[q]); }
        }
        __syncthreads();
        if (wave == 0) {
            const int blk = lane >> 4, col = lane & 15; float x[16];
#pragma unroll
            for (int tt = 0; tt < 16; ++tt) { float nr[16]; { float lo[8], hi[8]; unpack8(*(const LAS v4u*)(NI + (16 * blk + tt) * RW_LD + 16 * blk), lo); unpack8(*(const LAS v4u*)(NI + (16 * blk + tt) * RW_LD + 16 * blk + 8), hi);
#pragma unroll
                    for (int q = 0; q < 8; ++q) { nr[q] = lo[q]; nr[8 + q] = hi[q]; } }
                float a = (tt == col) ? 1.f : 0.f;
#pragma unroll
                for (int q = 0; q < tt; ++q) a += nr[q] * x[q];
                x[tt] = a; TI[(blk * 16 + tt) * 16 + col] = (bf16)f2bf(a); }
        } else {
            for (int tile = wave - 1; tile < 16; tile += 7) { const int mt = tile >> 2, nt = tile & 3;
                f32x4 acc = {0.f, 0.f, 0.f, 0.f}; acc = mm16(AAK + mt * 16 * RW_LD, RW_LD, VTc + nt * 16 * RW_LD, RW_LD, 64, acc, lane);
                *(LAS unsigned long long*)(XT + (64 + nt * 16 + cc) * RW_LD + mt * 16 + 4 * g) = pack4(acc); }
        }
        __syncthreads();
        {
            s16x4 xb[4];
#pragma unroll
            for (int i = 0; i < 4; ++i) {
                f32x4 acc; { const unsigned long long xr = *(const LAS unsigned long long*)(XT + (wave * 16 + cc) * RW_LD + 16 * i + 4 * g);
                    acc.x = bf2f((bf16)(xr & 0xffffu)); acc.y = bf2f((bf16)((xr >> 16) & 0xffffu)); acc.z = bf2f((bf16)((xr >> 32) & 0xffffu)); acc.w = bf2f((bf16)(xr >> 48)); }
#pragma unroll
                for (int k = 0; k < i; ++k) { const s16x4 a = *(const LAS s16x4*)(NI + (16 * i + cc) * RW_LD + 16 * k + 4 * g); acc = __builtin_amdgcn_mfma_f32_16x16x16bf16_1k(a, xb[k], acc, 0, 0, 0); }
                const s16x4 yb = cvt4(acc), ta = *(const LAS s16x4*)(TI + (i * 16 + cc) * 16 + 4 * g);
                const f32x4 xi = __builtin_amdgcn_mfma_f32_16x16x16bf16_1k(ta, yb, (f32x4){0.f, 0.f, 0.f, 0.f}, 0, 0, 0);
                xb[i] = cvt4(xi);
            }
            __syncthreads();
#pragma unroll
            for (int i = 0; i < 4; ++i) *(LAS s16x4*)(XB16 + (wave * 16 + cc) * RW_LD + 16 * i + 4 * g) = xb[i];
        }
        __syncthreads();
        {
            const int osel = wave >> 1; const size_t ob = (size_t)item * 4096;
#pragma unroll 1
            for (int q = 0; q < 8; ++q) { const int tile = (wave & 1) * 8 + q, mt = tile >> 2, nt = tile & 3; f32x4 acc = {0.f, 0.f, 0.f, 0.f};
                if (osel == 0) {
                    acc = mm16(XB16 + mt * 16 * RW_LD, RW_LD, BHc + nt * 16 * RW_LD, RW_LD, 64, acc, lane);
                    *(unsigned long long*)(PP + ob + (nt * 16 + cc) * 64 + mt * 16 + 4 * g) = pack4(acc);
                } else if (osel == 1) {
                    acc = mm16(BHc + mt * 16 * RW_LD, RW_LD, XB16 + (64 + nt * 16) * RW_LD, RW_LD, 64, acc, lane);
                    acc = mm16(KHc + mt * 16 * RW_LD, RW_LD, VTc + nt * 16 * RW_LD, RW_LD, 64, acc, lane);
                    *(unsigned long long*)(QQ + ob + (nt * 16 + cc) * 64 + mt * 16 + 4 * g) = pack4(acc);
                } else if (osel == 2) {
                    acc = mm16(XB16 + mt * 16 * RW_LD, RW_LD, ARB + nt * 16 * RW_LD, RW_LD, 64, acc, lane);
                    const unsigned long long rr = *(const LAS unsigned long long*)(RT + (nt * 16 + cc) * RW_LD + mt * 16 + 4 * g);
                    acc.x += bf2f((bf16)(rr & 0xffffu)); acc.y += bf2f((bf16)((rr >> 16) & 0xffffu)); acc.z += bf2f((bf16)((rr >> 32) & 0xffffu)); acc.w += bf2f((bf16)(rr >> 48));
                    *(unsigned long long*)(RH + ob + (nt * 16 + cc) * 64 + mt * 16 + 4 * g) = pack4(acc);
                } else {
                    acc = mm16(XB16 + (64 + mt * 16) * RW_LD, RW_LD, ARB + nt * 16 * RW_LD, RW_LD, 64, acc, lane);
                    acc = mm16(VTc + mt * 16 * RW_LD, RW_LD, ARK + nt * 16 * RW_LD, RW_LD, 64, acc, lane);
                    *(unsigned long long*)(YH + ob + (nt * 16 + cc) * 64 + mt * 16 + 4 * g) = pack4(acc);
                } }
        }
        __syncthreads();
      }
    }
}

constexpr int CH_R = 6, CH_SLOT = 9216 + 9216 + 256;
constexpr int CH_RING = 0, CH_SI = CH_R * CH_SLOT, CH_FLAGS = CH_SI + 4 * 2304;
static_assert(CH_FLAGS + 64 <= MISC_OFF, "chain LDS map");
struct ChainRegs { v4u p[8], q[8]; f32x4 gm; };
__device__ __forceinline__ void chain_fetch(ChainRegs& o, const bf16* PP, const bf16* QQ, const float* GAMC, int item, int lane) {
    const size_t ob = (size_t)item * 4096;
#pragma unroll
    for (int i = 0; i < 8; ++i) { o.p[i] = *(const v4u*)(PP + ob + (size_t)(i * 64 + lane) * 8); o.q[i] = *(const v4u*)(QQ + ob + (size_t)(i * 64 + lane) * 8); }
    o.gm = *(const f32x4*)(GAMC + (size_t)item * 64 + (lane & 15) * 4);
}
__device__ __forceinline__ void chain_commit(const ChainRegs& o, LAS unsigned char* L, int c, int lane) {
    volatile LAS unsigned* flags = (volatile LAS unsigned*)(L + CH_FLAGS);
    const int slot = c % CH_R;
    if (c >= CH_R) { const unsigned need = (unsigned)(c - CH_R + 1);
        for (;;) { const unsigned m0 = flags[CH_R + 0], m1 = flags[CH_R + 1], m2 = flags[CH_R + 2], m3 = flags[CH_R + 3];
            if (m0 >= need && m1 >= need && m2 >= need && m3 >= need) break; __builtin_amdgcn_s_sleep(1); } }
    asm volatile("" ::: "memory");
    LAS unsigned char* sl = L + CH_RING + slot * CH_SLOT;
#pragma unroll
    for (int i = 0; i < 8; ++i) { const int idx = i * 64 + lane, row = idx >> 3, c16 = idx & 7;
        *(LAS v4u*)(sl + row * 144 + c16 * 16) = o.p[i]; *(LAS v4u*)(sl + 9216 + row * 144 + c16 * 16) = o.q[i]; }
    if (lane < 16) *(LAS f32x4*)(sl + 18432 + lane * 16) = o.gm;
    asm volatile("s_waitcnt lgkmcnt(0)" ::: "memory");
    if (lane == 0) flags[slot] = (unsigned)(c + 1);
}
__device__ __forceinline__ void ph_rwkv_b(const Ctx& C, int bh  , const bf16* PP, const bf16* QQ, const float* GAMC, bf16* S0) {
    const int lane = C.lane, wave = C.wave, cc = lane & 15, g = lane >> 4, b = bh >> 3, h = bh & 7;
    LAS unsigned char* L = C.lds;
    volatile LAS unsigned* flags = (volatile LAS unsigned*)(L + CH_FLAGS);
    if (C.tid < 16) flags[C.tid] = 0u;
    __syncthreads();
    if (wave >= 4) {
        const int j = wave - 4;
        ChainRegs A, B;
        int lc = j;
        chain_fetch(A, PP, QQ, GAMC, (b * 128 + lc) * 8 + h, lane);
        for (;;) {
            if (lc + 4 < 128) chain_fetch(B, PP, QQ, GAMC, (b * 128 + lc + 4) * 8 + h, lane);
            chain_commit(A, L, lc, lane);
            lc += 4; if (lc >= 128) break;
            if (lc + 4 < 128) chain_fetch(A, PP, QQ, GAMC, (b * 128 + lc + 4) * 8 + h, lane);
            chain_commit(B, L, lc, lane);
            lc += 4; if (lc >= 128) break;
        }
    } else {
        const int vt = wave;
        LAS bf16* SI = (LAS bf16*)(L + CH_SI + vt * 2304);
        f32x4 st[4];
#pragma unroll
        for (int mt = 0; mt < 4; ++mt) st[mt] = (f32x4){0.f, 0.f, 0.f, 0.f};
        for (int c = 0; c < 128; ++c) {
            const int item = (b * 128 + c) * 8 + h, slot = c % CH_R; const size_t ob = (size_t)item * 4096;
#pragma unroll
            for (int mt = 0; mt < 4; ++mt) { const unsigned long long pk = pack4(st[mt]);
                *(unsigned long long*)(S0 + ob + (vt * 16 + cc) * 64 + mt * 16 + 4 * g) = pk; *(LAS unsigned long long*)(SI + cc * RW_LD + mt * 16 + 4 * g) = pk; }
            while (flags[slot] < (unsigned)(c + 1)) __builtin_amdgcn_s_sleep(1);
            asm volatile("s_waitcnt lgkmcnt(0)" ::: "memory");
            const LAS unsigned char* sl = L + CH_RING + slot * CH_SLOT;
            const LAS bf16* Pi = (const LAS bf16*)sl; const LAS bf16* Qi = (const LAS bf16*)(sl + 9216); const LAS float* Gi = (const LAS float*)(sl + 18432);
            const s16x8 b0 = *(const LAS s16x8*)(SI + cc * RW_LD + 8 * g), b1 = *(const LAS s16x8*)(SI + cc * RW_LD + 32 + 8 * g);
#pragma unroll
            for (int mt = 0; mt < 4; ++mt) {
                const f32x4 gm = *(const LAS f32x4*)(Gi + mt * 16 + 4 * g);
                const unsigned long long qq = *(const LAS unsigned long long*)(Qi + (vt * 16 + cc) * RW_LD + mt * 16 + 4 * g);
                const s16x8 a0 = *(const LAS s16x8*)(Pi + (mt * 16 + cc) * RW_LD + 8 * g), a1 = *(const LAS s16x8*)(Pi + (mt * 16 + cc) * RW_LD + 32 + 8 * g);
                f32x4 acc; acc.x = gm.x * st[mt].x + bf2f((bf16)(qq & 0xffffu)); acc.y = gm.y * st[mt].y + bf2f((bf16)((qq >> 16) & 0xffffu));
                acc.z = gm.z * st[mt].z + bf2f((bf16)((qq >> 32) & 0xffffu)); acc.w = gm.w * st[mt].w + bf2f((bf16)(qq >> 48));
                acc = __builtin_amdgcn_mfma_f32_16x16x32_bf16(a0, b0, acc, 0, 0, 0); acc = __builtin_amdgcn_mfma_f32_16x16x32_bf16(a1, b1, acc, 0, 0, 0);
                st[mt] = acc; }
            asm volatile("s_waitcnt lgkmcnt(0)" ::: "memory");
            if (lane == 0) flags[CH_R + vt] = (unsigned)(c + 1);
        }
    }
    __syncthreads();
}

__device__ __forceinline__ void ph_rwkv_c(const Ctx& C, const bf16* S0, const bf16* RH, const bf16* YH, const float* RK, const bf16* GG, const bf16* VF,
                                          const float* gn_g, const float* gn_b, bf16* O) {
    const int lane = C.lane, cc = lane & 15, g = lane >> 4;
    for (int item = C.bid * 8 + C.wave; item < 4096; item += C.nb * 8) {
        const int h = item & 7, c = (item >> 3) & 127, b = item >> 10; const size_t m0 = (size_t)b * T_ + c * 64, ob = (size_t)item * 4096;
        s16x8 af[4][2], bfr[4][2];
#pragma unroll
        for (int q = 0; q < 4; ++q)
#pragma unroll
            for (int k = 0; k < 2; ++k) { af[q][k] = *(const s16x8*)(S0 + ob + (q * 16 + cc) * 64 + k * 32 + 8 * g); bfr[q][k] = *(const s16x8*)(RH + ob + (q * 16 + cc) * 64 + k * 32 + 8 * g); }
#pragma unroll
        for (int nt = 0; nt < 4; ++nt) {
            const size_t m = m0 + nt * 16 + cc;
            f32x4 y[4]; float s1 = 0.f;
#pragma unroll
            for (int mt = 0; mt < 4; ++mt) { const unsigned long long yh = *(const unsigned long long*)(YH + ob + (nt * 16 + cc) * 64 + mt * 16 + 4 * g);
                f32x4 acc; acc.x = bf2f((bf16)(yh & 0xffffu)); acc.y = bf2f((bf16)((yh >> 16) & 0xffffu)); acc.z = bf2f((bf16)((yh >> 32) & 0xffffu)); acc.w = bf2f((bf16)(yh >> 48));
                acc = __builtin_amdgcn_mfma_f32_16x16x32_bf16(af[mt][0], bfr[nt][0], acc, 0, 0, 0); acc = __builtin_amdgcn_mfma_f32_16x16x32_bf16(af[mt][1], bfr[nt][1], acc, 0, 0, 0);
                y[mt] = acc; s1 += (acc.x + acc.y) + (acc.z + acc.w); }
            s1 += __shfl_xor(s1, 16); s1 += __shfl_xor(s1, 32);
            const float mean = s1 * (1.f / 64.f); float s2 = 0.f;
#pragma unroll
            for (int mt = 0; mt < 4; ++mt) { y[mt] = y[mt] - mean; s2 += (y[mt].x * y[mt].x + y[mt].y * y[mt].y) + (y[mt].z * y[mt].z + y[mt].w * y[mt].w); }
            s2 += __shfl_xor(s2, 16); s2 += __shfl_xor(s2, 32);
            const float rstd = 1.f / sqrtf(s2 * (1.f / 64.f) + 64e-5f), rk = RK[m * 8 + h];
#pragma unroll
            for (int mt = 0; mt < 4; ++mt) { const int v = h * 64 + mt * 16 + 4 * g;
                const f32x4 gg4 = *(const f32x4*)(gn_g + v), gb4 = *(const f32x4*)(gn_b + v);
                const unsigned long long vx = *(const unsigned long long*)(VF + m * 512 + v), gx = *(const unsigned long long*)(GG + m * 512 + v);
                f32x4 o;
                o.x = (y[mt].x * rstd * gg4.x + gb4.x + rk * bf2f((bf16)(vx & 0xffffu))) * bf2f((bf16)(gx & 0xffffu));
                o.y = (y[mt].y * rstd * gg4.y + gb4.y + rk * bf2f((bf16)((vx >> 16) & 0xffffu))) * bf2f((bf16)((gx >> 16) & 0xffffu));
                o.z = (y[mt].z * rstd * gg4.z + gb4.z + rk * bf2f((bf16)((vx >> 32) & 0xffffu))) * bf2f((bf16)((gx >> 32) & 0xffffu));
                o.w = (y[mt].w * rstd * gg4.w + gb4.w + rk * bf2f((bf16)(vx >> 48))) * bf2f((bf16)(gx >> 48));
                *(unsigned long long*)(O + m * D_ + 512 + v) = pack4(o); }
        }
    }
}

__device__ __forceinline__ void ph_convfix(const Ctx& C, const float* HALO, const float* FIXU, const float* cw, const float* cb, bf16* ACT) {
    for (int idx = C.bid * NT + C.tid; idx < 128 * 22 * 2 * 128; idx += C.nb * NT) {
        const int j = idx & 127, rr = (idx >> 7) & 1, tile = idx >> 8, pm = tile / 22, pn = tile % 22;
        const bool seq0 = (pm & 31) == 0;
        const float* fx = FIXU + (size_t)tile * 512; const float* hl = HALO + (size_t)(tile - 22) * 512;
        const float u0g = fx[rr * 256 + j], u0v = fx[rr * 256 + 128 + j];
        float u1g, u1v, u2g, u2v;
        if (rr == 0) { u1g = seq0 ? 0.f : hl[256 + j]; u1v = seq0 ? 0.f : hl[256 + 128 + j]; u2g = seq0 ? 0.f : hl[j]; u2v = seq0 ? 0.f : hl[128 + j]; }
        else { u1g = fx[j]; u1v = fx[128 + j]; u2g = seq0 ? 0.f : hl[256 + j]; u2v = seq0 ? 0.f : hl[256 + 128 + j]; }
        const int jg = pn * 128 + j, jv = DFF + jg;
        const float gc = cb[jg] + cw[jg] * u2g + cw[NUP + jg] * u1g + cw[2 * NUP + jg] * u0g, vc = cb[jv] + cw[jv] * u2v + cw[NUP + jv] * u1v + cw[2 * NUP + jv] * u0v;
        ACT[(size_t)(pm * 256 + rr) * DFF + jg] = (bf16)f2bf(siluf_(gc) * vc);
    }
}
}

namespace pg8 {
struct EpiRes {
    static constexpr bool PERM = false, AFTER_DRAIN = false;
    const float* base; float* out; const float* gate; int gstride;
    __device__ __forceinline__ void operator()(const f32x4 (&acc)[2][2][4][2], const Unit& u, int wr, int wc, int fr, int fq) const {
        const int b = (u.pm * BM) / 8192; const float* gp = gate + (size_t)b * gstride;
        const int col0 = u.pn * BM + wc * 32 + 4 * fq;
#pragma unroll
        for (int ai = 0; ai < 2; ++ai)
#pragma unroll
            for (int m = 0; m < 4; ++m) { const size_t off = (size_t)(u.pm * BM + ai * HALF + wr * 64 + m * 16 + fr) * 1024 + col0;
#pragma unroll
                for (int bj = 0; bj < 2; ++bj)
#pragma unroll
                    for (int n = 0; n < 2; ++n) { const int cc = bj * HALF + n * 16; const f32x4 gv = *(const f32x4*)(gp + col0 + cc); const f32x4 bs = *(const f32x4*)(base + off + cc);
                        *(f32x4*)(out + off + cc) = bs + gv * acc[ai][bj][m][n]; } }
    }
};

struct EpiConv {
    static constexpr bool PERM = true, AFTER_DRAIN = false;
    bf16_t* ACT; const float* cw; const float* cb; float* HALO; float* FIXU; PG8_LAS float* EX; int nN;
    template <int CTRL> static __device__ __forceinline__ float rot(float x) { return __builtin_bit_cast(float, __builtin_amdgcn_update_dpp(0, __builtin_bit_cast(int, x), CTRL, 0xf, 0xf, false)); }
    template <int CTRL> static __device__ __forceinline__ f32x4 rot4(f32x4 x) { return (f32x4){rot<CTRL>(x.x), rot<CTRL>(x.y), rot<CTRL>(x.z), rot<CTRL>(x.w)}; }
    __device__ __forceinline__ void operator()(const f32x4 (&acc)[2][2][4][2], const Unit& u, int wr, int wc, int fr, int fq) const {
        const int colw = wc * 32 + 8 * fq, tile = u.pm * nN + u.pn;
        if (fr >= 14) {
#pragma unroll
            for (int ai = 0; ai < 2; ++ai)
#pragma unroll
                for (int bj = 0; bj < 2; ++bj)
#pragma unroll
                    for (int n = 0; n < 2; ++n) { *(PG8_LAS f32x4*)(EX + ((ai * 2 + wr) * 2 + (fr - 14)) * 256 + bj * 128 + colw + 4 * n) = acc[ai][bj][3][n];
                        if (ai == 1 && wr == 1) *(f32x4*)(HALO + ((size_t)tile * 2 + (fr - 14)) * 256 + bj * 128 + colw + 4 * n) = acc[1][bj][3][n]; }
        }
        if (fr < 2 && wr == 0) {
#pragma unroll
            for (int bj = 0; bj < 2; ++bj)
#pragma unroll
                for (int n = 0; n < 2; ++n) *(f32x4*)(FIXU + ((size_t)tile * 2 + fr) * 256 + bj * 128 + colw + 4 * n) = acc[0][bj][0][n];
        }
        asm volatile("s_waitcnt lgkmcnt(0)" ::: "memory"); __builtin_amdgcn_s_barrier(); asm volatile("" ::: "memory");
#pragma unroll
        for (int n = 0; n < 2; ++n) {
            const int jg = u.pn * 128 + colw + 4 * n, jv = 2816 + jg;
            f32x4 cw0[2], cw1[2], cw2[2], cbb[2];
            cw0[0] = *(const f32x4*)(cw + jg); cw1[0] = *(const f32x4*)(cw + 5632 + jg); cw2[0] = *(const f32x4*)(cw + 2 * 5632 + jg); cbb[0] = *(const f32x4*)(cb + jg);
            cw0[1] = *(const f32x4*)(cw + jv); cw1[1] = *(const f32x4*)(cw + 5632 + jv); cw2[1] = *(const f32x4*)(cw + 2 * 5632 + jv); cbb[1] = *(const f32x4*)(cb + jv);
#pragma unroll
            for (int ai = 0; ai < 2; ++ai)
#pragma unroll
                for (int m = 0; m < 4; ++m) {
                    const int src = ai * 2 + wr - 1;
                    f32x4 res[2];
#pragma unroll
                    for (int bj = 0; bj < 2; ++bj) {
                        const f32x4 x = acc[ai][bj][m][n];
                        f32x4 x1 = rot4<0x121>(x), x2 = rot4<0x122>(x);
                        if (m > 0) { const f32x4 q = acc[ai][bj][m > 0 ? m - 1 : 0][n]; const f32x4 q1 = rot4<0x121>(q), q2 = rot4<0x122>(q);
                            if (fr == 0) x1 = q1; if (fr < 2) x2 = q2; }
                        else if (fr < 2) { f32x4 e14 = {0.f, 0.f, 0.f, 0.f}, e15 = e14;
                            if (src >= 0) { e14 = *(const PG8_LAS f32x4*)(EX + (src * 2 + 0) * 256 + bj * 128 + colw + 4 * n); e15 = *(const PG8_LAS f32x4*)(EX + (src * 2 + 1) * 256 + bj * 128 + colw + 4 * n); }
                            if (fr == 0) { x1 = e15; x2 = e14; } else x2 = e15; }
                        const f32x4 w0 = cw0[bj], w1 = cw1[bj], w2 = cw2[bj], bb = cbb[bj];
                        res[bj] = bb + w0 * x2 + w1 * x1 + w2 * x;
                    }
                    const f32x4 gc = res[0], vc = res[1];
                    f32x4 o;
                    o.x = gc.x * __builtin_amdgcn_rcpf(1.f + __expf(-gc.x)) * vc.x; o.y = gc.y * __builtin_amdgcn_rcpf(1.f + __expf(-gc.y)) * vc.y;
                    o.z = gc.z * __builtin_amdgcn_rcpf(1.f + __expf(-gc.z)) * vc.z; o.w = gc.w * __builtin_amdgcn_rcpf(1.f + __expf(-gc.w)) * vc.w;
                    typedef unsigned u32x2 __attribute__((ext_vector_type(2)));
                    u32x2 w; w.x = cvt_pk_bf16(o.x, o.y); w.y = cvt_pk_bf16(o.z, o.w);
                    *(u32x2*)(ACT + (size_t)(u.pm * BM + ai * HALF + wr * 64 + m * 16 + fr) * 2816 + u.pn * 128 + colw + 4 * n) = w;
                }
        }
    }
};
}

namespace hy {
struct Args { const float* in[31]; float* out; unsigned char* ws; };
__global__ void __launch_bounds__(NT, 2) hy_fwd(Args A) {
    extern __shared__ __attribute__((aligned(16))) unsigned char lds_raw[];
    Ctx C; C.bid = blockIdx.x; C.nb = gridDim.x; C.tid = threadIdx.x; C.lane = C.tid & 63; C.wave = __builtin_amdgcn_readfirstlane(C.tid >> 6); C.lds = (LAS unsigned char*)lds_raw;
    volatile LAS unsigned* MISC = (volatile LAS unsigned*)(C.lds + MISC_OFF);
    for (int u = C.tid; u < (LDS_BYTES - MISC_OFF) / 4; u += NT) ((LAS unsigned*)(C.lds + MISC_OFF))[u] = 0u;
    __syncthreads();
    unsigned char* ws = A.ws;
    XcdBarrier bar = xcd_barrier_post((unsigned*)(ws + WS_CTL) + CW_BAR, MISC + 8);
#define PHASE_BEGIN() do { int t_ = threadIdx.x; asm volatile("" : "+v"(t_)); int b_ = blockIdx.x; asm volatile("" : "+s"(b_)); \
    C.tid = t_; C.lane = t_ & 63; C.wave = __builtin_amdgcn_readfirstlane(t_ >> 6); C.bid = b_; } while (0)
#ifdef HY_DIAG
    unsigned long long ts_last = __builtin_amdgcn_s_memrealtime(); float tacc[10] = {0.f, 0.f, 0.f, 0.f, 0.f, 0.f, 0.f, 0.f, 0.f, 0.f};
#define GRID_BAR(cat) do { xcd_barrier(bar); PHASE_BEGIN(); { const unsigned long long n_ = __builtin_amdgcn_s_memrealtime(); tacc[cat] += (float)(n_ - ts_last); ts_last = n_; } } while (0)
#else
#define GRID_BAR(cat) do { xcd_barrier(bar); PHASE_BEGIN(); } while (0)
#endif
#ifndef HY_REPCAT
#define HY_REPCAT (-1)
#endif
#define NREP(cat) ((HY_REPCAT == (cat)) ? 2 : 1)
    float* out = A.out;
#define in A.in
    float* MOD = (float*)(ws + WS_MOD);
    bf16 *WIN = (bf16*)(ws + WS_WIN), *WOUT = (bf16*)(ws + WS_WOUT), *WUP = (bf16*)(ws + WS_WUP), *WDN = (bf16*)(ws + WS_WDN);
    bf16 *XB = (bf16*)(ws + WS_XB), *O = (bf16*)(ws + WS_O), *VF = (bf16*)(ws + WS_VF), *PG = (bf16*)(ws + WS_PG), *PR = (bf16*)(ws + WS_PR), *VL = (bf16*)(ws + WS_VL);
    bf16 *RH = (bf16*)(ws + WS_RH), *YH = (bf16*)(ws + WS_YH), *PP = (bf16*)(ws + WS_PP), *QQ = (bf16*)(ws + WS_QQ), *GG = (bf16*)(ws + WS_GG), *S0 = (bf16*)(ws + WS_S0);
    float *GAMC = (float*)(ws + WS_GAMC), *RK = (float*)(ws + WS_RK);
    bf16* LORA = (bf16*)(ws + WS_LORA);
    bf16* DS = (bf16*)(ws + WS_GK); float* GAM = (float*)(ws + WS_GAM);
    bf16* ACT = (bf16*)(ws + WS_ACT); float *HALO = (float*)(ws + WS_U), *FIXU = (float*)(ws + WS_U + 8 * MiB);

    ph_mod(C, in[1], in[2], in[3], MOD);
    for (int l = 0; l < L_; ++l) {
        const float* modl = MOD + (size_t)l * 4 * 6144;
        const float* xres = l ? out : in[0];
        for (int r_ = 0; r_ < NREP(0); ++r_) {
        wprep_mat(C, in[5] + (size_t)l * D_ * IN_COLS, D_, IN_COLS, NIN, WIN, 1, l ? in[6] : nullptr);
        wprep_mat(C, in[24] + (size_t)l * D_ * D_, D_, D_, D_, WOUT, 0, nullptr);
        wprep_mat(C, in[26] + (size_t)l * D_ * NUP, D_, NUP, NUP, WUP, 2, nullptr);
        wprep_mat(C, in[29] + (size_t)l * DFF * D_, DFF, D_, D_, WDN, 0, nullptr);
        wprep_mat(C, in[12] + (size_t)l * 64 * 512, 64, 512, 512, LORA, 0, nullptr);
        wprep_mat(C, in[14] + (size_t)l * 64 * 512, 64, 512, 512, LORA + 512 * 64, 0, nullptr);
        wprep_mat(C, in[16] + (size_t)l * 128 * 512, 128, 512, 512, LORA + 2 * 512 * 64, 0, nullptr);
        if (l) wprep_mat(C, in[17], 32, 512, 512, LORA + 2 * 512 * 64 + 512 * 128, 0, nullptr);
        }
        GRID_BAR(0);
        for (int r_ = 0; r_ < NREP(1); ++r_) ph_norm(C, xres, in[4] + l * D_, modl + 0 * D_, modl + 1 * D_, XB);
        GRID_BAR(1);
        for (int r_ = 0; r_ < NREP(2); ++r_) { pg8::Gemm g{XB, WIN, M_, NIN, D_}; pg8::StaticOrder S; S.init(M_, NIN, C.nb, C.bid);
          pg8::EpiBf16<0> E{PG, NPG, nullptr, NPG, (WS_PR - WS_PG) / 2, 1.f};
          pg8::gemm_phase<pg8::EpiBf16<0>, pg8::StaticOrder, true, true>(C.lds, g, S, E); }
        GRID_BAR(2);
        for (int r_ = 0; r_ < NREP(3); ++r_) {
        ph_gla_a(C, PG, in[7] + l * 16 * 256, in[8] + l * 256, DS, GAM);
        { RwkvW W{in[10] + l * 1792, in[11], in[13] + l * 512, in[15] + l * 512, in[18], in[19] + l * 512, in[20] + l * 512, in[21] + l * 512,
                  LORA, LORA + 512 * 64, LORA + 2 * 512 * 64, LORA + 2 * 512 * 64 + 512 * 128};
          ph_rwkv_a(C, PR, PG, W, l, PP, QQ, RH, YH, GAMC, RK, GG, VF, r_ == NREP(3) - 1); } }
        GRID_BAR(3);
        if (C.bid < 32) { for (int r_ = 0; r_ < NREP(4); ++r_) ph_rwkv_b(C, C.bid, PP, QQ, GAMC, S0); }
        else { Ctx C2 = C; C2.bid = C.bid - 32; C2.nb = C.nb - 32; ph_gla_b(C2, DS, GAM); }
        GRID_BAR(4);
        for (int r_ = 0; r_ < NREP(5); ++r_) {
        ph_gla_c(C, PG, in[7] + l * 16 * 256, in[8] + l * 256, in[9] + l * 128, DS, O);
        ph_rwkv_c(C, S0, RH, YH, RK, GG, VF, in[22] + l * 512, in[23] + l * 512, O); }
        GRID_BAR(5);
        { pg8::Gemm g{O, WOUT, M_, D_, D_}; pg8::StaticOrder S; S.init(M_, D_, C.nb, C.bid);
          pg8::EpiRes E{xres, out, modl + 2 * D_, 6144};
          pg8::gemm_phase<pg8::EpiRes, pg8::StaticOrder, true, true>(C.lds, g, S, E); }
        GRID_BAR(6);
        for (int r_ = 0; r_ < NREP(1); ++r_) ph_norm(C, out, in[25] + l * D_, modl + 3 * D_, modl + 4 * D_, XB);
        GRID_BAR(1);
        for (int r_ = 0; r_ < NREP(7); ++r_) { pg8::Gemm g{XB, WUP, M_, NUP, D_}; pg8::StaticOrder S; S.init(M_, NUP, C.nb, C.bid);
          pg8::EpiConv E{ACT, in[27] + (size_t)l * 3 * NUP, in[28] + (size_t)l * NUP, HALO, FIXU, (PG8_LAS float*)(C.lds + RING_BYTES), NUP / 256};
          pg8::gemm_phase<pg8::EpiConv, pg8::StaticOrder, true, true>(C.lds, g, S, E); }
        GRID_BAR(7);
        for (int r_ = 0; r_ < NREP(8); ++r_) ph_convfix(C, HALO, FIXU, in[27] + (size_t)l * 3 * NUP, in[28] + (size_t)l * NUP, ACT);
        GRID_BAR(8);
        { pg8::Gemm g{ACT, WDN, M_, D_, DFF}; pg8::StaticOrder S; S.init(M_, D_, C.nb, C.bid);
          pg8::EpiRes E{out, out, modl + 5 * D_, 6144};
          pg8::gemm_phase<pg8::EpiRes, pg8::StaticOrder, true, true>(C.lds, g, S, E); }
        GRID_BAR(9);
    }
    ph_final(C, out, in[30]);
#ifdef HY_DIAG
    GRID_BAR(1);
    if (C.bid == 0) { if (C.tid == 0) out[0] = tacc[HY_DIAG_A] * 0.1f; for (int i = 1 + C.tid; i <= 10000; i += NT) out[i] = tacc[HY_DIAG_B] * 0.01f; }
#endif
#undef GRID_BAR
#undef PHASE_BEGIN
#undef in
}
}

extern "C" void kernel_launch(void* const* d_in, const int* in_sizes, int n_in, void* d_out, int out_size, void* d_ws, size_t ws_size, hipStream_t stream) {
    using namespace hy;
    static int grid = 0;
    if (grid == 0) {
        if (n_in != 31 || in_sizes[0] != M_ * D_ || out_size != M_ * D_ || ws_size < WS_END) { fprintf(stderr, "kernel_launch: unexpected shapes (n_in %d, in0 %d, out %d, ws %zu)\n", n_in, n_in > 0 ? in_sizes[0] : -1, out_size, ws_size); grid = -1; return; }
        if (hipFuncSetAttribute((const void*)hy_fwd, hipFuncAttributeMaxDynamicSharedMemorySize, LDS_BYTES) != hipSuccess) { fprintf(stderr, "kernel_launch: hipFuncSetAttribute failed\n"); grid = -1; return; }
        int dev = 0, cus = 0, per_cu = 0;
        (void)hipGetDevice(&dev); (void)hipDeviceGetAttribute(&cus, hipDeviceAttributeMultiprocessorCount, dev);
        (void)hipOccupancyMaxActiveBlocksPerMultiprocessor(&per_cu, (const void*)hy_fwd, NT, LDS_BYTES);
        if (per_cu < 1) fprintf(stderr, "kernel_launch: occupancy query reports %d blocks per CU\n", per_cu);
        (void)hipGetLastError();
        grid = cus > 0 ? cus : 256;
    }
    if (grid < 0) return;
    (void)hipMemsetAsync((char*)d_ws + WS_CTL, 0, CTL_ZERO_BYTES, stream);
    Args a{};
    for (int i = 0; i < 31; ++i) a.in[i] = (const float*)d_in[i];
    a.out = (float*)d_out; a.ws = (unsigned char*)d_ws;
    hipLaunchKernelGGL(hy_fwd, dim3(grid), dim3(NT), LDS_BYTES, stream, a);
}
```

```cpp
#include <hip/hip_runtime.h>
#include <cstdio>
#include <cstdint>
namespace pg8 {
#define PG8_LAS __attribute__((address_space(3)))
typedef unsigned short bf16_t;
typedef short bf16x8 __attribute__((ext_vector_type(8)));
typedef float f32x4 __attribute__((ext_vector_type(4)));
typedef unsigned u32x4 __attribute__((ext_vector_type(4)));
constexpr int BM = 256, BK = 64, HALF = 128, HTB = HALF * BK * 2  , STAGE_BYTES = 8 * HTB, NXCD = 8, WGM = 8;

__host__ __device__ __forceinline__ int lds_byte(int r, int c) { const int st = (r >> 4) * 2 + (c >> 5), rr = r & 15, cc = c & 31, ob = rr * 64 + cc * 2; return st * 1024 + (ob ^ (((ob >> 9) & 1) << 5)); }
__host__ __device__ __forceinline__ void stage_rc(int b, int& R, int& C) { const int st = b / 1024, sb = b % 1024, swz = sb ^ (((sb >> 9) & 1) << 5); R = (st >> 1) * 16 + swz / 64; C = (st & 1) * 32 + (swz % 64) / 2; }
__host__ __device__ __forceinline__ int perm32(int rho) { const int n = rho >> 4, i = rho & 15; return 8 * (i >> 2) + 4 * n + (i & 3); }

struct Unit { int pm, pn; };
struct Gemm { const bf16_t* A; const bf16_t* Bt; int M, N, K; size_t bstride; };

struct StaticOrder {
    int nM, nN, nwg, G, c;
    __host__ __device__ void init(int M, int N, int G_, int c_) { nM = M / BM; nN = N / BM; nwg = nM * nN; G = G_; c = c_; }
    __host__ __device__ bool next(int i, Unit& u) const {
        const long L = (long)i * G + c; if (L >= nwg) return false;
        int wgid = (int)L; { const int q = nwg / NXCD, r = nwg % NXCD, xcd = wgid % NXCD, off = wgid / NXCD; wgid = (xcd < r ? xcd * (q + 1) : r * (q + 1) + (xcd - r) * q) + off; }
        const int nig = WGM * nN, gid = wgid / nig, fm = gid * WGM, gsz = (nM - fm) < WGM ? (nM - fm) : WGM;
        u.pm = fm + ((wgid % nig) % gsz); u.pn = (wgid % nig) / gsz; return true;
    }
    __device__ __forceinline__ void a_ready(const Unit&) const {}
    __device__ __forceinline__ void done(const Unit&) const {}
};

__device__ __forceinline__ unsigned cvt_pk_bf16(float lo, float hi) { unsigned r; asm volatile("v_cvt_pk_bf16_f32 %0, %1, %2" : "=v"(r) : "v"(lo), "v"(hi)); return r; }
typedef float f32x2 __attribute__((ext_vector_type(2)));
__device__ __forceinline__ f32x2 gelu_pk(f32x2 v) {
    const f32x2 av = __builtin_elementwise_abs(v), d = av * 0.2316418882f + 1.0f;
    f32x2 t; t.x = __builtin_amdgcn_rcpf(d.x); t.y = __builtin_amdgcn_rcpf(d.y);
    f32x2 q = t * 0.5307027145f + (-0.7265760135f); q = q * t + 0.7107068705f; q = q * t + (-0.142248368f); q = q * t + 0.127414796f; q = q * t;
    const f32x2 s = (v * v) * (-0.72134752044f);
    f32x2 e; e.x = __builtin_amdgcn_exp2f(s.x); e.y = __builtin_amdgcn_exp2f(s.y);
    const f32x2 m = v * (q * e), r = v - m;
    f32x2 o; o.x = v.x < 0.f ? m.x : r.x; o.y = v.y < 0.f ? m.y : r.y; return o;
}

template <int ACT  > struct EpiBf16 {
    static constexpr bool PERM = true, AFTER_DRAIN = false; static_assert(ACT == 0 || ACT == 1, "EpiBf16: ACT is 0 (none) or 1 (gelu_pk)");
    bf16_t* O; int ldc; const float* bias; int split_cols; size_t split_stride; float scale0;
    __device__ __forceinline__ void operator()(const f32x4 (&acc)[2][2][4][2], const Unit& u, int wr, int wc, int fr, int fq) const {
        const int row0 = u.pm * BM + wr * 64 + fr; int colt = u.pn * BM; bf16_t* base = O;
        float sc = 1.f; if (split_cols) { const int t = colt / split_cols; base += (size_t)t * split_stride; colt -= t * split_cols; if (t == 0) sc = scale0; }
        const int col0 = colt + wc * 32 + 8 * fq, bcol0 = u.pn * BM + wc * 32 + 8 * fq;
        f32x4 bv[2][2];
#pragma unroll
        for (int bj = 0; bj < 2; ++bj)
#pragma unroll
            for (int n = 0; n < 2; ++n) bv[bj][n] = bias ? *(const f32x4*)(bias + bcol0 + bj * HALF + 4 * n) : (f32x4){0.f, 0.f, 0.f, 0.f};
#pragma unroll
        for (int ai = 0; ai < 2; ++ai)
#pragma unroll
            for (int m = 0; m < 4; ++m) { bf16_t* rowp = base + (size_t)(row0 + ai * HALF + m * 16) * ldc + col0;
#pragma unroll
                for (int bj = 0; bj < 2; ++bj) { f32x4 v0 = acc[ai][bj][m][0] + bv[bj][0], v1 = acc[ai][bj][m][1] + bv[bj][1];
                    if (ACT == 1) { f32x2 a = gelu_pk((f32x2){v0[0], v0[1]}), b = gelu_pk((f32x2){v0[2], v0[3]}), c = gelu_pk((f32x2){v1[0], v1[1]}), d = gelu_pk((f32x2){v1[2], v1[3]});
                        v0 = (f32x4){a.x, a.y, b.x, b.y}; v1 = (f32x4){c.x, c.y, d.x, d.y}; }
                    v0 = v0 * sc; v1 = v1 * sc; u32x4 w; w.x = cvt_pk_bf16(v0[0], v0[1]); w.y = cvt_pk_bf16(v0[2], v0[3]); w.z = cvt_pk_bf16(v1[0], v1[1]); w.w = cvt_pk_bf16(v1[2], v1[3]);
                    *(u32x4*)(rowp + bj * HALF) = w; } }
    }
};
template <class Epi, class Sched, bool ALIGN_EPI = false, bool SP2 = false>
__device__ __forceinline__ void gemm_phase(PG8_LAS unsigned char* lds, const Gemm g, const Sched& S, const Epi& E, int tid_in) {
    int tid_ = tid_in; asm volatile("" : "+v"(tid_));
    const int tid = tid_, wid = __builtin_amdgcn_readfirstlane(tid >> 6), lane = tid & 63, wr = wid >> 2, wc = wid & 3, fr = lane & 15, fq = lane >> 4;
    const int K = g.K, nt = K / BK;
    unsigned voffA[2], voffB[2];
#pragma unroll
    for (int i = 0; i < 2; ++i) { int R, C; stage_rc(tid * 16 + i * 8192, R, C); const int Rb = Epi::PERM ? ((R & ~31) + perm32(R & 31)) : R;
        voffA[i] = (unsigned)(R * K + C) * 2u; voffB[i] = (unsigned)(Rb * K + C) * 2u; }
    const size_t kstep = (size_t)(BK * 2);
    const size_t hstep = (size_t)HALF * K * 2;
    const size_t tstep = 2 * hstep;
    const unsigned ldsw = (unsigned)wid * 1024u;
    const int aoff = lds_byte(wr * 64 + fr, fq * 8), boff = lds_byte(wc * 32 + fr, fq * 8);
#define PG8_SA(b, h) (((b) * 2 + (h)) * HTB)
#define PG8_SB(b, h) ((4 + (b) * 2 + (h)) * HTB)
#define PG8_STAGE(bufoff, gbase, voff) do { _Pragma("unroll") for (int _i = 0; _i < 2; ++_i) \
        __builtin_amdgcn_global_load_lds((const unsigned*)((const char*)(gbase) + (voff)[_i]), (PG8_LAS unsigned*)(lds + (bufoff) + ldsw + _i * 8192), 16, 0, 0); } while (0)
#define PG8_LDA(dst, b, h) do { _Pragma("unroll") for (int m = 0; m < 4; ++m) _Pragma("unroll") for (int k = 0; k < 2; ++k) dst[m][k] = *(const PG8_LAS bf16x8*)(lds + PG8_SA(b, h) + aoff + m * 2048 + k * 1024); } while (0)
#define PG8_LDB(dst, b, h) do { _Pragma("unroll") for (int n = 0; n < 2; ++n) _Pragma("unroll") for (int k = 0; k < 2; ++k) dst[n][k] = *(const PG8_LAS bf16x8*)(lds + PG8_SB(b, h) + boff + n * 2048 + k * 1024); } while (0)
#define PG8_MMA(ai, bj, At, Bt) do { __builtin_amdgcn_s_setprio(1); _Pragma("unroll") for (int m = 0; m < 4; ++m) _Pragma("unroll") for (int n = 0; n < 2; ++n) _Pragma("unroll") for (int k = 0; k < 2; ++k) \
        acc[ai][bj][m][n] = __builtin_amdgcn_mfma_f32_16x16x32_bf16(Bt[n][k], At[m][k], acc[ai][bj][m][n], 0, 0, 0); __builtin_amdgcn_s_setprio(0); } while (0)
#define PG8_WAIT_V(n) asm volatile("s_waitcnt vmcnt(" #n ")" ::: "memory")
#define PG8_WAIT_L(n) asm volatile("s_waitcnt lgkmcnt(" #n ")" ::: "memory")
#define PG8_BAR __builtin_amdgcn_s_barrier()
#define PG8_SCHED __builtin_amdgcn_sched_barrier(0)
    Unit cur, nxt; int ui = 0;
    if (!S.next(0, cur)) return;
    f32x4 acc[2][2][4][2];
#pragma unroll
    for (int a = 0; a < 2; ++a)
#pragma unroll
        for (int b = 0; b < 2; ++b)
#pragma unroll
            for (int m = 0; m < 4; ++m)
#pragma unroll
                for (int n = 0; n < 2; ++n) acc[a][b][m][n] = (f32x4){0.f, 0.f, 0.f, 0.f};
    bf16x8 At[4][2], B0[2][2], B1[2][2];
    const char* cA = (const char*)g.A + (size_t)cur.pm * tstep; const char* cB = (const char*)g.Bt + (size_t)cur.pn * tstep + (size_t)(cur.pm >> 5) * g.bstride;
    S.a_ready(cur);
    if constexpr (SP2) {
        PG8_STAGE(PG8_SB(0, 0), cB, voffB); PG8_STAGE(PG8_SB(0, 1), cB + hstep, voffB); PG8_STAGE(PG8_SA(0, 0), cA, voffA); PG8_STAGE(PG8_SA(0, 1), cA + hstep, voffA);
        if (wr == 1) PG8_BAR;
        PG8_WAIT_V(2); PG8_BAR;
        PG8_STAGE(PG8_SB(1, 0), cB + kstep, voffB); PG8_STAGE(PG8_SA(1, 0), cA + kstep, voffA); PG8_STAGE(PG8_SB(1, 1), cB + hstep + kstep, voffB);
        PG8_WAIT_V(6); PG8_BAR;
    } else {
        PG8_STAGE(PG8_SB(0, 0), cB, voffB); PG8_STAGE(PG8_SA(0, 0), cA, voffA); PG8_STAGE(PG8_SB(0, 1), cB + hstep, voffB); PG8_STAGE(PG8_SA(0, 1), cA + hstep, voffA);
        if (wr == 1) PG8_BAR;
        PG8_WAIT_V(4); PG8_BAR;
        PG8_STAGE(PG8_SB(1, 0), cB + kstep, voffB); PG8_STAGE(PG8_SA(1, 0), cA + kstep, voffA); PG8_STAGE(PG8_SB(1, 1), cB + hstep + kstep, voffB);
        PG8_WAIT_V(6); PG8_BAR;
    }
    for (;;) {
        const bool has_next = S.next(ui + 1, nxt);
        const char* nA = has_next ? (const char*)g.A + (size_t)nxt.pm * tstep : cA; const char* nB = has_next ? (const char*)g.Bt + (size_t)nxt.pn * tstep + (size_t)(nxt.pm >> 5) * g.bstride : cB;
        for (int t = 0; t < nt; t += 2) {
            const bool last = (t == nt - 2);
            const char* a1 = cA + (size_t)(t + 1) * kstep;
            const char* a2 = last ? nA : cA + (size_t)(t + 2) * kstep; const char* b2 = last ? nB : cB + (size_t)(t + 2) * kstep;
            const char* a3 = a2 + kstep; const char* b3 = b2 + kstep;
            if (last && has_next) S.a_ready(nxt);
            if constexpr (SP2) {
            PG8_LDB(B0, 0, 0); PG8_LDB(B1, 0, 1); PG8_SCHED; PG8_LDA(At, 0, 0); PG8_STAGE(PG8_SA(1, 1), a1 + hstep, voffA);
            PG8_WAIT_V(8); PG8_WAIT_L(0); PG8_BAR; PG8_MMA(0, 0, At, B0); PG8_MMA(0, 1, At, B1); PG8_BAR; PG8_SCHED;
            PG8_LDA(At, 0, 1); PG8_STAGE(PG8_SB(0, 0), b2, voffB); PG8_STAGE(PG8_SB(0, 1), b2 + hstep, voffB); PG8_STAGE(PG8_SA(0, 0), a2, voffA);
            PG8_WAIT_V(8); PG8_WAIT_L(0); PG8_BAR; PG8_MMA(1, 0, At, B0); PG8_MMA(1, 1, At, B1); PG8_BAR; PG8_SCHED;
            PG8_LDB(B0, 1, 0); PG8_LDB(B1, 1, 1); PG8_SCHED; PG8_LDA(At, 1, 0); PG8_STAGE(PG8_SA(0, 1), a2 + hstep, voffA);
            PG8_WAIT_V(8); PG8_WAIT_L(0); PG8_BAR; PG8_MMA(0, 0, At, B0); PG8_MMA(0, 1, At, B1); PG8_BAR; PG8_SCHED;
            PG8_LDA(At, 1, 1); PG8_STAGE(PG8_SB(1, 0), b3, voffB); PG8_STAGE(PG8_SB(1, 1), b3 + hstep, voffB); PG8_STAGE(PG8_SA(1, 0), a3, voffA);
            PG8_WAIT_V(8); PG8_WAIT_L(0); PG8_BAR; PG8_MMA(1, 0, At, B0); PG8_MMA(1, 1, At, B1); PG8_BAR; PG8_SCHED;
            } else {
            PG8_LDB(B0, 0, 0); PG8_SCHED; PG8_LDA(At, 0, 0); PG8_STAGE(PG8_SA(1, 1), a1 + hstep, voffA);
            PG8_WAIT_L(8); PG8_BAR; PG8_WAIT_L(0); PG8_MMA(0, 0, At, B0); PG8_BAR; PG8_SCHED;
            PG8_LDB(B1, 0, 1); PG8_STAGE(PG8_SB(0, 0), b2, voffB);
            PG8_BAR; PG8_WAIT_L(0); PG8_MMA(0, 1, At, B1); PG8_BAR;
            PG8_LDA(At, 0, 1); PG8_STAGE(PG8_SA(0, 0), a2, voffA);
            PG8_BAR; PG8_WAIT_L(0); PG8_MMA(1, 0, At, B0); PG8_BAR; PG8_SCHED;
            PG8_STAGE(PG8_SB(0, 1), b2 + hstep, voffB);
            PG8_WAIT_V(6); PG8_BAR; PG8_MMA(1, 1, At, B1); PG8_BAR;
            PG8_LDB(B0, 1, 0); PG8_SCHED; PG8_LDA(At, 1, 0); PG8_STAGE(PG8_SA(0, 1), a2 + hstep, voffA);
            PG8_WAIT_L(8); PG8_BAR; PG8_WAIT_L(0); PG8_MMA(0, 0, At, B0); PG8_BAR; PG8_SCHED;
            PG8_LDB(B1, 1, 1); PG8_STAGE(PG8_SB(1, 0), b3, voffB);
            PG8_BAR; PG8_WAIT_L(0); PG8_MMA(0, 1, At, B1); PG8_BAR;
            PG8_LDA(At, 1, 1); PG8_STAGE(PG8_SA(1, 0), a3, voffA);
            PG8_BAR; PG8_WAIT_L(0); PG8_MMA(1, 0, At, B0); PG8_BAR; PG8_SCHED;
            PG8_STAGE(PG8_SB(1, 1), b3 + hstep, voffB);
            PG8_WAIT_V(6); PG8_BAR; PG8_MMA(1, 1, At, B1); PG8_BAR;
            }
        }
        if constexpr (ALIGN_EPI) { if (wr == 0) PG8_BAR; }
        if constexpr (!Epi::AFTER_DRAIN) { E(acc, cur, wr, wc, fr, fq); S.done(cur); }
        if (!has_next) break;
#pragma unroll
        for (int a = 0; a < 2; ++a)
#pragma unroll
            for (int b = 0; b < 2; ++b)
#pragma unroll
                for (int m = 0; m < 4; ++m)
#pragma unroll
                    for (int n = 0; n < 2; ++n) acc[a][b][m][n] = (f32x4){0.f, 0.f, 0.f, 0.f};
        cur = nxt; cA = nA; cB = nB; ++ui;
        if constexpr (ALIGN_EPI) { if (wr == 1) PG8_BAR; }
    }
    PG8_WAIT_V(0);
    if constexpr (!ALIGN_EPI) { if (wr == 0) PG8_BAR; }
    PG8_BAR;
    if constexpr (Epi::AFTER_DRAIN) { E.fused(acc, cur, wr, wc, fr, fq, lds, wid, lane); S.done(cur); }
#undef PG8_SA
#undef PG8_SB
#undef PG8_STAGE
#undef PG8_LDA
#undef PG8_LDB
#undef PG8_MMA
#undef PG8_WAIT_V
#undef PG8_WAIT_L
#undef PG8_BAR
#undef PG8_SCHED
}
}

namespace hy {
#define GAS __attribute__((address_space(1)))
#define LAS __attribute__((address_space(3)))
typedef unsigned short bf16;
typedef unsigned v4u __attribute__((ext_vector_type(4)));
typedef float f32x4 __attribute__((ext_vector_type(4)));
typedef short bf16x8 __attribute__((ext_vector_type(8)));
typedef GAS unsigned gu32;
typedef GAS unsigned long long gu64;
#define RLX_AGENT __ATOMIC_RELAXED, __HIP_MEMORY_SCOPE_AGENT
#define LDS_WAIT() asm volatile("s_waitcnt lgkmcnt(0)" ::: "memory")
#define VM_WAIT() asm volatile("s_waitcnt vmcnt(0)" ::: "memory")
__device__ __forceinline__ unsigned long long rt() { return __builtin_amdgcn_s_memrealtime(); }
typedef __bf16 hwbf2 __attribute__((ext_vector_type(2))); typedef float hwf2 __attribute__((ext_vector_type(2)));
__device__ __forceinline__ unsigned f2bf(float f) { return (unsigned)__builtin_bit_cast(unsigned short, (__bf16)f); }
__device__ __forceinline__ unsigned pk2(float lo, float hi) { const hwf2 v = {lo, hi}; return __builtin_bit_cast(unsigned, __builtin_convertvector(v, hwbf2)); }
#define XB_TMO      128
#define XB_XCNT(j)  (256  + 64 * (j))
#define XB_XSUB(j)  (1280 + 64 * (j))
#define XB_XGEN(j)  (2304 + 64 * (j))
#define XB_TOP      3328
#define XB_TOPGEN   3392
#define XCD_BAR_WORDS 3456
#define XB_SPIN_CAP (1u << 18)

__device__ __forceinline__ unsigned xb_ld(unsigned* p)              { return __hip_atomic_load(p, __ATOMIC_RELAXED, __HIP_MEMORY_SCOPE_AGENT); }
__device__ __forceinline__ unsigned xb_add(unsigned* p, unsigned v) { return __hip_atomic_fetch_add(p, v, __ATOMIC_RELAXED, __HIP_MEMORY_SCOPE_AGENT); }
__device__ __forceinline__ unsigned xb_xcc_id() { return (unsigned)__builtin_amdgcn_s_getreg((3 << 11) | 20) & 0xFu; }
#define XB_SPIN(cond, bar) do { unsigned _sp = 0; while (cond) { __builtin_amdgcn_s_sleep(1); \
    if ((++_sp & 255u) == 0u) { if (xb_ld(&(bar)[XB_TMO])) break; if (_sp > XB_SPIN_CAP) { atomicAdd(&(bar)[XB_TMO], 1u); break; } } } } while (0)

struct XcdBarrier {
    unsigned* bar; unsigned x;
    volatile LAS unsigned* st;
};

__device__ __forceinline__ XcdBarrier xcd_barrier_post(unsigned* bar, volatile LAS unsigned* st) {
    XcdBarrier b; b.bar = bar; b.x = xb_xcc_id(); b.st = st;
    if (threadIdx.x == 0) (void)xb_add(&bar[XB_XCNT(b.x)], 1u);
    return b;
}
__device__ __forceinline__ void xcd_barrier_complete(unsigned* bar, unsigned x, unsigned& nloc, unsigned& nx) {
    const unsigned G = gridDim.x * gridDim.y * gridDim.z;
    unsigned sum, cnt, mine, sp = 0u;
    for (;;) {
        sum = 0u; cnt = 0u; mine = 0u;
#pragma unroll
        for (unsigned j = 0; j < 16; ++j) { const unsigned c = xb_ld(&bar[XB_XCNT(j)]); sum += c; cnt += (c > 0u) ? 1u : 0u; mine = (j == x) ? c : mine; }
        if (sum == G) break;
        __builtin_amdgcn_s_sleep(1);
        if ((++sp & 255u) == 0u) { if (xb_ld(&bar[XB_TMO])) break; if (sp > XB_SPIN_CAP) { atomicAdd(&bar[XB_TMO], 1u); break; } }
    }
    nloc = mine > 0u ? mine : 1u; nx = cnt > 0u ? cnt : 1u;
}

__device__ __forceinline__ void xcd_barrier(const XcdBarrier& b, bool leader  ) {
    asm volatile("s_waitcnt vmcnt(0)" ::: "memory");
    __syncthreads();
    if (leader) {
        unsigned* bar = b.bar;
        __builtin_amdgcn_s_waitcnt(0);
        unsigned nloc = b.st[0], nx = b.st[1];
        if (nloc == 0u) { xcd_barrier_complete(bar, b.x, nloc, nx); b.st[0] = nloc; b.st[1] = nx; }
        const unsigned old = xb_add(&bar[XB_XSUB(b.x)], 1u);
        const unsigned gen = old / nloc;
        if (old + 1u == (gen + 1u) * nloc) {
            __builtin_amdgcn_fence(__ATOMIC_RELEASE, "agent");
            asm volatile("s_waitcnt vmcnt(0)" ::: "memory");
            const unsigned og = xb_add(&bar[XB_TOP], 1u);
            const unsigned tg = og / nx;
            if (og + 1u == (tg + 1u) * nx) xb_add(&bar[XB_TOPGEN], 1u);
            else XB_SPIN(xb_ld(&bar[XB_TOPGEN]) == tg, bar);
            __builtin_amdgcn_fence(__ATOMIC_ACQUIRE, "agent");
            xb_add(&bar[XB_XGEN(b.x)], 1u);
            asm volatile("s_waitcnt vmcnt(0)" ::: "memory");
        } else {
            XB_SPIN(xb_ld(&bar[XB_XGEN(b.x)]) == gen, bar);
            __builtin_amdgcn_fence(__ATOMIC_ACQUIRE, "agent");
            asm volatile("s_waitcnt vmcnt(0)" ::: "memory");
        }
    }
    __syncthreads();
}

constexpr int B_ = 4, T_ = 8192, D_ = 1024, M_ = B_ * T_, L_ = 2;
constexpr int NIN = 3584, NPG = 1792, NPR = 1792;
constexpr int DFF = 2816, NUP = 5632, IN_COLS = 3344;
constexpr size_t MiB = 1u << 20;
constexpr size_t WS_CTL = 0, CTL_ZERO_BYTES = 65536;
constexpr int CW_BAR = 4096;
constexpr size_t WS_RK = MiB / 4;
constexpr size_t WS_MOD = 3 * MiB / 2;
constexpr size_t WS_BIN = 5 * MiB / 4, WS_BUP = 5 * MiB / 4 + 65536;
constexpr size_t WS_SSQ = 29 * MiB;
constexpr size_t WS_WINF = 96 * MiB, WS_WUPF = 400 * MiB;
constexpr size_t WS_WIN = 2 * MiB, WS_WOUT = 9 * MiB, WS_WUP = 11 * MiB, WS_WDN = 22 * MiB, WS_LORA = 55 * MiB / 2, WS_GAMC = 28 * MiB, WS_VL = 29 * MiB;
constexpr size_t WS_GAM = 31 * MiB;
constexpr size_t WS_XB = 32 * MiB, WS_O = 96 * MiB, WS_VF = 160 * MiB, WS_GK = 192 * MiB, WS_PG = 224 * MiB, WS_PR = 336 * MiB, WS_END = 512 * MiB;
constexpr size_t WS_RH = WS_XB, WS_YH = WS_XB + 32 * MiB, WS_PP = WS_O, WS_QQ = WS_O + 32 * MiB, WS_GG = 448 * MiB, WS_S0 = 480 * MiB;
constexpr size_t WS_ACT = 224 * MiB, WS_U = 400 * MiB;
constexpr int RING_BYTES = 131072, MISC_OFF = 161792, LDS_BYTES = 163840;
constexpr int NT = 512;

__device__ __forceinline__ float bf2f(bf16 h) { return __builtin_bit_cast(float, (unsigned)h << 16); }
__device__ __forceinline__ float sigmoidf_(float x) { return 1.f / (1.f + __expf(-x)); }
__device__ __forceinline__ float siluf_(float x) { return x / (1.f + __expf(-x)); }
__device__ __forceinline__ float softplusf_(float x) { return fmaxf(x, 0.f) + log1pf(__expf(-fabsf(x))); }

typedef unsigned u32x2 __attribute__((ext_vector_type(2)));
template <int CTRL> __device__ __forceinline__ float dpp_f(float v) {
    return __builtin_bit_cast(float, __builtin_amdgcn_update_dpp(0, __builtin_bit_cast(int, v), CTRL, 0xf, 0xf, false));
}
__device__ __forceinline__ float wave_sum(float v) {
    v += dpp_f<0xB1>(v);
    v += dpp_f<0x4E>(v);
    v += dpp_f<0x141>(v);
    v += dpp_f<0x140>(v);
    v += __builtin_bit_cast(float, __builtin_amdgcn_update_dpp(0, __builtin_bit_cast(int, v), 0x142, 0xa, 0xf, false));
    v += __builtin_bit_cast(float, __builtin_amdgcn_update_dpp(0, __builtin_bit_cast(int, v), 0x143, 0xc, 0xf, false));
    return __builtin_bit_cast(float, __builtin_amdgcn_readlane(__builtin_bit_cast(int, v), 63));
}

__device__ __forceinline__ int lane_now() { int l; asm volatile("v_mbcnt_lo_u32_b32 %0, -1, 0\n\tv_mbcnt_hi_u32_b32 %0, -1, %0" : "=v"(l)); return l; }
__device__ __forceinline__ float xsum4(float v) {
    const int l = lane_now();
    v += __builtin_bit_cast(float, __builtin_amdgcn_ds_bpermute((l ^ 16) << 2, __builtin_bit_cast(int, v)));
    v += __builtin_bit_cast(float, __builtin_amdgcn_ds_bpermute((l ^ 32) << 2, __builtin_bit_cast(int, v)));
    return v;
}
struct Ctx { int bid, nb, tid, lane, wave; LAS unsigned char* lds; };

__device__ __forceinline__ void ph_mod(const Ctx& C, const float* c, const float* ada_w, const float* ada_b, float* MOD) {
    LAS float* sc = (LAS float*)C.lds;
    LAS float* red = (LAS float*)(C.lds + 16384);
    for (int i = C.tid; i < 4096; i += NT) sc[i] = siluf_(c[i]);
    __syncthreads();
    for (int item = C.bid; item < 192; item += C.nb) {
        const int l = item / 96, j0 = (item % 96) * 64;
        const float* W = ada_w + (size_t)l * 1024 * 6144 + j0 + C.lane;
        float a0 = 0.f, a1 = 0.f, a2 = 0.f, a3 = 0.f;
        for (int k = C.wave * 128; k < C.wave * 128 + 128; ++k) { const float wv = W[(size_t)k * 6144]; a0 += sc[k] * wv; a1 += sc[1024 + k] * wv; a2 += sc[2048 + k] * wv; a3 += sc[3072 + k] * wv; }
        red[(C.wave * 4 + 0) * 64 + C.lane] = a0; red[(C.wave * 4 + 1) * 64 + C.lane] = a1; red[(C.wave * 4 + 2) * 64 + C.lane] = a2; red[(C.wave * 4 + 3) * 64 + C.lane] = a3;
        __syncthreads();
        if (C.wave < 4) { const int b = C.wave; float s = ada_b[l * 6144 + j0 + C.lane];
#pragma unroll
            for (int w = 0; w < 8; ++w) s += red[(w * 4 + b) * 64 + C.lane];
            MOD[((size_t)l * 4 + b) * 6144 + j0 + C.lane] = s; }
        __syncthreads();
    }
}

__device__ __forceinline__ void wprep_mat(const Ctx& C, const float* W, int K, int Nsrc, int Ndst, bf16* Wt, int mode, const float* vres) {
    const int half = C.tid >> 8, t = C.tid & 255, tx = t & 31, ty = t >> 5;
    LAS float* tile = (LAS float*)C.lds + half * (32 * 33);
    const int nbn = Ndst / 32, ntile = nbn * (K / 32);
    const int niter = (ntile + 2 * C.nb - 1) / (2 * C.nb);
    for (int it = 0; it < niter; ++it) {
        const int item = (it * C.nb + C.bid) * 2 + half;
        const bool act = item < ntile;
        const int n0 = (item % nbn) * 32, k0 = (item / nbn) * 32, n = n0 + tx;
        if (act) {
#pragma unroll
            for (int i = 0; i < 4; ++i) { const int k = k0 + ty + 8 * i; float v = 0.f;
                if (mode == 0) v = W[(size_t)k * Nsrc + n];
                else if (mode == 2) { const int tl = n >> 8, w = n & 255; v = W[(size_t)k * Nsrc + (w < 128 ? tl * 128 + w : 2816 + tl * 128 + (w - 128))]; }
                else { if (n < 1552) v = W[(size_t)k * Nsrc + n]; else if (n < 1584) v = vres ? vres[(size_t)k * 32 + (n - 1552)] : 0.f; else if (n < 1792) v = 0.f; else v = W[(size_t)k * Nsrc + (n - 240)]; }
                tile[(ty + 8 * i) * 33 + tx] = v; }
        }
        __syncthreads();
        if (act) {
#pragma unroll
            for (int i = 0; i < 4; ++i) { const int nn = n0 + ty + 8 * i; Wt[(size_t)nn * K + k0 + tx] = (bf16)f2bf(tile[tx * 33 + ty + 8 * i]); }
        }
        __syncthreads();
    }
}

__device__ __forceinline__ int fold_src_col(int n, int mode) {
    if (mode == 1) { if (n < 1552) return n; if (n < 1584) return -(n - 1552 + 2); if (n < 1792) return -1; return n - 240; }
    const int tl = n >> 8, w = n & 255; return w < 128 ? tl * 128 + w : 2816 + tl * 128 + (w - 128);
}
__device__ __forceinline__ void wprep_fold(const Ctx& C, const float* W, int Nsrc, int Ndst, int mode, const float* vres, const float* g, const float* sc  , bf16* Wt) {
    LAS float* tile = (LAS float*)C.lds;
    const int nbn = Ndst / 64, ntile = nbn * 16;
    for (int item = C.bid; item < ntile; item += C.nb) {
        const int n0 = (item % nbn) * 64, k0 = (item / nbn) * 64;
        { const int kk = C.tid >> 3, nq = (C.tid & 7) * 8;
#pragma unroll
          for (int q = 0; q < 8; ++q) { const int sc_ = fold_src_col(n0 + nq + q, mode); float v = 0.f;
              if (sc_ >= 0) v = W[(size_t)(k0 + kk) * Nsrc + sc_]; else if (sc_ <= -2 && vres) v = vres[(size_t)(k0 + kk) * 32 + (-sc_ - 2)];
              tile[kk * 65 + nq + q] = v; } }
        __syncthreads();
        { const int nn = C.tid >> 3, kq = (C.tid & 7) * 8; float w[8], gk[8];
#pragma unroll
          for (int q = 0; q < 8; ++q) { w[q] = tile[(kq + q) * 65 + nn]; gk[q] = g[k0 + kq + q]; }
#pragma unroll
          for (int b = 0; b < 4; ++b) { float o[8];
#pragma unroll
              for (int q = 0; q < 8; ++q) o[q] = w[q] * gk[q] * (1.f + sc[b * 6144 + k0 + kq + q]);
              *(v4u*)(Wt + ((size_t)b * Ndst + n0 + nn) * 1024 + k0 + kq) = (v4u){pk2(o[0], o[1]), pk2(o[2], o[3]), pk2(o[4], o[5]), pk2(o[6], o[7])}; } }
        __syncthreads();
    }
}
__device__ __forceinline__ void fold_bias(const Ctx& C, const float* W, int Nsrc, int Ndst, int mode, const float* vres, const float* sh  , float* bias) {
    LAS float* red = (LAS float*)C.lds;
    LAS float* shl = (LAS float*)(C.lds + 8192);
    if (C.bid >= Ndst / 64) return;
    for (int i = C.tid; i < 4096; i += NT) shl[i] = sh[(i >> 10) * 6144 + (i & 1023)];
    __syncthreads();
    for (int item = C.bid; item < Ndst / 64; item += C.nb) {
        const int n = item * 64 + C.lane, sc_ = fold_src_col(n, mode);
        float a0 = 0.f, a1 = 0.f, a2 = 0.f, a3 = 0.f;
        if (sc_ >= 0 || (sc_ <= -2 && vres)) {
            const float* p = sc_ >= 0 ? W + sc_ : vres + (-sc_ - 2); const int st = sc_ >= 0 ? Nsrc : 32;
            for (int k0 = C.wave * 128; k0 < C.wave * 128 + 128; k0 += 8) { float wv[8];
#pragma unroll
                for (int q = 0; q < 8; ++q) wv[q] = p[(size_t)(k0 + q) * st];
#pragma unroll
                for (int q = 0; q < 8; ++q) { a0 += shl[k0 + q] * wv[q]; a1 += shl[1024 + k0 + q] * wv[q]; a2 += shl[2048 + k0 + q] * wv[q]; a3 += shl[3072 + k0 + q] * wv[q]; } } }
        red[(C.wave * 4 + 0) * 64 + C.lane] = a0; red[(C.wave * 4 + 1) * 64 + C.lane] = a1; red[(C.wave * 4 + 2) * 64 + C.lane] = a2; red[(C.wave * 4 + 3) * 64 + C.lane] = a3;
        __syncthreads();
        if (C.wave < 4) { float s = 0.f;
#pragma unroll
            for (int w = 0; w < 8; ++w) s += red[(w * 4 + C.wave) * 64 + C.lane];
            bias[(size_t)C.wave * Ndst + n] = s; }
        __syncthreads();
    }
}
__device__ __forceinline__ void ph_xcast(const Ctx& C, const float* x, bf16* XB, float* SSQ) {
    const int gw = C.bid * 8 + C.wave, NGW = C.nb * 8, lane = C.lane;
    for (int m = gw; m < M_; m += NGW) {
        const f32x4* xr = (const f32x4*)(x + (size_t)m * D_) + lane;
        f32x4 v[4]; float s = 0.f;
#pragma unroll
        for (int j = 0; j < 4; ++j) { v[j] = xr[64 * j]; s += (v[j].x * v[j].x + v[j].y * v[j].y) + (v[j].z * v[j].z + v[j].w * v[j].w); }
        s = wave_sum(s);
        unsigned long long* o8 = (unsigned long long*)(XB + (size_t)m * D_) + lane;
#pragma unroll
        for (int j = 0; j < 4; ++j) o8[64 * j] = (unsigned long long)pk2(v[j].x, v[j].y) | ((unsigned long long)pk2(v[j].z, v[j].w) << 32);
        if (lane < 16) SSQ[(size_t)m * 16 + lane] = lane == 0 ? s : 0.f;
    }
}

__device__ __forceinline__ void ph_norm(const Ctx& C, const float* x, const float* g, const float* sh, const float* sc, bf16* XB) {
    const int gw = C.bid * 8 + C.wave, NGW = C.nb * 8, lane = C.lane;
    for (int m = gw; m < M_; m += NGW) {
        const int b = m / T_;
        const f32x4* xr = (const f32x4*)(x + (size_t)m * D_) + lane;
        f32x4 v[4]; float s = 0.f;
#pragma unroll
        for (int j = 0; j < 4; ++j) { v[j] = xr[64 * j]; s += (v[j].x * v[j].x + v[j].y * v[j].y) + (v[j].z * v[j].z + v[j].w * v[j].w); }
        const float rstd = 1.f / sqrtf(wave_sum(s) * (1.f / D_) + 1e-6f);
        unsigned long long* o8 = (unsigned long long*)(XB + (size_t)m * D_) + lane;
#pragma unroll
        for (int j = 0; j < 4; ++j) { const int col = 4 * lane + 256 * j;
            const f32x4 gv = *(const f32x4*)(g + col), shv = *(const f32x4*)(sh + b * 6144 + col), scv = *(const f32x4*)(sc + b * 6144 + col);
            const f32x4 h = v[j] * rstd * gv * (scv + 1.f) + shv;
            o8[64 * j] = (unsigned long long)pk2(h.x, h.y) | ((unsigned long long)pk2(h.z, h.w) << 32); }
    }
}
__device__ __forceinline__ void ph_final(const Ctx& C, float* x, const float* g) {
    const int gw = C.bid * 8 + C.wave, NGW = C.nb * 8, lane = C.lane;
    for (int m = gw; m < M_; m += NGW) {
        f32x4* xr = (f32x4*)(x + (size_t)m * D_) + lane;
        f32x4 v[4]; float s = 0.f;
#pragma unroll
        for (int j = 0; j < 4; ++j) { v[j] = xr[64 * j]; s += (v[j].x * v[j].x + v[j].y * v[j].y) + (v[j].z * v[j].z + v[j].w * v[j].w); }
        const float rstd = 1.f / sqrtf(wave_sum(s) * (1.f / D_) + 1e-6f);
#pragma unroll
        for (int j = 0; j < 4; ++j) { const f32x4 gv = *(const f32x4*)(g + 4 * lane + 256 * j); xr[64 * j] = v[j] * rstd * gv; }
    }
}


typedef short s16x8 __attribute__((ext_vector_type(8)));
__device__ __forceinline__ f32x4 mm16(const LAS bf16* A, int lda, const LAS bf16* B, int ldb, int K, f32x4 acc, int lane) {
    const int r = lane & 15, g = lane >> 4;
    const LAS bf16* ap = A + r * lda + 8 * g; const LAS bf16* bp = B + r * ldb + 8 * g;
    for (int k0 = 0; k0 < K; k0 += 32) { const s16x8 a = *(const LAS s16x8*)(ap + k0); const s16x8 b = *(const LAS s16x8*)(bp + k0); acc = __builtin_amdgcn_mfma_f32_16x16x32_bf16(a, b, acc, 0, 0, 0); }
    return acc;
}
__device__ __forceinline__ f32x4 mm16_ga(const bf16* A, int lda, const LAS bf16* B, int ldb, int K, f32x4 acc, int lane) {
    const int r = lane & 15, g = lane >> 4;
    const bf16* ap = A + r * lda + 8 * g; const LAS bf16* bp = B + r * ldb + 8 * g;
    for (int k0 = 0; k0 < K; k0 += 32) { const s16x8 a = *(const s16x8*)(ap + k0); const s16x8 b = *(const LAS s16x8*)(bp + k0); acc = __builtin_amdgcn_mfma_f32_16x16x32_bf16(a, b, acc, 0, 0, 0); }
    return acc;
}
__device__ __forceinline__ unsigned long long pack4(f32x4 v) { return (unsigned long long)pk2(v.x, v.y) | ((unsigned long long)pk2(v.z, v.w) << 32); }
__device__ __forceinline__ float logsigmoidf_(float x) { return fminf(x, 0.f) - __logf(1.f + __expf(-fabsf(x))); }

constexpr int GL_LD = 72;
constexpr int GL_GK = 0;
constexpr int GL_SEG = 16384;
constexpr int GL_Z = 18432;
constexpr int GL_GUP = 20480;
constexpr int GL_I0 = 24832;
constexpr int GL_I1 = GL_I0 + 9216;
constexpr int GL_I2 = GL_I1 + 9216;
constexpr int GL_VT = GL_I2 + 9216;
constexpr int GL_SSQ = GL_VT + 18432;
static_assert(GL_SSQ + 512 <= RING_BYTES, "GLA LDS map");

struct GlaRaw { v4u z, k, q, v0, v1; float g0, g1, gb; };
__device__ __forceinline__ void gla_fetch(GlaRaw& R, const Ctx& C, const bf16* pg, const float* gk_up, const float* gk_b, int h, bool want_q) {
    const int tid = C.tid, j = tid >> 3, d0 = (tid & 7) * 8, e0 = (tid & 7) * 16;
    R.z = (v4u){0u, 0u, 0u, 0u}; R.q = R.z;
    if (tid < 128) R.z = *(const v4u*)(pg + (size_t)(tid >> 1) * NPG + 1536 + (tid & 1) * 8);
    R.g0 = gk_up[(tid >> 6) * 256 + h * 64 + (tid & 63)]; R.g1 = gk_up[((tid + NT) >> 6) * 256 + h * 64 + (tid & 63)]; R.gb = gk_b[h * 64 + (tid & 63)];
    R.k = *(const v4u*)(pg + (size_t)j * NPG + 256 + h * 64 + d0);
    if (want_q) R.q = *(const v4u*)(pg + (size_t)j * NPG + h * 64 + d0);
    R.v0 = *(const v4u*)(pg + (size_t)j * NPG + 512 + h * 128 + e0); R.v1 = *(const v4u*)(pg + (size_t)j * NPG + 512 + h * 128 + e0 + 8);
}
__device__ __forceinline__ void gla_gates(const Ctx& C, const GlaRaw& R) {
    LAS float* GK = (LAS float*)(C.lds + GL_GK); LAS float* SEG = (LAS float*)(C.lds + GL_SEG); LAS bf16* Z = (LAS bf16*)(C.lds + GL_Z); LAS float* GUP = (LAS float*)(C.lds + GL_GUP);
    const int tid = C.tid;
    if (tid < 128) { const int t = tid >> 1, hh = tid & 1; *(LAS v4u*)(Z + t * 16 + hh * 8) = R.z; }
    GUP[tid] = R.g0; GUP[tid + NT] = R.g1;
    if (tid < 64) GUP[1024 + tid] = R.gb;
    __syncthreads();
    { const int t = tid >> 3, d0 = (tid & 7) * 8; float a[8];
#pragma unroll
      for (int q = 0; q < 8; ++q) a[q] = GUP[1024 + d0 + q];
#pragma unroll
      for (int i = 0; i < 16; ++i) { const float zv = bf2f(Z[t * 16 + i]);
#pragma unroll
          for (int q = 0; q < 8; ++q) a[q] += zv * GUP[i * 64 + d0 + q]; }
#pragma unroll
      for (int q = 0; q < 8; ++q) GK[t * 64 + d0 + q] = logsigmoidf_(a[q]) * (1.f / 16.f); }
    __syncthreads();
    { const int d = tid & 63, seg = tid >> 6; float run = 0.f;
#pragma unroll
      for (int q = 0; q < 8; ++q) { run += GK[(seg * 8 + q) * 64 + d]; GK[(seg * 8 + q) * 64 + d] = run; }
      SEG[seg * 64 + d] = run; }
    __syncthreads();
    { const int d = tid & 63, seg = tid >> 6; float off = 0.f;
      for (int s = 0; s < seg; ++s) off += SEG[s * 64 + d];
#pragma unroll
      for (int q = 0; q < 8; ++q) GK[(seg * 8 + q) * 64 + d] += off; }
    __syncthreads();
}
__device__ __forceinline__ void gla_stage_vt(const Ctx& C, const GlaRaw& R) {
    LAS bf16* VT = (LAS bf16*)(C.lds + GL_VT);
    const int j = C.tid >> 3, e0 = (C.tid & 7) * 16;
    const unsigned w[8] = {R.v0.x, R.v0.y, R.v0.z, R.v0.w, R.v1.x, R.v1.y, R.v1.z, R.v1.w};
#pragma unroll
    for (int q = 0; q < 8; ++q) { VT[(e0 + 2 * q) * GL_LD + j] = (bf16)(w[q] & 0xffffu); VT[(e0 + 2 * q + 1) * GL_LD + j] = (bf16)(w[q] >> 16); }
}

__device__ __forceinline__ void ph_gla_a(const Ctx& C, const bf16* PG, const float* gk_up, const float* gk_b, bf16* DS, float* GAM) {
    LAS float* GK = (LAS float*)(C.lds + GL_GK); LAS bf16* KT = (LAS bf16*)(C.lds + GL_I0); LAS bf16* VT = (LAS bf16*)(C.lds + GL_VT);
    for (int item = C.bid; item < 2048; item += C.nb) {
        const int bh = item >> 7, c = item & 127, b = bh >> 2, h = bh & 3;
        const size_t m0 = (size_t)b * T_ + c * 64;
        const bf16* pg = PG + m0 * NPG;
        GlaRaw R; gla_fetch(R, C, pg, gk_up, gk_b, h, false);
        gla_gates(C, R);
        { const int j = C.tid >> 3, d0 = (C.tid & 7) * 8;
          const unsigned w[4] = {R.k.x, R.k.y, R.k.z, R.k.w};
#pragma unroll
          for (int q = 0; q < 4; ++q) { const float k0 = bf2f((bf16)(w[q] & 0xffffu)), k1 = bf2f((bf16)(w[q] >> 16));
              const int d = d0 + 2 * q;
              KT[d * GL_LD + j] = (bf16)f2bf(k0 * __expf(GK[63 * 64 + d] - GK[j * 64 + d]));
              KT[(d + 1) * GL_LD + j] = (bf16)f2bf(k1 * __expf(GK[63 * 64 + d + 1] - GK[j * 64 + d + 1])); } }
        gla_stage_vt(C, R);
        if (C.tid < 64) GAM[(size_t)item * 64 + C.tid] = __expf(GK[63 * 64 + C.tid]);
        __syncthreads();
        { const int n0 = C.wave * 16, lane = C.lane, cc = lane & 15, g = lane >> 4;
          bf16* out = DS + (size_t)item * 8192 + (size_t)(n0 + cc) * 64 + 4 * g;
#pragma unroll
          for (int mt = 0; mt < 4; ++mt) { f32x4 acc = {0.f, 0.f, 0.f, 0.f}; acc = mm16(KT + mt * 16 * GL_LD, GL_LD, VT + n0 * GL_LD, GL_LD, 64, acc, lane);
              *(unsigned long long*)(out + mt * 16) = pack4(acc); } }
        __syncthreads();
    }
}
__device__ __forceinline__ void ph_gla_b(const Ctx& C, bf16* DS, const float* GAM) {
    for (int idx = C.bid * NT + C.tid; idx < 16 * 8192; idx += C.nb * NT) {
        const int bh = idx >> 13, ed = idx & 8191, d = ed & 63;
        bf16* p = DS + (size_t)bh * 128 * 8192 + ed; const float* gp = GAM + (size_t)bh * 128 * 64 + d;
        float S = 0.f;
        for (int c0 = 0; c0 < 128; c0 += 8) {
            float ds[8], gm[8];
#pragma unroll
            for (int i = 0; i < 8; ++i) { ds[i] = bf2f(p[(size_t)(c0 + i) * 8192]); gm[i] = gp[(c0 + i) * 64]; }
#pragma unroll
            for (int i = 0; i < 8; ++i) { const float gs = gm[i] * S; p[(size_t)(c0 + i) * 8192] = (bf16)f2bf(gs); S = gs + ds[i]; }
        }
    }
}
__device__ __forceinline__ void ph_gla_c(const Ctx& C, const bf16* PG, const float* gk_up, const float* gk_b, const float* norm_g, const bf16* DS, bf16* O) {
    LAS float* GK = (LAS float*)(C.lds + GL_GK); LAS bf16* QP = (LAS bf16*)(C.lds + GL_I0); LAS bf16* KM = (LAS bf16*)(C.lds + GL_I1); LAS bf16* AI = (LAS bf16*)(C.lds + GL_I2);
    LAS bf16* VT = (LAS bf16*)(C.lds + GL_VT); LAS float* SSQ = (LAS float*)(C.lds + GL_SSQ);
    for (int item = C.bid; item < 2048; item += C.nb) {
        const int bh = item >> 7, c = item & 127, b = bh >> 2, h = bh & 3;
        const size_t m0 = (size_t)b * T_ + c * 64;
        const bf16* pg = PG + m0 * NPG;
        GlaRaw R; gla_fetch(R, C, pg, gk_up, gk_b, h, true);
        s16x8 sfrag[4][2];
        { const int lane = C.lane, cc = lane & 15, g = lane >> 4, eh = C.wave >> 2; const bf16* Sg = DS + (size_t)item * 8192;
#pragma unroll
          for (int mt = 0; mt < 4; ++mt) { sfrag[mt][0] = *(const s16x8*)(Sg + (size_t)(eh * 64 + mt * 16 + cc) * 64 + 8 * g); sfrag[mt][1] = *(const s16x8*)(Sg + (size_t)(eh * 64 + mt * 16 + cc) * 64 + 32 + 8 * g); } }
        gla_gates(C, R);
        { const int j = C.tid >> 3, d0 = (C.tid & 7) * 8;
          const v4u qx = R.q, kx = R.k;
          const unsigned qw[4] = {qx.x, qx.y, qx.z, qx.w}, kw[4] = {kx.x, kx.y, kx.z, kx.w};
          unsigned qo[4], ko[4];
#pragma unroll
          for (int q = 0; q < 4; ++q) { const int d = d0 + 2 * q;
              const float e0 = GK[63 * 64 + d] - GK[j * 64 + d], e1 = GK[63 * 64 + d + 1] - GK[j * 64 + d + 1];
              const float q0 = 0.125f * bf2f((bf16)(qw[q] & 0xffffu)) * __expf(-e0), q1 = 0.125f * bf2f((bf16)(qw[q] >> 16)) * __expf(-e1);
              const float k0 = bf2f((bf16)(kw[q] & 0xffffu)) * __expf(e0), k1 = bf2f((bf16)(kw[q] >> 16)) * __expf(e1);
              qo[q] = pk2(q0, q1); ko[q] = pk2(k0, k1); }
          *(LAS v4u*)(QP + j * GL_LD + d0) = (v4u){qo[0], qo[1], qo[2], qo[3]}; *(LAS v4u*)(KM + j * GL_LD + d0) = (v4u){ko[0], ko[1], ko[2], ko[3]}; }
        gla_stage_vt(C, R);
        __syncthreads();
        { const int lane = C.lane, cc = lane & 15, g = lane >> 4, n0 = (C.wave >> 1) * 16;
#pragma unroll
          for (int q = 0; q < 2; ++q) { const int mt0 = ((C.wave & 1) * 2 + q) * 16; f32x4 acc = {0.f, 0.f, 0.f, 0.f};
              acc = mm16(KM + mt0 * GL_LD, GL_LD, QP + n0 * GL_LD, GL_LD, 64, acc, lane);
              const int i = n0 + cc, j = mt0 + 4 * g;
              acc.x = (j + 0 <= i) ? acc.x : 0.f; acc.y = (j + 1 <= i) ? acc.y : 0.f; acc.z = (j + 2 <= i) ? acc.z : 0.f; acc.w = (j + 3 <= i) ? acc.w : 0.f;
              *(LAS unsigned long long*)(AI + (n0 + cc) * GL_LD + mt0 + 4 * g) = pack4(acc); } }
        __syncthreads();
        { const int lane = C.lane, cc = lane & 15, g = lane >> 4, n0 = (C.wave & 3) * 16, eh = C.wave >> 2;
          f32x4 acc[4]; float ss = 0.f;
#pragma unroll
          for (int mt = 0; mt < 4; ++mt) { const int e0 = eh * 64 + mt * 16; acc[mt] = (f32x4){0.f, 0.f, 0.f, 0.f};
              { const LAS bf16* bp = QP + (n0 + cc) * GL_LD + 8 * g;
                acc[mt] = __builtin_amdgcn_mfma_f32_16x16x32_bf16(sfrag[mt][0], *(const LAS s16x8*)bp, acc[mt], 0, 0, 0); acc[mt] = __builtin_amdgcn_mfma_f32_16x16x32_bf16(sfrag[mt][1], *(const LAS s16x8*)(bp + 32), acc[mt], 0, 0, 0); }
              acc[mt] = mm16(VT + e0 * GL_LD, GL_LD, AI + n0 * GL_LD, GL_LD, 64, acc[mt], lane);
              ss += (acc[mt].x * acc[mt].x + acc[mt].y * acc[mt].y) + (acc[mt].z * acc[mt].z + acc[mt].w * acc[mt].w); }
          ss = hy::xsum4(ss);
          if (g == 0) SSQ[eh * 64 + n0 + cc] = ss;
          __syncthreads();
          const float rstd = 1.f / sqrtf((SSQ[n0 + cc] + SSQ[64 + n0 + cc]) * (1.f / 128.f) + 1e-6f);
          const size_t m = m0 + n0 + cc;
#pragma unroll
          for (int mt = 0; mt < 4; ++mt) { const int e = eh * 64 + mt * 16 + 4 * g;
              const unsigned long long gx = *(const unsigned long long*)(pg + (size_t)(n0 + cc) * NPG + 1024 + h * 128 + e);
              const f32x4 ng = *(const f32x4*)(norm_g + e);
              f32x4 o;
              o.x = acc[mt].x * rstd * ng.x * siluf_(bf2f((bf16)(gx & 0xffffu)));
              o.y = acc[mt].y * rstd * ng.y * siluf_(bf2f((bf16)((gx >> 16) & 0xffffu)));
              o.z = acc[mt].z * rstd * ng.z * siluf_(bf2f((bf16)((gx >> 32) & 0xffffu)));
              o.w = acc[mt].w * rstd * ng.w * siluf_(bf2f((bf16)(gx >> 48)));
              *(unsigned long long*)(O + m * D_ + h * 128 + e) = pack4(o); } }
        __syncthreads();
    }
}


struct RwkvW { const float *mu, *mu_vres, *w0, *a0, *v0, *k_k, *k_a, *r_k; const bf16 *wupT, *aupT, *gupT, *vupT; };
constexpr int RW_LD = 72, RW_XLD = 296;
constexpr int RW_R0 = 0;
constexpr int RW_SEG = 16384;
constexpr int RW_R1 = 36864;
constexpr int RW_R2 = RW_R1 + 27648;
constexpr int RW_R3 = RW_R2 + 9216;
constexpr int RW_R4 = RW_R3 + 27648;
constexpr int RW_TI = RW_R4 + 128 * RW_LD * 2;
constexpr int RW_MU = RW_TI + 2048;
constexpr int RW_X = RW_MU + 2048;
constexpr int RW_END = RW_X + 64 * RW_XLD * 2;
static_assert(RW_END <= MISC_OFF, "RWKV LDS map");

typedef short s16x4 __attribute__((ext_vector_type(4)));
__device__ __forceinline__ float tanh_fast(float x) { const float e = __expf(2.f * x); return 1.f - 2.f / (e + 1.f); }
__device__ __forceinline__ float softplus_fast(float x) { return fmaxf(x, 0.f) + __logf(1.f + __expf(-fabsf(x))); }
__device__ __forceinline__ s16x4 cvt4(f32x4 v) { const unsigned long long p = pack4(v); return __builtin_bit_cast(s16x4, p); }
__device__ __forceinline__ void ld8f(const float* p, float (&o)[8]) { const f32x4 a = *(const f32x4*)p, b = *(const f32x4*)(p + 4); o[0] = a.x; o[1] = a.y; o[2] = a.z; o[3] = a.w; o[4] = b.x; o[5] = b.y; o[6] = b.z; o[7] = b.w; }
__device__ __forceinline__ float sum8(float v) { v += dpp_f<0xB1>(v); v += dpp_f<0x4E>(v); v += dpp_f<0x141>(v); return v; }
__device__ __forceinline__ void unpack8(const v4u x, float (&o)[8]) {
    o[0] = bf2f((bf16)(x.x & 0xffffu)); o[1] = bf2f((bf16)(x.x >> 16)); o[2] = bf2f((bf16)(x.y & 0xffffu)); o[3] = bf2f((bf16)(x.y >> 16));
    o[4] = bf2f((bf16)(x.z & 0xffffu)); o[5] = bf2f((bf16)(x.z >> 16)); o[6] = bf2f((bf16)(x.w & 0xffffu)); o[7] = bf2f((bf16)(x.w >> 16)); }
__device__ __forceinline__ v4u pack8(const float (&o)[8]) { return (v4u){pk2(o[0], o[1]), pk2(o[2], o[3]), pk2(o[4], o[5]), pk2(o[6], o[7])}; }
__device__ __forceinline__ f32x4 mm16_gb(const LAS bf16* A, int lda, const bf16* B, int ldb, int K, f32x4 acc, int lane) {
    const int r = lane & 15, g = lane >> 4;
    const LAS bf16* ap = A + r * lda + 8 * g; const bf16* bp = B + r * ldb + 8 * g;
    for (int k0 = 0; k0 < K; k0 += 32) { const s16x8 a = *(const LAS s16x8*)(ap + k0); const s16x8 b = *(const s16x8*)(bp + k0); acc = __builtin_amdgcn_mfma_f32_16x16x32_bf16(a, b, acc, 0, 0, 0); }
    return acc;
}

__device__ __forceinline__ void ph_rwkv_a(const Ctx& C, const bf16* PR, const bf16* VL  , const RwkvW& W, int layer,
                                          bf16* PP, bf16* QQ, bf16* RH, bf16* YH, float* GAMC, float* RK, bf16* GG, bf16* VF, bool store_v = true) {
    LAS unsigned char* L = C.lds;
    LAS bf16* X = (LAS bf16*)(L + RW_X); LAS float* CUM = (LAS float*)(L + RW_R0); LAS float* SEG = (LAS float*)(L + RW_SEG);
    LAS bf16* NI = (LAS bf16*)(L + RW_R0), *AAK = NI + 64 * RW_LD, *ARB = AAK + 64 * RW_LD, *ARK = ARB + 64 * RW_LD;
    LAS bf16* PRE = (LAS bf16*)(L + RW_R1);
    LAS bf16* AT = (LAS bf16*)(L + RW_R1), *BT = AT + 64 * RW_LD, *KT = BT + 64 * RW_LD, *RT = (LAS bf16*)(L + RW_R2);
    LAS bf16* XB16 = (LAS bf16*)(L + RW_R1);
    LAS bf16* BHc = (LAS bf16*)(L + RW_R3), *KHc = BHc + 64 * RW_LD, *VTc = KHc + 64 * RW_LD;
    LAS bf16* XT = (LAS bf16*)(L + RW_R4); LAS bf16* TI = (LAS bf16*)(L + RW_TI);
    const int wave = C.wave;
    LAS float* MU = (LAS float*)(L + RW_MU);
    for (int i = C.tid; i < 288; i += NT) MU[i] = i < 256 ? W.mu[1536 + i] : (layer ? W.mu_vres[i - 256] : 0.f);
    __syncthreads();
    for (int bc = C.bid; bc < 512; bc += C.nb) {
        const int c = bc & 127, b = bc >> 7;
        const size_t m0 = (size_t)b * T_ + c * 64;
        { const int tid = C.tid;
          v4u xc[5], xp[5];
#pragma unroll
          for (int it = 0; it < 5; ++it) { const int idx = tid + it * NT; xc[it] = (v4u){0u, 0u, 0u, 0u}; xp[it] = xc[it];
            if (idx < 64 * 36) { const int t1 = idx / 36, q = idx % 36, col = q * 8; const size_t m1 = m0 + t1; const bool first1 = (c == 0 && t1 == 0);
                if (q < 32) { xc[it] = *(const v4u*)(PR + m1 * NPR + 1536 + col); if (!first1) xp[it] = *(const v4u*)(PR + (m1 - 1) * NPR + 1536 + col); }
                else if (layer) { xc[it] = *(const v4u*)(VL + m1 * NPG + 1552 + (col - 256)); if (!first1) xp[it] = *(const v4u*)(VL + (m1 - 1) * NPG + 1552 + (col - 256)); } } }
#pragma unroll
          for (int it = 0; it < 5; ++it) { const int idx = tid + it * NT;
            if (idx < 64 * 36) { const int t1 = idx / 36, q = idx % 36, col = q * 8;
                float cv[8], pv[8], mu[8]; unpack8(xc[it], cv); unpack8(xp[it], pv);
                { const f32x4 ma = *(const LAS f32x4*)(MU + col), mb = *(const LAS f32x4*)(MU + col + 4); mu[0] = ma.x; mu[1] = ma.y; mu[2] = ma.z; mu[3] = ma.w; mu[4] = mb.x; mu[5] = mb.y; mu[6] = mb.z; mu[7] = mb.w; }
#pragma unroll
                for (int i = 0; i < 8; ++i) { float p = cv[i] + (pv[i] - cv[i]) * mu[i]; if (q < 8) p = tanh_fast(p); else if (q >= 16 && q < 32) p = sigmoidf_(p); cv[i] = p; }
                *(LAS v4u*)(X + t1 * RW_XLD + col) = pack8(cv); } }
        }
        __syncthreads();
#pragma unroll 1
      for (int h = 0; h < 8; ++h) {
        const int item = bc * 8 + h;
        int tid_ = C.tid; asm volatile("" : "+v"(tid_));
        const int tid = tid_, lane = tid & 63, cc = lane & 15, g = lane >> 4;
        const int t = tid >> 3, d0 = (tid & 7) * 8, ch = h * 64 + d0; const size_t m = m0 + t; const bool first = (c == 0 && t == 0);
        v4u rcx = *(const v4u*)(PR + m * NPR + ch), kcx = *(const v4u*)(PR + m * NPR + 512 + ch), vcx = *(const v4u*)(PR + m * NPR + 1024 + ch);
        v4u rpx = (v4u){0u, 0u, 0u, 0u}, kpx = rpx, vpx = rpx, vfx = rpx;
        if (!first) { rpx = *(const v4u*)(PR + (m - 1) * NPR + ch); kpx = *(const v4u*)(PR + (m - 1) * NPR + 512 + ch); vpx = *(const v4u*)(PR + (m - 1) * NPR + 1024 + ch); }
        if (layer) vfx = *(const v4u*)(VF + m * 512 + ch);
        {
            const int lsel = wave >> 1;
            const bf16* WT = lsel == 0 ? W.wupT : lsel == 1 ? W.aupT : lsel == 2 ? W.gupT : W.vupT;
            const int Kl = lsel == 2 ? 128 : lsel == 3 ? 32 : 64, xoff = lsel == 0 ? 0 : lsel == 1 ? 64 : lsel == 2 ? 128 : 256;
            LAS bf16* outp = PRE + lsel * 64 * RW_LD;
            const bool live = (lsel != 3 || layer);
#pragma unroll
            for (int mq = 0; mq < 2; ++mq) { const int mt = (wave & 1) * 2 + mq;
                s16x8 af[4];
                const bf16* ap = WT + (size_t)(h * 64 + mt * 16 + cc) * Kl + 8 * g;
#pragma unroll
                for (int ks = 0; ks < 4; ++ks) af[ks] = (live && ks * 32 < Kl) ? *(const s16x8*)(ap + ks * 32) : (s16x8){0, 0, 0, 0, 0, 0, 0, 0};
#pragma unroll
                for (int nt = 0; nt < 4; ++nt) { f32x4 acc = {0.f, 0.f, 0.f, 0.f};
                    const LAS bf16* bp = X + (nt * 16 + cc) * RW_XLD + xoff + 8 * g;
#pragma unroll
                    for (int ks = 0; ks < 4; ++ks) if (ks * 32 < Kl) { const s16x8 bb = *(const LAS s16x8*)(bp + ks * 32); acc = __builtin_amdgcn_mfma_f32_16x16x32_bf16(af[ks], bb, acc, 0, 0, 0); }
                    *(LAS unsigned long long*)(outp + (nt * 16 + cc) * RW_LD + mt * 16 + 4 * g) = pack4(acc); } }
        }
        __syncthreads();
        float av[8], bv[8], kv[8], rv[8], lw[8], vv[8];
        {
            float rc[8], rp[8], kc[8], kp[8], vc[8], vp[8], pw[8], pa[8], pg_[8], pvg[8];
            unpack8(rcx, rc); unpack8(kcx, kc); unpack8(vcx, vc); unpack8(rpx, rp); unpack8(kpx, kp); unpack8(vpx, vp);
            unpack8(*(const LAS v4u*)(PRE + (0 * 64 + t) * RW_LD + d0), pw); unpack8(*(const LAS v4u*)(PRE + (1 * 64 + t) * RW_LD + d0), pa);
            unpack8(*(const LAS v4u*)(PRE + (2 * 64 + t) * RW_LD + d0), pg_); unpack8(*(const LAS v4u*)(PRE + (3 * 64 + t) * RW_LD + d0), pvg);
            float vf[8]; unpack8(vfx, vf);
            float ssq = 0.f, rks = 0.f, asg[8], gg[8];
            float mur[8], muk[8], muv[8], w0c[8], a0c[8], v0c[8], kkc[8], kac[8], rkc[8];
            ld8f(W.mu + ch, mur); ld8f(W.mu + 512 + ch, muk); ld8f(W.mu + 1024 + ch, muv); ld8f(W.w0 + ch, w0c); ld8f(W.a0 + ch, a0c);
            ld8f(W.k_k + ch, kkc); ld8f(W.k_a + ch, kac); ld8f(W.r_k + ch, rkc);
            if (layer) ld8f(W.v0 + ch, v0c);
#pragma unroll
            for (int i = 0; i < 8; ++i) {
                const float r = rc[i] + (rp[i] - rc[i]) * mur[i], k = kc[i] + (kp[i] - kc[i]) * muk[i]; float v = vc[i] + (vp[i] - vc[i]) * muv[i];
                lw[i] = -0.6065306597f * sigmoidf_(w0c[i] + pw[i]);
                asg[i] = sigmoidf_(a0c[i] + pa[i]);
                if (layer) v = v + (vf[i] - v) * sigmoidf_(v0c[i] + pvg[i]);
                const float kk = k * kkc[i]; ssq += kk * kk;
                kv[i] = k * (1.f + (asg[i] - 1.f) * kac[i]); rv[i] = r; vv[i] = v; gg[i] = pg_[i]; av[i] = kk;
                rks += r * kv[i] * rkc[i];
            }
            ssq = sum8(ssq); rks = sum8(rks);
            const float inv = 1.f / sqrtf(fmaxf(ssq, 1e-24f));
#pragma unroll
            for (int i = 0; i < 8; ++i) { const float kk = av[i] * inv; av[i] = -kk; bv[i] = kk * asg[i]; }
            if ((tid & 7) == 0) RK[m * 8 + h] = rks;
            *(v4u*)(GG + m * 512 + ch) = pack8(gg);
            if (store_v) *(v4u*)(VF + m * 512 + ch) = pack8(vv);
#pragma unroll
            for (int i = 0; i < 8; ++i) vv[i] = bf2f((bf16)f2bf(vv[i]));
        }
        __syncthreads();
#pragma unroll
        for (int i = 0; i < 8; ++i) CUM[t * 64 + d0 + i] = lw[i];
        __syncthreads();
        { const int d = tid & 63, seg = tid >> 6; float run = 0.f;
#pragma unroll
          for (int q = 0; q < 8; ++q) { run += CUM[(seg * 8 + q) * 64 + d]; CUM[(seg * 8 + q) * 64 + d] = run; }
          SEG[seg * 64 + d] = run; }
        __syncthreads();
        { const int d = tid & 63, seg = tid >> 6; float off = 0.f;
          for (int s = 0; s < seg; ++s) off += SEG[s * 64 + d];
#pragma unroll
          for (int q = 0; q < 8; ++q) CUM[(seg * 8 + q) * 64 + d] += off; }
        __syncthreads();
        {
            float at[8], bt[8], kt[8], rt[8];
#pragma unroll
            for (int i = 0; i < 8; ++i) { const float cu = CUM[t * 64 + d0 + i], cC = CUM[63 * 64 + d0 + i], en = __expf(-cu), ec = __expf(cC - cu);
                at[i] = av[i] * __expf(cu - lw[i]); bt[i] = bv[i] * en; kt[i] = kv[i] * en; rt[i] = rv[i] * __expf(cu);
                BHc[(d0 + i) * RW_LD + t] = (bf16)f2bf(bv[i] * ec); KHc[(d0 + i) * RW_LD + t] = (bf16)f2bf(kv[i] * ec); VTc[(d0 + i) * RW_LD + t] = (bf16)f2bf(vv[i]);
                XT[(d0 + i) * RW_LD + t] = (bf16)f2bf(at[i]);
                if (t == 63) GAMC[(size_t)item * 64 + d0 + i] = __expf(cC); }
            *(LAS v4u*)(AT + t * RW_LD + d0) = pack8(at); *(LAS v4u*)(BT + t * RW_LD + d0) = pack8(bt); *(LAS v4u*)(KT + t * RW_LD + d0) = pack8(kt); *(LAS v4u*)(RT + t * RW_LD + d0) = pack8(rt);
        }
        __syncthreads();
        {
            const int msel = wave >> 1;
            const LAS bf16* As = (msel == 0 || msel == 2) ? BT : KT; const LAS bf16* Bs = (msel < 2) ? AT : RT;
            f32x4 accs[8];
#pragma unroll
            for (int q = 0; q < 8; ++q) { const int tile = (wave & 1) * 8 + q, mt = tile >> 2, nt = tile & 3; accs[q] = (f32x4){0.f, 0.f, 0.f, 0.f};
                accs[q] = mm16(As + mt * 16 * RW_LD, RW_LD, Bs + nt * 16 * RW_LD, RW_LD, 64, accs[q], lane);
                const int tt = nt * 16 + cc, s0 = mt * 16 + 4 * g, lim = (msel < 2) ? tt - 1 : tt;
                accs[q].x = (s0 + 0 <= lim) ? accs[q].x : 0.f; accs[q].y = (s0 + 1 <= lim) ? accs[q].y : 0.f; accs[q].z = (s0 + 2 <= lim) ? accs[q].z : 0.f; accs[q].w = (s0 + 3 <= lim) ? accs[q].w : 0.f; }
            __syncthreads();
            LAS bf16* outp = NI + msel * 64 * RW_LD;
#pragma unroll
            for (int q = 0; q < 8; ++q) { const int tile = (wave & 1) * 8 + q, mt = tile >> 2, nt = tile & 3;
                *(LAS unsigned long long*)(outp + (nt * 16 + cc) * RW_LD + mt * 16 + 4 * g) = pack4(accs[q]); }
        }
        __syncthreads();
        if (wave == 0) {
            const int blk = lane >> 4, col = lane & 15; float x[16];
#pragma unroll
            for (int tt = 0; tt < 16; ++tt) { float nr[16]; { float lo[8], hi[8]; unpack8(*(const LAS v4u*)(NI + (16 * blk + tt) * RW_LD + 16 * blk), lo); unpack8(*(const LAS v4u*)(NI + (16 * blk + tt) * RW_LD + 16 * blk + 8), hi);
#pragma unroll
                    for (int q = 0; q < 8; ++q) { nr[q] = lo[q]; nr[8 + q] = hi[q]; } }
                float a = (tt == col) ? 1.f : 0.f;
#pragma unroll
                for (int q = 0; q < tt; ++q) a += nr[q] * x[q];
                x[tt] = a; TI[(blk * 16 + tt) * 16 + col] = (bf16)f2bf(a); }
        } else {
            for (int tile = wave - 1; tile < 16; tile += 7) { const int mt = tile >> 2, nt = tile & 3;
                f32x4 acc = {0.f, 0.f, 0.f, 0.f}; acc = mm16(AAK + mt * 16 * RW_LD, RW_LD, VTc + nt * 16 * RW_LD, RW_LD, 64, acc, lane);
                *(LAS unsigned long long*)(XT + (64 + nt * 16 + cc) * RW_LD + mt * 16 + 4 * g) = pack4(acc); }
        }
        __syncthreads();
        {
            s16x4 xb[4];
#pragma unroll
            for (int i = 0; i < 4; ++i) {
                f32x4 acc; { const unsigned long long xr = *(const LAS unsigned long long*)(XT + (wave * 16 + cc) * RW_LD + 16 * i + 4 * g);
                    acc.x = bf2f((bf16)(xr & 0xffffu)); acc.y = bf2f((bf16)((xr >> 16) & 0xffffu)); acc.z = bf2f((bf16)((xr >> 32) & 0xffffu)); acc.w = bf2f((bf16)(xr >> 48)); }
#pragma unroll
                for (int k = 0; k < i; ++k) { const s16x4 a = *(const LAS s16x4*)(NI + (16 * i + cc) * RW_LD + 16 * k + 4 * g); acc = __builtin_amdgcn_mfma_f32_16x16x16bf16_1k(a, xb[k], acc, 0, 0, 0); }
                const s16x4 yb = cvt4(acc), ta = *(const LAS s16x4*)(TI + (i * 16 + cc) * 16 + 4 * g);
                const f32x4 xi = __builtin_amdgcn_mfma_f32_16x16x16bf16_1k(ta, yb, (f32x4){0.f, 0.f, 0.f, 0.f}, 0, 0, 0);
                xb[i] = cvt4(xi);
            }
            __syncthreads();
#pragma unroll
            for (int i = 0; i < 4; ++i) *(LAS s16x4*)(XB16 + (wave * 16 + cc) * RW_LD + 16 * i + 4 * g) = xb[i];
        }
        __syncthreads();
        {
            const int osel = wave >> 1; const size_t ob = (size_t)item * 4096;
#pragma unroll 1
            for (int q = 0; q < 8; ++q) { const int tile = (wave & 1) * 8 + q, mt = tile >> 2, nt = tile & 3; f32x4 acc = {0.f, 0.f, 0.f, 0.f};
                if (osel == 0) {
                    acc = mm16(XB16 + mt * 16 * RW_LD, RW_LD, BHc + nt * 16 * RW_LD, RW_LD, 64, acc, lane);
                    *(unsigned long long*)(PP + ob + (nt * 16 + cc) * 64 + mt * 16 + 4 * g) = pack4(acc);
                } else if (osel == 1) {
                    acc = mm16(BHc + mt * 16 * RW_LD, RW_LD, XB16 + (64 + nt * 16) * RW_LD, RW_LD, 64, acc, lane);
                    acc = mm16(KHc + mt * 16 * RW_LD, RW_LD, VTc + nt * 16 * RW_LD, RW_LD, 64, acc, lane);
                    *(unsigned long long*)(QQ + ob + (nt * 16 + cc) * 64 + mt * 16 + 4 * g) = pack4(acc);
                } else if (osel == 2) {
                    acc = mm16(XB16 + mt * 16 * RW_LD, RW_LD, ARB + nt * 16 * RW_LD, RW_LD, 64, acc, lane);
                    const unsigned long long rr = *(const LAS unsigned long long*)(RT + (nt * 16 + cc) * RW_LD + mt * 16 + 4 * g);
                    acc.x += bf2f((bf16)(rr & 0xffffu)); acc.y += bf2f((bf16)((rr >> 16) & 0xffffu)); acc.z += bf2f((bf16)((rr >> 32) & 0xffffu)); acc.w += bf2f((bf16)(rr >> 48));
                    *(unsigned long long*)(RH + ob + (nt * 16 + cc) * 64 + mt * 16 + 4 * g) = pack4(acc);
                } else {
                    acc = mm16(XB16 + (64 + mt * 16) * RW_LD, RW_LD, ARB + nt * 16 * RW_LD, RW_LD, 64, acc, lane);
                    acc = mm16(VTc + mt * 16 * RW_LD, RW_LD, ARK + nt * 16 * RW_LD, RW_LD, 64, acc, lane);
                    *(unsigned long long*)(YH + ob + (nt * 16 + cc) * 64 + mt * 16 + 4 * g) = pack4(acc);
                } }
        }
        __syncthreads();
      }
    }
}

constexpr int CH_R = 6, CH_SLOT = 9216 + 9216 + 256;
constexpr int CH_RING = 0, CH_SI = CH_R * CH_SLOT, CH_FLAGS = CH_SI + 4 * 2304;
static_assert(CH_FLAGS + 64 <= MISC_OFF, "chain LDS map");
struct ChainRegs { v4u p[8], q[8]; f32x4 gm; };
__device__ __forceinline__ void chain_fetch(ChainRegs& o, const bf16* PP, const bf16* QQ, const float* GAMC, int item, int lane) {
    const size_t ob = (size_t)item * 4096;
#pragma unroll
    for (int i = 0; i < 8; ++i) { o.p[i] = *(const v4u*)(PP + ob + (size_t)(i * 64 + lane) * 8); o.q[i] = *(const v4u*)(QQ + ob + (size_t)(i * 64 + lane) * 8); }
    o.gm = *(const f32x4*)(GAMC + (size_t)item * 64 + (lane & 15) * 4);
}
__device__ __forceinline__ void chain_commit(const ChainRegs& o, LAS unsigned char* L, int c, int lane) {
    volatile LAS unsigned* flags = (volatile LAS unsigned*)(L + CH_FLAGS);
    const int slot = c % CH_R;
    if (c >= CH_R) { const unsigned need = (unsigned)(c - CH_R + 1);
        for (;;) { const unsigned m0 = flags[CH_R + 0], m1 = flags[CH_R + 1], m2 = flags[CH_R + 2], m3 = flags[CH_R + 3];
            if (m0 >= need && m1 >= need && m2 >= need && m3 >= need) break; __builtin_amdgcn_s_sleep(1); } }
    asm volatile("" ::: "memory");
    LAS unsigned char* sl = L + CH_RING + slot * CH_SLOT;
#pragma unroll
    for (int i = 0; i < 8; ++i) { const int idx = i * 64 + lane, row = idx >> 3, c16 = idx & 7;
        *(LAS v4u*)(sl + row * 144 + c16 * 16) = o.p[i]; *(LAS v4u*)(sl + 9216 + row * 144 + c16 * 16) = o.q[i]; }
    if (lane < 16) *(LAS f32x4*)(sl + 18432 + lane * 16) = o.gm;
    asm volatile("s_waitcnt lgkmcnt(0)" ::: "memory");
    if (lane == 0) flags[slot] = (unsigned)(c + 1);
}
__device__ __forceinline__ void ph_rwkv_b(const Ctx& C, int bh  , const bf16* PP, const bf16* QQ, const float* GAMC, bf16* S0) {
    const int lane = C.lane, wave = C.wave, cc = lane & 15, g = lane >> 4, b = bh >> 3, h = bh & 7;
    LAS unsigned char* L = C.lds;
    volatile LAS unsigned* flags = (volatile LAS unsigned*)(L + CH_FLAGS);
    if (C.tid < 16) flags[C.tid] = 0u;
    __syncthreads();
    if (wave >= 4) {
        const int j = wave - 4;
        ChainRegs A, B;
        int lc = j;
        chain_fetch(A, PP, QQ, GAMC, (b * 128 + lc) * 8 + h, lane);
        for (;;) {
            if (lc + 4 < 128) chain_fetch(B, PP, QQ, GAMC, (b * 128 + lc + 4) * 8 + h, lane);
            chain_commit(A, L, lc, lane);
            lc += 4; if (lc >= 128) break;
            if (lc + 4 < 128) chain_fetch(A, PP, QQ, GAMC, (b * 128 + lc + 4) * 8 + h, lane);
            chain_commit(B, L, lc, lane);
            lc += 4; if (lc >= 128) break;
        }
    } else {
        const int vt = wave;
        LAS bf16* SI = (LAS bf16*)(L + CH_SI + vt * 2304);
        f32x4 st[4];
#pragma unroll
        for (int mt = 0; mt < 4; ++mt) st[mt] = (f32x4){0.f, 0.f, 0.f, 0.f};
        for (int c = 0; c < 128; ++c) {
            const int item = (b * 128 + c) * 8 + h, slot = c % CH_R; const size_t ob = (size_t)item * 4096;
#pragma unroll
            for (int mt = 0; mt < 4; ++mt) { const unsigned long long pk = pack4(st[mt]);
                *(unsigned long long*)(S0 + ob + (vt * 16 + cc) * 64 + mt * 16 + 4 * g) = pk; *(LAS unsigned long long*)(SI + cc * RW_LD + mt * 16 + 4 * g) = pk; }
            while (flags[slot] < (unsigned)(c + 1)) __builtin_amdgcn_s_sleep(1);
            asm volatile("s_waitcnt lgkmcnt(0)" ::: "memory");
            const LAS unsigned char* sl = L + CH_RING + slot * CH_SLOT;
            const LAS bf16* Pi = (const LAS bf16*)sl; const LAS bf16* Qi = (const LAS bf16*)(sl + 9216); const LAS float* Gi = (const LAS float*)(sl + 18432);
            const s16x8 b0 = *(const LAS s16x8*)(SI + cc * RW_LD + 8 * g), b1 = *(const LAS s16x8*)(SI + cc * RW_LD + 32 + 8 * g);
#pragma unroll
            for (int mt = 0; mt < 4; ++mt) {
                const f32x4 gm = *(const LAS f32x4*)(Gi + mt * 16 + 4 * g);
                const unsigned long long qq = *(const LAS unsigned long long*)(Qi + (vt * 16 + cc) * RW_LD + mt * 16 + 4 * g);
                const s16x8 a0 = *(const LAS s16x8*)(Pi + (mt * 16 + cc) * RW_LD + 8 * g), a1 = *(const LAS s16x8*)(Pi + (mt * 16 + cc) * RW_LD + 32 + 8 * g);
                f32x4 acc; acc.x = gm.x * st[mt].x + bf2f((bf16)(qq & 0xffffu)); acc.y = gm.y * st[mt].y + bf2f((bf16)((qq >> 16) & 0xffffu));
                acc.z = gm.z * st[mt].z + bf2f((bf16)((qq >> 32) & 0xffffu)); acc.w = gm.w * st[mt].w + bf2f((bf16)(qq >> 48));
                acc = __builtin_amdgcn_mfma_f32_16x16x32_bf16(a0, b0, acc, 0, 0, 0); acc = __builtin_amdgcn_mfma_f32_16x16x32_bf16(a1, b1, acc, 0, 0, 0);
                st[mt] = acc; }
            asm volatile("s_waitcnt lgkmcnt(0)" ::: "memory");
            if (lane == 0) flags[CH_R + vt] = (unsigned)(c + 1);
        }
    }
    __syncthreads();
}

__device__ __forceinline__ void ph_rwkv_c(const Ctx& C, const bf16* S0, const bf16* RH, const bf16* YH, const float* RK, const bf16* GG, const bf16* VF,
                                          const float* gn_g, const float* gn_b, bf16* O) {
    const int lane = C.lane, cc = lane & 15, g = lane >> 4;
    for (int item = C.bid * 8 + C.wave; item < 4096; item += C.nb * 8) {
        const int h = item & 7, c = (item >> 3) & 127, b = item >> 10; const size_t m0 = (size_t)b * T_ + c * 64, ob = (size_t)item * 4096;
        s16x8 af[4][2], bfr[4][2];
#pragma unroll
        for (int q = 0; q < 4; ++q)
#pragma unroll
            for (int k = 0; k < 2; ++k) { af[q][k] = *(const s16x8*)(S0 + ob + (q * 16 + cc) * 64 + k * 32 + 8 * g); bfr[q][k] = *(const s16x8*)(RH + ob + (q * 16 + cc) * 64 + k * 32 + 8 * g); }
#pragma unroll
        for (int nt = 0; nt < 4; ++nt) {
            const size_t m = m0 + nt * 16 + cc;
            f32x4 y[4]; float s1 = 0.f;
#pragma unroll
            for (int mt = 0; mt < 4; ++mt) { const unsigned long long yh = *(const unsigned long long*)(YH + ob + (nt * 16 + cc) * 64 + mt * 16 + 4 * g);
                f32x4 acc; acc.x = bf2f((bf16)(yh & 0xffffu)); acc.y = bf2f((bf16)((yh >> 16) & 0xffffu)); acc.z = bf2f((bf16)((yh >> 32) & 0xffffu)); acc.w = bf2f((bf16)(yh >> 48));
                acc = __builtin_amdgcn_mfma_f32_16x16x32_bf16(af[mt][0], bfr[nt][0], acc, 0, 0, 0); acc = __builtin_amdgcn_mfma_f32_16x16x32_bf16(af[mt][1], bfr[nt][1], acc, 0, 0, 0);
                y[mt] = acc; s1 += (acc.x + acc.y) + (acc.z + acc.w); }
            s1 = hy::xsum4(s1);
            const float mean = s1 * (1.f / 64.f); float s2 = 0.f;
#pragma unroll
            for (int mt = 0; mt < 4; ++mt) { y[mt] = y[mt] - mean; s2 += (y[mt].x * y[mt].x + y[mt].y * y[mt].y) + (y[mt].z * y[mt].z + y[mt].w * y[mt].w); }
            s2 = hy::xsum4(s2);
            const float rstd = 1.f / sqrtf(s2 * (1.f / 64.f) + 64e-5f), rk = RK[m * 8 + h];
#pragma unroll
            for (int mt = 0; mt < 4; ++mt) { const int v = h * 64 + mt * 16 + 4 * g;
                const f32x4 gg4 = *(const f32x4*)(gn_g + v), gb4 = *(const f32x4*)(gn_b + v);
                const unsigned long long vx = *(const unsigned long long*)(VF + m * 512 + v), gx = *(const unsigned long long*)(GG + m * 512 + v);
                f32x4 o;
                o.x = (y[mt].x * rstd * gg4.x + gb4.x + rk * bf2f((bf16)(vx & 0xffffu))) * bf2f((bf16)(gx & 0xffffu));
                o.y = (y[mt].y * rstd * gg4.y + gb4.y + rk * bf2f((bf16)((vx >> 16) & 0xffffu))) * bf2f((bf16)((gx >> 16) & 0xffffu));
                o.z = (y[mt].z * rstd * gg4.z + gb4.z + rk * bf2f((bf16)((vx >> 32) & 0xffffu))) * bf2f((bf16)((gx >> 32) & 0xffffu));
                o.w = (y[mt].w * rstd * gg4.w + gb4.w + rk * bf2f((bf16)(vx >> 48))) * bf2f((bf16)(gx >> 48));
                *(unsigned long long*)(O + m * D_ + 512 + v) = pack4(o); }
        }
    }
}

__device__ __forceinline__ void ph_convfix(const Ctx& C, const float* HALO, const float* FIXU, const float* cw, const float* cb, bf16* ACT) {
    for (int idx = C.bid * NT + C.tid; idx < 128 * 22 * 2 * 128; idx += C.nb * NT) {
        const int j = idx & 127, rr = (idx >> 7) & 1, tile = idx >> 8, pm = tile / 22, pn = tile % 22;
        const bool seq0 = (pm & 31) == 0;
        const float* fx = FIXU + (size_t)tile * 512; const float* hl = HALO + (size_t)(tile - 22) * 512;
        const float u0g = fx[rr * 256 + j], u0v = fx[rr * 256 + 128 + j];
        float u1g, u1v, u2g, u2v;
        if (rr == 0) { u1g = seq0 ? 0.f : hl[256 + j]; u1v = seq0 ? 0.f : hl[256 + 128 + j]; u2g = seq0 ? 0.f : hl[j]; u2v = seq0 ? 0.f : hl[128 + j]; }
        else { u1g = fx[j]; u1v = fx[128 + j]; u2g = seq0 ? 0.f : hl[256 + j]; u2v = seq0 ? 0.f : hl[256 + 128 + j]; }
        const int jg = pn * 128 + j, jv = DFF + jg;
        const float gc = cb[jg] + cw[jg] * u2g + cw[NUP + jg] * u1g + cw[2 * NUP + jg] * u0g, vc = cb[jv] + cw[jv] * u2v + cw[NUP + jv] * u1v + cw[2 * NUP + jv] * u0v;
        ACT[(size_t)(pm * 256 + rr) * DFF + jg] = (bf16)f2bf(siluf_(gc) * vc);
    }
}
}

namespace pg8 {
struct EpiRes {
    static constexpr bool PERM = false, AFTER_DRAIN = false;
    const float* base; float* out; const float* gate; int gstride;
    __device__ __forceinline__ void operator()(const f32x4 (&acc)[2][2][4][2], const Unit& u, int wr, int wc, int fr, int fq) const {
        const int b = (u.pm * BM) / 8192; const float* gp = gate + (size_t)b * gstride;
        const int col0 = u.pn * BM + wc * 32 + 4 * fq;
        f32x4 gv[2][2];
#pragma unroll
        for (int bj = 0; bj < 2; ++bj)
#pragma unroll
            for (int n = 0; n < 2; ++n) gv[bj][n] = *(const f32x4*)(gp + col0 + bj * HALF + n * 16);
#pragma unroll
        for (int ai = 0; ai < 2; ++ai)
#pragma unroll
            for (int m = 0; m < 4; ++m) { const size_t off = (size_t)(u.pm * BM + ai * HALF + wr * 64 + m * 16 + fr) * 1024 + col0;
                f32x4 bs[2][2];
#pragma unroll
                for (int bj = 0; bj < 2; ++bj)
#pragma unroll
                    for (int n = 0; n < 2; ++n) bs[bj][n] = *(const f32x4*)(base + off + bj * HALF + n * 16);
#pragma unroll
                for (int bj = 0; bj < 2; ++bj)
#pragma unroll
                    for (int n = 0; n < 2; ++n) *(f32x4*)(out + off + bj * HALF + n * 16) = bs[bj][n] + gv[bj][n] * acc[ai][bj][m][n]; }
    }
};

__device__ __forceinline__ void fold_rstd(const float* SSQ, const Unit& u, int wr, int fr, int fq, float (&rs)[2][4]) {
#pragma unroll
    for (int ai = 0; ai < 2; ++ai)
#pragma unroll
        for (int m = 0; m < 4; ++m) { const f32x4 a = *(const f32x4*)(SSQ + (size_t)(u.pm * BM + ai * HALF + wr * 64 + m * 16 + fr) * 16 + 4 * fq);
            float s = (a.x + a.y) + (a.z + a.w); s = hy::xsum4(s);
            rs[ai][m] = 1.f / sqrtf(s * (1.f / 1024.f) + 1e-6f); }
}
struct EpiBf16F {
    static constexpr bool PERM = true, AFTER_DRAIN = false;
    bf16_t* O; int ldc; const float* bias; int bstride; const float* SSQ; int split_cols; size_t split_stride;
    __device__ __forceinline__ void operator()(const f32x4 (&acc)[2][2][4][2], const Unit& u, int wr, int wc, int fr, int fq) const {
        const int row0 = u.pm * BM + wr * 64 + fr; int colt = u.pn * BM; bf16_t* base = O;
        { const int t = colt / split_cols; base += (size_t)t * split_stride; colt -= t * split_cols; }
        const int col0 = colt + wc * 32 + 8 * fq, bcol0 = u.pn * BM + wc * 32 + 8 * fq;
        const float* bp = bias + (size_t)(u.pm >> 5) * bstride;
        float rs[2][4]; fold_rstd(SSQ, u, wr, fr, fq, rs);
        f32x4 bv[2][2];
#pragma unroll
        for (int bj = 0; bj < 2; ++bj)
#pragma unroll
            for (int n = 0; n < 2; ++n) bv[bj][n] = *(const f32x4*)(bp + bcol0 + bj * HALF + 4 * n);
#pragma unroll
        for (int ai = 0; ai < 2; ++ai)
#pragma unroll
            for (int m = 0; m < 4; ++m) { bf16_t* rowp = base + (size_t)(row0 + ai * HALF + m * 16) * ldc + col0; const float r = rs[ai][m];
#pragma unroll
                for (int bj = 0; bj < 2; ++bj) { const f32x4 v0 = acc[ai][bj][m][0] * r + bv[bj][0], v1 = acc[ai][bj][m][1] * r + bv[bj][1];
                    u32x4 w; w.x = cvt_pk_bf16(v0[0], v0[1]); w.y = cvt_pk_bf16(v0[2], v0[3]); w.z = cvt_pk_bf16(v1[0], v1[1]); w.w = cvt_pk_bf16(v1[2], v1[3]);
                    *(u32x4*)(rowp + bj * HALF) = w; } }
    }
};
struct EpiResF {
    static constexpr bool PERM = true, AFTER_DRAIN = false;
    const float* base; float* out; const float* gate; int gstride; bf16_t* XB; float* SSQ;
    __device__ __forceinline__ void operator()(const f32x4 (&acc)[2][2][4][2], const Unit& u, int wr, int wc, int fr, int fq) const {
        const int b = u.pm >> 5; const float* gp = gate + (size_t)b * gstride;
        const int col0 = u.pn * BM + wc * 32 + 8 * fq;
        f32x4 gv[2][2];
#pragma unroll
        for (int bj = 0; bj < 2; ++bj)
#pragma unroll
            for (int n = 0; n < 2; ++n) gv[bj][n] = *(const f32x4*)(gp + col0 + bj * HALF + n * 4);
#pragma unroll
        for (int ai = 0; ai < 2; ++ai)
#pragma unroll
            for (int m = 0; m < 4; ++m) { const int row = u.pm * BM + ai * HALF + wr * 64 + m * 16 + fr; const size_t off = (size_t)row * 1024 + col0;
                f32x4 bs[2][2]; float ss = 0.f;
#pragma unroll
                for (int bj = 0; bj < 2; ++bj)
#pragma unroll
                    for (int n = 0; n < 2; ++n) bs[bj][n] = *(const f32x4*)(base + off + bj * HALF + n * 4);
#pragma unroll
                for (int bj = 0; bj < 2; ++bj) { u32x4 w;
                    { const f32x4 o = bs[bj][0] + gv[bj][0] * acc[ai][bj][m][0]; *(f32x4*)(out + off + bj * HALF) = o; w.x = cvt_pk_bf16(o.x, o.y); w.y = cvt_pk_bf16(o.z, o.w); ss += (o.x * o.x + o.y * o.y) + (o.z * o.z + o.w * o.w); }
                    { const f32x4 o = bs[bj][1] + gv[bj][1] * acc[ai][bj][m][1]; *(f32x4*)(out + off + bj * HALF + 4) = o; w.z = cvt_pk_bf16(o.x, o.y); w.w = cvt_pk_bf16(o.z, o.w); ss += (o.x * o.x + o.y * o.y) + (o.z * o.z + o.w * o.w); }
                    *(u32x4*)(XB + off + bj * HALF) = w; }
                ss = hy::xsum4(ss);
                if (fq == 0) SSQ[(size_t)row * 16 + u.pn * 4 + wc] = ss; }
    }
};
struct EpiConv {
    static constexpr bool PERM = true, AFTER_DRAIN = false;
    bf16_t* ACT; const float* cw; const float* cb; float* HALO; float* FIXU; PG8_LAS float* EX; int nN;
    const float* bias; int bstride; const float* SSQ;
    template <int CTRL> static __device__ __forceinline__ float rot(float x) { return __builtin_bit_cast(float, __builtin_amdgcn_update_dpp(0, __builtin_bit_cast(int, x), CTRL, 0xf, 0xf, false)); }
    template <int CTRL> static __device__ __forceinline__ f32x4 rot4(f32x4 x) { return (f32x4){rot<CTRL>(x.x), rot<CTRL>(x.y), rot<CTRL>(x.z), rot<CTRL>(x.w)}; }
    __device__ __forceinline__ void operator()(f32x4 (&acc)[2][2][4][2], const Unit& u, int wr, int wc, int fr_, int fq_) const {
        int l_; asm volatile("v_mbcnt_lo_u32_b32 %0, -1, 0\n\tv_mbcnt_hi_u32_b32 %0, -1, %0" : "=v"(l_)); const int fr = l_ & 15, fq = l_ >> 4; (void)fr_; (void)fq_;
        const int colw = wc * 32 + 8 * fq, tile = u.pm * nN + u.pn;
        { float rs[2][4]; fold_rstd(SSQ, u, wr, fr, fq, rs); const float* bp = bias + (size_t)(u.pm >> 5) * bstride + u.pn * BM + colw;
#pragma unroll
          for (int bj = 0; bj < 2; ++bj)
#pragma unroll
              for (int n = 0; n < 2; ++n) { const f32x4 bv = *(const f32x4*)(bp + bj * HALF + 4 * n);
#pragma unroll
                  for (int ai = 0; ai < 2; ++ai)
#pragma unroll
                      for (int m = 0; m < 4; ++m) acc[ai][bj][m][n] = acc[ai][bj][m][n] * rs[ai][m] + bv; } }
        __builtin_amdgcn_sched_barrier(0);
        if (fr >= 14) {
#pragma unroll
            for (int ai = 0; ai < 2; ++ai)
#pragma unroll
                for (int bj = 0; bj < 2; ++bj)
#pragma unroll
                    for (int n = 0; n < 2; ++n) { *(PG8_LAS f32x4*)(EX + ((ai * 2 + wr) * 2 + (fr - 14)) * 256 + bj * 128 + colw + 4 * n) = acc[ai][bj][3][n];
                        if (ai == 1 && wr == 1) *(f32x4*)(HALO + ((size_t)tile * 2 + (fr - 14)) * 256 + bj * 128 + colw + 4 * n) = acc[1][bj][3][n]; }
        }
        if (fr < 2 && wr == 0) {
#pragma unroll
            for (int bj = 0; bj < 2; ++bj)
#pragma unroll
                for (int n = 0; n < 2; ++n) *(f32x4*)(FIXU + ((size_t)tile * 2 + fr) * 256 + bj * 128 + colw + 4 * n) = acc[0][bj][0][n];
        }
        asm volatile("s_waitcnt lgkmcnt(0)" ::: "memory"); __builtin_amdgcn_s_barrier(); asm volatile("" ::: "memory");
        __builtin_amdgcn_sched_barrier(0);
#pragma unroll
        for (int n = 0; n < 2; ++n) {
            const int jg = u.pn * 128 + colw + 4 * n, jv = 2816 + jg;
            f32x4 cw0[2], cw1[2], cw2[2], cbb[2];
            cw0[0] = *(const f32x4*)(cw + jg); cw1[0] = *(const f32x4*)(cw + 5632 + jg); cw2[0] = *(const f32x4*)(cw + 2 * 5632 + jg); cbb[0] = *(const f32x4*)(cb + jg);
            cw0[1] = *(const f32x4*)(cw + jv); cw1[1] = *(const f32x4*)(cw + 5632 + jv); cw2[1] = *(const f32x4*)(cw + 2 * 5632 + jv); cbb[1] = *(const f32x4*)(cb + jv);
#pragma unroll
            for (int ai = 0; ai < 2; ++ai)
#pragma unroll
                for (int m = 0; m < 4; ++m) {
                    const int src = ai * 2 + wr - 1;
                    f32x4 res[2];
#pragma unroll
                    for (int bj = 0; bj < 2; ++bj) {
                        const f32x4 x = acc[ai][bj][m][n];
                        f32x4 x1 = rot4<0x121>(x), x2 = rot4<0x122>(x);
                        if (m > 0) { const f32x4 q = acc[ai][bj][m > 0 ? m - 1 : 0][n]; const f32x4 q1 = rot4<0x121>(q), q2 = rot4<0x122>(q);
                            if (fr == 0) x1 = q1; if (fr < 2) x2 = q2; }
                        else if (fr < 2) { f32x4 e14 = {0.f, 0.f, 0.f, 0.f}, e15 = e14;
                            if (src >= 0) { e14 = *(const PG8_LAS f32x4*)(EX + (src * 2 + 0) * 256 + bj * 128 + colw + 4 * n); e15 = *(const PG8_LAS f32x4*)(EX + (src * 2 + 1) * 256 + bj * 128 + colw + 4 * n); }
                            if (fr == 0) { x1 = e15; x2 = e14; } else x2 = e15; }
                        const f32x4 w0 = cw0[bj], w1 = cw1[bj], w2 = cw2[bj], bb = cbb[bj];
                        res[bj] = bb + w0 * x2 + w1 * x1 + w2 * x;
                    }
                    const f32x4 gc = res[0], vc = res[1];
                    f32x4 o;
                    o.x = gc.x * __builtin_amdgcn_rcpf(1.f + __expf(-gc.x)) * vc.x; o.y = gc.y * __builtin_amdgcn_rcpf(1.f + __expf(-gc.y)) * vc.y;
                    o.z = gc.z * __builtin_amdgcn_rcpf(1.f + __expf(-gc.z)) * vc.z; o.w = gc.w * __builtin_amdgcn_rcpf(1.f + __expf(-gc.w)) * vc.w;
                    typedef unsigned u32x2 __attribute__((ext_vector_type(2)));
                    u32x2 w; w.x = cvt_pk_bf16(o.x, o.y); w.y = cvt_pk_bf16(o.z, o.w);
                    *(u32x2*)(ACT + (size_t)(u.pm * BM + ai * HALF + wr * 64 + m * 16 + fr) * 2816 + u.pn * 128 + colw + 4 * n) = w;
                }
        }
    }
};
}

namespace hy {
struct Args { const float* in[31]; float* out; unsigned char* ws; };
__global__ void __launch_bounds__(NT, 2) hy_fwd(Args A) {
    extern __shared__ __attribute__((aligned(16))) unsigned char lds_raw[];
    Ctx C; C.bid = blockIdx.x; C.nb = gridDim.x; C.tid = threadIdx.x; C.lane = C.tid & 63; C.wave = __builtin_amdgcn_readfirstlane(C.tid >> 6); C.lds = (LAS unsigned char*)lds_raw;
    volatile LAS unsigned* MISC = (volatile LAS unsigned*)(C.lds + MISC_OFF);
    for (int u = C.tid; u < (LDS_BYTES - MISC_OFF) / 4; u += NT) ((LAS unsigned*)(C.lds + MISC_OFF))[u] = 0u;
    __syncthreads();
    unsigned char* ws = A.ws;
    const int wave0 = __builtin_amdgcn_readfirstlane(threadIdx.x >> 6);
    (void)xcd_barrier_post((unsigned*)(ws + WS_CTL) + CW_BAR, MISC + 8);
#define PHASE_BEGIN() do { int t_ = wave0 * 64 + lane_now(); int b_ = blockIdx.x; asm volatile("" : "+s"(b_)); \
    C.tid = t_; C.lane = t_ & 63; C.wave = __builtin_amdgcn_readfirstlane(t_ >> 6); C.bid = b_; } while (0)
#ifdef HY_DIAG
    unsigned long long ts_last = __builtin_amdgcn_s_memrealtime(); float tacc[10] = {0.f, 0.f, 0.f, 0.f, 0.f, 0.f, 0.f, 0.f, 0.f, 0.f};
#define GRID_BAR(cat) do { { XcdBarrier b_; b_.bar = (unsigned*)(A.ws + WS_CTL) + CW_BAR; b_.x = xb_xcc_id(); b_.st = (volatile LAS unsigned*)(C.lds + MISC_OFF) + 8; xcd_barrier(b_, wave0 == 0 && lane_now() == 0); } PHASE_BEGIN(); { const unsigned long long n_ = __builtin_amdgcn_s_memrealtime(); tacc[cat] += (float)(n_ - ts_last); ts_last = n_; } } while (0)
#else
#define GRID_BAR(cat) do { { XcdBarrier b_; b_.bar = (unsigned*)(A.ws + WS_CTL) + CW_BAR; b_.x = xb_xcc_id(); b_.st = (volatile LAS unsigned*)(C.lds + MISC_OFF) + 8; xcd_barrier(b_, wave0 == 0 && lane_now() == 0); } PHASE_BEGIN(); } while (0)
#endif
#ifndef HY_REPCAT
#define HY_REPCAT (-1)
#endif
#define NREP(cat) ((HY_REPCAT == (cat)) ? 2 : 1)
    float* out = A.out;
#define in A.in
    float* MOD = (float*)(ws + WS_MOD);
    bf16 *WIN = (bf16*)(ws + WS_WIN), *WOUT = (bf16*)(ws + WS_WOUT), *WUP = (bf16*)(ws + WS_WUP), *WDN = (bf16*)(ws + WS_WDN);
    bf16 *XB = (bf16*)(ws + WS_XB), *O = (bf16*)(ws + WS_O), *VF = (bf16*)(ws + WS_VF), *PG = (bf16*)(ws + WS_PG), *PR = (bf16*)(ws + WS_PR), *VL = (bf16*)(ws + WS_VL);
    bf16 *RH = (bf16*)(ws + WS_RH), *YH = (bf16*)(ws + WS_YH), *PP = (bf16*)(ws + WS_PP), *QQ = (bf16*)(ws + WS_QQ), *GG = (bf16*)(ws + WS_GG), *S0 = (bf16*)(ws + WS_S0);
    float *GAMC = (float*)(ws + WS_GAMC), *RK = (float*)(ws + WS_RK);
    bf16 *WINF = (bf16*)(ws + WS_WINF), *WUPF = (bf16*)(ws + WS_WUPF); float *BIN = (float*)(ws + WS_BIN), *BUP = (float*)(ws + WS_BUP), *SSQ = (float*)(ws + WS_SSQ);
    bf16* LORA = (bf16*)(ws + WS_LORA);
    bf16* DS = (bf16*)(ws + WS_GK); float* GAM = (float*)(ws + WS_GAM);
    bf16* ACT = (bf16*)(ws + WS_ACT); float *HALO = (float*)(ws + WS_GG), *FIXU = (float*)(ws + WS_GG + 8 * MiB);

    ph_mod(C, in[1], in[2], in[3], MOD);
    ph_xcast(C, in[0], XB, SSQ);
    GRID_BAR(0);
    for (int l = 0; l < L_; ++l) {
        const float* modl = MOD + (size_t)l * 4 * 6144;
        const float* xres = l ? out : in[0];
        for (int r_ = 0; r_ < NREP(0); ++r_) {
        wprep_mat(C, in[24] + (size_t)l * D_ * D_, D_, D_, D_, WOUT, 0, nullptr);
        wprep_mat(C, in[29] + (size_t)l * DFF * D_, DFF, D_, D_, WDN, 0, nullptr);
        wprep_mat(C, in[12] + (size_t)l * 64 * 512, 64, 512, 512, LORA, 0, nullptr);
        wprep_mat(C, in[14] + (size_t)l * 64 * 512, 64, 512, 512, LORA + 512 * 64, 0, nullptr);
        wprep_mat(C, in[16] + (size_t)l * 128 * 512, 128, 512, 512, LORA + 2 * 512 * 64, 0, nullptr);
        if (l) wprep_mat(C, in[17], 32, 512, 512, LORA + 2 * 512 * 64 + 512 * 128, 0, nullptr);
        wprep_fold(C, in[5] + (size_t)l * D_ * IN_COLS, IN_COLS, NIN, 1, l ? in[6] : nullptr, in[4] + l * D_, modl + 1 * D_, WINF);
        fold_bias(C, in[5] + (size_t)l * D_ * IN_COLS, IN_COLS, NIN, 1, l ? in[6] : nullptr, modl + 0 * D_, BIN);
        }
        GRID_BAR(0);
        for (int r_ = 0; r_ < NREP(2); ++r_) { pg8::Gemm g{XB, WINF, M_, NIN, D_, (size_t)NIN * D_ * 2}; pg8::StaticOrder S; S.init(M_, NIN, C.nb, C.bid);
          pg8::EpiBf16F E{PG, NPG, BIN, NIN, SSQ, NPG, (WS_PR - WS_PG) / 2};
          pg8::gemm_phase<pg8::EpiBf16F, pg8::StaticOrder, true, true>(C.lds, g, S, E, C.tid); }
        GRID_BAR(2);
        for (int r_ = 0; r_ < NREP(3); ++r_) {
        ph_gla_a(C, PG, in[7] + l * 16 * 256, in[8] + l * 256, DS, GAM);
        { RwkvW W{in[10] + l * 1792, in[11], in[13] + l * 512, in[15] + l * 512, in[18], in[19] + l * 512, in[20] + l * 512, in[21] + l * 512,
                  LORA, LORA + 512 * 64, LORA + 2 * 512 * 64, LORA + 2 * 512 * 64 + 512 * 128};
          ph_rwkv_a(C, PR, PG, W, l, PP, QQ, RH, YH, GAMC, RK, GG, VF, r_ == NREP(3) - 1); } }
        GRID_BAR(3);
        if (C.bid < 32) { for (int r_ = 0; r_ < NREP(4); ++r_) ph_rwkv_b(C, C.bid, PP, QQ, GAMC, S0); }
        else { Ctx C2 = C; C2.bid = C.bid - 32; C2.nb = C.nb - 32; ph_gla_b(C2, DS, GAM); }
        GRID_BAR(4);
        for (int r_ = 0; r_ < NREP(5); ++r_) {
        ph_gla_c(C, PG, in[7] + l * 16 * 256, in[8] + l * 256, in[9] + l * 128, DS, O);
        ph_rwkv_c(C, S0, RH, YH, RK, GG, VF, in[22] + l * 512, in[23] + l * 512, O); }
        GRID_BAR(5);
        { pg8::Gemm g{O, WOUT, M_, D_, D_, 0}; pg8::StaticOrder S; S.init(M_, D_, C.nb, C.bid);
          pg8::EpiResF E{xres, out, modl + 2 * D_, 6144, XB, SSQ};
          pg8::gemm_phase<pg8::EpiResF, pg8::StaticOrder, true, true>(C.lds, g, S, E, C.tid); }
        wprep_fold(C, in[26] + (size_t)l * D_ * NUP, NUP, NUP, 2, nullptr, in[25] + l * D_, modl + 4 * D_, WUPF);
        fold_bias(C, in[26] + (size_t)l * D_ * NUP, NUP, NUP, 2, nullptr, modl + 3 * D_, BUP);
        GRID_BAR(6);
        for (int r_ = 0; r_ < NREP(7); ++r_) { pg8::Gemm g{XB, WUPF, M_, NUP, D_, (size_t)NUP * D_ * 2}; pg8::StaticOrder S; S.init(M_, NUP, C.nb, C.bid);
          pg8::EpiConv E{ACT, in[27] + (size_t)l * 3 * NUP, in[28] + (size_t)l * NUP, HALO, FIXU, (PG8_LAS float*)(C.lds + RING_BYTES), NUP / 256, BUP, NUP, SSQ};
          pg8::gemm_phase<pg8::EpiConv, pg8::StaticOrder, true, true>(C.lds, g, S, E, C.tid); }
        GRID_BAR(7);
        for (int r_ = 0; r_ < NREP(8); ++r_) ph_convfix(C, HALO, FIXU, in[27] + (size_t)l * 3 * NUP, in[28] + (size_t)l * NUP, ACT);
        GRID_BAR(8);
        { pg8::Gemm g{ACT, WDN, M_, D_, DFF, 0}; pg8::StaticOrder S; S.init(M_, D_, C.nb, C.bid);
          pg8::EpiResF E{out, out, modl + 5 * D_, 6144, XB, SSQ};
          pg8::gemm_phase<pg8::EpiResF, pg8::StaticOrder, true, true>(C.lds, g, S, E, C.tid); }
        GRID_BAR(9);
    }
    ph_final(C, out, in[30]);
#ifdef HY_DIAG
    GRID_BAR(1);
    if (C.bid == 0) { if (C.tid == 0) out[0] = tacc[HY_DIAG_A] * 0.1f; for (int i = 1 + C.tid; i <= 10000; i += NT) out[i] = tacc[HY_DIAG_B] * 0.01f; }
#endif
#undef GRID_BAR
#undef PHASE_BEGIN
#undef in
}
}

extern "C" void kernel_launch(void* const* d_in, const int* in_sizes, int n_in, void* d_out, int out_size, void* d_ws, size_t ws_size, hipStream_t stream) {
    using namespace hy;
    static int grid = 0;
    if (grid == 0) {
        if (n_in != 31 || in_sizes[0] != M_ * D_ || out_size != M_ * D_ || ws_size < WS_END) { fprintf(stderr, "kernel_launch: unexpected shapes (n_in %d, in0 %d, out %d, ws %zu)\n", n_in, n_in > 0 ? in_sizes[0] : -1, out_size, ws_size); grid = -1; return; }
        if (hipFuncSetAttribute((const void*)hy_fwd, hipFuncAttributeMaxDynamicSharedMemorySize, LDS_BYTES) != hipSuccess) { fprintf(stderr, "kernel_launch: hipFuncSetAttribute failed\n"); grid = -1; return; }
        int dev = 0, cus = 0, per_cu = 0;
        (void)hipGetDevice(&dev); (void)hipDeviceGetAttribute(&cus, hipDeviceAttributeMultiprocessorCount, dev);
        (void)hipOccupancyMaxActiveBlocksPerMultiprocessor(&per_cu, (const void*)hy_fwd, NT, LDS_BYTES);
        if (per_cu < 1) fprintf(stderr, "kernel_launch: occupancy query reports %d blocks per CU\n", per_cu);
        (void)hipGetLastError();
        grid = cus > 0 ? cus : 256;
    }
    if (grid < 0) return;
    (void)hipMemsetAsync((char*)d_ws + WS_CTL, 0, CTL_ZERO_BYTES, stream);
    Args a{};
    for (int i = 0; i < 31; ++i) a.in[i] = (const float*)d_in[i];
    a.out = (float*)d_out; a.ws = (unsigned char*)d_ws;
    hipLaunchKernelGGL(hy_fwd, dim3(grid), dim3(NT), LDS_BYTES, stream, a);
}
```

```cpp
#include <hip/hip_runtime.h>
#include <cstdio>
#include <cstdint>
namespace pg8 {
#define PG8_LAS __attribute__((address_space(3)))
typedef unsigned short bf16_t;
typedef short bf16x8 __attribute__((ext_vector_type(8)));
typedef float f32x4 __attribute__((ext_vector_type(4)));
typedef unsigned u32x4 __attribute__((ext_vector_type(4)));
constexpr int BM = 256, BK = 64, HALF = 128, HTB = HALF * BK * 2  , STAGE_BYTES = 8 * HTB, NXCD = 8, WGM = 8;

__host__ __device__ __forceinline__ int lds_byte(int r, int c) { const int st = (r >> 4) * 2 + (c >> 5), rr = r & 15, cc = c & 31, ob = rr * 64 + cc * 2; return st * 1024 + (ob ^ (((ob >> 9) & 1) << 5)); }
__host__ __device__ __forceinline__ void stage_rc(int b, int& R, int& C) { const int st = b / 1024, sb = b % 1024, swz = sb ^ (((sb >> 9) & 1) << 5); R = (st >> 1) * 16 + swz / 64; C = (st & 1) * 32 + (swz % 64) / 2; }
__host__ __device__ __forceinline__ int perm32(int rho) { const int n = rho >> 4, i = rho & 15; return 8 * (i >> 2) + 4 * n + (i & 3); }

struct Unit { int pm, pn; };
struct Gemm { const bf16_t* A; const bf16_t* Bt; int M, N, K; size_t bstride; };

struct StaticOrder {
    int nM, nN, nwg, G, c;
    __host__ __device__ void init(int M, int N, int G_, int c_) { nM = M / BM; nN = N / BM; nwg = nM * nN; G = G_; c = c_; }
    __host__ __device__ bool next(int i, Unit& u) const {
        const long L = (long)i * G + c; if (L >= nwg) return false;
        int wgid = (int)L; { const int q = nwg / NXCD, r = nwg % NXCD, xcd = wgid % NXCD, off = wgid / NXCD; wgid = (xcd < r ? xcd * (q + 1) : r * (q + 1) + (xcd - r) * q) + off; }
        const int nig = WGM * nN, gid = wgid / nig, fm = gid * WGM, gsz = (nM - fm) < WGM ? (nM - fm) : WGM;
        u.pm = fm + ((wgid % nig) % gsz); u.pn = (wgid % nig) / gsz; return true;
    }
    __device__ __forceinline__ void a_ready(const Unit&) const {}
    __device__ __forceinline__ void done(const Unit&) const {}
};

__device__ __forceinline__ unsigned cvt_pk_bf16(float lo, float hi) { unsigned r; asm volatile("v_cvt_pk_bf16_f32 %0, %1, %2" : "=v"(r) : "v"(lo), "v"(hi)); return r; }
typedef float f32x2 __attribute__((ext_vector_type(2)));
__device__ __forceinline__ f32x2 gelu_pk(f32x2 v) {
    const f32x2 av = __builtin_elementwise_abs(v), d = av * 0.2316418882f + 1.0f;
    f32x2 t; t.x = __builtin_amdgcn_rcpf(d.x); t.y = __builtin_amdgcn_rcpf(d.y);
    f32x2 q = t * 0.5307027145f + (-0.7265760135f); q = q * t + 0.7107068705f; q = q * t + (-0.142248368f); q = q * t + 0.127414796f; q = q * t;
    const f32x2 s = (v * v) * (-0.72134752044f);
    f32x2 e; e.x = __builtin_amdgcn_exp2f(s.x); e.y = __builtin_amdgcn_exp2f(s.y);
    const f32x2 m = v * (q * e), r = v - m;
    f32x2 o; o.x = v.x < 0.f ? m.x : r.x; o.y = v.y < 0.f ? m.y : r.y; return o;
}

template <int ACT  > struct EpiBf16 {
    static constexpr bool PERM = true, AFTER_DRAIN = false; static_assert(ACT == 0 || ACT == 1, "EpiBf16: ACT is 0 (none) or 1 (gelu_pk)");
    bf16_t* O; int ldc; const float* bias; int split_cols; size_t split_stride; float scale0;
    __device__ __forceinline__ void operator()(const f32x4 (&acc)[2][2][4][2], const Unit& u, int wr, int wc, int fr, int fq) const {
        const int row0 = u.pm * BM + wr * 64 + fr; int colt = u.pn * BM; bf16_t* base = O;
        float sc = 1.f; if (split_cols) { const int t = colt / split_cols; base += (size_t)t * split_stride; colt -= t * split_cols; if (t == 0) sc = scale0; }
        const int col0 = colt + wc * 32 + 8 * fq, bcol0 = u.pn * BM + wc * 32 + 8 * fq;
        f32x4 bv[2][2];
#pragma unroll
        for (int bj = 0; bj < 2; ++bj)
#pragma unroll
            for (int n = 0; n < 2; ++n) bv[bj][n] = bias ? *(const f32x4*)(bias + bcol0 + bj * HALF + 4 * n) : (f32x4){0.f, 0.f, 0.f, 0.f};
#pragma unroll
        for (int ai = 0; ai < 2; ++ai)
#pragma unroll
            for (int m = 0; m < 4; ++m) { bf16_t* rowp = base + (size_t)(row0 + ai * HALF + m * 16) * ldc + col0;
#pragma unroll
                for (int bj = 0; bj < 2; ++bj) { f32x4 v0 = acc[ai][bj][m][0] + bv[bj][0], v1 = acc[ai][bj][m][1] + bv[bj][1];
                    if (ACT == 1) { f32x2 a = gelu_pk((f32x2){v0[0], v0[1]}), b = gelu_pk((f32x2){v0[2], v0[3]}), c = gelu_pk((f32x2){v1[0], v1[1]}), d = gelu_pk((f32x2){v1[2], v1[3]});
                        v0 = (f32x4){a.x, a.y, b.x, b.y}; v1 = (f32x4){c.x, c.y, d.x, d.y}; }
                    v0 = v0 * sc; v1 = v1 * sc; u32x4 w; w.x = cvt_pk_bf16(v0[0], v0[1]); w.y = cvt_pk_bf16(v0[2], v0[3]); w.z = cvt_pk_bf16(v1[0], v1[1]); w.w = cvt_pk_bf16(v1[2], v1[3]);
                    *(u32x4*)(rowp + bj * HALF) = w; } }
    }
};
template <class Epi, class Sched, bool ALIGN_EPI = false, bool SP2 = false>
__device__ __forceinline__ void gemm_phase(PG8_LAS unsigned char* lds, const Gemm g, const Sched& S, const Epi& E, int tid_in) {
    int tid_ = tid_in; asm volatile("" : "+v"(tid_));
    const int tid = tid_, wid = __builtin_amdgcn_readfirstlane(tid >> 6), lane = tid & 63, wr = wid >> 2, wc = wid & 3, fr = lane & 15, fq = lane >> 4;
    const int K = g.K, nt = K / BK;
    unsigned voffA[2], voffB[2];
#pragma unroll
    for (int i = 0; i < 2; ++i) { int R, C; stage_rc(tid * 16 + i * 8192, R, C); const int Rb = Epi::PERM ? ((R & ~31) + perm32(R & 31)) : R;
        voffA[i] = (unsigned)(R * K + C) * 2u; voffB[i] = (unsigned)(Rb * K + C) * 2u; }
    const size_t kstep = (size_t)(BK * 2);
    const size_t hstep = (size_t)HALF * K * 2;
    const size_t tstep = 2 * hstep;
    const unsigned ldsw = (unsigned)wid * 1024u;
    const int aoff = lds_byte(wr * 64 + fr, fq * 8), boff = lds_byte(wc * 32 + fr, fq * 8);
#define PG8_SA(b, h) (((b) * 2 + (h)) * HTB)
#define PG8_SB(b, h) ((4 + (b) * 2 + (h)) * HTB)
#define PG8_STAGE(bufoff, gbase, voff) do { _Pragma("unroll") for (int _i = 0; _i < 2; ++_i) \
        __builtin_amdgcn_global_load_lds((const unsigned*)((const char*)(gbase) + (voff)[_i]), (PG8_LAS unsigned*)(lds + (bufoff) + ldsw + _i * 8192), 16, 0, 0); } while (0)
#define PG8_LDA(dst, b, h) do { _Pragma("unroll") for (int m = 0; m < 4; ++m) _Pragma("unroll") for (int k = 0; k < 2; ++k) dst[m][k] = *(const PG8_LAS bf16x8*)(lds + PG8_SA(b, h) + aoff + m * 2048 + k * 1024); } while (0)
#define PG8_LDB(dst, b, h) do { _Pragma("unroll") for (int n = 0; n < 2; ++n) _Pragma("unroll") for (int k = 0; k < 2; ++k) dst[n][k] = *(const PG8_LAS bf16x8*)(lds + PG8_SB(b, h) + boff + n * 2048 + k * 1024); } while (0)
#define PG8_MMA(ai, bj, At, Bt) do { __builtin_amdgcn_s_setprio(1); _Pragma("unroll") for (int m = 0; m < 4; ++m) _Pragma("unroll") for (int n = 0; n < 2; ++n) _Pragma("unroll") for (int k = 0; k < 2; ++k) \
        acc[ai][bj][m][n] = __builtin_amdgcn_mfma_f32_16x16x32_bf16(Bt[n][k], At[m][k], acc[ai][bj][m][n], 0, 0, 0); __builtin_amdgcn_s_setprio(0); } while (0)
#define PG8_WAIT_V(n) asm volatile("s_waitcnt vmcnt(" #n ")" ::: "memory")
#define PG8_WAIT_L(n) asm volatile("s_waitcnt lgkmcnt(" #n ")" ::: "memory")
#define PG8_BAR __builtin_amdgcn_s_barrier()
#define PG8_SCHED __builtin_amdgcn_sched_barrier(0)
    Unit cur, nxt; int ui = 0;
    if (!S.next(0, cur)) return;
    f32x4 acc[2][2][4][2];
#pragma unroll
    for (int a = 0; a < 2; ++a)
#pragma unroll
        for (int b = 0; b < 2; ++b)
#pragma unroll
            for (int m = 0; m < 4; ++m)
#pragma unroll
                for (int n = 0; n < 2; ++n) acc[a][b][m][n] = (f32x4){0.f, 0.f, 0.f, 0.f};
    bf16x8 At[4][2], B0[2][2], B1[2][2];
    const char* cA = (const char*)g.A + (size_t)cur.pm * tstep; const char* cB = (const char*)g.Bt + (size_t)cur.pn * tstep + (size_t)(cur.pm >> 5) * g.bstride;
    S.a_ready(cur);
    if constexpr (SP2) {
        PG8_STAGE(PG8_SB(0, 0), cB, voffB); PG8_STAGE(PG8_SB(0, 1), cB + hstep, voffB); PG8_STAGE(PG8_SA(0, 0), cA, voffA); PG8_STAGE(PG8_SA(0, 1), cA + hstep, voffA);
        if (wr == 1) PG8_BAR;
        PG8_WAIT_V(2); PG8_BAR;
        PG8_STAGE(PG8_SB(1, 0), cB + kstep, voffB); PG8_STAGE(PG8_SA(1, 0), cA + kstep, voffA); PG8_STAGE(PG8_SB(1, 1), cB + hstep + kstep, voffB);
        PG8_WAIT_V(6); PG8_BAR;
    } else {
        PG8_STAGE(PG8_SB(0, 0), cB, voffB); PG8_STAGE(PG8_SA(0, 0), cA, voffA); PG8_STAGE(PG8_SB(0, 1), cB + hstep, voffB); PG8_STAGE(PG8_SA(0, 1), cA + hstep, voffA);
        if (wr == 1) PG8_BAR;
        PG8_WAIT_V(4); PG8_BAR;
        PG8_STAGE(PG8_SB(1, 0), cB + kstep, voffB); PG8_STAGE(PG8_SA(1, 0), cA + kstep, voffA); PG8_STAGE(PG8_SB(1, 1), cB + hstep + kstep, voffB);
        PG8_WAIT_V(6); PG8_BAR;
    }
    for (;;) {
        const bool has_next = S.next(ui + 1, nxt);
        const char* nA = has_next ? (const char*)g.A + (size_t)nxt.pm * tstep : cA; const char* nB = has_next ? (const char*)g.Bt + (size_t)nxt.pn * tstep + (size_t)(nxt.pm >> 5) * g.bstride : cB;
        for (int t = 0; t < nt; t += 2) {
            const bool last = (t == nt - 2);
            const char* a1 = cA + (size_t)(t + 1) * kstep;
            const char* a2 = last ? nA : cA + (size_t)(t + 2) * kstep; const char* b2 = last ? nB : cB + (size_t)(t + 2) * kstep;
            const char* a3 = a2 + kstep; const char* b3 = b2 + kstep;
            if (last && has_next) S.a_ready(nxt);
            if constexpr (SP2) {
            PG8_LDB(B0, 0, 0); PG8_LDB(B1, 0, 1); PG8_SCHED; PG8_LDA(At, 0, 0); PG8_STAGE(PG8_SA(1, 1), a1 + hstep, voffA);
            PG8_WAIT_V(8); PG8_WAIT_L(0); PG8_BAR; PG8_MMA(0, 0, At, B0); PG8_MMA(0, 1, At, B1); PG8_BAR; PG8_SCHED;
            PG8_LDA(At, 0, 1); PG8_STAGE(PG8_SB(0, 0), b2, voffB); PG8_STAGE(PG8_SB(0, 1), b2 + hstep, voffB); PG8_STAGE(PG8_SA(0, 0), a2, voffA);
            PG8_WAIT_V(8); PG8_WAIT_L(0); PG8_BAR; PG8_MMA(1, 0, At, B0); PG8_MMA(1, 1, At, B1); PG8_BAR; PG8_SCHED;
            PG8_LDB(B0, 1, 0); PG8_LDB(B1, 1, 1); PG8_SCHED; PG8_LDA(At, 1, 0); PG8_STAGE(PG8_SA(0, 1), a2 + hstep, voffA);
            PG8_WAIT_V(8); PG8_WAIT_L(0); PG8_BAR; PG8_MMA(0, 0, At, B0); PG8_MMA(0, 1, At, B1); PG8_BAR; PG8_SCHED;
            PG8_LDA(At, 1, 1); PG8_STAGE(PG8_SB(1, 0), b3, voffB); PG8_STAGE(PG8_SB(1, 1), b3 + hstep, voffB); PG8_STAGE(PG8_SA(1, 0), a3, voffA);
            PG8_WAIT_V(8); PG8_WAIT_L(0); PG8_BAR; PG8_MMA(1, 0, At, B0); PG8_MMA(1, 1, At, B1); PG8_BAR; PG8_SCHED;
            } else {
            PG8_LDB(B0, 0, 0); PG8_SCHED; PG8_LDA(At, 0, 0); PG8_STAGE(PG8_SA(1, 1), a1 + hstep, voffA);
            PG8_WAIT_L(8); PG8_BAR; PG8_WAIT_L(0); PG8_MMA(0, 0, At, B0); PG8_BAR; PG8_SCHED;
            PG8_LDB(B1, 0, 1); PG8_STAGE(PG8_SB(0, 0), b2, voffB);
            PG8_BAR; PG8_WAIT_L(0); PG8_MMA(0, 1, At, B1); PG8_BAR;
            PG8_LDA(At, 0, 1); PG8_STAGE(PG8_SA(0, 0), a2, voffA);
            PG8_BAR; PG8_WAIT_L(0); PG8_MMA(1, 0, At, B0); PG8_BAR; PG8_SCHED;
            PG8_STAGE(PG8_SB(0, 1), b2 + hstep, voffB);
            PG8_WAIT_V(6); PG8_BAR; PG8_MMA(1, 1, At, B1); PG8_BAR;
            PG8_LDB(B0, 1, 0); PG8_SCHED; PG8_LDA(At, 1, 0); PG8_STAGE(PG8_SA(0, 1), a2 + hstep, voffA);
            PG8_WAIT_L(8); PG8_BAR; PG8_WAIT_L(0); PG8_MMA(0, 0, At, B0); PG8_BAR; PG8_SCHED;
            PG8_LDB(B1, 1, 1); PG8_STAGE(PG8_SB(1, 0), b3, voffB);
            PG8_BAR; PG8_WAIT_L(0); PG8_MMA(0, 1, At, B1); PG8_BAR;
            PG8_LDA(At, 1, 1); PG8_STAGE(PG8_SA(1, 0), a3, voffA);
            PG8_BAR; PG8_WAIT_L(0); PG8_MMA(1, 0, At, B0); PG8_BAR; PG8_SCHED;
            PG8_STAGE(PG8_SB(1, 1), b3 + hstep, voffB);
            PG8_WAIT_V(6); PG8_BAR; PG8_MMA(1, 1, At, B1); PG8_BAR;
            }
        }
        if constexpr (ALIGN_EPI) { if (wr == 0) PG8_BAR; }
        if constexpr (!Epi::AFTER_DRAIN) { E(acc, cur, wr, wc, fr, fq); S.done(cur); }
        if (!has_next) break;
#pragma unroll
        for (int a = 0; a < 2; ++a)
#pragma unroll
            for (int b = 0; b < 2; ++b)
#pragma unroll
                for (int m = 0; m < 4; ++m)
#pragma unroll
                    for (int n = 0; n < 2; ++n) acc[a][b][m][n] = (f32x4){0.f, 0.f, 0.f, 0.f};
        cur = nxt; cA = nA; cB = nB; ++ui;
        if constexpr (ALIGN_EPI) { if (wr == 1) PG8_BAR; }
    }
    PG8_WAIT_V(0);
    if constexpr (!ALIGN_EPI) { if (wr == 0) PG8_BAR; }
    PG8_BAR;
    if constexpr (Epi::AFTER_DRAIN) { E.fused(acc, cur, wr, wc, fr, fq, lds, wid, lane); S.done(cur); }
#undef PG8_SA
#undef PG8_SB
#undef PG8_STAGE
#undef PG8_LDA
#undef PG8_LDB
#undef PG8_MMA
#undef PG8_WAIT_V
#undef PG8_WAIT_L
#undef PG8_BAR
#undef PG8_SCHED
}
}

namespace hy {
#define GAS __attribute__((address_space(1)))
#define LAS __attribute__((address_space(3)))
typedef unsigned short bf16;
typedef unsigned v4u __attribute__((ext_vector_type(4)));
typedef float f32x4 __attribute__((ext_vector_type(4)));
typedef short bf16x8 __attribute__((ext_vector_type(8)));
typedef GAS unsigned gu32;
typedef GAS unsigned long long gu64;
#define RLX_AGENT __ATOMIC_RELAXED, __HIP_MEMORY_SCOPE_AGENT
#define LDS_WAIT() asm volatile("s_waitcnt lgkmcnt(0)" ::: "memory")
#define VM_WAIT() asm volatile("s_waitcnt vmcnt(0)" ::: "memory")
__device__ __forceinline__ unsigned long long rt() { return __builtin_amdgcn_s_memrealtime(); }
typedef __bf16 hwbf2 __attribute__((ext_vector_type(2))); typedef float hwf2 __attribute__((ext_vector_type(2)));
__device__ __forceinline__ unsigned f2bf(float f) { return (unsigned)__builtin_bit_cast(unsigned short, (__bf16)f); }
__device__ __forceinline__ unsigned pk2(float lo, float hi) { const hwf2 v = {lo, hi}; return __builtin_bit_cast(unsigned, __builtin_convertvector(v, hwbf2)); }
#define XB_TMO      128
#define XB_XCNT(j)  (256  + 64 * (j))
#define XB_XSUB(j)  (1280 + 64 * (j))
#define XB_XGEN(j)  (2304 + 64 * (j))
#define XB_TOP      3328
#define XB_TOPGEN   3392
#define XCD_BAR_WORDS 3456
#define XB_SPIN_CAP (1u << 18)

__device__ __forceinline__ unsigned xb_ld(unsigned* p)              { return __hip_atomic_load(p, __ATOMIC_RELAXED, __HIP_MEMORY_SCOPE_AGENT); }
__device__ __forceinline__ unsigned xb_add(unsigned* p, unsigned v) { return __hip_atomic_fetch_add(p, v, __ATOMIC_RELAXED, __HIP_MEMORY_SCOPE_AGENT); }
__device__ __forceinline__ unsigned xb_xcc_id() { return (unsigned)__builtin_amdgcn_s_getreg((3 << 11) | 20) & 0xFu; }
#define XB_SPIN(cond, bar) do { unsigned _sp = 0; while (cond) { __builtin_amdgcn_s_sleep(1); \
    if ((++_sp & 255u) == 0u) { if (xb_ld(&(bar)[XB_TMO])) break; if (_sp > XB_SPIN_CAP) { atomicAdd(&(bar)[XB_TMO], 1u); break; } } } } while (0)

struct XcdBarrier {
    unsigned* bar; unsigned x;
    volatile LAS unsigned* st;
};

__device__ __forceinline__ XcdBarrier xcd_barrier_post(unsigned* bar, volatile LAS unsigned* st) {
    XcdBarrier b; b.bar = bar; b.x = xb_xcc_id(); b.st = st;
    if (threadIdx.x == 0) (void)xb_add(&bar[XB_XCNT(b.x)], 1u);
    return b;
}
__device__ __forceinline__ void xcd_barrier_complete(unsigned* bar, unsigned x, unsigned& nloc, unsigned& nx) {
    const unsigned G = gridDim.x * gridDim.y * gridDim.z;
    unsigned sum, cnt, mine, sp = 0u;
    for (;;) {
        sum = 0u; cnt = 0u; mine = 0u;
#pragma unroll
        for (unsigned j = 0; j < 16; ++j) { const unsigned c = xb_ld(&bar[XB_XCNT(j)]); sum += c; cnt += (c > 0u) ? 1u : 0u; mine = (j == x) ? c : mine; }
        if (sum == G) break;
        __builtin_amdgcn_s_sleep(1);
        if ((++sp & 255u) == 0u) { if (xb_ld(&bar[XB_TMO])) break; if (sp > XB_SPIN_CAP) { atomicAdd(&bar[XB_TMO], 1u); break; } }
    }
    nloc = mine > 0u ? mine : 1u; nx = cnt > 0u ? cnt : 1u;
}

__device__ __forceinline__ void xcd_barrier(const XcdBarrier& b, bool leader  ) {
    asm volatile("s_waitcnt vmcnt(0)" ::: "memory");
    __syncthreads();
    if (leader) {
        unsigned* bar = b.bar;
        __builtin_amdgcn_s_waitcnt(0);
        unsigned nloc = b.st[0], nx = b.st[1];
        if (nloc == 0u) { xcd_barrier_complete(bar, b.x, nloc, nx); b.st[0] = nloc; b.st[1] = nx; }
        const unsigned old = xb_add(&bar[XB_XSUB(b.x)], 1u);
        const unsigned gen = old / nloc;
        if (old + 1u == (gen + 1u) * nloc) {
            __builtin_amdgcn_fence(__ATOMIC_RELEASE, "agent");
            asm volatile("s_waitcnt vmcnt(0)" ::: "memory");
            const unsigned og = xb_add(&bar[XB_TOP], 1u);
            const unsigned tg = og / nx;
            if (og + 1u == (tg + 1u) * nx) xb_add(&bar[XB_TOPGEN], 1u);
            else XB_SPIN(xb_ld(&bar[XB_TOPGEN]) == tg, bar);
            __builtin_amdgcn_fence(__ATOMIC_ACQUIRE, "agent");
            xb_add(&bar[XB_XGEN(b.x)], 1u);
            asm volatile("s_waitcnt vmcnt(0)" ::: "memory");
        } else {
            XB_SPIN(xb_ld(&bar[XB_XGEN(b.x)]) == gen, bar);
            __builtin_amdgcn_fence(__ATOMIC_ACQUIRE, "agent");
            asm volatile("s_waitcnt vmcnt(0)" ::: "memory");
        }
    }
    __syncthreads();
}

constexpr int B_ = 4, T_ = 8192, D_ = 1024, M_ = B_ * T_, L_ = 2;
constexpr int NIN = 3584, NPG = 1792, NPR = 1792;
constexpr int DFF = 2816, NUP = 5632, IN_COLS = 3344;
constexpr size_t MiB = 1u << 20;
constexpr size_t WS_CTL = 0, CTL_ZERO_BYTES = 65536;
constexpr int CW_BAR = 4096;
constexpr size_t WS_RK = MiB / 4;
constexpr size_t WS_MOD = 3 * MiB / 2;
constexpr size_t WS_WIN = 2 * MiB, WS_WOUT = 9 * MiB, WS_WUP = 11 * MiB, WS_WDN = 22 * MiB, WS_LORA = 55 * MiB / 2, WS_GAMC = 28 * MiB, WS_VL = 29 * MiB;
constexpr size_t WS_GAM = 31 * MiB;
constexpr size_t WS_XB = 32 * MiB, WS_O = 96 * MiB, WS_VF = 160 * MiB, WS_GK = 192 * MiB, WS_PG = 224 * MiB, WS_PR = 336 * MiB, WS_END = 512 * MiB;
constexpr size_t WS_RH = WS_XB, WS_YH = WS_XB + 32 * MiB, WS_PP = WS_O, WS_QQ = WS_O + 32 * MiB, WS_GG = 448 * MiB, WS_S0 = 480 * MiB;
constexpr size_t WS_ACT = 224 * MiB, WS_U = 400 * MiB;
constexpr int RING_BYTES = 131072, MISC_OFF = 161792, LDS_BYTES = 163840;
constexpr int NT = 512;

__device__ __forceinline__ float bf2f(bf16 h) { return __builtin_bit_cast(float, (unsigned)h << 16); }
__device__ __forceinline__ float sigmoidf_(float x) { return 1.f / (1.f + __expf(-x)); }
__device__ __forceinline__ float siluf_(float x) { return x / (1.f + __expf(-x)); }
__device__ __forceinline__ float softplusf_(float x) { return fmaxf(x, 0.f) + log1pf(__expf(-fabsf(x))); }

typedef unsigned u32x2 __attribute__((ext_vector_type(2)));
template <int CTRL> __device__ __forceinline__ float dpp_f(float v) {
    return __builtin_bit_cast(float, __builtin_amdgcn_update_dpp(0, __builtin_bit_cast(int, v), CTRL, 0xf, 0xf, false));
}
__device__ __forceinline__ float wave_sum(float v) {
    v += dpp_f<0xB1>(v);
    v += dpp_f<0x4E>(v);
    v += dpp_f<0x141>(v);
    v += dpp_f<0x140>(v);
    v += __builtin_bit_cast(float, __builtin_amdgcn_update_dpp(0, __builtin_bit_cast(int, v), 0x142, 0xa, 0xf, false));
    v += __builtin_bit_cast(float, __builtin_amdgcn_update_dpp(0, __builtin_bit_cast(int, v), 0x143, 0xc, 0xf, false));
    return __builtin_bit_cast(float, __builtin_amdgcn_readlane(__builtin_bit_cast(int, v), 63));
}

__device__ __forceinline__ int lane_now() { int l; asm volatile("v_mbcnt_lo_u32_b32 %0, -1, 0\n\tv_mbcnt_hi_u32_b32 %0, -1, %0" : "=v"(l)); return l; }
struct Ctx { int bid, nb, tid, lane, wave; LAS unsigned char* lds; };

__device__ __forceinline__ void ph_mod(const Ctx& C, const float* c, const float* ada_w, const float* ada_b, float* MOD) {
    LAS float* sc = (LAS float*)C.lds;
    LAS float* red = (LAS float*)(C.lds + 16384);
    for (int i = C.tid; i < 4096; i += NT) sc[i] = siluf_(c[i]);
    __syncthreads();
    for (int item = C.bid; item < 192; item += C.nb) {
        const int l = item / 96, j0 = (item % 96) * 64;
        const float* W = ada_w + (size_t)l * 1024 * 6144 + j0 + C.lane;
        float a0 = 0.f, a1 = 0.f, a2 = 0.f, a3 = 0.f;
        for (int k = C.wave * 128; k < C.wave * 128 + 128; ++k) { const float wv = W[(size_t)k * 6144]; a0 += sc[k] * wv; a1 += sc[1024 + k] * wv; a2 += sc[2048 + k] * wv; a3 += sc[3072 + k] * wv; }
        red[(C.wave * 4 + 0) * 64 + C.lane] = a0; red[(C.wave * 4 + 1) * 64 + C.lane] = a1; red[(C.wave * 4 + 2) * 64 + C.lane] = a2; red[(C.wave * 4 + 3) * 64 + C.lane] = a3;
        __syncthreads();
        if (C.wave < 4) { const int b = C.wave; float s = ada_b[l * 6144 + j0 + C.lane];
#pragma unroll
            for (int w = 0; w < 8; ++w) s += red[(w * 4 + b) * 64 + C.lane];
            MOD[((size_t)l * 4 + b) * 6144 + j0 + C.lane] = s; }
        __syncthreads();
    }
}

__device__ __forceinline__ void wprep_mat(const Ctx& C, const float* W, int K, int Nsrc, int Ndst, bf16* Wt, int mode, const float* vres) {
    const int half = C.tid >> 8, t = C.tid & 255, tx = t & 31, ty = t >> 5;
    LAS float* tile = (LAS float*)C.lds + half * (32 * 33);
    const int nbn = Ndst / 32, ntile = nbn * (K / 32);
    const int niter = (ntile + 2 * C.nb - 1) / (2 * C.nb);
    for (int it = 0; it < niter; ++it) {
        const int item = (it * C.nb + C.bid) * 2 + half;
        const bool act = item < ntile;
        const int n0 = (item % nbn) * 32, k0 = (item / nbn) * 32, n = n0 + tx;
        if (act) {
#pragma unroll
            for (int i = 0; i < 4; ++i) { const int k = k0 + ty + 8 * i; float v = 0.f;
                if (mode == 0) v = W[(size_t)k * Nsrc + n];
                else if (mode == 2) { const int tl = n >> 8, w = n & 255; v = W[(size_t)k * Nsrc + (w < 128 ? tl * 128 + w : 2816 + tl * 128 + (w - 128))]; }
                else { if (n < 1552) v = W[(size_t)k * Nsrc + n]; else if (n < 1584) v = vres ? vres[(size_t)k * 32 + (n - 1552)] : 0.f; else if (n < 1792) v = 0.f; else v = W[(size_t)k * Nsrc + (n - 240)]; }
                tile[(ty + 8 * i) * 33 + tx] = v; }
        }
        __syncthreads();
        if (act) {
#pragma unroll
            for (int i = 0; i < 4; ++i) { const int nn = n0 + ty + 8 * i; Wt[(size_t)nn * K + k0 + tx] = (bf16)f2bf(tile[tx * 33 + ty + 8 * i]); }
        }
        __syncthreads();
    }
}

__device__ __forceinline__ void ph_norm(const Ctx& C, const float* x, const float* g, const float* sh, const float* sc, bf16* XB) {
    const int gw = C.bid * 8 + C.wave, NGW = C.nb * 8, lane = C.lane;
    for (int m = gw; m < M_; m += NGW) {
        const int b = m / T_;
        const f32x4* xr = (const f32x4*)(x + (size_t)m * D_) + lane;
        f32x4 v[4]; float s = 0.f;
#pragma unroll
        for (int j = 0; j < 4; ++j) { v[j] = xr[64 * j]; s += (v[j].x * v[j].x + v[j].y * v[j].y) + (v[j].z * v[j].z + v[j].w * v[j].w); }
        const float rstd = 1.f / sqrtf(wave_sum(s) * (1.f / D_) + 1e-6f);
        unsigned long long* o8 = (unsigned long long*)(XB + (size_t)m * D_) + lane;
#pragma unroll
        for (int j = 0; j < 4; ++j) { const int col = 4 * lane + 256 * j;
            const f32x4 gv = *(const f32x4*)(g + col), shv = *(const f32x4*)(sh + b * 6144 + col), scv = *(const f32x4*)(sc + b * 6144 + col);
            const f32x4 h = v[j] * rstd * gv * (scv + 1.f) + shv;
            o8[64 * j] = (unsigned long long)pk2(h.x, h.y) | ((unsigned long long)pk2(h.z, h.w) << 32); }
    }
}
__device__ __forceinline__ void ph_final(const Ctx& C, float* x, const float* g) {
    const int gw = C.bid * 8 + C.wave, NGW = C.nb * 8, lane = C.lane;
    for (int m = gw; m < M_; m += NGW) {
        f32x4* xr = (f32x4*)(x + (size_t)m * D_) + lane;
        f32x4 v[4]; float s = 0.f;
#pragma unroll
        for (int j = 0; j < 4; ++j) { v[j] = xr[64 * j]; s += (v[j].x * v[j].x + v[j].y * v[j].y) + (v[j].z * v[j].z + v[j].w * v[j].w); }
        const float rstd = 1.f / sqrtf(wave_sum(s) * (1.f / D_) + 1e-6f);
#pragma unroll
        for (int j = 0; j < 4; ++j) { const f32x4 gv = *(const f32x4*)(g + 4 * lane + 256 * j); xr[64 * j] = v[j] * rstd * gv; }
    }
}


typedef short s16x8 __attribute__((ext_vector_type(8)));
__device__ __forceinline__ f32x4 mm16(const LAS bf16* A, int lda, const LAS bf16* B, int ldb, int K, f32x4 acc, int lane) {
    const int r = lane & 15, g = lane >> 4;
    const LAS bf16* ap = A + r * lda + 8 * g; const LAS bf16* bp = B + r * ldb + 8 * g;
    for (int k0 = 0; k0 < K; k0 += 32) { const s16x8 a = *(const LAS s16x8*)(ap + k0); const s16x8 b = *(const LAS s16x8*)(bp + k0); acc = __builtin_amdgcn_mfma_f32_16x16x32_bf16(a, b, acc, 0, 0, 0); }
    return acc;
}
__device__ __forceinline__ f32x4 mm16_ga(const bf16* A, int lda, const LAS bf16* B, int ldb, int K, f32x4 acc, int lane) {
    const int r = lane & 15, g = lane >> 4;
    const bf16* ap = A + r * lda + 8 * g; const LAS bf16* bp = B + r * ldb + 8 * g;
    for (int k0 = 0; k0 < K; k0 += 32) { const s16x8 a = *(const s16x8*)(ap + k0); const s16x8 b = *(const LAS s16x8*)(bp + k0); acc = __builtin_amdgcn_mfma_f32_16x16x32_bf16(a, b, acc, 0, 0, 0); }
    return acc;
}
__device__ __forceinline__ unsigned long long pack4(f32x4 v) { return (unsigned long long)pk2(v.x, v.y) | ((unsigned long long)pk2(v.z, v.w) << 32); }
__device__ __forceinline__ float logsigmoidf_(float x) { return fminf(x, 0.f) - __logf(1.f + __expf(-fabsf(x))); }

constexpr int GL_LD = 72;
constexpr int GL_GK = 0;
constexpr int GL_SEG = 16384;
constexpr int GL_Z = 18432;
constexpr int GL_GUP = 20480;
constexpr int GL_I0 = 24832;
constexpr int GL_I1 = GL_I0 + 9216;
constexpr int GL_I2 = GL_I1 + 9216;
constexpr int GL_VT = GL_I2 + 9216;
constexpr int GL_SSQ = GL_VT + 18432;
static_assert(GL_SSQ + 512 <= RING_BYTES, "GLA LDS map");

struct GlaRaw { v4u z, k, q, v0, v1; float g0, g1, gb; };
__device__ __forceinline__ void gla_fetch(GlaRaw& R, const Ctx& C, const bf16* pg, const float* gk_up, const float* gk_b, int h, bool want_q) {
    const int tid = C.tid, j = tid >> 3, d0 = (tid & 7) * 8, e0 = (tid & 7) * 16;
    R.z = (v4u){0u, 0u, 0u, 0u}; R.q = R.z;
    if (tid < 128) R.z = *(const v4u*)(pg + (size_t)(tid >> 1) * NPG + 1536 + (tid & 1) * 8);
    R.g0 = gk_up[(tid >> 6) * 256 + h * 64 + (tid & 63)]; R.g1 = gk_up[((tid + NT) >> 6) * 256 + h * 64 + (tid & 63)]; R.gb = gk_b[h * 64 + (tid & 63)];
    R.k = *(const v4u*)(pg + (size_t)j * NPG + 256 + h * 64 + d0);
    if (want_q) R.q = *(const v4u*)(pg + (size_t)j * NPG + h * 64 + d0);
    R.v0 = *(const v4u*)(pg + (size_t)j * NPG + 512 + h * 128 + e0); R.v1 = *(const v4u*)(pg + (size_t)j * NPG + 512 + h * 128 + e0 + 8);
}
__device__ __forceinline__ void gla_gates(const Ctx& C, const GlaRaw& R) {
    LAS float* GK = (LAS float*)(C.lds + GL_GK); LAS float* SEG = (LAS float*)(C.lds + GL_SEG); LAS bf16* Z = (LAS bf16*)(C.lds + GL_Z); LAS float* GUP = (LAS float*)(C.lds + GL_GUP);
    const int tid = C.tid;
    if (tid < 128) { const int t = tid >> 1, hh = tid & 1; *(LAS v4u*)(Z + t * 16 + hh * 8) = R.z; }
    GUP[tid] = R.g0; GUP[tid + NT] = R.g1;
    if (tid < 64) GUP[1024 + tid] = R.gb;
    __syncthreads();
    { const int t = tid >> 3, d0 = (tid & 7) * 8; float a[8];
#pragma unroll
      for (int q = 0; q < 8; ++q) a[q] = GUP[1024 + d0 + q];
#pragma unroll
      for (int i = 0; i < 16; ++i) { const float zv = bf2f(Z[t * 16 + i]);
#pragma unroll
          for (int q = 0; q < 8; ++q) a[q] += zv * GUP[i * 64 + d0 + q]; }
#pragma unroll
      for (int q = 0; q < 8; ++q) GK[t * 64 + d0 + q] = logsigmoidf_(a[q]) * (1.f / 16.f); }
    __syncthreads();
    { const int d = tid & 63, seg = tid >> 6; float run = 0.f;
#pragma unroll
      for (int q = 0; q < 8; ++q) { run += GK[(seg * 8 + q) * 64 + d]; GK[(seg * 8 + q) * 64 + d] = run; }
      SEG[seg * 64 + d] = run; }
    __syncthreads();
    { const int d = tid & 63, seg = tid >> 6; float off = 0.f;
      for (int s = 0; s < seg; ++s) off += SEG[s * 64 + d];
#pragma unroll
      for (int q = 0; q < 8; ++q) GK[(seg * 8 + q) * 64 + d] += off; }
    __syncthreads();
}
__device__ __forceinline__ void gla_stage_vt(const Ctx& C, const GlaRaw& R) {
    LAS bf16* VT = (LAS bf16*)(C.lds + GL_VT);
    const int j = C.tid >> 3, e0 = (C.tid & 7) * 16;
    const unsigned w[8] = {R.v0.x, R.v0.y, R.v0.z, R.v0.w, R.v1.x, R.v1.y, R.v1.z, R.v1.w};
#pragma unroll
    for (int q = 0; q < 8; ++q) { VT[(e0 + 2 * q) * GL_LD + j] = (bf16)(w[q] & 0xffffu); VT[(e0 + 2 * q + 1) * GL_LD + j] = (bf16)(w[q] >> 16); }
}

__device__ __forceinline__ void ph_gla_a(const Ctx& C, const bf16* PG, const float* gk_up, const float* gk_b, bf16* DS, float* GAM) {
    LAS float* GK = (LAS float*)(C.lds + GL_GK); LAS bf16* KT = (LAS bf16*)(C.lds + GL_I0); LAS bf16* VT = (LAS bf16*)(C.lds + GL_VT);
    for (int item = C.bid; item < 2048; item += C.nb) {
        const int bh = item >> 7, c = item & 127, b = bh >> 2, h = bh & 3;
        const size_t m0 = (size_t)b * T_ + c * 64;
        const bf16* pg = PG + m0 * NPG;
        GlaRaw R; gla_fetch(R, C, pg, gk_up, gk_b, h, false);
        gla_gates(C, R);
        { const int j = C.tid >> 3, d0 = (C.tid & 7) * 8;
          const unsigned w[4] = {R.k.x, R.k.y, R.k.z, R.k.w};
#pragma unroll
          for (int q = 0; q < 4; ++q) { const float k0 = bf2f((bf16)(w[q] & 0xffffu)), k1 = bf2f((bf16)(w[q] >> 16));
              const int d = d0 + 2 * q;
              KT[d * GL_LD + j] = (bf16)f2bf(k0 * __expf(GK[63 * 64 + d] - GK[j * 64 + d]));
              KT[(d + 1) * GL_LD + j] = (bf16)f2bf(k1 * __expf(GK[63 * 64 + d + 1] - GK[j * 64 + d + 1])); } }
        gla_stage_vt(C, R);
        if (C.tid < 64) GAM[(size_t)item * 64 + C.tid] = __expf(GK[63 * 64 + C.tid]);
        __syncthreads();
        { const int n0 = C.wave * 16, lane = C.lane, cc = lane & 15, g = lane >> 4;
          bf16* out = DS + (size_t)item * 8192 + (size_t)(n0 + cc) * 64 + 4 * g;
#pragma unroll
          for (int mt = 0; mt < 4; ++mt) { f32x4 acc = {0.f, 0.f, 0.f, 0.f}; acc = mm16(KT + mt * 16 * GL_LD, GL_LD, VT + n0 * GL_LD, GL_LD, 64, acc, lane);
              *(unsigned long long*)(out + mt * 16) = pack4(acc); } }
        __syncthreads();
    }
}
__device__ __forceinline__ void ph_gla_b(const Ctx& C, bf16* DS, const float* GAM) {
    for (int idx = C.bid * NT + C.tid; idx < 16 * 8192; idx += C.nb * NT) {
        const int bh = idx >> 13, ed = idx & 8191, d = ed & 63;
        bf16* p = DS + (size_t)bh * 128 * 8192 + ed; const float* gp = GAM + (size_t)bh * 128 * 64 + d;
        float S = 0.f;
        for (int c0 = 0; c0 < 128; c0 += 8) {
            float ds[8], gm[8];
#pragma unroll
            for (int i = 0; i < 8; ++i) { ds[i] = bf2f(p[(size_t)(c0 + i) * 8192]); gm[i] = gp[(c0 + i) * 64]; }
#pragma unroll
            for (int i = 0; i < 8; ++i) { const float gs = gm[i] * S; p[(size_t)(c0 + i) * 8192] = (bf16)f2bf(gs); S = gs + ds[i]; }
        }
    }
}
__device__ __forceinline__ void ph_gla_c(const Ctx& C, const bf16* PG, const float* gk_up, const float* gk_b, const float* norm_g, const bf16* DS, bf16* O) {
    LAS float* GK = (LAS float*)(C.lds + GL_GK); LAS bf16* QP = (LAS bf16*)(C.lds + GL_I0); LAS bf16* KM = (LAS bf16*)(C.lds + GL_I1); LAS bf16* AI = (LAS bf16*)(C.lds + GL_I2);
    LAS bf16* VT = (LAS bf16*)(C.lds + GL_VT); LAS float* SSQ = (LAS float*)(C.lds + GL_SSQ);
    for (int item = C.bid; item < 2048; item += C.nb) {
        const int bh = item >> 7, c = item & 127, b = bh >> 2, h = bh & 3;
        const size_t m0 = (size_t)b * T_ + c * 64;
        const bf16* pg = PG + m0 * NPG;
        GlaRaw R; gla_fetch(R, C, pg, gk_up, gk_b, h, true);
        s16x8 sfrag[4][2];
        { const int lane = C.lane, cc = lane & 15, g = lane >> 4, eh = C.wave >> 2; const bf16* Sg = DS + (size_t)item * 8192;
#pragma unroll
          for (int mt = 0; mt < 4; ++mt) { sfrag[mt][0] = *(const s16x8*)(Sg + (size_t)(eh * 64 + mt * 16 + cc) * 64 + 8 * g); sfrag[mt][1] = *(const s16x8*)(Sg + (size_t)(eh * 64 + mt * 16 + cc) * 64 + 32 + 8 * g); } }
        gla_gates(C, R);
        { const int j = C.tid >> 3, d0 = (C.tid & 7) * 8;
          const v4u qx = R.q, kx = R.k;
          const unsigned qw[4] = {qx.x, qx.y, qx.z, qx.w}, kw[4] = {kx.x, kx.y, kx.z, kx.w};
          unsigned qo[4], ko[4];
#pragma unroll
          for (int q = 0; q < 4; ++q) { const int d = d0 + 2 * q;
              const float e0 = GK[63 * 64 + d] - GK[j * 64 + d], e1 = GK[63 * 64 + d + 1] - GK[j * 64 + d + 1];
              const float q0 = 0.125f * bf2f((bf16)(qw[q] & 0xffffu)) * __expf(-e0), q1 = 0.125f * bf2f((bf16)(qw[q] >> 16)) * __expf(-e1);
              const float k0 = bf2f((bf16)(kw[q] & 0xffffu)) * __expf(e0), k1 = bf2f((bf16)(kw[q] >> 16)) * __expf(e1);
              qo[q] = pk2(q0, q1); ko[q] = pk2(k0, k1); }
          *(LAS v4u*)(QP + j * GL_LD + d0) = (v4u){qo[0], qo[1], qo[2], qo[3]}; *(LAS v4u*)(KM + j * GL_LD + d0) = (v4u){ko[0], ko[1], ko[2], ko[3]}; }
        gla_stage_vt(C, R);
        __syncthreads();
        { const int lane = C.lane, cc = lane & 15, g = lane >> 4, n0 = (C.wave >> 1) * 16;
#pragma unroll
          for (int q = 0; q < 2; ++q) { const int mt0 = ((C.wave & 1) * 2 + q) * 16; f32x4 acc = {0.f, 0.f, 0.f, 0.f};
              acc = mm16(KM + mt0 * GL_LD, GL_LD, QP + n0 * GL_LD, GL_LD, 64, acc, lane);
              const int i = n0 + cc, j = mt0 + 4 * g;
              acc.x = (j + 0 <= i) ? acc.x : 0.f; acc.y = (j + 1 <= i) ? acc.y : 0.f; acc.z = (j + 2 <= i) ? acc.z : 0.f; acc.w = (j + 3 <= i) ? acc.w : 0.f;
              *(LAS unsigned long long*)(AI + (n0 + cc) * GL_LD + mt0 + 4 * g) = pack4(acc); } }
        __syncthreads();
        { const int lane = C.lane, cc = lane & 15, g = lane >> 4, n0 = (C.wave & 3) * 16, eh = C.wave >> 2;
          f32x4 acc[4]; float ss = 0.f;
#pragma unroll
          for (int mt = 0; mt < 4; ++mt) { const int e0 = eh * 64 + mt * 16; acc[mt] = (f32x4){0.f, 0.f, 0.f, 0.f};
              { const LAS bf16* bp = QP + (n0 + cc) * GL_LD + 8 * g;
                acc[mt] = __builtin_amdgcn_mfma_f32_16x16x32_bf16(sfrag[mt][0], *(const LAS s16x8*)bp, acc[mt], 0, 0, 0); acc[mt] = __builtin_amdgcn_mfma_f32_16x16x32_bf16(sfrag[mt][1], *(const LAS s16x8*)(bp + 32), acc[mt], 0, 0, 0); }
              acc[mt] = mm16(VT + e0 * GL_LD, GL_LD, AI + n0 * GL_LD, GL_LD, 64, acc[mt], lane);
              ss += (acc[mt].x * acc[mt].x + acc[mt].y * acc[mt].y) + (acc[mt].z * acc[mt].z + acc[mt].w * acc[mt].w); }
          ss += __shfl_xor(ss, 16); ss += __shfl_xor(ss, 32);
          if (g == 0) SSQ[eh * 64 + n0 + cc] = ss;
          __syncthreads();
          const float rstd = 1.f / sqrtf((SSQ[n0 + cc] + SSQ[64 + n0 + cc]) * (1.f / 128.f) + 1e-6f);
          const size_t m = m0 + n0 + cc;
#pragma unroll
          for (int mt = 0; mt < 4; ++mt) { const int e = eh * 64 + mt * 16 + 4 * g;
              const unsigned long long gx = *(const unsigned long long*)(pg + (size_t)(n0 + cc) * NPG + 1024 + h * 128 + e);
              const f32x4 ng = *(const f32x4*)(norm_g + e);
              f32x4 o;
              o.x = acc[mt].x * rstd * ng.x * siluf_(bf2f((bf16)(gx & 0xffffu)));
              o.y = acc[mt].y * rstd * ng.y * siluf_(bf2f((bf16)((gx >> 16) & 0xffffu)));
              o.z = acc[mt].z * rstd * ng.z * siluf_(bf2f((bf16)((gx >> 32) & 0xffffu)));
              o.w = acc[mt].w * rstd * ng.w * siluf_(bf2f((bf16)(gx >> 48)));
              *(unsigned long long*)(O + m * D_ + h * 128 + e) = pack4(o); } }
        __syncthreads();
    }
}


struct RwkvW { const float *mu, *mu_vres, *w0, *a0, *v0, *k_k, *k_a, *r_k; const bf16 *wupT, *aupT, *gupT, *vupT; };
constexpr int RW_LD = 72, RW_XLD = 296;
constexpr int RW_R0 = 0;
constexpr int RW_SEG = 16384;
constexpr int RW_R1 = 36864;
constexpr int RW_R2 = RW_R1 + 27648;
constexpr int RW_R3 = RW_R2 + 9216;
constexpr int RW_R4 = RW_R3 + 27648;
constexpr int RW_TI = RW_R4 + 128 * RW_LD * 2;
constexpr int RW_MU = RW_TI + 2048;
constexpr int RW_X = RW_MU + 2048;
constexpr int RW_END = RW_X + 64 * RW_XLD * 2;
static_assert(RW_END <= MISC_OFF, "RWKV LDS map");

typedef short s16x4 __attribute__((ext_vector_type(4)));
__device__ __forceinline__ float tanh_fast(float x) { const float e = __expf(2.f * x); return 1.f - 2.f / (e + 1.f); }
__device__ __forceinline__ float softplus_fast(float x) { return fmaxf(x, 0.f) + __logf(1.f + __expf(-fabsf(x))); }
__device__ __forceinline__ s16x4 cvt4(f32x4 v) { const unsigned long long p = pack4(v); return __builtin_bit_cast(s16x4, p); }
__device__ __forceinline__ void ld8f(const float* p, float (&o)[8]) { const f32x4 a = *(const f32x4*)p, b = *(const f32x4*)(p + 4); o[0] = a.x; o[1] = a.y; o[2] = a.z; o[3] = a.w; o[4] = b.x; o[5] = b.y; o[6] = b.z; o[7] = b.w; }
__device__ __forceinline__ float sum8(float v) { v += dpp_f<0xB1>(v); v += dpp_f<0x4E>(v); v += dpp_f<0x141>(v); return v; }
__device__ __forceinline__ void unpack8(const v4u x, float (&o)[8]) {
    o[0] = bf2f((bf16)(x.x & 0xffffu)); o[1] = bf2f((bf16)(x.x >> 16)); o[2] = bf2f((bf16)(x.y & 0xffffu)); o[3] = bf2f((bf16)(x.y >> 16));
    o[4] = bf2f((bf16)(x.z & 0xffffu)); o[5] = bf2f((bf16)(x.z >> 16)); o[6] = bf2f((bf16)(x.w & 0xffffu)); o[7] = bf2f((bf16)(x.w >> 16)); }
__device__ __forceinline__ v4u pack8(const float (&o)[8]) { return (v4u){pk2(o[0], o[1]), pk2(o[2], o[3]), pk2(o[4], o[5]), pk2(o[6], o[7])}; }
__device__ __forceinline__ f32x4 mm16_gb(const LAS bf16* A, int lda, const bf16* B, int ldb, int K, f32x4 acc, int lane) {
    const int r = lane & 15, g = lane >> 4;
    const LAS bf16* ap = A + r * lda + 8 * g; const bf16* bp = B + r * ldb + 8 * g;
    for (int k0 = 0; k0 < K; k0 += 32) { const s16x8 a = *(const LAS s16x8*)(ap + k0); const s16x8 b = *(const s16x8*)(bp + k0); acc = __builtin_amdgcn_mfma_f32_16x16x32_bf16(a, b, acc, 0, 0, 0); }
    return acc;
}

__device__ __forceinline__ void ph_rwkv_a(const Ctx& C, const bf16* PR, const bf16* VL  , const RwkvW& W, int layer,
                                          bf16* PP, bf16* QQ, bf16* RH, bf16* YH, float* GAMC, float* RK, bf16* GG, bf16* VF, bool store_v = true) {
    LAS unsigned char* L = C.lds;
    LAS bf16* X = (LAS bf16*)(L + RW_X); LAS float* CUM = (LAS float*)(L + RW_R0); LAS float* SEG = (LAS float*)(L + RW_SEG);
    LAS bf16* NI = (LAS bf16*)(L + RW_R0), *AAK = NI + 64 * RW_LD, *ARB = AAK + 64 * RW_LD, *ARK = ARB + 64 * RW_LD;
    LAS bf16* PRE = (LAS bf16*)(L + RW_R1);
    LAS bf16* AT = (LAS bf16*)(L + RW_R1), *BT = AT + 64 * RW_LD, *KT = BT + 64 * RW_LD, *RT = (LAS bf16*)(L + RW_R2);
    LAS bf16* XB16 = (LAS bf16*)(L + RW_R1);
    LAS bf16* BHc = (LAS bf16*)(L + RW_R3), *KHc = BHc + 64 * RW_LD, *VTc = KHc + 64 * RW_LD;
    LAS bf16* XT = (LAS bf16*)(L + RW_R4); LAS bf16* TI = (LAS bf16*)(L + RW_TI);
    const int wave = C.wave;
    LAS float* MU = (LAS float*)(L + RW_MU);
    for (int i = C.tid; i < 288; i += NT) MU[i] = i < 256 ? W.mu[1536 + i] : (layer ? W.mu_vres[i - 256] : 0.f);
    __syncthreads();
    for (int bc = C.bid; bc < 512; bc += C.nb) {
        const int c = bc & 127, b = bc >> 7;
        const size_t m0 = (size_t)b * T_ + c * 64;
        { const int tid = C.tid;
          v4u xc[5], xp[5];
#pragma unroll
          for (int it = 0; it < 5; ++it) { const int idx = tid + it * NT; xc[it] = (v4u){0u, 0u, 0u, 0u}; xp[it] = xc[it];
            if (idx < 64 * 36) { const int t1 = idx / 36, q = idx % 36, col = q * 8; const size_t m1 = m0 + t1; const bool first1 = (c == 0 && t1 == 0);
                if (q < 32) { xc[it] = *(const v4u*)(PR + m1 * NPR + 1536 + col); if (!first1) xp[it] = *(const v4u*)(PR + (m1 - 1) * NPR + 1536 + col); }
                else if (layer) { xc[it] = *(const v4u*)(VL + m1 * NPG + 1552 + (col - 256)); if (!first1) xp[it] = *(const v4u*)(VL + (m1 - 1) * NPG + 1552 + (col - 256)); } } }
#pragma unroll
          for (int it = 0; it < 5; ++it) { const int idx = tid + it * NT;
            if (idx < 64 * 36) { const int t1 = idx / 36, q = idx % 36, col = q * 8;
                float cv[8], pv[8], mu[8]; unpack8(xc[it], cv); unpack8(xp[it], pv);
                { const f32x4 ma = *(const LAS f32x4*)(MU + col), mb = *(const LAS f32x4*)(MU + col + 4); mu[0] = ma.x; mu[1] = ma.y; mu[2] = ma.z; mu[3] = ma.w; mu[4] = mb.x; mu[5] = mb.y; mu[6] = mb.z; mu[7] = mb.w; }
#pragma unroll
                for (int i = 0; i < 8; ++i) { float p = cv[i] + (pv[i] - cv[i]) * mu[i]; if (q < 8) p = tanh_fast(p); else if (q >= 16 && q < 32) p = sigmoidf_(p); cv[i] = p; }
                *(LAS v4u*)(X + t1 * RW_XLD + col) = pack8(cv); } }
        }
        __syncthreads();
#pragma unroll 1
      for (int h = 0; h < 8; ++h) {
        const int item = bc * 8 + h;
        int tid_ = C.tid; asm volatile("" : "+v"(tid_));
        const int tid = tid_, lane = tid & 63, cc = lane & 15, g = lane >> 4;
        const int t = tid >> 3, d0 = (tid & 7) * 8, ch = h * 64 + d0; const size_t m = m0 + t; const bool first = (c == 0 && t == 0);
        v4u rcx = *(const v4u*)(PR + m * NPR + ch), kcx = *(const v4u*)(PR + m * NPR + 512 + ch), vcx = *(const v4u*)(PR + m * NPR + 1024 + ch);
        v4u rpx = (v4u){0u, 0u, 0u, 0u}, kpx = rpx, vpx = rpx, vfx = rpx;
        if (!first) { rpx = *(const v4u*)(PR + (m - 1) * NPR + ch); kpx = *(const v4u*)(PR + (m - 1) * NPR + 512 + ch); vpx = *(const v4u*)(PR + (m - 1) * NPR + 1024 + ch); }
        if (layer) vfx = *(const v4u*)(VF + m * 512 + ch);
        {
            const int lsel = wave >> 1;
            const bf16* WT = lsel == 0 ? W.wupT : lsel == 1 ? W.aupT : lsel == 2 ? W.gupT : W.vupT;
            const int Kl = lsel == 2 ? 128 : lsel == 3 ? 32 : 64, xoff = lsel == 0 ? 0 : lsel == 1 ? 64 : lsel == 2 ? 128 : 256;
            LAS bf16* outp = PRE + lsel * 64 * RW_LD;
            const bool live = (lsel != 3 || layer);
#pragma unroll
            for (int mq = 0; mq < 2; ++mq) { const int mt = (wave & 1) * 2 + mq;
                s16x8 af[4];
                const bf16* ap = WT + (size_t)(h * 64 + mt * 16 + cc) * Kl + 8 * g;
#pragma unroll
                for (int ks = 0; ks < 4; ++ks) af[ks] = (live && ks * 32 < Kl) ? *(const s16x8*)(ap + ks * 32) : (s16x8){0, 0, 0, 0, 0, 0, 0, 0};
#pragma unroll
                for (int nt = 0; nt < 4; ++nt) { f32x4 acc = {0.f, 0.f, 0.f, 0.f};
                    const LAS bf16* bp = X + (nt * 16 + cc) * RW_XLD + xoff + 8 * g;
#pragma unroll
                    for (int ks = 0; ks < 4; ++ks) if (ks * 32 < Kl) { const s16x8 bb = *(const LAS s16x8*)(bp + ks * 32); acc = __builtin_amdgcn_mfma_f32_16x16x32_bf16(af[ks], bb, acc, 0, 0, 0); }
                    *(LAS unsigned long long*)(outp + (nt * 16 + cc) * RW_LD + mt * 16 + 4 * g) = pack4(acc); } }
        }
        __syncthreads();
        float av[8], bv[8], kv[8], rv[8], lw[8], vv[8];
        {
            float rc[8], rp[8], kc[8], kp[8], vc[8], vp[8], pw[8], pa[8], pg_[8], pvg[8];
            unpack8(rcx, rc); unpack8(kcx, kc); unpack8(vcx, vc); unpack8(rpx, rp); unpack8(kpx, kp); unpack8(vpx, vp);
            unpack8(*(const LAS v4u*)(PRE + (0 * 64 + t) * RW_LD + d0), pw); unpack8(*(const LAS v4u*)(PRE + (1 * 64 + t) * RW_LD + d0), pa);
            unpack8(*(const LAS v4u*)(PRE + (2 * 64 + t) * RW_LD + d0), pg_); unpack8(*(const LAS v4u*)(PRE + (3 * 64 + t) * RW_LD + d0), pvg);
            float vf[8]; unpack8(vfx, vf);
            float ssq = 0.f, rks = 0.f, asg[8], gg[8];
            float mur[8], muk[8], muv[8], w0c[8], a0c[8], v0c[8], kkc[8], kac[8], rkc[8];
            ld8f(W.mu + ch, mur); ld8f(W.mu + 512 + ch, muk); ld8f(W.mu + 1024 + ch, muv); ld8f(W.w0 + ch, w0c); ld8f(W.a0 + ch, a0c);
            ld8f(W.k_k + ch, kkc); ld8f(W.k_a + ch, kac); ld8f(W.r_k + ch, rkc);
            if (layer) ld8f(W.v0 + ch, v0c);
#pragma unroll
            for (int i = 0; i < 8; ++i) {
                const float r = rc[i] + (rp[i] - rc[i]) * mur[i], k = kc[i] + (kp[i] - kc[i]) * muk[i]; float v = vc[i] + (vp[i] - vc[i]) * muv[i];
                lw[i] = -0.6065306597f * sigmoidf_(w0c[i] + pw[i]);
                asg[i] = sigmoidf_(a0c[i] + pa[i]);
                if (layer) v = v + (vf[i] - v) * sigmoidf_(v0c[i] + pvg[i]);
                const float kk = k * kkc[i]; ssq += kk * kk;
                kv[i] = k * (1.f + (asg[i] - 1.f) * kac[i]); rv[i] = r; vv[i] = v; gg[i] = pg_[i]; av[i] = kk;
                rks += r * kv[i] * rkc[i];
            }
            ssq = sum8(ssq); rks = sum8(rks);
            const float inv = 1.f / sqrtf(fmaxf(ssq, 1e-24f));
#pragma unroll
            for (int i = 0; i < 8; ++i) { const float kk = av[i] * inv; av[i] = -kk; bv[i] = kk * asg[i]; }
            if ((tid & 7) == 0) RK[m * 8 + h] = rks;
            *(v4u*)(GG + m * 512 + ch) = pack8(gg);
            if (store_v) *(v4u*)(VF + m * 512 + ch) = pack8(vv);
#pragma unroll
            for (int i = 0; i < 8; ++i) vv[i] = bf2f((bf16)f2bf(vv[i]));
        }
        __syncthreads();
#pragma unroll
        for (int i = 0; i < 8; ++i) CUM[t * 64 + d0 + i] = lw[i];
        __syncthreads();
        { const int d = tid & 63, seg = tid >> 6; float run = 0.f;
#pragma unroll
          for (int q = 0; q < 8; ++q) { run += CUM[(seg * 8 + q) * 64 + d]; CUM[(seg * 8 + q) * 64 + d] = run; }
          SEG[seg * 64 + d] = run; }
        __syncthreads();
        { const int d = tid & 63, seg = tid >> 6; float off = 0.f;
          for (int s = 0; s < seg; ++s) off += SEG[s * 64 + d];
#pragma unroll
          for (int q = 0; q < 8; ++q) CUM[(seg * 8 + q) * 64 + d] += off; }
        __syncthreads();
        {
            float at[8], bt[8], kt[8], rt[8];
#pragma unroll
            for (int i = 0; i < 8; ++i) { const float cu = CUM[t * 64 + d0 + i], cC = CUM[63 * 64 + d0 + i], en = __expf(-cu), ec = __expf(cC - cu);
                at[i] = av[i] * __expf(cu - lw[i]); bt[i] = bv[i] * en; kt[i] = kv[i] * en; rt[i] = rv[i] * __expf(cu);
                BHc[(d0 + i) * RW_LD + t] = (bf16)f2bf(bv[i] * ec); KHc[(d0 + i) * RW_LD + t] = (bf16)f2bf(kv[i] * ec); VTc[(d0 + i) * RW_LD + t] = (bf16)f2bf(vv[i]);
                XT[(d0 + i) * RW_LD + t] = (bf16)f2bf(at[i]);
                if (t == 63) GAMC[(size_t)item * 64 + d0 + i] = __expf(cC); }
            *(LAS v4u*)(AT + t * RW_LD + d0) = pack8(at); *(LAS v4u*)(BT + t * RW_LD + d0) = pack8(bt); *(LAS v4u*)(KT + t * RW_LD + d0) = pack8(kt); *(LAS v4u*)(RT + t * RW_LD + d0) = pack8(rt);
        }
        __syncthreads();
        {
            const int msel = wave >> 1;
            const LAS bf16* As = (msel == 0 || msel == 2) ? BT : KT; const LAS bf16* Bs = (msel < 2) ? AT : RT;
            f32x4 accs[8];
#pragma unroll
            for (int q = 0; q < 8; ++q) { const int tile = (wave & 1) * 8 + q, mt = tile >> 2, nt = tile & 3; accs[q] = (f32x4){0.f, 0.f, 0.f, 0.f};
                accs[q] = mm16(As + mt * 16 * RW_LD, RW_LD, Bs + nt * 16 * RW_LD, RW_LD, 64, accs[q], lane);
                const int tt = nt * 16 + cc, s0 = mt * 16 + 4 * g, lim = (msel < 2) ? tt - 1 : tt;
                accs[q].x = (s0 + 0 <= lim) ? accs[q].x : 0.f; accs[q].y = (s0 + 1 <= lim) ? accs[q].y : 0.f; accs[q].z = (s0 + 2 <= lim) ? accs[q].z : 0.f; accs[q].w = (s0 + 3 <= lim) ? accs[q].w : 0.f; }
            __syncthreads();
            LAS bf16* outp = NI + msel * 64 * RW_LD;
#pragma unroll
            for (int q = 0; q < 8; ++q) { const int tile = (wave & 1) * 8 + q, mt = tile >> 2, nt = tile & 3;
                *(LAS unsigned long long*)(outp + (nt * 16 + cc) * RW_LD + mt * 16 + 4 * g) = pack4(accs[q]); }
        }
        __syncthreads();
        if (wave == 0) {
            const int blk = lane >> 4, col = lane & 15; float x[16];
#pragma unroll
            for (int tt = 0; tt < 16; ++tt) { float nr[16]; { float lo[8], hi[8]; unpack8(*(const LAS v4u*)(NI + (16 * blk + tt) * RW_LD + 16 * blk), lo); unpack8(*(const LAS v4u*)(NI + (16 * blk + tt) * RW_LD + 16 * blk + 8), hi);
#pragma unroll
                    for (int q = 0; q < 8; ++q) { nr[q] = lo[q]; nr[8 + q] = hi[q]; } }
                float a = (tt == col) ? 1.f : 0.f;
#pragma unroll
                for (int q = 0; q < tt; ++q) a += nr[q] * x[q];
                x[tt] = a; TI[(blk * 16 + tt) * 16 + col] = (bf16)f2bf(a); }
        } else {
            for (int tile = wave - 1; tile < 16; tile += 7) { const int mt = tile >> 2, nt = tile & 3;
                f32x4 acc = {0.f, 0.f, 0.f, 0.f}; acc = mm16(AAK + mt * 16 * RW_LD, RW_LD, VTc + nt * 16 * RW_LD, RW_LD, 64, acc, lane);
                *(LAS unsigned long long*)(XT + (64 + nt * 16 + cc) * RW_LD + mt * 16 + 4 * g) = pack4(acc); }
        }
        __syncthreads();
        {
            s16x4 xb[4];
#pragma unroll
            for (int i = 0; i < 4; ++i) {
                f32x4 acc; { const unsigned long long xr = *(const LAS unsigned long long*)(XT + (wave * 16 + cc) * RW_LD + 16 * i + 4 * g);
                    acc.x = bf2f((bf16)(xr & 0xffffu)); acc.y = bf2f((bf16)((xr >> 16) & 0xffffu)); acc.z = bf2f((bf16)((xr >> 32) & 0xffffu)); acc.w = bf2f((bf16)(xr >> 48)); }
#pragma unroll
                for (int k = 0; k < i; ++k) { const s16x4 a = *(const LAS s16x4*)(NI + (16 * i + cc) * RW_LD + 16 * k + 4 * g); acc = __builtin_amdgcn_mfma_f32_16x16x16bf16_1k(a, xb[k], acc, 0, 0, 0); }
                const s16x4 yb = cvt4(acc), ta = *(const LAS s16x4*)(TI + (i * 16 + cc) * 16 + 4 * g);
                const f32x4 xi = __builtin_amdgcn_mfma_f32_16x16x16bf16_1k(ta, yb, (f32x4){0.f, 0.f, 0.f, 0.f}, 0, 0, 0);
                xb[i] = cvt4(xi);
            }
            __syncthreads();
#pragma unroll
            for (int i = 0; i < 4; ++i) *(LAS s16x4*)(XB16 + (wave * 16 + cc) * RW_LD + 16 * i + 4 * g) = xb[i];
        }
        __syncthreads();
        {
            const int osel = wave >> 1; const size_t ob = (size_t)item * 4096;
#pragma unroll 1
            for (int q = 0; q < 8; ++q) { const int tile = (wave & 1) * 8 + q, mt = tile >> 2, nt = tile & 3; f32x4 acc = {0.f, 0.f, 0.f, 0.f};
                if (osel == 0) {
                    acc = mm16(XB16 + mt * 16 * RW_LD, RW_LD, BHc + nt * 16 * RW_LD, RW_LD, 64, acc, lane);
                    *(unsigned long long*)(PP + ob + (nt * 16 + cc) * 64 + mt * 16 + 4 * g) = pack4(acc);
                } else if (osel == 1) {
                    acc = mm16(BHc + mt * 16 * RW_LD, RW_LD, XB16 + (64 + nt * 16) * RW_LD, RW_LD, 64, acc, lane);
                    acc = mm16(KHc + mt * 16 * RW_LD, RW_LD, VTc + nt * 16 * RW_LD, RW_LD, 64, acc, lane);
                    *(unsigned long long*)(QQ + ob + (nt * 16 + cc) * 64 + mt * 16 + 4 * g) = pack4(acc);
                } else if (osel == 2) {
                    acc = mm16(XB16 + mt * 16 * RW_LD, RW_LD, ARB + nt * 16 * RW_LD, RW_LD, 64, acc, lane);
                    const unsigned long long rr = *(const LAS unsigned long long*)(RT + (nt * 16 + cc) * RW_LD + mt * 16 + 4 * g);
                    acc.x += bf2f((bf16)(rr & 0xffffu)); acc.y += bf2f((bf16)((rr >> 16) & 0xffffu)); acc.z += bf2f((bf16)((rr >> 32) & 0xffffu)); acc.w += bf2f((bf16)(rr >> 48));
                    *(unsigned long long*)(RH + ob + (nt * 16 + cc) * 64 + mt * 16 + 4 * g) = pack4(acc);
                } else {
                    acc = mm16(XB16 + (64 + mt * 16) * RW_LD, RW_LD, ARB + nt * 16 * RW_LD, RW_LD, 64, acc, lane);
                    acc = mm16(VTc + mt * 16 * RW_LD, RW_LD, ARK + nt * 16 * RW_LD, RW_LD, 64, acc, lane);
                    *(unsigned long long*)(YH + ob + (nt * 16 + cc) * 64 + mt * 16 + 4 * g) = pack4(acc);
                } }
        }
        __syncthreads();
      }
    }
}

constexpr int CH_R = 6, CH_SLOT = 9216 + 9216 + 256;
constexpr int CH_RING = 0, CH_SI = CH_R * CH_SLOT, CH_FLAGS = CH_SI + 4 * 2304;
static_assert(CH_FLAGS + 64 <= MISC_OFF, "chain LDS map");
struct ChainRegs { v4u p[8], q[8]; f32x4 gm; };
__device__ __forceinline__ void chain_fetch(ChainRegs& o, const bf16* PP, const bf16* QQ, const float* GAMC, int item, int lane) {
    const size_t ob = (size_t)item * 4096;
#pragma unroll
    for (int i = 0; i < 8; ++i) { o.p[i] = *(const v4u*)(PP + ob + (size_t)(i * 64 + lane) * 8); o.q[i] = *(const v4u*)(QQ + ob + (size_t)(i * 64 + lane) * 8); }
    o.gm = *(const f32x4*)(GAMC + (size_t)item * 64 + (lane & 15) * 4);
}
__device__ __forceinline__ void chain_commit(const ChainRegs& o, LAS unsigned char* L, int c, int lane) {
    volatile LAS unsigned* flags = (volatile LAS unsigned*)(L + CH_FLAGS);
    const int slot = c % CH_R;
    if (c >= CH_R) { const unsigned need = (unsigned)(c - CH_R + 1);
        for (;;) { const unsigned m0 = flags[CH_R + 0], m1 = flags[CH_R + 1], m2 = flags[CH_R + 2], m3 = flags[CH_R + 3];
            if (m0 >= need && m1 >= need && m2 >= need && m3 >= need) break; __builtin_amdgcn_s_sleep(1); } }
    asm volatile("" ::: "memory");
    LAS unsigned char* sl = L + CH_RING + slot * CH_SLOT;
#pragma unroll
    for (int i = 0; i < 8; ++i) { const int idx = i * 64 + lane, row = idx >> 3, c16 = idx & 7;
        *(LAS v4u*)(sl + row * 144 + c16 * 16) = o.p[i]; *(LAS v4u*)(sl + 9216 + row * 144 + c16 * 16) = o.q[i]; }
    if (lane < 16) *(LAS f32x4*)(sl + 18432 + lane * 16) = o.gm;
    asm volatile("s_waitcnt lgkmcnt(0)" ::: "memory");
    if (lane == 0) flags[slot] = (unsigned)(c + 1);
}
__device__ __forceinline__ void ph_rwkv_b(const Ctx& C, int bh  , const bf16* PP, const bf16* QQ, const float* GAMC, bf16* S0) {
    const int lane = C.lane, wave = C.wave, cc = lane & 15, g = lane >> 4, b = bh >> 3, h = bh & 7;
    LAS unsigned char* L = C.lds;
    volatile LAS unsigned* flags = (volatile LAS unsigned*)(L + CH_FLAGS);
    if (C.tid < 16) flags[C.tid] = 0u;
    __syncthreads();
    if (wave >= 4) {
        const int j = wave - 4;
        ChainRegs A, B;
        int lc = j;
        chain_fetch(A, PP, QQ, GAMC, (b * 128 + lc) * 8 + h, lane);
        for (;;) {
            if (lc + 4 < 128) chain_fetch(B, PP, QQ, GAMC, (b * 128 + lc + 4) * 8 + h, lane);
            chain_commit(A, L, lc, lane);
            lc += 4; if (lc >= 128) break;
            if (lc + 4 < 128) chain_fetch(A, PP, QQ, GAMC, (b * 128 + lc + 4) * 8 + h, lane);
            chain_commit(B, L, lc, lane);
            lc += 4; if (lc >= 128) break;
        }
    } else {
        const int vt = wave;
        LAS bf16* SI = (LAS bf16*)(L + CH_SI + vt * 2304);
        f32x4 st[4];
#pragma unroll
        for (int mt = 0; mt < 4; ++mt) st[mt] = (f32x4){0.f, 0.f, 0.f, 0.f};
        for (int c = 0; c < 128; ++c) {
            const int item = (b * 128 + c) * 8 + h, slot = c % CH_R; const size_t ob = (size_t)item * 4096;
#pragma unroll
            for (int mt = 0; mt < 4; ++mt) { const unsigned long long pk = pack4(st[mt]);
                *(unsigned long long*)(S0 + ob + (vt * 16 + cc) * 64 + mt * 16 + 4 * g) = pk; *(LAS unsigned long long*)(SI + cc * RW_LD + mt * 16 + 4 * g) = pk; }
            while (flags[slot] < (unsigned)(c + 1)) __builtin_amdgcn_s_sleep(1);
            asm volatile("s_waitcnt lgkmcnt(0)" ::: "memory");
            const LAS unsigned char* sl = L + CH_RING + slot * CH_SLOT;
            const LAS bf16* Pi = (const LAS bf16*)sl; const LAS bf16* Qi = (const LAS bf16*)(sl + 9216); const LAS float* Gi = (const LAS float*)(sl + 18432);
            const s16x8 b0 = *(const LAS s16x8*)(SI + cc * RW_LD + 8 * g), b1 = *(const LAS s16x8*)(SI + cc * RW_LD + 32 + 8 * g);
#pragma unroll
            for (int mt = 0; mt < 4; ++mt) {
                const f32x4 gm = *(const LAS f32x4*)(Gi + mt * 16 + 4 * g);
                const unsigned long long qq = *(const LAS unsigned long long*)(Qi + (vt * 16 + cc) * RW_LD + mt * 16 + 4 * g);
                const s16x8 a0 = *(const LAS s16x8*)(Pi + (mt * 16 + cc) * RW_LD + 8 * g), a1 = *(const LAS s16x8*)(Pi + (mt * 16 + cc) * RW_LD + 32 + 8 * g);
                f32x4 acc; acc.x = gm.x * st[mt].x + bf2f((bf16)(qq & 0xffffu)); acc.y = gm.y * st[mt].y + bf2f((bf16)((qq >> 16) & 0xffffu));
                acc.z = gm.z * st[mt].z + bf2f((bf16)((qq >> 32) & 0xffffu)); acc.w = gm.w * st[mt].w + bf2f((bf16)(qq >> 48));
                acc = __builtin_amdgcn_mfma_f32_16x16x32_bf16(a0, b0, acc, 0, 0, 0); acc = __builtin_amdgcn_mfma_f32_16x16x32_bf16(a1, b1, acc, 0, 0, 0);
                st[mt] = acc; }
            asm volatile("s_waitcnt lgkmcnt(0)" ::: "memory");
            if (lane == 0) flags[CH_R + vt] = (unsigned)(c + 1);
        }
    }
    __syncthreads();
}

__device__ __forceinline__ void ph_rwkv_c(const Ctx& C, const bf16* S0, const bf16* RH, const bf16* YH, const float* RK, const bf16* GG, const bf16* VF,
                                          const float* gn_g, const float* gn_b, bf16* O) {
    const int lane = C.lane, cc = lane & 15, g = lane >> 4;
    for (int item = C.bid * 8 + C.wave; item < 4096; item += C.nb * 8) {
        const int h = item & 7, c = (item >> 3) & 127, b = item >> 10; const size_t m0 = (size_t)b * T_ + c * 64, ob = (size_t)item * 4096;
        s16x8 af[4][2], bfr[4][2];
#pragma unroll
        for (int q = 0; q < 4; ++q)
#pragma unroll
            for (int k = 0; k < 2; ++k) { af[q][k] = *(const s16x8*)(S0 + ob + (q * 16 + cc) * 64 + k * 32 + 8 * g); bfr[q][k] = *(const s16x8*)(RH + ob + (q * 16 + cc) * 64 + k * 32 + 8 * g); }
#pragma unroll
        for (int nt = 0; nt < 4; ++nt) {
            const size_t m = m0 + nt * 16 + cc;
            f32x4 y[4]; float s1 = 0.f;
#pragma unroll
            for (int mt = 0; mt < 4; ++mt) { const unsigned long long yh = *(const unsigned long long*)(YH + ob + (nt * 16 + cc) * 64 + mt * 16 + 4 * g);
                f32x4 acc; acc.x = bf2f((bf16)(yh & 0xffffu)); acc.y = bf2f((bf16)((yh >> 16) & 0xffffu)); acc.z = bf2f((bf16)((yh >> 32) & 0xffffu)); acc.w = bf2f((bf16)(yh >> 48));
                acc = __builtin_amdgcn_mfma_f32_16x16x32_bf16(af[mt][0], bfr[nt][0], acc, 0, 0, 0); acc = __builtin_amdgcn_mfma_f32_16x16x32_bf16(af[mt][1], bfr[nt][1], acc, 0, 0, 0);
                y[mt] = acc; s1 += (acc.x + acc.y) + (acc.z + acc.w); }
            s1 += __shfl_xor(s1, 16); s1 += __shfl_xor(s1, 32);
            const float mean = s1 * (1.f / 64.f); float s2 = 0.f;
#pragma unroll
            for (int mt = 0; mt < 4; ++mt) { y[mt] = y[mt] - mean; s2 += (y[mt].x * y[mt].x + y[mt].y * y[mt].y) + (y[mt].z * y[mt].z + y[mt].w * y[mt].w); }
            s2 += __shfl_xor(s2, 16); s2 += __shfl_xor(s2, 32);
            const float rstd = 1.f / sqrtf(s2 * (1.f / 64.f) + 64e-5f), rk = RK[m * 8 + h];
#pragma unroll
            for (int mt = 0; mt < 4; ++mt) { const int v = h * 64 + mt * 16 + 4 * g;
                const f32x4 gg4 = *(const f32x4*)(gn_g + v), gb4 = *(const f32x4*)(gn_b + v);
                const unsigned long long vx = *(const unsigned long long*)(VF + m * 512 + v), gx = *(const unsigned long long*)(GG + m * 512 + v);
                f32x4 o;
                o.x = (y[mt].x * rstd * gg4.x + gb4.x + rk * bf2f((bf16)(vx & 0xffffu))) * bf2f((bf16)(gx & 0xffffu));
                o.y = (y[mt].y * rstd * gg4.y + gb4.y + rk * bf2f((bf16)((vx >> 16) & 0xffffu))) * bf2f((bf16)((gx >> 16) & 0xffffu));
                o.z = (y[mt].z * rstd * gg4.z + gb4.z + rk * bf2f((bf16)((vx >> 32) & 0xffffu))) * bf2f((bf16)((gx >> 32) & 0xffffu));
                o.w = (y[mt].w * rstd * gg4.w + gb4.w + rk * bf2f((bf16)(vx >> 48))) * bf2f((bf16)(gx >> 48));
                *(unsigned long long*)(O + m * D_ + 512 + v) = pack4(o); }
        }
    }
}

__device__ __forceinline__ void ph_convfix(const Ctx& C, const float* HALO, const float* FIXU, const float* cw, const float* cb, bf16* ACT) {
    for (int idx = C.bid * NT + C.tid; idx < 128 * 22 * 2 * 128; idx += C.nb * NT) {
        const int j = idx & 127, rr = (idx >> 7) & 1, tile = idx >> 8, pm = tile / 22, pn = tile % 22;
        const bool seq0 = (pm & 31) == 0;
        const float* fx = FIXU + (size_t)tile * 512; const float* hl = HALO + (size_t)(tile - 22) * 512;
        const float u0g = fx[rr * 256 + j], u0v = fx[rr * 256 + 128 + j];
        float u1g, u1v, u2g, u2v;
        if (rr == 0) { u1g = seq0 ? 0.f : hl[256 + j]; u1v = seq0 ? 0.f : hl[256 + 128 + j]; u2g = seq0 ? 0.f : hl[j]; u2v = seq0 ? 0.f : hl[128 + j]; }
        else { u1g = fx[j]; u1v = fx[128 + j]; u2g = seq0 ? 0.f : hl[256 + j]; u2v = seq0 ? 0.f : hl[256 + 128 + j]; }
        const int jg = pn * 128 + j, jv = DFF + jg;
        const float gc = cb[jg] + cw[jg] * u2g + cw[NUP + jg] * u1g + cw[2 * NUP + jg] * u0g, vc = cb[jv] + cw[jv] * u2v + cw[NUP + jv] * u1v + cw[2 * NUP + jv] * u0v;
        ACT[(size_t)(pm * 256 + rr) * DFF + jg] = (bf16)f2bf(siluf_(gc) * vc);
    }
}
}

namespace pg8 {
struct EpiRes {
    static constexpr bool PERM = false, AFTER_DRAIN = false;
    const float* base; float* out; const float* gate; int gstride;
    __device__ __forceinline__ void operator()(const f32x4 (&acc)[2][2][4][2], const Unit& u, int wr, int wc, int fr, int fq) const {
        const int b = (u.pm * BM) / 8192; const float* gp = gate + (size_t)b * gstride;
        const int col0 = u.pn * BM + wc * 32 + 4 * fq;
        f32x4 gv[2][2];
#pragma unroll
        for (int bj = 0; bj < 2; ++bj)
#pragma unroll
            for (int n = 0; n < 2; ++n) gv[bj][n] = *(const f32x4*)(gp + col0 + bj * HALF + n * 16);
#pragma unroll
        for (int ai = 0; ai < 2; ++ai)
#pragma unroll
            for (int m = 0; m < 4; ++m) { const size_t off = (size_t)(u.pm * BM + ai * HALF + wr * 64 + m * 16 + fr) * 1024 + col0;
                f32x4 bs[2][2];
#pragma unroll
                for (int bj = 0; bj < 2; ++bj)
#pragma unroll
                    for (int n = 0; n < 2; ++n) bs[bj][n] = *(const f32x4*)(base + off + bj * HALF + n * 16);
#pragma unroll
                for (int bj = 0; bj < 2; ++bj)
#pragma unroll
                    for (int n = 0; n < 2; ++n) *(f32x4*)(out + off + bj * HALF + n * 16) = bs[bj][n] + gv[bj][n] * acc[ai][bj][m][n]; }
    }
};
struct EpiConv {
    static constexpr bool PERM = true, AFTER_DRAIN = false;
    bf16_t* ACT; const float* cw; const float* cb; float* HALO; float* FIXU; PG8_LAS float* EX; int nN;
    template <int CTRL> static __device__ __forceinline__ float rot(float x) { return __builtin_bit_cast(float, __builtin_amdgcn_update_dpp(0, __builtin_bit_cast(int, x), CTRL, 0xf, 0xf, false)); }
    template <int CTRL> static __device__ __forceinline__ f32x4 rot4(f32x4 x) { return (f32x4){rot<CTRL>(x.x), rot<CTRL>(x.y), rot<CTRL>(x.z), rot<CTRL>(x.w)}; }
    __device__ __forceinline__ void operator()(const f32x4 (&acc)[2][2][4][2], const Unit& u, int wr, int wc, int fr, int fq) const {
        const int colw = wc * 32 + 8 * fq, tile = u.pm * nN + u.pn;
        if (fr >= 14) {
#pragma unroll
            for (int ai = 0; ai < 2; ++ai)
#pragma unroll
                for (int bj = 0; bj < 2; ++bj)
#pragma unroll
                    for (int n = 0; n < 2; ++n) { *(PG8_LAS f32x4*)(EX + ((ai * 2 + wr) * 2 + (fr - 14)) * 256 + bj * 128 + colw + 4 * n) = acc[ai][bj][3][n];
                        if (ai == 1 && wr == 1) *(f32x4*)(HALO + ((size_t)tile * 2 + (fr - 14)) * 256 + bj * 128 + colw + 4 * n) = acc[1][bj][3][n]; }
        }
        if (fr < 2 && wr == 0) {
#pragma unroll
            for (int bj = 0; bj < 2; ++bj)
#pragma unroll
                for (int n = 0; n < 2; ++n) *(f32x4*)(FIXU + ((size_t)tile * 2 + fr) * 256 + bj * 128 + colw + 4 * n) = acc[0][bj][0][n];
        }
        asm volatile("s_waitcnt lgkmcnt(0)" ::: "memory"); __builtin_amdgcn_s_barrier(); asm volatile("" ::: "memory");
#pragma unroll
        for (int n = 0; n < 2; ++n) {
            const int jg = u.pn * 128 + colw + 4 * n, jv = 2816 + jg;
            f32x4 cw0[2], cw1[2], cw2[2], cbb[2];
            cw0[0] = *(const f32x4*)(cw + jg); cw1[0] = *(const f32x4*)(cw + 5632 + jg); cw2[0] = *(const f32x4*)(cw + 2 * 5632 + jg); cbb[0] = *(const f32x4*)(cb + jg);
            cw0[1] = *(const f32x4*)(cw + jv); cw1[1] = *(const f32x4*)(cw + 5632 + jv); cw2[1] = *(const f32x4*)(cw + 2 * 5632 + jv); cbb[1] = *(const f32x4*)(cb + jv);
#pragma unroll
            for (int ai = 0; ai < 2; ++ai)
#pragma unroll
                for (int m = 0; m < 4; ++m) {
                    const int src = ai * 2 + wr - 1;
                    f32x4 res[2];
#pragma unroll
                    for (int bj = 0; bj < 2; ++bj) {
                        const f32x4 x = acc[ai][bj][m][n];
                        f32x4 x1 = rot4<0x121>(x), x2 = rot4<0x122>(x);
                        if (m > 0) { const f32x4 q = acc[ai][bj][m > 0 ? m - 1 : 0][n]; const f32x4 q1 = rot4<0x121>(q), q2 = rot4<0x122>(q);
                            if (fr == 0) x1 = q1; if (fr < 2) x2 = q2; }
                        else if (fr < 2) { f32x4 e14 = {0.f, 0.f, 0.f, 0.f}, e15 = e14;
                            if (src >= 0) { e14 = *(const PG8_LAS f32x4*)(EX + (src * 2 + 0) * 256 + bj * 128 + colw + 4 * n); e15 = *(const PG8_LAS f32x4*)(EX + (src * 2 + 1) * 256 + bj * 128 + colw + 4 * n); }
                            if (fr == 0) { x1 = e15; x2 = e14; } else x2 = e15; }
                        const f32x4 w0 = cw0[bj], w1 = cw1[bj], w2 = cw2[bj], bb = cbb[bj];
                        res[bj] = bb + w0 * x2 + w1 * x1 + w2 * x;
                    }
                    const f32x4 gc = res[0], vc = res[1];
                    f32x4 o;
                    o.x = gc.x * __builtin_amdgcn_rcpf(1.f + __expf(-gc.x)) * vc.x; o.y = gc.y * __builtin_amdgcn_rcpf(1.f + __expf(-gc.y)) * vc.y;
                    o.z = gc.z * __builtin_amdgcn_rcpf(1.f + __expf(-gc.z)) * vc.z; o.w = gc.w * __builtin_amdgcn_rcpf(1.f + __expf(-gc.w)) * vc.w;
                    typedef unsigned u32x2 __attribute__((ext_vector_type(2)));
                    u32x2 w; w.x = cvt_pk_bf16(o.x, o.y); w.y = cvt_pk_bf16(o.z, o.w);
                    *(u32x2*)(ACT + (size_t)(u.pm * BM + ai * HALF + wr * 64 + m * 16 + fr) * 2816 + u.pn * 128 + colw + 4 * n) = w;
                }
        }
    }
};
}

namespace hy {
struct Args { const float* in[31]; float* out; unsigned char* ws; };
__global__ void __launch_bounds__(NT, 2) hy_fwd(Args A) {
    extern __shared__ __attribute__((aligned(16))) unsigned char lds_raw[];
    Ctx C; C.bid = blockIdx.x; C.nb = gridDim.x; C.tid = threadIdx.x; C.lane = C.tid & 63; C.wave = __builtin_amdgcn_readfirstlane(C.tid >> 6); C.lds = (LAS unsigned char*)lds_raw;
    volatile LAS unsigned* MISC = (volatile LAS unsigned*)(C.lds + MISC_OFF);
    for (int u = C.tid; u < (LDS_BYTES - MISC_OFF) / 4; u += NT) ((LAS unsigned*)(C.lds + MISC_OFF))[u] = 0u;
    __syncthreads();
    unsigned char* ws = A.ws;
    const int wave0 = __builtin_amdgcn_readfirstlane(threadIdx.x >> 6);
    (void)xcd_barrier_post((unsigned*)(ws + WS_CTL) + CW_BAR, MISC + 8);
#define PHASE_BEGIN() do { int t_ = wave0 * 64 + lane_now(); int b_ = blockIdx.x; asm volatile("" : "+s"(b_)); \
    C.tid = t_; C.lane = t_ & 63; C.wave = __builtin_amdgcn_readfirstlane(t_ >> 6); C.bid = b_; } while (0)
#ifdef HY_DIAG
    unsigned long long ts_last = __builtin_amdgcn_s_memrealtime(); float tacc[10] = {0.f, 0.f, 0.f, 0.f, 0.f, 0.f, 0.f, 0.f, 0.f, 0.f};
#define GRID_BAR(cat) do { { XcdBarrier b_; b_.bar = (unsigned*)(A.ws + WS_CTL) + CW_BAR; b_.x = xb_xcc_id(); b_.st = (volatile LAS unsigned*)(C.lds + MISC_OFF) + 8; xcd_barrier(b_, wave0 == 0 && lane_now() == 0); } PHASE_BEGIN(); { const unsigned long long n_ = __builtin_amdgcn_s_memrealtime(); tacc[cat] += (float)(n_ - ts_last); ts_last = n_; } } while (0)
#else
#define GRID_BAR(cat) do { { XcdBarrier b_; b_.bar = (unsigned*)(A.ws + WS_CTL) + CW_BAR; b_.x = xb_xcc_id(); b_.st = (volatile LAS unsigned*)(C.lds + MISC_OFF) + 8; xcd_barrier(b_, wave0 == 0 && lane_now() == 0); } PHASE_BEGIN(); } while (0)
#endif
#ifndef HY_REPCAT
#define HY_REPCAT (-1)
#endif
#define NREP(cat) ((HY_REPCAT == (cat)) ? 2 : 1)
    float* out = A.out;
#define in A.in
    float* MOD = (float*)(ws + WS_MOD);
    bf16 *WIN = (bf16*)(ws + WS_WIN), *WOUT = (bf16*)(ws + WS_WOUT), *WUP = (bf16*)(ws + WS_WUP), *WDN = (bf16*)(ws + WS_WDN);
    bf16 *XB = (bf16*)(ws + WS_XB), *O = (bf16*)(ws + WS_O), *VF = (bf16*)(ws + WS_VF), *PG = (bf16*)(ws + WS_PG), *PR = (bf16*)(ws + WS_PR), *VL = (bf16*)(ws + WS_VL);
    bf16 *RH = (bf16*)(ws + WS_RH), *YH = (bf16*)(ws + WS_YH), *PP = (bf16*)(ws + WS_PP), *QQ = (bf16*)(ws + WS_QQ), *GG = (bf16*)(ws + WS_GG), *S0 = (bf16*)(ws + WS_S0);
    float *GAMC = (float*)(ws + WS_GAMC), *RK = (float*)(ws + WS_RK);
    bf16* LORA = (bf16*)(ws + WS_LORA);
    bf16* DS = (bf16*)(ws + WS_GK); float* GAM = (float*)(ws + WS_GAM);
    bf16* ACT = (bf16*)(ws + WS_ACT); float *HALO = (float*)(ws + WS_U), *FIXU = (float*)(ws + WS_U + 8 * MiB);

    ph_mod(C, in[1], in[2], in[3], MOD);
    for (int l = 0; l < L_; ++l) {
        const float* modl = MOD + (size_t)l * 4 * 6144;
        const float* xres = l ? out : in[0];
        for (int r_ = 0; r_ < NREP(0); ++r_) {
        wprep_mat(C, in[5] + (size_t)l * D_ * IN_COLS, D_, IN_COLS, NIN, WIN, 1, l ? in[6] : nullptr);
        wprep_mat(C, in[24] + (size_t)l * D_ * D_, D_, D_, D_, WOUT, 0, nullptr);
        wprep_mat(C, in[26] + (size_t)l * D_ * NUP, D_, NUP, NUP, WUP, 2, nullptr);
        wprep_mat(C, in[29] + (size_t)l * DFF * D_, DFF, D_, D_, WDN, 0, nullptr);
        wprep_mat(C, in[12] + (size_t)l * 64 * 512, 64, 512, 512, LORA, 0, nullptr);
        wprep_mat(C, in[14] + (size_t)l * 64 * 512, 64, 512, 512, LORA + 512 * 64, 0, nullptr);
        wprep_mat(C, in[16] + (size_t)l * 128 * 512, 128, 512, 512, LORA + 2 * 512 * 64, 0, nullptr);
        if (l) wprep_mat(C, in[17], 32, 512, 512, LORA + 2 * 512 * 64 + 512 * 128, 0, nullptr);
        }
        GRID_BAR(0);
        for (int r_ = 0; r_ < NREP(1); ++r_) ph_norm(C, xres, in[4] + l * D_, modl + 0 * D_, modl + 1 * D_, XB);
        GRID_BAR(1);
        for (int r_ = 0; r_ < NREP(2); ++r_) { pg8::Gemm g{XB, WIN, M_, NIN, D_}; pg8::StaticOrder S; S.init(M_, NIN, C.nb, C.bid);
          pg8::EpiBf16<0> E{PG, NPG, nullptr, NPG, (WS_PR - WS_PG) / 2, 1.f};
          pg8::gemm_phase<pg8::EpiBf16<0>, pg8::StaticOrder, true, true>(C.lds, g, S, E, C.tid); }
        GRID_BAR(2);
        for (int r_ = 0; r_ < NREP(3); ++r_) {
        ph_gla_a(C, PG, in[7] + l * 16 * 256, in[8] + l * 256, DS, GAM);
        { RwkvW W{in[10] + l * 1792, in[11], in[13] + l * 512, in[15] + l * 512, in[18], in[19] + l * 512, in[20] + l * 512, in[21] + l * 512,
                  LORA, LORA + 512 * 64, LORA + 2 * 512 * 64, LORA + 2 * 512 * 64 + 512 * 128};
          ph_rwkv_a(C, PR, PG, W, l, PP, QQ, RH, YH, GAMC, RK, GG, VF, r_ == NREP(3) - 1); } }
        GRID_BAR(3);
        if (C.bid < 32) { for (int r_ = 0; r_ < NREP(4); ++r_) ph_rwkv_b(C, C.bid, PP, QQ, GAMC, S0); }
        else { Ctx C2 = C; C2.bid = C.bid - 32; C2.nb = C.nb - 32; ph_gla_b(C2, DS, GAM); }
        GRID_BAR(4);
        for (int r_ = 0; r_ < NREP(5); ++r_) {
        ph_gla_c(C, PG, in[7] + l * 16 * 256, in[8] + l * 256, in[9] + l * 128, DS, O);
        ph_rwkv_c(C, S0, RH, YH, RK, GG, VF, in[22] + l * 512, in[23] + l * 512, O); }
        GRID_BAR(5);
        { pg8::Gemm g{O, WOUT, M_, D_, D_}; pg8::StaticOrder S; S.init(M_, D_, C.nb, C.bid);
          pg8::EpiRes E{xres, out, modl + 2 * D_, 6144};
          pg8::gemm_phase<pg8::EpiRes, pg8::StaticOrder, true, true>(C.lds, g, S, E, C.tid); }
        GRID_BAR(6);
        for (int r_ = 0; r_ < NREP(1); ++r_) ph_norm(C, out, in[25] + l * D_, modl + 3 * D_, modl + 4 * D_, XB);
        GRID_BAR(1);
        for (int r_ = 0; r_ < NREP(7); ++r_) { pg8::Gemm g{XB, WUP, M_, NUP, D_}; pg8::StaticOrder S; S.init(M_, NUP, C.nb, C.bid);
          pg8::EpiConv E{ACT, in[27] + (size_t)l * 3 * NUP, in[28] + (size_t)l * NUP, HALO, FIXU, (PG8_LAS float*)(C.lds + RING_BYTES), NUP / 256};
          pg8::gemm_phase<pg8::EpiConv, pg8::StaticOrder, true, true>(C.lds, g, S, E, C.tid); }
        GRID_BAR(7);
        for (int r_ = 0; r_ < NREP(8); ++r_) ph_convfix(C, HALO, FIXU, in[27] + (size_t)l * 3 * NUP, in[28] + (size_t)l * NUP, ACT);
        GRID_BAR(8);
        { pg8::Gemm g{ACT, WDN, M_, D_, DFF}; pg8::StaticOrder S; S.init(M_, D_, C.nb, C.bid);
          pg8::EpiRes E{out, out, modl + 5 * D_, 6144};
          pg8::gemm_phase<pg8::EpiRes, pg8::StaticOrder, true, true>(C.lds, g, S, E, C.tid); }
        GRID_BAR(9);
    }
    ph_final(C, out, in[30]);
#ifdef HY_DIAG
    GRID_BAR(1);
    if (C.bid == 0) { if (C.tid == 0) out[0] = tacc[HY_DIAG_A] * 0.1f; for (int i = 1 + C.tid; i <= 10000; i += NT) out[i] = tacc[HY_DIAG_B] * 0.01f; }
#endif
#undef GRID_BAR
#undef PHASE_BEGIN
#undef in
}
}

extern "C" void kernel_launch(void* const* d_in, const int* in_sizes, int n_in, void* d_out, int out_size, void* d_ws, size_t ws_size, hipStream_t stream) {
    using namespace hy;
    static int grid = 0;
    if (grid == 0) {
        if (n_in != 31 || in_sizes[0] != M_ * D_ || out_size != M_ * D_ || ws_size < WS_END) { fprintf(stderr, "kernel_launch: unexpected shapes (n_in %d, in0 %d, out %d, ws %zu)\n", n_in, n_in > 0 ? in_sizes[0] : -1, out_size, ws_size); grid = -1; return; }
        if (hipFuncSetAttribute((const void*)hy_fwd, hipFuncAttributeMaxDynamicSharedMemorySize, LDS_BYTES) != hipSuccess) { fprintf(stderr, "kernel_launch: hipFuncSetAttribute failed\n"); grid = -1; return; }
        int dev = 0, cus = 0, per_cu = 0;
        (void)hipGetDevice(&dev); (void)hipDeviceGetAttribute(&cus, hipDeviceAttributeMultiprocessorCount, dev);
        (void)hipOccupancyMaxActiveBlocksPerMultiprocessor(&per_cu, (const void*)hy_fwd, NT, LDS_BYTES);
        if (per_cu < 1) fprintf(stderr, "kernel_launch: occupancy query reports %d blocks per CU\n", per_cu);
        (void)hipGetLastError();
        grid = cus > 0 ? cus : 256;
    }
    if (grid < 0) return;
    (void)hipMemsetAsync((char*)d_ws + WS_CTL, 0, CTL_ZERO_BYTES, stream);
    Args a{};
    for (int i = 0; i < 31; ++i) a.in[i] = (const float*)d_in[i];
    a.out = (float*)d_out; a.ws = (unsigned char*)d_ws;
    hipLaunchKernelGGL(hy_fwd, dim3(grid), dim3(NT), LDS_BYTES, stream, a);
}
```

```cpp
#include <hip/hip_runtime.h>
#include <cstdio>
#include <cstdint>
namespace pg8 {
#define PG8_LAS __attribute__((address_space(3)))
typedef unsigned short bf16_t;
typedef short bf16x8 __attribute__((ext_vector_type(8)));
typedef float f32x4 __attribute__((ext_vector_type(4)));
typedef unsigned u32x4 __attribute__((ext_vector_type(4)));
constexpr int BM = 256, BK = 64, HALF = 128, HTB = HALF * BK * 2  , STAGE_BYTES = 8 * HTB, NXCD = 8, WGM = 8;

__host__ __device__ __forceinline__ int lds_byte(int r, int c) { const int st = (r >> 4) * 2 + (c >> 5), rr = r & 15, cc = c & 31, ob = rr * 64 + cc * 2; return st * 1024 + (ob ^ (((ob >> 9) & 1) << 5)); }
__host__ __device__ __forceinline__ void stage_rc(int b, int& R, int& C) { const int st = b / 1024, sb = b % 1024, swz = sb ^ (((sb >> 9) & 1) << 5); R = (st >> 1) * 16 + swz / 64; C = (st & 1) * 32 + (swz % 64) / 2; }
__host__ __device__ __forceinline__ int perm32(int rho) { const int n = rho >> 4, i = rho & 15; return 8 * (i >> 2) + 4 * n + (i & 3); }

struct Unit { int pm, pn; };
struct Gemm { const bf16_t* A; const bf16_t* Bt; int M, N, K; size_t bstride; };

struct StaticOrder {
    int nM, nN, nwg, G, c;
    __host__ __device__ void init(int M, int N, int G_, int c_) { nM = M / BM; nN = N / BM; nwg = nM * nN; G = G_; c = c_; }
    __host__ __device__ bool next(int i, Unit& u) const {
        const long L = (long)i * G + c; if (L >= nwg) return false;
        int wgid = (int)L; { const int q = nwg / NXCD, r = nwg % NXCD, xcd = wgid % NXCD, off = wgid / NXCD; wgid = (xcd < r ? xcd * (q + 1) : r * (q + 1) + (xcd - r) * q) + off; }
        const int nig = WGM * nN, gid = wgid / nig, fm = gid * WGM, gsz = (nM - fm) < WGM ? (nM - fm) : WGM;
        u.pm = fm + ((wgid % nig) % gsz); u.pn = (wgid % nig) / gsz; return true;
    }
    __device__ __forceinline__ void a_ready(const Unit&) const {}
    __device__ __forceinline__ void done(const Unit&) const {}
};

__device__ __forceinline__ unsigned cvt_pk_bf16(float lo, float hi) { unsigned r; asm volatile("v_cvt_pk_bf16_f32 %0, %1, %2" : "=v"(r) : "v"(lo), "v"(hi)); return r; }
typedef float f32x2 __attribute__((ext_vector_type(2)));
__device__ __forceinline__ f32x2 gelu_pk(f32x2 v) {
    const f32x2 av = __builtin_elementwise_abs(v), d = av * 0.2316418882f + 1.0f;
    f32x2 t; t.x = __builtin_amdgcn_rcpf(d.x); t.y = __builtin_amdgcn_rcpf(d.y);
    f32x2 q = t * 0.5307027145f + (-0.7265760135f); q = q * t + 0.7107068705f; q = q * t + (-0.142248368f); q = q * t + 0.127414796f; q = q * t;
    const f32x2 s = (v * v) * (-0.72134752044f);
    f32x2 e; e.x = __builtin_amdgcn_exp2f(s.x); e.y = __builtin_amdgcn_exp2f(s.y);
    const f32x2 m = v * (q * e), r = v - m;
    f32x2 o; o.x = v.x < 0.f ? m.x : r.x; o.y = v.y < 0.f ? m.y : r.y; return o;
}

template <int ACT  > struct EpiBf16 {
    static constexpr bool PERM = true, AFTER_DRAIN = false; static_assert(ACT == 0 || ACT == 1, "EpiBf16: ACT is 0 (none) or 1 (gelu_pk)");
    bf16_t* O; int ldc; const float* bias; int split_cols; size_t split_stride; float scale0;
    __device__ __forceinline__ void operator()(const f32x4 (&acc)[2][2][4][2], const Unit& u, int wr, int wc, int fr, int fq) const {
        const int row0 = u.pm * BM + wr * 64 + fr; int colt = u.pn * BM; bf16_t* base = O;
        float sc = 1.f; if (split_cols) { const int t = colt / split_cols; base += (size_t)t * split_stride; colt -= t * split_cols; if (t == 0) sc = scale0; }
        const int col0 = colt + wc * 32 + 8 * fq, bcol0 = u.pn * BM + wc * 32 + 8 * fq;
        f32x4 bv[2][2];
#pragma unroll
        for (int bj = 0; bj < 2; ++bj)
#pragma unroll
            for (int n = 0; n < 2; ++n) bv[bj][n] = bias ? *(const f32x4*)(bias + bcol0 + bj * HALF + 4 * n) : (f32x4){0.f, 0.f, 0.f, 0.f};
#pragma unroll
        for (int ai = 0; ai < 2; ++ai)
#pragma unroll
            for (int m = 0; m < 4; ++m) { bf16_t* rowp = base + (size_t)(row0 + ai * HALF + m * 16) * ldc + col0;
#pragma unroll
                for (int bj = 0; bj < 2; ++bj) { f32x4 v0 = acc[ai][bj][m][0] + bv[bj][0], v1 = acc[ai][bj][m][1] + bv[bj][1];
                    if (ACT == 1) { f32x2 a = gelu_pk((f32x2){v0[0], v0[1]}), b = gelu_pk((f32x2){v0[2], v0[3]}), c = gelu_pk((f32x2){v1[0], v1[1]}), d = gelu_pk((f32x2){v1[2], v1[3]});
                        v0 = (f32x4){a.x, a.y, b.x, b.y}; v1 = (f32x4){c.x, c.y, d.x, d.y}; }
                    v0 = v0 * sc; v1 = v1 * sc; u32x4 w; w.x = cvt_pk_bf16(v0[0], v0[1]); w.y = cvt_pk_bf16(v0[2], v0[3]); w.z = cvt_pk_bf16(v1[0], v1[1]); w.w = cvt_pk_bf16(v1[2], v1[3]);
                    *(u32x4*)(rowp + bj * HALF) = w; } }
    }
};
template <class Epi, class Sched, bool ALIGN_EPI = false, bool SP2 = false>
__device__ __forceinline__ void gemm_phase(PG8_LAS unsigned char* lds, const Gemm g, const Sched& S, const Epi& E, int tid_in) {
    int tid_ = tid_in; asm volatile("" : "+v"(tid_));
    const int tid = tid_, wid = __builtin_amdgcn_readfirstlane(tid >> 6), lane = tid & 63, wr = wid >> 2, wc = wid & 3, fr = lane & 15, fq = lane >> 4;
    const int K = g.K, nt = K / BK;
    unsigned voffA[2], voffB[2];
#pragma unroll
    for (int i = 0; i < 2; ++i) { int R, C; stage_rc(tid * 16 + i * 8192, R, C); const int Rb = Epi::PERM ? ((R & ~31) + perm32(R & 31)) : R;
        voffA[i] = (unsigned)(R * K + C) * 2u; voffB[i] = (unsigned)(Rb * K + C) * 2u; }
    const size_t kstep = (size_t)(BK * 2);
    const size_t hstep = (size_t)HALF * K * 2;
    const size_t tstep = 2 * hstep;
    const unsigned ldsw = (unsigned)wid * 1024u;
    const int aoff = lds_byte(wr * 64 + fr, fq * 8), boff = lds_byte(wc * 32 + fr, fq * 8);
#define PG8_SA(b, h) (((b) * 2 + (h)) * HTB)
#define PG8_SB(b, h) ((4 + (b) * 2 + (h)) * HTB)
#define PG8_STAGE(bufoff, gbase, voff) do { _Pragma("unroll") for (int _i = 0; _i < 2; ++_i) \
        __builtin_amdgcn_global_load_lds((const unsigned*)((const char*)(gbase) + (voff)[_i]), (PG8_LAS unsigned*)(lds + (bufoff) + ldsw + _i * 8192), 16, 0, 0); } while (0)
#define PG8_LDA(dst, b, h) do { _Pragma("unroll") for (int m = 0; m < 4; ++m) _Pragma("unroll") for (int k = 0; k < 2; ++k) dst[m][k] = *(const PG8_LAS bf16x8*)(lds + PG8_SA(b, h) + aoff + m * 2048 + k * 1024); } while (0)
#define PG8_LDB(dst, b, h) do { _Pragma("unroll") for (int n = 0; n < 2; ++n) _Pragma("unroll") for (int k = 0; k < 2; ++k) dst[n][k] = *(const PG8_LAS bf16x8*)(lds + PG8_SB(b, h) + boff + n * 2048 + k * 1024); } while (0)
#define PG8_MMA(ai, bj, At, Bt) do { __builtin_amdgcn_s_setprio(1); _Pragma("unroll") for (int m = 0; m < 4; ++m) _Pragma("unroll") for (int n = 0; n < 2; ++n) _Pragma("unroll") for (int k = 0; k < 2; ++k) \
        acc[ai][bj][m][n] = __builtin_amdgcn_mfma_f32_16x16x32_bf16(Bt[n][k], At[m][k], acc[ai][bj][m][n], 0, 0, 0); __builtin_amdgcn_s_setprio(0); } while (0)
#define PG8_WAIT_V(n) asm volatile("s_waitcnt vmcnt(" #n ")" ::: "memory")
#define PG8_WAIT_L(n) asm volatile("s_waitcnt lgkmcnt(" #n ")" ::: "memory")
#define PG8_BAR __builtin_amdgcn_s_barrier()
#define PG8_SCHED __builtin_amdgcn_sched_barrier(0)
    Unit cur, nxt; int ui = 0;
    if (!S.next(0, cur)) return;
    f32x4 acc[2][2][4][2];
#pragma unroll
    for (int a = 0; a < 2; ++a)
#pragma unroll
        for (int b = 0; b < 2; ++b)
#pragma unroll
            for (int m = 0; m < 4; ++m)
#pragma unroll
                for (int n = 0; n < 2; ++n) acc[a][b][m][n] = (f32x4){0.f, 0.f, 0.f, 0.f};
    bf16x8 At[4][2], B0[2][2], B1[2][2];
    const char* cA = (const char*)g.A + (size_t)cur.pm * tstep; const char* cB = (const char*)g.Bt + (size_t)cur.pn * tstep + (size_t)(cur.pm >> 5) * g.bstride;
    S.a_ready(cur);
    if constexpr (SP2) {
        PG8_STAGE(PG8_SB(0, 0), cB, voffB); PG8_STAGE(PG8_SB(0, 1), cB + hstep, voffB); PG8_STAGE(PG8_SA(0, 0), cA, voffA); PG8_STAGE(PG8_SA(0, 1), cA + hstep, voffA);
        if (wr == 1) PG8_BAR;
        PG8_WAIT_V(2); PG8_BAR;
        PG8_STAGE(PG8_SB(1, 0), cB + kstep, voffB); PG8_STAGE(PG8_SA(1, 0), cA + kstep, voffA); PG8_STAGE(PG8_SB(1, 1), cB + hstep + kstep, voffB);
        PG8_WAIT_V(6); PG8_BAR;
    } else {
        PG8_STAGE(PG8_SB(0, 0), cB, voffB); PG8_STAGE(PG8_SA(0, 0), cA, voffA); PG8_STAGE(PG8_SB(0, 1), cB + hstep, voffB); PG8_STAGE(PG8_SA(0, 1), cA + hstep, voffA);
        if (wr == 1) PG8_BAR;
        PG8_WAIT_V(4); PG8_BAR;
        PG8_STAGE(PG8_SB(1, 0), cB + kstep, voffB); PG8_STAGE(PG8_SA(1, 0), cA + kstep, voffA); PG8_STAGE(PG8_SB(1, 1), cB + hstep + kstep, voffB);
        PG8_WAIT_V(6); PG8_BAR;
    }
    for (;;) {
        const bool has_next = S.next(ui + 1, nxt);
        const char* nA = has_next ? (const char*)g.A + (size_t)nxt.pm * tstep : cA; const char* nB = has_next ? (const char*)g.Bt + (size_t)nxt.pn * tstep + (size_t)(nxt.pm >> 5) * g.bstride : cB;
        for (int t = 0; t < nt; t += 2) {
            const bool last = (t == nt - 2);
            const char* a1 = cA + (size_t)(t + 1) * kstep;
            const char* a2 = last ? nA : cA + (size_t)(t + 2) * kstep; const char* b2 = last ? nB : cB + (size_t)(t + 2) * kstep;
            const char* a3 = a2 + kstep; const char* b3 = b2 + kstep;
            if (last && has_next) S.a_ready(nxt);
            if constexpr (SP2) {
            PG8_LDB(B0, 0, 0); PG8_LDB(B1, 0, 1); PG8_SCHED; PG8_LDA(At, 0, 0); PG8_STAGE(PG8_SA(1, 1), a1 + hstep, voffA);
            PG8_WAIT_V(8); PG8_WAIT_L(0); PG8_BAR; PG8_MMA(0, 0, At, B0); PG8_MMA(0, 1, At, B1); PG8_BAR; PG8_SCHED;
            PG8_LDA(At, 0, 1); PG8_STAGE(PG8_SB(0, 0), b2, voffB); PG8_STAGE(PG8_SB(0, 1), b2 + hstep, voffB); PG8_STAGE(PG8_SA(0, 0), a2, voffA);
            PG8_WAIT_V(8); PG8_WAIT_L(0); PG8_BAR; PG8_MMA(1, 0, At, B0); PG8_MMA(1, 1, At, B1); PG8_BAR; PG8_SCHED;
            PG8_LDB(B0, 1, 0); PG8_LDB(B1, 1, 1); PG8_SCHED; PG8_LDA(At, 1, 0); PG8_STAGE(PG8_SA(0, 1), a2 + hstep, voffA);
            PG8_WAIT_V(8); PG8_WAIT_L(0); PG8_BAR; PG8_MMA(0, 0, At, B0); PG8_MMA(0, 1, At, B1); PG8_BAR; PG8_SCHED;
            PG8_LDA(At, 1, 1); PG8_STAGE(PG8_SB(1, 0), b3, voffB); PG8_STAGE(PG8_SB(1, 1), b3 + hstep, voffB); PG8_STAGE(PG8_SA(1, 0), a3, voffA);
            PG8_WAIT_V(8); PG8_WAIT_L(0); PG8_BAR; PG8_MMA(1, 0, At, B0); PG8_MMA(1, 1, At, B1); PG8_BAR; PG8_SCHED;
            } else {
            PG8_LDB(B0, 0, 0); PG8_SCHED; PG8_LDA(At, 0, 0); PG8_STAGE(PG8_SA(1, 1), a1 + hstep, voffA);
            PG8_WAIT_L(8); PG8_BAR; PG8_WAIT_L(0); PG8_MMA(0, 0, At, B0); PG8_BAR; PG8_SCHED;
            PG8_LDB(B1, 0, 1); PG8_STAGE(PG8_SB(0, 0), b2, voffB);
            PG8_BAR; PG8_WAIT_L(0); PG8_MMA(0, 1, At, B1); PG8_BAR;
            PG8_LDA(At, 0, 1); PG8_STAGE(PG8_SA(0, 0), a2, voffA);
            PG8_BAR; PG8_WAIT_L(0); PG8_MMA(1, 0, At, B0); PG8_BAR; PG8_SCHED;
            PG8_STAGE(PG8_SB(0, 1), b2 + hstep, voffB);
            PG8_WAIT_V(6); PG8_BAR; PG8_MMA(1, 1, At, B1); PG8_BAR;
            PG8_LDB(B0, 1, 0); PG8_SCHED; PG8_LDA(At, 1, 0); PG8_STAGE(PG8_SA(0, 1), a2 + hstep, voffA);
            PG8_WAIT_L(8); PG8_BAR; PG8_WAIT_L(0); PG8_MMA(0, 0, At, B0); PG8_BAR; PG8_SCHED;
            PG8_LDB(B1, 1, 1); PG8_STAGE(PG8_SB(1, 0), b3, voffB);
            PG8_BAR; PG8_WAIT_L(0); PG8_MMA(0, 1, At, B1); PG8_BAR;
            PG8_LDA(At, 1, 1); PG8_STAGE(PG8_SA(1, 0), a3, voffA);
            PG8_BAR; PG8_WAIT_L(0); PG8_MMA(1, 0, At, B0); PG8_BAR; PG8_SCHED;
            PG8_STAGE(PG8_SB(1, 1), b3 + hstep, voffB);
            PG8_WAIT_V(6); PG8_BAR; PG8_MMA(1, 1, At, B1); PG8_BAR;
            }
        }
        if constexpr (ALIGN_EPI) { if (wr == 0) PG8_BAR; }
        if constexpr (!Epi::AFTER_DRAIN) { E(acc, cur, wr, wc, fr, fq); S.done(cur); }
        if (!has_next) break;
#pragma unroll
        for (int a = 0; a < 2; ++a)
#pragma unroll
            for (int b = 0; b < 2; ++b)
#pragma unroll
                for (int m = 0; m < 4; ++m)
#pragma unroll
                    for (int n = 0; n < 2; ++n) acc[a][b][m][n] = (f32x4){0.f, 0.f, 0.f, 0.f};
        cur = nxt; cA = nA; cB = nB; ++ui;
        if constexpr (ALIGN_EPI) { if (wr == 1) PG8_BAR; }
    }
    PG8_WAIT_V(0);
    if constexpr (!ALIGN_EPI) { if (wr == 0) PG8_BAR; }
    PG8_BAR;
    if constexpr (Epi::AFTER_DRAIN) { E.fused(acc, cur, wr, wc, fr, fq, lds, wid, lane); S.done(cur); }
#undef PG8_SA
#undef PG8_SB
#undef PG8_STAGE
#undef PG8_LDA
#undef PG8_LDB
#undef PG8_MMA
#undef PG8_WAIT_V
#undef PG8_WAIT_L
#undef PG8_BAR
#undef PG8_SCHED
}
}

namespace hy {
#define GAS __attribute__((address_space(1)))
#define LAS __attribute__((address_space(3)))
typedef unsigned short bf16;
typedef unsigned v4u __attribute__((ext_vector_type(4)));
typedef float f32x4 __attribute__((ext_vector_type(4)));
typedef short bf16x8 __attribute__((ext_vector_type(8)));
typedef GAS unsigned gu32;
typedef GAS unsigned long long gu64;
#define RLX_AGENT __ATOMIC_RELAXED, __HIP_MEMORY_SCOPE_AGENT
#define LDS_WAIT() asm volatile("s_waitcnt lgkmcnt(0)" ::: "memory")
#define VM_WAIT() asm volatile("s_waitcnt vmcnt(0)" ::: "memory")
__device__ __forceinline__ unsigned long long rt() { return __builtin_amdgcn_s_memrealtime(); }
typedef __bf16 hwbf2 __attribute__((ext_vector_type(2))); typedef float hwf2 __attribute__((ext_vector_type(2)));
__device__ __forceinline__ unsigned f2bf(float f) { return (unsigned)__builtin_bit_cast(unsigned short, (__bf16)f); }
__device__ __forceinline__ unsigned pk2(float lo, float hi) { const hwf2 v = {lo, hi}; return __builtin_bit_cast(unsigned, __builtin_convertvector(v, hwbf2)); }
#define XB_TMO      128
#define XB_XCNT(j)  (256  + 64 * (j))
#define XB_XSUB(j)  (1280 + 64 * (j))
#define XB_XGEN(j)  (2304 + 64 * (j))
#define XB_TOP      3328
#define XB_TOPGEN   3392
#define XCD_BAR_WORDS 3456
#define XB_SPIN_CAP (1u << 18)

__device__ __forceinline__ unsigned xb_ld(unsigned* p)              { return __hip_atomic_load(p, __ATOMIC_RELAXED, __HIP_MEMORY_SCOPE_AGENT); }
__device__ __forceinline__ unsigned xb_add(unsigned* p, unsigned v) { return __hip_atomic_fetch_add(p, v, __ATOMIC_RELAXED, __HIP_MEMORY_SCOPE_AGENT); }
__device__ __forceinline__ unsigned xb_xcc_id() { return (unsigned)__builtin_amdgcn_s_getreg((3 << 11) | 20) & 0xFu; }
#define XB_SPIN(cond, bar) do { unsigned _sp = 0; while (cond) { __builtin_amdgcn_s_sleep(1); \
    if ((++_sp & 255u) == 0u) { if (xb_ld(&(bar)[XB_TMO])) break; if (_sp > XB_SPIN_CAP) { atomicAdd(&(bar)[XB_TMO], 1u); break; } } } } while (0)

struct XcdBarrier {
    unsigned* bar; unsigned x;
    volatile LAS unsigned* st;
};

__device__ __forceinline__ XcdBarrier xcd_barrier_post(unsigned* bar, volatile LAS unsigned* st) {
    XcdBarrier b; b.bar = bar; b.x = xb_xcc_id(); b.st = st;
    if (threadIdx.x == 0) (void)xb_add(&bar[XB_XCNT(b.x)], 1u);
    return b;
}
__device__ __forceinline__ void xcd_barrier_complete(unsigned* bar, unsigned x, unsigned& nloc, unsigned& nx) {
    const unsigned G = gridDim.x * gridDim.y * gridDim.z;
    unsigned sum, cnt, mine, sp = 0u;
    for (;;) {
        sum = 0u; cnt = 0u; mine = 0u;
#pragma unroll
        for (unsigned j = 0; j < 16; ++j) { const unsigned c = xb_ld(&bar[XB_XCNT(j)]); sum += c; cnt += (c > 0u) ? 1u : 0u; mine = (j == x) ? c : mine; }
        if (sum == G) break;
        __builtin_amdgcn_s_sleep(1);
        if ((++sp & 255u) == 0u) { if (xb_ld(&bar[XB_TMO])) break; if (sp > XB_SPIN_CAP) { atomicAdd(&bar[XB_TMO], 1u); break; } }
    }
    nloc = mine > 0u ? mine : 1u; nx = cnt > 0u ? cnt : 1u;
}

__device__ __forceinline__ void xcd_barrier(const XcdBarrier& b, bool leader  ) {
    asm volatile("s_waitcnt vmcnt(0)" ::: "memory");
    __syncthreads();
    if (leader) {
        unsigned* bar = b.bar;
        __builtin_amdgcn_s_waitcnt(0);
        unsigned nloc = b.st[0], nx = b.st[1];
        if (nloc == 0u) { xcd_barrier_complete(bar, b.x, nloc, nx); b.st[0] = nloc; b.st[1] = nx; }
        const unsigned old = xb_add(&bar[XB_XSUB(b.x)], 1u);
        const unsigned gen = old / nloc;
        if (old + 1u == (gen + 1u) * nloc) {
            __builtin_amdgcn_fence(__ATOMIC_RELEASE, "agent");
            asm volatile("s_waitcnt vmcnt(0)" ::: "memory");
            const unsigned og = xb_add(&bar[XB_TOP], 1u);
            const unsigned tg = og / nx;
            if (og + 1u == (tg + 1u) * nx) xb_add(&bar[XB_TOPGEN], 1u);
            else XB_SPIN(xb_ld(&bar[XB_TOPGEN]) == tg, bar);
            __builtin_amdgcn_fence(__ATOMIC_ACQUIRE, "agent");
            xb_add(&bar[XB_XGEN(b.x)], 1u);
            asm volatile("s_waitcnt vmcnt(0)" ::: "memory");
        } else {
            XB_SPIN(xb_ld(&bar[XB_XGEN(b.x)]) == gen, bar);
            __builtin_amdgcn_fence(__ATOMIC_ACQUIRE, "agent");
            asm volatile("s_waitcnt vmcnt(0)" ::: "memory");
        }
    }
    __syncthreads();
}

constexpr int B_ = 4, T_ = 8192, D_ = 1024, M_ = B_ * T_, L_ = 2;
constexpr int NIN = 3584, NPG = 1792, NPR = 1792;
constexpr int DFF = 2816, NUP = 5632, IN_COLS = 3344;
constexpr size_t MiB = 1u << 20;
constexpr size_t WS_CTL = 0, CTL_ZERO_BYTES = 65536;
constexpr int CW_BAR = 4096;
constexpr size_t WS_RK = MiB / 4;
constexpr size_t WS_MOD = 3 * MiB / 2;
constexpr size_t WS_WIN = 2 * MiB, WS_WOUT = 9 * MiB, WS_WUP = 11 * MiB, WS_WDN = 22 * MiB, WS_LORA = 55 * MiB / 2, WS_GAMC = 28 * MiB, WS_VL = 29 * MiB;
constexpr size_t WS_GAM = 31 * MiB;
constexpr size_t WS_XB = 32 * MiB, WS_O = 336 * MiB  , WS_VF = 160 * MiB, WS_GK = 192 * MiB, WS_PG = 224 * MiB, WS_PR = 336 * MiB, WS_END = 512 * MiB;
constexpr size_t WS_RH = WS_XB, WS_YH = WS_XB + 32 * MiB, WS_PP = 96 * MiB, WS_QQ = 128 * MiB, WS_GG = 448 * MiB, WS_S0 = 480 * MiB;
constexpr size_t WS_ACT = 224 * MiB, WS_U = 400 * MiB;
constexpr int RING_BYTES = 131072, MISC_OFF = 161792, LDS_BYTES = 163840;
constexpr int NT = 512;

__device__ __forceinline__ float bf2f(bf16 h) { return __builtin_bit_cast(float, (unsigned)h << 16); }
__device__ __forceinline__ float sigmoidf_(float x) { return 1.f / (1.f + __expf(-x)); }
__device__ __forceinline__ float siluf_(float x) { return x / (1.f + __expf(-x)); }
__device__ __forceinline__ float softplusf_(float x) { return fmaxf(x, 0.f) + log1pf(__expf(-fabsf(x))); }

typedef unsigned u32x2 __attribute__((ext_vector_type(2)));
template <int CTRL> __device__ __forceinline__ float dpp_f(float v) {
    return __builtin_bit_cast(float, __builtin_amdgcn_update_dpp(0, __builtin_bit_cast(int, v), CTRL, 0xf, 0xf, false));
}
__device__ __forceinline__ float wave_sum(float v) {
    v += dpp_f<0xB1>(v);
    v += dpp_f<0x4E>(v);
    v += dpp_f<0x141>(v);
    v += dpp_f<0x140>(v);
    v += __builtin_bit_cast(float, __builtin_amdgcn_update_dpp(0, __builtin_bit_cast(int, v), 0x142, 0xa, 0xf, false));
    v += __builtin_bit_cast(float, __builtin_amdgcn_update_dpp(0, __builtin_bit_cast(int, v), 0x143, 0xc, 0xf, false));
    return __builtin_bit_cast(float, __builtin_amdgcn_readlane(__builtin_bit_cast(int, v), 63));
}

__device__ __forceinline__ int lane_now() { int l; asm volatile("v_mbcnt_lo_u32_b32 %0, -1, 0\n\tv_mbcnt_hi_u32_b32 %0, -1, %0" : "=v"(l)); return l; }
__device__ __forceinline__ float xsum4(float v) {
    const int l = lane_now();
    v += __builtin_bit_cast(float, __builtin_amdgcn_ds_bpermute((l ^ 16) << 2, __builtin_bit_cast(int, v)));
    v += __builtin_bit_cast(float, __builtin_amdgcn_ds_bpermute((l ^ 32) << 2, __builtin_bit_cast(int, v)));
    return v;
}
struct Ctx { int bid, nb, tid, lane, wave; LAS unsigned char* lds; };
__device__ __forceinline__ void group_barrier(unsigned* cnt, unsigned target, bool leader) {
    asm volatile("s_waitcnt vmcnt(0)" ::: "memory");
    __syncthreads();
    if (leader) {
        __builtin_amdgcn_fence(__ATOMIC_RELEASE, "agent");
        asm volatile("s_waitcnt vmcnt(0)" ::: "memory");
        (void)__hip_atomic_fetch_add(cnt, 1u, __ATOMIC_RELAXED, __HIP_MEMORY_SCOPE_AGENT);
        for (unsigned sp = 0; __hip_atomic_load(cnt, __ATOMIC_RELAXED, __HIP_MEMORY_SCOPE_AGENT) < target && sp < (1u << 22); ++sp) __builtin_amdgcn_s_sleep(2);
        __builtin_amdgcn_fence(__ATOMIC_ACQUIRE, "agent");
        asm volatile("s_waitcnt vmcnt(0)" ::: "memory");
    }
    __syncthreads();
}


__device__ __forceinline__ void ph_mod(const Ctx& C, const float* c, const float* ada_w, const float* ada_b, float* MOD) {
    LAS float* sc = (LAS float*)C.lds;
    LAS float* red = (LAS float*)(C.lds + 16384);
    for (int i = C.tid; i < 4096; i += NT) sc[i] = siluf_(c[i]);
    __syncthreads();
    for (int item = C.bid; item < 192; item += C.nb) {
        const int l = item / 96, j0 = (item % 96) * 64;
        const float* W = ada_w + (size_t)l * 1024 * 6144 + j0 + C.lane;
        float a0 = 0.f, a1 = 0.f, a2 = 0.f, a3 = 0.f;
        for (int k = C.wave * 128; k < C.wave * 128 + 128; ++k) { const float wv = W[(size_t)k * 6144]; a0 += sc[k] * wv; a1 += sc[1024 + k] * wv; a2 += sc[2048 + k] * wv; a3 += sc[3072 + k] * wv; }
        red[(C.wave * 4 + 0) * 64 + C.lane] = a0; red[(C.wave * 4 + 1) * 64 + C.lane] = a1; red[(C.wave * 4 + 2) * 64 + C.lane] = a2; red[(C.wave * 4 + 3) * 64 + C.lane] = a3;
        __syncthreads();
        if (C.wave < 4) { const int b = C.wave; float s = ada_b[l * 6144 + j0 + C.lane];
#pragma unroll
            for (int w = 0; w < 8; ++w) s += red[(w * 4 + b) * 64 + C.lane];
            MOD[((size_t)l * 4 + b) * 6144 + j0 + C.lane] = s; }
        __syncthreads();
    }
}

__device__ __forceinline__ void wprep_mat(const Ctx& C, const float* W, int K, int Nsrc, int Ndst, bf16* Wt, int mode, const float* vres) {
    const int half = C.tid >> 8, t = C.tid & 255, tx = t & 31, ty = t >> 5;
    LAS float* tile = (LAS float*)C.lds + half * (32 * 33);
    const int nbn = Ndst / 32, ntile = nbn * (K / 32);
    const int niter = (ntile + 2 * C.nb - 1) / (2 * C.nb);
    for (int it = 0; it < niter; ++it) {
        const int item = (it * C.nb + C.bid) * 2 + half;
        const bool act = item < ntile;
        const int n0 = (item % nbn) * 32, k0 = (item / nbn) * 32, n = n0 + tx;
        if (act) {
#pragma unroll
            for (int i = 0; i < 4; ++i) { const int k = k0 + ty + 8 * i; float v = 0.f;
                if (mode == 0) v = W[(size_t)k * Nsrc + n];
                else if (mode == 2) { const int tl = n >> 8, w = n & 255; v = W[(size_t)k * Nsrc + (w < 128 ? tl * 128 + w : 2816 + tl * 128 + (w - 128))]; }
                else { if (n < 1552) v = W[(size_t)k * Nsrc + n]; else if (n < 1584) v = vres ? vres[(size_t)k * 32 + (n - 1552)] : 0.f; else if (n < 1792) v = 0.f; else v = W[(size_t)k * Nsrc + (n - 240)]; }
                tile[(ty + 8 * i) * 33 + tx] = v; }
        }
        __syncthreads();
        if (act) {
#pragma unroll
            for (int i = 0; i < 4; ++i) { const int nn = n0 + ty + 8 * i; Wt[(size_t)nn * K + k0 + tx] = (bf16)f2bf(tile[tx * 33 + ty + 8 * i]); }
        }
        __syncthreads();
    }
}

__device__ __forceinline__ void ph_norm(const Ctx& C, const float* x, const float* g, const float* sh, const float* sc, bf16* XB) {
    const int gw = C.bid * 8 + C.wave, NGW = C.nb * 8, lane = C.lane;
    for (int m = gw; m < M_; m += NGW) {
        const int b = m / T_;
        const f32x4* xr = (const f32x4*)(x + (size_t)m * D_) + lane;
        f32x4 v[4]; float s = 0.f;
#pragma unroll
        for (int j = 0; j < 4; ++j) { v[j] = xr[64 * j]; s += (v[j].x * v[j].x + v[j].y * v[j].y) + (v[j].z * v[j].z + v[j].w * v[j].w); }
        const float rstd = 1.f / sqrtf(wave_sum(s) * (1.f / D_) + 1e-6f);
        unsigned long long* o8 = (unsigned long long*)(XB + (size_t)m * D_) + lane;
#pragma unroll
        for (int j = 0; j < 4; ++j) { const int col = 4 * lane + 256 * j;
            const f32x4 gv = *(const f32x4*)(g + col), shv = *(const f32x4*)(sh + b * 6144 + col), scv = *(const f32x4*)(sc + b * 6144 + col);
            const f32x4 h = v[j] * rstd * gv * (scv + 1.f) + shv;
            o8[64 * j] = (unsigned long long)pk2(h.x, h.y) | ((unsigned long long)pk2(h.z, h.w) << 32); }
    }
}
__device__ __forceinline__ void ph_final(const Ctx& C, float* x, const float* g) {
    const int gw = C.bid * 8 + C.wave, NGW = C.nb * 8, lane = C.lane;
    for (int m = gw; m < M_; m += NGW) {
        f32x4* xr = (f32x4*)(x + (size_t)m * D_) + lane;
        f32x4 v[4]; float s = 0.f;
#pragma unroll
        for (int j = 0; j < 4; ++j) { v[j] = xr[64 * j]; s += (v[j].x * v[j].x + v[j].y * v[j].y) + (v[j].z * v[j].z + v[j].w * v[j].w); }
        const float rstd = 1.f / sqrtf(wave_sum(s) * (1.f / D_) + 1e-6f);
#pragma unroll
        for (int j = 0; j < 4; ++j) { const f32x4 gv = *(const f32x4*)(g + 4 * lane + 256 * j); xr[64 * j] = v[j] * rstd * gv; }
    }
}


typedef short s16x8 __attribute__((ext_vector_type(8)));
__device__ __forceinline__ f32x4 mm16(const LAS bf16* A, int lda, const LAS bf16* B, int ldb, int K, f32x4 acc, int lane) {
    const int r = lane & 15, g = lane >> 4;
    const LAS bf16* ap = A + r * lda + 8 * g; const LAS bf16* bp = B + r * ldb + 8 * g;
    for (int k0 = 0; k0 < K; k0 += 32) { const s16x8 a = *(const LAS s16x8*)(ap + k0); const s16x8 b = *(const LAS s16x8*)(bp + k0); acc = __builtin_amdgcn_mfma_f32_16x16x32_bf16(a, b, acc, 0, 0, 0); }
    return acc;
}
__device__ __forceinline__ f32x4 mm16_ga(const bf16* A, int lda, const LAS bf16* B, int ldb, int K, f32x4 acc, int lane) {
    const int r = lane & 15, g = lane >> 4;
    const bf16* ap = A + r * lda + 8 * g; const LAS bf16* bp = B + r * ldb + 8 * g;
    for (int k0 = 0; k0 < K; k0 += 32) { const s16x8 a = *(const s16x8*)(ap + k0); const s16x8 b = *(const LAS s16x8*)(bp + k0); acc = __builtin_amdgcn_mfma_f32_16x16x32_bf16(a, b, acc, 0, 0, 0); }
    return acc;
}
__device__ __forceinline__ unsigned long long pack4(f32x4 v) { return (unsigned long long)pk2(v.x, v.y) | ((unsigned long long)pk2(v.z, v.w) << 32); }
__device__ __forceinline__ float logsigmoidf_(float x) { return fminf(x, 0.f) - __logf(1.f + __expf(-fabsf(x))); }

constexpr int GL_LD = 72;
constexpr int GL_GK = 0;
constexpr int GL_SEG = 16384;
constexpr int GL_Z = 18432;
constexpr int GL_GUP = 20480;
constexpr int GL_I0 = 24832;
constexpr int GL_I1 = GL_I0 + 9216;
constexpr int GL_I2 = GL_I1 + 9216;
constexpr int GL_VT = GL_I2 + 9216;
constexpr int GL_SSQ = GL_VT + 18432;
static_assert(GL_SSQ + 512 <= RING_BYTES, "GLA LDS map");

struct GlaRaw { v4u z, k, q, v0, v1; float g0, g1, gb; };
__device__ __forceinline__ void gla_fetch(GlaRaw& R, const Ctx& C, const bf16* pg, const float* gk_up, const float* gk_b, int h, bool want_q) {
    const int tid = C.tid, j = tid >> 3, d0 = (tid & 7) * 8, e0 = (tid & 7) * 16;
    R.z = (v4u){0u, 0u, 0u, 0u}; R.q = R.z;
    if (tid < 128) R.z = *(const v4u*)(pg + (size_t)(tid >> 1) * NPG + 1536 + (tid & 1) * 8);
    R.g0 = gk_up[(tid >> 6) * 256 + h * 64 + (tid & 63)]; R.g1 = gk_up[((tid + NT) >> 6) * 256 + h * 64 + (tid & 63)]; R.gb = gk_b[h * 64 + (tid & 63)];
    R.k = *(const v4u*)(pg + (size_t)j * NPG + 256 + h * 64 + d0);
    if (want_q) R.q = *(const v4u*)(pg + (size_t)j * NPG + h * 64 + d0);
    R.v0 = *(const v4u*)(pg + (size_t)j * NPG + 512 + h * 128 + e0); R.v1 = *(const v4u*)(pg + (size_t)j * NPG + 512 + h * 128 + e0 + 8);
}
__device__ __forceinline__ void gla_gates(const Ctx& C, const GlaRaw& R) {
    LAS float* GK = (LAS float*)(C.lds + GL_GK); LAS float* SEG = (LAS float*)(C.lds + GL_SEG); LAS bf16* Z = (LAS bf16*)(C.lds + GL_Z); LAS float* GUP = (LAS float*)(C.lds + GL_GUP);
    const int tid = C.tid;
    if (tid < 128) { const int t = tid >> 1, hh = tid & 1; *(LAS v4u*)(Z + t * 16 + hh * 8) = R.z; }
    GUP[tid] = R.g0; GUP[tid + NT] = R.g1;
    if (tid < 64) GUP[1024 + tid] = R.gb;
    __syncthreads();
    { const int t = tid >> 3, d0 = (tid & 7) * 8; float a[8];
#pragma unroll
      for (int q = 0; q < 8; ++q) a[q] = GUP[1024 + d0 + q];
#pragma unroll
      for (int i = 0; i < 16; ++i) { const float zv = bf2f(Z[t * 16 + i]);
#pragma unroll
          for (int q = 0; q < 8; ++q) a[q] += zv * GUP[i * 64 + d0 + q]; }
#pragma unroll
      for (int q = 0; q < 8; ++q) GK[t * 64 + d0 + q] = logsigmoidf_(a[q]) * (1.f / 16.f); }
    __syncthreads();
    { const int d = tid & 63, seg = tid >> 6; float run = 0.f;
#pragma unroll
      for (int q = 0; q < 8; ++q) { run += GK[(seg * 8 + q) * 64 + d]; GK[(seg * 8 + q) * 64 + d] = run; }
      SEG[seg * 64 + d] = run; }
    __syncthreads();
    { const int d = tid & 63, seg = tid >> 6; float off = 0.f;
      for (int s = 0; s < seg; ++s) off += SEG[s * 64 + d];
#pragma unroll
      for (int q = 0; q < 8; ++q) GK[(seg * 8 + q) * 64 + d] += off; }
    __syncthreads();
}
__device__ __forceinline__ void gla_stage_vt(const Ctx& C, const GlaRaw& R) {
    LAS bf16* VT = (LAS bf16*)(C.lds + GL_VT);
    const int j = C.tid >> 3, e0 = (C.tid & 7) * 16;
    const unsigned w[8] = {R.v0.x, R.v0.y, R.v0.z, R.v0.w, R.v1.x, R.v1.y, R.v1.z, R.v1.w};
#pragma unroll
    for (int q = 0; q < 8; ++q) { VT[(e0 + 2 * q) * GL_LD + j] = (bf16)(w[q] & 0xffffu); VT[(e0 + 2 * q + 1) * GL_LD + j] = (bf16)(w[q] >> 16); }
}

__device__ __forceinline__ void ph_gla_a(const Ctx& C, const bf16* PG, const float* gk_up, const float* gk_b, bf16* DS, float* GAM) {
    LAS float* GK = (LAS float*)(C.lds + GL_GK); LAS bf16* KT = (LAS bf16*)(C.lds + GL_I0); LAS bf16* VT = (LAS bf16*)(C.lds + GL_VT);
    for (int item = C.bid; item < 2048; item += C.nb) {
        const int bh = item >> 7, c = item & 127, b = bh >> 2, h = bh & 3;
        const size_t m0 = (size_t)b * T_ + c * 64;
        const bf16* pg = PG + m0 * NPG;
        GlaRaw R; gla_fetch(R, C, pg, gk_up, gk_b, h, false);
        gla_gates(C, R);
        { const int j = C.tid >> 3, d0 = (C.tid & 7) * 8;
          const unsigned w[4] = {R.k.x, R.k.y, R.k.z, R.k.w};
#pragma unroll
          for (int q = 0; q < 4; ++q) { const float k0 = bf2f((bf16)(w[q] & 0xffffu)), k1 = bf2f((bf16)(w[q] >> 16));
              const int d = d0 + 2 * q;
              KT[d * GL_LD + j] = (bf16)f2bf(k0 * __expf(GK[63 * 64 + d] - GK[j * 64 + d]));
              KT[(d + 1) * GL_LD + j] = (bf16)f2bf(k1 * __expf(GK[63 * 64 + d + 1] - GK[j * 64 + d + 1])); } }
        gla_stage_vt(C, R);
        if (C.tid < 64) GAM[(size_t)item * 64 + C.tid] = __expf(GK[63 * 64 + C.tid]);
        __syncthreads();
        { const int n0 = C.wave * 16, lane = C.lane, cc = lane & 15, g = lane >> 4;
          bf16* out = DS + (size_t)item * 8192 + (size_t)(n0 + cc) * 64 + 4 * g;
#pragma unroll
          for (int mt = 0; mt < 4; ++mt) { f32x4 acc = {0.f, 0.f, 0.f, 0.f}; acc = mm16(KT + mt * 16 * GL_LD, GL_LD, VT + n0 * GL_LD, GL_LD, 64, acc, lane);
              *(unsigned long long*)(out + mt * 16) = pack4(acc); } }
        __syncthreads();
    }
}
__device__ __forceinline__ void ph_gla_b(const Ctx& C, bf16* DS, const float* GAM) {
    for (int idx = C.bid * NT + C.tid; idx < 16 * 8192; idx += C.nb * NT) {
        const int bh = idx >> 13, ed = idx & 8191, d = ed & 63;
        bf16* p = DS + (size_t)bh * 128 * 8192 + ed; const float* gp = GAM + (size_t)bh * 128 * 64 + d;
        float S = 0.f;
        for (int c0 = 0; c0 < 128; c0 += 8) {
            float ds[8], gm[8];
#pragma unroll
            for (int i = 0; i < 8; ++i) { ds[i] = bf2f(p[(size_t)(c0 + i) * 8192]); gm[i] = gp[(c0 + i) * 64]; }
#pragma unroll
            for (int i = 0; i < 8; ++i) { const float gs = gm[i] * S; p[(size_t)(c0 + i) * 8192] = (bf16)f2bf(gs); S = gs + ds[i]; }
        }
    }
}
__device__ __forceinline__ void ph_gla_c(const Ctx& C, const bf16* PG, const float* gk_up, const float* gk_b, const float* norm_g, const bf16* DS, bf16* O) {
    LAS float* GK = (LAS float*)(C.lds + GL_GK); LAS bf16* QP = (LAS bf16*)(C.lds + GL_I0); LAS bf16* KM = (LAS bf16*)(C.lds + GL_I1); LAS bf16* AI = (LAS bf16*)(C.lds + GL_I2);
    LAS bf16* VT = (LAS bf16*)(C.lds + GL_VT); LAS float* SSQ = (LAS float*)(C.lds + GL_SSQ);
    for (int item = C.bid; item < 2048; item += C.nb) {
        const int bh = item >> 7, c = item & 127, b = bh >> 2, h = bh & 3;
        const size_t m0 = (size_t)b * T_ + c * 64;
        const bf16* pg = PG + m0 * NPG;
        GlaRaw R; gla_fetch(R, C, pg, gk_up, gk_b, h, true);
        s16x8 sfrag[4][2];
        { const int lane = C.lane, cc = lane & 15, g = lane >> 4, eh = C.wave >> 2; const bf16* Sg = DS + (size_t)item * 8192;
#pragma unroll
          for (int mt = 0; mt < 4; ++mt) { sfrag[mt][0] = *(const s16x8*)(Sg + (size_t)(eh * 64 + mt * 16 + cc) * 64 + 8 * g); sfrag[mt][1] = *(const s16x8*)(Sg + (size_t)(eh * 64 + mt * 16 + cc) * 64 + 32 + 8 * g); } }
        gla_gates(C, R);
        { const int j = C.tid >> 3, d0 = (C.tid & 7) * 8;
          const v4u qx = R.q, kx = R.k;
          const unsigned qw[4] = {qx.x, qx.y, qx.z, qx.w}, kw[4] = {kx.x, kx.y, kx.z, kx.w};
          unsigned qo[4], ko[4];
#pragma unroll
          for (int q = 0; q < 4; ++q) { const int d = d0 + 2 * q;
              const float e0 = GK[63 * 64 + d] - GK[j * 64 + d], e1 = GK[63 * 64 + d + 1] - GK[j * 64 + d + 1];
              const float q0 = 0.125f * bf2f((bf16)(qw[q] & 0xffffu)) * __expf(-e0), q1 = 0.125f * bf2f((bf16)(qw[q] >> 16)) * __expf(-e1);
              const float k0 = bf2f((bf16)(kw[q] & 0xffffu)) * __expf(e0), k1 = bf2f((bf16)(kw[q] >> 16)) * __expf(e1);
              qo[q] = pk2(q0, q1); ko[q] = pk2(k0, k1); }
          *(LAS v4u*)(QP + j * GL_LD + d0) = (v4u){qo[0], qo[1], qo[2], qo[3]}; *(LAS v4u*)(KM + j * GL_LD + d0) = (v4u){ko[0], ko[1], ko[2], ko[3]}; }
        gla_stage_vt(C, R);
        __syncthreads();
        { const int lane = C.lane, cc = lane & 15, g = lane >> 4, n0 = (C.wave >> 1) * 16;
#pragma unroll
          for (int q = 0; q < 2; ++q) { const int mt0 = ((C.wave & 1) * 2 + q) * 16; f32x4 acc = {0.f, 0.f, 0.f, 0.f};
              acc = mm16(KM + mt0 * GL_LD, GL_LD, QP + n0 * GL_LD, GL_LD, 64, acc, lane);
              const int i = n0 + cc, j = mt0 + 4 * g;
              acc.x = (j + 0 <= i) ? acc.x : 0.f; acc.y = (j + 1 <= i) ? acc.y : 0.f; acc.z = (j + 2 <= i) ? acc.z : 0.f; acc.w = (j + 3 <= i) ? acc.w : 0.f;
              *(LAS unsigned long long*)(AI + (n0 + cc) * GL_LD + mt0 + 4 * g) = pack4(acc); } }
        __syncthreads();
        { const int lane = C.lane, cc = lane & 15, g = lane >> 4, n0 = (C.wave & 3) * 16, eh = C.wave >> 2;
          f32x4 acc[4]; float ss = 0.f;
#pragma unroll
          for (int mt = 0; mt < 4; ++mt) { const int e0 = eh * 64 + mt * 16; acc[mt] = (f32x4){0.f, 0.f, 0.f, 0.f};
              { const LAS bf16* bp = QP + (n0 + cc) * GL_LD + 8 * g;
                acc[mt] = __builtin_amdgcn_mfma_f32_16x16x32_bf16(sfrag[mt][0], *(const LAS s16x8*)bp, acc[mt], 0, 0, 0); acc[mt] = __builtin_amdgcn_mfma_f32_16x16x32_bf16(sfrag[mt][1], *(const LAS s16x8*)(bp + 32), acc[mt], 0, 0, 0); }
              acc[mt] = mm16(VT + e0 * GL_LD, GL_LD, AI + n0 * GL_LD, GL_LD, 64, acc[mt], lane);
              ss += (acc[mt].x * acc[mt].x + acc[mt].y * acc[mt].y) + (acc[mt].z * acc[mt].z + acc[mt].w * acc[mt].w); }
          ss = xsum4(ss);
          if (g == 0) SSQ[eh * 64 + n0 + cc] = ss;
          __syncthreads();
          const float rstd = 1.f / sqrtf((SSQ[n0 + cc] + SSQ[64 + n0 + cc]) * (1.f / 128.f) + 1e-6f);
          const size_t m = m0 + n0 + cc;
#pragma unroll
          for (int mt = 0; mt < 4; ++mt) { const int e = eh * 64 + mt * 16 + 4 * g;
              const unsigned long long gx = *(const unsigned long long*)(pg + (size_t)(n0 + cc) * NPG + 1024 + h * 128 + e);
              const f32x4 ng = *(const f32x4*)(norm_g + e);
              f32x4 o;
              o.x = acc[mt].x * rstd * ng.x * siluf_(bf2f((bf16)(gx & 0xffffu)));
              o.y = acc[mt].y * rstd * ng.y * siluf_(bf2f((bf16)((gx >> 16) & 0xffffu)));
              o.z = acc[mt].z * rstd * ng.z * siluf_(bf2f((bf16)((gx >> 32) & 0xffffu)));
              o.w = acc[mt].w * rstd * ng.w * siluf_(bf2f((bf16)(gx >> 48)));
              *(unsigned long long*)(O + m * D_ + h * 128 + e) = pack4(o); } }
        __syncthreads();
    }
}


struct RwkvW { const float *mu, *mu_vres, *w0, *a0, *v0, *k_k, *k_a, *r_k; const bf16 *wupT, *aupT, *gupT, *vupT; };
constexpr int RW_LD = 72, RW_XLD = 296;
constexpr int RW_R0 = 0;
constexpr int RW_SEG = 16384;
constexpr int RW_R1 = 36864;
constexpr int RW_R2 = RW_R1 + 27648;
constexpr int RW_R3 = RW_R2 + 9216;
constexpr int RW_R4 = RW_R3 + 27648;
constexpr int RW_TI = RW_R4 + 128 * RW_LD * 2;
constexpr int RW_MU = RW_TI + 2048;
constexpr int RW_X = RW_MU + 2048;
constexpr int RW_END = RW_X + 64 * RW_XLD * 2;
static_assert(RW_END <= MISC_OFF, "RWKV LDS map");

typedef short s16x4 __attribute__((ext_vector_type(4)));
__device__ __forceinline__ float tanh_fast(float x) { const float e = __expf(2.f * x); return 1.f - 2.f / (e + 1.f); }
__device__ __forceinline__ float softplus_fast(float x) { return fmaxf(x, 0.f) + __logf(1.f + __expf(-fabsf(x))); }
__device__ __forceinline__ s16x4 cvt4(f32x4 v) { const unsigned long long p = pack4(v); return __builtin_bit_cast(s16x4, p); }
__device__ __forceinline__ void ld8f(const float* p, float (&o)[8]) { const f32x4 a = *(const f32x4*)p, b = *(const f32x4*)(p + 4); o[0] = a.x; o[1] = a.y; o[2] = a.z; o[3] = a.w; o[4] = b.x; o[5] = b.y; o[6] = b.z; o[7] = b.w; }
__device__ __forceinline__ float sum8(float v) { v += dpp_f<0xB1>(v); v += dpp_f<0x4E>(v); v += dpp_f<0x141>(v); return v; }
__device__ __forceinline__ void unpack8(const v4u x, float (&o)[8]) {
    o[0] = bf2f((bf16)(x.x & 0xffffu)); o[1] = bf2f((bf16)(x.x >> 16)); o[2] = bf2f((bf16)(x.y & 0xffffu)); o[3] = bf2f((bf16)(x.y >> 16));
    o[4] = bf2f((bf16)(x.z & 0xffffu)); o[5] = bf2f((bf16)(x.z >> 16)); o[6] = bf2f((bf16)(x.w & 0xffffu)); o[7] = bf2f((bf16)(x.w >> 16)); }
__device__ __forceinline__ v4u pack8(const float (&o)[8]) { return (v4u){pk2(o[0], o[1]), pk2(o[2], o[3]), pk2(o[4], o[5]), pk2(o[6], o[7])}; }
__device__ __forceinline__ f32x4 mm16_gb(const LAS bf16* A, int lda, const bf16* B, int ldb, int K, f32x4 acc, int lane) {
    const int r = lane & 15, g = lane >> 4;
    const LAS bf16* ap = A + r * lda + 8 * g; const bf16* bp = B + r * ldb + 8 * g;
    for (int k0 = 0; k0 < K; k0 += 32) { const s16x8 a = *(const LAS s16x8*)(ap + k0); const s16x8 b = *(const s16x8*)(bp + k0); acc = __builtin_amdgcn_mfma_f32_16x16x32_bf16(a, b, acc, 0, 0, 0); }
    return acc;
}

__device__ __forceinline__ void ph_rwkv_a(const Ctx& C, const bf16* PR, const bf16* VL  , const RwkvW& W, int layer,
                                          bf16* PP, bf16* QQ, bf16* RH, bf16* YH, float* GAMC, float* RK, bf16* GG, bf16* VF, bool store_v = true) {
    LAS unsigned char* L = C.lds;
    LAS bf16* X = (LAS bf16*)(L + RW_X); LAS float* CUM = (LAS float*)(L + RW_R0); LAS float* SEG = (LAS float*)(L + RW_SEG);
    LAS bf16* NI = (LAS bf16*)(L + RW_R0), *AAK = NI + 64 * RW_LD, *ARB = AAK + 64 * RW_LD, *ARK = ARB + 64 * RW_LD;
    LAS bf16* PRE = (LAS bf16*)(L + RW_R1);
    LAS bf16* AT = (LAS bf16*)(L + RW_R1), *BT = AT + 64 * RW_LD, *KT = BT + 64 * RW_LD, *RT = (LAS bf16*)(L + RW_R2);
    LAS bf16* XB16 = (LAS bf16*)(L + RW_R1);
    LAS bf16* BHc = (LAS bf16*)(L + RW_R3), *KHc = BHc + 64 * RW_LD, *VTc = KHc + 64 * RW_LD;
    LAS bf16* XT = (LAS bf16*)(L + RW_R4); LAS bf16* TI = (LAS bf16*)(L + RW_TI);
    const int wave = C.wave;
    LAS float* MU = (LAS float*)(L + RW_MU);
    for (int i = C.tid; i < 288; i += NT) MU[i] = i < 256 ? W.mu[1536 + i] : (layer ? W.mu_vres[i - 256] : 0.f);
    __syncthreads();
    for (int bc = C.bid; bc < 512; bc += C.nb) {
        const int c = bc & 127, b = bc >> 7;
        const size_t m0 = (size_t)b * T_ + c * 64;
        { const int tid = C.tid;
          v4u xc[5], xp[5];
#pragma unroll
          for (int it = 0; it < 5; ++it) { const int idx = tid + it * NT; xc[it] = (v4u){0u, 0u, 0u, 0u}; xp[it] = xc[it];
            if (idx < 64 * 36) { const int t1 = idx / 36, q = idx % 36, col = q * 8; const size_t m1 = m0 + t1; const bool first1 = (c == 0 && t1 == 0);
                if (q < 32) { xc[it] = *(const v4u*)(PR + m1 * NPR + 1536 + col); if (!first1) xp[it] = *(const v4u*)(PR + (m1 - 1) * NPR + 1536 + col); }
                else if (layer) { xc[it] = *(const v4u*)(VL + m1 * NPG + 1552 + (col - 256)); if (!first1) xp[it] = *(const v4u*)(VL + (m1 - 1) * NPG + 1552 + (col - 256)); } } }
#pragma unroll
          for (int it = 0; it < 5; ++it) { const int idx = tid + it * NT;
            if (idx < 64 * 36) { const int t1 = idx / 36, q = idx % 36, col = q * 8;
                float cv[8], pv[8], mu[8]; unpack8(xc[it], cv); unpack8(xp[it], pv);
                { const f32x4 ma = *(const LAS f32x4*)(MU + col), mb = *(const LAS f32x4*)(MU + col + 4); mu[0] = ma.x; mu[1] = ma.y; mu[2] = ma.z; mu[3] = ma.w; mu[4] = mb.x; mu[5] = mb.y; mu[6] = mb.z; mu[7] = mb.w; }
#pragma unroll
                for (int i = 0; i < 8; ++i) { float p = cv[i] + (pv[i] - cv[i]) * mu[i]; if (q < 8) p = tanh_fast(p); else if (q >= 16 && q < 32) p = sigmoidf_(p); cv[i] = p; }
                *(LAS v4u*)(X + t1 * RW_XLD + col) = pack8(cv); } }
        }
        __syncthreads();
#pragma unroll 1
      for (int h = 0; h < 8; ++h) {
        const int item = bc * 8 + h;
        int tid_ = C.tid; asm volatile("" : "+v"(tid_));
        const int tid = tid_, lane = tid & 63, cc = lane & 15, g = lane >> 4;
        const int t = tid >> 3, d0 = (tid & 7) * 8, ch = h * 64 + d0; const size_t m = m0 + t; const bool first = (c == 0 && t == 0);
        v4u rcx = *(const v4u*)(PR + m * NPR + ch), kcx = *(const v4u*)(PR + m * NPR + 512 + ch), vcx = *(const v4u*)(PR + m * NPR + 1024 + ch);
        v4u rpx = (v4u){0u, 0u, 0u, 0u}, kpx = rpx, vpx = rpx, vfx = rpx;
        if (!first) { rpx = *(const v4u*)(PR + (m - 1) * NPR + ch); kpx = *(const v4u*)(PR + (m - 1) * NPR + 512 + ch); vpx = *(const v4u*)(PR + (m - 1) * NPR + 1024 + ch); }
        if (layer) vfx = *(const v4u*)(VF + m * 512 + ch);
        {
            const int lsel = wave >> 1;
            const bf16* WT = lsel == 0 ? W.wupT : lsel == 1 ? W.aupT : lsel == 2 ? W.gupT : W.vupT;
            const int Kl = lsel == 2 ? 128 : lsel == 3 ? 32 : 64, xoff = lsel == 0 ? 0 : lsel == 1 ? 64 : lsel == 2 ? 128 : 256;
            LAS bf16* outp = PRE + lsel * 64 * RW_LD;
            const bool live = (lsel != 3 || layer);
#pragma unroll
            for (int mq = 0; mq < 2; ++mq) { const int mt = (wave & 1) * 2 + mq;
                s16x8 af[4];
                const bf16* ap = WT + (size_t)(h * 64 + mt * 16 + cc) * Kl + 8 * g;
#pragma unroll
                for (int ks = 0; ks < 4; ++ks) af[ks] = (live && ks * 32 < Kl) ? *(const s16x8*)(ap + ks * 32) : (s16x8){0, 0, 0, 0, 0, 0, 0, 0};
#pragma unroll
                for (int nt = 0; nt < 4; ++nt) { f32x4 acc = {0.f, 0.f, 0.f, 0.f};
                    const LAS bf16* bp = X + (nt * 16 + cc) * RW_XLD + xoff + 8 * g;
#pragma unroll
                    for (int ks = 0; ks < 4; ++ks) if (ks * 32 < Kl) { const s16x8 bb = *(const LAS s16x8*)(bp + ks * 32); acc = __builtin_amdgcn_mfma_f32_16x16x32_bf16(af[ks], bb, acc, 0, 0, 0); }
                    *(LAS unsigned long long*)(outp + (nt * 16 + cc) * RW_LD + mt * 16 + 4 * g) = pack4(acc); } }
        }
        __syncthreads();
        float av[8], bv[8], kv[8], rv[8], lw[8], vv[8];
        {
            float rc[8], rp[8], kc[8], kp[8], vc[8], vp[8], pw[8], pa[8], pg_[8], pvg[8];
            unpack8(rcx, rc); unpack8(kcx, kc); unpack8(vcx, vc); unpack8(rpx, rp); unpack8(kpx, kp); unpack8(vpx, vp);
            unpack8(*(const LAS v4u*)(PRE + (0 * 64 + t) * RW_LD + d0), pw); unpack8(*(const LAS v4u*)(PRE + (1 * 64 + t) * RW_LD + d0), pa);
            unpack8(*(const LAS v4u*)(PRE + (2 * 64 + t) * RW_LD + d0), pg_); unpack8(*(const LAS v4u*)(PRE + (3 * 64 + t) * RW_LD + d0), pvg);
            float vf[8]; unpack8(vfx, vf);
            float ssq = 0.f, rks = 0.f, asg[8], gg[8];
            float mur[8], muk[8], muv[8], w0c[8], a0c[8], v0c[8], kkc[8], kac[8], rkc[8];
            ld8f(W.mu + ch, mur); ld8f(W.mu + 512 + ch, muk); ld8f(W.mu + 1024 + ch, muv); ld8f(W.w0 + ch, w0c); ld8f(W.a0 + ch, a0c);
            ld8f(W.k_k + ch, kkc); ld8f(W.k_a + ch, kac); ld8f(W.r_k + ch, rkc);
            if (layer) ld8f(W.v0 + ch, v0c);
#pragma unroll
            for (int i = 0; i < 8; ++i) {
                const float r = rc[i] + (rp[i] - rc[i]) * mur[i], k = kc[i] + (kp[i] - kc[i]) * muk[i]; float v = vc[i] + (vp[i] - vc[i]) * muv[i];
                lw[i] = -0.6065306597f * sigmoidf_(w0c[i] + pw[i]);
                asg[i] = sigmoidf_(a0c[i] + pa[i]);
                if (layer) v = v + (vf[i] - v) * sigmoidf_(v0c[i] + pvg[i]);
                const float kk = k * kkc[i]; ssq += kk * kk;
                kv[i] = k * (1.f + (asg[i] - 1.f) * kac[i]); rv[i] = r; vv[i] = v; gg[i] = pg_[i]; av[i] = kk;
                rks += r * kv[i] * rkc[i];
            }
            ssq = sum8(ssq); rks = sum8(rks);
            const float inv = 1.f / sqrtf(fmaxf(ssq, 1e-24f));
#pragma unroll
            for (int i = 0; i < 8; ++i) { const float kk = av[i] * inv; av[i] = -kk; bv[i] = kk * asg[i]; }
            if ((tid & 7) == 0) RK[m * 8 + h] = rks;
            *(v4u*)(GG + m * 512 + ch) = pack8(gg);
            if (store_v) *(v4u*)(VF + m * 512 + ch) = pack8(vv);
#pragma unroll
            for (int i = 0; i < 8; ++i) vv[i] = bf2f((bf16)f2bf(vv[i]));
        }
        __syncthreads();
#pragma unroll
        for (int i = 0; i < 8; ++i) CUM[t * 64 + d0 + i] = lw[i];
        __syncthreads();
        { const int d = tid & 63, seg = tid >> 6; float run = 0.f;
#pragma unroll
          for (int q = 0; q < 8; ++q) { run += CUM[(seg * 8 + q) * 64 + d]; CUM[(seg * 8 + q) * 64 + d] = run; }
          SEG[seg * 64 + d] = run; }
        __syncthreads();
        { const int d = tid & 63, seg = tid >> 6; float off = 0.f;
          for (int s = 0; s < seg; ++s) off += SEG[s * 64 + d];
#pragma unroll
          for (int q = 0; q < 8; ++q) CUM[(seg * 8 + q) * 64 + d] += off; }
        __syncthreads();
        {
            float at[8], bt[8], kt[8], rt[8];
#pragma unroll
            for (int i = 0; i < 8; ++i) { const float cu = CUM[t * 64 + d0 + i], cC = CUM[63 * 64 + d0 + i], en = __expf(-cu), ec = __expf(cC - cu);
                at[i] = av[i] * __expf(cu - lw[i]); bt[i] = bv[i] * en; kt[i] = kv[i] * en; rt[i] = rv[i] * __expf(cu);
                BHc[(d0 + i) * RW_LD + t] = (bf16)f2bf(bv[i] * ec); KHc[(d0 + i) * RW_LD + t] = (bf16)f2bf(kv[i] * ec); VTc[(d0 + i) * RW_LD + t] = (bf16)f2bf(vv[i]);
                XT[(d0 + i) * RW_LD + t] = (bf16)f2bf(at[i]);
                if (t == 63) GAMC[(size_t)item * 64 + d0 + i] = __expf(cC); }
            *(LAS v4u*)(AT + t * RW_LD + d0) = pack8(at); *(LAS v4u*)(BT + t * RW_LD + d0) = pack8(bt); *(LAS v4u*)(KT + t * RW_LD + d0) = pack8(kt); *(LAS v4u*)(RT + t * RW_LD + d0) = pack8(rt);
        }
        __syncthreads();
        {
            const int msel = wave >> 1;
            const LAS bf16* As = (msel == 0 || msel == 2) ? BT : KT; const LAS bf16* Bs = (msel < 2) ? AT : RT;
            f32x4 accs[8];
#pragma unroll
            for (int q = 0; q < 8; ++q) { const int tile = (wave & 1) * 8 + q, mt = tile >> 2, nt = tile & 3; accs[q] = (f32x4){0.f, 0.f, 0.f, 0.f};
                accs[q] = mm16(As + mt * 16 * RW_LD, RW_LD, Bs + nt * 16 * RW_LD, RW_LD, 64, accs[q], lane);
                const int tt = nt * 16 + cc, s0 = mt * 16 + 4 * g, lim = (msel < 2) ? tt - 1 : tt;
                accs[q].x = (s0 + 0 <= lim) ? accs[q].x : 0.f; accs[q].y = (s0 + 1 <= lim) ? accs[q].y : 0.f; accs[q].z = (s0 + 2 <= lim) ? accs[q].z : 0.f; accs[q].w = (s0 + 3 <= lim) ? accs[q].w : 0.f; }
            __syncthreads();
            LAS bf16* outp = NI + msel * 64 * RW_LD;
#pragma unroll
            for (int q = 0; q < 8; ++q) { const int tile = (wave & 1) * 8 + q, mt = tile >> 2, nt = tile & 3;
                *(LAS unsigned long long*)(outp + (nt * 16 + cc) * RW_LD + mt * 16 + 4 * g) = pack4(accs[q]); }
        }
        __syncthreads();
        if (wave == 0) {
            const int blk = lane >> 4, col = lane & 15; float x[16];
#pragma unroll
            for (int tt = 0; tt < 16; ++tt) { float nr[16]; { float lo[8], hi[8]; unpack8(*(const LAS v4u*)(NI + (16 * blk + tt) * RW_LD + 16 * blk), lo); unpack8(*(const LAS v4u*)(NI + (16 * blk + tt) * RW_LD + 16 * blk + 8), hi);
#pragma unroll
                    for (int q = 0; q < 8; ++q) { nr[q] = lo[q]; nr[8 + q] = hi[q]; } }
                float a = (tt == col) ? 1.f : 0.f;
#pragma unroll
                for (int q = 0; q < tt; ++q) a += nr[q] * x[q];
                x[tt] = a; TI[(blk * 16 + tt) * 16 + col] = (bf16)f2bf(a); }
        } else {
            for (int tile = wave - 1; tile < 16; tile += 7) { const int mt = tile >> 2, nt = tile & 3;
                f32x4 acc = {0.f, 0.f, 0.f, 0.f}; acc = mm16(AAK + mt * 16 * RW_LD, RW_LD, VTc + nt * 16 * RW_LD, RW_LD, 64, acc, lane);
                *(LAS unsigned long long*)(XT + (64 + nt * 16 + cc) * RW_LD + mt * 16 + 4 * g) = pack4(acc); }
        }
        __syncthreads();
        {
            s16x4 xb[4];
#pragma unroll
            for (int i = 0; i < 4; ++i) {
                f32x4 acc; { const unsigned long long xr = *(const LAS unsigned long long*)(XT + (wave * 16 + cc) * RW_LD + 16 * i + 4 * g);
                    acc.x = bf2f((bf16)(xr & 0xffffu)); acc.y = bf2f((bf16)((xr >> 16) & 0xffffu)); acc.z = bf2f((bf16)((xr >> 32) & 0xffffu)); acc.w = bf2f((bf16)(xr >> 48)); }
#pragma unroll
                for (int k = 0; k < i; ++k) { const s16x4 a = *(const LAS s16x4*)(NI + (16 * i + cc) * RW_LD + 16 * k + 4 * g); acc = __builtin_amdgcn_mfma_f32_16x16x16bf16_1k(a, xb[k], acc, 0, 0, 0); }
                const s16x4 yb = cvt4(acc), ta = *(const LAS s16x4*)(TI + (i * 16 + cc) * 16 + 4 * g);
                const f32x4 xi = __builtin_amdgcn_mfma_f32_16x16x16bf16_1k(ta, yb, (f32x4){0.f, 0.f, 0.f, 0.f}, 0, 0, 0);
                xb[i] = cvt4(xi);
            }
            __syncthreads();
#pragma unroll
            for (int i = 0; i < 4; ++i) *(LAS s16x4*)(XB16 + (wave * 16 + cc) * RW_LD + 16 * i + 4 * g) = xb[i];
        }
        __syncthreads();
        {
            const int osel = wave >> 1; const size_t ob = (size_t)item * 4096;
#pragma unroll 1
            for (int q = 0; q < 8; ++q) { const int tile = (wave & 1) * 8 + q, mt = tile >> 2, nt = tile & 3; f32x4 acc = {0.f, 0.f, 0.f, 0.f};
                if (osel == 0) {
                    acc = mm16(XB16 + mt * 16 * RW_LD, RW_LD, BHc + nt * 16 * RW_LD, RW_LD, 64, acc, lane);
                    *(unsigned long long*)(PP + ob + (nt * 16 + cc) * 64 + mt * 16 + 4 * g) = pack4(acc);
                } else if (osel == 1) {
                    acc = mm16(BHc + mt * 16 * RW_LD, RW_LD, XB16 + (64 + nt * 16) * RW_LD, RW_LD, 64, acc, lane);
                    acc = mm16(KHc + mt * 16 * RW_LD, RW_LD, VTc + nt * 16 * RW_LD, RW_LD, 64, acc, lane);
                    *(unsigned long long*)(QQ + ob + (nt * 16 + cc) * 64 + mt * 16 + 4 * g) = pack4(acc);
                } else if (osel == 2) {
                    acc = mm16(XB16 + mt * 16 * RW_LD, RW_LD, ARB + nt * 16 * RW_LD, RW_LD, 64, acc, lane);
                    const unsigned long long rr = *(const LAS unsigned long long*)(RT + (nt * 16 + cc) * RW_LD + mt * 16 + 4 * g);
                    acc.x += bf2f((bf16)(rr & 0xffffu)); acc.y += bf2f((bf16)((rr >> 16) & 0xffffu)); acc.z += bf2f((bf16)((rr >> 32) & 0xffffu)); acc.w += bf2f((bf16)(rr >> 48));
                    *(unsigned long long*)(RH + ob + (nt * 16 + cc) * 64 + mt * 16 + 4 * g) = pack4(acc);
                } else {
                    acc = mm16(XB16 + (64 + mt * 16) * RW_LD, RW_LD, ARB + nt * 16 * RW_LD, RW_LD, 64, acc, lane);
                    acc = mm16(VTc + mt * 16 * RW_LD, RW_LD, ARK + nt * 16 * RW_LD, RW_LD, 64, acc, lane);
                    *(unsigned long long*)(YH + ob + (nt * 16 + cc) * 64 + mt * 16 + 4 * g) = pack4(acc);
                } }
        }
        __syncthreads();
      }
    }
}

constexpr int CH_R = 6, CH_SLOT = 9216 + 9216 + 256;
constexpr int CH_RING = 0, CH_SI = CH_R * CH_SLOT, CH_FLAGS = CH_SI + 4 * 2304;
static_assert(CH_FLAGS + 64 <= MISC_OFF, "chain LDS map");
struct ChainRegs { v4u p[8], q[8]; f32x4 gm; };
__device__ __forceinline__ void chain_fetch(ChainRegs& o, const bf16* PP, const bf16* QQ, const float* GAMC, int item, int lane) {
    const size_t ob = (size_t)item * 4096;
#pragma unroll
    for (int i = 0; i < 8; ++i) { o.p[i] = *(const v4u*)(PP + ob + (size_t)(i * 64 + lane) * 8); o.q[i] = *(const v4u*)(QQ + ob + (size_t)(i * 64 + lane) * 8); }
    o.gm = *(const f32x4*)(GAMC + (size_t)item * 64 + (lane & 15) * 4);
}
__device__ __forceinline__ void chain_commit(const ChainRegs& o, LAS unsigned char* L, int c, int lane) {
    volatile LAS unsigned* flags = (volatile LAS unsigned*)(L + CH_FLAGS);
    const int slot = c % CH_R;
    if (c >= CH_R) { const unsigned need = (unsigned)(c - CH_R + 1);
        for (;;) { const unsigned m0 = flags[CH_R + 0], m1 = flags[CH_R + 1], m2 = flags[CH_R + 2], m3 = flags[CH_R + 3];
            if (m0 >= need && m1 >= need && m2 >= need && m3 >= need) break; __builtin_amdgcn_s_sleep(1); } }
    asm volatile("" ::: "memory");
    LAS unsigned char* sl = L + CH_RING + slot * CH_SLOT;
#pragma unroll
    for (int i = 0; i < 8; ++i) { const int idx = i * 64 + lane, row = idx >> 3, c16 = idx & 7;
        *(LAS v4u*)(sl + row * 144 + c16 * 16) = o.p[i]; *(LAS v4u*)(sl + 9216 + row * 144 + c16 * 16) = o.q[i]; }
    if (lane < 16) *(LAS f32x4*)(sl + 18432 + lane * 16) = o.gm;
    asm volatile("s_waitcnt lgkmcnt(0)" ::: "memory");
    if (lane == 0) flags[slot] = (unsigned)(c + 1);
}
__device__ __forceinline__ void ph_rwkv_b(const Ctx& C, int bh  , const bf16* PP, const bf16* QQ, const float* GAMC, bf16* S0) {
    const int lane = C.lane, wave = C.wave, cc = lane & 15, g = lane >> 4, b = bh >> 3, h = bh & 7;
    LAS unsigned char* L = C.lds;
    volatile LAS unsigned* flags = (volatile LAS unsigned*)(L + CH_FLAGS);
    if (C.tid < 16) flags[C.tid] = 0u;
    __syncthreads();
    if (wave >= 4) {
        const int j = wave - 4;
        ChainRegs A, B;
        int lc = j;
        chain_fetch(A, PP, QQ, GAMC, (b * 128 + lc) * 8 + h, lane);
        for (;;) {
            if (lc + 4 < 128) chain_fetch(B, PP, QQ, GAMC, (b * 128 + lc + 4) * 8 + h, lane);
            chain_commit(A, L, lc, lane);
            lc += 4; if (lc >= 128) break;
            if (lc + 4 < 128) chain_fetch(A, PP, QQ, GAMC, (b * 128 + lc + 4) * 8 + h, lane);
            chain_commit(B, L, lc, lane);
            lc += 4; if (lc >= 128) break;
        }
    } else {
        const int vt = wave;
        LAS bf16* SI = (LAS bf16*)(L + CH_SI + vt * 2304);
        f32x4 st[4];
#pragma unroll
        for (int mt = 0; mt < 4; ++mt) st[mt] = (f32x4){0.f, 0.f, 0.f, 0.f};
        for (int c = 0; c < 128; ++c) {
            const int item = (b * 128 + c) * 8 + h, slot = c % CH_R; const size_t ob = (size_t)item * 4096;
#pragma unroll
            for (int mt = 0; mt < 4; ++mt) { const unsigned long long pk = pack4(st[mt]);
                *(unsigned long long*)(S0 + ob + (vt * 16 + cc) * 64 + mt * 16 + 4 * g) = pk; *(LAS unsigned long long*)(SI + cc * RW_LD + mt * 16 + 4 * g) = pk; }
            while (flags[slot] < (unsigned)(c + 1)) __builtin_amdgcn_s_sleep(1);
            asm volatile("s_waitcnt lgkmcnt(0)" ::: "memory");
            const LAS unsigned char* sl = L + CH_RING + slot * CH_SLOT;
            const LAS bf16* Pi = (const LAS bf16*)sl; const LAS bf16* Qi = (const LAS bf16*)(sl + 9216); const LAS float* Gi = (const LAS float*)(sl + 18432);
            const s16x8 b0 = *(const LAS s16x8*)(SI + cc * RW_LD + 8 * g), b1 = *(const LAS s16x8*)(SI + cc * RW_LD + 32 + 8 * g);
#pragma unroll
            for (int mt = 0; mt < 4; ++mt) {
                const f32x4 gm = *(const LAS f32x4*)(Gi + mt * 16 + 4 * g);
                const unsigned long long qq = *(const LAS unsigned long long*)(Qi + (vt * 16 + cc) * RW_LD + mt * 16 + 4 * g);
                const s16x8 a0 = *(const LAS s16x8*)(Pi + (mt * 16 + cc) * RW_LD + 8 * g), a1 = *(const LAS s16x8*)(Pi + (mt * 16 + cc) * RW_LD + 32 + 8 * g);
                f32x4 acc; acc.x = gm.x * st[mt].x + bf2f((bf16)(qq & 0xffffu)); acc.y = gm.y * st[mt].y + bf2f((bf16)((qq >> 16) & 0xffffu));
                acc.z = gm.z * st[mt].z + bf2f((bf16)((qq >> 32) & 0xffffu)); acc.w = gm.w * st[mt].w + bf2f((bf16)(qq >> 48));
                acc = __builtin_amdgcn_mfma_f32_16x16x32_bf16(a0, b0, acc, 0, 0, 0); acc = __builtin_amdgcn_mfma_f32_16x16x32_bf16(a1, b1, acc, 0, 0, 0);
                st[mt] = acc; }
            asm volatile("s_waitcnt lgkmcnt(0)" ::: "memory");
            if (lane == 0) flags[CH_R + vt] = (unsigned)(c + 1);
        }
    }
    __syncthreads();
}

__device__ __forceinline__ void ph_rwkv_c(const Ctx& C, const bf16* S0, const bf16* RH, const bf16* YH, const float* RK, const bf16* GG, const bf16* VF,
                                          const float* gn_g, const float* gn_b, bf16* O) {
    const int lane = C.lane, cc = lane & 15, g = lane >> 4;
    for (int item = C.bid * 8 + C.wave; item < 4096; item += C.nb * 8) {
        const int h = item & 7, c = (item >> 3) & 127, b = item >> 10; const size_t m0 = (size_t)b * T_ + c * 64, ob = (size_t)item * 4096;
        s16x8 af[4][2], bfr[4][2];
#pragma unroll
        for (int q = 0; q < 4; ++q)
#pragma unroll
            for (int k = 0; k < 2; ++k) { af[q][k] = *(const s16x8*)(S0 + ob + (q * 16 + cc) * 64 + k * 32 + 8 * g); bfr[q][k] = *(const s16x8*)(RH + ob + (q * 16 + cc) * 64 + k * 32 + 8 * g); }
#pragma unroll
        for (int nt = 0; nt < 4; ++nt) {
            const size_t m = m0 + nt * 16 + cc;
            f32x4 y[4]; float s1 = 0.f;
#pragma unroll
            for (int mt = 0; mt < 4; ++mt) { const unsigned long long yh = *(const unsigned long long*)(YH + ob + (nt * 16 + cc) * 64 + mt * 16 + 4 * g);
                f32x4 acc; acc.x = bf2f((bf16)(yh & 0xffffu)); acc.y = bf2f((bf16)((yh >> 16) & 0xffffu)); acc.z = bf2f((bf16)((yh >> 32) & 0xffffu)); acc.w = bf2f((bf16)(yh >> 48));
                acc = __builtin_amdgcn_mfma_f32_16x16x32_bf16(af[mt][0], bfr[nt][0], acc, 0, 0, 0); acc = __builtin_amdgcn_mfma_f32_16x16x32_bf16(af[mt][1], bfr[nt][1], acc, 0, 0, 0);
                y[mt] = acc; s1 += (acc.x + acc.y) + (acc.z + acc.w); }
            s1 = xsum4(s1);
            const float mean = s1 * (1.f / 64.f); float s2 = 0.f;
#pragma unroll
            for (int mt = 0; mt < 4; ++mt) { y[mt] = y[mt] - mean; s2 += (y[mt].x * y[mt].x + y[mt].y * y[mt].y) + (y[mt].z * y[mt].z + y[mt].w * y[mt].w); }
            s2 = xsum4(s2);
            const float rstd = 1.f / sqrtf(s2 * (1.f / 64.f) + 64e-5f), rk = RK[m * 8 + h];
#pragma unroll
            for (int mt = 0; mt < 4; ++mt) { const int v = h * 64 + mt * 16 + 4 * g;
                const f32x4 gg4 = *(const f32x4*)(gn_g + v), gb4 = *(const f32x4*)(gn_b + v);
                const unsigned long long vx = *(const unsigned long long*)(VF + m * 512 + v), gx = *(const unsigned long long*)(GG + m * 512 + v);
                f32x4 o;
                o.x = (y[mt].x * rstd * gg4.x + gb4.x + rk * bf2f((bf16)(vx & 0xffffu))) * bf2f((bf16)(gx & 0xffffu));
                o.y = (y[mt].y * rstd * gg4.y + gb4.y + rk * bf2f((bf16)((vx >> 16) & 0xffffu))) * bf2f((bf16)((gx >> 16) & 0xffffu));
                o.z = (y[mt].z * rstd * gg4.z + gb4.z + rk * bf2f((bf16)((vx >> 32) & 0xffffu))) * bf2f((bf16)((gx >> 32) & 0xffffu));
                o.w = (y[mt].w * rstd * gg4.w + gb4.w + rk * bf2f((bf16)(vx >> 48))) * bf2f((bf16)(gx >> 48));
                *(unsigned long long*)(O + m * D_ + 512 + v) = pack4(o); }
        }
    }
}

__device__ __forceinline__ void ph_convfix(const Ctx& C, const float* HALO, const float* FIXU, const float* cw, const float* cb, bf16* ACT) {
    for (int idx = C.bid * NT + C.tid; idx < 128 * 22 * 2 * 128; idx += C.nb * NT) {
        const int j = idx & 127, rr = (idx >> 7) & 1, tile = idx >> 8, pm = tile / 22, pn = tile % 22;
        const bool seq0 = (pm & 31) == 0;
        const float* fx = FIXU + (size_t)tile * 512; const float* hl = HALO + (size_t)(tile - 22) * 512;
        const float u0g = fx[rr * 256 + j], u0v = fx[rr * 256 + 128 + j];
        float u1g, u1v, u2g, u2v;
        if (rr == 0) { u1g = seq0 ? 0.f : hl[256 + j]; u1v = seq0 ? 0.f : hl[256 + 128 + j]; u2g = seq0 ? 0.f : hl[j]; u2v = seq0 ? 0.f : hl[128 + j]; }
        else { u1g = fx[j]; u1v = fx[128 + j]; u2g = seq0 ? 0.f : hl[256 + j]; u2v = seq0 ? 0.f : hl[256 + 128 + j]; }
        const int jg = pn * 128 + j, jv = DFF + jg;
        const float gc = cb[jg] + cw[jg] * u2g + cw[NUP + jg] * u1g + cw[2 * NUP + jg] * u0g, vc = cb[jv] + cw[jv] * u2v + cw[NUP + jv] * u1v + cw[2 * NUP + jv] * u0v;
        ACT[(size_t)(pm * 256 + rr) * DFF + jg] = (bf16)f2bf(siluf_(gc) * vc);
    }
}
}

namespace pg8 {
struct EpiRes {
    static constexpr bool PERM = false, AFTER_DRAIN = false;
    const float* base; float* out; const float* gate; int gstride;
    __device__ __forceinline__ void operator()(const f32x4 (&acc)[2][2][4][2], const Unit& u, int wr, int wc, int fr, int fq) const {
        const int b = (u.pm * BM) / 8192; const float* gp = gate + (size_t)b * gstride;
        const int col0 = u.pn * BM + wc * 32 + 4 * fq;
        f32x4 gv[2][2];
#pragma unroll
        for (int bj = 0; bj < 2; ++bj)
#pragma unroll
            for (int n = 0; n < 2; ++n) gv[bj][n] = *(const f32x4*)(gp + col0 + bj * HALF + n * 16);
#pragma unroll
        for (int ai = 0; ai < 2; ++ai)
#pragma unroll
            for (int m = 0; m < 4; ++m) { const size_t off = (size_t)(u.pm * BM + ai * HALF + wr * 64 + m * 16 + fr) * 1024 + col0;
                f32x4 bs[2][2];
#pragma unroll
                for (int bj = 0; bj < 2; ++bj)
#pragma unroll
                    for (int n = 0; n < 2; ++n) bs[bj][n] = *(const f32x4*)(base + off + bj * HALF + n * 16);
#pragma unroll
                for (int bj = 0; bj < 2; ++bj)
#pragma unroll
                    for (int n = 0; n < 2; ++n) *(f32x4*)(out + off + bj * HALF + n * 16) = bs[bj][n] + gv[bj][n] * acc[ai][bj][m][n]; }
    }
};
struct EpiConv {
    static constexpr bool PERM = true, AFTER_DRAIN = false;
    bf16_t* ACT; const float* cw; const float* cb; float* HALO; float* FIXU; PG8_LAS float* EX; int nN;
    template <int CTRL> static __device__ __forceinline__ float rot(float x) { return __builtin_bit_cast(float, __builtin_amdgcn_update_dpp(0, __builtin_bit_cast(int, x), CTRL, 0xf, 0xf, false)); }
    template <int CTRL> static __device__ __forceinline__ f32x4 rot4(f32x4 x) { return (f32x4){rot<CTRL>(x.x), rot<CTRL>(x.y), rot<CTRL>(x.z), rot<CTRL>(x.w)}; }
    __device__ __forceinline__ void operator()(const f32x4 (&acc)[2][2][4][2], const Unit& u, int wr, int wc, int fr, int fq) const {
        const int colw = wc * 32 + 8 * fq, tile = u.pm * nN + u.pn;
        if (fr >= 14) {
#pragma unroll
            for (int ai = 0; ai < 2; ++ai)
#pragma unroll
                for (int bj = 0; bj < 2; ++bj)
#pragma unroll
                    for (int n = 0; n < 2; ++n) { *(PG8_LAS f32x4*)(EX + ((ai * 2 + wr) * 2 + (fr - 14)) * 256 + bj * 128 + colw + 4 * n) = acc[ai][bj][3][n];
                        if (ai == 1 && wr == 1) *(f32x4*)(HALO + ((size_t)tile * 2 + (fr - 14)) * 256 + bj * 128 + colw + 4 * n) = acc[1][bj][3][n]; }
        }
        if (fr < 2 && wr == 0) {
#pragma unroll
            for (int bj = 0; bj < 2; ++bj)
#pragma unroll
                for (int n = 0; n < 2; ++n) *(f32x4*)(FIXU + ((size_t)tile * 2 + fr) * 256 + bj * 128 + colw + 4 * n) = acc[0][bj][0][n];
        }
        asm volatile("s_waitcnt lgkmcnt(0)" ::: "memory"); __builtin_amdgcn_s_barrier(); asm volatile("" ::: "memory");
#pragma unroll
        for (int n = 0; n < 2; ++n) {
            const int jg = u.pn * 128 + colw + 4 * n, jv = 2816 + jg;
            f32x4 cw0[2], cw1[2], cw2[2], cbb[2];
            cw0[0] = *(const f32x4*)(cw + jg); cw1[0] = *(const f32x4*)(cw + 5632 + jg); cw2[0] = *(const f32x4*)(cw + 2 * 5632 + jg); cbb[0] = *(const f32x4*)(cb + jg);
            cw0[1] = *(const f32x4*)(cw + jv); cw1[1] = *(const f32x4*)(cw + 5632 + jv); cw2[1] = *(const f32x4*)(cw + 2 * 5632 + jv); cbb[1] = *(const f32x4*)(cb + jv);
#pragma unroll
            for (int ai = 0; ai < 2; ++ai)
#pragma unroll
                for (int m = 0; m < 4; ++m) {
                    const int src = ai * 2 + wr - 1;
                    f32x4 res[2];
#pragma unroll
                    for (int bj = 0; bj < 2; ++bj) {
                        const f32x4 x = acc[ai][bj][m][n];
                        f32x4 x1 = rot4<0x121>(x), x2 = rot4<0x122>(x);
                        if (m > 0) { const f32x4 q = acc[ai][bj][m > 0 ? m - 1 : 0][n]; const f32x4 q1 = rot4<0x121>(q), q2 = rot4<0x122>(q);
                            if (fr == 0) x1 = q1; if (fr < 2) x2 = q2; }
                        else if (fr < 2) { f32x4 e14 = {0.f, 0.f, 0.f, 0.f}, e15 = e14;
                            if (src >= 0) { e14 = *(const PG8_LAS f32x4*)(EX + (src * 2 + 0) * 256 + bj * 128 + colw + 4 * n); e15 = *(const PG8_LAS f32x4*)(EX + (src * 2 + 1) * 256 + bj * 128 + colw + 4 * n); }
                            if (fr == 0) { x1 = e15; x2 = e14; } else x2 = e15; }
                        const f32x4 w0 = cw0[bj], w1 = cw1[bj], w2 = cw2[bj], bb = cbb[bj];
                        res[bj] = bb + w0 * x2 + w1 * x1 + w2 * x;
                    }
                    const f32x4 gc = res[0], vc = res[1];
                    f32x4 o;
                    o.x = gc.x * __builtin_amdgcn_rcpf(1.f + __expf(-gc.x)) * vc.x; o.y = gc.y * __builtin_amdgcn_rcpf(1.f + __expf(-gc.y)) * vc.y;
                    o.z = gc.z * __builtin_amdgcn_rcpf(1.f + __expf(-gc.z)) * vc.z; o.w = gc.w * __builtin_amdgcn_rcpf(1.f + __expf(-gc.w)) * vc.w;
                    typedef unsigned u32x2 __attribute__((ext_vector_type(2)));
                    u32x2 w; w.x = cvt_pk_bf16(o.x, o.y); w.y = cvt_pk_bf16(o.z, o.w);
                    *(u32x2*)(ACT + (size_t)(u.pm * BM + ai * HALF + wr * 64 + m * 16 + fr) * 2816 + u.pn * 128 + colw + 4 * n) = w;
                }
        }
    }
};
}

namespace hy {
struct Args { const float* in[31]; float* out; unsigned char* ws; };
__global__ void __launch_bounds__(NT, 2) hy_fwd(Args A) {
    extern __shared__ __attribute__((aligned(16))) unsigned char lds_raw[];
    Ctx C; C.bid = blockIdx.x; C.nb = gridDim.x; C.tid = threadIdx.x; C.lane = C.tid & 63; C.wave = __builtin_amdgcn_readfirstlane(C.tid >> 6); C.lds = (LAS unsigned char*)lds_raw;
    volatile LAS unsigned* MISC = (volatile LAS unsigned*)(C.lds + MISC_OFF);
    for (int u = C.tid; u < (LDS_BYTES - MISC_OFF) / 4; u += NT) ((LAS unsigned*)(C.lds + MISC_OFF))[u] = 0u;
    __syncthreads();
    unsigned char* ws = A.ws;
    const int wave0 = __builtin_amdgcn_readfirstlane(threadIdx.x >> 6);
    (void)xcd_barrier_post((unsigned*)(ws + WS_CTL) + CW_BAR, MISC + 8);
#define PHASE_BEGIN() do { int t_ = wave0 * 64 + lane_now(); int b_ = blockIdx.x; asm volatile("" : "+s"(b_)); \
    C.tid = t_; C.lane = t_ & 63; C.wave = __builtin_amdgcn_readfirstlane(t_ >> 6); C.bid = b_; } while (0)
#ifdef HY_DIAG
    unsigned long long ts_last = __builtin_amdgcn_s_memrealtime(); float tacc[10] = {0.f, 0.f, 0.f, 0.f, 0.f, 0.f, 0.f, 0.f, 0.f, 0.f};
#define GRID_BAR(cat) do { { XcdBarrier b_; b_.bar = (unsigned*)(A.ws + WS_CTL) + CW_BAR; b_.x = xb_xcc_id(); b_.st = (volatile LAS unsigned*)(C.lds + MISC_OFF) + 8; xcd_barrier(b_, wave0 == 0 && lane_now() == 0); } PHASE_BEGIN(); { const unsigned long long n_ = __builtin_amdgcn_s_memrealtime(); tacc[cat] += (float)(n_ - ts_last); ts_last = n_; } } while (0)
#else
#define GRID_BAR(cat) do { { XcdBarrier b_; b_.bar = (unsigned*)(A.ws + WS_CTL) + CW_BAR; b_.x = xb_xcc_id(); b_.st = (volatile LAS unsigned*)(C.lds + MISC_OFF) + 8; xcd_barrier(b_, wave0 == 0 && lane_now() == 0); } PHASE_BEGIN(); } while (0)
#endif
#ifndef HY_REPCAT
#define HY_REPCAT (-1)
#endif
#define NREP(cat) ((HY_REPCAT == (cat)) ? 2 : 1)
    float* out = A.out;
#define in A.in
    float* MOD = (float*)(ws + WS_MOD);
    bf16 *WIN = (bf16*)(ws + WS_WIN), *WOUT = (bf16*)(ws + WS_WOUT), *WUP = (bf16*)(ws + WS_WUP), *WDN = (bf16*)(ws + WS_WDN);
    bf16 *XB = (bf16*)(ws + WS_XB), *O = (bf16*)(ws + WS_O), *VF = (bf16*)(ws + WS_VF), *PG = (bf16*)(ws + WS_PG), *PR = (bf16*)(ws + WS_PR), *VL = (bf16*)(ws + WS_VL);
    bf16 *RH = (bf16*)(ws + WS_RH), *YH = (bf16*)(ws + WS_YH), *PP = (bf16*)(ws + WS_PP), *QQ = (bf16*)(ws + WS_QQ), *GG = (bf16*)(ws + WS_GG), *S0 = (bf16*)(ws + WS_S0);
    float *GAMC = (float*)(ws + WS_GAMC), *RK = (float*)(ws + WS_RK);
    bf16* LORA = (bf16*)(ws + WS_LORA);
    bf16* DS = (bf16*)(ws + WS_GK); float* GAM = (float*)(ws + WS_GAM);
    bf16* ACT = (bf16*)(ws + WS_ACT); float *HALO = (float*)(ws + WS_U), *FIXU = (float*)(ws + WS_U + 8 * MiB);

    ph_mod(C, in[1], in[2], in[3], MOD);
    for (int l = 0; l < L_; ++l) {
        const float* modl = MOD + (size_t)l * 4 * 6144;
        const float* xres = l ? out : in[0];
        for (int r_ = 0; r_ < NREP(0); ++r_) {
        wprep_mat(C, in[5] + (size_t)l * D_ * IN_COLS, D_, IN_COLS, NIN, WIN, 1, l ? in[6] : nullptr);
        wprep_mat(C, in[24] + (size_t)l * D_ * D_, D_, D_, D_, WOUT, 0, nullptr);
        wprep_mat(C, in[26] + (size_t)l * D_ * NUP, D_, NUP, NUP, WUP, 2, nullptr);
        wprep_mat(C, in[29] + (size_t)l * DFF * D_, DFF, D_, D_, WDN, 0, nullptr);
        wprep_mat(C, in[12] + (size_t)l * 64 * 512, 64, 512, 512, LORA, 0, nullptr);
        wprep_mat(C, in[14] + (size_t)l * 64 * 512, 64, 512, 512, LORA + 512 * 64, 0, nullptr);
        wprep_mat(C, in[16] + (size_t)l * 128 * 512, 128, 512, 512, LORA + 2 * 512 * 64, 0, nullptr);
        if (l) wprep_mat(C, in[17], 32, 512, 512, LORA + 2 * 512 * 64 + 512 * 128, 0, nullptr);
        }
        GRID_BAR(0);
        for (int r_ = 0; r_ < NREP(1); ++r_) ph_norm(C, xres, in[4] + l * D_, modl + 0 * D_, modl + 1 * D_, XB);
        GRID_BAR(1);
        for (int r_ = 0; r_ < NREP(2); ++r_) { pg8::Gemm g{XB, WIN, M_, NIN, D_}; pg8::StaticOrder S; S.init(M_, NIN, C.nb, C.bid);
          pg8::EpiBf16<0> E{PG, NPG, nullptr, NPG, (WS_PR - WS_PG) / 2, 1.f};
          pg8::gemm_phase<pg8::EpiBf16<0>, pg8::StaticOrder, true, true>(C.lds, g, S, E, C.tid); }
        GRID_BAR(2);
        for (int r_ = 0; r_ < NREP(3); ++r_) {
        ph_gla_a(C, PG, in[7] + l * 16 * 256, in[8] + l * 256, DS, GAM);
        { RwkvW W{in[10] + l * 1792, in[11], in[13] + l * 512, in[15] + l * 512, in[18], in[19] + l * 512, in[20] + l * 512, in[21] + l * 512,
                  LORA, LORA + 512 * 64, LORA + 2 * 512 * 64, LORA + 2 * 512 * 64 + 512 * 128};
          ph_rwkv_a(C, PR, PG, W, l, PP, QQ, RH, YH, GAMC, RK, GG, VF, r_ == NREP(3) - 1); } }
        GRID_BAR(3);
        if (C.bid < 32) { for (int r_ = 0; r_ < NREP(4); ++r_) ph_rwkv_b(C, C.bid, PP, QQ, GAMC, S0); }
        else { Ctx C2 = C; C2.bid = C.bid - 32; C2.nb = C.nb - 32;
               ph_gla_b(C2, DS, GAM);
               group_barrier((unsigned*)(ws + WS_CTL) + 2048, (unsigned)(C.nb - 32) * (unsigned)(l + 1), wave0 == 0 && lane_now() == 0);
               PHASE_BEGIN(); C2 = C; C2.bid = C.bid - 32; C2.nb = C.nb - 32;
               ph_gla_c(C2, PG, in[7] + l * 16 * 256, in[8] + l * 256, in[9] + l * 128, DS, O); }
        GRID_BAR(4);
        for (int r_ = 0; r_ < NREP(5); ++r_) {
        ph_rwkv_c(C, S0, RH, YH, RK, GG, VF, in[22] + l * 512, in[23] + l * 512, O); }
        GRID_BAR(5);
        { pg8::Gemm g{O, WOUT, M_, D_, D_}; pg8::StaticOrder S; S.init(M_, D_, C.nb, C.bid);
          pg8::EpiRes E{xres, out, modl + 2 * D_, 6144};
          pg8::gemm_phase<pg8::EpiRes, pg8::StaticOrder, true, true>(C.lds, g, S, E, C.tid); }
        GRID_BAR(6);
        for (int r_ = 0; r_ < NREP(1); ++r_) ph_norm(C, out, in[25] + l * D_, modl + 3 * D_, modl + 4 * D_, XB);
        GRID_BAR(1);
        for (int r_ = 0; r_ < NREP(7); ++r_) { pg8::Gemm g{XB, WUP, M_, NUP, D_}; pg8::StaticOrder S; S.init(M_, NUP, C.nb, C.bid);
          pg8::EpiConv E{ACT, in[27] + (size_t)l * 3 * NUP, in[28] + (size_t)l * NUP, HALO, FIXU, (PG8_LAS float*)(C.lds + RING_BYTES), NUP / 256};
          pg8::gemm_phase<pg8::EpiConv, pg8::StaticOrder, true, true>(C.lds, g, S, E, C.tid); }
        GRID_BAR(7);
        for (int r_ = 0; r_ < NREP(8); ++r_) ph_convfix(C, HALO, FIXU, in[27] + (size_t)l * 3 * NUP, in[28] + (size_t)l * NUP, ACT);
        GRID_BAR(8);
        { pg8::Gemm g{ACT, WDN, M_, D_, DFF}; pg8::StaticOrder S; S.init(M_, D_, C.nb, C.bid);
          pg8::EpiRes E{out, out, modl + 5 * D_, 6144};
          pg8::gemm_phase<pg8::EpiRes, pg8::StaticOrder, true, true>(C.lds, g, S, E, C.tid); }
        GRID_BAR(9);
    }
    ph_final(C, out, in[30]);
#ifdef HY_DIAG
    GRID_BAR(1);
    if (C.bid == 0) { if (C.tid == 0) out[0] = tacc[HY_DIAG_A] * 0.1f; for (int i = 1 + C.tid; i <= 10000; i += NT) out[i] = tacc[HY_DIAG_B] * 0.01f; }
#endif
#undef GRID_BAR
#undef PHASE_BEGIN
#undef in
}
}

extern "C" void kernel_launch(void* const* d_in, const int* in_sizes, int n_in, void* d_out, int out_size, void* d_ws, size_t ws_size, hipStream_t stream) {
    using namespace hy;
    static int grid = 0;
    if (grid == 0) {
        if (n_in != 31 || in_sizes[0] != M_ * D_ || out_size != M_ * D_ || ws_size < WS_END) { fprintf(stderr, "kernel_launch: unexpected shapes (n_in %d, in0 %d, out %d, ws %zu)\n", n_in, n_in > 0 ? in_sizes[0] : -1, out_size, ws_size); grid = -1; return; }
        if (hipFuncSetAttribute((const void*)hy_fwd, hipFuncAttributeMaxDynamicSharedMemorySize, LDS_BYTES) != hipSuccess) { fprintf(stderr, "kernel_launch: hipFuncSetAttribute failed\n"); grid = -1; return; }
        int dev = 0, cus = 0, per_cu = 0;
        (void)hipGetDevice(&dev); (void)hipDeviceGetAttribute(&cus, hipDeviceAttributeMultiprocessorCount, dev);
        (void)hipOccupancyMaxActiveBlocksPerMultiprocessor(&per_cu, (const void*)hy_fwd, NT, LDS_BYTES);
        if (per_cu < 1) fprintf(stderr, "kernel_launch: occupancy query reports %d blocks per CU\n", per_cu);
        (void)hipGetLastError();
        grid = cus > 0 ? cus : 256;
    }
    if (grid < 0) return;
    (void)hipMemsetAsync((char*)d_ws + WS_CTL, 0, CTL_ZERO_BYTES, stream);
    Args a{};
    for (int i = 0; i < 31; ++i) a.in[i] = (const float*)d_in[i];
    a.out = (float*)d_out; a.ws = (unsigned char*)d_ws;
    hipLaunchKernelGGL(hy_fwd, dim3(grid), dim3(NT), LDS_BYTES, stream, a);
}
```

```cpp
#include <hip/hip_runtime.h>
#include <cstdio>
#include <cstdint>
namespace pg8 {
#define PG8_LAS __attribute__((address_space(3)))
typedef unsigned short bf16_t;
typedef short bf16x8 __attribute__((ext_vector_type(8)));
typedef float f32x4 __attribute__((ext_vector_type(4)));
typedef unsigned u32x4 __attribute__((ext_vector_type(4)));
constexpr int BM = 256, BK = 64, HALF = 128, HTB = HALF * BK * 2  , STAGE_BYTES = 8 * HTB, NXCD = 8, WGM = 8;

__host__ __device__ __forceinline__ int lds_byte(int r, int c) { const int st = (r >> 4) * 2 + (c >> 5), rr = r & 15, cc = c & 31, ob = rr * 64 + cc * 2; return st * 1024 + (ob ^ (((ob >> 9) & 1) << 5)); }
__host__ __device__ __forceinline__ void stage_rc(int b, int& R, int& C) { const int st = b / 1024, sb = b % 1024, swz = sb ^ (((sb >> 9) & 1) << 5); R = (st >> 1) * 16 + swz / 64; C = (st & 1) * 32 + (swz % 64) / 2; }
__host__ __device__ __forceinline__ int perm32(int rho) { const int n = rho >> 4, i = rho & 15; return 8 * (i >> 2) + 4 * n + (i & 3); }

struct Unit { int pm, pn; };
struct Gemm { const bf16_t* A; const bf16_t* Bt; int M, N, K; size_t bstride; };

struct StaticOrder {
    int nM, nN, nwg, G, c;
    __host__ __device__ void init(int M, int N, int G_, int c_) { nM = M / BM; nN = N / BM; nwg = nM * nN; G = G_; c = c_; }
    __host__ __device__ bool next(int i, Unit& u) const {
        const long L = (long)i * G + c; if (L >= nwg) return false;
        int wgid = (int)L; { const int q = nwg / NXCD, r = nwg % NXCD, xcd = wgid % NXCD, off = wgid / NXCD; wgid = (xcd < r ? xcd * (q + 1) : r * (q + 1) + (xcd - r) * q) + off; }
        const int nig = WGM * nN, gid = wgid / nig, fm = gid * WGM, gsz = (nM - fm) < WGM ? (nM - fm) : WGM;
        u.pm = fm + ((wgid % nig) % gsz); u.pn = (wgid % nig) / gsz; return true;
    }
    __device__ __forceinline__ void a_ready(const Unit&) const {}
    __device__ __forceinline__ void done(const Unit&) const {}
};

__device__ __forceinline__ unsigned cvt_pk_bf16(float lo, float hi) { unsigned r; asm volatile("v_cvt_pk_bf16_f32 %0, %1, %2" : "=v"(r) : "v"(lo), "v"(hi)); return r; }
typedef float f32x2 __attribute__((ext_vector_type(2)));
__device__ __forceinline__ f32x2 gelu_pk(f32x2 v) {
    const f32x2 av = __builtin_elementwise_abs(v), d = av * 0.2316418882f + 1.0f;
    f32x2 t; t.x = __builtin_amdgcn_rcpf(d.x); t.y = __builtin_amdgcn_rcpf(d.y);
    f32x2 q = t * 0.5307027145f + (-0.7265760135f); q = q * t + 0.7107068705f; q = q * t + (-0.142248368f); q = q * t + 0.127414796f; q = q * t;
    const f32x2 s = (v * v) * (-0.72134752044f);
    f32x2 e; e.x = __builtin_amdgcn_exp2f(s.x); e.y = __builtin_amdgcn_exp2f(s.y);
    const f32x2 m = v * (q * e), r = v - m;
    f32x2 o; o.x = v.x < 0.f ? m.x : r.x; o.y = v.y < 0.f ? m.y : r.y; return o;
}

template <int ACT  > struct EpiBf16 {
    static constexpr bool PERM = true, AFTER_DRAIN = false; static_assert(ACT == 0 || ACT == 1, "EpiBf16: ACT is 0 (none) or 1 (gelu_pk)");
    bf16_t* O; int ldc; const float* bias; int split_cols; size_t split_stride; float scale0;
    __device__ __forceinline__ void operator()(const f32x4 (&acc)[2][2][4][2], const Unit& u, int wr, int wc, int fr, int fq) const {
        const int row0 = u.pm * BM + wr * 64 + fr; int colt = u.pn * BM; bf16_t* base = O;
        float sc = 1.f; if (split_cols) { const int t = colt / split_cols; base += (size_t)t * split_stride; colt -= t * split_cols; if (t == 0) sc = scale0; }
        const int col0 = colt + wc * 32 + 8 * fq, bcol0 = u.pn * BM + wc * 32 + 8 * fq;
        f32x4 bv[2][2];
#pragma unroll
        for (int bj = 0; bj < 2; ++bj)
#pragma unroll
            for (int n = 0; n < 2; ++n) bv[bj][n] = bias ? *(const f32x4*)(bias + bcol0 + bj * HALF + 4 * n) : (f32x4){0.f, 0.f, 0.f, 0.f};
#pragma unroll
        for (int ai = 0; ai < 2; ++ai)
#pragma unroll
            for (int m = 0; m < 4; ++m) { bf16_t* rowp = base + (size_t)(row0 + ai * HALF + m * 16) * ldc + col0;
#pragma unroll
                for (int bj = 0; bj < 2; ++bj) { f32x4 v0 = acc[ai][bj][m][0] + bv[bj][0], v1 = acc[ai][bj][m][1] + bv[bj][1];
                    if (ACT == 1) { f32x2 a = gelu_pk((f32x2){v0[0], v0[1]}), b = gelu_pk((f32x2){v0[2], v0[3]}), c = gelu_pk((f32x2){v1[0], v1[1]}), d = gelu_pk((f32x2){v1[2], v1[3]});
                        v0 = (f32x4){a.x, a.y, b.x, b.y}; v1 = (f32x4){c.x, c.y, d.x, d.y}; }
                    v0 = v0 * sc; v1 = v1 * sc; u32x4 w; w.x = cvt_pk_bf16(v0[0], v0[1]); w.y = cvt_pk_bf16(v0[2], v0[3]); w.z = cvt_pk_bf16(v1[0], v1[1]); w.w = cvt_pk_bf16(v1[2], v1[3]);
                    *(u32x4*)(rowp + bj * HALF) = w; } }
    }
};
template <class Epi, class Sched, bool ALIGN_EPI = false, bool SP2 = false>
__device__ __forceinline__ void gemm_phase(PG8_LAS unsigned char* lds, const Gemm g, const Sched& S, const Epi& E, int tid_in) {
    int tid_ = tid_in; asm volatile("" : "+v"(tid_));
    const int tid = tid_, wid = __builtin_amdgcn_readfirstlane(tid >> 6), lane = tid & 63, wr = wid >> 2, wc = wid & 3, fr = lane & 15, fq = lane >> 4;
    const int K = g.K, nt = K / BK;
    unsigned voffA[2], voffB[2];
#pragma unroll
    for (int i = 0; i < 2; ++i) { int R, C; stage_rc(tid * 16 + i * 8192, R, C); const int Rb = Epi::PERM ? ((R & ~31) + perm32(R & 31)) : R;
        voffA[i] = (unsigned)(R * K + C) * 2u; voffB[i] = (unsigned)(Rb * K + C) * 2u; }
    const size_t kstep = (size_t)(BK * 2);
    const size_t hstep = (size_t)HALF * K * 2;
    const size_t tstep = 2 * hstep;
    const unsigned ldsw = (unsigned)wid * 1024u;
    const int aoff = lds_byte(wr * 64 + fr, fq * 8), boff = lds_byte(wc * 32 + fr, fq * 8);
#define PG8_SA(b, h) (((b) * 2 + (h)) * HTB)
#define PG8_SB(b, h) ((4 + (b) * 2 + (h)) * HTB)
#define PG8_STAGE(bufoff, gbase, voff) do { _Pragma("unroll") for (int _i = 0; _i < 2; ++_i) \
        __builtin_amdgcn_global_load_lds((const unsigned*)((const char*)(gbase) + (voff)[_i]), (PG8_LAS unsigned*)(lds + (bufoff) + ldsw + _i * 8192), 16, 0, 0); } while (0)
#define PG8_LDA(dst, b, h) do { _Pragma("unroll") for (int m = 0; m < 4; ++m) _Pragma("unroll") for (int k = 0; k < 2; ++k) dst[m][k] = *(const PG8_LAS bf16x8*)(lds + PG8_SA(b, h) + aoff + m * 2048 + k * 1024); } while (0)
#define PG8_LDB(dst, b, h) do { _Pragma("unroll") for (int n = 0; n < 2; ++n) _Pragma("unroll") for (int k = 0; k < 2; ++k) dst[n][k] = *(const PG8_LAS bf16x8*)(lds + PG8_SB(b, h) + boff + n * 2048 + k * 1024); } while (0)
#define PG8_MMA(ai, bj, At, Bt) do { __builtin_amdgcn_s_setprio(1); _Pragma("unroll") for (int m = 0; m < 4; ++m) _Pragma("unroll") for (int n = 0; n < 2; ++n) _Pragma("unroll") for (int k = 0; k < 2; ++k) \
        acc[ai][bj][m][n] = __builtin_amdgcn_mfma_f32_16x16x32_bf16(Bt[n][k], At[m][k], acc[ai][bj][m][n], 0, 0, 0); __builtin_amdgcn_s_setprio(0); } while (0)
#define PG8_WAIT_V(n) asm volatile("s_waitcnt vmcnt(" #n ")" ::: "memory")
#define PG8_WAIT_L(n) asm volatile("s_waitcnt lgkmcnt(" #n ")" ::: "memory")
#define PG8_BAR __builtin_amdgcn_s_barrier()
#define PG8_SCHED __builtin_amdgcn_sched_barrier(0)
    Unit cur, nxt; int ui = 0;
    if (!S.next(0, cur)) return;
    f32x4 acc[2][2][4][2];
#pragma unroll
    for (int a = 0; a < 2; ++a)
#pragma unroll
        for (int b = 0; b < 2; ++b)
#pragma unroll
            for (int m = 0; m < 4; ++m)
#pragma unroll
                for (int n = 0; n < 2; ++n) acc[a][b][m][n] = (f32x4){0.f, 0.f, 0.f, 0.f};
    bf16x8 At[4][2], B0[2][2], B1[2][2];
    const char* cA = (const char*)g.A + (size_t)cur.pm * tstep; const char* cB = (const char*)g.Bt + (size_t)cur.pn * tstep + (size_t)(cur.pm >> 5) * g.bstride;
    S.a_ready(cur);
    if constexpr (SP2) {
        PG8_STAGE(PG8_SB(0, 0), cB, voffB); PG8_STAGE(PG8_SB(0, 1), cB + hstep, voffB); PG8_STAGE(PG8_SA(0, 0), cA, voffA); PG8_STAGE(PG8_SA(0, 1), cA + hstep, voffA);
        if (wr == 1) PG8_BAR;
        PG8_WAIT_V(2); PG8_BAR;
        PG8_STAGE(PG8_SB(1, 0), cB + kstep, voffB); PG8_STAGE(PG8_SA(1, 0), cA + kstep, voffA); PG8_STAGE(PG8_SB(1, 1), cB + hstep + kstep, voffB);
        PG8_WAIT_V(6); PG8_BAR;
    } else {
        PG8_STAGE(PG8_SB(0, 0), cB, voffB); PG8_STAGE(PG8_SA(0, 0), cA, voffA); PG8_STAGE(PG8_SB(0, 1), cB + hstep, voffB); PG8_STAGE(PG8_SA(0, 1), cA + hstep, voffA);
        if (wr == 1) PG8_BAR;
        PG8_WAIT_V(4); PG8_BAR;
        PG8_STAGE(PG8_SB(1, 0), cB + kstep, voffB); PG8_STAGE(PG8_SA(1, 0), cA + kstep, voffA); PG8_STAGE(PG8_SB(1, 1), cB + hstep + kstep, voffB);
        PG8_WAIT_V(6); PG8_BAR;
    }
    for (;;) {
        const bool has_next = S.next(ui + 1, nxt);
        const char* nA = has_next ? (const char*)g.A + (size_t)nxt.pm * tstep : cA; const char* nB = has_next ? (const char*)g.Bt + (size_t)nxt.pn * tstep + (size_t)(nxt.pm >> 5) * g.bstride : cB;
        for (int t = 0; t < nt; t += 2) {
            const bool last = (t == nt - 2);
            const char* a1 = cA + (size_t)(t + 1) * kstep;
            const char* a2 = last ? nA : cA + (size_t)(t + 2) * kstep; const char* b2 = last ? nB : cB + (size_t)(t + 2) * kstep;
            const char* a3 = a2 + kstep; const char* b3 = b2 + kstep;
            if (last && has_next) S.a_ready(nxt);
            if constexpr (SP2) {
            PG8_LDB(B0, 0, 0); PG8_LDB(B1, 0, 1); PG8_SCHED; PG8_LDA(At, 0, 0); PG8_STAGE(PG8_SA(1, 1), a1 + hstep, voffA);
            PG8_WAIT_V(8); PG8_WAIT_L(0); PG8_BAR; PG8_MMA(0, 0, At, B0); PG8_MMA(0, 1, At, B1); PG8_BAR; PG8_SCHED;
            PG8_LDA(At, 0, 1); PG8_STAGE(PG8_SB(0, 0), b2, voffB); PG8_STAGE(PG8_SB(0, 1), b2 + hstep, voffB); PG8_STAGE(PG8_SA(0, 0), a2, voffA);
            PG8_WAIT_V(8); PG8_WAIT_L(0); PG8_BAR; PG8_MMA(1, 0, At, B0); PG8_MMA(1, 1, At, B1); PG8_BAR; PG8_SCHED;
            PG8_LDB(B0, 1, 0); PG8_LDB(B1, 1, 1); PG8_SCHED; PG8_LDA(At, 1, 0); PG8_STAGE(PG8_SA(0, 1), a2 + hstep, voffA);
            PG8_WAIT_V(8); PG8_WAIT_L(0); PG8_BAR; PG8_MMA(0, 0, At, B0); PG8_MMA(0, 1, At, B1); PG8_BAR; PG8_SCHED;
            PG8_LDA(At, 1, 1); PG8_STAGE(PG8_SB(1, 0), b3, voffB); PG8_STAGE(PG8_SB(1, 1), b3 + hstep, voffB); PG8_STAGE(PG8_SA(1, 0), a3, voffA);
            PG8_WAIT_V(8); PG8_WAIT_L(0); PG8_BAR; PG8_MMA(1, 0, At, B0); PG8_MMA(1, 1, At, B1); PG8_BAR; PG8_SCHED;
            } else {
            PG8_LDB(B0, 0, 0); PG8_SCHED; PG8_LDA(At, 0, 0); PG8_STAGE(PG8_SA(1, 1), a1 + hstep, voffA);
            PG8_WAIT_L(8); PG8_BAR; PG8_WAIT_L(0); PG8_MMA(0, 0, At, B0); PG8_BAR; PG8_SCHED;
            PG8_LDB(B1, 0, 1); PG8_STAGE(PG8_SB(0, 0), b2, voffB);
            PG8_BAR; PG8_WAIT_L(0); PG8_MMA(0, 1, At, B1); PG8_BAR;
            PG8_LDA(At, 0, 1); PG8_STAGE(PG8_SA(0, 0), a2, voffA);
            PG8_BAR; PG8_WAIT_L(0); PG8_MMA(1, 0, At, B0); PG8_BAR; PG8_SCHED;
            PG8_STAGE(PG8_SB(0, 1), b2 + hstep, voffB);
            PG8_WAIT_V(6); PG8_BAR; PG8_MMA(1, 1, At, B1); PG8_BAR;
            PG8_LDB(B0, 1, 0); PG8_SCHED; PG8_LDA(At, 1, 0); PG8_STAGE(PG8_SA(0, 1), a2 + hstep, voffA);
            PG8_WAIT_L(8); PG8_BAR; PG8_WAIT_L(0); PG8_MMA(0, 0, At, B0); PG8_BAR; PG8_SCHED;
            PG8_LDB(B1, 1, 1); PG8_STAGE(PG8_SB(1, 0), b3, voffB);
            PG8_BAR; PG8_WAIT_L(0); PG8_MMA(0, 1, At, B1); PG8_BAR;
            PG8_LDA(At, 1, 1); PG8_STAGE(PG8_SA(1, 0), a3, voffA);
            PG8_BAR; PG8_WAIT_L(0); PG8_MMA(1, 0, At, B0); PG8_BAR; PG8_SCHED;
            PG8_STAGE(PG8_SB(1, 1), b3 + hstep, voffB);
            PG8_WAIT_V(6); PG8_BAR; PG8_MMA(1, 1, At, B1); PG8_BAR;
            }
        }
        if constexpr (ALIGN_EPI) { if (wr == 0) PG8_BAR; }
        if constexpr (!Epi::AFTER_DRAIN) { E(acc, cur, wr, wc, fr, fq); S.done(cur); }
        if (!has_next) break;
#pragma unroll
        for (int a = 0; a < 2; ++a)
#pragma unroll
            for (int b = 0; b < 2; ++b)
#pragma unroll
                for (int m = 0; m < 4; ++m)
#pragma unroll
                    for (int n = 0; n < 2; ++n) acc[a][b][m][n] = (f32x4){0.f, 0.f, 0.f, 0.f};
        cur = nxt; cA = nA; cB = nB; ++ui;
        if constexpr (ALIGN_EPI) { if (wr == 1) PG8_BAR; }
    }
    PG8_WAIT_V(0);
    if constexpr (!ALIGN_EPI) { if (wr == 0) PG8_BAR; }
    PG8_BAR;
    if constexpr (Epi::AFTER_DRAIN) { E.fused(acc, cur, wr, wc, fr, fq, lds, wid, lane); S.done(cur); }
#undef PG8_SA
#undef PG8_SB
#undef PG8_STAGE
#undef PG8_LDA
#undef PG8_LDB
#undef PG8_MMA
#undef PG8_WAIT_V
#undef PG8_WAIT_L
#undef PG8_BAR
#undef PG8_SCHED
}
}

namespace hy {
#define GAS __attribute__((address_space(1)))
#define LAS __attribute__((address_space(3)))
typedef unsigned short bf16;
typedef unsigned v4u __attribute__((ext_vector_type(4)));
typedef float f32x4 __attribute__((ext_vector_type(4)));
typedef short bf16x8 __attribute__((ext_vector_type(8)));
typedef GAS unsigned gu32;
typedef GAS unsigned long long gu64;
#define RLX_AGENT __ATOMIC_RELAXED, __HIP_MEMORY_SCOPE_AGENT
#define LDS_WAIT() asm volatile("s_waitcnt lgkmcnt(0)" ::: "memory")
#define VM_WAIT() asm volatile("s_waitcnt vmcnt(0)" ::: "memory")
__device__ __forceinline__ unsigned long long rt() { return __builtin_amdgcn_s_memrealtime(); }
typedef __bf16 hwbf2 __attribute__((ext_vector_type(2))); typedef float hwf2 __attribute__((ext_vector_type(2)));
__device__ __forceinline__ unsigned f2bf(float f) { return (unsigned)__builtin_bit_cast(unsigned short, (__bf16)f); }
__device__ __forceinline__ unsigned pk2(float lo, float hi) { const hwf2 v = {lo, hi}; return __builtin_bit_cast(unsigned, __builtin_convertvector(v, hwbf2)); }
#define XB_TMO      128
#define XB_XCNT(j)  (256  + 64 * (j))
#define XB_XSUB(j)  (1280 + 64 * (j))
#define XB_XGEN(j)  (2304 + 64 * (j))
#define XB_TOP      3328
#define XB_TOPGEN   3392
#define XCD_BAR_WORDS 3456
#define XB_SPIN_CAP (1u << 18)

__device__ __forceinline__ unsigned xb_ld(unsigned* p)              { return __hip_atomic_load(p, __ATOMIC_RELAXED, __HIP_MEMORY_SCOPE_AGENT); }
__device__ __forceinline__ unsigned xb_add(unsigned* p, unsigned v) { return __hip_atomic_fetch_add(p, v, __ATOMIC_RELAXED, __HIP_MEMORY_SCOPE_AGENT); }
__device__ __forceinline__ unsigned xb_xcc_id() { return (unsigned)__builtin_amdgcn_s_getreg((3 << 11) | 20) & 0xFu; }
#define XB_SPIN(cond, bar) do { unsigned _sp = 0; while (cond) { __builtin_amdgcn_s_sleep(1); \
    if ((++_sp & 255u) == 0u) { if (xb_ld(&(bar)[XB_TMO])) break; if (_sp > XB_SPIN_CAP) { atomicAdd(&(bar)[XB_TMO], 1u); break; } } } } while (0)

struct XcdBarrier {
    unsigned* bar; unsigned x;
    volatile LAS unsigned* st;
};

__device__ __forceinline__ XcdBarrier xcd_barrier_post(unsigned* bar, volatile LAS unsigned* st) {
    XcdBarrier b; b.bar = bar; b.x = xb_xcc_id(); b.st = st;
    if (threadIdx.x == 0) (void)xb_add(&bar[XB_XCNT(b.x)], 1u);
    return b;
}
__device__ __forceinline__ void xcd_barrier_complete(unsigned* bar, unsigned x, unsigned& nloc, unsigned& nx) {
    const unsigned G = gridDim.x * gridDim.y * gridDim.z;
    unsigned sum, cnt, mine, sp = 0u;
    for (;;) {
        sum = 0u; cnt = 0u; mine = 0u;
#pragma unroll
        for (unsigned j = 0; j < 16; ++j) { const unsigned c = xb_ld(&bar[XB_XCNT(j)]); sum += c; cnt += (c > 0u) ? 1u : 0u; mine = (j == x) ? c : mine; }
        if (sum == G) break;
        __builtin_amdgcn_s_sleep(1);
        if ((++sp & 255u) == 0u) { if (xb_ld(&bar[XB_TMO])) break; if (sp > XB_SPIN_CAP) { atomicAdd(&bar[XB_TMO], 1u); break; } }
    }
    nloc = mine > 0u ? mine : 1u; nx = cnt > 0u ? cnt : 1u;
}

__device__ __forceinline__ void xcd_barrier(const XcdBarrier& b, bool leader  ) {
    asm volatile("s_waitcnt vmcnt(0)" ::: "memory");
    __syncthreads();
    if (leader) {
        unsigned* bar = b.bar;
        __builtin_amdgcn_s_waitcnt(0);
        unsigned nloc = b.st[0], nx = b.st[1];
        if (nloc == 0u) { xcd_barrier_complete(bar, b.x, nloc, nx); b.st[0] = nloc; b.st[1] = nx; }
        const unsigned old = xb_add(&bar[XB_XSUB(b.x)], 1u);
        const unsigned gen = old / nloc;
        if (old + 1u == (gen + 1u) * nloc) {
            __builtin_amdgcn_fence(__ATOMIC_RELEASE, "agent");
            asm volatile("s_waitcnt vmcnt(0)" ::: "memory");
            const unsigned og = xb_add(&bar[XB_TOP], 1u);
            const unsigned tg = og / nx;
            if (og + 1u == (tg + 1u) * nx) xb_add(&bar[XB_TOPGEN], 1u);
            else XB_SPIN(xb_ld(&bar[XB_TOPGEN]) == tg, bar);
            __builtin_amdgcn_fence(__ATOMIC_ACQUIRE, "agent");
            xb_add(&bar[XB_XGEN(b.x)], 1u);
            asm volatile("s_waitcnt vmcnt(0)" ::: "memory");
        } else {
            XB_SPIN(xb_ld(&bar[XB_XGEN(b.x)]) == gen, bar);
            __builtin_amdgcn_fence(__ATOMIC_ACQUIRE, "agent");
            asm volatile("s_waitcnt vmcnt(0)" ::: "memory");
        }
    }
    __syncthreads();
}

constexpr int B_ = 4, T_ = 8192, D_ = 1024, M_ = B_ * T_, L_ = 2;
constexpr int NIN = 3584, NPG = 1792, NPR = 1792;
constexpr int DFF = 2816, NUP = 5632, IN_COLS = 3344;
constexpr size_t MiB = 1u << 20;
constexpr size_t WS_CTL = 0, CTL_ZERO_BYTES = 65536;
constexpr int CW_BAR = 4096;
constexpr size_t WS_RK = MiB / 4;
constexpr size_t WS_MOD = 3 * MiB / 2;
constexpr size_t WS_WIN = 2 * MiB, WS_WOUT = 9 * MiB, WS_WUP = 11 * MiB, WS_WDN = 22 * MiB, WS_LORA = 55 * MiB / 2, WS_GAMC = 28 * MiB, WS_VL = 29 * MiB;
constexpr size_t WS_GAM = 31 * MiB;
constexpr size_t WS_XB = 32 * MiB, WS_O = 336 * MiB  , WS_VF = 160 * MiB, WS_GK = 192 * MiB, WS_PG = 224 * MiB, WS_PR = 336 * MiB, WS_END = 512 * MiB;
constexpr size_t WS_RH = WS_XB, WS_YH = WS_XB + 32 * MiB, WS_PP = 96 * MiB, WS_QQ = 128 * MiB, WS_GG = 448 * MiB, WS_S0 = 480 * MiB;
constexpr size_t WS_ACT = 224 * MiB, WS_U = 400 * MiB;
constexpr int RING_BYTES = 131072, MISC_OFF = 161792, LDS_BYTES = 163840;
constexpr int NT = 512;

__device__ __forceinline__ float bf2f(bf16 h) { return __builtin_bit_cast(float, (unsigned)h << 16); }
__device__ __forceinline__ float sigmoidf_(float x) { return 1.f / (1.f + __expf(-x)); }
__device__ __forceinline__ float siluf_(float x) { return x / (1.f + __expf(-x)); }
__device__ __forceinline__ float softplusf_(float x) { return fmaxf(x, 0.f) + log1pf(__expf(-fabsf(x))); }

typedef unsigned u32x2 __attribute__((ext_vector_type(2)));
template <int CTRL> __device__ __forceinline__ float dpp_f(float v) {
    return __builtin_bit_cast(float, __builtin_amdgcn_update_dpp(0, __builtin_bit_cast(int, v), CTRL, 0xf, 0xf, false));
}
__device__ __forceinline__ float wave_sum(float v) {
    v += dpp_f<0xB1>(v);
    v += dpp_f<0x4E>(v);
    v += dpp_f<0x141>(v);
    v += dpp_f<0x140>(v);
    v += __builtin_bit_cast(float, __builtin_amdgcn_update_dpp(0, __builtin_bit_cast(int, v), 0x142, 0xa, 0xf, false));
    v += __builtin_bit_cast(float, __builtin_amdgcn_update_dpp(0, __builtin_bit_cast(int, v), 0x143, 0xc, 0xf, false));
    return __builtin_bit_cast(float, __builtin_amdgcn_readlane(__builtin_bit_cast(int, v), 63));
}

__device__ __forceinline__ int lane_now() { int l; asm volatile("v_mbcnt_lo_u32_b32 %0, -1, 0\n\tv_mbcnt_hi_u32_b32 %0, -1, %0" : "=v"(l)); return l; }
__device__ __forceinline__ float xsum4(float v) {
    const int l = lane_now();
    v += __builtin_bit_cast(float, __builtin_amdgcn_ds_bpermute((l ^ 16) << 2, __builtin_bit_cast(int, v)));
    v += __builtin_bit_cast(float, __builtin_amdgcn_ds_bpermute((l ^ 32) << 2, __builtin_bit_cast(int, v)));
    return v;
}
struct Ctx { int bid, nb, tid, lane, wave; LAS unsigned char* lds; };
__device__ __forceinline__ void group_barrier(unsigned* cnt, unsigned target, bool leader) {
    asm volatile("s_waitcnt vmcnt(0)" ::: "memory");
    __syncthreads();
    if (leader) {
        __builtin_amdgcn_fence(__ATOMIC_RELEASE, "agent");
        asm volatile("s_waitcnt vmcnt(0)" ::: "memory");
        (void)__hip_atomic_fetch_add(cnt, 1u, __ATOMIC_RELAXED, __HIP_MEMORY_SCOPE_AGENT);
        for (unsigned sp = 0; __hip_atomic_load(cnt, __ATOMIC_RELAXED, __HIP_MEMORY_SCOPE_AGENT) < target && sp < (1u << 22); ++sp) __builtin_amdgcn_s_sleep(2);
        __builtin_amdgcn_fence(__ATOMIC_ACQUIRE, "agent");
        asm volatile("s_waitcnt vmcnt(0)" ::: "memory");
    }
    __syncthreads();
}


__device__ __forceinline__ void ph_mod(const Ctx& C, const float* c, const float* ada_w, const float* ada_b, float* MOD) {
    LAS float* sc = (LAS float*)C.lds;
    LAS float* red = (LAS float*)(C.lds + 16384);
    for (int i = C.tid; i < 4096; i += NT) sc[i] = siluf_(c[i]);
    __syncthreads();
    for (int item = C.bid; item < 192; item += C.nb) {
        const int l = item / 96, j0 = (item % 96) * 64;
        const float* W = ada_w + (size_t)l * 1024 * 6144 + j0 + C.lane;
        float a0 = 0.f, a1 = 0.f, a2 = 0.f, a3 = 0.f;
        for (int k = C.wave * 128; k < C.wave * 128 + 128; ++k) { const float wv = W[(size_t)k * 6144]; a0 += sc[k] * wv; a1 += sc[1024 + k] * wv; a2 += sc[2048 + k] * wv; a3 += sc[3072 + k] * wv; }
        red[(C.wave * 4 + 0) * 64 + C.lane] = a0; red[(C.wave * 4 + 1) * 64 + C.lane] = a1; red[(C.wave * 4 + 2) * 64 + C.lane] = a2; red[(C.wave * 4 + 3) * 64 + C.lane] = a3;
        __syncthreads();
        if (C.wave < 4) { const int b = C.wave; float s = ada_b[l * 6144 + j0 + C.lane];
#pragma unroll
            for (int w = 0; w < 8; ++w) s += red[(w * 4 + b) * 64 + C.lane];
            MOD[((size_t)l * 4 + b) * 6144 + j0 + C.lane] = s; }
        __syncthreads();
    }
}

__device__ __forceinline__ void wprep_mat(const Ctx& C, const float* W, int K, int Nsrc, int Ndst, bf16* Wt, int mode, const float* vres) {
    const int half = C.tid >> 8, t = C.tid & 255, tx = t & 31, ty = t >> 5;
    LAS float* tile = (LAS float*)C.lds + half * (32 * 33);
    const int nbn = Ndst / 32, ntile = nbn * (K / 32);
    const int niter = (ntile + 2 * C.nb - 1) / (2 * C.nb);
    for (int it = 0; it < niter; ++it) {
        const int item = (it * C.nb + C.bid) * 2 + half;
        const bool act = item < ntile;
        const int n0 = (item % nbn) * 32, k0 = (item / nbn) * 32, n = n0 + tx;
        if (act) {
#pragma unroll
            for (int i = 0; i < 4; ++i) { const int k = k0 + ty + 8 * i; float v = 0.f;
                if (mode == 0) v = W[(size_t)k * Nsrc + n];
                else if (mode == 2) { const int tl = n >> 8, w = n & 255; v = W[(size_t)k * Nsrc + (w < 128 ? tl * 128 + w : 2816 + tl * 128 + (w - 128))]; }
                else { if (n < 1552) v = W[(size_t)k * Nsrc + n]; else if (n < 1584) v = vres ? vres[(size_t)k * 32 + (n - 1552)] : 0.f; else if (n < 1792) v = 0.f; else v = W[(size_t)k * Nsrc + (n - 240)]; }
                tile[(ty + 8 * i) * 33 + tx] = v; }
        }
        __syncthreads();
        if (act) {
#pragma unroll
            for (int i = 0; i < 4; ++i) { const int nn = n0 + ty + 8 * i; Wt[(size_t)nn * K + k0 + tx] = (bf16)f2bf(tile[tx * 33 + ty + 8 * i]); }
        }
        __syncthreads();
    }
}

__device__ __forceinline__ void ph_norm(const Ctx& C, const float* x, const float* g, const float* sh, const float* sc, bf16* XB) {
    const int gw = C.bid * 8 + C.wave, NGW = C.nb * 8, lane = C.lane;
    for (int m = gw; m < M_; m += NGW) {
        const int b = m / T_;
        const f32x4* xr = (const f32x4*)(x + (size_t)m * D_) + lane;
        f32x4 v[4]; float s = 0.f;
#pragma unroll
        for (int j = 0; j < 4; ++j) { v[j] = xr[64 * j]; s += (v[j].x * v[j].x + v[j].y * v[j].y) + (v[j].z * v[j].z + v[j].w * v[j].w); }
        const float rstd = 1.f / sqrtf(wave_sum(s) * (1.f / D_) + 1e-6f);
        unsigned long long* o8 = (unsigned long long*)(XB + (size_t)m * D_) + lane;
#pragma unroll
        for (int j = 0; j < 4; ++j) { const int col = 4 * lane + 256 * j;
            const f32x4 gv = *(const f32x4*)(g + col), shv = *(const f32x4*)(sh + b * 6144 + col), scv = *(const f32x4*)(sc + b * 6144 + col);
            const f32x4 h = v[j] * rstd * gv * (scv + 1.f) + shv;
            o8[64 * j] = (unsigned long long)pk2(h.x, h.y) | ((unsigned long long)pk2(h.z, h.w) << 32); }
    }
}
__device__ __forceinline__ void ph_final(const Ctx& C, float* x, const float* g) {
    const int gw = C.bid * 8 + C.wave, NGW = C.nb * 8, lane = C.lane;
    for (int m = gw; m < M_; m += NGW) {
        f32x4* xr = (f32x4*)(x + (size_t)m * D_) + lane;
        f32x4 v[4]; float s = 0.f;
#pragma unroll
        for (int j = 0; j < 4; ++j) { v[j] = xr[64 * j]; s += (v[j].x * v[j].x + v[j].y * v[j].y) + (v[j].z * v[j].z + v[j].w * v[j].w); }
        const float rstd = 1.f / sqrtf(wave_sum(s) * (1.f / D_) + 1e-6f);
#pragma unroll
        for (int j = 0; j < 4; ++j) { const f32x4 gv = *(const f32x4*)(g + 4 * lane + 256 * j); xr[64 * j] = v[j] * rstd * gv; }
    }
}


typedef short s16x8 __attribute__((ext_vector_type(8)));
__device__ __forceinline__ f32x4 mm16(const LAS bf16* A, int lda, const LAS bf16* B, int ldb, int K, f32x4 acc, int lane) {
    const int r = lane & 15, g = lane >> 4;
    const LAS bf16* ap = A + r * lda + 8 * g; const LAS bf16* bp = B + r * ldb + 8 * g;
    for (int k0 = 0; k0 < K; k0 += 32) { const s16x8 a = *(const LAS s16x8*)(ap + k0); const s16x8 b = *(const LAS s16x8*)(bp + k0); acc = __builtin_amdgcn_mfma_f32_16x16x32_bf16(a, b, acc, 0, 0, 0); }
    return acc;
}
__device__ __forceinline__ f32x4 mm16_ga(const bf16* A, int lda, const LAS bf16* B, int ldb, int K, f32x4 acc, int lane) {
    const int r = lane & 15, g = lane >> 4;
    const bf16* ap = A + r * lda + 8 * g; const LAS bf16* bp = B + r * ldb + 8 * g;
    for (int k0 = 0; k0 < K; k0 += 32) { const s16x8 a = *(const s16x8*)(ap + k0); const s16x8 b = *(const LAS s16x8*)(bp + k0); acc = __builtin_amdgcn_mfma_f32_16x16x32_bf16(a, b, acc, 0, 0, 0); }
    return acc;
}
__device__ __forceinline__ unsigned long long pack4(f32x4 v) { return (unsigned long long)pk2(v.x, v.y) | ((unsigned long long)pk2(v.z, v.w) << 32); }
__device__ __forceinline__ float logsigmoidf_(float x) { return fminf(x, 0.f) - __logf(1.f + __expf(-fabsf(x))); }

constexpr int GL_LD = 72;
constexpr int GL_GK = 0;
constexpr int GL_SEG = 16384;
constexpr int GL_Z = 18432;
constexpr int GL_GUP = 20480;
constexpr int GL_I0 = 24832;
constexpr int GL_I1 = GL_I0 + 9216;
constexpr int GL_I2 = GL_I1 + 9216;
constexpr int GL_VT = GL_I2 + 9216;
constexpr int GL_SSQ = GL_VT + 18432;
static_assert(GL_SSQ + 512 <= RING_BYTES, "GLA LDS map");

struct GlaRaw { v4u z, k, q, v0, v1; float g0, g1, gb; };
__device__ __forceinline__ void gla_fetch(GlaRaw& R, const Ctx& C, const bf16* pg, const float* gk_up, const float* gk_b, int h, bool want_q) {
    const int tid = C.tid, j = tid >> 3, d0 = (tid & 7) * 8, e0 = (tid & 7) * 16;
    R.z = (v4u){0u, 0u, 0u, 0u}; R.q = R.z;
    if (tid < 128) R.z = *(const v4u*)(pg + (size_t)(tid >> 1) * NPG + 1536 + (tid & 1) * 8);
    R.g0 = gk_up[(tid >> 6) * 256 + h * 64 + (tid & 63)]; R.g1 = gk_up[((tid + NT) >> 6) * 256 + h * 64 + (tid & 63)]; R.gb = gk_b[h * 64 + (tid & 63)];
    R.k = *(const v4u*)(pg + (size_t)j * NPG + 256 + h * 64 + d0);
    if (want_q) R.q = *(const v4u*)(pg + (size_t)j * NPG + h * 64 + d0);
    R.v0 = *(const v4u*)(pg + (size_t)j * NPG + 512 + h * 128 + e0); R.v1 = *(const v4u*)(pg + (size_t)j * NPG + 512 + h * 128 + e0 + 8);
}
__device__ __forceinline__ void gla_gates(const Ctx& C, const GlaRaw& R) {
    LAS float* GK = (LAS float*)(C.lds + GL_GK); LAS float* SEG = (LAS float*)(C.lds + GL_SEG); LAS bf16* Z = (LAS bf16*)(C.lds + GL_Z); LAS float* GUP = (LAS float*)(C.lds + GL_GUP);
    const int tid = C.tid;
    if (tid < 128) { const int t = tid >> 1, hh = tid & 1; *(LAS v4u*)(Z + t * 16 + hh * 8) = R.z; }
    GUP[tid] = R.g0; GUP[tid + NT] = R.g1;
    if (tid < 64) GUP[1024 + tid] = R.gb;
    __syncthreads();
    { const int t = tid >> 3, d0 = (tid & 7) * 8; float a[8];
#pragma unroll
      for (int q = 0; q < 8; ++q) a[q] = GUP[1024 + d0 + q];
#pragma unroll
      for (int i = 0; i < 16; ++i) { const float zv = bf2f(Z[t * 16 + i]);
#pragma unroll
          for (int q = 0; q < 8; ++q) a[q] += zv * GUP[i * 64 + d0 + q]; }
#pragma unroll
      for (int q = 0; q < 8; ++q) GK[t * 64 + d0 + q] = logsigmoidf_(a[q]) * (1.f / 16.f); }
    __syncthreads();
    { const int d = tid & 63, seg = tid >> 6; float run = 0.f;
#pragma unroll
      for (int q = 0; q < 8; ++q) { run += GK[(seg * 8 + q) * 64 + d]; GK[(seg * 8 + q) * 64 + d] = run; }
      SEG[seg * 64 + d] = run; }
    __syncthreads();
    { const int d = tid & 63, seg = tid >> 6; float off = 0.f;
      for (int s = 0; s < seg; ++s) off += SEG[s * 64 + d];
#pragma unroll
      for (int q = 0; q < 8; ++q) GK[(seg * 8 + q) * 64 + d] += off; }
    __syncthreads();
}
__device__ __forceinline__ void gla_stage_vt(const Ctx& C, const GlaRaw& R) {
    LAS bf16* VT = (LAS bf16*)(C.lds + GL_VT);
    const int j = C.tid >> 3, e0 = (C.tid & 7) * 16;
    const unsigned w[8] = {R.v0.x, R.v0.y, R.v0.z, R.v0.w, R.v1.x, R.v1.y, R.v1.z, R.v1.w};
#pragma unroll
    for (int q = 0; q < 8; ++q) { VT[(e0 + 2 * q) * GL_LD + j] = (bf16)(w[q] & 0xffffu); VT[(e0 + 2 * q + 1) * GL_LD + j] = (bf16)(w[q] >> 16); }
}

__device__ __forceinline__ void ph_gla_a(const Ctx& C, const bf16* PG, const float* gk_up, const float* gk_b, bf16* DS, float* GAM) {
    LAS float* GK = (LAS float*)(C.lds + GL_GK); LAS bf16* KT = (LAS bf16*)(C.lds + GL_I0); LAS bf16* VT = (LAS bf16*)(C.lds + GL_VT);
    for (int item = C.bid; item < 2048; item += C.nb) {
        const int bh = item >> 7, c = item & 127, b = bh >> 2, h = bh & 3;
        const size_t m0 = (size_t)b * T_ + c * 64;
        const bf16* pg = PG + m0 * NPG;
        GlaRaw R; gla_fetch(R, C, pg, gk_up, gk_b, h, false);
        gla_gates(C, R);
        { const int j = C.tid >> 3, d0 = (C.tid & 7) * 8;
          const unsigned w[4] = {R.k.x, R.k.y, R.k.z, R.k.w};
#pragma unroll
          for (int q = 0; q < 4; ++q) { const float k0 = bf2f((bf16)(w[q] & 0xffffu)), k1 = bf2f((bf16)(w[q] >> 16));
              const int d = d0 + 2 * q;
              KT[d * GL_LD + j] = (bf16)f2bf(k0 * __expf(GK[63 * 64 + d] - GK[j * 64 + d]));
              KT[(d + 1) * GL_LD + j] = (bf16)f2bf(k1 * __expf(GK[63 * 64 + d + 1] - GK[j * 64 + d + 1])); } }
        gla_stage_vt(C, R);
        if (C.tid < 64) GAM[(size_t)item * 64 + C.tid] = __expf(GK[63 * 64 + C.tid]);
        __syncthreads();
        { const int n0 = C.wave * 16, lane = C.lane, cc = lane & 15, g = lane >> 4;
          bf16* out = DS + (size_t)item * 8192 + (size_t)(n0 + cc) * 64 + 4 * g;
#pragma unroll
          for (int mt = 0; mt < 4; ++mt) { f32x4 acc = {0.f, 0.f, 0.f, 0.f}; acc = mm16(KT + mt * 16 * GL_LD, GL_LD, VT + n0 * GL_LD, GL_LD, 64, acc, lane);
              *(unsigned long long*)(out + mt * 16) = pack4(acc); } }
        __syncthreads();
    }
}
__device__ __forceinline__ void ph_gla_b(const Ctx& C, bf16* DS, const float* GAM) {
    for (int idx = C.bid * NT + C.tid; idx < 16 * 8192; idx += C.nb * NT) {
        const int bh = idx >> 13, ed = idx & 8191, d = ed & 63;
        bf16* p = DS + (size_t)bh * 128 * 8192 + ed; const float* gp = GAM + (size_t)bh * 128 * 64 + d;
        float S = 0.f;
        for (int c0 = 0; c0 < 128; c0 += 8) {
            float ds[8], gm[8];
#pragma unroll
            for (int i = 0; i < 8; ++i) { ds[i] = bf2f(p[(size_t)(c0 + i) * 8192]); gm[i] = gp[(c0 + i) * 64]; }
#pragma unroll
            for (int i = 0; i < 8; ++i) { const float gs = gm[i] * S; p[(size_t)(c0 + i) * 8192] = (bf16)f2bf(gs); S = gs + ds[i]; }
        }
    }
}
__device__ __forceinline__ void ph_gla_c(const Ctx& C, const bf16* PG, const float* gk_up, const float* gk_b, const float* norm_g, const bf16* DS, bf16* O) {
    LAS float* GK = (LAS float*)(C.lds + GL_GK); LAS bf16* QP = (LAS bf16*)(C.lds + GL_I0); LAS bf16* KM = (LAS bf16*)(C.lds + GL_I1); LAS bf16* AI = (LAS bf16*)(C.lds + GL_I2);
    LAS bf16* VT = (LAS bf16*)(C.lds + GL_VT); LAS float* SSQ = (LAS float*)(C.lds + GL_SSQ);
    for (int item = C.bid; item < 2048; item += C.nb) {
        const int bh = item >> 7, c = item & 127, b = bh >> 2, h = bh & 3;
        const size_t m0 = (size_t)b * T_ + c * 64;
        const bf16* pg = PG + m0 * NPG;
        GlaRaw R; gla_fetch(R, C, pg, gk_up, gk_b, h, true);
        s16x8 sfrag[4][2];
        { const int lane = C.lane, cc = lane & 15, g = lane >> 4, eh = C.wave >> 2; const bf16* Sg = DS + (size_t)item * 8192;
#pragma unroll
          for (int mt = 0; mt < 4; ++mt) { sfrag[mt][0] = *(const s16x8*)(Sg + (size_t)(eh * 64 + mt * 16 + cc) * 64 + 8 * g); sfrag[mt][1] = *(const s16x8*)(Sg + (size_t)(eh * 64 + mt * 16 + cc) * 64 + 32 + 8 * g); } }
        gla_gates(C, R);
        { const int j = C.tid >> 3, d0 = (C.tid & 7) * 8;
          const v4u qx = R.q, kx = R.k;
          const unsigned qw[4] = {qx.x, qx.y, qx.z, qx.w}, kw[4] = {kx.x, kx.y, kx.z, kx.w};
          unsigned qo[4], ko[4];
#pragma unroll
          for (int q = 0; q < 4; ++q) { const int d = d0 + 2 * q;
              const float e0 = GK[63 * 64 + d] - GK[j * 64 + d], e1 = GK[63 * 64 + d + 1] - GK[j * 64 + d + 1];
              const float q0 = 0.125f * bf2f((bf16)(qw[q] & 0xffffu)) * __expf(-e0), q1 = 0.125f * bf2f((bf16)(qw[q] >> 16)) * __expf(-e1);
              const float k0 = bf2f((bf16)(kw[q] & 0xffffu)) * __expf(e0), k1 = bf2f((bf16)(kw[q] >> 16)) * __expf(e1);
              qo[q] = pk2(q0, q1); ko[q] = pk2(k0, k1); }
          *(LAS v4u*)(QP + j * GL_LD + d0) = (v4u){qo[0], qo[1], qo[2], qo[3]}; *(LAS v4u*)(KM + j * GL_LD + d0) = (v4u){ko[0], ko[1], ko[2], ko[3]}; }
        gla_stage_vt(C, R);
        __syncthreads();
        { const int lane = C.lane, cc = lane & 15, g = lane >> 4, n0 = (C.wave >> 1) * 16;
#pragma unroll
          for (int q = 0; q < 2; ++q) { const int mt0 = ((C.wave & 1) * 2 + q) * 16; f32x4 acc = {0.f, 0.f, 0.f, 0.f};
              acc = mm16(KM + mt0 * GL_LD, GL_LD, QP + n0 * GL_LD, GL_LD, 64, acc, lane);
              const int i = n0 + cc, j = mt0 + 4 * g;
              acc.x = (j + 0 <= i) ? acc.x : 0.f; acc.y = (j + 1 <= i) ? acc.y : 0.f; acc.z = (j + 2 <= i) ? acc.z : 0.f; acc.w = (j + 3 <= i) ? acc.w : 0.f;
              *(LAS unsigned long long*)(AI + (n0 + cc) * GL_LD + mt0 + 4 * g) = pack4(acc); } }
        __syncthreads();
        { const int lane = C.lane, cc = lane & 15, g = lane >> 4, n0 = (C.wave & 3) * 16, eh = C.wave >> 2;
          f32x4 acc[4]; float ss = 0.f;
#pragma unroll
          for (int mt = 0; mt < 4; ++mt) { const int e0 = eh * 64 + mt * 16; acc[mt] = (f32x4){0.f, 0.f, 0.f, 0.f};
              { const LAS bf16* bp = QP + (n0 + cc) * GL_LD + 8 * g;
                acc[mt] = __builtin_amdgcn_mfma_f32_16x16x32_bf16(sfrag[mt][0], *(const LAS s16x8*)bp, acc[mt], 0, 0, 0); acc[mt] = __builtin_amdgcn_mfma_f32_16x16x32_bf16(sfrag[mt][1], *(const LAS s16x8*)(bp + 32), acc[mt], 0, 0, 0); }
              acc[mt] = mm16(VT + e0 * GL_LD, GL_LD, AI + n0 * GL_LD, GL_LD, 64, acc[mt], lane);
              ss += (acc[mt].x * acc[mt].x + acc[mt].y * acc[mt].y) + (acc[mt].z * acc[mt].z + acc[mt].w * acc[mt].w); }
          ss = xsum4(ss);
          if (g == 0) SSQ[eh * 64 + n0 + cc] = ss;
          __syncthreads();
          const float rstd = 1.f / sqrtf((SSQ[n0 + cc] + SSQ[64 + n0 + cc]) * (1.f / 128.f) + 1e-6f);
          const size_t m = m0 + n0 + cc;
#pragma unroll
          for (int mt = 0; mt < 4; ++mt) { const int e = eh * 64 + mt * 16 + 4 * g;
              const unsigned long long gx = *(const unsigned long long*)(pg + (size_t)(n0 + cc) * NPG + 1024 + h * 128 + e);
              const f32x4 ng = *(const f32x4*)(norm_g + e);
              f32x4 o;
              o.x = acc[mt].x * rstd * ng.x * siluf_(bf2f((bf16)(gx & 0xffffu)));
              o.y = acc[mt].y * rstd * ng.y * siluf_(bf2f((bf16)((gx >> 16) & 0xffffu)));
              o.z = acc[mt].z * rstd * ng.z * siluf_(bf2f((bf16)((gx >> 32) & 0xffffu)));
              o.w = acc[mt].w * rstd * ng.w * siluf_(bf2f((bf16)(gx >> 48)));
              *(unsigned long long*)(O + m * D_ + h * 128 + e) = pack4(o); } }
        __syncthreads();
    }
}


struct RwkvW { const float *mu, *mu_vres, *w0, *a0, *v0, *k_k, *k_a, *r_k; const bf16 *wupT, *aupT, *gupT, *vupT; };
constexpr int RW_LD = 72, RW_XLD = 296;
constexpr int RW_R0 = 0;
constexpr int RW_SEG = 16384;
constexpr int RW_R1 = 36864;
constexpr int RW_R2 = RW_R1 + 27648;
constexpr int RW_R3 = RW_R2 + 9216;
constexpr int RW_R4 = RW_R3 + 27648;
constexpr int RW_TI = RW_R4 + 128 * RW_LD * 2;
constexpr int RW_MU = RW_TI + 2048;
constexpr int RW_X = RW_MU + 2048;
constexpr int RW_END = RW_X + 64 * RW_XLD * 2;
static_assert(RW_END <= MISC_OFF, "RWKV LDS map");

typedef short s16x4 __attribute__((ext_vector_type(4)));
__device__ __forceinline__ float tanh_fast(float x) { const float e = __expf(2.f * x); return 1.f - 2.f / (e + 1.f); }
__device__ __forceinline__ float softplus_fast(float x) { return fmaxf(x, 0.f) + __logf(1.f + __expf(-fabsf(x))); }
__device__ __forceinline__ s16x4 cvt4(f32x4 v) { const unsigned long long p = pack4(v); return __builtin_bit_cast(s16x4, p); }
__device__ __forceinline__ void ld8f(const float* p, float (&o)[8]) { const f32x4 a = *(const f32x4*)p, b = *(const f32x4*)(p + 4); o[0] = a.x; o[1] = a.y; o[2] = a.z; o[3] = a.w; o[4] = b.x; o[5] = b.y; o[6] = b.z; o[7] = b.w; }
__device__ __forceinline__ float sum8(float v) { v += dpp_f<0xB1>(v); v += dpp_f<0x4E>(v); v += dpp_f<0x141>(v); return v; }
__device__ __forceinline__ void unpack8(const v4u x, float (&o)[8]) {
    o[0] = bf2f((bf16)(x.x & 0xffffu)); o[1] = bf2f((bf16)(x.x >> 16)); o[2] = bf2f((bf16)(x.y & 0xffffu)); o[3] = bf2f((bf16)(x.y >> 16));
    o[4] = bf2f((bf16)(x.z & 0xffffu)); o[5] = bf2f((bf16)(x.z >> 16)); o[6] = bf2f((bf16)(x.w & 0xffffu)); o[7] = bf2f((bf16)(x.w >> 16)); }
__device__ __forceinline__ v4u pack8(const float (&o)[8]) { return (v4u){pk2(o[0], o[1]), pk2(o[2], o[3]), pk2(o[4], o[5]), pk2(o[6], o[7])}; }
__device__ __forceinline__ f32x4 mm16_gb(const LAS bf16* A, int lda, const bf16* B, int ldb, int K, f32x4 acc, int lane) {
    const int r = lane & 15, g = lane >> 4;
    const LAS bf16* ap = A + r * lda + 8 * g; const bf16* bp = B + r * ldb + 8 * g;
    for (int k0 = 0; k0 < K; k0 += 32) { const s16x8 a = *(const LAS s16x8*)(ap + k0); const s16x8 b = *(const s16x8*)(bp + k0); acc = __builtin_amdgcn_mfma_f32_16x16x32_bf16(a, b, acc, 0, 0, 0); }
    return acc;
}

__device__ __forceinline__ void ph_norm_b(const Ctx& C, const bf16* x, const float* g, const float* sh, const float* sc, bf16* XB) {
    const int gw = C.bid * 8 + C.wave, NGW = C.nb * 8, lane = C.lane;
    for (int m = gw; m < M_; m += NGW) {
        const int b = m / T_;
        const v4u* xr = (const v4u*)(x + (size_t)m * D_) + lane;
        float v[2][8]; float s = 0.f;
#pragma unroll
        for (int j = 0; j < 2; ++j) { unpack8(xr[64 * j], v[j]);
#pragma unroll
            for (int i = 0; i < 8; ++i) s += v[j][i] * v[j][i]; }
        const float rstd = 1.f / sqrtf(wave_sum(s) * (1.f / D_) + 1e-6f);
        v4u* o = (v4u*)(XB + (size_t)m * D_) + lane;
#pragma unroll
        for (int j = 0; j < 2; ++j) { const int col = 8 * lane + 512 * j; float gv[8], shv[8], scv[8], h[8];
            ld8f(g + col, gv); ld8f(sh + b * 6144 + col, shv); ld8f(sc + b * 6144 + col, scv);
#pragma unroll
            for (int i = 0; i < 8; ++i) h[i] = v[j][i] * rstd * gv[i] * (scv[i] + 1.f) + shv[i];
            o[64 * j] = pack8(h); }
    }
}
__device__ __forceinline__ void ph_final_b(const Ctx& C, const bf16* x, const float* g, float* out, int m_lo, int m_hi, bf16* keep, int c_lo, int c_hi) {
    const int gw = C.bid * 8 + C.wave, NGW = C.nb * 8, lane = C.lane;
    for (int m = m_lo + gw; m < m_hi; m += NGW) {
        const v4u* xr = (const v4u*)(x + (size_t)m * D_) + lane;
        float v[2][8]; float s = 0.f;
#pragma unroll
        for (int j = 0; j < 2; ++j) { unpack8(xr[64 * j], v[j]);
#pragma unroll
            for (int i = 0; i < 8; ++i) s += v[j][i] * v[j][i]; }
        const float rstd = 1.f / sqrtf(wave_sum(s) * (1.f / D_) + 1e-6f);
#pragma unroll
        for (int j = 0; j < 2; ++j) { const int col = 8 * lane + 512 * j; float gv[8]; ld8f(g + col, gv);
            f32x4* o = (f32x4*)(out + (size_t)m * D_ + col);
            o[0] = (f32x4){v[j][0] * rstd * gv[0], v[j][1] * rstd * gv[1], v[j][2] * rstd * gv[2], v[j][3] * rstd * gv[3]};
            o[1] = (f32x4){v[j][4] * rstd * gv[4], v[j][5] * rstd * gv[5], v[j][6] * rstd * gv[6], v[j][7] * rstd * gv[7]}; }
    }
    for (int m = c_lo + gw; m < c_hi; m += NGW) { const v4u* xr = (const v4u*)(x + (size_t)m * D_) + lane; v4u* kr = (v4u*)(keep + (size_t)(m - c_lo) * D_) + lane; kr[0] = xr[0]; kr[64] = xr[64]; }
}
__device__ __forceinline__ void ph_rwkv_a(const Ctx& C, const bf16* PR, const bf16* VL  , const RwkvW& W, int layer,
                                          bf16* PP, bf16* QQ, bf16* RH, bf16* YH, float* GAMC, float* RK, bf16* GG, bf16* VF, bool store_v = true) {
    LAS unsigned char* L = C.lds;
    LAS bf16* X = (LAS bf16*)(L + RW_X); LAS float* CUM = (LAS float*)(L + RW_R0); LAS float* SEG = (LAS float*)(L + RW_SEG);
    LAS bf16* NI = (LAS bf16*)(L + RW_R0), *AAK = NI + 64 * RW_LD, *ARB = AAK + 64 * RW_LD, *ARK = ARB + 64 * RW_LD;
    LAS bf16* PRE = (LAS bf16*)(L + RW_R1);
    LAS bf16* AT = (LAS bf16*)(L + RW_R1), *BT = AT + 64 * RW_LD, *KT = BT + 64 * RW_LD, *RT = (LAS bf16*)(L + RW_R2);
    LAS bf16* XB16 = (LAS bf16*)(L + RW_R1);
    LAS bf16* BHc = (LAS bf16*)(L + RW_R3), *KHc = BHc + 64 * RW_LD, *VTc = KHc + 64 * RW_LD;
    LAS bf16* XT = (LAS bf16*)(L + RW_R4); LAS bf16* TI = (LAS bf16*)(L + RW_TI);
    const int wave = C.wave;
    LAS float* MU = (LAS float*)(L + RW_MU);
    for (int i = C.tid; i < 288; i += NT) MU[i] = i < 256 ? W.mu[1536 + i] : (layer ? W.mu_vres[i - 256] : 0.f);
    __syncthreads();
    for (int bc = C.bid; bc < 512; bc += C.nb) {
        const int c = bc & 127, b = bc >> 7;
        const size_t m0 = (size_t)b * T_ + c * 64;
        { const int tid = C.tid;
          v4u xc[5], xp[5];
#pragma unroll
          for (int it = 0; it < 5; ++it) { const int idx = tid + it * NT; xc[it] = (v4u){0u, 0u, 0u, 0u}; xp[it] = xc[it];
            if (idx < 64 * 36) { const int t1 = idx / 36, q = idx % 36, col = q * 8; const size_t m1 = m0 + t1; const bool first1 = (c == 0 && t1 == 0);
                if (q < 32) { xc[it] = *(const v4u*)(PR + m1 * NPR + 1536 + col); if (!first1) xp[it] = *(const v4u*)(PR + (m1 - 1) * NPR + 1536 + col); }
                else if (layer) { xc[it] = *(const v4u*)(VL + m1 * NPG + 1552 + (col - 256)); if (!first1) xp[it] = *(const v4u*)(VL + (m1 - 1) * NPG + 1552 + (col - 256)); } } }
#pragma unroll
          for (int it = 0; it < 5; ++it) { const int idx = tid + it * NT;
            if (idx < 64 * 36) { const int t1 = idx / 36, q = idx % 36, col = q * 8;
                float cv[8], pv[8], mu[8]; unpack8(xc[it], cv); unpack8(xp[it], pv);
                { const f32x4 ma = *(const LAS f32x4*)(MU + col), mb = *(const LAS f32x4*)(MU + col + 4); mu[0] = ma.x; mu[1] = ma.y; mu[2] = ma.z; mu[3] = ma.w; mu[4] = mb.x; mu[5] = mb.y; mu[6] = mb.z; mu[7] = mb.w; }
#pragma unroll
                for (int i = 0; i < 8; ++i) { float p = cv[i] + (pv[i] - cv[i]) * mu[i]; if (q < 8) p = tanh_fast(p); else if (q >= 16 && q < 32) p = sigmoidf_(p); cv[i] = p; }
                *(LAS v4u*)(X + t1 * RW_XLD + col) = pack8(cv); } }
        }
        __syncthreads();
#pragma unroll 1
      for (int h = 0; h < 8; ++h) {
        const int item = bc * 8 + h;
        int tid_ = C.tid; asm volatile("" : "+v"(tid_));
        const int tid = tid_, lane = tid & 63, cc = lane & 15, g = lane >> 4;
        const int t = tid >> 3, d0 = (tid & 7) * 8, ch = h * 64 + d0; const size_t m = m0 + t; const bool first = (c == 0 && t == 0);
        v4u rcx = *(const v4u*)(PR + m * NPR + ch), kcx = *(const v4u*)(PR + m * NPR + 512 + ch), vcx = *(const v4u*)(PR + m * NPR + 1024 + ch);
        v4u rpx = (v4u){0u, 0u, 0u, 0u}, kpx = rpx, vpx = rpx, vfx = rpx;
        if (!first) { rpx = *(const v4u*)(PR + (m - 1) * NPR + ch); kpx = *(const v4u*)(PR + (m - 1) * NPR + 512 + ch); vpx = *(const v4u*)(PR + (m - 1) * NPR + 1024 + ch); }
        if (layer) vfx = *(const v4u*)(VF + m * 512 + ch);
        {
            const int lsel = wave >> 1;
            const bf16* WT = lsel == 0 ? W.wupT : lsel == 1 ? W.aupT : lsel == 2 ? W.gupT : W.vupT;
            const int Kl = lsel == 2 ? 128 : lsel == 3 ? 32 : 64, xoff = lsel == 0 ? 0 : lsel == 1 ? 64 : lsel == 2 ? 128 : 256;
            LAS bf16* outp = PRE + lsel * 64 * RW_LD;
            const bool live = (lsel != 3 || layer);
#pragma unroll
            for (int mq = 0; mq < 2; ++mq) { const int mt = (wave & 1) * 2 + mq;
                s16x8 af[4];
                const bf16* ap = WT + (size_t)(h * 64 + mt * 16 + cc) * Kl + 8 * g;
#pragma unroll
                for (int ks = 0; ks < 4; ++ks) af[ks] = (live && ks * 32 < Kl) ? *(const s16x8*)(ap + ks * 32) : (s16x8){0, 0, 0, 0, 0, 0, 0, 0};
#pragma unroll
                for (int nt = 0; nt < 4; ++nt) { f32x4 acc = {0.f, 0.f, 0.f, 0.f};
                    const LAS bf16* bp = X + (nt * 16 + cc) * RW_XLD + xoff + 8 * g;
#pragma unroll
                    for (int ks = 0; ks < 4; ++ks) if (ks * 32 < Kl) { const s16x8 bb = *(const LAS s16x8*)(bp + ks * 32); acc = __builtin_amdgcn_mfma_f32_16x16x32_bf16(af[ks], bb, acc, 0, 0, 0); }
                    *(LAS unsigned long long*)(outp + (nt * 16 + cc) * RW_LD + mt * 16 + 4 * g) = pack4(acc); } }
        }
        __syncthreads();
        float av[8], bv[8], kv[8], rv[8], lw[8], vv[8];
        {
            float rc[8], rp[8], kc[8], kp[8], vc[8], vp[8], pw[8], pa[8], pg_[8], pvg[8];
            unpack8(rcx, rc); unpack8(kcx, kc); unpack8(vcx, vc); unpack8(rpx, rp); unpack8(kpx, kp); unpack8(vpx, vp);
            unpack8(*(const LAS v4u*)(PRE + (0 * 64 + t) * RW_LD + d0), pw); unpack8(*(const LAS v4u*)(PRE + (1 * 64 + t) * RW_LD + d0), pa);
            unpack8(*(const LAS v4u*)(PRE + (2 * 64 + t) * RW_LD + d0), pg_); unpack8(*(const LAS v4u*)(PRE + (3 * 64 + t) * RW_LD + d0), pvg);
            float vf[8]; unpack8(vfx, vf);
            float ssq = 0.f, rks = 0.f, asg[8], gg[8];
            float mur[8], muk[8], muv[8], w0c[8], a0c[8], v0c[8], kkc[8], kac[8], rkc[8];
            ld8f(W.mu + ch, mur); ld8f(W.mu + 512 + ch, muk); ld8f(W.mu + 1024 + ch, muv); ld8f(W.w0 + ch, w0c); ld8f(W.a0 + ch, a0c);
            ld8f(W.k_k + ch, kkc); ld8f(W.k_a + ch, kac); ld8f(W.r_k + ch, rkc);
            if (layer) ld8f(W.v0 + ch, v0c);
#pragma unroll
            for (int i = 0; i < 8; ++i) {
                const float r = rc[i] + (rp[i] - rc[i]) * mur[i], k = kc[i] + (kp[i] - kc[i]) * muk[i]; float v = vc[i] + (vp[i] - vc[i]) * muv[i];
                lw[i] = -0.6065306597f * sigmoidf_(w0c[i] + pw[i]);
                asg[i] = sigmoidf_(a0c[i] + pa[i]);
                if (layer) v = v + (vf[i] - v) * sigmoidf_(v0c[i] + pvg[i]);
                const float kk = k * kkc[i]; ssq += kk * kk;
                kv[i] = k * (1.f + (asg[i] - 1.f) * kac[i]); rv[i] = r; vv[i] = v; gg[i] = pg_[i]; av[i] = kk;
                rks += r * kv[i] * rkc[i];
            }
            ssq = sum8(ssq); rks = sum8(rks);
            const float inv = 1.f / sqrtf(fmaxf(ssq, 1e-24f));
#pragma unroll
            for (int i = 0; i < 8; ++i) { const float kk = av[i] * inv; av[i] = -kk; bv[i] = kk * asg[i]; }
            if ((tid & 7) == 0) RK[m * 8 + h] = rks;
            *(v4u*)(GG + m * 512 + ch) = pack8(gg);
            if (store_v) *(v4u*)(VF + m * 512 + ch) = pack8(vv);
#pragma unroll
            for (int i = 0; i < 8; ++i) vv[i] = bf2f((bf16)f2bf(vv[i]));
        }
        __syncthreads();
#pragma unroll
        for (int i = 0; i < 8; ++i) CUM[t * 64 + d0 + i] = lw[i];
        __syncthreads();
        { const int d = tid & 63, seg = tid >> 6; float run = 0.f;
#pragma unroll
          for (int q = 0; q < 8; ++q) { run += CUM[(seg * 8 + q) * 64 + d]; CUM[(seg * 8 + q) * 64 + d] = run; }
          SEG[seg * 64 + d] = run; }
        __syncthreads();
        { const int d = tid & 63, seg = tid >> 6; float off = 0.f;
          for (int s = 0; s < seg; ++s) off += SEG[s * 64 + d];
#pragma unroll
          for (int q = 0; q < 8; ++q) CUM[(seg * 8 + q) * 64 + d] += off; }
        __syncthreads();
        {
            float at[8], bt[8], kt[8], rt[8];
#pragma unroll
            for (int i = 0; i < 8; ++i) { const float cu = CUM[t * 64 + d0 + i], cC = CUM[63 * 64 + d0 + i], en = __expf(-cu), ec = __expf(cC - cu);
                at[i] = av[i] * __expf(cu - lw[i]); bt[i] = bv[i] * en; kt[i] = kv[i] * en; rt[i] = rv[i] * __expf(cu);
                BHc[(d0 + i) * RW_LD + t] = (bf16)f2bf(bv[i] * ec); KHc[(d0 + i) * RW_LD + t] = (bf16)f2bf(kv[i] * ec); VTc[(d0 + i) * RW_LD + t] = (bf16)f2bf(vv[i]);
                XT[(d0 + i) * RW_LD + t] = (bf16)f2bf(at[i]);
                if (t == 63) GAMC[(size_t)item * 64 + d0 + i] = __expf(cC); }
            *(LAS v4u*)(AT + t * RW_LD + d0) = pack8(at); *(LAS v4u*)(BT + t * RW_LD + d0) = pack8(bt); *(LAS v4u*)(KT + t * RW_LD + d0) = pack8(kt); *(LAS v4u*)(RT + t * RW_LD + d0) = pack8(rt);
        }
        __syncthreads();
        {
            const int msel = wave >> 1;
            const LAS bf16* As = (msel == 0 || msel == 2) ? BT : KT; const LAS bf16* Bs = (msel < 2) ? AT : RT;
            f32x4 accs[8];
#pragma unroll
            for (int q = 0; q < 8; ++q) { const int tile = (wave & 1) * 8 + q, mt = tile >> 2, nt = tile & 3; accs[q] = (f32x4){0.f, 0.f, 0.f, 0.f};
                accs[q] = mm16(As + mt * 16 * RW_LD, RW_LD, Bs + nt * 16 * RW_LD, RW_LD, 64, accs[q], lane);
                const int tt = nt * 16 + cc, s0 = mt * 16 + 4 * g, lim = (msel < 2) ? tt - 1 : tt;
                accs[q].x = (s0 + 0 <= lim) ? accs[q].x : 0.f; accs[q].y = (s0 + 1 <= lim) ? accs[q].y : 0.f; accs[q].z = (s0 + 2 <= lim) ? accs[q].z : 0.f; accs[q].w = (s0 + 3 <= lim) ? accs[q].w : 0.f; }
            __syncthreads();
            LAS bf16* outp = NI + msel * 64 * RW_LD;
#pragma unroll
            for (int q = 0; q < 8; ++q) { const int tile = (wave & 1) * 8 + q, mt = tile >> 2, nt = tile & 3;
                *(LAS unsigned long long*)(outp + (nt * 16 + cc) * RW_LD + mt * 16 + 4 * g) = pack4(accs[q]); }
        }
        __syncthreads();
        if (wave == 0) {
            const int blk = lane >> 4, col = lane & 15; float x[16];
#pragma unroll
            for (int tt = 0; tt < 16; ++tt) { float nr[16]; { float lo[8], hi[8]; unpack8(*(const LAS v4u*)(NI + (16 * blk + tt) * RW_LD + 16 * blk), lo); unpack8(*(const LAS v4u*)(NI + (16 * blk + tt) * RW_LD + 16 * blk + 8), hi);
#pragma unroll
                    for (int q = 0; q < 8; ++q) { nr[q] = lo[q]; nr[8 + q] = hi[q]; } }
                float a = (tt == col) ? 1.f : 0.f;
#pragma unroll
                for (int q = 0; q < tt; ++q) a += nr[q] * x[q];
                x[tt] = a; TI[(blk * 16 + tt) * 16 + col] = (bf16)f2bf(a); }
        } else {
            for (int tile = wave - 1; tile < 16; tile += 7) { const int mt = tile >> 2, nt = tile & 3;
                f32x4 acc = {0.f, 0.f, 0.f, 0.f}; acc = mm16(AAK + mt * 16 * RW_LD, RW_LD, VTc + nt * 16 * RW_LD, RW_LD, 64, acc, lane);
                *(LAS unsigned long long*)(XT + (64 + nt * 16 + cc) * RW_LD + mt * 16 + 4 * g) = pack4(acc); }
        }
        __syncthreads();
        {
            s16x4 xb[4];
#pragma unroll
            for (int i = 0; i < 4; ++i) {
                f32x4 acc; { const unsigned long long xr = *(const LAS unsigned long long*)(XT + (wave * 16 + cc) * RW_LD + 16 * i + 4 * g);
                    acc.x = bf2f((bf16)(xr & 0xffffu)); acc.y = bf2f((bf16)((xr >> 16) & 0xffffu)); acc.z = bf2f((bf16)((xr >> 32) & 0xffffu)); acc.w = bf2f((bf16)(xr >> 48)); }
#pragma unroll
                for (int k = 0; k < i; ++k) { const s16x4 a = *(const LAS s16x4*)(NI + (16 * i + cc) * RW_LD + 16 * k + 4 * g); acc = __builtin_amdgcn_mfma_f32_16x16x16bf16_1k(a, xb[k], acc, 0, 0, 0); }
                const s16x4 yb = cvt4(acc), ta = *(const LAS s16x4*)(TI + (i * 16 + cc) * 16 + 4 * g);
                const f32x4 xi = __builtin_amdgcn_mfma_f32_16x16x16bf16_1k(ta, yb, (f32x4){0.f, 0.f, 0.f, 0.f}, 0, 0, 0);
                xb[i] = cvt4(xi);
            }
            __syncthreads();
#pragma unroll
            for (int i = 0; i < 4; ++i) *(LAS s16x4*)(XB16 + (wave * 16 + cc) * RW_LD + 16 * i + 4 * g) = xb[i];
        }
        __syncthreads();
        {
            const int osel = wave >> 1; const size_t ob = (size_t)item * 4096;
#pragma unroll 1
            for (int q = 0; q < 8; ++q) { const int tile = (wave & 1) * 8 + q, mt = tile >> 2, nt = tile & 3; f32x4 acc = {0.f, 0.f, 0.f, 0.f};
                if (osel == 0) {
                    acc = mm16(XB16 + mt * 16 * RW_LD, RW_LD, BHc + nt * 16 * RW_LD, RW_LD, 64, acc, lane);
                    *(unsigned long long*)(PP + ob + (nt * 16 + cc) * 64 + mt * 16 + 4 * g) = pack4(acc);
                } else if (osel == 1) {
                    acc = mm16(BHc + mt * 16 * RW_LD, RW_LD, XB16 + (64 + nt * 16) * RW_LD, RW_LD, 64, acc, lane);
                    acc = mm16(KHc + mt * 16 * RW_LD, RW_LD, VTc + nt * 16 * RW_LD, RW_LD, 64, acc, lane);
                    *(unsigned long long*)(QQ + ob + (nt * 16 + cc) * 64 + mt * 16 + 4 * g) = pack4(acc);
                } else if (osel == 2) {
                    acc = mm16(XB16 + mt * 16 * RW_LD, RW_LD, ARB + nt * 16 * RW_LD, RW_LD, 64, acc, lane);
                    const unsigned long long rr = *(const LAS unsigned long long*)(RT + (nt * 16 + cc) * RW_LD + mt * 16 + 4 * g);
                    acc.x += bf2f((bf16)(rr & 0xffffu)); acc.y += bf2f((bf16)((rr >> 16) & 0xffffu)); acc.z += bf2f((bf16)((rr >> 32) & 0xffffu)); acc.w += bf2f((bf16)(rr >> 48));
                    *(unsigned long long*)(RH + ob + (nt * 16 + cc) * 64 + mt * 16 + 4 * g) = pack4(acc);
                } else {
                    acc = mm16(XB16 + (64 + mt * 16) * RW_LD, RW_LD, ARB + nt * 16 * RW_LD, RW_LD, 64, acc, lane);
                    acc = mm16(VTc + mt * 16 * RW_LD, RW_LD, ARK + nt * 16 * RW_LD, RW_LD, 64, acc, lane);
                    *(unsigned long long*)(YH + ob + (nt * 16 + cc) * 64 + mt * 16 + 4 * g) = pack4(acc);
                } }
        }
        __syncthreads();
      }
    }
}

constexpr int CH_R = 6, CH_SLOT = 9216 + 9216 + 256;
constexpr int CH_RING = 0, CH_SI = CH_R * CH_SLOT, CH_FLAGS = CH_SI + 4 * 2304;
static_assert(CH_FLAGS + 64 <= MISC_OFF, "chain LDS map");
struct ChainRegs { v4u p[8], q[8]; f32x4 gm; };
__device__ __forceinline__ void chain_fetch(ChainRegs& o, const bf16* PP, const bf16* QQ, const float* GAMC, int item, int lane) {
    const size_t ob = (size_t)item * 4096;
#pragma unroll
    for (int i = 0; i < 8; ++i) { o.p[i] = *(const v4u*)(PP + ob + (size_t)(i * 64 + lane) * 8); o.q[i] = *(const v4u*)(QQ + ob + (size_t)(i * 64 + lane) * 8); }
    o.gm = *(const f32x4*)(GAMC + (size_t)item * 64 + (lane & 15) * 4);
}
__device__ __forceinline__ void chain_commit(const ChainRegs& o, LAS unsigned char* L, int c, int lane) {
    volatile LAS unsigned* flags = (volatile LAS unsigned*)(L + CH_FLAGS);
    const int slot = c % CH_R;
    if (c >= CH_R) { const unsigned need = (unsigned)(c - CH_R + 1);
        for (;;) { const unsigned m0 = flags[CH_R + 0], m1 = flags[CH_R + 1], m2 = flags[CH_R + 2], m3 = flags[CH_R + 3];
            if (m0 >= need && m1 >= need && m2 >= need && m3 >= need) break; __builtin_amdgcn_s_sleep(1); } }
    asm volatile("" ::: "memory");
    LAS unsigned char* sl = L + CH_RING + slot * CH_SLOT;
#pragma unroll
    for (int i = 0; i < 8; ++i) { const int idx = i * 64 + lane, row = idx >> 3, c16 = idx & 7;
        *(LAS v4u*)(sl + row * 144 + c16 * 16) = o.p[i]; *(LAS v4u*)(sl + 9216 + row * 144 + c16 * 16) = o.q[i]; }
    if (lane < 16) *(LAS f32x4*)(sl + 18432 + lane * 16) = o.gm;
    asm volatile("s_waitcnt lgkmcnt(0)" ::: "memory");
    if (lane == 0) flags[slot] = (unsigned)(c + 1);
}
__device__ __forceinline__ void ph_rwkv_b(const Ctx& C, int bh  , const bf16* PP, const bf16* QQ, const float* GAMC, bf16* S0) {
    const int lane = C.lane, wave = C.wave, cc = lane & 15, g = lane >> 4, b = bh >> 3, h = bh & 7;
    LAS unsigned char* L = C.lds;
    volatile LAS unsigned* flags = (volatile LAS unsigned*)(L + CH_FLAGS);
    if (C.tid < 16) flags[C.tid] = 0u;
    __syncthreads();
    if (wave >= 4) {
        const int j = wave - 4;
        ChainRegs A, B;
        int lc = j;
        chain_fetch(A, PP, QQ, GAMC, (b * 128 + lc) * 8 + h, lane);
        for (;;) {
            if (lc + 4 < 128) chain_fetch(B, PP, QQ, GAMC, (b * 128 + lc + 4) * 8 + h, lane);
            chain_commit(A, L, lc, lane);
            lc += 4; if (lc >= 128) break;
            if (lc + 4 < 128) chain_fetch(A, PP, QQ, GAMC, (b * 128 + lc + 4) * 8 + h, lane);
            chain_commit(B, L, lc, lane);
            lc += 4; if (lc >= 128) break;
        }
    } else {
        const int vt = wave;
        LAS bf16* SI = (LAS bf16*)(L + CH_SI + vt * 2304);
        f32x4 st[4];
#pragma unroll
        for (int mt = 0; mt < 4; ++mt) st[mt] = (f32x4){0.f, 0.f, 0.f, 0.f};
        for (int c = 0; c < 128; ++c) {
            const int item = (b * 128 + c) * 8 + h, slot = c % CH_R; const size_t ob = (size_t)item * 4096;
#pragma unroll
            for (int mt = 0; mt < 4; ++mt) { const unsigned long long pk = pack4(st[mt]);
                *(unsigned long long*)(S0 + ob + (vt * 16 + cc) * 64 + mt * 16 + 4 * g) = pk; *(LAS unsigned long long*)(SI + cc * RW_LD + mt * 16 + 4 * g) = pk; }
            while (flags[slot] < (unsigned)(c + 1)) __builtin_amdgcn_s_sleep(1);
            asm volatile("s_waitcnt lgkmcnt(0)" ::: "memory");
            const LAS unsigned char* sl = L + CH_RING + slot * CH_SLOT;
            const LAS bf16* Pi = (const LAS bf16*)sl; const LAS bf16* Qi = (const LAS bf16*)(sl + 9216); const LAS float* Gi = (const LAS float*)(sl + 18432);
            const s16x8 b0 = *(const LAS s16x8*)(SI + cc * RW_LD + 8 * g), b1 = *(const LAS s16x8*)(SI + cc * RW_LD + 32 + 8 * g);
#pragma unroll
            for (int mt = 0; mt < 4; ++mt) {
                const f32x4 gm = *(const LAS f32x4*)(Gi + mt * 16 + 4 * g);
                const unsigned long long qq = *(const LAS unsigned long long*)(Qi + (vt * 16 + cc) * RW_LD + mt * 16 + 4 * g);
                const s16x8 a0 = *(const LAS s16x8*)(Pi + (mt * 16 + cc) * RW_LD + 8 * g), a1 = *(const LAS s16x8*)(Pi + (mt * 16 + cc) * RW_LD + 32 + 8 * g);
                f32x4 acc; acc.x = gm.x * st[mt].x + bf2f((bf16)(qq & 0xffffu)); acc.y = gm.y * st[mt].y + bf2f((bf16)((qq >> 16) & 0xffffu));
                acc.z = gm.z * st[mt].z + bf2f((bf16)((qq >> 32) & 0xffffu)); acc.w = gm.w * st[mt].w + bf2f((bf16)(qq >> 48));
                acc = __builtin_amdgcn_mfma_f32_16x16x32_bf16(a0, b0, acc, 0, 0, 0); acc = __builtin_amdgcn_mfma_f32_16x16x32_bf16(a1, b1, acc, 0, 0, 0);
                st[mt] = acc; }
            asm volatile("s_waitcnt lgkmcnt(0)" ::: "memory");
            if (lane == 0) flags[CH_R + vt] = (unsigned)(c + 1);
        }
    }
    __syncthreads();
}

__device__ __forceinline__ void ph_rwkv_c(const Ctx& C, const bf16* S0, const bf16* RH, const bf16* YH, const float* RK, const bf16* GG, const bf16* VF,
                                          const float* gn_g, const float* gn_b, bf16* O) {
    const int lane = C.lane, cc = lane & 15, g = lane >> 4;
    for (int item = C.bid * 8 + C.wave; item < 4096; item += C.nb * 8) {
        const int h = item & 7, c = (item >> 3) & 127, b = item >> 10; const size_t m0 = (size_t)b * T_ + c * 64, ob = (size_t)item * 4096;
        s16x8 af[4][2], bfr[4][2];
#pragma unroll
        for (int q = 0; q < 4; ++q)
#pragma unroll
            for (int k = 0; k < 2; ++k) { af[q][k] = *(const s16x8*)(S0 + ob + (q * 16 + cc) * 64 + k * 32 + 8 * g); bfr[q][k] = *(const s16x8*)(RH + ob + (q * 16 + cc) * 64 + k * 32 + 8 * g); }
#pragma unroll
        for (int nt = 0; nt < 4; ++nt) {
            const size_t m = m0 + nt * 16 + cc;
            f32x4 y[4]; float s1 = 0.f;
#pragma unroll
            for (int mt = 0; mt < 4; ++mt) { const unsigned long long yh = *(const unsigned long long*)(YH + ob + (nt * 16 + cc) * 64 + mt * 16 + 4 * g);
                f32x4 acc; acc.x = bf2f((bf16)(yh & 0xffffu)); acc.y = bf2f((bf16)((yh >> 16) & 0xffffu)); acc.z = bf2f((bf16)((yh >> 32) & 0xffffu)); acc.w = bf2f((bf16)(yh >> 48));
                acc = __builtin_amdgcn_mfma_f32_16x16x32_bf16(af[mt][0], bfr[nt][0], acc, 0, 0, 0); acc = __builtin_amdgcn_mfma_f32_16x16x32_bf16(af[mt][1], bfr[nt][1], acc, 0, 0, 0);
                y[mt] = acc; s1 += (acc.x + acc.y) + (acc.z + acc.w); }
            s1 = xsum4(s1);
            const float mean = s1 * (1.f / 64.f); float s2 = 0.f;
#pragma unroll
            for (int mt = 0; mt < 4; ++mt) { y[mt] = y[mt] - mean; s2 += (y[mt].x * y[mt].x + y[mt].y * y[mt].y) + (y[mt].z * y[mt].z + y[mt].w * y[mt].w); }
            s2 = xsum4(s2);
            const float rstd = 1.f / sqrtf(s2 * (1.f / 64.f) + 64e-5f), rk = RK[m * 8 + h];
#pragma unroll
            for (int mt = 0; mt < 4; ++mt) { const int v = h * 64 + mt * 16 + 4 * g;
                const f32x4 gg4 = *(const f32x4*)(gn_g + v), gb4 = *(const f32x4*)(gn_b + v);
                const unsigned long long vx = *(const unsigned long long*)(VF + m * 512 + v), gx = *(const unsigned long long*)(GG + m * 512 + v);
                f32x4 o;
                o.x = (y[mt].x * rstd * gg4.x + gb4.x + rk * bf2f((bf16)(vx & 0xffffu))) * bf2f((bf16)(gx & 0xffffu));
                o.y = (y[mt].y * rstd * gg4.y + gb4.y + rk * bf2f((bf16)((vx >> 16) & 0xffffu))) * bf2f((bf16)((gx >> 16) & 0xffffu));
                o.z = (y[mt].z * rstd * gg4.z + gb4.z + rk * bf2f((bf16)((vx >> 32) & 0xffffu))) * bf2f((bf16)((gx >> 32) & 0xffffu));
                o.w = (y[mt].w * rstd * gg4.w + gb4.w + rk * bf2f((bf16)(vx >> 48))) * bf2f((bf16)(gx >> 48));
                *(unsigned long long*)(O + m * D_ + 512 + v) = pack4(o); }
        }
    }
}

__device__ __forceinline__ void ph_convfix(const Ctx& C, const float* HALO, const float* FIXU, const float* cw, const float* cb, bf16* ACT) {
    for (int idx = C.bid * NT + C.tid; idx < 128 * 22 * 2 * 128; idx += C.nb * NT) {
        const int j = idx & 127, rr = (idx >> 7) & 1, tile = idx >> 8, pm = tile / 22, pn = tile % 22;
        const bool seq0 = (pm & 31) == 0;
        const float* fx = FIXU + (size_t)tile * 512; const float* hl = HALO + (size_t)(tile - 22) * 512;
        const float u0g = fx[rr * 256 + j], u0v = fx[rr * 256 + 128 + j];
        float u1g, u1v, u2g, u2v;
        if (rr == 0) { u1g = seq0 ? 0.f : hl[256 + j]; u1v = seq0 ? 0.f : hl[256 + 128 + j]; u2g = seq0 ? 0.f : hl[j]; u2v = seq0 ? 0.f : hl[128 + j]; }
        else { u1g = fx[j]; u1v = fx[128 + j]; u2g = seq0 ? 0.f : hl[256 + j]; u2v = seq0 ? 0.f : hl[256 + 128 + j]; }
        const int jg = pn * 128 + j, jv = DFF + jg;
        const float gc = cb[jg] + cw[jg] * u2g + cw[NUP + jg] * u1g + cw[2 * NUP + jg] * u0g, vc = cb[jv] + cw[jv] * u2v + cw[NUP + jv] * u1v + cw[2 * NUP + jv] * u0v;
        ACT[(size_t)(pm * 256 + rr) * DFF + jg] = (bf16)f2bf(siluf_(gc) * vc);
    }
}
}

namespace pg8 {
struct EpiRes {
    static constexpr bool PERM = false, AFTER_DRAIN = false;
    const float* base; float* out; const float* gate; int gstride;
    __device__ __forceinline__ void operator()(const f32x4 (&acc)[2][2][4][2], const Unit& u, int wr, int wc, int fr, int fq) const {
        const int b = (u.pm * BM) / 8192; const float* gp = gate + (size_t)b * gstride;
        const int col0 = u.pn * BM + wc * 32 + 4 * fq;
        f32x4 gv[2][2];
#pragma unroll
        for (int bj = 0; bj < 2; ++bj)
#pragma unroll
            for (int n = 0; n < 2; ++n) gv[bj][n] = *(const f32x4*)(gp + col0 + bj * HALF + n * 16);
#pragma unroll
        for (int ai = 0; ai < 2; ++ai)
#pragma unroll
            for (int m = 0; m < 4; ++m) { const size_t off = (size_t)(u.pm * BM + ai * HALF + wr * 64 + m * 16 + fr) * 1024 + col0;
                f32x4 bs[2][2];
#pragma unroll
                for (int bj = 0; bj < 2; ++bj)
#pragma unroll
                    for (int n = 0; n < 2; ++n) bs[bj][n] = *(const f32x4*)(base + off + bj * HALF + n * 16);
#pragma unroll
                for (int bj = 0; bj < 2; ++bj)
#pragma unroll
                    for (int n = 0; n < 2; ++n) *(f32x4*)(out + off + bj * HALF + n * 16) = bs[bj][n] + gv[bj][n] * acc[ai][bj][m][n]; }
    }
};

template <bool BASE32> struct EpiResB {
    static constexpr bool PERM = true, AFTER_DRAIN = false;
    const float* base32; bf16_t* R; const float* gate; int gstride;
    __device__ __forceinline__ void operator()(const f32x4 (&acc)[2][2][4][2], const Unit& u, int wr, int wc, int fr, int fq) const {
        const int b = u.pm >> 5; const float* gp = gate + (size_t)b * gstride;
        const int col0 = u.pn * BM + wc * 32 + 8 * fq;
        f32x4 gv[2][2];
#pragma unroll
        for (int bj = 0; bj < 2; ++bj)
#pragma unroll
            for (int n = 0; n < 2; ++n) gv[bj][n] = *(const f32x4*)(gp + col0 + bj * HALF + n * 4);
#pragma unroll
        for (int ai = 0; ai < 2; ++ai)
#pragma unroll
            for (int m = 0; m < 4; ++m) { const size_t off = (size_t)(u.pm * BM + ai * HALF + wr * 64 + m * 16 + fr) * 1024 + col0;
                f32x4 bs[2][2];
#pragma unroll
                for (int bj = 0; bj < 2; ++bj) {
                    if (BASE32) { bs[bj][0] = *(const f32x4*)(base32 + off + bj * HALF); bs[bj][1] = *(const f32x4*)(base32 + off + bj * HALF + 4); }
                    else { const u32x4 r = *(const u32x4*)(R + off + bj * HALF);
                        bs[bj][0] = (f32x4){__builtin_bit_cast(float, r.x << 16), __builtin_bit_cast(float, r.x & 0xffff0000u), __builtin_bit_cast(float, r.y << 16), __builtin_bit_cast(float, r.y & 0xffff0000u)};
                        bs[bj][1] = (f32x4){__builtin_bit_cast(float, r.z << 16), __builtin_bit_cast(float, r.z & 0xffff0000u), __builtin_bit_cast(float, r.w << 16), __builtin_bit_cast(float, r.w & 0xffff0000u)}; } }
#pragma unroll
                for (int bj = 0; bj < 2; ++bj) { const f32x4 o0 = bs[bj][0] + gv[bj][0] * acc[ai][bj][m][0], o1 = bs[bj][1] + gv[bj][1] * acc[ai][bj][m][1];
                    u32x4 w; w.x = cvt_pk_bf16(o0.x, o0.y); w.y = cvt_pk_bf16(o0.z, o0.w); w.z = cvt_pk_bf16(o1.x, o1.y); w.w = cvt_pk_bf16(o1.z, o1.w);
                    *(u32x4*)(R + off + bj * HALF) = w; } }
    }
};
struct EpiConv {
    static constexpr bool PERM = true, AFTER_DRAIN = false;
    bf16_t* ACT; const float* cw; const float* cb; float* HALO; float* FIXU; PG8_LAS float* EX; int nN;
    template <int CTRL> static __device__ __forceinline__ float rot(float x) { return __builtin_bit_cast(float, __builtin_amdgcn_update_dpp(0, __builtin_bit_cast(int, x), CTRL, 0xf, 0xf, false)); }
    template <int CTRL> static __device__ __forceinline__ f32x4 rot4(f32x4 x) { return (f32x4){rot<CTRL>(x.x), rot<CTRL>(x.y), rot<CTRL>(x.z), rot<CTRL>(x.w)}; }
    __device__ __forceinline__ void operator()(const f32x4 (&acc)[2][2][4][2], const Unit& u, int wr, int wc, int fr, int fq) const {
        const int colw = wc * 32 + 8 * fq, tile = u.pm * nN + u.pn;
        if (fr >= 14) {
#pragma unroll
            for (int ai = 0; ai < 2; ++ai)
#pragma unroll
                for (int bj = 0; bj < 2; ++bj)
#pragma unroll
                    for (int n = 0; n < 2; ++n) { *(PG8_LAS f32x4*)(EX + ((ai * 2 + wr) * 2 + (fr - 14)) * 256 + bj * 128 + colw + 4 * n) = acc[ai][bj][3][n];
                        if (ai == 1 && wr == 1) *(f32x4*)(HALO + ((size_t)tile * 2 + (fr - 14)) * 256 + bj * 128 + colw + 4 * n) = acc[1][bj][3][n]; }
        }
        if (fr < 2 && wr == 0) {
#pragma unroll
            for (int bj = 0; bj < 2; ++bj)
#pragma unroll
                for (int n = 0; n < 2; ++n) *(f32x4*)(FIXU + ((size_t)tile * 2 + fr) * 256 + bj * 128 + colw + 4 * n) = acc[0][bj][0][n];
        }
        asm volatile("s_waitcnt lgkmcnt(0)" ::: "memory"); __builtin_amdgcn_s_barrier(); asm volatile("" ::: "memory");
#pragma unroll
        for (int n = 0; n < 2; ++n) {
            const int jg = u.pn * 128 + colw + 4 * n, jv = 2816 + jg;
            f32x4 cw0[2], cw1[2], cw2[2], cbb[2];
            cw0[0] = *(const f32x4*)(cw + jg); cw1[0] = *(const f32x4*)(cw + 5632 + jg); cw2[0] = *(const f32x4*)(cw + 2 * 5632 + jg); cbb[0] = *(const f32x4*)(cb + jg);
            cw0[1] = *(const f32x4*)(cw + jv); cw1[1] = *(const f32x4*)(cw + 5632 + jv); cw2[1] = *(const f32x4*)(cw + 2 * 5632 + jv); cbb[1] = *(const f32x4*)(cb + jv);
#pragma unroll
            for (int ai = 0; ai < 2; ++ai)
#pragma unroll
                for (int m = 0; m < 4; ++m) {
                    const int src = ai * 2 + wr - 1;
                    f32x4 res[2];
#pragma unroll
                    for (int bj = 0; bj < 2; ++bj) {
                        const f32x4 x = acc[ai][bj][m][n];
                        f32x4 x1 = rot4<0x121>(x), x2 = rot4<0x122>(x);
                        if (m > 0) { const f32x4 q = acc[ai][bj][m > 0 ? m - 1 : 0][n]; const f32x4 q1 = rot4<0x121>(q), q2 = rot4<0x122>(q);
                            if (fr == 0) x1 = q1; if (fr < 2) x2 = q2; }
                        else if (fr < 2) { f32x4 e14 = {0.f, 0.f, 0.f, 0.f}, e15 = e14;
                            if (src >= 0) { e14 = *(const PG8_LAS f32x4*)(EX + (src * 2 + 0) * 256 + bj * 128 + colw + 4 * n); e15 = *(const PG8_LAS f32x4*)(EX + (src * 2 + 1) * 256 + bj * 128 + colw + 4 * n); }
                            if (fr == 0) { x1 = e15; x2 = e14; } else x2 = e15; }
                        const f32x4 w0 = cw0[bj], w1 = cw1[bj], w2 = cw2[bj], bb = cbb[bj];
                        res[bj] = bb + w0 * x2 + w1 * x1 + w2 * x;
                    }
                    const f32x4 gc = res[0], vc = res[1];
                    f32x4 o;
                    o.x = gc.x * __builtin_amdgcn_rcpf(1.f + __expf(-gc.x)) * vc.x; o.y = gc.y * __builtin_amdgcn_rcpf(1.f + __expf(-gc.y)) * vc.y;
                    o.z = gc.z * __builtin_amdgcn_rcpf(1.f + __expf(-gc.z)) * vc.z; o.w = gc.w * __builtin_amdgcn_rcpf(1.f + __expf(-gc.w)) * vc.w;
                    typedef unsigned u32x2 __attribute__((ext_vector_type(2)));
                    u32x2 w; w.x = cvt_pk_bf16(o.x, o.y); w.y = cvt_pk_bf16(o.z, o.w);
                    *(u32x2*)(ACT + (size_t)(u.pm * BM + ai * HALF + wr * 64 + m * 16 + fr) * 2816 + u.pn * 128 + colw + 4 * n) = w;
                }
        }
    }
};
}

namespace hy {
struct Args { const float* in[31]; float* out; unsigned char* ws; };
__global__ void __launch_bounds__(NT, 2) hy_fwd(Args A) {
    extern __shared__ __attribute__((aligned(16))) unsigned char lds_raw[];
    Ctx C; C.bid = blockIdx.x; C.nb = gridDim.x; C.tid = threadIdx.x; C.lane = C.tid & 63; C.wave = __builtin_amdgcn_readfirstlane(C.tid >> 6); C.lds = (LAS unsigned char*)lds_raw;
    volatile LAS unsigned* MISC = (volatile LAS unsigned*)(C.lds + MISC_OFF);
    for (int u = C.tid; u < (LDS_BYTES - MISC_OFF) / 4; u += NT) ((LAS unsigned*)(C.lds + MISC_OFF))[u] = 0u;
    __syncthreads();
    unsigned char* ws = A.ws;
    const int wave0 = __builtin_amdgcn_readfirstlane(threadIdx.x >> 6);
    (void)xcd_barrier_post((unsigned*)(ws + WS_CTL) + CW_BAR, MISC + 8);
#define PHASE_BEGIN() do { int t_ = wave0 * 64 + lane_now(); int b_ = blockIdx.x; asm volatile("" : "+s"(b_)); \
    C.tid = t_; C.lane = t_ & 63; C.wave = __builtin_amdgcn_readfirstlane(t_ >> 6); C.bid = b_; } while (0)
#ifdef HY_DIAG
    unsigned long long ts_last = __builtin_amdgcn_s_memrealtime(); float tacc[10] = {0.f, 0.f, 0.f, 0.f, 0.f, 0.f, 0.f, 0.f, 0.f, 0.f};
#define GRID_BAR(cat) do { { XcdBarrier b_; b_.bar = (unsigned*)(A.ws + WS_CTL) + CW_BAR; b_.x = xb_xcc_id(); b_.st = (volatile LAS unsigned*)(C.lds + MISC_OFF) + 8; xcd_barrier(b_, wave0 == 0 && lane_now() == 0); } PHASE_BEGIN(); { const unsigned long long n_ = __builtin_amdgcn_s_memrealtime(); tacc[cat] += (float)(n_ - ts_last); ts_last = n_; } } while (0)
#else
#define GRID_BAR(cat) do { { XcdBarrier b_; b_.bar = (unsigned*)(A.ws + WS_CTL) + CW_BAR; b_.x = xb_xcc_id(); b_.st = (volatile LAS unsigned*)(C.lds + MISC_OFF) + 8; xcd_barrier(b_, wave0 == 0 && lane_now() == 0); } PHASE_BEGIN(); } while (0)
#endif
#ifndef HY_REPCAT
#define HY_REPCAT (-1)
#endif
#define NREP(cat) ((HY_REPCAT == (cat)) ? 2 : 1)
    float* out = A.out;
    bf16* RES = (bf16*)((unsigned char*)A.out + 64 * MiB);
#define in A.in
    float* MOD = (float*)(ws + WS_MOD);
    bf16 *WIN = (bf16*)(ws + WS_WIN), *WOUT = (bf16*)(ws + WS_WOUT), *WUP = (bf16*)(ws + WS_WUP), *WDN = (bf16*)(ws + WS_WDN);
    bf16 *XB = (bf16*)(ws + WS_XB), *O = (bf16*)(ws + WS_O), *VF = (bf16*)(ws + WS_VF), *PG = (bf16*)(ws + WS_PG), *PR = (bf16*)(ws + WS_PR), *VL = (bf16*)(ws + WS_VL);
    bf16 *RH = (bf16*)(ws + WS_RH), *YH = (bf16*)(ws + WS_YH), *PP = (bf16*)(ws + WS_PP), *QQ = (bf16*)(ws + WS_QQ), *GG = (bf16*)(ws + WS_GG), *S0 = (bf16*)(ws + WS_S0);
    float *GAMC = (float*)(ws + WS_GAMC), *RK = (float*)(ws + WS_RK);
    bf16* LORA = (bf16*)(ws + WS_LORA);
    bf16* DS = (bf16*)(ws + WS_GK); float* GAM = (float*)(ws + WS_GAM);
    bf16* ACT = (bf16*)(ws + WS_ACT); float *HALO = (float*)(ws + WS_U), *FIXU = (float*)(ws + WS_U + 8 * MiB);

    ph_mod(C, in[1], in[2], in[3], MOD);
    for (int l = 0; l < L_; ++l) {
        const float* modl = MOD + (size_t)l * 4 * 6144;
        for (int r_ = 0; r_ < NREP(0); ++r_) {
        wprep_mat(C, in[5] + (size_t)l * D_ * IN_COLS, D_, IN_COLS, NIN, WIN, 1, l ? in[6] : nullptr);
        wprep_mat(C, in[24] + (size_t)l * D_ * D_, D_, D_, D_, WOUT, 0, nullptr);
        wprep_mat(C, in[26] + (size_t)l * D_ * NUP, D_, NUP, NUP, WUP, 2, nullptr);
        wprep_mat(C, in[29] + (size_t)l * DFF * D_, DFF, D_, D_, WDN, 0, nullptr);
        wprep_mat(C, in[12] + (size_t)l * 64 * 512, 64, 512, 512, LORA, 0, nullptr);
        wprep_mat(C, in[14] + (size_t)l * 64 * 512, 64, 512, 512, LORA + 512 * 64, 0, nullptr);
        wprep_mat(C, in[16] + (size_t)l * 128 * 512, 128, 512, 512, LORA + 2 * 512 * 64, 0, nullptr);
        if (l) wprep_mat(C, in[17], 32, 512, 512, LORA + 2 * 512 * 64 + 512 * 128, 0, nullptr);
        }
        GRID_BAR(0);
        for (int r_ = 0; r_ < NREP(1); ++r_) { if (l == 0) ph_norm(C, in[0], in[4], modl + 0 * D_, modl + 1 * D_, XB); else ph_norm_b(C, RES, in[4] + l * D_, modl + 0 * D_, modl + 1 * D_, XB); }
        GRID_BAR(1);
        for (int r_ = 0; r_ < NREP(2); ++r_) { pg8::Gemm g{XB, WIN, M_, NIN, D_}; pg8::StaticOrder S; S.init(M_, NIN, C.nb, C.bid);
          pg8::EpiBf16<0> E{PG, NPG, nullptr, NPG, (WS_PR - WS_PG) / 2, 1.f};
          pg8::gemm_phase<pg8::EpiBf16<0>, pg8::StaticOrder, true, true>(C.lds, g, S, E, C.tid); }
        GRID_BAR(2);
        for (int r_ = 0; r_ < NREP(3); ++r_) {
        ph_gla_a(C, PG, in[7] + l * 16 * 256, in[8] + l * 256, DS, GAM);
        { RwkvW W{in[10] + l * 1792, in[11], in[13] + l * 512, in[15] + l * 512, in[18], in[19] + l * 512, in[20] + l * 512, in[21] + l * 512,
                  LORA, LORA + 512 * 64, LORA + 2 * 512 * 64, LORA + 2 * 512 * 64 + 512 * 128};
          ph_rwkv_a(C, PR, PG, W, l, PP, QQ, RH, YH, GAMC, RK, GG, VF, r_ == NREP(3) - 1); } }
        GRID_BAR(3);
        if (C.bid < 32) { for (int r_ = 0; r_ < NREP(4); ++r_) ph_rwkv_b(C, C.bid, PP, QQ, GAMC, S0); }
        else { Ctx C2 = C; C2.bid = C.bid - 32; C2.nb = C.nb - 32;
               ph_gla_b(C2, DS, GAM);
               group_barrier((unsigned*)(ws + WS_CTL) + 2048, (unsigned)(C.nb - 32) * (unsigned)(l + 1), wave0 == 0 && lane_now() == 0);
               PHASE_BEGIN(); C2 = C; C2.bid = C.bid - 32; C2.nb = C.nb - 32;
               ph_gla_c(C2, PG, in[7] + l * 16 * 256, in[8] + l * 256, in[9] + l * 128, DS, O); }
        GRID_BAR(4);
        for (int r_ = 0; r_ < NREP(5); ++r_) {
        ph_rwkv_c(C, S0, RH, YH, RK, GG, VF, in[22] + l * 512, in[23] + l * 512, O); }
        GRID_BAR(5);
        { pg8::Gemm g{O, WOUT, M_, D_, D_}; pg8::StaticOrder S; S.init(M_, D_, C.nb, C.bid);
          if (l == 0) { pg8::EpiResB<true> E{in[0], RES, modl + 2 * D_, 6144}; pg8::gemm_phase<pg8::EpiResB<true>, pg8::StaticOrder, true, true>(C.lds, g, S, E, C.tid); }
          else { pg8::EpiResB<false> E{nullptr, RES, modl + 2 * D_, 6144}; pg8::gemm_phase<pg8::EpiResB<false>, pg8::StaticOrder, true, true>(C.lds, g, S, E, C.tid); } }
        GRID_BAR(6);
        for (int r_ = 0; r_ < NREP(1); ++r_) ph_norm_b(C, RES, in[25] + l * D_, modl + 3 * D_, modl + 4 * D_, XB);
        GRID_BAR(1);
        for (int r_ = 0; r_ < NREP(7); ++r_) { pg8::Gemm g{XB, WUP, M_, NUP, D_}; pg8::StaticOrder S; S.init(M_, NUP, C.nb, C.bid);
          pg8::EpiConv E{ACT, in[27] + (size_t)l * 3 * NUP, in[28] + (size_t)l * NUP, HALO, FIXU, (PG8_LAS float*)(C.lds + RING_BYTES), NUP / 256};
          pg8::gemm_phase<pg8::EpiConv, pg8::StaticOrder, true, true>(C.lds, g, S, E, C.tid); }
        GRID_BAR(7);
        for (int r_ = 0; r_ < NREP(8); ++r_) ph_convfix(C, HALO, FIXU, in[27] + (size_t)l * 3 * NUP, in[28] + (size_t)l * NUP, ACT);
        GRID_BAR(8);
        { pg8::Gemm g{ACT, WDN, M_, D_, DFF}; pg8::StaticOrder S; S.init(M_, D_, C.nb, C.bid);
          pg8::EpiResB<false> E{nullptr, RES, modl + 5 * D_, 6144};
          pg8::gemm_phase<pg8::EpiResB<false>, pg8::StaticOrder, true, true>(C.lds, g, S, E, C.tid); }
        GRID_BAR(9);
    }
    ph_final_b(C, RES, in[30], out, 0, M_ / 2, XB, M_ / 2, M_);
    GRID_BAR(1);
    ph_final_b(C, XB - (size_t)(M_ / 2) * D_, in[30], out, M_ / 2, M_, nullptr, 0, 0);
#ifdef HY_DIAG
    GRID_BAR(1);
    if (C.bid == 0) { if (C.tid == 0) out[0] = tacc[HY_DIAG_A] * 0.1f; for (int i = 1 + C.tid; i <= 10000; i += NT) out[i] = tacc[HY_DIAG_B] * 0.01f; }
#endif
#undef GRID_BAR
#undef PHASE_BEGIN
#undef in
}
}

extern "C" void kernel_launch(void* const* d_in, const int* in_sizes, int n_in, void* d_out, int out_size, void* d_ws, size_t ws_size, hipStream_t stream) {
    using namespace hy;
    static int grid = 0;
    if (grid == 0) {
        if (n_in != 31 || in_sizes[0] != M_ * D_ || out_size != M_ * D_ || ws_size < WS_END) { fprintf(stderr, "kernel_launch: unexpected shapes (n_in %d, in0 %d, out %d, ws %zu)\n", n_in, n_in > 0 ? in_sizes[0] : -1, out_size, ws_size); grid = -1; return; }
        if (hipFuncSetAttribute((const void*)hy_fwd, hipFuncAttributeMaxDynamicSharedMemorySize, LDS_BYTES) != hipSuccess) { fprintf(stderr, "kernel_launch: hipFuncSetAttribute failed\n"); grid = -1; return; }
        int dev = 0, cus = 0, per_cu = 0;
        (void)hipGetDevice(&dev); (void)hipDeviceGetAttribute(&cus, hipDeviceAttributeMultiprocessorCount, dev);
        (void)hipOccupancyMaxActiveBlocksPerMultiprocessor(&per_cu, (const void*)hy_fwd, NT, LDS_BYTES);
        if (per_cu < 1) fprintf(stderr, "kernel_launch: occupancy query reports %d blocks per CU\n", per_cu);
        (void)hipGetLastError();
        grid = cus > 0 ? cus : 256;
    }
    if (grid < 0) return;
    (void)hipMemsetAsync((char*)d_ws + WS_CTL, 0, CTL_ZERO_BYTES, stream);
    Args a{};
    for (int i = 0; i < 31; ++i) a.in[i] = (const float*)d_in[i];
    a.out = (float*)d_out; a.ws = (unsigned char*)d_ws;
    hipLaunchKernelGGL(hy_fwd, dim3(grid), dim3(NT), LDS_BYTES, stream, a);
}
```

```cpp
#include <hip/hip_runtime.h>
#include <cstdio>
#include <cstdint>
namespace pg8 {
#define PG8_LAS __attribute__((address_space(3)))
typedef unsigned short bf16_t;
typedef short bf16x8 __attribute__((ext_vector_type(8)));
typedef float f32x4 __attribute__((ext_vector_type(4)));
typedef unsigned u32x4 __attribute__((ext_vector_type(4)));
constexpr int BM = 256, BK = 64, HALF = 128, HTB = HALF * BK * 2  , STAGE_BYTES = 8 * HTB, NXCD = 8, WGM = 8;

__host__ __device__ __forceinline__ int lds_byte(int r, int c) { const int st = (r >> 4) * 2 + (c >> 5), rr = r & 15, cc = c & 31, ob = rr * 64 + cc * 2; return st * 1024 + (ob ^ (((ob >> 9) & 1) << 5)); }
__host__ __device__ __forceinline__ void stage_rc(int b, int& R, int& C) { const int st = b / 1024, sb = b % 1024, swz = sb ^ (((sb >> 9) & 1) << 5); R = (st >> 1) * 16 + swz / 64; C = (st & 1) * 32 + (swz % 64) / 2; }
__host__ __device__ __forceinline__ int perm32(int rho) { const int n = rho >> 4, i = rho & 15; return 8 * (i >> 2) + 4 * n + (i & 3); }

struct Unit { int pm, pn; };
struct Gemm { const bf16_t* A; const bf16_t* Bt; int M, N, K; size_t bstride; };

struct StaticOrder {
    int nM, nN, nwg, G, c;
    __host__ __device__ void init(int M, int N, int G_, int c_) { nM = M / BM; nN = N / BM; nwg = nM * nN; G = G_; c = c_; }
    __host__ __device__ bool next(int i, Unit& u) const {
        const long L = (long)i * G + c; if (L >= nwg) return false;
        int wgid = (int)L; { const int q = nwg / NXCD, r = nwg % NXCD, xcd = wgid % NXCD, off = wgid / NXCD; wgid = (xcd < r ? xcd * (q + 1) : r * (q + 1) + (xcd - r) * q) + off; }
        const int nig = WGM * nN, gid = wgid / nig, fm = gid * WGM, gsz = (nM - fm) < WGM ? (nM - fm) : WGM;
        u.pm = fm + ((wgid % nig) % gsz); u.pn = (wgid % nig) / gsz; return true;
    }
    __device__ __forceinline__ void a_ready(const Unit&) const {}
    __device__ __forceinline__ void done(const Unit&) const {}
};

__device__ __forceinline__ unsigned cvt_pk_bf16(float lo, float hi) { unsigned r; asm volatile("v_cvt_pk_bf16_f32 %0, %1, %2" : "=v"(r) : "v"(lo), "v"(hi)); return r; }
typedef float f32x2 __attribute__((ext_vector_type(2)));
__device__ __forceinline__ f32x2 gelu_pk(f32x2 v) {
    const f32x2 av = __builtin_elementwise_abs(v), d = av * 0.2316418882f + 1.0f;
    f32x2 t; t.x = __builtin_amdgcn_rcpf(d.x); t.y = __builtin_amdgcn_rcpf(d.y);
    f32x2 q = t * 0.5307027145f + (-0.7265760135f); q = q * t + 0.7107068705f; q = q * t + (-0.142248368f); q = q * t + 0.127414796f; q = q * t;
    const f32x2 s = (v * v) * (-0.72134752044f);
    f32x2 e; e.x = __builtin_amdgcn_exp2f(s.x); e.y = __builtin_amdgcn_exp2f(s.y);
    const f32x2 m = v * (q * e), r = v - m;
    f32x2 o; o.x = v.x < 0.f ? m.x : r.x; o.y = v.y < 0.f ? m.y : r.y; return o;
}

template <int ACT  > struct EpiBf16 {
    static constexpr bool PERM = true, AFTER_DRAIN = false; static_assert(ACT == 0 || ACT == 1, "EpiBf16: ACT is 0 (none) or 1 (gelu_pk)");
    bf16_t* O; int ldc; const float* bias; int split_cols; size_t split_stride; float scale0;
    __device__ __forceinline__ void operator()(const f32x4 (&acc)[2][2][4][2], const Unit& u, int wr, int wc, int fr, int fq) const {
        const int row0 = u.pm * BM + wr * 64 + fr; int colt = u.pn * BM; bf16_t* base = O;
        float sc = 1.f; if (split_cols) { const int t = colt / split_cols; base += (size_t)t * split_stride; colt -= t * split_cols; if (t == 0) sc = scale0; }
        const int col0 = colt + wc * 32 + 8 * fq, bcol0 = u.pn * BM + wc * 32 + 8 * fq;
        f32x4 bv[2][2];
#pragma unroll
        for (int bj = 0; bj < 2; ++bj)
#pragma unroll
            for (int n = 0; n < 2; ++n) bv[bj][n] = bias ? *(const f32x4*)(bias + bcol0 + bj * HALF + 4 * n) : (f32x4){0.f, 0.f, 0.f, 0.f};
#pragma unroll
        for (int ai = 0; ai < 2; ++ai)
#pragma unroll
            for (int m = 0; m < 4; ++m) { bf16_t* rowp = base + (size_t)(row0 + ai * HALF + m * 16) * ldc + col0;
#pragma unroll
                for (int bj = 0; bj < 2; ++bj) { f32x4 v0 = acc[ai][bj][m][0] + bv[bj][0], v1 = acc[ai][bj][m][1] + bv[bj][1];
                    if (ACT == 1) { f32x2 a = gelu_pk((f32x2){v0[0], v0[1]}), b = gelu_pk((f32x2){v0[2], v0[3]}), c = gelu_pk((f32x2){v1[0], v1[1]}), d = gelu_pk((f32x2){v1[2], v1[3]});
                        v0 = (f32x4){a.x, a.y, b.x, b.y}; v1 = (f32x4){c.x, c.y, d.x, d.y}; }
                    v0 = v0 * sc; v1 = v1 * sc; u32x4 w; w.x = cvt_pk_bf16(v0[0], v0[1]); w.y = cvt_pk_bf16(v0[2], v0[3]); w.z = cvt_pk_bf16(v1[0], v1[1]); w.w = cvt_pk_bf16(v1[2], v1[3]);
                    *(u32x4*)(rowp + bj * HALF) = w; } }
    }
};
template <class Epi, class Sched, bool ALIGN_EPI = false, bool SP2 = false>
__device__ __forceinline__ void gemm_phase(PG8_LAS unsigned char* lds, const Gemm g, const Sched& S, const Epi& E, int tid_in) {
    int tid_ = tid_in; asm volatile("" : "+v"(tid_));
    const int tid = tid_, wid = __builtin_amdgcn_readfirstlane(tid >> 6), lane = tid & 63, wr = wid >> 2, wc = wid & 3, fr = lane & 15, fq = lane >> 4;
    const int K = g.K, nt = K / BK;
    unsigned voffA[2], voffB[2];
#pragma unroll
    for (int i = 0; i < 2; ++i) { int R, C; stage_rc(tid * 16 + i * 8192, R, C); const int Rb = Epi::PERM ? ((R & ~31) + perm32(R & 31)) : R;
        voffA[i] = (unsigned)(R * K + C) * 2u; voffB[i] = (unsigned)(Rb * K + C) * 2u; }
    const size_t kstep = (size_t)(BK * 2);
    const size_t hstep = (size_t)HALF * K * 2;
    const size_t tstep = 2 * hstep;
    const unsigned ldsw = (unsigned)wid * 1024u;
    const int aoff = lds_byte(wr * 64 + fr, fq * 8), boff = lds_byte(wc * 32 + fr, fq * 8);
#define PG8_SA(b, h) (((b) * 2 + (h)) * HTB)
#define PG8_SB(b, h) ((4 + (b) * 2 + (h)) * HTB)
#define PG8_STAGE(bufoff, gbase, voff) do { _Pragma("unroll") for (int _i = 0; _i < 2; ++_i) \
        __builtin_amdgcn_global_load_lds((const unsigned*)((const char*)(gbase) + (voff)[_i]), (PG8_LAS unsigned*)(lds + (bufoff) + ldsw + _i * 8192), 16, 0, 0); } while (0)
#define PG8_LDA(dst, b, h) do { _Pragma("unroll") for (int m = 0; m < 4; ++m) _Pragma("unroll") for (int k = 0; k < 2; ++k) dst[m][k] = *(const PG8_LAS bf16x8*)(lds + PG8_SA(b, h) + aoff + m * 2048 + k * 1024); } while (0)
#define PG8_LDB(dst, b, h) do { _Pragma("unroll") for (int n = 0; n < 2; ++n) _Pragma("unroll") for (int k = 0; k < 2; ++k) dst[n][k] = *(const PG8_LAS bf16x8*)(lds + PG8_SB(b, h) + boff + n * 2048 + k * 1024); } while (0)
#define PG8_MMA(ai, bj, At, Bt) do { __builtin_amdgcn_s_setprio(1); _Pragma("unroll") for (int m = 0; m < 4; ++m) _Pragma("unroll") for (int n = 0; n < 2; ++n) _Pragma("unroll") for (int k = 0; k < 2; ++k) \
        acc[ai][bj][m][n] = __builtin_amdgcn_mfma_f32_16x16x32_bf16(Bt[n][k], At[m][k], acc[ai][bj][m][n], 0, 0, 0); __builtin_amdgcn_s_setprio(0); } while (0)
#define PG8_WAIT_V(n) asm volatile("s_waitcnt vmcnt(" #n ")" ::: "memory")
#define PG8_WAIT_L(n) asm volatile("s_waitcnt lgkmcnt(" #n ")" ::: "memory")
#define PG8_BAR __builtin_amdgcn_s_barrier()
#define PG8_SCHED __builtin_amdgcn_sched_barrier(0)
    Unit cur, nxt; int ui = 0;
    if (!S.next(0, cur)) return;
    f32x4 acc[2][2][4][2];
#pragma unroll
    for (int a = 0; a < 2; ++a)
#pragma unroll
        for (int b = 0; b < 2; ++b)
#pragma unroll
            for (int m = 0; m < 4; ++m)
#pragma unroll
                for (int n = 0; n < 2; ++n) acc[a][b][m][n] = (f32x4){0.f, 0.f, 0.f, 0.f};
    bf16x8 At[4][2], B0[2][2], B1[2][2];
    const char* cA = (const char*)g.A + (size_t)cur.pm * tstep; const char* cB = (const char*)g.Bt + (size_t)cur.pn * tstep + (size_t)(cur.pm >> 5) * g.bstride;
    S.a_ready(cur);
    if constexpr (SP2) {
        PG8_STAGE(PG8_SB(0, 0), cB, voffB); PG8_STAGE(PG8_SB(0, 1), cB + hstep, voffB); PG8_STAGE(PG8_SA(0, 0), cA, voffA); PG8_STAGE(PG8_SA(0, 1), cA + hstep, voffA);
        if (wr == 1) PG8_BAR;
        PG8_WAIT_V(2); PG8_BAR;
        PG8_STAGE(PG8_SB(1, 0), cB + kstep, voffB); PG8_STAGE(PG8_SA(1, 0), cA + kstep, voffA); PG8_STAGE(PG8_SB(1, 1), cB + hstep + kstep, voffB);
        PG8_WAIT_V(6); PG8_BAR;
    } else {
        PG8_STAGE(PG8_SB(0, 0), cB, voffB); PG8_STAGE(PG8_SA(0, 0), cA, voffA); PG8_STAGE(PG8_SB(0, 1), cB + hstep, voffB); PG8_STAGE(PG8_SA(0, 1), cA + hstep, voffA);
        if (wr == 1) PG8_BAR;
        PG8_WAIT_V(4); PG8_BAR;
        PG8_STAGE(PG8_SB(1, 0), cB + kstep, voffB); PG8_STAGE(PG8_SA(1, 0), cA + kstep, voffA); PG8_STAGE(PG8_SB(1, 1), cB + hstep + kstep, voffB);
        PG8_WAIT_V(6); PG8_BAR;
    }
    for (;;) {
        const bool has_next = S.next(ui + 1, nxt);
        const char* nA = has_next ? (const char*)g.A + (size_t)nxt.pm * tstep : cA; const char* nB = has_next ? (const char*)g.Bt + (size_t)nxt.pn * tstep + (size_t)(nxt.pm >> 5) * g.bstride : cB;
        for (int t = 0; t < nt; t += 2) {
            const bool last = (t == nt - 2);
            const char* a1 = cA + (size_t)(t + 1) * kstep;
            const char* a2 = last ? nA : cA + (size_t)(t + 2) * kstep; const char* b2 = last ? nB : cB + (size_t)(t + 2) * kstep;
            const char* a3 = a2 + kstep; const char* b3 = b2 + kstep;
            if (last && has_next) S.a_ready(nxt);
            if constexpr (SP2) {
            PG8_LDB(B0, 0, 0); PG8_LDB(B1, 0, 1); PG8_SCHED; PG8_LDA(At, 0, 0); PG8_STAGE(PG8_SA(1, 1), a1 + hstep, voffA);
            PG8_WAIT_V(8); PG8_WAIT_L(0); PG8_BAR; PG8_MMA(0, 0, At, B0); PG8_MMA(0, 1, At, B1); PG8_BAR; PG8_SCHED;
            PG8_LDA(At, 0, 1); PG8_STAGE(PG8_SB(0, 0), b2, voffB); PG8_STAGE(PG8_SB(0, 1), b2 + hstep, voffB); PG8_STAGE(PG8_SA(0, 0), a2, voffA);
            PG8_WAIT_V(8); PG8_WAIT_L(0); PG8_BAR; PG8_MMA(1, 0, At, B0); PG8_MMA(1, 1, At, B1); PG8_BAR; PG8_SCHED;
            PG8_LDB(B0, 1, 0); PG8_LDB(B1, 1, 1); PG8_SCHED; PG8_LDA(At, 1, 0); PG8_STAGE(PG8_SA(0, 1), a2 + hstep, voffA);
            PG8_WAIT_V(8); PG8_WAIT_L(0); PG8_BAR; PG8_MMA(0, 0, At, B0); PG8_MMA(0, 1, At, B1); PG8_BAR; PG8_SCHED;
            PG8_LDA(At, 1, 1); PG8_STAGE(PG8_SB(1, 0), b3, voffB); PG8_STAGE(PG8_SB(1, 1), b3 + hstep, voffB); PG8_STAGE(PG8_SA(1, 0), a3, voffA);
            PG8_WAIT_V(8); PG8_WAIT_L(0); PG8_BAR; PG8_MMA(1, 0, At, B0); PG8_MMA(1, 1, At, B1); PG8_BAR; PG8_SCHED;
            } else {
            PG8_LDB(B0, 0, 0); PG8_SCHED; PG8_LDA(At, 0, 0); PG8_STAGE(PG8_SA(1, 1), a1 + hstep, voffA);
            PG8_WAIT_L(8); PG8_BAR; PG8_WAIT_L(0); PG8_MMA(0, 0, At, B0); PG8_BAR; PG8_SCHED;
            PG8_LDB(B1, 0, 1); PG8_STAGE(PG8_SB(0, 0), b2, voffB);
            PG8_BAR; PG8_WAIT_L(0); PG8_MMA(0, 1, At, B1); PG8_BAR;
            PG8_LDA(At, 0, 1); PG8_STAGE(PG8_SA(0, 0), a2, voffA);
            PG8_BAR; PG8_WAIT_L(0); PG8_MMA(1, 0, At, B0); PG8_BAR; PG8_SCHED;
            PG8_STAGE(PG8_SB(0, 1), b2 + hstep, voffB);
            PG8_WAIT_V(6); PG8_BAR; PG8_MMA(1, 1, At, B1); PG8_BAR;
            PG8_LDB(B0, 1, 0); PG8_SCHED; PG8_LDA(At, 1, 0); PG8_STAGE(PG8_SA(0, 1), a2 + hstep, voffA);
            PG8_WAIT_L(8); PG8_BAR; PG8_WAIT_L(0); PG8_MMA(0, 0, At, B0); PG8_BAR; PG8_SCHED;
            PG8_LDB(B1, 1, 1); PG8_STAGE(PG8_SB(1, 0), b3, voffB);
            PG8_BAR; PG8_WAIT_L(0); PG8_MMA(0, 1, At, B1); PG8_BAR;
            PG8_LDA(At, 1, 1); PG8_STAGE(PG8_SA(1, 0), a3, voffA);
            PG8_BAR; PG8_WAIT_L(0); PG8_MMA(1, 0, At, B0); PG8_BAR; PG8_SCHED;
            PG8_STAGE(PG8_SB(1, 1), b3 + hstep, voffB);
            PG8_WAIT_V(6); PG8_BAR; PG8_MMA(1, 1, At, B1); PG8_BAR;
            }
        }
        if constexpr (ALIGN_EPI) { if (wr == 0) PG8_BAR; }
        if constexpr (!Epi::AFTER_DRAIN) { E(acc, cur, wr, wc, fr, fq); S.done(cur); }
        if (!has_next) break;
#pragma unroll
        for (int a = 0; a < 2; ++a)
#pragma unroll
            for (int b = 0; b < 2; ++b)
#pragma unroll
                for (int m = 0; m < 4; ++m)
#pragma unroll
                    for (int n = 0; n < 2; ++n) acc[a][b][m][n] = (f32x4){0.f, 0.f, 0.f, 0.f};
        cur = nxt; cA = nA; cB = nB; ++ui;
        if constexpr (ALIGN_EPI) { if (wr == 1) PG8_BAR; }
    }
    PG8_WAIT_V(0);
    if constexpr (!ALIGN_EPI) { if (wr == 0) PG8_BAR; }
    PG8_BAR;
    if constexpr (Epi::AFTER_DRAIN) { E.fused(acc, cur, wr, wc, fr, fq, lds, wid, lane); S.done(cur); }
#undef PG8_SA
#undef PG8_SB
#undef PG8_STAGE
#undef PG8_LDA
#undef PG8_LDB
#undef PG8_MMA
#undef PG8_WAIT_V
#undef PG8_WAIT_L
#undef PG8_BAR
#undef PG8_SCHED
}
}

namespace hy {
#define GAS __attribute__((address_space(1)))
#define LAS __attribute__((address_space(3)))
typedef unsigned short bf16;
typedef unsigned v4u __attribute__((ext_vector_type(4)));
typedef float f32x4 __attribute__((ext_vector_type(4)));
typedef short bf16x8 __attribute__((ext_vector_type(8)));
typedef GAS unsigned gu32;
typedef GAS unsigned long long gu64;
#define RLX_AGENT __ATOMIC_RELAXED, __HIP_MEMORY_SCOPE_AGENT
#define LDS_WAIT() asm volatile("s_waitcnt lgkmcnt(0)" ::: "memory")
#define VM_WAIT() asm volatile("s_waitcnt vmcnt(0)" ::: "memory")
__device__ __forceinline__ unsigned long long rt() { return __builtin_amdgcn_s_memrealtime(); }
typedef __bf16 hwbf2 __attribute__((ext_vector_type(2))); typedef float hwf2 __attribute__((ext_vector_type(2)));
__device__ __forceinline__ unsigned f2bf(float f) { return (unsigned)__builtin_bit_cast(unsigned short, (__bf16)f); }
__device__ __forceinline__ unsigned pk2(float lo, float hi) { const hwf2 v = {lo, hi}; return __builtin_bit_cast(unsigned, __builtin_convertvector(v, hwbf2)); }
#define XB_TMO      128
#define XB_XCNT(j)  (256  + 64 * (j))
#define XB_XSUB(j)  (1280 + 64 * (j))
#define XB_XGEN(j)  (2304 + 64 * (j))
#define XB_TOP      3328
#define XB_TOPGEN   3392
#define XCD_BAR_WORDS 3456
#define XB_SPIN_CAP (1u << 18)

__device__ __forceinline__ unsigned xb_ld(unsigned* p)              { return __hip_atomic_load(p, __ATOMIC_RELAXED, __HIP_MEMORY_SCOPE_AGENT); }
__device__ __forceinline__ unsigned xb_add(unsigned* p, unsigned v) { return __hip_atomic_fetch_add(p, v, __ATOMIC_RELAXED, __HIP_MEMORY_SCOPE_AGENT); }
__device__ __forceinline__ unsigned xb_xcc_id() { return (unsigned)__builtin_amdgcn_s_getreg((3 << 11) | 20) & 0xFu; }
#define XB_SPIN(cond, bar) do { unsigned _sp = 0; while (cond) { __builtin_amdgcn_s_sleep(1); \
    if ((++_sp & 255u) == 0u) { if (xb_ld(&(bar)[XB_TMO])) break; if (_sp > XB_SPIN_CAP) { atomicAdd(&(bar)[XB_TMO], 1u); break; } } } } while (0)

struct XcdBarrier {
    unsigned* bar; unsigned x;
    volatile LAS unsigned* st;
};

__device__ __forceinline__ XcdBarrier xcd_barrier_post(unsigned* bar, volatile LAS unsigned* st) {
    XcdBarrier b; b.bar = bar; b.x = xb_xcc_id(); b.st = st;
    if (threadIdx.x == 0) (void)xb_add(&bar[XB_XCNT(b.x)], 1u);
    return b;
}
__device__ __forceinline__ void xcd_barrier_complete(unsigned* bar, unsigned x, unsigned& nloc, unsigned& nx) {
    const unsigned G = gridDim.x * gridDim.y * gridDim.z;
    unsigned sum, cnt, mine, sp = 0u;
    for (;;) {
        sum = 0u; cnt = 0u; mine = 0u;
#pragma unroll
        for (unsigned j = 0; j < 16; ++j) { const unsigned c = xb_ld(&bar[XB_XCNT(j)]); sum += c; cnt += (c > 0u) ? 1u : 0u; mine = (j == x) ? c : mine; }
        if (sum == G) break;
        __builtin_amdgcn_s_sleep(1);
        if ((++sp & 255u) == 0u) { if (xb_ld(&bar[XB_TMO])) break; if (sp > XB_SPIN_CAP) { atomicAdd(&bar[XB_TMO], 1u); break; } }
    }
    nloc = mine > 0u ? mine : 1u; nx = cnt > 0u ? cnt : 1u;
}

__device__ __forceinline__ void xcd_barrier(const XcdBarrier& b, bool leader  ) {
    asm volatile("s_waitcnt vmcnt(0)" ::: "memory");
    __syncthreads();
    if (leader) {
        unsigned* bar = b.bar;
        __builtin_amdgcn_s_waitcnt(0);
        unsigned nloc = b.st[0], nx = b.st[1];
        if (nloc == 0u) { xcd_barrier_complete(bar, b.x, nloc, nx); b.st[0] = nloc; b.st[1] = nx; }
        const unsigned old = xb_add(&bar[XB_XSUB(b.x)], 1u);
        const unsigned gen = old / nloc;
        if (old + 1u == (gen + 1u) * nloc) {
            __builtin_amdgcn_fence(__ATOMIC_RELEASE, "agent");
            asm volatile("s_waitcnt vmcnt(0)" ::: "memory");
            const unsigned og = xb_add(&bar[XB_TOP], 1u);
            const unsigned tg = og / nx;
            if (og + 1u == (tg + 1u) * nx) xb_add(&bar[XB_TOPGEN], 1u);
            else XB_SPIN(xb_ld(&bar[XB_TOPGEN]) == tg, bar);
            __builtin_amdgcn_fence(__ATOMIC_ACQUIRE, "agent");
            xb_add(&bar[XB_XGEN(b.x)], 1u);
            asm volatile("s_waitcnt vmcnt(0)" ::: "memory");
        } else {
            XB_SPIN(xb_ld(&bar[XB_XGEN(b.x)]) == gen, bar);
            __builtin_amdgcn_fence(__ATOMIC_ACQUIRE, "agent");
            asm volatile("s_waitcnt vmcnt(0)" ::: "memory");
        }
    }
    __syncthreads();
}

constexpr int B_ = 4, T_ = 8192, D_ = 1024, M_ = B_ * T_, L_ = 2;
constexpr int NIN = 3584, NPG = 1792, NPR = 1792;
constexpr int DFF = 2816, NUP = 5632, IN_COLS = 3344;
constexpr size_t MiB = 1u << 20;
constexpr size_t WS_CTL = 0, CTL_ZERO_BYTES = 65536;
constexpr int CW_BAR = 4096;
constexpr size_t WS_RK = MiB / 4;
constexpr size_t WS_MOD = 3 * MiB / 2;
constexpr size_t WS_WIN = 2 * MiB, WS_WOUT = 9 * MiB, WS_WUP = 11 * MiB, WS_WDN = 22 * MiB, WS_LORA = 55 * MiB / 2, WS_GAMC = 28 * MiB, WS_VL = 29 * MiB;
constexpr size_t WS_GAM = 31 * MiB;
constexpr size_t WS_XB = 32 * MiB, WS_O = 336 * MiB  , WS_VF = 160 * MiB, WS_GK = 192 * MiB, WS_PG = 224 * MiB, WS_PR = 336 * MiB, WS_END = 512 * MiB;
constexpr size_t WS_RH = WS_XB, WS_YH = WS_XB + 32 * MiB, WS_PP = 96 * MiB, WS_QQ = 128 * MiB, WS_GG = 448 * MiB, WS_S0 = 480 * MiB;
constexpr size_t WS_ACT = 224 * MiB, WS_U = 400 * MiB;
constexpr int RING_BYTES = 131072, MISC_OFF = 161792, LDS_BYTES = 163840;
constexpr int NT = 512;

__device__ __forceinline__ float bf2f(bf16 h) { return __builtin_bit_cast(float, (unsigned)h << 16); }
__device__ __forceinline__ float sigmoidf_(float x) { return 1.f / (1.f + __expf(-x)); }
__device__ __forceinline__ float siluf_(float x) { return x / (1.f + __expf(-x)); }
__device__ __forceinline__ float softplusf_(float x) { return fmaxf(x, 0.f) + log1pf(__expf(-fabsf(x))); }

typedef unsigned u32x2 __attribute__((ext_vector_type(2)));
template <int CTRL> __device__ __forceinline__ float dpp_f(float v) {
    return __builtin_bit_cast(float, __builtin_amdgcn_update_dpp(0, __builtin_bit_cast(int, v), CTRL, 0xf, 0xf, false));
}
__device__ __forceinline__ float wave_sum(float v) {
    v += dpp_f<0xB1>(v);
    v += dpp_f<0x4E>(v);
    v += dpp_f<0x141>(v);
    v += dpp_f<0x140>(v);
    v += __builtin_bit_cast(float, __builtin_amdgcn_update_dpp(0, __builtin_bit_cast(int, v), 0x142, 0xa, 0xf, false));
    v += __builtin_bit_cast(float, __builtin_amdgcn_update_dpp(0, __builtin_bit_cast(int, v), 0x143, 0xc, 0xf, false));
    return __builtin_bit_cast(float, __builtin_amdgcn_readlane(__builtin_bit_cast(int, v), 63));
}

__device__ __forceinline__ int lane_now() { int l; asm volatile("v_mbcnt_lo_u32_b32 %0, -1, 0\n\tv_mbcnt_hi_u32_b32 %0, -1, %0" : "=v"(l)); return l; }
__device__ __forceinline__ float xsum4(float v) {
    const int l = lane_now();
    v += __builtin_bit_cast(float, __builtin_amdgcn_ds_bpermute((l ^ 16) << 2, __builtin_bit_cast(int, v)));
    v += __builtin_bit_cast(float, __builtin_amdgcn_ds_bpermute((l ^ 32) << 2, __builtin_bit_cast(int, v)));
    return v;
}
struct Ctx { int bid, nb, tid, lane, wave; LAS unsigned char* lds; };
__device__ __forceinline__ void group_barrier(unsigned* cnt, unsigned target, bool leader) {
    asm volatile("s_waitcnt vmcnt(0)" ::: "memory");
    __syncthreads();
    if (leader) {
        __builtin_amdgcn_fence(__ATOMIC_RELEASE, "agent");
        asm volatile("s_waitcnt vmcnt(0)" ::: "memory");
        (void)__hip_atomic_fetch_add(cnt, 1u, __ATOMIC_RELAXED, __HIP_MEMORY_SCOPE_AGENT);
        for (unsigned sp = 0; __hip_atomic_load(cnt, __ATOMIC_RELAXED, __HIP_MEMORY_SCOPE_AGENT) < target && sp < (1u << 22); ++sp) __builtin_amdgcn_s_sleep(2);
        __builtin_amdgcn_fence(__ATOMIC_ACQUIRE, "agent");
        asm volatile("s_waitcnt vmcnt(0)" ::: "memory");
    }
    __syncthreads();
}


__device__ __forceinline__ void ph_mod(const Ctx& C, const float* c, const float* ada_w, const float* ada_b, float* MOD) {
    LAS float* sc = (LAS float*)C.lds;
    LAS float* red = (LAS float*)(C.lds + 16384);
    for (int i = C.tid; i < 4096; i += NT) sc[i] = siluf_(c[i]);
    __syncthreads();
    for (int item = C.bid; item < 192; item += C.nb) {
        const int l = item / 96, j0 = (item % 96) * 64;
        const float* W = ada_w + (size_t)l * 1024 * 6144 + j0 + C.lane;
        float a0 = 0.f, a1 = 0.f, a2 = 0.f, a3 = 0.f;
        for (int k = C.wave * 128; k < C.wave * 128 + 128; ++k) { const float wv = W[(size_t)k * 6144]; a0 += sc[k] * wv; a1 += sc[1024 + k] * wv; a2 += sc[2048 + k] * wv; a3 += sc[3072 + k] * wv; }
        red[(C.wave * 4 + 0) * 64 + C.lane] = a0; red[(C.wave * 4 + 1) * 64 + C.lane] = a1; red[(C.wave * 4 + 2) * 64 + C.lane] = a2; red[(C.wave * 4 + 3) * 64 + C.lane] = a3;
        __syncthreads();
        if (C.wave < 4) { const int b = C.wave; float s = ada_b[l * 6144 + j0 + C.lane];
#pragma unroll
            for (int w = 0; w < 8; ++w) s += red[(w * 4 + b) * 64 + C.lane];
            MOD[((size_t)l * 4 + b) * 6144 + j0 + C.lane] = s; }
        __syncthreads();
    }
}

__device__ __forceinline__ void wprep_mat(const Ctx& C, const float* W, int K, int Nsrc, int Ndst, bf16* Wt, int mode, const float* vres) {
    const int half = C.tid >> 8, t = C.tid & 255, tx = t & 31, ty = t >> 5;
    LAS float* tile = (LAS float*)C.lds + half * (32 * 33);
    const int nbn = Ndst / 32, ntile = nbn * (K / 32);
    const int niter = (ntile + 2 * C.nb - 1) / (2 * C.nb);
    for (int it = 0; it < niter; ++it) {
        const int item = (it * C.nb + C.bid) * 2 + half;
        const bool act = item < ntile;
        const int n0 = (item % nbn) * 32, k0 = (item / nbn) * 32, n = n0 + tx;
        if (act) {
#pragma unroll
            for (int i = 0; i < 4; ++i) { const int k = k0 + ty + 8 * i; float v = 0.f;
                if (mode == 0) v = W[(size_t)k * Nsrc + n];
                else if (mode == 2) { const int tl = n >> 8, w = n & 255; v = W[(size_t)k * Nsrc + (w < 128 ? tl * 128 + w : 2816 + tl * 128 + (w - 128))]; }
                else { if (n < 1552) v = W[(size_t)k * Nsrc + n]; else if (n < 1584) v = vres ? vres[(size_t)k * 32 + (n - 1552)] : 0.f; else if (n < 1792) v = 0.f; else v = W[(size_t)k * Nsrc + (n - 240)]; }
                tile[(ty + 8 * i) * 33 + tx] = v; }
        }
        __syncthreads();
        if (act) {
#pragma unroll
            for (int i = 0; i < 4; ++i) { const int nn = n0 + ty + 8 * i; Wt[(size_t)nn * K + k0 + tx] = (bf16)f2bf(tile[tx * 33 + ty + 8 * i]); }
        }
        __syncthreads();
    }
}

__device__ __forceinline__ void ph_norm(const Ctx& C, const float* x, const float* g, const float* sh, const float* sc, bf16* XB) {
    const int gw = C.bid * 8 + C.wave, NGW = C.nb * 8, lane = C.lane;
    for (int m = gw; m < M_; m += NGW) {
        const int b = m / T_;
        const f32x4* xr = (const f32x4*)(x + (size_t)m * D_) + lane;
        f32x4 v[4]; float s = 0.f;
#pragma unroll
        for (int j = 0; j < 4; ++j) { v[j] = xr[64 * j]; s += (v[j].x * v[j].x + v[j].y * v[j].y) + (v[j].z * v[j].z + v[j].w * v[j].w); }
        const float rstd = 1.f / sqrtf(wave_sum(s) * (1.f / D_) + 1e-6f);
        unsigned long long* o8 = (unsigned long long*)(XB + (size_t)m * D_) + lane;
#pragma unroll
        for (int j = 0; j < 4; ++j) { const int col = 4 * lane + 256 * j;
            const f32x4 gv = *(const f32x4*)(g + col), shv = *(const f32x4*)(sh + b * 6144 + col), scv = *(const f32x4*)(sc + b * 6144 + col);
            const f32x4 h = v[j] * rstd * gv * (scv + 1.f) + shv;
            o8[64 * j] = (unsigned long long)pk2(h.x, h.y) | ((unsigned long long)pk2(h.z, h.w) << 32); }
    }
}
__device__ __forceinline__ void ph_final(const Ctx& C, float* x, const float* g) {
    const int gw = C.bid * 8 + C.wave, NGW = C.nb * 8, lane = C.lane;
    for (int m = gw; m < M_; m += NGW) {
        f32x4* xr = (f32x4*)(x + (size_t)m * D_) + lane;
        f32x4 v[4]; float s = 0.f;
#pragma unroll
        for (int j = 0; j < 4; ++j) { v[j] = xr[64 * j]; s += (v[j].x * v[j].x + v[j].y * v[j].y) + (v[j].z * v[j].z + v[j].w * v[j].w); }
        const float rstd = 1.f / sqrtf(wave_sum(s) * (1.f / D_) + 1e-6f);
#pragma unroll
        for (int j = 0; j < 4; ++j) { const f32x4 gv = *(const f32x4*)(g + 4 * lane + 256 * j); xr[64 * j] = v[j] * rstd * gv; }
    }
}


typedef short s16x8 __attribute__((ext_vector_type(8)));
__device__ __forceinline__ f32x4 mm16(const LAS bf16* A, int lda, const LAS bf16* B, int ldb, int K, f32x4 acc, int lane) {
    const int r = lane & 15, g = lane >> 4;
    const LAS bf16* ap = A + r * lda + 8 * g; const LAS bf16* bp = B + r * ldb + 8 * g;
    for (int k0 = 0; k0 < K; k0 += 32) { const s16x8 a = *(const LAS s16x8*)(ap + k0); const s16x8 b = *(const LAS s16x8*)(bp + k0); acc = __builtin_amdgcn_mfma_f32_16x16x32_bf16(a, b, acc, 0, 0, 0); }
    return acc;
}
__device__ __forceinline__ f32x4 mm16_ga(const bf16* A, int lda, const LAS bf16* B, int ldb, int K, f32x4 acc, int lane) {
    const int r = lane & 15, g = lane >> 4;
    const bf16* ap = A + r * lda + 8 * g; const LAS bf16* bp = B + r * ldb + 8 * g;
    for (int k0 = 0; k0 < K; k0 += 32) { const s16x8 a = *(const s16x8*)(ap + k0); const s16x8 b = *(const LAS s16x8*)(bp + k0); acc = __builtin_amdgcn_mfma_f32_16x16x32_bf16(a, b, acc, 0, 0, 0); }
    return acc;
}
__device__ __forceinline__ unsigned long long pack4(f32x4 v) { return (unsigned long long)pk2(v.x, v.y) | ((unsigned long long)pk2(v.z, v.w) << 32); }
__device__ __forceinline__ float logsigmoidf_(float x) { return fminf(x, 0.f) - __logf(1.f + __expf(-fabsf(x))); }

constexpr int GL_LD = 72;
constexpr int GL_GK = 0;
constexpr int GL_SEG = 16384;
constexpr int GL_Z = 18432;
constexpr int GL_GUP = 20480;
constexpr int GL_I0 = 24832;
constexpr int GL_I1 = GL_I0 + 9216;
constexpr int GL_I2 = GL_I1 + 9216;
constexpr int GL_VT = GL_I2 + 9216;
constexpr int GL_SSQ = GL_VT + 18432;
static_assert(GL_SSQ + 512 <= RING_BYTES, "GLA LDS map");

struct GlaRaw { v4u z, k, q, v0, v1; float g0, g1, gb; };
__device__ __forceinline__ void gla_fetch(GlaRaw& R, const Ctx& C, const bf16* pg, const float* gk_up, const float* gk_b, int h, bool want_q) {
    const int tid = C.tid, j = tid >> 3, d0 = (tid & 7) * 8, e0 = (tid & 7) * 16;
    R.z = (v4u){0u, 0u, 0u, 0u}; R.q = R.z;
    if (tid < 128) R.z = *(const v4u*)(pg + (size_t)(tid >> 1) * NPG + 1536 + (tid & 1) * 8);
    R.g0 = gk_up[(tid >> 6) * 256 + h * 64 + (tid & 63)]; R.g1 = gk_up[((tid + NT) >> 6) * 256 + h * 64 + (tid & 63)]; R.gb = gk_b[h * 64 + (tid & 63)];
    R.k = *(const v4u*)(pg + (size_t)j * NPG + 256 + h * 64 + d0);
    if (want_q) R.q = *(const v4u*)(pg + (size_t)j * NPG + h * 64 + d0);
    R.v0 = *(const v4u*)(pg + (size_t)j * NPG + 512 + h * 128 + e0); R.v1 = *(const v4u*)(pg + (size_t)j * NPG + 512 + h * 128 + e0 + 8);
}
__device__ __forceinline__ void gla_gates(const Ctx& C, const GlaRaw& R) {
    LAS float* GK = (LAS float*)(C.lds + GL_GK); LAS float* SEG = (LAS float*)(C.lds + GL_SEG); LAS bf16* Z = (LAS bf16*)(C.lds + GL_Z); LAS float* GUP = (LAS float*)(C.lds + GL_GUP);
    const int tid = C.tid;
    if (tid < 128) { const int t = tid >> 1, hh = tid & 1; *(LAS v4u*)(Z + t * 16 + hh * 8) = R.z; }
    GUP[tid] = R.g0; GUP[tid + NT] = R.g1;
    if (tid < 64) GUP[1024 + tid] = R.gb;
    __syncthreads();
    { const int t = tid >> 3, d0 = (tid & 7) * 8; float a[8];
#pragma unroll
      for (int q = 0; q < 8; ++q) a[q] = GUP[1024 + d0 + q];
#pragma unroll
      for (int i = 0; i < 16; ++i) { const float zv = bf2f(Z[t * 16 + i]);
#pragma unroll
          for (int q = 0; q < 8; ++q) a[q] += zv * GUP[i * 64 + d0 + q]; }
#pragma unroll
      for (int q = 0; q < 8; ++q) GK[t * 64 + d0 + q] = logsigmoidf_(a[q]) * (1.f / 16.f); }
    __syncthreads();
    { const int d = tid & 63, seg = tid >> 6; float run = 0.f;
#pragma unroll
      for (int q = 0; q < 8; ++q) { run += GK[(seg * 8 + q) * 64 + d]; GK[(seg * 8 + q) * 64 + d] = run; }
      SEG[seg * 64 + d] = run; }
    __syncthreads();
    { const int d = tid & 63, seg = tid >> 6; float off = 0.f;
      for (int s = 0; s < seg; ++s) off += SEG[s * 64 + d];
#pragma unroll
      for (int q = 0; q < 8; ++q) GK[(seg * 8 + q) * 64 + d] += off; }
    __syncthreads();
}
__device__ __forceinline__ void gla_stage_vt(const Ctx& C, const GlaRaw& R) {
    LAS bf16* VT = (LAS bf16*)(C.lds + GL_VT);
    const int j = C.tid >> 3, e0 = (C.tid & 7) * 16;
    const unsigned w[8] = {R.v0.x, R.v0.y, R.v0.z, R.v0.w, R.v1.x, R.v1.y, R.v1.z, R.v1.w};
#pragma unroll
    for (int q = 0; q < 8; ++q) { VT[(e0 + 2 * q) * GL_LD + j] = (bf16)(w[q] & 0xffffu); VT[(e0 + 2 * q + 1) * GL_LD + j] = (bf16)(w[q] >> 16); }
}

__device__ __forceinline__ void ph_gla_a(const Ctx& C, const bf16* PG, const float* gk_up, const float* gk_b, bf16* DS, float* GAM) {
    LAS float* GK = (LAS float*)(C.lds + GL_GK); LAS bf16* KT = (LAS bf16*)(C.lds + GL_I0); LAS bf16* VT = (LAS bf16*)(C.lds + GL_VT);
    for (int item = C.bid; item < 2048; item += C.nb) {
        const int bh = item >> 7, c = item & 127, b = bh >> 2, h = bh & 3;
        const size_t m0 = (size_t)b * T_ + c * 64;
        const bf16* pg = PG + m0 * NPG;
        GlaRaw R; gla_fetch(R, C, pg, gk_up, gk_b, h, false);
        gla_gates(C, R);
        { const int j = C.tid >> 3, d0 = (C.tid & 7) * 8;
          const unsigned w[4] = {R.k.x, R.k.y, R.k.z, R.k.w};
#pragma unroll
          for (int q = 0; q < 4; ++q) { const float k0 = bf2f((bf16)(w[q] & 0xffffu)), k1 = bf2f((bf16)(w[q] >> 16));
              const int d = d0 + 2 * q;
              KT[d * GL_LD + j] = (bf16)f2bf(k0 * __expf(GK[63 * 64 + d] - GK[j * 64 + d]));
              KT[(d + 1) * GL_LD + j] = (bf16)f2bf(k1 * __expf(GK[63 * 64 + d + 1] - GK[j * 64 + d + 1])); } }
        gla_stage_vt(C, R);
        if (C.tid < 64) GAM[(size_t)item * 64 + C.tid] = __expf(GK[63 * 64 + C.tid]);
        __syncthreads();
        { const int n0 = C.wave * 16, lane = C.lane, cc = lane & 15, g = lane >> 4;
          bf16* out = DS + (size_t)item * 8192 + (size_t)(n0 + cc) * 64 + 4 * g;
#pragma unroll
          for (int mt = 0; mt < 4; ++mt) { f32x4 acc = {0.f, 0.f, 0.f, 0.f}; acc = mm16(KT + mt * 16 * GL_LD, GL_LD, VT + n0 * GL_LD, GL_LD, 64, acc, lane);
              *(unsigned long long*)(out + mt * 16) = pack4(acc); } }
        __syncthreads();
    }
}
__device__ __forceinline__ void ph_gla_b(const Ctx& C, bf16* DS, const float* GAM) {
    for (int idx = C.bid * NT + C.tid; idx < 16 * 8192; idx += C.nb * NT) {
        const int bh = idx >> 13, ed = idx & 8191, d = ed & 63;
        bf16* p = DS + (size_t)bh * 128 * 8192 + ed; const float* gp = GAM + (size_t)bh * 128 * 64 + d;
        float S = 0.f;
        for (int c0 = 0; c0 < 128; c0 += 8) {
            float ds[8], gm[8];
#pragma unroll
            for (int i = 0; i < 8; ++i) { ds[i] = bf2f(p[(size_t)(c0 + i) * 8192]); gm[i] = gp[(c0 + i) * 64]; }
#pragma unroll
            for (int i = 0; i < 8; ++i) { const float gs = gm[i] * S; p[(size_t)(c0 + i) * 8192] = (bf16)f2bf(gs); S = gs + ds[i]; }
        }
    }
}
__device__ __forceinline__ void ph_gla_c(const Ctx& C, const bf16* PG, const float* gk_up, const float* gk_b, const float* norm_g, const bf16* DS, bf16* O) {
    LAS float* GK = (LAS float*)(C.lds + GL_GK); LAS bf16* QP = (LAS bf16*)(C.lds + GL_I0); LAS bf16* KM = (LAS bf16*)(C.lds + GL_I1); LAS bf16* AI = (LAS bf16*)(C.lds + GL_I2);
    LAS bf16* VT = (LAS bf16*)(C.lds + GL_VT); LAS float* SSQ = (LAS float*)(C.lds + GL_SSQ);
    for (int item = C.bid; item < 2048; item += C.nb) {
        const int bh = item >> 7, c = item & 127, b = bh >> 2, h = bh & 3;
        const size_t m0 = (size_t)b * T_ + c * 64;
        const bf16* pg = PG + m0 * NPG;
        GlaRaw R; gla_fetch(R, C, pg, gk_up, gk_b, h, true);
        s16x8 sfrag[4][2];
        { const int lane = C.lane, cc = lane & 15, g = lane >> 4, eh = C.wave >> 2; const bf16* Sg = DS + (size_t)item * 8192;
#pragma unroll
          for (int mt = 0; mt < 4; ++mt) { sfrag[mt][0] = *(const s16x8*)(Sg + (size_t)(eh * 64 + mt * 16 + cc) * 64 + 8 * g); sfrag[mt][1] = *(const s16x8*)(Sg + (size_t)(eh * 64 + mt * 16 + cc) * 64 + 32 + 8 * g); } }
        gla_gates(C, R);
        { const int j = C.tid >> 3, d0 = (C.tid & 7) * 8;
          const v4u qx = R.q, kx = R.k;
          const unsigned qw[4] = {qx.x, qx.y, qx.z, qx.w}, kw[4] = {kx.x, kx.y, kx.z, kx.w};
          unsigned qo[4], ko[4];
#pragma unroll
          for (int q = 0; q < 4; ++q) { const int d = d0 + 2 * q;
              const float e0 = GK[63 * 64 + d] - GK[j * 64 + d], e1 = GK[63 * 64 + d + 1] - GK[j * 64 + d + 1];
              const float q0 = 0.125f * bf2f((bf16)(qw[q] & 0xffffu)) * __expf(-e0), q1 = 0.125f * bf2f((bf16)(qw[q] >> 16)) * __expf(-e1);
              const float k0 = bf2f((bf16)(kw[q] & 0xffffu)) * __expf(e0), k1 = bf2f((bf16)(kw[q] >> 16)) * __expf(e1);
              qo[q] = pk2(q0, q1); ko[q] = pk2(k0, k1); }
          *(LAS v4u*)(QP + j * GL_LD + d0) = (v4u){qo[0], qo[1], qo[2], qo[3]}; *(LAS v4u*)(KM + j * GL_LD + d0) = (v4u){ko[0], ko[1], ko[2], ko[3]}; }
        gla_stage_vt(C, R);
        __syncthreads();
        { const int lane = C.lane, cc = lane & 15, g = lane >> 4, n0 = (C.wave >> 1) * 16;
#pragma unroll
          for (int q = 0; q < 2; ++q) { const int mt0 = ((C.wave & 1) * 2 + q) * 16; f32x4 acc = {0.f, 0.f, 0.f, 0.f};
              acc = mm16(KM + mt0 * GL_LD, GL_LD, QP + n0 * GL_LD, GL_LD, 64, acc, lane);
              const int i = n0 + cc, j = mt0 + 4 * g;
              acc.x = (j + 0 <= i) ? acc.x : 0.f; acc.y = (j + 1 <= i) ? acc.y : 0.f; acc.z = (j + 2 <= i) ? acc.z : 0.f; acc.w = (j + 3 <= i) ? acc.w : 0.f;
              *(LAS unsigned long long*)(AI + (n0 + cc) * GL_LD + mt0 + 4 * g) = pack4(acc); } }
        __syncthreads();
        { const int lane = C.lane, cc = lane & 15, g = lane >> 4, n0 = (C.wave & 3) * 16, eh = C.wave >> 2;
          f32x4 acc[4]; float ss = 0.f;
#pragma unroll
          for (int mt = 0; mt < 4; ++mt) { const int e0 = eh * 64 + mt * 16; acc[mt] = (f32x4){0.f, 0.f, 0.f, 0.f};
              { const LAS bf16* bp = QP + (n0 + cc) * GL_LD + 8 * g;
                acc[mt] = __builtin_amdgcn_mfma_f32_16x16x32_bf16(sfrag[mt][0], *(const LAS s16x8*)bp, acc[mt], 0, 0, 0); acc[mt] = __builtin_amdgcn_mfma_f32_16x16x32_bf16(sfrag[mt][1], *(const LAS s16x8*)(bp + 32), acc[mt], 0, 0, 0); }
              acc[mt] = mm16(VT + e0 * GL_LD, GL_LD, AI + n0 * GL_LD, GL_LD, 64, acc[mt], lane);
              ss += (acc[mt].x * acc[mt].x + acc[mt].y * acc[mt].y) + (acc[mt].z * acc[mt].z + acc[mt].w * acc[mt].w); }
          ss = xsum4(ss);
          if (g == 0) SSQ[eh * 64 + n0 + cc] = ss;
          __syncthreads();
          const float rstd = 1.f / sqrtf((SSQ[n0 + cc] + SSQ[64 + n0 + cc]) * (1.f / 128.f) + 1e-6f);
          const size_t m = m0 + n0 + cc;
#pragma unroll
          for (int mt = 0; mt < 4; ++mt) { const int e = eh * 64 + mt * 16 + 4 * g;
              const unsigned long long gx = *(const unsigned long long*)(pg + (size_t)(n0 + cc) * NPG + 1024 + h * 128 + e);
              const f32x4 ng = *(const f32x4*)(norm_g + e);
              f32x4 o;
              o.x = acc[mt].x * rstd * ng.x * siluf_(bf2f((bf16)(gx & 0xffffu)));
              o.y = acc[mt].y * rstd * ng.y * siluf_(bf2f((bf16)((gx >> 16) & 0xffffu)));
              o.z = acc[mt].z * rstd * ng.z * siluf_(bf2f((bf16)((gx >> 32) & 0xffffu)));
              o.w = acc[mt].w * rstd * ng.w * siluf_(bf2f((bf16)(gx >> 48)));
              *(unsigned long long*)(O + m * D_ + h * 128 + e) = pack4(o); } }
        __syncthreads();
    }
}


struct RwkvW { const float *mu, *mu_vres, *w0, *a0, *v0, *k_k, *k_a, *r_k; const bf16 *wupT, *aupT, *gupT, *vupT; };
constexpr int RW_LD = 72, RW_XLD = 296;
constexpr int RW_R0 = 0;
constexpr int RW_SEG = 16384;
constexpr int RW_R1 = 36864;
constexpr int RW_R2 = RW_R1 + 27648;
constexpr int RW_R3 = RW_R2 + 9216;
constexpr int RW_R4 = RW_R3 + 27648;
constexpr int RW_TI = RW_R4 + 128 * RW_LD * 2;
constexpr int RW_MU = RW_TI + 2048;
constexpr int RW_X = RW_MU + 2048;
constexpr int RW_END = RW_X + 64 * RW_XLD * 2;
static_assert(RW_END <= MISC_OFF, "RWKV LDS map");

typedef short s16x4 __attribute__((ext_vector_type(4)));
__device__ __forceinline__ float tanh_fast(float x) { const float e = __expf(2.f * x); return 1.f - 2.f / (e + 1.f); }
__device__ __forceinline__ float softplus_fast(float x) { return fmaxf(x, 0.f) + __logf(1.f + __expf(-fabsf(x))); }
__device__ __forceinline__ s16x4 cvt4(f32x4 v) { const unsigned long long p = pack4(v); return __builtin_bit_cast(s16x4, p); }
__device__ __forceinline__ void ld8f(const float* p, float (&o)[8]) { const f32x4 a = *(const f32x4*)p, b = *(const f32x4*)(p + 4); o[0] = a.x; o[1] = a.y; o[2] = a.z; o[3] = a.w; o[4] = b.x; o[5] = b.y; o[6] = b.z; o[7] = b.w; }
__device__ __forceinline__ float sum8(float v) { v += dpp_f<0xB1>(v); v += dpp_f<0x4E>(v); v += dpp_f<0x141>(v); return v; }
__device__ __forceinline__ void unpack8(const v4u x, float (&o)[8]) {
    o[0] = bf2f((bf16)(x.x & 0xffffu)); o[1] = bf2f((bf16)(x.x >> 16)); o[2] = bf2f((bf16)(x.y & 0xffffu)); o[3] = bf2f((bf16)(x.y >> 16));
    o[4] = bf2f((bf16)(x.z & 0xffffu)); o[5] = bf2f((bf16)(x.z >> 16)); o[6] = bf2f((bf16)(x.w & 0xffffu)); o[7] = bf2f((bf16)(x.w >> 16)); }
__device__ __forceinline__ v4u pack8(const float (&o)[8]) { return (v4u){pk2(o[0], o[1]), pk2(o[2], o[3]), pk2(o[4], o[5]), pk2(o[6], o[7])}; }
__device__ __forceinline__ f32x4 mm16_gb(const LAS bf16* A, int lda, const bf16* B, int ldb, int K, f32x4 acc, int lane) {
    const int r = lane & 15, g = lane >> 4;
    const LAS bf16* ap = A + r * lda + 8 * g; const bf16* bp = B + r * ldb + 8 * g;
    for (int k0 = 0; k0 < K; k0 += 32) { const s16x8 a = *(const LAS s16x8*)(ap + k0); const s16x8 b = *(const s16x8*)(bp + k0); acc = __builtin_amdgcn_mfma_f32_16x16x32_bf16(a, b, acc, 0, 0, 0); }
    return acc;
}

__device__ __forceinline__ void ph_norm_b(const Ctx& C, const bf16* x, const float* g, const float* sh, const float* sc, bf16* XB) {
    const int gw = C.bid * 8 + C.wave, NGW = C.nb * 8, lane = C.lane;
    for (int m = gw; m < M_; m += NGW) {
        const int b = m / T_;
        const v4u* xr = (const v4u*)(x + (size_t)m * D_) + lane;
        float v[2][8]; float s = 0.f;
#pragma unroll
        for (int j = 0; j < 2; ++j) { unpack8(xr[64 * j], v[j]);
#pragma unroll
            for (int i = 0; i < 8; ++i) s += v[j][i] * v[j][i]; }
        const float rstd = 1.f / sqrtf(wave_sum(s) * (1.f / D_) + 1e-6f);
        v4u* o = (v4u*)(XB + (size_t)m * D_) + lane;
#pragma unroll
        for (int j = 0; j < 2; ++j) { const int col = 8 * lane + 512 * j; float gv[8], shv[8], scv[8], h[8];
            ld8f(g + col, gv); ld8f(sh + b * 6144 + col, shv); ld8f(sc + b * 6144 + col, scv);
#pragma unroll
            for (int i = 0; i < 8; ++i) h[i] = v[j][i] * rstd * gv[i] * (scv[i] + 1.f) + shv[i];
            o[64 * j] = pack8(h); }
    }
}
__device__ __forceinline__ void ph_final_b(const Ctx& C, const bf16* x, const float* g, float* out, int m_lo, int m_hi, bf16* keep, int c_lo, int c_hi) {
    const int gw = C.bid * 8 + C.wave, NGW = C.nb * 8, lane = C.lane;
    for (int m = m_lo + gw; m < m_hi; m += NGW) {
        const v4u* xr = (const v4u*)(x + (size_t)m * D_) + lane;
        float v[2][8]; float s = 0.f;
#pragma unroll
        for (int j = 0; j < 2; ++j) { unpack8(xr[64 * j], v[j]);
#pragma unroll
            for (int i = 0; i < 8; ++i) s += v[j][i] * v[j][i]; }
        const float rstd = 1.f / sqrtf(wave_sum(s) * (1.f / D_) + 1e-6f);
#pragma unroll
        for (int j = 0; j < 2; ++j) { const int col = 8 * lane + 512 * j; float gv[8]; ld8f(g + col, gv);
            f32x4* o = (f32x4*)(out + (size_t)m * D_ + col);
            o[0] = (f32x4){v[j][0] * rstd * gv[0], v[j][1] * rstd * gv[1], v[j][2] * rstd * gv[2], v[j][3] * rstd * gv[3]};
            o[1] = (f32x4){v[j][4] * rstd * gv[4], v[j][5] * rstd * gv[5], v[j][6] * rstd * gv[6], v[j][7] * rstd * gv[7]}; }
    }
    for (int m = c_lo + gw; m < c_hi; m += NGW) { const v4u* xr = (const v4u*)(x + (size_t)m * D_) + lane; v4u* kr = (v4u*)(keep + (size_t)(m - c_lo) * D_) + lane; kr[0] = xr[0]; kr[64] = xr[64]; }
}
__device__ __forceinline__ void ph_rwkv_a(const Ctx& C, const bf16* PR, const bf16* VL  , const RwkvW& W, int layer,
                                          bf16* PP, bf16* QQ, bf16* RH, bf16* YH, float* GAMC, float* RK, bf16* GG, bf16* VF, bool store_v = true) {
    LAS unsigned char* L = C.lds;
    LAS bf16* X = (LAS bf16*)(L + RW_X); LAS float* CUM = (LAS float*)(L + RW_R0); LAS float* SEG = (LAS float*)(L + RW_SEG);
    LAS bf16* NI = (LAS bf16*)(L + RW_R0), *AAK = NI + 64 * RW_LD, *ARB = AAK + 64 * RW_LD, *ARK = ARB + 64 * RW_LD;
    LAS bf16* PRE = (LAS bf16*)(L + RW_R1);
    LAS bf16* AT = (LAS bf16*)(L + RW_R1), *BT = AT + 64 * RW_LD, *KT = BT + 64 * RW_LD, *RT = (LAS bf16*)(L + RW_R2);
    LAS bf16* XB16 = (LAS bf16*)(L + RW_R1);
    LAS bf16* BHc = (LAS bf16*)(L + RW_R3), *KHc = BHc + 64 * RW_LD, *VTc = KHc + 64 * RW_LD;
    LAS bf16* XT = (LAS bf16*)(L + RW_R4); LAS bf16* TI = (LAS bf16*)(L + RW_TI);
    const int wave = C.wave;
    LAS float* MU = (LAS float*)(L + RW_MU);
    for (int i = C.tid; i < 288; i += NT) MU[i] = i < 256 ? W.mu[1536 + i] : (layer ? W.mu_vres[i - 256] : 0.f);
    __syncthreads();
    for (int bc = C.bid; bc < 512; bc += C.nb) {
        const int c = bc & 127, b = bc >> 7;
        const size_t m0 = (size_t)b * T_ + c * 64;
        { const int tid = C.tid;
          v4u xc[5], xp[5];
#pragma unroll
          for (int it = 0; it < 5; ++it) { const int idx = tid + it * NT; xc[it] = (v4u){0u, 0u, 0u, 0u}; xp[it] = xc[it];
            if (idx < 64 * 36) { const int t1 = idx / 36, q = idx % 36, col = q * 8; const size_t m1 = m0 + t1; const bool first1 = (c == 0 && t1 == 0);
                if (q < 32) { xc[it] = *(const v4u*)(PR + m1 * NPR + 1536 + col); if (!first1) xp[it] = *(const v4u*)(PR + (m1 - 1) * NPR + 1536 + col); }
                else if (layer) { xc[it] = *(const v4u*)(VL + m1 * NPG + 1552 + (col - 256)); if (!first1) xp[it] = *(const v4u*)(VL + (m1 - 1) * NPG + 1552 + (col - 256)); } } }
#pragma unroll
          for (int it = 0; it < 5; ++it) { const int idx = tid + it * NT;
            if (idx < 64 * 36) { const int t1 = idx / 36, q = idx % 36, col = q * 8;
                float cv[8], pv[8], mu[8]; unpack8(xc[it], cv); unpack8(xp[it], pv);
                { const f32x4 ma = *(const LAS f32x4*)(MU + col), mb = *(const LAS f32x4*)(MU + col + 4); mu[0] = ma.x; mu[1] = ma.y; mu[2] = ma.z; mu[3] = ma.w; mu[4] = mb.x; mu[5] = mb.y; mu[6] = mb.z; mu[7] = mb.w; }
#pragma unroll
                for (int i = 0; i < 8; ++i) { float p = cv[i] + (pv[i] - cv[i]) * mu[i]; if (q < 8) p = tanh_fast(p); else if (q >= 16 && q < 32) p = sigmoidf_(p); cv[i] = p; }
                *(LAS v4u*)(X + t1 * RW_XLD + col) = pack8(cv); } }
        }
        __syncthreads();
      v4u rcx, kcx, vcx, rpx, kpx, vpx, vfx;
#define RW_FETCH(hh) do { const int t_ = C.tid >> 3, ch_ = (hh) * 64 + (C.tid & 7) * 8; const size_t m_ = m0 + t_; const bool first_ = (c == 0 && t_ == 0); \
        rcx = *(const v4u*)(PR + m_ * NPR + ch_); kcx = *(const v4u*)(PR + m_ * NPR + 512 + ch_); vcx = *(const v4u*)(PR + m_ * NPR + 1024 + ch_); \
        rpx = (v4u){0u, 0u, 0u, 0u}; kpx = rpx; vpx = rpx; vfx = rpx; \
        if (!first_) { rpx = *(const v4u*)(PR + (m_ - 1) * NPR + ch_); kpx = *(const v4u*)(PR + (m_ - 1) * NPR + 512 + ch_); vpx = *(const v4u*)(PR + (m_ - 1) * NPR + 1024 + ch_); } \
        if (layer) vfx = *(const v4u*)(VF + m_ * 512 + ch_); } while (0)
      RW_FETCH(0);
#pragma unroll 1
      for (int h = 0; h < 8; ++h) {
        const int item = bc * 8 + h;
        int tid_ = C.tid; asm volatile("" : "+v"(tid_));
        const int tid = tid_, lane = tid & 63, cc = lane & 15, g = lane >> 4;
        const int t = tid >> 3, d0 = (tid & 7) * 8, ch = h * 64 + d0; const size_t m = m0 + t;
        {
            const int lsel = wave >> 1;
            const bf16* WT = lsel == 0 ? W.wupT : lsel == 1 ? W.aupT : lsel == 2 ? W.gupT : W.vupT;
            const int Kl = lsel == 2 ? 128 : lsel == 3 ? 32 : 64, xoff = lsel == 0 ? 0 : lsel == 1 ? 64 : lsel == 2 ? 128 : 256;
            LAS bf16* outp = PRE + lsel * 64 * RW_LD;
            const bool live = (lsel != 3 || layer);
#pragma unroll
            for (int mq = 0; mq < 2; ++mq) { const int mt = (wave & 1) * 2 + mq;
                s16x8 af[4];
                const bf16* ap = WT + (size_t)(h * 64 + mt * 16 + cc) * Kl + 8 * g;
#pragma unroll
                for (int ks = 0; ks < 4; ++ks) af[ks] = (live && ks * 32 < Kl) ? *(const s16x8*)(ap + ks * 32) : (s16x8){0, 0, 0, 0, 0, 0, 0, 0};
#pragma unroll
                for (int nt = 0; nt < 4; ++nt) { f32x4 acc = {0.f, 0.f, 0.f, 0.f};
                    const LAS bf16* bp = X + (nt * 16 + cc) * RW_XLD + xoff + 8 * g;
#pragma unroll
                    for (int ks = 0; ks < 4; ++ks) if (ks * 32 < Kl) { const s16x8 bb = *(const LAS s16x8*)(bp + ks * 32); acc = __builtin_amdgcn_mfma_f32_16x16x32_bf16(af[ks], bb, acc, 0, 0, 0); }
                    *(LAS unsigned long long*)(outp + (nt * 16 + cc) * RW_LD + mt * 16 + 4 * g) = pack4(acc); } }
        }
        __syncthreads();
        float av[8], bv[8], kv[8], rv[8], lw[8], vv[8];
        {
            float rc[8], rp[8], kc[8], kp[8], vc[8], vp[8], pw[8], pa[8], pg_[8], pvg[8];
            unpack8(rcx, rc); unpack8(kcx, kc); unpack8(vcx, vc); unpack8(rpx, rp); unpack8(kpx, kp); unpack8(vpx, vp);
            unpack8(*(const LAS v4u*)(PRE + (0 * 64 + t) * RW_LD + d0), pw); unpack8(*(const LAS v4u*)(PRE + (1 * 64 + t) * RW_LD + d0), pa);
            unpack8(*(const LAS v4u*)(PRE + (2 * 64 + t) * RW_LD + d0), pg_); unpack8(*(const LAS v4u*)(PRE + (3 * 64 + t) * RW_LD + d0), pvg);
            float vf[8]; unpack8(vfx, vf);
            float ssq = 0.f, rks = 0.f, asg[8], gg[8];
            float mur[8], muk[8], muv[8], w0c[8], a0c[8], v0c[8], kkc[8], kac[8], rkc[8];
            ld8f(W.mu + ch, mur); ld8f(W.mu + 512 + ch, muk); ld8f(W.mu + 1024 + ch, muv); ld8f(W.w0 + ch, w0c); ld8f(W.a0 + ch, a0c);
            ld8f(W.k_k + ch, kkc); ld8f(W.k_a + ch, kac); ld8f(W.r_k + ch, rkc);
            if (layer) ld8f(W.v0 + ch, v0c);
#pragma unroll
            for (int i = 0; i < 8; ++i) {
                const float r = rc[i] + (rp[i] - rc[i]) * mur[i], k = kc[i] + (kp[i] - kc[i]) * muk[i]; float v = vc[i] + (vp[i] - vc[i]) * muv[i];
                lw[i] = -0.6065306597f * sigmoidf_(w0c[i] + pw[i]);
                asg[i] = sigmoidf_(a0c[i] + pa[i]);
                if (layer) v = v + (vf[i] - v) * sigmoidf_(v0c[i] + pvg[i]);
                const float kk = k * kkc[i]; ssq += kk * kk;
                kv[i] = k * (1.f + (asg[i] - 1.f) * kac[i]); rv[i] = r; vv[i] = v; gg[i] = pg_[i]; av[i] = kk;
                rks += r * kv[i] * rkc[i];
            }
            ssq = sum8(ssq); rks = sum8(rks);
            const float inv = 1.f / sqrtf(fmaxf(ssq, 1e-24f));
#pragma unroll
            for (int i = 0; i < 8; ++i) { const float kk = av[i] * inv; av[i] = -kk; bv[i] = kk * asg[i]; }
            if ((tid & 7) == 0) RK[m * 8 + h] = rks;
            *(v4u*)(GG + m * 512 + ch) = pack8(gg);
            if (store_v) *(v4u*)(VF + m * 512 + ch) = pack8(vv);
#pragma unroll
            for (int i = 0; i < 8; ++i) vv[i] = bf2f((bf16)f2bf(vv[i]));
        }
        __syncthreads();
#pragma unroll
        for (int i = 0; i < 8; ++i) CUM[t * 64 + d0 + i] = lw[i];
        __syncthreads();
        { const int d = tid & 63, seg = tid >> 6; float run = 0.f;
#pragma unroll
          for (int q = 0; q < 8; ++q) { run += CUM[(seg * 8 + q) * 64 + d]; CUM[(seg * 8 + q) * 64 + d] = run; }
          SEG[seg * 64 + d] = run; }
        __syncthreads();
        { const int d = tid & 63, seg = tid >> 6; float off = 0.f;
          for (int s = 0; s < seg; ++s) off += SEG[s * 64 + d];
#pragma unroll
          for (int q = 0; q < 8; ++q) CUM[(seg * 8 + q) * 64 + d] += off; }
        __syncthreads();
        {
            float at[8], bt[8], kt[8], rt[8];
#pragma unroll
            for (int i = 0; i < 8; ++i) { const float cu = CUM[t * 64 + d0 + i], cC = CUM[63 * 64 + d0 + i], en = __expf(-cu), ec = __expf(cC - cu);
                at[i] = av[i] * __expf(cu - lw[i]); bt[i] = bv[i] * en; kt[i] = kv[i] * en; rt[i] = rv[i] * __expf(cu);
                BHc[(d0 + i) * RW_LD + t] = (bf16)f2bf(bv[i] * ec); KHc[(d0 + i) * RW_LD + t] = (bf16)f2bf(kv[i] * ec); VTc[(d0 + i) * RW_LD + t] = (bf16)f2bf(vv[i]);
                XT[(d0 + i) * RW_LD + t] = (bf16)f2bf(at[i]);
                if (t == 63) GAMC[(size_t)item * 64 + d0 + i] = __expf(cC); }
            *(LAS v4u*)(AT + t * RW_LD + d0) = pack8(at); *(LAS v4u*)(BT + t * RW_LD + d0) = pack8(bt); *(LAS v4u*)(KT + t * RW_LD + d0) = pack8(kt); *(LAS v4u*)(RT + t * RW_LD + d0) = pack8(rt);
        }
        if (h < 7) RW_FETCH(h + 1);
        __syncthreads();
        {
            const int msel = wave >> 1;
            const LAS bf16* As = (msel == 0 || msel == 2) ? BT : KT; const LAS bf16* Bs = (msel < 2) ? AT : RT;
            f32x4 accs[8];
#pragma unroll
            for (int q = 0; q < 8; ++q) { const int tile = (wave & 1) * 8 + q, mt = tile >> 2, nt = tile & 3; accs[q] = (f32x4){0.f, 0.f, 0.f, 0.f};
                accs[q] = mm16(As + mt * 16 * RW_LD, RW_LD, Bs + nt * 16 * RW_LD, RW_LD, 64, accs[q], lane);
                const int tt = nt * 16 + cc, s0 = mt * 16 + 4 * g, lim = (msel < 2) ? tt - 1 : tt;
                accs[q].x = (s0 + 0 <= lim) ? accs[q].x : 0.f; accs[q].y = (s0 + 1 <= lim) ? accs[q].y : 0.f; accs[q].z = (s0 + 2 <= lim) ? accs[q].z : 0.f; accs[q].w = (s0 + 3 <= lim) ? accs[q].w : 0.f; }
            __syncthreads();
            LAS bf16* outp = NI + msel * 64 * RW_LD;
#pragma unroll
            for (int q = 0; q < 8; ++q) { const int tile = (wave & 1) * 8 + q, mt = tile >> 2, nt = tile & 3;
                *(LAS unsigned long long*)(outp + (nt * 16 + cc) * RW_LD + mt * 16 + 4 * g) = pack4(accs[q]); }
        }
        __syncthreads();
        if (wave == 0) {
            const int blk = lane >> 4, col = lane & 15; float x[16];
#pragma unroll
            for (int tt = 0; tt < 16; ++tt) { float nr[16]; { float lo[8], hi[8]; unpack8(*(const LAS v4u*)(NI + (16 * blk + tt) * RW_LD + 16 * blk), lo); unpack8(*(const LAS v4u*)(NI + (16 * blk + tt) * RW_LD + 16 * blk + 8), hi);
#pragma unroll
                    for (int q = 0; q < 8; ++q) { nr[q] = lo[q]; nr[8 + q] = hi[q]; } }
                float a = (tt == col) ? 1.f : 0.f;
#pragma unroll
                for (int q = 0; q < tt; ++q) a += nr[q] * x[q];
                x[tt] = a; TI[(blk * 16 + tt) * 16 + col] = (bf16)f2bf(a); }
        } else {
            for (int tile = wave - 1; tile < 16; tile += 7) { const int mt = tile >> 2, nt = tile & 3;
                f32x4 acc = {0.f, 0.f, 0.f, 0.f}; acc = mm16(AAK + mt * 16 * RW_LD, RW_LD, VTc + nt * 16 * RW_LD, RW_LD, 64, acc, lane);
                *(LAS unsigned long long*)(XT + (64 + nt * 16 + cc) * RW_LD + mt * 16 + 4 * g) = pack4(acc); }
        }
        __syncthreads();
        {
            s16x4 xb[4];
#pragma unroll
            for (int i = 0; i < 4; ++i) {
                f32x4 acc; { const unsigned long long xr = *(const LAS unsigned long long*)(XT + (wave * 16 + cc) * RW_LD + 16 * i + 4 * g);
                    acc.x = bf2f((bf16)(xr & 0xffffu)); acc.y = bf2f((bf16)((xr >> 16) & 0xffffu)); acc.z = bf2f((bf16)((xr >> 32) & 0xffffu)); acc.w = bf2f((bf16)(xr >> 48)); }
#pragma unroll
                for (int k = 0; k < i; ++k) { const s16x4 a = *(const LAS s16x4*)(NI + (16 * i + cc) * RW_LD + 16 * k + 4 * g); acc = __builtin_amdgcn_mfma_f32_16x16x16bf16_1k(a, xb[k], acc, 0, 0, 0); }
                const s16x4 yb = cvt4(acc), ta = *(const LAS s16x4*)(TI + (i * 16 + cc) * 16 + 4 * g);
                const f32x4 xi = __builtin_amdgcn_mfma_f32_16x16x16bf16_1k(ta, yb, (f32x4){0.f, 0.f, 0.f, 0.f}, 0, 0, 0);
                xb[i] = cvt4(xi);
            }
            __syncthreads();
#pragma unroll
            for (int i = 0; i < 4; ++i) *(LAS s16x4*)(XB16 + (wave * 16 + cc) * RW_LD + 16 * i + 4 * g) = xb[i];
        }
        __syncthreads();
        {
            const int osel = wave >> 1, mt0 = (wave & 1) * 2; const size_t ob = (size_t)item * 4096;
            const LAS bf16* A1 = osel == 0 ? XB16 : osel == 1 ? BHc : osel == 2 ? XB16 : XB16 + 64 * RW_LD;
            const LAS bf16* B1 = osel == 0 ? BHc : osel == 1 ? XB16 + 64 * RW_LD : ARB;
            const LAS bf16* A2 = osel == 1 ? KHc : VTc; const LAS bf16* B2 = osel == 1 ? VTc : ARK;
            bf16* OUT = osel == 0 ? PP : osel == 1 ? QQ : osel == 2 ? RH : YH;
            f32x4 acc[2][4];
#pragma unroll
            for (int mq = 0; mq < 2; ++mq)
#pragma unroll
                for (int nt = 0; nt < 4; ++nt) acc[mq][nt] = (f32x4){0.f, 0.f, 0.f, 0.f};
            { s16x8 af[2][2], bfm[4][2];
#pragma unroll
              for (int mq = 0; mq < 2; ++mq)
#pragma unroll
                  for (int k = 0; k < 2; ++k) af[mq][k] = *(const LAS s16x8*)(A1 + ((mt0 + mq) * 16 + cc) * RW_LD + 32 * k + 8 * g);
#pragma unroll
              for (int nt = 0; nt < 4; ++nt)
#pragma unroll
                  for (int k = 0; k < 2; ++k) bfm[nt][k] = *(const LAS s16x8*)(B1 + (nt * 16 + cc) * RW_LD + 32 * k + 8 * g);
#pragma unroll
              for (int mq = 0; mq < 2; ++mq)
#pragma unroll
                  for (int nt = 0; nt < 4; ++nt) { acc[mq][nt] = __builtin_amdgcn_mfma_f32_16x16x32_bf16(af[mq][0], bfm[nt][0], acc[mq][nt], 0, 0, 0); acc[mq][nt] = __builtin_amdgcn_mfma_f32_16x16x32_bf16(af[mq][1], bfm[nt][1], acc[mq][nt], 0, 0, 0); } }
            if (osel & 1) { s16x8 af[2][2], bfm[4][2];
#pragma unroll
              for (int mq = 0; mq < 2; ++mq)
#pragma unroll
                  for (int k = 0; k < 2; ++k) af[mq][k] = *(const LAS s16x8*)(A2 + ((mt0 + mq) * 16 + cc) * RW_LD + 32 * k + 8 * g);
#pragma unroll
              for (int nt = 0; nt < 4; ++nt)
#pragma unroll
                  for (int k = 0; k < 2; ++k) bfm[nt][k] = *(const LAS s16x8*)(B2 + (nt * 16 + cc) * RW_LD + 32 * k + 8 * g);
#pragma unroll
              for (int mq = 0; mq < 2; ++mq)
#pragma unroll
                  for (int nt = 0; nt < 4; ++nt) { acc[mq][nt] = __builtin_amdgcn_mfma_f32_16x16x32_bf16(af[mq][0], bfm[nt][0], acc[mq][nt], 0, 0, 0); acc[mq][nt] = __builtin_amdgcn_mfma_f32_16x16x32_bf16(af[mq][1], bfm[nt][1], acc[mq][nt], 0, 0, 0); } }
#pragma unroll
            for (int mq = 0; mq < 2; ++mq)
#pragma unroll
                for (int nt = 0; nt < 4; ++nt) { f32x4 a = acc[mq][nt];
                    if (osel == 2) { const unsigned long long rr = *(const LAS unsigned long long*)(RT + (nt * 16 + cc) * RW_LD + (mt0 + mq) * 16 + 4 * g);
                        a.x += bf2f((bf16)(rr & 0xffffu)); a.y += bf2f((bf16)((rr >> 16) & 0xffffu)); a.z += bf2f((bf16)((rr >> 32) & 0xffffu)); a.w += bf2f((bf16)(rr >> 48)); }
                    *(unsigned long long*)(OUT + ob + (nt * 16 + cc) * 64 + (mt0 + mq) * 16 + 4 * g) = pack4(a); }
        }
        __syncthreads();
      }
    }
}

#undef RW_FETCH
constexpr int CH_R = 6, CH_SLOT = 9216 + 9216 + 256;
constexpr int CH_RING = 0, CH_SI = CH_R * CH_SLOT, CH_FLAGS = CH_SI + 4 * 2304;
static_assert(CH_FLAGS + 64 <= MISC_OFF, "chain LDS map");
struct ChainRegs { v4u p[8], q[8]; f32x4 gm; };
__device__ __forceinline__ void chain_fetch(ChainRegs& o, const bf16* PP, const bf16* QQ, const float* GAMC, int item, int lane) {
    const size_t ob = (size_t)item * 4096;
#pragma unroll
    for (int i = 0; i < 8; ++i) { o.p[i] = *(const v4u*)(PP + ob + (size_t)(i * 64 + lane) * 8); o.q[i] = *(const v4u*)(QQ + ob + (size_t)(i * 64 + lane) * 8); }
    o.gm = *(const f32x4*)(GAMC + (size_t)item * 64 + (lane & 15) * 4);
}
__device__ __forceinline__ void chain_commit(const ChainRegs& o, LAS unsigned char* L, int c, int lane) {
    volatile LAS unsigned* flags = (volatile LAS unsigned*)(L + CH_FLAGS);
    const int slot = c % CH_R;
    if (c >= CH_R) { const unsigned need = (unsigned)(c - CH_R + 1);
        for (;;) { const unsigned m0 = flags[CH_R + 0], m1 = flags[CH_R + 1], m2 = flags[CH_R + 2], m3 = flags[CH_R + 3];
            if (m0 >= need && m1 >= need && m2 >= need && m3 >= need) break; __builtin_amdgcn_s_sleep(1); } }
    asm volatile("" ::: "memory");
    LAS unsigned char* sl = L + CH_RING + slot * CH_SLOT;
#pragma unroll
    for (int i = 0; i < 8; ++i) { const int idx = i * 64 + lane, row = idx >> 3, c16 = idx & 7;
        *(LAS v4u*)(sl + row * 144 + c16 * 16) = o.p[i]; *(LAS v4u*)(sl + 9216 + row * 144 + c16 * 16) = o.q[i]; }
    if (lane < 16) *(LAS f32x4*)(sl + 18432 + lane * 16) = o.gm;
    asm volatile("s_waitcnt lgkmcnt(0)" ::: "memory");
    if (lane == 0) flags[slot] = (unsigned)(c + 1);
}
__device__ __forceinline__ void ph_rwkv_b(const Ctx& C, int bh  , const bf16* PP, const bf16* QQ, const float* GAMC, bf16* S0) {
    const int lane = C.lane, wave = C.wave, cc = lane & 15, g = lane >> 4, b = bh >> 3, h = bh & 7;
    LAS unsigned char* L = C.lds;
    volatile LAS unsigned* flags = (volatile LAS unsigned*)(L + CH_FLAGS);
    if (C.tid < 16) flags[C.tid] = 0u;
    __syncthreads();
    if (wave >= 4) {
        const int j = wave - 4;
        ChainRegs A, B;
        int lc = j;
        chain_fetch(A, PP, QQ, GAMC, (b * 128 + lc) * 8 + h, lane);
        for (;;) {
            if (lc + 4 < 128) chain_fetch(B, PP, QQ, GAMC, (b * 128 + lc + 4) * 8 + h, lane);
            chain_commit(A, L, lc, lane);
            lc += 4; if (lc >= 128) break;
            if (lc + 4 < 128) chain_fetch(A, PP, QQ, GAMC, (b * 128 + lc + 4) * 8 + h, lane);
            chain_commit(B, L, lc, lane);
            lc += 4; if (lc >= 128) break;
        }
    } else {
        const int vt = wave;
        LAS bf16* SI = (LAS bf16*)(L + CH_SI + vt * 2304);
        f32x4 st[4];
#pragma unroll
        for (int mt = 0; mt < 4; ++mt) st[mt] = (f32x4){0.f, 0.f, 0.f, 0.f};
        for (int c = 0; c < 128; ++c) {
            const int item = (b * 128 + c) * 8 + h, slot = c % CH_R; const size_t ob = (size_t)item * 4096;
#pragma unroll
            for (int mt = 0; mt < 4; ++mt) { const unsigned long long pk = pack4(st[mt]);
                *(unsigned long long*)(S0 + ob + (vt * 16 + cc) * 64 + mt * 16 + 4 * g) = pk; *(LAS unsigned long long*)(SI + cc * RW_LD + mt * 16 + 4 * g) = pk; }
            while (flags[slot] < (unsigned)(c + 1)) __builtin_amdgcn_s_sleep(1);
            asm volatile("s_waitcnt lgkmcnt(0)" ::: "memory");
            const LAS unsigned char* sl = L + CH_RING + slot * CH_SLOT;
            const LAS bf16* Pi = (const LAS bf16*)sl; const LAS bf16* Qi = (const LAS bf16*)(sl + 9216); const LAS float* Gi = (const LAS float*)(sl + 18432);
            const s16x8 b0 = *(const LAS s16x8*)(SI + cc * RW_LD + 8 * g), b1 = *(const LAS s16x8*)(SI + cc * RW_LD + 32 + 8 * g);
#pragma unroll
            for (int mt = 0; mt < 4; ++mt) {
                const f32x4 gm = *(const LAS f32x4*)(Gi + mt * 16 + 4 * g);
                const unsigned long long qq = *(const LAS unsigned long long*)(Qi + (vt * 16 + cc) * RW_LD + mt * 16 + 4 * g);
                const s16x8 a0 = *(const LAS s16x8*)(Pi + (mt * 16 + cc) * RW_LD + 8 * g), a1 = *(const LAS s16x8*)(Pi + (mt * 16 + cc) * RW_LD + 32 + 8 * g);
                f32x4 acc; acc.x = gm.x * st[mt].x + bf2f((bf16)(qq & 0xffffu)); acc.y = gm.y * st[mt].y + bf2f((bf16)((qq >> 16) & 0xffffu));
                acc.z = gm.z * st[mt].z + bf2f((bf16)((qq >> 32) & 0xffffu)); acc.w = gm.w * st[mt].w + bf2f((bf16)(qq >> 48));
                acc = __builtin_amdgcn_mfma_f32_16x16x32_bf16(a0, b0, acc, 0, 0, 0); acc = __builtin_amdgcn_mfma_f32_16x16x32_bf16(a1, b1, acc, 0, 0, 0);
                st[mt] = acc; }
            asm volatile("s_waitcnt lgkmcnt(0)" ::: "memory");
            if (lane == 0) flags[CH_R + vt] = (unsigned)(c + 1);
        }
    }
    __syncthreads();
}

__device__ __forceinline__ void ph_rwkv_c(const Ctx& C, const bf16* S0, const bf16* RH, const bf16* YH, const float* RK, const bf16* GG, const bf16* VF,
                                          const float* gn_g, const float* gn_b, bf16* O) {
    const int lane = C.lane, cc = lane & 15, g = lane >> 4;
    for (int item = C.bid * 8 + C.wave; item < 4096; item += C.nb * 8) {
        const int h = item & 7, c = (item >> 3) & 127, b = item >> 10; const size_t m0 = (size_t)b * T_ + c * 64, ob = (size_t)item * 4096;
        s16x8 af[4][2], bfr[4][2];
#pragma unroll
        for (int q = 0; q < 4; ++q)
#pragma unroll
            for (int k = 0; k < 2; ++k) { af[q][k] = *(const s16x8*)(S0 + ob + (q * 16 + cc) * 64 + k * 32 + 8 * g); bfr[q][k] = *(const s16x8*)(RH + ob + (q * 16 + cc) * 64 + k * 32 + 8 * g); }
#pragma unroll
        for (int nt = 0; nt < 4; ++nt) {
            const size_t m = m0 + nt * 16 + cc;
            f32x4 y[4]; float s1 = 0.f;
#pragma unroll
            for (int mt = 0; mt < 4; ++mt) { const unsigned long long yh = *(const unsigned long long*)(YH + ob + (nt * 16 + cc) * 64 + mt * 16 + 4 * g);
                f32x4 acc; acc.x = bf2f((bf16)(yh & 0xffffu)); acc.y = bf2f((bf16)((yh >> 16) & 0xffffu)); acc.z = bf2f((bf16)((yh >> 32) & 0xffffu)); acc.w = bf2f((bf16)(yh >> 48));
                acc = __builtin_amdgcn_mfma_f32_16x16x32_bf16(af[mt][0], bfr[nt][0], acc, 0, 0, 0); acc = __builtin_amdgcn_mfma_f32_16x16x32_bf16(af[mt][1], bfr[nt][1], acc, 0, 0, 0);
                y[mt] = acc; s1 += (acc.x + acc.y) + (acc.z + acc.w); }
            s1 = xsum4(s1);
            const float mean = s1 * (1.f / 64.f); float s2 = 0.f;
#pragma unroll
            for (int mt = 0; mt < 4; ++mt) { y[mt] = y[mt] - mean; s2 += (y[mt].x * y[mt].x + y[mt].y * y[mt].y) + (y[mt].z * y[mt].z + y[mt].w * y[mt].w); }
            s2 = xsum4(s2);
            const float rstd = 1.f / sqrtf(s2 * (1.f / 64.f) + 64e-5f), rk = RK[m * 8 + h];
#pragma unroll
            for (int mt = 0; mt < 4; ++mt) { const int v = h * 64 + mt * 16 + 4 * g;
                const f32x4 gg4 = *(const f32x4*)(gn_g + v), gb4 = *(const f32x4*)(gn_b + v);
                const unsigned long long vx = *(const unsigned long long*)(VF + m * 512 + v), gx = *(const unsigned long long*)(GG + m * 512 + v);
                f32x4 o;
                o.x = (y[mt].x * rstd * gg4.x + gb4.x + rk * bf2f((bf16)(vx & 0xffffu))) * bf2f((bf16)(gx & 0xffffu));
                o.y = (y[mt].y * rstd * gg4.y + gb4.y + rk * bf2f((bf16)((vx >> 16) & 0xffffu))) * bf2f((bf16)((gx >> 16) & 0xffffu));
                o.z = (y[mt].z * rstd * gg4.z + gb4.z + rk * bf2f((bf16)((vx >> 32) & 0xffffu))) * bf2f((bf16)((gx >> 32) & 0xffffu));
                o.w = (y[mt].w * rstd * gg4.w + gb4.w + rk * bf2f((bf16)(vx >> 48))) * bf2f((bf16)(gx >> 48));
                *(unsigned long long*)(O + m * D_ + 512 + v) = pack4(o); }
        }
    }
}

__device__ __forceinline__ void ph_convfix(const Ctx& C, const float* HALO, const float* FIXU, const float* cw, const float* cb, bf16* ACT) {
    for (int idx = C.bid * NT + C.tid; idx < 128 * 22 * 2 * 128; idx += C.nb * NT) {
        const int j = idx & 127, rr = (idx >> 7) & 1, tile = idx >> 8, pm = tile / 22, pn = tile % 22;
        const bool seq0 = (pm & 31) == 0;
        const float* fx = FIXU + (size_t)tile * 512; const float* hl = HALO + (size_t)(tile - 22) * 512;
        const float u0g = fx[rr * 256 + j], u0v = fx[rr * 256 + 128 + j];
        float u1g, u1v, u2g, u2v;
        if (rr == 0) { u1g = seq0 ? 0.f : hl[256 + j]; u1v = seq0 ? 0.f : hl[256 + 128 + j]; u2g = seq0 ? 0.f : hl[j]; u2v = seq0 ? 0.f : hl[128 + j]; }
        else { u1g = fx[j]; u1v = fx[128 + j]; u2g = seq0 ? 0.f : hl[256 + j]; u2v = seq0 ? 0.f : hl[256 + 128 + j]; }
        const int jg = pn * 128 + j, jv = DFF + jg;
        const float gc = cb[jg] + cw[jg] * u2g + cw[NUP + jg] * u1g + cw[2 * NUP + jg] * u0g, vc = cb[jv] + cw[jv] * u2v + cw[NUP + jv] * u1v + cw[2 * NUP + jv] * u0v;
        ACT[(size_t)(pm * 256 + rr) * DFF + jg] = (bf16)f2bf(siluf_(gc) * vc);
    }
}
}

namespace pg8 {
struct EpiRes {
    static constexpr bool PERM = false, AFTER_DRAIN = false;
    const float* base; float* out; const float* gate; int gstride;
    __device__ __forceinline__ void operator()(const f32x4 (&acc)[2][2][4][2], const Unit& u, int wr, int wc, int fr, int fq) const {
        const int b = (u.pm * BM) / 8192; const float* gp = gate + (size_t)b * gstride;
        const int col0 = u.pn * BM + wc * 32 + 4 * fq;
        f32x4 gv[2][2];
#pragma unroll
        for (int bj = 0; bj < 2; ++bj)
#pragma unroll
            for (int n = 0; n < 2; ++n) gv[bj][n] = *(const f32x4*)(gp + col0 + bj * HALF + n * 16);
#pragma unroll
        for (int ai = 0; ai < 2; ++ai)
#pragma unroll
            for (int m = 0; m < 4; ++m) { const size_t off = (size_t)(u.pm * BM + ai * HALF + wr * 64 + m * 16 + fr) * 1024 + col0;
                f32x4 bs[2][2];
#pragma unroll
                for (int bj = 0; bj < 2; ++bj)
#pragma unroll
                    for (int n = 0; n < 2; ++n) bs[bj][n] = *(const f32x4*)(base + off + bj * HALF + n * 16);
#pragma unroll
                for (int bj = 0; bj < 2; ++bj)
#pragma unroll
                    for (int n = 0; n < 2; ++n) *(f32x4*)(out + off + bj * HALF + n * 16) = bs[bj][n] + gv[bj][n] * acc[ai][bj][m][n]; }
    }
};

template <bool BASE32> struct EpiResB {
    static constexpr bool PERM = true, AFTER_DRAIN = false;
    const float* base32; bf16_t* R; const float* gate; int gstride;
    __device__ __forceinline__ void operator()(const f32x4 (&acc)[2][2][4][2], const Unit& u, int wr, int wc, int fr, int fq) const {
        const int b = u.pm >> 5; const float* gp = gate + (size_t)b * gstride;
        const int col0 = u.pn * BM + wc * 32 + 8 * fq;
        f32x4 gv[2][2];
#pragma unroll
        for (int bj = 0; bj < 2; ++bj)
#pragma unroll
            for (int n = 0; n < 2; ++n) gv[bj][n] = *(const f32x4*)(gp + col0 + bj * HALF + n * 4);
#pragma unroll
        for (int ai = 0; ai < 2; ++ai)
#pragma unroll
            for (int m = 0; m < 4; ++m) { const size_t off = (size_t)(u.pm * BM + ai * HALF + wr * 64 + m * 16 + fr) * 1024 + col0;
                f32x4 bs[2][2];
#pragma unroll
                for (int bj = 0; bj < 2; ++bj) {
                    if (BASE32) { bs[bj][0] = *(const f32x4*)(base32 + off + bj * HALF); bs[bj][1] = *(const f32x4*)(base32 + off + bj * HALF + 4); }
                    else { const u32x4 r = *(const u32x4*)(R + off + bj * HALF);
                        bs[bj][0] = (f32x4){__builtin_bit_cast(float, r.x << 16), __builtin_bit_cast(float, r.x & 0xffff0000u), __builtin_bit_cast(float, r.y << 16), __builtin_bit_cast(float, r.y & 0xffff0000u)};
                        bs[bj][1] = (f32x4){__builtin_bit_cast(float, r.z << 16), __builtin_bit_cast(float, r.z & 0xffff0000u), __builtin_bit_cast(float, r.w << 16), __builtin_bit_cast(float, r.w & 0xffff0000u)}; } }
#pragma unroll
                for (int bj = 0; bj < 2; ++bj) { const f32x4 o0 = bs[bj][0] + gv[bj][0] * acc[ai][bj][m][0], o1 = bs[bj][1] + gv[bj][1] * acc[ai][bj][m][1];
                    u32x4 w; w.x = cvt_pk_bf16(o0.x, o0.y); w.y = cvt_pk_bf16(o0.z, o0.w); w.z = cvt_pk_bf16(o1.x, o1.y); w.w = cvt_pk_bf16(o1.z, o1.w);
                    *(u32x4*)(R + off + bj * HALF) = w; } }
    }
};
struct EpiConv {
    static constexpr bool PERM = true, AFTER_DRAIN = false;
    bf16_t* ACT; const float* cw; const float* cb; float* HALO; float* FIXU; PG8_LAS float* EX; int nN;
    template <int CTRL> static __device__ __forceinline__ float rot(float x) { return __builtin_bit_cast(float, __builtin_amdgcn_update_dpp(0, __builtin_bit_cast(int, x), CTRL, 0xf, 0xf, false)); }
    template <int CTRL> static __device__ __forceinline__ f32x4 rot4(f32x4 x) { return (f32x4){rot<CTRL>(x.x), rot<CTRL>(x.y), rot<CTRL>(x.z), rot<CTRL>(x.w)}; }
    __device__ __forceinline__ void operator()(const f32x4 (&acc)[2][2][4][2], const Unit& u, int wr, int wc, int fr, int fq) const {
        const int colw = wc * 32 + 8 * fq, tile = u.pm * nN + u.pn;
        if (fr >= 14) {
#pragma unroll
            for (int ai = 0; ai < 2; ++ai)
#pragma unroll
                for (int bj = 0; bj < 2; ++bj)
#pragma unroll
                    for (int n = 0; n < 2; ++n) { *(PG8_LAS f32x4*)(EX + ((ai * 2 + wr) * 2 + (fr - 14)) * 256 + bj * 128 + colw + 4 * n) = acc[ai][bj][3][n];
                        if (ai == 1 && wr == 1) *(f32x4*)(HALO + ((size_t)tile * 2 + (fr - 14)) * 256 + bj * 128 + colw + 4 * n) = acc[1][bj][3][n]; }
        }
        if (fr < 2 && wr == 0) {
#pragma unroll
            for (int bj = 0; bj < 2; ++bj)
#pragma unroll
                for (int n = 0; n < 2; ++n) *(f32x4*)(FIXU + ((size_t)tile * 2 + fr) * 256 + bj * 128 + colw + 4 * n) = acc[0][bj][0][n];
        }
        asm volatile("s_waitcnt lgkmcnt(0)" ::: "memory"); __builtin_amdgcn_s_barrier(); asm volatile("" ::: "memory");
#pragma unroll
        for (int n = 0; n < 2; ++n) {
            const int jg = u.pn * 128 + colw + 4 * n, jv = 2816 + jg;
            f32x4 cw0[2], cw1[2], cw2[2], cbb[2];
            cw0[0] = *(const f32x4*)(cw + jg); cw1[0] = *(const f32x4*)(cw + 5632 + jg); cw2[0] = *(const f32x4*)(cw + 2 * 5632 + jg); cbb[0] = *(const f32x4*)(cb + jg);
            cw0[1] = *(const f32x4*)(cw + jv); cw1[1] = *(const f32x4*)(cw + 5632 + jv); cw2[1] = *(const f32x4*)(cw + 2 * 5632 + jv); cbb[1] = *(const f32x4*)(cb + jv);
#pragma unroll
            for (int ai = 0; ai < 2; ++ai)
#pragma unroll
                for (int m = 0; m < 4; ++m) {
                    const int src = ai * 2 + wr - 1;
                    f32x4 res[2];
#pragma unroll
                    for (int bj = 0; bj < 2; ++bj) {
                        const f32x4 x = acc[ai][bj][m][n];
                        f32x4 x1 = rot4<0x121>(x), x2 = rot4<0x122>(x);
                        if (m > 0) { const f32x4 q = acc[ai][bj][m > 0 ? m - 1 : 0][n]; const f32x4 q1 = rot4<0x121>(q), q2 = rot4<0x122>(q);
                            if (fr == 0) x1 = q1; if (fr < 2) x2 = q2; }
                        else if (fr < 2) { f32x4 e14 = {0.f, 0.f, 0.f, 0.f}, e15 = e14;
                            if (src >= 0) { e14 = *(const PG8_LAS f32x4*)(EX + (src * 2 + 0) * 256 + bj * 128 + colw + 4 * n); e15 = *(const PG8_LAS f32x4*)(EX + (src * 2 + 1) * 256 + bj * 128 + colw + 4 * n); }
                            if (fr == 0) { x1 = e15; x2 = e14; } else x2 = e15; }
                        const f32x4 w0 = cw0[bj], w1 = cw1[bj], w2 = cw2[bj], bb = cbb[bj];
                        res[bj] = bb + w0 * x2 + w1 * x1 + w2 * x;
                    }
                    const f32x4 gc = res[0], vc = res[1];
                    f32x4 o;
                    o.x = gc.x * __builtin_amdgcn_rcpf(1.f + __expf(-gc.x)) * vc.x; o.y = gc.y * __builtin_amdgcn_rcpf(1.f + __expf(-gc.y)) * vc.y;
                    o.z = gc.z * __builtin_amdgcn_rcpf(1.f + __expf(-gc.z)) * vc.z; o.w = gc.w * __builtin_amdgcn_rcpf(1.f + __expf(-gc.w)) * vc.w;
                    typedef unsigned u32x2 __attribute__((ext_vector_type(2)));
                    u32x2 w; w.x = cvt_pk_bf16(o.x, o.y); w.y = cvt_pk_bf16(o.z, o.w);
                    *(u32x2*)(ACT + (size_t)(u.pm * BM + ai * HALF + wr * 64 + m * 16 + fr) * 2816 + u.pn * 128 + colw + 4 * n) = w;
                }
        }
    }
};
}

namespace hy {
struct Args { const float* in[31]; float* out; unsigned char* ws; };
__global__ void __launch_bounds__(NT, 2) hy_fwd(Args A) {
    extern __shared__ __attribute__((aligned(16))) unsigned char lds_raw[];
    Ctx C; C.bid = blockIdx.x; C.nb = gridDim.x; C.tid = threadIdx.x; C.lane = C.tid & 63; C.wave = __builtin_amdgcn_readfirstlane(C.tid >> 6); C.lds = (LAS unsigned char*)lds_raw;
    volatile LAS unsigned* MISC = (volatile LAS unsigned*)(C.lds + MISC_OFF);
    for (int u = C.tid; u < (LDS_BYTES - MISC_OFF) / 4; u += NT) ((LAS unsigned*)(C.lds + MISC_OFF))[u] = 0u;
    __syncthreads();
    unsigned char* ws = A.ws;
    const int wave0 = __builtin_amdgcn_readfirstlane(threadIdx.x >> 6);
    (void)xcd_barrier_post((unsigned*)(ws + WS_CTL) + CW_BAR, MISC + 8);
#define PHASE_BEGIN() do { int t_ = wave0 * 64 + lane_now(); int b_ = blockIdx.x; asm volatile("" : "+s"(b_)); \
    C.tid = t_; C.lane = t_ & 63; C.wave = __builtin_amdgcn_readfirstlane(t_ >> 6); C.bid = b_; } while (0)
#ifdef HY_DIAG
    unsigned long long ts_last = __builtin_amdgcn_s_memrealtime(); float tacc[10] = {0.f, 0.f, 0.f, 0.f, 0.f, 0.f, 0.f, 0.f, 0.f, 0.f};
#define GRID_BAR(cat) do { { XcdBarrier b_; b_.bar = (unsigned*)(A.ws + WS_CTL) + CW_BAR; b_.x = xb_xcc_id(); b_.st = (volatile LAS unsigned*)(C.lds + MISC_OFF) + 8; xcd_barrier(b_, wave0 == 0 && lane_now() == 0); } PHASE_BEGIN(); { const unsigned long long n_ = __builtin_amdgcn_s_memrealtime(); tacc[cat] += (float)(n_ - ts_last); ts_last = n_; } } while (0)
#else
#define GRID_BAR(cat) do { { XcdBarrier b_; b_.bar = (unsigned*)(A.ws + WS_CTL) + CW_BAR; b_.x = xb_xcc_id(); b_.st = (volatile LAS unsigned*)(C.lds + MISC_OFF) + 8; xcd_barrier(b_, wave0 == 0 && lane_now() == 0); } PHASE_BEGIN(); } while (0)
#endif
#ifndef HY_REPCAT
#define HY_REPCAT (-1)
#endif
#define NREP(cat) ((HY_REPCAT == (cat)) ? 2 : 1)
    float* out = A.out;
    bf16* RES = (bf16*)((unsigned char*)A.out + 64 * MiB);
#define in A.in
    float* MOD = (float*)(ws + WS_MOD);
    bf16 *WIN = (bf16*)(ws + WS_WIN), *WOUT = (bf16*)(ws + WS_WOUT), *WUP = (bf16*)(ws + WS_WUP), *WDN = (bf16*)(ws + WS_WDN);
    bf16 *XB = (bf16*)(ws + WS_XB), *O = (bf16*)(ws + WS_O), *VF = (bf16*)(ws + WS_VF), *PG = (bf16*)(ws + WS_PG), *PR = (bf16*)(ws + WS_PR), *VL = (bf16*)(ws + WS_VL);
    bf16 *RH = (bf16*)(ws + WS_RH), *YH = (bf16*)(ws + WS_YH), *PP = (bf16*)(ws + WS_PP), *QQ = (bf16*)(ws + WS_QQ), *GG = (bf16*)(ws + WS_GG), *S0 = (bf16*)(ws + WS_S0);
    float *GAMC = (float*)(ws + WS_GAMC), *RK = (float*)(ws + WS_RK);
    bf16* LORA = (bf16*)(ws + WS_LORA);
    bf16* DS = (bf16*)(ws + WS_GK); float* GAM = (float*)(ws + WS_GAM);
    bf16* ACT = (bf16*)(ws + WS_ACT); float *HALO = (float*)(ws + WS_U), *FIXU = (float*)(ws + WS_U + 8 * MiB);

    ph_mod(C, in[1], in[2], in[3], MOD);
    for (int l = 0; l < L_; ++l) {
        const float* modl = MOD + (size_t)l * 4 * 6144;
        for (int r_ = 0; r_ < NREP(0); ++r_) {
        wprep_mat(C, in[5] + (size_t)l * D_ * IN_COLS, D_, IN_COLS, NIN, WIN, 1, l ? in[6] : nullptr);
        wprep_mat(C, in[24] + (size_t)l * D_ * D_, D_, D_, D_, WOUT, 0, nullptr);
        wprep_mat(C, in[26] + (size_t)l * D_ * NUP, D_, NUP, NUP, WUP, 2, nullptr);
        wprep_mat(C, in[29] + (size_t)l * DFF * D_, DFF, D_, D_, WDN, 0, nullptr);
        wprep_mat(C, in[12] + (size_t)l * 64 * 512, 64, 512, 512, LORA, 0, nullptr);
        wprep_mat(C, in[14] + (size_t)l * 64 * 512, 64, 512, 512, LORA + 512 * 64, 0, nullptr);
        wprep_mat(C, in[16] + (size_t)l * 128 * 512, 128, 512, 512, LORA + 2 * 512 * 64, 0, nullptr);
        if (l) wprep_mat(C, in[17], 32, 512, 512, LORA + 2 * 512 * 64 + 512 * 128, 0, nullptr);
        }
        GRID_BAR(0);
        for (int r_ = 0; r_ < NREP(1); ++r_) { if (l == 0) ph_norm(C, in[0], in[4], modl + 0 * D_, modl + 1 * D_, XB); else ph_norm_b(C, RES, in[4] + l * D_, modl + 0 * D_, modl + 1 * D_, XB); }
        GRID_BAR(1);
        for (int r_ = 0; r_ < NREP(2); ++r_) { pg8::Gemm g{XB, WIN, M_, NIN, D_}; pg8::StaticOrder S; S.init(M_, NIN, C.nb, C.bid);
          pg8::EpiBf16<0> E{PG, NPG, nullptr, NPG, (WS_PR - WS_PG) / 2, 1.f};
          pg8::gemm_phase<pg8::EpiBf16<0>, pg8::StaticOrder, true, true>(C.lds, g, S, E, C.tid); }
        GRID_BAR(2);
        for (int r_ = 0; r_ < NREP(3); ++r_) {
        ph_gla_a(C, PG, in[7] + l * 16 * 256, in[8] + l * 256, DS, GAM);
        { RwkvW W{in[10] + l * 1792, in[11], in[13] + l * 512, in[15] + l * 512, in[18], in[19] + l * 512, in[20] + l * 512, in[21] + l * 512,
                  LORA, LORA + 512 * 64, LORA + 2 * 512 * 64, LORA + 2 * 512 * 64 + 512 * 128};
          ph_rwkv_a(C, PR, PG, W, l, PP, QQ, RH, YH, GAMC, RK, GG, VF, r_ == NREP(3) - 1); } }
        GRID_BAR(3);
        if (C.bid < 32) { for (int r_ = 0; r_ < NREP(4); ++r_) ph_rwkv_b(C, C.bid, PP, QQ, GAMC, S0); }
        else { Ctx C2 = C; C2.bid = C.bid - 32; C2.nb = C.nb - 32;
               ph_gla_b(C2, DS, GAM);
               group_barrier((unsigned*)(ws + WS_CTL) + 2048, (unsigned)(C.nb - 32) * (unsigned)(l + 1), wave0 == 0 && lane_now() == 0);
               PHASE_BEGIN(); C2 = C; C2.bid = C.bid - 32; C2.nb = C.nb - 32;
               ph_gla_c(C2, PG, in[7] + l * 16 * 256, in[8] + l * 256, in[9] + l * 128, DS, O); }
        GRID_BAR(4);
        for (int r_ = 0; r_ < NREP(5); ++r_) {
        ph_rwkv_c(C, S0, RH, YH, RK, GG, VF, in[22] + l * 512, in[23] + l * 512, O); }
        GRID_BAR(5);
        { pg8::Gemm g{O, WOUT, M_, D_, D_}; pg8::StaticOrder S; S.init(M_, D_, C.nb, C.bid);
          if (l == 0) { pg8::EpiResB<true> E{in[0], RES, modl + 2 * D_, 6144}; pg8::gemm_phase<pg8::EpiResB<true>, pg8::StaticOrder, true, true>(C.lds, g, S, E, C.tid); }
          else { pg8::EpiResB<false> E{nullptr, RES, modl + 2 * D_, 6144}; pg8::gemm_phase<pg8::EpiResB<false>, pg8::StaticOrder, true, true>(C.lds, g, S, E, C.tid); } }
        GRID_BAR(6);
        for (int r_ = 0; r_ < NREP(1); ++r_) ph_norm_b(C, RES, in[25] + l * D_, modl + 3 * D_, modl + 4 * D_, XB);
        GRID_BAR(1);
        for (int r_ = 0; r_ < NREP(7); ++r_) { pg8::Gemm g{XB, WUP, M_, NUP, D_}; pg8::StaticOrder S; S.init(M_, NUP, C.nb, C.bid);
          pg8::EpiConv E{ACT, in[27] + (size_t)l * 3 * NUP, in[28] + (size_t)l * NUP, HALO, FIXU, (PG8_LAS float*)(C.lds + RING_BYTES), NUP / 256};
          pg8::gemm_phase<pg8::EpiConv, pg8::StaticOrder, true, true>(C.lds, g, S, E, C.tid); }
        GRID_BAR(7);
        for (int r_ = 0; r_ < NREP(8); ++r_) ph_convfix(C, HALO, FIXU, in[27] + (size_t)l * 3 * NUP, in[28] + (size_t)l * NUP, ACT);
        GRID_BAR(8);
        { pg8::Gemm g{ACT, WDN, M_, D_, DFF}; pg8::StaticOrder S; S.init(M_, D_, C.nb, C.bid);
          pg8::EpiResB<false> E{nullptr, RES, modl + 5 * D_, 6144};
          pg8::gemm_phase<pg8::EpiResB<false>, pg8::StaticOrder, true, true>(C.lds, g, S, E, C.tid); }
        GRID_BAR(9);
    }
    ph_final_b(C, RES, in[30], out, 0, M_ / 2, XB, M_ / 2, M_);
    GRID_BAR(1);
    ph_final_b(C, XB - (size_t)(M_ / 2) * D_, in[30], out, M_ / 2, M_, nullptr, 0, 0);
#ifdef HY_DIAG
    GRID_BAR(1);
    if (C.bid == 0) { if (C.tid == 0) out[0] = tacc[HY_DIAG_A] * 0.1f; for (int i = 1 + C.tid; i <= 10000; i += NT) out[i] = tacc[HY_DIAG_B] * 0.01f; }
#endif
#undef GRID_BAR
#undef PHASE_BEGIN
#undef in
}
}

extern "C" void kernel_launch(void* const* d_in, const int* in_sizes, int n_in, void* d_out, int out_size, void* d_ws, size_t ws_size, hipStream_t stream) {
    using namespace hy;
    static int grid = 0;
    if (grid == 0) {
        if (n_in != 31 || in_sizes[0] != M_ * D_ || out_size != M_ * D_ || ws_size < WS_END) { fprintf(stderr, "kernel_launch: unexpected shapes (n_in %d, in0 %d, out %d, ws %zu)\n", n_in, n_in > 0 ? in_sizes[0] : -1, out_size, ws_size); grid = -1; return; }
        if (hipFuncSetAttribute((const void*)hy_fwd, hipFuncAttributeMaxDynamicSharedMemorySize, LDS_BYTES) != hipSuccess) { fprintf(stderr, "kernel_launch: hipFuncSetAttribute failed\n"); grid = -1; return; }
        int dev = 0, cus = 0, per_cu = 0;
        (void)hipGetDevice(&dev); (void)hipDeviceGetAttribute(&cus, hipDeviceAttributeMultiprocessorCount, dev);
        (void)hipOccupancyMaxActiveBlocksPerMultiprocessor(&per_cu, (const void*)hy_fwd, NT, LDS_BYTES);
        if (per_cu < 1) fprintf(stderr, "kernel_launch: occupancy query reports %d blocks per CU\n", per_cu);
        (void)hipGetLastError();
        grid = cus > 0 ? cus : 256;
    }
    if (grid < 0) return;
    (void)hipMemsetAsync((char*)d_ws + WS_CTL, 0, CTL_ZERO_BYTES, stream);
    Args a{};
    for (int i = 0; i < 31; ++i) a.in[i] = (const float*)d_in[i];
    a.out = (float*)d_out; a.ws = (unsigned char*)d_ws;
    hipLaunchKernelGGL(hy_fwd, dim3(grid), dim3(NT), LDS_BYTES, stream, a);
}
```

```cpp
#include <hip/hip_runtime.h>
#include <cstdio>
#include <cstdint>
namespace pg8 {
#define PG8_LAS __attribute__((address_space(3)))
typedef unsigned short bf16_t;
typedef short bf16x8 __attribute__((ext_vector_type(8)));
typedef float f32x4 __attribute__((ext_vector_type(4)));
typedef unsigned u32x4 __attribute__((ext_vector_type(4)));
constexpr int BM = 256, BK = 64, HALF = 128, HTB = HALF * BK * 2  , STAGE_BYTES = 8 * HTB, NXCD = 8;

__host__ __device__ __forceinline__ int lds_byte(int r, int c) { const int st = (r >> 4) * 2 + (c >> 5), rr = r & 15, cc = c & 31, ob = rr * 64 + cc * 2; return st * 1024 + (ob ^ (((ob >> 9) & 1) << 5)); }
__host__ __device__ __forceinline__ void stage_rc(int b, int& R, int& C) { const int st = b / 1024, sb = b % 1024, swz = sb ^ (((sb >> 9) & 1) << 5); R = (st >> 1) * 16 + swz / 64; C = (st & 1) * 32 + (swz % 64) / 2; }
__host__ __device__ __forceinline__ int perm32(int rho) { const int n = rho >> 4, i = rho & 15; return 8 * (i >> 2) + 4 * n + (i & 3); }

struct Unit { int pm, pn; };
struct Gemm { const bf16_t* A; const bf16_t* Bt; int M, N, K; size_t bstride; };

struct StaticOrder {
    int nM, nN, nwg, G, c, WGM;
    __host__ __device__ void init(int M, int N, int G_, int c_, int wgm = 2) { nM = M / BM; nN = N / BM; nwg = nM * nN; G = G_; c = c_; WGM = wgm; }
    __host__ __device__ bool next(int i, Unit& u) const {
        const long L = (long)i * G + c; if (L >= nwg) return false;
        int wgid = (int)L; { const int q = nwg / NXCD, r = nwg % NXCD, xcd = wgid % NXCD, off = wgid / NXCD; wgid = (xcd < r ? xcd * (q + 1) : r * (q + 1) + (xcd - r) * q) + off; }
        const int nig = WGM * nN, gid = wgid / nig, fm = gid * WGM, gsz = (nM - fm) < WGM ? (nM - fm) : WGM;
        u.pm = fm + ((wgid % nig) % gsz); u.pn = (wgid % nig) / gsz; return true;
    }
    __device__ __forceinline__ void a_ready(const Unit&) const {}
    __device__ __forceinline__ void done(const Unit&) const {}
};

__device__ __forceinline__ unsigned cvt_pk_bf16(float lo, float hi) { unsigned r; asm volatile("v_cvt_pk_bf16_f32 %0, %1, %2" : "=v"(r) : "v"(lo), "v"(hi)); return r; }
typedef float f32x2 __attribute__((ext_vector_type(2)));
__device__ __forceinline__ f32x2 gelu_pk(f32x2 v) {
    const f32x2 av = __builtin_elementwise_abs(v), d = av * 0.2316418882f + 1.0f;
    f32x2 t; t.x = __builtin_amdgcn_rcpf(d.x); t.y = __builtin_amdgcn_rcpf(d.y);
    f32x2 q = t * 0.5307027145f + (-0.7265760135f); q = q * t + 0.7107068705f; q = q * t + (-0.142248368f); q = q * t + 0.127414796f; q = q * t;
    const f32x2 s = (v * v) * (-0.72134752044f);
    f32x2 e; e.x = __builtin_amdgcn_exp2f(s.x); e.y = __builtin_amdgcn_exp2f(s.y);
    const f32x2 m = v * (q * e), r = v - m;
    f32x2 o; o.x = v.x < 0.f ? m.x : r.x; o.y = v.y < 0.f ? m.y : r.y; return o;
}

template <int ACT  > struct EpiBf16 {
    static constexpr bool PERM = true, AFTER_DRAIN = false; static_assert(ACT == 0 || ACT == 1, "EpiBf16: ACT is 0 (none) or 1 (gelu_pk)");
    bf16_t* O; int ldc; const float* bias; int split_cols; size_t split_stride; float scale0;
    __device__ __forceinline__ void operator()(const f32x4 (&acc)[2][2][4][2], const Unit& u, int wr, int wc, int fr, int fq) const {
        const int row0 = u.pm * BM + wr * 64 + fr; int colt = u.pn * BM; bf16_t* base = O;
        float sc = 1.f; if (split_cols) { const int t = colt / split_cols; base += (size_t)t * split_stride; colt -= t * split_cols; if (t == 0) sc = scale0; }
        const int col0 = colt + wc * 32 + 8 * fq, bcol0 = u.pn * BM + wc * 32 + 8 * fq;
        f32x4 bv[2][2];
#pragma unroll
        for (int bj = 0; bj < 2; ++bj)
#pragma unroll
            for (int n = 0; n < 2; ++n) bv[bj][n] = bias ? *(const f32x4*)(bias + bcol0 + bj * HALF + 4 * n) : (f32x4){0.f, 0.f, 0.f, 0.f};
#pragma unroll
        for (int ai = 0; ai < 2; ++ai)
#pragma unroll
            for (int m = 0; m < 4; ++m) { bf16_t* rowp = base + (size_t)(row0 + ai * HALF + m * 16) * ldc + col0;
#pragma unroll
                for (int bj = 0; bj < 2; ++bj) { f32x4 v0 = acc[ai][bj][m][0] + bv[bj][0], v1 = acc[ai][bj][m][1] + bv[bj][1];
                    if (ACT == 1) { f32x2 a = gelu_pk((f32x2){v0[0], v0[1]}), b = gelu_pk((f32x2){v0[2], v0[3]}), c = gelu_pk((f32x2){v1[0], v1[1]}), d = gelu_pk((f32x2){v1[2], v1[3]});
                        v0 = (f32x4){a.x, a.y, b.x, b.y}; v1 = (f32x4){c.x, c.y, d.x, d.y}; }
                    v0 = v0 * sc; v1 = v1 * sc; u32x4 w; w.x = cvt_pk_bf16(v0[0], v0[1]); w.y = cvt_pk_bf16(v0[2], v0[3]); w.z = cvt_pk_bf16(v1[0], v1[1]); w.w = cvt_pk_bf16(v1[2], v1[3]);
                    *(u32x4*)(rowp + bj * HALF) = w; } }
    }
};
template <class Epi, class Sched, bool ALIGN_EPI = false, bool SP2 = false>
__device__ __forceinline__ void gemm_phase(PG8_LAS unsigned char* lds, const Gemm g, const Sched& S, const Epi& E, int tid_in) {
    int tid_ = tid_in; asm volatile("" : "+v"(tid_));
    const int tid = tid_, wid = __builtin_amdgcn_readfirstlane(tid >> 6), lane = tid & 63, wr = wid >> 2, wc = wid & 3, fr = lane & 15, fq = lane >> 4;
    const int K = g.K, nt = K / BK;
    unsigned voffA[2], voffB[2];
#pragma unroll
    for (int i = 0; i < 2; ++i) { int R, C; stage_rc(tid * 16 + i * 8192, R, C); const int Rb = Epi::PERM ? ((R & ~31) + perm32(R & 31)) : R;
        voffA[i] = (unsigned)(R * K + C) * 2u; voffB[i] = (unsigned)(Rb * K + C) * 2u; }
    const size_t kstep = (size_t)(BK * 2);
    const size_t hstep = (size_t)HALF * K * 2;
    const size_t tstep = 2 * hstep;
    const unsigned ldsw = (unsigned)wid * 1024u;
    const int aoff = lds_byte(wr * 64 + fr, fq * 8), boff = lds_byte(wc * 32 + fr, fq * 8);
#define PG8_SA(b, h) (((b) * 2 + (h)) * HTB)
#define PG8_SB(b, h) ((4 + (b) * 2 + (h)) * HTB)
#define PG8_STAGE(bufoff, gbase, voff) do { _Pragma("unroll") for (int _i = 0; _i < 2; ++_i) \
        __builtin_amdgcn_global_load_lds((const unsigned*)((const char*)(gbase) + (voff)[_i]), (PG8_LAS unsigned*)(lds + (bufoff) + ldsw + _i * 8192), 16, 0, 0); } while (0)
#define PG8_LDA(dst, b, h) do { _Pragma("unroll") for (int m = 0; m < 4; ++m) _Pragma("unroll") for (int k = 0; k < 2; ++k) dst[m][k] = *(const PG8_LAS bf16x8*)(lds + PG8_SA(b, h) + aoff + m * 2048 + k * 1024); } while (0)
#define PG8_LDB(dst, b, h) do { _Pragma("unroll") for (int n = 0; n < 2; ++n) _Pragma("unroll") for (int k = 0; k < 2; ++k) dst[n][k] = *(const PG8_LAS bf16x8*)(lds + PG8_SB(b, h) + boff + n * 2048 + k * 1024); } while (0)
#define PG8_MMA(ai, bj, At, Bt) do { __builtin_amdgcn_s_setprio(1); _Pragma("unroll") for (int m = 0; m < 4; ++m) _Pragma("unroll") for (int n = 0; n < 2; ++n) _Pragma("unroll") for (int k = 0; k < 2; ++k) \
        acc[ai][bj][m][n] = __builtin_amdgcn_mfma_f32_16x16x32_bf16(Bt[n][k], At[m][k], acc[ai][bj][m][n], 0, 0, 0); __builtin_amdgcn_s_setprio(0); } while (0)
#define PG8_WAIT_V(n) asm volatile("s_waitcnt vmcnt(" #n ")" ::: "memory")
#define PG8_WAIT_L(n) asm volatile("s_waitcnt lgkmcnt(" #n ")" ::: "memory")
#define PG8_BAR __builtin_amdgcn_s_barrier()
#define PG8_SCHED __builtin_amdgcn_sched_barrier(0)
    Unit cur, nxt; int ui = 0;
    if (!S.next(0, cur)) return;
    f32x4 acc[2][2][4][2];
#pragma unroll
    for (int a = 0; a < 2; ++a)
#pragma unroll
        for (int b = 0; b < 2; ++b)
#pragma unroll
            for (int m = 0; m < 4; ++m)
#pragma unroll
                for (int n = 0; n < 2; ++n) acc[a][b][m][n] = (f32x4){0.f, 0.f, 0.f, 0.f};
    bf16x8 At[4][2], B0[2][2], B1[2][2];
    const char* cA = (const char*)g.A + (size_t)cur.pm * tstep; const char* cB = (const char*)g.Bt + (size_t)cur.pn * tstep + (size_t)(cur.pm >> 5) * g.bstride;
    S.a_ready(cur);
    if constexpr (SP2) {
        PG8_STAGE(PG8_SB(0, 0), cB, voffB); PG8_STAGE(PG8_SB(0, 1), cB + hstep, voffB); PG8_STAGE(PG8_SA(0, 0), cA, voffA); PG8_STAGE(PG8_SA(0, 1), cA + hstep, voffA);
        if (wr == 1) PG8_BAR;
        PG8_WAIT_V(2); PG8_BAR;
        PG8_STAGE(PG8_SB(1, 0), cB + kstep, voffB); PG8_STAGE(PG8_SA(1, 0), cA + kstep, voffA); PG8_STAGE(PG8_SB(1, 1), cB + hstep + kstep, voffB);
        PG8_WAIT_V(6); PG8_BAR;
    } else {
        PG8_STAGE(PG8_SB(0, 0), cB, voffB); PG8_STAGE(PG8_SA(0, 0), cA, voffA); PG8_STAGE(PG8_SB(0, 1), cB + hstep, voffB); PG8_STAGE(PG8_SA(0, 1), cA + hstep, voffA);
        if (wr == 1) PG8_BAR;
        PG8_WAIT_V(4); PG8_BAR;
        PG8_STAGE(PG8_SB(1, 0), cB + kstep, voffB); PG8_STAGE(PG8_SA(1, 0), cA + kstep, voffA); PG8_STAGE(PG8_SB(1, 1), cB + hstep + kstep, voffB);
        PG8_WAIT_V(6); PG8_BAR;
    }
    for (;;) {
        const bool has_next = S.next(ui + 1, nxt);
        const char* nA = has_next ? (const char*)g.A + (size_t)nxt.pm * tstep : cA; const char* nB = has_next ? (const char*)g.Bt + (size_t)nxt.pn * tstep + (size_t)(nxt.pm >> 5) * g.bstride : cB;
        for (int t = 0; t < nt; t += 2) {
            const bool last = (t == nt - 2);
            const char* a1 = cA + (size_t)(t + 1) * kstep;
            const char* a2 = last ? nA : cA + (size_t)(t + 2) * kstep; const char* b2 = last ? nB : cB + (size_t)(t + 2) * kstep;
            const char* a3 = a2 + kstep; const char* b3 = b2 + kstep;
            if (last && has_next) S.a_ready(nxt);
            if constexpr (SP2) {
            PG8_LDB(B0, 0, 0); PG8_LDB(B1, 0, 1); PG8_SCHED; PG8_LDA(At, 0, 0); PG8_STAGE(PG8_SA(1, 1), a1 + hstep, voffA);
            PG8_WAIT_V(8); PG8_WAIT_L(0); PG8_BAR; PG8_MMA(0, 0, At, B0); PG8_MMA(0, 1, At, B1); PG8_BAR; PG8_SCHED;
            PG8_LDA(At, 0, 1); PG8_STAGE(PG8_SB(0, 0), b2, voffB); PG8_STAGE(PG8_SB(0, 1), b2 + hstep, voffB); PG8_STAGE(PG8_SA(0, 0), a2, voffA);
            PG8_WAIT_V(8); PG8_WAIT_L(0); PG8_BAR; PG8_MMA(1, 0, At, B0); PG8_MMA(1, 1, At, B1); PG8_BAR; PG8_SCHED;
            PG8_LDB(B0, 1, 0); PG8_LDB(B1, 1, 1); PG8_SCHED; PG8_LDA(At, 1, 0); PG8_STAGE(PG8_SA(0, 1), a2 + hstep, voffA);
            PG8_WAIT_V(8); PG8_WAIT_L(0); PG8_BAR; PG8_MMA(0, 0, At, B0); PG8_MMA(0, 1, At, B1); PG8_BAR; PG8_SCHED;
            PG8_LDA(At, 1, 1); PG8_STAGE(PG8_SB(1, 0), b3, voffB); PG8_STAGE(PG8_SB(1, 1), b3 + hstep, voffB); PG8_STAGE(PG8_SA(1, 0), a3, voffA);
            PG8_WAIT_V(8); PG8_WAIT_L(0); PG8_BAR; PG8_MMA(1, 0, At, B0); PG8_MMA(1, 1, At, B1); PG8_BAR; PG8_SCHED;
            } else {
            PG8_LDB(B0, 0, 0); PG8_SCHED; PG8_LDA(At, 0, 0); PG8_STAGE(PG8_SA(1, 1), a1 + hstep, voffA);
            PG8_WAIT_L(8); PG8_BAR; PG8_WAIT_L(0); PG8_MMA(0, 0, At, B0); PG8_BAR; PG8_SCHED;
            PG8_LDB(B1, 0, 1); PG8_STAGE(PG8_SB(0, 0), b2, voffB);
            PG8_BAR; PG8_WAIT_L(0); PG8_MMA(0, 1, At, B1); PG8_BAR;
            PG8_LDA(At, 0, 1); PG8_STAGE(PG8_SA(0, 0), a2, voffA);
            PG8_BAR; PG8_WAIT_L(0); PG8_MMA(1, 0, At, B0); PG8_BAR; PG8_SCHED;
            PG8_STAGE(PG8_SB(0, 1), b2 + hstep, voffB);
            PG8_WAIT_V(6); PG8_BAR; PG8_MMA(1, 1, At, B1); PG8_BAR;
            PG8_LDB(B0, 1, 0); PG8_SCHED; PG8_LDA(At, 1, 0); PG8_STAGE(PG8_SA(0, 1), a2 + hstep, voffA);
            PG8_WAIT_L(8); PG8_BAR; PG8_WAIT_L(0); PG8_MMA(0, 0, At, B0); PG8_BAR; PG8_SCHED;
            PG8_LDB(B1, 1, 1); PG8_STAGE(PG8_SB(1, 0), b3, voffB);
            PG8_BAR; PG8_WAIT_L(0); PG8_MMA(0, 1, At, B1); PG8_BAR;
            PG8_LDA(At, 1, 1); PG8_STAGE(PG8_SA(1, 0), a3, voffA);
            PG8_BAR; PG8_WAIT_L(0); PG8_MMA(1, 0, At, B0); PG8_BAR; PG8_SCHED;
            PG8_STAGE(PG8_SB(1, 1), b3 + hstep, voffB);
            PG8_WAIT_V(6); PG8_BAR; PG8_MMA(1, 1, At, B1); PG8_BAR;
            }
        }
        if constexpr (ALIGN_EPI) { if (wr == 0) PG8_BAR; }
        if constexpr (!Epi::AFTER_DRAIN) { E(acc, cur, wr, wc, fr, fq); S.done(cur); }
        if (!has_next) break;
#pragma unroll
        for (int a = 0; a < 2; ++a)
#pragma unroll
            for (int b = 0; b < 2; ++b)
#pragma unroll
                for (int m = 0; m < 4; ++m)
#pragma unroll
                    for (int n = 0; n < 2; ++n) acc[a][b][m][n] = (f32x4){0.f, 0.f, 0.f, 0.f};
        cur = nxt; cA = nA; cB = nB; ++ui;
        if constexpr (ALIGN_EPI) { if (wr == 1) PG8_BAR; }
    }
    PG8_WAIT_V(0);
    if constexpr (!ALIGN_EPI) { if (wr == 0) PG8_BAR; }
    PG8_BAR;
    if constexpr (Epi::AFTER_DRAIN) { E.fused(acc, cur, wr, wc, fr, fq, lds, wid, lane); S.done(cur); }
#undef PG8_SA
#undef PG8_SB
#undef PG8_STAGE
#undef PG8_LDA
#undef PG8_LDB
#undef PG8_MMA
#undef PG8_WAIT_V
#undef PG8_WAIT_L
#undef PG8_BAR
#undef PG8_SCHED
}
}

#ifndef HY_WGM_IN
#define HY_WGM_IN 2
#endif
#ifndef HY_WGM_UP
#define HY_WGM_UP 2
#endif
namespace hy {
#define GAS __attribute__((address_space(1)))
#define LAS __attribute__((address_space(3)))
typedef unsigned short bf16;
typedef unsigned v4u __attribute__((ext_vector_type(4)));
typedef float f32x4 __attribute__((ext_vector_type(4)));
typedef short bf16x8 __attribute__((ext_vector_type(8)));
typedef GAS unsigned gu32;
typedef GAS unsigned long long gu64;
#define RLX_AGENT __ATOMIC_RELAXED, __HIP_MEMORY_SCOPE_AGENT
#define LDS_WAIT() asm volatile("s_waitcnt lgkmcnt(0)" ::: "memory")
#define VM_WAIT() asm volatile("s_waitcnt vmcnt(0)" ::: "memory")
__device__ __forceinline__ unsigned long long rt() { return __builtin_amdgcn_s_memrealtime(); }
typedef __bf16 hwbf2 __attribute__((ext_vector_type(2))); typedef float hwf2 __attribute__((ext_vector_type(2)));
__device__ __forceinline__ unsigned f2bf(float f) { return (unsigned)__builtin_bit_cast(unsigned short, (__bf16)f); }
__device__ __forceinline__ unsigned pk2(float lo, float hi) { const hwf2 v = {lo, hi}; return __builtin_bit_cast(unsigned, __builtin_convertvector(v, hwbf2)); }
#define XB_TMO      128
#define XB_XCNT(j)  (256  + 64 * (j))
#define XB_XSUB(j)  (1280 + 64 * (j))
#define XB_XGEN(j)  (2304 + 64 * (j))
#define XB_TOP      3328
#define XB_TOPGEN   3392
#define XCD_BAR_WORDS 3456
#define XB_SPIN_CAP (1u << 18)

__device__ __forceinline__ unsigned xb_ld(unsigned* p)              { return __hip_atomic_load(p, __ATOMIC_RELAXED, __HIP_MEMORY_SCOPE_AGENT); }
__device__ __forceinline__ unsigned xb_add(unsigned* p, unsigned v) { return __hip_atomic_fetch_add(p, v, __ATOMIC_RELAXED, __HIP_MEMORY_SCOPE_AGENT); }
__device__ __forceinline__ unsigned xb_xcc_id() { return (unsigned)__builtin_amdgcn_s_getreg((3 << 11) | 20) & 0xFu; }
#define XB_SPIN(cond, bar) do { unsigned _sp = 0; while (cond) { __builtin_amdgcn_s_sleep(1); \
    if ((++_sp & 255u) == 0u) { if (xb_ld(&(bar)[XB_TMO])) break; if (_sp > XB_SPIN_CAP) { atomicAdd(&(bar)[XB_TMO], 1u); break; } } } } while (0)

struct XcdBarrier {
    unsigned* bar; unsigned x;
    volatile LAS unsigned* st;
};

__device__ __forceinline__ XcdBarrier xcd_barrier_post(unsigned* bar, volatile LAS unsigned* st) {
    XcdBarrier b; b.bar = bar; b.x = xb_xcc_id(); b.st = st;
    if (threadIdx.x == 0) (void)xb_add(&bar[XB_XCNT(b.x)], 1u);
    return b;
}
__device__ __forceinline__ void xcd_barrier_complete(unsigned* bar, unsigned x, unsigned& nloc, unsigned& nx) {
    const unsigned G = gridDim.x * gridDim.y * gridDim.z;
    unsigned sum, cnt, mine, sp = 0u;
    for (;;) {
        sum = 0u; cnt = 0u; mine = 0u;
#pragma unroll
        for (unsigned j = 0; j < 16; ++j) { const unsigned c = xb_ld(&bar[XB_XCNT(j)]); sum += c; cnt += (c > 0u) ? 1u : 0u; mine = (j == x) ? c : mine; }
        if (sum == G) break;
        __builtin_amdgcn_s_sleep(1);
        if ((++sp & 255u) == 0u) { if (xb_ld(&bar[XB_TMO])) break; if (sp > XB_SPIN_CAP) { atomicAdd(&bar[XB_TMO], 1u); break; } }
    }
    nloc = mine > 0u ? mine : 1u; nx = cnt > 0u ? cnt : 1u;
}

__device__ __forceinline__ void xcd_barrier(const XcdBarrier& b, bool leader  ) {
    asm volatile("s_waitcnt vmcnt(0)" ::: "memory");
    __syncthreads();
    if (leader) {
        unsigned* bar = b.bar;
        __builtin_amdgcn_s_waitcnt(0);
        unsigned nloc = b.st[0], nx = b.st[1];
        if (nloc == 0u) { xcd_barrier_complete(bar, b.x, nloc, nx); b.st[0] = nloc; b.st[1] = nx; }
        const unsigned old = xb_add(&bar[XB_XSUB(b.x)], 1u);
        const unsigned gen = old / nloc;
        if (old + 1u == (gen + 1u) * nloc) {
            __builtin_amdgcn_fence(__ATOMIC_RELEASE, "agent");
            asm volatile("s_waitcnt vmcnt(0)" ::: "memory");
            const unsigned og = xb_add(&bar[XB_TOP], 1u);
            const unsigned tg = og / nx;
            if (og + 1u == (tg + 1u) * nx) xb_add(&bar[XB_TOPGEN], 1u);
            else XB_SPIN(xb_ld(&bar[XB_TOPGEN]) == tg, bar);
            __builtin_amdgcn_fence(__ATOMIC_ACQUIRE, "agent");
            xb_add(&bar[XB_XGEN(b.x)], 1u);
            asm volatile("s_waitcnt vmcnt(0)" ::: "memory");
        } else {
            XB_SPIN(xb_ld(&bar[XB_XGEN(b.x)]) == gen, bar);
            __builtin_amdgcn_fence(__ATOMIC_ACQUIRE, "agent");
            asm volatile("s_waitcnt vmcnt(0)" ::: "memory");
        }
    }
    __syncthreads();
}

constexpr int B_ = 4, T_ = 8192, D_ = 1024, M_ = B_ * T_, L_ = 2;
constexpr int NIN = 3584, NPG = 1792, NPR = 1792;
constexpr int DFF = 2816, NUP = 5632, IN_COLS = 3344;
constexpr size_t MiB = 1u << 20;
constexpr size_t WS_CTL = 0, CTL_ZERO_BYTES = 65536;
constexpr int CW_BAR = 4096;
constexpr size_t WS_RK = MiB / 4;
constexpr size_t WS_MOD = 3 * MiB / 2;
constexpr size_t WS_WIN = 2 * MiB, WS_WOUT = 9 * MiB, WS_WUP = 11 * MiB, WS_WDN = 22 * MiB, WS_LORA = 55 * MiB / 2, WS_GAMC = 28 * MiB, WS_VL = 29 * MiB;
constexpr size_t WS_GAM = 31 * MiB;
constexpr size_t WS_XB = 32 * MiB, WS_O = 336 * MiB  , WS_VF = 160 * MiB, WS_GK = 192 * MiB, WS_PG = 224 * MiB, WS_PR = 336 * MiB, WS_END = 512 * MiB;
constexpr size_t WS_RH = WS_XB, WS_YH = WS_XB + 32 * MiB, WS_PP = 96 * MiB, WS_QQ = 128 * MiB, WS_GG = 448 * MiB, WS_S0 = 480 * MiB;
constexpr size_t WS_ACT = 224 * MiB, WS_U = 400 * MiB;
constexpr int RING_BYTES = 131072, MISC_OFF = 161792, LDS_BYTES = 163840;
constexpr int NT = 512;

__device__ __forceinline__ float bf2f(bf16 h) { return __builtin_bit_cast(float, (unsigned)h << 16); }
__device__ __forceinline__ float sigmoidf_(float x) { return 1.f / (1.f + __expf(-x)); }
__device__ __forceinline__ float siluf_(float x) { return x / (1.f + __expf(-x)); }
__device__ __forceinline__ float softplusf_(float x) { return fmaxf(x, 0.f) + log1pf(__expf(-fabsf(x))); }

typedef unsigned u32x2 __attribute__((ext_vector_type(2)));
template <int CTRL> __device__ __forceinline__ float dpp_f(float v) {
    return __builtin_bit_cast(float, __builtin_amdgcn_update_dpp(0, __builtin_bit_cast(int, v), CTRL, 0xf, 0xf, false));
}
__device__ __forceinline__ float wave_sum(float v) {
    v += dpp_f<0xB1>(v);
    v += dpp_f<0x4E>(v);
    v += dpp_f<0x141>(v);
    v += dpp_f<0x140>(v);
    v += __builtin_bit_cast(float, __builtin_amdgcn_update_dpp(0, __builtin_bit_cast(int, v), 0x142, 0xa, 0xf, false));
    v += __builtin_bit_cast(float, __builtin_amdgcn_update_dpp(0, __builtin_bit_cast(int, v), 0x143, 0xc, 0xf, false));
    return __builtin_bit_cast(float, __builtin_amdgcn_readlane(__builtin_bit_cast(int, v), 63));
}

__device__ __forceinline__ int lane_now() { int l; asm volatile("v_mbcnt_lo_u32_b32 %0, -1, 0\n\tv_mbcnt_hi_u32_b32 %0, -1, %0" : "=v"(l)); return l; }
__device__ __forceinline__ float xsum4(float v) {
    const int l = lane_now();
    v += __builtin_bit_cast(float, __builtin_amdgcn_ds_bpermute((l ^ 16) << 2, __builtin_bit_cast(int, v)));
    v += __builtin_bit_cast(float, __builtin_amdgcn_ds_bpermute((l ^ 32) << 2, __builtin_bit_cast(int, v)));
    return v;
}
struct Ctx { int bid, nb, tid, lane, wave; LAS unsigned char* lds; };
__device__ __forceinline__ void group_barrier(unsigned* cnt, unsigned target, bool leader) {
    asm volatile("s_waitcnt vmcnt(0)" ::: "memory");
    __syncthreads();
    if (leader) {
        __builtin_amdgcn_fence(__ATOMIC_RELEASE, "agent");
        asm volatile("s_waitcnt vmcnt(0)" ::: "memory");
        (void)__hip_atomic_fetch_add(cnt, 1u, __ATOMIC_RELAXED, __HIP_MEMORY_SCOPE_AGENT);
        for (unsigned sp = 0; __hip_atomic_load(cnt, __ATOMIC_RELAXED, __HIP_MEMORY_SCOPE_AGENT) < target && sp < (1u << 22); ++sp) __builtin_amdgcn_s_sleep(2);
        __builtin_amdgcn_fence(__ATOMIC_ACQUIRE, "agent");
        asm volatile("s_waitcnt vmcnt(0)" ::: "memory");
    }
    __syncthreads();
}


__device__ __forceinline__ void ph_mod(const Ctx& C, const float* c, const float* ada_w, const float* ada_b, float* MOD) {
    LAS float* sc = (LAS float*)C.lds;
    LAS float* red = (LAS float*)(C.lds + 16384);
    for (int i = C.tid; i < 4096; i += NT) sc[i] = siluf_(c[i]);
    __syncthreads();
    for (int item = C.bid; item < 192; item += C.nb) {
        const int l = item / 96, j0 = (item % 96) * 64;
        const float* W = ada_w + (size_t)l * 1024 * 6144 + j0 + C.lane;
        float a0 = 0.f, a1 = 0.f, a2 = 0.f, a3 = 0.f;
        for (int k = C.wave * 128; k < C.wave * 128 + 128; ++k) { const float wv = W[(size_t)k * 6144]; a0 += sc[k] * wv; a1 += sc[1024 + k] * wv; a2 += sc[2048 + k] * wv; a3 += sc[3072 + k] * wv; }
        red[(C.wave * 4 + 0) * 64 + C.lane] = a0; red[(C.wave * 4 + 1) * 64 + C.lane] = a1; red[(C.wave * 4 + 2) * 64 + C.lane] = a2; red[(C.wave * 4 + 3) * 64 + C.lane] = a3;
        __syncthreads();
        if (C.wave < 4) { const int b = C.wave; float s = ada_b[l * 6144 + j0 + C.lane];
#pragma unroll
            for (int w = 0; w < 8; ++w) s += red[(w * 4 + b) * 64 + C.lane];
            MOD[((size_t)l * 4 + b) * 6144 + j0 + C.lane] = s; }
        __syncthreads();
    }
}

__device__ __forceinline__ void wprep_mat(const Ctx& C, const float* W, int K, int Nsrc, int Ndst, bf16* Wt, int mode, const float* vres) {
    const int half = C.tid >> 8, t = C.tid & 255, tx = t & 31, ty = t >> 5;
    LAS float* tile = (LAS float*)C.lds + half * (32 * 33);
    const int nbn = Ndst / 32, ntile = nbn * (K / 32);
    const int niter = (ntile + 2 * C.nb - 1) / (2 * C.nb);
    for (int it = 0; it < niter; ++it) {
        const int item = (it * C.nb + C.bid) * 2 + half;
        const bool act = item < ntile;
        const int n0 = (item % nbn) * 32, k0 = (item / nbn) * 32, n = n0 + tx;
        if (act) {
#pragma unroll
            for (int i = 0; i < 4; ++i) { const int k = k0 + ty + 8 * i; float v = 0.f;
                if (mode == 0) v = W[(size_t)k * Nsrc + n];
                else if (mode == 2) { const int tl = n >> 8, w = n & 255; v = W[(size_t)k * Nsrc + (w < 128 ? tl * 128 + w : 2816 + tl * 128 + (w - 128))]; }
                else { if (n < 1552) v = W[(size_t)k * Nsrc + n]; else if (n < 1584) v = vres ? vres[(size_t)k * 32 + (n - 1552)] : 0.f; else if (n < 1792) v = 0.f; else v = W[(size_t)k * Nsrc + (n - 240)]; }
                tile[(ty + 8 * i) * 33 + tx] = v; }
        }
        __syncthreads();
        if (act) {
#pragma unroll
            for (int i = 0; i < 4; ++i) { const int nn = n0 + ty + 8 * i; Wt[(size_t)nn * K + k0 + tx] = (bf16)f2bf(tile[tx * 33 + ty + 8 * i]); }
        }
        __syncthreads();
    }
}

__device__ __forceinline__ void ph_norm(const Ctx& C, const float* x, const float* g, const float* sh, const float* sc, bf16* XB) {
    const int gw = C.bid * 8 + C.wave, NGW = C.nb * 8, lane = C.lane;
    for (int m = gw; m < M_; m += NGW) {
        const int b = m / T_;
        const f32x4* xr = (const f32x4*)(x + (size_t)m * D_) + lane;
        f32x4 v[4]; float s = 0.f;
#pragma unroll
        for (int j = 0; j < 4; ++j) { v[j] = xr[64 * j]; s += (v[j].x * v[j].x + v[j].y * v[j].y) + (v[j].z * v[j].z + v[j].w * v[j].w); }
        const float rstd = 1.f / sqrtf(wave_sum(s) * (1.f / D_) + 1e-6f);
        unsigned long long* o8 = (unsigned long long*)(XB + (size_t)m * D_) + lane;
#pragma unroll
        for (int j = 0; j < 4; ++j) { const int col = 4 * lane + 256 * j;
            const f32x4 gv = *(const f32x4*)(g + col), shv = *(const f32x4*)(sh + b * 6144 + col), scv = *(const f32x4*)(sc + b * 6144 + col);
            const f32x4 h = v[j] * rstd * gv * (scv + 1.f) + shv;
            o8[64 * j] = (unsigned long long)pk2(h.x, h.y) | ((unsigned long long)pk2(h.z, h.w) << 32); }
    }
}
__device__ __forceinline__ void ph_final(const Ctx& C, float* x, const float* g) {
    const int gw = C.bid * 8 + C.wave, NGW = C.nb * 8, lane = C.lane;
    for (int m = gw; m < M_; m += NGW) {
        f32x4* xr = (f32x4*)(x + (size_t)m * D_) + lane;
        f32x4 v[4]; float s = 0.f;
#pragma unroll
        for (int j = 0; j < 4; ++j) { v[j] = xr[64 * j]; s += (v[j].x * v[j].x + v[j].y * v[j].y) + (v[j].z * v[j].z + v[j].w * v[j].w); }
        const float rstd = 1.f / sqrtf(wave_sum(s) * (1.f / D_) + 1e-6f);
#pragma unroll
        for (int j = 0; j < 4; ++j) { const f32x4 gv = *(const f32x4*)(g + 4 * lane + 256 * j); xr[64 * j] = v[j] * rstd * gv; }
    }
}


typedef short s16x8 __attribute__((ext_vector_type(8)));
__device__ __forceinline__ f32x4 mm16(const LAS bf16* A, int lda, const LAS bf16* B, int ldb, int K, f32x4 acc, int lane) {
    const int r = lane & 15, g = lane >> 4;
    const LAS bf16* ap = A + r * lda + 8 * g; const LAS bf16* bp = B + r * ldb + 8 * g;
    for (int k0 = 0; k0 < K; k0 += 32) { const s16x8 a = *(const LAS s16x8*)(ap + k0); const s16x8 b = *(const LAS s16x8*)(bp + k0); acc = __builtin_amdgcn_mfma_f32_16x16x32_bf16(a, b, acc, 0, 0, 0); }
    return acc;
}
__device__ __forceinline__ f32x4 mm16_ga(const bf16* A, int lda, const LAS bf16* B, int ldb, int K, f32x4 acc, int lane) {
    const int r = lane & 15, g = lane >> 4;
    const bf16* ap = A + r * lda + 8 * g; const LAS bf16* bp = B + r * ldb + 8 * g;
    for (int k0 = 0; k0 < K; k0 += 32) { const s16x8 a = *(const s16x8*)(ap + k0); const s16x8 b = *(const LAS s16x8*)(bp + k0); acc = __builtin_amdgcn_mfma_f32_16x16x32_bf16(a, b, acc, 0, 0, 0); }
    return acc;
}
__device__ __forceinline__ unsigned long long pack4(f32x4 v) { return (unsigned long long)pk2(v.x, v.y) | ((unsigned long long)pk2(v.z, v.w) << 32); }
__device__ __forceinline__ float logsigmoidf_(float x) { return fminf(x, 0.f) - __logf(1.f + __expf(-fabsf(x))); }

constexpr int GL_LD = 72;
constexpr int GL_GK = 0;
constexpr int GL_SEG = 16384;
constexpr int GL_Z = 18432;
constexpr int GL_GUP = 20480;
constexpr int GL_I0 = 24832;
constexpr int GL_I1 = GL_I0 + 9216;
constexpr int GL_I2 = GL_I1 + 9216;
constexpr int GL_VT = GL_I2 + 9216;
constexpr int GL_SSQ = GL_VT + 18432;
static_assert(GL_SSQ + 512 <= RING_BYTES, "GLA LDS map");

struct GlaRaw { v4u z, k, q, v0, v1; float g0, g1, gb; };
__device__ __forceinline__ void gla_fetch(GlaRaw& R, const Ctx& C, const bf16* pg, const float* gk_up, const float* gk_b, int h, bool want_q) {
    const int tid = C.tid, j = tid >> 3, d0 = (tid & 7) * 8, e0 = (tid & 7) * 16;
    R.z = (v4u){0u, 0u, 0u, 0u}; R.q = R.z;
    if (tid < 128) R.z = *(const v4u*)(pg + (size_t)(tid >> 1) * NPG + 1536 + (tid & 1) * 8);
    R.g0 = gk_up[(tid >> 6) * 256 + h * 64 + (tid & 63)]; R.g1 = gk_up[((tid + NT) >> 6) * 256 + h * 64 + (tid & 63)]; R.gb = gk_b[h * 64 + (tid & 63)];
    R.k = *(const v4u*)(pg + (size_t)j * NPG + 256 + h * 64 + d0);
    if (want_q) R.q = *(const v4u*)(pg + (size_t)j * NPG + h * 64 + d0);
    R.v0 = *(const v4u*)(pg + (size_t)j * NPG + 512 + h * 128 + e0); R.v1 = *(const v4u*)(pg + (size_t)j * NPG + 512 + h * 128 + e0 + 8);
}
__device__ __forceinline__ void gla_gates(const Ctx& C, const GlaRaw& R) {
    LAS float* GK = (LAS float*)(C.lds + GL_GK); LAS float* SEG = (LAS float*)(C.lds + GL_SEG); LAS bf16* Z = (LAS bf16*)(C.lds + GL_Z); LAS float* GUP = (LAS float*)(C.lds + GL_GUP);
    const int tid = C.tid;
    if (tid < 128) { const int t = tid >> 1, hh = tid & 1; *(LAS v4u*)(Z + t * 16 + hh * 8) = R.z; }
    GUP[tid] = R.g0; GUP[tid + NT] = R.g1;
    if (tid < 64) GUP[1024 + tid] = R.gb;
    __syncthreads();
    { const int t = tid >> 3, d0 = (tid & 7) * 8; float a[8];
#pragma unroll
      for (int q = 0; q < 8; ++q) a[q] = GUP[1024 + d0 + q];
#pragma unroll
      for (int i = 0; i < 16; ++i) { const float zv = bf2f(Z[t * 16 + i]);
#pragma unroll
          for (int q = 0; q < 8; ++q) a[q] += zv * GUP[i * 64 + d0 + q]; }
#pragma unroll
      for (int q = 0; q < 8; ++q) GK[t * 64 + d0 + q] = logsigmoidf_(a[q]) * (1.f / 16.f); }
    __syncthreads();
    { const int d = tid & 63, seg = tid >> 6; float run = 0.f;
#pragma unroll
      for (int q = 0; q < 8; ++q) { run += GK[(seg * 8 + q) * 64 + d]; GK[(seg * 8 + q) * 64 + d] = run; }
      SEG[seg * 64 + d] = run; }
    __syncthreads();
    { const int d = tid & 63, seg = tid >> 6; float off = 0.f;
      for (int s = 0; s < seg; ++s) off += SEG[s * 64 + d];
#pragma unroll
      for (int q = 0; q < 8; ++q) GK[(seg * 8 + q) * 64 + d] += off; }
    __syncthreads();
}
__device__ __forceinline__ void gla_stage_vt(const Ctx& C, const GlaRaw& R) {
    LAS bf16* VT = (LAS bf16*)(C.lds + GL_VT);
    const int j = C.tid >> 3, e0 = (C.tid & 7) * 16;
    const unsigned w[8] = {R.v0.x, R.v0.y, R.v0.z, R.v0.w, R.v1.x, R.v1.y, R.v1.z, R.v1.w};
#pragma unroll
    for (int q = 0; q < 8; ++q) { VT[(e0 + 2 * q) * GL_LD + j] = (bf16)(w[q] & 0xffffu); VT[(e0 + 2 * q + 1) * GL_LD + j] = (bf16)(w[q] >> 16); }
}

__device__ __forceinline__ void ph_gla_a(const Ctx& C, const bf16* PG, const float* gk_up, const float* gk_b, bf16* DS, float* GAM) {
    LAS float* GK = (LAS float*)(C.lds + GL_GK); LAS bf16* KT = (LAS bf16*)(C.lds + GL_I0); LAS bf16* VT = (LAS bf16*)(C.lds + GL_VT);
    for (int item = C.bid; item < 2048; item += C.nb) {
        const int bh = item >> 7, c = item & 127, b = bh >> 2, h = bh & 3;
        const size_t m0 = (size_t)b * T_ + c * 64;
        const bf16* pg = PG + m0 * NPG;
        GlaRaw R; gla_fetch(R, C, pg, gk_up, gk_b, h, false);
        gla_gates(C, R);
        { const int j = C.tid >> 3, d0 = (C.tid & 7) * 8;
          const unsigned w[4] = {R.k.x, R.k.y, R.k.z, R.k.w};
#pragma unroll
          for (int q = 0; q < 4; ++q) { const float k0 = bf2f((bf16)(w[q] & 0xffffu)), k1 = bf2f((bf16)(w[q] >> 16));
              const int d = d0 + 2 * q;
              KT[d * GL_LD + j] = (bf16)f2bf(k0 * __expf(GK[63 * 64 + d] - GK[j * 64 + d]));
              KT[(d + 1) * GL_LD + j] = (bf16)f2bf(k1 * __expf(GK[63 * 64 + d + 1] - GK[j * 64 + d + 1])); } }
        gla_stage_vt(C, R);
        if (C.tid < 64) GAM[(size_t)item * 64 + C.tid] = __expf(GK[63 * 64 + C.tid]);
        __syncthreads();
        { const int n0 = C.wave * 16, lane = C.lane, cc = lane & 15, g = lane >> 4;
          bf16* out = DS + (size_t)item * 8192 + (size_t)(n0 + cc) * 64 + 4 * g;
#pragma unroll
          for (int mt = 0; mt < 4; ++mt) { f32x4 acc = {0.f, 0.f, 0.f, 0.f}; acc = mm16(KT + mt * 16 * GL_LD, GL_LD, VT + n0 * GL_LD, GL_LD, 64, acc, lane);
              *(unsigned long long*)(out + mt * 16) = pack4(acc); } }
        __syncthreads();
    }
}
__device__ __forceinline__ void ph_gla_b(const Ctx& C, bf16* DS, const float* GAM) {
    for (int idx = C.bid * NT + C.tid; idx < 16 * 8192; idx += C.nb * NT) {
        const int bh = idx >> 13, ed = idx & 8191, d = ed & 63;
        bf16* p = DS + (size_t)bh * 128 * 8192 + ed; const float* gp = GAM + (size_t)bh * 128 * 64 + d;
        float S = 0.f;
        for (int c0 = 0; c0 < 128; c0 += 8) {
            float ds[8], gm[8];
#pragma unroll
            for (int i = 0; i < 8; ++i) { ds[i] = bf2f(p[(size_t)(c0 + i) * 8192]); gm[i] = gp[(c0 + i) * 64]; }
#pragma unroll
            for (int i = 0; i < 8; ++i) { const float gs = gm[i] * S; p[(size_t)(c0 + i) * 8192] = (bf16)f2bf(gs); S = gs + ds[i]; }
        }
    }
}
__device__ __forceinline__ void ph_gla_c(const Ctx& C, const bf16* PG, const float* gk_up, const float* gk_b, const float* norm_g, const bf16* DS, bf16* O) {
    LAS float* GK = (LAS float*)(C.lds + GL_GK); LAS bf16* QP = (LAS bf16*)(C.lds + GL_I0); LAS bf16* KM = (LAS bf16*)(C.lds + GL_I1); LAS bf16* AI = (LAS bf16*)(C.lds + GL_I2);
    LAS bf16* VT = (LAS bf16*)(C.lds + GL_VT); LAS float* SSQ = (LAS float*)(C.lds + GL_SSQ);
    for (int item = C.bid; item < 2048; item += C.nb) {
        const int bh = item >> 7, c = item & 127, b = bh >> 2, h = bh & 3;
        const size_t m0 = (size_t)b * T_ + c * 64;
        const bf16* pg = PG + m0 * NPG;
        GlaRaw R; gla_fetch(R, C, pg, gk_up, gk_b, h, true);
        s16x8 sfrag[4][2];
        { const int lane = C.lane, cc = lane & 15, g = lane >> 4, eh = C.wave >> 2; const bf16* Sg = DS + (size_t)item * 8192;
#pragma unroll
          for (int mt = 0; mt < 4; ++mt) { sfrag[mt][0] = *(const s16x8*)(Sg + (size_t)(eh * 64 + mt * 16 + cc) * 64 + 8 * g); sfrag[mt][1] = *(const s16x8*)(Sg + (size_t)(eh * 64 + mt * 16 + cc) * 64 + 32 + 8 * g); } }
        gla_gates(C, R);
        { const int j = C.tid >> 3, d0 = (C.tid & 7) * 8;
          const v4u qx = R.q, kx = R.k;
          const unsigned qw[4] = {qx.x, qx.y, qx.z, qx.w}, kw[4] = {kx.x, kx.y, kx.z, kx.w};
          unsigned qo[4], ko[4];
#pragma unroll
          for (int q = 0; q < 4; ++q) { const int d = d0 + 2 * q;
              const float e0 = GK[63 * 64 + d] - GK[j * 64 + d], e1 = GK[63 * 64 + d + 1] - GK[j * 64 + d + 1];
              const float q0 = 0.125f * bf2f((bf16)(qw[q] & 0xffffu)) * __expf(-e0), q1 = 0.125f * bf2f((bf16)(qw[q] >> 16)) * __expf(-e1);
              const float k0 = bf2f((bf16)(kw[q] & 0xffffu)) * __expf(e0), k1 = bf2f((bf16)(kw[q] >> 16)) * __expf(e1);
              qo[q] = pk2(q0, q1); ko[q] = pk2(k0, k1); }
          *(LAS v4u*)(QP + j * GL_LD + d0) = (v4u){qo[0], qo[1], qo[2], qo[3]}; *(LAS v4u*)(KM + j * GL_LD + d0) = (v4u){ko[0], ko[1], ko[2], ko[3]}; }
        gla_stage_vt(C, R);
        __syncthreads();
        { const int lane = C.lane, cc = lane & 15, g = lane >> 4, n0 = (C.wave >> 1) * 16;
#pragma unroll
          for (int q = 0; q < 2; ++q) { const int mt0 = ((C.wave & 1) * 2 + q) * 16; f32x4 acc = {0.f, 0.f, 0.f, 0.f};
              acc = mm16(KM + mt0 * GL_LD, GL_LD, QP + n0 * GL_LD, GL_LD, 64, acc, lane);
              const int i = n0 + cc, j = mt0 + 4 * g;
              acc.x = (j + 0 <= i) ? acc.x : 0.f; acc.y = (j + 1 <= i) ? acc.y : 0.f; acc.z = (j + 2 <= i) ? acc.z : 0.f; acc.w = (j + 3 <= i) ? acc.w : 0.f;
              *(LAS unsigned long long*)(AI + (n0 + cc) * GL_LD + mt0 + 4 * g) = pack4(acc); } }
        __syncthreads();
        { const int lane = C.lane, cc = lane & 15, g = lane >> 4, n0 = (C.wave & 3) * 16, eh = C.wave >> 2;
          f32x4 acc[4]; float ss = 0.f;
#pragma unroll
          for (int mt = 0; mt < 4; ++mt) { const int e0 = eh * 64 + mt * 16; acc[mt] = (f32x4){0.f, 0.f, 0.f, 0.f};
              { const LAS bf16* bp = QP + (n0 + cc) * GL_LD + 8 * g;
                acc[mt] = __builtin_amdgcn_mfma_f32_16x16x32_bf16(sfrag[mt][0], *(const LAS s16x8*)bp, acc[mt], 0, 0, 0); acc[mt] = __builtin_amdgcn_mfma_f32_16x16x32_bf16(sfrag[mt][1], *(const LAS s16x8*)(bp + 32), acc[mt], 0, 0, 0); }
              acc[mt] = mm16(VT + e0 * GL_LD, GL_LD, AI + n0 * GL_LD, GL_LD, 64, acc[mt], lane);
              ss += (acc[mt].x * acc[mt].x + acc[mt].y * acc[mt].y) + (acc[mt].z * acc[mt].z + acc[mt].w * acc[mt].w); }
          ss = xsum4(ss);
          if (g == 0) SSQ[eh * 64 + n0 + cc] = ss;
          __syncthreads();
          const float rstd = 1.f / sqrtf((SSQ[n0 + cc] + SSQ[64 + n0 + cc]) * (1.f / 128.f) + 1e-6f);
          const size_t m = m0 + n0 + cc;
#pragma unroll
          for (int mt = 0; mt < 4; ++mt) { const int e = eh * 64 + mt * 16 + 4 * g;
              const unsigned long long gx = *(const unsigned long long*)(pg + (size_t)(n0 + cc) * NPG + 1024 + h * 128 + e);
              const f32x4 ng = *(const f32x4*)(norm_g + e);
              f32x4 o;
              o.x = acc[mt].x * rstd * ng.x * siluf_(bf2f((bf16)(gx & 0xffffu)));
              o.y = acc[mt].y * rstd * ng.y * siluf_(bf2f((bf16)((gx >> 16) & 0xffffu)));
              o.z = acc[mt].z * rstd * ng.z * siluf_(bf2f((bf16)((gx >> 32) & 0xffffu)));
              o.w = acc[mt].w * rstd * ng.w * siluf_(bf2f((bf16)(gx >> 48)));
              *(unsigned long long*)(O + m * D_ + h * 128 + e) = pack4(o); } }
        __syncthreads();
    }
}


struct RwkvW { const float *mu, *mu_vres, *w0, *a0, *v0, *k_k, *k_a, *r_k; const bf16 *wupT, *aupT, *gupT, *vupT; };
constexpr int RW_LD = 72, RW_XLD = 296;
constexpr int RW_R0 = 0;
constexpr int RW_SEG = 16384;
constexpr int RW_R1 = 36864;
constexpr int RW_R2 = RW_R1 + 27648;
constexpr int RW_R3 = RW_R2 + 9216;
constexpr int RW_R4 = RW_R3 + 27648;
constexpr int RW_TI = RW_R4 + 128 * RW_LD * 2;
constexpr int RW_MU = RW_TI + 2048;
constexpr int RW_X = RW_MU + 2048;
constexpr int RW_END = RW_X + 64 * RW_XLD * 2;
static_assert(RW_END <= MISC_OFF, "RWKV LDS map");

typedef short s16x4 __attribute__((ext_vector_type(4)));
__device__ __forceinline__ float tanh_fast(float x) { const float e = __expf(2.f * x); return 1.f - 2.f / (e + 1.f); }
__device__ __forceinline__ float softplus_fast(float x) { return fmaxf(x, 0.f) + __logf(1.f + __expf(-fabsf(x))); }
__device__ __forceinline__ s16x4 cvt4(f32x4 v) { const unsigned long long p = pack4(v); return __builtin_bit_cast(s16x4, p); }
__device__ __forceinline__ void ld8f(const float* p, float (&o)[8]) { const f32x4 a = *(const f32x4*)p, b = *(const f32x4*)(p + 4); o[0] = a.x; o[1] = a.y; o[2] = a.z; o[3] = a.w; o[4] = b.x; o[5] = b.y; o[6] = b.z; o[7] = b.w; }
__device__ __forceinline__ float sum8(float v) { v += dpp_f<0xB1>(v); v += dpp_f<0x4E>(v); v += dpp_f<0x141>(v); return v; }
__device__ __forceinline__ void unpack8(const v4u x, float (&o)[8]) {
    o[0] = bf2f((bf16)(x.x & 0xffffu)); o[1] = bf2f((bf16)(x.x >> 16)); o[2] = bf2f((bf16)(x.y & 0xffffu)); o[3] = bf2f((bf16)(x.y >> 16));
    o[4] = bf2f((bf16)(x.z & 0xffffu)); o[5] = bf2f((bf16)(x.z >> 16)); o[6] = bf2f((bf16)(x.w & 0xffffu)); o[7] = bf2f((bf16)(x.w >> 16)); }
__device__ __forceinline__ v4u pack8(const float (&o)[8]) { return (v4u){pk2(o[0], o[1]), pk2(o[2], o[3]), pk2(o[4], o[5]), pk2(o[6], o[7])}; }
__device__ __forceinline__ f32x4 mm16_gb(const LAS bf16* A, int lda, const bf16* B, int ldb, int K, f32x4 acc, int lane) {
    const int r = lane & 15, g = lane >> 4;
    const LAS bf16* ap = A + r * lda + 8 * g; const bf16* bp = B + r * ldb + 8 * g;
    for (int k0 = 0; k0 < K; k0 += 32) { const s16x8 a = *(const LAS s16x8*)(ap + k0); const s16x8 b = *(const s16x8*)(bp + k0); acc = __builtin_amdgcn_mfma_f32_16x16x32_bf16(a, b, acc, 0, 0, 0); }
    return acc;
}

__device__ __forceinline__ void ph_norm_b(const Ctx& C, const bf16* x, const float* g, const float* sh, const float* sc, bf16* XB) {
    const int gw = C.bid * 8 + C.wave, NGW = C.nb * 8, lane = C.lane;
    for (int m = gw; m < M_; m += NGW) {
        const int b = m / T_;
        const v4u* xr = (const v4u*)(x + (size_t)m * D_) + lane;
        float v[2][8]; float s = 0.f;
#pragma unroll
        for (int j = 0; j < 2; ++j) { unpack8(xr[64 * j], v[j]);
#pragma unroll
            for (int i = 0; i < 8; ++i) s += v[j][i] * v[j][i]; }
        const float rstd = 1.f / sqrtf(wave_sum(s) * (1.f / D_) + 1e-6f);
        v4u* o = (v4u*)(XB + (size_t)m * D_) + lane;
#pragma unroll
        for (int j = 0; j < 2; ++j) { const int col = 8 * lane + 512 * j; float gv[8], shv[8], scv[8], h[8];
            ld8f(g + col, gv); ld8f(sh + b * 6144 + col, shv); ld8f(sc + b * 6144 + col, scv);
#pragma unroll
            for (int i = 0; i < 8; ++i) h[i] = v[j][i] * rstd * gv[i] * (scv[i] + 1.f) + shv[i];
            o[64 * j] = pack8(h); }
    }
}
__device__ __forceinline__ void ph_final_b(const Ctx& C, const bf16* x, const float* g, float* out, int m_lo, int m_hi, bf16* keep, int c_lo, int c_hi) {
    const int gw = C.bid * 8 + C.wave, NGW = C.nb * 8, lane = C.lane;
    for (int m = m_lo + gw; m < m_hi; m += NGW) {
        const v4u* xr = (const v4u*)(x + (size_t)m * D_) + lane;
        float v[2][8]; float s = 0.f;
#pragma unroll
        for (int j = 0; j < 2; ++j) { unpack8(xr[64 * j], v[j]);
#pragma unroll
            for (int i = 0; i < 8; ++i) s += v[j][i] * v[j][i]; }
        const float rstd = 1.f / sqrtf(wave_sum(s) * (1.f / D_) + 1e-6f);
#pragma unroll
        for (int j = 0; j < 2; ++j) { const int col = 8 * lane + 512 * j; float gv[8]; ld8f(g + col, gv);
            f32x4* o = (f32x4*)(out + (size_t)m * D_ + col);
            o[0] = (f32x4){v[j][0] * rstd * gv[0], v[j][1] * rstd * gv[1], v[j][2] * rstd * gv[2], v[j][3] * rstd * gv[3]};
            o[1] = (f32x4){v[j][4] * rstd * gv[4], v[j][5] * rstd * gv[5], v[j][6] * rstd * gv[6], v[j][7] * rstd * gv[7]}; }
    }
    for (int m = c_lo + gw; m < c_hi; m += NGW) { const v4u* xr = (const v4u*)(x + (size_t)m * D_) + lane; v4u* kr = (v4u*)(keep + (size_t)(m - c_lo) * D_) + lane; kr[0] = xr[0]; kr[64] = xr[64]; }
}
__device__ __forceinline__ void ph_rwkv_a(const Ctx& C, const bf16* PR, const bf16* VL  , const RwkvW& W, int layer,
                                          bf16* PP, bf16* QQ, bf16* RH, bf16* YH, float* GAMC, float* RK, bf16* GG, bf16* VF, bool store_v = true) {
    LAS unsigned char* L = C.lds;
    LAS bf16* X = (LAS bf16*)(L + RW_X); LAS float* CUM = (LAS float*)(L + RW_R0); LAS float* SEG = (LAS float*)(L + RW_SEG);
    LAS bf16* NI = (LAS bf16*)(L + RW_R0), *AAK = NI + 64 * RW_LD, *ARB = AAK + 64 * RW_LD, *ARK = ARB + 64 * RW_LD;
    LAS bf16* PRE = (LAS bf16*)(L + RW_R1);
    LAS bf16* AT = (LAS bf16*)(L + RW_R1), *BT = AT + 64 * RW_LD, *KT = BT + 64 * RW_LD, *RT = (LAS bf16*)(L + RW_R2);
    LAS bf16* XB16 = (LAS bf16*)(L + RW_R1);
    LAS bf16* BHc = (LAS bf16*)(L + RW_R3), *KHc = BHc + 64 * RW_LD, *VTc = KHc + 64 * RW_LD;
    LAS bf16* XT = (LAS bf16*)(L + RW_R4); LAS bf16* TI = (LAS bf16*)(L + RW_TI);
    const int wave = C.wave;
    LAS float* MU = (LAS float*)(L + RW_MU);
    for (int i = C.tid; i < 288; i += NT) MU[i] = i < 256 ? W.mu[1536 + i] : (layer ? W.mu_vres[i - 256] : 0.f);
    __syncthreads();
    for (int bc = C.bid; bc < 512; bc += C.nb) {
        const int c = bc & 127, b = bc >> 7;
        const size_t m0 = (size_t)b * T_ + c * 64;
        { const int tid = C.tid;
          v4u xc[5], xp[5];
#pragma unroll
          for (int it = 0; it < 5; ++it) { const int idx = tid + it * NT; xc[it] = (v4u){0u, 0u, 0u, 0u}; xp[it] = xc[it];
            if (idx < 64 * 36) { const int t1 = idx / 36, q = idx % 36, col = q * 8; const size_t m1 = m0 + t1; const bool first1 = (c == 0 && t1 == 0);
                if (q < 32) { xc[it] = *(const v4u*)(PR + m1 * NPR + 1536 + col); if (!first1) xp[it] = *(const v4u*)(PR + (m1 - 1) * NPR + 1536 + col); }
                else if (layer) { xc[it] = *(const v4u*)(VL + m1 * NPG + 1552 + (col - 256)); if (!first1) xp[it] = *(const v4u*)(VL + (m1 - 1) * NPG + 1552 + (col - 256)); } } }
#pragma unroll
          for (int it = 0; it < 5; ++it) { const int idx = tid + it * NT;
            if (idx < 64 * 36) { const int t1 = idx / 36, q = idx % 36, col = q * 8;
                float cv[8], pv[8], mu[8]; unpack8(xc[it], cv); unpack8(xp[it], pv);
                { const f32x4 ma = *(const LAS f32x4*)(MU + col), mb = *(const LAS f32x4*)(MU + col + 4); mu[0] = ma.x; mu[1] = ma.y; mu[2] = ma.z; mu[3] = ma.w; mu[4] = mb.x; mu[5] = mb.y; mu[6] = mb.z; mu[7] = mb.w; }
#pragma unroll
                for (int i = 0; i < 8; ++i) { float p = cv[i] + (pv[i] - cv[i]) * mu[i]; if (q < 8) p = tanh_fast(p); else if (q >= 16 && q < 32) p = sigmoidf_(p); cv[i] = p; }
                *(LAS v4u*)(X + t1 * RW_XLD + col) = pack8(cv); } }
        }
        __syncthreads();
      v4u rcx, kcx, vcx, rpx, kpx, vpx, vfx;
#define RW_FETCH(hh) do { const int t_ = C.tid >> 3, ch_ = (hh) * 64 + (C.tid & 7) * 8; const size_t m_ = m0 + t_; const bool first_ = (c == 0 && t_ == 0); \
        rcx = *(const v4u*)(PR + m_ * NPR + ch_); kcx = *(const v4u*)(PR + m_ * NPR + 512 + ch_); vcx = *(const v4u*)(PR + m_ * NPR + 1024 + ch_); \
        rpx = (v4u){0u, 0u, 0u, 0u}; kpx = rpx; vpx = rpx; vfx = rpx; \
        if (!first_) { rpx = *(const v4u*)(PR + (m_ - 1) * NPR + ch_); kpx = *(const v4u*)(PR + (m_ - 1) * NPR + 512 + ch_); vpx = *(const v4u*)(PR + (m_ - 1) * NPR + 1024 + ch_); } \
        if (layer) vfx = *(const v4u*)(VF + m_ * 512 + ch_); } while (0)
      RW_FETCH(0);
#pragma unroll 1
      for (int h = 0; h < 8; ++h) {
        const int item = bc * 8 + h;
        int tid_ = C.tid; asm volatile("" : "+v"(tid_));
        const int tid = tid_, lane = tid & 63, cc = lane & 15, g = lane >> 4;
        const int t = tid >> 3, d0 = (tid & 7) * 8, ch = h * 64 + d0; const size_t m = m0 + t;
        {
            const int lsel = wave >> 1;
            const bf16* WT = lsel == 0 ? W.wupT : lsel == 1 ? W.aupT : lsel == 2 ? W.gupT : W.vupT;
            const int Kl = lsel == 2 ? 128 : lsel == 3 ? 32 : 64, xoff = lsel == 0 ? 0 : lsel == 1 ? 64 : lsel == 2 ? 128 : 256;
            LAS bf16* outp = PRE + lsel * 64 * RW_LD;
            const bool live = (lsel != 3 || layer);
#pragma unroll
            for (int mq = 0; mq < 2; ++mq) { const int mt = (wave & 1) * 2 + mq;
                s16x8 af[4];
                const bf16* ap = WT + (size_t)(h * 64 + mt * 16 + cc) * Kl + 8 * g;
#pragma unroll
                for (int ks = 0; ks < 4; ++ks) af[ks] = (live && ks * 32 < Kl) ? *(const s16x8*)(ap + ks * 32) : (s16x8){0, 0, 0, 0, 0, 0, 0, 0};
#pragma unroll
                for (int nt = 0; nt < 4; ++nt) { f32x4 acc = {0.f, 0.f, 0.f, 0.f};
                    const LAS bf16* bp = X + (nt * 16 + cc) * RW_XLD + xoff + 8 * g;
#pragma unroll
                    for (int ks = 0; ks < 4; ++ks) if (ks * 32 < Kl) { const s16x8 bb = *(const LAS s16x8*)(bp + ks * 32); acc = __builtin_amdgcn_mfma_f32_16x16x32_bf16(af[ks], bb, acc, 0, 0, 0); }
                    *(LAS unsigned long long*)(outp + (nt * 16 + cc) * RW_LD + mt * 16 + 4 * g) = pack4(acc); } }
        }
        __syncthreads();
        float av[8], bv[8], kv[8], rv[8], lw[8], vv[8];
        {
            float rc[8], rp[8], kc[8], kp[8], vc[8], vp[8], pw[8], pa[8], pg_[8], pvg[8];
            unpack8(rcx, rc); unpack8(kcx, kc); unpack8(vcx, vc); unpack8(rpx, rp); unpack8(kpx, kp); unpack8(vpx, vp);
            unpack8(*(const LAS v4u*)(PRE + (0 * 64 + t) * RW_LD + d0), pw); unpack8(*(const LAS v4u*)(PRE + (1 * 64 + t) * RW_LD + d0), pa);
            unpack8(*(const LAS v4u*)(PRE + (2 * 64 + t) * RW_LD + d0), pg_); unpack8(*(const LAS v4u*)(PRE + (3 * 64 + t) * RW_LD + d0), pvg);
            float vf[8]; unpack8(vfx, vf);
            float ssq = 0.f, rks = 0.f, asg[8], gg[8];
            float mur[8], muk[8], muv[8], w0c[8], a0c[8], v0c[8], kkc[8], kac[8], rkc[8];
            ld8f(W.mu + ch, mur); ld8f(W.mu + 512 + ch, muk); ld8f(W.mu + 1024 + ch, muv); ld8f(W.w0 + ch, w0c); ld8f(W.a0 + ch, a0c);
            ld8f(W.k_k + ch, kkc); ld8f(W.k_a + ch, kac); ld8f(W.r_k + ch, rkc);
            if (layer) ld8f(W.v0 + ch, v0c);
#pragma unroll
            for (int i = 0; i < 8; ++i) {
                const float r = rc[i] + (rp[i] - rc[i]) * mur[i], k = kc[i] + (kp[i] - kc[i]) * muk[i]; float v = vc[i] + (vp[i] - vc[i]) * muv[i];
                lw[i] = -0.6065306597f * sigmoidf_(w0c[i] + pw[i]);
                asg[i] = sigmoidf_(a0c[i] + pa[i]);
                if (layer) v = v + (vf[i] - v) * sigmoidf_(v0c[i] + pvg[i]);
                const float kk = k * kkc[i]; ssq += kk * kk;
                kv[i] = k * (1.f + (asg[i] - 1.f) * kac[i]); rv[i] = r; vv[i] = v; gg[i] = pg_[i]; av[i] = kk;
                rks += r * kv[i] * rkc[i];
            }
            ssq = sum8(ssq); rks = sum8(rks);
            const float inv = 1.f / sqrtf(fmaxf(ssq, 1e-24f));
#pragma unroll
            for (int i = 0; i < 8; ++i) { const float kk = av[i] * inv; av[i] = -kk; bv[i] = kk * asg[i]; }
            if ((tid & 7) == 0) RK[m * 8 + h] = rks;
            *(v4u*)(GG + m * 512 + ch) = pack8(gg);
            if (store_v) *(v4u*)(VF + m * 512 + ch) = pack8(vv);
#pragma unroll
            for (int i = 0; i < 8; ++i) vv[i] = bf2f((bf16)f2bf(vv[i]));
        }
        __syncthreads();
#pragma unroll
        for (int i = 0; i < 8; ++i) CUM[t * 64 + d0 + i] = lw[i];
        __syncthreads();
        { const int d = tid & 63, seg = tid >> 6; float run = 0.f;
#pragma unroll
          for (int q = 0; q < 8; ++q) { run += CUM[(seg * 8 + q) * 64 + d]; CUM[(seg * 8 + q) * 64 + d] = run; }
          SEG[seg * 64 + d] = run; }
        __syncthreads();
        { const int d = tid & 63, seg = tid >> 6; float off = 0.f;
          for (int s = 0; s < seg; ++s) off += SEG[s * 64 + d];
#pragma unroll
          for (int q = 0; q < 8; ++q) CUM[(seg * 8 + q) * 64 + d] += off; }
        __syncthreads();
        {
            float at[8], bt[8], kt[8], rt[8];
#pragma unroll
            for (int i = 0; i < 8; ++i) { const float cu = CUM[t * 64 + d0 + i], cC = CUM[63 * 64 + d0 + i], en = __expf(-cu), ec = __expf(cC - cu);
                at[i] = av[i] * __expf(cu - lw[i]); bt[i] = bv[i] * en; kt[i] = kv[i] * en; rt[i] = rv[i] * __expf(cu);
                BHc[(d0 + i) * RW_LD + t] = (bf16)f2bf(bv[i] * ec); KHc[(d0 + i) * RW_LD + t] = (bf16)f2bf(kv[i] * ec); VTc[(d0 + i) * RW_LD + t] = (bf16)f2bf(vv[i]);
                XT[(d0 + i) * RW_LD + t] = (bf16)f2bf(at[i]);
                if (t == 63) GAMC[(size_t)item * 64 + d0 + i] = __expf(cC); }
            *(LAS v4u*)(AT + t * RW_LD + d0) = pack8(at); *(LAS v4u*)(BT + t * RW_LD + d0) = pack8(bt); *(LAS v4u*)(KT + t * RW_LD + d0) = pack8(kt); *(LAS v4u*)(RT + t * RW_LD + d0) = pack8(rt);
        }
        if (h < 7) RW_FETCH(h + 1);
        __syncthreads();
        {
            const int msel = wave >> 1;
            const LAS bf16* As = (msel == 0 || msel == 2) ? BT : KT; const LAS bf16* Bs = (msel < 2) ? AT : RT;
            f32x4 accs[8];
#pragma unroll
            for (int q = 0; q < 8; ++q) { const int tile = (wave & 1) * 8 + q, mt = tile >> 2, nt = tile & 3; accs[q] = (f32x4){0.f, 0.f, 0.f, 0.f};
                accs[q] = mm16(As + mt * 16 * RW_LD, RW_LD, Bs + nt * 16 * RW_LD, RW_LD, 64, accs[q], lane);
                const int tt = nt * 16 + cc, s0 = mt * 16 + 4 * g, lim = (msel < 2) ? tt - 1 : tt;
                accs[q].x = (s0 + 0 <= lim) ? accs[q].x : 0.f; accs[q].y = (s0 + 1 <= lim) ? accs[q].y : 0.f; accs[q].z = (s0 + 2 <= lim) ? accs[q].z : 0.f; accs[q].w = (s0 + 3 <= lim) ? accs[q].w : 0.f; }
            __syncthreads();
            LAS bf16* outp = NI + msel * 64 * RW_LD;
#pragma unroll
            for (int q = 0; q < 8; ++q) { const int tile = (wave & 1) * 8 + q, mt = tile >> 2, nt = tile & 3;
                *(LAS unsigned long long*)(outp + (nt * 16 + cc) * RW_LD + mt * 16 + 4 * g) = pack4(accs[q]); }
        }
        __syncthreads();
        if (wave == 0) {
            const int blk = lane >> 4, col = lane & 15; float x[16];
#pragma unroll
            for (int tt = 0; tt < 16; ++tt) { float nr[16]; { float lo[8], hi[8]; unpack8(*(const LAS v4u*)(NI + (16 * blk + tt) * RW_LD + 16 * blk), lo); unpack8(*(const LAS v4u*)(NI + (16 * blk + tt) * RW_LD + 16 * blk + 8), hi);
#pragma unroll
                    for (int q = 0; q < 8; ++q) { nr[q] = lo[q]; nr[8 + q] = hi[q]; } }
                float a = (tt == col) ? 1.f : 0.f;
#pragma unroll
                for (int q = 0; q < tt; ++q) a += nr[q] * x[q];
                x[tt] = a; TI[(blk * 16 + tt) * 16 + col] = (bf16)f2bf(a); }
        } else {
            for (int tile = wave - 1; tile < 16; tile += 7) { const int mt = tile >> 2, nt = tile & 3;
                f32x4 acc = {0.f, 0.f, 0.f, 0.f}; acc = mm16(AAK + mt * 16 * RW_LD, RW_LD, VTc + nt * 16 * RW_LD, RW_LD, 64, acc, lane);
                *(LAS unsigned long long*)(XT + (64 + nt * 16 + cc) * RW_LD + mt * 16 + 4 * g) = pack4(acc); }
        }
        __syncthreads();
        {
            s16x4 xb[4];
#pragma unroll
            for (int i = 0; i < 4; ++i) {
                f32x4 acc; { const unsigned long long xr = *(const LAS unsigned long long*)(XT + (wave * 16 + cc) * RW_LD + 16 * i + 4 * g);
                    acc.x = bf2f((bf16)(xr & 0xffffu)); acc.y = bf2f((bf16)((xr >> 16) & 0xffffu)); acc.z = bf2f((bf16)((xr >> 32) & 0xffffu)); acc.w = bf2f((bf16)(xr >> 48)); }
#pragma unroll
                for (int k = 0; k < i; ++k) { const s16x4 a = *(const LAS s16x4*)(NI + (16 * i + cc) * RW_LD + 16 * k + 4 * g); acc = __builtin_amdgcn_mfma_f32_16x16x16bf16_1k(a, xb[k], acc, 0, 0, 0); }
                const s16x4 yb = cvt4(acc), ta = *(const LAS s16x4*)(TI + (i * 16 + cc) * 16 + 4 * g);
                const f32x4 xi = __builtin_amdgcn_mfma_f32_16x16x16bf16_1k(ta, yb, (f32x4){0.f, 0.f, 0.f, 0.f}, 0, 0, 0);
                xb[i] = cvt4(xi);
            }
            __syncthreads();
#pragma unroll
            for (int i = 0; i < 4; ++i) *(LAS s16x4*)(XB16 + (wave * 16 + cc) * RW_LD + 16 * i + 4 * g) = xb[i];
        }
        __syncthreads();
        {
            const int osel = wave >> 1, mt0 = (wave & 1) * 2; const size_t ob = (size_t)item * 4096;
            const LAS bf16* A1 = osel == 0 ? XB16 : osel == 1 ? BHc : osel == 2 ? XB16 : XB16 + 64 * RW_LD;
            const LAS bf16* B1 = osel == 0 ? BHc : osel == 1 ? XB16 + 64 * RW_LD : ARB;
            const LAS bf16* A2 = osel == 1 ? KHc : VTc; const LAS bf16* B2 = osel == 1 ? VTc : ARK;
            bf16* OUT = osel == 0 ? PP : osel == 1 ? QQ : osel == 2 ? RH : YH;
            f32x4 acc[2][4];
#pragma unroll
            for (int mq = 0; mq < 2; ++mq)
#pragma unroll
                for (int nt = 0; nt < 4; ++nt) acc[mq][nt] = (f32x4){0.f, 0.f, 0.f, 0.f};
            { s16x8 af[2][2], bfm[4][2];
#pragma unroll
              for (int mq = 0; mq < 2; ++mq)
#pragma unroll
                  for (int k = 0; k < 2; ++k) af[mq][k] = *(const LAS s16x8*)(A1 + ((mt0 + mq) * 16 + cc) * RW_LD + 32 * k + 8 * g);
#pragma unroll
              for (int nt = 0; nt < 4; ++nt)
#pragma unroll
                  for (int k = 0; k < 2; ++k) bfm[nt][k] = *(const LAS s16x8*)(B1 + (nt * 16 + cc) * RW_LD + 32 * k + 8 * g);
#pragma unroll
              for (int mq = 0; mq < 2; ++mq)
#pragma unroll
                  for (int nt = 0; nt < 4; ++nt) { acc[mq][nt] = __builtin_amdgcn_mfma_f32_16x16x32_bf16(af[mq][0], bfm[nt][0], acc[mq][nt], 0, 0, 0); acc[mq][nt] = __builtin_amdgcn_mfma_f32_16x16x32_bf16(af[mq][1], bfm[nt][1], acc[mq][nt], 0, 0, 0); } }
            if (osel & 1) { s16x8 af[2][2], bfm[4][2];
#pragma unroll
              for (int mq = 0; mq < 2; ++mq)
#pragma unroll
                  for (int k = 0; k < 2; ++k) af[mq][k] = *(const LAS s16x8*)(A2 + ((mt0 + mq) * 16 + cc) * RW_LD + 32 * k + 8 * g);
#pragma unroll
              for (int nt = 0; nt < 4; ++nt)
#pragma unroll
                  for (int k = 0; k < 2; ++k) bfm[nt][k] = *(const LAS s16x8*)(B2 + (nt * 16 + cc) * RW_LD + 32 * k + 8 * g);
#pragma unroll
              for (int mq = 0; mq < 2; ++mq)
#pragma unroll
                  for (int nt = 0; nt < 4; ++nt) { acc[mq][nt] = __builtin_amdgcn_mfma_f32_16x16x32_bf16(af[mq][0], bfm[nt][0], acc[mq][nt], 0, 0, 0); acc[mq][nt] = __builtin_amdgcn_mfma_f32_16x16x32_bf16(af[mq][1], bfm[nt][1], acc[mq][nt], 0, 0, 0); } }
#pragma unroll
            for (int mq = 0; mq < 2; ++mq)
#pragma unroll
                for (int nt = 0; nt < 4; ++nt) { f32x4 a = acc[mq][nt];
                    if (osel == 2) { const unsigned long long rr = *(const LAS unsigned long long*)(RT + (nt * 16 + cc) * RW_LD + (mt0 + mq) * 16 + 4 * g);
                        a.x += bf2f((bf16)(rr & 0xffffu)); a.y += bf2f((bf16)((rr >> 16) & 0xffffu)); a.z += bf2f((bf16)((rr >> 32) & 0xffffu)); a.w += bf2f((bf16)(rr >> 48)); }
                    *(unsigned long long*)(OUT + ob + (nt * 16 + cc) * 64 + (mt0 + mq) * 16 + 4 * g) = pack4(a); }
        }
        __syncthreads();
      }
    }
}

#undef RW_FETCH
constexpr int CH_R = 6, CH_SLOT = 9216 + 9216 + 256;
constexpr int CH_RING = 0, CH_SI = CH_R * CH_SLOT, CH_FLAGS = CH_SI + 4 * 2304;
static_assert(CH_FLAGS + 64 <= MISC_OFF, "chain LDS map");
struct ChainRegs { v4u p[8], q[8]; f32x4 gm; };
__device__ __forceinline__ void chain_fetch(ChainRegs& o, const bf16* PP, const bf16* QQ, const float* GAMC, int item, int lane) {
    const size_t ob = (size_t)item * 4096;
#pragma unroll
    for (int i = 0; i < 8; ++i) { o.p[i] = *(const v4u*)(PP + ob + (size_t)(i * 64 + lane) * 8); o.q[i] = *(const v4u*)(QQ + ob + (size_t)(i * 64 + lane) * 8); }
    o.gm = *(const f32x4*)(GAMC + (size_t)item * 64 + (lane & 15) * 4);
}
__device__ __forceinline__ void chain_commit(const ChainRegs& o, LAS unsigned char* L, int c, int lane) {
    volatile LAS unsigned* flags = (volatile LAS unsigned*)(L + CH_FLAGS);
    const int slot = c % CH_R;
    if (c >= CH_R) { const unsigned need = (unsigned)(c - CH_R + 1);
        for (;;) { const unsigned m0 = flags[CH_R + 0], m1 = flags[CH_R + 1], m2 = flags[CH_R + 2], m3 = flags[CH_R + 3];
            if (m0 >= need && m1 >= need && m2 >= need && m3 >= need) break; __builtin_amdgcn_s_sleep(1); } }
    asm volatile("" ::: "memory");
    LAS unsigned char* sl = L + CH_RING + slot * CH_SLOT;
#pragma unroll
    for (int i = 0; i < 8; ++i) { const int idx = i * 64 + lane, row = idx >> 3, c16 = idx & 7;
        *(LAS v4u*)(sl + row * 144 + c16 * 16) = o.p[i]; *(LAS v4u*)(sl + 9216 + row * 144 + c16 * 16) = o.q[i]; }
    if (lane < 16) *(LAS f32x4*)(sl + 18432 + lane * 16) = o.gm;
    asm volatile("s_waitcnt lgkmcnt(0)" ::: "memory");
    if (lane == 0) flags[slot] = (unsigned)(c + 1);
}
__device__ __forceinline__ void ph_rwkv_b(const Ctx& C, int bh  , const bf16* PP, const bf16* QQ, const float* GAMC, bf16* S0) {
    const int lane = C.lane, wave = C.wave, cc = lane & 15, g = lane >> 4, b = bh >> 3, h = bh & 7;
    LAS unsigned char* L = C.lds;
    volatile LAS unsigned* flags = (volatile LAS unsigned*)(L + CH_FLAGS);
    if (C.tid < 16) flags[C.tid] = 0u;
    __syncthreads();
    if (wave >= 4) {
        const int j = wave - 4;
        ChainRegs A, B;
        int lc = j;
        chain_fetch(A, PP, QQ, GAMC, (b * 128 + lc) * 8 + h, lane);
        for (;;) {
            if (lc + 4 < 128) chain_fetch(B, PP, QQ, GAMC, (b * 128 + lc + 4) * 8 + h, lane);
            chain_commit(A, L, lc, lane);
            lc += 4; if (lc >= 128) break;
            if (lc + 4 < 128) chain_fetch(A, PP, QQ, GAMC, (b * 128 + lc + 4) * 8 + h, lane);
            chain_commit(B, L, lc, lane);
            lc += 4; if (lc >= 128) break;
        }
    } else {
        const int vt = wave;
        LAS bf16* SI = (LAS bf16*)(L + CH_SI + vt * 2304);
        f32x4 st[4];
#pragma unroll
        for (int mt = 0; mt < 4; ++mt) st[mt] = (f32x4){0.f, 0.f, 0.f, 0.f};
        for (int c = 0; c < 128; ++c) {
            const int item = (b * 128 + c) * 8 + h, slot = c % CH_R; const size_t ob = (size_t)item * 4096;
#pragma unroll
            for (int mt = 0; mt < 4; ++mt) { const unsigned long long pk = pack4(st[mt]);
                *(unsigned long long*)(S0 + ob + (vt * 16 + cc) * 64 + mt * 16 + 4 * g) = pk; *(LAS unsigned long long*)(SI + cc * RW_LD + mt * 16 + 4 * g) = pk; }
            while (flags[slot] < (unsigned)(c + 1)) __builtin_amdgcn_s_sleep(1);
            asm volatile("s_waitcnt lgkmcnt(0)" ::: "memory");
            const LAS unsigned char* sl = L + CH_RING + slot * CH_SLOT;
            const LAS bf16* Pi = (const LAS bf16*)sl; const LAS bf16* Qi = (const LAS bf16*)(sl + 9216); const LAS float* Gi = (const LAS float*)(sl + 18432);
            const s16x8 b0 = *(const LAS s16x8*)(SI + cc * RW_LD + 8 * g), b1 = *(const LAS s16x8*)(SI + cc * RW_LD + 32 + 8 * g);
#pragma unroll
            for (int mt = 0; mt < 4; ++mt) {
                const f32x4 gm = *(const LAS f32x4*)(Gi + mt * 16 + 4 * g);
                const unsigned long long qq = *(const LAS unsigned long long*)(Qi + (vt * 16 + cc) * RW_LD + mt * 16 + 4 * g);
                const s16x8 a0 = *(const LAS s16x8*)(Pi + (mt * 16 + cc) * RW_LD + 8 * g), a1 = *(const LAS s16x8*)(Pi + (mt * 16 + cc) * RW_LD + 32 + 8 * g);
                f32x4 acc; acc.x = gm.x * st[mt].x + bf2f((bf16)(qq & 0xffffu)); acc.y = gm.y * st[mt].y + bf2f((bf16)((qq >> 16) & 0xffffu));
                acc.z = gm.z * st[mt].z + bf2f((bf16)((qq >> 32) & 0xffffu)); acc.w = gm.w * st[mt].w + bf2f((bf16)(qq >> 48));
                acc = __builtin_amdgcn_mfma_f32_16x16x32_bf16(a0, b0, acc, 0, 0, 0); acc = __builtin_amdgcn_mfma_f32_16x16x32_bf16(a1, b1, acc, 0, 0, 0);
                st[mt] = acc; }
            asm volatile("s_waitcnt lgkmcnt(0)" ::: "memory");
            if (lane == 0) flags[CH_R + vt] = (unsigned)(c + 1);
        }
    }
    __syncthreads();
}

__device__ __forceinline__ void ph_rwkv_c(const Ctx& C, const bf16* S0, const bf16* RH, const bf16* YH, const float* RK, const bf16* GG, const bf16* VF,
                                          const float* gn_g, const float* gn_b, bf16* O) {
    const int lane = C.lane, cc = lane & 15, g = lane >> 4;
    for (int item = C.bid * 8 + C.wave; item < 4096; item += C.nb * 8) {
        const int h = item & 7, c = (item >> 3) & 127, b = item >> 10; const size_t m0 = (size_t)b * T_ + c * 64, ob = (size_t)item * 4096;
        s16x8 af[4][2], bfr[4][2];
#pragma unroll
        for (int q = 0; q < 4; ++q)
#pragma unroll
            for (int k = 0; k < 2; ++k) { af[q][k] = *(const s16x8*)(S0 + ob + (q * 16 + cc) * 64 + k * 32 + 8 * g); bfr[q][k] = *(const s16x8*)(RH + ob + (q * 16 + cc) * 64 + k * 32 + 8 * g); }
#pragma unroll
        for (int nt = 0; nt < 4; ++nt) {
            const size_t m = m0 + nt * 16 + cc;
            f32x4 y[4]; float s1 = 0.f;
#pragma unroll
            for (int mt = 0; mt < 4; ++mt) { const unsigned long long yh = *(const unsigned long long*)(YH + ob + (nt * 16 + cc) * 64 + mt * 16 + 4 * g);
                f32x4 acc; acc.x = bf2f((bf16)(yh & 0xffffu)); acc.y = bf2f((bf16)((yh >> 16) & 0xffffu)); acc.z = bf2f((bf16)((yh >> 32) & 0xffffu)); acc.w = bf2f((bf16)(yh >> 48));
                acc = __builtin_amdgcn_mfma_f32_16x16x32_bf16(af[mt][0], bfr[nt][0], acc, 0, 0, 0); acc = __builtin_amdgcn_mfma_f32_16x16x32_bf16(af[mt][1], bfr[nt][1], acc, 0, 0, 0);
                y[mt] = acc; s1 += (acc.x + acc.y) + (acc.z + acc.w); }
            s1 = xsum4(s1);
            const float mean = s1 * (1.f / 64.f); float s2 = 0.f;
#pragma unroll
            for (int mt = 0; mt < 4; ++mt) { y[mt] = y[mt] - mean; s2 += (y[mt].x * y[mt].x + y[mt].y * y[mt].y) + (y[mt].z * y[mt].z + y[mt].w * y[mt].w); }
            s2 = xsum4(s2);
            const float rstd = 1.f / sqrtf(s2 * (1.f / 64.f) + 64e-5f), rk = RK[m * 8 + h];
#pragma unroll
            for (int mt = 0; mt < 4; ++mt) { const int v = h * 64 + mt * 16 + 4 * g;
                const f32x4 gg4 = *(const f32x4*)(gn_g + v), gb4 = *(const f32x4*)(gn_b + v);
                const unsigned long long vx = *(const unsigned long long*)(VF + m * 512 + v), gx = *(const unsigned long long*)(GG + m * 512 + v);
                f32x4 o;
                o.x = (y[mt].x * rstd * gg4.x + gb4.x + rk * bf2f((bf16)(vx & 0xffffu))) * bf2f((bf16)(gx & 0xffffu));
                o.y = (y[mt].y * rstd * gg4.y + gb4.y + rk * bf2f((bf16)((vx >> 16) & 0xffffu))) * bf2f((bf16)((gx >> 16) & 0xffffu));
                o.z = (y[mt].z * rstd * gg4.z + gb4.z + rk * bf2f((bf16)((vx >> 32) & 0xffffu))) * bf2f((bf16)((gx >> 32) & 0xffffu));
                o.w = (y[mt].w * rstd * gg4.w + gb4.w + rk * bf2f((bf16)(vx >> 48))) * bf2f((bf16)(gx >> 48));
                *(unsigned long long*)(O + m * D_ + 512 + v) = pack4(o); }
        }
    }
}

__device__ __forceinline__ void ph_convfix(const Ctx& C, const float* HALO, const float* FIXU, const float* cw, const float* cb, bf16* ACT) {
    for (int idx = C.bid * NT + C.tid; idx < 128 * 22 * 2 * 128; idx += C.nb * NT) {
        const int j = idx & 127, rr = (idx >> 7) & 1, tile = idx >> 8, pm = tile / 22, pn = tile % 22;
        const bool seq0 = (pm & 31) == 0;
        const float* fx = FIXU + (size_t)tile * 512; const float* hl = HALO + (size_t)(tile - 22) * 512;
        const float u0g = fx[rr * 256 + j], u0v = fx[rr * 256 + 128 + j];
        float u1g, u1v, u2g, u2v;
        if (rr == 0) { u1g = seq0 ? 0.f : hl[256 + j]; u1v = seq0 ? 0.f : hl[256 + 128 + j]; u2g = seq0 ? 0.f : hl[j]; u2v = seq0 ? 0.f : hl[128 + j]; }
        else { u1g = fx[j]; u1v = fx[128 + j]; u2g = seq0 ? 0.f : hl[256 + j]; u2v = seq0 ? 0.f : hl[256 + 128 + j]; }
        const int jg = pn * 128 + j, jv = DFF + jg;
        const float gc = cb[jg] + cw[jg] * u2g + cw[NUP + jg] * u1g + cw[2 * NUP + jg] * u0g, vc = cb[jv] + cw[jv] * u2v + cw[NUP + jv] * u1v + cw[2 * NUP + jv] * u0v;
        ACT[(size_t)(pm * 256 + rr) * DFF + jg] = (bf16)f2bf(siluf_(gc) * vc);
    }
}
}

namespace pg8 {
struct EpiRes {
    static constexpr bool PERM = false, AFTER_DRAIN = false;
    const float* base; float* out; const float* gate; int gstride;
    __device__ __forceinline__ void operator()(const f32x4 (&acc)[2][2][4][2], const Unit& u, int wr, int wc, int fr, int fq) const {
        const int b = (u.pm * BM) / 8192; const float* gp = gate + (size_t)b * gstride;
        const int col0 = u.pn * BM + wc * 32 + 4 * fq;
        f32x4 gv[2][2];
#pragma unroll
        for (int bj = 0; bj < 2; ++bj)
#pragma unroll
            for (int n = 0; n < 2; ++n) gv[bj][n] = *(const f32x4*)(gp + col0 + bj * HALF + n * 16);
#pragma unroll
        for (int ai = 0; ai < 2; ++ai)
#pragma unroll
            for (int m = 0; m < 4; ++m) { const size_t off = (size_t)(u.pm * BM + ai * HALF + wr * 64 + m * 16 + fr) * 1024 + col0;
                f32x4 bs[2][2];
#pragma unroll
                for (int bj = 0; bj < 2; ++bj)
#pragma unroll
                    for (int n = 0; n < 2; ++n) bs[bj][n] = *(const f32x4*)(base + off + bj * HALF + n * 16);
#pragma unroll
                for (int bj = 0; bj < 2; ++bj)
#pragma unroll
                    for (int n = 0; n < 2; ++n) *(f32x4*)(out + off + bj * HALF + n * 16) = bs[bj][n] + gv[bj][n] * acc[ai][bj][m][n]; }
    }
};

template <bool BASE32> struct EpiResB {
    static constexpr bool PERM = true, AFTER_DRAIN = false;
    const float* base32; bf16_t* R; const float* gate; int gstride;
    __device__ __forceinline__ void operator()(const f32x4 (&acc)[2][2][4][2], const Unit& u, int wr, int wc, int fr, int fq) const {
        const int b = u.pm >> 5; const float* gp = gate + (size_t)b * gstride;
        const int col0 = u.pn * BM + wc * 32 + 8 * fq;
        f32x4 gv[2][2];
#pragma unroll
        for (int bj = 0; bj < 2; ++bj)
#pragma unroll
            for (int n = 0; n < 2; ++n) gv[bj][n] = *(const f32x4*)(gp + col0 + bj * HALF + n * 4);
#pragma unroll
        for (int ai = 0; ai < 2; ++ai)
#pragma unroll
            for (int m = 0; m < 4; ++m) { const size_t off = (size_t)(u.pm * BM + ai * HALF + wr * 64 + m * 16 + fr) * 1024 + col0;
                f32x4 bs[2][2];
#pragma unroll
                for (int bj = 0; bj < 2; ++bj) {
                    if (BASE32) { bs[bj][0] = *(const f32x4*)(base32 + off + bj * HALF); bs[bj][1] = *(const f32x4*)(base32 + off + bj * HALF + 4); }
                    else { const u32x4 r = *(const u32x4*)(R + off + bj * HALF);
                        bs[bj][0] = (f32x4){__builtin_bit_cast(float, r.x << 16), __builtin_bit_cast(float, r.x & 0xffff0000u), __builtin_bit_cast(float, r.y << 16), __builtin_bit_cast(float, r.y & 0xffff0000u)};
                        bs[bj][1] = (f32x4){__builtin_bit_cast(float, r.z << 16), __builtin_bit_cast(float, r.z & 0xffff0000u), __builtin_bit_cast(float, r.w << 16), __builtin_bit_cast(float, r.w & 0xffff0000u)}; } }
#pragma unroll
                for (int bj = 0; bj < 2; ++bj) { const f32x4 o0 = bs[bj][0] + gv[bj][0] * acc[ai][bj][m][0], o1 = bs[bj][1] + gv[bj][1] * acc[ai][bj][m][1];
                    u32x4 w; w.x = cvt_pk_bf16(o0.x, o0.y); w.y = cvt_pk_bf16(o0.z, o0.w); w.z = cvt_pk_bf16(o1.x, o1.y); w.w = cvt_pk_bf16(o1.z, o1.w);
                    *(u32x4*)(R + off + bj * HALF) = w; } }
    }
};
struct EpiConv {
    static constexpr bool PERM = true, AFTER_DRAIN = false;
    bf16_t* ACT; const float* cw; const float* cb; float* HALO; float* FIXU; PG8_LAS float* EX; int nN;
    template <int CTRL> static __device__ __forceinline__ float rot(float x) { return __builtin_bit_cast(float, __builtin_amdgcn_update_dpp(0, __builtin_bit_cast(int, x), CTRL, 0xf, 0xf, false)); }
    template <int CTRL> static __device__ __forceinline__ f32x4 rot4(f32x4 x) { return (f32x4){rot<CTRL>(x.x), rot<CTRL>(x.y), rot<CTRL>(x.z), rot<CTRL>(x.w)}; }
    __device__ __forceinline__ void operator()(const f32x4 (&acc)[2][2][4][2], const Unit& u, int wr, int wc, int fr, int fq) const {
        const int colw = wc * 32 + 8 * fq, tile = u.pm * nN + u.pn;
        if (fr >= 14) {
#pragma unroll
            for (int ai = 0; ai < 2; ++ai)
#pragma unroll
                for (int bj = 0; bj < 2; ++bj)
#pragma unroll
                    for (int n = 0; n < 2; ++n) { *(PG8_LAS f32x4*)(EX + ((ai * 2 + wr) * 2 + (fr - 14)) * 256 + bj * 128 + colw + 4 * n) = acc[ai][bj][3][n];
                        if (ai == 1 && wr == 1) *(f32x4*)(HALO + ((size_t)tile * 2 + (fr - 14)) * 256 + bj * 128 + colw + 4 * n) = acc[1][bj][3][n]; }
        }
        if (fr < 2 && wr == 0) {
#pragma unroll
            for (int bj = 0; bj < 2; ++bj)
#pragma unroll
                for (int n = 0; n < 2; ++n) *(f32x4*)(FIXU + ((size_t)tile * 2 + fr) * 256 + bj * 128 + colw + 4 * n) = acc[0][bj][0][n];
        }
        asm volatile("s_waitcnt lgkmcnt(0)" ::: "memory"); __builtin_amdgcn_s_barrier(); asm volatile("" ::: "memory");
#pragma unroll
        for (int n = 0; n < 2; ++n) {
            const int jg = u.pn * 128 + colw + 4 * n, jv = 2816 + jg;
            f32x4 cw0[2], cw1[2], cw2[2], cbb[2];
            cw0[0] = *(const f32x4*)(cw + jg); cw1[0] = *(const f32x4*)(cw + 5632 + jg); cw2[0] = *(const f32x4*)(cw + 2 * 5632 + jg); cbb[0] = *(const f32x4*)(cb + jg);
            cw0[1] = *(const f32x4*)(cw + jv); cw1[1] = *(const f32x4*)(cw + 5632 + jv); cw2[1] = *(const f32x4*)(cw + 2 * 5632 + jv); cbb[1] = *(const f32x4*)(cb + jv);
#pragma unroll
            for (int ai = 0; ai < 2; ++ai)
#pragma unroll
                for (int m = 0; m < 4; ++m) {
                    const int src = ai * 2 + wr - 1;
                    f32x4 res[2];
#pragma unroll
                    for (int bj = 0; bj < 2; ++bj) {
                        const f32x4 x = acc[ai][bj][m][n];
                        f32x4 x1 = rot4<0x121>(x), x2 = rot4<0x122>(x);
                        if (m > 0) { const f32x4 q = acc[ai][bj][m > 0 ? m - 1 : 0][n]; const f32x4 q1 = rot4<0x121>(q), q2 = rot4<0x122>(q);
                            if (fr == 0) x1 = q1; if (fr < 2) x2 = q2; }
                        else if (fr < 2) { f32x4 e14 = {0.f, 0.f, 0.f, 0.f}, e15 = e14;
                            if (src >= 0) { e14 = *(const PG8_LAS f32x4*)(EX + (src * 2 + 0) * 256 + bj * 128 + colw + 4 * n); e15 = *(const PG8_LAS f32x4*)(EX + (src * 2 + 1) * 256 + bj * 128 + colw + 4 * n); }
                            if (fr == 0) { x1 = e15; x2 = e14; } else x2 = e15; }
                        const f32x4 w0 = cw0[bj], w1 = cw1[bj], w2 = cw2[bj], bb = cbb[bj];
                        res[bj] = bb + w0 * x2 + w1 * x1 + w2 * x;
                    }
                    const f32x4 gc = res[0], vc = res[1];
                    f32x4 o;
                    o.x = gc.x * __builtin_amdgcn_rcpf(1.f + __expf(-gc.x)) * vc.x; o.y = gc.y * __builtin_amdgcn_rcpf(1.f + __expf(-gc.y)) * vc.y;
                    o.z = gc.z * __builtin_amdgcn_rcpf(1.f + __expf(-gc.z)) * vc.z; o.w = gc.w * __builtin_amdgcn_rcpf(1.f + __expf(-gc.w)) * vc.w;
                    typedef unsigned u32x2 __attribute__((ext_vector_type(2)));
                    u32x2 w; w.x = cvt_pk_bf16(o.x, o.y); w.y = cvt_pk_bf16(o.z, o.w);
                    *(u32x2*)(ACT + (size_t)(u.pm * BM + ai * HALF + wr * 64 + m * 16 + fr) * 2816 + u.pn * 128 + colw + 4 * n) = w;
                }
        }
    }
};
}

namespace hy {
struct Args { const float* in[31]; float* out; unsigned char* ws; };
__global__ void __launch_bounds__(NT, 2) hy_fwd(Args A) {
    extern __shared__ __attribute__((aligned(16))) unsigned char lds_raw[];
    Ctx C; C.bid = blockIdx.x; C.nb = gridDim.x; C.tid = threadIdx.x; C.lane = C.tid & 63; C.wave = __builtin_amdgcn_readfirstlane(C.tid >> 6); C.lds = (LAS unsigned char*)lds_raw;
    volatile LAS unsigned* MISC = (volatile LAS unsigned*)(C.lds + MISC_OFF);
    for (int u = C.tid; u < (LDS_BYTES - MISC_OFF) / 4; u += NT) ((LAS unsigned*)(C.lds + MISC_OFF))[u] = 0u;
    __syncthreads();
    unsigned char* ws = A.ws;
    const int wave0 = __builtin_amdgcn_readfirstlane(threadIdx.x >> 6);
    (void)xcd_barrier_post((unsigned*)(ws + WS_CTL) + CW_BAR, MISC + 8);
#define PHASE_BEGIN() do { int t_ = wave0 * 64 + lane_now(); int b_ = blockIdx.x; asm volatile("" : "+s"(b_)); \
    C.tid = t_; C.lane = t_ & 63; C.wave = __builtin_amdgcn_readfirstlane(t_ >> 6); C.bid = b_; } while (0)
#ifdef HY_DIAG
    unsigned long long ts_last = __builtin_amdgcn_s_memrealtime(); float tacc[10] = {0.f, 0.f, 0.f, 0.f, 0.f, 0.f, 0.f, 0.f, 0.f, 0.f};
#define GRID_BAR(cat) do { { XcdBarrier b_; b_.bar = (unsigned*)(A.ws + WS_CTL) + CW_BAR; b_.x = xb_xcc_id(); b_.st = (volatile LAS unsigned*)(C.lds + MISC_OFF) + 8; xcd_barrier(b_, wave0 == 0 && lane_now() == 0); } PHASE_BEGIN(); { const unsigned long long n_ = __builtin_amdgcn_s_memrealtime(); tacc[cat] += (float)(n_ - ts_last); ts_last = n_; } } while (0)
#else
#define GRID_BAR(cat) do { { XcdBarrier b_; b_.bar = (unsigned*)(A.ws + WS_CTL) + CW_BAR; b_.x = xb_xcc_id(); b_.st = (volatile LAS unsigned*)(C.lds + MISC_OFF) + 8; xcd_barrier(b_, wave0 == 0 && lane_now() == 0); } PHASE_BEGIN(); } while (0)
#endif
#ifndef HY_REPCAT
#define HY_REPCAT (-1)
#endif
#define NREP(cat) ((HY_REPCAT == (cat)) ? 2 : 1)
    float* out = A.out;
    bf16* RES = (bf16*)((unsigned char*)A.out + 64 * MiB);
#define in A.in
    float* MOD = (float*)(ws + WS_MOD);
    bf16 *WIN = (bf16*)(ws + WS_WIN), *WOUT = (bf16*)(ws + WS_WOUT), *WUP = (bf16*)(ws + WS_WUP), *WDN = (bf16*)(ws + WS_WDN);
    bf16 *XB = (bf16*)(ws + WS_XB), *O = (bf16*)(ws + WS_O), *VF = (bf16*)(ws + WS_VF), *PG = (bf16*)(ws + WS_PG), *PR = (bf16*)(ws + WS_PR), *VL = (bf16*)(ws + WS_VL);
    bf16 *RH = (bf16*)(ws + WS_RH), *YH = (bf16*)(ws + WS_YH), *PP = (bf16*)(ws + WS_PP), *QQ = (bf16*)(ws + WS_QQ), *GG = (bf16*)(ws + WS_GG), *S0 = (bf16*)(ws + WS_S0);
    float *GAMC = (float*)(ws + WS_GAMC), *RK = (float*)(ws + WS_RK);
    bf16* LORA = (bf16*)(ws + WS_LORA);
    bf16* DS = (bf16*)(ws + WS_GK); float* GAM = (float*)(ws + WS_GAM);
    bf16* ACT = (bf16*)(ws + WS_ACT); float *HALO = (float*)(ws + WS_U), *FIXU = (float*)(ws + WS_U + 8 * MiB);

    ph_mod(C, in[1], in[2], in[3], MOD);
    for (int l = 0; l < L_; ++l) {
        const float* modl = MOD + (size_t)l * 4 * 6144;
        for (int r_ = 0; r_ < NREP(0); ++r_) {
        wprep_mat(C, in[5] + (size_t)l * D_ * IN_COLS, D_, IN_COLS, NIN, WIN, 1, l ? in[6] : nullptr);
        wprep_mat(C, in[24] + (size_t)l * D_ * D_, D_, D_, D_, WOUT, 0, nullptr);
        wprep_mat(C, in[26] + (size_t)l * D_ * NUP, D_, NUP, NUP, WUP, 2, nullptr);
        wprep_mat(C, in[29] + (size_t)l * DFF * D_, DFF, D_, D_, WDN, 0, nullptr);
        wprep_mat(C, in[12] + (size_t)l * 64 * 512, 64, 512, 512, LORA, 0, nullptr);
        wprep_mat(C, in[14] + (size_t)l * 64 * 512, 64, 512, 512, LORA + 512 * 64, 0, nullptr);
        wprep_mat(C, in[16] + (size_t)l * 128 * 512, 128, 512, 512, LORA + 2 * 512 * 64, 0, nullptr);
        if (l) wprep_mat(C, in[17], 32, 512, 512, LORA + 2 * 512 * 64 + 512 * 128, 0, nullptr);
        }
        GRID_BAR(0);
        for (int r_ = 0; r_ < NREP(1); ++r_) { if (l == 0) ph_norm(C, in[0], in[4], modl + 0 * D_, modl + 1 * D_, XB); else ph_norm_b(C, RES, in[4] + l * D_, modl + 0 * D_, modl + 1 * D_, XB); }
        GRID_BAR(1);
        for (int r_ = 0; r_ < NREP(2); ++r_) { pg8::Gemm g{XB, WIN, M_, NIN, D_}; pg8::StaticOrder S; S.init(M_, NIN, C.nb, C.bid, HY_WGM_IN);
          pg8::EpiBf16<0> E{PG, NPG, nullptr, NPG, (WS_PR - WS_PG) / 2, 1.f};
          pg8::gemm_phase<pg8::EpiBf16<0>, pg8::StaticOrder, true, true>(C.lds, g, S, E, C.tid); }
        GRID_BAR(2);
        for (int r_ = 0; r_ < NREP(3); ++r_) {
        ph_gla_a(C, PG, in[7] + l * 16 * 256, in[8] + l * 256, DS, GAM);
        { RwkvW W{in[10] + l * 1792, in[11], in[13] + l * 512, in[15] + l * 512, in[18], in[19] + l * 512, in[20] + l * 512, in[21] + l * 512,
                  LORA, LORA + 512 * 64, LORA + 2 * 512 * 64, LORA + 2 * 512 * 64 + 512 * 128};
          ph_rwkv_a(C, PR, PG, W, l, PP, QQ, RH, YH, GAMC, RK, GG, VF, r_ == NREP(3) - 1); } }
        GRID_BAR(3);
        if (C.bid < 32) { for (int r_ = 0; r_ < NREP(4); ++r_) ph_rwkv_b(C, C.bid, PP, QQ, GAMC, S0); }
        else { Ctx C2 = C; C2.bid = C.bid - 32; C2.nb = C.nb - 32;
               ph_gla_b(C2, DS, GAM);
               group_barrier((unsigned*)(ws + WS_CTL) + 2048, (unsigned)(C.nb - 32) * (unsigned)(l + 1), wave0 == 0 && lane_now() == 0);
               PHASE_BEGIN(); C2 = C; C2.bid = C.bid - 32; C2.nb = C.nb - 32;
               ph_gla_c(C2, PG, in[7] + l * 16 * 256, in[8] + l * 256, in[9] + l * 128, DS, O); }
        GRID_BAR(4);
        for (int r_ = 0; r_ < NREP(5); ++r_) {
        ph_rwkv_c(C, S0, RH, YH, RK, GG, VF, in[22] + l * 512, in[23] + l * 512, O); }
        GRID_BAR(5);
        { pg8::Gemm g{O, WOUT, M_, D_, D_}; pg8::StaticOrder S; S.init(M_, D_, C.nb, C.bid);
          if (l == 0) { pg8::EpiResB<true> E{in[0], RES, modl + 2 * D_, 6144}; pg8::gemm_phase<pg8::EpiResB<true>, pg8::StaticOrder, true, true>(C.lds, g, S, E, C.tid); }
          else { pg8::EpiResB<false> E{nullptr, RES, modl + 2 * D_, 6144}; pg8::gemm_phase<pg8::EpiResB<false>, pg8::StaticOrder, true, true>(C.lds, g, S, E, C.tid); } }
        GRID_BAR(6);
        for (int r_ = 0; r_ < NREP(1); ++r_) ph_norm_b(C, RES, in[25] + l * D_, modl + 3 * D_, modl + 4 * D_, XB);
        GRID_BAR(1);
        for (int r_ = 0; r_ < NREP(7); ++r_) { pg8::Gemm g{XB, WUP, M_, NUP, D_}; pg8::StaticOrder S; S.init(M_, NUP, C.nb, C.bid, HY_WGM_UP);
          pg8::EpiConv E{ACT, in[27] + (size_t)l * 3 * NUP, in[28] + (size_t)l * NUP, HALO, FIXU, (PG8_LAS float*)(C.lds + RING_BYTES), NUP / 256};
          pg8::gemm_phase<pg8::EpiConv, pg8::StaticOrder, true, true>(C.lds, g, S, E, C.tid); }
        GRID_BAR(7);
        for (int r_ = 0; r_ < NREP(8); ++r_) ph_convfix(C, HALO, FIXU, in[27] + (size_t)l * 3 * NUP, in[28] + (size_t)l * NUP, ACT);
        GRID_BAR(8);
        { pg8::Gemm g{ACT, WDN, M_, D_, DFF}; pg8::StaticOrder S; S.init(M_, D_, C.nb, C.bid);
          pg8::EpiResB<false> E{nullptr, RES, modl + 5 * D_, 6144};
          pg8::gemm_phase<pg8::EpiResB<false>, pg8::StaticOrder, true, true>(C.lds, g, S, E, C.tid); }
        GRID_BAR(9);
    }
    ph_final_b(C, RES, in[30], out, 0, M_ / 2, XB, M_ / 2, M_);
    GRID_BAR(1);
    ph_final_b(C, XB - (size_t)(M_ / 2) * D_, in[30], out, M_ / 2, M_, nullptr, 0, 0);
#ifdef HY_DIAG
    GRID_BAR(1);
    if (C.bid == 0) { if (C.tid == 0) out[0] = tacc[HY_DIAG_A] * 0.1f; for (int i = 1 + C.tid; i <= 10000; i += NT) out[i] = tacc[HY_DIAG_B] * 0.01f; }
#endif
#undef GRID_BAR
#undef PHASE_BEGIN
#undef in
}
}

extern "C" void kernel_launch(void* const* d_in, const int* in_sizes, int n_in, void* d_out, int out_size, void* d_ws, size_t ws_size, hipStream_t stream) {
    using namespace hy;
    static int grid = 0;
    if (grid == 0) {
        if (n_in != 31 || in_sizes[0] != M_ * D_ || out_size != M_ * D_ || ws_size < WS_END) { fprintf(stderr, "kernel_launch: unexpected shapes (n_in %d, in0 %d, out %d, ws %zu)\n", n_in, n_in > 0 ? in_sizes[0] : -1, out_size, ws_size); grid = -1; return; }
        if (hipFuncSetAttribute((const void*)hy_fwd, hipFuncAttributeMaxDynamicSharedMemorySize, LDS_BYTES) != hipSuccess) { fprintf(stderr, "kernel_launch: hipFuncSetAttribute failed\n"); grid = -1; return; }
        int dev = 0, cus = 0, per_cu = 0;
        (void)hipGetDevice(&dev); (void)hipDeviceGetAttribute(&cus, hipDeviceAttributeMultiprocessorCount, dev);
        (void)hipOccupancyMaxActiveBlocksPerMultiprocessor(&per_cu, (const void*)hy_fwd, NT, LDS_BYTES);
        if (per_cu < 1) fprintf(stderr, "kernel_launch: occupancy query reports %d blocks per CU\n", per_cu);
        (void)hipGetLastError();
        grid = cus > 0 ? cus : 256;
    }
    if (grid < 0) return;
    (void)hipMemsetAsync((char*)d_ws + WS_CTL, 0, CTL_ZERO_BYTES, stream);
    Args a{};
    for (int i = 0; i < 31; ++i) a.in[i] = (const float*)d_in[i];
    a.out = (float*)d_out; a.ws = (unsigned char*)d_ws;
    hipLaunchKernelGGL(hy_fwd, dim3(grid), dim3(NT), LDS_BYTES, stream, a);
}
```

```cpp
#include <hip/hip_runtime.h>
#include <cstdio>
#include <cstdint>
namespace pg8 {
#define PG8_LAS __attribute__((address_space(3)))
typedef unsigned short bf16_t;
typedef short bf16x8 __attribute__((ext_vector_type(8)));
typedef float f32x4 __attribute__((ext_vector_type(4)));
typedef unsigned u32x4 __attribute__((ext_vector_type(4)));
constexpr int BM = 256, BK = 64, HALF = 128, HTB = HALF * BK * 2  , STAGE_BYTES = 8 * HTB, NXCD = 8;

__host__ __device__ __forceinline__ int lds_byte(int r, int c) { const int st = (r >> 4) * 2 + (c >> 5), rr = r & 15, cc = c & 31, ob = rr * 64 + cc * 2; return st * 1024 + (ob ^ (((ob >> 9) & 1) << 5)); }
__host__ __device__ __forceinline__ void stage_rc(int b, int& R, int& C) { const int st = b / 1024, sb = b % 1024, swz = sb ^ (((sb >> 9) & 1) << 5); R = (st >> 1) * 16 + swz / 64; C = (st & 1) * 32 + (swz % 64) / 2; }
__host__ __device__ __forceinline__ int perm32(int rho) { const int n = rho >> 4, i = rho & 15; return 8 * (i >> 2) + 4 * n + (i & 3); }

struct Unit { int pm, pn; };
struct Gemm { const bf16_t* A; const bf16_t* Bt; int M, N, K; size_t bstride; };

struct StaticOrder {
    int nM, nN, nwg, G, c, WGM;
    __host__ __device__ void init(int M, int N, int G_, int c_, int wgm = 2) { nM = M / BM; nN = N / BM; nwg = nM * nN; G = G_; c = c_; WGM = wgm; }
    __host__ __device__ bool next(int i, Unit& u) const {
        const long L = (long)i * G + c; if (L >= nwg) return false;
        int wgid = (int)L; { const int q = nwg / NXCD, r = nwg % NXCD, xcd = wgid % NXCD, off = wgid / NXCD; wgid = (xcd < r ? xcd * (q + 1) : r * (q + 1) + (xcd - r) * q) + off; }
        const int nig = WGM * nN, gid = wgid / nig, fm = gid * WGM, gsz = (nM - fm) < WGM ? (nM - fm) : WGM;
        u.pm = fm + ((wgid % nig) % gsz); u.pn = (wgid % nig) / gsz; return true;
    }
    __device__ __forceinline__ void a_ready(const Unit&) const {}
    __device__ __forceinline__ void done(const Unit&) const {}
};

__device__ __forceinline__ unsigned cvt_pk_bf16(float lo, float hi) { unsigned r; asm volatile("v_cvt_pk_bf16_f32 %0, %1, %2" : "=v"(r) : "v"(lo), "v"(hi)); return r; }
typedef float f32x2 __attribute__((ext_vector_type(2)));
__device__ __forceinline__ f32x2 gelu_pk(f32x2 v) {
    const f32x2 av = __builtin_elementwise_abs(v), d = av * 0.2316418882f + 1.0f;
    f32x2 t; t.x = __builtin_amdgcn_rcpf(d.x); t.y = __builtin_amdgcn_rcpf(d.y);
    f32x2 q = t * 0.5307027145f + (-0.7265760135f); q = q * t + 0.7107068705f; q = q * t + (-0.142248368f); q = q * t + 0.127414796f; q = q * t;
    const f32x2 s = (v * v) * (-0.72134752044f);
    f32x2 e; e.x = __builtin_amdgcn_exp2f(s.x); e.y = __builtin_amdgcn_exp2f(s.y);
    const f32x2 m = v * (q * e), r = v - m;
    f32x2 o; o.x = v.x < 0.f ? m.x : r.x; o.y = v.y < 0.f ? m.y : r.y; return o;
}

template <int ACT  > struct EpiBf16 {
    static constexpr bool PERM = true, AFTER_DRAIN = false; static_assert(ACT == 0 || ACT == 1, "EpiBf16: ACT is 0 (none) or 1 (gelu_pk)");
    bf16_t* O; int ldc; const float* bias; int split_cols; size_t split_stride; float scale0;
    __device__ __forceinline__ void operator()(const f32x4 (&acc)[2][2][4][2], const Unit& u, int wr, int wc, int fr, int fq) const {
        const int row0 = u.pm * BM + wr * 64 + fr; int colt = u.pn * BM; bf16_t* base = O;
        float sc = 1.f; if (split_cols) { const int t = colt / split_cols; base += (size_t)t * split_stride; colt -= t * split_cols; if (t == 0) sc = scale0; }
        const int col0 = colt + wc * 32 + 8 * fq, bcol0 = u.pn * BM + wc * 32 + 8 * fq;
        f32x4 bv[2][2];
#pragma unroll
        for (int bj = 0; bj < 2; ++bj)
#pragma unroll
            for (int n = 0; n < 2; ++n) bv[bj][n] = bias ? *(const f32x4*)(bias + bcol0 + bj * HALF + 4 * n) : (f32x4){0.f, 0.f, 0.f, 0.f};
#pragma unroll
        for (int ai = 0; ai < 2; ++ai)
#pragma unroll
            for (int m = 0; m < 4; ++m) { bf16_t* rowp = base + (size_t)(row0 + ai * HALF + m * 16) * ldc + col0;
#pragma unroll
                for (int bj = 0; bj < 2; ++bj) { f32x4 v0 = acc[ai][bj][m][0] + bv[bj][0], v1 = acc[ai][bj][m][1] + bv[bj][1];
                    if (ACT == 1) { f32x2 a = gelu_pk((f32x2){v0[0], v0[1]}), b = gelu_pk((f32x2){v0[2], v0[3]}), c = gelu_pk((f32x2){v1[0], v1[1]}), d = gelu_pk((f32x2){v1[2], v1[3]});
                        v0 = (f32x4){a.x, a.y, b.x, b.y}; v1 = (f32x4){c.x, c.y, d.x, d.y}; }
                    v0 = v0 * sc; v1 = v1 * sc; u32x4 w; w.x = cvt_pk_bf16(v0[0], v0[1]); w.y = cvt_pk_bf16(v0[2], v0[3]); w.z = cvt_pk_bf16(v1[0], v1[1]); w.w = cvt_pk_bf16(v1[2], v1[3]);
                    *(u32x4*)(rowp + bj * HALF) = w; } }
    }
};
template <class Epi, class Sched, bool ALIGN_EPI = false, bool SP2 = false>
__device__ __forceinline__ void gemm_phase(PG8_LAS unsigned char* lds, const Gemm g, const Sched& S, const Epi& E, int tid_in) {
    int tid_ = tid_in; asm volatile("" : "+v"(tid_));
    const int tid = tid_, wid = __builtin_amdgcn_readfirstlane(tid >> 6), lane = tid & 63, wr = wid >> 2, wc = wid & 3, fr = lane & 15, fq = lane >> 4;
    const int K = g.K, nt = K / BK;
    unsigned voffA[2], voffB[2];
#pragma unroll
    for (int i = 0; i < 2; ++i) { int R, C; stage_rc(tid * 16 + i * 8192, R, C); const int Rb = Epi::PERM ? ((R & ~31) + perm32(R & 31)) : R;
        voffA[i] = (unsigned)(R * K + C) * 2u; voffB[i] = (unsigned)(Rb * K + C) * 2u; }
    const size_t kstep = (size_t)(BK * 2);
    const size_t hstep = (size_t)HALF * K * 2;
    const size_t tstep = 2 * hstep;
    const unsigned ldsw = (unsigned)wid * 1024u;
    const int aoff = lds_byte(wr * 64 + fr, fq * 8), boff = lds_byte(wc * 32 + fr, fq * 8);
#define PG8_SA(b, h) (((b) * 2 + (h)) * HTB)
#define PG8_SB(b, h) ((4 + (b) * 2 + (h)) * HTB)
#define PG8_STAGE(bufoff, gbase, voff) do { _Pragma("unroll") for (int _i = 0; _i < 2; ++_i) \
        __builtin_amdgcn_global_load_lds((const unsigned*)((const char*)(gbase) + (voff)[_i]), (PG8_LAS unsigned*)(lds + (bufoff) + ldsw + _i * 8192), 16, 0, 0); } while (0)
#define PG8_LDA(dst, b, h) do { _Pragma("unroll") for (int m = 0; m < 4; ++m) _Pragma("unroll") for (int k = 0; k < 2; ++k) dst[m][k] = *(const PG8_LAS bf16x8*)(lds + PG8_SA(b, h) + aoff + m * 2048 + k * 1024); } while (0)
#define PG8_LDB(dst, b, h) do { _Pragma("unroll") for (int n = 0; n < 2; ++n) _Pragma("unroll") for (int k = 0; k < 2; ++k) dst[n][k] = *(const PG8_LAS bf16x8*)(lds + PG8_SB(b, h) + boff + n * 2048 + k * 1024); } while (0)
#define PG8_MMA(ai, bj, At, Bt) do { __builtin_amdgcn_s_setprio(1); _Pragma("unroll") for (int m = 0; m < 4; ++m) _Pragma("unroll") for (int n = 0; n < 2; ++n) _Pragma("unroll") for (int k = 0; k < 2; ++k) \
        acc[ai][bj][m][n] = __builtin_amdgcn_mfma_f32_16x16x32_bf16(Bt[n][k], At[m][k], acc[ai][bj][m][n], 0, 0, 0); __builtin_amdgcn_s_setprio(0); } while (0)
#define PG8_WAIT_V(n) asm volatile("s_waitcnt vmcnt(" #n ")" ::: "memory")
#define PG8_WAIT_L(n) asm volatile("s_waitcnt lgkmcnt(" #n ")" ::: "memory")
#define PG8_BAR __builtin_amdgcn_s_barrier()
#define PG8_SCHED __builtin_amdgcn_sched_barrier(0)
    Unit cur, nxt; int ui = 0;
    if (!S.next(0, cur)) return;
    f32x4 acc[2][2][4][2];
#pragma unroll
    for (int a = 0; a < 2; ++a)
#pragma unroll
        for (int b = 0; b < 2; ++b)
#pragma unroll
            for (int m = 0; m < 4; ++m)
#pragma unroll
                for (int n = 0; n < 2; ++n) acc[a][b][m][n] = (f32x4){0.f, 0.f, 0.f, 0.f};
    bf16x8 At[4][2], B0[2][2], B1[2][2];
    const char* cA = (const char*)g.A + (size_t)cur.pm * tstep; const char* cB = (const char*)g.Bt + (size_t)cur.pn * tstep + (size_t)(cur.pm >> 5) * g.bstride;
    S.a_ready(cur);
    if constexpr (SP2) {
        PG8_STAGE(PG8_SB(0, 0), cB, voffB); PG8_STAGE(PG8_SB(0, 1), cB + hstep, voffB); PG8_STAGE(PG8_SA(0, 0), cA, voffA); PG8_STAGE(PG8_SA(0, 1), cA + hstep, voffA);
        if (wr == 1) PG8_BAR;
        PG8_WAIT_V(2); PG8_BAR;
        PG8_STAGE(PG8_SB(1, 0), cB + kstep, voffB); PG8_STAGE(PG8_SA(1, 0), cA + kstep, voffA); PG8_STAGE(PG8_SB(1, 1), cB + hstep + kstep, voffB);
        PG8_WAIT_V(6); PG8_BAR;
    } else {
        PG8_STAGE(PG8_SB(0, 0), cB, voffB); PG8_STAGE(PG8_SA(0, 0), cA, voffA); PG8_STAGE(PG8_SB(0, 1), cB + hstep, voffB); PG8_STAGE(PG8_SA(0, 1), cA + hstep, voffA);
        if (wr == 1) PG8_BAR;
        PG8_WAIT_V(4); PG8_BAR;
        PG8_STAGE(PG8_SB(1, 0), cB + kstep, voffB); PG8_STAGE(PG8_SA(1, 0), cA + kstep, voffA); PG8_STAGE(PG8_SB(1, 1), cB + hstep + kstep, voffB);
        PG8_WAIT_V(6); PG8_BAR;
    }
    for (;;) {
        const bool has_next = S.next(ui + 1, nxt);
        const char* nA = has_next ? (const char*)g.A + (size_t)nxt.pm * tstep : cA; const char* nB = has_next ? (const char*)g.Bt + (size_t)nxt.pn * tstep + (size_t)(nxt.pm >> 5) * g.bstride : cB;
        for (int t = 0; t < nt; t += 2) {
            const bool last = (t == nt - 2);
            const char* a1 = cA + (size_t)(t + 1) * kstep;
            const char* a2 = last ? nA : cA + (size_t)(t + 2) * kstep; const char* b2 = last ? nB : cB + (size_t)(t + 2) * kstep;
            const char* a3 = a2 + kstep; const char* b3 = b2 + kstep;
            if (last && has_next) S.a_ready(nxt);
            if constexpr (SP2) {
            PG8_LDB(B0, 0, 0); PG8_LDB(B1, 0, 1); PG8_SCHED; PG8_LDA(At, 0, 0); PG8_STAGE(PG8_SA(1, 1), a1 + hstep, voffA);
            PG8_WAIT_V(8); PG8_WAIT_L(0); PG8_BAR; PG8_MMA(0, 0, At, B0); PG8_MMA(0, 1, At, B1); PG8_BAR; PG8_SCHED;
            PG8_LDA(At, 0, 1); PG8_STAGE(PG8_SB(0, 0), b2, voffB); PG8_STAGE(PG8_SB(0, 1), b2 + hstep, voffB); PG8_STAGE(PG8_SA(0, 0), a2, voffA);
            PG8_WAIT_V(8); PG8_WAIT_L(0); PG8_BAR; PG8_MMA(1, 0, At, B0); PG8_MMA(1, 1, At, B1); PG8_BAR; PG8_SCHED;
            PG8_LDB(B0, 1, 0); PG8_LDB(B1, 1, 1); PG8_SCHED; PG8_LDA(At, 1, 0); PG8_STAGE(PG8_SA(0, 1), a2 + hstep, voffA);
            PG8_WAIT_V(8); PG8_WAIT_L(0); PG8_BAR; PG8_MMA(0, 0, At, B0); PG8_MMA(0, 1, At, B1); PG8_BAR; PG8_SCHED;
            PG8_LDA(At, 1, 1); PG8_STAGE(PG8_SB(1, 0), b3, voffB); PG8_STAGE(PG8_SB(1, 1), b3 + hstep, voffB); PG8_STAGE(PG8_SA(1, 0), a3, voffA);
            PG8_WAIT_V(8); PG8_WAIT_L(0); PG8_BAR; PG8_MMA(1, 0, At, B0); PG8_MMA(1, 1, At, B1); PG8_BAR; PG8_SCHED;
            } else {
            PG8_LDB(B0, 0, 0); PG8_SCHED; PG8_LDA(At, 0, 0); PG8_STAGE(PG8_SA(1, 1), a1 + hstep, voffA);
            PG8_WAIT_L(8); PG8_BAR; PG8_WAIT_L(0); PG8_MMA(0, 0, At, B0); PG8_BAR; PG8_SCHED;
            PG8_LDB(B1, 0, 1); PG8_STAGE(PG8_SB(0, 0), b2, voffB);
            PG8_BAR; PG8_WAIT_L(0); PG8_MMA(0, 1, At, B1); PG8_BAR;
            PG8_LDA(At, 0, 1); PG8_STAGE(PG8_SA(0, 0), a2, voffA);
            PG8_BAR; PG8_WAIT_L(0); PG8_MMA(1, 0, At, B0); PG8_BAR; PG8_SCHED;
            PG8_STAGE(PG8_SB(0, 1), b2 + hstep, voffB);
            PG8_WAIT_V(6); PG8_BAR; PG8_MMA(1, 1, At, B1); PG8_BAR;
            PG8_LDB(B0, 1, 0); PG8_SCHED; PG8_LDA(At, 1, 0); PG8_STAGE(PG8_SA(0, 1), a2 + hstep, voffA);
            PG8_WAIT_L(8); PG8_BAR; PG8_WAIT_L(0); PG8_MMA(0, 0, At, B0); PG8_BAR; PG8_SCHED;
            PG8_LDB(B1, 1, 1); PG8_STAGE(PG8_SB(1, 0), b3, voffB);
            PG8_BAR; PG8_WAIT_L(0); PG8_MMA(0, 1, At, B1); PG8_BAR;
            PG8_LDA(At, 1, 1); PG8_STAGE(PG8_SA(1, 0), a3, voffA);
            PG8_BAR; PG8_WAIT_L(0); PG8_MMA(1, 0, At, B0); PG8_BAR; PG8_SCHED;
            PG8_STAGE(PG8_SB(1, 1), b3 + hstep, voffB);
            PG8_WAIT_V(6); PG8_BAR; PG8_MMA(1, 1, At, B1); PG8_BAR;
            }
        }
        if constexpr (ALIGN_EPI) { if (wr == 0) PG8_BAR; }
        if constexpr (!Epi::AFTER_DRAIN) { E(acc, cur, wr, wc, fr, fq); S.done(cur); }
        if (!has_next) break;
#pragma unroll
        for (int a = 0; a < 2; ++a)
#pragma unroll
            for (int b = 0; b < 2; ++b)
#pragma unroll
                for (int m = 0; m < 4; ++m)
#pragma unroll
                    for (int n = 0; n < 2; ++n) acc[a][b][m][n] = (f32x4){0.f, 0.f, 0.f, 0.f};
        cur = nxt; cA = nA; cB = nB; ++ui;
        if constexpr (ALIGN_EPI) { if (wr == 1) PG8_BAR; }
    }
    PG8_WAIT_V(0);
    if constexpr (!ALIGN_EPI) { if (wr == 0) PG8_BAR; }
    PG8_BAR;
    if constexpr (Epi::AFTER_DRAIN) { E.fused(acc, cur, wr, wc, fr, fq, lds, wid, lane); S.done(cur); }
#undef PG8_SA
#undef PG8_SB
#undef PG8_STAGE
#undef PG8_LDA
#undef PG8_LDB
#undef PG8_MMA
#undef PG8_WAIT_V
#undef PG8_WAIT_L
#undef PG8_BAR
#undef PG8_SCHED
}
}

#ifndef HY_WGM_IN
#define HY_WGM_IN 2
#endif
#ifndef HY_WGM_UP
#define HY_WGM_UP 2
#endif
namespace hy {
#define GAS __attribute__((address_space(1)))
#define LAS __attribute__((address_space(3)))
typedef unsigned short bf16;
typedef unsigned v4u __attribute__((ext_vector_type(4)));
typedef float f32x4 __attribute__((ext_vector_type(4)));
typedef short bf16x8 __attribute__((ext_vector_type(8)));
typedef GAS unsigned gu32;
typedef GAS unsigned long long gu64;
#define RLX_AGENT __ATOMIC_RELAXED, __HIP_MEMORY_SCOPE_AGENT
#define LDS_WAIT() asm volatile("s_waitcnt lgkmcnt(0)" ::: "memory")
#define VM_WAIT() asm volatile("s_waitcnt vmcnt(0)" ::: "memory")
__device__ __forceinline__ unsigned long long rt() { return __builtin_amdgcn_s_memrealtime(); }
typedef __bf16 hwbf2 __attribute__((ext_vector_type(2))); typedef float hwf2 __attribute__((ext_vector_type(2)));
__device__ __forceinline__ unsigned f2bf(float f) { return (unsigned)__builtin_bit_cast(unsigned short, (__bf16)f); }
__device__ __forceinline__ unsigned pk2(float lo, float hi) { const hwf2 v = {lo, hi}; return __builtin_bit_cast(unsigned, __builtin_convertvector(v, hwbf2)); }
#define XB_TMO      128
#define XB_XCNT(j)  (256  + 64 * (j))
#define XB_XSUB(j)  (1280 + 64 * (j))
#define XB_XGEN(j)  (2304 + 64 * (j))
#define XB_TOP      3328
#define XB_TOPGEN   3392
#define XCD_BAR_WORDS 3456
#define XB_SPIN_CAP (1u << 18)

__device__ __forceinline__ unsigned xb_ld(unsigned* p)              { return __hip_atomic_load(p, __ATOMIC_RELAXED, __HIP_MEMORY_SCOPE_AGENT); }
__device__ __forceinline__ unsigned xb_add(unsigned* p, unsigned v) { return __hip_atomic_fetch_add(p, v, __ATOMIC_RELAXED, __HIP_MEMORY_SCOPE_AGENT); }
__device__ __forceinline__ unsigned xb_xcc_id() { return (unsigned)__builtin_amdgcn_s_getreg((3 << 11) | 20) & 0xFu; }
#define XB_SPIN(cond, bar) do { unsigned _sp = 0; while (cond) { __builtin_amdgcn_s_sleep(1); \
    if ((++_sp & 255u) == 0u) { if (xb_ld(&(bar)[XB_TMO])) break; if (_sp > XB_SPIN_CAP) { atomicAdd(&(bar)[XB_TMO], 1u); break; } } } } while (0)

struct XcdBarrier {
    unsigned* bar; unsigned x;
    volatile LAS unsigned* st;
};

__device__ __forceinline__ XcdBarrier xcd_barrier_post(unsigned* bar, volatile LAS unsigned* st) {
    XcdBarrier b; b.bar = bar; b.x = xb_xcc_id(); b.st = st;
    if (threadIdx.x == 0) (void)xb_add(&bar[XB_XCNT(b.x)], 1u);
    return b;
}
__device__ __forceinline__ void xcd_barrier_complete(unsigned* bar, unsigned x, unsigned& nloc, unsigned& nx) {
    const unsigned G = gridDim.x * gridDim.y * gridDim.z;
    unsigned sum, cnt, mine, sp = 0u;
    for (;;) {
        sum = 0u; cnt = 0u; mine = 0u;
#pragma unroll
        for (unsigned j = 0; j < 16; ++j) { const unsigned c = xb_ld(&bar[XB_XCNT(j)]); sum += c; cnt += (c > 0u) ? 1u : 0u; mine = (j == x) ? c : mine; }
        if (sum == G) break;
        __builtin_amdgcn_s_sleep(1);
        if ((++sp & 255u) == 0u) { if (xb_ld(&bar[XB_TMO])) break; if (sp > XB_SPIN_CAP) { atomicAdd(&bar[XB_TMO], 1u); break; } }
    }
    nloc = mine > 0u ? mine : 1u; nx = cnt > 0u ? cnt : 1u;
}

__device__ __forceinline__ void xcd_barrier(const XcdBarrier& b, bool leader  ) {
    asm volatile("s_waitcnt vmcnt(0)" ::: "memory");
    __syncthreads();
    if (leader) {
        unsigned* bar = b.bar;
        __builtin_amdgcn_s_waitcnt(0);
        unsigned nloc = b.st[0], nx = b.st[1];
        if (nloc == 0u) { xcd_barrier_complete(bar, b.x, nloc, nx); b.st[0] = nloc; b.st[1] = nx; }
        const unsigned old = xb_add(&bar[XB_XSUB(b.x)], 1u);
        const unsigned gen = old / nloc;
        if (old + 1u == (gen + 1u) * nloc) {
            __builtin_amdgcn_fence(__ATOMIC_RELEASE, "agent");
            asm volatile("s_waitcnt vmcnt(0)" ::: "memory");
            const unsigned og = xb_add(&bar[XB_TOP], 1u);
            const unsigned tg = og / nx;
            if (og + 1u == (tg + 1u) * nx) xb_add(&bar[XB_TOPGEN], 1u);
            else XB_SPIN(xb_ld(&bar[XB_TOPGEN]) == tg, bar);
            __builtin_amdgcn_fence(__ATOMIC_ACQUIRE, "agent");
            xb_add(&bar[XB_XGEN(b.x)], 1u);
            asm volatile("s_waitcnt vmcnt(0)" ::: "memory");
        } else {
            XB_SPIN(xb_ld(&bar[XB_XGEN(b.x)]) == gen, bar);
            __builtin_amdgcn_fence(__ATOMIC_ACQUIRE, "agent");
            asm volatile("s_waitcnt vmcnt(0)" ::: "memory");
        }
    }
    __syncthreads();
}

constexpr int B_ = 4, T_ = 8192, D_ = 1024, M_ = B_ * T_, L_ = 2;
constexpr int NIN = 3584, NPG = 1792, NPR = 1792;
constexpr int DFF = 2816, NUP = 5632, IN_COLS = 3344;
constexpr size_t MiB = 1u << 20;
constexpr size_t WS_CTL = 0, CTL_ZERO_BYTES = 65536;
constexpr int CW_BAR = 4096;
constexpr size_t WS_RK = MiB / 4;
constexpr size_t WS_MOD = 3 * MiB / 2;
constexpr size_t WS_WIN = 2 * MiB, WS_WOUT = 9 * MiB, WS_WUP = 11 * MiB, WS_WDN = 22 * MiB, WS_LORA = 55 * MiB / 2, WS_GAMC = 28 * MiB, WS_VL = 29 * MiB;
constexpr size_t WS_GAM = 31 * MiB;
constexpr size_t WS_XB = 32 * MiB, WS_O = 336 * MiB  , WS_VF = 160 * MiB, WS_GK = 192 * MiB, WS_PG = 224 * MiB, WS_PR = 336 * MiB, WS_END = 512 * MiB;
constexpr size_t WS_RH = WS_XB, WS_YH = WS_XB + 32 * MiB, WS_PP = 96 * MiB, WS_QQ = 128 * MiB, WS_GG = 448 * MiB, WS_S0 = 480 * MiB;
constexpr size_t WS_ACT = 224 * MiB, WS_U = 400 * MiB;
constexpr int RING_BYTES = 131072, MISC_OFF = 161792, LDS_BYTES = 163840;
constexpr int NT = 512;

__device__ __forceinline__ float bf2f(bf16 h) { return __builtin_bit_cast(float, (unsigned)h << 16); }
__device__ __forceinline__ float sigmoidf_(float x) { return 1.f / (1.f + __expf(-x)); }
__device__ __forceinline__ float siluf_(float x) { return x / (1.f + __expf(-x)); }
__device__ __forceinline__ float softplusf_(float x) { return fmaxf(x, 0.f) + log1pf(__expf(-fabsf(x))); }

typedef unsigned u32x2 __attribute__((ext_vector_type(2)));
template <int CTRL> __device__ __forceinline__ float dpp_f(float v) {
    return __builtin_bit_cast(float, __builtin_amdgcn_update_dpp(0, __builtin_bit_cast(int, v), CTRL, 0xf, 0xf, false));
}
__device__ __forceinline__ float wave_sum(float v) {
    v += dpp_f<0xB1>(v);
    v += dpp_f<0x4E>(v);
    v += dpp_f<0x141>(v);
    v += dpp_f<0x140>(v);
    v += __builtin_bit_cast(float, __builtin_amdgcn_update_dpp(0, __builtin_bit_cast(int, v), 0x142, 0xa, 0xf, false));
    v += __builtin_bit_cast(float, __builtin_amdgcn_update_dpp(0, __builtin_bit_cast(int, v), 0x143, 0xc, 0xf, false));
    return __builtin_bit_cast(float, __builtin_amdgcn_readlane(__builtin_bit_cast(int, v), 63));
}

__device__ __forceinline__ int lane_now() { int l; asm volatile("v_mbcnt_lo_u32_b32 %0, -1, 0\n\tv_mbcnt_hi_u32_b32 %0, -1, %0" : "=v"(l)); return l; }
__device__ __forceinline__ float xsum4(float v) {
    const int l = lane_now();
    v += __builtin_bit_cast(float, __builtin_amdgcn_ds_bpermute((l ^ 16) << 2, __builtin_bit_cast(int, v)));
    v += __builtin_bit_cast(float, __builtin_amdgcn_ds_bpermute((l ^ 32) << 2, __builtin_bit_cast(int, v)));
    return v;
}
struct Ctx { int bid, nb, tid, lane, wave; LAS unsigned char* lds; };
__device__ __forceinline__ void group_barrier(unsigned* cnt, unsigned target, bool leader) {
    asm volatile("s_waitcnt vmcnt(0)" ::: "memory");
    __syncthreads();
    if (leader) {
        __builtin_amdgcn_fence(__ATOMIC_RELEASE, "agent");
        asm volatile("s_waitcnt vmcnt(0)" ::: "memory");
        (void)__hip_atomic_fetch_add(cnt, 1u, __ATOMIC_RELAXED, __HIP_MEMORY_SCOPE_AGENT);
        for (unsigned sp = 0; __hip_atomic_load(cnt, __ATOMIC_RELAXED, __HIP_MEMORY_SCOPE_AGENT) < target && sp < (1u << 22); ++sp) __builtin_amdgcn_s_sleep(2);
        __builtin_amdgcn_fence(__ATOMIC_ACQUIRE, "agent");
        asm volatile("s_waitcnt vmcnt(0)" ::: "memory");
    }
    __syncthreads();
}


__device__ __forceinline__ void ph_mod(const Ctx& C, const float* c, const float* ada_w, const float* ada_b, float* MOD) {
    LAS float* sc = (LAS float*)C.lds;
    LAS float* red = (LAS float*)(C.lds + 16384);
    for (int i = C.tid; i < 4096; i += NT) sc[i] = siluf_(c[i]);
    __syncthreads();
    for (int item = C.bid; item < 192; item += C.nb) {
        const int l = item / 96, j0 = (item % 96) * 64;
        const float* W = ada_w + (size_t)l * 1024 * 6144 + j0 + C.lane;
        float a0 = 0.f, a1 = 0.f, a2 = 0.f, a3 = 0.f;
        for (int k = C.wave * 128; k < C.wave * 128 + 128; ++k) { const float wv = W[(size_t)k * 6144]; a0 += sc[k] * wv; a1 += sc[1024 + k] * wv; a2 += sc[2048 + k] * wv; a3 += sc[3072 + k] * wv; }
        red[(C.wave * 4 + 0) * 64 + C.lane] = a0; red[(C.wave * 4 + 1) * 64 + C.lane] = a1; red[(C.wave * 4 + 2) * 64 + C.lane] = a2; red[(C.wave * 4 + 3) * 64 + C.lane] = a3;
        __syncthreads();
        if (C.wave < 4) { const int b = C.wave; float s = ada_b[l * 6144 + j0 + C.lane];
#pragma unroll
            for (int w = 0; w < 8; ++w) s += red[(w * 4 + b) * 64 + C.lane];
            MOD[((size_t)l * 4 + b) * 6144 + j0 + C.lane] = s; }
        __syncthreads();
    }
}

__device__ __forceinline__ void wprep_mat(const Ctx& C, const float* W, int K, int Nsrc, int Ndst, bf16* Wt, int mode, const float* vres) {
    const int half = C.tid >> 8, t = C.tid & 255, tx = t & 31, ty = t >> 5;
    LAS float* tile = (LAS float*)C.lds + half * (32 * 33);
    const int nbn = Ndst / 32, ntile = nbn * (K / 32);
    const int niter = (ntile + 2 * C.nb - 1) / (2 * C.nb);
    for (int it = 0; it < niter; ++it) {
        const int item = (it * C.nb + C.bid) * 2 + half;
        const bool act = item < ntile;
        const int n0 = (item % nbn) * 32, k0 = (item / nbn) * 32, n = n0 + tx;
        if (act) {
#pragma unroll
            for (int i = 0; i < 4; ++i) { const int k = k0 + ty + 8 * i; float v = 0.f;
                if (mode == 0) v = W[(size_t)k * Nsrc + n];
                else if (mode == 2) { const int tl = n >> 8, w = n & 255; v = W[(size_t)k * Nsrc + (w < 128 ? tl * 128 + w : 2816 + tl * 128 + (w - 128))]; }
                else { if (n < 1552) v = W[(size_t)k * Nsrc + n]; else if (n < 1584) v = vres ? vres[(size_t)k * 32 + (n - 1552)] : 0.f; else if (n < 1792) v = 0.f; else v = W[(size_t)k * Nsrc + (n - 240)]; }
                tile[(ty + 8 * i) * 33 + tx] = v; }
        }
        __syncthreads();
        if (act) {
#pragma unroll
            for (int i = 0; i < 4; ++i) { const int nn = n0 + ty + 8 * i; Wt[(size_t)nn * K + k0 + tx] = (bf16)f2bf(tile[tx * 33 + ty + 8 * i]); }
        }
        __syncthreads();
    }
}

__device__ __forceinline__ void ph_norm(const Ctx& C, const float* x, const float* g, const float* sh, const float* sc, bf16* XB) {
    const int gw = C.bid * 8 + C.wave, NGW = C.nb * 8, lane = C.lane;
    for (int m = gw; m < M_; m += NGW) {
        const int b = m / T_;
        const f32x4* xr = (const f32x4*)(x + (size_t)m * D_) + lane;
        f32x4 v[4]; float s = 0.f;
#pragma unroll
        for (int j = 0; j < 4; ++j) { v[j] = xr[64 * j]; s += (v[j].x * v[j].x + v[j].y * v[j].y) + (v[j].z * v[j].z + v[j].w * v[j].w); }
        const float rstd = 1.f / sqrtf(wave_sum(s) * (1.f / D_) + 1e-6f);
        unsigned long long* o8 = (unsigned long long*)(XB + (size_t)m * D_) + lane;
#pragma unroll
        for (int j = 0; j < 4; ++j) { const int col = 4 * lane + 256 * j;
            const f32x4 gv = *(const f32x4*)(g + col), shv = *(const f32x4*)(sh + b * 6144 + col), scv = *(const f32x4*)(sc + b * 6144 + col);
            const f32x4 h = v[j] * rstd * gv * (scv + 1.f) + shv;
            o8[64 * j] = (unsigned long long)pk2(h.x, h.y) | ((unsigned long long)pk2(h.z, h.w) << 32); }
    }
}
__device__ __forceinline__ void ph_final(const Ctx& C, float* x, const float* g) {
    const int gw = C.bid * 8 + C.wave, NGW = C.nb * 8, lane = C.lane;
    for (int m = gw; m < M_; m += NGW) {
        f32x4* xr = (f32x4*)(x + (size_t)m * D_) + lane;
        f32x4 v[4]; float s = 0.f;
#pragma unroll
        for (int j = 0; j < 4; ++j) { v[j] = xr[64 * j]; s += (v[j].x * v[j].x + v[j].y * v[j].y) + (v[j].z * v[j].z + v[j].w * v[j].w); }
        const float rstd = 1.f / sqrtf(wave_sum(s) * (1.f / D_) + 1e-6f);
#pragma unroll
        for (int j = 0; j < 4; ++j) { const f32x4 gv = *(const f32x4*)(g + 4 * lane + 256 * j); xr[64 * j] = v[j] * rstd * gv; }
    }
}


typedef short s16x8 __attribute__((ext_vector_type(8)));
__device__ __forceinline__ f32x4 mm16(const LAS bf16* A, int lda, const LAS bf16* B, int ldb, int K, f32x4 acc, int lane) {
    const int r = lane & 15, g = lane >> 4;
    const LAS bf16* ap = A + r * lda + 8 * g; const LAS bf16* bp = B + r * ldb + 8 * g;
    for (int k0 = 0; k0 < K; k0 += 32) { const s16x8 a = *(const LAS s16x8*)(ap + k0); const s16x8 b = *(const LAS s16x8*)(bp + k0); acc = __builtin_amdgcn_mfma_f32_16x16x32_bf16(a, b, acc, 0, 0, 0); }
    return acc;
}
__device__ __forceinline__ f32x4 mm16_ga(const bf16* A, int lda, const LAS bf16* B, int ldb, int K, f32x4 acc, int lane) {
    const int r = lane & 15, g = lane >> 4;
    const bf16* ap = A + r * lda + 8 * g; const LAS bf16* bp = B + r * ldb + 8 * g;
    for (int k0 = 0; k0 < K; k0 += 32) { const s16x8 a = *(const s16x8*)(ap + k0); const s16x8 b = *(const LAS s16x8*)(bp + k0); acc = __builtin_amdgcn_mfma_f32_16x16x32_bf16(a, b, acc, 0, 0, 0); }
    return acc;
}
__device__ __forceinline__ unsigned long long pack4(f32x4 v) { return (unsigned long long)pk2(v.x, v.y) | ((unsigned long long)pk2(v.z, v.w) << 32); }
__device__ __forceinline__ float logsigmoidf_(float x) { return fminf(x, 0.f) - __logf(1.f + __expf(-fabsf(x))); }

constexpr int GL_LD = 72;
constexpr int GL_GK = 0;
constexpr int GL_SEG = 16384;
constexpr int GL_Z = 18432;
constexpr int GL_GUP = 20480;
constexpr int GL_I0 = 24832;
constexpr int GL_I1 = GL_I0 + 9216;
constexpr int GL_I2 = GL_I1 + 9216;
constexpr int GL_VT = GL_I2 + 9216;
constexpr int GL_SSQ = GL_VT + 18432;
static_assert(GL_SSQ + 512 <= RING_BYTES, "GLA LDS map");

struct GlaRaw { v4u z, k, q, v0, v1; float g0, g1, gb; };
__device__ __forceinline__ void gla_fetch(GlaRaw& R, const Ctx& C, const bf16* pg, const float* gk_up, const float* gk_b, int h, bool want_q) {
    const int tid = C.tid, j = tid >> 3, d0 = (tid & 7) * 8, e0 = (tid & 7) * 16;
    R.z = (v4u){0u, 0u, 0u, 0u}; R.q = R.z;
    if (tid < 128) R.z = *(const v4u*)(pg + (size_t)(tid >> 1) * NPG + 1536 + (tid & 1) * 8);
    R.g0 = gk_up[(tid >> 6) * 256 + h * 64 + (tid & 63)]; R.g1 = gk_up[((tid + NT) >> 6) * 256 + h * 64 + (tid & 63)]; R.gb = gk_b[h * 64 + (tid & 63)];
    R.k = *(const v4u*)(pg + (size_t)j * NPG + 256 + h * 64 + d0);
    if (want_q) R.q = *(const v4u*)(pg + (size_t)j * NPG + h * 64 + d0);
    R.v0 = *(const v4u*)(pg + (size_t)j * NPG + 512 + h * 128 + e0); R.v1 = *(const v4u*)(pg + (size_t)j * NPG + 512 + h * 128 + e0 + 8);
}
__device__ __forceinline__ void gla_gates(const Ctx& C, const GlaRaw& R) {
    LAS float* GK = (LAS float*)(C.lds + GL_GK); LAS float* SEG = (LAS float*)(C.lds + GL_SEG); LAS bf16* Z = (LAS bf16*)(C.lds + GL_Z); LAS float* GUP = (LAS float*)(C.lds + GL_GUP);
    const int tid = C.tid;
    if (tid < 128) { const int t = tid >> 1, hh = tid & 1; *(LAS v4u*)(Z + t * 16 + hh * 8) = R.z; }
    GUP[tid] = R.g0; GUP[tid + NT] = R.g1;
    if (tid < 64) GUP[1024 + tid] = R.gb;
    __syncthreads();
    { const int t = tid >> 3, d0 = (tid & 7) * 8; float a[8];
#pragma unroll
      for (int q = 0; q < 8; ++q) a[q] = GUP[1024 + d0 + q];
#pragma unroll
      for (int i = 0; i < 16; ++i) { const float zv = bf2f(Z[t * 16 + i]);
#pragma unroll
          for (int q = 0; q < 8; ++q) a[q] += zv * GUP[i * 64 + d0 + q]; }
#pragma unroll
      for (int q = 0; q < 8; ++q) GK[t * 64 + d0 + q] = logsigmoidf_(a[q]) * (1.f / 16.f); }
    __syncthreads();
    { const int d = tid & 63, seg = tid >> 6; float run = 0.f;
#pragma unroll
      for (int q = 0; q < 8; ++q) { run += GK[(seg * 8 + q) * 64 + d]; GK[(seg * 8 + q) * 64 + d] = run; }
      SEG[seg * 64 + d] = run; }
    __syncthreads();
    { const int d = tid & 63, seg = tid >> 6; float off = 0.f;
      for (int s = 0; s < seg; ++s) off += SEG[s * 64 + d];
#pragma unroll
      for (int q = 0; q < 8; ++q) GK[(seg * 8 + q) * 64 + d] += off; }
    __syncthreads();
}
__device__ __forceinline__ void gla_stage_vt(const Ctx& C, const GlaRaw& R) {
    LAS bf16* VT = (LAS bf16*)(C.lds + GL_VT);
    const int j = C.tid >> 3, e0 = (C.tid & 7) * 16;
    const unsigned w[8] = {R.v0.x, R.v0.y, R.v0.z, R.v0.w, R.v1.x, R.v1.y, R.v1.z, R.v1.w};
#pragma unroll
    for (int q = 0; q < 8; ++q) { VT[(e0 + 2 * q) * GL_LD + j] = (bf16)(w[q] & 0xffffu); VT[(e0 + 2 * q + 1) * GL_LD + j] = (bf16)(w[q] >> 16); }
}

__device__ __forceinline__ void ph_gla_a(const Ctx& C, const bf16* PG, const float* gk_up, const float* gk_b, bf16* DS, float* GAM) {
    LAS float* GK = (LAS float*)(C.lds + GL_GK); LAS bf16* KT = (LAS bf16*)(C.lds + GL_I0); LAS bf16* VT = (LAS bf16*)(C.lds + GL_VT);
    for (int item = C.bid; item < 2048; item += C.nb) {
        const int bh = item >> 7, c = item & 127, b = bh >> 2, h = bh & 3;
        const size_t m0 = (size_t)b * T_ + c * 64;
        const bf16* pg = PG + m0 * NPG;
        GlaRaw R; gla_fetch(R, C, pg, gk_up, gk_b, h, false);
        gla_gates(C, R);
        { const int j = C.tid >> 3, d0 = (C.tid & 7) * 8;
          const unsigned w[4] = {R.k.x, R.k.y, R.k.z, R.k.w};
#pragma unroll
          for (int q = 0; q < 4; ++q) { const float k0 = bf2f((bf16)(w[q] & 0xffffu)), k1 = bf2f((bf16)(w[q] >> 16));
              const int d = d0 + 2 * q;
              KT[d * GL_LD + j] = (bf16)f2bf(k0 * __expf(GK[63 * 64 + d] - GK[j * 64 + d]));
              KT[(d + 1) * GL_LD + j] = (bf16)f2bf(k1 * __expf(GK[63 * 64 + d + 1] - GK[j * 64 + d + 1])); } }
        gla_stage_vt(C, R);
        if (C.tid < 64) GAM[(size_t)item * 64 + C.tid] = __expf(GK[63 * 64 + C.tid]);
        __syncthreads();
        { const int n0 = C.wave * 16, lane = C.lane, cc = lane & 15, g = lane >> 4;
          bf16* out = DS + (size_t)item * 8192 + (size_t)(n0 + cc) * 64 + 4 * g;
#pragma unroll
          for (int mt = 0; mt < 4; ++mt) { f32x4 acc = {0.f, 0.f, 0.f, 0.f}; acc = mm16(KT + mt * 16 * GL_LD, GL_LD, VT + n0 * GL_LD, GL_LD, 64, acc, lane);
              *(unsigned long long*)(out + mt * 16) = pack4(acc); } }
        __syncthreads();
    }
}
__device__ __forceinline__ void ph_gla_b(const Ctx& C, bf16* DS, const float* GAM) {
    for (int idx = C.bid * NT + C.tid; idx < 16 * 8192; idx += C.nb * NT) {
        const int bh = idx >> 13, ed = idx & 8191, d = ed & 63;
        bf16* p = DS + (size_t)bh * 128 * 8192 + ed; const float* gp = GAM + (size_t)bh * 128 * 64 + d;
        float S = 0.f;
        for (int c0 = 0; c0 < 128; c0 += 8) {
            float ds[8], gm[8];
#pragma unroll
            for (int i = 0; i < 8; ++i) { ds[i] = bf2f(p[(size_t)(c0 + i) * 8192]); gm[i] = gp[(c0 + i) * 64]; }
#pragma unroll
            for (int i = 0; i < 8; ++i) { const float gs = gm[i] * S; p[(size_t)(c0 + i) * 8192] = (bf16)f2bf(gs); S = gs + ds[i]; }
        }
    }
}
__device__ __forceinline__ void ph_gla_c(const Ctx& C, const bf16* PG, const float* gk_up, const float* gk_b, const float* norm_g, const bf16* DS, bf16* O) {
    LAS float* GK = (LAS float*)(C.lds + GL_GK); LAS bf16* QP = (LAS bf16*)(C.lds + GL_I0); LAS bf16* KM = (LAS bf16*)(C.lds + GL_I1); LAS bf16* AI = (LAS bf16*)(C.lds + GL_I2);
    LAS bf16* VT = (LAS bf16*)(C.lds + GL_VT); LAS float* SSQ = (LAS float*)(C.lds + GL_SSQ);
    for (int item = C.bid; item < 2048; item += C.nb) {
        const int bh = item >> 7, c = item & 127, b = bh >> 2, h = bh & 3;
        const size_t m0 = (size_t)b * T_ + c * 64;
        const bf16* pg = PG + m0 * NPG;
        GlaRaw R; gla_fetch(R, C, pg, gk_up, gk_b, h, true);
        s16x8 sfrag[4][2];
        { const int lane = C.lane, cc = lane & 15, g = lane >> 4, eh = C.wave >> 2; const bf16* Sg = DS + (size_t)item * 8192;
#pragma unroll
          for (int mt = 0; mt < 4; ++mt) { sfrag[mt][0] = *(const s16x8*)(Sg + (size_t)(eh * 64 + mt * 16 + cc) * 64 + 8 * g); sfrag[mt][1] = *(const s16x8*)(Sg + (size_t)(eh * 64 + mt * 16 + cc) * 64 + 32 + 8 * g); } }
        gla_gates(C, R);
        { const int j = C.tid >> 3, d0 = (C.tid & 7) * 8;
          const v4u qx = R.q, kx = R.k;
          const unsigned qw[4] = {qx.x, qx.y, qx.z, qx.w}, kw[4] = {kx.x, kx.y, kx.z, kx.w};
          unsigned qo[4], ko[4];
#pragma unroll
          for (int q = 0; q < 4; ++q) { const int d = d0 + 2 * q;
              const float e0 = GK[63 * 64 + d] - GK[j * 64 + d], e1 = GK[63 * 64 + d + 1] - GK[j * 64 + d + 1];
              const float q0 = 0.125f * bf2f((bf16)(qw[q] & 0xffffu)) * __expf(-e0), q1 = 0.125f * bf2f((bf16)(qw[q] >> 16)) * __expf(-e1);
              const float k0 = bf2f((bf16)(kw[q] & 0xffffu)) * __expf(e0), k1 = bf2f((bf16)(kw[q] >> 16)) * __expf(e1);
              qo[q] = pk2(q0, q1); ko[q] = pk2(k0, k1); }
          *(LAS v4u*)(QP + j * GL_LD + d0) = (v4u){qo[0], qo[1], qo[2], qo[3]}; *(LAS v4u*)(KM + j * GL_LD + d0) = (v4u){ko[0], ko[1], ko[2], ko[3]}; }
        gla_stage_vt(C, R);
        __syncthreads();
        { const int lane = C.lane, cc = lane & 15, g = lane >> 4, n0 = (C.wave >> 1) * 16;
#pragma unroll
          for (int q = 0; q < 2; ++q) { const int mt0 = ((C.wave & 1) * 2 + q) * 16; f32x4 acc = {0.f, 0.f, 0.f, 0.f};
              acc = mm16(KM + mt0 * GL_LD, GL_LD, QP + n0 * GL_LD, GL_LD, 64, acc, lane);
              const int i = n0 + cc, j = mt0 + 4 * g;
              acc.x = (j + 0 <= i) ? acc.x : 0.f; acc.y = (j + 1 <= i) ? acc.y : 0.f; acc.z = (j + 2 <= i) ? acc.z : 0.f; acc.w = (j + 3 <= i) ? acc.w : 0.f;
              *(LAS unsigned long long*)(AI + (n0 + cc) * GL_LD + mt0 + 4 * g) = pack4(acc); } }
        __syncthreads();
        { const int lane = C.lane, cc = lane & 15, g = lane >> 4, n0 = (C.wave & 3) * 16, eh = C.wave >> 2;
          f32x4 acc[4]; float ss = 0.f;
#pragma unroll
          for (int mt = 0; mt < 4; ++mt) { const int e0 = eh * 64 + mt * 16; acc[mt] = (f32x4){0.f, 0.f, 0.f, 0.f};
              { const LAS bf16* bp = QP + (n0 + cc) * GL_LD + 8 * g;
                acc[mt] = __builtin_amdgcn_mfma_f32_16x16x32_bf16(sfrag[mt][0], *(const LAS s16x8*)bp, acc[mt], 0, 0, 0); acc[mt] = __builtin_amdgcn_mfma_f32_16x16x32_bf16(sfrag[mt][1], *(const LAS s16x8*)(bp + 32), acc[mt], 0, 0, 0); }
              acc[mt] = mm16(VT + e0 * GL_LD, GL_LD, AI + n0 * GL_LD, GL_LD, 64, acc[mt], lane);
              ss += (acc[mt].x * acc[mt].x + acc[mt].y * acc[mt].y) + (acc[mt].z * acc[mt].z + acc[mt].w * acc[mt].w); }
          ss = xsum4(ss);
          if (g == 0) SSQ[eh * 64 + n0 + cc] = ss;
          __syncthreads();
          const float rstd = 1.f / sqrtf((SSQ[n0 + cc] + SSQ[64 + n0 + cc]) * (1.f / 128.f) + 1e-6f);
          const size_t m = m0 + n0 + cc;
#pragma unroll
          for (int mt = 0; mt < 4; ++mt) { const int e = eh * 64 + mt * 16 + 4 * g;
              const unsigned long long gx = *(const unsigned long long*)(pg + (size_t)(n0 + cc) * NPG + 1024 + h * 128 + e);
              const f32x4 ng = *(const f32x4*)(norm_g + e);
              f32x4 o;
              o.x = acc[mt].x * rstd * ng.x * siluf_(bf2f((bf16)(gx & 0xffffu)));
              o.y = acc[mt].y * rstd * ng.y * siluf_(bf2f((bf16)((gx >> 16) & 0xffffu)));
              o.z = acc[mt].z * rstd * ng.z * siluf_(bf2f((bf16)((gx >> 32) & 0xffffu)));
              o.w = acc[mt].w * rstd * ng.w * siluf_(bf2f((bf16)(gx >> 48)));
              *(unsigned long long*)(O + m * D_ + h * 128 + e) = pack4(o); } }
        __syncthreads();
    }
}


struct RwkvW { const float *mu, *mu_vres, *w0, *a0, *v0, *k_k, *k_a, *r_k; const bf16 *wupT, *aupT, *gupT, *vupT; };
constexpr int RW_LD = 72, RW_XLD = 296;
constexpr int RW_R0 = 0;
constexpr int RW_SEG = 16384;
constexpr int RW_R1 = 36864;
constexpr int RW_R2 = RW_R1 + 27648;
constexpr int RW_R3 = RW_R2 + 9216;
constexpr int RW_R4 = RW_R3 + 27648;
constexpr int RW_TI = RW_R4 + 128 * RW_LD * 2;
constexpr int RW_MU = RW_TI + 2048;
constexpr int RW_X = RW_MU + 2048;
constexpr int RW_END = RW_X + 64 * RW_XLD * 2;
static_assert(RW_END <= MISC_OFF, "RWKV LDS map");

typedef short s16x4 __attribute__((ext_vector_type(4)));
__device__ __forceinline__ float tanh_fast(float x) { const float e = __expf(2.f * x); return 1.f - 2.f / (e + 1.f); }
__device__ __forceinline__ float softplus_fast(float x) { return fmaxf(x, 0.f) + __logf(1.f + __expf(-fabsf(x))); }
__device__ __forceinline__ s16x4 cvt4(f32x4 v) { const unsigned long long p = pack4(v); return __builtin_bit_cast(s16x4, p); }
__device__ __forceinline__ void ld8f(const float* p, float (&o)[8]) { const f32x4 a = *(const f32x4*)p, b = *(const f32x4*)(p + 4); o[0] = a.x; o[1] = a.y; o[2] = a.z; o[3] = a.w; o[4] = b.x; o[5] = b.y; o[6] = b.z; o[7] = b.w; }
__device__ __forceinline__ float sum8(float v) { v += dpp_f<0xB1>(v); v += dpp_f<0x4E>(v); v += dpp_f<0x141>(v); return v; }
__device__ __forceinline__ void unpack8(const v4u x, float (&o)[8]) {
    o[0] = bf2f((bf16)(x.x & 0xffffu)); o[1] = bf2f((bf16)(x.x >> 16)); o[2] = bf2f((bf16)(x.y & 0xffffu)); o[3] = bf2f((bf16)(x.y >> 16));
    o[4] = bf2f((bf16)(x.z & 0xffffu)); o[5] = bf2f((bf16)(x.z >> 16)); o[6] = bf2f((bf16)(x.w & 0xffffu)); o[7] = bf2f((bf16)(x.w >> 16)); }
__device__ __forceinline__ v4u pack8(const float (&o)[8]) { return (v4u){pk2(o[0], o[1]), pk2(o[2], o[3]), pk2(o[4], o[5]), pk2(o[6], o[7])}; }
__device__ __forceinline__ f32x4 mm16_gb(const LAS bf16* A, int lda, const bf16* B, int ldb, int K, f32x4 acc, int lane) {
    const int r = lane & 15, g = lane >> 4;
    const LAS bf16* ap = A + r * lda + 8 * g; const bf16* bp = B + r * ldb + 8 * g;
    for (int k0 = 0; k0 < K; k0 += 32) { const s16x8 a = *(const LAS s16x8*)(ap + k0); const s16x8 b = *(const s16x8*)(bp + k0); acc = __builtin_amdgcn_mfma_f32_16x16x32_bf16(a, b, acc, 0, 0, 0); }
    return acc;
}

__device__ __forceinline__ void ph_norm_b(const Ctx& C, const bf16* x, const float* g, const float* sh, const float* sc, bf16* XB) {
    const int gw = C.bid * 8 + C.wave, NGW = C.nb * 8, lane = C.lane;
    for (int m = gw; m < M_; m += NGW) {
        const int b = m / T_;
        const v4u* xr = (const v4u*)(x + (size_t)m * D_) + lane;
        float v[2][8]; float s = 0.f;
#pragma unroll
        for (int j = 0; j < 2; ++j) { unpack8(xr[64 * j], v[j]);
#pragma unroll
            for (int i = 0; i < 8; ++i) s += v[j][i] * v[j][i]; }
        const float rstd = 1.f / sqrtf(wave_sum(s) * (1.f / D_) + 1e-6f);
        v4u* o = (v4u*)(XB + (size_t)m * D_) + lane;
#pragma unroll
        for (int j = 0; j < 2; ++j) { const int col = 8 * lane + 512 * j; float gv[8], shv[8], scv[8], h[8];
            ld8f(g + col, gv); ld8f(sh + b * 6144 + col, shv); ld8f(sc + b * 6144 + col, scv);
#pragma unroll
            for (int i = 0; i < 8; ++i) h[i] = v[j][i] * rstd * gv[i] * (scv[i] + 1.f) + shv[i];
            o[64 * j] = pack8(h); }
    }
}
__device__ __forceinline__ void ph_final_b(const Ctx& C, const bf16* x, const float* g, float* out, int m_lo, int m_hi, bf16* keep, int c_lo, int c_hi) {
    const int gw = C.bid * 8 + C.wave, NGW = C.nb * 8, lane = C.lane;
    for (int m = m_lo + gw; m < m_hi; m += NGW) {
        const v4u* xr = (const v4u*)(x + (size_t)m * D_) + lane;
        float v[2][8]; float s = 0.f;
#pragma unroll
        for (int j = 0; j < 2; ++j) { unpack8(xr[64 * j], v[j]);
#pragma unroll
            for (int i = 0; i < 8; ++i) s += v[j][i] * v[j][i]; }
        const float rstd = 1.f / sqrtf(wave_sum(s) * (1.f / D_) + 1e-6f);
#pragma unroll
        for (int j = 0; j < 2; ++j) { const int col = 8 * lane + 512 * j; float gv[8]; ld8f(g + col, gv);
            f32x4* o = (f32x4*)(out + (size_t)m * D_ + col);
            o[0] = (f32x4){v[j][0] * rstd * gv[0], v[j][1] * rstd * gv[1], v[j][2] * rstd * gv[2], v[j][3] * rstd * gv[3]};
            o[1] = (f32x4){v[j][4] * rstd * gv[4], v[j][5] * rstd * gv[5], v[j][6] * rstd * gv[6], v[j][7] * rstd * gv[7]}; }
    }
    for (int m = c_lo + gw; m < c_hi; m += NGW) { const v4u* xr = (const v4u*)(x + (size_t)m * D_) + lane; v4u* kr = (v4u*)(keep + (size_t)(m - c_lo) * D_) + lane; kr[0] = xr[0]; kr[64] = xr[64]; }
}
__device__ __forceinline__ void ph_rwkv_a(const Ctx& C, const bf16* PR, const bf16* VL  , const RwkvW& W, int layer,
                                          bf16* PP, bf16* QQ, bf16* RH, bf16* YH, float* GAMC, float* RK, bf16* GG, bf16* VF, bool store_v = true) {
    LAS unsigned char* L = C.lds;
    LAS bf16* X = (LAS bf16*)(L + RW_X); LAS float* CUM = (LAS float*)(L + RW_R0); LAS float* SEG = (LAS float*)(L + RW_SEG);
    LAS bf16* NI = (LAS bf16*)(L + RW_R0), *AAK = NI + 64 * RW_LD, *ARB = AAK + 64 * RW_LD, *ARK = ARB + 64 * RW_LD;
    LAS bf16* PRE = (LAS bf16*)(L + RW_R1);
    LAS bf16* AT = (LAS bf16*)(L + RW_R1), *BT = AT + 64 * RW_LD, *KT = BT + 64 * RW_LD, *RT = (LAS bf16*)(L + RW_R2);
    LAS bf16* XB16 = (LAS bf16*)(L + RW_R1);
    LAS bf16* BHc = (LAS bf16*)(L + RW_R3), *KHc = BHc + 64 * RW_LD, *VTc = KHc + 64 * RW_LD;
    LAS bf16* XT = (LAS bf16*)(L + RW_R4); LAS bf16* TI = (LAS bf16*)(L + RW_TI);
    const int wave = C.wave;
    LAS float* MU = (LAS float*)(L + RW_MU);
    for (int i = C.tid; i < 288; i += NT) MU[i] = i < 256 ? W.mu[1536 + i] : (layer ? W.mu_vres[i - 256] : 0.f);
    __syncthreads();
    for (int bc = C.bid; bc < 512; bc += C.nb) {
        const int c = bc & 127, b = bc >> 7;
        const size_t m0 = (size_t)b * T_ + c * 64;
        { const int tid = C.tid;
          v4u xc[5], xp[5];
#pragma unroll
          for (int it = 0; it < 5; ++it) { const int idx = tid + it * NT; xc[it] = (v4u){0u, 0u, 0u, 0u}; xp[it] = xc[it];
            if (idx < 64 * 36) { const int t1 = idx / 36, q = idx % 36, col = q * 8; const size_t m1 = m0 + t1; const bool first1 = (c == 0 && t1 == 0);
                if (q < 32) { xc[it] = *(const v4u*)(PR + m1 * NPR + 1536 + col); if (!first1) xp[it] = *(const v4u*)(PR + (m1 - 1) * NPR + 1536 + col); }
                else if (layer) { xc[it] = *(const v4u*)(VL + m1 * NPG + 1552 + (col - 256)); if (!first1) xp[it] = *(const v4u*)(VL + (m1 - 1) * NPG + 1552 + (col - 256)); } } }
#pragma unroll
          for (int it = 0; it < 5; ++it) { const int idx = tid + it * NT;
            if (idx < 64 * 36) { const int t1 = idx / 36, q = idx % 36, col = q * 8;
                float cv[8], pv[8], mu[8]; unpack8(xc[it], cv); unpack8(xp[it], pv);
                { const f32x4 ma = *(const LAS f32x4*)(MU + col), mb = *(const LAS f32x4*)(MU + col + 4); mu[0] = ma.x; mu[1] = ma.y; mu[2] = ma.z; mu[3] = ma.w; mu[4] = mb.x; mu[5] = mb.y; mu[6] = mb.z; mu[7] = mb.w; }
#pragma unroll
                for (int i = 0; i < 8; ++i) { float p = cv[i] + (pv[i] - cv[i]) * mu[i]; if (q < 8) p = tanh_fast(p); else if (q >= 16 && q < 32) p = sigmoidf_(p); cv[i] = p; }
                *(LAS v4u*)(X + t1 * RW_XLD + col) = pack8(cv); } }
        }
        __syncthreads();
      v4u rcx, kcx, vcx, rpx, kpx, vpx, vfx;
#define RW_FETCH(hh) do { const int t_ = C.tid >> 3, ch_ = (hh) * 64 + (C.tid & 7) * 8; const size_t m_ = m0 + t_; const bool first_ = (c == 0 && t_ == 0); \
        rcx = *(const v4u*)(PR + m_ * NPR + ch_); kcx = *(const v4u*)(PR + m_ * NPR + 512 + ch_); vcx = *(const v4u*)(PR + m_ * NPR + 1024 + ch_); \
        rpx = (v4u){0u, 0u, 0u, 0u}; kpx = rpx; vpx = rpx; vfx = rpx; \
        if (!first_) { rpx = *(const v4u*)(PR + (m_ - 1) * NPR + ch_); kpx = *(const v4u*)(PR + (m_ - 1) * NPR + 512 + ch_); vpx = *(const v4u*)(PR + (m_ - 1) * NPR + 1024 + ch_); } \
        if (layer) vfx = *(const v4u*)(VF + m_ * 512 + ch_); } while (0)
      RW_FETCH(0);
#pragma unroll 1
      for (int h = 0; h < 8; ++h) {
        const int item = bc * 8 + h;
        int tid_ = C.tid; asm volatile("" : "+v"(tid_));
        const int tid = tid_, lane = tid & 63, cc = lane & 15, g = lane >> 4;
        const int t = tid >> 3, d0 = (tid & 7) * 8, ch = h * 64 + d0; const size_t m = m0 + t;
        {
            const int lsel = wave >> 1;
            const bf16* WT = lsel == 0 ? W.wupT : lsel == 1 ? W.aupT : lsel == 2 ? W.gupT : W.vupT;
            const int Kl = lsel == 2 ? 128 : lsel == 3 ? 32 : 64, xoff = lsel == 0 ? 0 : lsel == 1 ? 64 : lsel == 2 ? 128 : 256;
            LAS bf16* outp = PRE + lsel * 64 * RW_LD;
            const bool live = (lsel != 3 || layer);
#pragma unroll
            for (int mq = 0; mq < 2; ++mq) { const int mt = (wave & 1) * 2 + mq;
                s16x8 af[4];
                const bf16* ap = WT + (size_t)(h * 64 + mt * 16 + cc) * Kl + 8 * g;
#pragma unroll
                for (int ks = 0; ks < 4; ++ks) af[ks] = (live && ks * 32 < Kl) ? *(const s16x8*)(ap + ks * 32) : (s16x8){0, 0, 0, 0, 0, 0, 0, 0};
#pragma unroll
                for (int nt = 0; nt < 4; ++nt) { f32x4 acc = {0.f, 0.f, 0.f, 0.f};
                    const LAS bf16* bp = X + (nt * 16 + cc) * RW_XLD + xoff + 8 * g;
#pragma unroll
                    for (int ks = 0; ks < 4; ++ks) if (ks * 32 < Kl) { const s16x8 bb = *(const LAS s16x8*)(bp + ks * 32); acc = __builtin_amdgcn_mfma_f32_16x16x32_bf16(af[ks], bb, acc, 0, 0, 0); }
                    *(LAS unsigned long long*)(outp + (nt * 16 + cc) * RW_LD + mt * 16 + 4 * g) = pack4(acc); } }
        }
        __syncthreads();
        float av[8], bv[8], kv[8], rv[8], lw[8], vv[8];
        {
            float rc[8], rp[8], kc[8], kp[8], vc[8], vp[8], pw[8], pa[8], pg_[8], pvg[8];
            unpack8(rcx, rc); unpack8(kcx, kc); unpack8(vcx, vc); unpack8(rpx, rp); unpack8(kpx, kp); unpack8(vpx, vp);
            unpack8(*(const LAS v4u*)(PRE + (0 * 64 + t) * RW_LD + d0), pw); unpack8(*(const LAS v4u*)(PRE + (1 * 64 + t) * RW_LD + d0), pa);
            unpack8(*(const LAS v4u*)(PRE + (2 * 64 + t) * RW_LD + d0), pg_); unpack8(*(const LAS v4u*)(PRE + (3 * 64 + t) * RW_LD + d0), pvg);
            float vf[8]; unpack8(vfx, vf);
            float ssq = 0.f, rks = 0.f, asg[8], gg[8];
            float mur[8], muk[8], muv[8], w0c[8], a0c[8], v0c[8], kkc[8], kac[8], rkc[8];
            ld8f(W.mu + ch, mur); ld8f(W.mu + 512 + ch, muk); ld8f(W.mu + 1024 + ch, muv); ld8f(W.w0 + ch, w0c); ld8f(W.a0 + ch, a0c);
            ld8f(W.k_k + ch, kkc); ld8f(W.k_a + ch, kac); ld8f(W.r_k + ch, rkc);
            if (layer) ld8f(W.v0 + ch, v0c);
#pragma unroll
            for (int i = 0; i < 8; ++i) {
                const float r = rc[i] + (rp[i] - rc[i]) * mur[i], k = kc[i] + (kp[i] - kc[i]) * muk[i]; float v = vc[i] + (vp[i] - vc[i]) * muv[i];
                lw[i] = -0.6065306597f * sigmoidf_(w0c[i] + pw[i]);
                asg[i] = sigmoidf_(a0c[i] + pa[i]);
                if (layer) v = v + (vf[i] - v) * sigmoidf_(v0c[i] + pvg[i]);
                const float kk = k * kkc[i]; ssq += kk * kk;
                kv[i] = k * (1.f + (asg[i] - 1.f) * kac[i]); rv[i] = r; vv[i] = v; gg[i] = pg_[i]; av[i] = kk;
                rks += r * kv[i] * rkc[i];
            }
            ssq = sum8(ssq); rks = sum8(rks);
            const float inv = 1.f / sqrtf(fmaxf(ssq, 1e-24f));
#pragma unroll
            for (int i = 0; i < 8; ++i) { const float kk = av[i] * inv; av[i] = -kk; bv[i] = kk * asg[i]; }
            if ((tid & 7) == 0) RK[m * 8 + h] = rks;
            *(v4u*)(GG + m * 512 + ch) = pack8(gg);
            if (store_v) *(v4u*)(VF + m * 512 + ch) = pack8(vv);
#pragma unroll
            for (int i = 0; i < 8; ++i) vv[i] = bf2f((bf16)f2bf(vv[i]));
        }
        __syncthreads();
#pragma unroll
        for (int i = 0; i < 8; ++i) CUM[t * 64 + d0 + i] = lw[i];
        __syncthreads();
        { const int d = tid & 63, seg = tid >> 6; float run = 0.f;
#pragma unroll
          for (int q = 0; q < 8; ++q) { run += CUM[(seg * 8 + q) * 64 + d]; CUM[(seg * 8 + q) * 64 + d] = run; }
          SEG[seg * 64 + d] = run; }
        __syncthreads();
        { const int d = tid & 63, seg = tid >> 6; float off = 0.f;
          for (int s = 0; s < seg; ++s) off += SEG[s * 64 + d];
#pragma unroll
          for (int q = 0; q < 8; ++q) CUM[(seg * 8 + q) * 64 + d] += off; }
        __syncthreads();
        {
            float at[8], bt[8], kt[8], rt[8];
#pragma unroll
            for (int i = 0; i < 8; ++i) { const float cu = CUM[t * 64 + d0 + i], cC = CUM[63 * 64 + d0 + i], en = __expf(-cu), ec = __expf(cC - cu);
                at[i] = av[i] * __expf(cu - lw[i]); bt[i] = bv[i] * en; kt[i] = kv[i] * en; rt[i] = rv[i] * __expf(cu);
                BHc[(d0 + i) * RW_LD + t] = (bf16)f2bf(bv[i] * ec); KHc[(d0 + i) * RW_LD + t] = (bf16)f2bf(kv[i] * ec); VTc[(d0 + i) * RW_LD + t] = (bf16)f2bf(vv[i]);
                XT[(d0 + i) * RW_LD + t] = (bf16)f2bf(at[i]);
                if (t == 63) GAMC[(size_t)item * 64 + d0 + i] = __expf(cC); }
            *(LAS v4u*)(AT + t * RW_LD + d0) = pack8(at); *(LAS v4u*)(BT + t * RW_LD + d0) = pack8(bt); *(LAS v4u*)(KT + t * RW_LD + d0) = pack8(kt); *(LAS v4u*)(RT + t * RW_LD + d0) = pack8(rt);
        }
        if (h < 7) RW_FETCH(h + 1);
        __syncthreads();
        {
            const int msel = wave >> 1;
            const LAS bf16* As = (msel == 0 || msel == 2) ? BT : KT; const LAS bf16* Bs = (msel < 2) ? AT : RT;
            f32x4 accs[8];
#pragma unroll
            for (int q = 0; q < 8; ++q) { const int tile = (wave & 1) * 8 + q, mt = tile >> 2, nt = tile & 3; accs[q] = (f32x4){0.f, 0.f, 0.f, 0.f};
                accs[q] = mm16(As + mt * 16 * RW_LD, RW_LD, Bs + nt * 16 * RW_LD, RW_LD, 64, accs[q], lane);
                const int tt = nt * 16 + cc, s0 = mt * 16 + 4 * g, lim = (msel < 2) ? tt - 1 : tt;
                accs[q].x = (s0 + 0 <= lim) ? accs[q].x : 0.f; accs[q].y = (s0 + 1 <= lim) ? accs[q].y : 0.f; accs[q].z = (s0 + 2 <= lim) ? accs[q].z : 0.f; accs[q].w = (s0 + 3 <= lim) ? accs[q].w : 0.f; }
            __syncthreads();
            LAS bf16* outp = NI + msel * 64 * RW_LD;
#pragma unroll
            for (int q = 0; q < 8; ++q) { const int tile = (wave & 1) * 8 + q, mt = tile >> 2, nt = tile & 3;
                *(LAS unsigned long long*)(outp + (nt * 16 + cc) * RW_LD + mt * 16 + 4 * g) = pack4(accs[q]); }
        }
        __syncthreads();
        if (wave == 0) {
            const int blk = lane >> 4, col = lane & 15; float x[16];
#pragma unroll
            for (int tt = 0; tt < 16; ++tt) { float nr[16]; { float lo[8], hi[8]; unpack8(*(const LAS v4u*)(NI + (16 * blk + tt) * RW_LD + 16 * blk), lo); unpack8(*(const LAS v4u*)(NI + (16 * blk + tt) * RW_LD + 16 * blk + 8), hi);
#pragma unroll
                    for (int q = 0; q < 8; ++q) { nr[q] = lo[q]; nr[8 + q] = hi[q]; } }
                float a = (tt == col) ? 1.f : 0.f;
#pragma unroll
                for (int q = 0; q < tt; ++q) a += nr[q] * x[q];
                x[tt] = a; TI[(blk * 16 + tt) * 16 + col] = (bf16)f2bf(a); }
        } else {
            for (int tile = wave - 1; tile < 16; tile += 7) { const int mt = tile >> 2, nt = tile & 3;
                f32x4 acc = {0.f, 0.f, 0.f, 0.f}; acc = mm16(AAK + mt * 16 * RW_LD, RW_LD, VTc + nt * 16 * RW_LD, RW_LD, 64, acc, lane);
                *(LAS unsigned long long*)(XT + (64 + nt * 16 + cc) * RW_LD + mt * 16 + 4 * g) = pack4(acc); }
        }
        __syncthreads();
        {
            s16x4 xb[4];
#pragma unroll
            for (int i = 0; i < 4; ++i) {
                f32x4 acc; { const unsigned long long xr = *(const LAS unsigned long long*)(XT + (wave * 16 + cc) * RW_LD + 16 * i + 4 * g);
                    acc.x = bf2f((bf16)(xr & 0xffffu)); acc.y = bf2f((bf16)((xr >> 16) & 0xffffu)); acc.z = bf2f((bf16)((xr >> 32) & 0xffffu)); acc.w = bf2f((bf16)(xr >> 48)); }
#pragma unroll
                for (int k = 0; k < i; ++k) { const s16x4 a = *(const LAS s16x4*)(NI + (16 * i + cc) * RW_LD + 16 * k + 4 * g); acc = __builtin_amdgcn_mfma_f32_16x16x16bf16_1k(a, xb[k], acc, 0, 0, 0); }
                const s16x4 yb = cvt4(acc), ta = *(const LAS s16x4*)(TI + (i * 16 + cc) * 16 + 4 * g);
                const f32x4 xi = __builtin_amdgcn_mfma_f32_16x16x16bf16_1k(ta, yb, (f32x4){0.f, 0.f, 0.f, 0.f}, 0, 0, 0);
                xb[i] = cvt4(xi);
            }
            __syncthreads();
#pragma unroll
            for (int i = 0; i < 4; ++i) *(LAS s16x4*)(XB16 + (wave * 16 + cc) * RW_LD + 16 * i + 4 * g) = xb[i];
        }
        __syncthreads();
        {
            const int osel = wave >> 1, mt0 = (wave & 1) * 2; const size_t ob = (size_t)item * 4096;
            const LAS bf16* A1 = osel == 0 ? XB16 : osel == 1 ? BHc : osel == 2 ? XB16 : XB16 + 64 * RW_LD;
            const LAS bf16* B1 = osel == 0 ? BHc : osel == 1 ? XB16 + 64 * RW_LD : ARB;
            const LAS bf16* A2 = osel == 1 ? KHc : VTc; const LAS bf16* B2 = osel == 1 ? VTc : ARK;
            bf16* OUT = osel == 0 ? PP : osel == 1 ? QQ : osel == 2 ? RH : YH;
            f32x4 acc[2][4];
#pragma unroll
            for (int mq = 0; mq < 2; ++mq)
#pragma unroll
                for (int nt = 0; nt < 4; ++nt) acc[mq][nt] = (f32x4){0.f, 0.f, 0.f, 0.f};
            { s16x8 af[2][2], bfm[4][2];
#pragma unroll
              for (int mq = 0; mq < 2; ++mq)
#pragma unroll
                  for (int k = 0; k < 2; ++k) af[mq][k] = *(const LAS s16x8*)(A1 + ((mt0 + mq) * 16 + cc) * RW_LD + 32 * k + 8 * g);
#pragma unroll
              for (int nt = 0; nt < 4; ++nt)
#pragma unroll
                  for (int k = 0; k < 2; ++k) bfm[nt][k] = *(const LAS s16x8*)(B1 + (nt * 16 + cc) * RW_LD + 32 * k + 8 * g);
#pragma unroll
              for (int mq = 0; mq < 2; ++mq)
#pragma unroll
                  for (int nt = 0; nt < 4; ++nt) { acc[mq][nt] = __builtin_amdgcn_mfma_f32_16x16x32_bf16(af[mq][0], bfm[nt][0], acc[mq][nt], 0, 0, 0); acc[mq][nt] = __builtin_amdgcn_mfma_f32_16x16x32_bf16(af[mq][1], bfm[nt][1], acc[mq][nt], 0, 0, 0); } }
            if (osel & 1) { s16x8 af[2][2], bfm[4][2];
#pragma unroll
              for (int mq = 0; mq < 2; ++mq)
#pragma unroll
                  for (int k = 0; k < 2; ++k) af[mq][k] = *(const LAS s16x8*)(A2 + ((mt0 + mq) * 16 + cc) * RW_LD + 32 * k + 8 * g);
#pragma unroll
              for (int nt = 0; nt < 4; ++nt)
#pragma unroll
                  for (int k = 0; k < 2; ++k) bfm[nt][k] = *(const LAS s16x8*)(B2 + (nt * 16 + cc) * RW_LD + 32 * k + 8 * g);
#pragma unroll
              for (int mq = 0; mq < 2; ++mq)
#pragma unroll
                  for (int nt = 0; nt < 4; ++nt) { acc[mq][nt] = __builtin_amdgcn_mfma_f32_16x16x32_bf16(af[mq][0], bfm[nt][0], acc[mq][nt], 0, 0, 0); acc[mq][nt] = __builtin_amdgcn_mfma_f32_16x16x32_bf16(af[mq][1], bfm[nt][1], acc[mq][nt], 0, 0, 0); } }
#pragma unroll
            for (int mq = 0; mq < 2; ++mq)
#pragma unroll
                for (int nt = 0; nt < 4; ++nt) { f32x4 a = acc[mq][nt];
                    if (osel == 2) { const unsigned long long rr = *(const LAS unsigned long long*)(RT + (nt * 16 + cc) * RW_LD + (mt0 + mq) * 16 + 4 * g);
                        a.x += bf2f((bf16)(rr & 0xffffu)); a.y += bf2f((bf16)((rr >> 16) & 0xffffu)); a.z += bf2f((bf16)((rr >> 32) & 0xffffu)); a.w += bf2f((bf16)(rr >> 48)); }
                    *(unsigned long long*)(OUT + ob + (nt * 16 + cc) * 64 + (mt0 + mq) * 16 + 4 * g) = pack4(a); }
        }
        __syncthreads();
      }
    }
}

#undef RW_FETCH
constexpr int CH_R = 6, CH_SLOT = 9216 + 9216 + 256;
constexpr int CH_RING = 0, CH_SI = CH_R * CH_SLOT, CH_FLAGS = CH_SI + 4 * 2304;
static_assert(CH_FLAGS + 64 <= MISC_OFF, "chain LDS map");
struct ChainRegs { v4u p[8], q[8]; f32x4 gm; };
__device__ __forceinline__ void chain_fetch(ChainRegs& o, const bf16* PP, const bf16* QQ, const float* GAMC, int item, int lane) {
    const size_t ob = (size_t)item * 4096;
#pragma unroll
    for (int i = 0; i < 8; ++i) { o.p[i] = *(const v4u*)(PP + ob + (size_t)(i * 64 + lane) * 8); o.q[i] = *(const v4u*)(QQ + ob + (size_t)(i * 64 + lane) * 8); }
    o.gm = *(const f32x4*)(GAMC + (size_t)item * 64 + (lane & 15) * 4);
}
__device__ __forceinline__ void chain_commit(const ChainRegs& o, LAS unsigned char* L, int c, int lane) {
    volatile LAS unsigned* flags = (volatile LAS unsigned*)(L + CH_FLAGS);
    const int slot = c % CH_R;
    if (c >= CH_R) { const unsigned need = (unsigned)(c - CH_R + 1);
        for (;;) { const unsigned m0 = flags[CH_R + 0], m1 = flags[CH_R + 1], m2 = flags[CH_R + 2], m3 = flags[CH_R + 3];
            if (m0 >= need && m1 >= need && m2 >= need && m3 >= need) break; __builtin_amdgcn_s_sleep(1); } }
    asm volatile("" ::: "memory");
    LAS unsigned char* sl = L + CH_RING + slot * CH_SLOT;
#pragma unroll
    for (int i = 0; i < 8; ++i) { const int idx = i * 64 + lane, row = idx >> 3, c16 = idx & 7;
        *(LAS v4u*)(sl + row * 144 + c16 * 16) = o.p[i]; *(LAS v4u*)(sl + 9216 + row * 144 + c16 * 16) = o.q[i]; }
    if (lane < 16) *(LAS f32x4*)(sl + 18432 + lane * 16) = o.gm;
    asm volatile("s_waitcnt lgkmcnt(0)" ::: "memory");
    if (lane == 0) flags[slot] = (unsigned)(c + 1);
}
__device__ __forceinline__ void ph_rwkv_b(const Ctx& C, int bh  , const bf16* PP, const bf16* QQ, const float* GAMC, bf16* S0) {
    const int lane = C.lane, wave = C.wave, cc = lane & 15, g = lane >> 4, b = bh >> 3, h = bh & 7;
    LAS unsigned char* L = C.lds;
    volatile LAS unsigned* flags = (volatile LAS unsigned*)(L + CH_FLAGS);
    if (C.tid < 16) flags[C.tid] = 0u;
    __syncthreads();
    if (wave >= 4) {
        const int j = wave - 4;
        ChainRegs A, B;
        int lc = j;
        chain_fetch(A, PP, QQ, GAMC, (b * 128 + lc) * 8 + h, lane);
        for (;;) {
            if (lc + 4 < 128) chain_fetch(B, PP, QQ, GAMC, (b * 128 + lc + 4) * 8 + h, lane);
            chain_commit(A, L, lc, lane);
            lc += 4; if (lc >= 128) break;
            if (lc + 4 < 128) chain_fetch(A, PP, QQ, GAMC, (b * 128 + lc + 4) * 8 + h, lane);
            chain_commit(B, L, lc, lane);
            lc += 4; if (lc >= 128) break;
        }
    } else {
        const int vt = wave;
        LAS bf16* SI = (LAS bf16*)(L + CH_SI + vt * 2304);
        f32x4 st[4];
#pragma unroll
        for (int mt = 0; mt < 4; ++mt) st[mt] = (f32x4){0.f, 0.f, 0.f, 0.f};
        for (int c = 0; c < 128; ++c) {
            const int item = (b * 128 + c) * 8 + h, slot = c % CH_R; const size_t ob = (size_t)item * 4096;
#pragma unroll
            for (int mt = 0; mt < 4; ++mt) { const unsigned long long pk = pack4(st[mt]);
                *(unsigned long long*)(S0 + ob + (vt * 16 + cc) * 64 + mt * 16 + 4 * g) = pk; *(LAS unsigned long long*)(SI + cc * RW_LD + mt * 16 + 4 * g) = pk; }
            while (flags[slot] < (unsigned)(c + 1)) __builtin_amdgcn_s_sleep(1);
            asm volatile("s_waitcnt lgkmcnt(0)" ::: "memory");
            const LAS unsigned char* sl = L + CH_RING + slot * CH_SLOT;
            const LAS bf16* Pi = (const LAS bf16*)sl; const LAS bf16* Qi = (const LAS bf16*)(sl + 9216); const LAS float* Gi = (const LAS float*)(sl + 18432);
            const s16x8 b0 = *(const LAS s16x8*)(SI + cc * RW_LD + 8 * g), b1 = *(const LAS s16x8*)(SI + cc * RW_LD + 32 + 8 * g);
#pragma unroll
            for (int mt = 0; mt < 4; ++mt) {
                const f32x4 gm = *(const LAS f32x4*)(Gi + mt * 16 + 4 * g);
                const unsigned long long qq = *(const LAS unsigned long long*)(Qi + (vt * 16 + cc) * RW_LD + mt * 16 + 4 * g);
                const s16x8 a0 = *(const LAS s16x8*)(Pi + (mt * 16 + cc) * RW_LD + 8 * g), a1 = *(const LAS s16x8*)(Pi + (mt * 16 + cc) * RW_LD + 32 + 8 * g);
                f32x4 acc; acc.x = gm.x * st[mt].x + bf2f((bf16)(qq & 0xffffu)); acc.y = gm.y * st[mt].y + bf2f((bf16)((qq >> 16) & 0xffffu));
                acc.z = gm.z * st[mt].z + bf2f((bf16)((qq >> 32) & 0xffffu)); acc.w = gm.w * st[mt].w + bf2f((bf16)(qq >> 48));
                acc = __builtin_amdgcn_mfma_f32_16x16x32_bf16(a0, b0, acc, 0, 0, 0); acc = __builtin_amdgcn_mfma_f32_16x16x32_bf16(a1, b1, acc, 0, 0, 0);
                st[mt] = acc; }
            asm volatile("s_waitcnt lgkmcnt(0)" ::: "memory");
            if (lane == 0) flags[CH_R + vt] = (unsigned)(c + 1);
        }
    }
    __syncthreads();
}

__device__ __forceinline__ void ph_rwkv_c(const Ctx& C, const bf16* S0, const bf16* RH, const bf16* YH, const float* RK, const bf16* GG, const bf16* VF,
                                          const float* gn_g, const float* gn_b, bf16* O) {
    const int lane = C.lane, cc = lane & 15, g = lane >> 4;
    for (int item = C.bid * 8 + C.wave; item < 4096; item += C.nb * 8) {
        const int h = item & 7, c = (item >> 3) & 127, b = item >> 10; const size_t m0 = (size_t)b * T_ + c * 64, ob = (size_t)item * 4096;
        s16x8 af[4][2], bfr[4][2];
#pragma unroll
        for (int q = 0; q < 4; ++q)
#pragma unroll
            for (int k = 0; k < 2; ++k) { af[q][k] = *(const s16x8*)(S0 + ob + (q * 16 + cc) * 64 + k * 32 + 8 * g); bfr[q][k] = *(const s16x8*)(RH + ob + (q * 16 + cc) * 64 + k * 32 + 8 * g); }
#pragma unroll
        for (int nt = 0; nt < 4; ++nt) {
            const size_t m = m0 + nt * 16 + cc;
            f32x4 y[4]; float s1 = 0.f;
#pragma unroll
            for (int mt = 0; mt < 4; ++mt) { const unsigned long long yh = *(const unsigned long long*)(YH + ob + (nt * 16 + cc) * 64 + mt * 16 + 4 * g);
                f32x4 acc; acc.x = bf2f((bf16)(yh & 0xffffu)); acc.y = bf2f((bf16)((yh >> 16) & 0xffffu)); acc.z = bf2f((bf16)((yh >> 32) & 0xffffu)); acc.w = bf2f((bf16)(yh >> 48));
                acc = __builtin_amdgcn_mfma_f32_16x16x32_bf16(af[mt][0], bfr[nt][0], acc, 0, 0, 0); acc = __builtin_amdgcn_mfma_f32_16x16x32_bf16(af[mt][1], bfr[nt][1], acc, 0, 0, 0);
                y[mt] = acc; s1 += (acc.x + acc.y) + (acc.z + acc.w); }
            s1 = xsum4(s1);
            const float mean = s1 * (1.f / 64.f); float s2 = 0.f;
#pragma unroll
            for (int mt = 0; mt < 4; ++mt) { y[mt] = y[mt] - mean; s2 += (y[mt].x * y[mt].x + y[mt].y * y[mt].y) + (y[mt].z * y[mt].z + y[mt].w * y[mt].w); }
            s2 = xsum4(s2);
            const float rstd = 1.f / sqrtf(s2 * (1.f / 64.f) + 64e-5f), rk = RK[m * 8 + h];
#pragma unroll
            for (int mt = 0; mt < 4; ++mt) { const int v = h * 64 + mt * 16 + 4 * g;
                const f32x4 gg4 = *(const f32x4*)(gn_g + v), gb4 = *(const f32x4*)(gn_b + v);
                const unsigned long long vx = *(const unsigned long long*)(VF + m * 512 + v), gx = *(const unsigned long long*)(GG + m * 512 + v);
                f32x4 o;
                o.x = (y[mt].x * rstd * gg4.x + gb4.x + rk * bf2f((bf16)(vx & 0xffffu))) * bf2f((bf16)(gx & 0xffffu));
                o.y = (y[mt].y * rstd * gg4.y + gb4.y + rk * bf2f((bf16)((vx >> 16) & 0xffffu))) * bf2f((bf16)((gx >> 16) & 0xffffu));
                o.z = (y[mt].z * rstd * gg4.z + gb4.z + rk * bf2f((bf16)((vx >> 32) & 0xffffu))) * bf2f((bf16)((gx >> 32) & 0xffffu));
                o.w = (y[mt].w * rstd * gg4.w + gb4.w + rk * bf2f((bf16)(vx >> 48))) * bf2f((bf16)(gx >> 48));
                *(unsigned long long*)(O + m * D_ + 512 + v) = pack4(o); }
        }
    }
}

__device__ __forceinline__ void ph_convfix(const Ctx& C, const float* HALO, const float* FIXU, const float* cw, const float* cb, bf16* ACT) {
    for (int idx = C.bid * NT + C.tid; idx < 128 * 22 * 2 * 128; idx += C.nb * NT) {
        const int j = idx & 127, rr = (idx >> 7) & 1, tile = idx >> 8, pm = tile / 22, pn = tile % 22;
        const bool seq0 = (pm & 31) == 0;
        const float* fx = FIXU + (size_t)tile * 512; const float* hl = HALO + (size_t)(tile - 22) * 512;
        const float u0g = fx[rr * 256 + j], u0v = fx[rr * 256 + 128 + j];
        float u1g, u1v, u2g, u2v;
        if (rr == 0) { u1g = seq0 ? 0.f : hl[256 + j]; u1v = seq0 ? 0.f : hl[256 + 128 + j]; u2g = seq0 ? 0.f : hl[j]; u2v = seq0 ? 0.f : hl[128 + j]; }
        else { u1g = fx[j]; u1v = fx[128 + j]; u2g = seq0 ? 0.f : hl[256 + j]; u2v = seq0 ? 0.f : hl[256 + 128 + j]; }
        const int jg = pn * 128 + j, jv = DFF + jg;
        const float gc = cb[jg] + cw[jg] * u2g + cw[NUP + jg] * u1g + cw[2 * NUP + jg] * u0g, vc = cb[jv] + cw[jv] * u2v + cw[NUP + jv] * u1v + cw[2 * NUP + jv] * u0v;
        ACT[(size_t)(pm * 256 + rr) * DFF + jg] = (bf16)f2bf(siluf_(gc) * vc);
    }
}
}

namespace pg8 {
struct EpiRes {
    static constexpr bool PERM = false, AFTER_DRAIN = false;
    const float* base; float* out; const float* gate; int gstride;
    __device__ __forceinline__ void operator()(const f32x4 (&acc)[2][2][4][2], const Unit& u, int wr, int wc, int fr, int fq) const {
        const int b = (u.pm * BM) / 8192; const float* gp = gate + (size_t)b * gstride;
        const int col0 = u.pn * BM + wc * 32 + 4 * fq;
        f32x4 gv[2][2];
#pragma unroll
        for (int bj = 0; bj < 2; ++bj)
#pragma unroll
            for (int n = 0; n < 2; ++n) gv[bj][n] = *(const f32x4*)(gp + col0 + bj * HALF + n * 16);
#pragma unroll
        for (int ai = 0; ai < 2; ++ai)
#pragma unroll
            for (int m = 0; m < 4; ++m) { const size_t off = (size_t)(u.pm * BM + ai * HALF + wr * 64 + m * 16 + fr) * 1024 + col0;
                f32x4 bs[2][2];
#pragma unroll
                for (int bj = 0; bj < 2; ++bj)
#pragma unroll
                    for (int n = 0; n < 2; ++n) bs[bj][n] = *(const f32x4*)(base + off + bj * HALF + n * 16);
#pragma unroll
                for (int bj = 0; bj < 2; ++bj)
#pragma unroll
                    for (int n = 0; n < 2; ++n) *(f32x4*)(out + off + bj * HALF + n * 16) = bs[bj][n] + gv[bj][n] * acc[ai][bj][m][n]; }
    }
};

template <bool BASE32> struct EpiResB {
    static constexpr bool PERM = true, AFTER_DRAIN = false;
    const float* base32; bf16_t* R; const float* gate; int gstride;
    __device__ __forceinline__ void operator()(const f32x4 (&acc)[2][2][4][2], const Unit& u, int wr, int wc, int fr, int fq) const {
        const int b = u.pm >> 5; const float* gp = gate + (size_t)b * gstride;
        const int col0 = u.pn * BM + wc * 32 + 8 * fq;
        f32x4 gv[2][2];
#pragma unroll
        for (int bj = 0; bj < 2; ++bj)
#pragma unroll
            for (int n = 0; n < 2; ++n) gv[bj][n] = *(const f32x4*)(gp + col0 + bj * HALF + n * 4);
#pragma unroll
        for (int ai = 0; ai < 2; ++ai)
#pragma unroll
            for (int m = 0; m < 4; ++m) { const size_t off = (size_t)(u.pm * BM + ai * HALF + wr * 64 + m * 16 + fr) * 1024 + col0;
                f32x4 bs[2][2];
#pragma unroll
                for (int bj = 0; bj < 2; ++bj) {
                    if (BASE32) { bs[bj][0] = *(const f32x4*)(base32 + off + bj * HALF); bs[bj][1] = *(const f32x4*)(base32 + off + bj * HALF + 4); }
                    else { const u32x4 r = *(const u32x4*)(R + off + bj * HALF);
                        bs[bj][0] = (f32x4){__builtin_bit_cast(float, r.x << 16), __builtin_bit_cast(float, r.x & 0xffff0000u), __builtin_bit_cast(float, r.y << 16), __builtin_bit_cast(float, r.y & 0xffff0000u)};
                        bs[bj][1] = (f32x4){__builtin_bit_cast(float, r.z << 16), __builtin_bit_cast(float, r.z & 0xffff0000u), __builtin_bit_cast(float, r.w << 16), __builtin_bit_cast(float, r.w & 0xffff0000u)}; } }
#pragma unroll
                for (int bj = 0; bj < 2; ++bj) { const f32x4 o0 = bs[bj][0] + gv[bj][0] * acc[ai][bj][m][0], o1 = bs[bj][1] + gv[bj][1] * acc[ai][bj][m][1];
                    u32x4 w; w.x = cvt_pk_bf16(o0.x, o0.y); w.y = cvt_pk_bf16(o0.z, o0.w); w.z = cvt_pk_bf16(o1.x, o1.y); w.w = cvt_pk_bf16(o1.z, o1.w);
                    *(u32x4*)(R + off + bj * HALF) = w; } }
    }
};
struct EpiConv {
    static constexpr bool PERM = true, AFTER_DRAIN = false;
    bf16_t* ACT; const float* cw; const float* cb; float* HALO; float* FIXU; PG8_LAS float* EX; int nN;
    template <int CTRL> static __device__ __forceinline__ float ror1(float x) { return __builtin_bit_cast(float, __builtin_amdgcn_mov_dpp(__builtin_bit_cast(int, x), CTRL, 0xf, 0xf, true)); }
    template <int CTRL> static __device__ __forceinline__ f32x4 ror4(f32x4 x) { return (f32x4){ror1<CTRL>(x.x), ror1<CTRL>(x.y), ror1<CTRL>(x.z), ror1<CTRL>(x.w)}; }
    template <int CTRL> static __device__ __forceinline__ float shr1(float old, float x) { return __builtin_bit_cast(float, __builtin_amdgcn_update_dpp(__builtin_bit_cast(int, old), __builtin_bit_cast(int, x), CTRL, 0xf, 0xf, false)); }
    template <int CTRL> static __device__ __forceinline__ f32x4 shr4(f32x4 o, f32x4 x) { return (f32x4){shr1<CTRL>(o.x, x.x), shr1<CTRL>(o.y, x.y), shr1<CTRL>(o.z, x.z), shr1<CTRL>(o.w, x.w)}; }
    __device__ __forceinline__ void operator()(const f32x4 (&acc)[2][2][4][2], const Unit& u, int wr, int wc, int fr, int fq) const {
        const int colw = wc * 32 + 8 * fq, tile = u.pm * nN + u.pn;
        if (fr >= 14) {
#pragma unroll
            for (int ai = 0; ai < 2; ++ai)
#pragma unroll
                for (int bj = 0; bj < 2; ++bj)
#pragma unroll
                    for (int n = 0; n < 2; ++n) { *(PG8_LAS f32x4*)(EX + ((ai * 2 + wr) * 2 + (fr - 14)) * 256 + bj * 128 + colw + 4 * n) = acc[ai][bj][3][n];
                        if (ai == 1 && wr == 1) *(f32x4*)(HALO + ((size_t)tile * 2 + (fr - 14)) * 256 + bj * 128 + colw + 4 * n) = acc[1][bj][3][n]; }
        }
        if (fr < 2 && wr == 0) {
#pragma unroll
            for (int bj = 0; bj < 2; ++bj)
#pragma unroll
                for (int n = 0; n < 2; ++n) *(f32x4*)(FIXU + ((size_t)tile * 2 + fr) * 256 + bj * 128 + colw + 4 * n) = acc[0][bj][0][n];
        }
        asm volatile("s_waitcnt lgkmcnt(0)" ::: "memory"); __builtin_amdgcn_s_barrier(); asm volatile("" ::: "memory");
#pragma unroll
        for (int n = 0; n < 2; ++n) {
            const int jg = u.pn * 128 + colw + 4 * n, jv = 2816 + jg;
            f32x4 cw0[2], cw1[2], cw2[2], cbb[2];
            cw0[0] = *(const f32x4*)(cw + jg); cw1[0] = *(const f32x4*)(cw + 5632 + jg); cw2[0] = *(const f32x4*)(cw + 2 * 5632 + jg); cbb[0] = *(const f32x4*)(cb + jg);
            cw0[1] = *(const f32x4*)(cw + jv); cw1[1] = *(const f32x4*)(cw + 5632 + jv); cw2[1] = *(const f32x4*)(cw + 2 * 5632 + jv); cbb[1] = *(const f32x4*)(cb + jv);
#pragma unroll
            for (int ai = 0; ai < 2; ++ai) {
                const int src = ai * 2 + wr - 1;
                f32x4 res[2][4];
#pragma unroll
                for (int bj = 0; bj < 2; ++bj) {
                    f32x4 o1 = {0.f, 0.f, 0.f, 0.f}, o2 = o1;
                    if (src >= 0) { const f32x4 e14 = *(const PG8_LAS f32x4*)(EX + (src * 2 + 0) * 256 + bj * 128 + colw + 4 * n), e15 = *(const PG8_LAS f32x4*)(EX + (src * 2 + 1) * 256 + bj * 128 + colw + 4 * n);
                        o1 = e15; o2 = (fr == 0) ? e14 : e15; }
#pragma unroll
                    for (int m = 0; m < 4; ++m) {
                        const f32x4 x = acc[ai][bj][m][n];
                        const f32x4 x1 = shr4<0x111>(o1, x), x2 = shr4<0x112>(o2, x);
                        res[bj][m] = cbb[bj] + cw0[bj] * x2 + cw1[bj] * x1 + cw2[bj] * x;
                        if (m < 3) { o1 = ror4<0x121>(x); o2 = ror4<0x122>(x); }
                    }
                }
#pragma unroll
                for (int m = 0; m < 4; ++m) {
                    const f32x4 gc = res[0][m], vc = res[1][m];
                    f32x4 o;
                    o.x = gc.x * __builtin_amdgcn_rcpf(1.f + __expf(-gc.x)) * vc.x; o.y = gc.y * __builtin_amdgcn_rcpf(1.f + __expf(-gc.y)) * vc.y;
                    o.z = gc.z * __builtin_amdgcn_rcpf(1.f + __expf(-gc.z)) * vc.z; o.w = gc.w * __builtin_amdgcn_rcpf(1.f + __expf(-gc.w)) * vc.w;
                    typedef unsigned u32x2 __attribute__((ext_vector_type(2)));
                    u32x2 w; w.x = cvt_pk_bf16(o.x, o.y); w.y = cvt_pk_bf16(o.z, o.w);
                    *(u32x2*)(ACT + (size_t)(u.pm * BM + ai * HALF + wr * 64 + m * 16 + fr) * 2816 + u.pn * 128 + colw + 4 * n) = w;
                }
            }
        }
    }
};
}

namespace hy {
struct Args { const float* in[31]; float* out; unsigned char* ws; };
__global__ void __launch_bounds__(NT, 2) hy_fwd(Args A) {
    extern __shared__ __attribute__((aligned(16))) unsigned char lds_raw[];
    Ctx C; C.bid = blockIdx.x; C.nb = gridDim.x; C.tid = threadIdx.x; C.lane = C.tid & 63; C.wave = __builtin_amdgcn_readfirstlane(C.tid >> 6); C.lds = (LAS unsigned char*)lds_raw;
    volatile LAS unsigned* MISC = (volatile LAS unsigned*)(C.lds + MISC_OFF);
    for (int u = C.tid; u < (LDS_BYTES - MISC_OFF) / 4; u += NT) ((LAS unsigned*)(C.lds + MISC_OFF))[u] = 0u;
    __syncthreads();
    unsigned char* ws = A.ws;
    const int wave0 = __builtin_amdgcn_readfirstlane(threadIdx.x >> 6);
    (void)xcd_barrier_post((unsigned*)(ws + WS_CTL) + CW_BAR, MISC + 8);
#define PHASE_BEGIN() do { int t_ = wave0 * 64 + lane_now(); int b_ = blockIdx.x; asm volatile("" : "+s"(b_)); \
    C.tid = t_; C.lane = t_ & 63; C.wave = __builtin_amdgcn_readfirstlane(t_ >> 6); C.bid = b_; } while (0)
#ifdef HY_DIAG
    unsigned long long ts_last = __builtin_amdgcn_s_memrealtime(); float tacc[10] = {0.f, 0.f, 0.f, 0.f, 0.f, 0.f, 0.f, 0.f, 0.f, 0.f};
#define GRID_BAR(cat) do { { XcdBarrier b_; b_.bar = (unsigned*)(A.ws + WS_CTL) + CW_BAR; b_.x = xb_xcc_id(); b_.st = (volatile LAS unsigned*)(C.lds + MISC_OFF) + 8; xcd_barrier(b_, wave0 == 0 && lane_now() == 0); } PHASE_BEGIN(); { const unsigned long long n_ = __builtin_amdgcn_s_memrealtime(); tacc[cat] += (float)(n_ - ts_last); ts_last = n_; } } while (0)
#else
#define GRID_BAR(cat) do { { XcdBarrier b_; b_.bar = (unsigned*)(A.ws + WS_CTL) + CW_BAR; b_.x = xb_xcc_id(); b_.st = (volatile LAS unsigned*)(C.lds + MISC_OFF) + 8; xcd_barrier(b_, wave0 == 0 && lane_now() == 0); } PHASE_BEGIN(); } while (0)
#endif
#ifndef HY_REPCAT
#define HY_REPCAT (-1)
#endif
#define NREP(cat) ((HY_REPCAT == (cat)) ? 2 : 1)
    float* out = A.out;
    bf16* RES = (bf16*)((unsigned char*)A.out + 64 * MiB);
#define in A.in
    float* MOD = (float*)(ws + WS_MOD);
    bf16 *WIN = (bf16*)(ws + WS_WIN), *WOUT = (bf16*)(ws + WS_WOUT), *WUP = (bf16*)(ws + WS_WUP), *WDN = (bf16*)(ws + WS_WDN);
    bf16 *XB = (bf16*)(ws + WS_XB), *O = (bf16*)(ws + WS_O), *VF = (bf16*)(ws + WS_VF), *PG = (bf16*)(ws + WS_PG), *PR = (bf16*)(ws + WS_PR), *VL = (bf16*)(ws + WS_VL);
    bf16 *RH = (bf16*)(ws + WS_RH), *YH = (bf16*)(ws + WS_YH), *PP = (bf16*)(ws + WS_PP), *QQ = (bf16*)(ws + WS_QQ), *GG = (bf16*)(ws + WS_GG), *S0 = (bf16*)(ws + WS_S0);
    float *GAMC = (float*)(ws + WS_GAMC), *RK = (float*)(ws + WS_RK);
    bf16* LORA = (bf16*)(ws + WS_LORA);
    bf16* DS = (bf16*)(ws + WS_GK); float* GAM = (float*)(ws + WS_GAM);
    bf16* ACT = (bf16*)(ws + WS_ACT); float *HALO = (float*)(ws + WS_U), *FIXU = (float*)(ws + WS_U + 8 * MiB);

    ph_mod(C, in[1], in[2], in[3], MOD);
    for (int l = 0; l < L_; ++l) {
        const float* modl = MOD + (size_t)l * 4 * 6144;
        for (int r_ = 0; r_ < NREP(0); ++r_) {
        wprep_mat(C, in[5] + (size_t)l * D_ * IN_COLS, D_, IN_COLS, NIN, WIN, 1, l ? in[6] : nullptr);
        wprep_mat(C, in[24] + (size_t)l * D_ * D_, D_, D_, D_, WOUT, 0, nullptr);
        wprep_mat(C, in[26] + (size_t)l * D_ * NUP, D_, NUP, NUP, WUP, 2, nullptr);
        wprep_mat(C, in[29] + (size_t)l * DFF * D_, DFF, D_, D_, WDN, 0, nullptr);
        wprep_mat(C, in[12] + (size_t)l * 64 * 512, 64, 512, 512, LORA, 0, nullptr);
        wprep_mat(C, in[14] + (size_t)l * 64 * 512, 64, 512, 512, LORA + 512 * 64, 0, nullptr);
        wprep_mat(C, in[16] + (size_t)l * 128 * 512, 128, 512, 512, LORA + 2 * 512 * 64, 0, nullptr);
        if (l) wprep_mat(C, in[17], 32, 512, 512, LORA + 2 * 512 * 64 + 512 * 128, 0, nullptr);
        }
        GRID_BAR(0);
        for (int r_ = 0; r_ < NREP(1); ++r_) { if (l == 0) ph_norm(C, in[0], in[4], modl + 0 * D_, modl + 1 * D_, XB); else ph_norm_b(C, RES, in[4] + l * D_, modl + 0 * D_, modl + 1 * D_, XB); }
        GRID_BAR(1);
        for (int r_ = 0; r_ < NREP(2); ++r_) { pg8::Gemm g{XB, WIN, M_, NIN, D_}; pg8::StaticOrder S; S.init(M_, NIN, C.nb, C.bid, HY_WGM_IN);
          pg8::EpiBf16<0> E{PG, NPG, nullptr, NPG, (WS_PR - WS_PG) / 2, 1.f};
          pg8::gemm_phase<pg8::EpiBf16<0>, pg8::StaticOrder, true, true>(C.lds, g, S, E, C.tid); }
        GRID_BAR(2);
        for (int r_ = 0; r_ < NREP(3); ++r_) {
        ph_gla_a(C, PG, in[7] + l * 16 * 256, in[8] + l * 256, DS, GAM);
        { RwkvW W{in[10] + l * 1792, in[11], in[13] + l * 512, in[15] + l * 512, in[18], in[19] + l * 512, in[20] + l * 512, in[21] + l * 512,
                  LORA, LORA + 512 * 64, LORA + 2 * 512 * 64, LORA + 2 * 512 * 64 + 512 * 128};
          ph_rwkv_a(C, PR, PG, W, l, PP, QQ, RH, YH, GAMC, RK, GG, VF, r_ == NREP(3) - 1); } }
        GRID_BAR(3);
        if (C.bid < 32) { for (int r_ = 0; r_ < NREP(4); ++r_) ph_rwkv_b(C, C.bid, PP, QQ, GAMC, S0); }
        else { Ctx C2 = C; C2.bid = C.bid - 32; C2.nb = C.nb - 32;
               ph_gla_b(C2, DS, GAM);
               group_barrier((unsigned*)(ws + WS_CTL) + 2048, (unsigned)(C.nb - 32) * (unsigned)(l + 1), wave0 == 0 && lane_now() == 0);
               PHASE_BEGIN(); C2 = C; C2.bid = C.bid - 32; C2.nb = C.nb - 32;
               ph_gla_c(C2, PG, in[7] + l * 16 * 256, in[8] + l * 256, in[9] + l * 128, DS, O); }
        GRID_BAR(4);
        for (int r_ = 0; r_ < NREP(5); ++r_) {
        ph_rwkv_c(C, S0, RH, YH, RK, GG, VF, in[22] + l * 512, in[23] + l * 512, O); }
        GRID_BAR(5);
        { pg8::Gemm g{O, WOUT, M_, D_, D_}; pg8::StaticOrder S; S.init(M_, D_, C.nb, C.bid);
          if (l == 0) { pg8::EpiResB<true> E{in[0], RES, modl + 2 * D_, 6144}; pg8::gemm_phase<pg8::EpiResB<true>, pg8::StaticOrder, true, true>(C.lds, g, S, E, C.tid); }
          else { pg8::EpiResB<false> E{nullptr, RES, modl + 2 * D_, 6144}; pg8::gemm_phase<pg8::EpiResB<false>, pg8::StaticOrder, true, true>(C.lds, g, S, E, C.tid); } }
        GRID_BAR(6);
        for (int r_ = 0; r_ < NREP(1); ++r_) ph_norm_b(C, RES, in[25] + l * D_, modl + 3 * D_, modl + 4 * D_, XB);
        GRID_BAR(1);
        for (int r_ = 0; r_ < NREP(7); ++r_) { pg8::Gemm g{XB, WUP, M_, NUP, D_}; pg8::StaticOrder S; S.init(M_, NUP, C.nb, C.bid, HY_WGM_UP);
          pg8::EpiConv E{ACT, in[27] + (size_t)l * 3 * NUP, in[28] + (size_t)l * NUP, HALO, FIXU, (PG8_LAS float*)(C.lds + RING_BYTES), NUP / 256};
          pg8::gemm_phase<pg8::EpiConv, pg8::StaticOrder, true, true>(C.lds, g, S, E, C.tid); }
        GRID_BAR(7);
        for (int r_ = 0; r_ < NREP(8); ++r_) ph_convfix(C, HALO, FIXU, in[27] + (size_t)l * 3 * NUP, in[28] + (size_t)l * NUP, ACT);
        GRID_BAR(8);
        { pg8::Gemm g{ACT, WDN, M_, D_, DFF}; pg8::StaticOrder S; S.init(M_, D_, C.nb, C.bid);
          pg8::EpiResB<false> E{nullptr, RES, modl + 5 * D_, 6144};
          pg8::gemm_phase<pg8::EpiResB<false>, pg8::StaticOrder, true, true>(C.lds, g, S, E, C.tid); }
        GRID_BAR(9);
    }
    ph_final_b(C, RES, in[30], out, 0, M_ / 2, XB, M_ / 2, M_);
    GRID_BAR(1);
    ph_final_b(C, XB - (size_t)(M_ / 2) * D_, in[30], out, M_ / 2, M_, nullptr, 0, 0);
#ifdef HY_DIAG
    GRID_BAR(1);
    if (C.bid == 0) { if (C.tid == 0) out[0] = tacc[HY_DIAG_A] * 0.1f; for (int i = 1 + C.tid; i <= 10000; i += NT) out[i] = tacc[HY_DIAG_B] * 0.01f; }
#endif
#undef GRID_BAR
#undef PHASE_BEGIN
#undef in
}
}

extern "C" void kernel_launch(void* const* d_in, const int* in_sizes, int n_in, void* d_out, int out_size, void* d_ws, size_t ws_size, hipStream_t stream) {
    using namespace hy;
    static int grid = 0;
    if (grid == 0) {
        if (n_in != 31 || in_sizes[0] != M_ * D_ || out_size != M_ * D_ || ws_size < WS_END) { fprintf(stderr, "kernel_launch: unexpected shapes (n_in %d, in0 %d, out %d, ws %zu)\n", n_in, n_in > 0 ? in_sizes[0] : -1, out_size, ws_size); grid = -1; return; }
        if (hipFuncSetAttribute((const void*)hy_fwd, hipFuncAttributeMaxDynamicSharedMemorySize, LDS_BYTES) != hipSuccess) { fprintf(stderr, "kernel_launch: hipFuncSetAttribute failed\n"); grid = -1; return; }
        int dev = 0, cus = 0, per_cu = 0;
        (void)hipGetDevice(&dev); (void)hipDeviceGetAttribute(&cus, hipDeviceAttributeMultiprocessorCount, dev);
        (void)hipOccupancyMaxActiveBlocksPerMultiprocessor(&per_cu, (const void*)hy_fwd, NT, LDS_BYTES);
        if (per_cu < 1) fprintf(stderr, "kernel_launch: occupancy query reports %d blocks per CU\n", per_cu);
        (void)hipGetLastError();
        grid = cus > 0 ? cus : 256;
    }
    if (grid < 0) return;
    (void)hipMemsetAsync((char*)d_ws + WS_CTL, 0, CTL_ZERO_BYTES, stream);
    Args a{};
    for (int i = 0; i < 31; ++i) a.in[i] = (const float*)d_in[i];
    a.out = (float*)d_out; a.ws = (unsigned char*)d_ws;
    hipLaunchKernelGGL(hy_fwd, dim3(grid), dim3(NT), LDS_BYTES, stream, a);
}
```

```cpp
#include <hip/hip_runtime.h>
#include <cstdio>
#include <cstdint>
namespace pg8 {
#define PG8_LAS __attribute__((address_space(3)))
typedef unsigned short bf16_t;
typedef short bf16x8 __attribute__((ext_vector_type(8)));
typedef float f32x4 __attribute__((ext_vector_type(4)));
typedef unsigned u32x4 __attribute__((ext_vector_type(4)));
constexpr int BM = 256, BK = 64, HALF = 128, HTB = HALF * BK * 2  , STAGE_BYTES = 8 * HTB, NXCD = 8;

__host__ __device__ __forceinline__ int lds_byte(int r, int c) { const int st = (r >> 4) * 2 + (c >> 5), rr = r & 15, cc = c & 31, ob = rr * 64 + cc * 2; return st * 1024 + (ob ^ (((ob >> 9) & 1) << 5)); }
__host__ __device__ __forceinline__ void stage_rc(int b, int& R, int& C) { const int st = b / 1024, sb = b % 1024, swz = sb ^ (((sb >> 9) & 1) << 5); R = (st >> 1) * 16 + swz / 64; C = (st & 1) * 32 + (swz % 64) / 2; }
__host__ __device__ __forceinline__ int perm32(int rho) { const int n = rho >> 4, i = rho & 15; return 8 * (i >> 2) + 4 * n + (i & 3); }

struct Unit { int pm, pn; };
struct Gemm { const bf16_t* A; const bf16_t* Bt; int M, N, K; size_t bstride; };

struct StaticOrder {
    int nM, nN, nwg, G, c, WGM;
    __host__ __device__ void init(int M, int N, int G_, int c_, int wgm = 2) { nM = M / BM; nN = N / BM; nwg = nM * nN; G = G_; c = c_; WGM = wgm; }
    __host__ __device__ bool next(int i, Unit& u) const {
        const long L = (long)i * G + c; if (L >= nwg) return false;
        int wgid = (int)L; { const int q = nwg / NXCD, r = nwg % NXCD, xcd = wgid % NXCD, off = wgid / NXCD; wgid = (xcd < r ? xcd * (q + 1) : r * (q + 1) + (xcd - r) * q) + off; }
        const int nig = WGM * nN, gid = wgid / nig, fm = gid * WGM, gsz = (nM - fm) < WGM ? (nM - fm) : WGM;
        u.pm = fm + ((wgid % nig) % gsz); u.pn = (wgid % nig) / gsz; return true;
    }
    __device__ __forceinline__ void a_ready(const Unit&) const {}
    __device__ __forceinline__ void done(const Unit&) const {}
};

__device__ __forceinline__ unsigned cvt_pk_bf16(float lo, float hi) { unsigned r; asm volatile("v_cvt_pk_bf16_f32 %0, %1, %2" : "=v"(r) : "v"(lo), "v"(hi)); return r; }
typedef float f32x2 __attribute__((ext_vector_type(2)));
__device__ __forceinline__ f32x2 gelu_pk(f32x2 v) {
    const f32x2 av = __builtin_elementwise_abs(v), d = av * 0.2316418882f + 1.0f;
    f32x2 t; t.x = __builtin_amdgcn_rcpf(d.x); t.y = __builtin_amdgcn_rcpf(d.y);
    f32x2 q = t * 0.5307027145f + (-0.7265760135f); q = q * t + 0.7107068705f; q = q * t + (-0.142248368f); q = q * t + 0.127414796f; q = q * t;
    const f32x2 s = (v * v) * (-0.72134752044f);
    f32x2 e; e.x = __builtin_amdgcn_exp2f(s.x); e.y = __builtin_amdgcn_exp2f(s.y);
    const f32x2 m = v * (q * e), r = v - m;
    f32x2 o; o.x = v.x < 0.f ? m.x : r.x; o.y = v.y < 0.f ? m.y : r.y; return o;
}

template <int ACT  > struct EpiBf16 {
    static constexpr bool PERM = true, AFTER_DRAIN = false; static_assert(ACT == 0 || ACT == 1, "EpiBf16: ACT is 0 (none) or 1 (gelu_pk)");
    bf16_t* O; int ldc; const float* bias; int split_cols; size_t split_stride; float scale0;
    __device__ __forceinline__ void operator()(const f32x4 (&acc)[2][2][4][2], const Unit& u, int wr, int wc, int fr, int fq) const {
        const int row0 = u.pm * BM + wr * 64 + fr; int colt = u.pn * BM; bf16_t* base = O;
        float sc = 1.f; if (split_cols) { const int t = colt / split_cols; base += (size_t)t * split_stride; colt -= t * split_cols; if (t == 0) sc = scale0; }
        const int col0 = colt + wc * 32 + 8 * fq, bcol0 = u.pn * BM + wc * 32 + 8 * fq;
        f32x4 bv[2][2];
#pragma unroll
        for (int bj = 0; bj < 2; ++bj)
#pragma unroll
            for (int n = 0; n < 2; ++n) bv[bj][n] = bias ? *(const f32x4*)(bias + bcol0 + bj * HALF + 4 * n) : (f32x4){0.f, 0.f, 0.f, 0.f};
#pragma unroll
        for (int ai = 0; ai < 2; ++ai)
#pragma unroll
            for (int m = 0; m < 4; ++m) { bf16_t* rowp = base + (size_t)(row0 + ai * HALF + m * 16) * ldc + col0;
#pragma unroll
                for (int bj = 0; bj < 2; ++bj) { f32x4 v0 = acc[ai][bj][m][0] + bv[bj][0], v1 = acc[ai][bj][m][1] + bv[bj][1];
                    if (ACT == 1) { f32x2 a = gelu_pk((f32x2){v0[0], v0[1]}), b = gelu_pk((f32x2){v0[2], v0[3]}), c = gelu_pk((f32x2){v1[0], v1[1]}), d = gelu_pk((f32x2){v1[2], v1[3]});
                        v0 = (f32x4){a.x, a.y, b.x, b.y}; v1 = (f32x4){c.x, c.y, d.x, d.y}; }
                    v0 = v0 * sc; v1 = v1 * sc; u32x4 w; w.x = cvt_pk_bf16(v0[0], v0[1]); w.y = cvt_pk_bf16(v0[2], v0[3]); w.z = cvt_pk_bf16(v1[0], v1[1]); w.w = cvt_pk_bf16(v1[2], v1[3]);
                    *(u32x4*)(rowp + bj * HALF) = w; } }
    }
};
template <class Epi, class Sched, bool ALIGN_EPI = false, bool SP2 = false>
__device__ __forceinline__ void gemm_phase(PG8_LAS unsigned char* lds, const Gemm g, const Sched& S, const Epi& E, int tid_in) {
    int tid_ = tid_in; asm volatile("" : "+v"(tid_));
    const int tid = tid_, wid = __builtin_amdgcn_readfirstlane(tid >> 6), lane = tid & 63, wr = wid >> 2, wc = wid & 3, fr = lane & 15, fq = lane >> 4;
    const int K = g.K, nt = K / BK;
    unsigned voffA[2], voffB[2];
#pragma unroll
    for (int i = 0; i < 2; ++i) { int R, C; stage_rc(tid * 16 + i * 8192, R, C); const int Rb = Epi::PERM ? ((R & ~31) + perm32(R & 31)) : R;
        voffA[i] = (unsigned)(R * K + C) * 2u; voffB[i] = (unsigned)(Rb * K + C) * 2u; }
    const size_t kstep = (size_t)(BK * 2);
    const size_t hstep = (size_t)HALF * K * 2;
    const size_t tstep = 2 * hstep;
    const unsigned ldsw = (unsigned)wid * 1024u;
    const int aoff = lds_byte(wr * 64 + fr, fq * 8), boff = lds_byte(wc * 32 + fr, fq * 8);
#define PG8_SA(b, h) (((b) * 2 + (h)) * HTB)
#define PG8_SB(b, h) ((4 + (b) * 2 + (h)) * HTB)
#define PG8_STAGE(bufoff, gbase, voff) do { _Pragma("unroll") for (int _i = 0; _i < 2; ++_i) \
        __builtin_amdgcn_global_load_lds((const unsigned*)((const char*)(gbase) + (voff)[_i]), (PG8_LAS unsigned*)(lds + (bufoff) + ldsw + _i * 8192), 16, 0, 0); } while (0)
#define PG8_LDA(dst, b, h) do { _Pragma("unroll") for (int m = 0; m < 4; ++m) _Pragma("unroll") for (int k = 0; k < 2; ++k) dst[m][k] = *(const PG8_LAS bf16x8*)(lds + PG8_SA(b, h) + aoff + m * 2048 + k * 1024); } while (0)
#define PG8_LDB(dst, b, h) do { _Pragma("unroll") for (int n = 0; n < 2; ++n) _Pragma("unroll") for (int k = 0; k < 2; ++k) dst[n][k] = *(const PG8_LAS bf16x8*)(lds + PG8_SB(b, h) + boff + n * 2048 + k * 1024); } while (0)
#define PG8_MMA(ai, bj, At, Bt) do { __builtin_amdgcn_s_setprio(1); _Pragma("unroll") for (int m = 0; m < 4; ++m) _Pragma("unroll") for (int n = 0; n < 2; ++n) _Pragma("unroll") for (int k = 0; k < 2; ++k) \
        acc[ai][bj][m][n] = __builtin_amdgcn_mfma_f32_16x16x32_bf16(Bt[n][k], At[m][k], acc[ai][bj][m][n], 0, 0, 0); __builtin_amdgcn_s_setprio(0); } while (0)
#define PG8_WAIT_V(n) asm volatile("s_waitcnt vmcnt(" #n ")" ::: "memory")
#define PG8_WAIT_L(n) asm volatile("s_waitcnt lgkmcnt(" #n ")" ::: "memory")
#define PG8_BAR __builtin_amdgcn_s_barrier()
#define PG8_SCHED __builtin_amdgcn_sched_barrier(0)
    Unit cur, nxt; int ui = 0;
    if (!S.next(0, cur)) return;
    f32x4 acc[2][2][4][2];
#pragma unroll
    for (int a = 0; a < 2; ++a)
#pragma unroll
        for (int b = 0; b < 2; ++b)
#pragma unroll
            for (int m = 0; m < 4; ++m)
#pragma unroll
                for (int n = 0; n < 2; ++n) acc[a][b][m][n] = (f32x4){0.f, 0.f, 0.f, 0.f};
    bf16x8 At[4][2], B0[2][2], B1[2][2];
    const char* cA = (const char*)g.A + (size_t)cur.pm * tstep; const char* cB = (const char*)g.Bt + (size_t)cur.pn * tstep + (size_t)(cur.pm >> 5) * g.bstride;
    S.a_ready(cur);
    if constexpr (SP2) {
        PG8_STAGE(PG8_SB(0, 0), cB, voffB); PG8_STAGE(PG8_SB(0, 1), cB + hstep, voffB); PG8_STAGE(PG8_SA(0, 0), cA, voffA); PG8_STAGE(PG8_SA(0, 1), cA + hstep, voffA);
        if (wr == 1) PG8_BAR;
        PG8_WAIT_V(2); PG8_BAR;
        PG8_STAGE(PG8_SB(1, 0), cB + kstep, voffB); PG8_STAGE(PG8_SA(1, 0), cA + kstep, voffA); PG8_STAGE(PG8_SB(1, 1), cB + hstep + kstep, voffB);
        PG8_WAIT_V(6); PG8_BAR;
    } else {
        PG8_STAGE(PG8_SB(0, 0), cB, voffB); PG8_STAGE(PG8_SA(0, 0), cA, voffA); PG8_STAGE(PG8_SB(0, 1), cB + hstep, voffB); PG8_STAGE(PG8_SA(0, 1), cA + hstep, voffA);
        if (wr == 1) PG8_BAR;
        PG8_WAIT_V(4); PG8_BAR;
        PG8_STAGE(PG8_SB(1, 0), cB + kstep, voffB); PG8_STAGE(PG8_SA(1, 0), cA + kstep, voffA); PG8_STAGE(PG8_SB(1, 1), cB + hstep + kstep, voffB);
        PG8_WAIT_V(6); PG8_BAR;
    }
    for (;;) {
        const bool has_next = S.next(ui + 1, nxt);
        const char* nA = has_next ? (const char*)g.A + (size_t)nxt.pm * tstep : cA; const char* nB = has_next ? (const char*)g.Bt + (size_t)nxt.pn * tstep + (size_t)(nxt.pm >> 5) * g.bstride : cB;
        for (int t = 0; t < nt; t += 2) {
            const bool last = (t == nt - 2);
            const char* a1 = cA + (size_t)(t + 1) * kstep;
            const char* a2 = last ? nA : cA + (size_t)(t + 2) * kstep; const char* b2 = last ? nB : cB + (size_t)(t + 2) * kstep;
            const char* a3 = a2 + kstep; const char* b3 = b2 + kstep;
            if (last && has_next) S.a_ready(nxt);
            if constexpr (SP2) {
            PG8_LDB(B0, 0, 0); PG8_LDB(B1, 0, 1); PG8_SCHED; PG8_LDA(At, 0, 0); PG8_STAGE(PG8_SA(1, 1), a1 + hstep, voffA);
            PG8_WAIT_V(8); PG8_WAIT_L(0); PG8_BAR; PG8_MMA(0, 0, At, B0); PG8_MMA(0, 1, At, B1); PG8_BAR; PG8_SCHED;
            PG8_LDA(At, 0, 1); PG8_STAGE(PG8_SB(0, 0), b2, voffB); PG8_STAGE(PG8_SB(0, 1), b2 + hstep, voffB); PG8_STAGE(PG8_SA(0, 0), a2, voffA);
            PG8_WAIT_V(8); PG8_WAIT_L(0); PG8_BAR; PG8_MMA(1, 0, At, B0); PG8_MMA(1, 1, At, B1); PG8_BAR; PG8_SCHED;
            PG8_LDB(B0, 1, 0); PG8_LDB(B1, 1, 1); PG8_SCHED; PG8_LDA(At, 1, 0); PG8_STAGE(PG8_SA(0, 1), a2 + hstep, voffA);
            PG8_WAIT_V(8); PG8_WAIT_L(0); PG8_BAR; PG8_MMA(0, 0, At, B0); PG8_MMA(0, 1, At, B1); PG8_BAR; PG8_SCHED;
            PG8_LDA(At, 1, 1); PG8_STAGE(PG8_SB(1, 0), b3, voffB); PG8_STAGE(PG8_SB(1, 1), b3 + hstep, voffB); PG8_STAGE(PG8_SA(1, 0), a3, voffA);
            PG8_WAIT_V(8); PG8_WAIT_L(0); PG8_BAR; PG8_MMA(1, 0, At, B0); PG8_MMA(1, 1, At, B1); PG8_BAR; PG8_SCHED;
            } else {
            PG8_LDB(B0, 0, 0); PG8_SCHED; PG8_LDA(At, 0, 0); PG8_STAGE(PG8_SA(1, 1), a1 + hstep, voffA);
            PG8_WAIT_L(8); PG8_BAR; PG8_WAIT_L(0); PG8_MMA(0, 0, At, B0); PG8_BAR; PG8_SCHED;
            PG8_LDB(B1, 0, 1); PG8_STAGE(PG8_SB(0, 0), b2, voffB);
            PG8_BAR; PG8_WAIT_L(0); PG8_MMA(0, 1, At, B1); PG8_BAR;
            PG8_LDA(At, 0, 1); PG8_STAGE(PG8_SA(0, 0), a2, voffA);
            PG8_BAR; PG8_WAIT_L(0); PG8_MMA(1, 0, At, B0); PG8_BAR; PG8_SCHED;
            PG8_STAGE(PG8_SB(0, 1), b2 + hstep, voffB);
            PG8_WAIT_V(6); PG8_BAR; PG8_MMA(1, 1, At, B1); PG8_BAR;
            PG8_LDB(B0, 1, 0); PG8_SCHED; PG8_LDA(At, 1, 0); PG8_STAGE(PG8_SA(0, 1), a2 + hstep, voffA);
            PG8_WAIT_L(8); PG8_BAR; PG8_WAIT_L(0); PG8_MMA(0, 0, At, B0); PG8_BAR; PG8_SCHED;
            PG8_LDB(B1, 1, 1); PG8_STAGE(PG8_SB(1, 0), b3, voffB);
            PG8_BAR; PG8_WAIT_L(0); PG8_MMA(0, 1, At, B1); PG8_BAR;
            PG8_LDA(At, 1, 1); PG8_STAGE(PG8_SA(1, 0), a3, voffA);
            PG8_BAR; PG8_WAIT_L(0); PG8_MMA(1, 0, At, B0); PG8_BAR; PG8_SCHED;
            PG8_STAGE(PG8_SB(1, 1), b3 + hstep, voffB);
            PG8_WAIT_V(6); PG8_BAR; PG8_MMA(1, 1, At, B1); PG8_BAR;
            }
        }
        if constexpr (ALIGN_EPI) { if (wr == 0) PG8_BAR; }
        if constexpr (!Epi::AFTER_DRAIN) { E(acc, cur, wr, wc, fr, fq); S.done(cur); }
        if (!has_next) break;
#pragma unroll
        for (int a = 0; a < 2; ++a)
#pragma unroll
            for (int b = 0; b < 2; ++b)
#pragma unroll
                for (int m = 0; m < 4; ++m)
#pragma unroll
                    for (int n = 0; n < 2; ++n) acc[a][b][m][n] = (f32x4){0.f, 0.f, 0.f, 0.f};
        cur = nxt; cA = nA; cB = nB; ++ui;
        if constexpr (ALIGN_EPI) { if (wr == 1) PG8_BAR; }
    }
    PG8_WAIT_V(0);
    if constexpr (!ALIGN_EPI) { if (wr == 0) PG8_BAR; }
    PG8_BAR;
    if constexpr (Epi::AFTER_DRAIN) { E.fused(acc, cur, wr, wc, fr, fq, lds, wid, lane); S.done(cur); }
#undef PG8_SA
#undef PG8_SB
#undef PG8_STAGE
#undef PG8_LDA
#undef PG8_LDB
#undef PG8_MMA
#undef PG8_WAIT_V
#undef PG8_WAIT_L
#undef PG8_BAR
#undef PG8_SCHED
}
}

#ifndef HY_WGM_IN
#define HY_WGM_IN 2
#endif
#ifndef HY_WGM_UP
#define HY_WGM_UP 2
#endif
namespace hy {
#define GAS __attribute__((address_space(1)))
#define LAS __attribute__((address_space(3)))
typedef unsigned short bf16;
typedef unsigned v4u __attribute__((ext_vector_type(4)));
typedef float f32x4 __attribute__((ext_vector_type(4)));
typedef short bf16x8 __attribute__((ext_vector_type(8)));
typedef GAS unsigned gu32;
typedef GAS unsigned long long gu64;
#define RLX_AGENT __ATOMIC_RELAXED, __HIP_MEMORY_SCOPE_AGENT
#define LDS_WAIT() asm volatile("s_waitcnt lgkmcnt(0)" ::: "memory")
#define VM_WAIT() asm volatile("s_waitcnt vmcnt(0)" ::: "memory")
__device__ __forceinline__ unsigned long long rt() { return __builtin_amdgcn_s_memrealtime(); }
typedef __bf16 hwbf2 __attribute__((ext_vector_type(2))); typedef float hwf2 __attribute__((ext_vector_type(2)));
__device__ __forceinline__ unsigned f2bf(float f) { return (unsigned)__builtin_bit_cast(unsigned short, (__bf16)f); }
__device__ __forceinline__ unsigned pk2(float lo, float hi) { const hwf2 v = {lo, hi}; return __builtin_bit_cast(unsigned, __builtin_convertvector(v, hwbf2)); }
#define XB_TMO      128
#define XB_XCNT(j)  (256  + 64 * (j))
#define XB_XSUB(j)  (1280 + 64 * (j))
#define XB_XGEN(j)  (2304 + 64 * (j))
#define XB_TOP      3328
#define XB_TOPGEN   3392
#define XCD_BAR_WORDS 3456
#define XB_SPIN_CAP (1u << 18)

__device__ __forceinline__ unsigned xb_ld(unsigned* p)              { return __hip_atomic_load(p, __ATOMIC_RELAXED, __HIP_MEMORY_SCOPE_AGENT); }
__device__ __forceinline__ unsigned xb_add(unsigned* p, unsigned v) { return __hip_atomic_fetch_add(p, v, __ATOMIC_RELAXED, __HIP_MEMORY_SCOPE_AGENT); }
__device__ __forceinline__ unsigned xb_xcc_id() { return (unsigned)__builtin_amdgcn_s_getreg((3 << 11) | 20) & 0xFu; }
#define XB_SPIN(cond, bar) do { unsigned _sp = 0; while (cond) { __builtin_amdgcn_s_sleep(1); \
    if ((++_sp & 255u) == 0u) { if (xb_ld(&(bar)[XB_TMO])) break; if (_sp > XB_SPIN_CAP) { atomicAdd(&(bar)[XB_TMO], 1u); break; } } } } while (0)

struct XcdBarrier {
    unsigned* bar; unsigned x;
    volatile LAS unsigned* st;
};

__device__ __forceinline__ XcdBarrier xcd_barrier_post(unsigned* bar, volatile LAS unsigned* st) {
    XcdBarrier b; b.bar = bar; b.x = xb_xcc_id(); b.st = st;
    if (threadIdx.x == 0) (void)xb_add(&bar[XB_XCNT(b.x)], 1u);
    return b;
}
__device__ __forceinline__ void xcd_barrier_complete(unsigned* bar, unsigned x, unsigned& nloc, unsigned& nx) {
    const unsigned G = gridDim.x * gridDim.y * gridDim.z;
    unsigned sum, cnt, mine, sp = 0u;
    for (;;) {
        sum = 0u; cnt = 0u; mine = 0u;
#pragma unroll
        for (unsigned j = 0; j < 16; ++j) { const unsigned c = xb_ld(&bar[XB_XCNT(j)]); sum += c; cnt += (c > 0u) ? 1u : 0u; mine = (j == x) ? c : mine; }
        if (sum == G) break;
        __builtin_amdgcn_s_sleep(1);
        if ((++sp & 255u) == 0u) { if (xb_ld(&bar[XB_TMO])) break; if (sp > XB_SPIN_CAP) { atomicAdd(&bar[XB_TMO], 1u); break; } }
    }
    nloc = mine > 0u ? mine : 1u; nx = cnt > 0u ? cnt : 1u;
}

__device__ __forceinline__ void xcd_barrier(const XcdBarrier& b, bool leader  ) {
    asm volatile("s_waitcnt vmcnt(0)" ::: "memory");
    __syncthreads();
    if (leader) {
        unsigned* bar = b.bar;
        __builtin_amdgcn_s_waitcnt(0);
        unsigned nloc = b.st[0], nx = b.st[1];
        if (nloc == 0u) { xcd_barrier_complete(bar, b.x, nloc, nx); b.st[0] = nloc; b.st[1] = nx; }
        const unsigned old = xb_add(&bar[XB_XSUB(b.x)], 1u);
        const unsigned gen = old / nloc;
        if (old + 1u == (gen + 1u) * nloc) {
            __builtin_amdgcn_fence(__ATOMIC_RELEASE, "agent");
            asm volatile("s_waitcnt vmcnt(0)" ::: "memory");
            const unsigned og = xb_add(&bar[XB_TOP], 1u);
            const unsigned tg = og / nx;
            if (og + 1u == (tg + 1u) * nx) xb_add(&bar[XB_TOPGEN], 1u);
            else XB_SPIN(xb_ld(&bar[XB_TOPGEN]) == tg, bar);
            __builtin_amdgcn_fence(__ATOMIC_ACQUIRE, "agent");
            xb_add(&bar[XB_XGEN(b.x)], 1u);
            asm volatile("s_waitcnt vmcnt(0)" ::: "memory");
        } else {
            XB_SPIN(xb_ld(&bar[XB_XGEN(b.x)]) == gen, bar);
            __builtin_amdgcn_fence(__ATOMIC_ACQUIRE, "agent");
            asm volatile("s_waitcnt vmcnt(0)" ::: "memory");
        }
    }
    __syncthreads();
}

constexpr int B_ = 4, T_ = 8192, D_ = 1024, M_ = B_ * T_, L_ = 2;
constexpr int NIN = 3584, NPG = 1792, NPR = 1792;
constexpr int DFF = 2816, NUP = 5632, IN_COLS = 3344;
constexpr size_t MiB = 1u << 20;
constexpr size_t WS_CTL = 0, CTL_ZERO_BYTES = 65536;
constexpr int CW_BAR = 4096;
constexpr size_t WS_RK = MiB / 4;
constexpr size_t WS_MOD = 3 * MiB / 2;
constexpr size_t WS_WIN = 2 * MiB, WS_WOUT = 9 * MiB, WS_WUP = 11 * MiB, WS_WDN = 22 * MiB, WS_LORA = 55 * MiB / 2, WS_GAMC = 28 * MiB, WS_VL = 29 * MiB;
constexpr size_t WS_GAM = 31 * MiB;
constexpr size_t WS_XB = 32 * MiB, WS_O = 336 * MiB  , WS_VF = 160 * MiB, WS_GK = 192 * MiB, WS_PG = 224 * MiB, WS_PR = 336 * MiB, WS_END = 512 * MiB;
constexpr size_t WS_RH = WS_XB, WS_YH = WS_XB + 32 * MiB, WS_PP = 96 * MiB, WS_QQ = 128 * MiB, WS_GG = 448 * MiB, WS_S0 = 480 * MiB;
constexpr size_t WS_ACT = 224 * MiB, WS_U = 400 * MiB;
constexpr int RING_BYTES = 131072, MISC_OFF = 161792, LDS_BYTES = 163840;
constexpr int NT = 512;

__device__ __forceinline__ float bf2f(bf16 h) { return __builtin_bit_cast(float, (unsigned)h << 16); }
__device__ __forceinline__ float sigmoidf_(float x) { return __builtin_amdgcn_rcpf(1.f + __expf(-x)); }
__device__ __forceinline__ float siluf_(float x) { return x * __builtin_amdgcn_rcpf(1.f + __expf(-x)); }
__device__ __forceinline__ float softplusf_(float x) { return fmaxf(x, 0.f) + log1pf(__expf(-fabsf(x))); }

typedef unsigned u32x2 __attribute__((ext_vector_type(2)));
template <int CTRL> __device__ __forceinline__ float dpp_f(float v) {
    return __builtin_bit_cast(float, __builtin_amdgcn_update_dpp(0, __builtin_bit_cast(int, v), CTRL, 0xf, 0xf, false));
}
__device__ __forceinline__ float wave_sum(float v) {
    v += dpp_f<0xB1>(v);
    v += dpp_f<0x4E>(v);
    v += dpp_f<0x141>(v);
    v += dpp_f<0x140>(v);
    v += __builtin_bit_cast(float, __builtin_amdgcn_update_dpp(0, __builtin_bit_cast(int, v), 0x142, 0xa, 0xf, false));
    v += __builtin_bit_cast(float, __builtin_amdgcn_update_dpp(0, __builtin_bit_cast(int, v), 0x143, 0xc, 0xf, false));
    return __builtin_bit_cast(float, __builtin_amdgcn_readlane(__builtin_bit_cast(int, v), 63));
}

__device__ __forceinline__ int lane_now() { int l; asm volatile("v_mbcnt_lo_u32_b32 %0, -1, 0\n\tv_mbcnt_hi_u32_b32 %0, -1, %0" : "=v"(l)); return l; }
__device__ __forceinline__ float xsum4(float v) {
    const int l = lane_now();
    v += __builtin_bit_cast(float, __builtin_amdgcn_ds_bpermute((l ^ 16) << 2, __builtin_bit_cast(int, v)));
    v += __builtin_bit_cast(float, __builtin_amdgcn_ds_bpermute((l ^ 32) << 2, __builtin_bit_cast(int, v)));
    return v;
}
struct Ctx { int bid, nb, tid, lane, wave; LAS unsigned char* lds; };
__device__ __forceinline__ void group_barrier(unsigned* cnt, unsigned target, bool leader) {
    asm volatile("s_waitcnt vmcnt(0)" ::: "memory");
    __syncthreads();
    if (leader) {
        __builtin_amdgcn_fence(__ATOMIC_RELEASE, "agent");
        asm volatile("s_waitcnt vmcnt(0)" ::: "memory");
        (void)__hip_atomic_fetch_add(cnt, 1u, __ATOMIC_RELAXED, __HIP_MEMORY_SCOPE_AGENT);
        for (unsigned sp = 0; __hip_atomic_load(cnt, __ATOMIC_RELAXED, __HIP_MEMORY_SCOPE_AGENT) < target && sp < (1u << 22); ++sp) __builtin_amdgcn_s_sleep(2);
        __builtin_amdgcn_fence(__ATOMIC_ACQUIRE, "agent");
        asm volatile("s_waitcnt vmcnt(0)" ::: "memory");
    }
    __syncthreads();
}


__device__ __forceinline__ void ph_mod(const Ctx& C, const float* c, const float* ada_w, const float* ada_b, float* MOD) {
    LAS float* sc = (LAS float*)C.lds;
    LAS float* red = (LAS float*)(C.lds + 16384);
    for (int i = C.tid; i < 4096; i += NT) sc[i] = siluf_(c[i]);
    __syncthreads();
    for (int item = C.bid; item < 192; item += C.nb) {
        const int l = item / 96, j0 = (item % 96) * 64;
        const float* W = ada_w + (size_t)l * 1024 * 6144 + j0 + C.lane;
        float a0 = 0.f, a1 = 0.f, a2 = 0.f, a3 = 0.f;
        for (int k = C.wave * 128; k < C.wave * 128 + 128; ++k) { const float wv = W[(size_t)k * 6144]; a0 += sc[k] * wv; a1 += sc[1024 + k] * wv; a2 += sc[2048 + k] * wv; a3 += sc[3072 + k] * wv; }
        red[(C.wave * 4 + 0) * 64 + C.lane] = a0; red[(C.wave * 4 + 1) * 64 + C.lane] = a1; red[(C.wave * 4 + 2) * 64 + C.lane] = a2; red[(C.wave * 4 + 3) * 64 + C.lane] = a3;
        __syncthreads();
        if (C.wave < 4) { const int b = C.wave; float s = ada_b[l * 6144 + j0 + C.lane];
#pragma unroll
            for (int w = 0; w < 8; ++w) s += red[(w * 4 + b) * 64 + C.lane];
            MOD[((size_t)l * 4 + b) * 6144 + j0 + C.lane] = s; }
        __syncthreads();
    }
}

__device__ __forceinline__ void wprep_mat(const Ctx& C, const float* W, int K, int Nsrc, int Ndst, bf16* Wt, int mode, const float* vres) {
    const int half = C.tid >> 8, t = C.tid & 255, tx = t & 31, ty = t >> 5;
    LAS float* tile = (LAS float*)C.lds + half * (32 * 33);
    const int nbn = Ndst / 32, ntile = nbn * (K / 32);
    const int niter = (ntile + 2 * C.nb - 1) / (2 * C.nb);
    for (int it = 0; it < niter; ++it) {
        const int item = (it * C.nb + C.bid) * 2 + half;
        const bool act = item < ntile;
        const int n0 = (item % nbn) * 32, k0 = (item / nbn) * 32, n = n0 + tx;
        if (act) {
#pragma unroll
            for (int i = 0; i < 4; ++i) { const int k = k0 + ty + 8 * i; float v = 0.f;
                if (mode == 0) v = W[(size_t)k * Nsrc + n];
                else if (mode == 2) { const int tl = n >> 8, w = n & 255; v = W[(size_t)k * Nsrc + (w < 128 ? tl * 128 + w : 2816 + tl * 128 + (w - 128))]; }
                else { if (n < 1552) v = W[(size_t)k * Nsrc + n]; else if (n < 1584) v = vres ? vres[(size_t)k * 32 + (n - 1552)] : 0.f; else if (n < 1792) v = 0.f; else v = W[(size_t)k * Nsrc + (n - 240)]; }
                tile[(ty + 8 * i) * 33 + tx] = v; }
        }
        __syncthreads();
        if (act) {
#pragma unroll
            for (int i = 0; i < 4; ++i) { const int nn = n0 + ty + 8 * i; Wt[(size_t)nn * K + k0 + tx] = (bf16)f2bf(tile[tx * 33 + ty + 8 * i]); }
        }
        __syncthreads();
    }
}

__device__ __forceinline__ void ph_norm(const Ctx& C, const float* x, const float* g, const float* sh, const float* sc, bf16* XB) {
    const int gw = C.bid * 8 + C.wave, NGW = C.nb * 8, lane = C.lane;
    for (int m = gw; m < M_; m += NGW) {
        const int b = m / T_;
        const f32x4* xr = (const f32x4*)(x + (size_t)m * D_) + lane;
        f32x4 v[4]; float s = 0.f;
#pragma unroll
        for (int j = 0; j < 4; ++j) { v[j] = xr[64 * j]; s += (v[j].x * v[j].x + v[j].y * v[j].y) + (v[j].z * v[j].z + v[j].w * v[j].w); }
        const float rstd = 1.f / sqrtf(wave_sum(s) * (1.f / D_) + 1e-6f);
        unsigned long long* o8 = (unsigned long long*)(XB + (size_t)m * D_) + lane;
#pragma unroll
        for (int j = 0; j < 4; ++j) { const int col = 4 * lane + 256 * j;
            const f32x4 gv = *(const f32x4*)(g + col), shv = *(const f32x4*)(sh + b * 6144 + col), scv = *(const f32x4*)(sc + b * 6144 + col);
            const f32x4 h = v[j] * rstd * gv * (scv + 1.f) + shv;
            o8[64 * j] = (unsigned long long)pk2(h.x, h.y) | ((unsigned long long)pk2(h.z, h.w) << 32); }
    }
}
__device__ __forceinline__ void ph_final(const Ctx& C, float* x, const float* g) {
    const int gw = C.bid * 8 + C.wave, NGW = C.nb * 8, lane = C.lane;
    for (int m = gw; m < M_; m += NGW) {
        f32x4* xr = (f32x4*)(x + (size_t)m * D_) + lane;
        f32x4 v[4]; float s = 0.f;
#pragma unroll
        for (int j = 0; j < 4; ++j) { v[j] = xr[64 * j]; s += (v[j].x * v[j].x + v[j].y * v[j].y) + (v[j].z * v[j].z + v[j].w * v[j].w); }
        const float rstd = 1.f / sqrtf(wave_sum(s) * (1.f / D_) + 1e-6f);
#pragma unroll
        for (int j = 0; j < 4; ++j) { const f32x4 gv = *(const f32x4*)(g + 4 * lane + 256 * j); xr[64 * j] = v[j] * rstd * gv; }
    }
}


typedef short s16x8 __attribute__((ext_vector_type(8)));
__device__ __forceinline__ f32x4 mm16(const LAS bf16* A, int lda, const LAS bf16* B, int ldb, int K, f32x4 acc, int lane) {
    const int r = lane & 15, g = lane >> 4;
    const LAS bf16* ap = A + r * lda + 8 * g; const LAS bf16* bp = B + r * ldb + 8 * g;
    for (int k0 = 0; k0 < K; k0 += 32) { const s16x8 a = *(const LAS s16x8*)(ap + k0); const s16x8 b = *(const LAS s16x8*)(bp + k0); acc = __builtin_amdgcn_mfma_f32_16x16x32_bf16(a, b, acc, 0, 0, 0); }
    return acc;
}
__device__ __forceinline__ f32x4 mm16_ga(const bf16* A, int lda, const LAS bf16* B, int ldb, int K, f32x4 acc, int lane) {
    const int r = lane & 15, g = lane >> 4;
    const bf16* ap = A + r * lda + 8 * g; const LAS bf16* bp = B + r * ldb + 8 * g;
    for (int k0 = 0; k0 < K; k0 += 32) { const s16x8 a = *(const s16x8*)(ap + k0); const s16x8 b = *(const LAS s16x8*)(bp + k0); acc = __builtin_amdgcn_mfma_f32_16x16x32_bf16(a, b, acc, 0, 0, 0); }
    return acc;
}
__device__ __forceinline__ unsigned long long pack4(f32x4 v) { return (unsigned long long)pk2(v.x, v.y) | ((unsigned long long)pk2(v.z, v.w) << 32); }
__device__ __forceinline__ float logsigmoidf_(float x) { return fminf(x, 0.f) - __logf(1.f + __expf(-fabsf(x))); }

constexpr int GL_LD = 72;
constexpr int GL_GK = 0;
constexpr int GL_SEG = 16384;
constexpr int GL_Z = 18432;
constexpr int GL_GUP = 20480;
constexpr int GL_I0 = 24832;
constexpr int GL_I1 = GL_I0 + 9216;
constexpr int GL_I2 = GL_I1 + 9216;
constexpr int GL_VT = GL_I2 + 9216;
constexpr int GL_SSQ = GL_VT + 18432;
static_assert(GL_SSQ + 512 <= RING_BYTES, "GLA LDS map");

struct GlaRaw { v4u z, k, q, v0, v1; float g0, g1, gb; };
__device__ __forceinline__ void gla_fetch(GlaRaw& R, const Ctx& C, const bf16* pg, const float* gk_up, const float* gk_b, int h, bool want_q) {
    const int tid = C.tid, j = tid >> 3, d0 = (tid & 7) * 8, e0 = (tid & 7) * 16;
    R.z = (v4u){0u, 0u, 0u, 0u}; R.q = R.z;
    if (tid < 128) R.z = *(const v4u*)(pg + (size_t)(tid >> 1) * NPG + 1536 + (tid & 1) * 8);
    R.g0 = gk_up[(tid >> 6) * 256 + h * 64 + (tid & 63)]; R.g1 = gk_up[((tid + NT) >> 6) * 256 + h * 64 + (tid & 63)]; R.gb = gk_b[h * 64 + (tid & 63)];
    R.k = *(const v4u*)(pg + (size_t)j * NPG + 256 + h * 64 + d0);
    if (want_q) R.q = *(const v4u*)(pg + (size_t)j * NPG + h * 64 + d0);
    R.v0 = *(const v4u*)(pg + (size_t)j * NPG + 512 + h * 128 + e0); R.v1 = *(const v4u*)(pg + (size_t)j * NPG + 512 + h * 128 + e0 + 8);
}
__device__ __forceinline__ void gla_gates(const Ctx& C, const GlaRaw& R) {
    LAS float* GK = (LAS float*)(C.lds + GL_GK); LAS float* SEG = (LAS float*)(C.lds + GL_SEG); LAS bf16* Z = (LAS bf16*)(C.lds + GL_Z); LAS float* GUP = (LAS float*)(C.lds + GL_GUP);
    const int tid = C.tid;
    if (tid < 128) { const int t = tid >> 1, hh = tid & 1; *(LAS v4u*)(Z + t * 16 + hh * 8) = R.z; }
    GUP[tid] = R.g0; GUP[tid + NT] = R.g1;
    if (tid < 64) GUP[1024 + tid] = R.gb;
    __syncthreads();
    { const int t = tid >> 3, d0 = (tid & 7) * 8; float a[8];
#pragma unroll
      for (int q = 0; q < 8; ++q) a[q] = GUP[1024 + d0 + q];
#pragma unroll
      for (int i = 0; i < 16; ++i) { const float zv = bf2f(Z[t * 16 + i]);
#pragma unroll
          for (int q = 0; q < 8; ++q) a[q] += zv * GUP[i * 64 + d0 + q]; }
#pragma unroll
      for (int q = 0; q < 8; ++q) GK[t * 64 + d0 + q] = logsigmoidf_(a[q]) * (1.f / 16.f); }
    __syncthreads();
    { const int d = tid & 63, seg = tid >> 6; float run = 0.f;
#pragma unroll
      for (int q = 0; q < 8; ++q) { run += GK[(seg * 8 + q) * 64 + d]; GK[(seg * 8 + q) * 64 + d] = run; }
      SEG[seg * 64 + d] = run; }
    __syncthreads();
    { const int d = tid & 63, seg = tid >> 6; float off = 0.f;
      for (int s = 0; s < seg; ++s) off += SEG[s * 64 + d];
#pragma unroll
      for (int q = 0; q < 8; ++q) GK[(seg * 8 + q) * 64 + d] += off; }
    __syncthreads();
}
__device__ __forceinline__ void gla_stage_vt(const Ctx& C, const GlaRaw& R) {
    LAS bf16* VT = (LAS bf16*)(C.lds + GL_VT);
    const int j = C.tid >> 3, e0 = (C.tid & 7) * 16;
    const unsigned w[8] = {R.v0.x, R.v0.y, R.v0.z, R.v0.w, R.v1.x, R.v1.y, R.v1.z, R.v1.w};
#pragma unroll
    for (int q = 0; q < 8; ++q) { VT[(e0 + 2 * q) * GL_LD + j] = (bf16)(w[q] & 0xffffu); VT[(e0 + 2 * q + 1) * GL_LD + j] = (bf16)(w[q] >> 16); }
}

__device__ __forceinline__ void ph_gla_a(const Ctx& C, const bf16* PG, const float* gk_up, const float* gk_b, bf16* DS, float* GAM) {
    LAS float* GK = (LAS float*)(C.lds + GL_GK); LAS bf16* KT = (LAS bf16*)(C.lds + GL_I0); LAS bf16* VT = (LAS bf16*)(C.lds + GL_VT);
    for (int item = C.bid; item < 2048; item += C.nb) {
        const int bh = item >> 7, c = item & 127, b = bh >> 2, h = bh & 3;
        const size_t m0 = (size_t)b * T_ + c * 64;
        const bf16* pg = PG + m0 * NPG;
        GlaRaw R; gla_fetch(R, C, pg, gk_up, gk_b, h, false);
        gla_gates(C, R);
        { const int j = C.tid >> 3, d0 = (C.tid & 7) * 8;
          const unsigned w[4] = {R.k.x, R.k.y, R.k.z, R.k.w};
#pragma unroll
          for (int q = 0; q < 4; ++q) { const float k0 = bf2f((bf16)(w[q] & 0xffffu)), k1 = bf2f((bf16)(w[q] >> 16));
              const int d = d0 + 2 * q;
              KT[d * GL_LD + j] = (bf16)f2bf(k0 * __expf(GK[63 * 64 + d] - GK[j * 64 + d]));
              KT[(d + 1) * GL_LD + j] = (bf16)f2bf(k1 * __expf(GK[63 * 64 + d + 1] - GK[j * 64 + d + 1])); } }
        gla_stage_vt(C, R);
        if (C.tid < 64) GAM[(size_t)item * 64 + C.tid] = __expf(GK[63 * 64 + C.tid]);
        __syncthreads();
        { const int n0 = C.wave * 16, lane = C.lane, cc = lane & 15, g = lane >> 4;
          bf16* out = DS + (size_t)item * 8192 + (size_t)(n0 + cc) * 64 + 4 * g;
#pragma unroll
          for (int mt = 0; mt < 4; ++mt) { f32x4 acc = {0.f, 0.f, 0.f, 0.f}; acc = mm16(KT + mt * 16 * GL_LD, GL_LD, VT + n0 * GL_LD, GL_LD, 64, acc, lane);
              *(unsigned long long*)(out + mt * 16) = pack4(acc); } }
        __syncthreads();
    }
}
__device__ __forceinline__ void ph_gla_b(const Ctx& C, bf16* DS, const float* GAM) {
    for (int idx = C.bid * NT + C.tid; idx < 16 * 8192; idx += C.nb * NT) {
        const int bh = idx >> 13, ed = idx & 8191, d = ed & 63;
        bf16* p = DS + (size_t)bh * 128 * 8192 + ed; const float* gp = GAM + (size_t)bh * 128 * 64 + d;
        float S = 0.f;
        for (int c0 = 0; c0 < 128; c0 += 8) {
            float ds[8], gm[8];
#pragma unroll
            for (int i = 0; i < 8; ++i) { ds[i] = bf2f(p[(size_t)(c0 + i) * 8192]); gm[i] = gp[(c0 + i) * 64]; }
#pragma unroll
            for (int i = 0; i < 8; ++i) { const float gs = gm[i] * S; p[(size_t)(c0 + i) * 8192] = (bf16)f2bf(gs); S = gs + ds[i]; }
        }
    }
}
__device__ __forceinline__ void ph_gla_c(const Ctx& C, const bf16* PG, const float* gk_up, const float* gk_b, const float* norm_g, const bf16* DS, bf16* O) {
    LAS float* GK = (LAS float*)(C.lds + GL_GK); LAS bf16* QP = (LAS bf16*)(C.lds + GL_I0); LAS bf16* KM = (LAS bf16*)(C.lds + GL_I1); LAS bf16* AI = (LAS bf16*)(C.lds + GL_I2);
    LAS bf16* VT = (LAS bf16*)(C.lds + GL_VT); LAS float* SSQ = (LAS float*)(C.lds + GL_SSQ);
    for (int item = C.bid; item < 2048; item += C.nb) {
        const int bh = item >> 7, c = item & 127, b = bh >> 2, h = bh & 3;
        const size_t m0 = (size_t)b * T_ + c * 64;
        const bf16* pg = PG + m0 * NPG;
        GlaRaw R; gla_fetch(R, C, pg, gk_up, gk_b, h, true);
        s16x8 sfrag[4][2];
        { const int lane = C.lane, cc = lane & 15, g = lane >> 4, eh = C.wave >> 2; const bf16* Sg = DS + (size_t)item * 8192;
#pragma unroll
          for (int mt = 0; mt < 4; ++mt) { sfrag[mt][0] = *(const s16x8*)(Sg + (size_t)(eh * 64 + mt * 16 + cc) * 64 + 8 * g); sfrag[mt][1] = *(const s16x8*)(Sg + (size_t)(eh * 64 + mt * 16 + cc) * 64 + 32 + 8 * g); } }
        gla_gates(C, R);
        { const int j = C.tid >> 3, d0 = (C.tid & 7) * 8;
          const v4u qx = R.q, kx = R.k;
          const unsigned qw[4] = {qx.x, qx.y, qx.z, qx.w}, kw[4] = {kx.x, kx.y, kx.z, kx.w};
          unsigned qo[4], ko[4];
#pragma unroll
          for (int q = 0; q < 4; ++q) { const int d = d0 + 2 * q;
              const float e0 = GK[63 * 64 + d] - GK[j * 64 + d], e1 = GK[63 * 64 + d + 1] - GK[j * 64 + d + 1];
              const float q0 = 0.125f * bf2f((bf16)(qw[q] & 0xffffu)) * __expf(-e0), q1 = 0.125f * bf2f((bf16)(qw[q] >> 16)) * __expf(-e1);
              const float k0 = bf2f((bf16)(kw[q] & 0xffffu)) * __expf(e0), k1 = bf2f((bf16)(kw[q] >> 16)) * __expf(e1);
              qo[q] = pk2(q0, q1); ko[q] = pk2(k0, k1); }
          *(LAS v4u*)(QP + j * GL_LD + d0) = (v4u){qo[0], qo[1], qo[2], qo[3]}; *(LAS v4u*)(KM + j * GL_LD + d0) = (v4u){ko[0], ko[1], ko[2], ko[3]}; }
        gla_stage_vt(C, R);
        __syncthreads();
        { const int lane = C.lane, cc = lane & 15, g = lane >> 4, n0 = (C.wave >> 1) * 16;
#pragma unroll
          for (int q = 0; q < 2; ++q) { const int mt0 = ((C.wave & 1) * 2 + q) * 16; f32x4 acc = {0.f, 0.f, 0.f, 0.f};
              acc = mm16(KM + mt0 * GL_LD, GL_LD, QP + n0 * GL_LD, GL_LD, 64, acc, lane);
              const int i = n0 + cc, j = mt0 + 4 * g;
              acc.x = (j + 0 <= i) ? acc.x : 0.f; acc.y = (j + 1 <= i) ? acc.y : 0.f; acc.z = (j + 2 <= i) ? acc.z : 0.f; acc.w = (j + 3 <= i) ? acc.w : 0.f;
              *(LAS unsigned long long*)(AI + (n0 + cc) * GL_LD + mt0 + 4 * g) = pack4(acc); } }
        __syncthreads();
        { const int lane = C.lane, cc = lane & 15, g = lane >> 4, n0 = (C.wave & 3) * 16, eh = C.wave >> 2;
          f32x4 acc[4]; float ss = 0.f;
#pragma unroll
          for (int mt = 0; mt < 4; ++mt) { const int e0 = eh * 64 + mt * 16; acc[mt] = (f32x4){0.f, 0.f, 0.f, 0.f};
              { const LAS bf16* bp = QP + (n0 + cc) * GL_LD + 8 * g;
                acc[mt] = __builtin_amdgcn_mfma_f32_16x16x32_bf16(sfrag[mt][0], *(const LAS s16x8*)bp, acc[mt], 0, 0, 0); acc[mt] = __builtin_amdgcn_mfma_f32_16x16x32_bf16(sfrag[mt][1], *(const LAS s16x8*)(bp + 32), acc[mt], 0, 0, 0); }
              acc[mt] = mm16(VT + e0 * GL_LD, GL_LD, AI + n0 * GL_LD, GL_LD, 64, acc[mt], lane);
              ss += (acc[mt].x * acc[mt].x + acc[mt].y * acc[mt].y) + (acc[mt].z * acc[mt].z + acc[mt].w * acc[mt].w); }
          ss = xsum4(ss);
          if (g == 0) SSQ[eh * 64 + n0 + cc] = ss;
          __syncthreads();
          const float rstd = __builtin_amdgcn_rsqf((SSQ[n0 + cc] + SSQ[64 + n0 + cc]) * (1.f / 128.f) + 1e-6f);
          const size_t m = m0 + n0 + cc;
#pragma unroll
          for (int mt = 0; mt < 4; ++mt) { const int e = eh * 64 + mt * 16 + 4 * g;
              const unsigned long long gx = *(const unsigned long long*)(pg + (size_t)(n0 + cc) * NPG + 1024 + h * 128 + e);
              const f32x4 ng = *(const f32x4*)(norm_g + e);
              f32x4 o;
              o.x = acc[mt].x * rstd * ng.x * siluf_(bf2f((bf16)(gx & 0xffffu)));
              o.y = acc[mt].y * rstd * ng.y * siluf_(bf2f((bf16)((gx >> 16) & 0xffffu)));
              o.z = acc[mt].z * rstd * ng.z * siluf_(bf2f((bf16)((gx >> 32) & 0xffffu)));
              o.w = acc[mt].w * rstd * ng.w * siluf_(bf2f((bf16)(gx >> 48)));
              *(unsigned long long*)(O + m * D_ + h * 128 + e) = pack4(o); } }
        __syncthreads();
    }
}


struct RwkvW { const float *mu, *mu_vres, *w0, *a0, *v0, *k_k, *k_a, *r_k; const bf16 *wupT, *aupT, *gupT, *vupT; };
constexpr int RW_LD = 72, RW_XLD = 296;
constexpr int RW_R0 = 0;
constexpr int RW_SEG = 16384;
constexpr int RW_R1 = 36864;
constexpr int RW_R2 = RW_R1 + 27648;
constexpr int RW_R3 = RW_R2 + 9216;
constexpr int RW_R4 = RW_R3 + 27648;
constexpr int RW_TI = RW_R4 + 128 * RW_LD * 2;
constexpr int RW_MU = RW_TI + 2048;
constexpr int RW_X = RW_MU + 2048;
constexpr int RW_END = RW_X + 64 * RW_XLD * 2;
static_assert(RW_END <= MISC_OFF, "RWKV LDS map");

typedef short s16x4 __attribute__((ext_vector_type(4)));
__device__ __forceinline__ float tanh_fast(float x) { const float e = __expf(2.f * x); return 1.f - 2.f * __builtin_amdgcn_rcpf(e + 1.f); }
__device__ __forceinline__ float softplus_fast(float x) { return fmaxf(x, 0.f) + __logf(1.f + __expf(-fabsf(x))); }
__device__ __forceinline__ s16x4 cvt4(f32x4 v) { const unsigned long long p = pack4(v); return __builtin_bit_cast(s16x4, p); }
__device__ __forceinline__ void ld8f(const float* p, float (&o)[8]) { const f32x4 a = *(const f32x4*)p, b = *(const f32x4*)(p + 4); o[0] = a.x; o[1] = a.y; o[2] = a.z; o[3] = a.w; o[4] = b.x; o[5] = b.y; o[6] = b.z; o[7] = b.w; }
__device__ __forceinline__ float sum8(float v) { v += dpp_f<0xB1>(v); v += dpp_f<0x4E>(v); v += dpp_f<0x141>(v); return v; }
__device__ __forceinline__ void unpack8(const v4u x, float (&o)[8]) {
    o[0] = bf2f((bf16)(x.x & 0xffffu)); o[1] = bf2f((bf16)(x.x >> 16)); o[2] = bf2f((bf16)(x.y & 0xffffu)); o[3] = bf2f((bf16)(x.y >> 16));
    o[4] = bf2f((bf16)(x.z & 0xffffu)); o[5] = bf2f((bf16)(x.z >> 16)); o[6] = bf2f((bf16)(x.w & 0xffffu)); o[7] = bf2f((bf16)(x.w >> 16)); }
__device__ __forceinline__ v4u pack8(const float (&o)[8]) { return (v4u){pk2(o[0], o[1]), pk2(o[2], o[3]), pk2(o[4], o[5]), pk2(o[6], o[7])}; }
__device__ __forceinline__ f32x4 mm16_gb(const LAS bf16* A, int lda, const bf16* B, int ldb, int K, f32x4 acc, int lane) {
    const int r = lane & 15, g = lane >> 4;
    const LAS bf16* ap = A + r * lda + 8 * g; const bf16* bp = B + r * ldb + 8 * g;
    for (int k0 = 0; k0 < K; k0 += 32) { const s16x8 a = *(const LAS s16x8*)(ap + k0); const s16x8 b = *(const s16x8*)(bp + k0); acc = __builtin_amdgcn_mfma_f32_16x16x32_bf16(a, b, acc, 0, 0, 0); }
    return acc;
}

__device__ __forceinline__ void ph_norm_b(const Ctx& C, const bf16* x, const float* g, const float* sh, const float* sc, bf16* XB) {
    const int gw = C.bid * 8 + C.wave, NGW = C.nb * 8, lane = C.lane;
    for (int m = gw; m < M_; m += NGW) {
        const int b = m / T_;
        const v4u* xr = (const v4u*)(x + (size_t)m * D_) + lane;
        float v[2][8]; float s = 0.f;
#pragma unroll
        for (int j = 0; j < 2; ++j) { unpack8(xr[64 * j], v[j]);
#pragma unroll
            for (int i = 0; i < 8; ++i) s += v[j][i] * v[j][i]; }
        const float rstd = 1.f / sqrtf(wave_sum(s) * (1.f / D_) + 1e-6f);
        v4u* o = (v4u*)(XB + (size_t)m * D_) + lane;
#pragma unroll
        for (int j = 0; j < 2; ++j) { const int col = 8 * lane + 512 * j; float gv[8], shv[8], scv[8], h[8];
            ld8f(g + col, gv); ld8f(sh + b * 6144 + col, shv); ld8f(sc + b * 6144 + col, scv);
#pragma unroll
            for (int i = 0; i < 8; ++i) h[i] = v[j][i] * rstd * gv[i] * (scv[i] + 1.f) + shv[i];
            o[64 * j] = pack8(h); }
    }
}
__device__ __forceinline__ void ph_final_b(const Ctx& C, const bf16* x, const float* g, float* out, int m_lo, int m_hi, bf16* keep, int c_lo, int c_hi) {
    const int gw = C.bid * 8 + C.wave, NGW = C.nb * 8, lane = C.lane;
    for (int m = m_lo + gw; m < m_hi; m += NGW) {
        const v4u* xr = (const v4u*)(x + (size_t)m * D_) + lane;
        float v[2][8]; float s = 0.f;
#pragma unroll
        for (int j = 0; j < 2; ++j) { unpack8(xr[64 * j], v[j]);
#pragma unroll
            for (int i = 0; i < 8; ++i) s += v[j][i] * v[j][i]; }
        const float rstd = 1.f / sqrtf(wave_sum(s) * (1.f / D_) + 1e-6f);
#pragma unroll
        for (int j = 0; j < 2; ++j) { const int col = 8 * lane + 512 * j; float gv[8]; ld8f(g + col, gv);
            f32x4* o = (f32x4*)(out + (size_t)m * D_ + col);
            o[0] = (f32x4){v[j][0] * rstd * gv[0], v[j][1] * rstd * gv[1], v[j][2] * rstd * gv[2], v[j][3] * rstd * gv[3]};
            o[1] = (f32x4){v[j][4] * rstd * gv[4], v[j][5] * rstd * gv[5], v[j][6] * rstd * gv[6], v[j][7] * rstd * gv[7]}; }
    }
    for (int m = c_lo + gw; m < c_hi; m += NGW) { const v4u* xr = (const v4u*)(x + (size_t)m * D_) + lane; v4u* kr = (v4u*)(keep + (size_t)(m - c_lo) * D_) + lane; kr[0] = xr[0]; kr[64] = xr[64]; }
}
__device__ __forceinline__ int rofs(int row, int t) { return row * RW_LD + ((((t >> 3) + (row >> 3)) & 7) << 3) + (t & 7); }
__device__ __forceinline__ void ph_rwkv_a(const Ctx& C, const bf16* PR, const bf16* VL  , const RwkvW& W, int layer,
                                          bf16* PP, bf16* QQ, bf16* RH, bf16* YH, float* GAMC, float* RK, bf16* GG, bf16* VF, bool store_v = true) {
    LAS unsigned char* L = C.lds;
    LAS bf16* X = (LAS bf16*)(L + RW_X); LAS float* CUM = (LAS float*)(L + RW_R0); LAS float* SEG = (LAS float*)(L + RW_SEG);
    LAS bf16* NI = (LAS bf16*)(L + RW_R0), *AAK = NI + 64 * RW_LD, *ARB = AAK + 64 * RW_LD, *ARK = ARB + 64 * RW_LD;
    LAS bf16* PRE = (LAS bf16*)(L + RW_R1);
    LAS bf16* AT = (LAS bf16*)(L + RW_R1), *BT = AT + 64 * RW_LD, *KT = BT + 64 * RW_LD, *RT = (LAS bf16*)(L + RW_R2);
    LAS bf16* XB16 = (LAS bf16*)(L + RW_R1);
    LAS bf16* BHc = (LAS bf16*)(L + RW_R3), *KHc = BHc + 64 * RW_LD, *VTc = KHc + 64 * RW_LD;
    LAS bf16* XT = (LAS bf16*)(L + RW_R4); LAS bf16* TI = (LAS bf16*)(L + RW_TI);
    const int wave = C.wave;
    LAS float* MU = (LAS float*)(L + RW_MU);
    for (int i = C.tid; i < 288; i += NT) MU[i] = i < 256 ? W.mu[1536 + i] : (layer ? W.mu_vres[i - 256] : 0.f);
    __syncthreads();
    for (int bc = C.bid; bc < 512; bc += C.nb) {
        const int c = bc & 127, b = bc >> 7;
        const size_t m0 = (size_t)b * T_ + c * 64;
        { const int tid = C.tid;
          v4u xc[5], xp[5];
#pragma unroll
          for (int it = 0; it < 5; ++it) { const int idx = tid + it * NT; xc[it] = (v4u){0u, 0u, 0u, 0u}; xp[it] = xc[it];
            if (idx < 64 * 36) { const int t1 = idx / 36, q = idx % 36, col = q * 8; const size_t m1 = m0 + t1; const bool first1 = (c == 0 && t1 == 0);
                if (q < 32) { xc[it] = *(const v4u*)(PR + m1 * NPR + 1536 + col); if (!first1) xp[it] = *(const v4u*)(PR + (m1 - 1) * NPR + 1536 + col); }
                else if (layer) { xc[it] = *(const v4u*)(VL + m1 * NPG + 1552 + (col - 256)); if (!first1) xp[it] = *(const v4u*)(VL + (m1 - 1) * NPG + 1552 + (col - 256)); } } }
#pragma unroll
          for (int it = 0; it < 5; ++it) { const int idx = tid + it * NT;
            if (idx < 64 * 36) { const int t1 = idx / 36, q = idx % 36, col = q * 8;
                float cv[8], pv[8], mu[8]; unpack8(xc[it], cv); unpack8(xp[it], pv);
                { const f32x4 ma = *(const LAS f32x4*)(MU + col), mb = *(const LAS f32x4*)(MU + col + 4); mu[0] = ma.x; mu[1] = ma.y; mu[2] = ma.z; mu[3] = ma.w; mu[4] = mb.x; mu[5] = mb.y; mu[6] = mb.z; mu[7] = mb.w; }
#pragma unroll
                for (int i = 0; i < 8; ++i) { float p = cv[i] + (pv[i] - cv[i]) * mu[i]; if (q < 8) p = tanh_fast(p); else if (q >= 16 && q < 32) p = sigmoidf_(p); cv[i] = p; }
                *(LAS v4u*)(X + t1 * RW_XLD + col) = pack8(cv); } }
        }
        __syncthreads();
      v4u rcx, kcx, vcx, rpx, kpx, vpx, vfx;
#define RW_FETCH(hh) do { const int t_ = C.tid >> 3, ch_ = (hh) * 64 + (C.tid & 7) * 8; const size_t m_ = m0 + t_; const bool first_ = (c == 0 && t_ == 0); \
        rcx = *(const v4u*)(PR + m_ * NPR + ch_); kcx = *(const v4u*)(PR + m_ * NPR + 512 + ch_); vcx = *(const v4u*)(PR + m_ * NPR + 1024 + ch_); \
        rpx = (v4u){0u, 0u, 0u, 0u}; kpx = rpx; vpx = rpx; vfx = rpx; \
        if (!first_) { rpx = *(const v4u*)(PR + (m_ - 1) * NPR + ch_); kpx = *(const v4u*)(PR + (m_ - 1) * NPR + 512 + ch_); vpx = *(const v4u*)(PR + (m_ - 1) * NPR + 1024 + ch_); } \
        if (layer) vfx = *(const v4u*)(VF + m_ * 512 + ch_); } while (0)
      RW_FETCH(0);
#pragma unroll 1
      for (int h = 0; h < 8; ++h) {
        const int item = bc * 8 + h;
        int tid_ = C.tid; asm volatile("" : "+v"(tid_));
        const int tid = tid_, lane = tid & 63, cc = lane & 15, g = lane >> 4;
        const int t = tid >> 3, d0 = (tid & 7) * 8, ch = h * 64 + d0; const size_t m = m0 + t;
        {
            const int lsel = wave >> 1;
            const bf16* WT = lsel == 0 ? W.wupT : lsel == 1 ? W.aupT : lsel == 2 ? W.gupT : W.vupT;
            const int Kl = lsel == 2 ? 128 : lsel == 3 ? 32 : 64, xoff = lsel == 0 ? 0 : lsel == 1 ? 64 : lsel == 2 ? 128 : 256;
            LAS bf16* outp = PRE + lsel * 64 * RW_LD;
            const bool live = (lsel != 3 || layer);
#pragma unroll
            for (int mq = 0; mq < 2; ++mq) { const int mt = (wave & 1) * 2 + mq;
                s16x8 af[4];
                const bf16* ap = WT + (size_t)(h * 64 + mt * 16 + cc) * Kl + 8 * g;
#pragma unroll
                for (int ks = 0; ks < 4; ++ks) af[ks] = (live && ks * 32 < Kl) ? *(const s16x8*)(ap + ks * 32) : (s16x8){0, 0, 0, 0, 0, 0, 0, 0};
#pragma unroll
                for (int nt = 0; nt < 4; ++nt) { f32x4 acc = {0.f, 0.f, 0.f, 0.f};
                    const LAS bf16* bp = X + (nt * 16 + cc) * RW_XLD + xoff + 8 * g;
#pragma unroll
                    for (int ks = 0; ks < 4; ++ks) if (ks * 32 < Kl) { const s16x8 bb = *(const LAS s16x8*)(bp + ks * 32); acc = __builtin_amdgcn_mfma_f32_16x16x32_bf16(af[ks], bb, acc, 0, 0, 0); }
                    *(LAS unsigned long long*)(outp + (nt * 16 + cc) * RW_LD + mt * 16 + 4 * g) = pack4(acc); } }
        }
        __syncthreads();
        float av[8], bv[8], kv[8], rv[8], lw[8], vv[8];
        {
            float rc[8], rp[8], kc[8], kp[8], vc[8], vp[8], pw[8], pa[8], pg_[8], pvg[8];
            unpack8(rcx, rc); unpack8(kcx, kc); unpack8(vcx, vc); unpack8(rpx, rp); unpack8(kpx, kp); unpack8(vpx, vp);
            unpack8(*(const LAS v4u*)(PRE + (0 * 64 + t) * RW_LD + d0), pw); unpack8(*(const LAS v4u*)(PRE + (1 * 64 + t) * RW_LD + d0), pa);
            unpack8(*(const LAS v4u*)(PRE + (2 * 64 + t) * RW_LD + d0), pg_); unpack8(*(const LAS v4u*)(PRE + (3 * 64 + t) * RW_LD + d0), pvg);
            float vf[8]; unpack8(vfx, vf);
            float ssq = 0.f, rks = 0.f, asg[8], gg[8];
            float mur[8], muk[8], muv[8], w0c[8], a0c[8], v0c[8], kkc[8], kac[8], rkc[8];
            ld8f(W.mu + ch, mur); ld8f(W.mu + 512 + ch, muk); ld8f(W.mu + 1024 + ch, muv); ld8f(W.w0 + ch, w0c); ld8f(W.a0 + ch, a0c);
            ld8f(W.k_k + ch, kkc); ld8f(W.k_a + ch, kac); ld8f(W.r_k + ch, rkc);
            if (layer) ld8f(W.v0 + ch, v0c);
#pragma unroll
            for (int i = 0; i < 8; ++i) {
                const float r = rc[i] + (rp[i] - rc[i]) * mur[i], k = kc[i] + (kp[i] - kc[i]) * muk[i]; float v = vc[i] + (vp[i] - vc[i]) * muv[i];
                lw[i] = -0.6065306597f * sigmoidf_(w0c[i] + pw[i]);
                asg[i] = sigmoidf_(a0c[i] + pa[i]);
                if (layer) v = v + (vf[i] - v) * sigmoidf_(v0c[i] + pvg[i]);
                const float kk = k * kkc[i]; ssq += kk * kk;
                kv[i] = k * (1.f + (asg[i] - 1.f) * kac[i]); rv[i] = r; vv[i] = v; gg[i] = pg_[i]; av[i] = kk;
                rks += r * kv[i] * rkc[i];
            }
            ssq = sum8(ssq); rks = sum8(rks);
            const float inv = __builtin_amdgcn_rsqf(fmaxf(ssq, 1e-24f));
#pragma unroll
            for (int i = 0; i < 8; ++i) { const float kk = av[i] * inv; av[i] = -kk; bv[i] = kk * asg[i]; }
            if ((tid & 7) == 0) RK[m * 8 + h] = rks;
            *(v4u*)(GG + m * 512 + ch) = pack8(gg);
            if (store_v) *(v4u*)(VF + m * 512 + ch) = pack8(vv);
#pragma unroll
            for (int i = 0; i < 8; ++i) vv[i] = bf2f((bf16)f2bf(vv[i]));
        }
        __syncthreads();
#pragma unroll
        for (int i = 0; i < 8; ++i) CUM[t * 64 + d0 + i] = lw[i];
        __syncthreads();
        { const int d = tid & 63, seg = tid >> 6; float run = 0.f;
#pragma unroll
          for (int q = 0; q < 8; ++q) { run += CUM[(seg * 8 + q) * 64 + d]; CUM[(seg * 8 + q) * 64 + d] = run; }
          SEG[seg * 64 + d] = run; }
        __syncthreads();
        { const int d = tid & 63, seg = tid >> 6; float off = 0.f;
          for (int s = 0; s < seg; ++s) off += SEG[s * 64 + d];
#pragma unroll
          for (int q = 0; q < 8; ++q) CUM[(seg * 8 + q) * 64 + d] += off; }
        __syncthreads();
        {
            float at[8], bt[8], kt[8], rt[8];
#pragma unroll
            for (int i = 0; i < 8; ++i) { const float cu = CUM[t * 64 + d0 + i], cC = CUM[63 * 64 + d0 + i], en = __expf(-cu), ec = __expf(cC - cu);
                at[i] = av[i] * __expf(cu - lw[i]); bt[i] = bv[i] * en; kt[i] = kv[i] * en; rt[i] = rv[i] * __expf(cu);
                { const int ro = rofs(d0 + i, t); BHc[ro] = (bf16)f2bf(bv[i] * ec); KHc[ro] = (bf16)f2bf(kv[i] * ec); VTc[ro] = (bf16)f2bf(vv[i]); XT[ro] = (bf16)f2bf(at[i]); }
                if (t == 63) GAMC[(size_t)item * 64 + d0 + i] = __expf(cC); }
            *(LAS v4u*)(AT + t * RW_LD + d0) = pack8(at); *(LAS v4u*)(BT + t * RW_LD + d0) = pack8(bt); *(LAS v4u*)(KT + t * RW_LD + d0) = pack8(kt); *(LAS v4u*)(RT + t * RW_LD + d0) = pack8(rt);
        }
        if (h < 7) RW_FETCH(h + 1);
        __syncthreads();
        {
            const int msel = wave >> 1;
            const LAS bf16* As = (msel == 0 || msel == 2) ? BT : KT; const LAS bf16* Bs = (msel < 2) ? AT : RT;
            f32x4 accs[8];
#pragma unroll
            for (int q = 0; q < 8; ++q) { const int tile = (wave & 1) * 8 + q, mt = tile >> 2, nt = tile & 3; accs[q] = (f32x4){0.f, 0.f, 0.f, 0.f};
                accs[q] = mm16(As + mt * 16 * RW_LD, RW_LD, Bs + nt * 16 * RW_LD, RW_LD, 64, accs[q], lane);
                const int tt = nt * 16 + cc, s0 = mt * 16 + 4 * g, lim = (msel < 2) ? tt - 1 : tt;
                accs[q].x = (s0 + 0 <= lim) ? accs[q].x : 0.f; accs[q].y = (s0 + 1 <= lim) ? accs[q].y : 0.f; accs[q].z = (s0 + 2 <= lim) ? accs[q].z : 0.f; accs[q].w = (s0 + 3 <= lim) ? accs[q].w : 0.f; }
            __syncthreads();
            LAS bf16* outp = NI + msel * 64 * RW_LD;
#pragma unroll
            for (int q = 0; q < 8; ++q) { const int tile = (wave & 1) * 8 + q, mt = tile >> 2, nt = tile & 3;
                *(LAS unsigned long long*)(outp + (nt * 16 + cc) * RW_LD + mt * 16 + 4 * g) = pack4(accs[q]); }
        }
        __syncthreads();
        if (wave == 0) {
            const int blk = lane >> 4, col = lane & 15; float x[16];
#pragma unroll
            for (int tt = 0; tt < 16; ++tt) { float nr[16]; { float lo[8], hi[8]; unpack8(*(const LAS v4u*)(NI + (16 * blk + tt) * RW_LD + 16 * blk), lo); unpack8(*(const LAS v4u*)(NI + (16 * blk + tt) * RW_LD + 16 * blk + 8), hi);
#pragma unroll
                    for (int q = 0; q < 8; ++q) { nr[q] = lo[q]; nr[8 + q] = hi[q]; } }
                float a = (tt == col) ? 1.f : 0.f;
#pragma unroll
                for (int q = 0; q < tt; ++q) a += nr[q] * x[q];
                x[tt] = a; TI[(blk * 16 + tt) * 16 + col] = (bf16)f2bf(a); }
        } else {
            for (int tile = wave - 1; tile < 16; tile += 7) { const int mt = tile >> 2, nt = tile & 3;
                f32x4 acc = {0.f, 0.f, 0.f, 0.f};
#pragma unroll
                for (int k = 0; k < 2; ++k) { const s16x8 a = *(const LAS s16x8*)(AAK + (mt * 16 + cc) * RW_LD + 32 * k + 8 * g), bb = *(const LAS s16x8*)(VTc + rofs(nt * 16 + cc, 32 * k + 8 * g)); acc = __builtin_amdgcn_mfma_f32_16x16x32_bf16(a, bb, acc, 0, 0, 0); }
                *(LAS unsigned long long*)(XT + rofs(64 + nt * 16 + cc, mt * 16 + 4 * g)) = pack4(acc); }
        }
        __syncthreads();
        {
            s16x4 xb[4];
#pragma unroll
            for (int i = 0; i < 4; ++i) {
                f32x4 acc; { const unsigned long long xr = *(const LAS unsigned long long*)(XT + rofs(wave * 16 + cc, 16 * i + 4 * g));
                    acc.x = bf2f((bf16)(xr & 0xffffu)); acc.y = bf2f((bf16)((xr >> 16) & 0xffffu)); acc.z = bf2f((bf16)((xr >> 32) & 0xffffu)); acc.w = bf2f((bf16)(xr >> 48)); }
#pragma unroll
                for (int k = 0; k < i; ++k) { const s16x4 a = *(const LAS s16x4*)(NI + (16 * i + cc) * RW_LD + 16 * k + 4 * g); acc = __builtin_amdgcn_mfma_f32_16x16x16bf16_1k(a, xb[k], acc, 0, 0, 0); }
                const s16x4 yb = cvt4(acc), ta = *(const LAS s16x4*)(TI + (i * 16 + cc) * 16 + 4 * g);
                const f32x4 xi = __builtin_amdgcn_mfma_f32_16x16x16bf16_1k(ta, yb, (f32x4){0.f, 0.f, 0.f, 0.f}, 0, 0, 0);
                xb[i] = cvt4(xi);
            }
            __syncthreads();
#pragma unroll
            for (int i = 0; i < 4; ++i) *(LAS s16x4*)(XB16 + (wave * 16 + cc) * RW_LD + 16 * i + 4 * g) = xb[i];
        }
        __syncthreads();
        {
            const int osel = wave >> 1, mt0 = (wave & 1) * 2; const size_t ob = (size_t)item * 4096;
            const LAS bf16* A1 = osel == 0 ? XB16 : osel == 1 ? BHc : osel == 2 ? XB16 : XB16 + 64 * RW_LD;
            const LAS bf16* B1 = osel == 0 ? BHc : osel == 1 ? XB16 + 64 * RW_LD : ARB;
            const LAS bf16* A2 = osel == 1 ? KHc : VTc; const LAS bf16* B2 = osel == 1 ? VTc : ARK;
            const bool rA1 = osel == 1, rB1 = osel == 0, rA2 = true, rB2 = osel == 1;
#define RW_FO(rot, row, k) ((rot) ? rofs((row), 32 * (k) + 8 * g) : (row) * RW_LD + 32 * (k) + 8 * g)
            bf16* OUT = osel == 0 ? PP : osel == 1 ? QQ : osel == 2 ? RH : YH;
            f32x4 acc[2][4];
#pragma unroll
            for (int mq = 0; mq < 2; ++mq)
#pragma unroll
                for (int nt = 0; nt < 4; ++nt) acc[mq][nt] = (f32x4){0.f, 0.f, 0.f, 0.f};
            { s16x8 af[2][2], bfm[4][2];
#pragma unroll
              for (int mq = 0; mq < 2; ++mq)
#pragma unroll
                  for (int k = 0; k < 2; ++k) af[mq][k] = *(const LAS s16x8*)(A1 + RW_FO(rA1, (mt0 + mq) * 16 + cc, k));
#pragma unroll
              for (int nt = 0; nt < 4; ++nt)
#pragma unroll
                  for (int k = 0; k < 2; ++k) bfm[nt][k] = *(const LAS s16x8*)(B1 + RW_FO(rB1, nt * 16 + cc, k));
#pragma unroll
              for (int mq = 0; mq < 2; ++mq)
#pragma unroll
                  for (int nt = 0; nt < 4; ++nt) { acc[mq][nt] = __builtin_amdgcn_mfma_f32_16x16x32_bf16(af[mq][0], bfm[nt][0], acc[mq][nt], 0, 0, 0); acc[mq][nt] = __builtin_amdgcn_mfma_f32_16x16x32_bf16(af[mq][1], bfm[nt][1], acc[mq][nt], 0, 0, 0); } }
            if (osel & 1) { s16x8 af[2][2], bfm[4][2];
#pragma unroll
              for (int mq = 0; mq < 2; ++mq)
#pragma unroll
                  for (int k = 0; k < 2; ++k) af[mq][k] = *(const LAS s16x8*)(A2 + RW_FO(rA2, (mt0 + mq) * 16 + cc, k));
#pragma unroll
              for (int nt = 0; nt < 4; ++nt)
#pragma unroll
                  for (int k = 0; k < 2; ++k) bfm[nt][k] = *(const LAS s16x8*)(B2 + RW_FO(rB2, nt * 16 + cc, k));
#pragma unroll
              for (int mq = 0; mq < 2; ++mq)
#pragma unroll
                  for (int nt = 0; nt < 4; ++nt) { acc[mq][nt] = __builtin_amdgcn_mfma_f32_16x16x32_bf16(af[mq][0], bfm[nt][0], acc[mq][nt], 0, 0, 0); acc[mq][nt] = __builtin_amdgcn_mfma_f32_16x16x32_bf16(af[mq][1], bfm[nt][1], acc[mq][nt], 0, 0, 0); } }
#pragma unroll
            for (int mq = 0; mq < 2; ++mq)
#pragma unroll
                for (int nt = 0; nt < 4; ++nt) { f32x4 a = acc[mq][nt];
                    if (osel == 2) { const unsigned long long rr = *(const LAS unsigned long long*)(RT + (nt * 16 + cc) * RW_LD + (mt0 + mq) * 16 + 4 * g);
                        a.x += bf2f((bf16)(rr & 0xffffu)); a.y += bf2f((bf16)((rr >> 16) & 0xffffu)); a.z += bf2f((bf16)((rr >> 32) & 0xffffu)); a.w += bf2f((bf16)(rr >> 48)); }
                    *(unsigned long long*)(OUT + ob + (nt * 16 + cc) * 64 + (mt0 + mq) * 16 + 4 * g) = pack4(a); }
        }
        __syncthreads();
      }
    }
}

#undef RW_FETCH
#undef RW_FO
constexpr int CH_R = 6, CH_SLOT = 9216 + 9216 + 256;
constexpr int CH_RING = 0, CH_SI = CH_R * CH_SLOT, CH_FLAGS = CH_SI + 4 * 2304;
static_assert(CH_FLAGS + 64 <= MISC_OFF, "chain LDS map");
struct ChainRegs { v4u p[8], q[8]; f32x4 gm; };
__device__ __forceinline__ void chain_fetch(ChainRegs& o, const bf16* PP, const bf16* QQ, const float* GAMC, int item, int lane) {
    const size_t ob = (size_t)item * 4096;
#pragma unroll
    for (int i = 0; i < 8; ++i) { o.p[i] = *(const v4u*)(PP + ob + (size_t)(i * 64 + lane) * 8); o.q[i] = *(const v4u*)(QQ + ob + (size_t)(i * 64 + lane) * 8); }
    o.gm = *(const f32x4*)(GAMC + (size_t)item * 64 + (lane & 15) * 4);
}
__device__ __forceinline__ void chain_commit(const ChainRegs& o, LAS unsigned char* L, int c, int lane) {
    volatile LAS unsigned* flags = (volatile LAS unsigned*)(L + CH_FLAGS);
    const int slot = c % CH_R;
    if (c >= CH_R) { const unsigned need = (unsigned)(c - CH_R + 1);
        for (;;) { const unsigned m0 = flags[CH_R + 0], m1 = flags[CH_R + 1], m2 = flags[CH_R + 2], m3 = flags[CH_R + 3];
            if (m0 >= need && m1 >= need && m2 >= need && m3 >= need) break; __builtin_amdgcn_s_sleep(1); } }
    asm volatile("" ::: "memory");
    LAS unsigned char* sl = L + CH_RING + slot * CH_SLOT;
#pragma unroll
    for (int i = 0; i < 8; ++i) { const int idx = i * 64 + lane, row = idx >> 3, c16 = idx & 7;
        *(LAS v4u*)(sl + row * 144 + c16 * 16) = o.p[i]; *(LAS v4u*)(sl + 9216 + row * 144 + c16 * 16) = o.q[i]; }
    if (lane < 16) *(LAS f32x4*)(sl + 18432 + lane * 16) = o.gm;
    asm volatile("s_waitcnt lgkmcnt(0)" ::: "memory");
    if (lane == 0) flags[slot] = (unsigned)(c + 1);
}
__device__ __forceinline__ void ph_rwkv_b(const Ctx& C, int bh  , const bf16* PP, const bf16* QQ, const float* GAMC, bf16* S0) {
    const int lane = C.lane, wave = C.wave, cc = lane & 15, g = lane >> 4, b = bh >> 3, h = bh & 7;
    LAS unsigned char* L = C.lds;
    volatile LAS unsigned* flags = (volatile LAS unsigned*)(L + CH_FLAGS);
    if (C.tid < 16) flags[C.tid] = 0u;
    __syncthreads();
    if (wave >= 4) {
        const int j = wave - 4;
        ChainRegs A, B;
        int lc = j;
        chain_fetch(A, PP, QQ, GAMC, (b * 128 + lc) * 8 + h, lane);
        for (;;) {
            if (lc + 4 < 128) chain_fetch(B, PP, QQ, GAMC, (b * 128 + lc + 4) * 8 + h, lane);
            chain_commit(A, L, lc, lane);
            lc += 4; if (lc >= 128) break;
            if (lc + 4 < 128) chain_fetch(A, PP, QQ, GAMC, (b * 128 + lc + 4) * 8 + h, lane);
            chain_commit(B, L, lc, lane);
            lc += 4; if (lc >= 128) break;
        }
    } else {
        const int vt = wave;
        LAS bf16* SI = (LAS bf16*)(L + CH_SI + vt * 2304);
        f32x4 st[4];
#pragma unroll
        for (int mt = 0; mt < 4; ++mt) st[mt] = (f32x4){0.f, 0.f, 0.f, 0.f};
        for (int c = 0; c < 128; ++c) {
            const int item = (b * 128 + c) * 8 + h, slot = c % CH_R; const size_t ob = (size_t)item * 4096;
#pragma unroll
            for (int mt = 0; mt < 4; ++mt) { const unsigned long long pk = pack4(st[mt]);
                *(unsigned long long*)(S0 + ob + (vt * 16 + cc) * 64 + mt * 16 + 4 * g) = pk; *(LAS unsigned long long*)(SI + cc * RW_LD + mt * 16 + 4 * g) = pk; }
            while (flags[slot] < (unsigned)(c + 1)) __builtin_amdgcn_s_sleep(1);
            asm volatile("s_waitcnt lgkmcnt(0)" ::: "memory");
            const LAS unsigned char* sl = L + CH_RING + slot * CH_SLOT;
            const LAS bf16* Pi = (const LAS bf16*)sl; const LAS bf16* Qi = (const LAS bf16*)(sl + 9216); const LAS float* Gi = (const LAS float*)(sl + 18432);
            const s16x8 b0 = *(const LAS s16x8*)(SI + cc * RW_LD + 8 * g), b1 = *(const LAS s16x8*)(SI + cc * RW_LD + 32 + 8 * g);
#pragma unroll
            for (int mt = 0; mt < 4; ++mt) {
                const f32x4 gm = *(const LAS f32x4*)(Gi + mt * 16 + 4 * g);
                const unsigned long long qq = *(const LAS unsigned long long*)(Qi + (vt * 16 + cc) * RW_LD + mt * 16 + 4 * g);
                const s16x8 a0 = *(const LAS s16x8*)(Pi + (mt * 16 + cc) * RW_LD + 8 * g), a1 = *(const LAS s16x8*)(Pi + (mt * 16 + cc) * RW_LD + 32 + 8 * g);
                f32x4 acc; acc.x = gm.x * st[mt].x + bf2f((bf16)(qq & 0xffffu)); acc.y = gm.y * st[mt].y + bf2f((bf16)((qq >> 16) & 0xffffu));
                acc.z = gm.z * st[mt].z + bf2f((bf16)((qq >> 32) & 0xffffu)); acc.w = gm.w * st[mt].w + bf2f((bf16)(qq >> 48));
                acc = __builtin_amdgcn_mfma_f32_16x16x32_bf16(a0, b0, acc, 0, 0, 0); acc = __builtin_amdgcn_mfma_f32_16x16x32_bf16(a1, b1, acc, 0, 0, 0);
                st[mt] = acc; }
            asm volatile("s_waitcnt lgkmcnt(0)" ::: "memory");
            if (lane == 0) flags[CH_R + vt] = (unsigned)(c + 1);
        }
    }
    __syncthreads();
}

__device__ __forceinline__ void ph_rwkv_c(const Ctx& C, const bf16* S0, const bf16* RH, const bf16* YH, const float* RK, const bf16* GG, const bf16* VF,
                                          const float* gn_g, const float* gn_b, bf16* O) {
    const int lane = C.lane, cc = lane & 15, g = lane >> 4;
    for (int item = C.bid * 8 + C.wave; item < 4096; item += C.nb * 8) {
        const int h = item & 7, c = (item >> 3) & 127, b = item >> 10; const size_t m0 = (size_t)b * T_ + c * 64, ob = (size_t)item * 4096;
        s16x8 af[4][2], bfr[4][2];
#pragma unroll
        for (int q = 0; q < 4; ++q)
#pragma unroll
            for (int k = 0; k < 2; ++k) { af[q][k] = *(const s16x8*)(S0 + ob + (q * 16 + cc) * 64 + k * 32 + 8 * g); bfr[q][k] = *(const s16x8*)(RH + ob + (q * 16 + cc) * 64 + k * 32 + 8 * g); }
#pragma unroll
        for (int nt = 0; nt < 4; ++nt) {
            const size_t m = m0 + nt * 16 + cc;
            f32x4 y[4]; float s1 = 0.f;
#pragma unroll
            for (int mt = 0; mt < 4; ++mt) { const unsigned long long yh = *(const unsigned long long*)(YH + ob + (nt * 16 + cc) * 64 + mt * 16 + 4 * g);
                f32x4 acc; acc.x = bf2f((bf16)(yh & 0xffffu)); acc.y = bf2f((bf16)((yh >> 16) & 0xffffu)); acc.z = bf2f((bf16)((yh >> 32) & 0xffffu)); acc.w = bf2f((bf16)(yh >> 48));
                acc = __builtin_amdgcn_mfma_f32_16x16x32_bf16(af[mt][0], bfr[nt][0], acc, 0, 0, 0); acc = __builtin_amdgcn_mfma_f32_16x16x32_bf16(af[mt][1], bfr[nt][1], acc, 0, 0, 0);
                y[mt] = acc; s1 += (acc.x + acc.y) + (acc.z + acc.w); }
            s1 = xsum4(s1);
            const float mean = s1 * (1.f / 64.f); float s2 = 0.f;
#pragma unroll
            for (int mt = 0; mt < 4; ++mt) { y[mt] = y[mt] - mean; s2 += (y[mt].x * y[mt].x + y[mt].y * y[mt].y) + (y[mt].z * y[mt].z + y[mt].w * y[mt].w); }
            s2 = xsum4(s2);
            const float rstd = __builtin_amdgcn_rsqf(s2 * (1.f / 64.f) + 64e-5f), rk = RK[m * 8 + h];
#pragma unroll
            for (int mt = 0; mt < 4; ++mt) { const int v = h * 64 + mt * 16 + 4 * g;
                const f32x4 gg4 = *(const f32x4*)(gn_g + v), gb4 = *(const f32x4*)(gn_b + v);
                const unsigned long long vx = *(const unsigned long long*)(VF + m * 512 + v), gx = *(const unsigned long long*)(GG + m * 512 + v);
                f32x4 o;
                o.x = (y[mt].x * rstd * gg4.x + gb4.x + rk * bf2f((bf16)(vx & 0xffffu))) * bf2f((bf16)(gx & 0xffffu));
                o.y = (y[mt].y * rstd * gg4.y + gb4.y + rk * bf2f((bf16)((vx >> 16) & 0xffffu))) * bf2f((bf16)((gx >> 16) & 0xffffu));
                o.z = (y[mt].z * rstd * gg4.z + gb4.z + rk * bf2f((bf16)((vx >> 32) & 0xffffu))) * bf2f((bf16)((gx >> 32) & 0xffffu));
                o.w = (y[mt].w * rstd * gg4.w + gb4.w + rk * bf2f((bf16)(vx >> 48))) * bf2f((bf16)(gx >> 48));
                *(unsigned long long*)(O + m * D_ + 512 + v) = pack4(o); }
        }
    }
}

__device__ __forceinline__ void ph_convfix(const Ctx& C, const float* HALO, const float* FIXU, const float* cw, const float* cb, bf16* ACT) {
    for (int idx = C.bid * NT + C.tid; idx < 128 * 22 * 2 * 128; idx += C.nb * NT) {
        const int j = idx & 127, rr = (idx >> 7) & 1, tile = idx >> 8, pm = tile / 22, pn = tile % 22;
        const bool seq0 = (pm & 31) == 0;
        const float* fx = FIXU + (size_t)tile * 512; const float* hl = HALO + (size_t)(tile - 22) * 512;
        const float u0g = fx[rr * 256 + j], u0v = fx[rr * 256 + 128 + j];
        float u1g, u1v, u2g, u2v;
        if (rr == 0) { u1g = seq0 ? 0.f : hl[256 + j]; u1v = seq0 ? 0.f : hl[256 + 128 + j]; u2g = seq0 ? 0.f : hl[j]; u2v = seq0 ? 0.f : hl[128 + j]; }
        else { u1g = fx[j]; u1v = fx[128 + j]; u2g = seq0 ? 0.f : hl[256 + j]; u2v = seq0 ? 0.f : hl[256 + 128 + j]; }
        const int jg = pn * 128 + j, jv = DFF + jg;
        const float gc = cb[jg] + cw[jg] * u2g + cw[NUP + jg] * u1g + cw[2 * NUP + jg] * u0g, vc = cb[jv] + cw[jv] * u2v + cw[NUP + jv] * u1v + cw[2 * NUP + jv] * u0v;
        ACT[(size_t)(pm * 256 + rr) * DFF + jg] = (bf16)f2bf(siluf_(gc) * vc);
    }
}
}

namespace pg8 {
struct EpiRes {
    static constexpr bool PERM = false, AFTER_DRAIN = false;
    const float* base; float* out; const float* gate; int gstride;
    __device__ __forceinline__ void operator()(const f32x4 (&acc)[2][2][4][2], const Unit& u, int wr, int wc, int fr, int fq) const {
        const int b = (u.pm * BM) / 8192; const float* gp = gate + (size_t)b * gstride;
        const int col0 = u.pn * BM + wc * 32 + 4 * fq;
        f32x4 gv[2][2];
#pragma unroll
        for (int bj = 0; bj < 2; ++bj)
#pragma unroll
            for (int n = 0; n < 2; ++n) gv[bj][n] = *(const f32x4*)(gp + col0 + bj * HALF + n * 16);
#pragma unroll
        for (int ai = 0; ai < 2; ++ai)
#pragma unroll
            for (int m = 0; m < 4; ++m) { const size_t off = (size_t)(u.pm * BM + ai * HALF + wr * 64 + m * 16 + fr) * 1024 + col0;
                f32x4 bs[2][2];
#pragma unroll
                for (int bj = 0; bj < 2; ++bj)
#pragma unroll
                    for (int n = 0; n < 2; ++n) bs[bj][n] = *(const f32x4*)(base + off + bj * HALF + n * 16);
#pragma unroll
                for (int bj = 0; bj < 2; ++bj)
#pragma unroll
                    for (int n = 0; n < 2; ++n) *(f32x4*)(out + off + bj * HALF + n * 16) = bs[bj][n] + gv[bj][n] * acc[ai][bj][m][n]; }
    }
};

template <bool BASE32> struct EpiResB {
    static constexpr bool PERM = true, AFTER_DRAIN = false;
    const float* base32; bf16_t* R; const float* gate; int gstride;
    __device__ __forceinline__ void operator()(const f32x4 (&acc)[2][2][4][2], const Unit& u, int wr, int wc, int fr, int fq) const {
        const int b = u.pm >> 5; const float* gp = gate + (size_t)b * gstride;
        const int col0 = u.pn * BM + wc * 32 + 8 * fq;
        f32x4 gv[2][2];
#pragma unroll
        for (int bj = 0; bj < 2; ++bj)
#pragma unroll
            for (int n = 0; n < 2; ++n) gv[bj][n] = *(const f32x4*)(gp + col0 + bj * HALF + n * 4);
#pragma unroll
        for (int ai = 0; ai < 2; ++ai)
#pragma unroll
            for (int m = 0; m < 4; ++m) { const size_t off = (size_t)(u.pm * BM + ai * HALF + wr * 64 + m * 16 + fr) * 1024 + col0;
                f32x4 bs[2][2];
#pragma unroll
                for (int bj = 0; bj < 2; ++bj) {
                    if (BASE32) { bs[bj][0] = *(const f32x4*)(base32 + off + bj * HALF); bs[bj][1] = *(const f32x4*)(base32 + off + bj * HALF + 4); }
                    else { const u32x4 r = *(const u32x4*)(R + off + bj * HALF);
                        bs[bj][0] = (f32x4){__builtin_bit_cast(float, r.x << 16), __builtin_bit_cast(float, r.x & 0xffff0000u), __builtin_bit_cast(float, r.y << 16), __builtin_bit_cast(float, r.y & 0xffff0000u)};
                        bs[bj][1] = (f32x4){__builtin_bit_cast(float, r.z << 16), __builtin_bit_cast(float, r.z & 0xffff0000u), __builtin_bit_cast(float, r.w << 16), __builtin_bit_cast(float, r.w & 0xffff0000u)}; } }
#pragma unroll
                for (int bj = 0; bj < 2; ++bj) { const f32x4 o0 = bs[bj][0] + gv[bj][0] * acc[ai][bj][m][0], o1 = bs[bj][1] + gv[bj][1] * acc[ai][bj][m][1];
                    u32x4 w; w.x = cvt_pk_bf16(o0.x, o0.y); w.y = cvt_pk_bf16(o0.z, o0.w); w.z = cvt_pk_bf16(o1.x, o1.y); w.w = cvt_pk_bf16(o1.z, o1.w);
                    *(u32x4*)(R + off + bj * HALF) = w; } }
    }
};
struct EpiConv {
    static constexpr bool PERM = true, AFTER_DRAIN = false;
    bf16_t* ACT; const float* cw; const float* cb; float* HALO; float* FIXU; PG8_LAS float* EX; int nN;
    template <int CTRL> static __device__ __forceinline__ float ror1(float x) { return __builtin_bit_cast(float, __builtin_amdgcn_mov_dpp(__builtin_bit_cast(int, x), CTRL, 0xf, 0xf, true)); }
    template <int CTRL> static __device__ __forceinline__ f32x4 ror4(f32x4 x) { return (f32x4){ror1<CTRL>(x.x), ror1<CTRL>(x.y), ror1<CTRL>(x.z), ror1<CTRL>(x.w)}; }
    template <int CTRL> static __device__ __forceinline__ float shr1(float old, float x) { return __builtin_bit_cast(float, __builtin_amdgcn_update_dpp(__builtin_bit_cast(int, old), __builtin_bit_cast(int, x), CTRL, 0xf, 0xf, false)); }
    template <int CTRL> static __device__ __forceinline__ f32x4 shr4(f32x4 o, f32x4 x) { return (f32x4){shr1<CTRL>(o.x, x.x), shr1<CTRL>(o.y, x.y), shr1<CTRL>(o.z, x.z), shr1<CTRL>(o.w, x.w)}; }
    __device__ __forceinline__ void operator()(const f32x4 (&acc)[2][2][4][2], const Unit& u, int wr, int wc, int fr, int fq) const {
        const int colw = wc * 32 + 8 * fq, tile = u.pm * nN + u.pn;
        if (fr >= 14) {
#pragma unroll
            for (int ai = 0; ai < 2; ++ai)
#pragma unroll
                for (int bj = 0; bj < 2; ++bj)
#pragma unroll
                    for (int n = 0; n < 2; ++n) { *(PG8_LAS f32x4*)(EX + ((ai * 2 + wr) * 2 + (fr - 14)) * 256 + bj * 128 + colw + 4 * n) = acc[ai][bj][3][n];
                        if (ai == 1 && wr == 1) *(f32x4*)(HALO + ((size_t)tile * 2 + (fr - 14)) * 256 + bj * 128 + colw + 4 * n) = acc[1][bj][3][n]; }
        }
        if (fr < 2 && wr == 0) {
#pragma unroll
            for (int bj = 0; bj < 2; ++bj)
#pragma unroll
                for (int n = 0; n < 2; ++n) *(f32x4*)(FIXU + ((size_t)tile * 2 + fr) * 256 + bj * 128 + colw + 4 * n) = acc[0][bj][0][n];
        }
        asm volatile("s_waitcnt lgkmcnt(0)" ::: "memory"); __builtin_amdgcn_s_barrier(); asm volatile("" ::: "memory");
#pragma unroll
        for (int n = 0; n < 2; ++n) {
            const int jg = u.pn * 128 + colw + 4 * n, jv = 2816 + jg;
            f32x4 cw0[2], cw1[2], cw2[2], cbb[2];
            cw0[0] = *(const f32x4*)(cw + jg); cw1[0] = *(const f32x4*)(cw + 5632 + jg); cw2[0] = *(const f32x4*)(cw + 2 * 5632 + jg); cbb[0] = *(const f32x4*)(cb + jg);
            cw0[1] = *(const f32x4*)(cw + jv); cw1[1] = *(const f32x4*)(cw + 5632 + jv); cw2[1] = *(const f32x4*)(cw + 2 * 5632 + jv); cbb[1] = *(const f32x4*)(cb + jv);
#pragma unroll
            for (int ai = 0; ai < 2; ++ai) {
                const int src = ai * 2 + wr - 1;
                f32x4 res[2][4];
#pragma unroll
                for (int bj = 0; bj < 2; ++bj) {
                    f32x4 o1 = {0.f, 0.f, 0.f, 0.f}, o2 = o1;
                    if (src >= 0) { const f32x4 e14 = *(const PG8_LAS f32x4*)(EX + (src * 2 + 0) * 256 + bj * 128 + colw + 4 * n), e15 = *(const PG8_LAS f32x4*)(EX + (src * 2 + 1) * 256 + bj * 128 + colw + 4 * n);
                        o1 = e15; o2 = (fr == 0) ? e14 : e15; }
#pragma unroll
                    for (int m = 0; m < 4; ++m) {
                        const f32x4 x = acc[ai][bj][m][n];
                        const f32x4 x1 = shr4<0x111>(o1, x), x2 = shr4<0x112>(o2, x);
                        res[bj][m] = cbb[bj] + cw0[bj] * x2 + cw1[bj] * x1 + cw2[bj] * x;
                        if (m < 3) { o1 = ror4<0x121>(x); o2 = ror4<0x122>(x); }
                    }
                }
#pragma unroll
                for (int m = 0; m < 4; ++m) {
                    const f32x4 gc = res[0][m], vc = res[1][m];
                    f32x4 o;
                    o.x = gc.x * __builtin_amdgcn_rcpf(1.f + __expf(-gc.x)) * vc.x; o.y = gc.y * __builtin_amdgcn_rcpf(1.f + __expf(-gc.y)) * vc.y;
                    o.z = gc.z * __builtin_amdgcn_rcpf(1.f + __expf(-gc.z)) * vc.z; o.w = gc.w * __builtin_amdgcn_rcpf(1.f + __expf(-gc.w)) * vc.w;
                    typedef unsigned u32x2 __attribute__((ext_vector_type(2)));
                    u32x2 w; w.x = cvt_pk_bf16(o.x, o.y); w.y = cvt_pk_bf16(o.z, o.w);
                    *(u32x2*)(ACT + (size_t)(u.pm * BM + ai * HALF + wr * 64 + m * 16 + fr) * 2816 + u.pn * 128 + colw + 4 * n) = w;
                }
            }
        }
    }
};
}

namespace hy {
struct Args { const float* in[31]; float* out; unsigned char* ws; };
__global__ void __launch_bounds__(NT, 2) hy_fwd(Args A) {
    extern __shared__ __attribute__((aligned(16))) unsigned char lds_raw[];
    Ctx C; C.bid = blockIdx.x; C.nb = gridDim.x; C.tid = threadIdx.x; C.lane = C.tid & 63; C.wave = __builtin_amdgcn_readfirstlane(C.tid >> 6); C.lds = (LAS unsigned char*)lds_raw;
    volatile LAS unsigned* MISC = (volatile LAS unsigned*)(C.lds + MISC_OFF);
    for (int u = C.tid; u < (LDS_BYTES - MISC_OFF) / 4; u += NT) ((LAS unsigned*)(C.lds + MISC_OFF))[u] = 0u;
    __syncthreads();
    unsigned char* ws = A.ws;
    const int wave0 = __builtin_amdgcn_readfirstlane(threadIdx.x >> 6);
    (void)xcd_barrier_post((unsigned*)(ws + WS_CTL) + CW_BAR, MISC + 8);
#define PHASE_BEGIN() do { int t_ = wave0 * 64 + lane_now(); int b_ = blockIdx.x; asm volatile("" : "+s"(b_)); \
    C.tid = t_; C.lane = t_ & 63; C.wave = __builtin_amdgcn_readfirstlane(t_ >> 6); C.bid = b_; } while (0)
#ifdef HY_DIAG
    unsigned long long ts_last = __builtin_amdgcn_s_memrealtime(); float tacc[10] = {0.f, 0.f, 0.f, 0.f, 0.f, 0.f, 0.f, 0.f, 0.f, 0.f};
#define GRID_BAR(cat) do { { XcdBarrier b_; b_.bar = (unsigned*)(A.ws + WS_CTL) + CW_BAR; b_.x = xb_xcc_id(); b_.st = (volatile LAS unsigned*)(C.lds + MISC_OFF) + 8; xcd_barrier(b_, wave0 == 0 && lane_now() == 0); } PHASE_BEGIN(); { const unsigned long long n_ = __builtin_amdgcn_s_memrealtime(); tacc[cat] += (float)(n_ - ts_last); ts_last = n_; } } while (0)
#else
#define GRID_BAR(cat) do { { XcdBarrier b_; b_.bar = (unsigned*)(A.ws + WS_CTL) + CW_BAR; b_.x = xb_xcc_id(); b_.st = (volatile LAS unsigned*)(C.lds + MISC_OFF) + 8; xcd_barrier(b_, wave0 == 0 && lane_now() == 0); } PHASE_BEGIN(); } while (0)
#endif
#ifndef HY_REPCAT
#define HY_REPCAT (-1)
#endif
#define NREP(cat) ((HY_REPCAT == (cat)) ? 2 : 1)
    float* out = A.out;
    bf16* RES = (bf16*)((unsigned char*)A.out + 64 * MiB);
#define in A.in
    float* MOD = (float*)(ws + WS_MOD);
    bf16 *WIN = (bf16*)(ws + WS_WIN), *WOUT = (bf16*)(ws + WS_WOUT), *WUP = (bf16*)(ws + WS_WUP), *WDN = (bf16*)(ws + WS_WDN);
    bf16 *XB = (bf16*)(ws + WS_XB), *O = (bf16*)(ws + WS_O), *VF = (bf16*)(ws + WS_VF), *PG = (bf16*)(ws + WS_PG), *PR = (bf16*)(ws + WS_PR), *VL = (bf16*)(ws + WS_VL);
    bf16 *RH = (bf16*)(ws + WS_RH), *YH = (bf16*)(ws + WS_YH), *PP = (bf16*)(ws + WS_PP), *QQ = (bf16*)(ws + WS_QQ), *GG = (bf16*)(ws + WS_GG), *S0 = (bf16*)(ws + WS_S0);
    float *GAMC = (float*)(ws + WS_GAMC), *RK = (float*)(ws + WS_RK);
    bf16* LORA = (bf16*)(ws + WS_LORA);
    bf16* DS = (bf16*)(ws + WS_GK); float* GAM = (float*)(ws + WS_GAM);
    bf16* ACT = (bf16*)(ws + WS_ACT); float *HALO = (float*)(ws + WS_U), *FIXU = (float*)(ws + WS_U + 8 * MiB);

    ph_mod(C, in[1], in[2], in[3], MOD);
    for (int l = 0; l < L_; ++l) {
        const float* modl = MOD + (size_t)l * 4 * 6144;
        for (int r_ = 0; r_ < NREP(0); ++r_) {
        wprep_mat(C, in[5] + (size_t)l * D_ * IN_COLS, D_, IN_COLS, NIN, WIN, 1, l ? in[6] : nullptr);
        wprep_mat(C, in[24] + (size_t)l * D_ * D_, D_, D_, D_, WOUT, 0, nullptr);
        wprep_mat(C, in[26] + (size_t)l * D_ * NUP, D_, NUP, NUP, WUP, 2, nullptr);
        wprep_mat(C, in[29] + (size_t)l * DFF * D_, DFF, D_, D_, WDN, 0, nullptr);
        wprep_mat(C, in[12] + (size_t)l * 64 * 512, 64, 512, 512, LORA, 0, nullptr);
        wprep_mat(C, in[14] + (size_t)l * 64 * 512, 64, 512, 512, LORA + 512 * 64, 0, nullptr);
        wprep_mat(C, in[16] + (size_t)l * 128 * 512, 128, 512, 512, LORA + 2 * 512 * 64, 0, nullptr);
        if (l) wprep_mat(C, in[17], 32, 512, 512, LORA + 2 * 512 * 64 + 512 * 128, 0, nullptr);
        }
        GRID_BAR(0);
        for (int r_ = 0; r_ < NREP(1); ++r_) { if (l == 0) ph_norm(C, in[0], in[4], modl + 0 * D_, modl + 1 * D_, XB); else ph_norm_b(C, RES, in[4] + l * D_, modl + 0 * D_, modl + 1 * D_, XB); }
        GRID_BAR(1);
        for (int r_ = 0; r_ < NREP(2); ++r_) { pg8::Gemm g{XB, WIN, M_, NIN, D_}; pg8::StaticOrder S; S.init(M_, NIN, C.nb, C.bid, HY_WGM_IN);
          pg8::EpiBf16<0> E{PG, NPG, nullptr, NPG, (WS_PR - WS_PG) / 2, 1.f};
          pg8::gemm_phase<pg8::EpiBf16<0>, pg8::StaticOrder, true, true>(C.lds, g, S, E, C.tid); }
        GRID_BAR(2);
        for (int r_ = 0; r_ < NREP(3); ++r_) {
        ph_gla_a(C, PG, in[7] + l * 16 * 256, in[8] + l * 256, DS, GAM);
        { RwkvW W{in[10] + l * 1792, in[11], in[13] + l * 512, in[15] + l * 512, in[18], in[19] + l * 512, in[20] + l * 512, in[21] + l * 512,
                  LORA, LORA + 512 * 64, LORA + 2 * 512 * 64, LORA + 2 * 512 * 64 + 512 * 128};
          ph_rwkv_a(C, PR, PG, W, l, PP, QQ, RH, YH, GAMC, RK, GG, VF, r_ == NREP(3) - 1); } }
        GRID_BAR(3);
        if (C.bid < 32) { for (int r_ = 0; r_ < NREP(4); ++r_) ph_rwkv_b(C, C.bid, PP, QQ, GAMC, S0); }
        else { Ctx C2 = C; C2.bid = C.bid - 32; C2.nb = C.nb - 32;
               ph_gla_b(C2, DS, GAM);
               group_barrier((unsigned*)(ws + WS_CTL) + 2048, (unsigned)(C.nb - 32) * (unsigned)(l + 1), wave0 == 0 && lane_now() == 0);
               PHASE_BEGIN(); C2 = C; C2.bid = C.bid - 32; C2.nb = C.nb - 32;
               ph_gla_c(C2, PG, in[7] + l * 16 * 256, in[8] + l * 256, in[9] + l * 128, DS, O); }
        GRID_BAR(4);
        for (int r_ = 0; r_ < NREP(5); ++r_) {
        ph_rwkv_c(C, S0, RH, YH, RK, GG, VF, in[22] + l * 512, in[23] + l * 512, O); }
        GRID_BAR(5);
        { pg8::Gemm g{O, WOUT, M_, D_, D_}; pg8::StaticOrder S; S.init(M_, D_, C.nb, C.bid);
          if (l == 0) { pg8::EpiResB<true> E{in[0], RES, modl + 2 * D_, 6144}; pg8::gemm_phase<pg8::EpiResB<true>, pg8::StaticOrder, true, true>(C.lds, g, S, E, C.tid); }
          else { pg8::EpiResB<false> E{nullptr, RES, modl + 2 * D_, 6144}; pg8::gemm_phase<pg8::EpiResB<false>, pg8::StaticOrder, true, true>(C.lds, g, S, E, C.tid); } }
        GRID_BAR(6);
        for (int r_ = 0; r_ < NREP(1); ++r_) ph_norm_b(C, RES, in[25] + l * D_, modl + 3 * D_, modl + 4 * D_, XB);
        GRID_BAR(1);
        for (int r_ = 0; r_ < NREP(7); ++r_) { pg8::Gemm g{XB, WUP, M_, NUP, D_}; pg8::StaticOrder S; S.init(M_, NUP, C.nb, C.bid, HY_WGM_UP);
          pg8::EpiConv E{ACT, in[27] + (size_t)l * 3 * NUP, in[28] + (size_t)l * NUP, HALO, FIXU, (PG8_LAS float*)(C.lds + RING_BYTES), NUP / 256};
          pg8::gemm_phase<pg8::EpiConv, pg8::StaticOrder, true, true>(C.lds, g, S, E, C.tid); }
        GRID_BAR(7);
        for (int r_ = 0; r_ < NREP(8); ++r_) ph_convfix(C, HALO, FIXU, in[27] + (size_t)l * 3 * NUP, in[28] + (size_t)l * NUP, ACT);
        GRID_BAR(8);
        { pg8::Gemm g{ACT, WDN, M_, D_, DFF}; pg8::StaticOrder S; S.init(M_, D_, C.nb, C.bid);
          pg8::EpiResB<false> E{nullptr, RES, modl + 5 * D_, 6144};
          pg8::gemm_phase<pg8::EpiResB<false>, pg8::StaticOrder, true, true>(C.lds, g, S, E, C.tid); }
        GRID_BAR(9);
    }
    ph_final_b(C, RES, in[30], out, 0, M_ / 2, XB, M_ / 2, M_);
    GRID_BAR(1);
    ph_final_b(C, XB - (size_t)(M_ / 2) * D_, in[30], out, M_ / 2, M_, nullptr, 0, 0);
#ifdef HY_DIAG
    GRID_BAR(1);
    if (C.bid == 0) { if (C.tid == 0) out[0] = tacc[HY_DIAG_A] * 0.1f; for (int i = 1 + C.tid; i <= 10000; i += NT) out[i] = tacc[HY_DIAG_B] * 0.01f; }
#endif
#undef GRID_BAR
#undef PHASE_BEGIN
#undef in
}
}

extern "C" void kernel_launch(void* const* d_in, const int* in_sizes, int n_in, void* d_out, int out_size, void* d_ws, size_t ws_size, hipStream_t stream) {
    using namespace hy;
    static int grid = 0;
    if (grid == 0) {
        if (n_in != 31 || in_sizes[0] != M_ * D_ || out_size != M_ * D_ || ws_size < WS_END) { fprintf(stderr, "kernel_launch: unexpected shapes (n_in %d, in0 %d, out %d, ws %zu)\n", n_in, n_in > 0 ? in_sizes[0] : -1, out_size, ws_size); grid = -1; return; }
        if (hipFuncSetAttribute((const void*)hy_fwd, hipFuncAttributeMaxDynamicSharedMemorySize, LDS_BYTES) != hipSuccess) { fprintf(stderr, "kernel_launch: hipFuncSetAttribute failed\n"); grid = -1; return; }
        int dev = 0, cus = 0, per_cu = 0;
        (void)hipGetDevice(&dev); (void)hipDeviceGetAttribute(&cus, hipDeviceAttributeMultiprocessorCount, dev);
        (void)hipOccupancyMaxActiveBlocksPerMultiprocessor(&per_cu, (const void*)hy_fwd, NT, LDS_BYTES);
        if (per_cu < 1) fprintf(stderr, "kernel_launch: occupancy query reports %d blocks per CU\n", per_cu);
        (void)hipGetLastError();
        grid = cus > 0 ? cus : 256;
    }
    if (grid < 0) return;
    (void)hipMemsetAsync((char*)d_ws + WS_CTL, 0, CTL_ZERO_BYTES, stream);
    Args a{};
    for (int i = 0; i < 31; ++i) a.in[i] = (const float*)d_in[i];
    a.out = (float*)d_out; a.ws = (unsigned char*)d_ws;
    hipLaunchKernelGGL(hy_fwd, dim3(grid), dim3(NT), LDS_BYTES, stream, a);
}
```

```cpp
#include <hip/hip_runtime.h>
#include <cstdio>
#include <cstdint>
namespace pg8 {
#define PG8_LAS __attribute__((address_space(3)))
typedef unsigned short bf16_t;
typedef short bf16x8 __attribute__((ext_vector_type(8)));
typedef float f32x4 __attribute__((ext_vector_type(4)));
typedef unsigned u32x4 __attribute__((ext_vector_type(4)));
constexpr int BM = 256, BK = 64, HALF = 128, HTB = HALF * BK * 2  , STAGE_BYTES = 8 * HTB, NXCD = 8;

__host__ __device__ __forceinline__ int lds_byte(int r, int c) { const int st = (r >> 4) * 2 + (c >> 5), rr = r & 15, cc = c & 31, ob = rr * 64 + cc * 2; return st * 1024 + (ob ^ (((ob >> 9) & 1) << 5)); }
__host__ __device__ __forceinline__ void stage_rc(int b, int& R, int& C) { const int st = b / 1024, sb = b % 1024, swz = sb ^ (((sb >> 9) & 1) << 5); R = (st >> 1) * 16 + swz / 64; C = (st & 1) * 32 + (swz % 64) / 2; }
__host__ __device__ __forceinline__ int perm32(int rho) { const int n = rho >> 4, i = rho & 15; return 8 * (i >> 2) + 4 * n + (i & 3); }

struct Unit { int pm, pn; };
struct Gemm { const bf16_t* A; const bf16_t* Bt; int M, N, K; size_t bstride; };

struct StaticOrder {
    int nM, nN, nwg, G, c, WGM;
    __host__ __device__ void init(int M, int N, int G_, int c_, int wgm = 2) { nM = M / BM; nN = N / BM; nwg = nM * nN; G = G_; c = c_; WGM = wgm; }
    __host__ __device__ bool next(int i, Unit& u) const {
        const long L = (long)i * G + c; if (L >= nwg) return false;
        int wgid = (int)L; { const int q = nwg / NXCD, r = nwg % NXCD, xcd = wgid % NXCD, off = wgid / NXCD; wgid = (xcd < r ? xcd * (q + 1) : r * (q + 1) + (xcd - r) * q) + off; }
        const int nig = WGM * nN, gid = wgid / nig, fm = gid * WGM, gsz = (nM - fm) < WGM ? (nM - fm) : WGM;
        u.pm = fm + ((wgid % nig) % gsz); u.pn = (wgid % nig) / gsz; return true;
    }
    __device__ __forceinline__ void a_ready(const Unit&) const {}
    __device__ __forceinline__ void done(const Unit&) const {}
};

__device__ __forceinline__ unsigned cvt_pk_bf16(float lo, float hi) { unsigned r; asm volatile("v_cvt_pk_bf16_f32 %0, %1, %2" : "=v"(r) : "v"(lo), "v"(hi)); return r; }
typedef float f32x2 __attribute__((ext_vector_type(2)));
__device__ __forceinline__ f32x2 gelu_pk(f32x2 v) {
    const f32x2 av = __builtin_elementwise_abs(v), d = av * 0.2316418882f + 1.0f;
    f32x2 t; t.x = __builtin_amdgcn_rcpf(d.x); t.y = __builtin_amdgcn_rcpf(d.y);
    f32x2 q = t * 0.5307027145f + (-0.7265760135f); q = q * t + 0.7107068705f; q = q * t + (-0.142248368f); q = q * t + 0.127414796f; q = q * t;
    const f32x2 s = (v * v) * (-0.72134752044f);
    f32x2 e; e.x = __builtin_amdgcn_exp2f(s.x); e.y = __builtin_amdgcn_exp2f(s.y);
    const f32x2 m = v * (q * e), r = v - m;
    f32x2 o; o.x = v.x < 0.f ? m.x : r.x; o.y = v.y < 0.f ? m.y : r.y; return o;
}

template <int ACT  > struct EpiBf16 {
    static constexpr bool PERM = true, AFTER_DRAIN = false; static_assert(ACT == 0 || ACT == 1, "EpiBf16: ACT is 0 (none) or 1 (gelu_pk)");
    bf16_t* O; int ldc; const float* bias; int split_cols; size_t split_stride; float scale0;
    __device__ __forceinline__ void operator()(const f32x4 (&acc)[2][2][4][2], const Unit& u, int wr, int wc, int fr, int fq) const {
        const int row0 = u.pm * BM + wr * 64 + fr; int colt = u.pn * BM; bf16_t* base = O;
        float sc = 1.f; if (split_cols) { const int t = colt / split_cols; base += (size_t)t * split_stride; colt -= t * split_cols; if (t == 0) sc = scale0; }
        const int col0 = colt + wc * 32 + 8 * fq, bcol0 = u.pn * BM + wc * 32 + 8 * fq;
        f32x4 bv[2][2];
#pragma unroll
        for (int bj = 0; bj < 2; ++bj)
#pragma unroll
            for (int n = 0; n < 2; ++n) bv[bj][n] = bias ? *(const f32x4*)(bias + bcol0 + bj * HALF + 4 * n) : (f32x4){0.f, 0.f, 0.f, 0.f};
#pragma unroll
        for (int ai = 0; ai < 2; ++ai)
#pragma unroll
            for (int m = 0; m < 4; ++m) { bf16_t* rowp = base + (size_t)(row0 + ai * HALF + m * 16) * ldc + col0;
#pragma unroll
                for (int bj = 0; bj < 2; ++bj) { f32x4 v0 = acc[ai][bj][m][0] + bv[bj][0], v1 = acc[ai][bj][m][1] + bv[bj][1];
                    if (ACT == 1) { f32x2 a = gelu_pk((f32x2){v0[0], v0[1]}), b = gelu_pk((f32x2){v0[2], v0[3]}), c = gelu_pk((f32x2){v1[0], v1[1]}), d = gelu_pk((f32x2){v1[2], v1[3]});
                        v0 = (f32x4){a.x, a.y, b.x, b.y}; v1 = (f32x4){c.x, c.y, d.x, d.y}; }
                    v0 = v0 * sc; v1 = v1 * sc; u32x4 w; w.x = cvt_pk_bf16(v0[0], v0[1]); w.y = cvt_pk_bf16(v0[2], v0[3]); w.z = cvt_pk_bf16(v1[0], v1[1]); w.w = cvt_pk_bf16(v1[2], v1[3]);
                    *(u32x4*)(rowp + bj * HALF) = w; } }
    }
};
template <class Epi, class Sched, bool ALIGN_EPI = false, bool SP2 = false>
__device__ __forceinline__ void gemm_phase(PG8_LAS unsigned char* lds, const Gemm g, const Sched& S, const Epi& E, int tid_in) {
    int tid_ = tid_in; asm volatile("" : "+v"(tid_));
    const int tid = tid_, wid = __builtin_amdgcn_readfirstlane(tid >> 6), lane = tid & 63, wr = wid >> 2, wc = wid & 3, fr = lane & 15, fq = lane >> 4;
    const int K = g.K, nt = K / BK;
    unsigned voffA[2], voffB[2];
#pragma unroll
    for (int i = 0; i < 2; ++i) { int R, C; stage_rc(tid * 16 + i * 8192, R, C); const int Rb = Epi::PERM ? ((R & ~31) + perm32(R & 31)) : R;
        voffA[i] = (unsigned)(R * K + C) * 2u; voffB[i] = (unsigned)(Rb * K + C) * 2u; }
    const size_t kstep = (size_t)(BK * 2);
    const size_t hstep = (size_t)HALF * K * 2;
    const size_t tstep = 2 * hstep;
    const unsigned ldsw = (unsigned)wid * 1024u;
    const int aoff = lds_byte(wr * 64 + fr, fq * 8), boff = lds_byte(wc * 32 + fr, fq * 8);
#define PG8_SA(b, h) (((b) * 2 + (h)) * HTB)
#define PG8_SB(b, h) ((4 + (b) * 2 + (h)) * HTB)
#define PG8_STAGE(bufoff, gbase, voff) do { _Pragma("unroll") for (int _i = 0; _i < 2; ++_i) \
        __builtin_amdgcn_global_load_lds((const unsigned*)((const char*)(gbase) + (voff)[_i]), (PG8_LAS unsigned*)(lds + (bufoff) + ldsw + _i * 8192), 16, 0, 0); } while (0)
#define PG8_LDA(dst, b, h) do { _Pragma("unroll") for (int m = 0; m < 4; ++m) _Pragma("unroll") for (int k = 0; k < 2; ++k) dst[m][k] = *(const PG8_LAS bf16x8*)(lds + PG8_SA(b, h) + aoff + m * 2048 + k * 1024); } while (0)
#define PG8_LDB(dst, b, h) do { _Pragma("unroll") for (int n = 0; n < 2; ++n) _Pragma("unroll") for (int k = 0; k < 2; ++k) dst[n][k] = *(const PG8_LAS bf16x8*)(lds + PG8_SB(b, h) + boff + n * 2048 + k * 1024); } while (0)
#define PG8_MMA(ai, bj, At, Bt) do { __builtin_amdgcn_s_setprio(1); _Pragma("unroll") for (int m = 0; m < 4; ++m) _Pragma("unroll") for (int n = 0; n < 2; ++n) _Pragma("unroll") for (int k = 0; k < 2; ++k) \
        acc[ai][bj][m][n] = __builtin_amdgcn_mfma_f32_16x16x32_bf16(Bt[n][k], At[m][k], acc[ai][bj][m][n], 0, 0, 0); __builtin_amdgcn_s_setprio(0); } while (0)
#define PG8_WAIT_V(n) asm volatile("s_waitcnt vmcnt(" #n ")" ::: "memory")
#define PG8_WAIT_L(n) asm volatile("s_waitcnt lgkmcnt(" #n ")" ::: "memory")
#define PG8_BAR __builtin_amdgcn_s_barrier()
#define PG8_SCHED __builtin_amdgcn_sched_barrier(0)
    Unit cur, nxt; int ui = 0;
    if (!S.next(0, cur)) return;
    f32x4 acc[2][2][4][2];
#pragma unroll
    for (int a = 0; a < 2; ++a)
#pragma unroll
        for (int b = 0; b < 2; ++b)
#pragma unroll
            for (int m = 0; m < 4; ++m)
#pragma unroll
                for (int n = 0; n < 2; ++n) acc[a][b][m][n] = (f32x4){0.f, 0.f, 0.f, 0.f};
    bf16x8 At[4][2], B0[2][2], B1[2][2];
    const char* cA = (const char*)g.A + (size_t)cur.pm * tstep; const char* cB = (const char*)g.Bt + (size_t)cur.pn * tstep + (size_t)(cur.pm >> 5) * g.bstride;
    S.a_ready(cur);
    if constexpr (SP2) {
        PG8_STAGE(PG8_SB(0, 0), cB, voffB); PG8_STAGE(PG8_SB(0, 1), cB + hstep, voffB); PG8_STAGE(PG8_SA(0, 0), cA, voffA); PG8_STAGE(PG8_SA(0, 1), cA + hstep, voffA);
        if (wr == 1) PG8_BAR;
        PG8_WAIT_V(2); PG8_BAR;
        PG8_STAGE(PG8_SB(1, 0), cB + kstep, voffB); PG8_STAGE(PG8_SA(1, 0), cA + kstep, voffA); PG8_STAGE(PG8_SB(1, 1), cB + hstep + kstep, voffB);
        PG8_WAIT_V(6); PG8_BAR;
    } else {
        PG8_STAGE(PG8_SB(0, 0), cB, voffB); PG8_STAGE(PG8_SA(0, 0), cA, voffA); PG8_STAGE(PG8_SB(0, 1), cB + hstep, voffB); PG8_STAGE(PG8_SA(0, 1), cA + hstep, voffA);
        if (wr == 1) PG8_BAR;
        PG8_WAIT_V(4); PG8_BAR;
        PG8_STAGE(PG8_SB(1, 0), cB + kstep, voffB); PG8_STAGE(PG8_SA(1, 0), cA + kstep, voffA); PG8_STAGE(PG8_SB(1, 1), cB + hstep + kstep, voffB);
        PG8_WAIT_V(6); PG8_BAR;
    }
    for (;;) {
        const bool has_next = S.next(ui + 1, nxt);
        const char* nA = has_next ? (const char*)g.A + (size_t)nxt.pm * tstep : cA; const char* nB = has_next ? (const char*)g.Bt + (size_t)nxt.pn * tstep + (size_t)(nxt.pm >> 5) * g.bstride : cB;
        for (int t = 0; t < nt; t += 2) {
            const bool last = (t == nt - 2);
            const char* a1 = cA + (size_t)(t + 1) * kstep;
            const char* a2 = last ? nA : cA + (size_t)(t + 2) * kstep; const char* b2 = last ? nB : cB + (size_t)(t + 2) * kstep;
            const char* a3 = a2 + kstep; const char* b3 = b2 + kstep;
            if (last && has_next) S.a_ready(nxt);
            if constexpr (SP2) {
            PG8_LDB(B0, 0, 0); PG8_LDB(B1, 0, 1); PG8_SCHED; PG8_LDA(At, 0, 0); PG8_STAGE(PG8_SA(1, 1), a1 + hstep, voffA);
            PG8_WAIT_V(8); PG8_WAIT_L(0); PG8_BAR; PG8_MMA(0, 0, At, B0); PG8_MMA(0, 1, At, B1); PG8_BAR; PG8_SCHED;
            PG8_LDA(At, 0, 1); PG8_STAGE(PG8_SB(0, 0), b2, voffB); PG8_STAGE(PG8_SB(0, 1), b2 + hstep, voffB); PG8_STAGE(PG8_SA(0, 0), a2, voffA);
            PG8_WAIT_V(8); PG8_WAIT_L(0); PG8_BAR; PG8_MMA(1, 0, At, B0); PG8_MMA(1, 1, At, B1); PG8_BAR; PG8_SCHED;
            PG8_LDB(B0, 1, 0); PG8_LDB(B1, 1, 1); PG8_SCHED; PG8_LDA(At, 1, 0); PG8_STAGE(PG8_SA(0, 1), a2 + hstep, voffA);
            PG8_WAIT_V(8); PG8_WAIT_L(0); PG8_BAR; PG8_MMA(0, 0, At, B0); PG8_MMA(0, 1, At, B1); PG8_BAR; PG8_SCHED;
            PG8_LDA(At, 1, 1); PG8_STAGE(PG8_SB(1, 0), b3, voffB); PG8_STAGE(PG8_SB(1, 1), b3 + hstep, voffB); PG8_STAGE(PG8_SA(1, 0), a3, voffA);
            PG8_WAIT_V(8); PG8_WAIT_L(0); PG8_BAR; PG8_MMA(1, 0, At, B0); PG8_MMA(1, 1, At, B1); PG8_BAR; PG8_SCHED;
            } else {
            PG8_LDB(B0, 0, 0); PG8_SCHED; PG8_LDA(At, 0, 0); PG8_STAGE(PG8_SA(1, 1), a1 + hstep, voffA);
            PG8_WAIT_L(8); PG8_BAR; PG8_WAIT_L(0); PG8_MMA(0, 0, At, B0); PG8_BAR; PG8_SCHED;
            PG8_LDB(B1, 0, 1); PG8_STAGE(PG8_SB(0, 0), b2, voffB);
            PG8_BAR; PG8_WAIT_L(0); PG8_MMA(0, 1, At, B1); PG8_BAR;
            PG8_LDA(At, 0, 1); PG8_STAGE(PG8_SA(0, 0), a2, voffA);
            PG8_BAR; PG8_WAIT_L(0); PG8_MMA(1, 0, At, B0); PG8_BAR; PG8_SCHED;
            PG8_STAGE(PG8_SB(0, 1), b2 + hstep, voffB);
            PG8_WAIT_V(6); PG8_BAR; PG8_MMA(1, 1, At, B1); PG8_BAR;
            PG8_LDB(B0, 1, 0); PG8_SCHED; PG8_LDA(At, 1, 0); PG8_STAGE(PG8_SA(0, 1), a2 + hstep, voffA);
            PG8_WAIT_L(8); PG8_BAR; PG8_WAIT_L(0); PG8_MMA(0, 0, At, B0); PG8_BAR; PG8_SCHED;
            PG8_LDB(B1, 1, 1); PG8_STAGE(PG8_SB(1, 0), b3, voffB);
            PG8_BAR; PG8_WAIT_L(0); PG8_MMA(0, 1, At, B1); PG8_BAR;
            PG8_LDA(At, 1, 1); PG8_STAGE(PG8_SA(1, 0), a3, voffA);
            PG8_BAR; PG8_WAIT_L(0); PG8_MMA(1, 0, At, B0); PG8_BAR; PG8_SCHED;
            PG8_STAGE(PG8_SB(1, 1), b3 + hstep, voffB);
            PG8_WAIT_V(6); PG8_BAR; PG8_MMA(1, 1, At, B1); PG8_BAR;
            }
        }
        if constexpr (ALIGN_EPI) { if (wr == 0) PG8_BAR; }
        if constexpr (!Epi::AFTER_DRAIN) { E(acc, cur, wr, wc, fr, fq); S.done(cur); }
        if (!has_next) break;
#pragma unroll
        for (int a = 0; a < 2; ++a)
#pragma unroll
            for (int b = 0; b < 2; ++b)
#pragma unroll
                for (int m = 0; m < 4; ++m)
#pragma unroll
                    for (int n = 0; n < 2; ++n) acc[a][b][m][n] = (f32x4){0.f, 0.f, 0.f, 0.f};
        cur = nxt; cA = nA; cB = nB; ++ui;
        if constexpr (ALIGN_EPI) { if (wr == 1) PG8_BAR; }
    }
    PG8_WAIT_V(0);
    if constexpr (!ALIGN_EPI) { if (wr == 0) PG8_BAR; }
    PG8_BAR;
    if constexpr (Epi::AFTER_DRAIN) { E.fused(acc, cur, wr, wc, fr, fq, lds, wid, lane); S.done(cur); }
#undef PG8_SA
#undef PG8_SB
#undef PG8_STAGE
#undef PG8_LDA
#undef PG8_LDB
#undef PG8_MMA
#undef PG8_WAIT_V
#undef PG8_WAIT_L
#undef PG8_BAR
#undef PG8_SCHED
}
}

#ifndef HY_WGM_IN
#define HY_WGM_IN 2
#endif
#ifndef HY_WGM_UP
#define HY_WGM_UP 2
#endif
namespace hy {
#define GAS __attribute__((address_space(1)))
#define LAS __attribute__((address_space(3)))
typedef unsigned short bf16;
typedef unsigned v4u __attribute__((ext_vector_type(4)));
typedef float f32x4 __attribute__((ext_vector_type(4)));
typedef short bf16x8 __attribute__((ext_vector_type(8)));
typedef GAS unsigned gu32;
typedef GAS unsigned long long gu64;
#define RLX_AGENT __ATOMIC_RELAXED, __HIP_MEMORY_SCOPE_AGENT
#define LDS_WAIT() asm volatile("s_waitcnt lgkmcnt(0)" ::: "memory")
#define VM_WAIT() asm volatile("s_waitcnt vmcnt(0)" ::: "memory")
__device__ __forceinline__ unsigned long long rt() { return __builtin_amdgcn_s_memrealtime(); }
typedef __bf16 hwbf2 __attribute__((ext_vector_type(2))); typedef float hwf2 __attribute__((ext_vector_type(2)));
__device__ __forceinline__ unsigned f2bf(float f) { return (unsigned)__builtin_bit_cast(unsigned short, (__bf16)f); }
__device__ __forceinline__ unsigned pk2(float lo, float hi) { const hwf2 v = {lo, hi}; return __builtin_bit_cast(unsigned, __builtin_convertvector(v, hwbf2)); }
#define XB_TMO      128
#define XB_XCNT(j)  (256  + 64 * (j))
#define XB_XSUB(j)  (1280 + 64 * (j))
#define XB_XGEN(j)  (2304 + 64 * (j))
#define XB_TOP      3328
#define XB_TOPGEN   3392
#define XCD_BAR_WORDS 3456
#define XB_SPIN_CAP (1u << 18)

__device__ __forceinline__ unsigned xb_ld(unsigned* p)              { return __hip_atomic_load(p, __ATOMIC_RELAXED, __HIP_MEMORY_SCOPE_AGENT); }
__device__ __forceinline__ unsigned xb_add(unsigned* p, unsigned v) { return __hip_atomic_fetch_add(p, v, __ATOMIC_RELAXED, __HIP_MEMORY_SCOPE_AGENT); }
__device__ __forceinline__ unsigned xb_xcc_id() { return (unsigned)__builtin_amdgcn_s_getreg((3 << 11) | 20) & 0xFu; }
#define XB_SPIN(cond, bar) do { unsigned _sp = 0; while (cond) { __builtin_amdgcn_s_sleep(1); \
    if ((++_sp & 255u) == 0u) { if (xb_ld(&(bar)[XB_TMO])) break; if (_sp > XB_SPIN_CAP) { atomicAdd(&(bar)[XB_TMO], 1u); break; } } } } while (0)

struct XcdBarrier {
    unsigned* bar; unsigned x;
    volatile LAS unsigned* st;
};

__device__ __forceinline__ XcdBarrier xcd_barrier_post(unsigned* bar, volatile LAS unsigned* st) {
    XcdBarrier b; b.bar = bar; b.x = xb_xcc_id(); b.st = st;
    if (threadIdx.x == 0) (void)xb_add(&bar[XB_XCNT(b.x)], 1u);
    return b;
}
__device__ __forceinline__ void xcd_barrier_complete(unsigned* bar, unsigned x, unsigned& nloc, unsigned& nx) {
    const unsigned G = gridDim.x * gridDim.y * gridDim.z;
    unsigned sum, cnt, mine, sp = 0u;
    for (;;) {
        sum = 0u; cnt = 0u; mine = 0u;
#pragma unroll
        for (unsigned j = 0; j < 16; ++j) { const unsigned c = xb_ld(&bar[XB_XCNT(j)]); sum += c; cnt += (c > 0u) ? 1u : 0u; mine = (j == x) ? c : mine; }
        if (sum == G) break;
        __builtin_amdgcn_s_sleep(1);
        if ((++sp & 255u) == 0u) { if (xb_ld(&bar[XB_TMO])) break; if (sp > XB_SPIN_CAP) { atomicAdd(&bar[XB_TMO], 1u); break; } }
    }
    nloc = mine > 0u ? mine : 1u; nx = cnt > 0u ? cnt : 1u;
}

__device__ __forceinline__ void xcd_barrier(const XcdBarrier& b, bool leader  ) {
    asm volatile("s_waitcnt vmcnt(0)" ::: "memory");
    __syncthreads();
    if (leader) {
        unsigned* bar = b.bar;
        __builtin_amdgcn_s_waitcnt(0);
        unsigned nloc = b.st[0], nx = b.st[1];
        if (nloc == 0u) { xcd_barrier_complete(bar, b.x, nloc, nx); b.st[0] = nloc; b.st[1] = nx; }
        const unsigned old = xb_add(&bar[XB_XSUB(b.x)], 1u);
        const unsigned gen = old / nloc;
        if (old + 1u == (gen + 1u) * nloc) {
            __builtin_amdgcn_fence(__ATOMIC_RELEASE, "agent");
            asm volatile("s_waitcnt vmcnt(0)" ::: "memory");
            const unsigned og = xb_add(&bar[XB_TOP], 1u);
            const unsigned tg = og / nx;
            if (og + 1u == (tg + 1u) * nx) xb_add(&bar[XB_TOPGEN], 1u);
            else XB_SPIN(xb_ld(&bar[XB_TOPGEN]) == tg, bar);
            __builtin_amdgcn_fence(__ATOMIC_ACQUIRE, "agent");
            xb_add(&bar[XB_XGEN(b.x)], 1u);
            asm volatile("s_waitcnt vmcnt(0)" ::: "memory");
        } else {
            XB_SPIN(xb_ld(&bar[XB_XGEN(b.x)]) == gen, bar);
            __builtin_amdgcn_fence(__ATOMIC_ACQUIRE, "agent");
            asm volatile("s_waitcnt vmcnt(0)" ::: "memory");
        }
    }
    __syncthreads();
}

constexpr int B_ = 4, T_ = 8192, D_ = 1024, M_ = B_ * T_, L_ = 2;
constexpr int NIN = 3584, NPG = 1792, NPR = 1792;
constexpr int DFF = 2816, NUP = 5632, IN_COLS = 3344;
constexpr size_t MiB = 1u << 20;
constexpr size_t WS_CTL = 0, CTL_ZERO_BYTES = 65536;
constexpr int CW_BAR = 4096;
constexpr size_t WS_RK = MiB / 4;
constexpr size_t WS_MOD = 3 * MiB / 2;
constexpr size_t WS_WIN = 2 * MiB, WS_WOUT = 9 * MiB, WS_WUP = 11 * MiB, WS_WDN = 22 * MiB, WS_LORA = 55 * MiB / 2, WS_GAMC = 28 * MiB, WS_VL = 29 * MiB;
constexpr size_t WS_GAM = 31 * MiB;
constexpr size_t WS_XB = 32 * MiB, WS_O = 336 * MiB  , WS_VF = 160 * MiB, WS_GK = 192 * MiB, WS_PG = 224 * MiB, WS_PR = 336 * MiB, WS_END = 512 * MiB;
constexpr size_t WS_RH = WS_XB, WS_YH = WS_XB + 32 * MiB, WS_PP = 96 * MiB, WS_QQ = 128 * MiB, WS_GG = 448 * MiB, WS_S0 = 480 * MiB;
constexpr size_t WS_ACT = 224 * MiB, WS_U = 400 * MiB;
constexpr int RING_BYTES = 131072, MISC_OFF = 161792, LDS_BYTES = 163840;
constexpr int NT = 512;

__device__ __forceinline__ float bf2f(bf16 h) { return __builtin_bit_cast(float, (unsigned)h << 16); }
__device__ __forceinline__ float sigmoidf_(float x) { return __builtin_amdgcn_rcpf(1.f + __expf(-x)); }
__device__ __forceinline__ float siluf_(float x) { return x * __builtin_amdgcn_rcpf(1.f + __expf(-x)); }
__device__ __forceinline__ float softplusf_(float x) { return fmaxf(x, 0.f) + log1pf(__expf(-fabsf(x))); }

typedef unsigned u32x2 __attribute__((ext_vector_type(2)));
template <int CTRL> __device__ __forceinline__ float dpp_f(float v) {
    return __builtin_bit_cast(float, __builtin_amdgcn_update_dpp(0, __builtin_bit_cast(int, v), CTRL, 0xf, 0xf, false));
}
__device__ __forceinline__ float wave_sum(float v) {
    v += dpp_f<0xB1>(v);
    v += dpp_f<0x4E>(v);
    v += dpp_f<0x141>(v);
    v += dpp_f<0x140>(v);
    v += __builtin_bit_cast(float, __builtin_amdgcn_update_dpp(0, __builtin_bit_cast(int, v), 0x142, 0xa, 0xf, false));
    v += __builtin_bit_cast(float, __builtin_amdgcn_update_dpp(0, __builtin_bit_cast(int, v), 0x143, 0xc, 0xf, false));
    return __builtin_bit_cast(float, __builtin_amdgcn_readlane(__builtin_bit_cast(int, v), 63));
}

__device__ __forceinline__ int lane_now() { int l; asm volatile("v_mbcnt_lo_u32_b32 %0, -1, 0\n\tv_mbcnt_hi_u32_b32 %0, -1, %0" : "=v"(l)); return l; }
__device__ __forceinline__ float xsum4(float v) {
    const int l = lane_now();
    v += __builtin_bit_cast(float, __builtin_amdgcn_ds_bpermute((l ^ 16) << 2, __builtin_bit_cast(int, v)));
    v += __builtin_bit_cast(float, __builtin_amdgcn_ds_bpermute((l ^ 32) << 2, __builtin_bit_cast(int, v)));
    return v;
}
struct Ctx { int bid, nb, tid, lane, wave; LAS unsigned char* lds; };
__device__ __forceinline__ void group_barrier(unsigned* cnt, unsigned target, bool leader) {
    asm volatile("s_waitcnt vmcnt(0)" ::: "memory");
    __syncthreads();
    if (leader) {
        __builtin_amdgcn_fence(__ATOMIC_RELEASE, "agent");
        asm volatile("s_waitcnt vmcnt(0)" ::: "memory");
        (void)__hip_atomic_fetch_add(cnt, 1u, __ATOMIC_RELAXED, __HIP_MEMORY_SCOPE_AGENT);
        for (unsigned sp = 0; __hip_atomic_load(cnt, __ATOMIC_RELAXED, __HIP_MEMORY_SCOPE_AGENT) < target && sp < (1u << 22); ++sp) __builtin_amdgcn_s_sleep(2);
        __builtin_amdgcn_fence(__ATOMIC_ACQUIRE, "agent");
        asm volatile("s_waitcnt vmcnt(0)" ::: "memory");
    }
    __syncthreads();
}


__device__ __forceinline__ void ph_mod(const Ctx& C, const float* c, const float* ada_w, const float* ada_b, float* MOD) {
    LAS float* sc = (LAS float*)C.lds;
    LAS float* red = (LAS float*)(C.lds + 16384);
    for (int i = C.tid; i < 4096; i += NT) sc[i] = siluf_(c[i]);
    __syncthreads();
    for (int item = C.bid; item < 192; item += C.nb) {
        const int l = item / 96, j0 = (item % 96) * 64;
        const float* W = ada_w + (size_t)l * 1024 * 6144 + j0 + C.lane;
        float a0 = 0.f, a1 = 0.f, a2 = 0.f, a3 = 0.f;
        for (int k = C.wave * 128; k < C.wave * 128 + 128; ++k) { const float wv = W[(size_t)k * 6144]; a0 += sc[k] * wv; a1 += sc[1024 + k] * wv; a2 += sc[2048 + k] * wv; a3 += sc[3072 + k] * wv; }
        red[(C.wave * 4 + 0) * 64 + C.lane] = a0; red[(C.wave * 4 + 1) * 64 + C.lane] = a1; red[(C.wave * 4 + 2) * 64 + C.lane] = a2; red[(C.wave * 4 + 3) * 64 + C.lane] = a3;
        __syncthreads();
        if (C.wave < 4) { const int b = C.wave; float s = ada_b[l * 6144 + j0 + C.lane];
#pragma unroll
            for (int w = 0; w < 8; ++w) s += red[(w * 4 + b) * 64 + C.lane];
            MOD[((size_t)l * 4 + b) * 6144 + j0 + C.lane] = s; }
        __syncthreads();
    }
}

__device__ __forceinline__ void wprep_mat(const Ctx& C, const float* W, int K, int Nsrc, int Ndst, bf16* Wt, int mode, const float* vres) {
    const int half = C.tid >> 8, t = C.tid & 255, tx = t & 31, ty = t >> 5;
    LAS float* tile = (LAS float*)C.lds + half * (32 * 33);
    const int nbn = Ndst / 32, ntile = nbn * (K / 32);
    const int niter = (ntile + 2 * C.nb - 1) / (2 * C.nb);
    for (int it = 0; it < niter; ++it) {
        const int item = (it * C.nb + C.bid) * 2 + half;
        const bool act = item < ntile;
        const int n0 = (item % nbn) * 32, k0 = (item / nbn) * 32, n = n0 + tx;
        if (act) {
#pragma unroll
            for (int i = 0; i < 4; ++i) { const int k = k0 + ty + 8 * i; float v = 0.f;
                if (mode == 0) v = W[(size_t)k * Nsrc + n];
                else if (mode == 2) { const int tl = n >> 8, w = n & 255; v = W[(size_t)k * Nsrc + (w < 128 ? tl * 128 + w : 2816 + tl * 128 + (w - 128))]; }
                else { if (n < 1552) v = W[(size_t)k * Nsrc + n]; else if (n < 1584) v = vres ? vres[(size_t)k * 32 + (n - 1552)] : 0.f; else if (n < 1792) v = 0.f; else v = W[(size_t)k * Nsrc + (n - 240)]; }
                tile[(ty + 8 * i) * 33 + tx] = v; }
        }
        __syncthreads();
        if (act) {
#pragma unroll
            for (int i = 0; i < 4; ++i) { const int nn = n0 + ty + 8 * i; Wt[(size_t)nn * K + k0 + tx] = (bf16)f2bf(tile[tx * 33 + ty + 8 * i]); }
        }
        __syncthreads();
    }
}

__device__ __forceinline__ void ph_norm(const Ctx& C, const float* x, const float* g, const float* sh, const float* sc, bf16* XB) {
    const int gw = C.bid * 8 + C.wave, NGW = C.nb * 8, lane = C.lane;
    for (int m = gw; m < M_; m += NGW) {
        const int b = m / T_;
        const f32x4* xr = (const f32x4*)(x + (size_t)m * D_) + lane;
        f32x4 v[4]; float s = 0.f;
#pragma unroll
        for (int j = 0; j < 4; ++j) { v[j] = xr[64 * j]; s += (v[j].x * v[j].x + v[j].y * v[j].y) + (v[j].z * v[j].z + v[j].w * v[j].w); }
        const float rstd = 1.f / sqrtf(wave_sum(s) * (1.f / D_) + 1e-6f);
        unsigned long long* o8 = (unsigned long long*)(XB + (size_t)m * D_) + lane;
#pragma unroll
        for (int j = 0; j < 4; ++j) { const int col = 4 * lane + 256 * j;
            const f32x4 gv = *(const f32x4*)(g + col), shv = *(const f32x4*)(sh + b * 6144 + col), scv = *(const f32x4*)(sc + b * 6144 + col);
            const f32x4 h = v[j] * rstd * gv * (scv + 1.f) + shv;
            o8[64 * j] = (unsigned long long)pk2(h.x, h.y) | ((unsigned long long)pk2(h.z, h.w) << 32); }
    }
}
__device__ __forceinline__ void ph_final(const Ctx& C, float* x, const float* g) {
    const int gw = C.bid * 8 + C.wave, NGW = C.nb * 8, lane = C.lane;
    for (int m = gw; m < M_; m += NGW) {
        f32x4* xr = (f32x4*)(x + (size_t)m * D_) + lane;
        f32x4 v[4]; float s = 0.f;
#pragma unroll
        for (int j = 0; j < 4; ++j) { v[j] = xr[64 * j]; s += (v[j].x * v[j].x + v[j].y * v[j].y) + (v[j].z * v[j].z + v[j].w * v[j].w); }
        const float rstd = 1.f / sqrtf(wave_sum(s) * (1.f / D_) + 1e-6f);
#pragma unroll
        for (int j = 0; j < 4; ++j) { const f32x4 gv = *(const f32x4*)(g + 4 * lane + 256 * j); xr[64 * j] = v[j] * rstd * gv; }
    }
}


typedef short s16x8 __attribute__((ext_vector_type(8)));
__device__ __forceinline__ f32x4 mm16(const LAS bf16* A, int lda, const LAS bf16* B, int ldb, int K, f32x4 acc, int lane) {
    const int r = lane & 15, g = lane >> 4;
    const LAS bf16* ap = A + r * lda + 8 * g; const LAS bf16* bp = B + r * ldb + 8 * g;
    for (int k0 = 0; k0 < K; k0 += 32) { const s16x8 a = *(const LAS s16x8*)(ap + k0); const s16x8 b = *(const LAS s16x8*)(bp + k0); acc = __builtin_amdgcn_mfma_f32_16x16x32_bf16(a, b, acc, 0, 0, 0); }
    return acc;
}
__device__ __forceinline__ f32x4 mm16_ga(const bf16* A, int lda, const LAS bf16* B, int ldb, int K, f32x4 acc, int lane) {
    const int r = lane & 15, g = lane >> 4;
    const bf16* ap = A + r * lda + 8 * g; const LAS bf16* bp = B + r * ldb + 8 * g;
    for (int k0 = 0; k0 < K; k0 += 32) { const s16x8 a = *(const s16x8*)(ap + k0); const s16x8 b = *(const LAS s16x8*)(bp + k0); acc = __builtin_amdgcn_mfma_f32_16x16x32_bf16(a, b, acc, 0, 0, 0); }
    return acc;
}
__device__ __forceinline__ unsigned long long pack4(f32x4 v) { return (unsigned long long)pk2(v.x, v.y) | ((unsigned long long)pk2(v.z, v.w) << 32); }
__device__ __forceinline__ float logsigmoidf_(float x) { return fminf(x, 0.f) - __logf(1.f + __expf(-fabsf(x))); }

constexpr int GL_LD = 72;
constexpr int GL_GK = 0;
constexpr int GL_SEG = 16384;
constexpr int GL_Z = 18432;
constexpr int GL_GUP = 20480;
constexpr int GL_I0 = 24832;
constexpr int GL_I1 = GL_I0 + 9216;
constexpr int GL_I2 = GL_I1 + 9216;
constexpr int GL_VT = GL_I2 + 9216;
constexpr int GL_SSQ = GL_VT + 18432;
static_assert(GL_SSQ + 512 <= RING_BYTES, "GLA LDS map");

struct GlaRaw { v4u z, k, q, v0, v1; float g0, g1, gb; };
__device__ __forceinline__ void gla_fetch(GlaRaw& R, const Ctx& C, const bf16* pg, const float* gk_up, const float* gk_b, int h, bool want_q) {
    const int tid = C.tid, j = tid >> 3, d0 = (tid & 7) * 8, e0 = (tid & 7) * 16;
    R.z = (v4u){0u, 0u, 0u, 0u}; R.q = R.z;
    if (tid < 128) R.z = *(const v4u*)(pg + (size_t)(tid >> 1) * NPG + 1536 + (tid & 1) * 8);
    R.g0 = gk_up[(tid >> 6) * 256 + h * 64 + (tid & 63)]; R.g1 = gk_up[((tid + NT) >> 6) * 256 + h * 64 + (tid & 63)]; R.gb = gk_b[h * 64 + (tid & 63)];
    R.k = *(const v4u*)(pg + (size_t)j * NPG + 256 + h * 64 + d0);
    if (want_q) R.q = *(const v4u*)(pg + (size_t)j * NPG + h * 64 + d0);
    R.v0 = *(const v4u*)(pg + (size_t)j * NPG + 512 + h * 128 + e0); R.v1 = *(const v4u*)(pg + (size_t)j * NPG + 512 + h * 128 + e0 + 8);
}
__device__ __forceinline__ void gla_gates(const Ctx& C, const GlaRaw& R) {
    LAS float* GK = (LAS float*)(C.lds + GL_GK); LAS float* SEG = (LAS float*)(C.lds + GL_SEG); LAS bf16* Z = (LAS bf16*)(C.lds + GL_Z); LAS float* GUP = (LAS float*)(C.lds + GL_GUP);
    const int tid = C.tid;
    if (tid < 128) { const int t = tid >> 1, hh = tid & 1; *(LAS v4u*)(Z + t * 16 + hh * 8) = R.z; }
    GUP[tid] = R.g0; GUP[tid + NT] = R.g1;
    if (tid < 64) GUP[1024 + tid] = R.gb;
    __syncthreads();
    { const int t = tid >> 3, d0 = (tid & 7) * 8; float a[8];
#pragma unroll
      for (int q = 0; q < 8; ++q) a[q] = GUP[1024 + d0 + q];
#pragma unroll
      for (int i = 0; i < 16; ++i) { const float zv = bf2f(Z[t * 16 + i]);
#pragma unroll
          for (int q = 0; q < 8; ++q) a[q] += zv * GUP[i * 64 + d0 + q]; }
#pragma unroll
      for (int q = 0; q < 8; ++q) GK[t * 64 + d0 + q] = logsigmoidf_(a[q]) * (1.f / 16.f); }
    __syncthreads();
    { const int d = tid & 63, seg = tid >> 6; float run = 0.f;
#pragma unroll
      for (int q = 0; q < 8; ++q) { run += GK[(seg * 8 + q) * 64 + d]; GK[(seg * 8 + q) * 64 + d] = run; }
      SEG[seg * 64 + d] = run; }
    __syncthreads();
    { const int d = tid & 63, seg = tid >> 6; float off = 0.f;
      for (int s = 0; s < seg; ++s) off += SEG[s * 64 + d];
#pragma unroll
      for (int q = 0; q < 8; ++q) GK[(seg * 8 + q) * 64 + d] += off; }
    __syncthreads();
}
__device__ __forceinline__ void gla_stage_vt(const Ctx& C, const GlaRaw& R) {
    LAS bf16* VT = (LAS bf16*)(C.lds + GL_VT);
    const int j = C.tid >> 3, e0 = (C.tid & 7) * 16;
    const unsigned w[8] = {R.v0.x, R.v0.y, R.v0.z, R.v0.w, R.v1.x, R.v1.y, R.v1.z, R.v1.w};
#pragma unroll
    for (int q = 0; q < 8; ++q) { VT[(e0 + 2 * q) * GL_LD + j] = (bf16)(w[q] & 0xffffu); VT[(e0 + 2 * q + 1) * GL_LD + j] = (bf16)(w[q] >> 16); }
}

__device__ __forceinline__ void ph_gla_a(const Ctx& C, const bf16* PG, const float* gk_up, const float* gk_b, bf16* DS, float* GAM) {
    LAS float* GK = (LAS float*)(C.lds + GL_GK); LAS bf16* KT = (LAS bf16*)(C.lds + GL_I0); LAS bf16* VT = (LAS bf16*)(C.lds + GL_VT);
    for (int item = C.bid; item < 2048; item += C.nb) {
        const int bh = item >> 7, c = item & 127, b = bh >> 2, h = bh & 3;
        const size_t m0 = (size_t)b * T_ + c * 64;
        const bf16* pg = PG + m0 * NPG;
        GlaRaw R; gla_fetch(R, C, pg, gk_up, gk_b, h, false);
        gla_gates(C, R);
        { const int j = C.tid >> 3, d0 = (C.tid & 7) * 8;
          const unsigned w[4] = {R.k.x, R.k.y, R.k.z, R.k.w};
#pragma unroll
          for (int q = 0; q < 4; ++q) { const float k0 = bf2f((bf16)(w[q] & 0xffffu)), k1 = bf2f((bf16)(w[q] >> 16));
              const int d = d0 + 2 * q;
              KT[d * GL_LD + j] = (bf16)f2bf(k0 * __expf(GK[63 * 64 + d] - GK[j * 64 + d]));
              KT[(d + 1) * GL_LD + j] = (bf16)f2bf(k1 * __expf(GK[63 * 64 + d + 1] - GK[j * 64 + d + 1])); } }
        gla_stage_vt(C, R);
        if (C.tid < 64) GAM[(size_t)item * 64 + C.tid] = __expf(GK[63 * 64 + C.tid]);
        __syncthreads();
        { const int n0 = C.wave * 16, lane = C.lane, cc = lane & 15, g = lane >> 4;
          bf16* out = DS + (size_t)item * 8192 + (size_t)(n0 + cc) * 64 + 4 * g;
#pragma unroll
          for (int mt = 0; mt < 4; ++mt) { f32x4 acc = {0.f, 0.f, 0.f, 0.f}; acc = mm16(KT + mt * 16 * GL_LD, GL_LD, VT + n0 * GL_LD, GL_LD, 64, acc, lane);
              *(unsigned long long*)(out + mt * 16) = pack4(acc); } }
        __syncthreads();
    }
}
__device__ __forceinline__ void ph_gla_b(const Ctx& C, bf16* DS, const float* GAM) {
    for (int idx = C.bid * NT + C.tid; idx < 16 * 8192; idx += C.nb * NT) {
        const int bh = idx >> 13, ed = idx & 8191, d = ed & 63;
        bf16* p = DS + (size_t)bh * 128 * 8192 + ed; const float* gp = GAM + (size_t)bh * 128 * 64 + d;
        float S = 0.f;
        for (int c0 = 0; c0 < 128; c0 += 8) {
            float ds[8], gm[8];
#pragma unroll
            for (int i = 0; i < 8; ++i) { ds[i] = bf2f(p[(size_t)(c0 + i) * 8192]); gm[i] = gp[(c0 + i) * 64]; }
#pragma unroll
            for (int i = 0; i < 8; ++i) { const float gs = gm[i] * S; p[(size_t)(c0 + i) * 8192] = (bf16)f2bf(gs); S = gs + ds[i]; }
        }
    }
}
__device__ __forceinline__ void ph_gla_c(const Ctx& C, const bf16* PG, const float* gk_up, const float* gk_b, const float* norm_g, const bf16* DS, bf16* O) {
    LAS float* GK = (LAS float*)(C.lds + GL_GK); LAS bf16* QP = (LAS bf16*)(C.lds + GL_I0); LAS bf16* KM = (LAS bf16*)(C.lds + GL_I1); LAS bf16* AI = (LAS bf16*)(C.lds + GL_I2);
    LAS bf16* VT = (LAS bf16*)(C.lds + GL_VT); LAS float* SSQ = (LAS float*)(C.lds + GL_SSQ);
    for (int item = C.bid; item < 2048; item += C.nb) {
        const int bh = item >> 7, c = item & 127, b = bh >> 2, h = bh & 3;
        const size_t m0 = (size_t)b * T_ + c * 64;
        const bf16* pg = PG + m0 * NPG;
        GlaRaw R; gla_fetch(R, C, pg, gk_up, gk_b, h, true);
        s16x8 sfrag[4][2];
        { const int lane = C.lane, cc = lane & 15, g = lane >> 4, eh = C.wave >> 2; const bf16* Sg = DS + (size_t)item * 8192;
#pragma unroll
          for (int mt = 0; mt < 4; ++mt) { sfrag[mt][0] = *(const s16x8*)(Sg + (size_t)(eh * 64 + mt * 16 + cc) * 64 + 8 * g); sfrag[mt][1] = *(const s16x8*)(Sg + (size_t)(eh * 64 + mt * 16 + cc) * 64 + 32 + 8 * g); } }
        gla_gates(C, R);
        { const int j = C.tid >> 3, d0 = (C.tid & 7) * 8;
          const v4u qx = R.q, kx = R.k;
          const unsigned qw[4] = {qx.x, qx.y, qx.z, qx.w}, kw[4] = {kx.x, kx.y, kx.z, kx.w};
          unsigned qo[4], ko[4];
#pragma unroll
          for (int q = 0; q < 4; ++q) { const int d = d0 + 2 * q;
              const float e0 = GK[63 * 64 + d] - GK[j * 64 + d], e1 = GK[63 * 64 + d + 1] - GK[j * 64 + d + 1];
              const float q0 = 0.125f * bf2f((bf16)(qw[q] & 0xffffu)) * __expf(-e0), q1 = 0.125f * bf2f((bf16)(qw[q] >> 16)) * __expf(-e1);
              const float k0 = bf2f((bf16)(kw[q] & 0xffffu)) * __expf(e0), k1 = bf2f((bf16)(kw[q] >> 16)) * __expf(e1);
              qo[q] = pk2(q0, q1); ko[q] = pk2(k0, k1); }
          *(LAS v4u*)(QP + j * GL_LD + d0) = (v4u){qo[0], qo[1], qo[2], qo[3]}; *(LAS v4u*)(KM + j * GL_LD + d0) = (v4u){ko[0], ko[1], ko[2], ko[3]}; }
        gla_stage_vt(C, R);
        __syncthreads();
        { const int lane = C.lane, cc = lane & 15, g = lane >> 4, n0 = (C.wave >> 1) * 16;
#pragma unroll
          for (int q = 0; q < 2; ++q) { const int mt0 = ((C.wave & 1) * 2 + q) * 16; f32x4 acc = {0.f, 0.f, 0.f, 0.f};
              acc = mm16(KM + mt0 * GL_LD, GL_LD, QP + n0 * GL_LD, GL_LD, 64, acc, lane);
              const int i = n0 + cc, j = mt0 + 4 * g;
              acc.x = (j + 0 <= i) ? acc.x : 0.f; acc.y = (j + 1 <= i) ? acc.y : 0.f; acc.z = (j + 2 <= i) ? acc.z : 0.f; acc.w = (j + 3 <= i) ? acc.w : 0.f;
              *(LAS unsigned long long*)(AI + (n0 + cc) * GL_LD + mt0 + 4 * g) = pack4(acc); } }
        __syncthreads();
        { const int lane = C.lane, cc = lane & 15, g = lane >> 4, n0 = (C.wave & 3) * 16, eh = C.wave >> 2;
          f32x4 acc[4]; float ss = 0.f;
#pragma unroll
          for (int mt = 0; mt < 4; ++mt) { const int e0 = eh * 64 + mt * 16; acc[mt] = (f32x4){0.f, 0.f, 0.f, 0.f};
              { const LAS bf16* bp = QP + (n0 + cc) * GL_LD + 8 * g;
                acc[mt] = __builtin_amdgcn_mfma_f32_16x16x32_bf16(sfrag[mt][0], *(const LAS s16x8*)bp, acc[mt], 0, 0, 0); acc[mt] = __builtin_amdgcn_mfma_f32_16x16x32_bf16(sfrag[mt][1], *(const LAS s16x8*)(bp + 32), acc[mt], 0, 0, 0); }
              acc[mt] = mm16(VT + e0 * GL_LD, GL_LD, AI + n0 * GL_LD, GL_LD, 64, acc[mt], lane);
              ss += (acc[mt].x * acc[mt].x + acc[mt].y * acc[mt].y) + (acc[mt].z * acc[mt].z + acc[mt].w * acc[mt].w); }
          ss = xsum4(ss);
          if (g == 0) SSQ[eh * 64 + n0 + cc] = ss;
          __syncthreads();
          const float rstd = __builtin_amdgcn_rsqf((SSQ[n0 + cc] + SSQ[64 + n0 + cc]) * (1.f / 128.f) + 1e-6f);
          const size_t m = m0 + n0 + cc;
#pragma unroll
          for (int mt = 0; mt < 4; ++mt) { const int e = eh * 64 + mt * 16 + 4 * g;
              const unsigned long long gx = *(const unsigned long long*)(pg + (size_t)(n0 + cc) * NPG + 1024 + h * 128 + e);
              const f32x4 ng = *(const f32x4*)(norm_g + e);
              f32x4 o;
              o.x = acc[mt].x * rstd * ng.x * siluf_(bf2f((bf16)(gx & 0xffffu)));
              o.y = acc[mt].y * rstd * ng.y * siluf_(bf2f((bf16)((gx >> 16) & 0xffffu)));
              o.z = acc[mt].z * rstd * ng.z * siluf_(bf2f((bf16)((gx >> 32) & 0xffffu)));
              o.w = acc[mt].w * rstd * ng.w * siluf_(bf2f((bf16)(gx >> 48)));
              *(unsigned long long*)(O + m * D_ + h * 128 + e) = pack4(o); } }
        __syncthreads();
    }
}


struct RwkvW { const float *mu, *mu_vres, *w0, *a0, *v0, *k_k, *k_a, *r_k; const bf16 *wupT, *aupT, *gupT, *vupT; };
constexpr int RW_LD = 72, RW_XLD = 296;
constexpr int RW_R0 = 0;
constexpr int RW_SEG = 16384;
constexpr int RW_R1 = 36864;
constexpr int RW_R2 = RW_R1 + 27648;
constexpr int RW_R3 = RW_R2 + 9216;
constexpr int RW_R4 = RW_R3 + 27648;
constexpr int RW_TI = RW_R4 + 128 * RW_LD * 2;
constexpr int RW_MU = RW_TI + 2048;
constexpr int RW_X = RW_MU + 2048;
constexpr int RW_END = RW_X + 64 * RW_XLD * 2;
static_assert(RW_END <= MISC_OFF, "RWKV LDS map");

typedef short s16x4 __attribute__((ext_vector_type(4)));
__device__ __forceinline__ float tanh_fast(float x) { const float e = __expf(2.f * x); return 1.f - 2.f * __builtin_amdgcn_rcpf(e + 1.f); }
__device__ __forceinline__ float softplus_fast(float x) { return fmaxf(x, 0.f) + __logf(1.f + __expf(-fabsf(x))); }
__device__ __forceinline__ s16x4 cvt4(f32x4 v) { const unsigned long long p = pack4(v); return __builtin_bit_cast(s16x4, p); }
__device__ __forceinline__ void ld8f(const float* p, float (&o)[8]) { const f32x4 a = *(const f32x4*)p, b = *(const f32x4*)(p + 4); o[0] = a.x; o[1] = a.y; o[2] = a.z; o[3] = a.w; o[4] = b.x; o[5] = b.y; o[6] = b.z; o[7] = b.w; }
__device__ __forceinline__ float sum8(float v) { v += dpp_f<0xB1>(v); v += dpp_f<0x4E>(v); v += dpp_f<0x141>(v); return v; }
__device__ __forceinline__ void unpack8(const v4u x, float (&o)[8]) {
    o[0] = bf2f((bf16)(x.x & 0xffffu)); o[1] = bf2f((bf16)(x.x >> 16)); o[2] = bf2f((bf16)(x.y & 0xffffu)); o[3] = bf2f((bf16)(x.y >> 16));
    o[4] = bf2f((bf16)(x.z & 0xffffu)); o[5] = bf2f((bf16)(x.z >> 16)); o[6] = bf2f((bf16)(x.w & 0xffffu)); o[7] = bf2f((bf16)(x.w >> 16)); }
__device__ __forceinline__ v4u pack8(const float (&o)[8]) { return (v4u){pk2(o[0], o[1]), pk2(o[2], o[3]), pk2(o[4], o[5]), pk2(o[6], o[7])}; }
__device__ __forceinline__ f32x4 mm16_gb(const LAS bf16* A, int lda, const bf16* B, int ldb, int K, f32x4 acc, int lane) {
    const int r = lane & 15, g = lane >> 4;
    const LAS bf16* ap = A + r * lda + 8 * g; const bf16* bp = B + r * ldb + 8 * g;
    for (int k0 = 0; k0 < K; k0 += 32) { const s16x8 a = *(const LAS s16x8*)(ap + k0); const s16x8 b = *(const s16x8*)(bp + k0); acc = __builtin_amdgcn_mfma_f32_16x16x32_bf16(a, b, acc, 0, 0, 0); }
    return acc;
}

__device__ __forceinline__ void ph_norm_b(const Ctx& C, const bf16* x, const float* g, const float* sh, const float* sc, bf16* XB) {
    const int gw = C.bid * 8 + C.wave, NGW = C.nb * 8, lane = C.lane;
    float gv[2][8];
#pragma unroll
    for (int j = 0; j < 2; ++j) ld8f(g + 8 * lane + 512 * j, gv[j]);
    for (int m0 = gw; m0 < M_; m0 += 4 * NGW) {
        v4u raw[4][2];
#pragma unroll
        for (int r = 0; r < 4; ++r) { const int m = m0 + r * NGW; const v4u* xr = (const v4u*)(x + (size_t)(m < M_ ? m : m0) * D_) + lane; raw[r][0] = xr[0]; raw[r][1] = xr[64]; }
#pragma unroll
        for (int r = 0; r < 4; ++r) { const int m = m0 + r * NGW; if (m >= M_) break;
            const int b = m / T_;
            float v[2][8]; float s = 0.f;
#pragma unroll
            for (int j = 0; j < 2; ++j) { unpack8(raw[r][j], v[j]);
#pragma unroll
                for (int i = 0; i < 8; ++i) s += v[j][i] * v[j][i]; }
            const float rstd = __builtin_amdgcn_rsqf(wave_sum(s) * (1.f / D_) + 1e-6f);
            v4u* o = (v4u*)(XB + (size_t)m * D_) + lane;
#pragma unroll
            for (int j = 0; j < 2; ++j) { const int col = 8 * lane + 512 * j; float shv[8], scv[8], h[8];
                ld8f(sh + b * 6144 + col, shv); ld8f(sc + b * 6144 + col, scv);
#pragma unroll
                for (int i = 0; i < 8; ++i) h[i] = v[j][i] * rstd * gv[j][i] * (scv[i] + 1.f) + shv[i];
                o[64 * j] = pack8(h); } }
    }
}
__device__ __forceinline__ void ph_final_b(const Ctx& C, const bf16* x, const float* g, float* out, int m_lo, int m_hi, bf16* keep, int c_lo, int c_hi) {
    const int gw = C.bid * 8 + C.wave, NGW = C.nb * 8, lane = C.lane;
    for (int m = m_lo + gw; m < m_hi; m += NGW) {
        const v4u* xr = (const v4u*)(x + (size_t)m * D_) + lane;
        float v[2][8]; float s = 0.f;
#pragma unroll
        for (int j = 0; j < 2; ++j) { unpack8(xr[64 * j], v[j]);
#pragma unroll
            for (int i = 0; i < 8; ++i) s += v[j][i] * v[j][i]; }
        const float rstd = 1.f / sqrtf(wave_sum(s) * (1.f / D_) + 1e-6f);
#pragma unroll
        for (int j = 0; j < 2; ++j) { const int col = 8 * lane + 512 * j; float gv[8]; ld8f(g + col, gv);
            f32x4* o = (f32x4*)(out + (size_t)m * D_ + col);
            o[0] = (f32x4){v[j][0] * rstd * gv[0], v[j][1] * rstd * gv[1], v[j][2] * rstd * gv[2], v[j][3] * rstd * gv[3]};
            o[1] = (f32x4){v[j][4] * rstd * gv[4], v[j][5] * rstd * gv[5], v[j][6] * rstd * gv[6], v[j][7] * rstd * gv[7]}; }
    }
    for (int m = c_lo + gw; m < c_hi; m += NGW) { const v4u* xr = (const v4u*)(x + (size_t)m * D_) + lane; v4u* kr = (v4u*)(keep + (size_t)(m - c_lo) * D_) + lane; kr[0] = xr[0]; kr[64] = xr[64]; }
}
__device__ __forceinline__ int rofs(int row, int t) { return row * RW_LD + ((((t >> 3) + (row >> 3)) & 7) << 3) + (t & 7); }
__device__ __forceinline__ void ph_rwkv_a(const Ctx& C, const bf16* PR, const bf16* VL  , const RwkvW& W, int layer,
                                          bf16* PP, bf16* QQ, bf16* RH, bf16* YH, float* GAMC, float* RK, bf16* GG, bf16* VF, bool store_v = true) {
    LAS unsigned char* L = C.lds;
    LAS bf16* X = (LAS bf16*)(L + RW_X); LAS float* CUM = (LAS float*)(L + RW_R0); LAS float* SEG = (LAS float*)(L + RW_SEG);
    LAS bf16* NI = (LAS bf16*)(L + RW_R0), *AAK = NI + 64 * RW_LD, *ARB = AAK + 64 * RW_LD, *ARK = ARB + 64 * RW_LD;
    LAS bf16* PRE = (LAS bf16*)(L + RW_R1);
    LAS bf16* AT = (LAS bf16*)(L + RW_R1), *BT = AT + 64 * RW_LD, *KT = BT + 64 * RW_LD, *RT = (LAS bf16*)(L + RW_R2);
    LAS bf16* XB16 = (LAS bf16*)(L + RW_R1);
    LAS bf16* BHc = (LAS bf16*)(L + RW_R3), *KHc = BHc + 64 * RW_LD, *VTc = KHc + 64 * RW_LD;
    LAS bf16* XT = (LAS bf16*)(L + RW_R4); LAS bf16* TI = (LAS bf16*)(L + RW_TI);
    const int wave = C.wave;
    LAS float* MU = (LAS float*)(L + RW_MU);
    for (int i = C.tid; i < 288; i += NT) MU[i] = i < 256 ? W.mu[1536 + i] : (layer ? W.mu_vres[i - 256] : 0.f);
    __syncthreads();
    for (int bc = C.bid; bc < 512; bc += C.nb) {
        const int c = bc & 127, b = bc >> 7;
        const size_t m0 = (size_t)b * T_ + c * 64;
        { const int tid = C.tid;
          v4u xc[5], xp[5];
#pragma unroll
          for (int it = 0; it < 5; ++it) { const int idx = tid + it * NT; xc[it] = (v4u){0u, 0u, 0u, 0u}; xp[it] = xc[it];
            if (idx < 64 * 36) { const int t1 = idx / 36, q = idx % 36, col = q * 8; const size_t m1 = m0 + t1; const bool first1 = (c == 0 && t1 == 0);
                if (q < 32) { xc[it] = *(const v4u*)(PR + m1 * NPR + 1536 + col); if (!first1) xp[it] = *(const v4u*)(PR + (m1 - 1) * NPR + 1536 + col); }
                else if (layer) { xc[it] = *(const v4u*)(VL + m1 * NPG + 1552 + (col - 256)); if (!first1) xp[it] = *(const v4u*)(VL + (m1 - 1) * NPG + 1552 + (col - 256)); } } }
#pragma unroll
          for (int it = 0; it < 5; ++it) { const int idx = tid + it * NT;
            if (idx < 64 * 36) { const int t1 = idx / 36, q = idx % 36, col = q * 8;
                float cv[8], pv[8], mu[8]; unpack8(xc[it], cv); unpack8(xp[it], pv);
                { const f32x4 ma = *(const LAS f32x4*)(MU + col), mb = *(const LAS f32x4*)(MU + col + 4); mu[0] = ma.x; mu[1] = ma.y; mu[2] = ma.z; mu[3] = ma.w; mu[4] = mb.x; mu[5] = mb.y; mu[6] = mb.z; mu[7] = mb.w; }
#pragma unroll
                for (int i = 0; i < 8; ++i) { float p = cv[i] + (pv[i] - cv[i]) * mu[i]; if (q < 8) p = tanh_fast(p); else if (q >= 16 && q < 32) p = sigmoidf_(p); cv[i] = p; }
                *(LAS v4u*)(X + t1 * RW_XLD + col) = pack8(cv); } }
        }
        __syncthreads();
      v4u rcx, kcx, vcx, rpx, kpx, vpx, vfx;
#define RW_FETCH(hh) do { const int t_ = C.tid >> 3, ch_ = (hh) * 64 + (C.tid & 7) * 8; const size_t m_ = m0 + t_; const bool first_ = (c == 0 && t_ == 0); \
        rcx = *(const v4u*)(PR + m_ * NPR + ch_); kcx = *(const v4u*)(PR + m_ * NPR + 512 + ch_); vcx = *(const v4u*)(PR + m_ * NPR + 1024 + ch_); \
        rpx = (v4u){0u, 0u, 0u, 0u}; kpx = rpx; vpx = rpx; vfx = rpx; \
        if (!first_) { rpx = *(const v4u*)(PR + (m_ - 1) * NPR + ch_); kpx = *(const v4u*)(PR + (m_ - 1) * NPR + 512 + ch_); vpx = *(const v4u*)(PR + (m_ - 1) * NPR + 1024 + ch_); } \
        if (layer) vfx = *(const v4u*)(VF + m_ * 512 + ch_); } while (0)
      RW_FETCH(0);
#pragma unroll 1
      for (int h = 0; h < 8; ++h) {
        const int item = bc * 8 + h;
        int tid_ = C.tid; asm volatile("" : "+v"(tid_));
        const int tid = tid_, lane = tid & 63, cc = lane & 15, g = lane >> 4;
        const int t = tid >> 3, d0 = (tid & 7) * 8, ch = h * 64 + d0; const size_t m = m0 + t;
        {
            const int lsel = wave >> 1;
            const bf16* WT = lsel == 0 ? W.wupT : lsel == 1 ? W.aupT : lsel == 2 ? W.gupT : W.vupT;
            const int Kl = lsel == 2 ? 128 : lsel == 3 ? 32 : 64, xoff = lsel == 0 ? 0 : lsel == 1 ? 64 : lsel == 2 ? 128 : 256;
            LAS bf16* outp = PRE + lsel * 64 * RW_LD;
            const bool live = (lsel != 3 || layer);
#pragma unroll
            for (int mq = 0; mq < 2; ++mq) { const int mt = (wave & 1) * 2 + mq;
                s16x8 af[4];
                const bf16* ap = WT + (size_t)(h * 64 + mt * 16 + cc) * Kl + 8 * g;
#pragma unroll
                for (int ks = 0; ks < 4; ++ks) af[ks] = (live && ks * 32 < Kl) ? *(const s16x8*)(ap + ks * 32) : (s16x8){0, 0, 0, 0, 0, 0, 0, 0};
#pragma unroll
                for (int nt = 0; nt < 4; ++nt) { f32x4 acc = {0.f, 0.f, 0.f, 0.f};
                    const LAS bf16* bp = X + (nt * 16 + cc) * RW_XLD + xoff + 8 * g;
#pragma unroll
                    for (int ks = 0; ks < 4; ++ks) if (ks * 32 < Kl) { const s16x8 bb = *(const LAS s16x8*)(bp + ks * 32); acc = __builtin_amdgcn_mfma_f32_16x16x32_bf16(af[ks], bb, acc, 0, 0, 0); }
                    *(LAS unsigned long long*)(outp + (nt * 16 + cc) * RW_LD + mt * 16 + 4 * g) = pack4(acc); } }
        }
        __syncthreads();
        float av[8], bv[8], kv[8], rv[8], lw[8], vv[8];
        {
            float rc[8], rp[8], kc[8], kp[8], vc[8], vp[8], pw[8], pa[8], pg_[8], pvg[8];
            unpack8(rcx, rc); unpack8(kcx, kc); unpack8(vcx, vc); unpack8(rpx, rp); unpack8(kpx, kp); unpack8(vpx, vp);
            unpack8(*(const LAS v4u*)(PRE + (0 * 64 + t) * RW_LD + d0), pw); unpack8(*(const LAS v4u*)(PRE + (1 * 64 + t) * RW_LD + d0), pa);
            unpack8(*(const LAS v4u*)(PRE + (2 * 64 + t) * RW_LD + d0), pg_); unpack8(*(const LAS v4u*)(PRE + (3 * 64 + t) * RW_LD + d0), pvg);
            float vf[8]; unpack8(vfx, vf);
            float ssq = 0.f, rks = 0.f, asg[8], gg[8];
            float mur[8], muk[8], muv[8], w0c[8], a0c[8], v0c[8], kkc[8], kac[8], rkc[8];
            ld8f(W.mu + ch, mur); ld8f(W.mu + 512 + ch, muk); ld8f(W.mu + 1024 + ch, muv); ld8f(W.w0 + ch, w0c); ld8f(W.a0 + ch, a0c);
            ld8f(W.k_k + ch, kkc); ld8f(W.k_a + ch, kac); ld8f(W.r_k + ch, rkc);
            if (layer) ld8f(W.v0 + ch, v0c);
#pragma unroll
            for (int i = 0; i < 8; ++i) {
                const float r = rc[i] + (rp[i] - rc[i]) * mur[i], k = kc[i] + (kp[i] - kc[i]) * muk[i]; float v = vc[i] + (vp[i] - vc[i]) * muv[i];
                lw[i] = -0.6065306597f * sigmoidf_(w0c[i] + pw[i]);
                asg[i] = sigmoidf_(a0c[i] + pa[i]);
                if (layer) v = v + (vf[i] - v) * sigmoidf_(v0c[i] + pvg[i]);
                const float kk = k * kkc[i]; ssq += kk * kk;
                kv[i] = k * (1.f + (asg[i] - 1.f) * kac[i]); rv[i] = r; vv[i] = v; gg[i] = pg_[i]; av[i] = kk;
                rks += r * kv[i] * rkc[i];
            }
            ssq = sum8(ssq); rks = sum8(rks);
            const float inv = __builtin_amdgcn_rsqf(fmaxf(ssq, 1e-24f));
#pragma unroll
            for (int i = 0; i < 8; ++i) { const float kk = av[i] * inv; av[i] = -kk; bv[i] = kk * asg[i]; }
            if ((tid & 7) == 0) RK[m * 8 + h] = rks;
            *(v4u*)(GG + m * 512 + ch) = pack8(gg);
            if (store_v) *(v4u*)(VF + m * 512 + ch) = pack8(vv);
#pragma unroll
            for (int i = 0; i < 8; ++i) vv[i] = bf2f((bf16)f2bf(vv[i]));
        }
        __syncthreads();
#pragma unroll
        for (int i = 0; i < 8; ++i) CUM[t * 64 + d0 + i] = lw[i];
        __syncthreads();
        { const int d = tid & 63, seg = tid >> 6; float run = 0.f;
#pragma unroll
          for (int q = 0; q < 8; ++q) { run += CUM[(seg * 8 + q) * 64 + d]; CUM[(seg * 8 + q) * 64 + d] = run; }
          SEG[seg * 64 + d] = run; }
        __syncthreads();
        { const int d = tid & 63, seg = tid >> 6; float off = 0.f;
          for (int s = 0; s < seg; ++s) off += SEG[s * 64 + d];
#pragma unroll
          for (int q = 0; q < 8; ++q) CUM[(seg * 8 + q) * 64 + d] += off; }
        __syncthreads();
        {
            float at[8], bt[8], kt[8], rt[8];
#pragma unroll
            for (int i = 0; i < 8; ++i) { const float cu = CUM[t * 64 + d0 + i], cC = CUM[63 * 64 + d0 + i], en = __expf(-cu), ec = __expf(cC - cu);
                at[i] = av[i] * __expf(cu - lw[i]); bt[i] = bv[i] * en; kt[i] = kv[i] * en; rt[i] = rv[i] * __expf(cu);
                { const int ro = rofs(d0 + i, t); BHc[ro] = (bf16)f2bf(bv[i] * ec); KHc[ro] = (bf16)f2bf(kv[i] * ec); VTc[ro] = (bf16)f2bf(vv[i]); XT[ro] = (bf16)f2bf(at[i]); }
                if (t == 63) GAMC[(size_t)item * 64 + d0 + i] = __expf(cC); }
            *(LAS v4u*)(AT + t * RW_LD + d0) = pack8(at); *(LAS v4u*)(BT + t * RW_LD + d0) = pack8(bt); *(LAS v4u*)(KT + t * RW_LD + d0) = pack8(kt); *(LAS v4u*)(RT + t * RW_LD + d0) = pack8(rt);
        }
        if (h < 7) RW_FETCH(h + 1);
        __syncthreads();
        {
            const int msel = wave >> 1;
            const LAS bf16* As = (msel == 0 || msel == 2) ? BT : KT; const LAS bf16* Bs = (msel < 2) ? AT : RT;
            f32x4 accs[8];
#pragma unroll
            for (int q = 0; q < 8; ++q) { const int tile = (wave & 1) * 8 + q, mt = tile >> 2, nt = tile & 3; accs[q] = (f32x4){0.f, 0.f, 0.f, 0.f};
                accs[q] = mm16(As + mt * 16 * RW_LD, RW_LD, Bs + nt * 16 * RW_LD, RW_LD, 64, accs[q], lane);
                const int tt = nt * 16 + cc, s0 = mt * 16 + 4 * g, lim = (msel < 2) ? tt - 1 : tt;
                accs[q].x = (s0 + 0 <= lim) ? accs[q].x : 0.f; accs[q].y = (s0 + 1 <= lim) ? accs[q].y : 0.f; accs[q].z = (s0 + 2 <= lim) ? accs[q].z : 0.f; accs[q].w = (s0 + 3 <= lim) ? accs[q].w : 0.f; }
            __syncthreads();
            LAS bf16* outp = NI + msel * 64 * RW_LD;
#pragma unroll
            for (int q = 0; q < 8; ++q) { const int tile = (wave & 1) * 8 + q, mt = tile >> 2, nt = tile & 3;
                *(LAS unsigned long long*)(outp + (nt * 16 + cc) * RW_LD + mt * 16 + 4 * g) = pack4(accs[q]); }
        }
        __syncthreads();
        if (wave == 0) {
            const int blk = lane >> 4, col = lane & 15; float x[16];
#pragma unroll
            for (int tt = 0; tt < 16; ++tt) { float nr[16]; { float lo[8], hi[8]; unpack8(*(const LAS v4u*)(NI + (16 * blk + tt) * RW_LD + 16 * blk), lo); unpack8(*(const LAS v4u*)(NI + (16 * blk + tt) * RW_LD + 16 * blk + 8), hi);
#pragma unroll
                    for (int q = 0; q < 8; ++q) { nr[q] = lo[q]; nr[8 + q] = hi[q]; } }
                float a = (tt == col) ? 1.f : 0.f;
#pragma unroll
                for (int q = 0; q < tt; ++q) a += nr[q] * x[q];
                x[tt] = a; TI[(blk * 16 + tt) * 16 + col] = (bf16)f2bf(a); }
        } else {
            for (int tile = wave - 1; tile < 16; tile += 7) { const int mt = tile >> 2, nt = tile & 3;
                f32x4 acc = {0.f, 0.f, 0.f, 0.f};
#pragma unroll
                for (int k = 0; k < 2; ++k) { const s16x8 a = *(const LAS s16x8*)(AAK + (mt * 16 + cc) * RW_LD + 32 * k + 8 * g), bb = *(const LAS s16x8*)(VTc + rofs(nt * 16 + cc, 32 * k + 8 * g)); acc = __builtin_amdgcn_mfma_f32_16x16x32_bf16(a, bb, acc, 0, 0, 0); }
                *(LAS unsigned long long*)(XT + rofs(64 + nt * 16 + cc, mt * 16 + 4 * g)) = pack4(acc); }
        }
        __syncthreads();
        {
            s16x4 xb[4];
#pragma unroll
            for (int i = 0; i < 4; ++i) {
                f32x4 acc; { const unsigned long long xr = *(const LAS unsigned long long*)(XT + rofs(wave * 16 + cc, 16 * i + 4 * g));
                    acc.x = bf2f((bf16)(xr & 0xffffu)); acc.y = bf2f((bf16)((xr >> 16) & 0xffffu)); acc.z = bf2f((bf16)((xr >> 32) & 0xffffu)); acc.w = bf2f((bf16)(xr >> 48)); }
#pragma unroll
                for (int k = 0; k < i; ++k) { const s16x4 a = *(const LAS s16x4*)(NI + (16 * i + cc) * RW_LD + 16 * k + 4 * g); acc = __builtin_amdgcn_mfma_f32_16x16x16bf16_1k(a, xb[k], acc, 0, 0, 0); }
                const s16x4 yb = cvt4(acc), ta = *(const LAS s16x4*)(TI + (i * 16 + cc) * 16 + 4 * g);
                const f32x4 xi = __builtin_amdgcn_mfma_f32_16x16x16bf16_1k(ta, yb, (f32x4){0.f, 0.f, 0.f, 0.f}, 0, 0, 0);
                xb[i] = cvt4(xi);
            }
            __syncthreads();
#pragma unroll
            for (int i = 0; i < 4; ++i) *(LAS s16x4*)(XB16 + (wave * 16 + cc) * RW_LD + 16 * i + 4 * g) = xb[i];
        }
        __syncthreads();
        {
            const int osel = wave >> 1, mt0 = (wave & 1) * 2; const size_t ob = (size_t)item * 4096;
            const LAS bf16* A1 = osel == 0 ? XB16 : osel == 1 ? BHc : osel == 2 ? XB16 : XB16 + 64 * RW_LD;
            const LAS bf16* B1 = osel == 0 ? BHc : osel == 1 ? XB16 + 64 * RW_LD : ARB;
            const LAS bf16* A2 = osel == 1 ? KHc : VTc; const LAS bf16* B2 = osel == 1 ? VTc : ARK;
            const bool rA1 = osel == 1, rB1 = osel == 0, rA2 = true, rB2 = osel == 1;
#define RW_FO(rot, row, k) ((rot) ? rofs((row), 32 * (k) + 8 * g) : (row) * RW_LD + 32 * (k) + 8 * g)
            bf16* OUT = osel == 0 ? PP : osel == 1 ? QQ : osel == 2 ? RH : YH;
            f32x4 acc[2][4];
#pragma unroll
            for (int mq = 0; mq < 2; ++mq)
#pragma unroll
                for (int nt = 0; nt < 4; ++nt) acc[mq][nt] = (f32x4){0.f, 0.f, 0.f, 0.f};
            { s16x8 af[2][2], bfm[4][2];
#pragma unroll
              for (int mq = 0; mq < 2; ++mq)
#pragma unroll
                  for (int k = 0; k < 2; ++k) af[mq][k] = *(const LAS s16x8*)(A1 + RW_FO(rA1, (mt0 + mq) * 16 + cc, k));
#pragma unroll
              for (int nt = 0; nt < 4; ++nt)
#pragma unroll
                  for (int k = 0; k < 2; ++k) bfm[nt][k] = *(const LAS s16x8*)(B1 + RW_FO(rB1, nt * 16 + cc, k));
#pragma unroll
              for (int mq = 0; mq < 2; ++mq)
#pragma unroll
                  for (int nt = 0; nt < 4; ++nt) { acc[mq][nt] = __builtin_amdgcn_mfma_f32_16x16x32_bf16(af[mq][0], bfm[nt][0], acc[mq][nt], 0, 0, 0); acc[mq][nt] = __builtin_amdgcn_mfma_f32_16x16x32_bf16(af[mq][1], bfm[nt][1], acc[mq][nt], 0, 0, 0); } }
            if (osel & 1) { s16x8 af[2][2], bfm[4][2];
#pragma unroll
              for (int mq = 0; mq < 2; ++mq)
#pragma unroll
                  for (int k = 0; k < 2; ++k) af[mq][k] = *(const LAS s16x8*)(A2 + RW_FO(rA2, (mt0 + mq) * 16 + cc, k));
#pragma unroll
              for (int nt = 0; nt < 4; ++nt)
#pragma unroll
                  for (int k = 0; k < 2; ++k) bfm[nt][k] = *(const LAS s16x8*)(B2 + RW_FO(rB2, nt * 16 + cc, k));
#pragma unroll
              for (int mq = 0; mq < 2; ++mq)
#pragma unroll
                  for (int nt = 0; nt < 4; ++nt) { acc[mq][nt] = __builtin_amdgcn_mfma_f32_16x16x32_bf16(af[mq][0], bfm[nt][0], acc[mq][nt], 0, 0, 0); acc[mq][nt] = __builtin_amdgcn_mfma_f32_16x16x32_bf16(af[mq][1], bfm[nt][1], acc[mq][nt], 0, 0, 0); } }
#pragma unroll
            for (int mq = 0; mq < 2; ++mq)
#pragma unroll
                for (int nt = 0; nt < 4; ++nt) { f32x4 a = acc[mq][nt];
                    if (osel == 2) { const unsigned long long rr = *(const LAS unsigned long long*)(RT + (nt * 16 + cc) * RW_LD + (mt0 + mq) * 16 + 4 * g);
                        a.x += bf2f((bf16)(rr & 0xffffu)); a.y += bf2f((bf16)((rr >> 16) & 0xffffu)); a.z += bf2f((bf16)((rr >> 32) & 0xffffu)); a.w += bf2f((bf16)(rr >> 48)); }
                    *(unsigned long long*)(OUT + ob + (nt * 16 + cc) * 64 + (mt0 + mq) * 16 + 4 * g) = pack4(a); }
        }
        __syncthreads();
      }
    }
}

#undef RW_FETCH
#undef RW_FO
constexpr int CH_R = 6, CH_SLOT = 9216 + 9216 + 256;
constexpr int CH_RING = 0, CH_SI = CH_R * CH_SLOT, CH_FLAGS = CH_SI + 4 * 2304;
static_assert(CH_FLAGS + 64 <= MISC_OFF, "chain LDS map");
struct ChainRegs { v4u p[8], q[8]; f32x4 gm; };
__device__ __forceinline__ void chain_fetch(ChainRegs& o, const bf16* PP, const bf16* QQ, const float* GAMC, int item, int lane) {
    const size_t ob = (size_t)item * 4096;
#pragma unroll
    for (int i = 0; i < 8; ++i) { o.p[i] = *(const v4u*)(PP + ob + (size_t)(i * 64 + lane) * 8); o.q[i] = *(const v4u*)(QQ + ob + (size_t)(i * 64 + lane) * 8); }
    o.gm = *(const f32x4*)(GAMC + (size_t)item * 64 + (lane & 15) * 4);
}
__device__ __forceinline__ void chain_commit(const ChainRegs& o, LAS unsigned char* L, int c, int lane) {
    volatile LAS unsigned* flags = (volatile LAS unsigned*)(L + CH_FLAGS);
    const int slot = c % CH_R;
    if (c >= CH_R) { const unsigned need = (unsigned)(c - CH_R + 1);
        for (;;) { const unsigned m0 = flags[CH_R + 0], m1 = flags[CH_R + 1], m2 = flags[CH_R + 2], m3 = flags[CH_R + 3];
            if (m0 >= need && m1 >= need && m2 >= need && m3 >= need) break; __builtin_amdgcn_s_sleep(1); } }
    asm volatile("" ::: "memory");
    LAS unsigned char* sl = L + CH_RING + slot * CH_SLOT;
#pragma unroll
    for (int i = 0; i < 8; ++i) { const int idx = i * 64 + lane, row = idx >> 3, c16 = idx & 7;
        *(LAS v4u*)(sl + row * 144 + c16 * 16) = o.p[i]; *(LAS v4u*)(sl + 9216 + row * 144 + c16 * 16) = o.q[i]; }
    if (lane < 16) *(LAS f32x4*)(sl + 18432 + lane * 16) = o.gm;
    asm volatile("s_waitcnt lgkmcnt(0)" ::: "memory");
    if (lane == 0) flags[slot] = (unsigned)(c + 1);
}
__device__ __forceinline__ void ph_rwkv_b(const Ctx& C, int bh  , const bf16* PP, const bf16* QQ, const float* GAMC, bf16* S0) {
    const int lane = C.lane, wave = C.wave, cc = lane & 15, g = lane >> 4, b = bh >> 3, h = bh & 7;
    LAS unsigned char* L = C.lds;
    volatile LAS unsigned* flags = (volatile LAS unsigned*)(L + CH_FLAGS);
    if (C.tid < 16) flags[C.tid] = 0u;
    __syncthreads();
    if (wave >= 4) {
        const int j = wave - 4;
        ChainRegs A, B;
        int lc = j;
        chain_fetch(A, PP, QQ, GAMC, (b * 128 + lc) * 8 + h, lane);
        for (;;) {
            if (lc + 4 < 128) chain_fetch(B, PP, QQ, GAMC, (b * 128 + lc + 4) * 8 + h, lane);
            chain_commit(A, L, lc, lane);
            lc += 4; if (lc >= 128) break;
            if (lc + 4 < 128) chain_fetch(A, PP, QQ, GAMC, (b * 128 + lc + 4) * 8 + h, lane);
            chain_commit(B, L, lc, lane);
            lc += 4; if (lc >= 128) break;
        }
    } else {
        const int vt = wave;
        LAS bf16* SI = (LAS bf16*)(L + CH_SI + vt * 2304);
        f32x4 st[4];
#pragma unroll
        for (int mt = 0; mt < 4; ++mt) st[mt] = (f32x4){0.f, 0.f, 0.f, 0.f};
        for (int c = 0; c < 128; ++c) {
            const int item = (b * 128 + c) * 8 + h, slot = c % CH_R; const size_t ob = (size_t)item * 4096;
#pragma unroll
            for (int mt = 0; mt < 4; ++mt) { const unsigned long long pk = pack4(st[mt]);
                *(unsigned long long*)(S0 + ob + (vt * 16 + cc) * 64 + mt * 16 + 4 * g) = pk; *(LAS unsigned long long*)(SI + cc * RW_LD + mt * 16 + 4 * g) = pk; }
            while (flags[slot] < (unsigned)(c + 1)) __builtin_amdgcn_s_sleep(1);
            asm volatile("s_waitcnt lgkmcnt(0)" ::: "memory");
            const LAS unsigned char* sl = L + CH_RING + slot * CH_SLOT;
            const LAS bf16* Pi = (const LAS bf16*)sl; const LAS bf16* Qi = (const LAS bf16*)(sl + 9216); const LAS float* Gi = (const LAS float*)(sl + 18432);
            const s16x8 b0 = *(const LAS s16x8*)(SI + cc * RW_LD + 8 * g), b1 = *(const LAS s16x8*)(SI + cc * RW_LD + 32 + 8 * g);
#pragma unroll
            for (int mt = 0; mt < 4; ++mt) {
                const f32x4 gm = *(const LAS f32x4*)(Gi + mt * 16 + 4 * g);
                const unsigned long long qq = *(const LAS unsigned long long*)(Qi + (vt * 16 + cc) * RW_LD + mt * 16 + 4 * g);
                const s16x8 a0 = *(const LAS s16x8*)(Pi + (mt * 16 + cc) * RW_LD + 8 * g), a1 = *(const LAS s16x8*)(Pi + (mt * 16 + cc) * RW_LD + 32 + 8 * g);
                f32x4 acc; acc.x = gm.x * st[mt].x + bf2f((bf16)(qq & 0xffffu)); acc.y = gm.y * st[mt].y + bf2f((bf16)((qq >> 16) & 0xffffu));
                acc.z = gm.z * st[mt].z + bf2f((bf16)((qq >> 32) & 0xffffu)); acc.w = gm.w * st[mt].w + bf2f((bf16)(qq >> 48));
                acc = __builtin_amdgcn_mfma_f32_16x16x32_bf16(a0, b0, acc, 0, 0, 0); acc = __builtin_amdgcn_mfma_f32_16x16x32_bf16(a1, b1, acc, 0, 0, 0);
                st[mt] = acc; }
            asm volatile("s_waitcnt lgkmcnt(0)" ::: "memory");
            if (lane == 0) flags[CH_R + vt] = (unsigned)(c + 1);
        }
    }
    __syncthreads();
}

__device__ __forceinline__ void ph_rwkv_c(const Ctx& C, const bf16* S0, const bf16* RH, const bf16* YH, const float* RK, const bf16* GG, const bf16* VF,
                                          const float* gn_g, const float* gn_b, bf16* O) {
    const int lane = C.lane, cc = lane & 15, g = lane >> 4;
    for (int item = C.bid * 8 + C.wave; item < 4096; item += C.nb * 8) {
        const int h = item & 7, c = (item >> 3) & 127, b = item >> 10; const size_t m0 = (size_t)b * T_ + c * 64, ob = (size_t)item * 4096;
        s16x8 af[4][2], bfr[4][2];
#pragma unroll
        for (int q = 0; q < 4; ++q)
#pragma unroll
            for (int k = 0; k < 2; ++k) { af[q][k] = *(const s16x8*)(S0 + ob + (q * 16 + cc) * 64 + k * 32 + 8 * g); bfr[q][k] = *(const s16x8*)(RH + ob + (q * 16 + cc) * 64 + k * 32 + 8 * g); }
#pragma unroll
        for (int nt = 0; nt < 4; ++nt) {
            const size_t m = m0 + nt * 16 + cc;
            f32x4 y[4]; float s1 = 0.f;
#pragma unroll
            for (int mt = 0; mt < 4; ++mt) { const unsigned long long yh = *(const unsigned long long*)(YH + ob + (nt * 16 + cc) * 64 + mt * 16 + 4 * g);
                f32x4 acc; acc.x = bf2f((bf16)(yh & 0xffffu)); acc.y = bf2f((bf16)((yh >> 16) & 0xffffu)); acc.z = bf2f((bf16)((yh >> 32) & 0xffffu)); acc.w = bf2f((bf16)(yh >> 48));
                acc = __builtin_amdgcn_mfma_f32_16x16x32_bf16(af[mt][0], bfr[nt][0], acc, 0, 0, 0); acc = __builtin_amdgcn_mfma_f32_16x16x32_bf16(af[mt][1], bfr[nt][1], acc, 0, 0, 0);
                y[mt] = acc; s1 += (acc.x + acc.y) + (acc.z + acc.w); }
            s1 = xsum4(s1);
            const float mean = s1 * (1.f / 64.f); float s2 = 0.f;
#pragma unroll
            for (int mt = 0; mt < 4; ++mt) { y[mt] = y[mt] - mean; s2 += (y[mt].x * y[mt].x + y[mt].y * y[mt].y) + (y[mt].z * y[mt].z + y[mt].w * y[mt].w); }
            s2 = xsum4(s2);
            const float rstd = __builtin_amdgcn_rsqf(s2 * (1.f / 64.f) + 64e-5f), rk = RK[m * 8 + h];
#pragma unroll
            for (int mt = 0; mt < 4; ++mt) { const int v = h * 64 + mt * 16 + 4 * g;
                const f32x4 gg4 = *(const f32x4*)(gn_g + v), gb4 = *(const f32x4*)(gn_b + v);
                const unsigned long long vx = *(const unsigned long long*)(VF + m * 512 + v), gx = *(const unsigned long long*)(GG + m * 512 + v);
                f32x4 o;
                o.x = (y[mt].x * rstd * gg4.x + gb4.x + rk * bf2f((bf16)(vx & 0xffffu))) * bf2f((bf16)(gx & 0xffffu));
                o.y = (y[mt].y * rstd * gg4.y + gb4.y + rk * bf2f((bf16)((vx >> 16) & 0xffffu))) * bf2f((bf16)((gx >> 16) & 0xffffu));
                o.z = (y[mt].z * rstd * gg4.z + gb4.z + rk * bf2f((bf16)((vx >> 32) & 0xffffu))) * bf2f((bf16)((gx >> 32) & 0xffffu));
                o.w = (y[mt].w * rstd * gg4.w + gb4.w + rk * bf2f((bf16)(vx >> 48))) * bf2f((bf16)(gx >> 48));
                *(unsigned long long*)(O + m * D_ + 512 + v) = pack4(o); }
        }
    }
}

__device__ __forceinline__ void ph_convfix(const Ctx& C, const float* HALO, const float* FIXU, const float* cw, const float* cb, bf16* ACT) {
    for (int idx = C.bid * NT + C.tid; idx < 128 * 22 * 2 * 128; idx += C.nb * NT) {
        const int j = idx & 127, rr = (idx >> 7) & 1, tile = idx >> 8, pm = tile / 22, pn = tile % 22;
        const bool seq0 = (pm & 31) == 0;
        const float* fx = FIXU + (size_t)tile * 512; const float* hl = HALO + (size_t)(tile - 22) * 512;
        const float u0g = fx[rr * 256 + j], u0v = fx[rr * 256 + 128 + j];
        float u1g, u1v, u2g, u2v;
        if (rr == 0) { u1g = seq0 ? 0.f : hl[256 + j]; u1v = seq0 ? 0.f : hl[256 + 128 + j]; u2g = seq0 ? 0.f : hl[j]; u2v = seq0 ? 0.f : hl[128 + j]; }
        else { u1g = fx[j]; u1v = fx[128 + j]; u2g = seq0 ? 0.f : hl[256 + j]; u2v = seq0 ? 0.f : hl[256 + 128 + j]; }
        const int jg = pn * 128 + j, jv = DFF + jg;
        const float gc = cb[jg] + cw[jg] * u2g + cw[NUP + jg] * u1g + cw[2 * NUP + jg] * u0g, vc = cb[jv] + cw[jv] * u2v + cw[NUP + jv] * u1v + cw[2 * NUP + jv] * u0v;
        ACT[(size_t)(pm * 256 + rr) * DFF + jg] = (bf16)f2bf(siluf_(gc) * vc);
    }
}
}

namespace pg8 {
struct EpiRes {
    static constexpr bool PERM = false, AFTER_DRAIN = false;
    const float* base; float* out; const float* gate; int gstride;
    __device__ __forceinline__ void operator()(const f32x4 (&acc)[2][2][4][2], const Unit& u, int wr, int wc, int fr, int fq) const {
        const int b = (u.pm * BM) / 8192; const float* gp = gate + (size_t)b * gstride;
        const int col0 = u.pn * BM + wc * 32 + 4 * fq;
        f32x4 gv[2][2];
#pragma unroll
        for (int bj = 0; bj < 2; ++bj)
#pragma unroll
            for (int n = 0; n < 2; ++n) gv[bj][n] = *(const f32x4*)(gp + col0 + bj * HALF + n * 16);
#pragma unroll
        for (int ai = 0; ai < 2; ++ai)
#pragma unroll
            for (int m = 0; m < 4; ++m) { const size_t off = (size_t)(u.pm * BM + ai * HALF + wr * 64 + m * 16 + fr) * 1024 + col0;
                f32x4 bs[2][2];
#pragma unroll
                for (int bj = 0; bj < 2; ++bj)
#pragma unroll
                    for (int n = 0; n < 2; ++n) bs[bj][n] = *(const f32x4*)(base + off + bj * HALF + n * 16);
#pragma unroll
                for (int bj = 0; bj < 2; ++bj)
#pragma unroll
                    for (int n = 0; n < 2; ++n) *(f32x4*)(out + off + bj * HALF + n * 16) = bs[bj][n] + gv[bj][n] * acc[ai][bj][m][n]; }
    }
};

template <bool BASE32> struct EpiResB {
    static constexpr bool PERM = true, AFTER_DRAIN = false;
    const float* base32; bf16_t* R; const float* gate; int gstride;
    __device__ __forceinline__ void operator()(const f32x4 (&acc)[2][2][4][2], const Unit& u, int wr, int wc, int fr, int fq) const {
        const int b = u.pm >> 5; const float* gp = gate + (size_t)b * gstride;
        const int col0 = u.pn * BM + wc * 32 + 8 * fq;
        f32x4 gv[2][2];
#pragma unroll
        for (int bj = 0; bj < 2; ++bj)
#pragma unroll
            for (int n = 0; n < 2; ++n) gv[bj][n] = *(const f32x4*)(gp + col0 + bj * HALF + n * 4);
#pragma unroll
        for (int ai = 0; ai < 2; ++ai)
#pragma unroll
            for (int m = 0; m < 4; ++m) { const size_t off = (size_t)(u.pm * BM + ai * HALF + wr * 64 + m * 16 + fr) * 1024 + col0;
                f32x4 bs[2][2];
#pragma unroll
                for (int bj = 0; bj < 2; ++bj) {
                    if (BASE32) { bs[bj][0] = *(const f32x4*)(base32 + off + bj * HALF); bs[bj][1] = *(const f32x4*)(base32 + off + bj * HALF + 4); }
                    else { const u32x4 r = *(const u32x4*)(R + off + bj * HALF);
                        bs[bj][0] = (f32x4){__builtin_bit_cast(float, r.x << 16), __builtin_bit_cast(float, r.x & 0xffff0000u), __builtin_bit_cast(float, r.y << 16), __builtin_bit_cast(float, r.y & 0xffff0000u)};
                        bs[bj][1] = (f32x4){__builtin_bit_cast(float, r.z << 16), __builtin_bit_cast(float, r.z & 0xffff0000u), __builtin_bit_cast(float, r.w << 16), __builtin_bit_cast(float, r.w & 0xffff0000u)}; } }
#pragma unroll
                for (int bj = 0; bj < 2; ++bj) { const f32x4 o0 = bs[bj][0] + gv[bj][0] * acc[ai][bj][m][0], o1 = bs[bj][1] + gv[bj][1] * acc[ai][bj][m][1];
                    u32x4 w; w.x = cvt_pk_bf16(o0.x, o0.y); w.y = cvt_pk_bf16(o0.z, o0.w); w.z = cvt_pk_bf16(o1.x, o1.y); w.w = cvt_pk_bf16(o1.z, o1.w);
                    *(u32x4*)(R + off + bj * HALF) = w; } }
    }
};
struct EpiConv {
    static constexpr bool PERM = true, AFTER_DRAIN = false;
    bf16_t* ACT; const float* cw; const float* cb; float* HALO; float* FIXU; PG8_LAS float* EX; int nN;
    template <int CTRL> static __device__ __forceinline__ float ror1(float x) { return __builtin_bit_cast(float, __builtin_amdgcn_mov_dpp(__builtin_bit_cast(int, x), CTRL, 0xf, 0xf, true)); }
    template <int CTRL> static __device__ __forceinline__ f32x4 ror4(f32x4 x) { return (f32x4){ror1<CTRL>(x.x), ror1<CTRL>(x.y), ror1<CTRL>(x.z), ror1<CTRL>(x.w)}; }
    template <int CTRL> static __device__ __forceinline__ float shr1(float old, float x) { return __builtin_bit_cast(float, __builtin_amdgcn_update_dpp(__builtin_bit_cast(int, old), __builtin_bit_cast(int, x), CTRL, 0xf, 0xf, false)); }
    template <int CTRL> static __device__ __forceinline__ f32x4 shr4(f32x4 o, f32x4 x) { return (f32x4){shr1<CTRL>(o.x, x.x), shr1<CTRL>(o.y, x.y), shr1<CTRL>(o.z, x.z), shr1<CTRL>(o.w, x.w)}; }
    __device__ __forceinline__ void operator()(const f32x4 (&acc)[2][2][4][2], const Unit& u, int wr, int wc, int fr, int fq) const {
        const int colw = wc * 32 + 8 * fq, tile = u.pm * nN + u.pn;
        if (fr >= 14) {
#pragma unroll
            for (int ai = 0; ai < 2; ++ai)
#pragma unroll
                for (int bj = 0; bj < 2; ++bj)
#pragma unroll
                    for (int n = 0; n < 2; ++n) { *(PG8_LAS f32x4*)(EX + ((ai * 2 + wr) * 2 + (fr - 14)) * 256 + bj * 128 + colw + 4 * n) = acc[ai][bj][3][n];
                        if (ai == 1 && wr == 1) *(f32x4*)(HALO + ((size_t)tile * 2 + (fr - 14)) * 256 + bj * 128 + colw + 4 * n) = acc[1][bj][3][n]; }
        }
        if (fr < 2 && wr == 0) {
#pragma unroll
            for (int bj = 0; bj < 2; ++bj)
#pragma unroll
                for (int n = 0; n < 2; ++n) *(f32x4*)(FIXU + ((size_t)tile * 2 + fr) * 256 + bj * 128 + colw + 4 * n) = acc[0][bj][0][n];
        }
        asm volatile("s_waitcnt lgkmcnt(0)" ::: "memory"); __builtin_amdgcn_s_barrier(); asm volatile("" ::: "memory");
#pragma unroll
        for (int n = 0; n < 2; ++n) {
            const int jg = u.pn * 128 + colw + 4 * n, jv = 2816 + jg;
            f32x4 cw0[2], cw1[2], cw2[2], cbb[2];
            cw0[0] = *(const f32x4*)(cw + jg); cw1[0] = *(const f32x4*)(cw + 5632 + jg); cw2[0] = *(const f32x4*)(cw + 2 * 5632 + jg); cbb[0] = *(const f32x4*)(cb + jg);
            cw0[1] = *(const f32x4*)(cw + jv); cw1[1] = *(const f32x4*)(cw + 5632 + jv); cw2[1] = *(const f32x4*)(cw + 2 * 5632 + jv); cbb[1] = *(const f32x4*)(cb + jv);
#pragma unroll
            for (int ai = 0; ai < 2; ++ai) {
                const int src = ai * 2 + wr - 1;
                f32x4 res[2][4];
#pragma unroll
                for (int bj = 0; bj < 2; ++bj) {
                    f32x4 o1 = {0.f, 0.f, 0.f, 0.f}, o2 = o1;
                    if (src >= 0) { const f32x4 e14 = *(const PG8_LAS f32x4*)(EX + (src * 2 + 0) * 256 + bj * 128 + colw + 4 * n), e15 = *(const PG8_LAS f32x4*)(EX + (src * 2 + 1) * 256 + bj * 128 + colw + 4 * n);
                        o1 = e15; o2 = (fr == 0) ? e14 : e15; }
#pragma unroll
                    for (int m = 0; m < 4; ++m) {
                        const f32x4 x = acc[ai][bj][m][n];
                        const f32x4 x1 = shr4<0x111>(o1, x), x2 = shr4<0x112>(o2, x);
                        res[bj][m] = cbb[bj] + cw0[bj] * x2 + cw1[bj] * x1 + cw2[bj] * x;
                        if (m < 3) { o1 = ror4<0x121>(x); o2 = ror4<0x122>(x); }
                    }
                }
#pragma unroll
                for (int m = 0; m < 4; ++m) {
                    const f32x4 gc = res[0][m], vc = res[1][m];
                    f32x4 o;
                    o.x = gc.x * __builtin_amdgcn_rcpf(1.f + __expf(-gc.x)) * vc.x; o.y = gc.y * __builtin_amdgcn_rcpf(1.f + __expf(-gc.y)) * vc.y;
                    o.z = gc.z * __builtin_amdgcn_rcpf(1.f + __expf(-gc.z)) * vc.z; o.w = gc.w * __builtin_amdgcn_rcpf(1.f + __expf(-gc.w)) * vc.w;
                    typedef unsigned u32x2 __attribute__((ext_vector_type(2)));
                    u32x2 w; w.x = cvt_pk_bf16(o.x, o.y); w.y = cvt_pk_bf16(o.z, o.w);
                    *(u32x2*)(ACT + (size_t)(u.pm * BM + ai * HALF + wr * 64 + m * 16 + fr) * 2816 + u.pn * 128 + colw + 4 * n) = w;
                }
            }
        }
    }
};
}

namespace hy {
struct Args { const float* in[31]; float* out; unsigned char* ws; };
__global__ void __launch_bounds__(NT, 2) hy_fwd(Args A) {
    extern __shared__ __attribute__((aligned(16))) unsigned char lds_raw[];
    Ctx C; C.bid = blockIdx.x; C.nb = gridDim.x; C.tid = threadIdx.x; C.lane = C.tid & 63; C.wave = __builtin_amdgcn_readfirstlane(C.tid >> 6); C.lds = (LAS unsigned char*)lds_raw;
    volatile LAS unsigned* MISC = (volatile LAS unsigned*)(C.lds + MISC_OFF);
    for (int u = C.tid; u < (LDS_BYTES - MISC_OFF) / 4; u += NT) ((LAS unsigned*)(C.lds + MISC_OFF))[u] = 0u;
    __syncthreads();
    unsigned char* ws = A.ws;
    const int wave0 = __builtin_amdgcn_readfirstlane(threadIdx.x >> 6);
    (void)xcd_barrier_post((unsigned*)(ws + WS_CTL) + CW_BAR, MISC + 8);
#define PHASE_BEGIN() do { int t_ = wave0 * 64 + lane_now(); int b_ = blockIdx.x; asm volatile("" : "+s"(b_)); \
    C.tid = t_; C.lane = t_ & 63; C.wave = __builtin_amdgcn_readfirstlane(t_ >> 6); C.bid = b_; } while (0)
#ifdef HY_DIAG
    unsigned long long ts_last = __builtin_amdgcn_s_memrealtime(); float tacc[10] = {0.f, 0.f, 0.f, 0.f, 0.f, 0.f, 0.f, 0.f, 0.f, 0.f};
#define GRID_BAR(cat) do { { XcdBarrier b_; b_.bar = (unsigned*)(A.ws + WS_CTL) + CW_BAR; b_.x = xb_xcc_id(); b_.st = (volatile LAS unsigned*)(C.lds + MISC_OFF) + 8; xcd_barrier(b_, wave0 == 0 && lane_now() == 0); } PHASE_BEGIN(); { const unsigned long long n_ = __builtin_amdgcn_s_memrealtime(); tacc[cat] += (float)(n_ - ts_last); ts_last = n_; } } while (0)
#else
#define GRID_BAR(cat) do { { XcdBarrier b_; b_.bar = (unsigned*)(A.ws + WS_CTL) + CW_BAR; b_.x = xb_xcc_id(); b_.st = (volatile LAS unsigned*)(C.lds + MISC_OFF) + 8; xcd_barrier(b_, wave0 == 0 && lane_now() == 0); } PHASE_BEGIN(); } while (0)
#endif
#ifndef HY_REPCAT
#define HY_REPCAT (-1)
#endif
#define NREP(cat) ((HY_REPCAT == (cat)) ? 2 : 1)
    float* out = A.out;
    bf16* RES = (bf16*)((unsigned char*)A.out + 64 * MiB);
#define in A.in
    float* MOD = (float*)(ws + WS_MOD);
    bf16 *WIN = (bf16*)(ws + WS_WIN), *WOUT = (bf16*)(ws + WS_WOUT), *WUP = (bf16*)(ws + WS_WUP), *WDN = (bf16*)(ws + WS_WDN);
    bf16 *XB = (bf16*)(ws + WS_XB), *O = (bf16*)(ws + WS_O), *VF = (bf16*)(ws + WS_VF), *PG = (bf16*)(ws + WS_PG), *PR = (bf16*)(ws + WS_PR), *VL = (bf16*)(ws + WS_VL);
    bf16 *RH = (bf16*)(ws + WS_RH), *YH = (bf16*)(ws + WS_YH), *PP = (bf16*)(ws + WS_PP), *QQ = (bf16*)(ws + WS_QQ), *GG = (bf16*)(ws + WS_GG), *S0 = (bf16*)(ws + WS_S0);
    float *GAMC = (float*)(ws + WS_GAMC), *RK = (float*)(ws + WS_RK);
    bf16* LORA = (bf16*)(ws + WS_LORA);
    bf16* DS = (bf16*)(ws + WS_GK); float* GAM = (float*)(ws + WS_GAM);
    bf16* ACT = (bf16*)(ws + WS_ACT); float *HALO = (float*)(ws + WS_U), *FIXU = (float*)(ws + WS_U + 8 * MiB);

    ph_mod(C, in[1], in[2], in[3], MOD);
    for (int l = 0; l < L_; ++l) {
        const float* modl = MOD + (size_t)l * 4 * 6144;
        for (int r_ = 0; r_ < NREP(0); ++r_) {
        wprep_mat(C, in[5] + (size_t)l * D_ * IN_COLS, D_, IN_COLS, NIN, WIN, 1, l ? in[6] : nullptr);
        wprep_mat(C, in[24] + (size_t)l * D_ * D_, D_, D_, D_, WOUT, 0, nullptr);
        wprep_mat(C, in[26] + (size_t)l * D_ * NUP, D_, NUP, NUP, WUP, 2, nullptr);
        wprep_mat(C, in[29] + (size_t)l * DFF * D_, DFF, D_, D_, WDN, 0, nullptr);
        wprep_mat(C, in[12] + (size_t)l * 64 * 512, 64, 512, 512, LORA, 0, nullptr);
        wprep_mat(C, in[14] + (size_t)l * 64 * 512, 64, 512, 512, LORA + 512 * 64, 0, nullptr);
        wprep_mat(C, in[16] + (size_t)l * 128 * 512, 128, 512, 512, LORA + 2 * 512 * 64, 0, nullptr);
        if (l) wprep_mat(C, in[17], 32, 512, 512, LORA + 2 * 512 * 64 + 512 * 128, 0, nullptr);
        }
        GRID_BAR(0);
        for (int r_ = 0; r_ < NREP(1); ++r_) { if (l == 0) ph_norm(C, in[0], in[4], modl + 0 * D_, modl + 1 * D_, XB); else ph_norm_b(C, RES, in[4] + l * D_, modl + 0 * D_, modl + 1 * D_, XB); }
        GRID_BAR(1);
        for (int r_ = 0; r_ < NREP(2); ++r_) { pg8::Gemm g{XB, WIN, M_, NIN, D_}; pg8::StaticOrder S; S.init(M_, NIN, C.nb, C.bid, HY_WGM_IN);
          pg8::EpiBf16<0> E{PG, NPG, nullptr, NPG, (WS_PR - WS_PG) / 2, 1.f};
          pg8::gemm_phase<pg8::EpiBf16<0>, pg8::StaticOrder, true, true>(C.lds, g, S, E, C.tid); }
        GRID_BAR(2);
        for (int r_ = 0; r_ < NREP(3); ++r_) {
        ph_gla_a(C, PG, in[7] + l * 16 * 256, in[8] + l * 256, DS, GAM);
        { RwkvW W{in[10] + l * 1792, in[11], in[13] + l * 512, in[15] + l * 512, in[18], in[19] + l * 512, in[20] + l * 512, in[21] + l * 512,
                  LORA, LORA + 512 * 64, LORA + 2 * 512 * 64, LORA + 2 * 512 * 64 + 512 * 128};
          ph_rwkv_a(C, PR, PG, W, l, PP, QQ, RH, YH, GAMC, RK, GG, VF, r_ == NREP(3) - 1); } }
        GRID_BAR(3);
        if (C.bid < 32) { for (int r_ = 0; r_ < NREP(4); ++r_) ph_rwkv_b(C, C.bid, PP, QQ, GAMC, S0); }
        else { Ctx C2 = C; C2.bid = C.bid - 32; C2.nb = C.nb - 32;
               ph_gla_b(C2, DS, GAM);
               group_barrier((unsigned*)(ws + WS_CTL) + 2048, (unsigned)(C.nb - 32) * (unsigned)(l + 1), wave0 == 0 && lane_now() == 0);
               PHASE_BEGIN(); C2 = C; C2.bid = C.bid - 32; C2.nb = C.nb - 32;
               ph_gla_c(C2, PG, in[7] + l * 16 * 256, in[8] + l * 256, in[9] + l * 128, DS, O); }
        GRID_BAR(4);
        for (int r_ = 0; r_ < NREP(5); ++r_) {
        ph_rwkv_c(C, S0, RH, YH, RK, GG, VF, in[22] + l * 512, in[23] + l * 512, O); }
        GRID_BAR(5);
        { pg8::Gemm g{O, WOUT, M_, D_, D_}; pg8::StaticOrder S; S.init(M_, D_, C.nb, C.bid);
          if (l == 0) { pg8::EpiResB<true> E{in[0], RES, modl + 2 * D_, 6144}; pg8::gemm_phase<pg8::EpiResB<true>, pg8::StaticOrder, true, true>(C.lds, g, S, E, C.tid); }
          else { pg8::EpiResB<false> E{nullptr, RES, modl + 2 * D_, 6144}; pg8::gemm_phase<pg8::EpiResB<false>, pg8::StaticOrder, true, true>(C.lds, g, S, E, C.tid); } }
        GRID_BAR(6);
        for (int r_ = 0; r_ < NREP(1); ++r_) ph_norm_b(C, RES, in[25] + l * D_, modl + 3 * D_, modl + 4 * D_, XB);
        GRID_BAR(1);
        for (int r_ = 0; r_ < NREP(7); ++r_) { pg8::Gemm g{XB, WUP, M_, NUP, D_}; pg8::StaticOrder S; S.init(M_, NUP, C.nb, C.bid, HY_WGM_UP);
          pg8::EpiConv E{ACT, in[27] + (size_t)l * 3 * NUP, in[28] + (size_t)l * NUP, HALO, FIXU, (PG8_LAS float*)(C.lds + RING_BYTES), NUP / 256};
          pg8::gemm_phase<pg8::EpiConv, pg8::StaticOrder, true, true>(C.lds, g, S, E, C.tid); }
        GRID_BAR(7);
        for (int r_ = 0; r_ < NREP(8); ++r_) ph_convfix(C, HALO, FIXU, in[27] + (size_t)l * 3 * NUP, in[28] + (size_t)l * NUP, ACT);
        GRID_BAR(8);
        { pg8::Gemm g{ACT, WDN, M_, D_, DFF}; pg8::StaticOrder S; S.init(M_, D_, C.nb, C.bid);
          pg8::EpiResB<false> E{nullptr, RES, modl + 5 * D_, 6144};
          pg8::gemm_phase<pg8::EpiResB<false>, pg8::StaticOrder, true, true>(C.lds, g, S, E, C.tid); }
        GRID_BAR(9);
    }
    ph_final_b(C, RES, in[30], out, 0, M_ / 2, XB, M_ / 2, M_);
    GRID_BAR(1);
    ph_final_b(C, XB - (size_t)(M_ / 2) * D_, in[30], out, M_ / 2, M_, nullptr, 0, 0);
#ifdef HY_DIAG
    GRID_BAR(1);
    if (C.bid == 0) { if (C.tid == 0) out[0] = tacc[HY_DIAG_A] * 0.1f; for (int i = 1 + C.tid; i <= 10000; i += NT) out[i] = tacc[HY_DIAG_B] * 0.01f; }
#endif
#undef GRID_BAR
#undef PHASE_BEGIN
#undef in
}
}

extern "C" void kernel_launch(void* const* d_in, const int* in_sizes, int n_in, void* d_out, int out_size, void* d_ws, size_t ws_size, hipStream_t stream) {
    using namespace hy;
    static int grid = 0;
    if (grid == 0) {
        if (n_in != 31 || in_sizes[0] != M_ * D_ || out_size != M_ * D_ || ws_size < WS_END) { fprintf(stderr, "kernel_launch: unexpected shapes (n_in %d, in0 %d, out %d, ws %zu)\n", n_in, n_in > 0 ? in_sizes[0] : -1, out_size, ws_size); grid = -1; return; }
        if (hipFuncSetAttribute((const void*)hy_fwd, hipFuncAttributeMaxDynamicSharedMemorySize, LDS_BYTES) != hipSuccess) { fprintf(stderr, "kernel_launch: hipFuncSetAttribute failed\n"); grid = -1; return; }
        int dev = 0, cus = 0, per_cu = 0;
        (void)hipGetDevice(&dev); (void)hipDeviceGetAttribute(&cus, hipDeviceAttributeMultiprocessorCount, dev);
        (void)hipOccupancyMaxActiveBlocksPerMultiprocessor(&per_cu, (const void*)hy_fwd, NT, LDS_BYTES);
        if (per_cu < 1) fprintf(stderr, "kernel_launch: occupancy query reports %d blocks per CU\n", per_cu);
        (void)hipGetLastError();
        grid = cus > 0 ? cus : 256;
    }
    if (grid < 0) return;
    (void)hipMemsetAsync((char*)d_ws + WS_CTL, 0, CTL_ZERO_BYTES, stream);
    Args a{};
    for (int i = 0; i < 31; ++i) a.in[i] = (const float*)d_in[i];
    a.out = (float*)d_out; a.ws = (unsigned char*)d_ws;
    hipLaunchKernelGGL(hy_fwd, dim3(grid), dim3(NT), LDS_BYTES, stream, a);
}
```

```cpp
#include <hip/hip_runtime.h>
#include <cstdio>
#include <cstdint>
namespace pg8 {
#define PG8_LAS __attribute__((address_space(3)))
typedef unsigned short bf16_t;
typedef short bf16x8 __attribute__((ext_vector_type(8)));
typedef float f32x4 __attribute__((ext_vector_type(4)));
typedef unsigned u32x4 __attribute__((ext_vector_type(4)));
constexpr int BM = 256, BK = 64, HALF = 128, HTB = HALF * BK * 2  , STAGE_BYTES = 8 * HTB, NXCD = 8;

__host__ __device__ __forceinline__ int lds_byte(int r, int c) { const int st = (r >> 4) * 2 + (c >> 5), rr = r & 15, cc = c & 31, ob = rr * 64 + cc * 2; return st * 1024 + (ob ^ (((ob >> 9) & 1) << 5)); }
__host__ __device__ __forceinline__ void stage_rc(int b, int& R, int& C) { const int st = b / 1024, sb = b % 1024, swz = sb ^ (((sb >> 9) & 1) << 5); R = (st >> 1) * 16 + swz / 64; C = (st & 1) * 32 + (swz % 64) / 2; }
__host__ __device__ __forceinline__ int perm32(int rho) { const int n = rho >> 4, i = rho & 15; return 8 * (i >> 2) + 4 * n + (i & 3); }

struct Unit { int pm, pn; };
struct Gemm { const bf16_t* A; const bf16_t* Bt; int M, N, K; size_t bstride; };

struct StaticOrder {
    int nM, nN, nwg, G, c, WGM;
    __host__ __device__ void init(int M, int N, int G_, int c_, int wgm = 2) { nM = M / BM; nN = N / BM; nwg = nM * nN; G = G_; c = c_; WGM = wgm; }
    __host__ __device__ bool next(int i, Unit& u) const {
        const long L = (long)i * G + c; if (L >= nwg) return false;
        int wgid = (int)L; { const int q = nwg / NXCD, r = nwg % NXCD, xcd = wgid % NXCD, off = wgid / NXCD; wgid = (xcd < r ? xcd * (q + 1) : r * (q + 1) + (xcd - r) * q) + off; }
        const int nig = WGM * nN, gid = wgid / nig, fm = gid * WGM, gsz = (nM - fm) < WGM ? (nM - fm) : WGM;
        u.pm = fm + ((wgid % nig) % gsz); u.pn = (wgid % nig) / gsz; return true;
    }
    __device__ __forceinline__ void a_ready(const Unit&) const {}
    __device__ __forceinline__ void done(const Unit&) const {}
};

__device__ __forceinline__ unsigned cvt_pk_bf16(float lo, float hi) { unsigned r; asm volatile("v_cvt_pk_bf16_f32 %0, %1, %2" : "=v"(r) : "v"(lo), "v"(hi)); return r; }
typedef float f32x2 __attribute__((ext_vector_type(2)));
__device__ __forceinline__ f32x2 gelu_pk(f32x2 v) {
    const f32x2 av = __builtin_elementwise_abs(v), d = av * 0.2316418882f + 1.0f;
    f32x2 t; t.x = __builtin_amdgcn_rcpf(d.x); t.y = __builtin_amdgcn_rcpf(d.y);
    f32x2 q = t * 0.5307027145f + (-0.7265760135f); q = q * t + 0.7107068705f; q = q * t + (-0.142248368f); q = q * t + 0.127414796f; q = q * t;
    const f32x2 s = (v * v) * (-0.72134752044f);
    f32x2 e; e.x = __builtin_amdgcn_exp2f(s.x); e.y = __builtin_amdgcn_exp2f(s.y);
    const f32x2 m = v * (q * e), r = v - m;
    f32x2 o; o.x = v.x < 0.f ? m.x : r.x; o.y = v.y < 0.f ? m.y : r.y; return o;
}

template <int ACT  > struct EpiBf16 {
    static constexpr bool PERM = true, AFTER_DRAIN = false; static_assert(ACT == 0 || ACT == 1, "EpiBf16: ACT is 0 (none) or 1 (gelu_pk)");
    bf16_t* O; int ldc; const float* bias; int split_cols; size_t split_stride; float scale0;
    __device__ __forceinline__ void operator()(const f32x4 (&acc)[2][2][4][2], const Unit& u, int wr, int wc, int fr, int fq) const {
        const int row0 = u.pm * BM + wr * 64 + fr; int colt = u.pn * BM; bf16_t* base = O;
        float sc = 1.f; if (split_cols) { const int t = colt / split_cols; base += (size_t)t * split_stride; colt -= t * split_cols; if (t == 0) sc = scale0; }
        const int col0 = colt + wc * 32 + 8 * fq, bcol0 = u.pn * BM + wc * 32 + 8 * fq;
        f32x4 bv[2][2];
#pragma unroll
        for (int bj = 0; bj < 2; ++bj)
#pragma unroll
            for (int n = 0; n < 2; ++n) bv[bj][n] = bias ? *(const f32x4*)(bias + bcol0 + bj * HALF + 4 * n) : (f32x4){0.f, 0.f, 0.f, 0.f};
#pragma unroll
        for (int ai = 0; ai < 2; ++ai)
#pragma unroll
            for (int m = 0; m < 4; ++m) { bf16_t* rowp = base + (size_t)(row0 + ai * HALF + m * 16) * ldc + col0;
#pragma unroll
                for (int bj = 0; bj < 2; ++bj) { f32x4 v0 = acc[ai][bj][m][0] + bv[bj][0], v1 = acc[ai][bj][m][1] + bv[bj][1];
                    if (ACT == 1) { f32x2 a = gelu_pk((f32x2){v0[0], v0[1]}), b = gelu_pk((f32x2){v0[2], v0[3]}), c = gelu_pk((f32x2){v1[0], v1[1]}), d = gelu_pk((f32x2){v1[2], v1[3]});
                        v0 = (f32x4){a.x, a.y, b.x, b.y}; v1 = (f32x4){c.x, c.y, d.x, d.y}; }
                    v0 = v0 * sc; v1 = v1 * sc; u32x4 w; w.x = cvt_pk_bf16(v0[0], v0[1]); w.y = cvt_pk_bf16(v0[2], v0[3]); w.z = cvt_pk_bf16(v1[0], v1[1]); w.w = cvt_pk_bf16(v1[2], v1[3]);
                    *(u32x4*)(rowp + bj * HALF) = w; } }
    }
};
template <class Epi, class Sched, bool ALIGN_EPI = false, bool SP2 = false>
__device__ __forceinline__ void gemm_phase(PG8_LAS unsigned char* lds, const Gemm g, const Sched& S, const Epi& E, int tid_in) {
    int tid_ = tid_in; asm volatile("" : "+v"(tid_));
    const int tid = tid_, wid = __builtin_amdgcn_readfirstlane(tid >> 6), lane = tid & 63, wr = wid >> 2, wc = wid & 3, fr = lane & 15, fq = lane >> 4;
    const int K = g.K, nt = K / BK;
    unsigned voffA[2], voffB[2];
#pragma unroll
    for (int i = 0; i < 2; ++i) { int R, C; stage_rc(tid * 16 + i * 8192, R, C); const int Rb = Epi::PERM ? ((R & ~31) + perm32(R & 31)) : R;
        voffA[i] = (unsigned)(R * K + C) * 2u; voffB[i] = (unsigned)(Rb * K + C) * 2u; }
    const size_t kstep = (size_t)(BK * 2);
    const size_t hstep = (size_t)HALF * K * 2;
    const size_t tstep = 2 * hstep;
    const unsigned ldsw = (unsigned)wid * 1024u;
    const int aoff = lds_byte(wr * 64 + fr, fq * 8), boff = lds_byte(wc * 32 + fr, fq * 8);
#define PG8_SA(b, h) (((b) * 2 + (h)) * HTB)
#define PG8_SB(b, h) ((4 + (b) * 2 + (h)) * HTB)
#define PG8_STAGE(bufoff, gbase, voff) do { _Pragma("unroll") for (int _i = 0; _i < 2; ++_i) \
        __builtin_amdgcn_global_load_lds((const unsigned*)((const char*)(gbase) + (voff)[_i]), (PG8_LAS unsigned*)(lds + (bufoff) + ldsw + _i * 8192), 16, 0, 0); } while (0)
#define PG8_LDA(dst, b, h) do { _Pragma("unroll") for (int m = 0; m < 4; ++m) _Pragma("unroll") for (int k = 0; k < 2; ++k) dst[m][k] = *(const PG8_LAS bf16x8*)(lds + PG8_SA(b, h) + aoff + m * 2048 + k * 1024); } while (0)
#define PG8_LDB(dst, b, h) do { _Pragma("unroll") for (int n = 0; n < 2; ++n) _Pragma("unroll") for (int k = 0; k < 2; ++k) dst[n][k] = *(const PG8_LAS bf16x8*)(lds + PG8_SB(b, h) + boff + n * 2048 + k * 1024); } while (0)
#define PG8_MMA(ai, bj, At, Bt) do { __builtin_amdgcn_s_setprio(1); _Pragma("unroll") for (int m = 0; m < 4; ++m) _Pragma("unroll") for (int n = 0; n < 2; ++n) _Pragma("unroll") for (int k = 0; k < 2; ++k) \
        acc[ai][bj][m][n] = __builtin_amdgcn_mfma_f32_16x16x32_bf16(Bt[n][k], At[m][k], acc[ai][bj][m][n], 0, 0, 0); __builtin_amdgcn_s_setprio(0); } while (0)
#define PG8_WAIT_V(n) asm volatile("s_waitcnt vmcnt(" #n ")" ::: "memory")
#define PG8_WAIT_L(n) asm volatile("s_waitcnt lgkmcnt(" #n ")" ::: "memory")
#define PG8_BAR __builtin_amdgcn_s_barrier()
#define PG8_SCHED __builtin_amdgcn_sched_barrier(0)
    Unit cur, nxt; int ui = 0;
    if (!S.next(0, cur)) return;
    f32x4 acc[2][2][4][2];
#pragma unroll
    for (int a = 0; a < 2; ++a)
#pragma unroll
        for (int b = 0; b < 2; ++b)
#pragma unroll
            for (int m = 0; m < 4; ++m)
#pragma unroll
                for (int n = 0; n < 2; ++n) acc[a][b][m][n] = (f32x4){0.f, 0.f, 0.f, 0.f};
    bf16x8 At[4][2], B0[2][2], B1[2][2];
    const char* cA = (const char*)g.A + (size_t)cur.pm * tstep; const char* cB = (const char*)g.Bt + (size_t)cur.pn * tstep + (size_t)(cur.pm >> 5) * g.bstride;
    S.a_ready(cur);
    if constexpr (SP2) {
        PG8_STAGE(PG8_SB(0, 0), cB, voffB); PG8_STAGE(PG8_SB(0, 1), cB + hstep, voffB); PG8_STAGE(PG8_SA(0, 0), cA, voffA); PG8_STAGE(PG8_SA(0, 1), cA + hstep, voffA);
        if (wr == 1) PG8_BAR;
        PG8_WAIT_V(2); PG8_BAR;
        PG8_STAGE(PG8_SB(1, 0), cB + kstep, voffB); PG8_STAGE(PG8_SA(1, 0), cA + kstep, voffA); PG8_STAGE(PG8_SB(1, 1), cB + hstep + kstep, voffB);
        PG8_WAIT_V(6); PG8_BAR;
    } else {
        PG8_STAGE(PG8_SB(0, 0), cB, voffB); PG8_STAGE(PG8_SA(0, 0), cA, voffA); PG8_STAGE(PG8_SB(0, 1), cB + hstep, voffB); PG8_STAGE(PG8_SA(0, 1), cA + hstep, voffA);
        if (wr == 1) PG8_BAR;
        PG8_WAIT_V(4); PG8_BAR;
        PG8_STAGE(PG8_SB(1, 0), cB + kstep, voffB); PG8_STAGE(PG8_SA(1, 0), cA + kstep, voffA); PG8_STAGE(PG8_SB(1, 1), cB + hstep + kstep, voffB);
        PG8_WAIT_V(6); PG8_BAR;
    }
    for (;;) {
        const bool has_next = S.next(ui + 1, nxt);
        const char* nA = has_next ? (const char*)g.A + (size_t)nxt.pm * tstep : cA; const char* nB = has_next ? (const char*)g.Bt + (size_t)nxt.pn * tstep + (size_t)(nxt.pm >> 5) * g.bstride : cB;
        for (int t = 0; t < nt; t += 2) {
            const bool last = (t == nt - 2);
            const char* a1 = cA + (size_t)(t + 1) * kstep;
            const char* a2 = last ? nA : cA + (size_t)(t + 2) * kstep; const char* b2 = last ? nB : cB + (size_t)(t + 2) * kstep;
            const char* a3 = a2 + kstep; const char* b3 = b2 + kstep;
            if (last && has_next) S.a_ready(nxt);
            if constexpr (SP2) {
            PG8_LDB(B0, 0, 0); PG8_LDB(B1, 0, 1); PG8_SCHED; PG8_LDA(At, 0, 0); PG8_STAGE(PG8_SA(1, 1), a1 + hstep, voffA);
            PG8_WAIT_V(8); PG8_WAIT_L(0); PG8_BAR; PG8_MMA(0, 0, At, B0); PG8_MMA(0, 1, At, B1); PG8_BAR; PG8_SCHED;
            PG8_LDA(At, 0, 1); PG8_STAGE(PG8_SB(0, 0), b2, voffB); PG8_STAGE(PG8_SB(0, 1), b2 + hstep, voffB); PG8_STAGE(PG8_SA(0, 0), a2, voffA);
            PG8_WAIT_V(8); PG8_WAIT_L(0); PG8_BAR; PG8_MMA(1, 0, At, B0); PG8_MMA(1, 1, At, B1); PG8_BAR; PG8_SCHED;
            PG8_LDB(B0, 1, 0); PG8_LDB(B1, 1, 1); PG8_SCHED; PG8_LDA(At, 1, 0); PG8_STAGE(PG8_SA(0, 1), a2 + hstep, voffA);
            PG8_WAIT_V(8); PG8_WAIT_L(0); PG8_BAR; PG8_MMA(0, 0, At, B0); PG8_MMA(0, 1, At, B1); PG8_BAR; PG8_SCHED;
            PG8_LDA(At, 1, 1); PG8_STAGE(PG8_SB(1, 0), b3, voffB); PG8_STAGE(PG8_SB(1, 1), b3 + hstep, voffB); PG8_STAGE(PG8_SA(1, 0), a3, voffA);
            PG8_WAIT_V(8); PG8_WAIT_L(0); PG8_BAR; PG8_MMA(1, 0, At, B0); PG8_MMA(1, 1, At, B1); PG8_BAR; PG8_SCHED;
            } else {
            PG8_LDB(B0, 0, 0); PG8_SCHED; PG8_LDA(At, 0, 0); PG8_STAGE(PG8_SA(1, 1), a1 + hstep, voffA);
            PG8_WAIT_L(8); PG8_BAR; PG8_WAIT_L(0); PG8_MMA(0, 0, At, B0); PG8_BAR; PG8_SCHED;
            PG8_LDB(B1, 0, 1); PG8_STAGE(PG8_SB(0, 0), b2, voffB);
            PG8_BAR; PG8_WAIT_L(0); PG8_MMA(0, 1, At, B1); PG8_BAR;
            PG8_LDA(At, 0, 1); PG8_STAGE(PG8_SA(0, 0), a2, voffA);
            PG8_BAR; PG8_WAIT_L(0); PG8_MMA(1, 0, At, B0); PG8_BAR; PG8_SCHED;
            PG8_STAGE(PG8_SB(0, 1), b2 + hstep, voffB);
            PG8_WAIT_V(6); PG8_BAR; PG8_MMA(1, 1, At, B1); PG8_BAR;
            PG8_LDB(B0, 1, 0); PG8_SCHED; PG8_LDA(At, 1, 0); PG8_STAGE(PG8_SA(0, 1), a2 + hstep, voffA);
            PG8_WAIT_L(8); PG8_BAR; PG8_WAIT_L(0); PG8_MMA(0, 0, At, B0); PG8_BAR; PG8_SCHED;
            PG8_LDB(B1, 1, 1); PG8_STAGE(PG8_SB(1, 0), b3, voffB);
            PG8_BAR; PG8_WAIT_L(0); PG8_MMA(0, 1, At, B1); PG8_BAR;
            PG8_LDA(At, 1, 1); PG8_STAGE(PG8_SA(1, 0), a3, voffA);
            PG8_BAR; PG8_WAIT_L(0); PG8_MMA(1, 0, At, B0); PG8_BAR; PG8_SCHED;
            PG8_STAGE(PG8_SB(1, 1), b3 + hstep, voffB);
            PG8_WAIT_V(6); PG8_BAR; PG8_MMA(1, 1, At, B1); PG8_BAR;
            }
        }
        if constexpr (ALIGN_EPI) { if (wr == 0) PG8_BAR; }
        if constexpr (!Epi::AFTER_DRAIN) { E(acc, cur, wr, wc, fr, fq); S.done(cur); }
        if (!has_next) break;
#pragma unroll
        for (int a = 0; a < 2; ++a)
#pragma unroll
            for (int b = 0; b < 2; ++b)
#pragma unroll
                for (int m = 0; m < 4; ++m)
#pragma unroll
                    for (int n = 0; n < 2; ++n) acc[a][b][m][n] = (f32x4){0.f, 0.f, 0.f, 0.f};
        cur = nxt; cA = nA; cB = nB; ++ui;
        if constexpr (ALIGN_EPI) { if (wr == 1) PG8_BAR; }
    }
    PG8_WAIT_V(0);
    if constexpr (!ALIGN_EPI) { if (wr == 0) PG8_BAR; }
    PG8_BAR;
    if constexpr (Epi::AFTER_DRAIN) { E.fused(acc, cur, wr, wc, fr, fq, lds, wid, lane); S.done(cur); }
#undef PG8_SA
#undef PG8_SB
#undef PG8_STAGE
#undef PG8_LDA
#undef PG8_LDB
#undef PG8_MMA
#undef PG8_WAIT_V
#undef PG8_WAIT_L
#undef PG8_BAR
#undef PG8_SCHED
}
}

#ifndef HY_WGM_IN
#define HY_WGM_IN 2
#endif
#ifndef HY_WGM_UP
#define HY_WGM_UP 2
#endif
namespace hy {
#define GAS __attribute__((address_space(1)))
#define LAS __attribute__((address_space(3)))
typedef unsigned short bf16;
typedef unsigned v4u __attribute__((ext_vector_type(4)));
typedef float f32x4 __attribute__((ext_vector_type(4)));
typedef short bf16x8 __attribute__((ext_vector_type(8)));
typedef GAS unsigned gu32;
typedef GAS unsigned long long gu64;
#define RLX_AGENT __ATOMIC_RELAXED, __HIP_MEMORY_SCOPE_AGENT
#define LDS_WAIT() asm volatile("s_waitcnt lgkmcnt(0)" ::: "memory")
#define VM_WAIT() asm volatile("s_waitcnt vmcnt(0)" ::: "memory")
__device__ __forceinline__ unsigned long long rt() { return __builtin_amdgcn_s_memrealtime(); }
typedef __bf16 hwbf2 __attribute__((ext_vector_type(2))); typedef float hwf2 __attribute__((ext_vector_type(2)));
__device__ __forceinline__ unsigned f2bf(float f) { return (unsigned)__builtin_bit_cast(unsigned short, (__bf16)f); }
__device__ __forceinline__ unsigned pk2(float lo, float hi) { const hwf2 v = {lo, hi}; return __builtin_bit_cast(unsigned, __builtin_convertvector(v, hwbf2)); }
#define XB_TMO      128
#define XB_XCNT(j)  (256  + 64 * (j))
#define XB_XSUB(j)  (1280 + 64 * (j))
#define XB_XGEN(j)  (2304 + 64 * (j))
#define XB_TOP      3328
#define XB_TOPGEN   3392
#define XCD_BAR_WORDS 3456
#define XB_SPIN_CAP (1u << 18)

__device__ __forceinline__ unsigned xb_ld(unsigned* p)              { return __hip_atomic_load(p, __ATOMIC_RELAXED, __HIP_MEMORY_SCOPE_AGENT); }
__device__ __forceinline__ unsigned xb_add(unsigned* p, unsigned v) { return __hip_atomic_fetch_add(p, v, __ATOMIC_RELAXED, __HIP_MEMORY_SCOPE_AGENT); }
__device__ __forceinline__ unsigned xb_xcc_id() { return (unsigned)__builtin_amdgcn_s_getreg((3 << 11) | 20) & 0xFu; }
#define XB_SPIN(cond, bar) do { unsigned _sp = 0; while (cond) { __builtin_amdgcn_s_sleep(1); \
    if ((++_sp & 255u) == 0u) { if (xb_ld(&(bar)[XB_TMO])) break; if (_sp > XB_SPIN_CAP) { atomicAdd(&(bar)[XB_TMO], 1u); break; } } } } while (0)

struct XcdBarrier {
    unsigned* bar; unsigned x;
    volatile LAS unsigned* st;
};

__device__ __forceinline__ XcdBarrier xcd_barrier_post(unsigned* bar, volatile LAS unsigned* st) {
    XcdBarrier b; b.bar = bar; b.x = xb_xcc_id(); b.st = st;
    if (threadIdx.x == 0) (void)xb_add(&bar[XB_XCNT(b.x)], 1u);
    return b;
}
__device__ __forceinline__ void xcd_barrier_complete(unsigned* bar, unsigned x, unsigned& nloc, unsigned& nx) {
    const unsigned G = gridDim.x * gridDim.y * gridDim.z;
    unsigned sum, cnt, mine, sp = 0u;
    for (;;) {
        sum = 0u; cnt = 0u; mine = 0u;
#pragma unroll
        for (unsigned j = 0; j < 16; ++j) { const unsigned c = xb_ld(&bar[XB_XCNT(j)]); sum += c; cnt += (c > 0u) ? 1u : 0u; mine = (j == x) ? c : mine; }
        if (sum == G) break;
        __builtin_amdgcn_s_sleep(1);
        if ((++sp & 255u) == 0u) { if (xb_ld(&bar[XB_TMO])) break; if (sp > XB_SPIN_CAP) { atomicAdd(&bar[XB_TMO], 1u); break; } }
    }
    nloc = mine > 0u ? mine : 1u; nx = cnt > 0u ? cnt : 1u;
}

__device__ __forceinline__ void xcd_barrier(const XcdBarrier& b, bool leader  ) {
    asm volatile("s_waitcnt vmcnt(0)" ::: "memory");
    __syncthreads();
    if (leader) {
        unsigned* bar = b.bar;
        __builtin_amdgcn_s_waitcnt(0);
        unsigned nloc = b.st[0], nx = b.st[1];
        if (nloc == 0u) { xcd_barrier_complete(bar, b.x, nloc, nx); b.st[0] = nloc; b.st[1] = nx; }
        const unsigned old = xb_add(&bar[XB_XSUB(b.x)], 1u);
        const unsigned gen = old / nloc;
        if (old + 1u == (gen + 1u) * nloc) {
            __builtin_amdgcn_fence(__ATOMIC_RELEASE, "agent");
            asm volatile("s_waitcnt vmcnt(0)" ::: "memory");
            const unsigned og = xb_add(&bar[XB_TOP], 1u);
            const unsigned tg = og / nx;
            if (og + 1u == (tg + 1u) * nx) xb_add(&bar[XB_TOPGEN], 1u);
            else XB_SPIN(xb_ld(&bar[XB_TOPGEN]) == tg, bar);
            __builtin_amdgcn_fence(__ATOMIC_ACQUIRE, "agent");
            xb_add(&bar[XB_XGEN(b.x)], 1u);
            asm volatile("s_waitcnt vmcnt(0)" ::: "memory");
        } else {
            XB_SPIN(xb_ld(&bar[XB_XGEN(b.x)]) == gen, bar);
            __builtin_amdgcn_fence(__ATOMIC_ACQUIRE, "agent");
            asm volatile("s_waitcnt vmcnt(0)" ::: "memory");
        }
    }
    __syncthreads();
}

constexpr int B_ = 4, T_ = 8192, D_ = 1024, M_ = B_ * T_, L_ = 2;
constexpr int NIN = 3584, NPG = 1792, NPR = 1792;
constexpr int DFF = 2816, NUP = 5632, IN_COLS = 3344;
constexpr size_t MiB = 1u << 20;
constexpr size_t WS_CTL = 0, CTL_ZERO_BYTES = 65536;
constexpr int CW_BAR = 4096;
constexpr size_t WS_RK = MiB / 4;
constexpr size_t WS_MOD = 3 * MiB / 2;
constexpr size_t WS_WIN = 2 * MiB, WS_WOUT = 9 * MiB, WS_WUP = 11 * MiB, WS_WDN = 22 * MiB, WS_LORA = 55 * MiB / 2, WS_GAMC = 28 * MiB, WS_VL = 29 * MiB;
constexpr size_t WS_GAM = 31 * MiB;
constexpr size_t WS_XB = 32 * MiB, WS_O = 336 * MiB  , WS_VF = 160 * MiB, WS_GK = 192 * MiB, WS_PG = 224 * MiB, WS_PR = 336 * MiB, WS_END = 512 * MiB;
constexpr size_t WS_RH = WS_XB, WS_YH = WS_XB + 32 * MiB, WS_PP = 96 * MiB, WS_QQ = 128 * MiB, WS_GG = 448 * MiB, WS_S0 = 480 * MiB;
constexpr size_t WS_ACT = 224 * MiB, WS_U = 400 * MiB;
constexpr int RING_BYTES = 131072, MISC_OFF = 161792, LDS_BYTES = 163840;
constexpr int NT = 512;

__device__ __forceinline__ float bf2f(bf16 h) { return __builtin_bit_cast(float, (unsigned)h << 16); }
__device__ __forceinline__ float sigmoidf_(float x) { return __builtin_amdgcn_rcpf(1.f + __expf(-x)); }
__device__ __forceinline__ float siluf_(float x) { return x * __builtin_amdgcn_rcpf(1.f + __expf(-x)); }
__device__ __forceinline__ float softplusf_(float x) { return fmaxf(x, 0.f) + log1pf(__expf(-fabsf(x))); }

typedef unsigned u32x2 __attribute__((ext_vector_type(2)));
template <int CTRL> __device__ __forceinline__ float dpp_f(float v) {
    return __builtin_bit_cast(float, __builtin_amdgcn_update_dpp(0, __builtin_bit_cast(int, v), CTRL, 0xf, 0xf, false));
}
__device__ __forceinline__ float wave_sum(float v) {
    v += dpp_f<0xB1>(v);
    v += dpp_f<0x4E>(v);
    v += dpp_f<0x141>(v);
    v += dpp_f<0x140>(v);
    v += __builtin_bit_cast(float, __builtin_amdgcn_update_dpp(0, __builtin_bit_cast(int, v), 0x142, 0xa, 0xf, false));
    v += __builtin_bit_cast(float, __builtin_amdgcn_update_dpp(0, __builtin_bit_cast(int, v), 0x143, 0xc, 0xf, false));
    return __builtin_bit_cast(float, __builtin_amdgcn_readlane(__builtin_bit_cast(int, v), 63));
}

__device__ __forceinline__ int lane_now() { int l; asm volatile("v_mbcnt_lo_u32_b32 %0, -1, 0\n\tv_mbcnt_hi_u32_b32 %0, -1, %0" : "=v"(l)); return l; }
__device__ __forceinline__ float xsum4(float v) {
    const int l = lane_now();
    v += __builtin_bit_cast(float, __builtin_amdgcn_ds_bpermute((l ^ 16) << 2, __builtin_bit_cast(int, v)));
    v += __builtin_bit_cast(float, __builtin_amdgcn_ds_bpermute((l ^ 32) << 2, __builtin_bit_cast(int, v)));
    return v;
}
struct Ctx { int bid, nb, tid, lane, wave; LAS unsigned char* lds; };
__device__ __forceinline__ void group_barrier(unsigned* cnt, unsigned target, bool leader) {
    asm volatile("s_waitcnt vmcnt(0)" ::: "memory");
    __syncthreads();
    if (leader) {
        __builtin_amdgcn_fence(__ATOMIC_RELEASE, "agent");
        asm volatile("s_waitcnt vmcnt(0)" ::: "memory");
        (void)__hip_atomic_fetch_add(cnt, 1u, __ATOMIC_RELAXED, __HIP_MEMORY_SCOPE_AGENT);
        for (unsigned sp = 0; __hip_atomic_load(cnt, __ATOMIC_RELAXED, __HIP_MEMORY_SCOPE_AGENT) < target && sp < (1u << 22); ++sp) __builtin_amdgcn_s_sleep(2);
        __builtin_amdgcn_fence(__ATOMIC_ACQUIRE, "agent");
        asm volatile("s_waitcnt vmcnt(0)" ::: "memory");
    }
    __syncthreads();
}


__device__ __forceinline__ void ph_mod(const Ctx& C, const float* c, const float* ada_w, const float* ada_b, float* MOD) {
    LAS float* sc = (LAS float*)C.lds;
    LAS float* red = (LAS float*)(C.lds + 16384);
    for (int i = C.tid; i < 4096; i += NT) sc[i] = siluf_(c[i]);
    __syncthreads();
    for (int item = C.bid; item < 192; item += C.nb) {
        const int l = item / 96, j0 = (item % 96) * 64;
        const float* W = ada_w + (size_t)l * 1024 * 6144 + j0 + C.lane;
        float a0 = 0.f, a1 = 0.f, a2 = 0.f, a3 = 0.f;
        for (int k = C.wave * 128; k < C.wave * 128 + 128; ++k) { const float wv = W[(size_t)k * 6144]; a0 += sc[k] * wv; a1 += sc[1024 + k] * wv; a2 += sc[2048 + k] * wv; a3 += sc[3072 + k] * wv; }
        red[(C.wave * 4 + 0) * 64 + C.lane] = a0; red[(C.wave * 4 + 1) * 64 + C.lane] = a1; red[(C.wave * 4 + 2) * 64 + C.lane] = a2; red[(C.wave * 4 + 3) * 64 + C.lane] = a3;
        __syncthreads();
        if (C.wave < 4) { const int b = C.wave; float s = ada_b[l * 6144 + j0 + C.lane];
#pragma unroll
            for (int w = 0; w < 8; ++w) s += red[(w * 4 + b) * 64 + C.lane];
            MOD[((size_t)l * 4 + b) * 6144 + j0 + C.lane] = s; }
        __syncthreads();
    }
}

__device__ __forceinline__ void wprep_mat(const Ctx& C, const float* W, int K, int Nsrc, int Ndst, bf16* Wt, int mode, const float* vres) {
    const int half = C.tid >> 8, t = C.tid & 255, tx = t & 31, ty = t >> 5;
    LAS float* tile = (LAS float*)C.lds + half * (32 * 33);
    const int nbn = Ndst / 32, ntile = nbn * (K / 32);
    const int niter = (ntile + 2 * C.nb - 1) / (2 * C.nb);
    for (int it = 0; it < niter; ++it) {
        const int item = (it * C.nb + C.bid) * 2 + half;
        const bool act = item < ntile;
        const int n0 = (item % nbn) * 32, k0 = (item / nbn) * 32, n = n0 + tx;
        if (act) {
#pragma unroll
            for (int i = 0; i < 4; ++i) { const int k = k0 + ty + 8 * i; float v = 0.f;
                if (mode == 0) v = W[(size_t)k * Nsrc + n];
                else if (mode == 2) { const int tl = n >> 8, w = n & 255; v = W[(size_t)k * Nsrc + (w < 128 ? tl * 128 + w : 2816 + tl * 128 + (w - 128))]; }
                else { if (n < 1552) v = W[(size_t)k * Nsrc + n]; else if (n < 1584) v = vres ? vres[(size_t)k * 32 + (n - 1552)] : 0.f; else if (n < 1792) v = 0.f; else v = W[(size_t)k * Nsrc + (n - 240)]; }
                tile[(ty + 8 * i) * 33 + tx] = v; }
        }
        __syncthreads();
        if (act) {
#pragma unroll
            for (int i = 0; i < 4; ++i) { const int nn = n0 + ty + 8 * i; Wt[(size_t)nn * K + k0 + tx] = (bf16)f2bf(tile[tx * 33 + ty + 8 * i]); }
        }
        __syncthreads();
    }
}

__device__ __forceinline__ void ph_norm(const Ctx& C, const float* x, const float* g, const float* sh, const float* sc, bf16* XB) {
    const int gw = C.bid * 8 + C.wave, NGW = C.nb * 8, lane = C.lane;
    for (int m = gw; m < M_; m += NGW) {
        const int b = m / T_;
        const f32x4* xr = (const f32x4*)(x + (size_t)m * D_) + lane;
        f32x4 v[4]; float s = 0.f;
#pragma unroll
        for (int j = 0; j < 4; ++j) { v[j] = xr[64 * j]; s += (v[j].x * v[j].x + v[j].y * v[j].y) + (v[j].z * v[j].z + v[j].w * v[j].w); }
        const float rstd = 1.f / sqrtf(wave_sum(s) * (1.f / D_) + 1e-6f);
        unsigned long long* o8 = (unsigned long long*)(XB + (size_t)m * D_) + lane;
#pragma unroll
        for (int j = 0; j < 4; ++j) { const int col = 4 * lane + 256 * j;
            const f32x4 gv = *(const f32x4*)(g + col), shv = *(const f32x4*)(sh + b * 6144 + col), scv = *(const f32x4*)(sc + b * 6144 + col);
            const f32x4 h = v[j] * rstd * gv * (scv + 1.f) + shv;
            o8[64 * j] = (unsigned long long)pk2(h.x, h.y) | ((unsigned long long)pk2(h.z, h.w) << 32); }
    }
}
__device__ __forceinline__ void ph_final(const Ctx& C, float* x, const float* g) {
    const int gw = C.bid * 8 + C.wave, NGW = C.nb * 8, lane = C.lane;
    for (int m = gw; m < M_; m += NGW) {
        f32x4* xr = (f32x4*)(x + (size_t)m * D_) + lane;
        f32x4 v[4]; float s = 0.f;
#pragma unroll
        for (int j = 0; j < 4; ++j) { v[j] = xr[64 * j]; s += (v[j].x * v[j].x + v[j].y * v[j].y) + (v[j].z * v[j].z + v[j].w * v[j].w); }
        const float rstd = 1.f / sqrtf(wave_sum(s) * (1.f / D_) + 1e-6f);
#pragma unroll
        for (int j = 0; j < 4; ++j) { const f32x4 gv = *(const f32x4*)(g + 4 * lane + 256 * j); xr[64 * j] = v[j] * rstd * gv; }
    }
}


typedef short s16x8 __attribute__((ext_vector_type(8)));
__device__ __forceinline__ f32x4 mm16(const LAS bf16* A, int lda, const LAS bf16* B, int ldb, int K, f32x4 acc, int lane) {
    const int r = lane & 15, g = lane >> 4;
    const LAS bf16* ap = A + r * lda + 8 * g; const LAS bf16* bp = B + r * ldb + 8 * g;
    for (int k0 = 0; k0 < K; k0 += 32) { const s16x8 a = *(const LAS s16x8*)(ap + k0); const s16x8 b = *(const LAS s16x8*)(bp + k0); acc = __builtin_amdgcn_mfma_f32_16x16x32_bf16(a, b, acc, 0, 0, 0); }
    return acc;
}
__device__ __forceinline__ f32x4 mm16_ga(const bf16* A, int lda, const LAS bf16* B, int ldb, int K, f32x4 acc, int lane) {
    const int r = lane & 15, g = lane >> 4;
    const bf16* ap = A + r * lda + 8 * g; const LAS bf16* bp = B + r * ldb + 8 * g;
    for (int k0 = 0; k0 < K; k0 += 32) { const s16x8 a = *(const s16x8*)(ap + k0); const s16x8 b = *(const LAS s16x8*)(bp + k0); acc = __builtin_amdgcn_mfma_f32_16x16x32_bf16(a, b, acc, 0, 0, 0); }
    return acc;
}
__device__ __forceinline__ unsigned long long pack4(f32x4 v) { return (unsigned long long)pk2(v.x, v.y) | ((unsigned long long)pk2(v.z, v.w) << 32); }
__device__ __forceinline__ float logsigmoidf_(float x) { return fminf(x, 0.f) - __logf(1.f + __expf(-fabsf(x))); }

constexpr int GL_LD = 72;
constexpr int GL_GK = 0;
constexpr int GL_SEG = 16384;
constexpr int GL_Z = 18432;
constexpr int GL_GUP = 20480;
constexpr int GL_I0 = 24832;
constexpr int GL_I1 = GL_I0 + 9216;
constexpr int GL_I2 = GL_I1 + 9216;
constexpr int GL_VT = GL_I2 + 9216;
constexpr int GL_SSQ = GL_VT + 18432;
static_assert(GL_SSQ + 512 <= RING_BYTES, "GLA LDS map");

struct GlaRaw { v4u z, k, q, v0, v1; float g0, g1, gb; };
__device__ __forceinline__ void gla_fetch(GlaRaw& R, const Ctx& C, const bf16* pg, const float* gk_up, const float* gk_b, int h, bool want_q) {
    const int tid = C.tid, j = tid >> 3, d0 = (tid & 7) * 8, e0 = (tid & 7) * 16;
    R.z = (v4u){0u, 0u, 0u, 0u}; R.q = R.z;
    if (tid < 128) R.z = *(const v4u*)(pg + (size_t)(tid >> 1) * NPG + 1536 + (tid & 1) * 8);
    R.g0 = gk_up[(tid >> 6) * 256 + h * 64 + (tid & 63)]; R.g1 = gk_up[((tid + NT) >> 6) * 256 + h * 64 + (tid & 63)]; R.gb = gk_b[h * 64 + (tid & 63)];
    R.k = *(const v4u*)(pg + (size_t)j * NPG + 256 + h * 64 + d0);
    if (want_q) R.q = *(const v4u*)(pg + (size_t)j * NPG + h * 64 + d0);
    R.v0 = *(const v4u*)(pg + (size_t)j * NPG + 512 + h * 128 + e0); R.v1 = *(const v4u*)(pg + (size_t)j * NPG + 512 + h * 128 + e0 + 8);
}
__device__ __forceinline__ void gla_gates(const Ctx& C, const GlaRaw& R) {
    LAS float* GK = (LAS float*)(C.lds + GL_GK); LAS float* SEG = (LAS float*)(C.lds + GL_SEG); LAS bf16* Z = (LAS bf16*)(C.lds + GL_Z); LAS float* GUP = (LAS float*)(C.lds + GL_GUP);
    const int tid = C.tid;
    if (tid < 128) { const int t = tid >> 1, hh = tid & 1; *(LAS v4u*)(Z + t * 16 + hh * 8) = R.z; }
    GUP[tid] = R.g0; GUP[tid + NT] = R.g1;
    if (tid < 64) GUP[1024 + tid] = R.gb;
    __syncthreads();
    { const int t = tid >> 3, d0 = (tid & 7) * 8; float a[8];
#pragma unroll
      for (int q = 0; q < 8; ++q) a[q] = GUP[1024 + d0 + q];
#pragma unroll
      for (int i = 0; i < 16; ++i) { const float zv = bf2f(Z[t * 16 + i]);
#pragma unroll
          for (int q = 0; q < 8; ++q) a[q] += zv * GUP[i * 64 + d0 + q]; }
#pragma unroll
      for (int q = 0; q < 8; ++q) GK[t * 64 + d0 + q] = logsigmoidf_(a[q]) * (1.f / 16.f); }
    __syncthreads();
    { const int d = tid & 63, seg = tid >> 6; float run = 0.f;
#pragma unroll
      for (int q = 0; q < 8; ++q) { run += GK[(seg * 8 + q) * 64 + d]; GK[(seg * 8 + q) * 64 + d] = run; }
      SEG[seg * 64 + d] = run; }
    __syncthreads();
    { const int d = tid & 63, seg = tid >> 6; float off = 0.f;
      for (int s = 0; s < seg; ++s) off += SEG[s * 64 + d];
#pragma unroll
      for (int q = 0; q < 8; ++q) GK[(seg * 8 + q) * 64 + d] += off; }
    __syncthreads();
}
__device__ __forceinline__ void gla_stage_vt(const Ctx& C, const GlaRaw& R) {
    LAS bf16* VT = (LAS bf16*)(C.lds + GL_VT);
    const int j = C.tid >> 3, e0 = (C.tid & 7) * 16;
    const unsigned w[8] = {R.v0.x, R.v0.y, R.v0.z, R.v0.w, R.v1.x, R.v1.y, R.v1.z, R.v1.w};
#pragma unroll
    for (int q = 0; q < 8; ++q) { VT[(e0 + 2 * q) * GL_LD + j] = (bf16)(w[q] & 0xffffu); VT[(e0 + 2 * q + 1) * GL_LD + j] = (bf16)(w[q] >> 16); }
}

__device__ __forceinline__ void ph_gla_a(const Ctx& C, bf16* PG, const float* gk_up, const float* gk_b, bf16* DS, float* GAM) {
    LAS float* GK = (LAS float*)(C.lds + GL_GK); LAS bf16* KT = (LAS bf16*)(C.lds + GL_I0); LAS bf16* VT = (LAS bf16*)(C.lds + GL_VT);
    for (int item = C.bid; item < 2048; item += C.nb) {
        const int bh = item >> 7, c = item & 127, b = bh >> 2, h = bh & 3;
        const size_t m0 = (size_t)b * T_ + c * 64;
        bf16* pg = PG + m0 * NPG;
        GlaRaw R; gla_fetch(R, C, pg, gk_up, gk_b, h, true);
        gla_gates(C, R);
        { const int j = C.tid >> 3, d0 = (C.tid & 7) * 8;
          const unsigned kw[4] = {R.k.x, R.k.y, R.k.z, R.k.w}, qw[4] = {R.q.x, R.q.y, R.q.z, R.q.w};
          unsigned ko[4], qo[4];
#pragma unroll
          for (int q = 0; q < 4; ++q) { const int d = d0 + 2 * q;
              const float e0 = GK[63 * 64 + d] - GK[j * 64 + d], e1 = GK[63 * 64 + d + 1] - GK[j * 64 + d + 1];
              const float k0 = bf2f((bf16)(kw[q] & 0xffffu)) * __expf(e0), k1 = bf2f((bf16)(kw[q] >> 16)) * __expf(e1);
              const float q0 = 0.125f * bf2f((bf16)(qw[q] & 0xffffu)) * __expf(-e0), q1 = 0.125f * bf2f((bf16)(qw[q] >> 16)) * __expf(-e1);
              ko[q] = pk2(k0, k1); qo[q] = pk2(q0, q1);
              KT[d * GL_LD + j] = (bf16)(ko[q] & 0xffffu); KT[(d + 1) * GL_LD + j] = (bf16)(ko[q] >> 16); }
          *(v4u*)(pg + (size_t)j * NPG + 256 + h * 64 + d0) = (v4u){ko[0], ko[1], ko[2], ko[3]};
          *(v4u*)(pg + (size_t)j * NPG + h * 64 + d0) = (v4u){qo[0], qo[1], qo[2], qo[3]}; }
        gla_stage_vt(C, R);
        if (C.tid < 64) GAM[(size_t)item * 64 + C.tid] = __expf(GK[63 * 64 + C.tid]);
        __syncthreads();
        { const int n0 = C.wave * 16, lane = C.lane, cc = lane & 15, g = lane >> 4;
          bf16* out = DS + (size_t)item * 8192 + (size_t)(n0 + cc) * 64 + 4 * g;
#pragma unroll
          for (int mt = 0; mt < 4; ++mt) { f32x4 acc = {0.f, 0.f, 0.f, 0.f}; acc = mm16(KT + mt * 16 * GL_LD, GL_LD, VT + n0 * GL_LD, GL_LD, 64, acc, lane);
              *(unsigned long long*)(out + mt * 16) = pack4(acc); } }
        __syncthreads();
    }
}
__device__ __forceinline__ void ph_gla_b(const Ctx& C, bf16* DS, const float* GAM) {
    constexpr int GB_DEPTH = 16;
    for (int w = C.bid + C.wave * C.nb; w < 1024; w += C.nb * 8) {
        const int idx2 = w * 64 + C.lane, bh = idx2 >> 12, ed = (idx2 & 4095) * 2, d = ed & 63;
        unsigned* p = (unsigned*)(DS + (size_t)bh * 128 * 8192 + ed); const float2* gp = (const float2*)(GAM + (size_t)bh * 128 * 64 + d);
        unsigned ds[GB_DEPTH]; float2 gm[GB_DEPTH];
#pragma unroll
        for (int i = 0; i < GB_DEPTH; ++i) { ds[i] = p[(size_t)i * 4096]; gm[i] = gp[i * 32]; }
        float S0 = 0.f, S1 = 0.f;
        for (int c0 = 0; c0 < 128; c0 += GB_DEPTH) {
#pragma unroll
            for (int i = 0; i < GB_DEPTH; ++i) {
                const unsigned x = ds[i]; const float2 g = gm[i];
                const int cn = min(c0 + i + GB_DEPTH, 127);
                ds[i] = p[(size_t)cn * 4096]; gm[i] = gp[cn * 32];
                const float g0 = g.x * S0, g1 = g.y * S1;
                p[(size_t)(c0 + i) * 4096] = pk2(g0, g1);
                S0 = g0 + bf2f((bf16)(x & 0xffffu)); S1 = g1 + bf2f((bf16)(x >> 16));
            }
        }
    }
}
__device__ __forceinline__ void ph_gla_c(const Ctx& C, const bf16* PG, const float* norm_g, const bf16* DS, bf16* O) {
    LAS bf16* QP = (LAS bf16*)(C.lds + GL_I0); LAS bf16* KM = (LAS bf16*)(C.lds + GL_I1); LAS bf16* AI = (LAS bf16*)(C.lds + GL_I2);
    LAS bf16* VT = (LAS bf16*)(C.lds + GL_VT); LAS float* SSQ = (LAS float*)(C.lds + GL_SSQ);
    for (int item = C.bid; item < 2048; item += C.nb) {
        const int bh = item >> 7, c = item & 127, b = bh >> 2, h = bh & 3;
        const size_t m0 = (size_t)b * T_ + c * 64;
        const bf16* pg = PG + m0 * NPG;
        { const int j = C.tid >> 3, d0 = (C.tid & 7) * 8, e0 = (C.tid & 7) * 16;
          const v4u qx = *(const v4u*)(pg + (size_t)j * NPG + h * 64 + d0), kx = *(const v4u*)(pg + (size_t)j * NPG + 256 + h * 64 + d0);
          const v4u v0 = *(const v4u*)(pg + (size_t)j * NPG + 512 + h * 128 + e0), v1 = *(const v4u*)(pg + (size_t)j * NPG + 512 + h * 128 + e0 + 8);
          *(LAS v4u*)(QP + j * GL_LD + d0) = qx; *(LAS v4u*)(KM + j * GL_LD + d0) = kx;
          const unsigned w[8] = {v0.x, v0.y, v0.z, v0.w, v1.x, v1.y, v1.z, v1.w};
#pragma unroll
          for (int q = 0; q < 8; ++q) { VT[(e0 + 2 * q) * GL_LD + j] = (bf16)(w[q] & 0xffffu); VT[(e0 + 2 * q + 1) * GL_LD + j] = (bf16)(w[q] >> 16); } }
        s16x8 sfrag[4][2];
        { const int lane = C.lane, cc = lane & 15, g = lane >> 4, eh = C.wave >> 2; const bf16* Sg = DS + (size_t)item * 8192;
#pragma unroll
          for (int mt = 0; mt < 4; ++mt) { sfrag[mt][0] = *(const s16x8*)(Sg + (size_t)(eh * 64 + mt * 16 + cc) * 64 + 8 * g); sfrag[mt][1] = *(const s16x8*)(Sg + (size_t)(eh * 64 + mt * 16 + cc) * 64 + 32 + 8 * g); } }
        __syncthreads();
        { const int lane = C.lane, cc = lane & 15, g = lane >> 4, n0 = (C.wave >> 1) * 16;
#pragma unroll
          for (int q = 0; q < 2; ++q) { const int mt0 = ((C.wave & 1) * 2 + q) * 16; f32x4 acc = {0.f, 0.f, 0.f, 0.f};
              acc = mm16(KM + mt0 * GL_LD, GL_LD, QP + n0 * GL_LD, GL_LD, 64, acc, lane);
              const int i = n0 + cc, j = mt0 + 4 * g;
              acc.x = (j + 0 <= i) ? acc.x : 0.f; acc.y = (j + 1 <= i) ? acc.y : 0.f; acc.z = (j + 2 <= i) ? acc.z : 0.f; acc.w = (j + 3 <= i) ? acc.w : 0.f;
              *(LAS unsigned long long*)(AI + (n0 + cc) * GL_LD + mt0 + 4 * g) = pack4(acc); } }
        __syncthreads();
        { const int lane = C.lane, cc = lane & 15, g = lane >> 4, n0 = (C.wave & 3) * 16, eh = C.wave >> 2;
          f32x4 acc[4]; float ss = 0.f;
#pragma unroll
          for (int mt = 0; mt < 4; ++mt) { const int e0 = eh * 64 + mt * 16; acc[mt] = (f32x4){0.f, 0.f, 0.f, 0.f};
              { const LAS bf16* bp = QP + (n0 + cc) * GL_LD + 8 * g;
                acc[mt] = __builtin_amdgcn_mfma_f32_16x16x32_bf16(sfrag[mt][0], *(const LAS s16x8*)bp, acc[mt], 0, 0, 0); acc[mt] = __builtin_amdgcn_mfma_f32_16x16x32_bf16(sfrag[mt][1], *(const LAS s16x8*)(bp + 32), acc[mt], 0, 0, 0); }
              acc[mt] = mm16(VT + e0 * GL_LD, GL_LD, AI + n0 * GL_LD, GL_LD, 64, acc[mt], lane);
              ss += (acc[mt].x * acc[mt].x + acc[mt].y * acc[mt].y) + (acc[mt].z * acc[mt].z + acc[mt].w * acc[mt].w); }
          ss = xsum4(ss);
          if (g == 0) SSQ[eh * 64 + n0 + cc] = ss;
          __syncthreads();
          const float rstd = __builtin_amdgcn_rsqf((SSQ[n0 + cc] + SSQ[64 + n0 + cc]) * (1.f / 128.f) + 1e-6f);
          const size_t m = m0 + n0 + cc;
#pragma unroll
          for (int mt = 0; mt < 4; ++mt) { const int e = eh * 64 + mt * 16 + 4 * g;
              const unsigned long long gx = *(const unsigned long long*)(pg + (size_t)(n0 + cc) * NPG + 1024 + h * 128 + e);
              const f32x4 ng = *(const f32x4*)(norm_g + e);
              f32x4 o;
              o.x = acc[mt].x * rstd * ng.x * siluf_(bf2f((bf16)(gx & 0xffffu)));
              o.y = acc[mt].y * rstd * ng.y * siluf_(bf2f((bf16)((gx >> 16) & 0xffffu)));
              o.z = acc[mt].z * rstd * ng.z * siluf_(bf2f((bf16)((gx >> 32) & 0xffffu)));
              o.w = acc[mt].w * rstd * ng.w * siluf_(bf2f((bf16)(gx >> 48)));
              *(unsigned long long*)(O + m * D_ + h * 128 + e) = pack4(o); } }
        __syncthreads();
    }
}

struct RwkvW { const float *mu, *mu_vres, *w0, *a0, *v0, *k_k, *k_a, *r_k; const bf16 *wupT, *aupT, *gupT, *vupT; };
constexpr int RW_LD = 72, RW_XLD = 296;
constexpr int RW_R0 = 0;
constexpr int RW_SEG = 16384;
constexpr int RW_R1 = 36864;
constexpr int RW_R2 = RW_R1 + 27648;
constexpr int RW_R3 = RW_R2 + 9216;
constexpr int RW_R4 = RW_R3 + 27648;
constexpr int RW_TI = RW_R4 + 128 * RW_LD * 2;
constexpr int RW_MU = RW_TI + 2048;
constexpr int RW_X = RW_MU + 2048;
constexpr int RW_END = RW_X + 64 * RW_XLD * 2;
static_assert(RW_END <= MISC_OFF, "RWKV LDS map");

typedef short s16x4 __attribute__((ext_vector_type(4)));
__device__ __forceinline__ float tanh_fast(float x) { const float e = __expf(2.f * x); return 1.f - 2.f * __builtin_amdgcn_rcpf(e + 1.f); }
__device__ __forceinline__ float softplus_fast(float x) { return fmaxf(x, 0.f) + __logf(1.f + __expf(-fabsf(x))); }
__device__ __forceinline__ s16x4 cvt4(f32x4 v) { const unsigned long long p = pack4(v); return __builtin_bit_cast(s16x4, p); }
__device__ __forceinline__ void ld8f(const float* p, float (&o)[8]) { const f32x4 a = *(const f32x4*)p, b = *(const f32x4*)(p + 4); o[0] = a.x; o[1] = a.y; o[2] = a.z; o[3] = a.w; o[4] = b.x; o[5] = b.y; o[6] = b.z; o[7] = b.w; }
__device__ __forceinline__ float sum8(float v) { v += dpp_f<0xB1>(v); v += dpp_f<0x4E>(v); v += dpp_f<0x141>(v); return v; }
__device__ __forceinline__ void unpack8(const v4u x, float (&o)[8]) {
    o[0] = bf2f((bf16)(x.x & 0xffffu)); o[1] = bf2f((bf16)(x.x >> 16)); o[2] = bf2f((bf16)(x.y & 0xffffu)); o[3] = bf2f((bf16)(x.y >> 16));
    o[4] = bf2f((bf16)(x.z & 0xffffu)); o[5] = bf2f((bf16)(x.z >> 16)); o[6] = bf2f((bf16)(x.w & 0xffffu)); o[7] = bf2f((bf16)(x.w >> 16)); }
__device__ __forceinline__ v4u pack8(const float (&o)[8]) { return (v4u){pk2(o[0], o[1]), pk2(o[2], o[3]), pk2(o[4], o[5]), pk2(o[6], o[7])}; }
__device__ __forceinline__ f32x4 mm16_gb(const LAS bf16* A, int lda, const bf16* B, int ldb, int K, f32x4 acc, int lane) {
    const int r = lane & 15, g = lane >> 4;
    const LAS bf16* ap = A + r * lda + 8 * g; const bf16* bp = B + r * ldb + 8 * g;
    for (int k0 = 0; k0 < K; k0 += 32) { const s16x8 a = *(const LAS s16x8*)(ap + k0); const s16x8 b = *(const s16x8*)(bp + k0); acc = __builtin_amdgcn_mfma_f32_16x16x32_bf16(a, b, acc, 0, 0, 0); }
    return acc;
}

__device__ __forceinline__ void ph_norm_b(const Ctx& C, const bf16* x, const float* g, const float* sh, const float* sc, bf16* XB) {
    const int gw = C.bid * 8 + C.wave, NGW = C.nb * 8, lane = C.lane;
    float gv[2][8];
#pragma unroll
    for (int j = 0; j < 2; ++j) ld8f(g + 8 * lane + 512 * j, gv[j]);
    for (int m0 = gw; m0 < M_; m0 += 4 * NGW) {
        v4u raw[4][2];
#pragma unroll
        for (int r = 0; r < 4; ++r) { const int m = m0 + r * NGW; const v4u* xr = (const v4u*)(x + (size_t)(m < M_ ? m : m0) * D_) + lane; raw[r][0] = xr[0]; raw[r][1] = xr[64]; }
#pragma unroll
        for (int r = 0; r < 4; ++r) { const int m = m0 + r * NGW; if (m >= M_) break;
            const int b = m / T_;
            float v[2][8]; float s = 0.f;
#pragma unroll
            for (int j = 0; j < 2; ++j) { unpack8(raw[r][j], v[j]);
#pragma unroll
                for (int i = 0; i < 8; ++i) s += v[j][i] * v[j][i]; }
            const float rstd = __builtin_amdgcn_rsqf(wave_sum(s) * (1.f / D_) + 1e-6f);
            v4u* o = (v4u*)(XB + (size_t)m * D_) + lane;
#pragma unroll
            for (int j = 0; j < 2; ++j) { const int col = 8 * lane + 512 * j; float shv[8], scv[8], h[8];
                ld8f(sh + b * 6144 + col, shv); ld8f(sc + b * 6144 + col, scv);
#pragma unroll
                for (int i = 0; i < 8; ++i) h[i] = v[j][i] * rstd * gv[j][i] * (scv[i] + 1.f) + shv[i];
                o[64 * j] = pack8(h); } }
    }
}
__device__ __forceinline__ void ph_final_b(const Ctx& C, const bf16* x, const float* g, float* out, int m_lo, int m_hi, bf16* keep, int c_lo, int c_hi) {
    const int gw = C.bid * 8 + C.wave, NGW = C.nb * 8, lane = C.lane;
    for (int m = m_lo + gw; m < m_hi; m += NGW) {
        const v4u* xr = (const v4u*)(x + (size_t)m * D_) + lane;
        float v[2][8]; float s = 0.f;
#pragma unroll
        for (int j = 0; j < 2; ++j) { unpack8(xr[64 * j], v[j]);
#pragma unroll
            for (int i = 0; i < 8; ++i) s += v[j][i] * v[j][i]; }
        const float rstd = 1.f / sqrtf(wave_sum(s) * (1.f / D_) + 1e-6f);
#pragma unroll
        for (int j = 0; j < 2; ++j) { const int col = 8 * lane + 512 * j; float gv[8]; ld8f(g + col, gv);
            f32x4* o = (f32x4*)(out + (size_t)m * D_ + col);
            o[0] = (f32x4){v[j][0] * rstd * gv[0], v[j][1] * rstd * gv[1], v[j][2] * rstd * gv[2], v[j][3] * rstd * gv[3]};
            o[1] = (f32x4){v[j][4] * rstd * gv[4], v[j][5] * rstd * gv[5], v[j][6] * rstd * gv[6], v[j][7] * rstd * gv[7]}; }
    }
    for (int m = c_lo + gw; m < c_hi; m += NGW) { const v4u* xr = (const v4u*)(x + (size_t)m * D_) + lane; v4u* kr = (v4u*)(keep + (size_t)(m - c_lo) * D_) + lane; kr[0] = xr[0]; kr[64] = xr[64]; }
}
__device__ __forceinline__ int rofs(int row, int t) { return row * RW_LD + ((((t >> 3) + (row >> 3)) & 7) << 3) + (t & 7); }
__device__ __forceinline__ void ph_rwkv_a(const Ctx& C, const bf16* PR, const bf16* VL  , const RwkvW& W, int layer,
                                          bf16* PP, bf16* QQ, bf16* RH, bf16* YH, float* GAMC, float* RK, bf16* GG, bf16* VF, bool store_v = true) {
    LAS unsigned char* L = C.lds;
    LAS bf16* X = (LAS bf16*)(L + RW_X); LAS float* CUM = (LAS float*)(L + RW_R0); LAS float* SEG = (LAS float*)(L + RW_SEG);
    LAS bf16* NI = (LAS bf16*)(L + RW_R0), *AAK = NI + 64 * RW_LD, *ARB = AAK + 64 * RW_LD, *ARK = ARB + 64 * RW_LD;
    LAS bf16* PRE = (LAS bf16*)(L + RW_R1);
    LAS bf16* AT = (LAS bf16*)(L + RW_R1), *BT = AT + 64 * RW_LD, *KT = BT + 64 * RW_LD, *RT = (LAS bf16*)(L + RW_R2);
    LAS bf16* XB16 = (LAS bf16*)(L + RW_R1);
    LAS bf16* BHc = (LAS bf16*)(L + RW_R3), *KHc = BHc + 64 * RW_LD, *VTc = KHc + 64 * RW_LD;
    LAS bf16* XT = (LAS bf16*)(L + RW_R4); LAS bf16* TI = (LAS bf16*)(L + RW_TI);
    const int wave = C.wave;
    LAS float* MU = (LAS float*)(L + RW_MU);
    for (int i = C.tid; i < 288; i += NT) MU[i] = i < 256 ? W.mu[1536 + i] : (layer ? W.mu_vres[i - 256] : 0.f);
    __syncthreads();
    for (int bc = C.bid; bc < 512; bc += C.nb) {
        const int c = bc & 127, b = bc >> 7;
        const size_t m0 = (size_t)b * T_ + c * 64;
        { const int tid = C.tid;
          v4u xc[5], xp[5];
#pragma unroll
          for (int it = 0; it < 5; ++it) { const int idx = tid + it * NT; xc[it] = (v4u){0u, 0u, 0u, 0u}; xp[it] = xc[it];
            if (idx < 64 * 36) { const int t1 = idx / 36, q = idx % 36, col = q * 8; const size_t m1 = m0 + t1; const bool first1 = (c == 0 && t1 == 0);
                if (q < 32) { xc[it] = *(const v4u*)(PR + m1 * NPR + 1536 + col); if (!first1) xp[it] = *(const v4u*)(PR + (m1 - 1) * NPR + 1536 + col); }
                else if (layer) { xc[it] = *(const v4u*)(VL + m1 * NPG + 1552 + (col - 256)); if (!first1) xp[it] = *(const v4u*)(VL + (m1 - 1) * NPG + 1552 + (col - 256)); } } }
#pragma unroll
          for (int it = 0; it < 5; ++it) { const int idx = tid + it * NT;
            if (idx < 64 * 36) { const int t1 = idx / 36, q = idx % 36, col = q * 8;
                float cv[8], pv[8], mu[8]; unpack8(xc[it], cv); unpack8(xp[it], pv);
                { const f32x4 ma = *(const LAS f32x4*)(MU + col), mb = *(const LAS f32x4*)(MU + col + 4); mu[0] = ma.x; mu[1] = ma.y; mu[2] = ma.z; mu[3] = ma.w; mu[4] = mb.x; mu[5] = mb.y; mu[6] = mb.z; mu[7] = mb.w; }
#pragma unroll
                for (int i = 0; i < 8; ++i) { float p = cv[i] + (pv[i] - cv[i]) * mu[i]; if (q < 8) p = tanh_fast(p); else if (q >= 16 && q < 32) p = sigmoidf_(p); cv[i] = p; }
                *(LAS v4u*)(X + t1 * RW_XLD + col) = pack8(cv); } }
        }
        __syncthreads();
      v4u rcx, kcx, vcx, rpx, kpx, vpx, vfx;
#define RW_FETCH(hh) do { const int t_ = C.tid >> 3, ch_ = (hh) * 64 + (C.tid & 7) * 8; const size_t m_ = m0 + t_; const bool first_ = (c == 0 && t_ == 0); \
        rcx = *(const v4u*)(PR + m_ * NPR + ch_); kcx = *(const v4u*)(PR + m_ * NPR + 512 + ch_); vcx = *(const v4u*)(PR + m_ * NPR + 1024 + ch_); \
        rpx = (v4u){0u, 0u, 0u, 0u}; kpx = rpx; vpx = rpx; vfx = rpx; \
        if (!first_) { rpx = *(const v4u*)(PR + (m_ - 1) * NPR + ch_); kpx = *(const v4u*)(PR + (m_ - 1) * NPR + 512 + ch_); vpx = *(const v4u*)(PR + (m_ - 1) * NPR + 1024 + ch_); } \
        if (layer) vfx = *(const v4u*)(VF + m_ * 512 + ch_); } while (0)
      RW_FETCH(0);
#pragma unroll 1
      for (int h = 0; h < 8; ++h) {
        const int item = bc * 8 + h;
        int tid_ = C.tid; asm volatile("" : "+v"(tid_));
        const int tid = tid_, lane = tid & 63, cc = lane & 15, g = lane >> 4;
        const int t = tid >> 3, d0 = (tid & 7) * 8, ch = h * 64 + d0; const size_t m = m0 + t;
        {
            const int lsel = wave >> 1;
            const bf16* WT = lsel == 0 ? W.wupT : lsel == 1 ? W.aupT : lsel == 2 ? W.gupT : W.vupT;
            const int Kl = lsel == 2 ? 128 : lsel == 3 ? 32 : 64, xoff = lsel == 0 ? 0 : lsel == 1 ? 64 : lsel == 2 ? 128 : 256;
            LAS bf16* outp = PRE + lsel * 64 * RW_LD;
            const bool live = (lsel != 3 || layer);
#pragma unroll
            for (int mq = 0; mq < 2; ++mq) { const int mt = (wave & 1) * 2 + mq;
                s16x8 af[4];
                const bf16* ap = WT + (size_t)(h * 64 + mt * 16 + cc) * Kl + 8 * g;
#pragma unroll
                for (int ks = 0; ks < 4; ++ks) af[ks] = (live && ks * 32 < Kl) ? *(const s16x8*)(ap + ks * 32) : (s16x8){0, 0, 0, 0, 0, 0, 0, 0};
#pragma unroll
                for (int nt = 0; nt < 4; ++nt) { f32x4 acc = {0.f, 0.f, 0.f, 0.f};
                    const LAS bf16* bp = X + (nt * 16 + cc) * RW_XLD + xoff + 8 * g;
#pragma unroll
                    for (int ks = 0; ks < 4; ++ks) if (ks * 32 < Kl) { const s16x8 bb = *(const LAS s16x8*)(bp + ks * 32); acc = __builtin_amdgcn_mfma_f32_16x16x32_bf16(af[ks], bb, acc, 0, 0, 0); }
                    *(LAS unsigned long long*)(outp + (nt * 16 + cc) * RW_LD + mt * 16 + 4 * g) = pack4(acc); } }
        }
        __syncthreads();
        float av[8], bv[8], kv[8], rv[8], lw[8], vv[8];
        {
            float rc[8], rp[8], kc[8], kp[8], vc[8], vp[8], pw[8], pa[8], pg_[8], pvg[8];
            unpack8(rcx, rc); unpack8(kcx, kc); unpack8(vcx, vc); unpack8(rpx, rp); unpack8(kpx, kp); unpack8(vpx, vp);
            unpack8(*(const LAS v4u*)(PRE + (0 * 64 + t) * RW_LD + d0), pw); unpack8(*(const LAS v4u*)(PRE + (1 * 64 + t) * RW_LD + d0), pa);
            unpack8(*(const LAS v4u*)(PRE + (2 * 64 + t) * RW_LD + d0), pg_); unpack8(*(const LAS v4u*)(PRE + (3 * 64 + t) * RW_LD + d0), pvg);
            float vf[8]; unpack8(vfx, vf);
            float ssq = 0.f, rks = 0.f, asg[8], gg[8];
            float mur[8], muk[8], muv[8], w0c[8], a0c[8], v0c[8], kkc[8], kac[8], rkc[8];
            ld8f(W.mu + ch, mur); ld8f(W.mu + 512 + ch, muk); ld8f(W.mu + 1024 + ch, muv); ld8f(W.w0 + ch, w0c); ld8f(W.a0 + ch, a0c);
            ld8f(W.k_k + ch, kkc); ld8f(W.k_a + ch, kac); ld8f(W.r_k + ch, rkc);
            if (layer) ld8f(W.v0 + ch, v0c);
#pragma unroll
            for (int i = 0; i < 8; ++i) {
                const float r = rc[i] + (rp[i] - rc[i]) * mur[i], k = kc[i] + (kp[i] - kc[i]) * muk[i]; float v = vc[i] + (vp[i] - vc[i]) * muv[i];
                lw[i] = -0.6065306597f * sigmoidf_(w0c[i] + pw[i]);
                asg[i] = sigmoidf_(a0c[i] + pa[i]);
                if (layer) v = v + (vf[i] - v) * sigmoidf_(v0c[i] + pvg[i]);
                const float kk = k * kkc[i]; ssq += kk * kk;
                kv[i] = k * (1.f + (asg[i] - 1.f) * kac[i]); rv[i] = r; vv[i] = v; gg[i] = pg_[i]; av[i] = kk;
                rks += r * kv[i] * rkc[i];
            }
            ssq = sum8(ssq); rks = sum8(rks);
            const float inv = __builtin_amdgcn_rsqf(fmaxf(ssq, 1e-24f));
#pragma unroll
            for (int i = 0; i < 8; ++i) { const float kk = av[i] * inv; av[i] = -kk; bv[i] = kk * asg[i]; }
            if ((tid & 7) == 0) RK[m * 8 + h] = rks;
            *(v4u*)(GG + m * 512 + ch) = pack8(gg);
            if (store_v) *(v4u*)(VF + m * 512 + ch) = pack8(vv);
#pragma unroll
            for (int i = 0; i < 8; ++i) vv[i] = bf2f((bf16)f2bf(vv[i]));
        }
        __syncthreads();
#pragma unroll
        for (int i = 0; i < 8; ++i) CUM[t * 64 + d0 + i] = lw[i];
        __syncthreads();
        { const int d = tid & 63, seg = tid >> 6; float run = 0.f;
#pragma unroll
          for (int q = 0; q < 8; ++q) { run += CUM[(seg * 8 + q) * 64 + d]; CUM[(seg * 8 + q) * 64 + d] = run; }
          SEG[seg * 64 + d] = run; }
        __syncthreads();
        { const int d = tid & 63, seg = tid >> 6; float off = 0.f;
          for (int s = 0; s < seg; ++s) off += SEG[s * 64 + d];
#pragma unroll
          for (int q = 0; q < 8; ++q) CUM[(seg * 8 + q) * 64 + d] += off; }
        __syncthreads();
        {
            float at[8], bt[8], kt[8], rt[8];
#pragma unroll
            for (int i = 0; i < 8; ++i) { const float cu = CUM[t * 64 + d0 + i], cC = CUM[63 * 64 + d0 + i], en = __expf(-cu), ec = __expf(cC - cu);
                at[i] = av[i] * __expf(cu - lw[i]); bt[i] = bv[i] * en; kt[i] = kv[i] * en; rt[i] = rv[i] * __expf(cu);
                { const int ro = rofs(d0 + i, t); BHc[ro] = (bf16)f2bf(bv[i] * ec); KHc[ro] = (bf16)f2bf(kv[i] * ec); VTc[ro] = (bf16)f2bf(vv[i]); XT[ro] = (bf16)f2bf(at[i]); }
                if (t == 63) GAMC[(size_t)item * 64 + d0 + i] = __expf(cC); }
            *(LAS v4u*)(AT + t * RW_LD + d0) = pack8(at); *(LAS v4u*)(BT + t * RW_LD + d0) = pack8(bt); *(LAS v4u*)(KT + t * RW_LD + d0) = pack8(kt); *(LAS v4u*)(RT + t * RW_LD + d0) = pack8(rt);
        }
        if (h < 7) RW_FETCH(h + 1);
        __syncthreads();
        {
            const int msel = wave >> 1;
            const LAS bf16* As = (msel == 0 || msel == 2) ? BT : KT; const LAS bf16* Bs = (msel < 2) ? AT : RT;
            f32x4 accs[8];
#pragma unroll
            for (int q = 0; q < 8; ++q) { const int tile = (wave & 1) * 8 + q, mt = tile >> 2, nt = tile & 3; accs[q] = (f32x4){0.f, 0.f, 0.f, 0.f};
                accs[q] = mm16(As + mt * 16 * RW_LD, RW_LD, Bs + nt * 16 * RW_LD, RW_LD, 64, accs[q], lane);
                const int tt = nt * 16 + cc, s0 = mt * 16 + 4 * g, lim = (msel < 2) ? tt - 1 : tt;
                accs[q].x = (s0 + 0 <= lim) ? accs[q].x : 0.f; accs[q].y = (s0 + 1 <= lim) ? accs[q].y : 0.f; accs[q].z = (s0 + 2 <= lim) ? accs[q].z : 0.f; accs[q].w = (s0 + 3 <= lim) ? accs[q].w : 0.f; }
            __syncthreads();
            LAS bf16* outp = NI + msel * 64 * RW_LD;
#pragma unroll
            for (int q = 0; q < 8; ++q) { const int tile = (wave & 1) * 8 + q, mt = tile >> 2, nt = tile & 3;
                *(LAS unsigned long long*)(outp + (nt * 16 + cc) * RW_LD + mt * 16 + 4 * g) = pack4(accs[q]); }
        }
        __syncthreads();
        if (wave == 0) {
            const int blk = lane >> 4, col = lane & 15; float x[16];
#pragma unroll
            for (int tt = 0; tt < 16; ++tt) { float nr[16]; { float lo[8], hi[8]; unpack8(*(const LAS v4u*)(NI + (16 * blk + tt) * RW_LD + 16 * blk), lo); unpack8(*(const LAS v4u*)(NI + (16 * blk + tt) * RW_LD + 16 * blk + 8), hi);
#pragma unroll
                    for (int q = 0; q < 8; ++q) { nr[q] = lo[q]; nr[8 + q] = hi[q]; } }
                float a = (tt == col) ? 1.f : 0.f;
#pragma unroll
                for (int q = 0; q < tt; ++q) a += nr[q] * x[q];
                x[tt] = a; TI[(blk * 16 + tt) * 16 + col] = (bf16)f2bf(a); }
        } else {
            for (int tile = wave - 1; tile < 16; tile += 7) { const int mt = tile >> 2, nt = tile & 3;
                f32x4 acc = {0.f, 0.f, 0.f, 0.f};
#pragma unroll
                for (int k = 0; k < 2; ++k) { const s16x8 a = *(const LAS s16x8*)(AAK + (mt * 16 + cc) * RW_LD + 32 * k + 8 * g), bb = *(const LAS s16x8*)(VTc + rofs(nt * 16 + cc, 32 * k + 8 * g)); acc = __builtin_amdgcn_mfma_f32_16x16x32_bf16(a, bb, acc, 0, 0, 0); }
                *(LAS unsigned long long*)(XT + rofs(64 + nt * 16 + cc, mt * 16 + 4 * g)) = pack4(acc); }
        }
        __syncthreads();
        {
            s16x4 xb[4];
#pragma unroll
            for (int i = 0; i < 4; ++i) {
                f32x4 acc; { const unsigned long long xr = *(const LAS unsigned long long*)(XT + rofs(wave * 16 + cc, 16 * i + 4 * g));
                    acc.x = bf2f((bf16)(xr & 0xffffu)); acc.y = bf2f((bf16)((xr >> 16) & 0xffffu)); acc.z = bf2f((bf16)((xr >> 32) & 0xffffu)); acc.w = bf2f((bf16)(xr >> 48)); }
#pragma unroll
                for (int k = 0; k < i; ++k) { const s16x4 a = *(const LAS s16x4*)(NI + (16 * i + cc) * RW_LD + 16 * k + 4 * g); acc = __builtin_amdgcn_mfma_f32_16x16x16bf16_1k(a, xb[k], acc, 0, 0, 0); }
                const s16x4 yb = cvt4(acc), ta = *(const LAS s16x4*)(TI + (i * 16 + cc) * 16 + 4 * g);
                const f32x4 xi = __builtin_amdgcn_mfma_f32_16x16x16bf16_1k(ta, yb, (f32x4){0.f, 0.f, 0.f, 0.f}, 0, 0, 0);
                xb[i] = cvt4(xi);
            }
            __syncthreads();
#pragma unroll
            for (int i = 0; i < 4; ++i) *(LAS s16x4*)(XB16 + (wave * 16 + cc) * RW_LD + 16 * i + 4 * g) = xb[i];
        }
        __syncthreads();
        {
            const int osel = wave >> 1, mt0 = (wave & 1) * 2; const size_t ob = (size_t)item * 4096;
            const LAS bf16* A1 = osel == 0 ? XB16 : osel == 1 ? BHc : osel == 2 ? XB16 : XB16 + 64 * RW_LD;
            const LAS bf16* B1 = osel == 0 ? BHc : osel == 1 ? XB16 + 64 * RW_LD : ARB;
            const LAS bf16* A2 = osel == 1 ? KHc : VTc; const LAS bf16* B2 = osel == 1 ? VTc : ARK;
            const bool rA1 = osel == 1, rB1 = osel == 0, rA2 = true, rB2 = osel == 1;
#define RW_FO(rot, row, k) ((rot) ? rofs((row), 32 * (k) + 8 * g) : (row) * RW_LD + 32 * (k) + 8 * g)
            bf16* OUT = osel == 0 ? PP : osel == 1 ? QQ : osel == 2 ? RH : YH;
            f32x4 acc[2][4];
#pragma unroll
            for (int mq = 0; mq < 2; ++mq)
#pragma unroll
                for (int nt = 0; nt < 4; ++nt) acc[mq][nt] = (f32x4){0.f, 0.f, 0.f, 0.f};
            { s16x8 af[2][2], bfm[4][2];
#pragma unroll
              for (int mq = 0; mq < 2; ++mq)
#pragma unroll
                  for (int k = 0; k < 2; ++k) af[mq][k] = *(const LAS s16x8*)(A1 + RW_FO(rA1, (mt0 + mq) * 16 + cc, k));
#pragma unroll
              for (int nt = 0; nt < 4; ++nt)
#pragma unroll
                  for (int k = 0; k < 2; ++k) bfm[nt][k] = *(const LAS s16x8*)(B1 + RW_FO(rB1, nt * 16 + cc, k));
#pragma unroll
              for (int mq = 0; mq < 2; ++mq)
#pragma unroll
                  for (int nt = 0; nt < 4; ++nt) { acc[mq][nt] = __builtin_amdgcn_mfma_f32_16x16x32_bf16(af[mq][0], bfm[nt][0], acc[mq][nt], 0, 0, 0); acc[mq][nt] = __builtin_amdgcn_mfma_f32_16x16x32_bf16(af[mq][1], bfm[nt][1], acc[mq][nt], 0, 0, 0); } }
            if (osel & 1) { s16x8 af[2][2], bfm[4][2];
#pragma unroll
              for (int mq = 0; mq < 2; ++mq)
#pragma unroll
                  for (int k = 0; k < 2; ++k) af[mq][k] = *(const LAS s16x8*)(A2 + RW_FO(rA2, (mt0 + mq) * 16 + cc, k));
#pragma unroll
              for (int nt = 0; nt < 4; ++nt)
#pragma unroll
                  for (int k = 0; k < 2; ++k) bfm[nt][k] = *(const LAS s16x8*)(B2 + RW_FO(rB2, nt * 16 + cc, k));
#pragma unroll
              for (int mq = 0; mq < 2; ++mq)
#pragma unroll
                  for (int nt = 0; nt < 4; ++nt) { acc[mq][nt] = __builtin_amdgcn_mfma_f32_16x16x32_bf16(af[mq][0], bfm[nt][0], acc[mq][nt], 0, 0, 0); acc[mq][nt] = __builtin_amdgcn_mfma_f32_16x16x32_bf16(af[mq][1], bfm[nt][1], acc[mq][nt], 0, 0, 0); } }
#pragma unroll
            for (int mq = 0; mq < 2; ++mq)
#pragma unroll
                for (int nt = 0; nt < 4; ++nt) { f32x4 a = acc[mq][nt];
                    if (osel == 2) { const unsigned long long rr = *(const LAS unsigned long long*)(RT + (nt * 16 + cc) * RW_LD + (mt0 + mq) * 16 + 4 * g);
                        a.x += bf2f((bf16)(rr & 0xffffu)); a.y += bf2f((bf16)((rr >> 16) & 0xffffu)); a.z += bf2f((bf16)((rr >> 32) & 0xffffu)); a.w += bf2f((bf16)(rr >> 48)); }
                    const int co = osel < 2 ? ((mt0 + mq) >> 1) * 32 + g * 8 + ((mt0 + mq) & 1) * 4 : (mt0 + mq) * 16 + 4 * g;
                    *(unsigned long long*)(OUT + ob + (nt * 16 + cc) * 64 + co) = pack4(a); }
        }
        __syncthreads();
      }
    }
}

#undef RW_FETCH
#undef RW_FO
constexpr int CH_R = 6, CH_LDB = 160, CH_IMG = 64 * CH_LDB, CH_SLOT = 2 * CH_IMG + 256;
constexpr int CH_RING = 0, CH_FLAGS = CH_R * CH_SLOT;
static_assert(CH_FLAGS + 64 <= MISC_OFF, "chain LDS map");
struct ChainRegs { v4u p[8], q[8]; f32x4 gm; };
__device__ __forceinline__ void chain_fetch(ChainRegs& o, const bf16* PP, const bf16* QQ, const float* GAMC, int item, int lane) {
    const size_t ob = (size_t)item * 4096;
#pragma unroll
    for (int i = 0; i < 8; ++i) { o.p[i] = *(const v4u*)(PP + ob + (size_t)(i * 64 + lane) * 8); o.q[i] = *(const v4u*)(QQ + ob + (size_t)(i * 64 + lane) * 8); }
    o.gm = *(const f32x4*)(GAMC + (size_t)item * 64 + (lane & 15) * 4);
}
__device__ __forceinline__ void chain_commit(const ChainRegs& o, LAS unsigned char* L, int c, int lane) {
    volatile LAS unsigned* flags = (volatile LAS unsigned*)(L + CH_FLAGS);
    const int slot = c % CH_R;
    if (c >= CH_R) { const unsigned need = (unsigned)(c - CH_R + 1);
        for (;;) { const unsigned m0 = flags[CH_R + 0], m1 = flags[CH_R + 1], m2 = flags[CH_R + 2], m3 = flags[CH_R + 3];
            if (m0 >= need && m1 >= need && m2 >= need && m3 >= need) break; __builtin_amdgcn_s_sleep(1); } }
    asm volatile("" ::: "memory");
    LAS unsigned char* sl = L + CH_RING + slot * CH_SLOT;
#pragma unroll
    for (int i = 0; i < 8; ++i) { const int idx = i * 64 + lane, row = idx >> 3, c16 = idx & 7;
        *(LAS v4u*)(sl + row * CH_LDB + c16 * 16) = o.p[i]; *(LAS v4u*)(sl + CH_IMG + row * CH_LDB + c16 * 16) = o.q[i]; }
    *(LAS f32x4*)(sl + 2 * CH_IMG + (lane & 15) * 16) = o.gm;
    asm volatile("s_waitcnt lgkmcnt(0)" ::: "memory");
    if (lane == 0) flags[slot] = (unsigned)(c + 1);
}
struct ChainOps { s16x8 a[4][2]; v4u q[2]; f32x4 gm[4]; };
__device__ __forceinline__ void chain_read(ChainOps& X, LAS unsigned char* L, int c, int vt, int cc, int g) {
    const LAS unsigned char* sl = L + CH_RING + (c % CH_R) * CH_SLOT;
#pragma unroll
    for (int mt = 0; mt < 4; ++mt) {
#pragma unroll
        for (int kb = 0; kb < 2; ++kb) X.a[mt][kb] = *(const LAS s16x8*)(sl + (mt * 16 + cc) * CH_LDB + kb * 64 + g * 16);
        X.gm[mt] = *(const LAS f32x4*)(sl + 2 * CH_IMG + (mt * 16 + 4 * g) * 4); }
#pragma unroll
    for (int kb = 0; kb < 2; ++kb) X.q[kb] = *(const LAS v4u*)(sl + CH_IMG + (vt * 16 + cc) * CH_LDB + kb * 64 + g * 16);
}
__device__ __forceinline__ void chain_step(const ChainOps& X, ChainOps& Y, f32x4 (&st)[4], LAS unsigned char* L, volatile LAS unsigned* flags, bf16* S0, size_t ob, int c, int vt, int cc, int g, int lane) {
    unsigned long long pk[4];
#pragma unroll
    for (int mt = 0; mt < 4; ++mt) { pk[mt] = pack4(st[mt]); *(unsigned long long*)(S0 + ob + (vt * 16 + cc) * 64 + mt * 16 + 4 * g) = pk[mt]; }
    asm volatile("s_waitcnt lgkmcnt(0)" ::: "memory");
    if (lane == 0) flags[CH_R + vt] = (unsigned)(c + 1);
    if (c + 1 < 128) {
        while (flags[(c + 1) % CH_R] < (unsigned)(c + 2)) __builtin_amdgcn_s_sleep(1);
        asm volatile("s_waitcnt lgkmcnt(0)" ::: "memory");
        chain_read(Y, L, c + 1, vt, cc, g); }
    s16x8 bq[2];
#pragma unroll
    for (int kb = 0; kb < 2; ++kb) { const unsigned long long lo = pk[2 * kb], hi = pk[2 * kb + 1];
        bq[kb] = __builtin_bit_cast(s16x8, (v4u){(unsigned)lo, (unsigned)(lo >> 32), (unsigned)hi, (unsigned)(hi >> 32)}); }
#pragma unroll
    for (int mt = 0; mt < 4; ++mt) { const unsigned q0 = (mt & 1) ? X.q[mt >> 1].z : X.q[mt >> 1].x, q1 = (mt & 1) ? X.q[mt >> 1].w : X.q[mt >> 1].y; const f32x4 gm = X.gm[mt];
        f32x4 acc; acc.x = gm.x * st[mt].x + bf2f((bf16)(q0 & 0xffffu)); acc.y = gm.y * st[mt].y + bf2f((bf16)(q0 >> 16));
        acc.z = gm.z * st[mt].z + bf2f((bf16)(q1 & 0xffffu)); acc.w = gm.w * st[mt].w + bf2f((bf16)(q1 >> 16));
#pragma unroll
        for (int kb = 0; kb < 2; ++kb) acc = __builtin_amdgcn_mfma_f32_16x16x32_bf16(X.a[mt][kb], bq[kb], acc, 0, 0, 0);
        st[mt] = acc; }
}
__device__ __forceinline__ void ph_rwkv_b(const Ctx& C, int bh  , const bf16* PP, const bf16* QQ, const float* GAMC, bf16* S0) {
    const int lane = C.lane, wave = C.wave, cc = lane & 15, g = lane >> 4, b = bh >> 3, h = bh & 7;
    LAS unsigned char* L = C.lds;
    volatile LAS unsigned* flags = (volatile LAS unsigned*)(L + CH_FLAGS);
    if (C.tid < 16) flags[C.tid] = 0u;
    __syncthreads();
    if (wave >= 4) {
        const int j = wave - 4;
        ChainRegs A, B;
        int lc = j;
        chain_fetch(A, PP, QQ, GAMC, (b * 128 + lc) * 8 + h, lane);
        for (int it = 0; it < 16; ++it) {
            chain_fetch(B, PP, QQ, GAMC, (b * 128 + min(lc + 4, 124 + j)) * 8 + h, lane);
            chain_commit(A, L, lc, lane);
            lc += 4;
            chain_fetch(A, PP, QQ, GAMC, (b * 128 + min(lc + 4, 124 + j)) * 8 + h, lane);
            chain_commit(B, L, lc, lane);
            lc += 4;
        }
    } else {
        const int vt = wave;
        f32x4 st[4];
#pragma unroll
        for (int mt = 0; mt < 4; ++mt) st[mt] = (f32x4){0.f, 0.f, 0.f, 0.f};
        ChainOps X0, X1;
        while (flags[0] < 1u) __builtin_amdgcn_s_sleep(1);
        asm volatile("s_waitcnt lgkmcnt(0)" ::: "memory");
        chain_read(X0, L, 0, vt, cc, g);
        for (int c = 0; c < 128; c += 2) {
            chain_step(X0, X1, st, L, flags, S0, (size_t)((b * 128 + c) * 8 + h) * 4096, c, vt, cc, g, lane);
            chain_step(X1, X0, st, L, flags, S0, (size_t)((b * 128 + c + 1) * 8 + h) * 4096, c + 1, vt, cc, g, lane);
        }
    }
    __syncthreads();
}

__device__ __forceinline__ void ph_rwkv_c(const Ctx& C, const bf16* S0, const bf16* RH, const bf16* YH, const float* RK, const bf16* GG, const bf16* VF,
                                          const float* gn_g, const float* gn_b, bf16* O) {
    const int lane = C.lane, cc = lane & 15, g = lane >> 4;
    for (int item = C.bid * 8 + C.wave; item < 4096; item += C.nb * 8) {
        const int h = item & 7, c = (item >> 3) & 127, b = item >> 10; const size_t m0 = (size_t)b * T_ + c * 64, ob = (size_t)item * 4096;
        s16x8 af[4][2], bfr[4][2];
#pragma unroll
        for (int q = 0; q < 4; ++q)
#pragma unroll
            for (int k = 0; k < 2; ++k) { af[q][k] = *(const s16x8*)(S0 + ob + (q * 16 + cc) * 64 + k * 32 + 8 * g); bfr[q][k] = *(const s16x8*)(RH + ob + (q * 16 + cc) * 64 + k * 32 + 8 * g); }
#pragma unroll
        for (int nt = 0; nt < 4; ++nt) {
            const size_t m = m0 + nt * 16 + cc;
            f32x4 y[4]; float s1 = 0.f;
#pragma unroll
            for (int mt = 0; mt < 4; ++mt) { const unsigned long long yh = *(const unsigned long long*)(YH + ob + (nt * 16 + cc) * 64 + mt * 16 + 4 * g);
                f32x4 acc; acc.x = bf2f((bf16)(yh & 0xffffu)); acc.y = bf2f((bf16)((yh >> 16) & 0xffffu)); acc.z = bf2f((bf16)((yh >> 32) & 0xffffu)); acc.w = bf2f((bf16)(yh >> 48));
                acc = __builtin_amdgcn_mfma_f32_16x16x32_bf16(af[mt][0], bfr[nt][0], acc, 0, 0, 0); acc = __builtin_amdgcn_mfma_f32_16x16x32_bf16(af[mt][1], bfr[nt][1], acc, 0, 0, 0);
                y[mt] = acc; s1 += (acc.x + acc.y) + (acc.z + acc.w); }
            s1 = xsum4(s1);
            const float mean = s1 * (1.f / 64.f); float s2 = 0.f;
#pragma unroll
            for (int mt = 0; mt < 4; ++mt) { y[mt] = y[mt] - mean; s2 += (y[mt].x * y[mt].x + y[mt].y * y[mt].y) + (y[mt].z * y[mt].z + y[mt].w * y[mt].w); }
            s2 = xsum4(s2);
            const float rstd = __builtin_amdgcn_rsqf(s2 * (1.f / 64.f) + 64e-5f), rk = RK[m * 8 + h];
#pragma unroll
            for (int mt = 0; mt < 4; ++mt) { const int v = h * 64 + mt * 16 + 4 * g;
                const f32x4 gg4 = *(const f32x4*)(gn_g + v), gb4 = *(const f32x4*)(gn_b + v);
                const unsigned long long vx = *(const unsigned long long*)(VF + m * 512 + v), gx = *(const unsigned long long*)(GG + m * 512 + v);
                f32x4 o;
                o.x = (y[mt].x * rstd * gg4.x + gb4.x + rk * bf2f((bf16)(vx & 0xffffu))) * bf2f((bf16)(gx & 0xffffu));
                o.y = (y[mt].y * rstd * gg4.y + gb4.y + rk * bf2f((bf16)((vx >> 16) & 0xffffu))) * bf2f((bf16)((gx >> 16) & 0xffffu));
                o.z = (y[mt].z * rstd * gg4.z + gb4.z + rk * bf2f((bf16)((vx >> 32) & 0xffffu))) * bf2f((bf16)((gx >> 32) & 0xffffu));
                o.w = (y[mt].w * rstd * gg4.w + gb4.w + rk * bf2f((bf16)(vx >> 48))) * bf2f((bf16)(gx >> 48));
                *(unsigned long long*)(O + m * D_ + 512 + v) = pack4(o); }
        }
    }
}

__device__ __forceinline__ void ph_convfix(const Ctx& C, const float* HALO, const float* FIXU, const float* cw, const float* cb, bf16* ACT) {
    for (int idx = C.bid * NT + C.tid; idx < 128 * 22 * 2 * 128; idx += C.nb * NT) {
        const int j = idx & 127, rr = (idx >> 7) & 1, tile = idx >> 8, pm = tile / 22, pn = tile % 22;
        const bool seq0 = (pm & 31) == 0;
        const float* fx = FIXU + (size_t)tile * 512; const float* hl = HALO + (size_t)(tile - 22) * 512;
        const float u0g = fx[rr * 256 + j], u0v = fx[rr * 256 + 128 + j];
        float u1g, u1v, u2g, u2v;
        if (rr == 0) { u1g = seq0 ? 0.f : hl[256 + j]; u1v = seq0 ? 0.f : hl[256 + 128 + j]; u2g = seq0 ? 0.f : hl[j]; u2v = seq0 ? 0.f : hl[128 + j]; }
        else { u1g = fx[j]; u1v = fx[128 + j]; u2g = seq0 ? 0.f : hl[256 + j]; u2v = seq0 ? 0.f : hl[256 + 128 + j]; }
        const int jg = pn * 128 + j, jv = DFF + jg;
        const float gc = cb[jg] + cw[jg] * u2g + cw[NUP + jg] * u1g + cw[2 * NUP + jg] * u0g, vc = cb[jv] + cw[jv] * u2v + cw[NUP + jv] * u1v + cw[2 * NUP + jv] * u0v;
        ACT[(size_t)(pm * 256 + rr) * DFF + jg] = (bf16)f2bf(siluf_(gc) * vc);
    }
}
}

namespace pg8 {
struct EpiRes {
    static constexpr bool PERM = false, AFTER_DRAIN = false;
    const float* base; float* out; const float* gate; int gstride;
    __device__ __forceinline__ void operator()(const f32x4 (&acc)[2][2][4][2], const Unit& u, int wr, int wc, int fr, int fq) const {
        const int b = (u.pm * BM) / 8192; const float* gp = gate + (size_t)b * gstride;
        const int col0 = u.pn * BM + wc * 32 + 4 * fq;
        f32x4 gv[2][2];
#pragma unroll
        for (int bj = 0; bj < 2; ++bj)
#pragma unroll
            for (int n = 0; n < 2; ++n) gv[bj][n] = *(const f32x4*)(gp + col0 + bj * HALF + n * 16);
#pragma unroll
        for (int ai = 0; ai < 2; ++ai)
#pragma unroll
            for (int m = 0; m < 4; ++m) { const size_t off = (size_t)(u.pm * BM + ai * HALF + wr * 64 + m * 16 + fr) * 1024 + col0;
                f32x4 bs[2][2];
#pragma unroll
                for (int bj = 0; bj < 2; ++bj)
#pragma unroll
                    for (int n = 0; n < 2; ++n) bs[bj][n] = *(const f32x4*)(base + off + bj * HALF + n * 16);
#pragma unroll
                for (int bj = 0; bj < 2; ++bj)
#pragma unroll
                    for (int n = 0; n < 2; ++n) *(f32x4*)(out + off + bj * HALF + n * 16) = bs[bj][n] + gv[bj][n] * acc[ai][bj][m][n]; }
    }
};

template <bool BASE32> struct EpiResB {
    static constexpr bool PERM = true, AFTER_DRAIN = false;
    const float* base32; const bf16_t* Rin; bf16_t* R; const float* gate; int gstride;
    __device__ __forceinline__ void operator()(const f32x4 (&acc)[2][2][4][2], const Unit& u, int wr, int wc, int fr, int fq) const {
        const int b = u.pm >> 5; const float* gp = gate + (size_t)b * gstride;
        const int col0 = u.pn * BM + wc * 32 + 8 * fq;
        f32x4 gv[2][2];
#pragma unroll
        for (int bj = 0; bj < 2; ++bj)
#pragma unroll
            for (int n = 0; n < 2; ++n) gv[bj][n] = *(const f32x4*)(gp + col0 + bj * HALF + n * 4);
#pragma unroll
        for (int ai = 0; ai < 2; ++ai)
#pragma unroll
            for (int m = 0; m < 4; ++m) { const size_t off = (size_t)(u.pm * BM + ai * HALF + wr * 64 + m * 16 + fr) * 1024 + col0;
                f32x4 bs[2][2];
#pragma unroll
                for (int bj = 0; bj < 2; ++bj) {
                    if (BASE32) { bs[bj][0] = *(const f32x4*)(base32 + off + bj * HALF); bs[bj][1] = *(const f32x4*)(base32 + off + bj * HALF + 4); }
                    else { const u32x4 r = *(const u32x4*)(Rin + off + bj * HALF);
                        bs[bj][0] = (f32x4){__builtin_bit_cast(float, r.x << 16), __builtin_bit_cast(float, r.x & 0xffff0000u), __builtin_bit_cast(float, r.y << 16), __builtin_bit_cast(float, r.y & 0xffff0000u)};
                        bs[bj][1] = (f32x4){__builtin_bit_cast(float, r.z << 16), __builtin_bit_cast(float, r.z & 0xffff0000u), __builtin_bit_cast(float, r.w << 16), __builtin_bit_cast(float, r.w & 0xffff0000u)}; } }
#pragma unroll
                for (int bj = 0; bj < 2; ++bj) { const f32x4 o0 = bs[bj][0] + gv[bj][0] * acc[ai][bj][m][0], o1 = bs[bj][1] + gv[bj][1] * acc[ai][bj][m][1];
                    u32x4 w; w.x = cvt_pk_bf16(o0.x, o0.y); w.y = cvt_pk_bf16(o0.z, o0.w); w.z = cvt_pk_bf16(o1.x, o1.y); w.w = cvt_pk_bf16(o1.z, o1.w);
                    *(u32x4*)(R + off + bj * HALF) = w; } }
    }
};
struct EpiConv {
    static constexpr bool PERM = true, AFTER_DRAIN = false;
    bf16_t* ACT; const float* cw; const float* cb; float* HALO; float* FIXU; PG8_LAS float* EX; int nN;
    template <int CTRL> static __device__ __forceinline__ float ror1(float x) { return __builtin_bit_cast(float, __builtin_amdgcn_mov_dpp(__builtin_bit_cast(int, x), CTRL, 0xf, 0xf, true)); }
    template <int CTRL> static __device__ __forceinline__ f32x4 ror4(f32x4 x) { return (f32x4){ror1<CTRL>(x.x), ror1<CTRL>(x.y), ror1<CTRL>(x.z), ror1<CTRL>(x.w)}; }
    template <int CTRL> static __device__ __forceinline__ float shr1(float old, float x) { return __builtin_bit_cast(float, __builtin_amdgcn_update_dpp(__builtin_bit_cast(int, old), __builtin_bit_cast(int, x), CTRL, 0xf, 0xf, false)); }
    template <int CTRL> static __device__ __forceinline__ f32x4 shr4(f32x4 o, f32x4 x) { return (f32x4){shr1<CTRL>(o.x, x.x), shr1<CTRL>(o.y, x.y), shr1<CTRL>(o.z, x.z), shr1<CTRL>(o.w, x.w)}; }
    __device__ __forceinline__ void operator()(const f32x4 (&acc)[2][2][4][2], const Unit& u, int wr, int wc, int fr, int fq) const {
        const int colw = wc * 32 + 8 * fq, tile = u.pm * nN + u.pn;
        if (fr >= 14) {
#pragma unroll
            for (int ai = 0; ai < 2; ++ai)
#pragma unroll
                for (int bj = 0; bj < 2; ++bj)
#pragma unroll
                    for (int n = 0; n < 2; ++n) { *(PG8_LAS f32x4*)(EX + ((ai * 2 + wr) * 2 + (fr - 14)) * 256 + bj * 128 + colw + 4 * n) = acc[ai][bj][3][n];
                        if (ai == 1 && wr == 1) *(f32x4*)(HALO + ((size_t)tile * 2 + (fr - 14)) * 256 + bj * 128 + colw + 4 * n) = acc[1][bj][3][n]; }
        }
        if (fr < 2 && wr == 0) {
#pragma unroll
            for (int bj = 0; bj < 2; ++bj)
#pragma unroll
                for (int n = 0; n < 2; ++n) *(f32x4*)(FIXU + ((size_t)tile * 2 + fr) * 256 + bj * 128 + colw + 4 * n) = acc[0][bj][0][n];
        }
        asm volatile("s_waitcnt lgkmcnt(0)" ::: "memory"); __builtin_amdgcn_s_barrier(); asm volatile("" ::: "memory");
#pragma unroll
        for (int n = 0; n < 2; ++n) {
            const int jg = u.pn * 128 + colw + 4 * n, jv = 2816 + jg;
            f32x4 cw0[2], cw1[2], cw2[2], cbb[2];
            cw0[0] = *(const f32x4*)(cw + jg); cw1[0] = *(const f32x4*)(cw + 5632 + jg); cw2[0] = *(const f32x4*)(cw + 2 * 5632 + jg); cbb[0] = *(const f32x4*)(cb + jg);
            cw0[1] = *(const f32x4*)(cw + jv); cw1[1] = *(const f32x4*)(cw + 5632 + jv); cw2[1] = *(const f32x4*)(cw + 2 * 5632 + jv); cbb[1] = *(const f32x4*)(cb + jv);
#pragma unroll
            for (int ai = 0; ai < 2; ++ai) {
                const int src = ai * 2 + wr - 1;
                f32x4 res[2][4];
#pragma unroll
                for (int bj = 0; bj < 2; ++bj) {
                    f32x4 o1 = {0.f, 0.f, 0.f, 0.f}, o2 = o1;
                    if (src >= 0) { const f32x4 e14 = *(const PG8_LAS f32x4*)(EX + (src * 2 + 0) * 256 + bj * 128 + colw + 4 * n), e15 = *(const PG8_LAS f32x4*)(EX + (src * 2 + 1) * 256 + bj * 128 + colw + 4 * n);
                        o1 = e15; o2 = (fr == 0) ? e14 : e15; }
#pragma unroll
                    for (int m = 0; m < 4; ++m) {
                        const f32x4 x = acc[ai][bj][m][n];
                        const f32x4 x1 = shr4<0x111>(o1, x), x2 = shr4<0x112>(o2, x);
                        res[bj][m] = cbb[bj] + cw0[bj] * x2 + cw1[bj] * x1 + cw2[bj] * x;
                        if (m < 3) { o1 = ror4<0x121>(x); o2 = ror4<0x122>(x); }
                    }
                }
#pragma unroll
                for (int m = 0; m < 4; ++m) {
                    const f32x4 gc = res[0][m], vc = res[1][m];
                    f32x4 o;
                    o.x = gc.x * __builtin_amdgcn_rcpf(1.f + __expf(-gc.x)) * vc.x; o.y = gc.y * __builtin_amdgcn_rcpf(1.f + __expf(-gc.y)) * vc.y;
                    o.z = gc.z * __builtin_amdgcn_rcpf(1.f + __expf(-gc.z)) * vc.z; o.w = gc.w * __builtin_amdgcn_rcpf(1.f + __expf(-gc.w)) * vc.w;
                    typedef unsigned u32x2 __attribute__((ext_vector_type(2)));
                    u32x2 w; w.x = cvt_pk_bf16(o.x, o.y); w.y = cvt_pk_bf16(o.z, o.w);
                    *(u32x2*)(ACT + (size_t)(u.pm * BM + ai * HALF + wr * 64 + m * 16 + fr) * 2816 + u.pn * 128 + colw + 4 * n) = w;
                }
            }
        }
    }
};
}

namespace hy {
struct Args { const float* in[31]; float* out; unsigned char* ws; };
__global__ void __launch_bounds__(NT, 2) hy_fwd(Args A) {
    extern __shared__ __attribute__((aligned(16))) unsigned char lds_raw[];
    Ctx C; C.bid = blockIdx.x; C.nb = gridDim.x; C.tid = threadIdx.x; C.lane = C.tid & 63; C.wave = __builtin_amdgcn_readfirstlane(C.tid >> 6); C.lds = (LAS unsigned char*)lds_raw;
    volatile LAS unsigned* MISC = (volatile LAS unsigned*)(C.lds + MISC_OFF);
    for (int u = C.tid; u < (LDS_BYTES - MISC_OFF) / 4; u += NT) ((LAS unsigned*)(C.lds + MISC_OFF))[u] = 0u;
    __syncthreads();
    unsigned char* ws = A.ws;
    const int wave0 = __builtin_amdgcn_readfirstlane(threadIdx.x >> 6);
    (void)xcd_barrier_post((unsigned*)(ws + WS_CTL) + CW_BAR, MISC + 8);
#define PHASE_BEGIN() do { int t_ = wave0 * 64 + lane_now(); int b_ = blockIdx.x; asm volatile("" : "+s"(b_)); \
    C.tid = t_; C.lane = t_ & 63; C.wave = __builtin_amdgcn_readfirstlane(t_ >> 6); C.bid = b_; } while (0)
#ifdef HY_DIAG
    unsigned long long ts_last = __builtin_amdgcn_s_memrealtime(); float tacc[10] = {0.f, 0.f, 0.f, 0.f, 0.f, 0.f, 0.f, 0.f, 0.f, 0.f};
#define GRID_BAR(cat) do { { XcdBarrier b_; b_.bar = (unsigned*)(A.ws + WS_CTL) + CW_BAR; b_.x = xb_xcc_id(); b_.st = (volatile LAS unsigned*)(C.lds + MISC_OFF) + 8; xcd_barrier(b_, wave0 == 0 && lane_now() == 0); } PHASE_BEGIN(); { const unsigned long long n_ = __builtin_amdgcn_s_memrealtime(); tacc[cat] += (float)(n_ - ts_last); ts_last = n_; } } while (0)
#else
#define GRID_BAR(cat) do { { XcdBarrier b_; b_.bar = (unsigned*)(A.ws + WS_CTL) + CW_BAR; b_.x = xb_xcc_id(); b_.st = (volatile LAS unsigned*)(C.lds + MISC_OFF) + 8; xcd_barrier(b_, wave0 == 0 && lane_now() == 0); } PHASE_BEGIN(); } while (0)
#endif
#ifndef HY_REPCAT
#define HY_REPCAT (-1)
#endif
#ifndef HY_REPN
#define HY_REPN 2
#endif
#define NREP(cat) ((HY_REPCAT == (cat)) ? HY_REPN : 1)
    float* out = A.out;
    bf16* RES = (bf16*)((unsigned char*)A.out + 64 * MiB);
#define in A.in
    float* MOD = (float*)(ws + WS_MOD);
    bf16 *WIN = (bf16*)(ws + WS_WIN), *WOUT = (bf16*)(ws + WS_WOUT), *WUP = (bf16*)(ws + WS_WUP), *WDN = (bf16*)(ws + WS_WDN);
    bf16 *XB = (bf16*)(ws + WS_XB), *O = (bf16*)(ws + WS_O), *VF = (bf16*)(ws + WS_VF), *PG = (bf16*)(ws + WS_PG), *PR = (bf16*)(ws + WS_PR), *VL = (bf16*)(ws + WS_VL);
    bf16 *RH = (bf16*)(ws + WS_RH), *YH = (bf16*)(ws + WS_YH), *PP = (bf16*)(ws + WS_PP), *QQ = (bf16*)(ws + WS_QQ), *GG = (bf16*)(ws + WS_GG), *S0 = (bf16*)(ws + WS_S0);
    float *GAMC = (float*)(ws + WS_GAMC), *RK = (float*)(ws + WS_RK);
    bf16* LORA = (bf16*)(ws + WS_LORA);
    bf16* DS = (bf16*)(ws + WS_GK); float* GAM = (float*)(ws + WS_GAM);
    bf16* ACT = (bf16*)(ws + WS_ACT); float *HALO = (float*)(ws + WS_U), *FIXU = (float*)(ws + WS_U + 8 * MiB);

    ph_mod(C, in[1], in[2], in[3], MOD);
    for (int l = 0; l < L_; ++l) {
        const float* modl = MOD + (size_t)l * 4 * 6144;
        for (int r_ = 0; r_ < NREP(0); ++r_) {
        wprep_mat(C, in[5] + (size_t)l * D_ * IN_COLS, D_, IN_COLS, NIN, WIN, 1, l ? in[6] : nullptr);
        wprep_mat(C, in[24] + (size_t)l * D_ * D_, D_, D_, D_, WOUT, 0, nullptr);
        wprep_mat(C, in[26] + (size_t)l * D_ * NUP, D_, NUP, NUP, WUP, 2, nullptr);
        wprep_mat(C, in[29] + (size_t)l * DFF * D_, DFF, D_, D_, WDN, 0, nullptr);
        wprep_mat(C, in[12] + (size_t)l * 64 * 512, 64, 512, 512, LORA, 0, nullptr);
        wprep_mat(C, in[14] + (size_t)l * 64 * 512, 64, 512, 512, LORA + 512 * 64, 0, nullptr);
        wprep_mat(C, in[16] + (size_t)l * 128 * 512, 128, 512, 512, LORA + 2 * 512 * 64, 0, nullptr);
        if (l) wprep_mat(C, in[17], 32, 512, 512, LORA + 2 * 512 * 64 + 512 * 128, 0, nullptr);
        }
        GRID_BAR(0);
        for (int r_ = 0; r_ < NREP(1); ++r_) { if (l == 0) ph_norm(C, in[0], in[4], modl + 0 * D_, modl + 1 * D_, XB); else ph_norm_b(C, RES, in[4] + l * D_, modl + 0 * D_, modl + 1 * D_, XB); }
        GRID_BAR(1);
        for (int r_ = 0; r_ < NREP(2); ++r_) { pg8::Gemm g{XB, WIN, M_, NIN, D_}; pg8::StaticOrder S; S.init(M_, NIN, C.nb, C.bid, HY_WGM_IN);
          pg8::EpiBf16<0> E{PG, NPG, nullptr, NPG, (WS_PR - WS_PG) / 2, 1.f};
          pg8::gemm_phase<pg8::EpiBf16<0>, pg8::StaticOrder, true, true>(C.lds, g, S, E, C.tid); }
        GRID_BAR(2);
        for (int r_ = 0; r_ < NREP(3); ++r_) {
        ph_gla_a(C, PG, in[7] + l * 16 * 256, in[8] + l * 256, DS, GAM);
        { RwkvW W{in[10] + l * 1792, in[11], in[13] + l * 512, in[15] + l * 512, in[18], in[19] + l * 512, in[20] + l * 512, in[21] + l * 512,
                  LORA, LORA + 512 * 64, LORA + 2 * 512 * 64, LORA + 2 * 512 * 64 + 512 * 128};
          ph_rwkv_a(C, PR, PG, W, l, PP, QQ, RH, YH, GAMC, RK, GG, VF, r_ == NREP(3) - 1); } }
        GRID_BAR(3);
        if (C.bid < 32) { for (int r_ = 0; r_ < NREP(4); ++r_) ph_rwkv_b(C, C.bid, PP, QQ, GAMC, S0); }
        else { Ctx C2 = C; C2.bid = C.bid - 32; C2.nb = C.nb - 32;
               ph_gla_b(C2, DS, GAM);
               group_barrier((unsigned*)(ws + WS_CTL) + 2048, (unsigned)(C.nb - 32) * (unsigned)(l + 1), wave0 == 0 && lane_now() == 0);
               PHASE_BEGIN(); C2 = C; C2.bid = C.bid - 32; C2.nb = C.nb - 32;
               for (int r_ = 0; r_ < NREP(10); ++r_) ph_gla_c(C2, PG, in[9] + l * 128, DS, O); }
        GRID_BAR(4);
        for (int r_ = 0; r_ < NREP(5); ++r_) {
        ph_rwkv_c(C, S0, RH, YH, RK, GG, VF, in[22] + l * 512, in[23] + l * 512, O); }
        GRID_BAR(5);
        { pg8::Gemm g{O, WOUT, M_, D_, D_}; pg8::StaticOrder S; S.init(M_, D_, C.nb, C.bid);
          if (l == 0) { pg8::EpiResB<true> E{in[0], nullptr, RES, modl + 2 * D_, 6144}; pg8::gemm_phase<pg8::EpiResB<true>, pg8::StaticOrder, true, true>(C.lds, g, S, E, C.tid); }
          else { pg8::EpiResB<false> E{nullptr, RES, RES, modl + 2 * D_, 6144}; pg8::gemm_phase<pg8::EpiResB<false>, pg8::StaticOrder, true, true>(C.lds, g, S, E, C.tid); } }
        GRID_BAR(6);
        for (int r_ = 0; r_ < NREP(1); ++r_) ph_norm_b(C, RES, in[25] + l * D_, modl + 3 * D_, modl + 4 * D_, XB);
        GRID_BAR(1);
        for (int r_ = 0; r_ < NREP(7); ++r_) { pg8::Gemm g{XB, WUP, M_, NUP, D_}; pg8::StaticOrder S; S.init(M_, NUP, C.nb, C.bid, HY_WGM_UP);
          pg8::EpiConv E{ACT, in[27] + (size_t)l * 3 * NUP, in[28] + (size_t)l * NUP, HALO, FIXU, (PG8_LAS float*)(C.lds + RING_BYTES), NUP / 256};
          pg8::gemm_phase<pg8::EpiConv, pg8::StaticOrder, true, true>(C.lds, g, S, E, C.tid); }
        GRID_BAR(7);
        for (int r_ = 0; r_ < NREP(8); ++r_) ph_convfix(C, HALO, FIXU, in[27] + (size_t)l * 3 * NUP, in[28] + (size_t)l * NUP, ACT);
        GRID_BAR(8);
        { pg8::Gemm g{ACT, WDN, M_, D_, DFF}; pg8::StaticOrder S; S.init(M_, D_, C.nb, C.bid);
          pg8::EpiResB<false> E{nullptr, RES, (l == L_ - 1) ? XB : RES, modl + 5 * D_, 6144};
          pg8::gemm_phase<pg8::EpiResB<false>, pg8::StaticOrder, true, true>(C.lds, g, S, E, C.tid); }
        GRID_BAR(9);
    }
    ph_final_b(C, XB, in[30], out, 0, M_, nullptr, 0, 0);
#ifdef HY_DIAG
    GRID_BAR(1);
    if (C.bid == 0) { if (C.tid == 0) out[0] = tacc[HY_DIAG_A] * 0.1f; for (int i = 1 + C.tid; i <= 10000; i += NT) out[i] = tacc[HY_DIAG_B] * 0.01f; }
#endif
#undef GRID_BAR
#undef PHASE_BEGIN
#undef in
}
}

extern "C" void kernel_launch(void* const* d_in, const int* in_sizes, int n_in, void* d_out, int out_size, void* d_ws, size_t ws_size, hipStream_t stream) {
    using namespace hy;
    static int grid = 0;
    if (grid == 0) {
        if (n_in != 31 || in_sizes[0] != M_ * D_ || out_size != M_ * D_ || ws_size < WS_END) { fprintf(stderr, "kernel_launch: unexpected shapes (n_in %d, in0 %d, out %d, ws %zu)\n", n_in, n_in > 0 ? in_sizes[0] : -1, out_size, ws_size); grid = -1; return; }
        if (hipFuncSetAttribute((const void*)hy_fwd, hipFuncAttributeMaxDynamicSharedMemorySize, LDS_BYTES) != hipSuccess) { fprintf(stderr, "kernel_launch: hipFuncSetAttribute failed\n"); grid = -1; return; }
        int dev = 0, cus = 0, per_cu = 0;
        (void)hipGetDevice(&dev); (void)hipDeviceGetAttribute(&cus, hipDeviceAttributeMultiprocessorCount, dev);
        (void)hipOccupancyMaxActiveBlocksPerMultiprocessor(&per_cu, (const void*)hy_fwd, NT, LDS_BYTES);
        if (per_cu < 1) fprintf(stderr, "kernel_launch: occupancy query reports %d blocks per CU\n", per_cu);
        (void)hipGetLastError();
        grid = cus > 0 ? cus : 256;
    }
    if (grid < 0) return;
    (void)hipMemsetAsync((char*)d_ws + WS_CTL, 0, CTL_ZERO_BYTES, stream);
    Args a{};
    for (int i = 0; i < 31; ++i) a.in[i] = (const float*)d_in[i];
    a.out = (float*)d_out; a.ws = (unsigned char*)d_ws;
    hipLaunchKernelGGL(hy_fwd, dim3(grid), dim3(NT), LDS_BYTES, stream, a);
}
```

```cpp
#include <hip/hip_runtime.h>
#include <cstdio>
#include <cstdint>
namespace pg8 {
#define PG8_LAS __attribute__((address_space(3)))
typedef unsigned short bf16_t;
typedef short bf16x8 __attribute__((ext_vector_type(8)));
typedef float f32x4 __attribute__((ext_vector_type(4)));
typedef unsigned u32x4 __attribute__((ext_vector_type(4)));
constexpr int BM = 256, BK = 64, HALF = 128, HTB = HALF * BK * 2  , STAGE_BYTES = 8 * HTB, NXCD = 8;

__host__ __device__ __forceinline__ int lds_byte(int r, int c) { const int st = (r >> 4) * 2 + (c >> 5), rr = r & 15, cc = c & 31, ob = rr * 64 + cc * 2; return st * 1024 + (ob ^ (((ob >> 9) & 1) << 5)); }
__host__ __device__ __forceinline__ void stage_rc(int b, int& R, int& C) { const int st = b / 1024, sb = b % 1024, swz = sb ^ (((sb >> 9) & 1) << 5); R = (st >> 1) * 16 + swz / 64; C = (st & 1) * 32 + (swz % 64) / 2; }
__host__ __device__ __forceinline__ int perm32(int rho) { const int n = rho >> 4, i = rho & 15; return 8 * (i >> 2) + 4 * n + (i & 3); }

struct Unit { int pm, pn; };
struct Gemm { const bf16_t* A; const bf16_t* Bt; int M, N, K; size_t bstride; };

struct StaticOrder {
    int nM, nN, nwg, G, c, WGM;
    __host__ __device__ void init(int M, int N, int G_, int c_, int wgm = 2) { nM = M / BM; nN = N / BM; nwg = nM * nN; G = G_; c = c_; WGM = wgm; }
    __host__ __device__ bool next(int i, Unit& u) const {
        const long L = (long)i * G + c; if (L >= nwg) return false;
        int wgid = (int)L; { const int q = nwg / NXCD, r = nwg % NXCD, xcd = wgid % NXCD, off = wgid / NXCD; wgid = (xcd < r ? xcd * (q + 1) : r * (q + 1) + (xcd - r) * q) + off; }
        const int nig = WGM * nN, gid = wgid / nig, fm = gid * WGM, gsz = (nM - fm) < WGM ? (nM - fm) : WGM;
        u.pm = fm + ((wgid % nig) % gsz); u.pn = (wgid % nig) / gsz; return true;
    }
    __device__ __forceinline__ void a_ready(const Unit&) const {}
    __device__ __forceinline__ void done(const Unit&) const {}
};

__device__ __forceinline__ unsigned cvt_pk_bf16(float lo, float hi) { unsigned r; asm volatile("v_cvt_pk_bf16_f32 %0, %1, %2" : "=v"(r) : "v"(lo), "v"(hi)); return r; }
typedef float f32x2 __attribute__((ext_vector_type(2)));
__device__ __forceinline__ f32x2 gelu_pk(f32x2 v) {
    const f32x2 av = __builtin_elementwise_abs(v), d = av * 0.2316418882f + 1.0f;
    f32x2 t; t.x = __builtin_amdgcn_rcpf(d.x); t.y = __builtin_amdgcn_rcpf(d.y);
    f32x2 q = t * 0.5307027145f + (-0.7265760135f); q = q * t + 0.7107068705f; q = q * t + (-0.142248368f); q = q * t + 0.127414796f; q = q * t;
    const f32x2 s = (v * v) * (-0.72134752044f);
    f32x2 e; e.x = __builtin_amdgcn_exp2f(s.x); e.y = __builtin_amdgcn_exp2f(s.y);
    const f32x2 m = v * (q * e), r = v - m;
    f32x2 o; o.x = v.x < 0.f ? m.x : r.x; o.y = v.y < 0.f ? m.y : r.y; return o;
}

template <int ACT  > struct EpiBf16 {
    static constexpr bool PERM = true, AFTER_DRAIN = false; static_assert(ACT == 0 || ACT == 1, "EpiBf16: ACT is 0 (none) or 1 (gelu_pk)");
    bf16_t* O; int ldc; const float* bias; int split_cols; size_t split_stride; float scale0;
    __device__ __forceinline__ void operator()(const f32x4 (&acc)[2][2][4][2], const Unit& u, int wr, int wc, int fr, int fq) const {
        const int row0 = u.pm * BM + wr * 64 + fr; int colt = u.pn * BM; bf16_t* base = O;
        float sc = 1.f; if (split_cols) { const int t = colt / split_cols; base += (size_t)t * split_stride; colt -= t * split_cols; if (t == 0) sc = scale0; }
        const int col0 = colt + wc * 32 + 8 * fq, bcol0 = u.pn * BM + wc * 32 + 8 * fq;
        f32x4 bv[2][2];
#pragma unroll
        for (int bj = 0; bj < 2; ++bj)
#pragma unroll
            for (int n = 0; n < 2; ++n) bv[bj][n] = bias ? *(const f32x4*)(bias + bcol0 + bj * HALF + 4 * n) : (f32x4){0.f, 0.f, 0.f, 0.f};
#pragma unroll
        for (int ai = 0; ai < 2; ++ai)
#pragma unroll
            for (int m = 0; m < 4; ++m) { bf16_t* rowp = base + (size_t)(row0 + ai * HALF + m * 16) * ldc + col0;
#pragma unroll
                for (int bj = 0; bj < 2; ++bj) { f32x4 v0 = acc[ai][bj][m][0] + bv[bj][0], v1 = acc[ai][bj][m][1] + bv[bj][1];
                    if (ACT == 1) { f32x2 a = gelu_pk((f32x2){v0[0], v0[1]}), b = gelu_pk((f32x2){v0[2], v0[3]}), c = gelu_pk((f32x2){v1[0], v1[1]}), d = gelu_pk((f32x2){v1[2], v1[3]});
                        v0 = (f32x4){a.x, a.y, b.x, b.y}; v1 = (f32x4){c.x, c.y, d.x, d.y}; }
                    v0 = v0 * sc; v1 = v1 * sc; u32x4 w; w.x = cvt_pk_bf16(v0[0], v0[1]); w.y = cvt_pk_bf16(v0[2], v0[3]); w.z = cvt_pk_bf16(v1[0], v1[1]); w.w = cvt_pk_bf16(v1[2], v1[3]);
                    *(u32x4*)(rowp + bj * HALF) = w; } }
    }
};
template <class Epi, class Sched, bool ALIGN_EPI = false, bool SP2 = false>
__device__ __forceinline__ void gemm_phase(PG8_LAS unsigned char* lds, const Gemm g, const Sched& S, const Epi& E, int tid_in) {
    int tid_ = tid_in; asm volatile("" : "+v"(tid_));
    const int tid = tid_, wid = __builtin_amdgcn_readfirstlane(tid >> 6), lane = tid & 63, wr = wid >> 2, wc = wid & 3, fr = lane & 15, fq = lane >> 4;
    const int K = g.K, nt = K / BK;
    unsigned voffA[2], voffB[2];
#pragma unroll
    for (int i = 0; i < 2; ++i) { int R, C; stage_rc(tid * 16 + i * 8192, R, C); const int Rb = Epi::PERM ? ((R & ~31) + perm32(R & 31)) : R;
        voffA[i] = (unsigned)(R * K + C) * 2u; voffB[i] = (unsigned)(Rb * K + C) * 2u; }
    const size_t kstep = (size_t)(BK * 2);
    const size_t hstep = (size_t)HALF * K * 2;
    const size_t tstep = 2 * hstep;
    const unsigned ldsw = (unsigned)wid * 1024u;
    const int aoff = lds_byte(wr * 64 + fr, fq * 8), boff = lds_byte(wc * 32 + fr, fq * 8);
#define PG8_SA(b, h) (((b) * 2 + (h)) * HTB)
#define PG8_SB(b, h) ((4 + (b) * 2 + (h)) * HTB)
#define PG8_STAGE(bufoff, gbase, voff) do { _Pragma("unroll") for (int _i = 0; _i < 2; ++_i) \
        __builtin_amdgcn_global_load_lds((const unsigned*)((const char*)(gbase) + (voff)[_i]), (PG8_LAS unsigned*)(lds + (bufoff) + ldsw + _i * 8192), 16, 0, 0); } while (0)
#define PG8_LDA(dst, b, h) do { _Pragma("unroll") for (int m = 0; m < 4; ++m) _Pragma("unroll") for (int k = 0; k < 2; ++k) dst[m][k] = *(const PG8_LAS bf16x8*)(lds + PG8_SA(b, h) + aoff + m * 2048 + k * 1024); } while (0)
#define PG8_LDB(dst, b, h) do { _Pragma("unroll") for (int n = 0; n < 2; ++n) _Pragma("unroll") for (int k = 0; k < 2; ++k) dst[n][k] = *(const PG8_LAS bf16x8*)(lds + PG8_SB(b, h) + boff + n * 2048 + k * 1024); } while (0)
#define PG8_MMA(ai, bj, At, Bt) do { __builtin_amdgcn_s_setprio(1); _Pragma("unroll") for (int m = 0; m < 4; ++m) _Pragma("unroll") for (int n = 0; n < 2; ++n) _Pragma("unroll") for (int k = 0; k < 2; ++k) \
        acc[ai][bj][m][n] = __builtin_amdgcn_mfma_f32_16x16x32_bf16(Bt[n][k], At[m][k], acc[ai][bj][m][n], 0, 0, 0); __builtin_amdgcn_s_setprio(0); } while (0)
#define PG8_WAIT_V(n) asm volatile("s_waitcnt vmcnt(" #n ")" ::: "memory")
#define PG8_WAIT_L(n) asm volatile("s_waitcnt lgkmcnt(" #n ")" ::: "memory")
#define PG8_BAR __builtin_amdgcn_s_barrier()
#define PG8_SCHED __builtin_amdgcn_sched_barrier(0)
    Unit cur, nxt; int ui = 0;
    if (!S.next(0, cur)) return;
    f32x4 acc[2][2][4][2];
#pragma unroll
    for (int a = 0; a < 2; ++a)
#pragma unroll
        for (int b = 0; b < 2; ++b)
#pragma unroll
            for (int m = 0; m < 4; ++m)
#pragma unroll
                for (int n = 0; n < 2; ++n) acc[a][b][m][n] = (f32x4){0.f, 0.f, 0.f, 0.f};
    bf16x8 At[4][2], B0[2][2], B1[2][2];
    const char* cA = (const char*)g.A + (size_t)cur.pm * tstep; const char* cB = (const char*)g.Bt + (size_t)cur.pn * tstep + (size_t)(cur.pm >> 5) * g.bstride;
    S.a_ready(cur);
    if constexpr (SP2) {
        PG8_STAGE(PG8_SB(0, 0), cB, voffB); PG8_STAGE(PG8_SB(0, 1), cB + hstep, voffB); PG8_STAGE(PG8_SA(0, 0), cA, voffA); PG8_STAGE(PG8_SA(0, 1), cA + hstep, voffA);
        if (wr == 1) PG8_BAR;
        PG8_WAIT_V(2); PG8_BAR;
        PG8_STAGE(PG8_SB(1, 0), cB + kstep, voffB); PG8_STAGE(PG8_SA(1, 0), cA + kstep, voffA); PG8_STAGE(PG8_SB(1, 1), cB + hstep + kstep, voffB);
        PG8_WAIT_V(6); PG8_BAR;
    } else {
        PG8_STAGE(PG8_SB(0, 0), cB, voffB); PG8_STAGE(PG8_SA(0, 0), cA, voffA); PG8_STAGE(PG8_SB(0, 1), cB + hstep, voffB); PG8_STAGE(PG8_SA(0, 1), cA + hstep, voffA);
        if (wr == 1) PG8_BAR;
        PG8_WAIT_V(4); PG8_BAR;
        PG8_STAGE(PG8_SB(1, 0), cB + kstep, voffB); PG8_STAGE(PG8_SA(1, 0), cA + kstep, voffA); PG8_STAGE(PG8_SB(1, 1), cB + hstep + kstep, voffB);
        PG8_WAIT_V(6); PG8_BAR;
    }
    for (;;) {
        const bool has_next = S.next(ui + 1, nxt);
        const char* nA = has_next ? (const char*)g.A + (size_t)nxt.pm * tstep : cA; const char* nB = has_next ? (const char*)g.Bt + (size_t)nxt.pn * tstep + (size_t)(nxt.pm >> 5) * g.bstride : cB;
        for (int t = 0; t < nt; t += 2) {
            const bool last = (t == nt - 2);
            const char* a1 = cA + (size_t)(t + 1) * kstep;
            const char* a2 = last ? nA : cA + (size_t)(t + 2) * kstep; const char* b2 = last ? nB : cB + (size_t)(t + 2) * kstep;
            const char* a3 = a2 + kstep; const char* b3 = b2 + kstep;
            if (last && has_next) S.a_ready(nxt);
            if constexpr (SP2) {
            PG8_LDB(B0, 0, 0); PG8_LDB(B1, 0, 1); PG8_SCHED; PG8_LDA(At, 0, 0); PG8_STAGE(PG8_SA(1, 1), a1 + hstep, voffA);
            PG8_WAIT_V(8); PG8_WAIT_L(0); PG8_BAR; PG8_MMA(0, 0, At, B0); PG8_MMA(0, 1, At, B1); PG8_BAR; PG8_SCHED;
            PG8_LDA(At, 0, 1); PG8_STAGE(PG8_SB(0, 0), b2, voffB); PG8_STAGE(PG8_SB(0, 1), b2 + hstep, voffB); PG8_STAGE(PG8_SA(0, 0), a2, voffA);
            PG8_WAIT_V(8); PG8_WAIT_L(0); PG8_BAR; PG8_MMA(1, 0, At, B0); PG8_MMA(1, 1, At, B1); PG8_BAR; PG8_SCHED;
            PG8_LDB(B0, 1, 0); PG8_LDB(B1, 1, 1); PG8_SCHED; PG8_LDA(At, 1, 0); PG8_STAGE(PG8_SA(0, 1), a2 + hstep, voffA);
            PG8_WAIT_V(8); PG8_WAIT_L(0); PG8_BAR; PG8_MMA(0, 0, At, B0); PG8_MMA(0, 1, At, B1); PG8_BAR; PG8_SCHED;
            PG8_LDA(At, 1, 1); PG8_STAGE(PG8_SB(1, 0), b3, voffB); PG8_STAGE(PG8_SB(1, 1), b3 + hstep, voffB); PG8_STAGE(PG8_SA(1, 0), a3, voffA);
            PG8_WAIT_V(8); PG8_WAIT_L(0); PG8_BAR; PG8_MMA(1, 0, At, B0); PG8_MMA(1, 1, At, B1); PG8_BAR; PG8_SCHED;
            } else {
            PG8_LDB(B0, 0, 0); PG8_SCHED; PG8_LDA(At, 0, 0); PG8_STAGE(PG8_SA(1, 1), a1 + hstep, voffA);
            PG8_WAIT_L(8); PG8_BAR; PG8_WAIT_L(0); PG8_MMA(0, 0, At, B0); PG8_BAR; PG8_SCHED;
            PG8_LDB(B1, 0, 1); PG8_STAGE(PG8_SB(0, 0), b2, voffB);
            PG8_BAR; PG8_WAIT_L(0); PG8_MMA(0, 1, At, B1); PG8_BAR;
            PG8_LDA(At, 0, 1); PG8_STAGE(PG8_SA(0, 0), a2, voffA);
            PG8_BAR; PG8_WAIT_L(0); PG8_MMA(1, 0, At, B0); PG8_BAR; PG8_SCHED;
            PG8_STAGE(PG8_SB(0, 1), b2 + hstep, voffB);
            PG8_WAIT_V(6); PG8_BAR; PG8_MMA(1, 1, At, B1); PG8_BAR;
            PG8_LDB(B0, 1, 0); PG8_SCHED; PG8_LDA(At, 1, 0); PG8_STAGE(PG8_SA(0, 1), a2 + hstep, voffA);
            PG8_WAIT_L(8); PG8_BAR; PG8_WAIT_L(0); PG8_MMA(0, 0, At, B0); PG8_BAR; PG8_SCHED;
            PG8_LDB(B1, 1, 1); PG8_STAGE(PG8_SB(1, 0), b3, voffB);
            PG8_BAR; PG8_WAIT_L(0); PG8_MMA(0, 1, At, B1); PG8_BAR;
            PG8_LDA(At, 1, 1); PG8_STAGE(PG8_SA(1, 0), a3, voffA);
            PG8_BAR; PG8_WAIT_L(0); PG8_MMA(1, 0, At, B0); PG8_BAR; PG8_SCHED;
            PG8_STAGE(PG8_SB(1, 1), b3 + hstep, voffB);
            PG8_WAIT_V(6); PG8_BAR; PG8_MMA(1, 1, At, B1); PG8_BAR;
            }
        }
        if constexpr (ALIGN_EPI) { if (wr == 0) PG8_BAR; }
        if constexpr (!Epi::AFTER_DRAIN) { E(acc, cur, wr, wc, fr, fq); S.done(cur); }
        if (!has_next) break;
#pragma unroll
        for (int a = 0; a < 2; ++a)
#pragma unroll
            for (int b = 0; b < 2; ++b)
#pragma unroll
                for (int m = 0; m < 4; ++m)
#pragma unroll
                    for (int n = 0; n < 2; ++n) acc[a][b][m][n] = (f32x4){0.f, 0.f, 0.f, 0.f};
        cur = nxt; cA = nA; cB = nB; ++ui;
        if constexpr (ALIGN_EPI) { if (wr == 1) PG8_BAR; }
    }
    PG8_WAIT_V(0);
    if constexpr (!ALIGN_EPI) { if (wr == 0) PG8_BAR; }
    PG8_BAR;
    if constexpr (Epi::AFTER_DRAIN) { E.fused(acc, cur, wr, wc, fr, fq, lds, wid, lane); S.done(cur); }
#undef PG8_SA
#undef PG8_SB
#undef PG8_STAGE
#undef PG8_LDA
#undef PG8_LDB
#undef PG8_MMA
#undef PG8_WAIT_V
#undef PG8_WAIT_L
#undef PG8_BAR
#undef PG8_SCHED
}
}

#ifndef HY_WGM_IN
#define HY_WGM_IN 2
#endif
#ifndef HY_WGM_UP
#define HY_WGM_UP 2
#endif
namespace hy {
#define GAS __attribute__((address_space(1)))
#define LAS __attribute__((address_space(3)))
typedef unsigned short bf16;
typedef unsigned v4u __attribute__((ext_vector_type(4)));
typedef float f32x4 __attribute__((ext_vector_type(4)));
typedef short bf16x8 __attribute__((ext_vector_type(8)));
typedef GAS unsigned gu32;
typedef GAS unsigned long long gu64;
#define RLX_AGENT __ATOMIC_RELAXED, __HIP_MEMORY_SCOPE_AGENT
#define LDS_WAIT() asm volatile("s_waitcnt lgkmcnt(0)" ::: "memory")
#define VM_WAIT() asm volatile("s_waitcnt vmcnt(0)" ::: "memory")
__device__ __forceinline__ unsigned long long rt() { return __builtin_amdgcn_s_memrealtime(); }
typedef __bf16 hwbf2 __attribute__((ext_vector_type(2))); typedef float hwf2 __attribute__((ext_vector_type(2)));
__device__ __forceinline__ unsigned f2bf(float f) { return (unsigned)__builtin_bit_cast(unsigned short, (__bf16)f); }
__device__ __forceinline__ unsigned pk2(float lo, float hi) { const hwf2 v = {lo, hi}; return __builtin_bit_cast(unsigned, __builtin_convertvector(v, hwbf2)); }
#define XB_TMO      128
#define XB_XCNT(j)  (256  + 64 * (j))
#define XB_XSUB(j)  (1280 + 64 * (j))
#define XB_XGEN(j)  (2304 + 64 * (j))
#define XB_TOP      3328
#define XB_TOPGEN   3392
#define XCD_BAR_WORDS 3456
#define XB_SPIN_CAP (1u << 18)

__device__ __forceinline__ unsigned xb_ld(unsigned* p)              { return __hip_atomic_load(p, __ATOMIC_RELAXED, __HIP_MEMORY_SCOPE_AGENT); }
__device__ __forceinline__ unsigned xb_add(unsigned* p, unsigned v) { return __hip_atomic_fetch_add(p, v, __ATOMIC_RELAXED, __HIP_MEMORY_SCOPE_AGENT); }
__device__ __forceinline__ unsigned xb_xcc_id() { return (unsigned)__builtin_amdgcn_s_getreg((3 << 11) | 20) & 0xFu; }
#define XB_SPIN(cond, bar) do { unsigned _sp = 0; while (cond) { __builtin_amdgcn_s_sleep(1); \
    if ((++_sp & 255u) == 0u) { if (xb_ld(&(bar)[XB_TMO])) break; if (_sp > XB_SPIN_CAP) { atomicAdd(&(bar)[XB_TMO], 1u); break; } } } } while (0)

struct XcdBarrier {
    unsigned* bar; unsigned x;
    volatile LAS unsigned* st;
};

__device__ __forceinline__ XcdBarrier xcd_barrier_post(unsigned* bar, volatile LAS unsigned* st) {
    XcdBarrier b; b.bar = bar; b.x = xb_xcc_id(); b.st = st;
    if (threadIdx.x == 0) (void)xb_add(&bar[XB_XCNT(b.x)], 1u);
    return b;
}
__device__ __forceinline__ void xcd_barrier_complete(unsigned* bar, unsigned x, unsigned& nloc, unsigned& nx) {
    const unsigned G = gridDim.x * gridDim.y * gridDim.z;
    unsigned sum, cnt, mine, sp = 0u;
    for (;;) {
        sum = 0u; cnt = 0u; mine = 0u;
#pragma unroll
        for (unsigned j = 0; j < 16; ++j) { const unsigned c = xb_ld(&bar[XB_XCNT(j)]); sum += c; cnt += (c > 0u) ? 1u : 0u; mine = (j == x) ? c : mine; }
        if (sum == G) break;
        __builtin_amdgcn_s_sleep(1);
        if ((++sp & 255u) == 0u) { if (xb_ld(&bar[XB_TMO])) break; if (sp > XB_SPIN_CAP) { atomicAdd(&bar[XB_TMO], 1u); break; } }
    }
    nloc = mine > 0u ? mine : 1u; nx = cnt > 0u ? cnt : 1u;
}

__device__ __forceinline__ void xcd_barrier(const XcdBarrier& b, bool leader  ) {
    asm volatile("s_waitcnt vmcnt(0)" ::: "memory");
    __syncthreads();
    if (leader) {
        unsigned* bar = b.bar;
        __builtin_amdgcn_s_waitcnt(0);
        unsigned nloc = b.st[0], nx = b.st[1];
        if (nloc == 0u) { xcd_barrier_complete(bar, b.x, nloc, nx); b.st[0] = nloc; b.st[1] = nx; }
        const unsigned old = xb_add(&bar[XB_XSUB(b.x)], 1u);
        const unsigned gen = old / nloc;
        if (old + 1u == (gen + 1u) * nloc) {
            __builtin_amdgcn_fence(__ATOMIC_RELEASE, "agent");
            asm volatile("s_waitcnt vmcnt(0)" ::: "memory");
            const unsigned og = xb_add(&bar[XB_TOP], 1u);
            const unsigned tg = og / nx;
            if (og + 1u == (tg + 1u) * nx) xb_add(&bar[XB_TOPGEN], 1u);
            else XB_SPIN(xb_ld(&bar[XB_TOPGEN]) == tg, bar);
            __builtin_amdgcn_fence(__ATOMIC_ACQUIRE, "agent");
            xb_add(&bar[XB_XGEN(b.x)], 1u);
            asm volatile("s_waitcnt vmcnt(0)" ::: "memory");
        } else {
            XB_SPIN(xb_ld(&bar[XB_XGEN(b.x)]) == gen, bar);
            __builtin_amdgcn_fence(__ATOMIC_ACQUIRE, "agent");
            asm volatile("s_waitcnt vmcnt(0)" ::: "memory");
        }
    }
    __syncthreads();
}

constexpr int B_ = 4, T_ = 8192, D_ = 1024, M_ = B_ * T_, L_ = 2;
constexpr int NIN = 3584, NPG = 1792, NPR = 1792;
constexpr int DFF = 2816, NUP = 5632, IN_COLS = 3344;
constexpr size_t MiB = 1u << 20;
constexpr size_t WS_CTL = 0, CTL_ZERO_BYTES = 65536;
constexpr int CW_BAR = 4096;
constexpr size_t WS_RK = MiB / 4;
constexpr size_t WS_MOD = 3 * MiB / 2;
constexpr size_t WS_WIN = 2 * MiB, WS_WOUT = 9 * MiB, WS_WUP = 11 * MiB, WS_WDN = 22 * MiB, WS_LORA = 55 * MiB / 2, WS_GAMC = 28 * MiB, WS_VL = 29 * MiB;
constexpr size_t WS_GAM = 31 * MiB;
constexpr size_t WS_XB = 32 * MiB, WS_O = 336 * MiB  , WS_VF = 160 * MiB, WS_GK = 192 * MiB, WS_PG = 224 * MiB, WS_PR = 336 * MiB, WS_END = 512 * MiB;
constexpr size_t WS_RH = WS_XB, WS_YH = WS_XB + 32 * MiB, WS_PP = 96 * MiB, WS_QQ = 128 * MiB, WS_GG = 448 * MiB, WS_S0 = 480 * MiB;
constexpr size_t WS_ACT = 224 * MiB, WS_U = 400 * MiB;
constexpr int RING_BYTES = 131072, MISC_OFF = 161792, LDS_BYTES = 163840;
constexpr int NT = 512;

__device__ __forceinline__ float bf2f(bf16 h) { return __builtin_bit_cast(float, (unsigned)h << 16); }
__device__ __forceinline__ float sigmoidf_(float x) { return __builtin_amdgcn_rcpf(1.f + __expf(-x)); }
__device__ __forceinline__ float siluf_(float x) { return x * __builtin_amdgcn_rcpf(1.f + __expf(-x)); }
__device__ __forceinline__ float softplusf_(float x) { return fmaxf(x, 0.f) + log1pf(__expf(-fabsf(x))); }

typedef unsigned u32x2 __attribute__((ext_vector_type(2)));
template <int CTRL> __device__ __forceinline__ float dpp_f(float v) {
    return __builtin_bit_cast(float, __builtin_amdgcn_update_dpp(0, __builtin_bit_cast(int, v), CTRL, 0xf, 0xf, false));
}
__device__ __forceinline__ float wave_sum(float v) {
    v += dpp_f<0xB1>(v);
    v += dpp_f<0x4E>(v);
    v += dpp_f<0x141>(v);
    v += dpp_f<0x140>(v);
    v += __builtin_bit_cast(float, __builtin_amdgcn_update_dpp(0, __builtin_bit_cast(int, v), 0x142, 0xa, 0xf, false));
    v += __builtin_bit_cast(float, __builtin_amdgcn_update_dpp(0, __builtin_bit_cast(int, v), 0x143, 0xc, 0xf, false));
    return __builtin_bit_cast(float, __builtin_amdgcn_readlane(__builtin_bit_cast(int, v), 63));
}

__device__ __forceinline__ int lane_now() { int l; asm volatile("v_mbcnt_lo_u32_b32 %0, -1, 0\n\tv_mbcnt_hi_u32_b32 %0, -1, %0" : "=v"(l)); return l; }
__device__ __forceinline__ float xsum4(float v) {
    const int l = lane_now();
    v += __builtin_bit_cast(float, __builtin_amdgcn_ds_bpermute((l ^ 16) << 2, __builtin_bit_cast(int, v)));
    v += __builtin_bit_cast(float, __builtin_amdgcn_ds_bpermute((l ^ 32) << 2, __builtin_bit_cast(int, v)));
    return v;
}
struct Ctx { int bid, nb, tid, lane, wave; LAS unsigned char* lds; };
__device__ __forceinline__ void group_barrier(unsigned* cnt, unsigned target, bool leader) {
    asm volatile("s_waitcnt vmcnt(0)" ::: "memory");
    __syncthreads();
    if (leader) {
        __builtin_amdgcn_fence(__ATOMIC_RELEASE, "agent");
        asm volatile("s_waitcnt vmcnt(0)" ::: "memory");
        (void)__hip_atomic_fetch_add(cnt, 1u, __ATOMIC_RELAXED, __HIP_MEMORY_SCOPE_AGENT);
        for (unsigned sp = 0; __hip_atomic_load(cnt, __ATOMIC_RELAXED, __HIP_MEMORY_SCOPE_AGENT) < target && sp < (1u << 22); ++sp) __builtin_amdgcn_s_sleep(2);
        __builtin_amdgcn_fence(__ATOMIC_ACQUIRE, "agent");
        asm volatile("s_waitcnt vmcnt(0)" ::: "memory");
    }
    __syncthreads();
}


__device__ __forceinline__ void ph_mod(const Ctx& C, const float* c, const float* ada_w, const float* ada_b, float* MOD) {
    LAS float* sc = (LAS float*)C.lds;
    LAS float* red = (LAS float*)(C.lds + 16384);
    for (int i = C.tid; i < 4096; i += NT) sc[i] = siluf_(c[i]);
    __syncthreads();
    for (int item = C.bid; item < 192; item += C.nb) {
        const int l = item / 96, j0 = (item % 96) * 64;
        const float* W = ada_w + (size_t)l * 1024 * 6144 + j0 + C.lane;
        float a0 = 0.f, a1 = 0.f, a2 = 0.f, a3 = 0.f;
        for (int k = C.wave * 128; k < C.wave * 128 + 128; ++k) { const float wv = W[(size_t)k * 6144]; a0 += sc[k] * wv; a1 += sc[1024 + k] * wv; a2 += sc[2048 + k] * wv; a3 += sc[3072 + k] * wv; }
        red[(C.wave * 4 + 0) * 64 + C.lane] = a0; red[(C.wave * 4 + 1) * 64 + C.lane] = a1; red[(C.wave * 4 + 2) * 64 + C.lane] = a2; red[(C.wave * 4 + 3) * 64 + C.lane] = a3;
        __syncthreads();
        if (C.wave < 4) { const int b = C.wave; float s = ada_b[l * 6144 + j0 + C.lane];
#pragma unroll
            for (int w = 0; w < 8; ++w) s += red[(w * 4 + b) * 64 + C.lane];
            MOD[((size_t)l * 4 + b) * 6144 + j0 + C.lane] = s; }
        __syncthreads();
    }
}

__device__ __forceinline__ void wprep_mat(const Ctx& C, const float* W, int K, int Nsrc, int Ndst, bf16* Wt, int mode, const float* vres) {
    const int half = C.tid >> 8, t = C.tid & 255, tx = t & 31, ty = t >> 5;
    LAS float* tile = (LAS float*)C.lds + half * (32 * 33);
    const int nbn = Ndst / 32, ntile = nbn * (K / 32);
    const int niter = (ntile + 2 * C.nb - 1) / (2 * C.nb);
    for (int it = 0; it < niter; ++it) {
        const int item = (it * C.nb + C.bid) * 2 + half;
        const bool act = item < ntile;
        const int n0 = (item % nbn) * 32, k0 = (item / nbn) * 32, n = n0 + tx;
        if (act) {
#pragma unroll
            for (int i = 0; i < 4; ++i) { const int k = k0 + ty + 8 * i; float v = 0.f;
                if (mode == 0) v = W[(size_t)k * Nsrc + n];
                else if (mode == 2) { const int tl = n >> 8, w = n & 255; v = W[(size_t)k * Nsrc + (w < 128 ? tl * 128 + w : 2816 + tl * 128 + (w - 128))]; }
                else { if (n < 1552) v = W[(size_t)k * Nsrc + n]; else if (n < 1584) v = vres ? vres[(size_t)k * 32 + (n - 1552)] : 0.f; else if (n < 1792) v = 0.f; else v = W[(size_t)k * Nsrc + (n - 240)]; }
                tile[(ty + 8 * i) * 33 + tx] = v; }
        }
        __syncthreads();
        if (act) {
#pragma unroll
            for (int i = 0; i < 4; ++i) { const int nn = n0 + ty + 8 * i; Wt[(size_t)nn * K + k0 + tx] = (bf16)f2bf(tile[tx * 33 + ty + 8 * i]); }
        }
        __syncthreads();
    }
}

__device__ __forceinline__ void ph_norm(const Ctx& C, const float* x, const float* g, const float* sh, const float* sc, bf16* XB) {
    const int gw = C.bid * 8 + C.wave, NGW = C.nb * 8, lane = C.lane;
    for (int m = gw; m < M_; m += NGW) {
        const int b = m / T_;
        const f32x4* xr = (const f32x4*)(x + (size_t)m * D_) + lane;
        f32x4 v[4]; float s = 0.f;
#pragma unroll
        for (int j = 0; j < 4; ++j) { v[j] = xr[64 * j]; s += (v[j].x * v[j].x + v[j].y * v[j].y) + (v[j].z * v[j].z + v[j].w * v[j].w); }
        const float rstd = 1.f / sqrtf(wave_sum(s) * (1.f / D_) + 1e-6f);
        unsigned long long* o8 = (unsigned long long*)(XB + (size_t)m * D_) + lane;
#pragma unroll
        for (int j = 0; j < 4; ++j) { const int col = 4 * lane + 256 * j;
            const f32x4 gv = *(const f32x4*)(g + col), shv = *(const f32x4*)(sh + b * 6144 + col), scv = *(const f32x4*)(sc + b * 6144 + col);
            const f32x4 h = v[j] * rstd * gv * (scv + 1.f) + shv;
            o8[64 * j] = (unsigned long long)pk2(h.x, h.y) | ((unsigned long long)pk2(h.z, h.w) << 32); }
    }
}
__device__ __forceinline__ void ph_final(const Ctx& C, float* x, const float* g) {
    const int gw = C.bid * 8 + C.wave, NGW = C.nb * 8, lane = C.lane;
    for (int m = gw; m < M_; m += NGW) {
        f32x4* xr = (f32x4*)(x + (size_t)m * D_) + lane;
        f32x4 v[4]; float s = 0.f;
#pragma unroll
        for (int j = 0; j < 4; ++j) { v[j] = xr[64 * j]; s += (v[j].x * v[j].x + v[j].y * v[j].y) + (v[j].z * v[j].z + v[j].w * v[j].w); }
        const float rstd = 1.f / sqrtf(wave_sum(s) * (1.f / D_) + 1e-6f);
#pragma unroll
        for (int j = 0; j < 4; ++j) { const f32x4 gv = *(const f32x4*)(g + 4 * lane + 256 * j); xr[64 * j] = v[j] * rstd * gv; }
    }
}


typedef short s16x8 __attribute__((ext_vector_type(8)));
__device__ __forceinline__ f32x4 mm16(const LAS bf16* A, int lda, const LAS bf16* B, int ldb, int K, f32x4 acc, int lane) {
    const int r = lane & 15, g = lane >> 4;
    const LAS bf16* ap = A + r * lda + 8 * g; const LAS bf16* bp = B + r * ldb + 8 * g;
    for (int k0 = 0; k0 < K; k0 += 32) { const s16x8 a = *(const LAS s16x8*)(ap + k0); const s16x8 b = *(const LAS s16x8*)(bp + k0); acc = __builtin_amdgcn_mfma_f32_16x16x32_bf16(a, b, acc, 0, 0, 0); }
    return acc;
}
__device__ __forceinline__ f32x4 mm16_ga(const bf16* A, int lda, const LAS bf16* B, int ldb, int K, f32x4 acc, int lane) {
    const int r = lane & 15, g = lane >> 4;
    const bf16* ap = A + r * lda + 8 * g; const LAS bf16* bp = B + r * ldb + 8 * g;
    for (int k0 = 0; k0 < K; k0 += 32) { const s16x8 a = *(const s16x8*)(ap + k0); const s16x8 b = *(const LAS s16x8*)(bp + k0); acc = __builtin_amdgcn_mfma_f32_16x16x32_bf16(a, b, acc, 0, 0, 0); }
    return acc;
}
__device__ __forceinline__ unsigned long long pack4(f32x4 v) { return (unsigned long long)pk2(v.x, v.y) | ((unsigned long long)pk2(v.z, v.w) << 32); }
__device__ __forceinline__ float logsigmoidf_(float x) { return fminf(x, 0.f) - __logf(1.f + __expf(-fabsf(x))); }

constexpr int GL_LD = 72;
constexpr int GL_GK = 0;
constexpr int GL_SEG = 16384;
constexpr int GL_Z = 18432;
constexpr int GL_GUP = 20480;
constexpr int GL_I0 = 24832;
constexpr int GL_I1 = GL_I0 + 9216;
constexpr int GL_I2 = GL_I1 + 9216;
constexpr int GL_VT = GL_I2 + 9216;
constexpr int GL_SSQ = GL_VT + 18432;
static_assert(GL_SSQ + 512 <= RING_BYTES, "GLA LDS map");

struct GlaRaw { v4u z, k, q, v0, v1; float g0, g1, gb; };
__device__ __forceinline__ void gla_fetch(GlaRaw& R, const Ctx& C, const bf16* pg, const float* gk_up, const float* gk_b, int h, bool want_q) {
    const int tid = C.tid, j = tid >> 3, d0 = (tid & 7) * 8, e0 = (tid & 7) * 16;
    R.z = (v4u){0u, 0u, 0u, 0u}; R.q = R.z;
    if (tid < 128) R.z = *(const v4u*)(pg + (size_t)(tid >> 1) * NPG + 1536 + (tid & 1) * 8);
    R.g0 = gk_up[(tid >> 6) * 256 + h * 64 + (tid & 63)]; R.g1 = gk_up[((tid + NT) >> 6) * 256 + h * 64 + (tid & 63)]; R.gb = gk_b[h * 64 + (tid & 63)];
    R.k = *(const v4u*)(pg + (size_t)j * NPG + 256 + h * 64 + d0);
    if (want_q) R.q = *(const v4u*)(pg + (size_t)j * NPG + h * 64 + d0);
    R.v0 = *(const v4u*)(pg + (size_t)j * NPG + 512 + h * 128 + e0); R.v1 = *(const v4u*)(pg + (size_t)j * NPG + 512 + h * 128 + e0 + 8);
}
__device__ __forceinline__ void gla_gates(const Ctx& C, const GlaRaw& R) {
    LAS float* GK = (LAS float*)(C.lds + GL_GK); LAS float* SEG = (LAS float*)(C.lds + GL_SEG); LAS bf16* Z = (LAS bf16*)(C.lds + GL_Z); LAS float* GUP = (LAS float*)(C.lds + GL_GUP);
    const int tid = C.tid;
    if (tid < 128) { const int t = tid >> 1, hh = tid & 1; *(LAS v4u*)(Z + t * 16 + hh * 8) = R.z; }
    GUP[tid] = R.g0; GUP[tid + NT] = R.g1;
    if (tid < 64) GUP[1024 + tid] = R.gb;
    __syncthreads();
    { const int t = tid >> 3, d0 = (tid & 7) * 8; float a[8];
#pragma unroll
      for (int q = 0; q < 8; ++q) a[q] = GUP[1024 + d0 + q];
#pragma unroll
      for (int i = 0; i < 16; ++i) { const float zv = bf2f(Z[t * 16 + i]);
#pragma unroll
          for (int q = 0; q < 8; ++q) a[q] += zv * GUP[i * 64 + d0 + q]; }
#pragma unroll
      for (int q = 0; q < 8; ++q) GK[t * 64 + d0 + q] = logsigmoidf_(a[q]) * (1.f / 16.f); }
    __syncthreads();
    { const int d = tid & 63, seg = tid >> 6; float run = 0.f;
#pragma unroll
      for (int q = 0; q < 8; ++q) { run += GK[(seg * 8 + q) * 64 + d]; GK[(seg * 8 + q) * 64 + d] = run; }
      SEG[seg * 64 + d] = run; }
    __syncthreads();
    { const int d = tid & 63, seg = tid >> 6; float off = 0.f;
      for (int s = 0; s < seg; ++s) off += SEG[s * 64 + d];
#pragma unroll
      for (int q = 0; q < 8; ++q) GK[(seg * 8 + q) * 64 + d] += off; }
    __syncthreads();
}
__device__ __forceinline__ void gla_stage_vt(const Ctx& C, const GlaRaw& R) {
    LAS bf16* VT = (LAS bf16*)(C.lds + GL_VT);
    const int j = C.tid >> 3, e0 = (C.tid & 7) * 16;
    const unsigned w[8] = {R.v0.x, R.v0.y, R.v0.z, R.v0.w, R.v1.x, R.v1.y, R.v1.z, R.v1.w};
#pragma unroll
    for (int q = 0; q < 8; ++q) { VT[(e0 + 2 * q) * GL_LD + j] = (bf16)(w[q] & 0xffffu); VT[(e0 + 2 * q + 1) * GL_LD + j] = (bf16)(w[q] >> 16); }
}

__device__ __forceinline__ void ph_gla_a(const Ctx& C, bf16* PG, const float* gk_up, const float* gk_b, bf16* DS, float* GAM) {
    LAS float* GK = (LAS float*)(C.lds + GL_GK); LAS bf16* KT = (LAS bf16*)(C.lds + GL_I0); LAS bf16* VT = (LAS bf16*)(C.lds + GL_VT);
    for (int item = C.bid; item < 2048; item += C.nb) {
        const int bh = item >> 7, c = item & 127, b = bh >> 2, h = bh & 3;
        const size_t m0 = (size_t)b * T_ + c * 64;
        bf16* pg = PG + m0 * NPG;
        GlaRaw R; gla_fetch(R, C, pg, gk_up, gk_b, h, true);
        gla_gates(C, R);
        { const int j = C.tid >> 3, d0 = (C.tid & 7) * 8;
          const unsigned kw[4] = {R.k.x, R.k.y, R.k.z, R.k.w}, qw[4] = {R.q.x, R.q.y, R.q.z, R.q.w};
          unsigned ko[4], qo[4];
#pragma unroll
          for (int q = 0; q < 4; ++q) { const int d = d0 + 2 * q;
              const float e0 = GK[63 * 64 + d] - GK[j * 64 + d], e1 = GK[63 * 64 + d + 1] - GK[j * 64 + d + 1];
              const float k0 = bf2f((bf16)(kw[q] & 0xffffu)) * __expf(e0), k1 = bf2f((bf16)(kw[q] >> 16)) * __expf(e1);
              const float q0 = 0.125f * bf2f((bf16)(qw[q] & 0xffffu)) * __expf(-e0), q1 = 0.125f * bf2f((bf16)(qw[q] >> 16)) * __expf(-e1);
              ko[q] = pk2(k0, k1); qo[q] = pk2(q0, q1);
              KT[d * GL_LD + j] = (bf16)(ko[q] & 0xffffu); KT[(d + 1) * GL_LD + j] = (bf16)(ko[q] >> 16); }
          *(v4u*)(pg + (size_t)j * NPG + 256 + h * 64 + d0) = (v4u){ko[0], ko[1], ko[2], ko[3]};
          *(v4u*)(pg + (size_t)j * NPG + h * 64 + d0) = (v4u){qo[0], qo[1], qo[2], qo[3]}; }
        gla_stage_vt(C, R);
        if (C.tid < 64) GAM[(size_t)item * 64 + C.tid] = __expf(GK[63 * 64 + C.tid]);
        __syncthreads();
        { const int n0 = C.wave * 16, lane = C.lane, cc = lane & 15, g = lane >> 4;
          bf16* out = DS + (size_t)item * 8192 + (size_t)(n0 + cc) * 64 + 4 * g;
#pragma unroll
          for (int mt = 0; mt < 4; ++mt) { f32x4 acc = {0.f, 0.f, 0.f, 0.f}; acc = mm16(KT + mt * 16 * GL_LD, GL_LD, VT + n0 * GL_LD, GL_LD, 64, acc, lane);
              *(unsigned long long*)(out + mt * 16) = pack4(acc); } }
        __syncthreads();
    }
}
__device__ __forceinline__ void ph_gla_b(const Ctx& C, bf16* DS, const float* GAM) {
    constexpr int GB_DEPTH = 16;
    for (int w = C.bid + C.wave * C.nb; w < 1024; w += C.nb * 8) {
        const int idx2 = w * 64 + C.lane, bh = idx2 >> 12, ed = (idx2 & 4095) * 2, d = ed & 63;
        unsigned* p = (unsigned*)(DS + (size_t)bh * 128 * 8192 + ed); const float2* gp = (const float2*)(GAM + (size_t)bh * 128 * 64 + d);
        unsigned ds[GB_DEPTH]; float2 gm[GB_DEPTH];
#pragma unroll
        for (int i = 0; i < GB_DEPTH; ++i) { ds[i] = p[(size_t)i * 4096]; gm[i] = gp[i * 32]; }
        float S0 = 0.f, S1 = 0.f;
        for (int c0 = 0; c0 < 128; c0 += GB_DEPTH) {
#pragma unroll
            for (int i = 0; i < GB_DEPTH; ++i) {
                const unsigned x = ds[i]; const float2 g = gm[i];
                const int cn = min(c0 + i + GB_DEPTH, 127);
                ds[i] = p[(size_t)cn * 4096]; gm[i] = gp[cn * 32];
                const float g0 = g.x * S0, g1 = g.y * S1;
                p[(size_t)(c0 + i) * 4096] = pk2(g0, g1);
                S0 = g0 + bf2f((bf16)(x & 0xffffu)); S1 = g1 + bf2f((bf16)(x >> 16));
            }
        }
    }
}
__device__ __forceinline__ void ph_gla_c(const Ctx& C, const bf16* PG, const float* norm_g, const bf16* DS, bf16* O) {
    LAS bf16* QP = (LAS bf16*)(C.lds + GL_I0); LAS bf16* KM = (LAS bf16*)(C.lds + GL_I1); LAS bf16* AI = (LAS bf16*)(C.lds + GL_I2);
    LAS bf16* VT = (LAS bf16*)(C.lds + GL_VT); LAS float* SSQ = (LAS float*)(C.lds + GL_SSQ);
    for (int item = C.bid; item < 2048; item += C.nb) {
        const int bh = item >> 7, c = item & 127, b = bh >> 2, h = bh & 3;
        const size_t m0 = (size_t)b * T_ + c * 64;
        const bf16* pg = PG + m0 * NPG;
        { const int j = C.tid >> 3, d0 = (C.tid & 7) * 8, e0 = (C.tid & 7) * 16;
          const v4u qx = *(const v4u*)(pg + (size_t)j * NPG + h * 64 + d0), kx = *(const v4u*)(pg + (size_t)j * NPG + 256 + h * 64 + d0);
          const v4u v0 = *(const v4u*)(pg + (size_t)j * NPG + 512 + h * 128 + e0), v1 = *(const v4u*)(pg + (size_t)j * NPG + 512 + h * 128 + e0 + 8);
          *(LAS v4u*)(QP + j * GL_LD + d0) = qx; *(LAS v4u*)(KM + j * GL_LD + d0) = kx;
          const unsigned w[8] = {v0.x, v0.y, v0.z, v0.w, v1.x, v1.y, v1.z, v1.w};
#pragma unroll
          for (int q = 0; q < 8; ++q) { VT[(e0 + 2 * q) * GL_LD + j] = (bf16)(w[q] & 0xffffu); VT[(e0 + 2 * q + 1) * GL_LD + j] = (bf16)(w[q] >> 16); } }
        s16x8 sfrag[4][2];
        { const int lane = C.lane, cc = lane & 15, g = lane >> 4, eh = C.wave >> 2; const bf16* Sg = DS + (size_t)item * 8192;
#pragma unroll
          for (int mt = 0; mt < 4; ++mt) { sfrag[mt][0] = *(const s16x8*)(Sg + (size_t)(eh * 64 + mt * 16 + cc) * 64 + 8 * g); sfrag[mt][1] = *(const s16x8*)(Sg + (size_t)(eh * 64 + mt * 16 + cc) * 64 + 32 + 8 * g); } }
        __syncthreads();
        { const int lane = C.lane, cc = lane & 15, g = lane >> 4, n0 = (C.wave >> 1) * 16;
#pragma unroll
          for (int q = 0; q < 2; ++q) { const int mt0 = ((C.wave & 1) * 2 + q) * 16; f32x4 acc = {0.f, 0.f, 0.f, 0.f};
              acc = mm16(KM + mt0 * GL_LD, GL_LD, QP + n0 * GL_LD, GL_LD, 64, acc, lane);
              const int i = n0 + cc, j = mt0 + 4 * g;
              acc.x = (j + 0 <= i) ? acc.x : 0.f; acc.y = (j + 1 <= i) ? acc.y : 0.f; acc.z = (j + 2 <= i) ? acc.z : 0.f; acc.w = (j + 3 <= i) ? acc.w : 0.f;
              *(LAS unsigned long long*)(AI + (n0 + cc) * GL_LD + mt0 + 4 * g) = pack4(acc); } }
        __syncthreads();
        { const int lane = C.lane, cc = lane & 15, g = lane >> 4, n0 = (C.wave & 3) * 16, eh = C.wave >> 2;
          f32x4 acc[4]; float ss = 0.f;
#pragma unroll
          for (int mt = 0; mt < 4; ++mt) { const int e0 = eh * 64 + mt * 16; acc[mt] = (f32x4){0.f, 0.f, 0.f, 0.f};
              { const LAS bf16* bp = QP + (n0 + cc) * GL_LD + 8 * g;
                acc[mt] = __builtin_amdgcn_mfma_f32_16x16x32_bf16(sfrag[mt][0], *(const LAS s16x8*)bp, acc[mt], 0, 0, 0); acc[mt] = __builtin_amdgcn_mfma_f32_16x16x32_bf16(sfrag[mt][1], *(const LAS s16x8*)(bp + 32), acc[mt], 0, 0, 0); }
              acc[mt] = mm16(VT + e0 * GL_LD, GL_LD, AI + n0 * GL_LD, GL_LD, 64, acc[mt], lane);
              ss += (acc[mt].x * acc[mt].x + acc[mt].y * acc[mt].y) + (acc[mt].z * acc[mt].z + acc[mt].w * acc[mt].w); }
          ss = xsum4(ss);
          if (g == 0) SSQ[eh * 64 + n0 + cc] = ss;
          __syncthreads();
          const float rstd = __builtin_amdgcn_rsqf((SSQ[n0 + cc] + SSQ[64 + n0 + cc]) * (1.f / 128.f) + 1e-6f);
          const size_t m = m0 + n0 + cc;
#pragma unroll
          for (int mt = 0; mt < 4; ++mt) { const int e = eh * 64 + mt * 16 + 4 * g;
              const unsigned long long gx = *(const unsigned long long*)(pg + (size_t)(n0 + cc) * NPG + 1024 + h * 128 + e);
              const f32x4 ng = *(const f32x4*)(norm_g + e);
              f32x4 o;
              o.x = acc[mt].x * rstd * ng.x * siluf_(bf2f((bf16)(gx & 0xffffu)));
              o.y = acc[mt].y * rstd * ng.y * siluf_(bf2f((bf16)((gx >> 16) & 0xffffu)));
              o.z = acc[mt].z * rstd * ng.z * siluf_(bf2f((bf16)((gx >> 32) & 0xffffu)));
              o.w = acc[mt].w * rstd * ng.w * siluf_(bf2f((bf16)(gx >> 48)));
              *(unsigned long long*)(O + m * D_ + h * 128 + e) = pack4(o); } }
        __syncthreads();
    }
}

__device__ __forceinline__ size_t chain_blk(int item, int rot) { const int h = item & 7, c = (item >> 3) & 127, b = item >> 10, k = b * 8 + h; return (size_t)(k * 128 + ((c + 4 * k + rot) & 127)) * 4096; }
struct RwkvW { const float *mu, *mu_vres, *w0, *a0, *v0, *k_k, *k_a, *r_k; const bf16 *wupT, *aupT, *gupT, *vupT; };
constexpr int RW_LD = 72, RW_XLD = 296;
constexpr int RW_R0 = 0;
constexpr int RW_SEG = 16384;
constexpr int RW_R1 = 36864;
constexpr int RW_R2 = RW_R1 + 27648;
constexpr int RW_R3 = RW_R2 + 9216;
constexpr int RW_R4 = RW_R3 + 27648;
constexpr int RW_TI = RW_R4 + 128 * RW_LD * 2;
constexpr int RW_MU = RW_TI + 2048;
constexpr int RW_X = RW_MU + 2048;
constexpr int RW_END = RW_X + 64 * RW_XLD * 2;
static_assert(RW_END <= MISC_OFF, "RWKV LDS map");

typedef short s16x4 __attribute__((ext_vector_type(4)));
__device__ __forceinline__ float tanh_fast(float x) { const float e = __expf(2.f * x); return 1.f - 2.f * __builtin_amdgcn_rcpf(e + 1.f); }
__device__ __forceinline__ float softplus_fast(float x) { return fmaxf(x, 0.f) + __logf(1.f + __expf(-fabsf(x))); }
__device__ __forceinline__ s16x4 cvt4(f32x4 v) { const unsigned long long p = pack4(v); return __builtin_bit_cast(s16x4, p); }
__device__ __forceinline__ void ld8f(const float* p, float (&o)[8]) { const f32x4 a = *(const f32x4*)p, b = *(const f32x4*)(p + 4); o[0] = a.x; o[1] = a.y; o[2] = a.z; o[3] = a.w; o[4] = b.x; o[5] = b.y; o[6] = b.z; o[7] = b.w; }
__device__ __forceinline__ float sum8(float v) { v += dpp_f<0xB1>(v); v += dpp_f<0x4E>(v); v += dpp_f<0x141>(v); return v; }
__device__ __forceinline__ void unpack8(const v4u x, float (&o)[8]) {
    o[0] = bf2f((bf16)(x.x & 0xffffu)); o[1] = bf2f((bf16)(x.x >> 16)); o[2] = bf2f((bf16)(x.y & 0xffffu)); o[3] = bf2f((bf16)(x.y >> 16));
    o[4] = bf2f((bf16)(x.z & 0xffffu)); o[5] = bf2f((bf16)(x.z >> 16)); o[6] = bf2f((bf16)(x.w & 0xffffu)); o[7] = bf2f((bf16)(x.w >> 16)); }
__device__ __forceinline__ v4u pack8(const float (&o)[8]) { return (v4u){pk2(o[0], o[1]), pk2(o[2], o[3]), pk2(o[4], o[5]), pk2(o[6], o[7])}; }
__device__ __forceinline__ f32x4 mm16_gb(const LAS bf16* A, int lda, const bf16* B, int ldb, int K, f32x4 acc, int lane) {
    const int r = lane & 15, g = lane >> 4;
    const LAS bf16* ap = A + r * lda + 8 * g; const bf16* bp = B + r * ldb + 8 * g;
    for (int k0 = 0; k0 < K; k0 += 32) { const s16x8 a = *(const LAS s16x8*)(ap + k0); const s16x8 b = *(const s16x8*)(bp + k0); acc = __builtin_amdgcn_mfma_f32_16x16x32_bf16(a, b, acc, 0, 0, 0); }
    return acc;
}

__device__ __forceinline__ void ph_norm_b(const Ctx& C, const bf16* x, const float* g, const float* sh, const float* sc, bf16* XB) {
    const int gw = C.bid * 8 + C.wave, NGW = C.nb * 8, lane = C.lane;
    float gv[2][8];
#pragma unroll
    for (int j = 0; j < 2; ++j) ld8f(g + 8 * lane + 512 * j, gv[j]);
    for (int m0 = gw; m0 < M_; m0 += 4 * NGW) {
        v4u raw[4][2];
#pragma unroll
        for (int r = 0; r < 4; ++r) { const int m = m0 + r * NGW; const v4u* xr = (const v4u*)(x + (size_t)(m < M_ ? m : m0) * D_) + lane; raw[r][0] = xr[0]; raw[r][1] = xr[64]; }
#pragma unroll
        for (int r = 0; r < 4; ++r) { const int m = m0 + r * NGW; if (m >= M_) break;
            const int b = m / T_;
            float v[2][8]; float s = 0.f;
#pragma unroll
            for (int j = 0; j < 2; ++j) { unpack8(raw[r][j], v[j]);
#pragma unroll
                for (int i = 0; i < 8; ++i) s += v[j][i] * v[j][i]; }
            const float rstd = __builtin_amdgcn_rsqf(wave_sum(s) * (1.f / D_) + 1e-6f);
            v4u* o = (v4u*)(XB + (size_t)m * D_) + lane;
#pragma unroll
            for (int j = 0; j < 2; ++j) { const int col = 8 * lane + 512 * j; float shv[8], scv[8], h[8];
                ld8f(sh + b * 6144 + col, shv); ld8f(sc + b * 6144 + col, scv);
#pragma unroll
                for (int i = 0; i < 8; ++i) h[i] = v[j][i] * rstd * gv[j][i] * (scv[i] + 1.f) + shv[i];
                o[64 * j] = pack8(h); } }
    }
}
__device__ __forceinline__ void ph_final_b(const Ctx& C, const bf16* x, const float* g, float* out, int m_lo, int m_hi, bf16* keep, int c_lo, int c_hi) {
    const int gw = C.bid * 8 + C.wave, NGW = C.nb * 8, lane = C.lane;
    for (int m = m_lo + gw; m < m_hi; m += NGW) {
        const v4u* xr = (const v4u*)(x + (size_t)m * D_) + lane;
        float v[2][8]; float s = 0.f;
#pragma unroll
        for (int j = 0; j < 2; ++j) { unpack8(xr[64 * j], v[j]);
#pragma unroll
            for (int i = 0; i < 8; ++i) s += v[j][i] * v[j][i]; }
        const float rstd = 1.f / sqrtf(wave_sum(s) * (1.f / D_) + 1e-6f);
#pragma unroll
        for (int j = 0; j < 2; ++j) { const int col = 8 * lane + 512 * j; float gv[8]; ld8f(g + col, gv);
            f32x4* o = (f32x4*)(out + (size_t)m * D_ + col);
            o[0] = (f32x4){v[j][0] * rstd * gv[0], v[j][1] * rstd * gv[1], v[j][2] * rstd * gv[2], v[j][3] * rstd * gv[3]};
            o[1] = (f32x4){v[j][4] * rstd * gv[4], v[j][5] * rstd * gv[5], v[j][6] * rstd * gv[6], v[j][7] * rstd * gv[7]}; }
    }
    for (int m = c_lo + gw; m < c_hi; m += NGW) { const v4u* xr = (const v4u*)(x + (size_t)m * D_) + lane; v4u* kr = (v4u*)(keep + (size_t)(m - c_lo) * D_) + lane; kr[0] = xr[0]; kr[64] = xr[64]; }
}
__device__ __forceinline__ int rofs(int row, int t) { return row * RW_LD + ((((t >> 3) + (row >> 3)) & 7) << 3) + (t & 7); }
__device__ __forceinline__ void ph_rwkv_a(const Ctx& C, const bf16* PR, const bf16* VL  , const RwkvW& W, int layer,
                                          bf16* PP, bf16* QQ, bf16* RH, bf16* YH, float* GAMC, float* RK, bf16* GG, bf16* VF, bool store_v = true) {
    LAS unsigned char* L = C.lds;
    LAS bf16* X = (LAS bf16*)(L + RW_X); LAS float* CUM = (LAS float*)(L + RW_R0); LAS float* SEG = (LAS float*)(L + RW_SEG);
    LAS bf16* NI = (LAS bf16*)(L + RW_R0), *AAK = NI + 64 * RW_LD, *ARB = AAK + 64 * RW_LD, *ARK = ARB + 64 * RW_LD;
    LAS bf16* PRE = (LAS bf16*)(L + RW_R1);
    LAS bf16* AT = (LAS bf16*)(L + RW_R1), *BT = AT + 64 * RW_LD, *KT = BT + 64 * RW_LD, *RT = (LAS bf16*)(L + RW_R2);
    LAS bf16* XB16 = (LAS bf16*)(L + RW_R1);
    LAS bf16* BHc = (LAS bf16*)(L + RW_R3), *KHc = BHc + 64 * RW_LD, *VTc = KHc + 64 * RW_LD;
    LAS bf16* XT = (LAS bf16*)(L + RW_R4); LAS bf16* TI = (LAS bf16*)(L + RW_TI);
    const int wave = C.wave;
    LAS float* MU = (LAS float*)(L + RW_MU);
    for (int i = C.tid; i < 288; i += NT) MU[i] = i < 256 ? W.mu[1536 + i] : (layer ? W.mu_vres[i - 256] : 0.f);
    __syncthreads();
    for (int bc = C.bid; bc < 512; bc += C.nb) {
        const int c = bc & 127, b = bc >> 7;
        const size_t m0 = (size_t)b * T_ + c * 64;
        { const int tid = C.tid;
          v4u xc[5], xp[5];
#pragma unroll
          for (int it = 0; it < 5; ++it) { const int idx = tid + it * NT; xc[it] = (v4u){0u, 0u, 0u, 0u}; xp[it] = xc[it];
            if (idx < 64 * 36) { const int t1 = idx / 36, q = idx % 36, col = q * 8; const size_t m1 = m0 + t1; const bool first1 = (c == 0 && t1 == 0);
                if (q < 32) { xc[it] = *(const v4u*)(PR + m1 * NPR + 1536 + col); if (!first1) xp[it] = *(const v4u*)(PR + (m1 - 1) * NPR + 1536 + col); }
                else if (layer) { xc[it] = *(const v4u*)(VL + m1 * NPG + 1552 + (col - 256)); if (!first1) xp[it] = *(const v4u*)(VL + (m1 - 1) * NPG + 1552 + (col - 256)); } } }
#pragma unroll
          for (int it = 0; it < 5; ++it) { const int idx = tid + it * NT;
            if (idx < 64 * 36) { const int t1 = idx / 36, q = idx % 36, col = q * 8;
                float cv[8], pv[8], mu[8]; unpack8(xc[it], cv); unpack8(xp[it], pv);
                { const f32x4 ma = *(const LAS f32x4*)(MU + col), mb = *(const LAS f32x4*)(MU + col + 4); mu[0] = ma.x; mu[1] = ma.y; mu[2] = ma.z; mu[3] = ma.w; mu[4] = mb.x; mu[5] = mb.y; mu[6] = mb.z; mu[7] = mb.w; }
#pragma unroll
                for (int i = 0; i < 8; ++i) { float p = cv[i] + (pv[i] - cv[i]) * mu[i]; if (q < 8) p = tanh_fast(p); else if (q >= 16 && q < 32) p = sigmoidf_(p); cv[i] = p; }
                *(LAS v4u*)(X + t1 * RW_XLD + col) = pack8(cv); } }
        }
        __syncthreads();
      v4u rcx, kcx, vcx, rpx, kpx, vpx, vfx;
#define RW_FETCH(hh) do { const int t_ = C.tid >> 3, ch_ = (hh) * 64 + (C.tid & 7) * 8; const size_t m_ = m0 + t_; const bool first_ = (c == 0 && t_ == 0); \
        rcx = *(const v4u*)(PR + m_ * NPR + ch_); kcx = *(const v4u*)(PR + m_ * NPR + 512 + ch_); vcx = *(const v4u*)(PR + m_ * NPR + 1024 + ch_); \
        rpx = (v4u){0u, 0u, 0u, 0u}; kpx = rpx; vpx = rpx; vfx = rpx; \
        if (!first_) { rpx = *(const v4u*)(PR + (m_ - 1) * NPR + ch_); kpx = *(const v4u*)(PR + (m_ - 1) * NPR + 512 + ch_); vpx = *(const v4u*)(PR + (m_ - 1) * NPR + 1024 + ch_); } \
        if (layer) vfx = *(const v4u*)(VF + m_ * 512 + ch_); } while (0)
      RW_FETCH(0);
#pragma unroll 1
      for (int h = 0; h < 8; ++h) {
        const int item = bc * 8 + h;
        int tid_ = C.tid; asm volatile("" : "+v"(tid_));
        const int tid = tid_, lane = tid & 63, cc = lane & 15, g = lane >> 4;
        const int t = tid >> 3, d0 = (tid & 7) * 8, ch = h * 64 + d0; const size_t m = m0 + t;
        {
            const int lsel = wave >> 1;
            const bf16* WT = lsel == 0 ? W.wupT : lsel == 1 ? W.aupT : lsel == 2 ? W.gupT : W.vupT;
            const int Kl = lsel == 2 ? 128 : lsel == 3 ? 32 : 64, xoff = lsel == 0 ? 0 : lsel == 1 ? 64 : lsel == 2 ? 128 : 256;
            LAS bf16* outp = PRE + lsel * 64 * RW_LD;
            const bool live = (lsel != 3 || layer);
#pragma unroll
            for (int mq = 0; mq < 2; ++mq) { const int mt = (wave & 1) * 2 + mq;
                s16x8 af[4];
                const bf16* ap = WT + (size_t)(h * 64 + mt * 16 + cc) * Kl + 8 * g;
#pragma unroll
                for (int ks = 0; ks < 4; ++ks) af[ks] = (live && ks * 32 < Kl) ? *(const s16x8*)(ap + ks * 32) : (s16x8){0, 0, 0, 0, 0, 0, 0, 0};
#pragma unroll
                for (int nt = 0; nt < 4; ++nt) { f32x4 acc = {0.f, 0.f, 0.f, 0.f};
                    const LAS bf16* bp = X + (nt * 16 + cc) * RW_XLD + xoff + 8 * g;
#pragma unroll
                    for (int ks = 0; ks < 4; ++ks) if (ks * 32 < Kl) { const s16x8 bb = *(const LAS s16x8*)(bp + ks * 32); acc = __builtin_amdgcn_mfma_f32_16x16x32_bf16(af[ks], bb, acc, 0, 0, 0); }
                    *(LAS unsigned long long*)(outp + (nt * 16 + cc) * RW_LD + mt * 16 + 4 * g) = pack4(acc); } }
        }
        __syncthreads();
        float av[8], bv[8], kv[8], rv[8], lw[8], vv[8];
        {
            float rc[8], rp[8], kc[8], kp[8], vc[8], vp[8], pw[8], pa[8], pg_[8], pvg[8];
            unpack8(rcx, rc); unpack8(kcx, kc); unpack8(vcx, vc); unpack8(rpx, rp); unpack8(kpx, kp); unpack8(vpx, vp);
            unpack8(*(const LAS v4u*)(PRE + (0 * 64 + t) * RW_LD + d0), pw); unpack8(*(const LAS v4u*)(PRE + (1 * 64 + t) * RW_LD + d0), pa);
            unpack8(*(const LAS v4u*)(PRE + (2 * 64 + t) * RW_LD + d0), pg_); unpack8(*(const LAS v4u*)(PRE + (3 * 64 + t) * RW_LD + d0), pvg);
            float vf[8]; unpack8(vfx, vf);
            float ssq = 0.f, rks = 0.f, asg[8], gg[8];
            float mur[8], muk[8], muv[8], w0c[8], a0c[8], v0c[8], kkc[8], kac[8], rkc[8];
            ld8f(W.mu + ch, mur); ld8f(W.mu + 512 + ch, muk); ld8f(W.mu + 1024 + ch, muv); ld8f(W.w0 + ch, w0c); ld8f(W.a0 + ch, a0c);
            ld8f(W.k_k + ch, kkc); ld8f(W.k_a + ch, kac); ld8f(W.r_k + ch, rkc);
            if (layer) ld8f(W.v0 + ch, v0c);
#pragma unroll
            for (int i = 0; i < 8; ++i) {
                const float r = rc[i] + (rp[i] - rc[i]) * mur[i], k = kc[i] + (kp[i] - kc[i]) * muk[i]; float v = vc[i] + (vp[i] - vc[i]) * muv[i];
                lw[i] = -0.6065306597f * sigmoidf_(w0c[i] + pw[i]);
                asg[i] = sigmoidf_(a0c[i] + pa[i]);
                if (layer) v = v + (vf[i] - v) * sigmoidf_(v0c[i] + pvg[i]);
                const float kk = k * kkc[i]; ssq += kk * kk;
                kv[i] = k * (1.f + (asg[i] - 1.f) * kac[i]); rv[i] = r; vv[i] = v; gg[i] = pg_[i]; av[i] = kk;
                rks += r * kv[i] * rkc[i];
            }
            ssq = sum8(ssq); rks = sum8(rks);
            const float inv = __builtin_amdgcn_rsqf(fmaxf(ssq, 1e-24f));
#pragma unroll
            for (int i = 0; i < 8; ++i) { const float kk = av[i] * inv; av[i] = -kk; bv[i] = kk * asg[i]; }
            if ((tid & 7) == 0) RK[m * 8 + h] = rks;
            *(v4u*)(GG + m * 512 + ch) = pack8(gg);
            if (store_v) *(v4u*)(VF + m * 512 + ch) = pack8(vv);
#pragma unroll
            for (int i = 0; i < 8; ++i) vv[i] = bf2f((bf16)f2bf(vv[i]));
        }
        __syncthreads();
#pragma unroll
        for (int i = 0; i < 8; ++i) CUM[t * 64 + d0 + i] = lw[i];
        __syncthreads();
        { const int d = tid & 63, seg = tid >> 6; float run = 0.f;
#pragma unroll
          for (int q = 0; q < 8; ++q) { run += CUM[(seg * 8 + q) * 64 + d]; CUM[(seg * 8 + q) * 64 + d] = run; }
          SEG[seg * 64 + d] = run; }
        __syncthreads();
        { const int d = tid & 63, seg = tid >> 6; float off = 0.f;
          for (int s = 0; s < seg; ++s) off += SEG[s * 64 + d];
#pragma unroll
          for (int q = 0; q < 8; ++q) CUM[(seg * 8 + q) * 64 + d] += off; }
        __syncthreads();
        {
            float at[8], bt[8], kt[8], rt[8];
#pragma unroll
            for (int i = 0; i < 8; ++i) { const float cu = CUM[t * 64 + d0 + i], cC = CUM[63 * 64 + d0 + i], en = __expf(-cu), ec = __expf(cC - cu);
                at[i] = av[i] * __expf(cu - lw[i]); bt[i] = bv[i] * en; kt[i] = kv[i] * en; rt[i] = rv[i] * __expf(cu);
                { const int ro = rofs(d0 + i, t); BHc[ro] = (bf16)f2bf(bv[i] * ec); KHc[ro] = (bf16)f2bf(kv[i] * ec); VTc[ro] = (bf16)f2bf(vv[i]); XT[ro] = (bf16)f2bf(at[i]); }
                if (t == 63) GAMC[(size_t)item * 64 + d0 + i] = __expf(cC); }
            *(LAS v4u*)(AT + t * RW_LD + d0) = pack8(at); *(LAS v4u*)(BT + t * RW_LD + d0) = pack8(bt); *(LAS v4u*)(KT + t * RW_LD + d0) = pack8(kt); *(LAS v4u*)(RT + t * RW_LD + d0) = pack8(rt);
        }
        if (h < 7) RW_FETCH(h + 1);
        __syncthreads();
        {
            const int msel = wave >> 1;
            const LAS bf16* As = (msel == 0 || msel == 2) ? BT : KT; const LAS bf16* Bs = (msel < 2) ? AT : RT;
            f32x4 accs[8];
#pragma unroll
            for (int q = 0; q < 8; ++q) { const int tile = (wave & 1) * 8 + q, mt = tile >> 2, nt = tile & 3; accs[q] = (f32x4){0.f, 0.f, 0.f, 0.f};
                accs[q] = mm16(As + mt * 16 * RW_LD, RW_LD, Bs + nt * 16 * RW_LD, RW_LD, 64, accs[q], lane);
                const int tt = nt * 16 + cc, s0 = mt * 16 + 4 * g, lim = (msel < 2) ? tt - 1 : tt;
                accs[q].x = (s0 + 0 <= lim) ? accs[q].x : 0.f; accs[q].y = (s0 + 1 <= lim) ? accs[q].y : 0.f; accs[q].z = (s0 + 2 <= lim) ? accs[q].z : 0.f; accs[q].w = (s0 + 3 <= lim) ? accs[q].w : 0.f; }
            __syncthreads();
            LAS bf16* outp = NI + msel * 64 * RW_LD;
#pragma unroll
            for (int q = 0; q < 8; ++q) { const int tile = (wave & 1) * 8 + q, mt = tile >> 2, nt = tile & 3;
                *(LAS unsigned long long*)(outp + (nt * 16 + cc) * RW_LD + mt * 16 + 4 * g) = pack4(accs[q]); }
        }
        __syncthreads();
        if (wave == 0) {
            const int blk = lane >> 4, col = lane & 15; float x[16];
#pragma unroll
            for (int tt = 0; tt < 16; ++tt) { float nr[16]; { float lo[8], hi[8]; unpack8(*(const LAS v4u*)(NI + (16 * blk + tt) * RW_LD + 16 * blk), lo); unpack8(*(const LAS v4u*)(NI + (16 * blk + tt) * RW_LD + 16 * blk + 8), hi);
#pragma unroll
                    for (int q = 0; q < 8; ++q) { nr[q] = lo[q]; nr[8 + q] = hi[q]; } }
                float a = (tt == col) ? 1.f : 0.f;
#pragma unroll
                for (int q = 0; q < tt; ++q) a += nr[q] * x[q];
                x[tt] = a; TI[(blk * 16 + tt) * 16 + col] = (bf16)f2bf(a); }
        } else {
            for (int tile = wave - 1; tile < 16; tile += 7) { const int mt = tile >> 2, nt = tile & 3;
                f32x4 acc = {0.f, 0.f, 0.f, 0.f};
#pragma unroll
                for (int k = 0; k < 2; ++k) { const s16x8 a = *(const LAS s16x8*)(AAK + (mt * 16 + cc) * RW_LD + 32 * k + 8 * g), bb = *(const LAS s16x8*)(VTc + rofs(nt * 16 + cc, 32 * k + 8 * g)); acc = __builtin_amdgcn_mfma_f32_16x16x32_bf16(a, bb, acc, 0, 0, 0); }
                *(LAS unsigned long long*)(XT + rofs(64 + nt * 16 + cc, mt * 16 + 4 * g)) = pack4(acc); }
        }
        __syncthreads();
        {
            s16x4 xb[4];
#pragma unroll
            for (int i = 0; i < 4; ++i) {
                f32x4 acc; { const unsigned long long xr = *(const LAS unsigned long long*)(XT + rofs(wave * 16 + cc, 16 * i + 4 * g));
                    acc.x = bf2f((bf16)(xr & 0xffffu)); acc.y = bf2f((bf16)((xr >> 16) & 0xffffu)); acc.z = bf2f((bf16)((xr >> 32) & 0xffffu)); acc.w = bf2f((bf16)(xr >> 48)); }
#pragma unroll
                for (int k = 0; k < i; ++k) { const s16x4 a = *(const LAS s16x4*)(NI + (16 * i + cc) * RW_LD + 16 * k + 4 * g); acc = __builtin_amdgcn_mfma_f32_16x16x16bf16_1k(a, xb[k], acc, 0, 0, 0); }
                const s16x4 yb = cvt4(acc), ta = *(const LAS s16x4*)(TI + (i * 16 + cc) * 16 + 4 * g);
                const f32x4 xi = __builtin_amdgcn_mfma_f32_16x16x16bf16_1k(ta, yb, (f32x4){0.f, 0.f, 0.f, 0.f}, 0, 0, 0);
                xb[i] = cvt4(xi);
            }
            __syncthreads();
#pragma unroll
            for (int i = 0; i < 4; ++i) *(LAS s16x4*)(XB16 + (wave * 16 + cc) * RW_LD + 16 * i + 4 * g) = xb[i];
        }
        __syncthreads();
        {
            const int osel = wave >> 1, mt0 = (wave & 1) * 2; const size_t ob = osel == 0 ? chain_blk(item, 0) : osel == 1 ? chain_blk(item, 64) : (size_t)item * 4096;
            const LAS bf16* A1 = osel == 0 ? XB16 : osel == 1 ? BHc : osel == 2 ? XB16 : XB16 + 64 * RW_LD;
            const LAS bf16* B1 = osel == 0 ? BHc : osel == 1 ? XB16 + 64 * RW_LD : ARB;
            const LAS bf16* A2 = osel == 1 ? KHc : VTc; const LAS bf16* B2 = osel == 1 ? VTc : ARK;
            const bool rA1 = osel == 1, rB1 = osel == 0, rA2 = true, rB2 = osel == 1;
#define RW_FO(rot, row, k) ((rot) ? rofs((row), 32 * (k) + 8 * g) : (row) * RW_LD + 32 * (k) + 8 * g)
            bf16* OUT = osel == 0 ? PP : osel == 1 ? QQ : osel == 2 ? RH : YH;
            f32x4 acc[2][4];
#pragma unroll
            for (int mq = 0; mq < 2; ++mq)
#pragma unroll
                for (int nt = 0; nt < 4; ++nt) acc[mq][nt] = (f32x4){0.f, 0.f, 0.f, 0.f};
            { s16x8 af[2][2], bfm[4][2];
#pragma unroll
              for (int mq = 0; mq < 2; ++mq)
#pragma unroll
                  for (int k = 0; k < 2; ++k) af[mq][k] = *(const LAS s16x8*)(A1 + RW_FO(rA1, (mt0 + mq) * 16 + cc, k));
#pragma unroll
              for (int nt = 0; nt < 4; ++nt)
#pragma unroll
                  for (int k = 0; k < 2; ++k) bfm[nt][k] = *(const LAS s16x8*)(B1 + RW_FO(rB1, nt * 16 + cc, k));
#pragma unroll
              for (int mq = 0; mq < 2; ++mq)
#pragma unroll
                  for (int nt = 0; nt < 4; ++nt) { acc[mq][nt] = __builtin_amdgcn_mfma_f32_16x16x32_bf16(af[mq][0], bfm[nt][0], acc[mq][nt], 0, 0, 0); acc[mq][nt] = __builtin_amdgcn_mfma_f32_16x16x32_bf16(af[mq][1], bfm[nt][1], acc[mq][nt], 0, 0, 0); } }
            if (osel & 1) { s16x8 af[2][2], bfm[4][2];
#pragma unroll
              for (int mq = 0; mq < 2; ++mq)
#pragma unroll
                  for (int k = 0; k < 2; ++k) af[mq][k] = *(const LAS s16x8*)(A2 + RW_FO(rA2, (mt0 + mq) * 16 + cc, k));
#pragma unroll
              for (int nt = 0; nt < 4; ++nt)
#pragma unroll
                  for (int k = 0; k < 2; ++k) bfm[nt][k] = *(const LAS s16x8*)(B2 + RW_FO(rB2, nt * 16 + cc, k));
#pragma unroll
              for (int mq = 0; mq < 2; ++mq)
#pragma unroll
                  for (int nt = 0; nt < 4; ++nt) { acc[mq][nt] = __builtin_amdgcn_mfma_f32_16x16x32_bf16(af[mq][0], bfm[nt][0], acc[mq][nt], 0, 0, 0); acc[mq][nt] = __builtin_amdgcn_mfma_f32_16x16x32_bf16(af[mq][1], bfm[nt][1], acc[mq][nt], 0, 0, 0); } }
#pragma unroll
            for (int mq = 0; mq < 2; ++mq)
#pragma unroll
                for (int nt = 0; nt < 4; ++nt) { f32x4 a = acc[mq][nt];
                    if (osel == 2) { const unsigned long long rr = *(const LAS unsigned long long*)(RT + (nt * 16 + cc) * RW_LD + (mt0 + mq) * 16 + 4 * g);
                        a.x += bf2f((bf16)(rr & 0xffffu)); a.y += bf2f((bf16)((rr >> 16) & 0xffffu)); a.z += bf2f((bf16)((rr >> 32) & 0xffffu)); a.w += bf2f((bf16)(rr >> 48)); }
                    const int co = osel < 3 ? ((mt0 + mq) >> 1) * 32 + g * 8 + ((mt0 + mq) & 1) * 4 : (mt0 + mq) * 16 + 4 * g;
                    *(unsigned long long*)(OUT + ob + (nt * 16 + cc) * 64 + co) = pack4(a); }
        }
        __syncthreads();
      }
    }
}

#undef RW_FETCH
#undef RW_FO
constexpr int CH_R = 6, CH_LDB = 160, CH_IMG = 64 * CH_LDB, CH_SLOT = 2 * CH_IMG + 256;
constexpr int CH_RING = 0, CH_FLAGS = CH_R * CH_SLOT;
static_assert(CH_FLAGS + 64 <= MISC_OFF, "chain LDS map");
struct ChainRegs { v4u p[8], q[8]; f32x4 gm; };
__device__ __forceinline__ void chain_fetch(ChainRegs& o, const bf16* PP, const bf16* QQ, const float* GAMC, int item, int lane) {
    const size_t obp = chain_blk(item, 0), obq = chain_blk(item, 64);
#pragma unroll
    for (int i = 0; i < 8; ++i) { o.p[i] = *(const v4u*)(PP + obp + (size_t)(i * 64 + lane) * 8); o.q[i] = *(const v4u*)(QQ + obq + (size_t)(i * 64 + lane) * 8); }
    o.gm = *(const f32x4*)(GAMC + (size_t)item * 64 + (lane & 15) * 4);
}
__device__ __forceinline__ void chain_commit(const ChainRegs& o, LAS unsigned char* L, int c, int lane) {
    volatile LAS unsigned* flags = (volatile LAS unsigned*)(L + CH_FLAGS);
    const int slot = c % CH_R;
    if (c >= CH_R) { const unsigned need = (unsigned)(c - CH_R + 1);
        for (;;) { const unsigned m0 = flags[CH_R + 0], m1 = flags[CH_R + 1], m2 = flags[CH_R + 2], m3 = flags[CH_R + 3];
            if (m0 >= need && m1 >= need && m2 >= need && m3 >= need) break; __builtin_amdgcn_s_sleep(1); } }
    asm volatile("" ::: "memory");
    LAS unsigned char* sl = L + CH_RING + slot * CH_SLOT;
#pragma unroll
    for (int i = 0; i < 8; ++i) { const int idx = i * 64 + lane, row = idx >> 3, c16 = idx & 7;
        *(LAS v4u*)(sl + row * CH_LDB + c16 * 16) = o.p[i]; *(LAS v4u*)(sl + CH_IMG + row * CH_LDB + c16 * 16) = o.q[i]; }
    *(LAS f32x4*)(sl + 2 * CH_IMG + (lane & 15) * 16) = o.gm;
    asm volatile("s_waitcnt lgkmcnt(0)" ::: "memory");
    if (lane == 0) flags[slot] = (unsigned)(c + 1);
}
struct ChainOps { s16x8 a[4][2]; v4u q[2]; f32x4 gm[4]; };
__device__ __forceinline__ void chain_read(ChainOps& X, LAS unsigned char* L, int c, int vt, int cc, int g) {
    const LAS unsigned char* sl = L + CH_RING + (c % CH_R) * CH_SLOT;
#pragma unroll
    for (int mt = 0; mt < 4; ++mt) {
#pragma unroll
        for (int kb = 0; kb < 2; ++kb) X.a[mt][kb] = *(const LAS s16x8*)(sl + (mt * 16 + cc) * CH_LDB + kb * 64 + g * 16);
        X.gm[mt] = *(const LAS f32x4*)(sl + 2 * CH_IMG + (mt * 16 + 4 * g) * 4); }
#pragma unroll
    for (int kb = 0; kb < 2; ++kb) X.q[kb] = *(const LAS v4u*)(sl + CH_IMG + (vt * 16 + cc) * CH_LDB + kb * 64 + g * 16);
}
__device__ __forceinline__ void chain_step(const ChainOps& X, ChainOps& Y, f32x4 (&st)[4], LAS unsigned char* L, volatile LAS unsigned* flags, bf16* S0, size_t ob, int c, int vt, int cc, int g, int lane) {
    unsigned long long pk[4];
#pragma unroll
    for (int mt = 0; mt < 4; ++mt) pk[mt] = pack4(st[mt]);
    s16x8 bq[2];
#pragma unroll
    for (int kb = 0; kb < 2; ++kb) { const unsigned long long lo = pk[2 * kb], hi = pk[2 * kb + 1];
        const v4u w = {(unsigned)lo, (unsigned)(lo >> 32), (unsigned)hi, (unsigned)(hi >> 32)};
        bq[kb] = __builtin_bit_cast(s16x8, w);
        *(v4u*)(S0 + ob + (size_t)((vt * 2 + kb) * 64 + lane) * 8) = w; }
    asm volatile("s_waitcnt lgkmcnt(0)" ::: "memory");
    if (lane == 0) flags[CH_R + vt] = (unsigned)(c + 1);
    if (c + 1 < 128) {
        while (flags[(c + 1) % CH_R] < (unsigned)(c + 2)) __builtin_amdgcn_s_sleep(1);
        asm volatile("s_waitcnt lgkmcnt(0)" ::: "memory");
        chain_read(Y, L, c + 1, vt, cc, g); }
#pragma unroll
    for (int mt = 0; mt < 4; ++mt) { const unsigned q0 = (mt & 1) ? X.q[mt >> 1].z : X.q[mt >> 1].x, q1 = (mt & 1) ? X.q[mt >> 1].w : X.q[mt >> 1].y; const f32x4 gm = X.gm[mt];
        f32x4 acc; acc.x = gm.x * st[mt].x + bf2f((bf16)(q0 & 0xffffu)); acc.y = gm.y * st[mt].y + bf2f((bf16)(q0 >> 16));
        acc.z = gm.z * st[mt].z + bf2f((bf16)(q1 & 0xffffu)); acc.w = gm.w * st[mt].w + bf2f((bf16)(q1 >> 16));
#pragma unroll
        for (int kb = 0; kb < 2; ++kb) acc = __builtin_amdgcn_mfma_f32_16x16x32_bf16(X.a[mt][kb], bq[kb], acc, 0, 0, 0);
        st[mt] = acc; }
}
__device__ __forceinline__ void ph_rwkv_b(const Ctx& C, int bh  , const bf16* PP, const bf16* QQ, const float* GAMC, bf16* S0) {
    const int lane = C.lane, wave = C.wave, cc = lane & 15, g = lane >> 4, b = bh >> 3, h = bh & 7;
    LAS unsigned char* L = C.lds;
    volatile LAS unsigned* flags = (volatile LAS unsigned*)(L + CH_FLAGS);
    if (C.tid < 16) flags[C.tid] = 0u;
    __syncthreads();
    if (wave >= 4) {
        const int j = wave - 4;
        ChainRegs A, B;
        int lc = j;
        chain_fetch(A, PP, QQ, GAMC, (b * 128 + lc) * 8 + h, lane);
        for (int it = 0; it < 16; ++it) {
            chain_fetch(B, PP, QQ, GAMC, (b * 128 + min(lc + 4, 124 + j)) * 8 + h, lane);
            chain_commit(A, L, lc, lane);
            lc += 4;
            chain_fetch(A, PP, QQ, GAMC, (b * 128 + min(lc + 4, 124 + j)) * 8 + h, lane);
            chain_commit(B, L, lc, lane);
            lc += 4;
        }
    } else {
        const int vt = wave;
        f32x4 st[4];
#pragma unroll
        for (int mt = 0; mt < 4; ++mt) st[mt] = (f32x4){0.f, 0.f, 0.f, 0.f};
        ChainOps X0, X1;
        while (flags[0] < 1u) __builtin_amdgcn_s_sleep(1);
        asm volatile("s_waitcnt lgkmcnt(0)" ::: "memory");
        chain_read(X0, L, 0, vt, cc, g);
        for (int c = 0; c < 128; c += 2) {
            chain_step(X0, X1, st, L, flags, S0, chain_blk((b * 128 + c) * 8 + h, 32), c, vt, cc, g, lane);
            chain_step(X1, X0, st, L, flags, S0, chain_blk((b * 128 + c + 1) * 8 + h, 32), c + 1, vt, cc, g, lane);
        }
    }
    __syncthreads();
}

__device__ __forceinline__ void ph_rwkv_c(const Ctx& C, const bf16* S0, const bf16* RH, const bf16* YH, const float* RK, const bf16* GG, const bf16* VF,
                                          const float* gn_g, const float* gn_b, bf16* O) {
    const int lane = C.lane, cc = lane & 15, g = lane >> 4;
    for (int item = C.bid * 8 + C.wave; item < 4096; item += C.nb * 8) {
        const int h = item & 7, c = (item >> 3) & 127, b = item >> 10; const size_t m0 = (size_t)b * T_ + c * 64, ob = (size_t)item * 4096;
        s16x8 af[4][2], bfr[4][2];
#pragma unroll
        for (int q = 0; q < 4; ++q)
#pragma unroll
            for (int k = 0; k < 2; ++k) { af[q][k] = *(const s16x8*)(S0 + chain_blk(item, 32) + (size_t)((q * 2 + k) * 64 + lane) * 8); bfr[q][k] = *(const s16x8*)(RH + ob + (q * 16 + cc) * 64 + k * 32 + 8 * g); }
#pragma unroll
        for (int nt = 0; nt < 4; ++nt) {
            const size_t m = m0 + nt * 16 + cc;
            f32x4 y[4]; float s1 = 0.f;
#pragma unroll
            for (int mt = 0; mt < 4; ++mt) { const unsigned long long yh = *(const unsigned long long*)(YH + ob + (nt * 16 + cc) * 64 + mt * 16 + 4 * g);
                f32x4 acc; acc.x = bf2f((bf16)(yh & 0xffffu)); acc.y = bf2f((bf16)((yh >> 16) & 0xffffu)); acc.z = bf2f((bf16)((yh >> 32) & 0xffffu)); acc.w = bf2f((bf16)(yh >> 48));
                acc = __builtin_amdgcn_mfma_f32_16x16x32_bf16(af[mt][0], bfr[nt][0], acc, 0, 0, 0); acc = __builtin_amdgcn_mfma_f32_16x16x32_bf16(af[mt][1], bfr[nt][1], acc, 0, 0, 0);
                y[mt] = acc; s1 += (acc.x + acc.y) + (acc.z + acc.w); }
            s1 = xsum4(s1);
            const float mean = s1 * (1.f / 64.f); float s2 = 0.f;
#pragma unroll
            for (int mt = 0; mt < 4; ++mt) { y[mt] = y[mt] - mean; s2 += (y[mt].x * y[mt].x + y[mt].y * y[mt].y) + (y[mt].z * y[mt].z + y[mt].w * y[mt].w); }
            s2 = xsum4(s2);
            const float rstd = __builtin_amdgcn_rsqf(s2 * (1.f / 64.f) + 64e-5f), rk = RK[m * 8 + h];
#pragma unroll
            for (int mt = 0; mt < 4; ++mt) { const int v = h * 64 + mt * 16 + 4 * g;
                const f32x4 gg4 = *(const f32x4*)(gn_g + v), gb4 = *(const f32x4*)(gn_b + v);
                const unsigned long long vx = *(const unsigned long long*)(VF + m * 512 + v), gx = *(const unsigned long long*)(GG + m * 512 + v);
                f32x4 o;
                o.x = (y[mt].x * rstd * gg4.x + gb4.x + rk * bf2f((bf16)(vx & 0xffffu))) * bf2f((bf16)(gx & 0xffffu));
                o.y = (y[mt].y * rstd * gg4.y + gb4.y + rk * bf2f((bf16)((vx >> 16) & 0xffffu))) * bf2f((bf16)((gx >> 16) & 0xffffu));
                o.z = (y[mt].z * rstd * gg4.z + gb4.z + rk * bf2f((bf16)((vx >> 32) & 0xffffu))) * bf2f((bf16)((gx >> 32) & 0xffffu));
                o.w = (y[mt].w * rstd * gg4.w + gb4.w + rk * bf2f((bf16)(vx >> 48))) * bf2f((bf16)(gx >> 48));
                *(unsigned long long*)(O + m * D_ + 512 + v) = pack4(o); }
        }
    }
}

__device__ __forceinline__ void ph_convfix(const Ctx& C, const float* HALO, const float* FIXU, const float* cw, const float* cb, bf16* ACT) {
    for (int idx = C.bid * NT + C.tid; idx < 128 * 22 * 2 * 128; idx += C.nb * NT) {
        const int j = idx & 127, rr = (idx >> 7) & 1, tile = idx >> 8, pm = tile / 22, pn = tile % 22;
        const bool seq0 = (pm & 31) == 0;
        const float* fx = FIXU + (size_t)tile * 512; const float* hl = HALO + (size_t)(tile - 22) * 512;
        const float u0g = fx[rr * 256 + j], u0v = fx[rr * 256 + 128 + j];
        float u1g, u1v, u2g, u2v;
        if (rr == 0) { u1g = seq0 ? 0.f : hl[256 + j]; u1v = seq0 ? 0.f : hl[256 + 128 + j]; u2g = seq0 ? 0.f : hl[j]; u2v = seq0 ? 0.f : hl[128 + j]; }
        else { u1g = fx[j]; u1v = fx[128 + j]; u2g = seq0 ? 0.f : hl[256 + j]; u2v = seq0 ? 0.f : hl[256 + 128 + j]; }
        const int jg = pn * 128 + j, jv = DFF + jg;
        const float gc = cb[jg] + cw[jg] * u2g + cw[NUP + jg] * u1g + cw[2 * NUP + jg] * u0g, vc = cb[jv] + cw[jv] * u2v + cw[NUP + jv] * u1v + cw[2 * NUP + jv] * u0v;
        ACT[(size_t)(pm * 256 + rr) * DFF + jg] = (bf16)f2bf(siluf_(gc) * vc);
    }
}
}

namespace pg8 {
struct EpiRes {
    static constexpr bool PERM = false, AFTER_DRAIN = false;
    const float* base; float* out; const float* gate; int gstride;
    __device__ __forceinline__ void operator()(const f32x4 (&acc)[2][2][4][2], const Unit& u, int wr, int wc, int fr, int fq) const {
        const int b = (u.pm * BM) / 8192; const float* gp = gate + (size_t)b * gstride;
        const int col0 = u.pn * BM + wc * 32 + 4 * fq;
        f32x4 gv[2][2];
#pragma unroll
        for (int bj = 0; bj < 2; ++bj)
#pragma unroll
            for (int n = 0; n < 2; ++n) gv[bj][n] = *(const f32x4*)(gp + col0 + bj * HALF + n * 16);
#pragma unroll
        for (int ai = 0; ai < 2; ++ai)
#pragma unroll
            for (int m = 0; m < 4; ++m) { const size_t off = (size_t)(u.pm * BM + ai * HALF + wr * 64 + m * 16 + fr) * 1024 + col0;
                f32x4 bs[2][2];
#pragma unroll
                for (int bj = 0; bj < 2; ++bj)
#pragma unroll
                    for (int n = 0; n < 2; ++n) bs[bj][n] = *(const f32x4*)(base + off + bj * HALF + n * 16);
#pragma unroll
                for (int bj = 0; bj < 2; ++bj)
#pragma unroll
                    for (int n = 0; n < 2; ++n) *(f32x4*)(out + off + bj * HALF + n * 16) = bs[bj][n] + gv[bj][n] * acc[ai][bj][m][n]; }
    }
};

template <bool BASE32> struct EpiResB {
    static constexpr bool PERM = true, AFTER_DRAIN = false;
    const float* base32; const bf16_t* Rin; bf16_t* R; const float* gate; int gstride;
    __device__ __forceinline__ void operator()(const f32x4 (&acc)[2][2][4][2], const Unit& u, int wr, int wc, int fr, int fq) const {
        const int b = u.pm >> 5; const float* gp = gate + (size_t)b * gstride;
        const int col0 = u.pn * BM + wc * 32 + 8 * fq;
        f32x4 gv[2][2];
#pragma unroll
        for (int bj = 0; bj < 2; ++bj)
#pragma unroll
            for (int n = 0; n < 2; ++n) gv[bj][n] = *(const f32x4*)(gp + col0 + bj * HALF + n * 4);
#pragma unroll
        for (int ai = 0; ai < 2; ++ai)
#pragma unroll
            for (int m = 0; m < 4; ++m) { const size_t off = (size_t)(u.pm * BM + ai * HALF + wr * 64 + m * 16 + fr) * 1024 + col0;
                f32x4 bs[2][2];
#pragma unroll
                for (int bj = 0; bj < 2; ++bj) {
                    if (BASE32) { bs[bj][0] = *(const f32x4*)(base32 + off + bj * HALF); bs[bj][1] = *(const f32x4*)(base32 + off + bj * HALF + 4); }
                    else { const u32x4 r = *(const u32x4*)(Rin + off + bj * HALF);
                        bs[bj][0] = (f32x4){__builtin_bit_cast(float, r.x << 16), __builtin_bit_cast(float, r.x & 0xffff0000u), __builtin_bit_cast(float, r.y << 16), __builtin_bit_cast(float, r.y & 0xffff0000u)};
                        bs[bj][1] = (f32x4){__builtin_bit_cast(float, r.z << 16), __builtin_bit_cast(float, r.z & 0xffff0000u), __builtin_bit_cast(float, r.w << 16), __builtin_bit_cast(float, r.w & 0xffff0000u)}; } }
#pragma unroll
                for (int bj = 0; bj < 2; ++bj) { const f32x4 o0 = bs[bj][0] + gv[bj][0] * acc[ai][bj][m][0], o1 = bs[bj][1] + gv[bj][1] * acc[ai][bj][m][1];
                    u32x4 w; w.x = cvt_pk_bf16(o0.x, o0.y); w.y = cvt_pk_bf16(o0.z, o0.w); w.z = cvt_pk_bf16(o1.x, o1.y); w.w = cvt_pk_bf16(o1.z, o1.w);
                    *(u32x4*)(R + off + bj * HALF) = w; } }
    }
};
struct EpiConv {
    static constexpr bool PERM = true, AFTER_DRAIN = false;
    bf16_t* ACT; const float* cw; const float* cb; float* HALO; float* FIXU; PG8_LAS float* EX; int nN;
    template <int CTRL> static __device__ __forceinline__ float ror1(float x) { return __builtin_bit_cast(float, __builtin_amdgcn_mov_dpp(__builtin_bit_cast(int, x), CTRL, 0xf, 0xf, true)); }
    template <int CTRL> static __device__ __forceinline__ f32x4 ror4(f32x4 x) { return (f32x4){ror1<CTRL>(x.x), ror1<CTRL>(x.y), ror1<CTRL>(x.z), ror1<CTRL>(x.w)}; }
    template <int CTRL> static __device__ __forceinline__ float shr1(float old, float x) { return __builtin_bit_cast(float, __builtin_amdgcn_update_dpp(__builtin_bit_cast(int, old), __builtin_bit_cast(int, x), CTRL, 0xf, 0xf, false)); }
    template <int CTRL> static __device__ __forceinline__ f32x4 shr4(f32x4 o, f32x4 x) { return (f32x4){shr1<CTRL>(o.x, x.x), shr1<CTRL>(o.y, x.y), shr1<CTRL>(o.z, x.z), shr1<CTRL>(o.w, x.w)}; }
    __device__ __forceinline__ void operator()(const f32x4 (&acc)[2][2][4][2], const Unit& u, int wr, int wc, int fr, int fq) const {
        const int colw = wc * 32 + 8 * fq, tile = u.pm * nN + u.pn;
        if (fr >= 14) {
#pragma unroll
            for (int ai = 0; ai < 2; ++ai)
#pragma unroll
                for (int bj = 0; bj < 2; ++bj)
#pragma unroll
                    for (int n = 0; n < 2; ++n) { *(PG8_LAS f32x4*)(EX + ((ai * 2 + wr) * 2 + (fr - 14)) * 256 + bj * 128 + colw + 4 * n) = acc[ai][bj][3][n];
                        if (ai == 1 && wr == 1) *(f32x4*)(HALO + ((size_t)tile * 2 + (fr - 14)) * 256 + bj * 128 + colw + 4 * n) = acc[1][bj][3][n]; }
        }
        if (fr < 2 && wr == 0) {
#pragma unroll
            for (int bj = 0; bj < 2; ++bj)
#pragma unroll
                for (int n = 0; n < 2; ++n) *(f32x4*)(FIXU + ((size_t)tile * 2 + fr) * 256 + bj * 128 + colw + 4 * n) = acc[0][bj][0][n];
        }
        asm volatile("s_waitcnt lgkmcnt(0)" ::: "memory"); __builtin_amdgcn_s_barrier(); asm volatile("" ::: "memory");
#pragma unroll
        for (int n = 0; n < 2; ++n) {
            const int jg = u.pn * 128 + colw + 4 * n, jv = 2816 + jg;
            f32x4 cw0[2], cw1[2], cw2[2], cbb[2];
            cw0[0] = *(const f32x4*)(cw + jg); cw1[0] = *(const f32x4*)(cw + 5632 + jg); cw2[0] = *(const f32x4*)(cw + 2 * 5632 + jg); cbb[0] = *(const f32x4*)(cb + jg);
            cw0[1] = *(const f32x4*)(cw + jv); cw1[1] = *(const f32x4*)(cw + 5632 + jv); cw2[1] = *(const f32x4*)(cw + 2 * 5632 + jv); cbb[1] = *(const f32x4*)(cb + jv);
#pragma unroll
            for (int ai = 0; ai < 2; ++ai) {
                const int src = ai * 2 + wr - 1;
                f32x4 res[2][4];
#pragma unroll
                for (int bj = 0; bj < 2; ++bj) {
                    f32x4 o1 = {0.f, 0.f, 0.f, 0.f}, o2 = o1;
                    if (src >= 0) { const f32x4 e14 = *(const PG8_LAS f32x4*)(EX + (src * 2 + 0) * 256 + bj * 128 + colw + 4 * n), e15 = *(const PG8_LAS f32x4*)(EX + (src * 2 + 1) * 256 + bj * 128 + colw + 4 * n);
                        o1 = e15; o2 = (fr == 0) ? e14 : e15; }
#pragma unroll
                    for (int m = 0; m < 4; ++m) {
                        const f32x4 x = acc[ai][bj][m][n];
                        const f32x4 x1 = shr4<0x111>(o1, x), x2 = shr4<0x112>(o2, x);
                        res[bj][m] = cbb[bj] + cw0[bj] * x2 + cw1[bj] * x1 + cw2[bj] * x;
                        if (m < 3) { o1 = ror4<0x121>(x); o2 = ror4<0x122>(x); }
                    }
                }
#pragma unroll
                for (int m = 0; m < 4; ++m) {
                    const f32x4 gc = res[0][m], vc = res[1][m];
                    f32x4 o;
                    o.x = gc.x * __builtin_amdgcn_rcpf(1.f + __expf(-gc.x)) * vc.x; o.y = gc.y * __builtin_amdgcn_rcpf(1.f + __expf(-gc.y)) * vc.y;
                    o.z = gc.z * __builtin_amdgcn_rcpf(1.f + __expf(-gc.z)) * vc.z; o.w = gc.w * __builtin_amdgcn_rcpf(1.f + __expf(-gc.w)) * vc.w;
                    typedef unsigned u32x2 __attribute__((ext_vector_type(2)));
                    u32x2 w; w.x = cvt_pk_bf16(o.x, o.y); w.y = cvt_pk_bf16(o.z, o.w);
                    *(u32x2*)(ACT + (size_t)(u.pm * BM + ai * HALF + wr * 64 + m * 16 + fr) * 2816 + u.pn * 128 + colw + 4 * n) = w;
                }
            }
        }
    }
};
}

namespace hy {
struct Args { const float* in[31]; float* out; unsigned char* ws; };
__global__ void __launch_bounds__(NT, 2) hy_fwd(Args A) {
    extern __shared__ __attribute__((aligned(16))) unsigned char lds_raw[];
    Ctx C; C.bid = blockIdx.x; C.nb = gridDim.x; C.tid = threadIdx.x; C.lane = C.tid & 63; C.wave = __builtin_amdgcn_readfirstlane(C.tid >> 6); C.lds = (LAS unsigned char*)lds_raw;
    volatile LAS unsigned* MISC = (volatile LAS unsigned*)(C.lds + MISC_OFF);
    for (int u = C.tid; u < (LDS_BYTES - MISC_OFF) / 4; u += NT) ((LAS unsigned*)(C.lds + MISC_OFF))[u] = 0u;
    __syncthreads();
    unsigned char* ws = A.ws;
    const int wave0 = __builtin_amdgcn_readfirstlane(threadIdx.x >> 6);
    (void)xcd_barrier_post((unsigned*)(ws + WS_CTL) + CW_BAR, MISC + 8);
#define PHASE_BEGIN() do { int t_ = wave0 * 64 + lane_now(); int b_ = blockIdx.x; asm volatile("" : "+s"(b_)); \
    C.tid = t_; C.lane = t_ & 63; C.wave = __builtin_amdgcn_readfirstlane(t_ >> 6); C.bid = b_; } while (0)
#ifdef HY_DIAG
    unsigned long long ts_last = __builtin_amdgcn_s_memrealtime(); float tacc[10] = {0.f, 0.f, 0.f, 0.f, 0.f, 0.f, 0.f, 0.f, 0.f, 0.f};
#define GRID_BAR(cat) do { { XcdBarrier b_; b_.bar = (unsigned*)(A.ws + WS_CTL) + CW_BAR; b_.x = xb_xcc_id(); b_.st = (volatile LAS unsigned*)(C.lds + MISC_OFF) + 8; xcd_barrier(b_, wave0 == 0 && lane_now() == 0); } PHASE_BEGIN(); { const unsigned long long n_ = __builtin_amdgcn_s_memrealtime(); tacc[cat] += (float)(n_ - ts_last); ts_last = n_; } } while (0)
#else
#define GRID_BAR(cat) do { { XcdBarrier b_; b_.bar = (unsigned*)(A.ws + WS_CTL) + CW_BAR; b_.x = xb_xcc_id(); b_.st = (volatile LAS unsigned*)(C.lds + MISC_OFF) + 8; xcd_barrier(b_, wave0 == 0 && lane_now() == 0); } PHASE_BEGIN(); } while (0)
#endif
#ifndef HY_REPCAT
#define HY_REPCAT (-1)
#endif
#ifndef HY_REPN
#define HY_REPN 2
#endif
#define NREP(cat) ((HY_REPCAT == (cat)) ? HY_REPN : 1)
    float* out = A.out;
    bf16* RES = (bf16*)((unsigned char*)A.out + 64 * MiB);
#define in A.in
    float* MOD = (float*)(ws + WS_MOD);
    bf16 *WIN = (bf16*)(ws + WS_WIN), *WOUT = (bf16*)(ws + WS_WOUT), *WUP = (bf16*)(ws + WS_WUP), *WDN = (bf16*)(ws + WS_WDN);
    bf16 *XB = (bf16*)(ws + WS_XB), *O = (bf16*)(ws + WS_O), *VF = (bf16*)(ws + WS_VF), *PG = (bf16*)(ws + WS_PG), *PR = (bf16*)(ws + WS_PR), *VL = (bf16*)(ws + WS_VL);
    bf16 *RH = (bf16*)(ws + WS_RH), *YH = (bf16*)(ws + WS_YH), *PP = (bf16*)(ws + WS_PP), *QQ = (bf16*)(ws + WS_QQ), *GG = (bf16*)(ws + WS_GG), *S0 = (bf16*)(ws + WS_S0);
    float *GAMC = (float*)(ws + WS_GAMC), *RK = (float*)(ws + WS_RK);
    bf16* LORA = (bf16*)(ws + WS_LORA);
    bf16* DS = (bf16*)(ws + WS_GK); float* GAM = (float*)(ws + WS_GAM);
    bf16* ACT = (bf16*)(ws + WS_ACT); float *HALO = (float*)(ws + WS_U), *FIXU = (float*)(ws + WS_U + 8 * MiB);

    ph_mod(C, in[1], in[2], in[3], MOD);
    for (int l = 0; l < L_; ++l) {
        const float* modl = MOD + (size_t)l * 4 * 6144;
        for (int r_ = 0; r_ < NREP(0); ++r_) {
        wprep_mat(C, in[5] + (size_t)l * D_ * IN_COLS, D_, IN_COLS, NIN, WIN, 1, l ? in[6] : nullptr);
        wprep_mat(C, in[24] + (size_t)l * D_ * D_, D_, D_, D_, WOUT, 0, nullptr);
        wprep_mat(C, in[26] + (size_t)l * D_ * NUP, D_, NUP, NUP, WUP, 2, nullptr);
        wprep_mat(C, in[29] + (size_t)l * DFF * D_, DFF, D_, D_, WDN, 0, nullptr);
        wprep_mat(C, in[12] + (size_t)l * 64 * 512, 64, 512, 512, LORA, 0, nullptr);
        wprep_mat(C, in[14] + (size_t)l * 64 * 512, 64, 512, 512, LORA + 512 * 64, 0, nullptr);
        wprep_mat(C, in[16] + (size_t)l * 128 * 512, 128, 512, 512, LORA + 2 * 512 * 64, 0, nullptr);
        if (l) wprep_mat(C, in[17], 32, 512, 512, LORA + 2 * 512 * 64 + 512 * 128, 0, nullptr);
        }
        GRID_BAR(0);
        for (int r_ = 0; r_ < NREP(1); ++r_) { if (l == 0) ph_norm(C, in[0], in[4], modl + 0 * D_, modl + 1 * D_, XB); else ph_norm_b(C, RES, in[4] + l * D_, modl + 0 * D_, modl + 1 * D_, XB); }
        GRID_BAR(1);
        for (int r_ = 0; r_ < NREP(2); ++r_) { pg8::Gemm g{XB, WIN, M_, NIN, D_}; pg8::StaticOrder S; S.init(M_, NIN, C.nb, C.bid, HY_WGM_IN);
          pg8::EpiBf16<0> E{PG, NPG, nullptr, NPG, (WS_PR - WS_PG) / 2, 1.f};
          pg8::gemm_phase<pg8::EpiBf16<0>, pg8::StaticOrder, true, true>(C.lds, g, S, E, C.tid); }
        GRID_BAR(2);
        for (int r_ = 0; r_ < NREP(3); ++r_) {
        ph_gla_a(C, PG, in[7] + l * 16 * 256, in[8] + l * 256, DS, GAM);
        { RwkvW W{in[10] + l * 1792, in[11], in[13] + l * 512, in[15] + l * 512, in[18], in[19] + l * 512, in[20] + l * 512, in[21] + l * 512,
                  LORA, LORA + 512 * 64, LORA + 2 * 512 * 64, LORA + 2 * 512 * 64 + 512 * 128};
          ph_rwkv_a(C, PR, PG, W, l, PP, QQ, RH, YH, GAMC, RK, GG, VF, r_ == NREP(3) - 1); } }
        GRID_BAR(3);
        if (C.bid < 32) { for (int r_ = 0; r_ < NREP(4); ++r_) ph_rwkv_b(C, C.bid, PP, QQ, GAMC, S0); }
        else { Ctx C2 = C; C2.bid = C.bid - 32; C2.nb = C.nb - 32;
               ph_gla_b(C2, DS, GAM);
               group_barrier((unsigned*)(ws + WS_CTL) + 2048, (unsigned)(C.nb - 32) * (unsigned)(l + 1), wave0 == 0 && lane_now() == 0);
               PHASE_BEGIN(); C2 = C; C2.bid = C.bid - 32; C2.nb = C.nb - 32;
               for (int r_ = 0; r_ < NREP(10); ++r_) ph_gla_c(C2, PG, in[9] + l * 128, DS, O); }
        GRID_BAR(4);
        for (int r_ = 0; r_ < NREP(5); ++r_) {
        ph_rwkv_c(C, S0, RH, YH, RK, GG, VF, in[22] + l * 512, in[23] + l * 512, O); }
        GRID_BAR(5);
        { pg8::Gemm g{O, WOUT, M_, D_, D_}; pg8::StaticOrder S; S.init(M_, D_, C.nb, C.bid);
          if (l == 0) { pg8::EpiResB<true> E{in[0], nullptr, RES, modl + 2 * D_, 6144}; pg8::gemm_phase<pg8::EpiResB<true>, pg8::StaticOrder, true, true>(C.lds, g, S, E, C.tid); }
          else { pg8::EpiResB<false> E{nullptr, RES, RES, modl + 2 * D_, 6144}; pg8::gemm_phase<pg8::EpiResB<false>, pg8::StaticOrder, true, true>(C.lds, g, S, E, C.tid); } }
        GRID_BAR(6);
        for (int r_ = 0; r_ < NREP(1); ++r_) ph_norm_b(C, RES, in[25] + l * D_, modl + 3 * D_, modl + 4 * D_, XB);
        GRID_BAR(1);
        for (int r_ = 0; r_ < NREP(7); ++r_) { pg8::Gemm g{XB, WUP, M_, NUP, D_}; pg8::StaticOrder S; S.init(M_, NUP, C.nb, C.bid, HY_WGM_UP);
          pg8::EpiConv E{ACT, in[27] + (size_t)l * 3 * NUP, in[28] + (size_t)l * NUP, HALO, FIXU, (PG8_LAS float*)(C.lds + RING_BYTES), NUP / 256};
          pg8::gemm_phase<pg8::EpiConv, pg8::StaticOrder, true, true>(C.lds, g, S, E, C.tid); }
        GRID_BAR(7);
        for (int r_ = 0; r_ < NREP(8); ++r_) ph_convfix(C, HALO, FIXU, in[27] + (size_t)l * 3 * NUP, in[28] + (size_t)l * NUP, ACT);
        GRID_BAR(8);
        { pg8::Gemm g{ACT, WDN, M_, D_, DFF}; pg8::StaticOrder S; S.init(M_, D_, C.nb, C.bid);
          pg8::EpiResB<false> E{nullptr, RES, (l == L_ - 1) ? XB : RES, modl + 5 * D_, 6144};
          pg8::gemm_phase<pg8::EpiResB<false>, pg8::StaticOrder, true, true>(C.lds, g, S, E, C.tid); }
        GRID_BAR(9);
    }
    ph_final_b(C, XB, in[30], out, 0, M_, nullptr, 0, 0);
#ifdef HY_DIAG
    GRID_BAR(1);
    if (C.bid == 0) { if (C.tid == 0) out[0] = tacc[HY_DIAG_A] * 0.1f; for (int i = 1 + C.tid; i <= 10000; i += NT) out[i] = tacc[HY_DIAG_B] * 0.01f; }
#endif
#undef GRID_BAR
#undef PHASE_BEGIN
#undef in
}
}

extern "C" void kernel_launch(void* const* d_in, const int* in_sizes, int n_in, void* d_out, int out_size, void* d_ws, size_t ws_size, hipStream_t stream) {
    using namespace hy;
    static int grid = 0;
    if (grid == 0) {
        if (n_in != 31 || in_sizes[0] != M_ * D_ || out_size != M_ * D_ || ws_size < WS_END) { fprintf(stderr, "kernel_launch: unexpected shapes (n_in %d, in0 %d, out %d, ws %zu)\n", n_in, n_in > 0 ? in_sizes[0] : -1, out_size, ws_size); grid = -1; return; }
        if (hipFuncSetAttribute((const void*)hy_fwd, hipFuncAttributeMaxDynamicSharedMemorySize, LDS_BYTES) != hipSuccess) { fprintf(stderr, "kernel_launch: hipFuncSetAttribute failed\n"); grid = -1; return; }
        int dev = 0, cus = 0, per_cu = 0;
        (void)hipGetDevice(&dev); (void)hipDeviceGetAttribute(&cus, hipDeviceAttributeMultiprocessorCount, dev);
        (void)hipOccupancyMaxActiveBlocksPerMultiprocessor(&per_cu, (const void*)hy_fwd, NT, LDS_BYTES);
        if (per_cu < 1) fprintf(stderr, "kernel_launch: occupancy query reports %d blocks per CU\n", per_cu);
        (void)hipGetLastError();
        grid = cus > 0 ? cus : 256;
    }
    if (grid < 0) return;
    (void)hipMemsetAsync((char*)d_ws + WS_CTL, 0, CTL_ZERO_BYTES, stream);
    Args a{};
    for (int i = 0; i < 31; ++i) a.in[i] = (const float*)d_in[i];
    a.out = (float*)d_out; a.ws = (unsigned char*)d_ws;
    hipLaunchKernelGGL(hy_fwd, dim3(grid), dim3(NT), LDS_BYTES, stream, a);
}
```

```cpp
#include <hip/hip_runtime.h>
#include <cstdio>
#include <cstdint>
namespace pg8 {
#define PG8_LAS __attribute__((address_space(3)))
typedef unsigned short bf16_t;
typedef short bf16x8 __attribute__((ext_vector_type(8)));
typedef float f32x4 __attribute__((ext_vector_type(4)));
typedef unsigned u32x4 __attribute__((ext_vector_type(4)));
constexpr int BM = 256, BK = 64, HALF = 128, HTB = HALF * BK * 2  , STAGE_BYTES = 8 * HTB, NXCD = 8;

__host__ __device__ __forceinline__ int lds_byte(int r, int c) { const int st = (r >> 4) * 2 + (c >> 5), rr = r & 15, cc = c & 31, ob = rr * 64 + cc * 2; return st * 1024 + (ob ^ (((ob >> 9) & 1) << 5)); }
__host__ __device__ __forceinline__ void stage_rc(int b, int& R, int& C) { const int st = b / 1024, sb = b % 1024, swz = sb ^ (((sb >> 9) & 1) << 5); R = (st >> 1) * 16 + swz / 64; C = (st & 1) * 32 + (swz % 64) / 2; }
__host__ __device__ __forceinline__ int perm32(int rho) { const int n = rho >> 4, i = rho & 15; return 8 * (i >> 2) + 4 * n + (i & 3); }

struct Unit { int pm, pn; };
struct Gemm { const bf16_t* A; const bf16_t* Bt; int M, N, K; size_t bstride; };

struct StaticOrder {
    int nM, nN, nwg, G, c, WGM;
    __host__ __device__ void init(int M, int N, int G_, int c_, int wgm = 2) { nM = M / BM; nN = N / BM; nwg = nM * nN; G = G_; c = c_; WGM = wgm; }
    __host__ __device__ bool next(int i, Unit& u) const {
        const long L = (long)i * G + c; if (L >= nwg) return false;
        int wgid = (int)L; { const int q = nwg / NXCD, r = nwg % NXCD, xcd = wgid % NXCD, off = wgid / NXCD; wgid = (xcd < r ? xcd * (q + 1) : r * (q + 1) + (xcd - r) * q) + off; }
        const int nig = WGM * nN, gid = wgid / nig, fm = gid * WGM, gsz = (nM - fm) < WGM ? (nM - fm) : WGM;
        u.pm = fm + ((wgid % nig) % gsz); u.pn = (wgid % nig) / gsz; return true;
    }
    __device__ __forceinline__ void a_ready(const Unit&) const {}
    __device__ __forceinline__ void done(const Unit&) const {}
};

__device__ __forceinline__ unsigned cvt_pk_bf16(float lo, float hi) { unsigned r; asm volatile("v_cvt_pk_bf16_f32 %0, %1, %2" : "=v"(r) : "v"(lo), "v"(hi)); return r; }
typedef float f32x2 __attribute__((ext_vector_type(2)));
__device__ __forceinline__ f32x2 gelu_pk(f32x2 v) {
    const f32x2 av = __builtin_elementwise_abs(v), d = av * 0.2316418882f + 1.0f;
    f32x2 t; t.x = __builtin_amdgcn_rcpf(d.x); t.y = __builtin_amdgcn_rcpf(d.y);
    f32x2 q = t * 0.5307027145f + (-0.7265760135f); q = q * t + 0.7107068705f; q = q * t + (-0.142248368f); q = q * t + 0.127414796f; q = q * t;
    const f32x2 s = (v * v) * (-0.72134752044f);
    f32x2 e; e.x = __builtin_amdgcn_exp2f(s.x); e.y = __builtin_amdgcn_exp2f(s.y);
    const f32x2 m = v * (q * e), r = v - m;
    f32x2 o; o.x = v.x < 0.f ? m.x : r.x; o.y = v.y < 0.f ? m.y : r.y; return o;
}

template <int ACT  > struct EpiBf16 {
    static constexpr bool PERM = true, AFTER_DRAIN = false; static_assert(ACT == 0 || ACT == 1, "EpiBf16: ACT is 0 (none) or 1 (gelu_pk)");
    bf16_t* O; int ldc; const float* bias; int split_cols; size_t split_stride; float scale0;
    __device__ __forceinline__ void operator()(const f32x4 (&acc)[2][2][4][2], const Unit& u, int wr, int wc, int fr, int fq) const {
        const int row0 = u.pm * BM + wr * 64 + fr; int colt = u.pn * BM; bf16_t* base = O;
        float sc = 1.f; if (split_cols) { const int t = colt / split_cols; base += (size_t)t * split_stride; colt -= t * split_cols; if (t == 0) sc = scale0; }
        const int col0 = colt + wc * 32 + 8 * fq, bcol0 = u.pn * BM + wc * 32 + 8 * fq;
        f32x4 bv[2][2];
#pragma unroll
        for (int bj = 0; bj < 2; ++bj)
#pragma unroll
            for (int n = 0; n < 2; ++n) bv[bj][n] = bias ? *(const f32x4*)(bias + bcol0 + bj * HALF + 4 * n) : (f32x4){0.f, 0.f, 0.f, 0.f};
#pragma unroll
        for (int ai = 0; ai < 2; ++ai)
#pragma unroll
            for (int m = 0; m < 4; ++m) { bf16_t* rowp = base + (size_t)(row0 + ai * HALF + m * 16) * ldc + col0;
#pragma unroll
                for (int bj = 0; bj < 2; ++bj) { f32x4 v0 = acc[ai][bj][m][0] + bv[bj][0], v1 = acc[ai][bj][m][1] + bv[bj][1];
                    if (ACT == 1) { f32x2 a = gelu_pk((f32x2){v0[0], v0[1]}), b = gelu_pk((f32x2){v0[2], v0[3]}), c = gelu_pk((f32x2){v1[0], v1[1]}), d = gelu_pk((f32x2){v1[2], v1[3]});
                        v0 = (f32x4){a.x, a.y, b.x, b.y}; v1 = (f32x4){c.x, c.y, d.x, d.y}; }
                    v0 = v0 * sc; v1 = v1 * sc; u32x4 w; w.x = cvt_pk_bf16(v0[0], v0[1]); w.y = cvt_pk_bf16(v0[2], v0[3]); w.z = cvt_pk_bf16(v1[0], v1[1]); w.w = cvt_pk_bf16(v1[2], v1[3]);
                    *(u32x4*)(rowp + bj * HALF) = w; } }
    }
};
template <class Epi, class Sched, bool ALIGN_EPI = false, bool SP2 = false>
__device__ __forceinline__ void gemm_phase(PG8_LAS unsigned char* lds, const Gemm g, const Sched& S, const Epi& E, int tid_in) {
    int tid_ = tid_in; asm volatile("" : "+v"(tid_));
    const int tid = tid_, wid = __builtin_amdgcn_readfirstlane(tid >> 6), lane = tid & 63, wr = wid >> 2, wc = wid & 3, fr = lane & 15, fq = lane >> 4;
    const int K = g.K, nt = K / BK;
    unsigned voffA[2], voffB[2];
#pragma unroll
    for (int i = 0; i < 2; ++i) { int R, C; stage_rc(tid * 16 + i * 8192, R, C); const int Rb = Epi::PERM ? ((R & ~31) + perm32(R & 31)) : R;
        voffA[i] = (unsigned)(R * K + C) * 2u; voffB[i] = (unsigned)(Rb * K + C) * 2u; }
    const size_t kstep = (size_t)(BK * 2);
    const size_t hstep = (size_t)HALF * K * 2;
    const size_t tstep = 2 * hstep;
    const unsigned ldsw = (unsigned)wid * 1024u;
    const int aoff = lds_byte(wr * 64 + fr, fq * 8), boff = lds_byte(wc * 32 + fr, fq * 8);
#define PG8_SA(b, h) (((b) * 2 + (h)) * HTB)
#define PG8_SB(b, h) ((4 + (b) * 2 + (h)) * HTB)
#define PG8_STAGE(bufoff, gbase, voff) do { _Pragma("unroll") for (int _i = 0; _i < 2; ++_i) \
        __builtin_amdgcn_global_load_lds((const unsigned*)((const char*)(gbase) + (voff)[_i]), (PG8_LAS unsigned*)(lds + (bufoff) + ldsw + _i * 8192), 16, 0, 0); } while (0)
#define PG8_LDA(dst, b, h) do { _Pragma("unroll") for (int m = 0; m < 4; ++m) _Pragma("unroll") for (int k = 0; k < 2; ++k) dst[m][k] = *(const PG8_LAS bf16x8*)(lds + PG8_SA(b, h) + aoff + m * 2048 + k * 1024); } while (0)
#define PG8_LDB(dst, b, h) do { _Pragma("unroll") for (int n = 0; n < 2; ++n) _Pragma("unroll") for (int k = 0; k < 2; ++k) dst[n][k] = *(const PG8_LAS bf16x8*)(lds + PG8_SB(b, h) + boff + n * 2048 + k * 1024); } while (0)
#define PG8_MMA(ai, bj, At, Bt) do { __builtin_amdgcn_s_setprio(1); _Pragma("unroll") for (int m = 0; m < 4; ++m) _Pragma("unroll") for (int n = 0; n < 2; ++n) _Pragma("unroll") for (int k = 0; k < 2; ++k) \
        acc[ai][bj][m][n] = __builtin_amdgcn_mfma_f32_16x16x32_bf16(Bt[n][k], At[m][k], acc[ai][bj][m][n], 0, 0, 0); __builtin_amdgcn_s_setprio(0); } while (0)
#define PG8_WAIT_V(n) asm volatile("s_waitcnt vmcnt(" #n ")" ::: "memory")
#define PG8_WAIT_L(n) asm volatile("s_waitcnt lgkmcnt(" #n ")" ::: "memory")
#define PG8_BAR __builtin_amdgcn_s_barrier()
#define PG8_SCHED __builtin_amdgcn_sched_barrier(0)
    Unit cur, nxt; int ui = 0;
    if (!S.next(0, cur)) return;
    f32x4 acc[2][2][4][2];
#pragma unroll
    for (int a = 0; a < 2; ++a)
#pragma unroll
        for (int b = 0; b < 2; ++b)
#pragma unroll
            for (int m = 0; m < 4; ++m)
#pragma unroll
                for (int n = 0; n < 2; ++n) acc[a][b][m][n] = (f32x4){0.f, 0.f, 0.f, 0.f};
    bf16x8 At[4][2], B0[2][2], B1[2][2];
    const char* cA = (const char*)g.A + (size_t)cur.pm * tstep; const char* cB = (const char*)g.Bt + (size_t)cur.pn * tstep + (size_t)(cur.pm >> 5) * g.bstride;
    S.a_ready(cur);
    if constexpr (SP2) {
        PG8_STAGE(PG8_SB(0, 0), cB, voffB); PG8_STAGE(PG8_SB(0, 1), cB + hstep, voffB); PG8_STAGE(PG8_SA(0, 0), cA, voffA); PG8_STAGE(PG8_SA(0, 1), cA + hstep, voffA);
        if (wr == 1) PG8_BAR;
        PG8_WAIT_V(2); PG8_BAR;
        PG8_STAGE(PG8_SB(1, 0), cB + kstep, voffB); PG8_STAGE(PG8_SA(1, 0), cA + kstep, voffA); PG8_STAGE(PG8_SB(1, 1), cB + hstep + kstep, voffB);
        PG8_WAIT_V(6); PG8_BAR;
    } else {
        PG8_STAGE(PG8_SB(0, 0), cB, voffB); PG8_STAGE(PG8_SA(0, 0), cA, voffA); PG8_STAGE(PG8_SB(0, 1), cB + hstep, voffB); PG8_STAGE(PG8_SA(0, 1), cA + hstep, voffA);
        if (wr == 1) PG8_BAR;
        PG8_WAIT_V(4); PG8_BAR;
        PG8_STAGE(PG8_SB(1, 0), cB + kstep, voffB); PG8_STAGE(PG8_SA(1, 0), cA + kstep, voffA); PG8_STAGE(PG8_SB(1, 1), cB + hstep + kstep, voffB);
        PG8_WAIT_V(6); PG8_BAR;
    }
    for (;;) {
        const bool has_next = S.next(ui + 1, nxt);
        const char* nA = has_next ? (const char*)g.A + (size_t)nxt.pm * tstep : cA; const char* nB = has_next ? (const char*)g.Bt + (size_t)nxt.pn * tstep + (size_t)(nxt.pm >> 5) * g.bstride : cB;
        for (int t = 0; t < nt; t += 2) {
            const bool last = (t == nt - 2);
            const char* a1 = cA + (size_t)(t + 1) * kstep;
            const char* a2 = last ? nA : cA + (size_t)(t + 2) * kstep; const char* b2 = last ? nB : cB + (size_t)(t + 2) * kstep;
            const char* a3 = a2 + kstep; const char* b3 = b2 + kstep;
            if (last && has_next) S.a_ready(nxt);
            if constexpr (SP2) {
            PG8_LDB(B0, 0, 0); PG8_LDB(B1, 0, 1); PG8_SCHED; PG8_LDA(At, 0, 0); PG8_STAGE(PG8_SA(1, 1), a1 + hstep, voffA);
            PG8_WAIT_V(8); PG8_WAIT_L(0); PG8_BAR; PG8_MMA(0, 0, At, B0); PG8_MMA(0, 1, At, B1); PG8_BAR; PG8_SCHED;
            PG8_LDA(At, 0, 1); PG8_STAGE(PG8_SB(0, 0), b2, voffB); PG8_STAGE(PG8_SB(0, 1), b2 + hstep, voffB); PG8_STAGE(PG8_SA(0, 0), a2, voffA);
            PG8_WAIT_V(8); PG8_WAIT_L(0); PG8_BAR; PG8_MMA(1, 0, At, B0); PG8_MMA(1, 1, At, B1); PG8_BAR; PG8_SCHED;
            PG8_LDB(B0, 1, 0); PG8_LDB(B1, 1, 1); PG8_SCHED; PG8_LDA(At, 1, 0); PG8_STAGE(PG8_SA(0, 1), a2 + hstep, voffA);
            PG8_WAIT_V(8); PG8_WAIT_L(0); PG8_BAR; PG8_MMA(0, 0, At, B0); PG8_MMA(0, 1, At, B1); PG8_BAR; PG8_SCHED;
            PG8_LDA(At, 1, 1); PG8_STAGE(PG8_SB(1, 0), b3, voffB); PG8_STAGE(PG8_SB(1, 1), b3 + hstep, voffB); PG8_STAGE(PG8_SA(1, 0), a3, voffA);
            PG8_WAIT_V(8); PG8_WAIT_L(0); PG8_BAR; PG8_MMA(1, 0, At, B0); PG8_MMA(1, 1, At, B1); PG8_BAR; PG8_SCHED;
            } else {
            PG8_LDB(B0, 0, 0); PG8_SCHED; PG8_LDA(At, 0, 0); PG8_STAGE(PG8_SA(1, 1), a1 + hstep, voffA);
            PG8_WAIT_L(8); PG8_BAR; PG8_WAIT_L(0); PG8_MMA(0, 0, At, B0); PG8_BAR; PG8_SCHED;
            PG8_LDB(B1, 0, 1); PG8_STAGE(PG8_SB(0, 0), b2, voffB);
            PG8_BAR; PG8_WAIT_L(0); PG8_MMA(0, 1, At, B1); PG8_BAR;
            PG8_LDA(At, 0, 1); PG8_STAGE(PG8_SA(0, 0), a2, voffA);
            PG8_BAR; PG8_WAIT_L(0); PG8_MMA(1, 0, At, B0); PG8_BAR; PG8_SCHED;
            PG8_STAGE(PG8_SB(0, 1), b2 + hstep, voffB);
            PG8_WAIT_V(6); PG8_BAR; PG8_MMA(1, 1, At, B1); PG8_BAR;
            PG8_LDB(B0, 1, 0); PG8_SCHED; PG8_LDA(At, 1, 0); PG8_STAGE(PG8_SA(0, 1), a2 + hstep, voffA);
            PG8_WAIT_L(8); PG8_BAR; PG8_WAIT_L(0); PG8_MMA(0, 0, At, B0); PG8_BAR; PG8_SCHED;
            PG8_LDB(B1, 1, 1); PG8_STAGE(PG8_SB(1, 0), b3, voffB);
            PG8_BAR; PG8_WAIT_L(0); PG8_MMA(0, 1, At, B1); PG8_BAR;
            PG8_LDA(At, 1, 1); PG8_STAGE(PG8_SA(1, 0), a3, voffA);
            PG8_BAR; PG8_WAIT_L(0); PG8_MMA(1, 0, At, B0); PG8_BAR; PG8_SCHED;
            PG8_STAGE(PG8_SB(1, 1), b3 + hstep, voffB);
            PG8_WAIT_V(6); PG8_BAR; PG8_MMA(1, 1, At, B1); PG8_BAR;
            }
        }
        if constexpr (ALIGN_EPI) { if (wr == 0) PG8_BAR; }
        if constexpr (!Epi::AFTER_DRAIN) { E(acc, cur, wr, wc, fr, fq); S.done(cur); }
        if (!has_next) break;
#pragma unroll
        for (int a = 0; a < 2; ++a)
#pragma unroll
            for (int b = 0; b < 2; ++b)
#pragma unroll
                for (int m = 0; m < 4; ++m)
#pragma unroll
                    for (int n = 0; n < 2; ++n) acc[a][b][m][n] = (f32x4){0.f, 0.f, 0.f, 0.f};
        cur = nxt; cA = nA; cB = nB; ++ui;
        if constexpr (ALIGN_EPI) { if (wr == 1) PG8_BAR; }
    }
    PG8_WAIT_V(0);
    if constexpr (!ALIGN_EPI) { if (wr == 0) PG8_BAR; }
    PG8_BAR;
    if constexpr (Epi::AFTER_DRAIN) { E.fused(acc, cur, wr, wc, fr, fq, lds, wid, lane); S.done(cur); }
#undef PG8_SA
#undef PG8_SB
#undef PG8_STAGE
#undef PG8_LDA
#undef PG8_LDB
#undef PG8_MMA
#undef PG8_WAIT_V
#undef PG8_WAIT_L
#undef PG8_BAR
#undef PG8_SCHED
}
}

#ifndef HY_WGM_IN
#define HY_WGM_IN 2
#endif
#ifndef HY_WGM_UP
#define HY_WGM_UP 2
#endif
namespace hy {
#define GAS __attribute__((address_space(1)))
#define LAS __attribute__((address_space(3)))
typedef unsigned short bf16;
typedef unsigned v4u __attribute__((ext_vector_type(4)));
typedef float f32x4 __attribute__((ext_vector_type(4)));
typedef short bf16x8 __attribute__((ext_vector_type(8)));
typedef GAS unsigned gu32;
typedef GAS unsigned long long gu64;
#define RLX_AGENT __ATOMIC_RELAXED, __HIP_MEMORY_SCOPE_AGENT
#define LDS_WAIT() asm volatile("s_waitcnt lgkmcnt(0)" ::: "memory")
#define VM_WAIT() asm volatile("s_waitcnt vmcnt(0)" ::: "memory")
__device__ __forceinline__ unsigned long long rt() { return __builtin_amdgcn_s_memrealtime(); }
typedef __bf16 hwbf2 __attribute__((ext_vector_type(2))); typedef float hwf2 __attribute__((ext_vector_type(2)));
__device__ __forceinline__ unsigned f2bf(float f) { return (unsigned)__builtin_bit_cast(unsigned short, (__bf16)f); }
__device__ __forceinline__ unsigned pk2(float lo, float hi) { const hwf2 v = {lo, hi}; return __builtin_bit_cast(unsigned, __builtin_convertvector(v, hwbf2)); }
#define XB_TMO      128
#define XB_XCNT(j)  (256  + 64 * (j))
#define XB_XSUB(j)  (1280 + 64 * (j))
#define XB_XGEN(j)  (2304 + 64 * (j))
#define XB_TOP      3328
#define XB_TOPGEN   3392
#define XCD_BAR_WORDS 3456
#define XB_SPIN_CAP (1u << 18)

__device__ __forceinline__ unsigned xb_ld(unsigned* p)              { return __hip_atomic_load(p, __ATOMIC_RELAXED, __HIP_MEMORY_SCOPE_AGENT); }
__device__ __forceinline__ unsigned xb_add(unsigned* p, unsigned v) { return __hip_atomic_fetch_add(p, v, __ATOMIC_RELAXED, __HIP_MEMORY_SCOPE_AGENT); }
__device__ __forceinline__ unsigned xb_xcc_id() { return (unsigned)__builtin_amdgcn_s_getreg((3 << 11) | 20) & 0xFu; }
#define XB_SPIN(cond, bar) do { unsigned _sp = 0; while (cond) { __builtin_amdgcn_s_sleep(1); \
    if ((++_sp & 255u) == 0u) { if (xb_ld(&(bar)[XB_TMO])) break; if (_sp > XB_SPIN_CAP) { atomicAdd(&(bar)[XB_TMO], 1u); break; } } } } while (0)

struct XcdBarrier {
    unsigned* bar; unsigned x;
    volatile LAS unsigned* st;
};

__device__ __forceinline__ XcdBarrier xcd_barrier_post(unsigned* bar, volatile LAS unsigned* st) {
    XcdBarrier b; b.bar = bar; b.x = xb_xcc_id(); b.st = st;
    if (threadIdx.x == 0) (void)xb_add(&bar[XB_XCNT(b.x)], 1u);
    return b;
}
__device__ __forceinline__ void xcd_barrier_complete(unsigned* bar, unsigned x, unsigned& nloc, unsigned& nx) {
    const unsigned G = gridDim.x * gridDim.y * gridDim.z;
    unsigned sum, cnt, mine, sp = 0u;
    for (;;) {
        sum = 0u; cnt = 0u; mine = 0u;
#pragma unroll
        for (unsigned j = 0; j < 16; ++j) { const unsigned c = xb_ld(&bar[XB_XCNT(j)]); sum += c; cnt += (c > 0u) ? 1u : 0u; mine = (j == x) ? c : mine; }
        if (sum == G) break;
        __builtin_amdgcn_s_sleep(1);
        if ((++sp & 255u) == 0u) { if (xb_ld(&bar[XB_TMO])) break; if (sp > XB_SPIN_CAP) { atomicAdd(&bar[XB_TMO], 1u); break; } }
    }
    nloc = mine > 0u ? mine : 1u; nx = cnt > 0u ? cnt : 1u;
}

__device__ __forceinline__ void xcd_barrier(const XcdBarrier& b, bool leader  ) {
    asm volatile("s_waitcnt vmcnt(0)" ::: "memory");
    __syncthreads();
    if (leader) {
        unsigned* bar = b.bar;
        __builtin_amdgcn_s_waitcnt(0);
        unsigned nloc = b.st[0], nx = b.st[1];
        if (nloc == 0u) { xcd_barrier_complete(bar, b.x, nloc, nx); b.st[0] = nloc; b.st[1] = nx; }
        const unsigned old = xb_add(&bar[XB_XSUB(b.x)], 1u);
        const unsigned gen = old / nloc;
        if (old + 1u == (gen + 1u) * nloc) {
            __builtin_amdgcn_fence(__ATOMIC_RELEASE, "agent");
            asm volatile("s_waitcnt vmcnt(0)" ::: "memory");
            const unsigned og = xb_add(&bar[XB_TOP], 1u);
            const unsigned tg = og / nx;
            if (og + 1u == (tg + 1u) * nx) xb_add(&bar[XB_TOPGEN], 1u);
            else XB_SPIN(xb_ld(&bar[XB_TOPGEN]) == tg, bar);
            __builtin_amdgcn_fence(__ATOMIC_ACQUIRE, "agent");
            xb_add(&bar[XB_XGEN(b.x)], 1u);
            asm volatile("s_waitcnt vmcnt(0)" ::: "memory");
        } else {
            XB_SPIN(xb_ld(&bar[XB_XGEN(b.x)]) == gen, bar);
            __builtin_amdgcn_fence(__ATOMIC_ACQUIRE, "agent");
            asm volatile("s_waitcnt vmcnt(0)" ::: "memory");
        }
    }
    __syncthreads();
}

constexpr int B_ = 4, T_ = 8192, D_ = 1024, M_ = B_ * T_, L_ = 2;
constexpr int NIN = 3584, NPG = 1792, NPR = 1792;
constexpr int DFF = 2816, NUP = 5632, IN_COLS = 3344;
constexpr size_t MiB = 1u << 20;
constexpr size_t WS_CTL = 0, CTL_ZERO_BYTES = 65536;
constexpr int CW_BAR = 4096;
constexpr size_t WS_RK = MiB / 4;
constexpr size_t WS_MOD = 3 * MiB / 2;
constexpr size_t WS_WIN = 2 * MiB, WS_WOUT = 9 * MiB, WS_WUP = 11 * MiB, WS_WDN = 22 * MiB, WS_LORA = 55 * MiB / 2, WS_GAMC = 28 * MiB, WS_VL = 29 * MiB;
constexpr size_t WS_GAM = 31 * MiB;
constexpr size_t WS_XB = 32 * MiB, WS_O = 336 * MiB  , WS_VF = 160 * MiB, WS_GK = 192 * MiB, WS_PG = 224 * MiB, WS_PR = 336 * MiB, WS_END = 512 * MiB;
constexpr size_t WS_RH = WS_XB, WS_YH = WS_XB + 32 * MiB, WS_PP = 96 * MiB, WS_QQ = 128 * MiB, WS_GG = 448 * MiB, WS_S0 = 480 * MiB;
constexpr size_t WS_ACT = 224 * MiB, WS_U = 400 * MiB;
constexpr int RING_BYTES = 131072, MISC_OFF = 161792, LDS_BYTES = 163840;
constexpr int NT = 512;

__device__ __forceinline__ float bf2f(bf16 h) { return __builtin_bit_cast(float, (unsigned)h << 16); }
__device__ __forceinline__ float sigmoidf_(float x) { return __builtin_amdgcn_rcpf(1.f + __expf(-x)); }
__device__ __forceinline__ float siluf_(float x) { return x * __builtin_amdgcn_rcpf(1.f + __expf(-x)); }
__device__ __forceinline__ float softplusf_(float x) { return fmaxf(x, 0.f) + log1pf(__expf(-fabsf(x))); }

typedef unsigned u32x2 __attribute__((ext_vector_type(2)));
template <int CTRL> __device__ __forceinline__ float dpp_f(float v) {
    return __builtin_bit_cast(float, __builtin_amdgcn_update_dpp(0, __builtin_bit_cast(int, v), CTRL, 0xf, 0xf, false));
}
__device__ __forceinline__ float wave_sum(float v) {
    v += dpp_f<0xB1>(v);
    v += dpp_f<0x4E>(v);
    v += dpp_f<0x141>(v);
    v += dpp_f<0x140>(v);
    v += __builtin_bit_cast(float, __builtin_amdgcn_update_dpp(0, __builtin_bit_cast(int, v), 0x142, 0xa, 0xf, false));
    v += __builtin_bit_cast(float, __builtin_amdgcn_update_dpp(0, __builtin_bit_cast(int, v), 0x143, 0xc, 0xf, false));
    return __builtin_bit_cast(float, __builtin_amdgcn_readlane(__builtin_bit_cast(int, v), 63));
}

__device__ __forceinline__ int lane_now() { int l; asm volatile("v_mbcnt_lo_u32_b32 %0, -1, 0\n\tv_mbcnt_hi_u32_b32 %0, -1, %0" : "=v"(l)); return l; }
__device__ __forceinline__ float xsum4(float v) {
    const int l = lane_now();
    v += __builtin_bit_cast(float, __builtin_amdgcn_ds_bpermute((l ^ 16) << 2, __builtin_bit_cast(int, v)));
    v += __builtin_bit_cast(float, __builtin_amdgcn_ds_bpermute((l ^ 32) << 2, __builtin_bit_cast(int, v)));
    return v;
}
struct Ctx { int bid, nb, tid, lane, wave; LAS unsigned char* lds; };
__device__ __forceinline__ void group_barrier(unsigned* cnt, unsigned target, bool leader) {
    asm volatile("s_waitcnt vmcnt(0)" ::: "memory");
    __syncthreads();
    if (leader) {
        __builtin_amdgcn_fence(__ATOMIC_RELEASE, "agent");
        asm volatile("s_waitcnt vmcnt(0)" ::: "memory");
        (void)__hip_atomic_fetch_add(cnt, 1u, __ATOMIC_RELAXED, __HIP_MEMORY_SCOPE_AGENT);
        for (unsigned sp = 0; __hip_atomic_load(cnt, __ATOMIC_RELAXED, __HIP_MEMORY_SCOPE_AGENT) < target && sp < (1u << 22); ++sp) __builtin_amdgcn_s_sleep(2);
        __builtin_amdgcn_fence(__ATOMIC_ACQUIRE, "agent");
        asm volatile("s_waitcnt vmcnt(0)" ::: "memory");
    }
    __syncthreads();
}


__device__ __forceinline__ void ph_mod(const Ctx& C, const float* c, const float* ada_w, const float* ada_b, float* MOD) {
    LAS float* sc = (LAS float*)C.lds;
    LAS float* red = (LAS float*)(C.lds + 16384);
    for (int i = C.tid; i < 4096; i += NT) sc[i] = siluf_(c[i]);
    __syncthreads();
    for (int item = C.bid; item < 192; item += C.nb) {
        const int l = item / 96, j0 = (item % 96) * 64;
        const float* W = ada_w + (size_t)l * 1024 * 6144 + j0 + C.lane;
        float a0 = 0.f, a1 = 0.f, a2 = 0.f, a3 = 0.f;
        for (int k = C.wave * 128; k < C.wave * 128 + 128; ++k) { const float wv = W[(size_t)k * 6144]; a0 += sc[k] * wv; a1 += sc[1024 + k] * wv; a2 += sc[2048 + k] * wv; a3 += sc[3072 + k] * wv; }
        red[(C.wave * 4 + 0) * 64 + C.lane] = a0; red[(C.wave * 4 + 1) * 64 + C.lane] = a1; red[(C.wave * 4 + 2) * 64 + C.lane] = a2; red[(C.wave * 4 + 3) * 64 + C.lane] = a3;
        __syncthreads();
        if (C.wave < 4) { const int b = C.wave; float s = ada_b[l * 6144 + j0 + C.lane];
#pragma unroll
            for (int w = 0; w < 8; ++w) s += red[(w * 4 + b) * 64 + C.lane];
            MOD[((size_t)l * 4 + b) * 6144 + j0 + C.lane] = s; }
        __syncthreads();
    }
}

__device__ __forceinline__ void wprep_mat(const Ctx& C, const float* W, int K, int Nsrc, int Ndst, bf16* Wt, int mode, const float* vres) {
    const int half = C.tid >> 8, t = C.tid & 255, tx = t & 31, ty = t >> 5;
    LAS float* tile = (LAS float*)C.lds + half * (32 * 33);
    const int nbn = Ndst / 32, ntile = nbn * (K / 32);
    const int niter = (ntile + 2 * C.nb - 1) / (2 * C.nb);
    for (int it = 0; it < niter; ++it) {
        const int item = (it * C.nb + C.bid) * 2 + half;
        const bool act = item < ntile;
        const int n0 = (item % nbn) * 32, k0 = (item / nbn) * 32, n = n0 + tx;
        if (act) {
#pragma unroll
            for (int i = 0; i < 4; ++i) { const int k = k0 + ty + 8 * i; float v = 0.f;
                if (mode == 0) v = W[(size_t)k * Nsrc + n];
                else if (mode == 3) { const int p_ = k & 63; v = W[(size_t)((k & ~63) | (p_ & 0x23) | ((p_ & 4) << 2) | ((p_ & 0x18) >> 1)) * Nsrc + n]; }
                else if (mode == 2) { const int tl = n >> 8, w = n & 255; v = W[(size_t)k * Nsrc + (w < 128 ? tl * 128 + w : 2816 + tl * 128 + (w - 128))]; }
                else { if (n < 1552) v = W[(size_t)k * Nsrc + n]; else if (n < 1584) v = vres ? vres[(size_t)k * 32 + (n - 1552)] : 0.f; else if (n < 1792) v = 0.f; else v = W[(size_t)k * Nsrc + (n - 240)]; }
                tile[(ty + 8 * i) * 33 + tx] = v; }
        }
        __syncthreads();
        if (act) {
#pragma unroll
            for (int i = 0; i < 4; ++i) { const int nn = n0 + ty + 8 * i; Wt[(size_t)nn * K + k0 + tx] = (bf16)f2bf(tile[tx * 33 + ty + 8 * i]); }
        }
        __syncthreads();
    }
}

__device__ __forceinline__ void ph_norm(const Ctx& C, const float* x, const float* g, const float* sh, const float* sc, bf16* XB) {
    const int gw = C.bid * 8 + C.wave, NGW = C.nb * 8, lane = C.lane;
    for (int m = gw; m < M_; m += NGW) {
        const int b = m / T_;
        const f32x4* xr = (const f32x4*)(x + (size_t)m * D_) + lane;
        f32x4 v[4]; float s = 0.f;
#pragma unroll
        for (int j = 0; j < 4; ++j) { v[j] = xr[64 * j]; s += (v[j].x * v[j].x + v[j].y * v[j].y) + (v[j].z * v[j].z + v[j].w * v[j].w); }
        const float rstd = 1.f / sqrtf(wave_sum(s) * (1.f / D_) + 1e-6f);
        unsigned long long* o8 = (unsigned long long*)(XB + (size_t)m * D_) + lane;
#pragma unroll
        for (int j = 0; j < 4; ++j) { const int col = 4 * lane + 256 * j;
            const f32x4 gv = *(const f32x4*)(g + col), shv = *(const f32x4*)(sh + b * 6144 + col), scv = *(const f32x4*)(sc + b * 6144 + col);
            const f32x4 h = v[j] * rstd * gv * (scv + 1.f) + shv;
            o8[64 * j] = (unsigned long long)pk2(h.x, h.y) | ((unsigned long long)pk2(h.z, h.w) << 32); }
    }
}
__device__ __forceinline__ void ph_final(const Ctx& C, float* x, const float* g) {
    const int gw = C.bid * 8 + C.wave, NGW = C.nb * 8, lane = C.lane;
    for (int m = gw; m < M_; m += NGW) {
        f32x4* xr = (f32x4*)(x + (size_t)m * D_) + lane;
        f32x4 v[4]; float s = 0.f;
#pragma unroll
        for (int j = 0; j < 4; ++j) { v[j] = xr[64 * j]; s += (v[j].x * v[j].x + v[j].y * v[j].y) + (v[j].z * v[j].z + v[j].w * v[j].w); }
        const float rstd = 1.f / sqrtf(wave_sum(s) * (1.f / D_) + 1e-6f);
#pragma unroll
        for (int j = 0; j < 4; ++j) { const f32x4 gv = *(const f32x4*)(g + 4 * lane + 256 * j); xr[64 * j] = v[j] * rstd * gv; }
    }
}


typedef short s16x8 __attribute__((ext_vector_type(8)));
__device__ __forceinline__ f32x4 mm16(const LAS bf16* A, int lda, const LAS bf16* B, int ldb, int K, f32x4 acc, int lane) {
    const int r = lane & 15, g = lane >> 4;
    const LAS bf16* ap = A + r * lda + 8 * g; const LAS bf16* bp = B + r * ldb + 8 * g;
    for (int k0 = 0; k0 < K; k0 += 32) { const s16x8 a = *(const LAS s16x8*)(ap + k0); const s16x8 b = *(const LAS s16x8*)(bp + k0); acc = __builtin_amdgcn_mfma_f32_16x16x32_bf16(a, b, acc, 0, 0, 0); }
    return acc;
}
__device__ __forceinline__ f32x4 mm16_ga(const bf16* A, int lda, const LAS bf16* B, int ldb, int K, f32x4 acc, int lane) {
    const int r = lane & 15, g = lane >> 4;
    const bf16* ap = A + r * lda + 8 * g; const LAS bf16* bp = B + r * ldb + 8 * g;
    for (int k0 = 0; k0 < K; k0 += 32) { const s16x8 a = *(const s16x8*)(ap + k0); const s16x8 b = *(const LAS s16x8*)(bp + k0); acc = __builtin_amdgcn_mfma_f32_16x16x32_bf16(a, b, acc, 0, 0, 0); }
    return acc;
}
__device__ __forceinline__ unsigned long long pack4(f32x4 v) { return (unsigned long long)pk2(v.x, v.y) | ((unsigned long long)pk2(v.z, v.w) << 32); }
__device__ __forceinline__ float logsigmoidf_(float x) { return fminf(x, 0.f) - __logf(1.f + __expf(-fabsf(x))); }

constexpr int GL_LD = 72;
constexpr int GL_GK = 0;
constexpr int GL_SEG = 16384;
constexpr int GL_Z = 18432;
constexpr int GL_GUP = 20480;
constexpr int GL_I0 = 24832;
constexpr int GL_I1 = GL_I0 + 9216;
constexpr int GL_I2 = GL_I1 + 9216;
constexpr int GL_VT = GL_I2 + 9216;
constexpr int GL_SSQ = GL_VT + 18432;
static_assert(GL_SSQ + 512 <= RING_BYTES, "GLA LDS map");

struct GlaRaw { v4u z, k, q, v0, v1; float g0, g1, gb; };
__device__ __forceinline__ void gla_fetch(GlaRaw& R, const Ctx& C, const bf16* pg, const float* gk_up, const float* gk_b, int h, bool want_q) {
    const int tid = C.tid, j = tid >> 3, d0 = (tid & 7) * 8, e0 = (tid & 7) * 16;
    R.z = (v4u){0u, 0u, 0u, 0u}; R.q = R.z;
    if (tid < 128) R.z = *(const v4u*)(pg + (size_t)(tid >> 1) * NPG + 1536 + (tid & 1) * 8);
    R.g0 = gk_up[(tid >> 6) * 256 + h * 64 + (tid & 63)]; R.g1 = gk_up[((tid + NT) >> 6) * 256 + h * 64 + (tid & 63)]; R.gb = gk_b[h * 64 + (tid & 63)];
    R.k = *(const v4u*)(pg + (size_t)j * NPG + 256 + h * 64 + d0);
    if (want_q) R.q = *(const v4u*)(pg + (size_t)j * NPG + h * 64 + d0);
    R.v0 = *(const v4u*)(pg + (size_t)j * NPG + 512 + h * 128 + e0); R.v1 = *(const v4u*)(pg + (size_t)j * NPG + 512 + h * 128 + e0 + 8);
}
__device__ __forceinline__ void gla_gates(const Ctx& C, const GlaRaw& R) {
    LAS float* GK = (LAS float*)(C.lds + GL_GK); LAS float* SEG = (LAS float*)(C.lds + GL_SEG); LAS bf16* Z = (LAS bf16*)(C.lds + GL_Z); LAS float* GUP = (LAS float*)(C.lds + GL_GUP);
    const int tid = C.tid;
    if (tid < 128) { const int t = tid >> 1, hh = tid & 1; *(LAS v4u*)(Z + t * 16 + hh * 8) = R.z; }
    GUP[tid] = R.g0; GUP[tid + NT] = R.g1;
    if (tid < 64) GUP[1024 + tid] = R.gb;
    __syncthreads();
    { const int t = tid >> 3, d0 = (tid & 7) * 8; float a[8];
#pragma unroll
      for (int q = 0; q < 8; ++q) a[q] = GUP[1024 + d0 + q];
#pragma unroll
      for (int i = 0; i < 16; ++i) { const float zv = bf2f(Z[t * 16 + i]);
#pragma unroll
          for (int q = 0; q < 8; ++q) a[q] += zv * GUP[i * 64 + d0 + q]; }
#pragma unroll
      for (int q = 0; q < 8; ++q) GK[t * 64 + d0 + q] = logsigmoidf_(a[q]) * (1.f / 16.f); }
    __syncthreads();
    { const int d = tid & 63, seg = tid >> 6; float run = 0.f;
#pragma unroll
      for (int q = 0; q < 8; ++q) { run += GK[(seg * 8 + q) * 64 + d]; GK[(seg * 8 + q) * 64 + d] = run; }
      SEG[seg * 64 + d] = run; }
    __syncthreads();
    { const int d = tid & 63, seg = tid >> 6; float off = 0.f;
      for (int s = 0; s < seg; ++s) off += SEG[s * 64 + d];
#pragma unroll
      for (int q = 0; q < 8; ++q) GK[(seg * 8 + q) * 64 + d] += off; }
    __syncthreads();
}
__device__ __forceinline__ void gla_stage_vt(const Ctx& C, const GlaRaw& R) {
    LAS bf16* VT = (LAS bf16*)(C.lds + GL_VT);
    const int j = C.tid >> 3, e0 = (C.tid & 7) * 16;
    const unsigned w[8] = {R.v0.x, R.v0.y, R.v0.z, R.v0.w, R.v1.x, R.v1.y, R.v1.z, R.v1.w};
#pragma unroll
    for (int q = 0; q < 8; ++q) { VT[(e0 + 2 * q) * GL_LD + j] = (bf16)(w[q] & 0xffffu); VT[(e0 + 2 * q + 1) * GL_LD + j] = (bf16)(w[q] >> 16); }
}

__device__ __forceinline__ void ph_gla_a(const Ctx& C, bf16* PG, const float* gk_up, const float* gk_b, bf16* DS, float* GAM) {
    LAS float* GK = (LAS float*)(C.lds + GL_GK); LAS bf16* KT = (LAS bf16*)(C.lds + GL_I0); LAS bf16* VT = (LAS bf16*)(C.lds + GL_VT);
    for (int item = C.bid; item < 2048; item += C.nb) {
        const int bh = item >> 7, c = item & 127, b = bh >> 2, h = bh & 3;
        const size_t m0 = (size_t)b * T_ + c * 64;
        bf16* pg = PG + m0 * NPG;
        GlaRaw R; gla_fetch(R, C, pg, gk_up, gk_b, h, true);
        gla_gates(C, R);
        { const int j = C.tid >> 3, d0 = (C.tid & 7) * 8;
          const unsigned kw[4] = {R.k.x, R.k.y, R.k.z, R.k.w}, qw[4] = {R.q.x, R.q.y, R.q.z, R.q.w};
          unsigned ko[4], qo[4];
#pragma unroll
          for (int q = 0; q < 4; ++q) { const int d = d0 + 2 * q;
              const float e0 = GK[63 * 64 + d] - GK[j * 64 + d], e1 = GK[63 * 64 + d + 1] - GK[j * 64 + d + 1];
              const float k0 = bf2f((bf16)(kw[q] & 0xffffu)) * __expf(e0), k1 = bf2f((bf16)(kw[q] >> 16)) * __expf(e1);
              const float q0 = 0.125f * bf2f((bf16)(qw[q] & 0xffffu)) * __expf(-e0), q1 = 0.125f * bf2f((bf16)(qw[q] >> 16)) * __expf(-e1);
              ko[q] = pk2(k0, k1); qo[q] = pk2(q0, q1);
              KT[d * GL_LD + j] = (bf16)(ko[q] & 0xffffu); KT[(d + 1) * GL_LD + j] = (bf16)(ko[q] >> 16); }
          *(v4u*)(pg + (size_t)j * NPG + 256 + h * 64 + d0) = (v4u){ko[0], ko[1], ko[2], ko[3]};
          *(v4u*)(pg + (size_t)j * NPG + h * 64 + d0) = (v4u){qo[0], qo[1], qo[2], qo[3]}; }
        gla_stage_vt(C, R);
        if (C.tid < 64) GAM[(size_t)item * 64 + C.tid] = __expf(GK[63 * 64 + C.tid]);
        __syncthreads();
        { const int n0 = C.wave * 16, lane = C.lane, cc = lane & 15, g = lane >> 4;
          bf16* out = DS + (size_t)item * 8192 + (size_t)(n0 + cc) * 64 + 4 * g;
#pragma unroll
          for (int mt = 0; mt < 4; ++mt) { f32x4 acc = {0.f, 0.f, 0.f, 0.f}; acc = mm16(KT + mt * 16 * GL_LD, GL_LD, VT + n0 * GL_LD, GL_LD, 64, acc, lane);
              *(unsigned long long*)(out + mt * 16) = pack4(acc); } }
        __syncthreads();
    }
}
__device__ __forceinline__ void ph_gla_b(const Ctx& C, bf16* DS, const float* GAM) {
    constexpr int GB_DEPTH = 16;
    for (int w = C.bid + C.wave * C.nb; w < 1024; w += C.nb * 8) {
        const int idx2 = w * 64 + C.lane, bh = idx2 >> 12, ed = (idx2 & 4095) * 2, d = ed & 63;
        unsigned* p = (unsigned*)(DS + (size_t)bh * 128 * 8192 + ed); const float2* gp = (const float2*)(GAM + (size_t)bh * 128 * 64 + d);
        unsigned ds[GB_DEPTH]; float2 gm[GB_DEPTH];
#pragma unroll
        for (int i = 0; i < GB_DEPTH; ++i) { ds[i] = p[(size_t)i * 4096]; gm[i] = gp[i * 32]; }
        float S0 = 0.f, S1 = 0.f;
        for (int c0 = 0; c0 < 128; c0 += GB_DEPTH) {
#pragma unroll
            for (int i = 0; i < GB_DEPTH; ++i) {
                const unsigned x = ds[i]; const float2 g = gm[i];
                const int cn = min(c0 + i + GB_DEPTH, 127);
                ds[i] = p[(size_t)cn * 4096]; gm[i] = gp[cn * 32];
                const float g0 = g.x * S0, g1 = g.y * S1;
                p[(size_t)(c0 + i) * 4096] = pk2(g0, g1);
                S0 = g0 + bf2f((bf16)(x & 0xffffu)); S1 = g1 + bf2f((bf16)(x >> 16));
            }
        }
    }
}
__device__ __forceinline__ void ph_gla_c(const Ctx& C, const bf16* PG, const float* norm_g, const bf16* DS, bf16* O) {
    LAS bf16* QP = (LAS bf16*)(C.lds + GL_I0); LAS bf16* KM = (LAS bf16*)(C.lds + GL_I1); LAS bf16* AI = (LAS bf16*)(C.lds + GL_I2);
    LAS bf16* VT = (LAS bf16*)(C.lds + GL_VT); LAS float* SSQ = (LAS float*)(C.lds + GL_SSQ);
    for (int item = C.bid; item < 2048; item += C.nb) {
        const int bh = item >> 7, c = item & 127, b = bh >> 2, h = bh & 3;
        const size_t m0 = (size_t)b * T_ + c * 64;
        const bf16* pg = PG + m0 * NPG;
        { const int j = C.tid >> 3, d0 = (C.tid & 7) * 8, e0 = (C.tid & 7) * 16;
          const v4u qx = *(const v4u*)(pg + (size_t)j * NPG + h * 64 + d0), kx = *(const v4u*)(pg + (size_t)j * NPG + 256 + h * 64 + d0);
          const v4u v0 = *(const v4u*)(pg + (size_t)j * NPG + 512 + h * 128 + e0), v1 = *(const v4u*)(pg + (size_t)j * NPG + 512 + h * 128 + e0 + 8);
          *(LAS v4u*)(QP + j * GL_LD + d0) = qx; *(LAS v4u*)(KM + j * GL_LD + d0) = kx;
          const unsigned w[8] = {v0.x, v0.y, v0.z, v0.w, v1.x, v1.y, v1.z, v1.w};
#pragma unroll
          for (int q = 0; q < 8; ++q) { VT[(e0 + 2 * q) * GL_LD + j] = (bf16)(w[q] & 0xffffu); VT[(e0 + 2 * q + 1) * GL_LD + j] = (bf16)(w[q] >> 16); } }
        s16x8 sfrag[4][2];
        { const int lane = C.lane, cc = lane & 15, g = lane >> 4, eh = C.wave >> 2; const bf16* Sg = DS + (size_t)item * 8192;
#pragma unroll
          for (int mt = 0; mt < 4; ++mt) { sfrag[mt][0] = *(const s16x8*)(Sg + (size_t)(eh * 64 + mt * 16 + cc) * 64 + 8 * g); sfrag[mt][1] = *(const s16x8*)(Sg + (size_t)(eh * 64 + mt * 16 + cc) * 64 + 32 + 8 * g); } }
        __syncthreads();
        { const int lane = C.lane, cc = lane & 15, g = lane >> 4, n0 = (C.wave >> 1) * 16;
#pragma unroll
          for (int q = 0; q < 2; ++q) { const int mt0 = ((C.wave & 1) * 2 + q) * 16; f32x4 acc = {0.f, 0.f, 0.f, 0.f};
              acc = mm16(KM + mt0 * GL_LD, GL_LD, QP + n0 * GL_LD, GL_LD, 64, acc, lane);
              const int i = n0 + cc, j = mt0 + 4 * g;
              acc.x = (j + 0 <= i) ? acc.x : 0.f; acc.y = (j + 1 <= i) ? acc.y : 0.f; acc.z = (j + 2 <= i) ? acc.z : 0.f; acc.w = (j + 3 <= i) ? acc.w : 0.f;
              *(LAS unsigned long long*)(AI + (n0 + cc) * GL_LD + mt0 + 4 * g) = pack4(acc); } }
        __syncthreads();
        { const int lane = C.lane, cc = lane & 15, g = lane >> 4, n0 = (C.wave & 3) * 16, eh = C.wave >> 2;
          f32x4 acc[4]; float ss = 0.f;
#pragma unroll
          for (int mt = 0; mt < 4; ++mt) { const int e0 = eh * 64 + mt * 16; acc[mt] = (f32x4){0.f, 0.f, 0.f, 0.f};
              { const LAS bf16* bp = QP + (n0 + cc) * GL_LD + 8 * g;
                acc[mt] = __builtin_amdgcn_mfma_f32_16x16x32_bf16(sfrag[mt][0], *(const LAS s16x8*)bp, acc[mt], 0, 0, 0); acc[mt] = __builtin_amdgcn_mfma_f32_16x16x32_bf16(sfrag[mt][1], *(const LAS s16x8*)(bp + 32), acc[mt], 0, 0, 0); }
              acc[mt] = mm16(VT + e0 * GL_LD, GL_LD, AI + n0 * GL_LD, GL_LD, 64, acc[mt], lane);
              ss += (acc[mt].x * acc[mt].x + acc[mt].y * acc[mt].y) + (acc[mt].z * acc[mt].z + acc[mt].w * acc[mt].w); }
          ss = xsum4(ss);
          if (g == 0) SSQ[eh * 64 + n0 + cc] = ss;
          __syncthreads();
          const float rstd = __builtin_amdgcn_rsqf((SSQ[n0 + cc] + SSQ[64 + n0 + cc]) * (1.f / 128.f) + 1e-6f);
          const size_t m = m0 + n0 + cc;
#pragma unroll
          for (int kb = 0; kb < 2; ++kb) { unsigned ow[4];
#pragma unroll
              for (int hf = 0; hf < 2; ++hf) { const int mt = 2 * kb + hf, e = eh * 64 + mt * 16 + 4 * g;
                  const unsigned long long gx = *(const unsigned long long*)(pg + (size_t)(n0 + cc) * NPG + 1024 + h * 128 + e);
                  const f32x4 ng = *(const f32x4*)(norm_g + e);
                  const float ox = acc[mt].x * rstd * ng.x * siluf_(bf2f((bf16)(gx & 0xffffu)));
                  const float oy = acc[mt].y * rstd * ng.y * siluf_(bf2f((bf16)((gx >> 16) & 0xffffu)));
                  const float oz = acc[mt].z * rstd * ng.z * siluf_(bf2f((bf16)((gx >> 32) & 0xffffu)));
                  const float ow_ = acc[mt].w * rstd * ng.w * siluf_(bf2f((bf16)(gx >> 48)));
                  ow[2 * hf] = pk2(ox, oy); ow[2 * hf + 1] = pk2(oz, ow_); }
              *(v4u*)(O + m * D_ + h * 128 + eh * 64 + kb * 32 + g * 8) = (v4u){ow[0], ow[1], ow[2], ow[3]}; } }
        __syncthreads();
    }
}

__device__ __forceinline__ size_t chain_blk(int item, int rot) { const int h = item & 7, c = (item >> 3) & 127, b = item >> 10, k = b * 8 + h; return (size_t)(k * 128 + ((c + 4 * k + rot) & 127)) * 4096; }
struct RwkvW { const float *mu, *mu_vres, *w0, *a0, *v0, *k_k, *k_a, *r_k; const bf16 *wupT, *aupT, *gupT, *vupT; };
constexpr int RW_LD = 72, RW_XLD = 296;
constexpr int RW_R0 = 0;
constexpr int RW_SEG = 16384;
constexpr int RW_R1 = 36864;
constexpr int RW_R2 = RW_R1 + 27648;
constexpr int RW_R3 = RW_R2 + 9216;
constexpr int RW_R4 = RW_R3 + 27648;
constexpr int RW_TI = RW_R4 + 128 * RW_LD * 2;
constexpr int RW_MU = RW_TI + 2048;
constexpr int RW_X = RW_MU + 2048;
constexpr int RW_END = RW_X + 64 * RW_XLD * 2;
static_assert(RW_END <= MISC_OFF, "RWKV LDS map");

typedef short s16x4 __attribute__((ext_vector_type(4)));
__device__ __forceinline__ float tanh_fast(float x) { const float e = __expf(2.f * x); return 1.f - 2.f * __builtin_amdgcn_rcpf(e + 1.f); }
__device__ __forceinline__ float softplus_fast(float x) { return fmaxf(x, 0.f) + __logf(1.f + __expf(-fabsf(x))); }
__device__ __forceinline__ s16x4 cvt4(f32x4 v) { const unsigned long long p = pack4(v); return __builtin_bit_cast(s16x4, p); }
__device__ __forceinline__ void ld8f(const float* p, float (&o)[8]) { const f32x4 a = *(const f32x4*)p, b = *(const f32x4*)(p + 4); o[0] = a.x; o[1] = a.y; o[2] = a.z; o[3] = a.w; o[4] = b.x; o[5] = b.y; o[6] = b.z; o[7] = b.w; }
__device__ __forceinline__ float sum8(float v) { v += dpp_f<0xB1>(v); v += dpp_f<0x4E>(v); v += dpp_f<0x141>(v); return v; }
__device__ __forceinline__ void unpack8(const v4u x, float (&o)[8]) {
    o[0] = bf2f((bf16)(x.x & 0xffffu)); o[1] = bf2f((bf16)(x.x >> 16)); o[2] = bf2f((bf16)(x.y & 0xffffu)); o[3] = bf2f((bf16)(x.y >> 16));
    o[4] = bf2f((bf16)(x.z & 0xffffu)); o[5] = bf2f((bf16)(x.z >> 16)); o[6] = bf2f((bf16)(x.w & 0xffffu)); o[7] = bf2f((bf16)(x.w >> 16)); }
__device__ __forceinline__ v4u pack8(const float (&o)[8]) { return (v4u){pk2(o[0], o[1]), pk2(o[2], o[3]), pk2(o[4], o[5]), pk2(o[6], o[7])}; }
__device__ __forceinline__ f32x4 mm16_gb(const LAS bf16* A, int lda, const bf16* B, int ldb, int K, f32x4 acc, int lane) {
    const int r = lane & 15, g = lane >> 4;
    const LAS bf16* ap = A + r * lda + 8 * g; const bf16* bp = B + r * ldb + 8 * g;
    for (int k0 = 0; k0 < K; k0 += 32) { const s16x8 a = *(const LAS s16x8*)(ap + k0); const s16x8 b = *(const s16x8*)(bp + k0); acc = __builtin_amdgcn_mfma_f32_16x16x32_bf16(a, b, acc, 0, 0, 0); }
    return acc;
}

__device__ __forceinline__ void ph_norm_b(const Ctx& C, const bf16* x, const float* g, const float* sh, const float* sc, bf16* XB) {
    const int gw = C.bid * 8 + C.wave, NGW = C.nb * 8, lane = C.lane;
    float gv[2][8];
#pragma unroll
    for (int j = 0; j < 2; ++j) ld8f(g + 8 * lane + 512 * j, gv[j]);
    for (int m0 = gw; m0 < M_; m0 += 4 * NGW) {
        v4u raw[4][2];
#pragma unroll
        for (int r = 0; r < 4; ++r) { const int m = m0 + r * NGW; const v4u* xr = (const v4u*)(x + (size_t)(m < M_ ? m : m0) * D_) + lane; raw[r][0] = xr[0]; raw[r][1] = xr[64]; }
#pragma unroll
        for (int r = 0; r < 4; ++r) { const int m = m0 + r * NGW; if (m >= M_) break;
            const int b = m / T_;
            float v[2][8]; float s = 0.f;
#pragma unroll
            for (int j = 0; j < 2; ++j) { unpack8(raw[r][j], v[j]);
#pragma unroll
                for (int i = 0; i < 8; ++i) s += v[j][i] * v[j][i]; }
            const float rstd = __builtin_amdgcn_rsqf(wave_sum(s) * (1.f / D_) + 1e-6f);
            v4u* o = (v4u*)(XB + (size_t)m * D_) + lane;
#pragma unroll
            for (int j = 0; j < 2; ++j) { const int col = 8 * lane + 512 * j; float shv[8], scv[8], h[8];
                ld8f(sh + b * 6144 + col, shv); ld8f(sc + b * 6144 + col, scv);
#pragma unroll
                for (int i = 0; i < 8; ++i) h[i] = v[j][i] * rstd * gv[j][i] * (scv[i] + 1.f) + shv[i];
                o[64 * j] = pack8(h); } }
    }
}
__device__ __forceinline__ void ph_final_b(const Ctx& C, const bf16* x, const float* g, float* out, int m_lo, int m_hi, bf16* keep, int c_lo, int c_hi) {
    const int gw = C.bid * 8 + C.wave, NGW = C.nb * 8, lane = C.lane;
    for (int m = m_lo + gw; m < m_hi; m += NGW) {
        const v4u* xr = (const v4u*)(x + (size_t)m * D_) + lane;
        float v[2][8]; float s = 0.f;
#pragma unroll
        for (int j = 0; j < 2; ++j) { unpack8(xr[64 * j], v[j]);
#pragma unroll
            for (int i = 0; i < 8; ++i) s += v[j][i] * v[j][i]; }
        const float rstd = 1.f / sqrtf(wave_sum(s) * (1.f / D_) + 1e-6f);
#pragma unroll
        for (int j = 0; j < 2; ++j) { const int col = 8 * lane + 512 * j; float gv[8]; ld8f(g + col, gv);
            f32x4* o = (f32x4*)(out + (size_t)m * D_ + col);
            o[0] = (f32x4){v[j][0] * rstd * gv[0], v[j][1] * rstd * gv[1], v[j][2] * rstd * gv[2], v[j][3] * rstd * gv[3]};
            o[1] = (f32x4){v[j][4] * rstd * gv[4], v[j][5] * rstd * gv[5], v[j][6] * rstd * gv[6], v[j][7] * rstd * gv[7]}; }
    }
    for (int m = c_lo + gw; m < c_hi; m += NGW) { const v4u* xr = (const v4u*)(x + (size_t)m * D_) + lane; v4u* kr = (v4u*)(keep + (size_t)(m - c_lo) * D_) + lane; kr[0] = xr[0]; kr[64] = xr[64]; }
}
__device__ __forceinline__ int rofs(int row, int t) { return row * RW_LD + ((((t >> 3) + (row >> 3)) & 7) << 3) + (t & 7); }
__device__ __forceinline__ void ph_rwkv_a(const Ctx& C, const bf16* PR, const bf16* VL  , const RwkvW& W, int layer,
                                          bf16* PP, bf16* QQ, bf16* RH, bf16* YH, float* GAMC, float* RK, bf16* GG, bf16* VF, bf16* VP, bool store_v = true) {
    LAS unsigned char* L = C.lds;
    LAS bf16* X = (LAS bf16*)(L + RW_X); LAS float* CUM = (LAS float*)(L + RW_R0); LAS float* SEG = (LAS float*)(L + RW_SEG);
    LAS bf16* NI = (LAS bf16*)(L + RW_R0), *AAK = NI + 64 * RW_LD, *ARB = AAK + 64 * RW_LD, *ARK = ARB + 64 * RW_LD;
    LAS bf16* PRE = (LAS bf16*)(L + RW_R1);
    LAS bf16* AT = (LAS bf16*)(L + RW_R1), *BT = AT + 64 * RW_LD, *KT = BT + 64 * RW_LD, *RT = (LAS bf16*)(L + RW_R2);
    LAS bf16* XB16 = (LAS bf16*)(L + RW_R1);
    LAS bf16* BHc = (LAS bf16*)(L + RW_R3), *KHc = BHc + 64 * RW_LD, *VTc = KHc + 64 * RW_LD;
    LAS bf16* XT = (LAS bf16*)(L + RW_R4); LAS bf16* TI = (LAS bf16*)(L + RW_TI);
    const int wave = C.wave;
    LAS float* MU = (LAS float*)(L + RW_MU);
    for (int i = C.tid; i < 288; i += NT) MU[i] = i < 256 ? W.mu[1536 + i] : (layer ? W.mu_vres[i - 256] : 0.f);
    __syncthreads();
    for (int bc = C.bid; bc < 512; bc += C.nb) {
        const int c = bc & 127, b = bc >> 7;
        const size_t m0 = (size_t)b * T_ + c * 64;
        { const int tid = C.tid;
          v4u xc[5], xp[5];
#pragma unroll
          for (int it = 0; it < 5; ++it) { const int idx = tid + it * NT; xc[it] = (v4u){0u, 0u, 0u, 0u}; xp[it] = xc[it];
            if (idx < 64 * 36) { const int t1 = idx / 36, q = idx % 36, col = q * 8; const size_t m1 = m0 + t1; const bool first1 = (c == 0 && t1 == 0);
                if (q < 32) { xc[it] = *(const v4u*)(PR + m1 * NPR + 1536 + col); if (!first1) xp[it] = *(const v4u*)(PR + (m1 - 1) * NPR + 1536 + col); }
                else if (layer) { xc[it] = *(const v4u*)(VL + m1 * NPG + 1552 + (col - 256)); if (!first1) xp[it] = *(const v4u*)(VL + (m1 - 1) * NPG + 1552 + (col - 256)); } } }
#pragma unroll
          for (int it = 0; it < 5; ++it) { const int idx = tid + it * NT;
            if (idx < 64 * 36) { const int t1 = idx / 36, q = idx % 36, col = q * 8;
                float cv[8], pv[8], mu[8]; unpack8(xc[it], cv); unpack8(xp[it], pv);
                { const f32x4 ma = *(const LAS f32x4*)(MU + col), mb = *(const LAS f32x4*)(MU + col + 4); mu[0] = ma.x; mu[1] = ma.y; mu[2] = ma.z; mu[3] = ma.w; mu[4] = mb.x; mu[5] = mb.y; mu[6] = mb.z; mu[7] = mb.w; }
#pragma unroll
                for (int i = 0; i < 8; ++i) { float p = cv[i] + (pv[i] - cv[i]) * mu[i]; if (q < 8) p = tanh_fast(p); else if (q >= 16 && q < 32) p = sigmoidf_(p); cv[i] = p; }
                *(LAS v4u*)(X + t1 * RW_XLD + col) = pack8(cv); } }
        }
        __syncthreads();
      v4u rcx, kcx, vcx, rpx, kpx, vpx, vfx;
#define RW_FETCH(hh) do { const int t_ = C.tid >> 3, ch_ = (hh) * 64 + (C.tid & 7) * 8; const size_t m_ = m0 + t_; const bool first_ = (c == 0 && t_ == 0); \
        rcx = *(const v4u*)(PR + m_ * NPR + ch_); kcx = *(const v4u*)(PR + m_ * NPR + 512 + ch_); vcx = *(const v4u*)(PR + m_ * NPR + 1024 + ch_); \
        rpx = (v4u){0u, 0u, 0u, 0u}; kpx = rpx; vpx = rpx; vfx = rpx; \
        if (!first_) { rpx = *(const v4u*)(PR + (m_ - 1) * NPR + ch_); kpx = *(const v4u*)(PR + (m_ - 1) * NPR + 512 + ch_); vpx = *(const v4u*)(PR + (m_ - 1) * NPR + 1024 + ch_); } \
        if (layer) vfx = *(const v4u*)(VF + m_ * 512 + ch_); } while (0)
      RW_FETCH(0);
#pragma unroll 1
      for (int h = 0; h < 8; ++h) {
        const int item = bc * 8 + h;
        int tid_ = C.tid; asm volatile("" : "+v"(tid_));
        const int tid = tid_, lane = tid & 63, cc = lane & 15, g = lane >> 4;
        const int t = tid >> 3, d0 = (tid & 7) * 8, ch = h * 64 + d0; const size_t m = m0 + t;
        {
            const int lsel = wave >> 1;
            const bf16* WT = lsel == 0 ? W.wupT : lsel == 1 ? W.aupT : lsel == 2 ? W.gupT : W.vupT;
            const int Kl = lsel == 2 ? 128 : lsel == 3 ? 32 : 64, xoff = lsel == 0 ? 0 : lsel == 1 ? 64 : lsel == 2 ? 128 : 256;
            LAS bf16* outp = PRE + lsel * 64 * RW_LD;
            const bool live = (lsel != 3 || layer);
#pragma unroll
            for (int mq = 0; mq < 2; ++mq) { const int mt = (wave & 1) * 2 + mq;
                s16x8 af[4];
                const bf16* ap = WT + (size_t)(h * 64 + mt * 16 + cc) * Kl + 8 * g;
#pragma unroll
                for (int ks = 0; ks < 4; ++ks) af[ks] = (live && ks * 32 < Kl) ? *(const s16x8*)(ap + ks * 32) : (s16x8){0, 0, 0, 0, 0, 0, 0, 0};
#pragma unroll
                for (int nt = 0; nt < 4; ++nt) { f32x4 acc = {0.f, 0.f, 0.f, 0.f};
                    const LAS bf16* bp = X + (nt * 16 + cc) * RW_XLD + xoff + 8 * g;
#pragma unroll
                    for (int ks = 0; ks < 4; ++ks) if (ks * 32 < Kl) { const s16x8 bb = *(const LAS s16x8*)(bp + ks * 32); acc = __builtin_amdgcn_mfma_f32_16x16x32_bf16(af[ks], bb, acc, 0, 0, 0); }
                    *(LAS unsigned long long*)(outp + (nt * 16 + cc) * RW_LD + mt * 16 + 4 * g) = pack4(acc); } }
        }
        __syncthreads();
        float av[8], bv[8], kv[8], rv[8], lw[8], vv[8];
        {
            float rc[8], rp[8], kc[8], kp[8], vc[8], vp[8], pw[8], pa[8], pg_[8], pvg[8];
            unpack8(rcx, rc); unpack8(kcx, kc); unpack8(vcx, vc); unpack8(rpx, rp); unpack8(kpx, kp); unpack8(vpx, vp);
            unpack8(*(const LAS v4u*)(PRE + (0 * 64 + t) * RW_LD + d0), pw); unpack8(*(const LAS v4u*)(PRE + (1 * 64 + t) * RW_LD + d0), pa);
            unpack8(*(const LAS v4u*)(PRE + (2 * 64 + t) * RW_LD + d0), pg_); unpack8(*(const LAS v4u*)(PRE + (3 * 64 + t) * RW_LD + d0), pvg);
            float vf[8]; unpack8(vfx, vf);
            float ssq = 0.f, rks = 0.f, asg[8], gg[8];
            float mur[8], muk[8], muv[8], w0c[8], a0c[8], v0c[8], kkc[8], kac[8], rkc[8];
            ld8f(W.mu + ch, mur); ld8f(W.mu + 512 + ch, muk); ld8f(W.mu + 1024 + ch, muv); ld8f(W.w0 + ch, w0c); ld8f(W.a0 + ch, a0c);
            ld8f(W.k_k + ch, kkc); ld8f(W.k_a + ch, kac); ld8f(W.r_k + ch, rkc);
            if (layer) ld8f(W.v0 + ch, v0c);
#pragma unroll
            for (int i = 0; i < 8; ++i) {
                const float r = rc[i] + (rp[i] - rc[i]) * mur[i], k = kc[i] + (kp[i] - kc[i]) * muk[i]; float v = vc[i] + (vp[i] - vc[i]) * muv[i];
                lw[i] = -0.6065306597f * sigmoidf_(w0c[i] + pw[i]);
                asg[i] = sigmoidf_(a0c[i] + pa[i]);
                if (layer) v = v + (vf[i] - v) * sigmoidf_(v0c[i] + pvg[i]);
                const float kk = k * kkc[i]; ssq += kk * kk;
                kv[i] = k * (1.f + (asg[i] - 1.f) * kac[i]); rv[i] = r; vv[i] = v; gg[i] = pg_[i]; av[i] = kk;
                rks += r * kv[i] * rkc[i];
            }
            ssq = sum8(ssq); rks = sum8(rks);
            const float inv = __builtin_amdgcn_rsqf(fmaxf(ssq, 1e-24f));
#pragma unroll
            for (int i = 0; i < 8; ++i) { const float kk = av[i] * inv; av[i] = -kk; bv[i] = kk * asg[i]; }
            if ((tid & 7) == 0) RK[m * 8 + h] = rks;
            {
              const int p0 = h * 64 + (d0 >> 5) * 32 + ((d0 >> 2) & 3) * 8 + ((d0 >> 4) & 1) * 4;
              const v4u gp = pack8(gg), vp = pack8(vv);
              *(unsigned long long*)(GG + m * 512 + p0) = (unsigned long long)gp.x | ((unsigned long long)gp.y << 32); *(unsigned long long*)(GG + m * 512 + p0 + 8) = (unsigned long long)gp.z | ((unsigned long long)gp.w << 32);
              *(unsigned long long*)(VP + m * 512 + p0) = (unsigned long long)vp.x | ((unsigned long long)vp.y << 32); *(unsigned long long*)(VP + m * 512 + p0 + 8) = (unsigned long long)vp.z | ((unsigned long long)vp.w << 32);
              if (store_v && layer == 0) *(v4u*)(VF + m * 512 + ch) = vp; }
#pragma unroll
            for (int i = 0; i < 8; ++i) vv[i] = bf2f((bf16)f2bf(vv[i]));
        }
        __syncthreads();
#pragma unroll
        for (int i = 0; i < 8; ++i) CUM[t * 64 + d0 + i] = lw[i];
        __syncthreads();
        { const int d = tid & 63, seg = tid >> 6; float run = 0.f;
#pragma unroll
          for (int q = 0; q < 8; ++q) { run += CUM[(seg * 8 + q) * 64 + d]; CUM[(seg * 8 + q) * 64 + d] = run; }
          SEG[seg * 64 + d] = run; }
        __syncthreads();
        { const int d = tid & 63, seg = tid >> 6; float off = 0.f;
          for (int s = 0; s < seg; ++s) off += SEG[s * 64 + d];
#pragma unroll
          for (int q = 0; q < 8; ++q) CUM[(seg * 8 + q) * 64 + d] += off; }
        __syncthreads();
        {
            float at[8], bt[8], kt[8], rt[8];
#pragma unroll
            for (int i = 0; i < 8; ++i) { const float cu = CUM[t * 64 + d0 + i], cC = CUM[63 * 64 + d0 + i], en = __expf(-cu), ec = __expf(cC - cu);
                at[i] = av[i] * __expf(cu - lw[i]); bt[i] = bv[i] * en; kt[i] = kv[i] * en; rt[i] = rv[i] * __expf(cu);
                { const int ro = rofs(d0 + i, t); BHc[ro] = (bf16)f2bf(bv[i] * ec); KHc[ro] = (bf16)f2bf(kv[i] * ec); VTc[ro] = (bf16)f2bf(vv[i]); XT[ro] = (bf16)f2bf(at[i]); }
                if (t == 63) GAMC[(size_t)item * 64 + d0 + i] = __expf(cC); }
            *(LAS v4u*)(AT + t * RW_LD + d0) = pack8(at); *(LAS v4u*)(BT + t * RW_LD + d0) = pack8(bt); *(LAS v4u*)(KT + t * RW_LD + d0) = pack8(kt); *(LAS v4u*)(RT + t * RW_LD + d0) = pack8(rt);
        }
        if (h < 7) RW_FETCH(h + 1);
        __syncthreads();
        {
            const int msel = wave >> 1;
            const LAS bf16* As = (msel == 0 || msel == 2) ? BT : KT; const LAS bf16* Bs = (msel < 2) ? AT : RT;
            f32x4 accs[8];
#pragma unroll
            for (int q = 0; q < 8; ++q) { const int tile = (wave & 1) * 8 + q, mt = tile >> 2, nt = tile & 3; accs[q] = (f32x4){0.f, 0.f, 0.f, 0.f};
                accs[q] = mm16(As + mt * 16 * RW_LD, RW_LD, Bs + nt * 16 * RW_LD, RW_LD, 64, accs[q], lane);
                const int tt = nt * 16 + cc, s0 = mt * 16 + 4 * g, lim = (msel < 2) ? tt - 1 : tt;
                accs[q].x = (s0 + 0 <= lim) ? accs[q].x : 0.f; accs[q].y = (s0 + 1 <= lim) ? accs[q].y : 0.f; accs[q].z = (s0 + 2 <= lim) ? accs[q].z : 0.f; accs[q].w = (s0 + 3 <= lim) ? accs[q].w : 0.f; }
            __syncthreads();
            LAS bf16* outp = NI + msel * 64 * RW_LD;
#pragma unroll
            for (int q = 0; q < 8; ++q) { const int tile = (wave & 1) * 8 + q, mt = tile >> 2, nt = tile & 3;
                *(LAS unsigned long long*)(outp + (nt * 16 + cc) * RW_LD + mt * 16 + 4 * g) = pack4(accs[q]); }
        }
        __syncthreads();
        if (wave == 0) {
            const int blk = lane >> 4, col = lane & 15; float x[16];
#pragma unroll
            for (int tt = 0; tt < 16; ++tt) { float nr[16]; { float lo[8], hi[8]; unpack8(*(const LAS v4u*)(NI + (16 * blk + tt) * RW_LD + 16 * blk), lo); unpack8(*(const LAS v4u*)(NI + (16 * blk + tt) * RW_LD + 16 * blk + 8), hi);
#pragma unroll
                    for (int q = 0; q < 8; ++q) { nr[q] = lo[q]; nr[8 + q] = hi[q]; } }
                float a = (tt == col) ? 1.f : 0.f;
#pragma unroll
                for (int q = 0; q < tt; ++q) a += nr[q] * x[q];
                x[tt] = a; TI[(blk * 16 + tt) * 16 + col] = (bf16)f2bf(a); }
        } else {
            for (int tile = wave - 1; tile < 16; tile += 7) { const int mt = tile >> 2, nt = tile & 3;
                f32x4 acc = {0.f, 0.f, 0.f, 0.f};
#pragma unroll
                for (int k = 0; k < 2; ++k) { const s16x8 a = *(const LAS s16x8*)(AAK + (mt * 16 + cc) * RW_LD + 32 * k + 8 * g), bb = *(const LAS s16x8*)(VTc + rofs(nt * 16 + cc, 32 * k + 8 * g)); acc = __builtin_amdgcn_mfma_f32_16x16x32_bf16(a, bb, acc, 0, 0, 0); }
                *(LAS unsigned long long*)(XT + rofs(64 + nt * 16 + cc, mt * 16 + 4 * g)) = pack4(acc); }
        }
        __syncthreads();
        {
            s16x4 xb[4];
#pragma unroll
            for (int i = 0; i < 4; ++i) {
                f32x4 acc; { const unsigned long long xr = *(const LAS unsigned long long*)(XT + rofs(wave * 16 + cc, 16 * i + 4 * g));
                    acc.x = bf2f((bf16)(xr & 0xffffu)); acc.y = bf2f((bf16)((xr >> 16) & 0xffffu)); acc.z = bf2f((bf16)((xr >> 32) & 0xffffu)); acc.w = bf2f((bf16)(xr >> 48)); }
#pragma unroll
                for (int k = 0; k < i; ++k) { const s16x4 a = *(const LAS s16x4*)(NI + (16 * i + cc) * RW_LD + 16 * k + 4 * g); acc = __builtin_amdgcn_mfma_f32_16x16x16bf16_1k(a, xb[k], acc, 0, 0, 0); }
                const s16x4 yb = cvt4(acc), ta = *(const LAS s16x4*)(TI + (i * 16 + cc) * 16 + 4 * g);
                const f32x4 xi = __builtin_amdgcn_mfma_f32_16x16x16bf16_1k(ta, yb, (f32x4){0.f, 0.f, 0.f, 0.f}, 0, 0, 0);
                xb[i] = cvt4(xi);
            }
            __syncthreads();
#pragma unroll
            for (int i = 0; i < 4; ++i) *(LAS s16x4*)(XB16 + (wave * 16 + cc) * RW_LD + 16 * i + 4 * g) = xb[i];
        }
        __syncthreads();
        {
            const int osel = wave >> 1, mt0 = (wave & 1) * 2; const size_t ob = osel == 0 ? chain_blk(item, 0) : osel == 1 ? chain_blk(item, 64) : (size_t)item * 4096;
            const LAS bf16* A1 = osel == 0 ? XB16 : osel == 1 ? BHc : osel == 2 ? XB16 : XB16 + 64 * RW_LD;
            const LAS bf16* B1 = osel == 0 ? BHc : osel == 1 ? XB16 + 64 * RW_LD : ARB;
            const LAS bf16* A2 = osel == 1 ? KHc : VTc; const LAS bf16* B2 = osel == 1 ? VTc : ARK;
            const bool rA1 = osel == 1, rB1 = osel == 0, rA2 = true, rB2 = osel == 1;
#define RW_FO(rot, row, k) ((rot) ? rofs((row), 32 * (k) + 8 * g) : (row) * RW_LD + 32 * (k) + 8 * g)
            bf16* OUT = osel == 0 ? PP : osel == 1 ? QQ : osel == 2 ? RH : YH;
            f32x4 acc[2][4];
#pragma unroll
            for (int mq = 0; mq < 2; ++mq)
#pragma unroll
                for (int nt = 0; nt < 4; ++nt) acc[mq][nt] = (f32x4){0.f, 0.f, 0.f, 0.f};
            { s16x8 af[2][2], bfm[4][2];
#pragma unroll
              for (int mq = 0; mq < 2; ++mq)
#pragma unroll
                  for (int k = 0; k < 2; ++k) af[mq][k] = *(const LAS s16x8*)(A1 + RW_FO(rA1, (mt0 + mq) * 16 + cc, k));
#pragma unroll
              for (int nt = 0; nt < 4; ++nt)
#pragma unroll
                  for (int k = 0; k < 2; ++k) bfm[nt][k] = *(const LAS s16x8*)(B1 + RW_FO(rB1, nt * 16 + cc, k));
#pragma unroll
              for (int mq = 0; mq < 2; ++mq)
#pragma unroll
                  for (int nt = 0; nt < 4; ++nt) { acc[mq][nt] = __builtin_amdgcn_mfma_f32_16x16x32_bf16(af[mq][0], bfm[nt][0], acc[mq][nt], 0, 0, 0); acc[mq][nt] = __builtin_amdgcn_mfma_f32_16x16x32_bf16(af[mq][1], bfm[nt][1], acc[mq][nt], 0, 0, 0); } }
            if (osel & 1) { s16x8 af[2][2], bfm[4][2];
#pragma unroll
              for (int mq = 0; mq < 2; ++mq)
#pragma unroll
                  for (int k = 0; k < 2; ++k) af[mq][k] = *(const LAS s16x8*)(A2 + RW_FO(rA2, (mt0 + mq) * 16 + cc, k));
#pragma unroll
              for (int nt = 0; nt < 4; ++nt)
#pragma unroll
                  for (int k = 0; k < 2; ++k) bfm[nt][k] = *(const LAS s16x8*)(B2 + RW_FO(rB2, nt * 16 + cc, k));
#pragma unroll
              for (int mq = 0; mq < 2; ++mq)
#pragma unroll
                  for (int nt = 0; nt < 4; ++nt) { acc[mq][nt] = __builtin_amdgcn_mfma_f32_16x16x32_bf16(af[mq][0], bfm[nt][0], acc[mq][nt], 0, 0, 0); acc[mq][nt] = __builtin_amdgcn_mfma_f32_16x16x32_bf16(af[mq][1], bfm[nt][1], acc[mq][nt], 0, 0, 0); } }
#pragma unroll
            for (int nt = 0; nt < 4; ++nt) { f32x4 a0 = acc[0][nt], a1 = acc[1][nt];
                if (osel == 2) {
                    const unsigned long long r0 = *(const LAS unsigned long long*)(RT + (nt * 16 + cc) * RW_LD + mt0 * 16 + 4 * g), r1 = *(const LAS unsigned long long*)(RT + (nt * 16 + cc) * RW_LD + (mt0 + 1) * 16 + 4 * g);
                    a0.x += bf2f((bf16)(r0 & 0xffffu)); a0.y += bf2f((bf16)((r0 >> 16) & 0xffffu)); a0.z += bf2f((bf16)((r0 >> 32) & 0xffffu)); a0.w += bf2f((bf16)(r0 >> 48));
                    a1.x += bf2f((bf16)(r1 & 0xffffu)); a1.y += bf2f((bf16)((r1 >> 16) & 0xffffu)); a1.z += bf2f((bf16)((r1 >> 32) & 0xffffu)); a1.w += bf2f((bf16)(r1 >> 48)); }
                const unsigned long long lo = pack4(a0), hi = pack4(a1);
                *(v4u*)(OUT + ob + (size_t)((nt * 2 + (wave & 1)) * 64 + lane) * 8) = (v4u){(unsigned)lo, (unsigned)(lo >> 32), (unsigned)hi, (unsigned)(hi >> 32)}; }
        }
        __syncthreads();
      }
    }
}

#undef RW_FETCH
#undef RW_FO
constexpr int CH_R = 8, CH_IMG = 8192, CH_SLOT = 2 * CH_IMG + 256;
constexpr int CH_RING = 0, CH_FLAGS = CH_R * CH_SLOT;
static_assert(CH_FLAGS + 64 <= MISC_OFF, "chain LDS map");
struct ChainRegs { v4u p[8], q[8]; f32x4 gm; };
__device__ __forceinline__ void chain_fetch(ChainRegs& o, const bf16* PP, const bf16* QQ, const float* GAMC, int item, int lane) {
    const size_t obp = chain_blk(item, 0), obq = chain_blk(item, 64);
#pragma unroll
    for (int i = 0; i < 8; ++i) { o.p[i] = *(const v4u*)(PP + obp + (size_t)(i * 64 + lane) * 8); o.q[i] = *(const v4u*)(QQ + obq + (size_t)(i * 64 + lane) * 8); }
    o.gm = *(const f32x4*)(GAMC + (size_t)item * 64 + (lane & 15) * 4);
}
__device__ __forceinline__ void chain_commit(const ChainRegs& o, LAS unsigned char* L, int c, int lane) {
    volatile LAS unsigned* flags = (volatile LAS unsigned*)(L + CH_FLAGS);
    const int slot = c % CH_R;
    if (c >= CH_R) { const unsigned need = (unsigned)(c - CH_R + 1);
        for (;;) { const unsigned m0 = flags[CH_R + 0], m1 = flags[CH_R + 1], m2 = flags[CH_R + 2], m3 = flags[CH_R + 3];
            if (m0 >= need && m1 >= need && m2 >= need && m3 >= need) break; __builtin_amdgcn_s_sleep(1); } }
    asm volatile("" ::: "memory");
    LAS unsigned char* sl = L + CH_RING + slot * CH_SLOT;
#pragma unroll
    for (int i = 0; i < 8; ++i) { *(LAS v4u*)(sl + (i * 64 + lane) * 16) = o.p[i]; *(LAS v4u*)(sl + CH_IMG + (i * 64 + lane) * 16) = o.q[i]; }
    *(LAS f32x4*)(sl + 2 * CH_IMG + (lane & 15) * 16) = o.gm;
    asm volatile("s_waitcnt lgkmcnt(0)" ::: "memory");
    if (lane == 0) flags[slot] = (unsigned)(c + 1);
}
struct ChainOps { s16x8 a[4][2]; v4u q[2]; f32x4 gm[4]; };
__device__ __forceinline__ void chain_read(ChainOps& X, LAS unsigned char* L, int c, int vt, int cc, int g) {
    const LAS unsigned char* sl = L + CH_RING + (c % CH_R) * CH_SLOT; const int lane = g * 16 + cc;
#pragma unroll
    for (int mt = 0; mt < 4; ++mt) {
#pragma unroll
        for (int kb = 0; kb < 2; ++kb) X.a[mt][kb] = *(const LAS s16x8*)(sl + ((mt * 2 + kb) * 64 + lane) * 16);
        X.gm[mt] = *(const LAS f32x4*)(sl + 2 * CH_IMG + (mt * 16 + 4 * g) * 4); }
#pragma unroll
    for (int kb = 0; kb < 2; ++kb) X.q[kb] = *(const LAS v4u*)(sl + CH_IMG + ((vt * 2 + kb) * 64 + lane) * 16);
}
__device__ __forceinline__ void chain_step(const ChainOps& X, ChainOps& Y, f32x4 (&st)[4], LAS unsigned char* L, volatile LAS unsigned* flags, bf16* S0, size_t ob, int c, int vt, int cc, int g, int lane) {
    unsigned long long pk[4];
#pragma unroll
    for (int mt = 0; mt < 4; ++mt) pk[mt] = pack4(st[mt]);
    s16x8 bq[2];
#pragma unroll
    for (int kb = 0; kb < 2; ++kb) { const unsigned long long lo = pk[2 * kb], hi = pk[2 * kb + 1];
        const v4u w = {(unsigned)lo, (unsigned)(lo >> 32), (unsigned)hi, (unsigned)(hi >> 32)};
        bq[kb] = __builtin_bit_cast(s16x8, w);
        *(v4u*)(S0 + ob + (size_t)((vt * 2 + kb) * 64 + lane) * 8) = w; }
    asm volatile("s_waitcnt lgkmcnt(0)" ::: "memory");
    if (lane == 0) flags[CH_R + vt] = (unsigned)(c + 1);
    if (c + 1 < 128) {
        while (flags[(c + 1) % CH_R] < (unsigned)(c + 2)) __builtin_amdgcn_s_sleep(1);
        asm volatile("s_waitcnt lgkmcnt(0)" ::: "memory");
        chain_read(Y, L, c + 1, vt, cc, g); }
#pragma unroll
    for (int mt = 0; mt < 4; ++mt) { const unsigned q0 = (mt & 1) ? X.q[mt >> 1].z : X.q[mt >> 1].x, q1 = (mt & 1) ? X.q[mt >> 1].w : X.q[mt >> 1].y; const f32x4 gm = X.gm[mt];
        f32x4 acc; acc.x = gm.x * st[mt].x + bf2f((bf16)(q0 & 0xffffu)); acc.y = gm.y * st[mt].y + bf2f((bf16)(q0 >> 16));
        acc.z = gm.z * st[mt].z + bf2f((bf16)(q1 & 0xffffu)); acc.w = gm.w * st[mt].w + bf2f((bf16)(q1 >> 16));
#pragma unroll
        for (int kb = 0; kb < 2; ++kb) acc = __builtin_amdgcn_mfma_f32_16x16x32_bf16(X.a[mt][kb], bq[kb], acc, 0, 0, 0);
        st[mt] = acc; }
}
__device__ __forceinline__ void ph_rwkv_b(const Ctx& C, int bh  , const bf16* PP, const bf16* QQ, const float* GAMC, bf16* S0) {
    const int lane = C.lane, wave = C.wave, cc = lane & 15, g = lane >> 4, b = bh >> 3, h = bh & 7;
    LAS unsigned char* L = C.lds;
    volatile LAS unsigned* flags = (volatile LAS unsigned*)(L + CH_FLAGS);
    if (C.tid < 16) flags[C.tid] = 0u;
    __syncthreads();
    if (wave >= 4) {
        const int j = wave - 4;
        ChainRegs A, B;
        int lc = j;
        chain_fetch(A, PP, QQ, GAMC, (b * 128 + lc) * 8 + h, lane);
        for (int it = 0; it < 16; ++it) {
            chain_fetch(B, PP, QQ, GAMC, (b * 128 + min(lc + 4, 124 + j)) * 8 + h, lane);
            chain_commit(A, L, lc, lane);
            lc += 4;
            chain_fetch(A, PP, QQ, GAMC, (b * 128 + min(lc + 4, 124 + j)) * 8 + h, lane);
            chain_commit(B, L, lc, lane);
            lc += 4;
        }
    } else {
        const int vt = wave;
        f32x4 st[4];
#pragma unroll
        for (int mt = 0; mt < 4; ++mt) st[mt] = (f32x4){0.f, 0.f, 0.f, 0.f};
        ChainOps X0, X1;
        while (flags[0] < 1u) __builtin_amdgcn_s_sleep(1);
        asm volatile("s_waitcnt lgkmcnt(0)" ::: "memory");
        chain_read(X0, L, 0, vt, cc, g);
        for (int c = 0; c < 128; c += 2) {
            chain_step(X0, X1, st, L, flags, S0, chain_blk((b * 128 + c) * 8 + h, 32), c, vt, cc, g, lane);
            chain_step(X1, X0, st, L, flags, S0, chain_blk((b * 128 + c + 1) * 8 + h, 32), c + 1, vt, cc, g, lane);
        }
    }
    __syncthreads();
}

__device__ __forceinline__ void ph_rwkv_c(const Ctx& C, const bf16* S0, const bf16* RH, const bf16* YH, const float* RK, const bf16* GG, const bf16* VF,
                                          const float* gn_g, const float* gn_b, bf16* O) {
    const int lane = C.lane, cc = lane & 15, g = lane >> 4;
    for (int item = C.bid * 8 + C.wave; item < 4096; item += C.nb * 8) {
        const int h = item & 7, c = (item >> 3) & 127, b = item >> 10; const size_t m0 = (size_t)b * T_ + c * 64, ob = (size_t)item * 4096;
        s16x8 af[4][2], bfr[4][2];
#pragma unroll
        for (int q = 0; q < 4; ++q)
#pragma unroll
            for (int k = 0; k < 2; ++k) { af[q][k] = *(const s16x8*)(S0 + chain_blk(item, 32) + (size_t)((q * 2 + k) * 64 + lane) * 8); bfr[q][k] = *(const s16x8*)(RH + ob + (size_t)((q * 2 + k) * 64 + lane) * 8); }
#pragma unroll
        for (int nt = 0; nt < 4; ++nt) {
            const size_t m = m0 + nt * 16 + cc;
            f32x4 y[4]; float s1 = 0.f;
            const v4u yv0 = *(const v4u*)(YH + ob + (size_t)((nt * 2 + 0) * 64 + lane) * 8), yv1 = *(const v4u*)(YH + ob + (size_t)((nt * 2 + 1) * 64 + lane) * 8);
#pragma unroll
            for (int mt = 0; mt < 4; ++mt) { const v4u yv = (mt >> 1) ? yv1 : yv0; const unsigned y0 = (mt & 1) ? yv.z : yv.x, y1 = (mt & 1) ? yv.w : yv.y;
                f32x4 acc; acc.x = bf2f((bf16)(y0 & 0xffffu)); acc.y = bf2f((bf16)(y0 >> 16)); acc.z = bf2f((bf16)(y1 & 0xffffu)); acc.w = bf2f((bf16)(y1 >> 16));
                acc = __builtin_amdgcn_mfma_f32_16x16x32_bf16(af[mt][0], bfr[nt][0], acc, 0, 0, 0); acc = __builtin_amdgcn_mfma_f32_16x16x32_bf16(af[mt][1], bfr[nt][1], acc, 0, 0, 0);
                y[mt] = acc; s1 += (acc.x + acc.y) + (acc.z + acc.w); }
            s1 = xsum4(s1);
            const float mean = s1 * (1.f / 64.f); float s2 = 0.f;
#pragma unroll
            for (int mt = 0; mt < 4; ++mt) { y[mt] = y[mt] - mean; s2 += (y[mt].x * y[mt].x + y[mt].y * y[mt].y) + (y[mt].z * y[mt].z + y[mt].w * y[mt].w); }
            s2 = xsum4(s2);
            const float rstd = __builtin_amdgcn_rsqf(s2 * (1.f / 64.f) + 64e-5f), rk = RK[m * 8 + h];
#pragma unroll
            for (int kb = 0; kb < 2; ++kb) { const int p = h * 64 + kb * 32 + g * 8;
                const v4u vx = *(const v4u*)(VF + m * 512 + p), gx = *(const v4u*)(GG + m * 512 + p); unsigned ow[4];
#pragma unroll
                for (int hf = 0; hf < 2; ++hf) { const int mt = 2 * kb + hf, v = h * 64 + mt * 16 + 4 * g;
                    const f32x4 gg4 = *(const f32x4*)(gn_g + v), gb4 = *(const f32x4*)(gn_b + v);
                    const unsigned v0 = hf ? vx.z : vx.x, v1 = hf ? vx.w : vx.y, g0 = hf ? gx.z : gx.x, g1 = hf ? gx.w : gx.y;
                    const float ox = (y[mt].x * rstd * gg4.x + gb4.x + rk * bf2f((bf16)(v0 & 0xffffu))) * bf2f((bf16)(g0 & 0xffffu));
                    const float oy = (y[mt].y * rstd * gg4.y + gb4.y + rk * bf2f((bf16)(v0 >> 16))) * bf2f((bf16)(g0 >> 16));
                    const float oz = (y[mt].z * rstd * gg4.z + gb4.z + rk * bf2f((bf16)(v1 & 0xffffu))) * bf2f((bf16)(g1 & 0xffffu));
                    const float ow_ = (y[mt].w * rstd * gg4.w + gb4.w + rk * bf2f((bf16)(v1 >> 16))) * bf2f((bf16)(g1 >> 16));
                    ow[2 * hf] = pk2(ox, oy); ow[2 * hf + 1] = pk2(oz, ow_); }
                *(v4u*)(O + m * D_ + 512 + p) = (v4u){ow[0], ow[1], ow[2], ow[3]}; }
        }
    }
}

__device__ __forceinline__ void ph_convfix(const Ctx& C, const float* HALO, const float* FIXU, const float* cw, const float* cb, bf16* ACT) {
    for (int idx = C.bid * NT + C.tid; idx < 128 * 22 * 2 * 128; idx += C.nb * NT) {
        const int j = idx & 127, rr = (idx >> 7) & 1, tile = idx >> 8, pm = tile / 22, pn = tile % 22;
        const bool seq0 = (pm & 31) == 0;
        const float* fx = FIXU + (size_t)tile * 512; const float* hl = HALO + (size_t)(tile - 22) * 512;
        const float u0g = fx[rr * 256 + j], u0v = fx[rr * 256 + 128 + j];
        float u1g, u1v, u2g, u2v;
        if (rr == 0) { u1g = seq0 ? 0.f : hl[256 + j]; u1v = seq0 ? 0.f : hl[256 + 128 + j]; u2g = seq0 ? 0.f : hl[j]; u2v = seq0 ? 0.f : hl[128 + j]; }
        else { u1g = fx[j]; u1v = fx[128 + j]; u2g = seq0 ? 0.f : hl[256 + j]; u2v = seq0 ? 0.f : hl[256 + 128 + j]; }
        const int jg = pn * 128 + j, jv = DFF + jg;
        const float gc = cb[jg] + cw[jg] * u2g + cw[NUP + jg] * u1g + cw[2 * NUP + jg] * u0g, vc = cb[jv] + cw[jv] * u2v + cw[NUP + jv] * u1v + cw[2 * NUP + jv] * u0v;
        ACT[(size_t)(pm * 256 + rr) * DFF + jg] = (bf16)f2bf(siluf_(gc) * vc);
    }
}
}

namespace pg8 {
struct EpiRes {
    static constexpr bool PERM = false, AFTER_DRAIN = false;
    const float* base; float* out; const float* gate; int gstride;
    __device__ __forceinline__ void operator()(const f32x4 (&acc)[2][2][4][2], const Unit& u, int wr, int wc, int fr, int fq) const {
        const int b = (u.pm * BM) / 8192; const float* gp = gate + (size_t)b * gstride;
        const int col0 = u.pn * BM + wc * 32 + 4 * fq;
        f32x4 gv[2][2];
#pragma unroll
        for (int bj = 0; bj < 2; ++bj)
#pragma unroll
            for (int n = 0; n < 2; ++n) gv[bj][n] = *(const f32x4*)(gp + col0 + bj * HALF + n * 16);
#pragma unroll
        for (int ai = 0; ai < 2; ++ai)
#pragma unroll
            for (int m = 0; m < 4; ++m) { const size_t off = (size_t)(u.pm * BM + ai * HALF + wr * 64 + m * 16 + fr) * 1024 + col0;
                f32x4 bs[2][2];
#pragma unroll
                for (int bj = 0; bj < 2; ++bj)
#pragma unroll
                    for (int n = 0; n < 2; ++n) bs[bj][n] = *(const f32x4*)(base + off + bj * HALF + n * 16);
#pragma unroll
                for (int bj = 0; bj < 2; ++bj)
#pragma unroll
                    for (int n = 0; n < 2; ++n) *(f32x4*)(out + off + bj * HALF + n * 16) = bs[bj][n] + gv[bj][n] * acc[ai][bj][m][n]; }
    }
};

template <bool BASE32> struct EpiResB {
    static constexpr bool PERM = true, AFTER_DRAIN = false;
    const float* base32; const bf16_t* Rin; bf16_t* R; const float* gate; int gstride;
    __device__ __forceinline__ void operator()(const f32x4 (&acc)[2][2][4][2], const Unit& u, int wr, int wc, int fr, int fq) const {
        const int b = u.pm >> 5; const float* gp = gate + (size_t)b * gstride;
        const int col0 = u.pn * BM + wc * 32 + 8 * fq;
        f32x4 gv[2][2];
#pragma unroll
        for (int bj = 0; bj < 2; ++bj)
#pragma unroll
            for (int n = 0; n < 2; ++n) gv[bj][n] = *(const f32x4*)(gp + col0 + bj * HALF + n * 4);
#pragma unroll
        for (int ai = 0; ai < 2; ++ai)
#pragma unroll
            for (int m = 0; m < 4; ++m) { const size_t off = (size_t)(u.pm * BM + ai * HALF + wr * 64 + m * 16 + fr) * 1024 + col0;
                f32x4 bs[2][2];
#pragma unroll
                for (int bj = 0; bj < 2; ++bj) {
                    if (BASE32) { bs[bj][0] = *(const f32x4*)(base32 + off + bj * HALF); bs[bj][1] = *(const f32x4*)(base32 + off + bj * HALF + 4); }
                    else { const u32x4 r = *(const u32x4*)(Rin + off + bj * HALF);
                        bs[bj][0] = (f32x4){__builtin_bit_cast(float, r.x << 16), __builtin_bit_cast(float, r.x & 0xffff0000u), __builtin_bit_cast(float, r.y << 16), __builtin_bit_cast(float, r.y & 0xffff0000u)};
                        bs[bj][1] = (f32x4){__builtin_bit_cast(float, r.z << 16), __builtin_bit_cast(float, r.z & 0xffff0000u), __builtin_bit_cast(float, r.w << 16), __builtin_bit_cast(float, r.w & 0xffff0000u)}; } }
#pragma unroll
                for (int bj = 0; bj < 2; ++bj) { const f32x4 o0 = bs[bj][0] + gv[bj][0] * acc[ai][bj][m][0], o1 = bs[bj][1] + gv[bj][1] * acc[ai][bj][m][1];
                    u32x4 w; w.x = cvt_pk_bf16(o0.x, o0.y); w.y = cvt_pk_bf16(o0.z, o0.w); w.z = cvt_pk_bf16(o1.x, o1.y); w.w = cvt_pk_bf16(o1.z, o1.w);
                    *(u32x4*)(R + off + bj * HALF) = w; } }
    }
};
struct EpiConv {
    static constexpr bool PERM = true, AFTER_DRAIN = false;
    bf16_t* ACT; const float* cw; const float* cb; float* HALO; float* FIXU; PG8_LAS float* EX; int nN;
    template <int CTRL> static __device__ __forceinline__ float ror1(float x) { return __builtin_bit_cast(float, __builtin_amdgcn_mov_dpp(__builtin_bit_cast(int, x), CTRL, 0xf, 0xf, true)); }
    template <int CTRL> static __device__ __forceinline__ f32x4 ror4(f32x4 x) { return (f32x4){ror1<CTRL>(x.x), ror1<CTRL>(x.y), ror1<CTRL>(x.z), ror1<CTRL>(x.w)}; }
    template <int CTRL> static __device__ __forceinline__ float shr1(float old, float x) { return __builtin_bit_cast(float, __builtin_amdgcn_update_dpp(__builtin_bit_cast(int, old), __builtin_bit_cast(int, x), CTRL, 0xf, 0xf, false)); }
    template <int CTRL> static __device__ __forceinline__ f32x4 shr4(f32x4 o, f32x4 x) { return (f32x4){shr1<CTRL>(o.x, x.x), shr1<CTRL>(o.y, x.y), shr1<CTRL>(o.z, x.z), shr1<CTRL>(o.w, x.w)}; }
    __device__ __forceinline__ void operator()(const f32x4 (&acc)[2][2][4][2], const Unit& u, int wr, int wc, int fr, int fq) const {
        const int colw = wc * 32 + 8 * fq, tile = u.pm * nN + u.pn;
        if (fr >= 14) {
#pragma unroll
            for (int ai = 0; ai < 2; ++ai)
#pragma unroll
                for (int bj = 0; bj < 2; ++bj)
#pragma unroll
                    for (int n = 0; n < 2; ++n) { *(PG8_LAS f32x4*)(EX + ((ai * 2 + wr) * 2 + (fr - 14)) * 256 + bj * 128 + colw + 4 * n) = acc[ai][bj][3][n];
                        if (ai == 1 && wr == 1) *(f32x4*)(HALO + ((size_t)tile * 2 + (fr - 14)) * 256 + bj * 128 + colw + 4 * n) = acc[1][bj][3][n]; }
        }
        if (fr < 2 && wr == 0) {
#pragma unroll
            for (int bj = 0; bj < 2; ++bj)
#pragma unroll
                for (int n = 0; n < 2; ++n) *(f32x4*)(FIXU + ((size_t)tile * 2 + fr) * 256 + bj * 128 + colw + 4 * n) = acc[0][bj][0][n];
        }
        asm volatile("s_waitcnt lgkmcnt(0)" ::: "memory"); __builtin_amdgcn_s_barrier(); asm volatile("" ::: "memory");
        typedef unsigned u32x2 __attribute__((ext_vector_type(2)));
        u32x2 hold[2][4];
#pragma unroll
        for (int n = 0; n < 2; ++n) {
            const int jg = u.pn * 128 + colw + 4 * n, jv = 2816 + jg;
            f32x4 cw0[2], cw1[2], cw2[2], cbb[2];
            cw0[0] = *(const f32x4*)(cw + jg); cw1[0] = *(const f32x4*)(cw + 5632 + jg); cw2[0] = *(const f32x4*)(cw + 2 * 5632 + jg); cbb[0] = *(const f32x4*)(cb + jg);
            cw0[1] = *(const f32x4*)(cw + jv); cw1[1] = *(const f32x4*)(cw + 5632 + jv); cw2[1] = *(const f32x4*)(cw + 2 * 5632 + jv); cbb[1] = *(const f32x4*)(cb + jv);
#pragma unroll
            for (int ai = 0; ai < 2; ++ai) {
                const int src = ai * 2 + wr - 1;
                f32x4 res[2][4];
#pragma unroll
                for (int bj = 0; bj < 2; ++bj) {
                    f32x4 o1 = {0.f, 0.f, 0.f, 0.f}, o2 = o1;
                    if (src >= 0) { const f32x4 e14 = *(const PG8_LAS f32x4*)(EX + (src * 2 + 0) * 256 + bj * 128 + colw + 4 * n), e15 = *(const PG8_LAS f32x4*)(EX + (src * 2 + 1) * 256 + bj * 128 + colw + 4 * n);
                        o1 = e15; o2 = (fr == 0) ? e14 : e15; }
#pragma unroll
                    for (int m = 0; m < 4; ++m) {
                        const f32x4 x = acc[ai][bj][m][n];
                        const f32x4 x1 = shr4<0x111>(o1, x), x2 = shr4<0x112>(o2, x);
                        res[bj][m] = cbb[bj] + cw0[bj] * x2 + cw1[bj] * x1 + cw2[bj] * x;
                        if (m < 3) { o1 = ror4<0x121>(x); o2 = ror4<0x122>(x); }
                    }
                }
#pragma unroll
                for (int m = 0; m < 4; ++m) {
                    const f32x4 gc = res[0][m], vc = res[1][m];
                    f32x4 o;
                    o.x = gc.x * __builtin_amdgcn_rcpf(1.f + __expf(-gc.x)) * vc.x; o.y = gc.y * __builtin_amdgcn_rcpf(1.f + __expf(-gc.y)) * vc.y;
                    o.z = gc.z * __builtin_amdgcn_rcpf(1.f + __expf(-gc.z)) * vc.z; o.w = gc.w * __builtin_amdgcn_rcpf(1.f + __expf(-gc.w)) * vc.w;
                    u32x2 w; w.x = cvt_pk_bf16(o.x, o.y); w.y = cvt_pk_bf16(o.z, o.w);
                    if (n == 0) hold[ai][m] = w;
                    else *(u32x4*)(ACT + (size_t)(u.pm * BM + ai * HALF + wr * 64 + m * 16 + fr) * 2816 + u.pn * 128 + colw) = (u32x4){hold[ai][m].x, hold[ai][m].y, w.x, w.y};
                }
            }
        }
    }
};
}

namespace hy {
struct Args { const float* in[31]; float* out; unsigned char* ws; };
__global__ void __launch_bounds__(NT, 2) hy_fwd(Args A) {
    extern __shared__ __attribute__((aligned(16))) unsigned char lds_raw[];
    Ctx C; C.bid = blockIdx.x; C.nb = gridDim.x; C.tid = threadIdx.x; C.lane = C.tid & 63; C.wave = __builtin_amdgcn_readfirstlane(C.tid >> 6); C.lds = (LAS unsigned char*)lds_raw;
    volatile LAS unsigned* MISC = (volatile LAS unsigned*)(C.lds + MISC_OFF);
    for (int u = C.tid; u < (LDS_BYTES - MISC_OFF) / 4; u += NT) ((LAS unsigned*)(C.lds + MISC_OFF))[u] = 0u;
    __syncthreads();
    unsigned char* ws = A.ws;
    const int wave0 = __builtin_amdgcn_readfirstlane(threadIdx.x >> 6);
    (void)xcd_barrier_post((unsigned*)(ws + WS_CTL) + CW_BAR, MISC + 8);
#define PHASE_BEGIN() do { int t_ = wave0 * 64 + lane_now(); int b_ = blockIdx.x; asm volatile("" : "+s"(b_)); \
    C.tid = t_; C.lane = t_ & 63; C.wave = __builtin_amdgcn_readfirstlane(t_ >> 6); C.bid = b_; } while (0)
#ifdef HY_DIAG
    unsigned long long ts_last = __builtin_amdgcn_s_memrealtime(); float tacc[10] = {0.f, 0.f, 0.f, 0.f, 0.f, 0.f, 0.f, 0.f, 0.f, 0.f};
#define GRID_BAR(cat) do { { XcdBarrier b_; b_.bar = (unsigned*)(A.ws + WS_CTL) + CW_BAR; b_.x = xb_xcc_id(); b_.st = (volatile LAS unsigned*)(C.lds + MISC_OFF) + 8; xcd_barrier(b_, wave0 == 0 && lane_now() == 0); } PHASE_BEGIN(); { const unsigned long long n_ = __builtin_amdgcn_s_memrealtime(); tacc[cat] += (float)(n_ - ts_last); ts_last = n_; } } while (0)
#else
#define GRID_BAR(cat) do { { XcdBarrier b_; b_.bar = (unsigned*)(A.ws + WS_CTL) + CW_BAR; b_.x = xb_xcc_id(); b_.st = (volatile LAS unsigned*)(C.lds + MISC_OFF) + 8; xcd_barrier(b_, wave0 == 0 && lane_now() == 0); } PHASE_BEGIN(); } while (0)
#endif
#ifndef HY_REPCAT
#define HY_REPCAT (-1)
#endif
#ifndef HY_REPN
#define HY_REPN 2
#endif
#define NREP(cat) ((HY_REPCAT == (cat)) ? HY_REPN : 1)
    float* out = A.out;
    bf16* RES = (bf16*)((unsigned char*)A.out + 64 * MiB);
#define in A.in
    float* MOD = (float*)(ws + WS_MOD);
    bf16 *WIN = (bf16*)(ws + WS_WIN), *WOUT = (bf16*)(ws + WS_WOUT), *WUP = (bf16*)(ws + WS_WUP), *WDN = (bf16*)(ws + WS_WDN);
    bf16 *XB = (bf16*)(ws + WS_XB), *O = (bf16*)(ws + WS_O), *VF = (bf16*)(ws + WS_VF), *PG = (bf16*)(ws + WS_PG), *PR = (bf16*)(ws + WS_PR), *VL = (bf16*)(ws + WS_VL);
    bf16 *RH = (bf16*)(ws + WS_RH), *YH = (bf16*)(ws + WS_YH), *PP = (bf16*)(ws + WS_PP), *QQ = (bf16*)(ws + WS_QQ), *GG = (bf16*)(ws + WS_GG), *S0 = (bf16*)(ws + WS_S0);
    float *GAMC = (float*)(ws + WS_GAMC), *RK = (float*)(ws + WS_RK);
    bf16* VP = (bf16*)A.out;
    bf16* LORA = (bf16*)(ws + WS_LORA);
    bf16* DS = (bf16*)(ws + WS_GK); float* GAM = (float*)(ws + WS_GAM);
    bf16* ACT = (bf16*)(ws + WS_ACT); float *HALO = (float*)(ws + WS_U), *FIXU = (float*)(ws + WS_U + 8 * MiB);

    ph_mod(C, in[1], in[2], in[3], MOD);
    for (int l = 0; l < L_; ++l) {
        const float* modl = MOD + (size_t)l * 4 * 6144;
        for (int r_ = 0; r_ < NREP(0); ++r_) {
        wprep_mat(C, in[5] + (size_t)l * D_ * IN_COLS, D_, IN_COLS, NIN, WIN, 1, l ? in[6] : nullptr);
        wprep_mat(C, in[24] + (size_t)l * D_ * D_, D_, D_, D_, WOUT, 3, nullptr);
        wprep_mat(C, in[26] + (size_t)l * D_ * NUP, D_, NUP, NUP, WUP, 2, nullptr);
        wprep_mat(C, in[29] + (size_t)l * DFF * D_, DFF, D_, D_, WDN, 0, nullptr);
        wprep_mat(C, in[12] + (size_t)l * 64 * 512, 64, 512, 512, LORA, 0, nullptr);
        wprep_mat(C, in[14] + (size_t)l * 64 * 512, 64, 512, 512, LORA + 512 * 64, 0, nullptr);
        wprep_mat(C, in[16] + (size_t)l * 128 * 512, 128, 512, 512, LORA + 2 * 512 * 64, 0, nullptr);
        if (l) wprep_mat(C, in[17], 32, 512, 512, LORA + 2 * 512 * 64 + 512 * 128, 0, nullptr);
        }
        GRID_BAR(0);
        for (int r_ = 0; r_ < NREP(1); ++r_) { if (l == 0) ph_norm(C, in[0], in[4], modl + 0 * D_, modl + 1 * D_, XB); else ph_norm_b(C, RES, in[4] + l * D_, modl + 0 * D_, modl + 1 * D_, XB); }
        GRID_BAR(1);
        for (int r_ = 0; r_ < NREP(2); ++r_) { pg8::Gemm g{XB, WIN, M_, NIN, D_}; pg8::StaticOrder S; S.init(M_, NIN, C.nb, C.bid, HY_WGM_IN);
          pg8::EpiBf16<0> E{PG, NPG, nullptr, NPG, (WS_PR - WS_PG) / 2, 1.f};
          pg8::gemm_phase<pg8::EpiBf16<0>, pg8::StaticOrder, true, true>(C.lds, g, S, E, C.tid); }
        GRID_BAR(2);
        for (int r_ = 0; r_ < NREP(3); ++r_) {
        ph_gla_a(C, PG, in[7] + l * 16 * 256, in[8] + l * 256, DS, GAM);
        { RwkvW W{in[10] + l * 1792, in[11], in[13] + l * 512, in[15] + l * 512, in[18], in[19] + l * 512, in[20] + l * 512, in[21] + l * 512,
                  LORA, LORA + 512 * 64, LORA + 2 * 512 * 64, LORA + 2 * 512 * 64 + 512 * 128};
          ph_rwkv_a(C, PR, PG, W, l, PP, QQ, RH, YH, GAMC, RK, GG, VF, VP, r_ == NREP(3) - 1); } }
        GRID_BAR(3);
        if (C.bid < 32) { for (int r_ = 0; r_ < NREP(4); ++r_) ph_rwkv_b(C, C.bid, PP, QQ, GAMC, S0); }
        else { Ctx C2 = C; C2.bid = C.bid - 32; C2.nb = C.nb - 32;
               ph_gla_b(C2, DS, GAM);
               group_barrier((unsigned*)(ws + WS_CTL) + 2048, (unsigned)(C.nb - 32) * (unsigned)(l + 1), wave0 == 0 && lane_now() == 0);
               PHASE_BEGIN(); C2 = C; C2.bid = C.bid - 32; C2.nb = C.nb - 32;
               for (int r_ = 0; r_ < NREP(10); ++r_) ph_gla_c(C2, PG, in[9] + l * 128, DS, O); }
        GRID_BAR(4);
        for (int r_ = 0; r_ < NREP(5); ++r_) {
        ph_rwkv_c(C, S0, RH, YH, RK, GG, VP, in[22] + l * 512, in[23] + l * 512, O); }
        GRID_BAR(5);
        { pg8::Gemm g{O, WOUT, M_, D_, D_}; pg8::StaticOrder S; S.init(M_, D_, C.nb, C.bid);
          if (l == 0) { pg8::EpiResB<true> E{in[0], nullptr, RES, modl + 2 * D_, 6144}; pg8::gemm_phase<pg8::EpiResB<true>, pg8::StaticOrder, true, true>(C.lds, g, S, E, C.tid); }
          else { pg8::EpiResB<false> E{nullptr, RES, RES, modl + 2 * D_, 6144}; pg8::gemm_phase<pg8::EpiResB<false>, pg8::StaticOrder, true, true>(C.lds, g, S, E, C.tid); } }
        GRID_BAR(6);
        for (int r_ = 0; r_ < NREP(1); ++r_) ph_norm_b(C, RES, in[25] + l * D_, modl + 3 * D_, modl + 4 * D_, XB);
        GRID_BAR(1);
        for (int r_ = 0; r_ < NREP(7); ++r_) { pg8::Gemm g{XB, WUP, M_, NUP, D_}; pg8::StaticOrder S; S.init(M_, NUP, C.nb, C.bid, HY_WGM_UP);
          pg8::EpiConv E{ACT, in[27] + (size_t)l * 3 * NUP, in[28] + (size_t)l * NUP, HALO, FIXU, (PG8_LAS float*)(C.lds + RING_BYTES), NUP / 256};
          pg8::gemm_phase<pg8::EpiConv, pg8::StaticOrder, true, true>(C.lds, g, S, E, C.tid); }
        GRID_BAR(7);
        for (int r_ = 0; r_ < NREP(8); ++r_) ph_convfix(C, HALO, FIXU, in[27] + (size_t)l * 3 * NUP, in[28] + (size_t)l * NUP, ACT);
        GRID_BAR(8);
        { pg8::Gemm g{ACT, WDN, M_, D_, DFF}; pg8::StaticOrder S; S.init(M_, D_, C.nb, C.bid);
          pg8::EpiResB<false> E{nullptr, RES, (l == L_ - 1) ? XB : RES, modl + 5 * D_, 6144};
          pg8::gemm_phase<pg8::EpiResB<false>, pg8::StaticOrder, true, true>(C.lds, g, S, E, C.tid); }
        GRID_BAR(9);
    }
    ph_final_b(C, XB, in[30], out, 0, M_, nullptr, 0, 0);
#ifdef HY_DIAG
    GRID_BAR(1);
    if (C.bid == 0) { if (C.tid == 0) out[0] = tacc[HY_DIAG_A] * 0.1f; for (int i = 1 + C.tid; i <= 10000; i += NT) out[i] = tacc[HY_DIAG_B] * 0.01f; }
#endif
#undef GRID_BAR
#undef PHASE_BEGIN
#undef in
}
}

extern "C" void kernel_launch(void* const* d_in, const int* in_sizes, int n_in, void* d_out, int out_size, void* d_ws, size_t ws_size, hipStream_t stream) {
    using namespace hy;
    static int grid = 0;
    if (grid == 0) {
        if (n_in != 31 || in_sizes[0] != M_ * D_ || out_size != M_ * D_ || ws_size < WS_END) { fprintf(stderr, "kernel_launch: unexpected shapes (n_in %d, in0 %d, out %d, ws %zu)\n", n_in, n_in > 0 ? in_sizes[0] : -1, out_size, ws_size); grid = -1; return; }
        if (hipFuncSetAttribute((const void*)hy_fwd, hipFuncAttributeMaxDynamicSharedMemorySize, LDS_BYTES) != hipSuccess) { fprintf(stderr, "kernel_launch: hipFuncSetAttribute failed\n"); grid = -1; return; }
        int dev = 0, cus = 0, per_cu = 0;
        (void)hipGetDevice(&dev); (void)hipDeviceGetAttribute(&cus, hipDeviceAttributeMultiprocessorCount, dev);
        (void)hipOccupancyMaxActiveBlocksPerMultiprocessor(&per_cu, (const void*)hy_fwd, NT, LDS_BYTES);
        if (per_cu < 1) fprintf(stderr, "kernel_launch: occupancy query reports %d blocks per CU\n", per_cu);
        (void)hipGetLastError();
        grid = cus > 0 ? cus : 256;
    }
    if (grid < 0) return;
    (void)hipMemsetAsync((char*)d_ws + WS_CTL, 0, CTL_ZERO_BYTES, stream);
    Args a{};
    for (int i = 0; i < 31; ++i) a.in[i] = (const float*)d_in[i];
    a.out = (float*)d_out; a.ws = (unsigned char*)d_ws;
    hipLaunchKernelGGL(hy_fwd, dim3(grid), dim3(NT), LDS_BYTES, stream, a);
}
```
